# Optimizing an MI355X kernel written in HIP

```python
import math
import jax, jax.numpy as jnp
from jax import lax
import numpy as np

D_MODEL = 1024
BATCH = 8
SEQ = 4096
DEPTH = 1

POOL_WIDTH = D_MODEL // 2
POOL_WINDOWS = (2, 4, 8, 16)
POOL_GROUPS = len(POOL_WINDOWS)
POOL_GROUP_DIM = POOL_WIDTH // POOL_GROUPS
N_HEADS = 8
N_KV_GROUPS = 2
HEADS_PER_GROUP = N_HEADS // N_KV_GROUPS
HEAD_DIM = 64
Q_WIDTH = N_HEADS * HEAD_DIM
KV_WIDTH = N_KV_GROUPS * HEAD_DIM
CMP_BLOCK = 32
CMP_STRIDE = 16
CMP_HIDDEN = 128
SEL_BLOCK = 64
SEL_TOPK = 16
WINDOW = 512
Q_CHUNK = 64
FORCE_SCORE = 1000.0
N_BUCKETS = 32
MAX_DISTANCE = 128
PEER_HEADS = 8
PEER_KEYS = 128
PEER_EXPERTS = PEER_KEYS * PEER_KEYS
PEER_TOPK = 16
PEER_QDIM = 256
PEER_CHUNK = 128
IN_SIZES = (POOL_WIDTH, Q_WIDTH, KV_WIDTH, KV_WIDTH, KV_WIDTH, KV_WIDTH, KV_WIDTH, KV_WIDTH, N_HEADS * 3, 2 * D_MODEL)
IN_COLS = sum(IN_SIZES)
EPS = 1e-6
NEG_INF = -1e30

kernel_name = 'hybrid_pool_nsa_peer_block'


def rms_norm(x, g):
    xf = x.astype(jnp.float32)
    y = xf * lax.rsqrt(jnp.mean(xf * xf, axis=-1, keepdims=True) + EPS)
    return (y * g.astype(jnp.float32)).astype(x.dtype)


def masked_softmax(logits, valid):
    lf = jnp.where(valid, logits.astype(jnp.float32), NEG_INF)
    p = jax.nn.softmax(lf, axis=-1)
    return jnp.where(valid, p, 0.0)


def t5_bucket(rel):
    n = jnp.maximum(rel, 0)
    max_exact = N_BUCKETS // 2
    nf = jnp.maximum(n, 1).astype(jnp.float32)
    large = max_exact + (jnp.log(nf / max_exact) / math.log(MAX_DISTANCE / max_exact) * (N_BUCKETS - max_exact)).astype(jnp.int32)
    large = jnp.minimum(large, N_BUCKETS - 1)
    return jnp.where(n < max_exact, n, large)


def rel_bias_dense(table, rel):
    b = table[t5_bucket(rel)]
    return jnp.transpose(b, (2, 0, 1)).reshape(N_KV_GROUPS, HEADS_PER_GROUP, *rel.shape)


def sel_mapping(n_cmp, n_sel):
    m = np.zeros((n_cmp, n_sel), np.float32)
    pos = np.arange(n_cmp)[:, None] * CMP_STRIDE + np.arange(CMP_BLOCK)[None, :]
    np.add.at(m, (np.repeat(np.arange(n_cmp), CMP_BLOCK), (pos // SEL_BLOCK).ravel()), 1.0 / CMP_BLOCK)
    return jnp.asarray(m)


def pool_mixer(u, w_pool, pool_scale):
    b_, s_, c_ = u.shape
    uf = u.astype(jnp.float32)
    csp = jnp.concatenate([jnp.zeros((b_, 1, c_), jnp.float32), jnp.cumsum(uf, axis=1)], axis=1)
    t = jnp.arange(s_)
    outs = []
    for gi, w in enumerate(POOL_WINDOWS):
        sl = slice(gi * POOL_GROUP_DIM, (gi + 1) * POOL_GROUP_DIM)
        cg = csp[:, :, sl]
        upper = cg[:, 1:]
        lower = jnp.pad(cg[:, :s_ + 1 - w], ((0, 0), (w - 1, 0), (0, 0)))
        cnt = jnp.minimum(t + 1, w).astype(jnp.float32)[:, None]
        outs.append((upper - lower) / cnt - uf[:, :, sl])
    pooled = jnp.stack(outs, axis=2).astype(u.dtype)
    y = jnp.einsum('bsgc,gcd->bsgd', pooled, w_pool).reshape(b_, s_, POOL_WIDTH)
    return y * pool_scale


def compress_blocks(t, pe, w1, w2):
    b_, g_, s_, dh = t.shape
    ratio = CMP_BLOCK // CMP_STRIDE
    n_str = s_ // CMP_STRIDE
    n_cmp = n_str - ratio + 1
    pieces = t.reshape(b_, g_, n_str, CMP_STRIDE, dh)
    blk = jnp.concatenate([pieces[:, :, r:r + n_cmp] for r in range(ratio)], axis=3)
    blk = (blk + pe).reshape(b_, g_, n_cmp, CMP_BLOCK * dh)
    return jax.nn.gelu(blk @ w1) @ w2


def nsa_attention(q, kc, vc, ks, vs, kw, vw, gates, rel_bias):
    b_, g_, j_, s_, dh = q.shape
    scale = dh ** -0.5
    n_cmp = kc.shape[2]
    n_sel = s_ // SEL_BLOCK
    k_top = min(SEL_TOPK, n_sel)
    cmp_end = jnp.arange(n_cmp) * CMP_STRIDE + CMP_BLOCK - 1
    smap = sel_mapping(n_cmp, n_sel)
    ksb = ks.reshape(b_, g_, n_sel, SEL_BLOCK, dh)
    vsb = vs.reshape(b_, g_, n_sel, SEL_BLOCK, dh)
    kw_pad = jnp.pad(kw, ((0, 0), (0, 0), (WINDOW, 0), (0, 0)))
    vw_pad = jnp.pad(vw, ((0, 0), (0, 0), (WINDOW, 0), (0, 0)))
    tbl_g = rel_bias.reshape(N_BUCKETS, g_, j_)
    bi = jnp.arange(b_)[:, None, None, None]
    gi = jnp.arange(g_)[None, :, None, None]
    blk_id = jnp.arange(n_sel)

    def chunk(ci):
        s0 = ci * Q_CHUNK
        qc = lax.dynamic_slice_in_dim(q, s0, Q_CHUNK, axis=3)
        gc = lax.dynamic_slice_in_dim(gates, s0, Q_CHUNK, axis=3)
        tpos = s0 + jnp.arange(Q_CHUNK)
        rel_c = tpos[:, None] - cmp_end[None, :]
        lg_c = jnp.einsum('bgjqd,bgnd->bgjqn', qc, kc) * scale + rel_bias_dense(rel_bias, rel_c)
        p_c = masked_softmax(lg_c, rel_c >= 0)
        o_cmp = jnp.einsum('bgjqn,bgnd->bgjqd', p_c.astype(vc.dtype), vc)
        imp = jnp.einsum('bgjqn,ns->bgqs', p_c, smap)
        cur = tpos // SEL_BLOCK
        forced = (blk_id[None, :] == 0) | (blk_id[None, :] == cur[:, None]) | (blk_id[None, :] == cur[:, None] - 1)
        visible = blk_id[None, :] * SEL_BLOCK <= tpos[:, None]
        score = jnp.where(visible, imp + jnp.where(forced, FORCE_SCORE, 0.0), -1.0)
        _, idx = lax.top_k(score, k_top)
        k_g = ksb[bi, gi, idx].reshape(b_, g_, Q_CHUNK, k_top * SEL_BLOCK, dh)
        v_g = vsb[bi, gi, idx].reshape(b_, g_, Q_CHUNK, k_top * SEL_BLOCK, dh)
        kpos = (idx[..., None] * SEL_BLOCK + jnp.arange(SEL_BLOCK)).reshape(b_, g_, Q_CHUNK, k_top * SEL_BLOCK)
        rel_s = tpos[None, None, :, None] - kpos
        bias_s = jnp.moveaxis(tbl_g[t5_bucket(rel_s), gi], -1, 2)
        lg_s = jnp.einsum('bgjqd,bgqkd->bgjqk', qc, k_g) * scale + bias_s
        p_s = masked_softmax(lg_s, (rel_s >= 0)[:, :, None])
        o_sel = jnp.einsum('bgjqk,bgqkd->bgjqd', p_s.astype(v_g.dtype), v_g)
        kwc = lax.dynamic_slice_in_dim(kw_pad, s0, WINDOW + Q_CHUNK, axis=2)
        vwc = lax.dynamic_slice_in_dim(vw_pad, s0, WINDOW + Q_CHUNK, axis=2)
        kpos_w = s0 - WINDOW + jnp.arange(WINDOW + Q_CHUNK)
        rel_w = tpos[:, None] - kpos_w[None, :]
        valid_w = (rel_w >= 0) & (rel_w < WINDOW) & (kpos_w >= 0)[None, :]
        lg_w = jnp.einsum('bgjqd,bgkd->bgjqk', qc, kwc) * scale + rel_bias_dense(rel_bias, rel_w)
        p_w = masked_softmax(lg_w, valid_w)
        o_win = jnp.einsum('bgjqk,bgkd->bgjqd', p_w.astype(vwc.dtype), vwc)
        out = gc[..., 0:1] * o_cmp + gc[..., 1:2] * o_sel + gc[..., 2:3] * o_win
        return out.astype(q.dtype)

    outs = lax.map(chunk, jnp.arange(s_ // Q_CHUNK))
    return jnp.transpose(outs, (1, 0, 4, 2, 3, 5)).reshape(b_, s_, g_ * j_ * dh)


def peer_ffn(h, w_q, sub_keys, u, v):
    b_, s_, d_ = h.shape
    tokens = h.reshape(-1, PEER_CHUNK, d_)

    def chunk(xc):
        qv = (xc @ w_q).reshape(PEER_CHUNK, PEER_HEADS, 2, PEER_QDIM // 2)
        sc = jnp.einsum('chpd,hpkd->chpk', qv, sub_keys).astype(jnp.float32)
        s_half, i_half = lax.top_k(sc, PEER_TOPK)
        cand = (s_half[:, :, 0, :, None] + s_half[:, :, 1, None, :]).reshape(PEER_CHUNK, PEER_HEADS, PEER_TOPK * PEER_TOPK)
        cid = (i_half[:, :, 0, :, None] * PEER_KEYS + i_half[:, :, 1, None, :]).reshape(PEER_CHUNK, PEER_HEADS, PEER_TOPK * PEER_TOPK)
        top_s, top_j = lax.top_k(cand, PEER_TOPK)
        eid = jnp.take_along_axis(cid, top_j, axis=-1)
        g = jax.nn.softmax(top_s, axis=-1).astype(xc.dtype)
        ue = u[eid]
        ve = v[eid]
        a = jax.nn.gelu(jnp.einsum('cd,chkd->chk', xc, ue))
        return jnp.einsum('chk,chkd->cd', g * a, ve)

    return lax.map(chunk, tokens).reshape(b_, s_, d_)


def setup_inputs(seed: int = 0) -> dict:
    key = jax.random.key(seed)
    ks = jax.random.split(key, 25)
    f32 = jnp.float32
    L = DEPTH
    D = D_MODEL

    def nrm(k, shape, s):
        return jax.random.normal(k, shape, f32) * s

    return {
        'x': nrm(ks[0], (BATCH, SEQ, D), 1.0),
        'c': nrm(ks[1], (BATCH, D), 1.0),
        'rel_bias': nrm(ks[2], (N_BUCKETS, N_HEADS), 0.5),
        'ada_w': nrm(ks[3], (L, D, 6 * D), 0.5 * D ** -0.5),
        'ada_b': nrm(ks[4], (L, 6 * D), 0.01),
        'norm1_g': 1.0 + nrm(ks[5], (L, D), 0.05),
        'norm2_g': 1.0 + nrm(ks[6], (L, D), 0.05),
        'w_in': nrm(ks[7], (L, D, IN_COLS), D ** -0.5),
        'pool_w': nrm(ks[8], (L, POOL_GROUPS, POOL_GROUP_DIM, POOL_GROUP_DIM), POOL_GROUP_DIM ** -0.5),
        'pool_scale': 1.0 + nrm(ks[9], (L, POOL_WIDTH), 0.05),
        'cmp_pe_k': nrm(ks[10], (L, CMP_BLOCK, HEAD_DIM), 0.5),
        'cmp_w1_k': nrm(ks[11], (L, CMP_BLOCK * HEAD_DIM, CMP_HIDDEN), (CMP_BLOCK * HEAD_DIM) ** -0.5),
        'cmp_w2_k': nrm(ks[12], (L, CMP_HIDDEN, HEAD_DIM), CMP_HIDDEN ** -0.5),
        'cmp_pe_v': nrm(ks[13], (L, CMP_BLOCK, HEAD_DIM), 0.5),
        'cmp_w1_v': nrm(ks[14], (L, CMP_BLOCK * HEAD_DIM, CMP_HIDDEN), (CMP_BLOCK * HEAD_DIM) ** -0.5),
        'cmp_w2_v': nrm(ks[15], (L, CMP_HIDDEN, HEAD_DIM), CMP_HIDDEN ** -0.5),
        'q_norm_g': 1.0 + nrm(ks[16], (L, HEAD_DIM), 0.05),
        'k_norm_g': 1.0 + nrm(ks[17], (L, 3, HEAD_DIM), 0.05),
        'w_branch_pool': nrm(ks[18], (L, POOL_WIDTH, D), POOL_WIDTH ** -0.5),
        'w_branch_attn': nrm(ks[19], (L, Q_WIDTH, D), Q_WIDTH ** -0.5),
        'w_out': nrm(ks[20], (L, D, D), D ** -0.5),
        'peer_w_q': nrm(ks[21], (L, D, PEER_HEADS * PEER_QDIM), D ** -0.5),
        'peer_sub_keys': nrm(ks[22], (L, PEER_HEADS, 2, PEER_KEYS, PEER_QDIM // 2), (PEER_QDIM // 2) ** -0.5),
        'peer_u': nrm(ks[23], (L, PEER_EXPERTS, D), D ** -0.5),
        'peer_v': nrm(ks[24], (L, PEER_EXPERTS, D), PEER_HEADS ** -0.5),
    }


def reference(x, c, rel_bias, ada_w, ada_b, norm1_g, norm2_g, w_in, pool_w, pool_scale, cmp_pe_k, cmp_w1_k, cmp_w2_k, cmp_pe_v, cmp_w1_v, cmp_w2_v, q_norm_g, k_norm_g, w_branch_pool, w_branch_attn, w_out, peer_w_q, peer_sub_keys, peer_u, peer_v):
    b_, s_, d_ = x.shape
    split_at = np.cumsum(IN_SIZES)[:-1].tolist()

    def to_groups(t):
        return jnp.transpose(t.reshape(b_, s_, N_KV_GROUPS, HEAD_DIM), (0, 2, 1, 3))

    for l in range(DEPTH):
        ada = (jax.nn.silu(c) @ ada_w[l] + ada_b[l]).reshape(b_, 6, 1, d_)
        shift1, scale1, gate1 = ada[:, 0], ada[:, 1], ada[:, 2]
        shift2, scale2, gate2 = ada[:, 3], ada[:, 4], ada[:, 5]
        h = rms_norm(x, norm1_g[l]) * (1.0 + scale1) + shift1
        z = h @ w_in[l]
        z_pool, z_q, z_kc, z_vc, z_ks, z_vs, z_kw, z_vw, z_gate, z_merge = jnp.split(z, split_at, axis=-1)
        y_pool = pool_mixer(z_pool, pool_w[l], pool_scale[l])
        q = rms_norm(z_q.reshape(b_, s_, N_KV_GROUPS, HEADS_PER_GROUP, HEAD_DIM), q_norm_g[l])
        q = jnp.transpose(q, (0, 2, 3, 1, 4))
        kc = rms_norm(compress_blocks(to_groups(z_kc), cmp_pe_k[l], cmp_w1_k[l], cmp_w2_k[l]), k_norm_g[l, 0])
        vc = compress_blocks(to_groups(z_vc), cmp_pe_v[l], cmp_w1_v[l], cmp_w2_v[l])
        ksl = rms_norm(to_groups(z_ks), k_norm_g[l, 1])
        vsl = to_groups(z_vs)
        kwn = rms_norm(to_groups(z_kw), k_norm_g[l, 2])
        vwn = to_groups(z_vw)
        gates = jnp.transpose(jax.nn.sigmoid(z_gate.reshape(b_, s_, N_KV_GROUPS, HEADS_PER_GROUP, 3)), (0, 2, 3, 1, 4))
        y_attn = nsa_attention(q, kc, vc, ksl, vsl, kwn, vwn, gates, rel_bias)
        g_merge = jax.nn.sigmoid(z_merge).reshape(b_, s_, 2, d_)
        mixed = g_merge[:, :, 0] * (y_pool @ w_branch_pool[l]) + g_merge[:, :, 1] * (y_attn @ w_branch_attn[l])
        x = x + gate1 * (mixed @ w_out[l])
        h2 = rms_norm(x, norm2_g[l]) * (1.0 + scale2) + shift2
        x = x + gate2 * peer_ffn(h2, peer_w_q[l], peer_sub_keys[l], peer_u[l], peer_v[l])
    return x
```

```cpp
#include <hip/hip_runtime.h>
#include <cstdio>
#include <cstdint>
namespace pg8 {
#define PG8_LAS __attribute__((address_space(3)))
typedef unsigned short bf16_t;
typedef short bf16x8 __attribute__((ext_vector_type(8)));
typedef float f32x4 __attribute__((ext_vector_type(4)));
typedef unsigned u32x4 __attribute__((ext_vector_type(4)));
constexpr int BM = 256, BK = 64, HALF = 128, HTB = HALF * BK * 2  , STAGE_BYTES = 8 * HTB, NXCD = 8, WGM = 8;

__host__ __device__ __forceinline__ int lds_byte(int r, int c) { const int st = (r >> 4) * 2 + (c >> 5), rr = r & 15, cc = c & 31, ob = rr * 64 + cc * 2; return st * 1024 + (ob ^ (((ob >> 9) & 1) << 5)); }
__host__ __device__ __forceinline__ void stage_rc(int b, int& R, int& C) { const int st = b / 1024, sb = b % 1024, swz = sb ^ (((sb >> 9) & 1) << 5); R = (st >> 1) * 16 + swz / 64; C = (st & 1) * 32 + (swz % 64) / 2; }
__host__ __device__ __forceinline__ int perm32(int rho) { const int n = rho >> 4, i = rho & 15; return 8 * (i >> 2) + 4 * n + (i & 3); }

struct Unit { int pm, pn; };
struct Gemm { const bf16_t* A; const bf16_t* Bt; int M, N, K, lda, ldb; };

struct StaticOrder {
    int nM, nN, nwg, G, c;
    __host__ __device__ void init(int M, int N, int G_, int c_) { nM = M / BM; nN = N / BM; nwg = nM * nN; G = G_; c = c_; }
    __host__ __device__ bool next(int i, Unit& u) const {
        const long L = (long)i * G + c; if (L >= nwg) return false;
        int wgid = (int)L; { const int q = nwg / NXCD, r = nwg % NXCD, xcd = wgid % NXCD, off = wgid / NXCD; wgid = (xcd < r ? xcd * (q + 1) : r * (q + 1) + (xcd - r) * q) + off; }
        const int nig = WGM * nN, gid = wgid / nig, fm = gid * WGM, gsz = (nM - fm) < WGM ? (nM - fm) : WGM;
        u.pm = fm + ((wgid % nig) % gsz); u.pn = (wgid % nig) / gsz; return true;
    }
    __device__ __forceinline__ void a_ready(const Unit&) const {}
    __device__ __forceinline__ void done(const Unit&) const {}
};

__device__ __forceinline__ unsigned cvt_pk_bf16(float lo, float hi) { unsigned r; asm volatile("v_cvt_pk_bf16_f32 %0, %1, %2" : "=v"(r) : "v"(lo), "v"(hi)); return r; }
template <class Epi, class Sched, bool ALIGN_EPI = false, bool SP2 = false>
__device__ __forceinline__ void gemm_phase(PG8_LAS unsigned char* lds, const Gemm g, const Sched& S, const Epi& E) {
    const int tid = threadIdx.x, wid = __builtin_amdgcn_readfirstlane(tid >> 6), lane = tid & 63, wr = wid >> 2, wc = wid & 3, fr = lane & 15, fq = lane >> 4;
    const int K = g.K, nt = K / BK;
    unsigned voffA[2], voffB[2];
#pragma unroll
    for (int i = 0; i < 2; ++i) { int R, C; stage_rc(tid * 16 + i * 8192, R, C); const int Rb = Epi::PERM ? ((R & ~31) + perm32(R & 31)) : R;
        voffA[i] = (unsigned)(R * g.lda + C) * 2u; voffB[i] = (unsigned)(Rb * g.ldb + C) * 2u; }
    const size_t kstep = (size_t)(BK * 2);
    const size_t hstepA = (size_t)HALF * g.lda * 2, hstepB = (size_t)HALF * g.ldb * 2;
    const size_t tstepA = 2 * hstepA, tstepB = 2 * hstepB;
    const unsigned ldsw = (unsigned)wid * 1024u;
    const int aoff = lds_byte(wr * 64 + fr, fq * 8), boff = lds_byte(wc * 32 + fr, fq * 8);
#define PG8_SA(b, h) (((b) * 2 + (h)) * HTB)
#define PG8_SB(b, h) ((4 + (b) * 2 + (h)) * HTB)
#define PG8_STAGE(bufoff, gbase, voff) do { _Pragma("unroll") for (int _i = 0; _i < 2; ++_i) \
        __builtin_amdgcn_global_load_lds((const unsigned*)((const char*)(gbase) + (voff)[_i]), (PG8_LAS unsigned*)(lds + (bufoff) + ldsw + _i * 8192), 16, 0, 0); } while (0)
#define PG8_LDA(dst, b, h) do { _Pragma("unroll") for (int m = 0; m < 4; ++m) _Pragma("unroll") for (int k = 0; k < 2; ++k) dst[m][k] = *(const PG8_LAS bf16x8*)(lds + PG8_SA(b, h) + aoff + m * 2048 + k * 1024); } while (0)
#define PG8_LDB(dst, b, h) do { _Pragma("unroll") for (int n = 0; n < 2; ++n) _Pragma("unroll") for (int k = 0; k < 2; ++k) dst[n][k] = *(const PG8_LAS bf16x8*)(lds + PG8_SB(b, h) + boff + n * 2048 + k * 1024); } while (0)
#define PG8_MMA(ai, bj, At, Bt) do { __builtin_amdgcn_s_setprio(1); _Pragma("unroll") for (int m = 0; m < 4; ++m) _Pragma("unroll") for (int n = 0; n < 2; ++n) _Pragma("unroll") for (int k = 0; k < 2; ++k) \
        acc[ai][bj][m][n] = __builtin_amdgcn_mfma_f32_16x16x32_bf16(Bt[n][k], At[m][k], acc[ai][bj][m][n], 0, 0, 0); __builtin_amdgcn_s_setprio(0); } while (0)
#define PG8_WAIT_V(n) asm volatile("s_waitcnt vmcnt(" #n ")" ::: "memory")
#define PG8_WAIT_L(n) asm volatile("s_waitcnt lgkmcnt(" #n ")" ::: "memory")
#define PG8_BAR __builtin_amdgcn_s_barrier()
#define PG8_SCHED __builtin_amdgcn_sched_barrier(0)
    Unit cur, nxt; int ui = 0;
    if (!S.next(0, cur)) return;
    f32x4 acc[2][2][4][2];
#pragma unroll
    for (int a = 0; a < 2; ++a)
#pragma unroll
        for (int b = 0; b < 2; ++b)
#pragma unroll
            for (int m = 0; m < 4; ++m)
#pragma unroll
                for (int n = 0; n < 2; ++n) acc[a][b][m][n] = (f32x4){0.f, 0.f, 0.f, 0.f};
    bf16x8 At[4][2], B0[2][2], B1[2][2];
    const char* cA = (const char*)g.A + (size_t)cur.pm * tstepA; const char* cB = (const char*)g.Bt + (size_t)cur.pn * tstepB;
    S.a_ready(cur);
    if constexpr (SP2) {
        PG8_STAGE(PG8_SB(0, 0), cB, voffB); PG8_STAGE(PG8_SB(0, 1), cB + hstepB, voffB); PG8_STAGE(PG8_SA(0, 0), cA, voffA); PG8_STAGE(PG8_SA(0, 1), cA + hstepA, voffA);
        if (wr == 1) PG8_BAR;
        PG8_WAIT_V(2); PG8_BAR;
        PG8_STAGE(PG8_SB(1, 0), cB + kstep, voffB); PG8_STAGE(PG8_SA(1, 0), cA + kstep, voffA); PG8_STAGE(PG8_SB(1, 1), cB + hstepB + kstep, voffB);
        PG8_WAIT_V(6); PG8_BAR;
    } else {
        PG8_STAGE(PG8_SB(0, 0), cB, voffB); PG8_STAGE(PG8_SA(0, 0), cA, voffA); PG8_STAGE(PG8_SB(0, 1), cB + hstepB, voffB); PG8_STAGE(PG8_SA(0, 1), cA + hstepA, voffA);
        if (wr == 1) PG8_BAR;
        PG8_WAIT_V(4); PG8_BAR;
        PG8_STAGE(PG8_SB(1, 0), cB + kstep, voffB); PG8_STAGE(PG8_SA(1, 0), cA + kstep, voffA); PG8_STAGE(PG8_SB(1, 1), cB + hstepB + kstep, voffB);
        PG8_WAIT_V(6); PG8_BAR;
    }
    for (;;) {
        const bool has_next = S.next(ui + 1, nxt);
        const char* nA = has_next ? (const char*)g.A + (size_t)nxt.pm * tstepA : cA; const char* nB = has_next ? (const char*)g.Bt + (size_t)nxt.pn * tstepB : cB;
        for (int t = 0; t < nt; t += 2) {
            const bool last = (t == nt - 2);
            const char* a1 = cA + (size_t)(t + 1) * kstep;
            const char* a2 = last ? nA : cA + (size_t)(t + 2) * kstep; const char* b2 = last ? nB : cB + (size_t)(t + 2) * kstep;
            const char* a3 = a2 + kstep; const char* b3 = b2 + kstep;
            if (last && has_next) S.a_ready(nxt);
            if constexpr (SP2) {
            PG8_LDB(B0, 0, 0); PG8_LDB(B1, 0, 1); PG8_SCHED; PG8_LDA(At, 0, 0); PG8_STAGE(PG8_SA(1, 1), a1 + hstepA, voffA);
            PG8_WAIT_V(8); PG8_WAIT_L(0); PG8_BAR; PG8_MMA(0, 0, At, B0); PG8_MMA(0, 1, At, B1); PG8_BAR; PG8_SCHED;
            PG8_LDA(At, 0, 1); PG8_STAGE(PG8_SB(0, 0), b2, voffB); PG8_STAGE(PG8_SB(0, 1), b2 + hstepB, voffB); PG8_STAGE(PG8_SA(0, 0), a2, voffA);
            PG8_WAIT_V(8); PG8_WAIT_L(0); PG8_BAR; PG8_MMA(1, 0, At, B0); PG8_MMA(1, 1, At, B1); PG8_BAR; PG8_SCHED;
            PG8_LDB(B0, 1, 0); PG8_LDB(B1, 1, 1); PG8_SCHED; PG8_LDA(At, 1, 0); PG8_STAGE(PG8_SA(0, 1), a2 + hstepA, voffA);
            PG8_WAIT_V(8); PG8_WAIT_L(0); PG8_BAR; PG8_MMA(0, 0, At, B0); PG8_MMA(0, 1, At, B1); PG8_BAR; PG8_SCHED;
            PG8_LDA(At, 1, 1); PG8_STAGE(PG8_SB(1, 0), b3, voffB); PG8_STAGE(PG8_SB(1, 1), b3 + hstepB, voffB); PG8_STAGE(PG8_SA(1, 0), a3, voffA);
            PG8_WAIT_V(8); PG8_WAIT_L(0); PG8_BAR; PG8_MMA(1, 0, At, B0); PG8_MMA(1, 1, At, B1); PG8_BAR; PG8_SCHED;
            } else {
            PG8_LDB(B0, 0, 0); PG8_SCHED; PG8_LDA(At, 0, 0); PG8_STAGE(PG8_SA(1, 1), a1 + hstepA, voffA);
            PG8_WAIT_L(8); PG8_BAR; PG8_WAIT_L(0); PG8_MMA(0, 0, At, B0); PG8_BAR; PG8_SCHED;
            PG8_LDB(B1, 0, 1); PG8_STAGE(PG8_SB(0, 0), b2, voffB);
            PG8_BAR; PG8_WAIT_L(0); PG8_MMA(0, 1, At, B1); PG8_BAR;
            PG8_LDA(At, 0, 1); PG8_STAGE(PG8_SA(0, 0), a2, voffA);
            PG8_BAR; PG8_WAIT_L(0); PG8_MMA(1, 0, At, B0); PG8_BAR; PG8_SCHED;
            PG8_STAGE(PG8_SB(0, 1), b2 + hstepB, voffB);
            PG8_WAIT_V(6); PG8_BAR; PG8_MMA(1, 1, At, B1); PG8_BAR;
            PG8_LDB(B0, 1, 0); PG8_SCHED; PG8_LDA(At, 1, 0); PG8_STAGE(PG8_SA(0, 1), a2 + hstepA, voffA);
            PG8_WAIT_L(8); PG8_BAR; PG8_WAIT_L(0); PG8_MMA(0, 0, At, B0); PG8_BAR; PG8_SCHED;
            PG8_LDB(B1, 1, 1); PG8_STAGE(PG8_SB(1, 0), b3, voffB);
            PG8_BAR; PG8_WAIT_L(0); PG8_MMA(0, 1, At, B1); PG8_BAR;
            PG8_LDA(At, 1, 1); PG8_STAGE(PG8_SA(1, 0), a3, voffA);
            PG8_BAR; PG8_WAIT_L(0); PG8_MMA(1, 0, At, B0); PG8_BAR; PG8_SCHED;
            PG8_STAGE(PG8_SB(1, 1), b3 + hstepB, voffB);
            PG8_WAIT_V(6); PG8_BAR; PG8_MMA(1, 1, At, B1); PG8_BAR;
            }
        }
        if constexpr (ALIGN_EPI) { if (wr == 0) PG8_BAR; }
        if constexpr (!Epi::AFTER_DRAIN) { E(acc, cur, wr, wc, fr, fq); S.done(cur); }
        if (!has_next) break;
#pragma unroll
        for (int a = 0; a < 2; ++a)
#pragma unroll
            for (int b = 0; b < 2; ++b)
#pragma unroll
                for (int m = 0; m < 4; ++m)
#pragma unroll
                    for (int n = 0; n < 2; ++n) acc[a][b][m][n] = (f32x4){0.f, 0.f, 0.f, 0.f};
        cur = nxt; cA = nA; cB = nB; ++ui;
        if constexpr (ALIGN_EPI) { if (wr == 1) PG8_BAR; }
    }
    PG8_WAIT_V(0);
    if constexpr (!ALIGN_EPI) { if (wr == 0) PG8_BAR; }
    PG8_BAR;
    if constexpr (Epi::AFTER_DRAIN) { E.fused(acc, cur, wr, wc, fr, fq, lds, wid, lane); S.done(cur); }
#undef PG8_SA
#undef PG8_SB
#undef PG8_STAGE
#undef PG8_LDA
#undef PG8_LDB
#undef PG8_MMA
#undef PG8_WAIT_V
#undef PG8_WAIT_L
#undef PG8_BAR
#undef PG8_SCHED
}
}

constexpr int NWAVES = 8, NTHREADS = NWAVES * 64;
constexpr int BATCH = 8, SEQ = 4096, D = 1024, M = BATCH * SEQ;
constexpr int POOLW = 512, QW = 512, NG = 2, HD = 64, NBG = BATCH * NG;
constexpr int IN_COLS = 3864, NIN = 4096;
constexpr int NCMP = 255, NCMP_PAD = 256, NSEL = 64;
constexpr int PH = 8, PK = 128, PTOP = 16, PQD = 256, PQW = PH * PQD;
constexpr int NEXP = PK * PK;
constexpr float EPS = 1e-6f;
enum { I_X = 0, I_C, I_RELB, I_ADAW, I_ADAB, I_N1G, I_N2G, I_WIN, I_POOLW, I_POOLS, I_CPEK, I_CW1K, I_CW2K, I_CPEV, I_CW1V, I_CW2V, I_QNG, I_KNG, I_WBP, I_WBA, I_WOUT, I_PWQ, I_PSK, I_PU, I_PV, N_IN };

constexpr size_t MiB = 1u << 20, KiB = 1u << 10;
constexpr size_t WS_CTL = 0, CTL_ZERO_BYTES = 1 * MiB;
constexpr size_t WS_ADA = 1 * MiB;
constexpr size_t WS_CB1K = WS_ADA + 256 * KiB;
constexpr size_t WS_CB1V = WS_CB1K + 1 * KiB;
constexpr size_t WS_BIASL = WS_CB1V + 1 * KiB;
constexpr size_t WS_WIN_T = 2 * MiB;
constexpr size_t WS_WEFF_T = 10 * MiB;
constexpr size_t WS_WBA_T = 11 * MiB;
constexpr size_t WS_WOUT_T = 12 * MiB;
constexpr size_t WS_WQ_T = 14 * MiB;
constexpr size_t WS_SUBK = 18 * MiB;
constexpr size_t WS_CW1K_T = 18 * MiB + 512 * KiB;
constexpr size_t WS_CW1V_T = 19 * MiB;
constexpr size_t WS_CW2K_T = 19 * MiB + 512 * KiB;
constexpr size_t WS_CW2V_T = WS_CW2K_T + 64 * KiB;
constexpr size_t WS_KC = 20 * MiB;
constexpr size_t WS_VCT = 20 * MiB + 512 * KiB;
constexpr size_t WS_GATE = 21 * MiB;
constexpr size_t WS_UB = 24 * MiB;
constexpr size_t WS_VB = 56 * MiB;
constexpr size_t WS_H = 88 * MiB;
constexpr size_t WS_ZP = 152 * MiB;
constexpr size_t WS_Q = 184 * MiB;
constexpr size_t WS_KCR = 216 * MiB;
constexpr size_t WS_VCR = 225 * MiB;
constexpr size_t WS_KS = 234 * MiB, WS_VS = 242 * MiB, WS_KW = 250 * MiB, WS_VW = 258 * MiB;
constexpr size_t WS_VST = 266 * MiB, WS_VWT = 274 * MiB;
constexpr size_t WS_PL = 282 * MiB;
constexpr size_t WS_YA = 314 * MiB;
constexpr size_t WS_GM = 346 * MiB;
constexpr size_t WS_MIX = WS_ZP;
constexpr size_t WS_QV = WS_GM;
constexpr size_t WS_EID = WS_PL;
constexpr size_t WS_GW = WS_PL + 16 * MiB;
constexpr size_t WS_END = 474 * MiB;
constexpr int CW_TMO = 0, CW_CODE = 1, CW_BAR = 4096;

constexpr int RING_OFF = 0, RING_BYTES = 131072;
constexpr int LDSCTL_OFF = RING_BYTES, MISC_OFF = LDSCTL_OFF + 320;
constexpr int LDS_BYTES = 147456;

#define GAS __attribute__((address_space(1)))
#define LAS __attribute__((address_space(3)))
typedef unsigned short bf16;
typedef unsigned v4u __attribute__((ext_vector_type(4)));
typedef unsigned v2u __attribute__((ext_vector_type(2)));
typedef float f32x4 __attribute__((ext_vector_type(4)));
typedef short bf16x8 __attribute__((ext_vector_type(8)));
typedef GAS unsigned gu32;
#define RLX_AGENT __ATOMIC_RELAXED, __HIP_MEMORY_SCOPE_AGENT
#define LDS_WAIT() asm volatile("s_waitcnt lgkmcnt(0)" ::: "memory")
#define VM_WAIT() asm volatile("s_waitcnt vmcnt(0)" ::: "memory")
__device__ __forceinline__ unsigned f2bf(float f) { unsigned u = __builtin_bit_cast(unsigned, f); return (u + 0x7fffu + ((u >> 16) & 1u)) >> 16; }
__device__ __forceinline__ unsigned pk2(float lo, float hi) { return f2bf(lo) | (f2bf(hi) << 16); }
__device__ __forceinline__ float bflo(unsigned w) { return __builtin_bit_cast(float, w << 16); }
__device__ __forceinline__ float bfhi(unsigned w) { return __builtin_bit_cast(float, w & 0xffff0000u); }
__device__ __forceinline__ float sigmoidf_(float v) { return 1.0f / (1.0f + __expf(-v)); }
__device__ __forceinline__ float gelu_tanh_safe(float v) { const float u = 0.7978845608028654f * (v + 0.044715f * v * v * v); return 0.5f * v * (1.0f + tanhf(u)); }
__device__ __forceinline__ float wave_sum(float v) {
#pragma unroll
    for (int o = 1; o < 64; o <<= 1) v += __shfl_xor(v, o);
    return v;
}

#define XB_TMO      128
#define XB_XCNT(j)  (256  + 64 * (j))
#define XB_XSUB(j)  (1280 + 64 * (j))
#define XB_XGEN(j)  (2304 + 64 * (j))
#define XB_TOP      3328
#define XB_TOPGEN   3392
#define XCD_BAR_WORDS 3456
#define XB_SPIN_CAP (1u << 18)
__device__ __forceinline__ unsigned xb_ld(unsigned* p)              { return __hip_atomic_load(p, __ATOMIC_RELAXED, __HIP_MEMORY_SCOPE_AGENT); }
__device__ __forceinline__ unsigned xb_add(unsigned* p, unsigned v) { return __hip_atomic_fetch_add(p, v, __ATOMIC_RELAXED, __HIP_MEMORY_SCOPE_AGENT); }
__device__ __forceinline__ unsigned xb_xcc_id() { return (unsigned)__builtin_amdgcn_s_getreg((3 << 11) | 20) & 0xFu; }
#define XB_SPIN(cond, bar) do { unsigned _sp = 0; while (cond) { __builtin_amdgcn_s_sleep(1); \
    if ((++_sp & 255u) == 0u) { if (xb_ld(&(bar)[XB_TMO])) break; if (_sp > XB_SPIN_CAP) { atomicAdd(&(bar)[XB_TMO], 1u); break; } } } } while (0)
struct XcdBarrier { unsigned* bar; unsigned x; volatile LAS unsigned* st; };
__device__ __forceinline__ XcdBarrier xcd_barrier_post(unsigned* bar, volatile LAS unsigned* st) {
    XcdBarrier b; b.bar = bar; b.x = xb_xcc_id(); b.st = st;
    if (threadIdx.x == 0) (void)xb_add(&bar[XB_XCNT(b.x)], 1u);
    return b;
}
__device__ __forceinline__ void xcd_barrier_complete(unsigned* bar, unsigned x, unsigned& nloc, unsigned& nx) {
    const unsigned G = gridDim.x * gridDim.y * gridDim.z;
    unsigned sum, cnt, mine, sp = 0u;
    for (;;) {
        sum = 0u; cnt = 0u; mine = 0u;
#pragma unroll
        for (unsigned j = 0; j < 16; ++j) { const unsigned c = xb_ld(&bar[XB_XCNT(j)]); sum += c; cnt += (c > 0u) ? 1u : 0u; mine = (j == x) ? c : mine; }
        if (sum == G) break;
        __builtin_amdgcn_s_sleep(1);
        if ((++sp & 255u) == 0u) { if (xb_ld(&bar[XB_TMO])) break; if (sp > XB_SPIN_CAP) { atomicAdd(&bar[XB_TMO], 1u); break; } }
    }
    nloc = mine > 0u ? mine : 1u; nx = cnt > 0u ? cnt : 1u;
}
__device__ __forceinline__ void xcd_barrier(const XcdBarrier& b) {
    asm volatile("s_waitcnt vmcnt(0)" ::: "memory");
    __syncthreads();
    if (threadIdx.x == 0) {
        unsigned* bar = b.bar;
        __builtin_amdgcn_s_waitcnt(0);
        unsigned nloc = b.st[0], nx = b.st[1];
        if (nloc == 0u) { xcd_barrier_complete(bar, b.x, nloc, nx); b.st[0] = nloc; b.st[1] = nx; }
        const unsigned old = xb_add(&bar[XB_XSUB(b.x)], 1u);
        const unsigned gen = old / nloc;
        if (old + 1u == (gen + 1u) * nloc) {
            __builtin_amdgcn_fence(__ATOMIC_RELEASE, "agent");
            asm volatile("s_waitcnt vmcnt(0)" ::: "memory");
            const unsigned og = xb_add(&bar[XB_TOP], 1u);
            const unsigned tg = og / nx;
            if (og + 1u == (tg + 1u) * nx) xb_add(&bar[XB_TOPGEN], 1u);
            else XB_SPIN(xb_ld(&bar[XB_TOPGEN]) == tg, bar);
            __builtin_amdgcn_fence(__ATOMIC_ACQUIRE, "agent");
            xb_add(&bar[XB_XGEN(b.x)], 1u);
            asm volatile("s_waitcnt vmcnt(0)" ::: "memory");
        } else {
            XB_SPIN(xb_ld(&bar[XB_XGEN(b.x)]) == gen, bar);
            __builtin_amdgcn_fence(__ATOMIC_ACQUIRE, "agent");
            asm volatile("s_waitcnt vmcnt(0)" ::: "memory");
        }
    }
    __syncthreads();
}

struct Args { const float* in[N_IN]; float* out; unsigned char* ws; int ph_lo, ph_hi, li, pad; };
struct Frame {
    LAS unsigned char* lds;
    volatile LAS unsigned* MISC;
    gu32* ctl;
    int tid, lane, wave, G, bid;
    unsigned char* ws;
};

__device__ __forceinline__ void p0_transpose_item(const float* W, int ldw, int src_col0, int valid, int K, bf16* WT, int dst_row0, int k0, LAS float* scr, int lane) {
    const int n_ = lane & 31;
#pragma unroll 8
    for (int i = 0; i < 32; ++i) { const int kk = 2 * i + (lane >> 5); scr[kk * 33 + n_] = (n_ < valid) ? W[(size_t)(k0 + kk) * ldw + src_col0 + n_] : 0.f; }
    LDS_WAIT(); asm volatile("" ::: "memory");
    const int c = lane & 7;
#pragma unroll
    for (int j = 0; j < 4; ++j) { const int n = (lane >> 3) + 8 * j; const LAS float* s = scr + (8 * c) * 33 + n;
        v4u o; o.x = pk2(s[0 * 33], s[1 * 33]); o.y = pk2(s[2 * 33], s[3 * 33]); o.z = pk2(s[4 * 33], s[5 * 33]); o.w = pk2(s[6 * 33], s[7 * 33]);
        *(GAS v4u*)(WT + (size_t)(dst_row0 + n) * K + k0 + 8 * c) = o; }
    LDS_WAIT(); asm volatile("" ::: "memory");
}
__device__ __forceinline__ bool p0_mat(int& r, const float* W, int K, int N, bf16* WT, LAS float* scr, int lane) {
    const int ng = N / 32, items = ng * (K / 64);
    if (r < items) { const int kb = r / ng, nb = r % ng; p0_transpose_item(W, N, 32 * nb, 32, K, WT, 32 * nb, 64 * kb, scr, lane); return true; }
    r -= items; return false;
}
__device__ __forceinline__ void cvt_f32_bf16_stream(const float* src, bf16* dst, size_t n8, size_t gtid, size_t gthreads) {
    for (size_t i = gtid; i < n8; i += gthreads) {
        const f32x4 a = *(const GAS f32x4*)(src + 8 * i), b = *(const GAS f32x4*)(src + 8 * i + 4);
        v4u o; o.x = pk2(a.x, a.y); o.y = pk2(a.z, a.w); o.z = pk2(b.x, b.y); o.w = pk2(b.z, b.w);
        *(GAS v4u*)(dst + 8 * i) = o; }
}

__device__ __forceinline__ void p0_prologue(Frame& F, const Args& args) {
    unsigned char* ws = F.ws;
    const int gw = F.bid * NWAVES + F.wave, NGW = F.G * NWAVES;
    const size_t gtid = (size_t)F.bid * NTHREADS + F.tid, gthreads = (size_t)F.G * NTHREADS;
    {
        LAS float* sl = (LAS float*)(F.lds);
        LAS float* red = (LAS float*)(F.lds + 32768);
        const float* c = args.in[I_C];
        for (int i = F.tid; i < BATCH * D; i += NTHREADS) { const float v = c[i]; sl[i] = v / (1.0f + __expf(-v)); }
        __syncthreads();
        for (int cb = F.bid; cb < 6 * D / 24; cb += F.G) {
            const int j0 = cb * 24;
            if (F.tid < 504) {
                const int kk = F.tid / 24, jj = F.tid % 24;
                float a[BATCH];
#pragma unroll
                for (int b = 0; b < BATCH; ++b) a[b] = 0.f;
                const float* w = args.in[I_ADAW] + j0 + jj;
                for (int k = kk; k < D; k += 21) { const float wv = w[(size_t)k * (6 * D)];
#pragma unroll
                    for (int b = 0; b < BATCH; ++b) a[b] += sl[b * D + k] * wv; }
#pragma unroll
                for (int b = 0; b < BATCH; ++b) red[(kk * 24 + jj) * BATCH + b] = a[b];
            }
            __syncthreads();
            if (F.tid < 24 * BATCH) { const int jj = F.tid / BATCH, b = F.tid % BATCH; float s = 0.f;
                for (int kk = 0; kk < 21; ++kk) s += red[(kk * 24 + jj) * BATCH + b];
                ((float*)(ws + WS_ADA))[b * (6 * D) + j0 + jj] = s + args.in[I_ADAB][j0 + jj]; }
            __syncthreads();
        }
    }
    if (F.bid < 2) {
        const float* pe = args.in[F.bid == 0 ? I_CPEK : I_CPEV]; const float* w1 = args.in[F.bid == 0 ? I_CW1K : I_CW1V];
        LAS float* red = (LAS float*)(F.lds);
        const int j = F.tid & 127, ic = F.tid >> 7; float s = 0.f;
        for (int i = ic * 512; i < ic * 512 + 512; ++i) s += pe[i] * w1[(size_t)i * 128 + j];
        red[ic * 128 + j] = s; __syncthreads();
        if (F.tid < 128) ((float*)(ws + (F.bid == 0 ? WS_CB1K : WS_CB1V)))[F.tid] = (red[F.tid] + red[128 + F.tid]) + (red[256 + F.tid] + red[384 + F.tid]);
        __syncthreads();
    } else if (F.bid == 2) {
        for (int i = F.tid; i < 8 * 128; i += NTHREADS) { const int h = i >> 7, rel = i & 127;
            int bk = rel;
            if (rel >= 16) bk = 16 + (rel >= 19) + (rel >= 21) + (rel >= 24) + (rel >= 27) + (rel >= 31) + (rel >= 35) + (rel >= 40) + (rel >= 46) + (rel >= 52) + (rel >= 59) + (rel >= 67) + (rel >= 77) + (rel >= 87) + (rel >= 99) + (rel >= 113);
            ((float*)(ws + WS_BIASL))[i] = args.in[I_RELB][bk * 8 + h]; }
    }
    {
        LAS float* scr = (LAS float*)(F.lds + F.wave * 16384);
        constexpr int I_WINT = (NIN / 32) * (D / 64);
        constexpr int NITEMS = I_WINT + (1024 / 32) * (512 / 64) + (1024 / 32) * (1024 / 64) + (2048 / 32) * (1024 / 64) + 2 * (128 / 32) * (2048 / 64) + 2 * (64 / 32) * (128 / 64);
        for (int it = gw; it < NITEMS; it += NGW) {
            int r = it;
            if (r < I_WINT) {
                const int grp = r % (NIN / 32), kb = r / (NIN / 32);
                const int tile = grp >> 3, ct0 = (grp & 7) * 32;
                const int L0 = 64 * ((ct0 >> 5) & 3) + 32 * (ct0 >> 7);
                int src0, valid = 32;
                if (tile < 7) src0 = 256 * tile + L0; else if (tile < 15) src0 = 1816 + 256 * (tile - 7) + L0; else { src0 = 1792 + L0; valid = (L0 == 0) ? 24 : 0; }
                if (valid == 0) src0 = 0;
                p0_transpose_item(args.in[I_WIN], IN_COLS, src0, valid, D, (bf16*)(ws + WS_WIN_T), 32 * grp, 64 * kb, scr, F.lane);
                continue; }
            r -= I_WINT;
            if (p0_mat(r, args.in[I_WBA], 512, 1024, (bf16*)(ws + WS_WBA_T), scr, F.lane)) continue;
            if (p0_mat(r, args.in[I_WOUT], 1024, 1024, (bf16*)(ws + WS_WOUT_T), scr, F.lane)) continue;
            if (p0_mat(r, args.in[I_PWQ], 1024, 2048, (bf16*)(ws + WS_WQ_T), scr, F.lane)) continue;
            if (p0_mat(r, args.in[I_CW1K], 2048, 128, (bf16*)(ws + WS_CW1K_T), scr, F.lane)) continue;
            if (p0_mat(r, args.in[I_CW1V], 2048, 128, (bf16*)(ws + WS_CW1V_T), scr, F.lane)) continue;
            if (p0_mat(r, args.in[I_CW2K], 128, 64, (bf16*)(ws + WS_CW2K_T), scr, F.lane)) continue;
            p0_mat(r, args.in[I_CW2V], 128, 64, (bf16*)(ws + WS_CW2V_T), scr, F.lane);
        }
    }
    {
        const float* pw = args.in[I_POOLW]; const float* ps = args.in[I_POOLS]; const float* wbp = args.in[I_WBP];
        bf16* weff = (bf16*)(ws + WS_WEFF_T);
        for (size_t idx = gtid; idx < (size_t)D * POOLW; idx += gthreads) {
            const int d = (int)(idx >> 9), r = (int)(idx & 511), g = r >> 7;
            const float* pr = pw + (size_t)r * 128; float s = 0.f;
            for (int cc = 0; cc < 128; ++cc) s += pr[cc] * ps[g * 128 + cc] * wbp[(size_t)(g * 128 + cc) * D + d];
            weff[idx] = (bf16)f2bf(s); }
    }
    cvt_f32_bf16_stream(args.in[I_PSK], (bf16*)(ws + WS_SUBK), (size_t)16 * 128 * 128 / 8, gtid, gthreads);
    cvt_f32_bf16_stream(args.in[I_PU], (bf16*)(ws + WS_UB), (size_t)NEXP * D / 8, gtid, gthreads);
    cvt_f32_bf16_stream(args.in[I_PV], (bf16*)(ws + WS_VB), (size_t)NEXP * D / 8, gtid, gthreads);
}

__device__ __forceinline__ void modnorm_rows(Frame& F, const float* x, const float* g, const float* ada, int shift_idx, bf16* out) {
    const int gw = F.bid * NWAVES + F.wave, NGW = F.G * NWAVES;
    for (int m = gw; m < M; m += NGW) {
        const int b = m >> 12;
        const GAS f32x4* xr = (const GAS f32x4*)(x + (size_t)m * D) + F.lane;
        const GAS f32x4* gr = (const GAS f32x4*)g + F.lane;
        const GAS f32x4* sh = (const GAS f32x4*)(ada + (size_t)b * 6 * D + shift_idx * D) + F.lane;
        const GAS f32x4* sc = (const GAS f32x4*)(ada + (size_t)b * 6 * D + (shift_idx + 1) * D) + F.lane;
        f32x4 v[4]; float s = 0.f;
#pragma unroll
        for (int j = 0; j < 4; ++j) { v[j] = xr[64 * j]; s += (v[j].x * v[j].x + v[j].y * v[j].y) + (v[j].z * v[j].z + v[j].w * v[j].w); }
        const float rstd = rsqrtf(wave_sum(s) * (1.f / D) + EPS);
        GAS v2u* o8 = (GAS v2u*)(out + (size_t)m * D) + F.lane;
#pragma unroll
        for (int j = 0; j < 4; ++j) { const f32x4 gg = gr[64 * j], ss = sh[64 * j], cc = sc[64 * j];
            const f32x4 y = (v[j] * rstd) * gg * (cc + 1.0f) + ss;
            v2u o; o.x = pk2(y.x, y.y); o.y = pk2(y.z, y.w); o8[64 * j] = o; }
    }
}

struct EpiIn {
    static constexpr bool PERM = true, AFTER_DRAIN = false;
    unsigned char* ws; const float* qg; const float* kg;
    __device__ __forceinline__ void operator()(const pg8::f32x4 (&acc)[2][2][4][2], const pg8::Unit& u, int wr, int wc, int fr, int fq) const {
        const int pn = u.pn;
#pragma unroll
        for (int ai = 0; ai < 2; ++ai)
#pragma unroll
            for (int m = 0; m < 4; ++m) {
                const int row = u.pm * 256 + ai * 128 + wr * 64 + m * 16 + fr;
                float v[2][8];
#pragma unroll
                for (int bj = 0; bj < 2; ++bj)
#pragma unroll
                    for (int n = 0; n < 2; ++n)
#pragma unroll
                        for (int i = 0; i < 4; ++i) v[bj][4 * n + i] = acc[ai][bj][m][n][i];
                bf16* dst = nullptr; bool norm = false; const float* gain = nullptr; float mul = 1.f; bool sig = false;
                if (pn < 2) { dst = (bf16*)(ws + WS_ZP) + (size_t)row * 512 + 256 * pn + 64 * wc; }
                else if (pn < 4) { dst = (bf16*)(ws + WS_Q) + (size_t)row * 512 + 256 * (pn - 2) + 64 * wc; norm = true; gain = qg; mul = 0.125f; }
                else if (pn < 7) { const int kind = pn - 4, isv = wc >> 1, g = wc & 1, b = row >> 12, t = row & 4095;
                    const size_t base = ((size_t)(b * 2 + g) * SEQ + t) * 64;
                    const size_t off = kind == 0 ? (isv ? WS_VCR : WS_KCR) : kind == 1 ? (isv ? WS_VS : WS_KS) : (isv ? WS_VW : WS_KW);
                    dst = (bf16*)(ws + off) + base; if (!isv && kind > 0) { norm = true; gain = kg + kind * 64; } }
                else if (pn < 15) { dst = (bf16*)(ws + WS_GM) + (size_t)row * 2048 + 256 * (pn - 7) + 64 * wc; sig = true; }
                else {
                    if (wc == 0 && fq < 3) { float* gp = (float*)(ws + WS_GATE) + (size_t)row * 24 + 8 * fq;
                        *(GAS f32x4*)gp = (f32x4){sigmoidf_(v[0][0]), sigmoidf_(v[0][1]), sigmoidf_(v[0][2]), sigmoidf_(v[0][3])};
                        *(GAS f32x4*)(gp + 4) = (f32x4){sigmoidf_(v[0][4]), sigmoidf_(v[0][5]), sigmoidf_(v[0][6]), sigmoidf_(v[0][7])}; }
                    continue; }
                if (norm) { float ss = 0.f;
#pragma unroll
                    for (int bj = 0; bj < 2; ++bj)
#pragma unroll
                        for (int e = 0; e < 8; ++e) ss += v[bj][e] * v[bj][e];
                    ss += __shfl_xor(ss, 16); ss += __shfl_xor(ss, 32);
                    const float rs = rsqrtf(ss * (1.f / 64.f) + EPS) * mul;
#pragma unroll
                    for (int bj = 0; bj < 2; ++bj)
#pragma unroll
                        for (int e = 0; e < 8; ++e) v[bj][e] = v[bj][e] * rs * gain[32 * bj + 8 * fq + e]; }
                if (sig) {
#pragma unroll
                    for (int bj = 0; bj < 2; ++bj)
#pragma unroll
                        for (int e = 0; e < 8; ++e) v[bj][e] = sigmoidf_(v[bj][e]); }
#pragma unroll
                for (int bj = 0; bj < 2; ++bj) { v4u o; o.x = pk2(v[bj][0], v[bj][1]); o.y = pk2(v[bj][2], v[bj][3]); o.z = pk2(v[bj][4], v[bj][5]); o.w = pk2(v[bj][6], v[bj][7]);
                    *(GAS v4u*)(dst + 32 * bj + 8 * fq) = o; }
            }
    }
};
template <bool ADD> struct EpiMix {
    static constexpr bool PERM = true, AFTER_DRAIN = false;
    bf16* MIX; const bf16* GM; int gmoff;
    __device__ __forceinline__ void operator()(const pg8::f32x4 (&acc)[2][2][4][2], const pg8::Unit& u, int wr, int wc, int fr, int fq) const {
#pragma unroll
        for (int ai = 0; ai < 2; ++ai)
#pragma unroll
            for (int m = 0; m < 4; ++m) {
                const int row = u.pm * 256 + ai * 128 + wr * 64 + m * 16 + fr;
#pragma unroll
                for (int bj = 0; bj < 2; ++bj) {
                    const int col = u.pn * 256 + bj * 128 + wc * 32 + 8 * fq;
                    const v4u gmv = *(const GAS v4u*)(GM + (size_t)row * 2048 + gmoff + col);
                    float r[8];
                    r[0] = acc[ai][bj][m][0][0] * bflo(gmv.x); r[1] = acc[ai][bj][m][0][1] * bfhi(gmv.x); r[2] = acc[ai][bj][m][0][2] * bflo(gmv.y); r[3] = acc[ai][bj][m][0][3] * bfhi(gmv.y);
                    r[4] = acc[ai][bj][m][1][0] * bflo(gmv.z); r[5] = acc[ai][bj][m][1][1] * bfhi(gmv.z); r[6] = acc[ai][bj][m][1][2] * bflo(gmv.w); r[7] = acc[ai][bj][m][1][3] * bfhi(gmv.w);
                    GAS v4u* dp = (GAS v4u*)(MIX + (size_t)row * 1024 + col);
                    if (ADD) { const v4u old = *dp; r[0] += bflo(old.x); r[1] += bfhi(old.x); r[2] += bflo(old.y); r[3] += bfhi(old.y); r[4] += bflo(old.z); r[5] += bfhi(old.z); r[6] += bflo(old.w); r[7] += bfhi(old.w); }
                    v4u o; o.x = pk2(r[0], r[1]); o.y = pk2(r[2], r[3]); o.z = pk2(r[4], r[5]); o.w = pk2(r[6], r[7]); *dp = o; }
            }
    }
};
struct EpiRes {
    static constexpr bool PERM = false, AFTER_DRAIN = false;
    const float* x; float* out; const float* ada; int gate_idx;
    __device__ __forceinline__ void operator()(const pg8::f32x4 (&acc)[2][2][4][2], const pg8::Unit& u, int wr, int wc, int fr, int fq) const {
#pragma unroll
        for (int ai = 0; ai < 2; ++ai)
#pragma unroll
            for (int m = 0; m < 4; ++m) {
                const int row = u.pm * 256 + ai * 128 + wr * 64 + m * 16 + fr, b = row >> 12;
#pragma unroll
                for (int bj = 0; bj < 2; ++bj)
#pragma unroll
                    for (int n = 0; n < 2; ++n) {
                        const int col = u.pn * 256 + bj * 128 + wc * 32 + 16 * n + 4 * fq;
                        const f32x4 gt = *(const GAS f32x4*)(ada + (size_t)b * 6 * D + gate_idx * D + col);
                        const f32x4 xv = *(const GAS f32x4*)(x + (size_t)row * D + col);
                        *(GAS f32x4*)(out + (size_t)row * D + col) = xv + gt * acc[ai][bj][m][n]; }
            }
    }
};

__device__ __forceinline__ void pool_phase(Frame& F) {
    const bf16* zp = (const bf16*)(F.ws + WS_ZP); bf16* pl = (bf16*)(F.ws + WS_PL);
    const size_t gtid = (size_t)F.bid * NTHREADS + F.tid, gthreads = (size_t)F.G * NTHREADS;
    for (size_t idx = gtid; idx < (size_t)M * 64; idx += gthreads) {
        const int row = (int)(idx >> 6), c8 = (int)(idx & 63), t = row & 4095, w = 2 << (c8 >> 4), cnt = (t + 1 < w) ? (t + 1) : w;
        float s[8];
#pragma unroll
        for (int e = 0; e < 8; ++e) s[e] = 0.f;
        float self[8];
        for (int j = 0; j < cnt; ++j) { const v4u z = *(const GAS v4u*)(zp + (size_t)(row - j) * 512 + 8 * c8);
            const float f[8] = {bflo(z.x), bfhi(z.x), bflo(z.y), bfhi(z.y), bflo(z.z), bfhi(z.z), bflo(z.w), bfhi(z.w)};
#pragma unroll
            for (int e = 0; e < 8; ++e) { s[e] += f[e]; if (j == 0) self[e] = f[e]; } }
        const float inv = 1.0f / (float)cnt;
        v4u o; o.x = pk2(s[0] * inv - self[0], s[1] * inv - self[1]); o.y = pk2(s[2] * inv - self[2], s[3] * inv - self[3]);
        o.z = pk2(s[4] * inv - self[4], s[5] * inv - self[5]); o.w = pk2(s[6] * inv - self[6], s[7] * inv - self[7]);
        *(GAS v4u*)(pl + (size_t)row * 512 + 8 * c8) = o; }
}

typedef int v4i __attribute__((ext_vector_type(4)));
struct EpiStoreBf16 {
    static constexpr bool PERM = true, AFTER_DRAIN = false;
    bf16* O; int ldc;
    __device__ __forceinline__ void operator()(const pg8::f32x4 (&acc)[2][2][4][2], const pg8::Unit& u, int wr, int wc, int fr, int fq) const {
#pragma unroll
        for (int ai = 0; ai < 2; ++ai)
#pragma unroll
            for (int m = 0; m < 4; ++m) {
                const int row = u.pm * 256 + ai * 128 + wr * 64 + m * 16 + fr;
#pragma unroll
                for (int bj = 0; bj < 2; ++bj) {
                    const int col = u.pn * 256 + bj * 128 + wc * 32 + 8 * fq;
                    v4u o; o.x = pk2(acc[ai][bj][m][0][0], acc[ai][bj][m][0][1]); o.y = pk2(acc[ai][bj][m][0][2], acc[ai][bj][m][0][3]);
                    o.z = pk2(acc[ai][bj][m][1][0], acc[ai][bj][m][1][1]); o.w = pk2(acc[ai][bj][m][1][2], acc[ai][bj][m][1][3]);
                    *(GAS v4u*)(O + (size_t)row * ldc + col) = o; }
            }
    }
};

__device__ __forceinline__ unsigned fkey(float f) { const unsigned u = __builtin_bit_cast(unsigned, f); return (u >> 31) ? ~u : (u | 0x80000000u); }
__device__ __forceinline__ float funkey(unsigned k) { const unsigned u = (k >> 31) ? (k & 0x7fffffffu) : ~k; return __builtin_bit_cast(float, u); }
#define TOP16_INSERT(L, xin) do { unsigned _x = (xin); _Pragma("unroll") for (int _i = 0; _i < 16; ++_i) { const unsigned _h = L[_i] > _x ? L[_i] : _x; _x = L[_i] > _x ? _x : L[_i]; L[_i] = _h; } } while (0)
constexpr int SST = 129;
constexpr int P9_S_BYTES = 2 * 64 * SST * 4;
constexpr int P9_LIST_OFF = 66560;
__device__ __forceinline__ void peer_select_phase(Frame& F) {
    const bf16* QV = (const bf16*)(F.ws + WS_QV); const bf16* SK = (const bf16*)(F.ws + WS_SUBK);
    int* EID = (int*)(F.ws + WS_EID); float* GW = (float*)(F.ws + WS_GW);
    LAS float* S = (LAS float*)(F.lds);
    LAS unsigned* LIST = (LAS unsigned*)(F.lds + P9_LIST_OFF);
    const int lane = F.lane, w = F.wave, l15 = lane & 15, lq = lane >> 4;
    for (int u = F.bid; u < (M / 64) * PH; u += F.G) {
        const int tt = u >> 3, h = u & 7, tok0 = tt * 64;
        {
            const int p = w >> 2, kb = w & 3;
            pg8::f32x4 acc[4][2];
#pragma unroll
            for (int rb = 0; rb < 4; ++rb)
#pragma unroll
                for (int cb = 0; cb < 2; ++cb) acc[rb][cb] = (pg8::f32x4){0.f, 0.f, 0.f, 0.f};
            const bf16* qa = QV + (size_t)(tok0 + l15) * PQW + h * 256 + p * 128 + 8 * lq;
            const bf16* kbp = SK + (size_t)((h * 2 + p) * 128 + 32 * kb + l15) * 128 + 8 * lq;
#pragma unroll
            for (int ks = 0; ks < 4; ++ks) {
                bf16x8 a[4], b[2];
#pragma unroll
                for (int rb = 0; rb < 4; ++rb) a[rb] = *(const GAS bf16x8*)(qa + (size_t)(16 * rb) * PQW + 32 * ks);
#pragma unroll
                for (int cb = 0; cb < 2; ++cb) b[cb] = *(const GAS bf16x8*)(kbp + (size_t)(16 * cb) * 128 + 32 * ks);
#pragma unroll
                for (int rb = 0; rb < 4; ++rb)
#pragma unroll
                    for (int cb = 0; cb < 2; ++cb) acc[rb][cb] = __builtin_amdgcn_mfma_f32_16x16x32_bf16(a[rb], b[cb], acc[rb][cb], 0, 0, 0);
            }
#pragma unroll
            for (int rb = 0; rb < 4; ++rb)
#pragma unroll
                for (int cb = 0; cb < 2; ++cb)
#pragma unroll
                    for (int r = 0; r < 4; ++r) S[(p * 64 + 16 * rb + 4 * lq + r) * SST + 32 * kb + 16 * cb + l15] = acc[rb][cb][r];
        }
        __syncthreads();
        if (F.tid < 128) {
            const LAS float* sr = S + F.tid * SST;
            unsigned L[16];
#pragma unroll
            for (int i = 0; i < 16; ++i) L[i] = 0u;
#pragma unroll 4
            for (int k = 0; k < 128; ++k) { const unsigned key = (fkey(sr[k]) & ~127u) | (unsigned)k; TOP16_INSERT(L, key); }
#pragma unroll
            for (int i = 0; i < 16; ++i) LIST[F.tid * 16 + i] = L[i];
        }
        __syncthreads();
        if (F.tid < 64) {
            const int tok = F.tid;
            float va[16], vb[16];
#pragma unroll
            for (int i = 0; i < 16; ++i) { va[i] = funkey(LIST[tok * 16 + i] & ~127u); vb[i] = funkey(LIST[(64 + tok) * 16 + i] & ~127u); }
            unsigned L[16];
#pragma unroll
            for (int i = 0; i < 16; ++i) L[i] = 0u;
#pragma unroll
            for (int i = 0; i < 16; ++i)
#pragma unroll
                for (int j = 0; j < 16; ++j)
                    if ((i + 1) * (j + 1) <= 16) { const unsigned key = (fkey(va[i] + vb[j]) & ~255u) | (unsigned)(i * 16 + j); TOP16_INSERT(L, key); }
            const float mx = funkey(L[0] & ~255u);
            float e[16], sum = 0.f;
#pragma unroll
            for (int k = 0; k < 16; ++k) { e[k] = __expf(funkey(L[k] & ~255u) - mx); sum += e[k]; }
            const float inv = 1.0f / sum;
            const size_t ob = ((size_t)(tok0 + tok) * PH + h) * 16;
#pragma unroll
            for (int k4 = 0; k4 < 4; ++k4) {
                int id[4];
#pragma unroll
                for (int q = 0; q < 4; ++q) { const unsigned cid = L[4 * k4 + q] & 255u;
                    const unsigned ia = LIST[tok * 16 + (cid >> 4)] & 127u, ib = LIST[(64 + tok) * 16 + (cid & 15u)] & 127u; id[q] = (int)(ia * 128u + ib); }
                *(GAS v4i*)(EID + ob + 4 * k4) = (v4i){id[0], id[1], id[2], id[3]};
                *(GAS f32x4*)(GW + ob + 4 * k4) = (f32x4){e[4 * k4] * inv, e[4 * k4 + 1] * inv, e[4 * k4 + 2] * inv, e[4 * k4 + 3] * inv};
            }
        }
        __syncthreads();
    }
}

__device__ __forceinline__ void unpack8(const v4u w, float (&f)[8]) { f[0] = bflo(w.x); f[1] = bfhi(w.x); f[2] = bflo(w.y); f[3] = bfhi(w.y); f[4] = bflo(w.z); f[5] = bfhi(w.z); f[6] = bflo(w.w); f[7] = bfhi(w.w); }
__device__ __forceinline__ void peer_gather_phase(Frame& F, const float* ada, float* out) {
    const bf16* H = (const bf16*)(F.ws + WS_H); const bf16* UB = (const bf16*)(F.ws + WS_UB); const bf16* VB = (const bf16*)(F.ws + WS_VB);
    const int* EID = (const int*)(F.ws + WS_EID); const float* GW = (const float*)(F.ws + WS_GW);
    const int gw = F.bid * NWAVES + F.wave, NGW = F.G * NWAVES, lane = F.lane;
    for (int row = gw; row < M; row += NGW) {
        const int b = row >> 12;
        float hx[16];
        { const v4u h0 = *(const GAS v4u*)(H + (size_t)row * D + 8 * lane), h1 = *(const GAS v4u*)(H + (size_t)row * D + 512 + 8 * lane);
          float t0[8], t1[8]; unpack8(h0, t0); unpack8(h1, t1);
#pragma unroll
          for (int i = 0; i < 8; ++i) { hx[i] = t0[i]; hx[8 + i] = t1[i]; } }
        const int e_lo = EID[(size_t)row * 128 + lane], e_hi = EID[(size_t)row * 128 + 64 + lane];
        const float g_lo = GW[(size_t)row * 128 + lane], g_hi = GW[(size_t)row * 128 + 64 + lane];
        float o[16];
#pragma unroll
        for (int i = 0; i < 16; ++i) o[i] = 0.f;
        for (int e0 = 0; e0 < 128; e0 += 4) {
            int eid[4]; float gg[4]; v4u u0[4], u1[4], w0[4], w1[4];
#pragma unroll
            for (int q = 0; q < 4; ++q) { const int e = e0 + q;
                eid[q] = __shfl(e < 64 ? e_lo : e_hi, e & 63); gg[q] = __shfl(e < 64 ? g_lo : g_hi, e & 63);
                const bf16* up = UB + (size_t)eid[q] * D + 8 * lane; const bf16* vp = VB + (size_t)eid[q] * D + 8 * lane;
                u0[q] = *(const GAS v4u*)up; u1[q] = *(const GAS v4u*)(up + 512); w0[q] = *(const GAS v4u*)vp; w1[q] = *(const GAS v4u*)(vp + 512); }
#pragma unroll
            for (int q = 0; q < 4; ++q) {
                float f0[8], f1[8]; unpack8(u0[q], f0); unpack8(u1[q], f1);
                float s = 0.f;
#pragma unroll
                for (int i = 0; i < 8; ++i) s += hx[i] * f0[i] + hx[8 + i] * f1[i];
                s = wave_sum(s);
                const float cf = gg[q] * gelu_tanh_safe(s);
                unpack8(w0[q], f0); unpack8(w1[q], f1);
#pragma unroll
                for (int i = 0; i < 8; ++i) { o[i] += cf * f0[i]; o[8 + i] += cf * f1[i]; }
            }
        }
        const float* gt = ada + (size_t)b * 6 * D + 5 * D;
        float* xo = out + (size_t)row * D;
#pragma unroll
        for (int hh = 0; hh < 2; ++hh)
#pragma unroll
            for (int q = 0; q < 2; ++q) { const int col = 512 * hh + 8 * lane + 4 * q;
                const f32x4 xv = *(const GAS f32x4*)(xo + col), gv = *(const GAS f32x4*)(gt + col);
                *(GAS f32x4*)(xo + col) = xv + gv * (f32x4){o[8 * hh + 4 * q], o[8 * hh + 4 * q + 1], o[8 * hh + 4 * q + 2], o[8 * hh + 4 * q + 3]}; }
    }
}

__device__ __forceinline__ void compress_phase(Frame& F, const float* kng) {
    LAS bf16* H2 = (LAS bf16*)(F.lds);
    LAS float* OUTS = (LAS float*)(F.lds + 16384);
    const int lane = F.lane, w = F.wave, l15 = lane & 15, lq = lane >> 4;
    for (int u = F.bid; u < NBG * 2 * 8; u += F.G) {
        const int ns = u & 7, kv = (u >> 3) & 1, bg = u >> 4, n0 = ns * 32;
        const bf16* A = (const bf16*)(F.ws + (kv ? WS_VCR : WS_KCR)) + (size_t)bg * SEQ * 64;
        const bf16* W1T = (const bf16*)(F.ws + (kv ? WS_CW1V_T : WS_CW1K_T));
        const bf16* W2T = (const bf16*)(F.ws + (kv ? WS_CW2V_T : WS_CW2K_T));
        const float* b1 = (const float*)(F.ws + (kv ? WS_CB1V : WS_CB1K));
        pg8::f32x4 acc[2];
        acc[0] = (pg8::f32x4){0.f, 0.f, 0.f, 0.f}; acc[1] = acc[0];
        const bf16* ap = A + (size_t)(n0 + l15) * 1024 + 8 * lq;
        const bf16* bp = W1T + (size_t)(16 * w + l15) * 2048 + 8 * lq;
#pragma unroll 4
        for (int ks = 0; ks < 64; ++ks) {
            const bf16x8 a0 = *(const GAS bf16x8*)(ap + 32 * ks), a1 = *(const GAS bf16x8*)(ap + 16 * 1024 + 32 * ks), b = *(const GAS bf16x8*)(bp + 32 * ks);
            acc[0] = __builtin_amdgcn_mfma_f32_16x16x32_bf16(a0, b, acc[0], 0, 0, 0);
            acc[1] = __builtin_amdgcn_mfma_f32_16x16x32_bf16(a1, b, acc[1], 0, 0, 0);
        }
        { const float bb = b1[16 * w + l15];
#pragma unroll
          for (int rb = 0; rb < 2; ++rb)
#pragma unroll
            for (int r = 0; r < 4; ++r) H2[(16 * rb + 4 * lq + r) * 136 + 16 * w + l15] = (bf16)f2bf(gelu_tanh_safe(acc[rb][r] + bb)); }
        __syncthreads();
        { const int rb = w >> 2, db = w & 3;
          pg8::f32x4 o = (pg8::f32x4){0.f, 0.f, 0.f, 0.f};
#pragma unroll
          for (int ks = 0; ks < 4; ++ks) {
              const bf16x8 a = *(const LAS bf16x8*)(H2 + (16 * rb + l15) * 136 + 32 * ks + 8 * lq);
              const bf16x8 b = *(const GAS bf16x8*)(W2T + (size_t)(16 * db + l15) * 128 + 32 * ks + 8 * lq);
              o = __builtin_amdgcn_mfma_f32_16x16x32_bf16(a, b, o, 0, 0, 0); }
#pragma unroll
          for (int r = 0; r < 4; ++r) OUTS[(16 * rb + 4 * lq + r) * 65 + 16 * db + l15] = o[r]; }
        __syncthreads();
        { const int n = F.tid >> 4, d4 = (F.tid & 15) * 4, ng = n0 + n;
          float v[4]; float ss = 0.f;
#pragma unroll
          for (int i = 0; i < 4; ++i) { v[i] = OUTS[n * 65 + d4 + i]; ss += v[i] * v[i]; }
          ss += __shfl_xor(ss, 1); ss += __shfl_xor(ss, 2); ss += __shfl_xor(ss, 4); ss += __shfl_xor(ss, 8);
          const bool pad = (ng >= NCMP);
          if (kv == 0) { const float rs = rsqrtf(ss * (1.f / 64.f) + EPS);
              v2u o; o.x = pad ? 0u : pk2(v[0] * rs * kng[d4], v[1] * rs * kng[d4 + 1]); o.y = pad ? 0u : pk2(v[2] * rs * kng[d4 + 2], v[3] * rs * kng[d4 + 3]);
              *(GAS v2u*)((bf16*)(F.ws + WS_KC) + ((size_t)bg * 256 + ng) * 64 + d4) = o; }
          else { bf16* vt = (bf16*)(F.ws + WS_VCT) + (size_t)bg * 64 * 256 + ng;
#pragma unroll
              for (int i = 0; i < 4; ++i) vt[(size_t)(d4 + i) * 256] = pad ? (bf16)0 : (bf16)f2bf(v[i]); } }
        __syncthreads();
    }
}
__device__ __forceinline__ void vtranspose_phase(Frame& F) {
    LAS bf16* T = (LAS bf16*)(F.lds + F.wave * 9216);
    const int gw = F.bid * NWAVES + F.wave, NGW = F.G * NWAVES, lane = F.lane;
    for (int job = gw; job < 2 * NBG * 64; job += NGW) {
        const int s = job & 63, bg = (job >> 6) & 15, which = job >> 10;
        const bf16* X = (const bf16*)(F.ws + (which ? WS_VW : WS_VS)) + ((size_t)bg * SEQ + 64 * s) * 64;
        bf16* XT = (bf16*)(F.ws + (which ? WS_VWT : WS_VST)) + (size_t)bg * 64 * SEQ + 64 * s;
#pragma unroll
        for (int i = 0; i < 8; ++i) { const int tok = (lane >> 3) + 8 * i, ch = lane & 7;
            const v4u x = *(const GAS v4u*)(X + (size_t)tok * 64 + 8 * ch);
            const unsigned ww[4] = {x.x, x.y, x.z, x.w};
#pragma unroll
            for (int e = 0; e < 4; ++e) { T[(8 * ch + 2 * e) * 72 + tok] = (bf16)(ww[e] & 0xffffu); T[(8 * ch + 2 * e + 1) * 72 + tok] = (bf16)(ww[e] >> 16); } }
        LDS_WAIT(); asm volatile("" ::: "memory");
#pragma unroll
        for (int i = 0; i < 8; ++i) { const int dim = (lane >> 3) + 8 * i, ch = lane & 7;
            const v4u y = *(const LAS v4u*)(T + dim * 72 + 8 * ch);
            *(GAS v4u*)(XT + (size_t)dim * SEQ + 8 * ch) = y; }
        LDS_WAIT(); asm volatile("" ::: "memory");
    }
}

constexpr int AT_KSTR = 72;
constexpr int AT_KBUF = 64 * AT_KSTR * 2;
constexpr int AT_OFF_K = 0, AT_OFF_V = 2 * AT_KBUF, AT_OFF_P = 4 * AT_KBUF;
constexpr int AT_OFF_IMP1 = AT_OFF_P + 8 * 4608, AT_OFF_IMP2 = AT_OFF_IMP1 + 64 * 65 * 4, AT_OFF_SEL = AT_OFF_IMP2 + 64 * 65 * 4;
constexpr int AT_OFF_LUT = AT_OFF_SEL + 4096, AT_OFF_LROW = AT_OFF_LUT + 4 * 128 * 4;
constexpr int AT_LDS_END = AT_OFF_LROW + 8 * 32 * 4;
static_assert(AT_LDS_END <= RING_BYTES, "attention LDS");

struct AtTile { const bf16* k; const bf16* vt; int vstride; };
__device__ __forceinline__ void attention_phase(Frame& F, const Args& args) {
    unsigned char* ws = F.ws;
    const int lane = F.lane, w = F.wave, l15 = lane & 15, lq = lane >> 4, tid = F.tid;
    LAS unsigned char* L = F.lds;
    LAS float* IMP1 = (LAS float*)(L + AT_OFF_IMP1); LAS float* IMP2 = (LAS float*)(L + AT_OFF_IMP2);
    LAS unsigned char* SEL = L + AT_OFF_SEL; LAS float* LUT = (LAS float*)(L + AT_OFF_LUT); LAS float* LROW = (LAS float*)(L + AT_OFF_LROW) + w * 32;
    LAS bf16* PW = (LAS bf16*)(L + AT_OFF_P + w * 4608);
    float M0;
    { float mq = 0.f, mk = 0.f, mb = 0.f;
      for (int i = 0; i < 64; ++i) mq = fmaxf(mq, fabsf(args.in[I_QNG][i]));
      for (int i = 0; i < 192; ++i) mk = fmaxf(mk, fabsf(args.in[I_KNG][i]));
      for (int i = 0; i < 256; ++i) mb = fmaxf(mb, fabsf(args.in[I_RELB][i]));
      M0 = 8.0f * mq * mk + mb; }
    const bf16* Qg = (const bf16*)(ws + WS_Q); const float* GATE = (const float*)(ws + WS_GATE); bf16* YA = (bf16*)(ws + WS_YA); float* YAF = (float*)(ws + WS_H);
    const int nrounds = (F.G == 256) ? 4 : (1024 + F.G - 1) / F.G;
    for (int round = 0; round < nrounds; ++round) {
        const int ui = (F.G == 256) ? ((round & 1) ? ((round >> 1) * 512 + 511 - F.bid) : ((round >> 1) * 512 + F.bid)) : (round * F.G + F.bid);
        if (ui >= 1024) break;
        {
        const int c = 63 - (ui >> 4), bg = ui & 15, b = bg >> 1, g = bg & 1;
        const int m0 = b * SEQ + 64 * c;
        __syncthreads();
        for (int i = tid; i < 512; i += NTHREADS) LUT[i] = ((const float*)(ws + WS_BIASL))[(4 * g + (i >> 7)) * 128 + (i & 127)] - M0;
        for (int i = tid; i < 64 * 65; i += NTHREADS) { IMP1[i] = 0.f; IMP2[i] = 0.f; }
        bf16x8 qf[2][2];
#pragma unroll
        for (int rb = 0; rb < 2; ++rb)
#pragma unroll
            for (int ks = 0; ks < 2; ++ks) qf[rb][ks] = *(const GAS bf16x8*)(Qg + (size_t)(m0 + 8 * w + 4 * rb + (l15 >> 2)) * 512 + g * 256 + (l15 & 3) * 64 + 32 * ks + 8 * lq);
        const int jq = l15 & 3;
        const int ncmp = 4 * c + 3, n1 = (ncmp + 63) >> 6, nsel = c + 1, w0 = c >= 8 ? c - 8 : 0, nwin = c - w0 + 1;
        const int ntiles = 2 * n1 + nsel + nwin;
        const bf16* KC = (const bf16*)(ws + WS_KC) + (size_t)bg * 256 * 64; const bf16* VCT = (const bf16*)(ws + WS_VCT) + (size_t)bg * 64 * 256;
        const bf16* KS = (const bf16*)(ws + WS_KS) + (size_t)bg * SEQ * 64; const bf16* VST = (const bf16*)(ws + WS_VST) + (size_t)bg * 64 * SEQ;
        const bf16* KW = (const bf16*)(ws + WS_KW) + (size_t)bg * SEQ * 64; const bf16* VWT = (const bf16*)(ws + WS_VWT) + (size_t)bg * 64 * SEQ;
#define AT_TILE(i, kind, idx, T) do { int _i = (i); if (_i < n1) { kind = 0; idx = _i; T.k = KC + (size_t)idx * 4096; T.vt = VCT + 64 * idx; T.vstride = 256; } \
        else if (_i < 2 * n1) { kind = 1; idx = _i - n1; T.k = KC + (size_t)idx * 4096; T.vt = VCT + 64 * idx; T.vstride = 256; } \
        else if (_i < 2 * n1 + nsel) { kind = 2; idx = _i - 2 * n1; T.k = KS + (size_t)idx * 4096; T.vt = VST + 64 * idx; T.vstride = SEQ; } \
        else { kind = 3; idx = w0 + (_i - 2 * n1 - nsel); T.k = KW + (size_t)idx * 4096; T.vt = VWT + 64 * idx; T.vstride = SEQ; } } while (0)
        const int srow = tid >> 3, sch = tid & 7;
        v4u kreg, vreg;
        { int kind, idx; AtTile T; AT_TILE(0, kind, idx, T); (void)kind;
          kreg = *(const GAS v4u*)(T.k + srow * 64 + 8 * sch); vreg = *(const GAS v4u*)(T.vt + (size_t)srow * T.vstride + 8 * sch);
          *(LAS v4u*)(L + AT_OFF_K + srow * 144 + 16 * sch) = kreg; *(LAS v4u*)(L + AT_OFF_V + srow * 144 + 16 * sch) = vreg; }
        __syncthreads();
        float lpart[2] = {0.f, 0.f};
        float linv[2];
        pg8::f32x4 oacc[2][4];
        float lsum[2];
#pragma unroll
        for (int rb = 0; rb < 2; ++rb) { lsum[rb] = 0.f; linv[rb] = 0.f;
#pragma unroll
            for (int db = 0; db < 4; ++db) oacc[rb][db] = (pg8::f32x4){0.f, 0.f, 0.f, 0.f}; }
        const int tok_r[2] = {8 * w + (l15 >> 2), 8 * w + 4 + (l15 >> 2)};
        for (int it = 0; it < ntiles; ++it) {
            int kind, idx; AtTile T; AT_TILE(it, kind, idx, T);
            const int buf = it & 1;
            if (it + 1 < ntiles) { int k2, i2; AtTile T2; AT_TILE(it + 1, k2, i2, T2); (void)k2; (void)i2;
                kreg = *(const GAS v4u*)(T2.k + srow * 64 + 8 * sch); vreg = *(const GAS v4u*)(T2.vt + (size_t)srow * T2.vstride + 8 * sch); }
            if (kind == 2 && idx == 0) {
                { const int tok = tid >> 3, s0 = (tid & 7) * 8;
                  float my[8]; int rank[8];
#pragma unroll
                  for (int q = 0; q < 8; ++q) { const int s = s0 + q;
                      const bool vis = s <= c, forced = (s == 0) || (s == c) || (s == c - 1);
                      my[q] = vis ? (IMP1[tok * 65 + s] + IMP2[tok * 65 + s] + (forced ? 1000.f : 0.f)) : -1.f; rank[q] = 0; }
#pragma unroll
                  for (int q = 0; q < 8; ++q) IMP1[tok * 65 + s0 + q] = my[q];
                  __syncthreads();
#pragma unroll 2
                  for (int s2 = 0; s2 < 64; ++s2) { const float sc2 = IMP1[tok * 65 + s2];
#pragma unroll
                      for (int q = 0; q < 8; ++q) rank[q] += (sc2 > my[q] || (sc2 == my[q] && s2 < s0 + q)) ? 1 : 0; }
#pragma unroll
                  for (int q = 0; q < 8; ++q) SEL[tok * 64 + s0 + q] = (unsigned char)((rank[q] < 16 && (s0 + q) <= c) ? 1 : 0); }
                __syncthreads();
            }
            const LAS unsigned char* kb_ = L + AT_OFF_K + buf * AT_KBUF;
            unsigned selb[2] = {1u, 1u};
            if (kind == 2) { selb[0] = SEL[tok_r[0] * 64 + idx]; selb[1] = SEL[tok_r[1] * 64 + idx]; }
#pragma unroll
            for (int cb = 0; cb < 4; ++cb) {
                pg8::f32x4 st[2];
                st[0] = (pg8::f32x4){0.f, 0.f, 0.f, 0.f}; st[1] = st[0];
#pragma unroll
                for (int ks = 0; ks < 2; ++ks) { const bf16x8 kf = *(const LAS bf16x8*)(kb_ + (16 * cb + l15) * 144 + 64 * ks + 16 * lq);
#pragma unroll
                    for (int rb = 0; rb < 2; ++rb) st[rb] = __builtin_amdgcn_mfma_f32_16x16x32_bf16(kf, qf[rb][ks], st[rb], 0, 0, 0); }
#pragma unroll
                for (int rb = 0; rb < 2; ++rb) {
                    const int tokc = tok_r[rb];
                    float p[4];
#pragma unroll
                    for (int r = 0; r < 4; ++r) {
                        const int kl = 16 * cb + 4 * lq + r;
                        int rel; bool valid;
                        if (kind < 2) { rel = 64 * c + tokc - 16 * (64 * idx + kl) - 31; valid = rel >= 0; }
                        else { rel = 64 * (c - idx) + tokc - kl; valid = rel >= 0;
                               if (kind == 2) valid = valid && (selb[rb] != 0u); else valid = valid && (rel < 512); }
                        const int ri = rel < 0 ? 0 : (rel > 127 ? 127 : rel);
                        const float e = __expf(st[rb][r] + LUT[jq * 128 + ri]);
                        p[r] = valid ? e : 0.f; }
                    if (kind == 0) { lpart[rb] = (idx == 0 && cb == 0 ? 0.f : lpart[rb]) + ((p[0] + p[1]) + (p[2] + p[3])); }
                    else {
                        if (kind == 1) {
#pragma unroll
                            for (int r = 0; r < 4; ++r) p[r] *= linv[rb];
                            float h0 = p[0], h1 = p[1], h2 = p[2], h3 = p[3];
                            h0 += __shfl_xor(h0, 1); h1 += __shfl_xor(h1, 1); h2 += __shfl_xor(h2, 1); h3 += __shfl_xor(h3, 1);
                            h0 += __shfl_xor(h0, 2); h1 += __shfl_xor(h1, 2); h2 += __shfl_xor(h2, 2); h3 += __shfl_xor(h3, 2);
                            if (jq == 0) { const int sp = 16 * idx + 4 * cb + lq;
                                IMP1[tokc * 65 + sp] = (h0 + h1) + (h2 + 0.5f * h3);
                                if (sp + 1 < 64) IMP2[tokc * 65 + sp + 1] = 0.5f * h3; }
                        } else lsum[rb] += (p[0] + p[1]) + (p[2] + p[3]);
                        v2u pk; pk.x = pk2(p[0], p[1]); pk.y = pk2(p[2], p[3]);
                        *(LAS v2u*)(PW + (16 * rb + l15) * AT_KSTR + 16 * cb + 4 * lq) = pk; }
                }
            }
            if (kind == 0) {
                if (idx == n1 - 1) {
#pragma unroll
                    for (int rb = 0; rb < 2; ++rb) { float s = lpart[rb]; s += __shfl_xor(s, 16); s += __shfl_xor(s, 32); linv[rb] = s > 0.f ? 1.0f / s : 0.f; }
                }
            } else {
                LDS_WAIT();
                const LAS unsigned char* vb_ = L + AT_OFF_V + buf * AT_KBUF;
#pragma unroll
                for (int ks = 0; ks < 2; ++ks) {
                    bf16x8 pf[2];
#pragma unroll
                    for (int rb = 0; rb < 2; ++rb) pf[rb] = *(const LAS bf16x8*)(PW + (16 * rb + l15) * AT_KSTR + 32 * ks + 8 * lq);
#pragma unroll
                    for (int db = 0; db < 4; ++db) { const bf16x8 vf = *(const LAS bf16x8*)(vb_ + (16 * db + l15) * 144 + 64 * ks + 16 * lq);
#pragma unroll
                        for (int rb = 0; rb < 2; ++rb) oacc[rb][db] = __builtin_amdgcn_mfma_f32_16x16x32_bf16(pf[rb], vf, oacc[rb][db], 0, 0, 0); } }
                const bool endb = (kind == 1 && idx == n1 - 1) || (kind == 2 && idx == nsel - 1) || (kind == 3 && idx == c);
                if (endb) {
                    const int br = kind - 1;
                    if (kind == 1) { LROW[l15] = 1.0f; LROW[16 + l15] = 1.0f; }
                    else {
#pragma unroll
                        for (int rb = 0; rb < 2; ++rb) { float s = lsum[rb]; s += __shfl_xor(s, 16); s += __shfl_xor(s, 32); if (lq == 0) LROW[16 * rb + l15] = s > 0.f ? 1.0f / s : 0.f; lsum[rb] = 0.f; } }
                    LDS_WAIT(); asm volatile("" ::: "memory");
                    int trow0 = m0 + 8 * w + lq;
                    asm volatile("" : "+v"(trow0));
                    const float* gp = GATE + (size_t)trow0 * 24 + g * 12 + br;
                    float* yf0 = YAF + (size_t)trow0 * 512 + g * 256 + l15;
                    bf16* ya0 = YA + (size_t)trow0 * 512 + g * 256 + l15;
#pragma unroll
                    for (int rb = 0; rb < 2; ++rb)
#pragma unroll
                        for (int r = 0; r < 4; ++r) { const int qrow = 16 * rb + 4 * lq + r;
                            const float gt = gp[rb * 96 + r * 3] * LROW[qrow];
#pragma unroll
                            for (int db = 0; db < 4; ++db) { float v = gt * oacc[rb][db][r]; oacc[rb][db][r] = 0.f;
                                const int off = rb * 2048 + r * 64 + 16 * db;
                                if (br > 0) v += yf0[off];
                                if (br < 2) yf0[off] = v; else ya0[off] = (bf16)f2bf(v); } }
                }
            }
            if (it + 1 < ntiles) { *(LAS v4u*)(L + AT_OFF_K + (buf ^ 1) * AT_KBUF + srow * 144 + 16 * sch) = kreg; *(LAS v4u*)(L + AT_OFF_V + (buf ^ 1) * AT_KBUF + srow * 144 + 16 * sch) = vreg; }
            __syncthreads();
        }
        }
    }
#undef AT_TILE
}

constexpr int N_PHASES = 11;
#ifndef MK_ONE_LAUNCH
#define MK_ONE_LAUNCH 0
#endif
#ifndef MK_BUILD
#define MK_BUILD 0
#endif

__global__ void __launch_bounds__(NTHREADS, 2) fwd_kernel(Args args) {
    extern __shared__ __attribute__((aligned(16))) unsigned char lds[];
    Frame F;
    F.lds = (LAS unsigned char*)lds;
    F.MISC = (volatile LAS unsigned*)(F.lds + MISC_OFF);
    F.tid = threadIdx.x; F.lane = F.tid & 63; F.wave = __builtin_amdgcn_readfirstlane(F.tid >> 6);
    F.G = gridDim.x; F.bid = blockIdx.x; F.ws = args.ws;
    F.ctl = (gu32*)(args.ws + WS_CTL);
    for (int u = F.tid; u < (LDS_BYTES - LDSCTL_OFF) / 4; u += NTHREADS) ((LAS unsigned*)(F.lds + LDSCTL_OFF))[u] = 0u;
    __syncthreads();
    XcdBarrier bar; bar.bar = (unsigned*)(F.ctl + CW_BAR); bar.x = 0; bar.st = nullptr;
    if (MK_ONE_LAUNCH) bar = xcd_barrier_post((unsigned*)(F.ctl + CW_BAR), F.MISC + 8);
    const int lo = args.ph_lo, hi = args.ph_hi;
#define IN(k) (lo <= (k) && (k) < hi)
#define SEAM(k) do { if (IN(k) && IN((k) + 1)) xcd_barrier(bar); } while (0)
    unsigned char* ws = args.ws;
    const float* ada = (const float*)(ws + WS_ADA);

    if (IN(0)) { p0_prologue(F, args); } SEAM(0);
    if (IN(1)) { modnorm_rows(F, args.in[I_X], args.in[I_N1G], ada, 0, (bf16*)(ws + WS_H)); } SEAM(1);
    if (IN(2)) {
        pg8::Gemm g{(const bf16*)(ws + WS_H), (const bf16*)(ws + WS_WIN_T), M, NIN, D, D, D}; pg8::StaticOrder S; S.init(M, NIN, F.G, F.bid);
        EpiIn E{ws, args.in[I_QNG], args.in[I_KNG]};
        pg8::gemm_phase<EpiIn, pg8::StaticOrder, true, true>(F.lds + RING_OFF, g, S, E);
    } SEAM(2);
    if (IN(3)) { pool_phase(F); __syncthreads(); compress_phase(F, args.in[I_KNG]); __syncthreads(); vtranspose_phase(F); } SEAM(3);
    if (IN(4)) { attention_phase(F, args); } SEAM(4);
    if (IN(5)) {
        { pg8::Gemm g{(const bf16*)(ws + WS_PL), (const bf16*)(ws + WS_WEFF_T), M, D, POOLW, POOLW, POOLW}; pg8::StaticOrder S; S.init(M, D, F.G, F.bid);
          EpiMix<false> E{(bf16*)(ws + WS_MIX), (const bf16*)(ws + WS_GM), 0};
          pg8::gemm_phase<EpiMix<false>, pg8::StaticOrder, true, true>(F.lds + RING_OFF, g, S, E); }
        { pg8::Gemm g{(const bf16*)(ws + WS_YA), (const bf16*)(ws + WS_WBA_T), M, D, QW, QW, QW}; pg8::StaticOrder S; S.init(M, D, F.G, F.bid);
          EpiMix<true> E{(bf16*)(ws + WS_MIX), (const bf16*)(ws + WS_GM), 1024};
          pg8::gemm_phase<EpiMix<true>, pg8::StaticOrder, true, true>(F.lds + RING_OFF, g, S, E); }
    } SEAM(5);
    if (IN(6)) {
        pg8::Gemm g{(const bf16*)(ws + WS_MIX), (const bf16*)(ws + WS_WOUT_T), M, D, D, D, D}; pg8::StaticOrder S; S.init(M, D, F.G, F.bid);
        EpiRes E{args.in[I_X], args.out, ada, 2};
        pg8::gemm_phase<EpiRes, pg8::StaticOrder, true, true>(F.lds + RING_OFF, g, S, E);
    } SEAM(6);
    if (IN(7)) { modnorm_rows(F, args.out, args.in[I_N2G], ada, 3, (bf16*)(ws + WS_H)); } SEAM(7);
    if (IN(8)) {
        pg8::Gemm g{(const bf16*)(ws + WS_H), (const bf16*)(ws + WS_WQ_T), M, PQW, D, D, D}; pg8::StaticOrder S; S.init(M, PQW, F.G, F.bid);
        EpiStoreBf16 E{(bf16*)(ws + WS_QV), PQW};
        pg8::gemm_phase<EpiStoreBf16, pg8::StaticOrder, true, true>(F.lds + RING_OFF, g, S, E);
    } SEAM(8);
    if (IN(9)) { peer_select_phase(F); } SEAM(9);
    if (IN(10)) { peer_gather_phase(F, ada, args.out); }
#undef IN
#undef SEAM
}

extern "C" void kernel_launch(void* const* d_in, const int* in_sizes, int n_in, void* d_out, int out_size, void* d_ws, size_t ws_size, hipStream_t stream) {
    static int grid = 0;
    if (grid == 0) {
        if (n_in != N_IN || in_sizes[0] != M * D || out_size != M * D || ws_size < WS_END) {
            fprintf(stderr, "kernel_launch: unexpected shapes: n_in %d in0 %d out %d ws %zu (need %zu)\n", n_in, n_in > 0 ? in_sizes[0] : -1, out_size, ws_size, (size_t)WS_END); grid = -1; return; }
        int dev = 0, cus = 0, per_cu = 0;
        if (hipGetDevice(&dev) != hipSuccess || hipDeviceGetAttribute(&cus, hipDeviceAttributeMultiprocessorCount, dev) != hipSuccess) { grid = -1; return; }
        if (hipFuncSetAttribute((const void*)fwd_kernel, hipFuncAttributeMaxDynamicSharedMemorySize, LDS_BYTES) != hipSuccess) { fprintf(stderr, "kernel_launch: hipFuncSetAttribute failed\n"); grid = -1; return; }
        if (hipOccupancyMaxActiveBlocksPerMultiprocessor(&per_cu, (const void*)fwd_kernel, NTHREADS, LDS_BYTES) != hipSuccess || per_cu < 1)
            fprintf(stderr, "kernel_launch: occupancy query reports %d workgroups per CU\n", per_cu);
        (void)hipGetLastError();
        grid = cus;
    }
    if (grid < 0) return;
    if (hipMemsetAsync((char*)d_ws + WS_CTL, 0, CTL_ZERO_BYTES, stream) != hipSuccess) return;
    Args a{};
    for (int i = 0; i < N_IN; ++i) a.in[i] = (const float*)d_in[i];
    a.out = (float*)d_out; a.ws = (unsigned char*)d_ws;
    if (MK_ONE_LAUNCH) {
        a.ph_lo = 0; a.ph_hi = N_PHASES; a.li = 0;
        hipLaunchKernelGGL(fwd_kernel, dim3(grid), dim3(NTHREADS), LDS_BYTES, stream, a);
    } else {
        for (int p = 0; p < N_PHASES; ++p) {
            a.ph_lo = p; a.ph_hi = p + 1; a.li = p;
            hipLaunchKernelGGL(fwd_kernel, dim3(grid), dim3(NTHREADS), LDS_BYTES, stream, a);
        }
    }
}
```

```cpp
#include <hip/hip_runtime.h>
#include <cstdio>
#include <cstdint>
namespace pg8 {
#define PG8_LAS __attribute__((address_space(3)))
typedef unsigned short bf16_t;
typedef short bf16x8 __attribute__((ext_vector_type(8)));
typedef float f32x4 __attribute__((ext_vector_type(4)));
typedef unsigned u32x4 __attribute__((ext_vector_type(4)));
constexpr int BM = 256, BK = 64, HALF = 128, HTB = HALF * BK * 2  , STAGE_BYTES = 8 * HTB, NXCD = 8, WGM = 8;

__host__ __device__ __forceinline__ int lds_byte(int r, int c) { const int st = (r >> 4) * 2 + (c >> 5), rr = r & 15, cc = c & 31, ob = rr * 64 + cc * 2; return st * 1024 + (ob ^ (((ob >> 9) & 1) << 5)); }
__host__ __device__ __forceinline__ void stage_rc(int b, int& R, int& C) { const int st = b / 1024, sb = b % 1024, swz = sb ^ (((sb >> 9) & 1) << 5); R = (st >> 1) * 16 + swz / 64; C = (st & 1) * 32 + (swz % 64) / 2; }
__host__ __device__ __forceinline__ int perm32(int rho) { const int n = rho >> 4, i = rho & 15; return 8 * (i >> 2) + 4 * n + (i & 3); }

struct Unit { int pm, pn; };
struct Gemm { const bf16_t* A; const bf16_t* Bt; int M, N, K, lda, ldb; };

struct StaticOrder {
    int nM, nN, nwg, G, c;
    __host__ __device__ void init(int M, int N, int G_, int c_) { nM = M / BM; nN = N / BM; nwg = nM * nN; G = G_; c = c_; }
    __host__ __device__ bool next(int i, Unit& u) const {
        const long L = (long)i * G + c; if (L >= nwg) return false;
        int wgid = (int)L; { const int q = nwg / NXCD, r = nwg % NXCD, xcd = wgid % NXCD, off = wgid / NXCD; wgid = (xcd < r ? xcd * (q + 1) : r * (q + 1) + (xcd - r) * q) + off; }
        const int nig = WGM * nN, gid = wgid / nig, fm = gid * WGM, gsz = (nM - fm) < WGM ? (nM - fm) : WGM;
        u.pm = fm + ((wgid % nig) % gsz); u.pn = (wgid % nig) / gsz; return true;
    }
    __device__ __forceinline__ void a_ready(const Unit&) const {}
    __device__ __forceinline__ void done(const Unit&) const {}
};

__device__ __forceinline__ unsigned cvt_pk_bf16(float lo, float hi) { unsigned r; asm volatile("v_cvt_pk_bf16_f32 %0, %1, %2" : "=v"(r) : "v"(lo), "v"(hi)); return r; }
template <class Epi, class Sched, bool ALIGN_EPI = false, bool SP2 = false>
__device__ __forceinline__ void gemm_phase(PG8_LAS unsigned char* lds, const Gemm g, const Sched& S, const Epi& E) {
    const int tid = threadIdx.x, wid = __builtin_amdgcn_readfirstlane(tid >> 6), lane = tid & 63, wr = wid >> 2, wc = wid & 3, fr = lane & 15, fq = lane >> 4;
    const int K = g.K, nt = K / BK;
    unsigned voffA[2], voffB[2];
#pragma unroll
    for (int i = 0; i < 2; ++i) { int R, C; stage_rc(tid * 16 + i * 8192, R, C); const int Rb = Epi::PERM ? ((R & ~31) + perm32(R & 31)) : R;
        voffA[i] = (unsigned)(R * g.lda + C) * 2u; voffB[i] = (unsigned)(Rb * g.ldb + C) * 2u; }
    const size_t kstep = (size_t)(BK * 2);
    const size_t hstepA = (size_t)HALF * g.lda * 2, hstepB = (size_t)HALF * g.ldb * 2;
    const size_t tstepA = 2 * hstepA, tstepB = 2 * hstepB;
    const unsigned ldsw = (unsigned)wid * 1024u;
    const int aoff = lds_byte(wr * 64 + fr, fq * 8), boff = lds_byte(wc * 32 + fr, fq * 8);
#define PG8_SA(b, h) (((b) * 2 + (h)) * HTB)
#define PG8_SB(b, h) ((4 + (b) * 2 + (h)) * HTB)
#define PG8_STAGE(bufoff, gbase, voff) do { _Pragma("unroll") for (int _i = 0; _i < 2; ++_i) \
        __builtin_amdgcn_global_load_lds((const unsigned*)((const char*)(gbase) + (voff)[_i]), (PG8_LAS unsigned*)(lds + (bufoff) + ldsw + _i * 8192), 16, 0, 0); } while (0)
#define PG8_LDA(dst, b, h) do { _Pragma("unroll") for (int m = 0; m < 4; ++m) _Pragma("unroll") for (int k = 0; k < 2; ++k) dst[m][k] = *(const PG8_LAS bf16x8*)(lds + PG8_SA(b, h) + aoff + m * 2048 + k * 1024); } while (0)
#define PG8_LDB(dst, b, h) do { _Pragma("unroll") for (int n = 0; n < 2; ++n) _Pragma("unroll") for (int k = 0; k < 2; ++k) dst[n][k] = *(const PG8_LAS bf16x8*)(lds + PG8_SB(b, h) + boff + n * 2048 + k * 1024); } while (0)
#define PG8_MMA(ai, bj, At, Bt) do { __builtin_amdgcn_s_setprio(1); _Pragma("unroll") for (int m = 0; m < 4; ++m) _Pragma("unroll") for (int n = 0; n < 2; ++n) _Pragma("unroll") for (int k = 0; k < 2; ++k) \
        acc[ai][bj][m][n] = __builtin_amdgcn_mfma_f32_16x16x32_bf16(Bt[n][k], At[m][k], acc[ai][bj][m][n], 0, 0, 0); __builtin_amdgcn_s_setprio(0); } while (0)
#define PG8_WAIT_V(n) asm volatile("s_waitcnt vmcnt(" #n ")" ::: "memory")
#define PG8_WAIT_L(n) asm volatile("s_waitcnt lgkmcnt(" #n ")" ::: "memory")
#define PG8_BAR __builtin_amdgcn_s_barrier()
#define PG8_SCHED __builtin_amdgcn_sched_barrier(0)
    Unit cur, nxt; int ui = 0;
    if (!S.next(0, cur)) return;
    f32x4 acc[2][2][4][2];
#pragma unroll
    for (int a = 0; a < 2; ++a)
#pragma unroll
        for (int b = 0; b < 2; ++b)
#pragma unroll
            for (int m = 0; m < 4; ++m)
#pragma unroll
                for (int n = 0; n < 2; ++n) acc[a][b][m][n] = (f32x4){0.f, 0.f, 0.f, 0.f};
    bf16x8 At[4][2], B0[2][2], B1[2][2];
    const char* cA = (const char*)g.A + (size_t)cur.pm * tstepA; const char* cB = (const char*)g.Bt + (size_t)cur.pn * tstepB;
    S.a_ready(cur);
    if constexpr (SP2) {
        PG8_STAGE(PG8_SB(0, 0), cB, voffB); PG8_STAGE(PG8_SB(0, 1), cB + hstepB, voffB); PG8_STAGE(PG8_SA(0, 0), cA, voffA); PG8_STAGE(PG8_SA(0, 1), cA + hstepA, voffA);
        if (wr == 1) PG8_BAR;
        PG8_WAIT_V(2); PG8_BAR;
        PG8_STAGE(PG8_SB(1, 0), cB + kstep, voffB); PG8_STAGE(PG8_SA(1, 0), cA + kstep, voffA); PG8_STAGE(PG8_SB(1, 1), cB + hstepB + kstep, voffB);
        PG8_WAIT_V(6); PG8_BAR;
    } else {
        PG8_STAGE(PG8_SB(0, 0), cB, voffB); PG8_STAGE(PG8_SA(0, 0), cA, voffA); PG8_STAGE(PG8_SB(0, 1), cB + hstepB, voffB); PG8_STAGE(PG8_SA(0, 1), cA + hstepA, voffA);
        if (wr == 1) PG8_BAR;
        PG8_WAIT_V(4); PG8_BAR;
        PG8_STAGE(PG8_SB(1, 0), cB + kstep, voffB); PG8_STAGE(PG8_SA(1, 0), cA + kstep, voffA); PG8_STAGE(PG8_SB(1, 1), cB + hstepB + kstep, voffB);
        PG8_WAIT_V(6); PG8_BAR;
    }
    for (;;) {
        const bool has_next = S.next(ui + 1, nxt);
        const char* nA = has_next ? (const char*)g.A + (size_t)nxt.pm * tstepA : cA; const char* nB = has_next ? (const char*)g.Bt + (size_t)nxt.pn * tstepB : cB;
        for (int t = 0; t < nt; t += 2) {
            const bool last = (t == nt - 2);
            const char* a1 = cA + (size_t)(t + 1) * kstep;
            const char* a2 = last ? nA : cA + (size_t)(t + 2) * kstep; const char* b2 = last ? nB : cB + (size_t)(t + 2) * kstep;
            const char* a3 = a2 + kstep; const char* b3 = b2 + kstep;
            if (last && has_next) S.a_ready(nxt);
            if constexpr (SP2) {
            PG8_LDB(B0, 0, 0); PG8_LDB(B1, 0, 1); PG8_SCHED; PG8_LDA(At, 0, 0); PG8_STAGE(PG8_SA(1, 1), a1 + hstepA, voffA);
            PG8_WAIT_V(8); PG8_WAIT_L(0); PG8_BAR; PG8_MMA(0, 0, At, B0); PG8_MMA(0, 1, At, B1); PG8_BAR; PG8_SCHED;
            PG8_LDA(At, 0, 1); PG8_STAGE(PG8_SB(0, 0), b2, voffB); PG8_STAGE(PG8_SB(0, 1), b2 + hstepB, voffB); PG8_STAGE(PG8_SA(0, 0), a2, voffA);
            PG8_WAIT_V(8); PG8_WAIT_L(0); PG8_BAR; PG8_MMA(1, 0, At, B0); PG8_MMA(1, 1, At, B1); PG8_BAR; PG8_SCHED;
            PG8_LDB(B0, 1, 0); PG8_LDB(B1, 1, 1); PG8_SCHED; PG8_LDA(At, 1, 0); PG8_STAGE(PG8_SA(0, 1), a2 + hstepA, voffA);
            PG8_WAIT_V(8); PG8_WAIT_L(0); PG8_BAR; PG8_MMA(0, 0, At, B0); PG8_MMA(0, 1, At, B1); PG8_BAR; PG8_SCHED;
            PG8_LDA(At, 1, 1); PG8_STAGE(PG8_SB(1, 0), b3, voffB); PG8_STAGE(PG8_SB(1, 1), b3 + hstepB, voffB); PG8_STAGE(PG8_SA(1, 0), a3, voffA);
            PG8_WAIT_V(8); PG8_WAIT_L(0); PG8_BAR; PG8_MMA(1, 0, At, B0); PG8_MMA(1, 1, At, B1); PG8_BAR; PG8_SCHED;
            } else {
            PG8_LDB(B0, 0, 0); PG8_SCHED; PG8_LDA(At, 0, 0); PG8_STAGE(PG8_SA(1, 1), a1 + hstepA, voffA);
            PG8_WAIT_L(8); PG8_BAR; PG8_WAIT_L(0); PG8_MMA(0, 0, At, B0); PG8_BAR; PG8_SCHED;
            PG8_LDB(B1, 0, 1); PG8_STAGE(PG8_SB(0, 0), b2, voffB);
            PG8_BAR; PG8_WAIT_L(0); PG8_MMA(0, 1, At, B1); PG8_BAR;
            PG8_LDA(At, 0, 1); PG8_STAGE(PG8_SA(0, 0), a2, voffA);
            PG8_BAR; PG8_WAIT_L(0); PG8_MMA(1, 0, At, B0); PG8_BAR; PG8_SCHED;
            PG8_STAGE(PG8_SB(0, 1), b2 + hstepB, voffB);
            PG8_WAIT_V(6); PG8_BAR; PG8_MMA(1, 1, At, B1); PG8_BAR;
            PG8_LDB(B0, 1, 0); PG8_SCHED; PG8_LDA(At, 1, 0); PG8_STAGE(PG8_SA(0, 1), a2 + hstepA, voffA);
            PG8_WAIT_L(8); PG8_BAR; PG8_WAIT_L(0); PG8_MMA(0, 0, At, B0); PG8_BAR; PG8_SCHED;
            PG8_LDB(B1, 1, 1); PG8_STAGE(PG8_SB(1, 0), b3, voffB);
            PG8_BAR; PG8_WAIT_L(0); PG8_MMA(0, 1, At, B1); PG8_BAR;
            PG8_LDA(At, 1, 1); PG8_STAGE(PG8_SA(1, 0), a3, voffA);
            PG8_BAR; PG8_WAIT_L(0); PG8_MMA(1, 0, At, B0); PG8_BAR; PG8_SCHED;
            PG8_STAGE(PG8_SB(1, 1), b3 + hstepB, voffB);
            PG8_WAIT_V(6); PG8_BAR; PG8_MMA(1, 1, At, B1); PG8_BAR;
            }
        }
        if constexpr (ALIGN_EPI) { if (wr == 0) PG8_BAR; }
        if constexpr (!Epi::AFTER_DRAIN) { E(acc, cur, wr, wc, fr, fq); S.done(cur); }
        if (!has_next) break;
#pragma unroll
        for (int a = 0; a < 2; ++a)
#pragma unroll
            for (int b = 0; b < 2; ++b)
#pragma unroll
                for (int m = 0; m < 4; ++m)
#pragma unroll
                    for (int n = 0; n < 2; ++n) acc[a][b][m][n] = (f32x4){0.f, 0.f, 0.f, 0.f};
        cur = nxt; cA = nA; cB = nB; ++ui;
        if constexpr (ALIGN_EPI) { if (wr == 1) PG8_BAR; }
    }
    PG8_WAIT_V(0);
    if constexpr (!ALIGN_EPI) { if (wr == 0) PG8_BAR; }
    PG8_BAR;
    if constexpr (Epi::AFTER_DRAIN) { E.fused(acc, cur, wr, wc, fr, fq, lds, wid, lane); S.done(cur); }
#undef PG8_SA
#undef PG8_SB
#undef PG8_STAGE
#undef PG8_LDA
#undef PG8_LDB
#undef PG8_MMA
#undef PG8_WAIT_V
#undef PG8_WAIT_L
#undef PG8_BAR
#undef PG8_SCHED
}
}

constexpr int NWAVES = 8, NTHREADS = NWAVES * 64;
constexpr int BATCH = 8, SEQ = 4096, D = 1024, M = BATCH * SEQ;
constexpr int POOLW = 512, QW = 512, NG = 2, HD = 64, NBG = BATCH * NG;
constexpr int IN_COLS = 3864, NIN = 4096;
constexpr int NCMP = 255, NCMP_PAD = 256, NSEL = 64;
constexpr int PH = 8, PK = 128, PTOP = 16, PQD = 256, PQW = PH * PQD;
constexpr int NEXP = PK * PK;
constexpr float EPS = 1e-6f;
enum { I_X = 0, I_C, I_RELB, I_ADAW, I_ADAB, I_N1G, I_N2G, I_WIN, I_POOLW, I_POOLS, I_CPEK, I_CW1K, I_CW2K, I_CPEV, I_CW1V, I_CW2V, I_QNG, I_KNG, I_WBP, I_WBA, I_WOUT, I_PWQ, I_PSK, I_PU, I_PV, N_IN };

constexpr size_t MiB = 1u << 20, KiB = 1u << 10;
constexpr size_t WS_CTL = 0, CTL_ZERO_BYTES = 1 * MiB;
constexpr size_t WS_ADA = 1 * MiB;
constexpr size_t WS_CB1K = WS_ADA + 256 * KiB;
constexpr size_t WS_CB1V = WS_CB1K + 1 * KiB;
constexpr size_t WS_BIASL = WS_CB1V + 1 * KiB;
constexpr size_t WS_WIN_T = 2 * MiB;
constexpr size_t WS_WEFF_T = 10 * MiB;
constexpr size_t WS_WBA_T = 11 * MiB;
constexpr size_t WS_WOUT_T = 12 * MiB;
constexpr size_t WS_WQ_T = 14 * MiB;
constexpr size_t WS_SUBK = 18 * MiB;
constexpr size_t WS_CW1K_T = 18 * MiB + 512 * KiB;
constexpr size_t WS_CW1V_T = 19 * MiB;
constexpr size_t WS_CW2K_T = 19 * MiB + 512 * KiB;
constexpr size_t WS_CW2V_T = WS_CW2K_T + 64 * KiB;
constexpr size_t WS_KC = 20 * MiB;
constexpr size_t WS_VCT = 20 * MiB + 512 * KiB;
constexpr size_t WS_GATE = 21 * MiB;
constexpr size_t WS_UB = 24 * MiB;
constexpr size_t WS_VB = 56 * MiB;
constexpr size_t WS_H = 88 * MiB;
constexpr size_t WS_ZP = 152 * MiB;
constexpr size_t WS_Q = 184 * MiB;
constexpr size_t WS_KCR = 216 * MiB;
constexpr size_t WS_VCR = 225 * MiB;
constexpr size_t WS_KS = 234 * MiB, WS_VS = 242 * MiB, WS_KW = 250 * MiB, WS_VW = 258 * MiB;
constexpr size_t WS_VST = 266 * MiB, WS_VWT = 274 * MiB;
constexpr size_t WS_PL = 282 * MiB;
constexpr size_t WS_YA = 314 * MiB;
constexpr size_t WS_GM = 346 * MiB;
constexpr size_t WS_MIX = WS_ZP;
constexpr size_t WS_QV = WS_GM;
constexpr size_t WS_EID = WS_PL;
constexpr size_t WS_GW = WS_PL + 16 * MiB;
constexpr size_t WS_END = 474 * MiB;
constexpr int CW_TMO = 0, CW_CODE = 1, CW_BAR = 4096;

constexpr int RING_OFF = 0, RING_BYTES = 131072;
constexpr int LDSCTL_OFF = RING_BYTES, MISC_OFF = LDSCTL_OFF + 320;
constexpr int LDS_BYTES = 147456;

#define GAS __attribute__((address_space(1)))
#define LAS __attribute__((address_space(3)))
typedef unsigned short bf16;
typedef unsigned v4u __attribute__((ext_vector_type(4)));
typedef unsigned v2u __attribute__((ext_vector_type(2)));
typedef float f32x4 __attribute__((ext_vector_type(4)));
typedef short bf16x8 __attribute__((ext_vector_type(8)));
typedef GAS unsigned gu32;
#define RLX_AGENT __ATOMIC_RELAXED, __HIP_MEMORY_SCOPE_AGENT
#define LDS_WAIT() asm volatile("s_waitcnt lgkmcnt(0)" ::: "memory")
#define VM_WAIT() asm volatile("s_waitcnt vmcnt(0)" ::: "memory")
__device__ __forceinline__ unsigned f2bf(float f) { unsigned u = __builtin_bit_cast(unsigned, f); return (u + 0x7fffu + ((u >> 16) & 1u)) >> 16; }
__device__ __forceinline__ unsigned pk2(float lo, float hi) { return f2bf(lo) | (f2bf(hi) << 16); }
__device__ __forceinline__ float bflo(unsigned w) { return __builtin_bit_cast(float, w << 16); }
__device__ __forceinline__ float bfhi(unsigned w) { return __builtin_bit_cast(float, w & 0xffff0000u); }
__device__ __forceinline__ float sigmoidf_(float v) { return 1.0f / (1.0f + __expf(-v)); }
__device__ __forceinline__ float gelu_tanh_safe(float v) { const float u = 0.7978845608028654f * (v + 0.044715f * v * v * v); return 0.5f * v * (1.0f + tanhf(u)); }
__device__ __forceinline__ float wave_sum(float v) {
#pragma unroll
    for (int o = 1; o < 64; o <<= 1) v += __shfl_xor(v, o);
    return v;
}

#define XB_TMO      128
#define XB_XCNT(j)  (256  + 64 * (j))
#define XB_XSUB(j)  (1280 + 64 * (j))
#define XB_XGEN(j)  (2304 + 64 * (j))
#define XB_TOP      3328
#define XB_TOPGEN   3392
#define XCD_BAR_WORDS 3456
#define XB_SPIN_CAP (1u << 18)
__device__ __forceinline__ unsigned xb_ld(unsigned* p)              { return __hip_atomic_load(p, __ATOMIC_RELAXED, __HIP_MEMORY_SCOPE_AGENT); }
__device__ __forceinline__ unsigned xb_add(unsigned* p, unsigned v) { return __hip_atomic_fetch_add(p, v, __ATOMIC_RELAXED, __HIP_MEMORY_SCOPE_AGENT); }
__device__ __forceinline__ unsigned xb_xcc_id() { return (unsigned)__builtin_amdgcn_s_getreg((3 << 11) | 20) & 0xFu; }
#define XB_SPIN(cond, bar) do { unsigned _sp = 0; while (cond) { __builtin_amdgcn_s_sleep(1); \
    if ((++_sp & 255u) == 0u) { if (xb_ld(&(bar)[XB_TMO])) break; if (_sp > XB_SPIN_CAP) { atomicAdd(&(bar)[XB_TMO], 1u); break; } } } } while (0)
struct XcdBarrier { unsigned* bar; unsigned x; volatile LAS unsigned* st; };
__device__ __forceinline__ XcdBarrier xcd_barrier_post(unsigned* bar, volatile LAS unsigned* st) {
    XcdBarrier b; b.bar = bar; b.x = xb_xcc_id(); b.st = st;
    if (threadIdx.x == 0) (void)xb_add(&bar[XB_XCNT(b.x)], 1u);
    return b;
}
__device__ __forceinline__ void xcd_barrier_complete(unsigned* bar, unsigned x, unsigned& nloc, unsigned& nx) {
    const unsigned G = gridDim.x * gridDim.y * gridDim.z;
    unsigned sum, cnt, mine, sp = 0u;
    for (;;) {
        sum = 0u; cnt = 0u; mine = 0u;
#pragma unroll
        for (unsigned j = 0; j < 16; ++j) { const unsigned c = xb_ld(&bar[XB_XCNT(j)]); sum += c; cnt += (c > 0u) ? 1u : 0u; mine = (j == x) ? c : mine; }
        if (sum == G) break;
        __builtin_amdgcn_s_sleep(1);
        if ((++sp & 255u) == 0u) { if (xb_ld(&bar[XB_TMO])) break; if (sp > XB_SPIN_CAP) { atomicAdd(&bar[XB_TMO], 1u); break; } }
    }
    nloc = mine > 0u ? mine : 1u; nx = cnt > 0u ? cnt : 1u;
}
__device__ __forceinline__ void xcd_barrier(const XcdBarrier& b) {
    asm volatile("s_waitcnt vmcnt(0)" ::: "memory");
    __syncthreads();
    if (threadIdx.x == 0) {
        unsigned* bar = b.bar;
        __builtin_amdgcn_s_waitcnt(0);
        unsigned nloc = b.st[0], nx = b.st[1];
        if (nloc == 0u) { xcd_barrier_complete(bar, b.x, nloc, nx); b.st[0] = nloc; b.st[1] = nx; }
        const unsigned old = xb_add(&bar[XB_XSUB(b.x)], 1u);
        const unsigned gen = old / nloc;
        if (old + 1u == (gen + 1u) * nloc) {
            __builtin_amdgcn_fence(__ATOMIC_RELEASE, "agent");
            asm volatile("s_waitcnt vmcnt(0)" ::: "memory");
            const unsigned og = xb_add(&bar[XB_TOP], 1u);
            const unsigned tg = og / nx;
            if (og + 1u == (tg + 1u) * nx) xb_add(&bar[XB_TOPGEN], 1u);
            else XB_SPIN(xb_ld(&bar[XB_TOPGEN]) == tg, bar);
            __builtin_amdgcn_fence(__ATOMIC_ACQUIRE, "agent");
            xb_add(&bar[XB_XGEN(b.x)], 1u);
            asm volatile("s_waitcnt vmcnt(0)" ::: "memory");
        } else {
            XB_SPIN(xb_ld(&bar[XB_XGEN(b.x)]) == gen, bar);
            __builtin_amdgcn_fence(__ATOMIC_ACQUIRE, "agent");
            asm volatile("s_waitcnt vmcnt(0)" ::: "memory");
        }
    }
    __syncthreads();
}

struct Args { const float* in[N_IN]; float* out; unsigned char* ws; int ph_lo, ph_hi, li, pad; };
struct Frame {
    LAS unsigned char* lds;
    volatile LAS unsigned* MISC;
    gu32* ctl;
    int tid, lane, wave, G, bid;
    unsigned char* ws;
};

__device__ __forceinline__ void p0_transpose_item(const float* W, int ldw, int src_col0, int valid, int K, bf16* WT, int dst_row0, int k0, LAS float* scr, int lane) {
    const int n_ = lane & 31;
#pragma unroll 8
    for (int i = 0; i < 32; ++i) { const int kk = 2 * i + (lane >> 5); scr[kk * 33 + n_] = (n_ < valid) ? W[(size_t)(k0 + kk) * ldw + src_col0 + n_] : 0.f; }
    LDS_WAIT(); asm volatile("" ::: "memory");
    const int c = lane & 7;
#pragma unroll
    for (int j = 0; j < 4; ++j) { const int n = (lane >> 3) + 8 * j; const LAS float* s = scr + (8 * c) * 33 + n;
        v4u o; o.x = pk2(s[0 * 33], s[1 * 33]); o.y = pk2(s[2 * 33], s[3 * 33]); o.z = pk2(s[4 * 33], s[5 * 33]); o.w = pk2(s[6 * 33], s[7 * 33]);
        *(GAS v4u*)(WT + (size_t)(dst_row0 + n) * K + k0 + 8 * c) = o; }
    LDS_WAIT(); asm volatile("" ::: "memory");
}
__device__ __forceinline__ bool p0_mat(int& r, const float* W, int K, int N, bf16* WT, LAS float* scr, int lane) {
    const int ng = N / 32, items = ng * (K / 64);
    if (r < items) { const int kb = r / ng, nb = r % ng; p0_transpose_item(W, N, 32 * nb, 32, K, WT, 32 * nb, 64 * kb, scr, lane); return true; }
    r -= items; return false;
}
__device__ __forceinline__ void cvt_f32_bf16_stream(const float* src, bf16* dst, size_t n8, size_t gtid, size_t gthreads) {
    for (size_t i = gtid; i < n8; i += gthreads) {
        const f32x4 a = *(const GAS f32x4*)(src + 8 * i), b = *(const GAS f32x4*)(src + 8 * i + 4);
        v4u o; o.x = pk2(a.x, a.y); o.y = pk2(a.z, a.w); o.z = pk2(b.x, b.y); o.w = pk2(b.z, b.w);
        *(GAS v4u*)(dst + 8 * i) = o; }
}

__device__ __forceinline__ void p0_prologue(Frame& F, const Args& args) {
    unsigned char* ws = F.ws;
    const int gw = F.bid * NWAVES + F.wave, NGW = F.G * NWAVES;
    const size_t gtid = (size_t)F.bid * NTHREADS + F.tid, gthreads = (size_t)F.G * NTHREADS;
    {
        LAS float* sl = (LAS float*)(F.lds);
        LAS float* red = (LAS float*)(F.lds + 32768);
        const float* c = args.in[I_C];
        for (int i = F.tid; i < BATCH * D; i += NTHREADS) { const float v = c[i]; sl[i] = v / (1.0f + __expf(-v)); }
        __syncthreads();
        for (int cb = F.bid; cb < 6 * D / 24; cb += F.G) {
            const int j0 = cb * 24;
            if (F.tid < 504) {
                const int kk = F.tid / 24, jj = F.tid % 24;
                float a[BATCH];
#pragma unroll
                for (int b = 0; b < BATCH; ++b) a[b] = 0.f;
                const float* w = args.in[I_ADAW] + j0 + jj;
                for (int k = kk; k < D; k += 21) { const float wv = w[(size_t)k * (6 * D)];
#pragma unroll
                    for (int b = 0; b < BATCH; ++b) a[b] += sl[b * D + k] * wv; }
#pragma unroll
                for (int b = 0; b < BATCH; ++b) red[(kk * 24 + jj) * BATCH + b] = a[b];
            }
            __syncthreads();
            if (F.tid < 24 * BATCH) { const int jj = F.tid / BATCH, b = F.tid % BATCH; float s = 0.f;
                for (int kk = 0; kk < 21; ++kk) s += red[(kk * 24 + jj) * BATCH + b];
                ((float*)(ws + WS_ADA))[b * (6 * D) + j0 + jj] = s + args.in[I_ADAB][j0 + jj]; }
            __syncthreads();
        }
    }
    if (F.bid < 2) {
        const float* pe = args.in[F.bid == 0 ? I_CPEK : I_CPEV]; const float* w1 = args.in[F.bid == 0 ? I_CW1K : I_CW1V];
        LAS float* red = (LAS float*)(F.lds);
        const int j = F.tid & 127, ic = F.tid >> 7; float s = 0.f;
        for (int i = ic * 512; i < ic * 512 + 512; ++i) s += pe[i] * w1[(size_t)i * 128 + j];
        red[ic * 128 + j] = s; __syncthreads();
        if (F.tid < 128) ((float*)(ws + (F.bid == 0 ? WS_CB1K : WS_CB1V)))[F.tid] = (red[F.tid] + red[128 + F.tid]) + (red[256 + F.tid] + red[384 + F.tid]);
        __syncthreads();
    } else if (F.bid == 2) {
        for (int i = F.tid; i < 8 * 128; i += NTHREADS) { const int h = i >> 7, rel = i & 127;
            int bk = rel;
            if (rel >= 16) bk = 16 + (rel >= 19) + (rel >= 21) + (rel >= 24) + (rel >= 27) + (rel >= 31) + (rel >= 35) + (rel >= 40) + (rel >= 46) + (rel >= 52) + (rel >= 59) + (rel >= 67) + (rel >= 77) + (rel >= 87) + (rel >= 99) + (rel >= 113);
            ((float*)(ws + WS_BIASL))[i] = args.in[I_RELB][bk * 8 + h]; }
    }
    {
        LAS float* scr = (LAS float*)(F.lds + F.wave * 16384);
        constexpr int I_WINT = (NIN / 32) * (D / 64);
        constexpr int NITEMS = I_WINT + (1024 / 32) * (512 / 64) + (1024 / 32) * (1024 / 64) + (2048 / 32) * (1024 / 64) + 2 * (128 / 32) * (2048 / 64) + 2 * (64 / 32) * (128 / 64);
        for (int it = gw; it < NITEMS; it += NGW) {
            int r = it;
            if (r < I_WINT) {
                const int grp = r % (NIN / 32), kb = r / (NIN / 32);
                const int tile = grp >> 3, ct0 = (grp & 7) * 32;
                const int L0 = 64 * ((ct0 >> 5) & 3) + 32 * (ct0 >> 7);
                int src0, valid = 32;
                if (tile < 7) src0 = 256 * tile + L0; else if (tile < 15) src0 = 1816 + 256 * (tile - 7) + L0; else { src0 = 1792 + L0; valid = (L0 == 0) ? 24 : 0; }
                if (valid == 0) src0 = 0;
                p0_transpose_item(args.in[I_WIN], IN_COLS, src0, valid, D, (bf16*)(ws + WS_WIN_T), 32 * grp, 64 * kb, scr, F.lane);
                continue; }
            r -= I_WINT;
            if (p0_mat(r, args.in[I_WBA], 512, 1024, (bf16*)(ws + WS_WBA_T), scr, F.lane)) continue;
            if (p0_mat(r, args.in[I_WOUT], 1024, 1024, (bf16*)(ws + WS_WOUT_T), scr, F.lane)) continue;
            if (p0_mat(r, args.in[I_PWQ], 1024, 2048, (bf16*)(ws + WS_WQ_T), scr, F.lane)) continue;
            if (p0_mat(r, args.in[I_CW1K], 2048, 128, (bf16*)(ws + WS_CW1K_T), scr, F.lane)) continue;
            if (p0_mat(r, args.in[I_CW1V], 2048, 128, (bf16*)(ws + WS_CW1V_T), scr, F.lane)) continue;
            if (p0_mat(r, args.in[I_CW2K], 128, 64, (bf16*)(ws + WS_CW2K_T), scr, F.lane)) continue;
            p0_mat(r, args.in[I_CW2V], 128, 64, (bf16*)(ws + WS_CW2V_T), scr, F.lane);
        }
    }
    {
        const float* pw = args.in[I_POOLW]; const float* ps = args.in[I_POOLS]; const float* wbp = args.in[I_WBP];
        bf16* weff = (bf16*)(ws + WS_WEFF_T);
        for (size_t idx = gtid; idx < (size_t)D * POOLW; idx += gthreads) {
            const int d = (int)(idx >> 9), r = (int)(idx & 511), g = r >> 7;
            const float* pr = pw + (size_t)r * 128; float s = 0.f;
            for (int cc = 0; cc < 128; ++cc) s += pr[cc] * ps[g * 128 + cc] * wbp[(size_t)(g * 128 + cc) * D + d];
            weff[idx] = (bf16)f2bf(s); }
    }
    cvt_f32_bf16_stream(args.in[I_PSK], (bf16*)(ws + WS_SUBK), (size_t)16 * 128 * 128 / 8, gtid, gthreads);
    cvt_f32_bf16_stream(args.in[I_PU], (bf16*)(ws + WS_UB), (size_t)NEXP * D / 8, gtid, gthreads);
    cvt_f32_bf16_stream(args.in[I_PV], (bf16*)(ws + WS_VB), (size_t)NEXP * D / 8, gtid, gthreads);
}

__device__ __forceinline__ void modnorm_rows(Frame& F, const float* x, const float* g, const float* ada, int shift_idx, bf16* out) {
    const int gw = F.bid * NWAVES + F.wave, NGW = F.G * NWAVES;
    for (int m = gw; m < M; m += NGW) {
        const int b = m >> 12;
        const GAS f32x4* xr = (const GAS f32x4*)(x + (size_t)m * D) + F.lane;
        const GAS f32x4* gr = (const GAS f32x4*)g + F.lane;
        const GAS f32x4* sh = (const GAS f32x4*)(ada + (size_t)b * 6 * D + shift_idx * D) + F.lane;
        const GAS f32x4* sc = (const GAS f32x4*)(ada + (size_t)b * 6 * D + (shift_idx + 1) * D) + F.lane;
        f32x4 v[4]; float s = 0.f;
#pragma unroll
        for (int j = 0; j < 4; ++j) { v[j] = xr[64 * j]; s += (v[j].x * v[j].x + v[j].y * v[j].y) + (v[j].z * v[j].z + v[j].w * v[j].w); }
        const float rstd = rsqrtf(wave_sum(s) * (1.f / D) + EPS);
        GAS v2u* o8 = (GAS v2u*)(out + (size_t)m * D) + F.lane;
#pragma unroll
        for (int j = 0; j < 4; ++j) { const f32x4 gg = gr[64 * j], ss = sh[64 * j], cc = sc[64 * j];
            const f32x4 y = (v[j] * rstd) * gg * (cc + 1.0f) + ss;
            v2u o; o.x = pk2(y.x, y.y); o.y = pk2(y.z, y.w); o8[64 * j] = o; }
    }
}

struct EpiIn {
    static constexpr bool PERM = true, AFTER_DRAIN = false;
    unsigned char* ws; const float* qg; const float* kg;
    __device__ __forceinline__ void operator()(const pg8::f32x4 (&acc)[2][2][4][2], const pg8::Unit& u, int wr, int wc, int fr, int fq) const {
        const int pn = u.pn;
#pragma unroll
        for (int ai = 0; ai < 2; ++ai)
#pragma unroll
            for (int m = 0; m < 4; ++m) {
                const int row = u.pm * 256 + ai * 128 + wr * 64 + m * 16 + fr;
                float v[2][8];
#pragma unroll
                for (int bj = 0; bj < 2; ++bj)
#pragma unroll
                    for (int n = 0; n < 2; ++n)
#pragma unroll
                        for (int i = 0; i < 4; ++i) v[bj][4 * n + i] = acc[ai][bj][m][n][i];
                bf16* dst = nullptr; bool norm = false; const float* gain = nullptr; float mul = 1.f; bool sig = false;
                if (pn < 2) { dst = (bf16*)(ws + WS_ZP) + (size_t)row * 512 + 256 * pn + 64 * wc; }
                else if (pn < 4) { dst = (bf16*)(ws + WS_Q) + (size_t)row * 512 + 256 * (pn - 2) + 64 * wc; norm = true; gain = qg; mul = 0.125f; }
                else if (pn < 7) { const int kind = pn - 4, isv = wc >> 1, g = wc & 1, b = row >> 12, t = row & 4095;
                    const size_t base = ((size_t)(b * 2 + g) * SEQ + t) * 64;
                    const size_t off = kind == 0 ? (isv ? WS_VCR : WS_KCR) : kind == 1 ? (isv ? WS_VS : WS_KS) : (isv ? WS_VW : WS_KW);
                    dst = (bf16*)(ws + off) + base; if (!isv && kind > 0) { norm = true; gain = kg + kind * 64; } }
                else if (pn < 15) { dst = (bf16*)(ws + WS_GM) + (size_t)row * 2048 + 256 * (pn - 7) + 64 * wc; sig = true; }
                else {
                    if (wc == 0 && fq < 3) { float* gp = (float*)(ws + WS_GATE) + (size_t)row * 24 + 8 * fq;
                        *(GAS f32x4*)gp = (f32x4){sigmoidf_(v[0][0]), sigmoidf_(v[0][1]), sigmoidf_(v[0][2]), sigmoidf_(v[0][3])};
                        *(GAS f32x4*)(gp + 4) = (f32x4){sigmoidf_(v[0][4]), sigmoidf_(v[0][5]), sigmoidf_(v[0][6]), sigmoidf_(v[0][7])}; }
                    continue; }
                if (norm) { float ss = 0.f;
#pragma unroll
                    for (int bj = 0; bj < 2; ++bj)
#pragma unroll
                        for (int e = 0; e < 8; ++e) ss += v[bj][e] * v[bj][e];
                    ss += __shfl_xor(ss, 16); ss += __shfl_xor(ss, 32);
                    const float rs = rsqrtf(ss * (1.f / 64.f) + EPS) * mul;
#pragma unroll
                    for (int bj = 0; bj < 2; ++bj)
#pragma unroll
                        for (int e = 0; e < 8; ++e) v[bj][e] = v[bj][e] * rs * gain[32 * bj + 8 * fq + e]; }
                if (sig) {
#pragma unroll
                    for (int bj = 0; bj < 2; ++bj)
#pragma unroll
                        for (int e = 0; e < 8; ++e) v[bj][e] = sigmoidf_(v[bj][e]); }
#pragma unroll
                for (int bj = 0; bj < 2; ++bj) { v4u o; o.x = pk2(v[bj][0], v[bj][1]); o.y = pk2(v[bj][2], v[bj][3]); o.z = pk2(v[bj][4], v[bj][5]); o.w = pk2(v[bj][6], v[bj][7]);
                    *(GAS v4u*)(dst + 32 * bj + 8 * fq) = o; }
            }
    }
};
template <bool ADD> struct EpiMix {
    static constexpr bool PERM = true, AFTER_DRAIN = false;
    bf16* MIX; const bf16* GM; int gmoff;
    __device__ __forceinline__ void operator()(const pg8::f32x4 (&acc)[2][2][4][2], const pg8::Unit& u, int wr, int wc, int fr, int fq) const {
#pragma unroll
        for (int ai = 0; ai < 2; ++ai)
#pragma unroll
            for (int m = 0; m < 4; ++m) {
                const int row = u.pm * 256 + ai * 128 + wr * 64 + m * 16 + fr;
#pragma unroll
                for (int bj = 0; bj < 2; ++bj) {
                    const int col = u.pn * 256 + bj * 128 + wc * 32 + 8 * fq;
                    const v4u gmv = *(const GAS v4u*)(GM + (size_t)row * 2048 + gmoff + col);
                    float r[8];
                    r[0] = acc[ai][bj][m][0][0] * bflo(gmv.x); r[1] = acc[ai][bj][m][0][1] * bfhi(gmv.x); r[2] = acc[ai][bj][m][0][2] * bflo(gmv.y); r[3] = acc[ai][bj][m][0][3] * bfhi(gmv.y);
                    r[4] = acc[ai][bj][m][1][0] * bflo(gmv.z); r[5] = acc[ai][bj][m][1][1] * bfhi(gmv.z); r[6] = acc[ai][bj][m][1][2] * bflo(gmv.w); r[7] = acc[ai][bj][m][1][3] * bfhi(gmv.w);
                    GAS v4u* dp = (GAS v4u*)(MIX + (size_t)row * 1024 + col);
                    if (ADD) { const v4u old = *dp; r[0] += bflo(old.x); r[1] += bfhi(old.x); r[2] += bflo(old.y); r[3] += bfhi(old.y); r[4] += bflo(old.z); r[5] += bfhi(old.z); r[6] += bflo(old.w); r[7] += bfhi(old.w); }
                    v4u o; o.x = pk2(r[0], r[1]); o.y = pk2(r[2], r[3]); o.z = pk2(r[4], r[5]); o.w = pk2(r[6], r[7]); *dp = o; }
            }
    }
};
struct EpiRes {
    static constexpr bool PERM = false, AFTER_DRAIN = false;
    const float* x; float* out; const float* ada; int gate_idx;
    __device__ __forceinline__ void operator()(const pg8::f32x4 (&acc)[2][2][4][2], const pg8::Unit& u, int wr, int wc, int fr, int fq) const {
#pragma unroll
        for (int ai = 0; ai < 2; ++ai)
#pragma unroll
            for (int m = 0; m < 4; ++m) {
                const int row = u.pm * 256 + ai * 128 + wr * 64 + m * 16 + fr, b = row >> 12;
#pragma unroll
                for (int bj = 0; bj < 2; ++bj)
#pragma unroll
                    for (int n = 0; n < 2; ++n) {
                        const int col = u.pn * 256 + bj * 128 + wc * 32 + 16 * n + 4 * fq;
                        const f32x4 gt = *(const GAS f32x4*)(ada + (size_t)b * 6 * D + gate_idx * D + col);
                        const f32x4 xv = *(const GAS f32x4*)(x + (size_t)row * D + col);
                        *(GAS f32x4*)(out + (size_t)row * D + col) = xv + gt * acc[ai][bj][m][n]; }
            }
    }
};

__device__ __forceinline__ void pool_phase(Frame& F) {
    const bf16* zp = (const bf16*)(F.ws + WS_ZP); bf16* pl = (bf16*)(F.ws + WS_PL);
    const size_t gtid = (size_t)F.bid * NTHREADS + F.tid, gthreads = (size_t)F.G * NTHREADS;
    for (size_t idx = gtid; idx < (size_t)M * 64; idx += gthreads) {
        const int row = (int)(idx >> 6), c8 = (int)(idx & 63), t = row & 4095, w = 2 << (c8 >> 4), cnt = (t + 1 < w) ? (t + 1) : w;
        float s[8];
#pragma unroll
        for (int e = 0; e < 8; ++e) s[e] = 0.f;
        float self[8];
        for (int j = 0; j < cnt; ++j) { const v4u z = *(const GAS v4u*)(zp + (size_t)(row - j) * 512 + 8 * c8);
            const float f[8] = {bflo(z.x), bfhi(z.x), bflo(z.y), bfhi(z.y), bflo(z.z), bfhi(z.z), bflo(z.w), bfhi(z.w)};
#pragma unroll
            for (int e = 0; e < 8; ++e) { s[e] += f[e]; if (j == 0) self[e] = f[e]; } }
        const float inv = 1.0f / (float)cnt;
        v4u o; o.x = pk2(s[0] * inv - self[0], s[1] * inv - self[1]); o.y = pk2(s[2] * inv - self[2], s[3] * inv - self[3]);
        o.z = pk2(s[4] * inv - self[4], s[5] * inv - self[5]); o.w = pk2(s[6] * inv - self[6], s[7] * inv - self[7]);
        *(GAS v4u*)(pl + (size_t)row * 512 + 8 * c8) = o; }
}

typedef int v4i __attribute__((ext_vector_type(4)));
struct EpiStoreBf16 {
    static constexpr bool PERM = true, AFTER_DRAIN = false;
    bf16* O; int ldc;
    __device__ __forceinline__ void operator()(const pg8::f32x4 (&acc)[2][2][4][2], const pg8::Unit& u, int wr, int wc, int fr, int fq) const {
#pragma unroll
        for (int ai = 0; ai < 2; ++ai)
#pragma unroll
            for (int m = 0; m < 4; ++m) {
                const int row = u.pm * 256 + ai * 128 + wr * 64 + m * 16 + fr;
#pragma unroll
                for (int bj = 0; bj < 2; ++bj) {
                    const int col = u.pn * 256 + bj * 128 + wc * 32 + 8 * fq;
                    v4u o; o.x = pk2(acc[ai][bj][m][0][0], acc[ai][bj][m][0][1]); o.y = pk2(acc[ai][bj][m][0][2], acc[ai][bj][m][0][3]);
                    o.z = pk2(acc[ai][bj][m][1][0], acc[ai][bj][m][1][1]); o.w = pk2(acc[ai][bj][m][1][2], acc[ai][bj][m][1][3]);
                    *(GAS v4u*)(O + (size_t)row * ldc + col) = o; }
            }
    }
};

__device__ __forceinline__ unsigned fkey(float f) { const unsigned u = __builtin_bit_cast(unsigned, f); return (u >> 31) ? ~u : (u | 0x80000000u); }
__device__ __forceinline__ float funkey(unsigned k) { const unsigned u = (k >> 31) ? (k & 0x7fffffffu) : ~k; return __builtin_bit_cast(float, u); }
#define TOP16_INSERT(L, xin) do { unsigned _x = (xin); _Pragma("unroll") for (int _i = 0; _i < 16; ++_i) { const unsigned _h = L[_i] > _x ? L[_i] : _x; _x = L[_i] > _x ? _x : L[_i]; L[_i] = _h; } } while (0)
constexpr int SST = 129;
constexpr int P9_S_BYTES = 2 * 64 * SST * 4;
constexpr int P9_LIST_OFF = 66560;
__device__ __forceinline__ void peer_select_phase(Frame& F) {
    const bf16* QV = (const bf16*)(F.ws + WS_QV); const bf16* SK = (const bf16*)(F.ws + WS_SUBK);
    int* EID = (int*)(F.ws + WS_EID); float* GW = (float*)(F.ws + WS_GW);
    LAS float* S = (LAS float*)(F.lds);
    LAS unsigned* LIST = (LAS unsigned*)(F.lds + P9_LIST_OFF);
    const int lane = F.lane, w = F.wave, l15 = lane & 15, lq = lane >> 4;
    for (int u = F.bid; u < (M / 64) * PH; u += F.G) {
        const int tt = u >> 3, h = u & 7, tok0 = tt * 64;
        {
            const int p = w >> 2, kb = w & 3;
            pg8::f32x4 acc[4][2];
#pragma unroll
            for (int rb = 0; rb < 4; ++rb)
#pragma unroll
                for (int cb = 0; cb < 2; ++cb) acc[rb][cb] = (pg8::f32x4){0.f, 0.f, 0.f, 0.f};
            const bf16* qa = QV + (size_t)(tok0 + l15) * PQW + h * 256 + p * 128 + 8 * lq;
            const bf16* kbp = SK + (size_t)((h * 2 + p) * 128 + 32 * kb + l15) * 128 + 8 * lq;
#pragma unroll
            for (int ks = 0; ks < 4; ++ks) {
                bf16x8 a[4], b[2];
#pragma unroll
                for (int rb = 0; rb < 4; ++rb) a[rb] = *(const GAS bf16x8*)(qa + (size_t)(16 * rb) * PQW + 32 * ks);
#pragma unroll
                for (int cb = 0; cb < 2; ++cb) b[cb] = *(const GAS bf16x8*)(kbp + (size_t)(16 * cb) * 128 + 32 * ks);
#pragma unroll
                for (int rb = 0; rb < 4; ++rb)
#pragma unroll
                    for (int cb = 0; cb < 2; ++cb) acc[rb][cb] = __builtin_amdgcn_mfma_f32_16x16x32_bf16(a[rb], b[cb], acc[rb][cb], 0, 0, 0);
            }
#pragma unroll
            for (int rb = 0; rb < 4; ++rb)
#pragma unroll
                for (int cb = 0; cb < 2; ++cb)
#pragma unroll
                    for (int r = 0; r < 4; ++r) S[(p * 64 + 16 * rb + 4 * lq + r) * SST + 32 * kb + 16 * cb + l15] = acc[rb][cb][r];
        }
        __syncthreads();
        if (F.tid < 128) {
            const LAS float* sr = S + F.tid * SST;
            unsigned L[16];
#pragma unroll
            for (int i = 0; i < 16; ++i) L[i] = 0u;
#pragma unroll 4
            for (int k = 0; k < 128; ++k) { const unsigned key = (fkey(sr[k]) & ~127u) | (unsigned)k; TOP16_INSERT(L, key); }
#pragma unroll
            for (int i = 0; i < 16; ++i) LIST[F.tid * 16 + i] = L[i];
        }
        __syncthreads();
        if (F.tid < 64) {
            const int tok = F.tid;
            float va[16], vb[16];
#pragma unroll
            for (int i = 0; i < 16; ++i) { va[i] = funkey(LIST[tok * 16 + i] & ~127u); vb[i] = funkey(LIST[(64 + tok) * 16 + i] & ~127u); }
            unsigned L[16];
#pragma unroll
            for (int i = 0; i < 16; ++i) L[i] = 0u;
#pragma unroll
            for (int i = 0; i < 16; ++i)
#pragma unroll
                for (int j = 0; j < 16; ++j)
                    if ((i + 1) * (j + 1) <= 16) { const unsigned key = (fkey(va[i] + vb[j]) & ~255u) | (unsigned)(i * 16 + j); TOP16_INSERT(L, key); }
            const float mx = funkey(L[0] & ~255u);
            float e[16], sum = 0.f;
#pragma unroll
            for (int k = 0; k < 16; ++k) { e[k] = __expf(funkey(L[k] & ~255u) - mx); sum += e[k]; }
            const float inv = 1.0f / sum;
            const size_t ob = ((size_t)(tok0 + tok) * PH + h) * 16;
#pragma unroll
            for (int k4 = 0; k4 < 4; ++k4) {
                int id[4];
#pragma unroll
                for (int q = 0; q < 4; ++q) { const unsigned cid = L[4 * k4 + q] & 255u;
                    const unsigned ia = LIST[tok * 16 + (cid >> 4)] & 127u, ib = LIST[(64 + tok) * 16 + (cid & 15u)] & 127u; id[q] = (int)(ia * 128u + ib); }
                *(GAS v4i*)(EID + ob + 4 * k4) = (v4i){id[0], id[1], id[2], id[3]};
                *(GAS f32x4*)(GW + ob + 4 * k4) = (f32x4){e[4 * k4] * inv, e[4 * k4 + 1] * inv, e[4 * k4 + 2] * inv, e[4 * k4 + 3] * inv};
            }
        }
        __syncthreads();
    }
}

__device__ __forceinline__ void unpack8(const v4u w, float (&f)[8]) { f[0] = bflo(w.x); f[1] = bfhi(w.x); f[2] = bflo(w.y); f[3] = bfhi(w.y); f[4] = bflo(w.z); f[5] = bfhi(w.z); f[6] = bflo(w.w); f[7] = bfhi(w.w); }
__device__ __forceinline__ void peer_gather_phase(Frame& F, const float* ada, float* out) {
    const bf16* H = (const bf16*)(F.ws + WS_H); const bf16* UB = (const bf16*)(F.ws + WS_UB); const bf16* VB = (const bf16*)(F.ws + WS_VB);
    const int* EID = (const int*)(F.ws + WS_EID); const float* GW = (const float*)(F.ws + WS_GW);
    const int gw = F.bid * NWAVES + F.wave, NGW = F.G * NWAVES, lane = F.lane;
    for (int row = gw; row < M; row += NGW) {
        const int b = row >> 12;
        float hx[16];
        { const v4u h0 = *(const GAS v4u*)(H + (size_t)row * D + 8 * lane), h1 = *(const GAS v4u*)(H + (size_t)row * D + 512 + 8 * lane);
          float t0[8], t1[8]; unpack8(h0, t0); unpack8(h1, t1);
#pragma unroll
          for (int i = 0; i < 8; ++i) { hx[i] = t0[i]; hx[8 + i] = t1[i]; } }
        const int e_lo = EID[(size_t)row * 128 + lane], e_hi = EID[(size_t)row * 128 + 64 + lane];
        const float g_lo = GW[(size_t)row * 128 + lane], g_hi = GW[(size_t)row * 128 + 64 + lane];
        float o[16];
#pragma unroll
        for (int i = 0; i < 16; ++i) o[i] = 0.f;
        for (int e0 = 0; e0 < 128; e0 += 4) {
            int eid[4]; float gg[4]; v4u u0[4], u1[4], w0[4], w1[4];
#pragma unroll
            for (int q = 0; q < 4; ++q) { const int e = e0 + q;
                eid[q] = __shfl(e < 64 ? e_lo : e_hi, e & 63); gg[q] = __shfl(e < 64 ? g_lo : g_hi, e & 63);
                const bf16* up = UB + (size_t)eid[q] * D + 8 * lane; const bf16* vp = VB + (size_t)eid[q] * D + 8 * lane;
                u0[q] = *(const GAS v4u*)up; u1[q] = *(const GAS v4u*)(up + 512); w0[q] = *(const GAS v4u*)vp; w1[q] = *(const GAS v4u*)(vp + 512); }
#pragma unroll
            for (int q = 0; q < 4; ++q) {
                float f0[8], f1[8]; unpack8(u0[q], f0); unpack8(u1[q], f1);
                float s = 0.f;
#pragma unroll
                for (int i = 0; i < 8; ++i) s += hx[i] * f0[i] + hx[8 + i] * f1[i];
                s = wave_sum(s);
                const float cf = gg[q] * gelu_tanh_safe(s);
                unpack8(w0[q], f0); unpack8(w1[q], f1);
#pragma unroll
                for (int i = 0; i < 8; ++i) { o[i] += cf * f0[i]; o[8 + i] += cf * f1[i]; }
            }
        }
        const float* gt = ada + (size_t)b * 6 * D + 5 * D;
        float* xo = out + (size_t)row * D;
#pragma unroll
        for (int hh = 0; hh < 2; ++hh)
#pragma unroll
            for (int q = 0; q < 2; ++q) { const int col = 512 * hh + 8 * lane + 4 * q;
                const f32x4 xv = *(const GAS f32x4*)(xo + col), gv = *(const GAS f32x4*)(gt + col);
                *(GAS f32x4*)(xo + col) = xv + gv * (f32x4){o[8 * hh + 4 * q], o[8 * hh + 4 * q + 1], o[8 * hh + 4 * q + 2], o[8 * hh + 4 * q + 3]}; }
    }
}

__device__ __forceinline__ void compress_phase(Frame& F, const float* kng) {
    LAS bf16* H2 = (LAS bf16*)(F.lds);
    LAS float* OUTS = (LAS float*)(F.lds + 16384);
    const int lane = F.lane, w = F.wave, l15 = lane & 15, lq = lane >> 4;
    for (int u = F.bid; u < NBG * 2 * 8; u += F.G) {
        const int ns = u & 7, kv = (u >> 3) & 1, bg = u >> 4, n0 = ns * 32;
        const bf16* A = (const bf16*)(F.ws + (kv ? WS_VCR : WS_KCR)) + (size_t)bg * SEQ * 64;
        const bf16* W1T = (const bf16*)(F.ws + (kv ? WS_CW1V_T : WS_CW1K_T));
        const bf16* W2T = (const bf16*)(F.ws + (kv ? WS_CW2V_T : WS_CW2K_T));
        const float* b1 = (const float*)(F.ws + (kv ? WS_CB1V : WS_CB1K));
        pg8::f32x4 acc[2];
        acc[0] = (pg8::f32x4){0.f, 0.f, 0.f, 0.f}; acc[1] = acc[0];
        const bf16* ap = A + (size_t)(n0 + l15) * 1024 + 8 * lq;
        const bf16* bp = W1T + (size_t)(16 * w + l15) * 2048 + 8 * lq;
#pragma unroll 4
        for (int ks = 0; ks < 64; ++ks) {
            const bf16x8 a0 = *(const GAS bf16x8*)(ap + 32 * ks), a1 = *(const GAS bf16x8*)(ap + 16 * 1024 + 32 * ks), b = *(const GAS bf16x8*)(bp + 32 * ks);
            acc[0] = __builtin_amdgcn_mfma_f32_16x16x32_bf16(a0, b, acc[0], 0, 0, 0);
            acc[1] = __builtin_amdgcn_mfma_f32_16x16x32_bf16(a1, b, acc[1], 0, 0, 0);
        }
        { const float bb = b1[16 * w + l15];
#pragma unroll
          for (int rb = 0; rb < 2; ++rb)
#pragma unroll
            for (int r = 0; r < 4; ++r) H2[(16 * rb + 4 * lq + r) * 136 + 16 * w + l15] = (bf16)f2bf(gelu_tanh_safe(acc[rb][r] + bb)); }
        __syncthreads();
        { const int rb = w >> 2, db = w & 3;
          pg8::f32x4 o = (pg8::f32x4){0.f, 0.f, 0.f, 0.f};
#pragma unroll
          for (int ks = 0; ks < 4; ++ks) {
              const bf16x8 a = *(const LAS bf16x8*)(H2 + (16 * rb + l15) * 136 + 32 * ks + 8 * lq);
              const bf16x8 b = *(const GAS bf16x8*)(W2T + (size_t)(16 * db + l15) * 128 + 32 * ks + 8 * lq);
              o = __builtin_amdgcn_mfma_f32_16x16x32_bf16(a, b, o, 0, 0, 0); }
#pragma unroll
          for (int r = 0; r < 4; ++r) OUTS[(16 * rb + 4 * lq + r) * 65 + 16 * db + l15] = o[r]; }
        __syncthreads();
        { const int n = F.tid >> 4, d4 = (F.tid & 15) * 4, ng = n0 + n;
          float v[4]; float ss = 0.f;
#pragma unroll
          for (int i = 0; i < 4; ++i) { v[i] = OUTS[n * 65 + d4 + i]; ss += v[i] * v[i]; }
          ss += __shfl_xor(ss, 1); ss += __shfl_xor(ss, 2); ss += __shfl_xor(ss, 4); ss += __shfl_xor(ss, 8);
          const bool pad = (ng >= NCMP);
          if (kv == 0) { const float rs = rsqrtf(ss * (1.f / 64.f) + EPS);
              v2u o; o.x = pad ? 0u : pk2(v[0] * rs * kng[d4], v[1] * rs * kng[d4 + 1]); o.y = pad ? 0u : pk2(v[2] * rs * kng[d4 + 2], v[3] * rs * kng[d4 + 3]);
              *(GAS v2u*)((bf16*)(F.ws + WS_KC) + ((size_t)bg * 256 + ng) * 64 + d4) = o; }
          else { bf16* vt = (bf16*)(F.ws + WS_VCT) + (size_t)bg * 64 * 256 + ng;
#pragma unroll
              for (int i = 0; i < 4; ++i) vt[(size_t)(d4 + i) * 256] = pad ? (bf16)0 : (bf16)f2bf(v[i]); } }
        __syncthreads();
    }
}
__device__ __forceinline__ void vtranspose_phase(Frame& F) {
    LAS bf16* T = (LAS bf16*)(F.lds + F.wave * 9216);
    const int gw = F.bid * NWAVES + F.wave, NGW = F.G * NWAVES, lane = F.lane;
    for (int job = gw; job < 2 * NBG * 64; job += NGW) {
        const int s = job & 63, bg = (job >> 6) & 15, which = job >> 10;
        const bf16* X = (const bf16*)(F.ws + (which ? WS_VW : WS_VS)) + ((size_t)bg * SEQ + 64 * s) * 64;
        bf16* XT = (bf16*)(F.ws + (which ? WS_VWT : WS_VST)) + (size_t)bg * 64 * SEQ + 64 * s;
#pragma unroll
        for (int i = 0; i < 8; ++i) { const int tok = (lane >> 3) + 8 * i, ch = lane & 7;
            const v4u x = *(const GAS v4u*)(X + (size_t)tok * 64 + 8 * ch);
            const unsigned ww[4] = {x.x, x.y, x.z, x.w};
#pragma unroll
            for (int e = 0; e < 4; ++e) { T[(8 * ch + 2 * e) * 72 + tok] = (bf16)(ww[e] & 0xffffu); T[(8 * ch + 2 * e + 1) * 72 + tok] = (bf16)(ww[e] >> 16); } }
        LDS_WAIT(); asm volatile("" ::: "memory");
#pragma unroll
        for (int i = 0; i < 8; ++i) { const int dim = (lane >> 3) + 8 * i, ch = lane & 7;
            const v4u y = *(const LAS v4u*)(T + dim * 72 + 8 * ch);
            *(GAS v4u*)(XT + (size_t)dim * SEQ + 8 * ch) = y; }
        LDS_WAIT(); asm volatile("" ::: "memory");
    }
}

constexpr int AT_KSTR = 72;
constexpr int AT_KBUF = 64 * AT_KSTR * 2;
constexpr int AT_OFF_K = 0, AT_OFF_V = 2 * AT_KBUF, AT_OFF_P = 4 * AT_KBUF;
constexpr int AT_OFF_IMP1 = AT_OFF_P + 8 * 4608, AT_OFF_IMP2 = AT_OFF_IMP1 + 64 * 65 * 4, AT_OFF_SEL = AT_OFF_IMP2 + 64 * 65 * 4;
constexpr int AT_OFF_LUT = AT_OFF_SEL + 4096, AT_OFF_LROW = AT_OFF_LUT + 4 * 128 * 4;
constexpr int AT_LDS_END = AT_OFF_LROW + 8 * 32 * 4;
static_assert(AT_LDS_END <= RING_BYTES, "attention LDS");

struct AtTile { const bf16* k; const bf16* vt; int vstride; };
__device__ __forceinline__ void attention_phase(Frame& F, const Args& args) {
    unsigned char* ws = F.ws;
    const int lane = F.lane, w = F.wave, l15 = lane & 15, lq = lane >> 4, tid = F.tid;
    LAS unsigned char* L = F.lds;
    LAS float* IMP1 = (LAS float*)(L + AT_OFF_IMP1); LAS float* IMP2 = (LAS float*)(L + AT_OFF_IMP2);
    LAS unsigned char* SEL = L + AT_OFF_SEL; LAS float* LUT = (LAS float*)(L + AT_OFF_LUT); LAS float* LROW = (LAS float*)(L + AT_OFF_LROW) + w * 32;
    LAS bf16* PW = (LAS bf16*)(L + AT_OFF_P + w * 4608);
    float M0;
    { float mq = 0.f, mk = 0.f, mb = 0.f;
      for (int i = 0; i < 64; ++i) mq = fmaxf(mq, fabsf(args.in[I_QNG][i]));
      for (int i = 0; i < 192; ++i) mk = fmaxf(mk, fabsf(args.in[I_KNG][i]));
      for (int i = 0; i < 256; ++i) mb = fmaxf(mb, fabsf(args.in[I_RELB][i]));
      M0 = 8.0f * mq * mk + mb; }
    const bf16* Qg = (const bf16*)(ws + WS_Q); const float* GATE = (const float*)(ws + WS_GATE); bf16* YA = (bf16*)(ws + WS_YA); float* YAF = (float*)(ws + WS_H);
    const int nrounds = (F.G == 256) ? 4 : (1024 + F.G - 1) / F.G;
    for (int round = 0; round < nrounds; ++round) {
        const int ui = (F.G == 256) ? ((round & 1) ? ((round >> 1) * 512 + 511 - F.bid) : ((round >> 1) * 512 + F.bid)) : (round * F.G + F.bid);
        if (ui >= 1024) break;
        {
        const int c = 63 - (ui >> 4), bg = ui & 15, b = bg >> 1, g = bg & 1;
        const int m0 = b * SEQ + 64 * c;
        __syncthreads();
        for (int i = tid; i < 512; i += NTHREADS) LUT[i] = ((const float*)(ws + WS_BIASL))[(4 * g + (i >> 7)) * 128 + (i & 127)] - M0;
        for (int i = tid; i < 64 * 65; i += NTHREADS) { IMP1[i] = 0.f; IMP2[i] = 0.f; }
        bf16x8 qf[2][2];
#pragma unroll
        for (int rb = 0; rb < 2; ++rb)
#pragma unroll
            for (int ks = 0; ks < 2; ++ks) qf[rb][ks] = *(const GAS bf16x8*)(Qg + (size_t)(m0 + 8 * w + 4 * rb + (l15 >> 2)) * 512 + g * 256 + (l15 & 3) * 64 + 32 * ks + 8 * lq);
        const int jq = l15 & 3;
        const int ncmp = 4 * c + 3, n1 = (ncmp + 63) >> 6, nsel = c + 1, w0 = c >= 8 ? c - 8 : 0, nwin = c - w0 + 1;
        const int ntiles = 2 * n1 + nsel + nwin;
        const bf16* KC = (const bf16*)(ws + WS_KC) + (size_t)bg * 256 * 64; const bf16* VCT = (const bf16*)(ws + WS_VCT) + (size_t)bg * 64 * 256;
        const bf16* KS = (const bf16*)(ws + WS_KS) + (size_t)bg * SEQ * 64; const bf16* VST = (const bf16*)(ws + WS_VST) + (size_t)bg * 64 * SEQ;
        const bf16* KW = (const bf16*)(ws + WS_KW) + (size_t)bg * SEQ * 64; const bf16* VWT = (const bf16*)(ws + WS_VWT) + (size_t)bg * 64 * SEQ;
#define AT_TILE(i, kind, idx, T) do { int _i = (i); if (_i < n1) { kind = 0; idx = _i; T.k = KC + (size_t)idx * 4096; T.vt = VCT + 64 * idx; T.vstride = 256; } \
        else if (_i < 2 * n1) { kind = 1; idx = _i - n1; T.k = KC + (size_t)idx * 4096; T.vt = VCT + 64 * idx; T.vstride = 256; } \
        else if (_i < 2 * n1 + nsel) { kind = 2; idx = _i - 2 * n1; T.k = KS + (size_t)idx * 4096; T.vt = VST + 64 * idx; T.vstride = SEQ; } \
        else { kind = 3; idx = w0 + (_i - 2 * n1 - nsel); T.k = KW + (size_t)idx * 4096; T.vt = VWT + 64 * idx; T.vstride = SEQ; } } while (0)
        const int srow = tid >> 3, sch = tid & 7;
        v4u kreg, vreg;
        { int kind, idx; AtTile T; AT_TILE(0, kind, idx, T); (void)kind;
          kreg = *(const GAS v4u*)(T.k + srow * 64 + 8 * sch); vreg = *(const GAS v4u*)(T.vt + (size_t)srow * T.vstride + 8 * sch);
          *(LAS v4u*)(L + AT_OFF_K + srow * 144 + 16 * sch) = kreg; *(LAS v4u*)(L + AT_OFF_V + srow * 144 + 16 * sch) = vreg; }
        __syncthreads();
        float lpart[2] = {0.f, 0.f};
        float linv[2];
        pg8::f32x4 oacc[2][4];
        float lsum[2];
#pragma unroll
        for (int rb = 0; rb < 2; ++rb) { lsum[rb] = 0.f; linv[rb] = 0.f;
#pragma unroll
            for (int db = 0; db < 4; ++db) oacc[rb][db] = (pg8::f32x4){0.f, 0.f, 0.f, 0.f}; }
        const int tok_r[2] = {8 * w + (l15 >> 2), 8 * w + 4 + (l15 >> 2)};
        for (int it = 0; it < ntiles; ++it) {
            int kind, idx; AtTile T; AT_TILE(it, kind, idx, T);
            const int buf = it & 1;
            if (it + 1 < ntiles) { int k2, i2; AtTile T2; AT_TILE(it + 1, k2, i2, T2); (void)k2; (void)i2;
                kreg = *(const GAS v4u*)(T2.k + srow * 64 + 8 * sch); vreg = *(const GAS v4u*)(T2.vt + (size_t)srow * T2.vstride + 8 * sch); }
            if (kind == 2 && idx == 0) {
                { const int tok = tid >> 3, s0 = (tid & 7) * 8;
                  float my[8]; int rank[8];
#pragma unroll
                  for (int q = 0; q < 8; ++q) { const int s = s0 + q;
                      const bool vis = s <= c, forced = (s == 0) || (s == c) || (s == c - 1);
                      my[q] = vis ? (IMP1[tok * 65 + s] + IMP2[tok * 65 + s] + (forced ? 1000.f : 0.f)) : -1.f; rank[q] = 0; }
#pragma unroll
                  for (int q = 0; q < 8; ++q) IMP1[tok * 65 + s0 + q] = my[q];
                  __syncthreads();
#pragma unroll 2
                  for (int s2 = 0; s2 < 64; ++s2) { const float sc2 = IMP1[tok * 65 + s2];
#pragma unroll
                      for (int q = 0; q < 8; ++q) rank[q] += (sc2 > my[q] || (sc2 == my[q] && s2 < s0 + q)) ? 1 : 0; }
#pragma unroll
                  for (int q = 0; q < 8; ++q) SEL[tok * 64 + s0 + q] = (unsigned char)((rank[q] < 16 && (s0 + q) <= c) ? 1 : 0); }
                __syncthreads();
            }
            const LAS unsigned char* kb_ = L + AT_OFF_K + buf * AT_KBUF;
            unsigned selb[2] = {1u, 1u};
            if (kind == 2) { selb[0] = SEL[tok_r[0] * 64 + idx]; selb[1] = SEL[tok_r[1] * 64 + idx]; }
#pragma unroll
            for (int cb = 0; cb < 4; ++cb) {
                pg8::f32x4 st[2];
                st[0] = (pg8::f32x4){0.f, 0.f, 0.f, 0.f}; st[1] = st[0];
#pragma unroll
                for (int ks = 0; ks < 2; ++ks) { const bf16x8 kf = *(const LAS bf16x8*)(kb_ + (16 * cb + l15) * 144 + 64 * ks + 16 * lq);
#pragma unroll
                    for (int rb = 0; rb < 2; ++rb) st[rb] = __builtin_amdgcn_mfma_f32_16x16x32_bf16(kf, qf[rb][ks], st[rb], 0, 0, 0); }
#pragma unroll
                for (int rb = 0; rb < 2; ++rb) {
                    const int tokc = tok_r[rb];
                    float p[4];
#pragma unroll
                    for (int r = 0; r < 4; ++r) {
                        const int kl = 16 * cb + 4 * lq + r;
                        int rel; bool valid;
                        if (kind < 2) { rel = 64 * c + tokc - 16 * (64 * idx + kl) - 31; valid = rel >= 0; }
                        else { rel = 64 * (c - idx) + tokc - kl; valid = rel >= 0;
                               if (kind == 2) valid = valid && (selb[rb] != 0u); else valid = valid && (rel < 512); }
                        const int ri = rel < 0 ? 0 : (rel > 127 ? 127 : rel);
                        const float e = __expf(st[rb][r] + LUT[jq * 128 + ri]);
                        p[r] = valid ? e : 0.f; }
                    if (kind == 0) { lpart[rb] = (idx == 0 && cb == 0 ? 0.f : lpart[rb]) + ((p[0] + p[1]) + (p[2] + p[3])); }
                    else {
                        if (kind == 1) {
#pragma unroll
                            for (int r = 0; r < 4; ++r) p[r] *= linv[rb];
                            float h0 = p[0], h1 = p[1], h2 = p[2], h3 = p[3];
                            h0 += __shfl_xor(h0, 1); h1 += __shfl_xor(h1, 1); h2 += __shfl_xor(h2, 1); h3 += __shfl_xor(h3, 1);
                            h0 += __shfl_xor(h0, 2); h1 += __shfl_xor(h1, 2); h2 += __shfl_xor(h2, 2); h3 += __shfl_xor(h3, 2);
                            if (jq == 0) { const int sp = 16 * idx + 4 * cb + lq;
                                IMP1[tokc * 65 + sp] = (h0 + h1) + (h2 + 0.5f * h3);
                                if (sp + 1 < 64) IMP2[tokc * 65 + sp + 1] = 0.5f * h3; }
                        } else lsum[rb] += (p[0] + p[1]) + (p[2] + p[3]);
                        v2u pk; pk.x = pk2(p[0], p[1]); pk.y = pk2(p[2], p[3]);
                        *(LAS v2u*)(PW + (16 * rb + l15) * AT_KSTR + 16 * cb + 4 * lq) = pk; }
                }
            }
            if (kind == 0) {
                if (idx == n1 - 1) {
#pragma unroll
                    for (int rb = 0; rb < 2; ++rb) { float s = lpart[rb]; s += __shfl_xor(s, 16); s += __shfl_xor(s, 32); linv[rb] = s > 0.f ? 1.0f / s : 0.f; }
                }
            } else {
                LDS_WAIT();
                const LAS unsigned char* vb_ = L + AT_OFF_V + buf * AT_KBUF;
#pragma unroll
                for (int ks = 0; ks < 2; ++ks) {
                    bf16x8 pf[2];
#pragma unroll
                    for (int rb = 0; rb < 2; ++rb) pf[rb] = *(const LAS bf16x8*)(PW + (16 * rb + l15) * AT_KSTR + 32 * ks + 8 * lq);
#pragma unroll
                    for (int db = 0; db < 4; ++db) { const bf16x8 vf = *(const LAS bf16x8*)(vb_ + (16 * db + l15) * 144 + 64 * ks + 16 * lq);
#pragma unroll
                        for (int rb = 0; rb < 2; ++rb) oacc[rb][db] = __builtin_amdgcn_mfma_f32_16x16x32_bf16(pf[rb], vf, oacc[rb][db], 0, 0, 0); } }
                const bool endb = (kind == 1 && idx == n1 - 1) || (kind == 2 && idx == nsel - 1) || (kind == 3 && idx == c);
                if (endb) {
                    const int br = kind - 1;
                    if (kind == 1) { LROW[l15] = 1.0f; LROW[16 + l15] = 1.0f; }
                    else {
#pragma unroll
                        for (int rb = 0; rb < 2; ++rb) { float s = lsum[rb]; s += __shfl_xor(s, 16); s += __shfl_xor(s, 32); if (lq == 0) LROW[16 * rb + l15] = s > 0.f ? 1.0f / s : 0.f; lsum[rb] = 0.f; } }
                    LDS_WAIT(); asm volatile("" ::: "memory");
                    int trow0 = m0 + 8 * w + lq;
                    asm volatile("" : "+v"(trow0));
                    const float* gp = GATE + (size_t)trow0 * 24 + g * 12 + br;
                    float* yf0 = YAF + (size_t)trow0 * 512 + g * 256 + l15;
                    bf16* ya0 = YA + (size_t)trow0 * 512 + g * 256 + l15;
#pragma unroll
                    for (int rb = 0; rb < 2; ++rb)
#pragma unroll
                        for (int r = 0; r < 4; ++r) { const int qrow = 16 * rb + 4 * lq + r;
                            const float gt = gp[rb * 96 + r * 3] * LROW[qrow];
#pragma unroll
                            for (int db = 0; db < 4; ++db) { float v = gt * oacc[rb][db][r]; oacc[rb][db][r] = 0.f;
                                const int off = rb * 2048 + r * 64 + 16 * db;
                                if (br > 0) v += yf0[off];
                                if (br < 2) yf0[off] = v; else ya0[off] = (bf16)f2bf(v); } }
                }
            }
            if (it + 1 < ntiles) { *(LAS v4u*)(L + AT_OFF_K + (buf ^ 1) * AT_KBUF + srow * 144 + 16 * sch) = kreg; *(LAS v4u*)(L + AT_OFF_V + (buf ^ 1) * AT_KBUF + srow * 144 + 16 * sch) = vreg; }
            __syncthreads();
        }
        }
    }
#undef AT_TILE
}

constexpr int N_PHASES = 11;
#ifndef MK_ONE_LAUNCH
#define MK_ONE_LAUNCH 1
#endif
#ifndef MK_BUILD
#define MK_BUILD 0
#endif

__global__ void __launch_bounds__(NTHREADS, 2) fwd_kernel(Args args) {
    extern __shared__ __attribute__((aligned(16))) unsigned char lds[];
    Frame F;
    F.lds = (LAS unsigned char*)lds;
    F.MISC = (volatile LAS unsigned*)(F.lds + MISC_OFF);
    F.tid = threadIdx.x; F.lane = F.tid & 63; F.wave = __builtin_amdgcn_readfirstlane(F.tid >> 6);
    F.G = gridDim.x; F.bid = blockIdx.x; F.ws = args.ws;
    F.ctl = (gu32*)(args.ws + WS_CTL);
    for (int u = F.tid; u < (LDS_BYTES - LDSCTL_OFF) / 4; u += NTHREADS) ((LAS unsigned*)(F.lds + LDSCTL_OFF))[u] = 0u;
    __syncthreads();
    XcdBarrier bar; bar.bar = (unsigned*)(F.ctl + CW_BAR); bar.x = 0; bar.st = nullptr;
    if (MK_ONE_LAUNCH) bar = xcd_barrier_post((unsigned*)(F.ctl + CW_BAR), F.MISC + 8);
    const int lo = args.ph_lo, hi = args.ph_hi;
#define IN(k) (lo <= (k) && (k) < hi)
#define SEAM(k) do { if (IN(k) && IN((k) + 1)) xcd_barrier(bar); } while (0)
    unsigned char* ws = args.ws;
    const float* ada = (const float*)(ws + WS_ADA);

    if (IN(0)) { p0_prologue(F, args); } SEAM(0);
    if (IN(1)) { modnorm_rows(F, args.in[I_X], args.in[I_N1G], ada, 0, (bf16*)(ws + WS_H)); } SEAM(1);
    if (IN(2)) {
        pg8::Gemm g{(const bf16*)(ws + WS_H), (const bf16*)(ws + WS_WIN_T), M, NIN, D, D, D}; pg8::StaticOrder S; S.init(M, NIN, F.G, F.bid);
        EpiIn E{ws, args.in[I_QNG], args.in[I_KNG]};
        pg8::gemm_phase<EpiIn, pg8::StaticOrder, true, true>(F.lds + RING_OFF, g, S, E);
    } SEAM(2);
    if (IN(3)) { pool_phase(F); __syncthreads(); compress_phase(F, args.in[I_KNG]); __syncthreads(); vtranspose_phase(F); } SEAM(3);
    if (IN(4)) { attention_phase(F, args); } SEAM(4);
    if (IN(5)) {
        { pg8::Gemm g{(const bf16*)(ws + WS_PL), (const bf16*)(ws + WS_WEFF_T), M, D, POOLW, POOLW, POOLW}; pg8::StaticOrder S; S.init(M, D, F.G, F.bid);
          EpiMix<false> E{(bf16*)(ws + WS_MIX), (const bf16*)(ws + WS_GM), 0};
          pg8::gemm_phase<EpiMix<false>, pg8::StaticOrder, true, true>(F.lds + RING_OFF, g, S, E); }
        { pg8::Gemm g{(const bf16*)(ws + WS_YA), (const bf16*)(ws + WS_WBA_T), M, D, QW, QW, QW}; pg8::StaticOrder S; S.init(M, D, F.G, F.bid);
          EpiMix<true> E{(bf16*)(ws + WS_MIX), (const bf16*)(ws + WS_GM), 1024};
          pg8::gemm_phase<EpiMix<true>, pg8::StaticOrder, true, true>(F.lds + RING_OFF, g, S, E); }
    } SEAM(5);
    if (IN(6)) {
        pg8::Gemm g{(const bf16*)(ws + WS_MIX), (const bf16*)(ws + WS_WOUT_T), M, D, D, D, D}; pg8::StaticOrder S; S.init(M, D, F.G, F.bid);
        EpiRes E{args.in[I_X], args.out, ada, 2};
        pg8::gemm_phase<EpiRes, pg8::StaticOrder, true, true>(F.lds + RING_OFF, g, S, E);
    } SEAM(6);
    if (IN(7)) { modnorm_rows(F, args.out, args.in[I_N2G], ada, 3, (bf16*)(ws + WS_H)); } SEAM(7);
    if (IN(8)) {
        pg8::Gemm g{(const bf16*)(ws + WS_H), (const bf16*)(ws + WS_WQ_T), M, PQW, D, D, D}; pg8::StaticOrder S; S.init(M, PQW, F.G, F.bid);
        EpiStoreBf16 E{(bf16*)(ws + WS_QV), PQW};
        pg8::gemm_phase<EpiStoreBf16, pg8::StaticOrder, true, true>(F.lds + RING_OFF, g, S, E);
    } SEAM(8);
    if (IN(9)) { peer_select_phase(F); } SEAM(9);
    if (IN(10)) { peer_gather_phase(F, ada, args.out); }
#undef IN
#undef SEAM
}

extern "C" void kernel_launch(void* const* d_in, const int* in_sizes, int n_in, void* d_out, int out_size, void* d_ws, size_t ws_size, hipStream_t stream) {
    static int grid = 0;
    if (grid == 0) {
        if (n_in != N_IN || in_sizes[0] != M * D || out_size != M * D || ws_size < WS_END) {
            fprintf(stderr, "kernel_launch: unexpected shapes: n_in %d in0 %d out %d ws %zu (need %zu)\n", n_in, n_in > 0 ? in_sizes[0] : -1, out_size, ws_size, (size_t)WS_END); grid = -1; return; }
        int dev = 0, cus = 0, per_cu = 0;
        if (hipGetDevice(&dev) != hipSuccess || hipDeviceGetAttribute(&cus, hipDeviceAttributeMultiprocessorCount, dev) != hipSuccess) { grid = -1; return; }
        if (hipFuncSetAttribute((const void*)fwd_kernel, hipFuncAttributeMaxDynamicSharedMemorySize, LDS_BYTES) != hipSuccess) { fprintf(stderr, "kernel_launch: hipFuncSetAttribute failed\n"); grid = -1; return; }
        if (hipOccupancyMaxActiveBlocksPerMultiprocessor(&per_cu, (const void*)fwd_kernel, NTHREADS, LDS_BYTES) != hipSuccess || per_cu < 1)
            fprintf(stderr, "kernel_launch: occupancy query reports %d workgroups per CU\n", per_cu);
        (void)hipGetLastError();
        grid = cus;
    }
    if (grid < 0) return;
    if (hipMemsetAsync((char*)d_ws + WS_CTL, 0, CTL_ZERO_BYTES, stream) != hipSuccess) return;
    Args a{};
    for (int i = 0; i < N_IN; ++i) a.in[i] = (const float*)d_in[i];
    a.out = (float*)d_out; a.ws = (unsigned char*)d_ws;
    if (MK_ONE_LAUNCH) {
        a.ph_lo = 0; a.ph_hi = N_PHASES; a.li = 0;
        hipLaunchKernelGGL(fwd_kernel, dim3(grid), dim3(NTHREADS), LDS_BYTES, stream, a);
    } else {
        for (int p = 0; p < N_PHASES; ++p) {
            a.ph_lo = p; a.ph_hi = p + 1; a.li = p;
            hipLaunchKernelGGL(fwd_kernel, dim3(grid), dim3(NTHREADS), LDS_BYTES, stream, a);
        }
    }
}
```

```cpp
#include <hip/hip_runtime.h>
#include <cstdio>
#include <cstdint>
namespace pg8 {
#define PG8_LAS __attribute__((address_space(3)))
typedef unsigned short bf16_t;
typedef short bf16x8 __attribute__((ext_vector_type(8)));
typedef float f32x4 __attribute__((ext_vector_type(4)));
typedef unsigned u32x4 __attribute__((ext_vector_type(4)));
constexpr int BM = 256, BK = 64, HALF = 128, HTB = HALF * BK * 2  , STAGE_BYTES = 8 * HTB, NXCD = 8, WGM = 8;

__host__ __device__ __forceinline__ int lds_byte(int r, int c) { const int st = (r >> 4) * 2 + (c >> 5), rr = r & 15, cc = c & 31, ob = rr * 64 + cc * 2; return st * 1024 + (ob ^ (((ob >> 9) & 1) << 5)); }
__host__ __device__ __forceinline__ void stage_rc(int b, int& R, int& C) { const int st = b / 1024, sb = b % 1024, swz = sb ^ (((sb >> 9) & 1) << 5); R = (st >> 1) * 16 + swz / 64; C = (st & 1) * 32 + (swz % 64) / 2; }
__host__ __device__ __forceinline__ int perm32(int rho) { const int n = rho >> 4, i = rho & 15; return 8 * (i >> 2) + 4 * n + (i & 3); }

struct Unit { int pm, pn; };
struct Gemm { const bf16_t* A; const bf16_t* Bt; int M, N, K, lda, ldb; };

struct StaticOrder {
    int nM, nN, nwg, G, c;
    __host__ __device__ void init(int M, int N, int G_, int c_) { nM = M / BM; nN = N / BM; nwg = nM * nN; G = G_; c = c_; }
    __host__ __device__ bool next(int i, Unit& u) const {
        const long L = (long)i * G + c; if (L >= nwg) return false;
        int wgid = (int)L; { const int q = nwg / NXCD, r = nwg % NXCD, xcd = wgid % NXCD, off = wgid / NXCD; wgid = (xcd < r ? xcd * (q + 1) : r * (q + 1) + (xcd - r) * q) + off; }
        const int nig = WGM * nN, gid = wgid / nig, fm = gid * WGM, gsz = (nM - fm) < WGM ? (nM - fm) : WGM;
        u.pm = fm + ((wgid % nig) % gsz); u.pn = (wgid % nig) / gsz; return true;
    }
    __device__ __forceinline__ void a_ready(const Unit&) const {}
    __device__ __forceinline__ void done(const Unit&) const {}
};

__device__ __forceinline__ unsigned cvt_pk_bf16(float lo, float hi) { unsigned r; asm volatile("v_cvt_pk_bf16_f32 %0, %1, %2" : "=v"(r) : "v"(lo), "v"(hi)); return r; }
template <class Epi, class Sched, bool ALIGN_EPI = false, bool SP2 = false>
__device__ __forceinline__ void gemm_phase(PG8_LAS unsigned char* lds, const Gemm g, const Sched& S, const Epi& E) {
    const int tid = threadIdx.x, wid = __builtin_amdgcn_readfirstlane(tid >> 6), lane = tid & 63, wr = wid >> 2, wc = wid & 3, fr = lane & 15, fq = lane >> 4;
    const int K = g.K, nt = K / BK;
    unsigned voffA[2], voffB[2];
#pragma unroll
    for (int i = 0; i < 2; ++i) { int R, C; stage_rc(tid * 16 + i * 8192, R, C); const int Rb = Epi::PERM ? ((R & ~31) + perm32(R & 31)) : R;
        voffA[i] = (unsigned)(R * g.lda + C) * 2u; voffB[i] = (unsigned)(Rb * g.ldb + C) * 2u; }
    const size_t kstep = (size_t)(BK * 2);
    const size_t hstepA = (size_t)HALF * g.lda * 2, hstepB = (size_t)HALF * g.ldb * 2;
    const size_t tstepA = 2 * hstepA, tstepB = 2 * hstepB;
    const unsigned ldsw = (unsigned)wid * 1024u;
    const int aoff = lds_byte(wr * 64 + fr, fq * 8), boff = lds_byte(wc * 32 + fr, fq * 8);
#define PG8_SA(b, h) (((b) * 2 + (h)) * HTB)
#define PG8_SB(b, h) ((4 + (b) * 2 + (h)) * HTB)
#define PG8_STAGE(bufoff, gbase, voff) do { _Pragma("unroll") for (int _i = 0; _i < 2; ++_i) \
        __builtin_amdgcn_global_load_lds((const unsigned*)((const char*)(gbase) + (voff)[_i]), (PG8_LAS unsigned*)(lds + (bufoff) + ldsw + _i * 8192), 16, 0, 0); } while (0)
#define PG8_LDA(dst, b, h) do { _Pragma("unroll") for (int m = 0; m < 4; ++m) _Pragma("unroll") for (int k = 0; k < 2; ++k) dst[m][k] = *(const PG8_LAS bf16x8*)(lds + PG8_SA(b, h) + aoff + m * 2048 + k * 1024); } while (0)
#define PG8_LDB(dst, b, h) do { _Pragma("unroll") for (int n = 0; n < 2; ++n) _Pragma("unroll") for (int k = 0; k < 2; ++k) dst[n][k] = *(const PG8_LAS bf16x8*)(lds + PG8_SB(b, h) + boff + n * 2048 + k * 1024); } while (0)
#define PG8_MMA(ai, bj, At, Bt) do { __builtin_amdgcn_s_setprio(1); _Pragma("unroll") for (int m = 0; m < 4; ++m) _Pragma("unroll") for (int n = 0; n < 2; ++n) _Pragma("unroll") for (int k = 0; k < 2; ++k) \
        acc[ai][bj][m][n] = __builtin_amdgcn_mfma_f32_16x16x32_bf16(Bt[n][k], At[m][k], acc[ai][bj][m][n], 0, 0, 0); __builtin_amdgcn_s_setprio(0); } while (0)
#define PG8_WAIT_V(n) asm volatile("s_waitcnt vmcnt(" #n ")" ::: "memory")
#define PG8_WAIT_L(n) asm volatile("s_waitcnt lgkmcnt(" #n ")" ::: "memory")
#define PG8_BAR __builtin_amdgcn_s_barrier()
#define PG8_SCHED __builtin_amdgcn_sched_barrier(0)
    Unit cur, nxt; int ui = 0;
    if (!S.next(0, cur)) return;
    f32x4 acc[2][2][4][2];
#pragma unroll
    for (int a = 0; a < 2; ++a)
#pragma unroll
        for (int b = 0; b < 2; ++b)
#pragma unroll
            for (int m = 0; m < 4; ++m)
#pragma unroll
                for (int n = 0; n < 2; ++n) acc[a][b][m][n] = (f32x4){0.f, 0.f, 0.f, 0.f};
    bf16x8 At[4][2], B0[2][2], B1[2][2];
    const char* cA = (const char*)g.A + (size_t)cur.pm * tstepA; const char* cB = (const char*)g.Bt + (size_t)cur.pn * tstepB;
    S.a_ready(cur);
    if constexpr (SP2) {
        PG8_STAGE(PG8_SB(0, 0), cB, voffB); PG8_STAGE(PG8_SB(0, 1), cB + hstepB, voffB); PG8_STAGE(PG8_SA(0, 0), cA, voffA); PG8_STAGE(PG8_SA(0, 1), cA + hstepA, voffA);
        if (wr == 1) PG8_BAR;
        PG8_WAIT_V(2); PG8_BAR;
        PG8_STAGE(PG8_SB(1, 0), cB + kstep, voffB); PG8_STAGE(PG8_SA(1, 0), cA + kstep, voffA); PG8_STAGE(PG8_SB(1, 1), cB + hstepB + kstep, voffB);
        PG8_WAIT_V(6); PG8_BAR;
    } else {
        PG8_STAGE(PG8_SB(0, 0), cB, voffB); PG8_STAGE(PG8_SA(0, 0), cA, voffA); PG8_STAGE(PG8_SB(0, 1), cB + hstepB, voffB); PG8_STAGE(PG8_SA(0, 1), cA + hstepA, voffA);
        if (wr == 1) PG8_BAR;
        PG8_WAIT_V(4); PG8_BAR;
        PG8_STAGE(PG8_SB(1, 0), cB + kstep, voffB); PG8_STAGE(PG8_SA(1, 0), cA + kstep, voffA); PG8_STAGE(PG8_SB(1, 1), cB + hstepB + kstep, voffB);
        PG8_WAIT_V(6); PG8_BAR;
    }
    for (;;) {
        const bool has_next = S.next(ui + 1, nxt);
        const char* nA = has_next ? (const char*)g.A + (size_t)nxt.pm * tstepA : cA; const char* nB = has_next ? (const char*)g.Bt + (size_t)nxt.pn * tstepB : cB;
        for (int t = 0; t < nt; t += 2) {
            const bool last = (t == nt - 2);
            const char* a1 = cA + (size_t)(t + 1) * kstep;
            const char* a2 = last ? nA : cA + (size_t)(t + 2) * kstep; const char* b2 = last ? nB : cB + (size_t)(t + 2) * kstep;
            const char* a3 = a2 + kstep; const char* b3 = b2 + kstep;
            if (last && has_next) S.a_ready(nxt);
            if constexpr (SP2) {
            PG8_LDB(B0, 0, 0); PG8_LDB(B1, 0, 1); PG8_SCHED; PG8_LDA(At, 0, 0); PG8_STAGE(PG8_SA(1, 1), a1 + hstepA, voffA);
            PG8_WAIT_V(8); PG8_WAIT_L(0); PG8_BAR; PG8_MMA(0, 0, At, B0); PG8_MMA(0, 1, At, B1); PG8_BAR; PG8_SCHED;
            PG8_LDA(At, 0, 1); PG8_STAGE(PG8_SB(0, 0), b2, voffB); PG8_STAGE(PG8_SB(0, 1), b2 + hstepB, voffB); PG8_STAGE(PG8_SA(0, 0), a2, voffA);
            PG8_WAIT_V(8); PG8_WAIT_L(0); PG8_BAR; PG8_MMA(1, 0, At, B0); PG8_MMA(1, 1, At, B1); PG8_BAR; PG8_SCHED;
            PG8_LDB(B0, 1, 0); PG8_LDB(B1, 1, 1); PG8_SCHED; PG8_LDA(At, 1, 0); PG8_STAGE(PG8_SA(0, 1), a2 + hstepA, voffA);
            PG8_WAIT_V(8); PG8_WAIT_L(0); PG8_BAR; PG8_MMA(0, 0, At, B0); PG8_MMA(0, 1, At, B1); PG8_BAR; PG8_SCHED;
            PG8_LDA(At, 1, 1); PG8_STAGE(PG8_SB(1, 0), b3, voffB); PG8_STAGE(PG8_SB(1, 1), b3 + hstepB, voffB); PG8_STAGE(PG8_SA(1, 0), a3, voffA);
            PG8_WAIT_V(8); PG8_WAIT_L(0); PG8_BAR; PG8_MMA(1, 0, At, B0); PG8_MMA(1, 1, At, B1); PG8_BAR; PG8_SCHED;
            } else {
            PG8_LDB(B0, 0, 0); PG8_SCHED; PG8_LDA(At, 0, 0); PG8_STAGE(PG8_SA(1, 1), a1 + hstepA, voffA);
            PG8_WAIT_L(8); PG8_BAR; PG8_WAIT_L(0); PG8_MMA(0, 0, At, B0); PG8_BAR; PG8_SCHED;
            PG8_LDB(B1, 0, 1); PG8_STAGE(PG8_SB(0, 0), b2, voffB);
            PG8_BAR; PG8_WAIT_L(0); PG8_MMA(0, 1, At, B1); PG8_BAR;
            PG8_LDA(At, 0, 1); PG8_STAGE(PG8_SA(0, 0), a2, voffA);
            PG8_BAR; PG8_WAIT_L(0); PG8_MMA(1, 0, At, B0); PG8_BAR; PG8_SCHED;
            PG8_STAGE(PG8_SB(0, 1), b2 + hstepB, voffB);
            PG8_WAIT_V(6); PG8_BAR; PG8_MMA(1, 1, At, B1); PG8_BAR;
            PG8_LDB(B0, 1, 0); PG8_SCHED; PG8_LDA(At, 1, 0); PG8_STAGE(PG8_SA(0, 1), a2 + hstepA, voffA);
            PG8_WAIT_L(8); PG8_BAR; PG8_WAIT_L(0); PG8_MMA(0, 0, At, B0); PG8_BAR; PG8_SCHED;
            PG8_LDB(B1, 1, 1); PG8_STAGE(PG8_SB(1, 0), b3, voffB);
            PG8_BAR; PG8_WAIT_L(0); PG8_MMA(0, 1, At, B1); PG8_BAR;
            PG8_LDA(At, 1, 1); PG8_STAGE(PG8_SA(1, 0), a3, voffA);
            PG8_BAR; PG8_WAIT_L(0); PG8_MMA(1, 0, At, B0); PG8_BAR; PG8_SCHED;
            PG8_STAGE(PG8_SB(1, 1), b3 + hstepB, voffB);
            PG8_WAIT_V(6); PG8_BAR; PG8_MMA(1, 1, At, B1); PG8_BAR;
            }
        }
        if constexpr (ALIGN_EPI) { if (wr == 0) PG8_BAR; }
        if constexpr (!Epi::AFTER_DRAIN) { E(acc, cur, wr, wc, fr, fq); S.done(cur); }
        if (!has_next) break;
#pragma unroll
        for (int a = 0; a < 2; ++a)
#pragma unroll
            for (int b = 0; b < 2; ++b)
#pragma unroll
                for (int m = 0; m < 4; ++m)
#pragma unroll
                    for (int n = 0; n < 2; ++n) acc[a][b][m][n] = (f32x4){0.f, 0.f, 0.f, 0.f};
        cur = nxt; cA = nA; cB = nB; ++ui;
        if constexpr (ALIGN_EPI) { if (wr == 1) PG8_BAR; }
    }
    PG8_WAIT_V(0);
    if constexpr (!ALIGN_EPI) { if (wr == 0) PG8_BAR; }
    PG8_BAR;
    if constexpr (Epi::AFTER_DRAIN) { E.fused(acc, cur, wr, wc, fr, fq, lds, wid, lane); S.done(cur); }
#undef PG8_SA
#undef PG8_SB
#undef PG8_STAGE
#undef PG8_LDA
#undef PG8_LDB
#undef PG8_MMA
#undef PG8_WAIT_V
#undef PG8_WAIT_L
#undef PG8_BAR
#undef PG8_SCHED
}
}

constexpr int NWAVES = 8, NTHREADS = NWAVES * 64;
constexpr int BATCH = 8, SEQ = 4096, D = 1024, M = BATCH * SEQ;
constexpr int POOLW = 512, QW = 512, NG = 2, HD = 64, NBG = BATCH * NG;
constexpr int IN_COLS = 3864, NIN = 4096;
constexpr int NCMP = 255, NCMP_PAD = 256, NSEL = 64;
constexpr int PH = 8, PK = 128, PTOP = 16, PQD = 256, PQW = PH * PQD;
constexpr int NEXP = PK * PK;
constexpr float EPS = 1e-6f;
enum { I_X = 0, I_C, I_RELB, I_ADAW, I_ADAB, I_N1G, I_N2G, I_WIN, I_POOLW, I_POOLS, I_CPEK, I_CW1K, I_CW2K, I_CPEV, I_CW1V, I_CW2V, I_QNG, I_KNG, I_WBP, I_WBA, I_WOUT, I_PWQ, I_PSK, I_PU, I_PV, N_IN };

constexpr size_t MiB = 1u << 20, KiB = 1u << 10;
constexpr size_t WS_CTL = 0, CTL_ZERO_BYTES = 1 * MiB;
constexpr size_t WS_ADA = 1 * MiB;
constexpr size_t WS_CB1K = WS_ADA + 256 * KiB;
constexpr size_t WS_CB1V = WS_CB1K + 1 * KiB;
constexpr size_t WS_BIASL = WS_CB1V + 1 * KiB;
constexpr size_t WS_WIN_T = 2 * MiB;
constexpr size_t WS_WEFF_T = 10 * MiB;
constexpr size_t WS_WBA_T = 11 * MiB;
constexpr size_t WS_WOUT_T = 12 * MiB;
constexpr size_t WS_WQ_T = 14 * MiB;
constexpr size_t WS_SUBK = 18 * MiB;
constexpr size_t WS_CW1K_T = 18 * MiB + 512 * KiB;
constexpr size_t WS_CW1V_T = 19 * MiB;
constexpr size_t WS_CW2K_T = 19 * MiB + 512 * KiB;
constexpr size_t WS_CW2V_T = WS_CW2K_T + 64 * KiB;
constexpr size_t WS_KC = 20 * MiB;
constexpr size_t WS_VCT = 20 * MiB + 512 * KiB;
constexpr size_t WS_GATE = 21 * MiB;
constexpr size_t WS_UB = 24 * MiB;
constexpr size_t WS_VB = 56 * MiB;
constexpr size_t WS_SCLU = WS_UB + 16 * MiB, WS_SCLV = WS_SCLU + 64 * KiB;
constexpr size_t WS_H = 88 * MiB;
constexpr size_t WS_ZP = 152 * MiB;
constexpr size_t WS_Q = 184 * MiB;
constexpr size_t WS_KCR = 216 * MiB;
constexpr size_t WS_VCR = 225 * MiB;
constexpr size_t WS_KS = 234 * MiB, WS_VS = 242 * MiB, WS_KW = 250 * MiB, WS_VW = 258 * MiB;
constexpr size_t WS_VST = 266 * MiB, WS_VWT = 274 * MiB;
constexpr size_t WS_PL = 282 * MiB;
constexpr size_t WS_YA = 314 * MiB;
constexpr size_t WS_GM = 346 * MiB;
constexpr size_t WS_MIX = WS_ZP;
constexpr size_t WS_QV = WS_GM;
constexpr size_t WS_EID = WS_PL;
constexpr size_t WS_GW = WS_PL + 16 * MiB;
constexpr size_t WS_END = 474 * MiB;
constexpr int CW_TMO = 0, CW_CODE = 1, CW_BAR = 4096;

constexpr int RING_OFF = 0, RING_BYTES = 131072;
constexpr int LDSCTL_OFF = RING_BYTES, MISC_OFF = LDSCTL_OFF + 320;
constexpr int LDS_BYTES = 147456;

#define GAS __attribute__((address_space(1)))
#define LAS __attribute__((address_space(3)))
typedef unsigned short bf16;
typedef unsigned v4u __attribute__((ext_vector_type(4)));
typedef unsigned v2u __attribute__((ext_vector_type(2)));
typedef float f32x4 __attribute__((ext_vector_type(4)));
typedef short bf16x8 __attribute__((ext_vector_type(8)));
typedef GAS unsigned gu32;
#define RLX_AGENT __ATOMIC_RELAXED, __HIP_MEMORY_SCOPE_AGENT
#define LDS_WAIT() asm volatile("s_waitcnt lgkmcnt(0)" ::: "memory")
#define VM_WAIT() asm volatile("s_waitcnt vmcnt(0)" ::: "memory")
__device__ __forceinline__ unsigned f2bf(float f) { unsigned u = __builtin_bit_cast(unsigned, f); return (u + 0x7fffu + ((u >> 16) & 1u)) >> 16; }
__device__ __forceinline__ unsigned pk2(float lo, float hi) { return f2bf(lo) | (f2bf(hi) << 16); }
__device__ __forceinline__ float bflo(unsigned w) { return __builtin_bit_cast(float, w << 16); }
__device__ __forceinline__ float bfhi(unsigned w) { return __builtin_bit_cast(float, w & 0xffff0000u); }
__device__ __forceinline__ float sigmoidf_(float v) { return 1.0f / (1.0f + __expf(-v)); }
__device__ __forceinline__ float gelu_tanh_safe(float v) { const float u = 0.7978845608028654f * (v + 0.044715f * v * v * v); return 0.5f * v * (1.0f + tanhf(u)); }
__device__ __forceinline__ float wave_sum(float v) {
#pragma unroll
    for (int o = 1; o < 64; o <<= 1) v += __shfl_xor(v, o);
    return v;
}

#define XB_TMO      128
#define XB_XCNT(j)  (256  + 64 * (j))
#define XB_XSUB(j)  (1280 + 64 * (j))
#define XB_XGEN(j)  (2304 + 64 * (j))
#define XB_TOP      3328
#define XB_TOPGEN   3392
#define XCD_BAR_WORDS 3456
#define XB_SPIN_CAP (1u << 18)
__device__ __forceinline__ unsigned xb_ld(unsigned* p)              { return __hip_atomic_load(p, __ATOMIC_RELAXED, __HIP_MEMORY_SCOPE_AGENT); }
__device__ __forceinline__ unsigned xb_add(unsigned* p, unsigned v) { return __hip_atomic_fetch_add(p, v, __ATOMIC_RELAXED, __HIP_MEMORY_SCOPE_AGENT); }
__device__ __forceinline__ unsigned xb_xcc_id() { return (unsigned)__builtin_amdgcn_s_getreg((3 << 11) | 20) & 0xFu; }
#define XB_SPIN(cond, bar) do { unsigned _sp = 0; while (cond) { __builtin_amdgcn_s_sleep(1); \
    if ((++_sp & 255u) == 0u) { if (xb_ld(&(bar)[XB_TMO])) break; if (_sp > XB_SPIN_CAP) { atomicAdd(&(bar)[XB_TMO], 1u); break; } } } } while (0)
struct XcdBarrier { unsigned* bar; unsigned x; volatile LAS unsigned* st; };
__device__ __forceinline__ XcdBarrier xcd_barrier_post(unsigned* bar, volatile LAS unsigned* st) {
    XcdBarrier b; b.bar = bar; b.x = xb_xcc_id(); b.st = st;
    if (threadIdx.x == 0) (void)xb_add(&bar[XB_XCNT(b.x)], 1u);
    return b;
}
__device__ __forceinline__ void xcd_barrier_complete(unsigned* bar, unsigned x, unsigned& nloc, unsigned& nx) {
    const unsigned G = gridDim.x * gridDim.y * gridDim.z;
    unsigned sum, cnt, mine, sp = 0u;
    for (;;) {
        sum = 0u; cnt = 0u; mine = 0u;
#pragma unroll
        for (unsigned j = 0; j < 16; ++j) { const unsigned c = xb_ld(&bar[XB_XCNT(j)]); sum += c; cnt += (c > 0u) ? 1u : 0u; mine = (j == x) ? c : mine; }
        if (sum == G) break;
        __builtin_amdgcn_s_sleep(1);
        if ((++sp & 255u) == 0u) { if (xb_ld(&bar[XB_TMO])) break; if (sp > XB_SPIN_CAP) { atomicAdd(&bar[XB_TMO], 1u); break; } }
    }
    nloc = mine > 0u ? mine : 1u; nx = cnt > 0u ? cnt : 1u;
}
__device__ __forceinline__ void xcd_barrier(const XcdBarrier& b) {
    asm volatile("s_waitcnt vmcnt(0)" ::: "memory");
    __syncthreads();
    if (threadIdx.x == 0) {
        unsigned* bar = b.bar;
        __builtin_amdgcn_s_waitcnt(0);
        unsigned nloc = b.st[0], nx = b.st[1];
        if (nloc == 0u) { xcd_barrier_complete(bar, b.x, nloc, nx); b.st[0] = nloc; b.st[1] = nx; }
        const unsigned old = xb_add(&bar[XB_XSUB(b.x)], 1u);
        const unsigned gen = old / nloc;
        if (old + 1u == (gen + 1u) * nloc) {
            __builtin_amdgcn_fence(__ATOMIC_RELEASE, "agent");
            asm volatile("s_waitcnt vmcnt(0)" ::: "memory");
            const unsigned og = xb_add(&bar[XB_TOP], 1u);
            const unsigned tg = og / nx;
            if (og + 1u == (tg + 1u) * nx) xb_add(&bar[XB_TOPGEN], 1u);
            else XB_SPIN(xb_ld(&bar[XB_TOPGEN]) == tg, bar);
            __builtin_amdgcn_fence(__ATOMIC_ACQUIRE, "agent");
            xb_add(&bar[XB_XGEN(b.x)], 1u);
            asm volatile("s_waitcnt vmcnt(0)" ::: "memory");
        } else {
            XB_SPIN(xb_ld(&bar[XB_XGEN(b.x)]) == gen, bar);
            __builtin_amdgcn_fence(__ATOMIC_ACQUIRE, "agent");
            asm volatile("s_waitcnt vmcnt(0)" ::: "memory");
        }
    }
    __syncthreads();
}

struct Args { const float* in[N_IN]; float* out; unsigned char* ws; int ph_lo, ph_hi, li, pad; };
struct Frame {
    LAS unsigned char* lds;
    volatile LAS unsigned* MISC;
    gu32* ctl;
    int tid, lane, wave, G, bid;
    unsigned char* ws;
};

__device__ __forceinline__ void cvt_rows_fp8(const float* src, unsigned char* dst, float* inv_scale, int gw, int NGW, int lane) {
    for (int row = gw; row < NEXP; row += NGW) {
        const float* r = src + (size_t)row * D + 16 * lane;
        f32x4 v[4]; float m = 0.f;
#pragma unroll
        for (int j = 0; j < 4; ++j) { v[j] = *(const GAS f32x4*)(r + 4 * j); m = fmaxf(m, fmaxf(fmaxf(fabsf(v[j].x), fabsf(v[j].y)), fmaxf(fabsf(v[j].z), fabsf(v[j].w)))); }
#pragma unroll
        for (int o = 1; o < 64; o <<= 1) m = fmaxf(m, __shfl_xor(m, o));
        const unsigned E = (__builtin_bit_cast(unsigned, m) >> 23) & 0xffu;
        float sc = 1.f, isc = 1.f;
        if (E >= 8u && E <= 250u) { sc = __builtin_bit_cast(float, (261u - E) << 23); isc = __builtin_bit_cast(float, (E - 7u) << 23); }
        v4u w; unsigned ww[4];
#pragma unroll
        for (int j = 0; j < 4; ++j) { int t = __builtin_amdgcn_cvt_pk_fp8_f32(v[j].x * sc, v[j].y * sc, 0, false); t = __builtin_amdgcn_cvt_pk_fp8_f32(v[j].z * sc, v[j].w * sc, t, true); ww[j] = (unsigned)t; }
        w.x = ww[0]; w.y = ww[1]; w.z = ww[2]; w.w = ww[3];
        *(GAS v4u*)(dst + (size_t)row * D + 16 * lane) = w;
        if (lane == 0) inv_scale[row] = isc;
    }
}

__device__ __forceinline__ void p0_transpose_item(const float* W, int ldw, int src_col0, int valid, int K, bf16* WT, int dst_row0, int k0, LAS float* scr, int lane) {
    const int n_ = lane & 31;
#pragma unroll 8
    for (int i = 0; i < 32; ++i) { const int kk = 2 * i + (lane >> 5); scr[kk * 33 + n_] = (n_ < valid) ? W[(size_t)(k0 + kk) * ldw + src_col0 + n_] : 0.f; }
    LDS_WAIT(); asm volatile("" ::: "memory");
    const int c = lane & 7;
#pragma unroll
    for (int j = 0; j < 4; ++j) { const int n = (lane >> 3) + 8 * j; const LAS float* s = scr + (8 * c) * 33 + n;
        v4u o; o.x = pk2(s[0 * 33], s[1 * 33]); o.y = pk2(s[2 * 33], s[3 * 33]); o.z = pk2(s[4 * 33], s[5 * 33]); o.w = pk2(s[6 * 33], s[7 * 33]);
        *(GAS v4u*)(WT + (size_t)(dst_row0 + n) * K + k0 + 8 * c) = o; }
    LDS_WAIT(); asm volatile("" ::: "memory");
}
__device__ __forceinline__ bool p0_mat(int& r, const float* W, int K, int N, bf16* WT, LAS float* scr, int lane) {
    const int ng = N / 32, items = ng * (K / 64);
    if (r < items) { const int kb = r / ng, nb = r % ng; p0_transpose_item(W, N, 32 * nb, 32, K, WT, 32 * nb, 64 * kb, scr, lane); return true; }
    r -= items; return false;
}
__device__ __forceinline__ void cvt_f32_bf16_stream(const float* src, bf16* dst, size_t n8, size_t gtid, size_t gthreads) {
    for (size_t i = gtid; i < n8; i += gthreads) {
        const f32x4 a = *(const GAS f32x4*)(src + 8 * i), b = *(const GAS f32x4*)(src + 8 * i + 4);
        v4u o; o.x = pk2(a.x, a.y); o.y = pk2(a.z, a.w); o.z = pk2(b.x, b.y); o.w = pk2(b.z, b.w);
        *(GAS v4u*)(dst + 8 * i) = o; }
}

__device__ __forceinline__ void p0_prologue(Frame& F, const Args& args) {
    unsigned char* ws = F.ws;
    const int gw = F.bid * NWAVES + F.wave, NGW = F.G * NWAVES;
    const size_t gtid = (size_t)F.bid * NTHREADS + F.tid, gthreads = (size_t)F.G * NTHREADS;
    {
        LAS float* sl = (LAS float*)(F.lds);
        LAS float* red = (LAS float*)(F.lds + 32768);
        const float* c = args.in[I_C];
        for (int i = F.tid; i < BATCH * D; i += NTHREADS) { const float v = c[i]; sl[i] = v / (1.0f + __expf(-v)); }
        __syncthreads();
        for (int cb = F.bid; cb < 6 * D / 24; cb += F.G) {
            const int j0 = cb * 24;
            if (F.tid < 504) {
                const int kk = F.tid / 24, jj = F.tid % 24;
                float a[BATCH];
#pragma unroll
                for (int b = 0; b < BATCH; ++b) a[b] = 0.f;
                const float* w = args.in[I_ADAW] + j0 + jj;
                for (int k = kk; k < D; k += 21) { const float wv = w[(size_t)k * (6 * D)];
#pragma unroll
                    for (int b = 0; b < BATCH; ++b) a[b] += sl[b * D + k] * wv; }
#pragma unroll
                for (int b = 0; b < BATCH; ++b) red[(kk * 24 + jj) * BATCH + b] = a[b];
            }
            __syncthreads();
            if (F.tid < 24 * BATCH) { const int jj = F.tid / BATCH, b = F.tid % BATCH; float s = 0.f;
                for (int kk = 0; kk < 21; ++kk) s += red[(kk * 24 + jj) * BATCH + b];
                ((float*)(ws + WS_ADA))[b * (6 * D) + j0 + jj] = s + args.in[I_ADAB][j0 + jj]; }
            __syncthreads();
        }
    }
    if (F.bid < 2) {
        const float* pe = args.in[F.bid == 0 ? I_CPEK : I_CPEV]; const float* w1 = args.in[F.bid == 0 ? I_CW1K : I_CW1V];
        LAS float* red = (LAS float*)(F.lds);
        const int j = F.tid & 127, ic = F.tid >> 7; float s = 0.f;
        for (int i = ic * 512; i < ic * 512 + 512; ++i) s += pe[i] * w1[(size_t)i * 128 + j];
        red[ic * 128 + j] = s; __syncthreads();
        if (F.tid < 128) ((float*)(ws + (F.bid == 0 ? WS_CB1K : WS_CB1V)))[F.tid] = (red[F.tid] + red[128 + F.tid]) + (red[256 + F.tid] + red[384 + F.tid]);
        __syncthreads();
    } else if (F.bid == 2) {
        for (int i = F.tid; i < 8 * 128; i += NTHREADS) { const int h = i >> 7, rel = i & 127;
            int bk = rel;
            if (rel >= 16) bk = 16 + (rel >= 19) + (rel >= 21) + (rel >= 24) + (rel >= 27) + (rel >= 31) + (rel >= 35) + (rel >= 40) + (rel >= 46) + (rel >= 52) + (rel >= 59) + (rel >= 67) + (rel >= 77) + (rel >= 87) + (rel >= 99) + (rel >= 113);
            ((float*)(ws + WS_BIASL))[i] = args.in[I_RELB][bk * 8 + h]; }
        if (F.tid < 64) {
            float mq = fabsf(args.in[I_QNG][F.tid]), mk = fmaxf(fmaxf(fabsf(args.in[I_KNG][F.tid]), fabsf(args.in[I_KNG][64 + F.tid])), fabsf(args.in[I_KNG][128 + F.tid]));
            float mb = fmaxf(fmaxf(fabsf(args.in[I_RELB][F.tid]), fabsf(args.in[I_RELB][64 + F.tid])), fmaxf(fabsf(args.in[I_RELB][128 + F.tid]), fabsf(args.in[I_RELB][192 + F.tid])));
#pragma unroll
            for (int o = 1; o < 64; o <<= 1) { mq = fmaxf(mq, __shfl_xor(mq, o)); mk = fmaxf(mk, __shfl_xor(mk, o)); mb = fmaxf(mb, __shfl_xor(mb, o)); }
            if (F.tid == 0) ((float*)(ws + WS_BIASL))[8 * 128] = 8.0f * mq * mk + mb; }
    }
    {
        LAS float* scr = (LAS float*)(F.lds + F.wave * 16384);
        constexpr int I_WINT = (NIN / 32) * (D / 64);
        constexpr int NITEMS = I_WINT + (1024 / 32) * (512 / 64) + (1024 / 32) * (1024 / 64) + (2048 / 32) * (1024 / 64) + 2 * (128 / 32) * (2048 / 64) + 2 * (64 / 32) * (128 / 64);
        for (int it = gw; it < NITEMS; it += NGW) {
            int r = it;
            if (r < I_WINT) {
                const int grp = r % (NIN / 32), kb = r / (NIN / 32);
                const int tile = grp >> 3, ct0 = (grp & 7) * 32;
                const int L0 = 64 * ((ct0 >> 5) & 3) + 32 * (ct0 >> 7);
                int src0, valid = 32;
                if (tile < 7) src0 = 256 * tile + L0; else if (tile < 15) src0 = 1816 + 256 * (tile - 7) + L0; else { src0 = 1792 + L0; valid = (L0 == 0) ? 24 : 0; }
                if (valid == 0) src0 = 0;
                p0_transpose_item(args.in[I_WIN], IN_COLS, src0, valid, D, (bf16*)(ws + WS_WIN_T), 32 * grp, 64 * kb, scr, F.lane);
                continue; }
            r -= I_WINT;
            if (p0_mat(r, args.in[I_WBA], 512, 1024, (bf16*)(ws + WS_WBA_T), scr, F.lane)) continue;
            if (p0_mat(r, args.in[I_WOUT], 1024, 1024, (bf16*)(ws + WS_WOUT_T), scr, F.lane)) continue;
            if (p0_mat(r, args.in[I_PWQ], 1024, 2048, (bf16*)(ws + WS_WQ_T), scr, F.lane)) continue;
            if (p0_mat(r, args.in[I_CW1K], 2048, 128, (bf16*)(ws + WS_CW1K_T), scr, F.lane)) continue;
            if (p0_mat(r, args.in[I_CW1V], 2048, 128, (bf16*)(ws + WS_CW1V_T), scr, F.lane)) continue;
            if (p0_mat(r, args.in[I_CW2K], 128, 64, (bf16*)(ws + WS_CW2K_T), scr, F.lane)) continue;
            p0_mat(r, args.in[I_CW2V], 128, 64, (bf16*)(ws + WS_CW2V_T), scr, F.lane);
        }
    }
    {
        const float* pw = args.in[I_POOLW]; const float* ps = args.in[I_POOLS]; const float* wbp = args.in[I_WBP];
        bf16* weff = (bf16*)(ws + WS_WEFF_T);
        for (size_t idx = gtid; idx < (size_t)D * POOLW; idx += gthreads) {
            const int d = (int)(idx >> 9), r = (int)(idx & 511), g = r >> 7;
            const float* pr = pw + (size_t)r * 128; float s = 0.f;
            for (int cc = 0; cc < 128; ++cc) s += pr[cc] * ps[g * 128 + cc] * wbp[(size_t)(g * 128 + cc) * D + d];
            weff[idx] = (bf16)f2bf(s); }
    }
    cvt_f32_bf16_stream(args.in[I_PSK], (bf16*)(ws + WS_SUBK), (size_t)16 * 128 * 128 / 8, gtid, gthreads);
    cvt_rows_fp8(args.in[I_PU], ws + WS_UB, (float*)(ws + WS_SCLU), gw, NGW, F.lane);
    cvt_rows_fp8(args.in[I_PV], ws + WS_VB, (float*)(ws + WS_SCLV), gw, NGW, F.lane);
}

__device__ __forceinline__ void modnorm_rows(Frame& F, const float* x, const float* g, const float* ada, int shift_idx, bf16* out) {
    const int gw = F.bid * NWAVES + F.wave, NGW = F.G * NWAVES;
    for (int m = gw; m < M; m += NGW) {
        const int b = m >> 12;
        const GAS f32x4* xr = (const GAS f32x4*)(x + (size_t)m * D) + F.lane;
        const GAS f32x4* gr = (const GAS f32x4*)g + F.lane;
        const GAS f32x4* sh = (const GAS f32x4*)(ada + (size_t)b * 6 * D + shift_idx * D) + F.lane;
        const GAS f32x4* sc = (const GAS f32x4*)(ada + (size_t)b * 6 * D + (shift_idx + 1) * D) + F.lane;
        f32x4 v[4]; float s = 0.f;
#pragma unroll
        for (int j = 0; j < 4; ++j) { v[j] = xr[64 * j]; s += (v[j].x * v[j].x + v[j].y * v[j].y) + (v[j].z * v[j].z + v[j].w * v[j].w); }
        const float rstd = rsqrtf(wave_sum(s) * (1.f / D) + EPS);
        GAS v2u* o8 = (GAS v2u*)(out + (size_t)m * D) + F.lane;
#pragma unroll
        for (int j = 0; j < 4; ++j) { const f32x4 gg = gr[64 * j], ss = sh[64 * j], cc = sc[64 * j];
            const f32x4 y = (v[j] * rstd) * gg * (cc + 1.0f) + ss;
            v2u o; o.x = pk2(y.x, y.y); o.y = pk2(y.z, y.w); o8[64 * j] = o; }
    }
}

struct EpiIn {
    static constexpr bool PERM = true, AFTER_DRAIN = false;
    unsigned char* ws; const float* qg; const float* kg;
    __device__ __forceinline__ void operator()(const pg8::f32x4 (&acc)[2][2][4][2], const pg8::Unit& u, int wr, int wc, int fr, int fq) const {
        const int pn = u.pn;
#pragma unroll
        for (int ai = 0; ai < 2; ++ai)
#pragma unroll
            for (int m = 0; m < 4; ++m) {
                const int row = u.pm * 256 + ai * 128 + wr * 64 + m * 16 + fr;
                float v[2][8];
#pragma unroll
                for (int bj = 0; bj < 2; ++bj)
#pragma unroll
                    for (int n = 0; n < 2; ++n)
#pragma unroll
                        for (int i = 0; i < 4; ++i) v[bj][4 * n + i] = acc[ai][bj][m][n][i];
                bf16* dst = nullptr; bool norm = false; const float* gain = nullptr; float mul = 1.f; bool sig = false;
                if (pn < 2) { dst = (bf16*)(ws + WS_ZP) + (size_t)row * 512 + 256 * pn + 64 * wc; }
                else if (pn < 4) { dst = (bf16*)(ws + WS_Q) + (size_t)row * 512 + 256 * (pn - 2) + 64 * wc; norm = true; gain = qg; mul = 0.125f * 1.4426950408889634f; }
                else if (pn < 7) { const int kind = pn - 4, isv = wc >> 1, g = wc & 1, b = row >> 12, t = row & 4095;
                    const size_t base = ((size_t)(b * 2 + g) * SEQ + t) * 64;
                    const size_t off = kind == 0 ? (isv ? WS_VCR : WS_KCR) : kind == 1 ? (isv ? WS_VS : WS_KS) : (isv ? WS_VW : WS_KW);
                    dst = (bf16*)(ws + off) + base; if (!isv && kind > 0) { norm = true; gain = kg + kind * 64; } }
                else if (pn < 15) { dst = (bf16*)(ws + WS_GM) + (size_t)row * 2048 + 256 * (pn - 7) + 64 * wc; sig = true; }
                else {
                    if (wc == 0 && fq < 3) { float* gp = (float*)(ws + WS_GATE) + (size_t)row * 24 + 8 * fq;
                        *(GAS f32x4*)gp = (f32x4){sigmoidf_(v[0][0]), sigmoidf_(v[0][1]), sigmoidf_(v[0][2]), sigmoidf_(v[0][3])};
                        *(GAS f32x4*)(gp + 4) = (f32x4){sigmoidf_(v[0][4]), sigmoidf_(v[0][5]), sigmoidf_(v[0][6]), sigmoidf_(v[0][7])}; }
                    continue; }
                if (norm) { float ss = 0.f;
#pragma unroll
                    for (int bj = 0; bj < 2; ++bj)
#pragma unroll
                        for (int e = 0; e < 8; ++e) ss += v[bj][e] * v[bj][e];
                    ss += __shfl_xor(ss, 16); ss += __shfl_xor(ss, 32);
                    const float rs = rsqrtf(ss * (1.f / 64.f) + EPS) * mul;
#pragma unroll
                    for (int bj = 0; bj < 2; ++bj)
#pragma unroll
                        for (int e = 0; e < 8; ++e) v[bj][e] = v[bj][e] * rs * gain[32 * bj + 8 * fq + e]; }
                if (sig) {
#pragma unroll
                    for (int bj = 0; bj < 2; ++bj)
#pragma unroll
                        for (int e = 0; e < 8; ++e) v[bj][e] = sigmoidf_(v[bj][e]); }
#pragma unroll
                for (int bj = 0; bj < 2; ++bj) { v4u o; o.x = pk2(v[bj][0], v[bj][1]); o.y = pk2(v[bj][2], v[bj][3]); o.z = pk2(v[bj][4], v[bj][5]); o.w = pk2(v[bj][6], v[bj][7]);
                    *(GAS v4u*)(dst + 32 * bj + 8 * fq) = o; }
            }
    }
};
template <bool ADD> struct EpiMix {
    static constexpr bool PERM = true, AFTER_DRAIN = false;
    bf16* MIX; const bf16* GM; int gmoff;
    __device__ __forceinline__ void operator()(const pg8::f32x4 (&acc)[2][2][4][2], const pg8::Unit& u, int wr, int wc, int fr, int fq) const {
#pragma unroll
        for (int ai = 0; ai < 2; ++ai)
#pragma unroll
            for (int m = 0; m < 4; ++m) {
                const int row = u.pm * 256 + ai * 128 + wr * 64 + m * 16 + fr;
#pragma unroll
                for (int bj = 0; bj < 2; ++bj) {
                    const int col = u.pn * 256 + bj * 128 + wc * 32 + 8 * fq;
                    const v4u gmv = *(const GAS v4u*)(GM + (size_t)row * 2048 + gmoff + col);
                    float r[8];
                    r[0] = acc[ai][bj][m][0][0] * bflo(gmv.x); r[1] = acc[ai][bj][m][0][1] * bfhi(gmv.x); r[2] = acc[ai][bj][m][0][2] * bflo(gmv.y); r[3] = acc[ai][bj][m][0][3] * bfhi(gmv.y);
                    r[4] = acc[ai][bj][m][1][0] * bflo(gmv.z); r[5] = acc[ai][bj][m][1][1] * bfhi(gmv.z); r[6] = acc[ai][bj][m][1][2] * bflo(gmv.w); r[7] = acc[ai][bj][m][1][3] * bfhi(gmv.w);
                    GAS v4u* dp = (GAS v4u*)(MIX + (size_t)row * 1024 + col);
                    if (ADD) { const v4u old = *dp; r[0] += bflo(old.x); r[1] += bfhi(old.x); r[2] += bflo(old.y); r[3] += bfhi(old.y); r[4] += bflo(old.z); r[5] += bfhi(old.z); r[6] += bflo(old.w); r[7] += bfhi(old.w); }
                    v4u o; o.x = pk2(r[0], r[1]); o.y = pk2(r[2], r[3]); o.z = pk2(r[4], r[5]); o.w = pk2(r[6], r[7]); *dp = o; }
            }
    }
};
struct EpiRes {
    static constexpr bool PERM = false, AFTER_DRAIN = false;
    const float* x; float* out; const float* ada; int gate_idx;
    __device__ __forceinline__ void operator()(const pg8::f32x4 (&acc)[2][2][4][2], const pg8::Unit& u, int wr, int wc, int fr, int fq) const {
#pragma unroll
        for (int ai = 0; ai < 2; ++ai)
#pragma unroll
            for (int m = 0; m < 4; ++m) {
                const int row = u.pm * 256 + ai * 128 + wr * 64 + m * 16 + fr, b = row >> 12;
#pragma unroll
                for (int bj = 0; bj < 2; ++bj)
#pragma unroll
                    for (int n = 0; n < 2; ++n) {
                        const int col = u.pn * 256 + bj * 128 + wc * 32 + 16 * n + 4 * fq;
                        const f32x4 gt = *(const GAS f32x4*)(ada + (size_t)b * 6 * D + gate_idx * D + col);
                        const f32x4 xv = *(const GAS f32x4*)(x + (size_t)row * D + col);
                        *(GAS f32x4*)(out + (size_t)row * D + col) = xv + gt * acc[ai][bj][m][n]; }
            }
    }
};

__device__ __forceinline__ void pool_phase(Frame& F) {
    const bf16* zp = (const bf16*)(F.ws + WS_ZP); bf16* pl = (bf16*)(F.ws + WS_PL);
    const size_t gtid = (size_t)F.bid * NTHREADS + F.tid, gthreads = (size_t)F.G * NTHREADS;
    for (size_t idx = gtid; idx < (size_t)M * 64; idx += gthreads) {
        const int row = (int)(idx >> 6), c8 = (int)(idx & 63), t = row & 4095, w = 2 << (c8 >> 4), cnt = (t + 1 < w) ? (t + 1) : w;
        float s[8];
#pragma unroll
        for (int e = 0; e < 8; ++e) s[e] = 0.f;
        float self[8];
        for (int j = 0; j < cnt; ++j) { const v4u z = *(const GAS v4u*)(zp + (size_t)(row - j) * 512 + 8 * c8);
            const float f[8] = {bflo(z.x), bfhi(z.x), bflo(z.y), bfhi(z.y), bflo(z.z), bfhi(z.z), bflo(z.w), bfhi(z.w)};
#pragma unroll
            for (int e = 0; e < 8; ++e) { s[e] += f[e]; if (j == 0) self[e] = f[e]; } }
        const float inv = 1.0f / (float)cnt;
        v4u o; o.x = pk2(s[0] * inv - self[0], s[1] * inv - self[1]); o.y = pk2(s[2] * inv - self[2], s[3] * inv - self[3]);
        o.z = pk2(s[4] * inv - self[4], s[5] * inv - self[5]); o.w = pk2(s[6] * inv - self[6], s[7] * inv - self[7]);
        *(GAS v4u*)(pl + (size_t)row * 512 + 8 * c8) = o; }
}

typedef int v4i __attribute__((ext_vector_type(4)));
struct EpiStoreBf16 {
    static constexpr bool PERM = true, AFTER_DRAIN = false;
    bf16* O; int ldc;
    __device__ __forceinline__ void operator()(const pg8::f32x4 (&acc)[2][2][4][2], const pg8::Unit& u, int wr, int wc, int fr, int fq) const {
#pragma unroll
        for (int ai = 0; ai < 2; ++ai)
#pragma unroll
            for (int m = 0; m < 4; ++m) {
                const int row = u.pm * 256 + ai * 128 + wr * 64 + m * 16 + fr;
#pragma unroll
                for (int bj = 0; bj < 2; ++bj) {
                    const int col = u.pn * 256 + bj * 128 + wc * 32 + 8 * fq;
                    v4u o; o.x = pk2(acc[ai][bj][m][0][0], acc[ai][bj][m][0][1]); o.y = pk2(acc[ai][bj][m][0][2], acc[ai][bj][m][0][3]);
                    o.z = pk2(acc[ai][bj][m][1][0], acc[ai][bj][m][1][1]); o.w = pk2(acc[ai][bj][m][1][2], acc[ai][bj][m][1][3]);
                    *(GAS v4u*)(O + (size_t)row * ldc + col) = o; }
            }
    }
};

__device__ __forceinline__ unsigned fkey(float f) { const unsigned u = __builtin_bit_cast(unsigned, f); return (u >> 31) ? ~u : (u | 0x80000000u); }
__device__ __forceinline__ float funkey(unsigned k) { const unsigned u = (k >> 31) ? (k & 0x7fffffffu) : ~k; return __builtin_bit_cast(float, u); }
#define TOP16_INSERT(L, xin) do { unsigned _x = (xin); _Pragma("unroll") for (int _i = 0; _i < 16; ++_i) { const unsigned _h = L[_i] > _x ? L[_i] : _x; _x = L[_i] > _x ? _x : L[_i]; L[_i] = _h; } } while (0)
constexpr int SST = 129;
constexpr int P9_S_BYTES = 2 * 64 * SST * 4;
constexpr int P9_LIST_OFF = 66560;
__device__ __forceinline__ void peer_select_phase(Frame& F) {
    const bf16* QV = (const bf16*)(F.ws + WS_QV); const bf16* SK = (const bf16*)(F.ws + WS_SUBK);
    int* EID = (int*)(F.ws + WS_EID); float* GW = (float*)(F.ws + WS_GW);
    LAS float* S = (LAS float*)(F.lds);
    LAS unsigned* LIST = (LAS unsigned*)(F.lds + P9_LIST_OFF);
    const int lane = F.lane, w = F.wave, l15 = lane & 15, lq = lane >> 4;
    for (int u = F.bid; u < (M / 64) * PH; u += F.G) {
        const int tt = u >> 3, h = u & 7, tok0 = tt * 64;
        {
            const int p = w >> 2, kb = w & 3;
            pg8::f32x4 acc[4][2];
#pragma unroll
            for (int rb = 0; rb < 4; ++rb)
#pragma unroll
                for (int cb = 0; cb < 2; ++cb) acc[rb][cb] = (pg8::f32x4){0.f, 0.f, 0.f, 0.f};
            const bf16* qa = QV + (size_t)(tok0 + l15) * PQW + h * 256 + p * 128 + 8 * lq;
            const bf16* kbp = SK + (size_t)((h * 2 + p) * 128 + 32 * kb + l15) * 128 + 8 * lq;
#pragma unroll
            for (int ks = 0; ks < 4; ++ks) {
                bf16x8 a[4], b[2];
#pragma unroll
                for (int rb = 0; rb < 4; ++rb) a[rb] = *(const GAS bf16x8*)(qa + (size_t)(16 * rb) * PQW + 32 * ks);
#pragma unroll
                for (int cb = 0; cb < 2; ++cb) b[cb] = *(const GAS bf16x8*)(kbp + (size_t)(16 * cb) * 128 + 32 * ks);
#pragma unroll
                for (int rb = 0; rb < 4; ++rb)
#pragma unroll
                    for (int cb = 0; cb < 2; ++cb) acc[rb][cb] = __builtin_amdgcn_mfma_f32_16x16x32_bf16(a[rb], b[cb], acc[rb][cb], 0, 0, 0);
            }
#pragma unroll
            for (int rb = 0; rb < 4; ++rb)
#pragma unroll
                for (int cb = 0; cb < 2; ++cb)
#pragma unroll
                    for (int r = 0; r < 4; ++r) S[(p * 64 + 16 * rb + 4 * lq + r) * SST + 32 * kb + 16 * cb + l15] = acc[rb][cb][r];
        }
        __syncthreads();
        if (F.tid < 128) {
            const LAS float* sr = S + F.tid * SST;
            unsigned L[16];
#pragma unroll
            for (int i = 0; i < 16; ++i) L[i] = 0u;
#pragma unroll 4
            for (int k = 0; k < 128; ++k) { const unsigned key = (fkey(sr[k]) & ~127u) | (unsigned)k; TOP16_INSERT(L, key); }
#pragma unroll
            for (int i = 0; i < 16; ++i) LIST[F.tid * 16 + i] = L[i];
        }
        __syncthreads();
        if (F.tid < 64) {
            const int tok = F.tid;
            float va[16], vb[16];
#pragma unroll
            for (int i = 0; i < 16; ++i) { va[i] = funkey(LIST[tok * 16 + i] & ~127u); vb[i] = funkey(LIST[(64 + tok) * 16 + i] & ~127u); }
            unsigned L[16];
#pragma unroll
            for (int i = 0; i < 16; ++i) L[i] = 0u;
#pragma unroll
            for (int i = 0; i < 16; ++i)
#pragma unroll
                for (int j = 0; j < 16; ++j)
                    if ((i + 1) * (j + 1) <= 16) { const unsigned key = (fkey(va[i] + vb[j]) & ~255u) | (unsigned)(i * 16 + j); TOP16_INSERT(L, key); }
            const float mx = funkey(L[0] & ~255u);
            float e[16], sum = 0.f;
#pragma unroll
            for (int k = 0; k < 16; ++k) { e[k] = __expf(funkey(L[k] & ~255u) - mx); sum += e[k]; }
            const float inv = 1.0f / sum;
            const size_t ob = ((size_t)(tok0 + tok) * PH + h) * 16;
#pragma unroll
            for (int k4 = 0; k4 < 4; ++k4) {
                int id[4];
#pragma unroll
                for (int q = 0; q < 4; ++q) { const unsigned cid = L[4 * k4 + q] & 255u;
                    const unsigned ia = LIST[tok * 16 + (cid >> 4)] & 127u, ib = LIST[(64 + tok) * 16 + (cid & 15u)] & 127u; id[q] = (int)(ia * 128u + ib); }
                *(GAS v4i*)(EID + ob + 4 * k4) = (v4i){id[0], id[1], id[2], id[3]};
                *(GAS f32x4*)(GW + ob + 4 * k4) = (f32x4){e[4 * k4] * inv, e[4 * k4 + 1] * inv, e[4 * k4 + 2] * inv, e[4 * k4 + 3] * inv};
            }
        }
        __syncthreads();
    }
}

__device__ __forceinline__ void unpack8(const v4u w, float (&f)[8]) { f[0] = bflo(w.x); f[1] = bfhi(w.x); f[2] = bflo(w.y); f[3] = bfhi(w.y); f[4] = bflo(w.z); f[5] = bfhi(w.z); f[6] = bflo(w.w); f[7] = bfhi(w.w); }
typedef float f32x2 __attribute__((ext_vector_type(2)));
__device__ __forceinline__ void unpack16_fp8(const v4u w, float (&f)[16]) {
    const unsigned ww[4] = {w.x, w.y, w.z, w.w};
#pragma unroll
    for (int d = 0; d < 4; ++d) { const f32x2 a = __builtin_amdgcn_cvt_pk_f32_fp8((int)ww[d], false), b = __builtin_amdgcn_cvt_pk_f32_fp8((int)ww[d], true);
        f[4 * d] = a.x; f[4 * d + 1] = a.y; f[4 * d + 2] = b.x; f[4 * d + 3] = b.y; }
}
template <bool DRY> __device__ __forceinline__ void peer_gather_phase(Frame& F, const float* ada, float* out) {
    const bf16* H = (const bf16*)(F.ws + WS_H); const unsigned char* UB = F.ws + WS_UB; const unsigned char* VB = F.ws + WS_VB;
    const float* SCU = (const float*)(F.ws + WS_SCLU); const float* SCV = (const float*)(F.ws + WS_SCLV);
    const int* EID = (const int*)(F.ws + WS_EID); const float* GW = (const float*)(F.ws + WS_GW);
    const int gw = F.bid * NWAVES + F.wave, NGW = F.G * NWAVES, lane = F.lane;
    const bool b32 = (lane & 32) != 0, b16 = (lane & 16) != 0, b8 = (lane & 8) != 0;
    for (int row = gw; row < M; row += NGW) {
        const int b = row >> 12;
        float hx[16];
        { const v4u h0 = *(const GAS v4u*)(H + (size_t)row * D + 16 * lane), h1 = *(const GAS v4u*)(H + (size_t)row * D + 16 * lane + 8);
          float t0[8], t1[8]; unpack8(h0, t0); unpack8(h1, t1);
#pragma unroll
          for (int i = 0; i < 8; ++i) { hx[i] = t0[i]; hx[8 + i] = t1[i]; } }
        const int e_lo = EID[(size_t)row * 128 + lane], e_hi = EID[(size_t)row * 128 + 64 + lane];
        const float g_lo = GW[(size_t)row * 128 + lane], g_hi = GW[(size_t)row * 128 + 64 + lane];
        const float su_lo = SCU[e_lo], su_hi = SCU[e_hi];
        const float gv_lo = g_lo * SCV[e_lo], gv_hi = g_hi * SCV[e_hi];
        float o[16];
#pragma unroll
        for (int i = 0; i < 16; ++i) o[i] = 0.f;
        for (int e0 = 0; e0 < 128; e0 += 8) {
            const int esrc = (e0 < 64) ? e_lo : e_hi;
            int eid[8]; v4u uu[8], vv[8];
#pragma unroll
            for (int q = 0; q < 8; ++q) { eid[q] = __builtin_amdgcn_readlane(esrc, (e0 & 63) + q);
                uu[q] = *(const GAS v4u*)(UB + (size_t)eid[q] * D + 16 * lane); }
#pragma unroll
            for (int q = 0; q < 8; ++q) vv[q] = *(const GAS v4u*)(VB + (size_t)eid[q] * D + 16 * lane);
            float s[8];
#pragma unroll
            for (int q = 0; q < 8; ++q) { float f[16]; unpack16_fp8(uu[q], f); float a0 = 0.f, a1 = 0.f;
#pragma unroll
                for (int i = 0; i < 8; ++i) { a0 += hx[i] * f[i]; a1 += hx[8 + i] * f[8 + i]; }
                s[q] = a0 + a1; }
            float r1[4], r2[2], r3;
#pragma unroll
            for (int j = 0; j < 4; ++j) { const float send = b32 ? s[j] : s[j + 4], keep = b32 ? s[j + 4] : s[j]; r1[j] = keep + __shfl_xor(send, 32); }
#pragma unroll
            for (int j = 0; j < 2; ++j) { const float send = b16 ? r1[j] : r1[j + 2], keep = b16 ? r1[j + 2] : r1[j]; r2[j] = keep + __shfl_xor(send, 16); }
            { const float send = b8 ? r2[0] : r2[1], keep = b8 ? r2[1] : r2[0]; r3 = keep + __shfl_xor(send, 8); }
            r3 += __shfl_xor(r3, 4); r3 += __shfl_xor(r3, 2); r3 += __shfl_xor(r3, 1);
            const int qsrc = (e0 & 63) + (lane >> 3);
            const float isu = __shfl((e0 < 64) ? su_lo : su_hi, qsrc), gvs = __shfl((e0 < 64) ? gv_lo : gv_hi, qsrc);
            const float cfv = gvs * gelu_tanh_safe(r3 * isu);
#pragma unroll
            for (int q = 0; q < 8; ++q) { const float cf = __builtin_bit_cast(float, __builtin_amdgcn_readlane(__builtin_bit_cast(int, cfv), 8 * q));
                float f[16]; unpack16_fp8(vv[q], f);
#pragma unroll
                for (int i = 0; i < 16; ++i) o[i] += cf * f[i]; }
        }
        const float* gt = ada + (size_t)b * 6 * D + 5 * D + 16 * lane;
        float* xo = out + (size_t)row * D + 16 * lane;
#pragma unroll
        for (int q = 0; q < 4; ++q) {
            const f32x4 xv = *(const GAS f32x4*)(xo + 4 * q), gv = *(const GAS f32x4*)(gt + 4 * q);
            const f32x4 res = xv + gv * (f32x4){o[4 * q], o[4 * q + 1], o[4 * q + 2], o[4 * q + 3]};
            if (DRY) { asm volatile("" :: "v"(res.x), "v"(res.y), "v"(res.z), "v"(res.w)); } else *(GAS f32x4*)(xo + 4 * q) = res; }
    }
}

__device__ __forceinline__ void compress_phase(Frame& F, const float* kng) {
    LAS bf16* H2 = (LAS bf16*)(F.lds);
    LAS float* OUTS = (LAS float*)(F.lds + 16384);
    const int lane = F.lane, w = F.wave, l15 = lane & 15, lq = lane >> 4;
    for (int u = F.bid; u < NBG * 2 * 8; u += F.G) {
        const int ns = u & 7, kv = (u >> 3) & 1, bg = u >> 4, n0 = ns * 32;
        const bf16* A = (const bf16*)(F.ws + (kv ? WS_VCR : WS_KCR)) + (size_t)bg * SEQ * 64;
        const bf16* W1T = (const bf16*)(F.ws + (kv ? WS_CW1V_T : WS_CW1K_T));
        const bf16* W2T = (const bf16*)(F.ws + (kv ? WS_CW2V_T : WS_CW2K_T));
        const float* b1 = (const float*)(F.ws + (kv ? WS_CB1V : WS_CB1K));
        pg8::f32x4 acc[2];
        acc[0] = (pg8::f32x4){0.f, 0.f, 0.f, 0.f}; acc[1] = acc[0];
        const bf16* ap = A + (size_t)(n0 + l15) * 1024 + 8 * lq;
        const bf16* bp = W1T + (size_t)(16 * w + l15) * 2048 + 8 * lq;
#pragma unroll 4
        for (int ks = 0; ks < 64; ++ks) {
            const bf16x8 a0 = *(const GAS bf16x8*)(ap + 32 * ks), a1 = *(const GAS bf16x8*)(ap + 16 * 1024 + 32 * ks), b = *(const GAS bf16x8*)(bp + 32 * ks);
            acc[0] = __builtin_amdgcn_mfma_f32_16x16x32_bf16(a0, b, acc[0], 0, 0, 0);
            acc[1] = __builtin_amdgcn_mfma_f32_16x16x32_bf16(a1, b, acc[1], 0, 0, 0);
        }
        { const float bb = b1[16 * w + l15];
#pragma unroll
          for (int rb = 0; rb < 2; ++rb)
#pragma unroll
            for (int r = 0; r < 4; ++r) H2[(16 * rb + 4 * lq + r) * 136 + 16 * w + l15] = (bf16)f2bf(gelu_tanh_safe(acc[rb][r] + bb)); }
        __syncthreads();
        { const int rb = w >> 2, db = w & 3;
          pg8::f32x4 o = (pg8::f32x4){0.f, 0.f, 0.f, 0.f};
#pragma unroll
          for (int ks = 0; ks < 4; ++ks) {
              const bf16x8 a = *(const LAS bf16x8*)(H2 + (16 * rb + l15) * 136 + 32 * ks + 8 * lq);
              const bf16x8 b = *(const GAS bf16x8*)(W2T + (size_t)(16 * db + l15) * 128 + 32 * ks + 8 * lq);
              o = __builtin_amdgcn_mfma_f32_16x16x32_bf16(a, b, o, 0, 0, 0); }
#pragma unroll
          for (int r = 0; r < 4; ++r) OUTS[(16 * rb + 4 * lq + r) * 65 + 16 * db + l15] = o[r]; }
        __syncthreads();
        { const int n = F.tid >> 4, d4 = (F.tid & 15) * 4, ng = n0 + n;
          float v[4]; float ss = 0.f;
#pragma unroll
          for (int i = 0; i < 4; ++i) { v[i] = OUTS[n * 65 + d4 + i]; ss += v[i] * v[i]; }
          ss += __shfl_xor(ss, 1); ss += __shfl_xor(ss, 2); ss += __shfl_xor(ss, 4); ss += __shfl_xor(ss, 8);
          const bool pad = (ng >= NCMP);
          if (kv == 0) { const float rs = rsqrtf(ss * (1.f / 64.f) + EPS);
              v2u o; o.x = pad ? 0u : pk2(v[0] * rs * kng[d4], v[1] * rs * kng[d4 + 1]); o.y = pad ? 0u : pk2(v[2] * rs * kng[d4 + 2], v[3] * rs * kng[d4 + 3]);
              *(GAS v2u*)((bf16*)(F.ws + WS_KC) + ((size_t)bg * 256 + ng) * 64 + d4) = o; }
          else { bf16* vt = (bf16*)(F.ws + WS_VCT) + (size_t)bg * 64 * 256 + ng;
#pragma unroll
              for (int i = 0; i < 4; ++i) vt[(size_t)(d4 + i) * 256] = pad ? (bf16)0 : (bf16)f2bf(v[i]); } }
        __syncthreads();
    }
}
__device__ __forceinline__ void vtranspose_phase(Frame& F) {
    LAS bf16* T = (LAS bf16*)(F.lds + F.wave * 9216);
    const int gw = F.bid * NWAVES + F.wave, NGW = F.G * NWAVES, lane = F.lane;
    for (int job = gw; job < 2 * NBG * 64; job += NGW) {
        const int s = job & 63, bg = (job >> 6) & 15, which = job >> 10;
        const bf16* X = (const bf16*)(F.ws + (which ? WS_VW : WS_VS)) + ((size_t)bg * SEQ + 64 * s) * 64;
        bf16* XT = (bf16*)(F.ws + (which ? WS_VWT : WS_VST)) + (size_t)bg * 64 * SEQ + 64 * s;
#pragma unroll
        for (int i = 0; i < 8; ++i) { const int tok = (lane >> 3) + 8 * i, ch = lane & 7;
            const v4u x = *(const GAS v4u*)(X + (size_t)tok * 64 + 8 * ch);
            const unsigned ww[4] = {x.x, x.y, x.z, x.w};
#pragma unroll
            for (int e = 0; e < 4; ++e) { T[(8 * ch + 2 * e) * 72 + tok] = (bf16)(ww[e] & 0xffffu); T[(8 * ch + 2 * e + 1) * 72 + tok] = (bf16)(ww[e] >> 16); } }
        LDS_WAIT(); asm volatile("" ::: "memory");
#pragma unroll
        for (int i = 0; i < 8; ++i) { const int dim = (lane >> 3) + 8 * i, ch = lane & 7;
            const v4u y = *(const LAS v4u*)(T + dim * 72 + 8 * ch);
            *(GAS v4u*)(XT + (size_t)dim * SEQ + 8 * ch) = y; }
        LDS_WAIT(); asm volatile("" ::: "memory");
    }
}

constexpr int AT_KSTR = 72;
constexpr int AT_KBUF = 64 * AT_KSTR * 2;
constexpr int AT_OFF_K = 0, AT_OFF_V = 2 * AT_KBUF, AT_OFF_P = 4 * AT_KBUF;
constexpr int AT_OFF_IMP1 = AT_OFF_P + 8 * 4608, AT_OFF_IMP2 = AT_OFF_IMP1 + 64 * 65 * 4, AT_OFF_SEL = AT_OFF_IMP2 + 64 * 65 * 4;
constexpr int AT_OFF_LUT = AT_OFF_SEL + 4096, AT_OFF_LROW = AT_OFF_LUT + 4 * 128 * 4;
constexpr int AT_OFF_TD = AT_OFF_LROW + 8 * 32 * 4;
constexpr int AT_LDS_END = AT_OFF_TD + 96 * 32;
static_assert(AT_LDS_END <= RING_BYTES, "attention LDS");

struct AtTile { const bf16* k; const bf16* vt; int vstride; };
enum { TM_CMP1 = 0, TM_CMP2, TM_SELN, TM_SELF, TM_WINN, TM_WINF, TM_WINE };
__device__ __forceinline__ float fexp2(float x) { return __builtin_amdgcn_exp2f(x); }
template <int TM, int VAR>
__device__ __forceinline__ void at_tile(const LAS unsigned char* kb_, const LAS unsigned char* vb_, LAS bf16* PW, const LAS float* LUTJ, LAS float* IMP1, LAS float* IMP2,
                                        const bf16x8 (&qf)[2][2], pg8::f32x4 (&oacc)[2][4], float (&lsum)[2], float (&lpart)[2], const float (&linv)[2],
                                        const int (&tok_r)[2], const unsigned (&selb)[2], float cfar, int relbase, int idx, int l15, int lq) {
#pragma unroll
    for (int cb = 0; cb < 4; ++cb) {
        pg8::f32x4 st[2];
        st[0] = (pg8::f32x4){0.f, 0.f, 0.f, 0.f}; st[1] = st[0];
        if (!(VAR & 64)) {
#pragma unroll
        for (int ks = 0; ks < 2; ++ks) { const bf16x8 kf = *(const LAS bf16x8*)(kb_ + (16 * cb + l15) * 144 + 64 * ks + 16 * lq);
#pragma unroll
            for (int rb = 0; rb < 2; ++rb) st[rb] = __builtin_amdgcn_mfma_f32_16x16x32_bf16(kf, qf[rb][ks], st[rb], 0, 0, 0); } }
#pragma unroll
        for (int rb = 0; rb < 2; ++rb) {
            const int tokc = tok_r[rb];
            float p[4];
#pragma unroll
            for (int r = 0; r < 4; ++r) {
                const int kl = 16 * cb + 4 * lq + r;
                if (VAR & 16) { p[r] = st[rb][r] + cfar; }
                else if (TM == TM_SELF) { const float e = fexp2(st[rb][r] + cfar); p[r] = selb[rb] ? e : 0.f; }
                else if (TM == TM_WINF) { p[r] = fexp2(st[rb][r] + cfar); }
                else if (TM == TM_WINE) { const float e = fexp2(st[rb][r] + cfar); p[r] = (kl > tokc) ? e : 0.f; }
                else {
                    const int rel = (TM == TM_CMP1 || TM == TM_CMP2) ? (relbase + tokc - 16 * kl) : (relbase + tokc - kl);
                    bool valid = rel >= 0; if (TM == TM_SELN) valid = valid && (selb[rb] != 0u);
                    const int ri = rel < 0 ? 0 : (rel > 127 ? 127 : rel);
                    const float e = fexp2(st[rb][r] + LUTJ[ri]);
                    p[r] = valid ? e : 0.f; }
            }
            if (TM == TM_CMP1) { lpart[rb] += (p[0] + p[1]) + (p[2] + p[3]); }
            else {
                if (TM == TM_CMP2) {
#pragma unroll
                    for (int r = 0; r < 4; ++r) p[r] *= linv[rb];
                    float h0 = p[0], h1 = p[1], h2 = p[2], h3 = p[3];
                    h0 += __shfl_xor(h0, 1); h1 += __shfl_xor(h1, 1); h2 += __shfl_xor(h2, 1); h3 += __shfl_xor(h3, 1);
                    h0 += __shfl_xor(h0, 2); h1 += __shfl_xor(h1, 2); h2 += __shfl_xor(h2, 2); h3 += __shfl_xor(h3, 2);
                    if ((l15 & 3) == 0) { const int sp = 16 * idx + 4 * cb + lq;
                        IMP1[tokc * 65 + sp] = (h0 + h1) + (h2 + 0.5f * h3);
                        if (sp + 1 < 64) IMP2[tokc * 65 + sp + 1] = 0.5f * h3; }
                } else lsum[rb] += (p[0] + p[1]) + (p[2] + p[3]);
                v2u pk; pk.x = pg8::cvt_pk_bf16(p[0], p[1]); pk.y = pg8::cvt_pk_bf16(p[2], p[3]);
                *(LAS v2u*)(PW + (16 * rb + l15) * AT_KSTR + 16 * cb + 4 * lq) = pk; }
        }
    }
    if (TM != TM_CMP1 && !(VAR & 8)) {
        LDS_WAIT();
#pragma unroll
        for (int ks = 0; ks < 2; ++ks) {
            bf16x8 pf[2];
#pragma unroll
            for (int rb = 0; rb < 2; ++rb) pf[rb] = *(const LAS bf16x8*)(PW + (16 * rb + l15) * AT_KSTR + 32 * ks + 8 * lq);
#pragma unroll
            for (int db = 0; db < 4; ++db) { const bf16x8 vf = *(const LAS bf16x8*)(vb_ + (16 * db + l15) * 144 + 64 * ks + 16 * lq);
#pragma unroll
                for (int rb = 0; rb < 2; ++rb) oacc[rb][db] = __builtin_amdgcn_mfma_f32_16x16x32_bf16(pf[rb], vf, oacc[rb][db], 0, 0, 0); } }
    }
}

template <int VAR> __device__ __forceinline__ void attention_phase(Frame& F, const Args& args) {
    unsigned char* ws = F.ws;
    const int lane = F.lane, w = F.wave, l15 = lane & 15, lq = lane >> 4, tid = F.tid;
    LAS unsigned char* L = F.lds;
    LAS float* IMP1 = (LAS float*)(L + AT_OFF_IMP1); LAS float* IMP2 = (LAS float*)(L + AT_OFF_IMP2);
    LAS unsigned char* SEL = L + AT_OFF_SEL; LAS float* LUT = (LAS float*)(L + AT_OFF_LUT); LAS float* LROW = (LAS float*)(L + AT_OFF_LROW) + w * 32;
    LAS bf16* PW = (LAS bf16*)(L + AT_OFF_P + w * 4608); LAS int* TD = (LAS int*)(L + AT_OFF_TD);
    const float M0 = ((const float*)(ws + WS_BIASL))[8 * 128];
    const bf16* Qg = (const bf16*)(ws + WS_Q); const float* GATE = (const float*)(ws + WS_GATE); bf16* YA = (bf16*)(ws + WS_YA); float* YAF = (float*)(ws + WS_H);
    const int jq = l15 & 3;
    const LAS float* LUTJ = LUT + jq * 128;
    const int nrounds = (F.G == 256) ? 4 : (1024 + F.G - 1) / F.G;
    for (int round = 0; round < nrounds; ++round) {
        const int ui = (F.G == 256) ? ((round & 1) ? ((round >> 1) * 512 + 511 - F.bid) : ((round >> 1) * 512 + F.bid)) : (round * F.G + F.bid);
        if (ui >= 1024) break;
        const int c = 63 - (ui >> 4), bg = ui & 15, b = bg >> 1, g = bg & 1;
        const int m0 = b * SEQ + 64 * c;
        __syncthreads();
        for (int i = tid; i < 512; i += NTHREADS) LUT[i] = (((const float*)(ws + WS_BIASL))[(4 * g + (i >> 7)) * 128 + (i & 127)] - M0) * 1.4426950408889634f;
        for (int i = tid; i < 64 * 65; i += NTHREADS) { IMP1[i] = 0.f; IMP2[i] = 0.f; }
        bf16x8 qf[2][2];
#pragma unroll
        for (int rb = 0; rb < 2; ++rb)
#pragma unroll
            for (int ks = 0; ks < 2; ++ks) qf[rb][ks] = *(const GAS bf16x8*)(Qg + (size_t)(m0 + 8 * w + 4 * rb + (l15 >> 2)) * 512 + g * 256 + jq * 64 + 32 * ks + 8 * lq);
        asm volatile("" :: "v"(qf[0][0]), "v"(qf[0][1]), "v"(qf[1][0]), "v"(qf[1][1]));
        const int ncmp = 4 * c + 3, n1 = (ncmp + 63) >> 6, nsel = c + 1, w0 = c >= 8 ? c - 8 : 0, nwin = c - w0 + 1;
        const int ntiles = 2 * n1 + nsel + nwin;
        if (tid < ntiles) { const int i = tid; int kind, idx; unsigned ko, vo, vs;
            if (i < n1) { kind = 0; idx = i; } else if (i < 2 * n1) { kind = 1; idx = i - n1; } else if (i < 2 * n1 + nsel) { kind = 2; idx = i - 2 * n1; } else { kind = 3; idx = w0 + (i - 2 * n1 - nsel); }
            if (kind < 2) { ko = (unsigned)(WS_KC + ((size_t)bg * 256 * 64 + (size_t)idx * 4096) * 2); vo = (unsigned)(WS_VCT + ((size_t)bg * 64 * 256 + 64 * idx) * 2); vs = 512u; }
            else if (kind == 2) { ko = (unsigned)(WS_KS + ((size_t)bg * SEQ * 64 + (size_t)idx * 4096) * 2); vo = (unsigned)(WS_VST + ((size_t)bg * 64 * SEQ + 64 * idx) * 2); vs = 2u * SEQ; }
            else { ko = (unsigned)(WS_KW + ((size_t)bg * SEQ * 64 + (size_t)idx * 4096) * 2); vo = (unsigned)(WS_VWT + ((size_t)bg * 64 * SEQ + 64 * idx) * 2); vs = 2u * SEQ; }
            const int dd = c - idx;
            int mode, relbase;
            if (kind == 0) { mode = TM_CMP1; relbase = 64 * c - 31 - 1024 * idx; } else if (kind == 1) { mode = TM_CMP2; relbase = 64 * c - 31 - 1024 * idx; }
            else if (kind == 2) { mode = dd <= 2 ? TM_SELN : TM_SELF; relbase = 64 * dd; } else { mode = dd <= 2 ? TM_WINN : (dd == 8 ? TM_WINE : TM_WINF); relbase = 64 * dd; }
            const int endf = ((kind == 1 && idx == n1 - 1) || (kind == 2 && idx == nsel - 1) || (kind == 3 && idx == c)) ? kind : 0;
            LAS int* td = TD + 8 * i; td[0] = mode; td[1] = idx; td[2] = relbase; td[3] = endf; td[4] = (int)ko; td[5] = (int)vo; td[6] = (int)vs; td[7] = (kind == 2 && idx == 0) ? 1 : 0; }
        const int srow = tid >> 3, sch = tid & 7;
        __syncthreads();
        v4u kreg, vreg;
        { const unsigned ko = (unsigned)TD[4], vo = (unsigned)TD[5], vs = (unsigned)TD[6];
          kreg = *(const GAS v4u*)(ws + (size_t)(ko + srow * 128 + 16 * sch)); vreg = *(const GAS v4u*)(ws + (size_t)(vo + srow * vs + 16 * sch));
          *(LAS v4u*)(L + AT_OFF_K + srow * 144 + 16 * sch) = kreg; *(LAS v4u*)(L + AT_OFF_V + srow * 144 + 16 * sch) = vreg; }
        __syncthreads();
        const float cfar = LUTJ[127];
        float lpart[2] = {0.f, 0.f};
        float linv[2] = {0.f, 0.f};
        pg8::f32x4 oacc[2][4];
        float lsum[2] = {0.f, 0.f};
#pragma unroll
        for (int rb = 0; rb < 2; ++rb)
#pragma unroll
            for (int db = 0; db < 4; ++db) oacc[rb][db] = (pg8::f32x4){0.f, 0.f, 0.f, 0.f};
        const int tok_r[2] = {8 * w + (l15 >> 2), 8 * w + 4 + (l15 >> 2)};
        for (int it = 0; it < ((VAR & 32) ? 0 : ntiles); ++it) {
            const LAS int* td = TD + 8 * it;
            const int mode = __builtin_amdgcn_readfirstlane(td[0]), idx = __builtin_amdgcn_readfirstlane(td[1]), relbase = __builtin_amdgcn_readfirstlane(td[2]);
            const int endf = __builtin_amdgcn_readfirstlane(td[3]), selfirst = __builtin_amdgcn_readfirstlane(td[7]);
            const int buf = it & 1;
            if (!(VAR & 2) && it + 1 < ntiles) { const unsigned ko = (unsigned)td[12], vo = (unsigned)td[13], vs = (unsigned)td[14];
                kreg = *(const GAS v4u*)(ws + (size_t)(ko + srow * 128 + 16 * sch)); vreg = *(const GAS v4u*)(ws + (size_t)(vo + srow * vs + 16 * sch)); }
            if (selfirst) {
                { const int tok = tid >> 3, s0 = (tid & 7) * 8;
                  float my[8]; int rank[8];
#pragma unroll
                  for (int q = 0; q < 8; ++q) { const int s = s0 + q;
                      const bool vis = s <= c, forced = (s == 0) || (s == c) || (s == c - 1);
                      my[q] = vis ? (IMP1[tok * 65 + s] + IMP2[tok * 65 + s] + (forced ? 1000.f : 0.f)) : -1.f; rank[q] = 0; }
#pragma unroll
                  for (int q = 0; q < 8; ++q) IMP1[tok * 65 + s0 + q] = my[q];
                  __syncthreads();
#pragma unroll 2
                  for (int s2 = 0; s2 < 64; ++s2) { const float sc2 = IMP1[tok * 65 + s2];
#pragma unroll
                      for (int q = 0; q < 8; ++q) rank[q] += (sc2 > my[q] || (sc2 == my[q] && s2 < s0 + q)) ? 1 : 0; }
#pragma unroll
                  for (int q = 0; q < 8; ++q) SEL[tok * 64 + s0 + q] = (unsigned char)((rank[q] < 16 && (s0 + q) <= c) ? 1 : 0); }
                __syncthreads();
            }
            const LAS unsigned char* kb_ = L + AT_OFF_K + buf * AT_KBUF; const LAS unsigned char* vb_ = L + AT_OFF_V + buf * AT_KBUF;
            unsigned selb[2] = {1u, 1u};
#define AT_CALL(TMX) at_tile<TMX, VAR>(kb_, vb_, PW, LUTJ, IMP1, IMP2, qf, oacc, lsum, lpart, linv, tok_r, selb, cfar, relbase, idx, l15, lq)
            if (mode == TM_SELF || mode == TM_SELN) { selb[0] = SEL[tok_r[0] * 64 + idx]; selb[1] = SEL[tok_r[1] * 64 + idx]; }
            if (mode == TM_SELF) AT_CALL(TM_SELF);
            else if (mode == TM_WINF) AT_CALL(TM_WINF);
            else if (mode == TM_SELN) AT_CALL(TM_SELN);
            else if (mode == TM_WINN) AT_CALL(TM_WINN);
            else if (mode == TM_WINE) AT_CALL(TM_WINE);
            else if (mode == TM_CMP2) AT_CALL(TM_CMP2);
            else { if (idx == 0) { lpart[0] = 0.f; lpart[1] = 0.f; }
                AT_CALL(TM_CMP1);
                if (idx == n1 - 1) {
#pragma unroll
                    for (int rb = 0; rb < 2; ++rb) { float s = lpart[rb]; s += __shfl_xor(s, 16); s += __shfl_xor(s, 32); linv[rb] = s > 0.f ? 1.0f / s : 0.f; } } }
#undef AT_CALL
            {
                if (endf) {
                    const int br = endf - 1;
                    if (endf == 1) { LROW[l15] = 1.0f; LROW[16 + l15] = 1.0f; }
                    else {
#pragma unroll
                        for (int rb = 0; rb < 2; ++rb) { float s = lsum[rb]; s += __shfl_xor(s, 16); s += __shfl_xor(s, 32); if (lq == 0) LROW[16 * rb + l15] = s > 0.f ? 1.0f / s : 0.f; lsum[rb] = 0.f; } }
                    LDS_WAIT(); asm volatile("" ::: "memory");
                    int trow0 = m0 + 8 * w + lq;
                    asm volatile("" : "+v"(trow0));
                    const float* gp = GATE + (size_t)trow0 * 24 + g * 12 + br;
                    float* yf0 = YAF + (size_t)trow0 * 512 + g * 256 + l15;
                    bf16* ya0 = YA + (size_t)trow0 * 512 + g * 256 + l15;
#pragma unroll
                    for (int rb = 0; rb < 2; ++rb)
#pragma unroll
                        for (int r = 0; r < 4; ++r) { const int qrow = 16 * rb + 4 * lq + r;
                            const float gt = gp[rb * 96 + r * 3] * LROW[qrow];
#pragma unroll
                            for (int db = 0; db < 4; ++db) { float v = gt * oacc[rb][db][r]; oacc[rb][db][r] = 0.f;
                                const int off = rb * 2048 + r * 64 + 16 * db;
                                if (br > 0) v += yf0[off];
                                if (VAR & 1) { asm volatile("" :: "v"(v)); } else { if (br < 2) yf0[off] = v; else ya0[off] = (bf16)f2bf(v); } } }
                }
            }
            if (!(VAR & 2) && it + 1 < ntiles) { *(LAS v4u*)(L + AT_OFF_K + (buf ^ 1) * AT_KBUF + srow * 144 + 16 * sch) = kreg; *(LAS v4u*)(L + AT_OFF_V + (buf ^ 1) * AT_KBUF + srow * 144 + 16 * sch) = vreg; }
            if (!(VAR & 4)) __syncthreads();
        }
    }
}

constexpr int N_PHASES = 11;
#ifndef MK_ONE_LAUNCH
#define MK_ONE_LAUNCH 1
#endif
#ifndef REP_P0
#define REP_P0 1
#endif
#ifndef REP_P4
#define REP_P4 1
#endif
#ifndef REP_P9
#define REP_P9 1
#endif
#ifndef REP_P10
#define REP_P10 1
#endif
#ifndef MK_BUILD
#define MK_BUILD 0
#endif

__global__ void __launch_bounds__(NTHREADS, 2) fwd_kernel(Args args) {
    extern __shared__ __attribute__((aligned(16))) unsigned char lds[];
    Frame F;
    F.lds = (LAS unsigned char*)lds;
    F.MISC = (volatile LAS unsigned*)(F.lds + MISC_OFF);
    F.tid = threadIdx.x; F.lane = F.tid & 63; F.wave = __builtin_amdgcn_readfirstlane(F.tid >> 6);
    F.G = gridDim.x; F.bid = blockIdx.x; F.ws = args.ws;
    F.ctl = (gu32*)(args.ws + WS_CTL);
    for (int u = F.tid; u < (LDS_BYTES - LDSCTL_OFF) / 4; u += NTHREADS) ((LAS unsigned*)(F.lds + LDSCTL_OFF))[u] = 0u;
    __syncthreads();
    XcdBarrier bar; bar.bar = (unsigned*)(F.ctl + CW_BAR); bar.x = 0; bar.st = nullptr;
    if (MK_ONE_LAUNCH) bar = xcd_barrier_post((unsigned*)(F.ctl + CW_BAR), F.MISC + 8);
    const int lo = args.ph_lo, hi = args.ph_hi;
#define IN(k) (lo <= (k) && (k) < hi)
#define SEAM(k) do { if (IN(k) && IN((k) + 1)) xcd_barrier(bar); } while (0)
    unsigned char* ws = args.ws;
    const float* ada = (const float*)(ws + WS_ADA);

    if (IN(0)) { for (int rep = 0; rep < REP_P0; ++rep) { p0_prologue(F, args); __syncthreads(); } } SEAM(0);
    if (IN(1)) { modnorm_rows(F, args.in[I_X], args.in[I_N1G], ada, 0, (bf16*)(ws + WS_H)); } SEAM(1);
    if (IN(2)) {
        pg8::Gemm g{(const bf16*)(ws + WS_H), (const bf16*)(ws + WS_WIN_T), M, NIN, D, D, D}; pg8::StaticOrder S; S.init(M, NIN, F.G, F.bid);
        EpiIn E{ws, args.in[I_QNG], args.in[I_KNG]};
        pg8::gemm_phase<EpiIn, pg8::StaticOrder, true, true>(F.lds + RING_OFF, g, S, E);
    } SEAM(2);
    if (IN(3)) { pool_phase(F); __syncthreads(); compress_phase(F, args.in[I_KNG]); __syncthreads(); vtranspose_phase(F); } SEAM(3);
    if (IN(4)) {
#ifdef PROBE_P4
        attention_phase<PROBE_P4>(F, args); __syncthreads();
#endif
        attention_phase<0>(F, args); } SEAM(4);
    if (IN(5)) {
        { pg8::Gemm g{(const bf16*)(ws + WS_PL), (const bf16*)(ws + WS_WEFF_T), M, D, POOLW, POOLW, POOLW}; pg8::StaticOrder S; S.init(M, D, F.G, F.bid);
          EpiMix<false> E{(bf16*)(ws + WS_MIX), (const bf16*)(ws + WS_GM), 0};
          pg8::gemm_phase<EpiMix<false>, pg8::StaticOrder, true, true>(F.lds + RING_OFF, g, S, E); }
        { pg8::Gemm g{(const bf16*)(ws + WS_YA), (const bf16*)(ws + WS_WBA_T), M, D, QW, QW, QW}; pg8::StaticOrder S; S.init(M, D, F.G, F.bid);
          EpiMix<true> E{(bf16*)(ws + WS_MIX), (const bf16*)(ws + WS_GM), 1024};
          pg8::gemm_phase<EpiMix<true>, pg8::StaticOrder, true, true>(F.lds + RING_OFF, g, S, E); }
    } SEAM(5);
    if (IN(6)) {
        pg8::Gemm g{(const bf16*)(ws + WS_MIX), (const bf16*)(ws + WS_WOUT_T), M, D, D, D, D}; pg8::StaticOrder S; S.init(M, D, F.G, F.bid);
        EpiRes E{args.in[I_X], args.out, ada, 2};
        pg8::gemm_phase<EpiRes, pg8::StaticOrder, true, true>(F.lds + RING_OFF, g, S, E);
    } SEAM(6);
    if (IN(7)) { modnorm_rows(F, args.out, args.in[I_N2G], ada, 3, (bf16*)(ws + WS_H)); } SEAM(7);
    if (IN(8)) {
        pg8::Gemm g{(const bf16*)(ws + WS_H), (const bf16*)(ws + WS_WQ_T), M, PQW, D, D, D}; pg8::StaticOrder S; S.init(M, PQW, F.G, F.bid);
        EpiStoreBf16 E{(bf16*)(ws + WS_QV), PQW};
        pg8::gemm_phase<EpiStoreBf16, pg8::StaticOrder, true, true>(F.lds + RING_OFF, g, S, E);
    } SEAM(8);
    if (IN(9)) { for (int rep = 0; rep < REP_P9; ++rep) peer_select_phase(F); } SEAM(9);
    if (IN(10)) { for (int rep = 1; rep < REP_P10; ++rep) peer_gather_phase<true>(F, ada, args.out); peer_gather_phase<false>(F, ada, args.out); }
#undef IN
#undef SEAM
}

extern "C" void kernel_launch(void* const* d_in, const int* in_sizes, int n_in, void* d_out, int out_size, void* d_ws, size_t ws_size, hipStream_t stream) {
    static int grid = 0;
    if (grid == 0) {
        if (n_in != N_IN || in_sizes[0] != M * D || out_size != M * D || ws_size < WS_END) {
            fprintf(stderr, "kernel_launch: unexpected shapes: n_in %d in0 %d out %d ws %zu (need %zu)\n", n_in, n_in > 0 ? in_sizes[0] : -1, out_size, ws_size, (size_t)WS_END); grid = -1; return; }
        int dev = 0, cus = 0, per_cu = 0;
        if (hipGetDevice(&dev) != hipSuccess || hipDeviceGetAttribute(&cus, hipDeviceAttributeMultiprocessorCount, dev) != hipSuccess) { grid = -1; return; }
        if (hipFuncSetAttribute((const void*)fwd_kernel, hipFuncAttributeMaxDynamicSharedMemorySize, LDS_BYTES) != hipSuccess) { fprintf(stderr, "kernel_launch: hipFuncSetAttribute failed\n"); grid = -1; return; }
        if (hipOccupancyMaxActiveBlocksPerMultiprocessor(&per_cu, (const void*)fwd_kernel, NTHREADS, LDS_BYTES) != hipSuccess || per_cu < 1)
            fprintf(stderr, "kernel_launch: occupancy query reports %d workgroups per CU\n", per_cu);
        (void)hipGetLastError();
        grid = cus;
    }
    if (grid < 0) return;
    if (hipMemsetAsync((char*)d_ws + WS_CTL, 0, CTL_ZERO_BYTES, stream) != hipSuccess) return;
    Args a{};
    for (int i = 0; i < N_IN; ++i) a.in[i] = (const float*)d_in[i];
    a.out = (float*)d_out; a.ws = (unsigned char*)d_ws;
    if (MK_ONE_LAUNCH) {
        a.ph_lo = 0; a.ph_hi = N_PHASES; a.li = 0;
        hipLaunchKernelGGL(fwd_kernel, dim3(grid), dim3(NTHREADS), LDS_BYTES, stream, a);
    } else {
        for (int p = 0; p < N_PHASES; ++p) {
            a.ph_lo = p; a.ph_hi = p + 1; a.li = p;
            hipLaunchKernelGGL(fwd_kernel, dim3(grid), dim3(NTHREADS), LDS_BYTES, stream, a);
        }
    }
}
```

```cpp
#include <hip/hip_runtime.h>
#include <cstdio>
#include <cstdint>
namespace pg8 {
#define PG8_LAS __attribute__((address_space(3)))
typedef unsigned short bf16_t;
typedef short bf16x8 __attribute__((ext_vector_type(8)));
typedef float f32x4 __attribute__((ext_vector_type(4)));
typedef unsigned u32x4 __attribute__((ext_vector_type(4)));
constexpr int BM = 256, BK = 64, HALF = 128, HTB = HALF * BK * 2  , STAGE_BYTES = 8 * HTB, NXCD = 8, WGM = 8;

__host__ __device__ __forceinline__ int lds_byte(int r, int c) { const int st = (r >> 4) * 2 + (c >> 5), rr = r & 15, cc = c & 31, ob = rr * 64 + cc * 2; return st * 1024 + (ob ^ (((ob >> 9) & 1) << 5)); }
__host__ __device__ __forceinline__ void stage_rc(int b, int& R, int& C) { const int st = b / 1024, sb = b % 1024, swz = sb ^ (((sb >> 9) & 1) << 5); R = (st >> 1) * 16 + swz / 64; C = (st & 1) * 32 + (swz % 64) / 2; }
__host__ __device__ __forceinline__ int perm32(int rho) { const int n = rho >> 4, i = rho & 15; return 8 * (i >> 2) + 4 * n + (i & 3); }

struct Unit { int pm, pn; };
struct Gemm { const bf16_t* A; const bf16_t* Bt; int M, N, K, lda, ldb; };

struct StaticOrder {
    int nM, nN, nwg, G, c;
    __host__ __device__ void init(int M, int N, int G_, int c_) { nM = M / BM; nN = N / BM; nwg = nM * nN; G = G_; c = c_; }
    __host__ __device__ bool next(int i, Unit& u) const {
        const long L = (long)i * G + c; if (L >= nwg) return false;
        int wgid = (int)L; { const int q = nwg / NXCD, r = nwg % NXCD, xcd = wgid % NXCD, off = wgid / NXCD; wgid = (xcd < r ? xcd * (q + 1) : r * (q + 1) + (xcd - r) * q) + off; }
        const int nig = WGM * nN, gid = wgid / nig, fm = gid * WGM, gsz = (nM - fm) < WGM ? (nM - fm) : WGM;
        u.pm = fm + ((wgid % nig) % gsz); u.pn = (wgid % nig) / gsz; return true;
    }
    __device__ __forceinline__ void a_ready(const Unit&) const {}
    __device__ __forceinline__ void done(const Unit&) const {}
};

__device__ __forceinline__ unsigned cvt_pk_bf16(float lo, float hi) { unsigned r; asm volatile("v_cvt_pk_bf16_f32 %0, %1, %2" : "=v"(r) : "v"(lo), "v"(hi)); return r; }
template <class Epi, class Sched, bool ALIGN_EPI = false, bool SP2 = false>
__device__ __forceinline__ void gemm_phase(PG8_LAS unsigned char* lds, const Gemm g, const Sched& S, const Epi& E) {
    const int tid = threadIdx.x, wid = __builtin_amdgcn_readfirstlane(tid >> 6), lane = tid & 63, wr = wid >> 2, wc = wid & 3, fr = lane & 15, fq = lane >> 4;
    const int K = g.K, nt = K / BK;
    unsigned voffA[2], voffB[2];
#pragma unroll
    for (int i = 0; i < 2; ++i) { int R, C; stage_rc(tid * 16 + i * 8192, R, C); const int Rb = Epi::PERM ? ((R & ~31) + perm32(R & 31)) : R;
        voffA[i] = (unsigned)(R * g.lda + C) * 2u; voffB[i] = (unsigned)(Rb * g.ldb + C) * 2u; }
    const size_t kstep = (size_t)(BK * 2);
    const size_t hstepA = (size_t)HALF * g.lda * 2, hstepB = (size_t)HALF * g.ldb * 2;
    const size_t tstepA = 2 * hstepA, tstepB = 2 * hstepB;
    const unsigned ldsw = (unsigned)wid * 1024u;
    const int aoff = lds_byte(wr * 64 + fr, fq * 8), boff = lds_byte(wc * 32 + fr, fq * 8);
#define PG8_SA(b, h) (((b) * 2 + (h)) * HTB)
#define PG8_SB(b, h) ((4 + (b) * 2 + (h)) * HTB)
#define PG8_STAGE(bufoff, gbase, voff) do { _Pragma("unroll") for (int _i = 0; _i < 2; ++_i) \
        __builtin_amdgcn_global_load_lds((const unsigned*)((const char*)(gbase) + (voff)[_i]), (PG8_LAS unsigned*)(lds + (bufoff) + ldsw + _i * 8192), 16, 0, 0); } while (0)
#define PG8_LDA(dst, b, h) do { _Pragma("unroll") for (int m = 0; m < 4; ++m) _Pragma("unroll") for (int k = 0; k < 2; ++k) dst[m][k] = *(const PG8_LAS bf16x8*)(lds + PG8_SA(b, h) + aoff + m * 2048 + k * 1024); } while (0)
#define PG8_LDB(dst, b, h) do { _Pragma("unroll") for (int n = 0; n < 2; ++n) _Pragma("unroll") for (int k = 0; k < 2; ++k) dst[n][k] = *(const PG8_LAS bf16x8*)(lds + PG8_SB(b, h) + boff + n * 2048 + k * 1024); } while (0)
#define PG8_MMA(ai, bj, At, Bt) do { __builtin_amdgcn_s_setprio(1); _Pragma("unroll") for (int m = 0; m < 4; ++m) _Pragma("unroll") for (int n = 0; n < 2; ++n) _Pragma("unroll") for (int k = 0; k < 2; ++k) \
        acc[ai][bj][m][n] = __builtin_amdgcn_mfma_f32_16x16x32_bf16(Bt[n][k], At[m][k], acc[ai][bj][m][n], 0, 0, 0); __builtin_amdgcn_s_setprio(0); } while (0)
#define PG8_WAIT_V(n) asm volatile("s_waitcnt vmcnt(" #n ")" ::: "memory")
#define PG8_WAIT_L(n) asm volatile("s_waitcnt lgkmcnt(" #n ")" ::: "memory")
#define PG8_BAR __builtin_amdgcn_s_barrier()
#define PG8_SCHED __builtin_amdgcn_sched_barrier(0)
    Unit cur, nxt; int ui = 0;
    if (!S.next(0, cur)) return;
    f32x4 acc[2][2][4][2];
#pragma unroll
    for (int a = 0; a < 2; ++a)
#pragma unroll
        for (int b = 0; b < 2; ++b)
#pragma unroll
            for (int m = 0; m < 4; ++m)
#pragma unroll
                for (int n = 0; n < 2; ++n) acc[a][b][m][n] = (f32x4){0.f, 0.f, 0.f, 0.f};
    bf16x8 At[4][2], B0[2][2], B1[2][2];
    const char* cA = (const char*)g.A + (size_t)cur.pm * tstepA; const char* cB = (const char*)g.Bt + (size_t)cur.pn * tstepB;
    S.a_ready(cur);
    if constexpr (SP2) {
        PG8_STAGE(PG8_SB(0, 0), cB, voffB); PG8_STAGE(PG8_SB(0, 1), cB + hstepB, voffB); PG8_STAGE(PG8_SA(0, 0), cA, voffA); PG8_STAGE(PG8_SA(0, 1), cA + hstepA, voffA);
        if (wr == 1) PG8_BAR;
        PG8_WAIT_V(2); PG8_BAR;
        PG8_STAGE(PG8_SB(1, 0), cB + kstep, voffB); PG8_STAGE(PG8_SA(1, 0), cA + kstep, voffA); PG8_STAGE(PG8_SB(1, 1), cB + hstepB + kstep, voffB);
        PG8_WAIT_V(6); PG8_BAR;
    } else {
        PG8_STAGE(PG8_SB(0, 0), cB, voffB); PG8_STAGE(PG8_SA(0, 0), cA, voffA); PG8_STAGE(PG8_SB(0, 1), cB + hstepB, voffB); PG8_STAGE(PG8_SA(0, 1), cA + hstepA, voffA);
        if (wr == 1) PG8_BAR;
        PG8_WAIT_V(4); PG8_BAR;
        PG8_STAGE(PG8_SB(1, 0), cB + kstep, voffB); PG8_STAGE(PG8_SA(1, 0), cA + kstep, voffA); PG8_STAGE(PG8_SB(1, 1), cB + hstepB + kstep, voffB);
        PG8_WAIT_V(6); PG8_BAR;
    }
    for (;;) {
        const bool has_next = S.next(ui + 1, nxt);
        const char* nA = has_next ? (const char*)g.A + (size_t)nxt.pm * tstepA : cA; const char* nB = has_next ? (const char*)g.Bt + (size_t)nxt.pn * tstepB : cB;
        for (int t = 0; t < nt; t += 2) {
            const bool last = (t == nt - 2);
            const char* a1 = cA + (size_t)(t + 1) * kstep;
            const char* a2 = last ? nA : cA + (size_t)(t + 2) * kstep; const char* b2 = last ? nB : cB + (size_t)(t + 2) * kstep;
            const char* a3 = a2 + kstep; const char* b3 = b2 + kstep;
            if (last && has_next) S.a_ready(nxt);
            if constexpr (SP2) {
            PG8_LDB(B0, 0, 0); PG8_LDB(B1, 0, 1); PG8_SCHED; PG8_LDA(At, 0, 0); PG8_STAGE(PG8_SA(1, 1), a1 + hstepA, voffA);
            PG8_WAIT_V(8); PG8_WAIT_L(0); PG8_BAR; PG8_MMA(0, 0, At, B0); PG8_MMA(0, 1, At, B1); PG8_BAR; PG8_SCHED;
            PG8_LDA(At, 0, 1); PG8_STAGE(PG8_SB(0, 0), b2, voffB); PG8_STAGE(PG8_SB(0, 1), b2 + hstepB, voffB); PG8_STAGE(PG8_SA(0, 0), a2, voffA);
            PG8_WAIT_V(8); PG8_WAIT_L(0); PG8_BAR; PG8_MMA(1, 0, At, B0); PG8_MMA(1, 1, At, B1); PG8_BAR; PG8_SCHED;
            PG8_LDB(B0, 1, 0); PG8_LDB(B1, 1, 1); PG8_SCHED; PG8_LDA(At, 1, 0); PG8_STAGE(PG8_SA(0, 1), a2 + hstepA, voffA);
            PG8_WAIT_V(8); PG8_WAIT_L(0); PG8_BAR; PG8_MMA(0, 0, At, B0); PG8_MMA(0, 1, At, B1); PG8_BAR; PG8_SCHED;
            PG8_LDA(At, 1, 1); PG8_STAGE(PG8_SB(1, 0), b3, voffB); PG8_STAGE(PG8_SB(1, 1), b3 + hstepB, voffB); PG8_STAGE(PG8_SA(1, 0), a3, voffA);
            PG8_WAIT_V(8); PG8_WAIT_L(0); PG8_BAR; PG8_MMA(1, 0, At, B0); PG8_MMA(1, 1, At, B1); PG8_BAR; PG8_SCHED;
            } else {
            PG8_LDB(B0, 0, 0); PG8_SCHED; PG8_LDA(At, 0, 0); PG8_STAGE(PG8_SA(1, 1), a1 + hstepA, voffA);
            PG8_WAIT_L(8); PG8_BAR; PG8_WAIT_L(0); PG8_MMA(0, 0, At, B0); PG8_BAR; PG8_SCHED;
            PG8_LDB(B1, 0, 1); PG8_STAGE(PG8_SB(0, 0), b2, voffB);
            PG8_BAR; PG8_WAIT_L(0); PG8_MMA(0, 1, At, B1); PG8_BAR;
            PG8_LDA(At, 0, 1); PG8_STAGE(PG8_SA(0, 0), a2, voffA);
            PG8_BAR; PG8_WAIT_L(0); PG8_MMA(1, 0, At, B0); PG8_BAR; PG8_SCHED;
            PG8_STAGE(PG8_SB(0, 1), b2 + hstepB, voffB);
            PG8_WAIT_V(6); PG8_BAR; PG8_MMA(1, 1, At, B1); PG8_BAR;
            PG8_LDB(B0, 1, 0); PG8_SCHED; PG8_LDA(At, 1, 0); PG8_STAGE(PG8_SA(0, 1), a2 + hstepA, voffA);
            PG8_WAIT_L(8); PG8_BAR; PG8_WAIT_L(0); PG8_MMA(0, 0, At, B0); PG8_BAR; PG8_SCHED;
            PG8_LDB(B1, 1, 1); PG8_STAGE(PG8_SB(1, 0), b3, voffB);
            PG8_BAR; PG8_WAIT_L(0); PG8_MMA(0, 1, At, B1); PG8_BAR;
            PG8_LDA(At, 1, 1); PG8_STAGE(PG8_SA(1, 0), a3, voffA);
            PG8_BAR; PG8_WAIT_L(0); PG8_MMA(1, 0, At, B0); PG8_BAR; PG8_SCHED;
            PG8_STAGE(PG8_SB(1, 1), b3 + hstepB, voffB);
            PG8_WAIT_V(6); PG8_BAR; PG8_MMA(1, 1, At, B1); PG8_BAR;
            }
        }
        if constexpr (ALIGN_EPI) { if (wr == 0) PG8_BAR; }
        if constexpr (!Epi::AFTER_DRAIN) { E(acc, cur, wr, wc, fr, fq); S.done(cur); }
        if (!has_next) break;
#pragma unroll
        for (int a = 0; a < 2; ++a)
#pragma unroll
            for (int b = 0; b < 2; ++b)
#pragma unroll
                for (int m = 0; m < 4; ++m)
#pragma unroll
                    for (int n = 0; n < 2; ++n) acc[a][b][m][n] = (f32x4){0.f, 0.f, 0.f, 0.f};
        cur = nxt; cA = nA; cB = nB; ++ui;
        if constexpr (ALIGN_EPI) { if (wr == 1) PG8_BAR; }
    }
    PG8_WAIT_V(0);
    if constexpr (!ALIGN_EPI) { if (wr == 0) PG8_BAR; }
    PG8_BAR;
    if constexpr (Epi::AFTER_DRAIN) { E.fused(acc, cur, wr, wc, fr, fq, lds, wid, lane); S.done(cur); }
#undef PG8_SA
#undef PG8_SB
#undef PG8_STAGE
#undef PG8_LDA
#undef PG8_LDB
#undef PG8_MMA
#undef PG8_WAIT_V
#undef PG8_WAIT_L
#undef PG8_BAR
#undef PG8_SCHED
}
}

constexpr int NWAVES = 8, NTHREADS = NWAVES * 64;
constexpr int BATCH = 8, SEQ = 4096, D = 1024, M = BATCH * SEQ;
constexpr int POOLW = 512, QW = 512, NG = 2, HD = 64, NBG = BATCH * NG;
constexpr int IN_COLS = 3864, NIN = 4096;
constexpr int NCMP = 255, NCMP_PAD = 256, NSEL = 64;
constexpr int PH = 8, PK = 128, PTOP = 16, PQD = 256, PQW = PH * PQD;
constexpr int NEXP = PK * PK;
constexpr float EPS = 1e-6f;
enum { I_X = 0, I_C, I_RELB, I_ADAW, I_ADAB, I_N1G, I_N2G, I_WIN, I_POOLW, I_POOLS, I_CPEK, I_CW1K, I_CW2K, I_CPEV, I_CW1V, I_CW2V, I_QNG, I_KNG, I_WBP, I_WBA, I_WOUT, I_PWQ, I_PSK, I_PU, I_PV, N_IN };

constexpr size_t MiB = 1u << 20, KiB = 1u << 10;
constexpr size_t WS_CTL = 0, CTL_ZERO_BYTES = 1 * MiB;
constexpr size_t WS_ADA = 1 * MiB;
constexpr size_t WS_CB1K = 64 * KiB;
constexpr size_t WS_CB1V = WS_CB1K + 1 * KiB;
constexpr size_t WS_BIASL = WS_ADA + 256 * KiB;
constexpr size_t WS_WIN_T = 2 * MiB;
constexpr size_t WS_WEFF_T = 10 * MiB;
constexpr size_t WS_WBA_T = 11 * MiB;
constexpr size_t WS_WOUT_T = 12 * MiB;
constexpr size_t WS_WQ_T = 14 * MiB;
constexpr size_t WS_SUBK = 18 * MiB;
constexpr size_t WS_CW1K_T = 18 * MiB + 512 * KiB;
constexpr size_t WS_CW1V_T = 19 * MiB;
constexpr size_t WS_CW2K_T = 19 * MiB + 512 * KiB;
constexpr size_t WS_CW2V_T = WS_CW2K_T + 64 * KiB;
constexpr size_t WS_KC = 20 * MiB;
constexpr size_t WS_VCT = 20 * MiB + 512 * KiB;
constexpr size_t WS_GATE = 21 * MiB;
constexpr size_t WS_UB = 24 * MiB;
constexpr size_t WS_VB = 56 * MiB;
constexpr size_t WS_SCLU = WS_UB + 16 * MiB, WS_SCLV = WS_SCLU + 64 * KiB;
constexpr size_t WS_H = 88 * MiB;
constexpr size_t WS_ZP = 152 * MiB;
constexpr size_t WS_Q = 184 * MiB;
constexpr size_t WS_KCR = 216 * MiB;
constexpr size_t WS_VCR = 225 * MiB;
constexpr size_t WS_KS = 234 * MiB, WS_VS = 242 * MiB, WS_KW = 250 * MiB, WS_VW = 258 * MiB;
constexpr size_t WS_VST = 266 * MiB, WS_VWT = 274 * MiB;
constexpr size_t WS_PL = 282 * MiB;
constexpr size_t WS_YA = 314 * MiB;
constexpr size_t WS_GM = 346 * MiB;
constexpr size_t WS_MIX = WS_ZP;
constexpr size_t WS_QV = WS_GM;
constexpr size_t WS_EID = WS_PL;
constexpr size_t WS_GW = WS_PL + 16 * MiB;
constexpr size_t WS_PART = WS_GM;
constexpr size_t WS_CF = WS_YA;
constexpr size_t WS_H8 = WS_ZP;
constexpr size_t WS_HS = WS_ZP + 32 * MiB;
constexpr size_t WS_END = 474 * MiB;
constexpr int CW_TMO = 0, CW_CODE = 1, CW_BAR = 4096;

constexpr int RING_OFF = 0, RING_BYTES = 131072;
constexpr int LDSCTL_OFF = RING_BYTES, MISC_OFF = LDSCTL_OFF + 320;
constexpr int LDS_BYTES = 147456;

#define GAS __attribute__((address_space(1)))
#define LAS __attribute__((address_space(3)))
typedef unsigned short bf16;
typedef unsigned v4u __attribute__((ext_vector_type(4)));
typedef unsigned v2u __attribute__((ext_vector_type(2)));
typedef float f32x4 __attribute__((ext_vector_type(4)));
typedef short bf16x8 __attribute__((ext_vector_type(8)));
typedef GAS unsigned gu32;
#define RLX_AGENT __ATOMIC_RELAXED, __HIP_MEMORY_SCOPE_AGENT
#define LDS_WAIT() asm volatile("s_waitcnt lgkmcnt(0)" ::: "memory")
#define VM_WAIT() asm volatile("s_waitcnt vmcnt(0)" ::: "memory")
__device__ __forceinline__ unsigned f2bf(float f) { unsigned u = __builtin_bit_cast(unsigned, f); return (u + 0x7fffu + ((u >> 16) & 1u)) >> 16; }
__device__ __forceinline__ unsigned pk2(float lo, float hi) { return f2bf(lo) | (f2bf(hi) << 16); }
__device__ __forceinline__ float bflo(unsigned w) { return __builtin_bit_cast(float, w << 16); }
__device__ __forceinline__ float bfhi(unsigned w) { return __builtin_bit_cast(float, w & 0xffff0000u); }
__device__ __forceinline__ float sigmoidf_(float v) { return 1.0f / (1.0f + __expf(-v)); }
__device__ __forceinline__ float gelu_tanh_safe(float v) { const float u = 0.7978845608028654f * (v + 0.044715f * v * v * v); return 0.5f * v * (1.0f + tanhf(u)); }
__device__ __forceinline__ float wave_sum(float v) {
#pragma unroll
    for (int o = 1; o < 64; o <<= 1) v += __shfl_xor(v, o);
    return v;
}

#define XB_TMO      128
#define XB_XCNT(j)  (256  + 64 * (j))
#define XB_XSUB(j)  (1280 + 64 * (j))
#define XB_XGEN(j)  (2304 + 64 * (j))
#define XB_TOP      3328
#define XB_TOPGEN   3392
#define XCD_BAR_WORDS 3456
#define XB_SPIN_CAP (1u << 18)
__device__ __forceinline__ unsigned xb_ld(unsigned* p)              { return __hip_atomic_load(p, __ATOMIC_RELAXED, __HIP_MEMORY_SCOPE_AGENT); }
__device__ __forceinline__ unsigned xb_add(unsigned* p, unsigned v) { return __hip_atomic_fetch_add(p, v, __ATOMIC_RELAXED, __HIP_MEMORY_SCOPE_AGENT); }
__device__ __forceinline__ unsigned xb_xcc_id() { return (unsigned)__builtin_amdgcn_s_getreg((3 << 11) | 20) & 0xFu; }
#define XB_SPIN(cond, bar) do { unsigned _sp = 0; while (cond) { __builtin_amdgcn_s_sleep(1); \
    if ((++_sp & 255u) == 0u) { if (xb_ld(&(bar)[XB_TMO])) break; if (_sp > XB_SPIN_CAP) { atomicAdd(&(bar)[XB_TMO], 1u); break; } } } } while (0)
struct XcdBarrier { unsigned* bar; unsigned x; volatile LAS unsigned* st; };
__device__ __forceinline__ XcdBarrier xcd_barrier_post(unsigned* bar, volatile LAS unsigned* st) {
    XcdBarrier b; b.bar = bar; b.x = xb_xcc_id(); b.st = st;
    if (threadIdx.x == 0) (void)xb_add(&bar[XB_XCNT(b.x)], 1u);
    return b;
}
__device__ __forceinline__ void xcd_barrier_complete(unsigned* bar, unsigned x, unsigned& nloc, unsigned& nx) {
    const unsigned G = gridDim.x * gridDim.y * gridDim.z;
    unsigned sum, cnt, mine, sp = 0u;
    for (;;) {
        sum = 0u; cnt = 0u; mine = 0u;
#pragma unroll
        for (unsigned j = 0; j < 16; ++j) { const unsigned c = xb_ld(&bar[XB_XCNT(j)]); sum += c; cnt += (c > 0u) ? 1u : 0u; mine = (j == x) ? c : mine; }
        if (sum == G) break;
        __builtin_amdgcn_s_sleep(1);
        if ((++sp & 255u) == 0u) { if (xb_ld(&bar[XB_TMO])) break; if (sp > XB_SPIN_CAP) { atomicAdd(&bar[XB_TMO], 1u); break; } }
    }
    nloc = mine > 0u ? mine : 1u; nx = cnt > 0u ? cnt : 1u;
}
__device__ __forceinline__ void xcd_barrier(const XcdBarrier& b) {
    asm volatile("s_waitcnt vmcnt(0)" ::: "memory");
    __syncthreads();
    if (threadIdx.x == 0) {
        unsigned* bar = b.bar;
        __builtin_amdgcn_s_waitcnt(0);
        unsigned nloc = b.st[0], nx = b.st[1];
        if (nloc == 0u) { xcd_barrier_complete(bar, b.x, nloc, nx); b.st[0] = nloc; b.st[1] = nx; }
        const unsigned old = xb_add(&bar[XB_XSUB(b.x)], 1u);
        const unsigned gen = old / nloc;
        if (old + 1u == (gen + 1u) * nloc) {
            __builtin_amdgcn_fence(__ATOMIC_RELEASE, "agent");
            asm volatile("s_waitcnt vmcnt(0)" ::: "memory");
            const unsigned og = xb_add(&bar[XB_TOP], 1u);
            const unsigned tg = og / nx;
            if (og + 1u == (tg + 1u) * nx) xb_add(&bar[XB_TOPGEN], 1u);
            else XB_SPIN(xb_ld(&bar[XB_TOPGEN]) == tg, bar);
            __builtin_amdgcn_fence(__ATOMIC_ACQUIRE, "agent");
            xb_add(&bar[XB_XGEN(b.x)], 1u);
            asm volatile("s_waitcnt vmcnt(0)" ::: "memory");
        } else {
            XB_SPIN(xb_ld(&bar[XB_XGEN(b.x)]) == gen, bar);
            __builtin_amdgcn_fence(__ATOMIC_ACQUIRE, "agent");
            asm volatile("s_waitcnt vmcnt(0)" ::: "memory");
        }
    }
    __syncthreads();
}

struct Args { const float* in[N_IN]; float* out; unsigned char* ws; int ph_lo, ph_hi, li, pad; };
struct Frame {
    LAS unsigned char* lds;
    volatile LAS unsigned* MISC;
    gu32* ctl;
    int tid, lane, wave, G, bid;
    unsigned char* ws;
};

__device__ __forceinline__ void cvt_rows_i8(const float* src, unsigned char* dst, float* inv_scale, int gw, int NGW, int lane) {
    for (int row = gw; row < NEXP; row += NGW) {
        const float* r = src + (size_t)row * D + 16 * lane;
        f32x4 v[4]; float m = 0.f;
#pragma unroll
        for (int j = 0; j < 4; ++j) { v[j] = *(const GAS f32x4*)(r + 4 * j); m = fmaxf(m, fmaxf(fmaxf(fabsf(v[j].x), fabsf(v[j].y)), fmaxf(fabsf(v[j].z), fabsf(v[j].w)))); }
#pragma unroll
        for (int o = 1; o < 64; o <<= 1) m = fmaxf(m, __shfl_xor(m, o));
        const float sc = m > 0.f ? 127.0f / m : 0.f;
        unsigned ww[4];
#pragma unroll
        for (int j = 0; j < 4; ++j) { const int q0 = (int)rintf(v[j].x * sc), q1 = (int)rintf(v[j].y * sc), q2 = (int)rintf(v[j].z * sc), q3 = (int)rintf(v[j].w * sc);
            ww[j] = ((unsigned)q0 & 0xffu) | (((unsigned)q1 & 0xffu) << 8) | (((unsigned)q2 & 0xffu) << 16) | (((unsigned)q3 & 0xffu) << 24); }
        *(GAS v4u*)(dst + (size_t)(lane >> 3) * NEXP * 128 + (size_t)row * 128 + 16 * (lane & 7)) = (v4u){ww[0], ww[1], ww[2], ww[3]};
        if (lane == 0) inv_scale[row] = m * (1.0f / 127.0f);
    }
}
__device__ __forceinline__ void cvt_rows_fp8(const float* src, unsigned char* dst, float* inv_scale, int gw, int NGW, int lane) {
    for (int row = gw; row < NEXP; row += NGW) {
        const float* r = src + (size_t)row * D + 16 * lane;
        f32x4 v[4]; float m = 0.f;
#pragma unroll
        for (int j = 0; j < 4; ++j) { v[j] = *(const GAS f32x4*)(r + 4 * j); m = fmaxf(m, fmaxf(fmaxf(fabsf(v[j].x), fabsf(v[j].y)), fmaxf(fabsf(v[j].z), fabsf(v[j].w)))); }
#pragma unroll
        for (int o = 1; o < 64; o <<= 1) m = fmaxf(m, __shfl_xor(m, o));
        const unsigned E = (__builtin_bit_cast(unsigned, m) >> 23) & 0xffu;
        float sc = 1.f, isc = 1.f;
        if (E >= 8u && E <= 250u) { sc = __builtin_bit_cast(float, (261u - E) << 23); isc = __builtin_bit_cast(float, (E - 7u) << 23); }
        v4u w; unsigned ww[4];
#pragma unroll
        for (int j = 0; j < 4; ++j) { int t = __builtin_amdgcn_cvt_pk_fp8_f32(v[j].x * sc, v[j].y * sc, 0, false); t = __builtin_amdgcn_cvt_pk_fp8_f32(v[j].z * sc, v[j].w * sc, t, true); ww[j] = (unsigned)t; }
        w.x = ww[0]; w.y = ww[1]; w.z = ww[2]; w.w = ww[3];
        *(GAS v4u*)(dst + (size_t)(lane >> 3) * NEXP * 128 + (size_t)row * 128 + 16 * (lane & 7)) = w;
        if (lane == 0) inv_scale[row] = isc;
    }
}

__device__ __forceinline__ void p0_transpose_item(const float* W, int ldw, int src_col0, int valid, int K, bf16* WT, int dst_row0, int k0, LAS float* scr, int lane) {
    const int n_ = lane & 31;
#pragma unroll 8
    for (int i = 0; i < 32; ++i) { const int kk = 2 * i + (lane >> 5); scr[kk * 33 + n_] = (n_ < valid) ? W[(size_t)(k0 + kk) * ldw + src_col0 + n_] : 0.f; }
    LDS_WAIT(); asm volatile("" ::: "memory");
    const int c = lane & 7;
#pragma unroll
    for (int j = 0; j < 4; ++j) { const int n = (lane >> 3) + 8 * j; const LAS float* s = scr + (8 * c) * 33 + n;
        v4u o; o.x = pk2(s[0 * 33], s[1 * 33]); o.y = pk2(s[2 * 33], s[3 * 33]); o.z = pk2(s[4 * 33], s[5 * 33]); o.w = pk2(s[6 * 33], s[7 * 33]);
        *(GAS v4u*)(WT + (size_t)(dst_row0 + n) * K + k0 + 8 * c) = o; }
    LDS_WAIT(); asm volatile("" ::: "memory");
}
__device__ __forceinline__ bool p0_mat(int& r, const float* W, int K, int N, bf16* WT, LAS float* scr, int lane) {
    const int ng = N / 32, items = ng * (K / 64);
    if (r < items) { const int kb = r / ng, nb = r % ng; p0_transpose_item(W, N, 32 * nb, 32, K, WT, 32 * nb, 64 * kb, scr, lane); return true; }
    r -= items; return false;
}
__device__ __forceinline__ void cvt_f32_bf16_stream(const float* src, bf16* dst, size_t n8, size_t gtid, size_t gthreads) {
    for (size_t i = gtid; i < n8; i += gthreads) {
        const f32x4 a = *(const GAS f32x4*)(src + 8 * i), b = *(const GAS f32x4*)(src + 8 * i + 4);
        v4u o; o.x = pk2(a.x, a.y); o.y = pk2(a.z, a.w); o.z = pk2(b.x, b.y); o.w = pk2(b.z, b.w);
        *(GAS v4u*)(dst + 8 * i) = o; }
}

__device__ __forceinline__ void p0_prologue(Frame& F, const Args& args) {
    unsigned char* ws = F.ws;
    const int gw = F.bid * NWAVES + F.wave, NGW = F.G * NWAVES;
    const size_t gtid = (size_t)F.bid * NTHREADS + F.tid, gthreads = (size_t)F.G * NTHREADS;
    {
        LAS float* sl = (LAS float*)(F.lds);
        LAS float* red = (LAS float*)(F.lds + 32768);
        const float* c = args.in[I_C];
        for (int i = F.tid; i < BATCH * D; i += NTHREADS) { const float v = c[i]; sl[i] = v / (1.0f + __expf(-v)); }
        __syncthreads();
        for (int cb = F.bid; cb < 6 * D / 24; cb += F.G) {
            const int j0 = cb * 24;
            if (F.tid < 504) {
                const int kk = F.tid / 24, jj = F.tid % 24;
                float a[BATCH];
#pragma unroll
                for (int b = 0; b < BATCH; ++b) a[b] = 0.f;
                const float* w = args.in[I_ADAW] + j0 + jj;
                for (int k = kk; k < D; k += 21) { const float wv = w[(size_t)k * (6 * D)];
#pragma unroll
                    for (int b = 0; b < BATCH; ++b) a[b] += sl[b * D + k] * wv; }
#pragma unroll
                for (int b = 0; b < BATCH; ++b) red[(kk * 24 + jj) * BATCH + b] = a[b];
            }
            __syncthreads();
            if (F.tid < 24 * BATCH) { const int jj = F.tid / BATCH, b = F.tid % BATCH; float s = 0.f;
                for (int kk = 0; kk < 21; ++kk) s += red[(kk * 24 + jj) * BATCH + b];
                ((float*)(ws + WS_ADA))[b * (6 * D) + j0 + jj] = s + args.in[I_ADAB][j0 + jj]; }
            __syncthreads();
        }
    }
    if (F.bid >= 8 && F.bid < 40) {
        const int bb = F.bid - 8, kv = bb & 1, ch = bb >> 1;
        const float* pe = args.in[kv == 0 ? I_CPEK : I_CPEV]; const float* w1 = args.in[kv == 0 ? I_CW1K : I_CW1V];
        LAS float* red = (LAS float*)(F.lds);
        const int j = F.tid & 127, ic = F.tid >> 7; float s = 0.f;
        const int i0 = ch * 128 + ic * 32;
#pragma unroll 8
        for (int i = i0; i < i0 + 32; ++i) s += pe[i] * w1[(size_t)i * 128 + j];
        red[ic * 128 + j] = s; __syncthreads();
        if (F.tid < 128) atomicAdd((float*)(ws + (kv == 0 ? WS_CB1K : WS_CB1V)) + F.tid, (red[F.tid] + red[128 + F.tid]) + (red[256 + F.tid] + red[384 + F.tid]));
        __syncthreads();
    } else if (F.bid == 2) {
        for (int i = F.tid; i < 8 * 128; i += NTHREADS) { const int h = i >> 7, rel = i & 127;
            int bk = rel;
            if (rel >= 16) bk = 16 + (rel >= 19) + (rel >= 21) + (rel >= 24) + (rel >= 27) + (rel >= 31) + (rel >= 35) + (rel >= 40) + (rel >= 46) + (rel >= 52) + (rel >= 59) + (rel >= 67) + (rel >= 77) + (rel >= 87) + (rel >= 99) + (rel >= 113);
            ((float*)(ws + WS_BIASL))[i] = args.in[I_RELB][bk * 8 + h]; }
        if (F.tid < 64) {
            float mq = fabsf(args.in[I_QNG][F.tid]), mk = fmaxf(fmaxf(fabsf(args.in[I_KNG][F.tid]), fabsf(args.in[I_KNG][64 + F.tid])), fabsf(args.in[I_KNG][128 + F.tid]));
            float mb = fmaxf(fmaxf(fabsf(args.in[I_RELB][F.tid]), fabsf(args.in[I_RELB][64 + F.tid])), fmaxf(fabsf(args.in[I_RELB][128 + F.tid]), fabsf(args.in[I_RELB][192 + F.tid])));
#pragma unroll
            for (int o = 1; o < 64; o <<= 1) { mq = fmaxf(mq, __shfl_xor(mq, o)); mk = fmaxf(mk, __shfl_xor(mk, o)); mb = fmaxf(mb, __shfl_xor(mb, o)); }
            if (F.tid == 0) ((float*)(ws + WS_BIASL))[8 * 128] = 8.0f * mq * mk + mb; }
    }
    {
        LAS float* scr = (LAS float*)(F.lds + F.wave * 16384);
        constexpr int I_WINT = (NIN / 32) * (D / 64);
        constexpr int NITEMS = I_WINT + (1024 / 32) * (512 / 64) + (1024 / 32) * (1024 / 64) + (2048 / 32) * (1024 / 64) + 2 * (128 / 32) * (2048 / 64) + 2 * (64 / 32) * (128 / 64);
        for (int it = gw; it < NITEMS; it += NGW) {
            int r = it;
            if (r < I_WINT) {
                const int grp = r % (NIN / 32), kb = r / (NIN / 32);
                const int tile = grp >> 3, ct0 = (grp & 7) * 32;
                const int L0 = 64 * ((ct0 >> 5) & 3) + 32 * (ct0 >> 7);
                int src0, valid = 32;
                if (tile < 7) src0 = 256 * tile + L0; else if (tile < 15) src0 = 1816 + 256 * (tile - 7) + L0; else { src0 = 1792 + L0; valid = (L0 == 0) ? 24 : 0; }
                if (valid == 0) src0 = 0;
                p0_transpose_item(args.in[I_WIN], IN_COLS, src0, valid, D, (bf16*)(ws + WS_WIN_T), 32 * grp, 64 * kb, scr, F.lane);
                continue; }
            r -= I_WINT;
            if (p0_mat(r, args.in[I_WBA], 512, 1024, (bf16*)(ws + WS_WBA_T), scr, F.lane)) continue;
            if (p0_mat(r, args.in[I_WOUT], 1024, 1024, (bf16*)(ws + WS_WOUT_T), scr, F.lane)) continue;
            if (p0_mat(r, args.in[I_PWQ], 1024, 2048, (bf16*)(ws + WS_WQ_T), scr, F.lane)) continue;
            if (p0_mat(r, args.in[I_CW1K], 2048, 128, (bf16*)(ws + WS_CW1K_T), scr, F.lane)) continue;
            if (p0_mat(r, args.in[I_CW1V], 2048, 128, (bf16*)(ws + WS_CW1V_T), scr, F.lane)) continue;
            if (p0_mat(r, args.in[I_CW2K], 128, 64, (bf16*)(ws + WS_CW2K_T), scr, F.lane)) continue;
            p0_mat(r, args.in[I_CW2V], 128, 64, (bf16*)(ws + WS_CW2V_T), scr, F.lane);
        }
    }
    {
        const float* pw = args.in[I_POOLW]; const float* ps = args.in[I_POOLS]; const float* wbp = args.in[I_WBP];
        bf16* weff = (bf16*)(ws + WS_WEFF_T);
        LAS float* PWl = (LAS float*)(F.lds);
        LAS float* WBl = (LAS float*)(F.lds + 128 * 129 * 4);
        __syncthreads();
        for (int bb = F.bid; bb < 256; bb += F.G) {
            const int g = bb >> 6, d0 = (bb & 63) * 16;
            for (int i = F.tid; i < 128 * 128; i += NTHREADS) PWl[(i >> 7) * 129 + (i & 127)] = pw[(size_t)g * 16384 + i];
            for (int i = F.tid; i < 128 * 16; i += NTHREADS) { const int cc = i >> 4, dd = i & 15; WBl[cc * 17 + dd] = wbp[(size_t)(g * 128 + cc) * D + d0 + dd] * ps[g * 128 + cc]; }
            __syncthreads();
            const int c = F.tid & 127, q = F.tid >> 7;
            float acc4[4] = {0.f, 0.f, 0.f, 0.f};
#pragma unroll 4
            for (int cc = 0; cc < 128; ++cc) { const float a = PWl[c * 129 + cc];
#pragma unroll
                for (int e = 0; e < 4; ++e) acc4[e] += a * WBl[cc * 17 + 4 * q + e]; }
#pragma unroll
            for (int e = 0; e < 4; ++e) weff[(size_t)(d0 + 4 * q + e) * POOLW + g * 128 + c] = (bf16)f2bf(acc4[e]);
            __syncthreads();
        }
    }
    cvt_f32_bf16_stream(args.in[I_PSK], (bf16*)(ws + WS_SUBK), (size_t)16 * 128 * 128 / 8, gtid, gthreads);
    cvt_rows_i8(args.in[I_PU], ws + WS_UB, (float*)(ws + WS_SCLU), gw, NGW, F.lane);
    cvt_rows_fp8(args.in[I_PV], ws + WS_VB, (float*)(ws + WS_SCLV), gw, NGW, F.lane);
}

template <bool Q8> __device__ __forceinline__ void modnorm_rows(Frame& F, const float* x, const float* g, const float* ada, int shift_idx, bf16* out) {
    const int gw = F.bid * NWAVES + F.wave, NGW = F.G * NWAVES;
    for (int m = gw; m < M; m += NGW) {
        const int b = m >> 12;
        const GAS f32x4* xr = (const GAS f32x4*)(x + (size_t)m * D) + F.lane;
        const GAS f32x4* gr = (const GAS f32x4*)g + F.lane;
        const GAS f32x4* sh = (const GAS f32x4*)(ada + (size_t)b * 6 * D + shift_idx * D) + F.lane;
        const GAS f32x4* sc = (const GAS f32x4*)(ada + (size_t)b * 6 * D + (shift_idx + 1) * D) + F.lane;
        f32x4 v[4]; float s = 0.f;
#pragma unroll
        for (int j = 0; j < 4; ++j) { v[j] = xr[64 * j]; s += (v[j].x * v[j].x + v[j].y * v[j].y) + (v[j].z * v[j].z + v[j].w * v[j].w); }
        const float rstd = rsqrtf(wave_sum(s) * (1.f / D) + EPS);
        GAS v2u* o8 = (GAS v2u*)(out + (size_t)m * D) + F.lane;
        float mx = 0.f;
#pragma unroll
        for (int j = 0; j < 4; ++j) { const f32x4 gg = gr[64 * j], ss = sh[64 * j], cc = sc[64 * j];
            const f32x4 y = (v[j] * rstd) * gg * (cc + 1.0f) + ss; v[j] = y;
            mx = fmaxf(mx, fmaxf(fmaxf(fabsf(y.x), fabsf(y.y)), fmaxf(fabsf(y.z), fabsf(y.w))));
            v2u o; o.x = pk2(y.x, y.y); o.y = pk2(y.z, y.w); o8[64 * j] = o; }
        if (Q8) {
#pragma unroll
            for (int o = 1; o < 64; o <<= 1) mx = fmaxf(mx, __shfl_xor(mx, o));
            const float qs = mx > 0.f ? 127.0f / mx : 0.f;
            GAS unsigned* h8 = (GAS unsigned*)(F.ws + WS_H8 + (size_t)m * D) + F.lane;
#pragma unroll
            for (int j = 0; j < 4; ++j) { const int q0 = (int)rintf(v[j].x * qs), q1 = (int)rintf(v[j].y * qs), q2 = (int)rintf(v[j].z * qs), q3 = (int)rintf(v[j].w * qs);
                h8[64 * j] = ((unsigned)q0 & 0xffu) | (((unsigned)q1 & 0xffu) << 8) | (((unsigned)q2 & 0xffu) << 16) | (((unsigned)q3 & 0xffu) << 24); }
            if (F.lane == 0) ((float*)(F.ws + WS_HS))[m] = mx * (1.0f / 127.0f);
        }
    }
}

struct EpiIn {
    static constexpr bool PERM = true, AFTER_DRAIN = false;
    unsigned char* ws; const float* qg; const float* kg;
    __device__ __forceinline__ void operator()(const pg8::f32x4 (&acc)[2][2][4][2], const pg8::Unit& u, int wr, int wc, int fr, int fq) const {
        const int pn = u.pn;
#pragma unroll
        for (int ai = 0; ai < 2; ++ai)
#pragma unroll
            for (int m = 0; m < 4; ++m) {
                const int row = u.pm * 256 + ai * 128 + wr * 64 + m * 16 + fr;
                float v[2][8];
#pragma unroll
                for (int bj = 0; bj < 2; ++bj)
#pragma unroll
                    for (int n = 0; n < 2; ++n)
#pragma unroll
                        for (int i = 0; i < 4; ++i) v[bj][4 * n + i] = acc[ai][bj][m][n][i];
                bf16* dst = nullptr; bool norm = false; const float* gain = nullptr; float mul = 1.f; bool sig = false;
                if (pn < 2) { dst = (bf16*)(ws + WS_ZP) + (size_t)row * 512 + 256 * pn + 64 * wc; }
                else if (pn < 4) { dst = (bf16*)(ws + WS_Q) + (size_t)row * 512 + 256 * (pn - 2) + 64 * wc; norm = true; gain = qg; mul = 0.125f * 1.4426950408889634f; }
                else if (pn < 7) { const int kind = pn - 4, isv = wc >> 1, g = wc & 1, b = row >> 12, t = row & 4095;
                    const size_t base = ((size_t)(b * 2 + g) * SEQ + t) * 64;
                    const size_t off = kind == 0 ? (isv ? WS_VCR : WS_KCR) : kind == 1 ? (isv ? WS_VS : WS_KS) : (isv ? WS_VW : WS_KW);
                    dst = (bf16*)(ws + off) + base; if (!isv && kind > 0) { norm = true; gain = kg + kind * 64; } }
                else if (pn < 15) { dst = (bf16*)(ws + WS_GM) + (size_t)row * 2048 + 256 * (pn - 7) + 64 * wc; sig = true; }
                else {
                    if (wc == 0 && fq < 3) { float* gp = (float*)(ws + WS_GATE) + (size_t)row * 24 + 8 * fq;
                        *(GAS f32x4*)gp = (f32x4){sigmoidf_(v[0][0]), sigmoidf_(v[0][1]), sigmoidf_(v[0][2]), sigmoidf_(v[0][3])};
                        *(GAS f32x4*)(gp + 4) = (f32x4){sigmoidf_(v[0][4]), sigmoidf_(v[0][5]), sigmoidf_(v[0][6]), sigmoidf_(v[0][7])}; }
                    continue; }
                if (norm) { float ss = 0.f;
#pragma unroll
                    for (int bj = 0; bj < 2; ++bj)
#pragma unroll
                        for (int e = 0; e < 8; ++e) ss += v[bj][e] * v[bj][e];
                    ss += __shfl_xor(ss, 16); ss += __shfl_xor(ss, 32);
                    const float rs = rsqrtf(ss * (1.f / 64.f) + EPS) * mul;
#pragma unroll
                    for (int bj = 0; bj < 2; ++bj)
#pragma unroll
                        for (int e = 0; e < 8; ++e) v[bj][e] = v[bj][e] * rs * gain[32 * bj + 8 * fq + e]; }
                if (sig) {
#pragma unroll
                    for (int bj = 0; bj < 2; ++bj)
#pragma unroll
                        for (int e = 0; e < 8; ++e) v[bj][e] = sigmoidf_(v[bj][e]); }
#pragma unroll
                for (int bj = 0; bj < 2; ++bj) { v4u o; o.x = pk2(v[bj][0], v[bj][1]); o.y = pk2(v[bj][2], v[bj][3]); o.z = pk2(v[bj][4], v[bj][5]); o.w = pk2(v[bj][6], v[bj][7]);
                    *(GAS v4u*)(dst + 32 * bj + 8 * fq) = o; }
            }
    }
};
template <bool ADD> struct EpiMix {
    static constexpr bool PERM = true, AFTER_DRAIN = false;
    bf16* MIX; const bf16* GM; int gmoff;
    __device__ __forceinline__ void operator()(const pg8::f32x4 (&acc)[2][2][4][2], const pg8::Unit& u, int wr, int wc, int fr, int fq) const {
#pragma unroll
        for (int ai = 0; ai < 2; ++ai)
#pragma unroll
            for (int m = 0; m < 4; ++m) {
                const int row = u.pm * 256 + ai * 128 + wr * 64 + m * 16 + fr;
#pragma unroll
                for (int bj = 0; bj < 2; ++bj) {
                    const int col = u.pn * 256 + bj * 128 + wc * 32 + 8 * fq;
                    const v4u gmv = *(const GAS v4u*)(GM + (size_t)row * 2048 + gmoff + col);
                    float r[8];
                    r[0] = acc[ai][bj][m][0][0] * bflo(gmv.x); r[1] = acc[ai][bj][m][0][1] * bfhi(gmv.x); r[2] = acc[ai][bj][m][0][2] * bflo(gmv.y); r[3] = acc[ai][bj][m][0][3] * bfhi(gmv.y);
                    r[4] = acc[ai][bj][m][1][0] * bflo(gmv.z); r[5] = acc[ai][bj][m][1][1] * bfhi(gmv.z); r[6] = acc[ai][bj][m][1][2] * bflo(gmv.w); r[7] = acc[ai][bj][m][1][3] * bfhi(gmv.w);
                    GAS v4u* dp = (GAS v4u*)(MIX + (size_t)row * 1024 + col);
                    if (ADD) { const v4u old = *dp; r[0] += bflo(old.x); r[1] += bfhi(old.x); r[2] += bflo(old.y); r[3] += bfhi(old.y); r[4] += bflo(old.z); r[5] += bfhi(old.z); r[6] += bflo(old.w); r[7] += bfhi(old.w); }
                    v4u o; o.x = pk2(r[0], r[1]); o.y = pk2(r[2], r[3]); o.z = pk2(r[4], r[5]); o.w = pk2(r[6], r[7]); *dp = o; }
            }
    }
};
struct EpiRes {
    static constexpr bool PERM = false, AFTER_DRAIN = false;
    const float* x; float* out; const float* ada; int gate_idx;
    __device__ __forceinline__ void operator()(const pg8::f32x4 (&acc)[2][2][4][2], const pg8::Unit& u, int wr, int wc, int fr, int fq) const {
#pragma unroll
        for (int ai = 0; ai < 2; ++ai)
#pragma unroll
            for (int m = 0; m < 4; ++m) {
                const int row = u.pm * 256 + ai * 128 + wr * 64 + m * 16 + fr, b = row >> 12;
#pragma unroll
                for (int bj = 0; bj < 2; ++bj)
#pragma unroll
                    for (int n = 0; n < 2; ++n) {
                        const int col = u.pn * 256 + bj * 128 + wc * 32 + 16 * n + 4 * fq;
                        const f32x4 gt = *(const GAS f32x4*)(ada + (size_t)b * 6 * D + gate_idx * D + col);
                        const f32x4 xv = *(const GAS f32x4*)(x + (size_t)row * D + col);
                        *(GAS f32x4*)(out + (size_t)row * D + col) = xv + gt * acc[ai][bj][m][n]; }
            }
    }
};

__device__ __forceinline__ void pool_phase(Frame& F) {
    const bf16* zp = (const bf16*)(F.ws + WS_ZP); bf16* pl = (bf16*)(F.ws + WS_PL);
    const size_t gtid = (size_t)F.bid * NTHREADS + F.tid, gthreads = (size_t)F.G * NTHREADS;
    for (size_t idx = gtid; idx < (size_t)M * 64; idx += gthreads) {
        const int row = (int)(idx >> 6), c8 = (int)(idx & 63), t = row & 4095, w = 2 << (c8 >> 4), cnt = (t + 1 < w) ? (t + 1) : w;
        float s[8];
#pragma unroll
        for (int e = 0; e < 8; ++e) s[e] = 0.f;
        float self[8];
        for (int j = 0; j < cnt; ++j) { const v4u z = *(const GAS v4u*)(zp + (size_t)(row - j) * 512 + 8 * c8);
            const float f[8] = {bflo(z.x), bfhi(z.x), bflo(z.y), bfhi(z.y), bflo(z.z), bfhi(z.z), bflo(z.w), bfhi(z.w)};
#pragma unroll
            for (int e = 0; e < 8; ++e) { s[e] += f[e]; if (j == 0) self[e] = f[e]; } }
        const float inv = 1.0f / (float)cnt;
        v4u o; o.x = pk2(s[0] * inv - self[0], s[1] * inv - self[1]); o.y = pk2(s[2] * inv - self[2], s[3] * inv - self[3]);
        o.z = pk2(s[4] * inv - self[4], s[5] * inv - self[5]); o.w = pk2(s[6] * inv - self[6], s[7] * inv - self[7]);
        *(GAS v4u*)(pl + (size_t)row * 512 + 8 * c8) = o; }
}

typedef int v4i __attribute__((ext_vector_type(4)));
struct EpiStoreBf16 {
    static constexpr bool PERM = true, AFTER_DRAIN = false;
    bf16* O; int ldc;
    __device__ __forceinline__ void operator()(const pg8::f32x4 (&acc)[2][2][4][2], const pg8::Unit& u, int wr, int wc, int fr, int fq) const {
#pragma unroll
        for (int ai = 0; ai < 2; ++ai)
#pragma unroll
            for (int m = 0; m < 4; ++m) {
                const int row = u.pm * 256 + ai * 128 + wr * 64 + m * 16 + fr;
#pragma unroll
                for (int bj = 0; bj < 2; ++bj) {
                    const int col = u.pn * 256 + bj * 128 + wc * 32 + 8 * fq;
                    v4u o; o.x = pk2(acc[ai][bj][m][0][0], acc[ai][bj][m][0][1]); o.y = pk2(acc[ai][bj][m][0][2], acc[ai][bj][m][0][3]);
                    o.z = pk2(acc[ai][bj][m][1][0], acc[ai][bj][m][1][1]); o.w = pk2(acc[ai][bj][m][1][2], acc[ai][bj][m][1][3]);
                    *(GAS v4u*)(O + (size_t)row * ldc + col) = o; }
            }
    }
};

__device__ __forceinline__ unsigned fkey(float f) { const unsigned u = __builtin_bit_cast(unsigned, f); return (u >> 31) ? ~u : (u | 0x80000000u); }
__device__ __forceinline__ float funkey(unsigned k) { const unsigned u = (k >> 31) ? (k & 0x7fffffffu) : ~k; return __builtin_bit_cast(float, u); }
__device__ __forceinline__ unsigned umax_(unsigned a, unsigned b) { return a > b ? a : b; }
__device__ __forceinline__ unsigned umin_(unsigned a, unsigned b) { return a > b ? b : a; }
#define TOP16_INSERT(L, xin) do { unsigned _x = (xin); _Pragma("unroll") for (int _i = 0; _i < 16; ++_i) { const unsigned _h = umax_(L[_i], _x); _x = umin_(L[_i], _x); L[_i] = _h; } } while (0)
template <int MASK> __device__ __forceinline__ void top16_merge(unsigned (&L)[16]) {
    unsigned o[16];
#pragma unroll
    for (int i = 0; i < 16; ++i) o[i] = (unsigned)__shfl_xor((int)L[i], MASK);
#pragma unroll
    for (int i = 0; i < 16; ++i) L[i] = umax_(L[i], o[15 - i]);
#pragma unroll
    for (int d = 8; d >= 1; d >>= 1)
#pragma unroll
        for (int i = 0; i < 16; ++i) if ((i & d) == 0) { const unsigned hi = umax_(L[i], L[i + d]), lo = umin_(L[i], L[i + d]); L[i] = hi; L[i + d] = lo; }
}
constexpr int SST = 132;
constexpr int P9_LIST_OFF = 2 * 64 * SST * 4;
__device__ __forceinline__ void peer_select_phase(Frame& F) {
    const bf16* QV = (const bf16*)(F.ws + WS_QV); const bf16* SK = (const bf16*)(F.ws + WS_SUBK);
    int* EID = (int*)(F.ws + WS_EID); float* GW = (float*)(F.ws + WS_GW);
    LAS float* S = (LAS float*)(F.lds);
    LAS unsigned* LIST = (LAS unsigned*)(F.lds + P9_LIST_OFF);
    const int lane = F.lane, w = F.wave, l15 = lane & 15, lq = lane >> 4;
    const int p = w >> 2, kb = w & 3;
    constexpr int NU = (M / 64) * PH;
    bf16x8 a[4][4], bq[2][4];
#define P9_LOAD(u_) do { const int _tt = (u_) >> 3, _h = (u_) & 7; \
        const bf16* qa = QV + (size_t)(_tt * 64 + l15) * PQW + _h * 256 + p * 128 + 8 * lq; \
        const bf16* kbp = SK + (size_t)((_h * 2 + p) * 128 + 32 * kb + l15) * 128 + 8 * lq; \
        _Pragma("unroll") for (int ks = 0; ks < 4; ++ks) { \
            _Pragma("unroll") for (int rb = 0; rb < 4; ++rb) a[rb][ks] = *(const GAS bf16x8*)(qa + (size_t)(16 * rb) * PQW + 32 * ks); \
            _Pragma("unroll") for (int cb = 0; cb < 2; ++cb) bq[cb][ks] = *(const GAS bf16x8*)(kbp + (size_t)(16 * cb) * 128 + 32 * ks); } } while (0)
    if (F.bid < NU) P9_LOAD(F.bid);
    for (int u = F.bid; u < NU; u += F.G) {
        const int tt = u >> 3, h = u & 7, tok0 = tt * 64;
        {
            pg8::f32x4 acc[4][2];
#pragma unroll
            for (int rb = 0; rb < 4; ++rb)
#pragma unroll
                for (int cb = 0; cb < 2; ++cb) acc[rb][cb] = (pg8::f32x4){0.f, 0.f, 0.f, 0.f};
#pragma unroll
            for (int ks = 0; ks < 4; ++ks)
#pragma unroll
                for (int rb = 0; rb < 4; ++rb)
#pragma unroll
                    for (int cb = 0; cb < 2; ++cb) acc[rb][cb] = __builtin_amdgcn_mfma_f32_16x16x32_bf16(a[rb][ks], bq[cb][ks], acc[rb][cb], 0, 0, 0);
#pragma unroll
            for (int rb = 0; rb < 4; ++rb)
#pragma unroll
                for (int cb = 0; cb < 2; ++cb)
#pragma unroll
                    for (int r = 0; r < 4; ++r) S[(p * 64 + 16 * rb + 4 * lq + r) * SST + 32 * kb + 16 * cb + l15] = acc[rb][cb][r];
        }
        __syncthreads();
        if (u + F.G < NU) P9_LOAD(u + F.G);
        {
            const int row = F.tid >> 2, sub = F.tid & 3;
            const LAS float* sr = S + row * SST + sub;
            unsigned L[16];
#pragma unroll
            for (int i = 0; i < 16; ++i) L[i] = 0u;
#pragma unroll 4
            for (int i = 0; i < 32; ++i) { const unsigned key = (fkey(sr[4 * i]) & ~127u) | (unsigned)(4 * i + sub); TOP16_INSERT(L, key); }
            top16_merge<1>(L); top16_merge<2>(L);
            if (sub == 0) {
#pragma unroll
                for (int i = 0; i < 4; ++i) *(LAS v4u*)(LIST + row * 16 + 4 * i) = (v4u){L[4 * i], L[4 * i + 1], L[4 * i + 2], L[4 * i + 3]}; }
        }
        __syncthreads();
        if (F.tid < 256) {
            const int tok = F.tid >> 2, sub = F.tid & 3;
            float va[16], vb[16];
#pragma unroll
            for (int i = 0; i < 4; ++i) { const v4u x = *(const LAS v4u*)(LIST + tok * 16 + 4 * i), y = *(const LAS v4u*)(LIST + (64 + tok) * 16 + 4 * i);
                va[4 * i] = funkey(x.x & ~127u); va[4 * i + 1] = funkey(x.y & ~127u); va[4 * i + 2] = funkey(x.z & ~127u); va[4 * i + 3] = funkey(x.w & ~127u);
                vb[4 * i] = funkey(y.x & ~127u); vb[4 * i + 1] = funkey(y.y & ~127u); vb[4 * i + 2] = funkey(y.z & ~127u); vb[4 * i + 3] = funkey(y.w & ~127u); }
            unsigned L[16];
#pragma unroll
            for (int i = 0; i < 16; ++i) L[i] = 0u;
            {
                constexpr int NC = 50;
                constexpr unsigned char CI[52] = {0,0,0,0,0,0,0,0,0,0,0,0,0,0,0,0, 1,1,1,1,1,1,1,1, 2,2,2,2,2, 3,3,3,3, 4,4,4, 5,5, 6,6, 7,7, 8,9,10,11,12,13,14,15, 0,0};
                constexpr unsigned char CJ[52] = {0,1,2,3,4,5,6,7,8,9,10,11,12,13,14,15, 0,1,2,3,4,5,6,7, 0,1,2,3,4, 0,1,2,3, 0,1,2, 0,1, 0,1, 0,1, 0,0,0,0,0,0,0,0, 0,0};
#pragma unroll
                for (int g4 = 0; g4 < 13; ++g4) {
                    float sa = 0.f, sb = 0.f; unsigned id = 0u; bool ok = false;
#pragma unroll
                    for (int q = 0; q < 4; ++q) { const int n = 4 * g4 + q; if (n < NC) { const bool me = (sub == q); sa = me ? va[CI[n]] : sa; sb = me ? vb[CJ[n]] : sb; id = me ? (unsigned)(CI[n] * 16 + CJ[n]) : id; ok = ok || me; } }
                    const unsigned key = ok ? ((fkey(sa + sb) & ~255u) | id) : 0u;
                    TOP16_INSERT(L, key);
                }
            }
            top16_merge<1>(L); top16_merge<2>(L);
            const float mx = funkey(L[0] & ~255u);
            float e[16], sum = 0.f;
#pragma unroll
            for (int k = 0; k < 16; ++k) { e[k] = __expf(funkey(L[k] & ~255u) - mx); sum += e[k]; }
            const float inv = 1.0f / sum;
            const size_t ob = (size_t)(tok0 + tok) * 128;
#pragma unroll
            for (int k4 = 0; k4 < 4; ++k4) if (sub == k4) {
#pragma unroll
                for (int q = 0; q < 4; ++q) { const unsigned cid = L[4 * k4 + q] & 255u;
                    const unsigned ia = LIST[tok * 16 + (cid >> 4)] & 127u, ib = LIST[(64 + tok) * 16 + (cid & 15u)] & 127u;
                    const int slot = h * 16 + 4 * k4 + q;
                    EID[ob + slot] = (int)(ia * 128u + ib); GW[ob + slot] = e[4 * k4 + q] * inv; }
            }
        }
        __syncthreads();
    }
#undef P9_LOAD
}

__device__ __forceinline__ void unpack8(const v4u w, float (&f)[8]) { f[0] = bflo(w.x); f[1] = bfhi(w.x); f[2] = bflo(w.y); f[3] = bfhi(w.y); f[4] = bflo(w.z); f[5] = bfhi(w.z); f[6] = bflo(w.w); f[7] = bfhi(w.w); }
typedef float f32x2 __attribute__((ext_vector_type(2)));
__device__ __forceinline__ void unpack16_fp8(const v4u w, float (&f)[16]) {
    const unsigned ww[4] = {w.x, w.y, w.z, w.w};
#pragma unroll
    for (int d = 0; d < 4; ++d) { const f32x2 a = __builtin_amdgcn_cvt_pk_f32_fp8((int)ww[d], false), b = __builtin_amdgcn_cvt_pk_f32_fp8((int)ww[d], true);
        f[4 * d] = a.x; f[4 * d + 1] = a.y; f[4 * d + 2] = b.x; f[4 * d + 3] = b.y; }
}
template <int PV_> __device__ __forceinline__ void peer_dot_phase(Frame& F) {
    const unsigned char* H8 = F.ws + WS_H8; const int* EID = (const int*)(F.ws + WS_EID); float* PART = (float*)(F.ws + WS_PART);
    const int lane = F.lane, g = lane >> 3, j = lane & 7, x = F.bid & 7;
    const int nbx = (F.G - x + 7) >> 3, NW = nbx * NWAVES, gwv = (F.bid >> 3) * NWAVES + F.wave;
    const unsigned char* US = F.ws + WS_UB + (size_t)x * NEXP * 128; const unsigned j16 = 16u * (unsigned)j;
    int token = gwv;
    if (token >= M) return;
    v4i e4[4]; v4i hb;
#define PD_LOAD_E(tok_) do { _Pragma("unroll") for (int q = 0; q < 4; ++q) e4[q] = *(const GAS v4i*)(EID + (size_t)(tok_) * 128 + 16 * g + 4 * q); } while (0)
#define PD_ISSUE4(buf_, e_, b0_) do { buf_[b0_] = *(const GAS v4i*)(US + ((unsigned)e_.x * 128u + j16)); buf_[b0_ + 1] = *(const GAS v4i*)(US + ((unsigned)e_.y * 128u + j16)); \
        buf_[b0_ + 2] = *(const GAS v4i*)(US + ((unsigned)e_.z * 128u + j16)); buf_[b0_ + 3] = *(const GAS v4i*)(US + ((unsigned)e_.w * 128u + j16)); } while (0)
#define PD_DOT1(w_, dst_) do { int t = __builtin_amdgcn_sdot4(w_.x, hc.x, 0, false); t = __builtin_amdgcn_sdot4(w_.y, hc.y, t, false); t = __builtin_amdgcn_sdot4(w_.z, hc.z, t, false); t = __builtin_amdgcn_sdot4(w_.w, hc.w, t, false); \
        t += __shfl_xor(t, 1); t += __shfl_xor(t, 2); t += __shfl_xor(t, 4); dst_ = (float)t; } while (0)
    PD_LOAD_E(token); hb = *(const GAS v4i*)(H8 + (size_t)token * D + 128 * x + j16);
    v4i bA[8], bB[8];
    PD_ISSUE4(bA, e4[0], 0); PD_ISSUE4(bA, e4[1], 4);
    for (; token < M; token += NW) {
        const bool more = token + NW < M;
        PD_ISSUE4(bB, e4[2], 0); PD_ISSUE4(bB, e4[3], 4);
        const v4i hc = hb;
        if (more) { PD_LOAD_E(token + NW); hb = *(const GAS v4i*)(H8 + (size_t)(token + NW) * D + 128 * x + j16); }
        float s[16];
#pragma unroll
        for (int i = 0; i < 8; ++i) PD_DOT1(bA[i], s[i]);
        if (more) { PD_ISSUE4(bA, e4[0], 0); PD_ISSUE4(bA, e4[1], 4); }
#pragma unroll
        for (int i = 0; i < 8; ++i) PD_DOT1(bB[i], s[8 + i]);
        if (j == 0) { float* pp = PART + ((size_t)x * M + token) * 128 + g * 16;
#pragma unroll
            for (int i4 = 0; i4 < 4; ++i4) *(GAS f32x4*)(pp + 4 * i4) = (f32x4){s[4 * i4], s[4 * i4 + 1], s[4 * i4 + 2], s[4 * i4 + 3]}; }
    }
#undef PD_LOAD_E
#undef PD_ISSUE4
#undef PD_DOT1
}
__device__ __forceinline__ void peer_coef_phase(Frame& F) {
    const float* PART = (const float*)(F.ws + WS_PART); const int* EID = (const int*)(F.ws + WS_EID); const float* GW = (const float*)(F.ws + WS_GW); float* CF = (float*)(F.ws + WS_CF);
    const float* SCU = (const float*)(F.ws + WS_SCLU); const float* SCV = (const float*)(F.ws + WS_SCLV); const float* HS = (const float*)(F.ws + WS_HS);
    const size_t gtid = (size_t)F.bid * NTHREADS + F.tid, gthreads = (size_t)F.G * NTHREADS, n4 = (size_t)M * 128 / 4;
    for (size_t i4 = gtid; i4 < n4; i4 += gthreads) {
        f32x4 d = *(const GAS f32x4*)(PART + 4 * i4);
#pragma unroll
        for (int xx = 1; xx < 8; ++xx) d = d + *(const GAS f32x4*)(PART + (size_t)xx * M * 128 + 4 * i4);
        const v4i e = *(const GAS v4i*)(EID + 4 * i4); const f32x4 gw = *(const GAS f32x4*)(GW + 4 * i4);
        const float hs = HS[i4 >> 5];
        f32x4 r; r.x = gw.x * SCV[e.x] * gelu_tanh_safe(d.x * (SCU[e.x] * hs)); r.y = gw.y * SCV[e.y] * gelu_tanh_safe(d.y * (SCU[e.y] * hs));
        r.z = gw.z * SCV[e.z] * gelu_tanh_safe(d.z * (SCU[e.z] * hs)); r.w = gw.w * SCV[e.w] * gelu_tanh_safe(d.w * (SCU[e.w] * hs));
        *(GAS f32x4*)(CF + 4 * i4) = r; }
}
template <bool DRY> __device__ __forceinline__ void peer_out_phase(Frame& F, const float* ada, float* out) {
    const int* EID = (const int*)(F.ws + WS_EID); const float* CF = (const float*)(F.ws + WS_CF);
    const int lane = F.lane, g = lane >> 3, j = lane & 7, x = F.bid & 7;
    const int nbx = (F.G - x + 7) >> 3, NW = nbx * NWAVES, gwv = (F.bid >> 3) * NWAVES + F.wave;
    const unsigned char* VS = F.ws + WS_VB + (size_t)x * NEXP * 128; const unsigned j16 = 16u * (unsigned)j;
    int token = gwv;
    if (token >= M) return;
    v4i e4[4]; f32x4 c4[4];
#pragma unroll
    for (int q = 0; q < 4; ++q) { e4[q] = *(const GAS v4i*)(EID + (size_t)token * 128 + g * 16 + 4 * q); c4[q] = *(const GAS f32x4*)(CF + (size_t)token * 128 + g * 16 + 4 * q); }
    for (; token < M; token += NW) {
        const bool more = token + NW < M;
        v4u vv[16];
#pragma unroll
        for (int q = 0; q < 4; ++q) { vv[4 * q] = *(const GAS v4u*)(VS + ((unsigned)e4[q].x * 128u + j16)); vv[4 * q + 1] = *(const GAS v4u*)(VS + ((unsigned)e4[q].y * 128u + j16));
            vv[4 * q + 2] = *(const GAS v4u*)(VS + ((unsigned)e4[q].z * 128u + j16)); vv[4 * q + 3] = *(const GAS v4u*)(VS + ((unsigned)e4[q].w * 128u + j16)); }
        float cf[16];
#pragma unroll
        for (int q = 0; q < 4; ++q) { cf[4 * q] = c4[q].x; cf[4 * q + 1] = c4[q].y; cf[4 * q + 2] = c4[q].z; cf[4 * q + 3] = c4[q].w; }
        if (more) {
#pragma unroll
            for (int q = 0; q < 4; ++q) { e4[q] = *(const GAS v4i*)(EID + (size_t)(token + NW) * 128 + g * 16 + 4 * q); c4[q] = *(const GAS f32x4*)(CF + (size_t)(token + NW) * 128 + g * 16 + 4 * q); } }
        float o[16];
#pragma unroll
        for (int k = 0; k < 16; ++k) o[k] = 0.f;
#pragma unroll
        for (int i = 0; i < 16; ++i) { float f[16]; unpack16_fp8(vv[i], f);
#pragma unroll
            for (int k = 0; k < 16; ++k) o[k] += cf[i] * f[k]; }
#pragma unroll
        for (int k = 0; k < 16; ++k) { float t = o[k]; t += __shfl_xor(t, 8); t += __shfl_xor(t, 16); t += __shfl_xor(t, 32); o[k] = t; }
        if (g == 0) { const int b = token >> 12;
            const float* gt = ada + (size_t)b * 6 * D + 5 * D + 128 * x + 16 * j;
            float* xo = out + (size_t)token * D + 128 * x + 16 * j;
#pragma unroll
            for (int q = 0; q < 4; ++q) { const f32x4 xv = *(const GAS f32x4*)(xo + 4 * q), gv = *(const GAS f32x4*)(gt + 4 * q);
                const f32x4 res = xv + gv * (f32x4){o[4 * q], o[4 * q + 1], o[4 * q + 2], o[4 * q + 3]};
                if (DRY) { asm volatile("" :: "v"(res.x), "v"(res.y), "v"(res.z), "v"(res.w)); } else *(GAS f32x4*)(xo + 4 * q) = res; } }
    }
}

__device__ __forceinline__ void compress_phase(Frame& F, const float* kng) {
    LAS bf16* H2 = (LAS bf16*)(F.lds);
    LAS float* OUTS = (LAS float*)(F.lds + 16384);
    const int lane = F.lane, w = F.wave, l15 = lane & 15, lq = lane >> 4;
    for (int u = F.bid; u < NBG * 2 * 8; u += F.G) {
        const int ns = u & 7, kv = (u >> 3) & 1, bg = u >> 4, n0 = ns * 32;
        const bf16* A = (const bf16*)(F.ws + (kv ? WS_VCR : WS_KCR)) + (size_t)bg * SEQ * 64;
        const bf16* W1T = (const bf16*)(F.ws + (kv ? WS_CW1V_T : WS_CW1K_T));
        const bf16* W2T = (const bf16*)(F.ws + (kv ? WS_CW2V_T : WS_CW2K_T));
        const float* b1 = (const float*)(F.ws + (kv ? WS_CB1V : WS_CB1K));
        pg8::f32x4 acc[2];
        acc[0] = (pg8::f32x4){0.f, 0.f, 0.f, 0.f}; acc[1] = acc[0];
        const bf16* ap = A + (size_t)(n0 + l15) * 1024 + 8 * lq;
        const bf16* bp = W1T + (size_t)(16 * w + l15) * 2048 + 8 * lq;
#pragma unroll 4
        for (int ks = 0; ks < 64; ++ks) {
            const bf16x8 a0 = *(const GAS bf16x8*)(ap + 32 * ks), a1 = *(const GAS bf16x8*)(ap + 16 * 1024 + 32 * ks), b = *(const GAS bf16x8*)(bp + 32 * ks);
            acc[0] = __builtin_amdgcn_mfma_f32_16x16x32_bf16(a0, b, acc[0], 0, 0, 0);
            acc[1] = __builtin_amdgcn_mfma_f32_16x16x32_bf16(a1, b, acc[1], 0, 0, 0);
        }
        { const float bb = b1[16 * w + l15];
#pragma unroll
          for (int rb = 0; rb < 2; ++rb)
#pragma unroll
            for (int r = 0; r < 4; ++r) H2[(16 * rb + 4 * lq + r) * 136 + 16 * w + l15] = (bf16)f2bf(gelu_tanh_safe(acc[rb][r] + bb)); }
        __syncthreads();
        { const int rb = w >> 2, db = w & 3;
          pg8::f32x4 o = (pg8::f32x4){0.f, 0.f, 0.f, 0.f};
#pragma unroll
          for (int ks = 0; ks < 4; ++ks) {
              const bf16x8 a = *(const LAS bf16x8*)(H2 + (16 * rb + l15) * 136 + 32 * ks + 8 * lq);
              const bf16x8 b = *(const GAS bf16x8*)(W2T + (size_t)(16 * db + l15) * 128 + 32 * ks + 8 * lq);
              o = __builtin_amdgcn_mfma_f32_16x16x32_bf16(a, b, o, 0, 0, 0); }
#pragma unroll
          for (int r = 0; r < 4; ++r) OUTS[(16 * rb + 4 * lq + r) * 65 + 16 * db + l15] = o[r]; }
        __syncthreads();
        { const int n = F.tid >> 4, d4 = (F.tid & 15) * 4, ng = n0 + n;
          float v[4]; float ss = 0.f;
#pragma unroll
          for (int i = 0; i < 4; ++i) { v[i] = OUTS[n * 65 + d4 + i]; ss += v[i] * v[i]; }
          ss += __shfl_xor(ss, 1); ss += __shfl_xor(ss, 2); ss += __shfl_xor(ss, 4); ss += __shfl_xor(ss, 8);
          const bool pad = (ng >= NCMP);
          if (kv == 0) { const float rs = rsqrtf(ss * (1.f / 64.f) + EPS);
              v2u o; o.x = pad ? 0u : pk2(v[0] * rs * kng[d4], v[1] * rs * kng[d4 + 1]); o.y = pad ? 0u : pk2(v[2] * rs * kng[d4 + 2], v[3] * rs * kng[d4 + 3]);
              *(GAS v2u*)((bf16*)(F.ws + WS_KC) + ((size_t)bg * 256 + ng) * 64 + d4) = o; }
          else { bf16* vt = (bf16*)(F.ws + WS_VCT) + (size_t)bg * 64 * 256 + ng;
#pragma unroll
              for (int i = 0; i < 4; ++i) vt[(size_t)(d4 + i) * 256] = pad ? (bf16)0 : (bf16)f2bf(v[i]); } }
        __syncthreads();
    }
}
__device__ __forceinline__ void vtranspose_phase(Frame& F) {
    LAS bf16* T = (LAS bf16*)(F.lds + F.wave * 9216);
    const int gw = F.bid * NWAVES + F.wave, NGW = F.G * NWAVES, lane = F.lane;
    for (int job = gw; job < 2 * NBG * 64; job += NGW) {
        const int s = job & 63, bg = (job >> 6) & 15, which = job >> 10;
        const bf16* X = (const bf16*)(F.ws + (which ? WS_VW : WS_VS)) + ((size_t)bg * SEQ + 64 * s) * 64;
        bf16* XT = (bf16*)(F.ws + (which ? WS_VWT : WS_VST)) + (size_t)bg * 64 * SEQ + 64 * s;
#pragma unroll
        for (int i = 0; i < 8; ++i) { const int tok = (lane >> 3) + 8 * i, ch = lane & 7;
            const v4u x = *(const GAS v4u*)(X + (size_t)tok * 64 + 8 * ch);
            const unsigned ww[4] = {x.x, x.y, x.z, x.w};
#pragma unroll
            for (int e = 0; e < 4; ++e) { T[(8 * ch + 2 * e) * 72 + tok] = (bf16)(ww[e] & 0xffffu); T[(8 * ch + 2 * e + 1) * 72 + tok] = (bf16)(ww[e] >> 16); } }
        LDS_WAIT(); asm volatile("" ::: "memory");
#pragma unroll
        for (int i = 0; i < 8; ++i) { const int dim = (lane >> 3) + 8 * i, ch = lane & 7;
            const v4u y = *(const LAS v4u*)(T + dim * 72 + 8 * ch);
            *(GAS v4u*)(XT + (size_t)dim * SEQ + 8 * ch) = y; }
        LDS_WAIT(); asm volatile("" ::: "memory");
    }
}

constexpr int AT_KSTR = 72;
constexpr int AT_KBUF = 64 * AT_KSTR * 2;
constexpr int AT_OFF_K = 0, AT_OFF_V = 4 * AT_KBUF;
constexpr int AT_OFF_IMP1 = 8 * AT_KBUF, AT_OFF_IMP2 = AT_OFF_IMP1 + 64 * 65 * 4, AT_OFF_SEL = AT_OFF_IMP2 + 64 * 65 * 4;
constexpr int AT_OFF_LUT = AT_OFF_SEL + 4096, AT_OFF_LROW = AT_OFF_LUT + 4 * 128 * 4;
constexpr int AT_OFF_TD = AT_OFF_LROW + 8 * 32 * 4;
constexpr int AT_LDS_END = AT_OFF_TD + 96 * 32;
static_assert(AT_LDS_END <= RING_BYTES, "attention LDS");

struct AtTile { const bf16* k; const bf16* vt; int vstride; };
enum { TM_CMP1 = 0, TM_CMP2, TM_SELN, TM_SELF, TM_WINN, TM_WINF, TM_WINE };
__device__ __forceinline__ float fexp2(float x) { return __builtin_amdgcn_exp2f(x); }
template <int TM, int VAR>
__device__ __forceinline__ void at_tile(const LAS unsigned char* kb_, const LAS unsigned char* vb_, const LAS float* LUTJ, LAS float* IMP1, LAS float* IMP2,
                                        const bf16x8 (&qf)[2][2], pg8::f32x4 (&oacc)[2][4], float (&lsum)[2], float (&lpart)[2], const float (&linv)[2],
                                        const int (&tok_r)[2], const unsigned (&selb)[2], float cfar, int relbase, int idx, int l15, int lq) {
    constexpr bool FAR = (TM == TM_SELF || TM == TM_WINF || TM == TM_WINE);
    v4u pfr[2][2];
#pragma unroll
    for (int cb = 0; cb < 4; ++cb) {
        pg8::f32x4 st[2];
        st[0] = FAR ? (pg8::f32x4){cfar, cfar, cfar, cfar} : (pg8::f32x4){0.f, 0.f, 0.f, 0.f}; st[1] = st[0];
        if (!(VAR & 64)) {
#pragma unroll
        for (int ks = 0; ks < 2; ++ks) { const bf16x8 kf = *(const LAS bf16x8*)(kb_ + (16 * cb + l15) * 144 + 64 * ks + 16 * lq);
#pragma unroll
            for (int rb = 0; rb < 2; ++rb) st[rb] = __builtin_amdgcn_mfma_f32_16x16x32_bf16(kf, qf[rb][ks], st[rb], 0, 0, 0); } }
#pragma unroll
        for (int rb = 0; rb < 2; ++rb) {
            const int tokc = tok_r[rb];
            float p[4];
#pragma unroll
            for (int r = 0; r < 4; ++r) {
                const int kl = 16 * cb + 4 * lq + r;
                if (VAR & 16) { p[r] = st[rb][r]; }
                else if (TM == TM_SELF) { const float e = fexp2(st[rb][r]); p[r] = selb[rb] ? e : 0.f; }
                else if (TM == TM_WINF) { p[r] = fexp2(st[rb][r]); }
                else if (TM == TM_WINE) { const float e = fexp2(st[rb][r]); p[r] = (kl > tokc) ? e : 0.f; }
                else {
                    const int rel = (TM == TM_CMP1 || TM == TM_CMP2) ? (relbase + tokc - 16 * kl) : (relbase + tokc - kl);
                    bool valid = rel >= 0; if (TM == TM_SELN) valid = valid && (selb[rb] != 0u);
                    const int ri = rel < 0 ? 0 : (rel > 127 ? 127 : rel);
                    const float e = fexp2(st[rb][r] + LUTJ[ri]);
                    p[r] = valid ? e : 0.f; }
            }
            if (TM == TM_CMP1) { lpart[rb] += (p[0] + p[1]) + (p[2] + p[3]); }
            else {
                if (TM == TM_CMP2) {
#pragma unroll
                    for (int r = 0; r < 4; ++r) p[r] *= linv[rb];
                    float h0 = p[0], h1 = p[1], h2 = p[2], h3 = p[3];
                    h0 += __shfl_xor(h0, 1); h1 += __shfl_xor(h1, 1); h2 += __shfl_xor(h2, 1); h3 += __shfl_xor(h3, 1);
                    h0 += __shfl_xor(h0, 2); h1 += __shfl_xor(h1, 2); h2 += __shfl_xor(h2, 2); h3 += __shfl_xor(h3, 2);
                    if ((l15 & 3) == 0) { const int sp = 16 * idx + 4 * cb + lq;
                        IMP1[tokc * 65 + sp] = (h0 + h1) + (h2 + 0.5f * h3);
                        if (sp + 1 < 64) IMP2[tokc * 65 + sp + 1] = 0.5f * h3; }
                } else lsum[rb] += (p[0] + p[1]) + (p[2] + p[3]);
                const unsigned lo = pg8::cvt_pk_bf16(p[0], p[1]), hi = pg8::cvt_pk_bf16(p[2], p[3]);
                if (cb & 1) { pfr[rb][cb >> 1].z = lo; pfr[rb][cb >> 1].w = hi; } else { pfr[rb][cb >> 1].x = lo; pfr[rb][cb >> 1].y = hi; } }
        }
    }
    if (TM != TM_CMP1 && !(VAR & 8)) {
#pragma unroll
        for (int ks = 0; ks < 2; ++ks)
#pragma unroll
            for (int db = 0; db < 4; ++db) {
                const LAS unsigned char* vp = vb_ + (16 * db + l15) * 144 + 64 * ks + 8 * lq;
                const v2u v0 = *(const LAS v2u*)vp, v1 = *(const LAS v2u*)(vp + 32);
                const v4u vv = (v4u){v0.x, v0.y, v1.x, v1.y};
#pragma unroll
                for (int rb = 0; rb < 2; ++rb) oacc[rb][db] = __builtin_amdgcn_mfma_f32_16x16x32_bf16(__builtin_bit_cast(bf16x8, pfr[rb][ks]), __builtin_bit_cast(bf16x8, vv), oacc[rb][db], 0, 0, 0); }
    }
}

template <int VAR> __device__ __forceinline__ void attention_phase(Frame& F, const Args& args) {
    unsigned char* ws = F.ws;
    const int lane = F.lane, w = F.wave, l15 = lane & 15, lq = lane >> 4, tid = F.tid;
    LAS unsigned char* L = F.lds;
    LAS float* IMP1 = (LAS float*)(L + AT_OFF_IMP1); LAS float* IMP2 = (LAS float*)(L + AT_OFF_IMP2);
    LAS unsigned char* SEL = L + AT_OFF_SEL; LAS float* LUT = (LAS float*)(L + AT_OFF_LUT); LAS float* LROW = (LAS float*)(L + AT_OFF_LROW) + w * 32;
    LAS int* TD = (LAS int*)(L + AT_OFF_TD);
    const float M0 = ((const float*)(ws + WS_BIASL))[8 * 128];
    const bf16* Qg = (const bf16*)(ws + WS_Q); const float* GATE = (const float*)(ws + WS_GATE); bf16* YA = (bf16*)(ws + WS_YA); float* YAF = (float*)(ws + WS_H);
    const int jq = l15 & 3;
    const LAS float* LUTJ = LUT + jq * 128;
    const int nrounds = (F.G == 256) ? 4 : (1024 + F.G - 1) / F.G;
    for (int round = 0; round < nrounds; ++round) {
        const int ui = (F.G == 256) ? ((round & 1) ? ((round >> 1) * 512 + 511 - F.bid) : ((round >> 1) * 512 + F.bid)) : (round * F.G + F.bid);
        if (ui >= 1024) break;
        const int c = 63 - (ui >> 4), bg = ui & 15, b = bg >> 1, g = bg & 1;
        const int m0 = b * SEQ + 64 * c;
        __syncthreads();
        for (int i = tid; i < 512; i += NTHREADS) LUT[i] = (((const float*)(ws + WS_BIASL))[(4 * g + (i >> 7)) * 128 + (i & 127)] - M0) * 1.4426950408889634f;
        for (int i = tid; i < 64 * 65; i += NTHREADS) { IMP1[i] = 0.f; IMP2[i] = 0.f; }
        bf16x8 qf[2][2];
#pragma unroll
        for (int rb = 0; rb < 2; ++rb)
#pragma unroll
            for (int ks = 0; ks < 2; ++ks) qf[rb][ks] = *(const GAS bf16x8*)(Qg + (size_t)(m0 + 8 * w + 4 * rb + (l15 >> 2)) * 512 + g * 256 + jq * 64 + 32 * ks + 8 * lq);
        asm volatile("" :: "v"(qf[0][0]), "v"(qf[0][1]), "v"(qf[1][0]), "v"(qf[1][1]));
        const int ncmp = 4 * c + 3, n1 = (ncmp + 63) >> 6, nsel = c + 1, w0 = c >= 8 ? c - 8 : 0, nwin = c - w0 + 1;
        const int ntiles = 2 * n1 + nsel + nwin;
        if (tid < ntiles) { const int i = tid; int kind, idx; unsigned ko, vo, vs;
            if (i < n1) { kind = 0; idx = i; } else if (i < 2 * n1) { kind = 1; idx = i - n1; } else if (i < 2 * n1 + nsel) { kind = 2; idx = i - 2 * n1; } else { kind = 3; idx = w0 + (i - 2 * n1 - nsel); }
            if (kind < 2) { ko = (unsigned)(WS_KC + ((size_t)bg * 256 * 64 + (size_t)idx * 4096) * 2); vo = (unsigned)(WS_VCT + ((size_t)bg * 64 * 256 + 64 * idx) * 2); vs = 512u; }
            else if (kind == 2) { ko = (unsigned)(WS_KS + ((size_t)bg * SEQ * 64 + (size_t)idx * 4096) * 2); vo = (unsigned)(WS_VST + ((size_t)bg * 64 * SEQ + 64 * idx) * 2); vs = 2u * SEQ; }
            else { ko = (unsigned)(WS_KW + ((size_t)bg * SEQ * 64 + (size_t)idx * 4096) * 2); vo = (unsigned)(WS_VWT + ((size_t)bg * 64 * SEQ + 64 * idx) * 2); vs = 2u * SEQ; }
            const int dd = c - idx;
            int mode, relbase;
            if (kind == 0) { mode = TM_CMP1; relbase = 64 * c - 31 - 1024 * idx; } else if (kind == 1) { mode = TM_CMP2; relbase = 64 * c - 31 - 1024 * idx; }
            else if (kind == 2) { mode = dd <= 2 ? TM_SELN : TM_SELF; relbase = 64 * dd; } else { mode = dd <= 2 ? TM_WINN : (dd == 8 ? TM_WINE : TM_WINF); relbase = 64 * dd; }
            const int endf = ((kind == 1 && idx == n1 - 1) || (kind == 2 && idx == nsel - 1) || (kind == 3 && idx == c)) ? kind : 0;
            LAS int* td = TD + 8 * i; td[0] = mode; td[1] = idx; td[2] = relbase; td[3] = endf; td[4] = (int)ko; td[5] = (int)vo; td[6] = (int)vs; td[7] = (kind == 2 && idx == 0) ? 1 : 0; }
        const int srow = tid >> 3, sch = tid & 7;
        __syncthreads();
        v4u kreg[2], vreg[2];
#pragma unroll
        for (int q = 0; q < 2; ++q) if (q < ntiles) { const unsigned ko = (unsigned)TD[8 * q + 4], vo = (unsigned)TD[8 * q + 5], vs = (unsigned)TD[8 * q + 6];
          kreg[q] = *(const GAS v4u*)(ws + (size_t)(ko + srow * 128 + 16 * sch)); vreg[q] = *(const GAS v4u*)(ws + (size_t)(vo + srow * vs + 16 * sch));
          *(LAS v4u*)(L + AT_OFF_K + q * AT_KBUF + srow * 144 + 16 * sch) = kreg[q]; *(LAS v4u*)(L + AT_OFF_V + q * AT_KBUF + srow * 144 + 16 * sch) = vreg[q]; }
        __syncthreads();
        const float cfar = LUTJ[127];
        float lpart[2] = {0.f, 0.f};
        float linv[2] = {0.f, 0.f};
        pg8::f32x4 oacc[2][4];
        float lsum[2] = {0.f, 0.f};
#pragma unroll
        for (int rb = 0; rb < 2; ++rb)
#pragma unroll
            for (int db = 0; db < 4; ++db) oacc[rb][db] = (pg8::f32x4){0.f, 0.f, 0.f, 0.f};
        const int tok_r[2] = {8 * w + (l15 >> 2), 8 * w + 4 + (l15 >> 2)};
        for (int it0 = 0; it0 < ((VAR & 32) ? 0 : ntiles); it0 += 2) {
            const int pb = (it0 >> 1) & 1;
            if (!(VAR & 2)) {
#pragma unroll
                for (int q = 0; q < 2; ++q) if (it0 + 2 + q < ntiles) { const LAS int* tn = TD + 8 * (it0 + 2 + q); const unsigned ko = (unsigned)tn[4], vo = (unsigned)tn[5], vs = (unsigned)tn[6];
                    kreg[q] = *(const GAS v4u*)(ws + (size_t)(ko + srow * 128 + 16 * sch)); vreg[q] = *(const GAS v4u*)(ws + (size_t)(vo + srow * vs + 16 * sch)); } }
#pragma unroll 1
            for (int sub = 0; sub < 2; ++sub) {
            const int it = it0 + sub; if (it >= ntiles) break;
            const LAS int* td = TD + 8 * it;
            const int mode = __builtin_amdgcn_readfirstlane(td[0]), idx = __builtin_amdgcn_readfirstlane(td[1]), relbase = __builtin_amdgcn_readfirstlane(td[2]);
            const int endf = __builtin_amdgcn_readfirstlane(td[3]), selfirst = __builtin_amdgcn_readfirstlane(td[7]);
            const int buf = 2 * pb + sub;
            if (selfirst) {
                for (int tq = 0; tq < 8; ++tq) { const int tok = 8 * w + tq, sB = lane;
                    const bool vis = sB <= c, forced = (sB == 0) || (sB == c) || (sB == c - 1);
                    const float sc = vis ? (IMP1[tok * 65 + sB] + IMP2[tok * 65 + sB] + (forced ? 1000.f : 0.f)) : -1.f;
                    unsigned char flag;
                    if (c < 16) flag = vis ? 1 : 0;
                    else { const unsigned u = __builtin_bit_cast(unsigned, sc); const unsigned fk = (u >> 31) ? ~u : (u | 0x80000000u);
                        const unsigned key = (fk & ~63u) | (unsigned)(63 - sB);
                        int rank = 0;
#pragma unroll 8
                        for (int s2 = 0; s2 < 64; ++s2) { const unsigned k2 = (unsigned)__builtin_amdgcn_readlane((int)key, s2); rank += (k2 > key) ? 1 : 0; }
                        flag = (rank < 16 && vis) ? 1 : 0; }
                    SEL[tok * 64 + sB] = flag; }
                __syncthreads();
            }
            const LAS unsigned char* kb_ = L + AT_OFF_K + buf * AT_KBUF; const LAS unsigned char* vb_ = L + AT_OFF_V + buf * AT_KBUF;
            unsigned selb[2] = {1u, 1u};
#define AT_CALL(TMX) at_tile<TMX, VAR>(kb_, vb_, LUTJ, IMP1, IMP2, qf, oacc, lsum, lpart, linv, tok_r, selb, cfar, relbase, idx, l15, lq)
            if (mode == TM_SELF || mode == TM_SELN) { selb[0] = SEL[tok_r[0] * 64 + idx]; selb[1] = SEL[tok_r[1] * 64 + idx]; }
            if (mode == TM_SELF) AT_CALL(TM_SELF);
            else if (mode == TM_WINF) AT_CALL(TM_WINF);
            else if (mode == TM_SELN) AT_CALL(TM_SELN);
            else if (mode == TM_WINN) AT_CALL(TM_WINN);
            else if (mode == TM_WINE) AT_CALL(TM_WINE);
            else if (mode == TM_CMP2) AT_CALL(TM_CMP2);
            else { if (idx == 0) { lpart[0] = 0.f; lpart[1] = 0.f; }
                AT_CALL(TM_CMP1);
                if (idx == n1 - 1) {
#pragma unroll
                    for (int rb = 0; rb < 2; ++rb) { float s = lpart[rb]; s += __shfl_xor(s, 16); s += __shfl_xor(s, 32); linv[rb] = s > 0.f ? 1.0f / s : 0.f; } } }
#undef AT_CALL
            {
                if (endf) {
                    const int br = endf - 1;
                    if (endf == 1) { LROW[l15] = 1.0f; LROW[16 + l15] = 1.0f; }
                    else {
#pragma unroll
                        for (int rb = 0; rb < 2; ++rb) { float s = lsum[rb]; s += __shfl_xor(s, 16); s += __shfl_xor(s, 32); if (lq == 0) LROW[16 * rb + l15] = s > 0.f ? 1.0f / s : 0.f; lsum[rb] = 0.f; } }
                    LDS_WAIT(); asm volatile("" ::: "memory");
                    int trow0 = m0 + 8 * w + lq;
                    asm volatile("" : "+v"(trow0));
                    const float* gp = GATE + (size_t)trow0 * 24 + g * 12 + br;
                    float* yf0 = YAF + (size_t)trow0 * 512 + g * 256 + l15;
                    bf16* ya0 = YA + (size_t)trow0 * 512 + g * 256 + l15;
#pragma unroll
                    for (int rb = 0; rb < 2; ++rb)
#pragma unroll
                        for (int r = 0; r < 4; ++r) { const int qrow = 16 * rb + 4 * lq + r;
                            const float gt = gp[rb * 96 + r * 3] * LROW[qrow];
#pragma unroll
                            for (int db = 0; db < 4; ++db) { float v = gt * oacc[rb][db][r]; oacc[rb][db][r] = 0.f;
                                const int off = rb * 2048 + r * 64 + 16 * db;
                                if (br > 0) v += yf0[off];
                                if (VAR & 1) { asm volatile("" :: "v"(v)); } else { if (br < 2) yf0[off] = v; else ya0[off] = (bf16)f2bf(v); } } }
                }
            }
            }
            if (!(VAR & 2)) {
#pragma unroll
                for (int q = 0; q < 2; ++q) if (it0 + 2 + q < ntiles) { *(LAS v4u*)(L + AT_OFF_K + (2 * (pb ^ 1) + q) * AT_KBUF + srow * 144 + 16 * sch) = kreg[q]; *(LAS v4u*)(L + AT_OFF_V + (2 * (pb ^ 1) + q) * AT_KBUF + srow * 144 + 16 * sch) = vreg[q]; } }
            if (!(VAR & 4)) __syncthreads();
        }
    }
}

constexpr int N_PHASES = 13;
#ifndef MK_ONE_LAUNCH
#define MK_ONE_LAUNCH 1
#endif
#ifndef REP_P0
#define REP_P0 1
#endif
#ifndef REP_P1
#define REP_P1 1
#endif
#ifndef REP_P2
#define REP_P2 1
#endif
#ifndef REP_P3
#define REP_P3 1
#endif
#ifndef REP_P5
#define REP_P5 1
#endif
#ifndef REP_P6
#define REP_P6 1
#endif
#ifndef REP_P8
#define REP_P8 1
#endif
#ifndef REP_P4
#define REP_P4 1
#endif
#ifndef REP_P9
#define REP_P9 1
#endif
#ifndef REP_P10
#define REP_P10 1
#endif
#ifndef MK_BUILD
#define MK_BUILD 0
#endif

__global__ void __launch_bounds__(NTHREADS, 2) fwd_kernel(Args args) {
    extern __shared__ __attribute__((aligned(16))) unsigned char lds[];
    Frame F;
    F.lds = (LAS unsigned char*)lds;
    F.MISC = (volatile LAS unsigned*)(F.lds + MISC_OFF);
    F.tid = threadIdx.x; F.lane = F.tid & 63; F.wave = __builtin_amdgcn_readfirstlane(F.tid >> 6);
    F.G = gridDim.x; F.bid = blockIdx.x; F.ws = args.ws;
    F.ctl = (gu32*)(args.ws + WS_CTL);
    for (int u = F.tid; u < (LDS_BYTES - LDSCTL_OFF) / 4; u += NTHREADS) ((LAS unsigned*)(F.lds + LDSCTL_OFF))[u] = 0u;
    __syncthreads();
    XcdBarrier bar; bar.bar = (unsigned*)(F.ctl + CW_BAR); bar.x = 0; bar.st = nullptr;
    if (MK_ONE_LAUNCH) bar = xcd_barrier_post((unsigned*)(F.ctl + CW_BAR), F.MISC + 8);
    const int lo = args.ph_lo, hi = args.ph_hi;
#define IN(k) (lo <= (k) && (k) < hi)
#define SEAM(k) do { if (IN(k) && IN((k) + 1)) xcd_barrier(bar); } while (0)
    unsigned char* ws = args.ws;
    const float* ada = (const float*)(ws + WS_ADA);

    if (IN(0)) { for (int rep = 0; rep < REP_P0; ++rep) { p0_prologue(F, args); __syncthreads(); } } SEAM(0);
    if (IN(1)) { for (int rep = 0; rep < REP_P1; ++rep) modnorm_rows<false>(F, args.in[I_X], args.in[I_N1G], ada, 0, (bf16*)(ws + WS_H)); } SEAM(1);
    if (IN(2)) { {
        pg8::Gemm g{(const bf16*)(ws + WS_H), (const bf16*)(ws + WS_WIN_T), M, NIN, D, D, D}; pg8::StaticOrder S; S.init(M, NIN, F.G, F.bid);
        EpiIn E{ws, args.in[I_QNG], args.in[I_KNG]};
        pg8::gemm_phase<EpiIn, pg8::StaticOrder, true, true>(F.lds + RING_OFF, g, S, E);
#if REP_P2 > 1
        __syncthreads(); pg8::gemm_phase<EpiIn, pg8::StaticOrder, true, true>(F.lds + RING_OFF, g, S, E);
#endif
        }
    } SEAM(2);
    if (IN(3)) { for (int rep = 0; rep < REP_P3; ++rep) { __syncthreads(); pool_phase(F); __syncthreads(); compress_phase(F, args.in[I_KNG]); __syncthreads(); vtranspose_phase(F); } } SEAM(3);
    if (IN(4)) {
#ifdef PROBE_P4
        attention_phase<PROBE_P4>(F, args); __syncthreads();
#endif
        attention_phase<0>(F, args); } SEAM(4);
    if (IN(5)) { {
        { pg8::Gemm g{(const bf16*)(ws + WS_PL), (const bf16*)(ws + WS_WEFF_T), M, D, POOLW, POOLW, POOLW}; pg8::StaticOrder S; S.init(M, D, F.G, F.bid);
          EpiMix<false> E{(bf16*)(ws + WS_MIX), (const bf16*)(ws + WS_GM), 0};
          pg8::gemm_phase<EpiMix<false>, pg8::StaticOrder, true, true>(F.lds + RING_OFF, g, S, E); }
        { pg8::Gemm g{(const bf16*)(ws + WS_YA), (const bf16*)(ws + WS_WBA_T), M, D, QW, QW, QW}; pg8::StaticOrder S; S.init(M, D, F.G, F.bid);
          EpiMix<true> E{(bf16*)(ws + WS_MIX), (const bf16*)(ws + WS_GM), 1024};
          pg8::gemm_phase<EpiMix<true>, pg8::StaticOrder, true, true>(F.lds + RING_OFF, g, S, E); } }
    } SEAM(5);
    if (IN(6)) { {
        pg8::Gemm g{(const bf16*)(ws + WS_MIX), (const bf16*)(ws + WS_WOUT_T), M, D, D, D, D}; pg8::StaticOrder S; S.init(M, D, F.G, F.bid);
        EpiRes E{args.in[I_X], args.out, ada, 2};
        pg8::gemm_phase<EpiRes, pg8::StaticOrder, true, true>(F.lds + RING_OFF, g, S, E); }
    } SEAM(6);
    if (IN(7)) { modnorm_rows<true>(F, args.out, args.in[I_N2G], ada, 3, (bf16*)(ws + WS_H)); } SEAM(7);
    if (IN(8)) { {
        pg8::Gemm g{(const bf16*)(ws + WS_H), (const bf16*)(ws + WS_WQ_T), M, PQW, D, D, D}; pg8::StaticOrder S; S.init(M, PQW, F.G, F.bid);
        EpiStoreBf16 E{(bf16*)(ws + WS_QV), PQW};
        pg8::gemm_phase<EpiStoreBf16, pg8::StaticOrder, true, true>(F.lds + RING_OFF, g, S, E);
#if REP_P8 > 1
        __syncthreads(); pg8::gemm_phase<EpiStoreBf16, pg8::StaticOrder, true, true>(F.lds + RING_OFF, g, S, E);
#endif
        }
    } SEAM(8);
    if (IN(9)) { for (int rep = 0; rep < REP_P9; ++rep) peer_select_phase(F); } SEAM(9);
#ifdef PROBE_XCD
    if (IN(10)) { if (F.tid == 0) __hip_atomic_store((unsigned*)(F.ctl + 2048 + F.bid), 100u + xb_xcc_id(), RLX_AGENT); }
#endif
    if (IN(10)) {
#ifdef PROBE_DOT
        peer_dot_phase<PROBE_DOT>(F); __syncthreads();
#endif
        peer_dot_phase<0>(F); } SEAM(10);
    if (IN(11)) { peer_coef_phase(F); } SEAM(11);
#ifdef PROBE_XCD
    if (IN(12) && F.bid == 0 && F.tid == 0) { bool ok = true; for (int i = 0; i < F.G; ++i) { const unsigned a = __hip_atomic_load((unsigned*)(F.ctl + 2048 + i), RLX_AGENT), b0 = __hip_atomic_load((unsigned*)(F.ctl + 2048 + (i & 7)), RLX_AGENT); if (a != b0 || a < 100u) ok = false; }
        for (int i = 0; i < 8; ++i) for (int q = 0; q < i; ++q) if (__hip_atomic_load((unsigned*)(F.ctl + 2048 + i), RLX_AGENT) == __hip_atomic_load((unsigned*)(F.ctl + 2048 + q), RLX_AGENT)) ok = false;
        if (!ok) args.out[12345] = 1.0e9f; }
    __syncthreads();
#endif
    if (IN(12)) { for (int rep = 1; rep < REP_P10; ++rep) peer_out_phase<true>(F, ada, args.out); peer_out_phase<false>(F, ada, args.out); }
#undef IN
#undef SEAM
}

extern "C" void kernel_launch(void* const* d_in, const int* in_sizes, int n_in, void* d_out, int out_size, void* d_ws, size_t ws_size, hipStream_t stream) {
    static int grid = 0;
    if (grid == 0) {
        if (n_in != N_IN || in_sizes[0] != M * D || out_size != M * D || ws_size < WS_END) {
            fprintf(stderr, "kernel_launch: unexpected shapes: n_in %d in0 %d out %d ws %zu (need %zu)\n", n_in, n_in > 0 ? in_sizes[0] : -1, out_size, ws_size, (size_t)WS_END); grid = -1; return; }
        int dev = 0, cus = 0, per_cu = 0;
        if (hipGetDevice(&dev) != hipSuccess || hipDeviceGetAttribute(&cus, hipDeviceAttributeMultiprocessorCount, dev) != hipSuccess) { grid = -1; return; }
        if (hipFuncSetAttribute((const void*)fwd_kernel, hipFuncAttributeMaxDynamicSharedMemorySize, LDS_BYTES) != hipSuccess) { fprintf(stderr, "kernel_launch: hipFuncSetAttribute failed\n"); grid = -1; return; }
        if (hipOccupancyMaxActiveBlocksPerMultiprocessor(&per_cu, (const void*)fwd_kernel, NTHREADS, LDS_BYTES) != hipSuccess || per_cu < 1)
            fprintf(stderr, "kernel_launch: occupancy query reports %d workgroups per CU\n", per_cu);
        (void)hipGetLastError();
        grid = cus;
    }
    if (grid < 0) return;
    if (hipMemsetAsync((char*)d_ws + WS_CTL, 0, CTL_ZERO_BYTES, stream) != hipSuccess) return;
    Args a{};
    for (int i = 0; i < N_IN; ++i) a.in[i] = (const float*)d_in[i];
    a.out = (float*)d_out; a.ws = (unsigned char*)d_ws;
    if (MK_ONE_LAUNCH) {
        a.ph_lo = 0; a.ph_hi = N_PHASES; a.li = 0;
        hipLaunchKernelGGL(fwd_kernel, dim3(grid), dim3(NTHREADS), LDS_BYTES, stream, a);
    } else {
        for (int p = 0; p < N_PHASES; ++p) {
            a.ph_lo = p; a.ph_hi = p + 1; a.li = p;
            hipLaunchKernelGGL(fwd_kernel, dim3(grid), dim3(NTHREADS), LDS_BYTES, stream, a);
        }
    }
}
```

```cpp
#include <hip/hip_runtime.h>
#include <cstdio>
#include <cstdint>
namespace pg8 {
#define PG8_LAS __attribute__((address_space(3)))
typedef unsigned short bf16_t;
typedef short bf16x8 __attribute__((ext_vector_type(8)));
typedef float f32x4 __attribute__((ext_vector_type(4)));
typedef unsigned u32x4 __attribute__((ext_vector_type(4)));
constexpr int BM = 256, BK = 64, HALF = 128, HTB = HALF * BK * 2  , STAGE_BYTES = 8 * HTB, NXCD = 8, WGM = 8;

__host__ __device__ __forceinline__ int lds_byte(int r, int c) { const int st = (r >> 4) * 2 + (c >> 5), rr = r & 15, cc = c & 31, ob = rr * 64 + cc * 2; return st * 1024 + (ob ^ (((ob >> 9) & 1) << 5)); }
__host__ __device__ __forceinline__ void stage_rc(int b, int& R, int& C) { const int st = b / 1024, sb = b % 1024, swz = sb ^ (((sb >> 9) & 1) << 5); R = (st >> 1) * 16 + swz / 64; C = (st & 1) * 32 + (swz % 64) / 2; }
__host__ __device__ __forceinline__ int perm32(int rho) { const int n = rho >> 4, i = rho & 15; return 8 * (i >> 2) + 4 * n + (i & 3); }

struct Unit { int pm, pn; };
struct Gemm { const bf16_t* A; const bf16_t* Bt; int M, N, K, lda, ldb; };

struct StaticOrder {
    int nM, nN, nwg, G, c;
    __host__ __device__ void init(int M, int N, int G_, int c_) { nM = M / BM; nN = N / BM; nwg = nM * nN; G = G_; c = c_; }
    __host__ __device__ bool next(int i, Unit& u) const {
        const long L = (long)i * G + c; if (L >= nwg) return false;
        int wgid = (int)L; { const int q = nwg / NXCD, r = nwg % NXCD, xcd = wgid % NXCD, off = wgid / NXCD; wgid = (xcd < r ? xcd * (q + 1) : r * (q + 1) + (xcd - r) * q) + off; }
        const int nig = WGM * nN, gid = wgid / nig, fm = gid * WGM, gsz = (nM - fm) < WGM ? (nM - fm) : WGM;
        u.pm = fm + ((wgid % nig) % gsz); u.pn = (wgid % nig) / gsz; return true;
    }
    __device__ __forceinline__ void a_ready(const Unit&) const {}
    __device__ __forceinline__ void done(const Unit&) const {}
};

__device__ __forceinline__ unsigned cvt_pk_bf16(float lo, float hi) { unsigned r; asm volatile("v_cvt_pk_bf16_f32 %0, %1, %2" : "=v"(r) : "v"(lo), "v"(hi)); return r; }
template <class Epi, class Sched, bool ALIGN_EPI = false, bool SP2 = false>
__device__ __forceinline__ void gemm_phase(PG8_LAS unsigned char* lds, const Gemm g, const Sched& S, const Epi& E) {
    const int tid = threadIdx.x, wid = __builtin_amdgcn_readfirstlane(tid >> 6), lane = tid & 63, wr = wid >> 2, wc = wid & 3, fr = lane & 15, fq = lane >> 4;
    const int K = g.K, nt = K / BK;
    unsigned voffA[2], voffB[2];
#pragma unroll
    for (int i = 0; i < 2; ++i) { int R, C; stage_rc(tid * 16 + i * 8192, R, C); const int Rb = Epi::PERM ? ((R & ~31) + perm32(R & 31)) : R;
        voffA[i] = (unsigned)(R * g.lda + C) * 2u; voffB[i] = (unsigned)(Rb * g.ldb + C) * 2u; }
    const size_t kstep = (size_t)(BK * 2);
    const size_t hstepA = (size_t)HALF * g.lda * 2, hstepB = (size_t)HALF * g.ldb * 2;
    const size_t tstepA = 2 * hstepA, tstepB = 2 * hstepB;
    const unsigned ldsw = (unsigned)wid * 1024u;
    const int aoff = lds_byte(wr * 64 + fr, fq * 8), boff = lds_byte(wc * 32 + fr, fq * 8);
#define PG8_SA(b, h) (((b) * 2 + (h)) * HTB)
#define PG8_SB(b, h) ((4 + (b) * 2 + (h)) * HTB)
#define PG8_STAGE(bufoff, gbase, voff) do { _Pragma("unroll") for (int _i = 0; _i < 2; ++_i) \
        __builtin_amdgcn_global_load_lds((const unsigned*)((const char*)(gbase) + (voff)[_i]), (PG8_LAS unsigned*)(lds + (bufoff) + ldsw + _i * 8192), 16, 0, 0); } while (0)
#define PG8_LDA(dst, b, h) do { _Pragma("unroll") for (int m = 0; m < 4; ++m) _Pragma("unroll") for (int k = 0; k < 2; ++k) dst[m][k] = *(const PG8_LAS bf16x8*)(lds + PG8_SA(b, h) + aoff + m * 2048 + k * 1024); } while (0)
#define PG8_LDB(dst, b, h) do { _Pragma("unroll") for (int n = 0; n < 2; ++n) _Pragma("unroll") for (int k = 0; k < 2; ++k) dst[n][k] = *(const PG8_LAS bf16x8*)(lds + PG8_SB(b, h) + boff + n * 2048 + k * 1024); } while (0)
#define PG8_MMA(ai, bj, At, Bt) do { __builtin_amdgcn_s_setprio(1); _Pragma("unroll") for (int m = 0; m < 4; ++m) _Pragma("unroll") for (int n = 0; n < 2; ++n) _Pragma("unroll") for (int k = 0; k < 2; ++k) \
        acc[ai][bj][m][n] = __builtin_amdgcn_mfma_f32_16x16x32_bf16(Bt[n][k], At[m][k], acc[ai][bj][m][n], 0, 0, 0); __builtin_amdgcn_s_setprio(0); } while (0)
#define PG8_WAIT_V(n) asm volatile("s_waitcnt vmcnt(" #n ")" ::: "memory")
#define PG8_WAIT_L(n) asm volatile("s_waitcnt lgkmcnt(" #n ")" ::: "memory")
#define PG8_BAR __builtin_amdgcn_s_barrier()
#define PG8_SCHED __builtin_amdgcn_sched_barrier(0)
    Unit cur, nxt; int ui = 0;
    if (!S.next(0, cur)) return;
    f32x4 acc[2][2][4][2];
#pragma unroll
    for (int a = 0; a < 2; ++a)
#pragma unroll
        for (int b = 0; b < 2; ++b)
#pragma unroll
            for (int m = 0; m < 4; ++m)
#pragma unroll
                for (int n = 0; n < 2; ++n) acc[a][b][m][n] = (f32x4){0.f, 0.f, 0.f, 0.f};
    bf16x8 At[4][2], B0[2][2], B1[2][2];
    const char* cA = (const char*)g.A + (size_t)cur.pm * tstepA; const char* cB = (const char*)g.Bt + (size_t)cur.pn * tstepB;
    S.a_ready(cur);
    if constexpr (SP2) {
        PG8_STAGE(PG8_SB(0, 0), cB, voffB); PG8_STAGE(PG8_SB(0, 1), cB + hstepB, voffB); PG8_STAGE(PG8_SA(0, 0), cA, voffA); PG8_STAGE(PG8_SA(0, 1), cA + hstepA, voffA);
        if (wr == 1) PG8_BAR;
        PG8_WAIT_V(2); PG8_BAR;
        PG8_STAGE(PG8_SB(1, 0), cB + kstep, voffB); PG8_STAGE(PG8_SA(1, 0), cA + kstep, voffA); PG8_STAGE(PG8_SB(1, 1), cB + hstepB + kstep, voffB);
        PG8_WAIT_V(6); PG8_BAR;
    } else {
        PG8_STAGE(PG8_SB(0, 0), cB, voffB); PG8_STAGE(PG8_SA(0, 0), cA, voffA); PG8_STAGE(PG8_SB(0, 1), cB + hstepB, voffB); PG8_STAGE(PG8_SA(0, 1), cA + hstepA, voffA);
        if (wr == 1) PG8_BAR;
        PG8_WAIT_V(4); PG8_BAR;
        PG8_STAGE(PG8_SB(1, 0), cB + kstep, voffB); PG8_STAGE(PG8_SA(1, 0), cA + kstep, voffA); PG8_STAGE(PG8_SB(1, 1), cB + hstepB + kstep, voffB);
        PG8_WAIT_V(6); PG8_BAR;
    }
    for (;;) {
        const bool has_next = S.next(ui + 1, nxt);
        const char* nA = has_next ? (const char*)g.A + (size_t)nxt.pm * tstepA : cA; const char* nB = has_next ? (const char*)g.Bt + (size_t)nxt.pn * tstepB : cB;
        for (int t = 0; t < nt; t += 2) {
            const bool last = (t == nt - 2);
            const char* a1 = cA + (size_t)(t + 1) * kstep;
            const char* a2 = last ? nA : cA + (size_t)(t + 2) * kstep; const char* b2 = last ? nB : cB + (size_t)(t + 2) * kstep;
            const char* a3 = a2 + kstep; const char* b3 = b2 + kstep;
            if (last && has_next) S.a_ready(nxt);
            if constexpr (SP2) {
            PG8_LDB(B0, 0, 0); PG8_LDB(B1, 0, 1); PG8_SCHED; PG8_LDA(At, 0, 0); PG8_STAGE(PG8_SA(1, 1), a1 + hstepA, voffA);
            PG8_WAIT_V(8); PG8_WAIT_L(0); PG8_BAR; PG8_MMA(0, 0, At, B0); PG8_MMA(0, 1, At, B1); PG8_BAR; PG8_SCHED;
            PG8_LDA(At, 0, 1); PG8_STAGE(PG8_SB(0, 0), b2, voffB); PG8_STAGE(PG8_SB(0, 1), b2 + hstepB, voffB); PG8_STAGE(PG8_SA(0, 0), a2, voffA);
            PG8_WAIT_V(8); PG8_WAIT_L(0); PG8_BAR; PG8_MMA(1, 0, At, B0); PG8_MMA(1, 1, At, B1); PG8_BAR; PG8_SCHED;
            PG8_LDB(B0, 1, 0); PG8_LDB(B1, 1, 1); PG8_SCHED; PG8_LDA(At, 1, 0); PG8_STAGE(PG8_SA(0, 1), a2 + hstepA, voffA);
            PG8_WAIT_V(8); PG8_WAIT_L(0); PG8_BAR; PG8_MMA(0, 0, At, B0); PG8_MMA(0, 1, At, B1); PG8_BAR; PG8_SCHED;
            PG8_LDA(At, 1, 1); PG8_STAGE(PG8_SB(1, 0), b3, voffB); PG8_STAGE(PG8_SB(1, 1), b3 + hstepB, voffB); PG8_STAGE(PG8_SA(1, 0), a3, voffA);
            PG8_WAIT_V(8); PG8_WAIT_L(0); PG8_BAR; PG8_MMA(1, 0, At, B0); PG8_MMA(1, 1, At, B1); PG8_BAR; PG8_SCHED;
            } else {
            PG8_LDB(B0, 0, 0); PG8_SCHED; PG8_LDA(At, 0, 0); PG8_STAGE(PG8_SA(1, 1), a1 + hstepA, voffA);
            PG8_WAIT_L(8); PG8_BAR; PG8_WAIT_L(0); PG8_MMA(0, 0, At, B0); PG8_BAR; PG8_SCHED;
            PG8_LDB(B1, 0, 1); PG8_STAGE(PG8_SB(0, 0), b2, voffB);
            PG8_BAR; PG8_WAIT_L(0); PG8_MMA(0, 1, At, B1); PG8_BAR;
            PG8_LDA(At, 0, 1); PG8_STAGE(PG8_SA(0, 0), a2, voffA);
            PG8_BAR; PG8_WAIT_L(0); PG8_MMA(1, 0, At, B0); PG8_BAR; PG8_SCHED;
            PG8_STAGE(PG8_SB(0, 1), b2 + hstepB, voffB);
            PG8_WAIT_V(6); PG8_BAR; PG8_MMA(1, 1, At, B1); PG8_BAR;
            PG8_LDB(B0, 1, 0); PG8_SCHED; PG8_LDA(At, 1, 0); PG8_STAGE(PG8_SA(0, 1), a2 + hstepA, voffA);
            PG8_WAIT_L(8); PG8_BAR; PG8_WAIT_L(0); PG8_MMA(0, 0, At, B0); PG8_BAR; PG8_SCHED;
            PG8_LDB(B1, 1, 1); PG8_STAGE(PG8_SB(1, 0), b3, voffB);
            PG8_BAR; PG8_WAIT_L(0); PG8_MMA(0, 1, At, B1); PG8_BAR;
            PG8_LDA(At, 1, 1); PG8_STAGE(PG8_SA(1, 0), a3, voffA);
            PG8_BAR; PG8_WAIT_L(0); PG8_MMA(1, 0, At, B0); PG8_BAR; PG8_SCHED;
            PG8_STAGE(PG8_SB(1, 1), b3 + hstepB, voffB);
            PG8_WAIT_V(6); PG8_BAR; PG8_MMA(1, 1, At, B1); PG8_BAR;
            }
        }
        if constexpr (ALIGN_EPI) { if (wr == 0) PG8_BAR; }
        if constexpr (!Epi::AFTER_DRAIN) { E(acc, cur, wr, wc, fr, fq); S.done(cur); }
        if (!has_next) break;
#pragma unroll
        for (int a = 0; a < 2; ++a)
#pragma unroll
            for (int b = 0; b < 2; ++b)
#pragma unroll
                for (int m = 0; m < 4; ++m)
#pragma unroll
                    for (int n = 0; n < 2; ++n) acc[a][b][m][n] = (f32x4){0.f, 0.f, 0.f, 0.f};
        cur = nxt; cA = nA; cB = nB; ++ui;
        if constexpr (ALIGN_EPI) { if (wr == 1) PG8_BAR; }
    }
    PG8_WAIT_V(0);
    if constexpr (!ALIGN_EPI) { if (wr == 0) PG8_BAR; }
    PG8_BAR;
    if constexpr (Epi::AFTER_DRAIN) { E.fused(acc, cur, wr, wc, fr, fq, lds, wid, lane); S.done(cur); }
#undef PG8_SA
#undef PG8_SB
#undef PG8_STAGE
#undef PG8_LDA
#undef PG8_LDB
#undef PG8_MMA
#undef PG8_WAIT_V
#undef PG8_WAIT_L
#undef PG8_BAR
#undef PG8_SCHED
}
}

constexpr int NWAVES = 8, NTHREADS = NWAVES * 64;
constexpr int BATCH = 8, SEQ = 4096, D = 1024, M = BATCH * SEQ;
constexpr int POOLW = 512, QW = 512, NG = 2, HD = 64, NBG = BATCH * NG;
constexpr int IN_COLS = 3864, NIN = 4096;
constexpr int NCMP = 255, NCMP_PAD = 256, NSEL = 64;
constexpr int PH = 8, PK = 128, PTOP = 16, PQD = 256, PQW = PH * PQD;
constexpr int NEXP = PK * PK;
constexpr float EPS = 1e-6f;
enum { I_X = 0, I_C, I_RELB, I_ADAW, I_ADAB, I_N1G, I_N2G, I_WIN, I_POOLW, I_POOLS, I_CPEK, I_CW1K, I_CW2K, I_CPEV, I_CW1V, I_CW2V, I_QNG, I_KNG, I_WBP, I_WBA, I_WOUT, I_PWQ, I_PSK, I_PU, I_PV, N_IN };

constexpr size_t MiB = 1u << 20, KiB = 1u << 10;
constexpr size_t WS_CTL = 0, CTL_ZERO_BYTES = 1 * MiB;
constexpr size_t WS_ADA = 1 * MiB;
constexpr size_t WS_CB1K = 64 * KiB;
constexpr size_t WS_CB1V = WS_CB1K + 1 * KiB;
constexpr size_t WS_BIASL = WS_ADA + 256 * KiB;
constexpr size_t WS_WIN_T = 2 * MiB;
constexpr size_t WS_WEFF_T = 10 * MiB;
constexpr size_t WS_WBA_T = 11 * MiB;
constexpr size_t WS_WOUT_T = 12 * MiB;
constexpr size_t WS_WQ_T = 14 * MiB;
constexpr size_t WS_SUBK = 18 * MiB;
constexpr size_t WS_CW1K_T = 18 * MiB + 512 * KiB;
constexpr size_t WS_CW1V_T = 19 * MiB;
constexpr size_t WS_CW2K_T = 19 * MiB + 512 * KiB;
constexpr size_t WS_CW2V_T = WS_CW2K_T + 64 * KiB;
constexpr size_t WS_KC = 20 * MiB;
constexpr size_t WS_VCT = 20 * MiB + 512 * KiB;
constexpr size_t WS_GATE = 21 * MiB;
constexpr size_t WS_UB = 24 * MiB;
constexpr size_t WS_VB = 56 * MiB;
constexpr size_t WS_SCLU = WS_UB + 16 * MiB, WS_SCLV = WS_SCLU + 64 * KiB;
constexpr size_t WS_H = 88 * MiB;
constexpr size_t WS_ZP = 152 * MiB;
constexpr size_t WS_Q = 184 * MiB;
constexpr size_t WS_KCR = 216 * MiB;
constexpr size_t WS_VCR = 225 * MiB;
constexpr size_t WS_KS = 234 * MiB, WS_VS = 242 * MiB, WS_KW = 250 * MiB, WS_VW = 258 * MiB;
constexpr size_t WS_VST = 266 * MiB, WS_VWT = 274 * MiB;
constexpr size_t WS_PL = 282 * MiB;
constexpr size_t WS_YA = 314 * MiB;
constexpr size_t WS_GM = 346 * MiB;
constexpr size_t WS_MIX = WS_ZP;
constexpr size_t WS_QV = WS_GM;
constexpr size_t WS_EID = WS_PL;
constexpr size_t WS_GW = WS_PL + 16 * MiB;
constexpr size_t WS_PART = WS_GM;
constexpr size_t WS_CF = WS_YA;
constexpr size_t WS_H8 = WS_ZP;
constexpr size_t WS_HS = WS_ZP + 32 * MiB;
constexpr size_t WS_END = 474 * MiB;
constexpr int CW_TMO = 0, CW_CODE = 1, CW_BAR = 4096;

constexpr int RING_OFF = 0, RING_BYTES = 131072;
constexpr int LDSCTL_OFF = RING_BYTES, MISC_OFF = LDSCTL_OFF + 320;
constexpr int LDS_BYTES = 147456;

#define GAS __attribute__((address_space(1)))
#define LAS __attribute__((address_space(3)))
typedef unsigned short bf16;
typedef unsigned v4u __attribute__((ext_vector_type(4)));
typedef unsigned v2u __attribute__((ext_vector_type(2)));
typedef float f32x4 __attribute__((ext_vector_type(4)));
typedef short bf16x8 __attribute__((ext_vector_type(8)));
typedef GAS unsigned gu32;
#define RLX_AGENT __ATOMIC_RELAXED, __HIP_MEMORY_SCOPE_AGENT
#define LDS_WAIT() asm volatile("s_waitcnt lgkmcnt(0)" ::: "memory")
#define VM_WAIT() asm volatile("s_waitcnt vmcnt(0)" ::: "memory")
__device__ __forceinline__ unsigned f2bf(float f) { unsigned u = __builtin_bit_cast(unsigned, f); return (u + 0x7fffu + ((u >> 16) & 1u)) >> 16; }
__device__ __forceinline__ unsigned pk2(float lo, float hi) { return f2bf(lo) | (f2bf(hi) << 16); }
__device__ __forceinline__ float bflo(unsigned w) { return __builtin_bit_cast(float, w << 16); }
__device__ __forceinline__ float bfhi(unsigned w) { return __builtin_bit_cast(float, w & 0xffff0000u); }
__device__ __forceinline__ float sigmoidf_(float v) { return __builtin_amdgcn_rcpf(1.0f + __builtin_amdgcn_exp2f(v * -1.4426950408889634f)); }
__device__ __forceinline__ unsigned pkh(float lo, float hi) { unsigned r; asm volatile("v_cvt_pk_bf16_f32 %0, %1, %2" : "=v"(r) : "v"(lo), "v"(hi)); return r; }
__device__ __forceinline__ float gelu_tanh_safe(float v) { const float u = 0.7978845608028654f * (v + 0.044715f * v * v * v); return 0.5f * v * (1.0f + tanhf(u)); }
__device__ __forceinline__ float wave_sum(float v) {
#pragma unroll
    for (int o = 1; o < 64; o <<= 1) v += __shfl_xor(v, o);
    return v;
}

#define XB_TMO      128
#define XB_XCNT(j)  (256  + 64 * (j))
#define XB_XSUB(j)  (1280 + 64 * (j))
#define XB_XGEN(j)  (2304 + 64 * (j))
#define XB_TOP      3328
#define XB_TOPGEN   3392
#define XCD_BAR_WORDS 3456
#define XB_SPIN_CAP (1u << 18)
__device__ __forceinline__ unsigned xb_ld(unsigned* p)              { return __hip_atomic_load(p, __ATOMIC_RELAXED, __HIP_MEMORY_SCOPE_AGENT); }
__device__ __forceinline__ unsigned xb_add(unsigned* p, unsigned v) { return __hip_atomic_fetch_add(p, v, __ATOMIC_RELAXED, __HIP_MEMORY_SCOPE_AGENT); }
__device__ __forceinline__ unsigned xb_xcc_id() { return (unsigned)__builtin_amdgcn_s_getreg((3 << 11) | 20) & 0xFu; }
#define XB_SPIN(cond, bar) do { unsigned _sp = 0; while (cond) { __builtin_amdgcn_s_sleep(1); \
    if ((++_sp & 255u) == 0u) { if (xb_ld(&(bar)[XB_TMO])) break; if (_sp > XB_SPIN_CAP) { atomicAdd(&(bar)[XB_TMO], 1u); break; } } } } while (0)
struct XcdBarrier { unsigned* bar; unsigned x; volatile LAS unsigned* st; };
__device__ __forceinline__ XcdBarrier xcd_barrier_post(unsigned* bar, volatile LAS unsigned* st) {
    XcdBarrier b; b.bar = bar; b.x = xb_xcc_id(); b.st = st;
    if (threadIdx.x == 0) (void)xb_add(&bar[XB_XCNT(b.x)], 1u);
    return b;
}
__device__ __forceinline__ void xcd_barrier_complete(unsigned* bar, unsigned x, unsigned& nloc, unsigned& nx) {
    const unsigned G = gridDim.x * gridDim.y * gridDim.z;
    unsigned sum, cnt, mine, sp = 0u;
    for (;;) {
        sum = 0u; cnt = 0u; mine = 0u;
#pragma unroll
        for (unsigned j = 0; j < 16; ++j) { const unsigned c = xb_ld(&bar[XB_XCNT(j)]); sum += c; cnt += (c > 0u) ? 1u : 0u; mine = (j == x) ? c : mine; }
        if (sum == G) break;
        __builtin_amdgcn_s_sleep(1);
        if ((++sp & 255u) == 0u) { if (xb_ld(&bar[XB_TMO])) break; if (sp > XB_SPIN_CAP) { atomicAdd(&bar[XB_TMO], 1u); break; } }
    }
    nloc = mine > 0u ? mine : 1u; nx = cnt > 0u ? cnt : 1u;
}
__device__ __forceinline__ void xcd_barrier(const XcdBarrier& b) {
    asm volatile("s_waitcnt vmcnt(0)" ::: "memory");
    __syncthreads();
    if (threadIdx.x == 0) {
        unsigned* bar = b.bar;
        __builtin_amdgcn_s_waitcnt(0);
        unsigned nloc = b.st[0], nx = b.st[1];
        if (nloc == 0u) { xcd_barrier_complete(bar, b.x, nloc, nx); b.st[0] = nloc; b.st[1] = nx; }
        const unsigned old = xb_add(&bar[XB_XSUB(b.x)], 1u);
        const unsigned gen = old / nloc;
        if (old + 1u == (gen + 1u) * nloc) {
            __builtin_amdgcn_fence(__ATOMIC_RELEASE, "agent");
            asm volatile("s_waitcnt vmcnt(0)" ::: "memory");
            const unsigned og = xb_add(&bar[XB_TOP], 1u);
            const unsigned tg = og / nx;
            if (og + 1u == (tg + 1u) * nx) xb_add(&bar[XB_TOPGEN], 1u);
            else XB_SPIN(xb_ld(&bar[XB_TOPGEN]) == tg, bar);
            __builtin_amdgcn_fence(__ATOMIC_ACQUIRE, "agent");
            xb_add(&bar[XB_XGEN(b.x)], 1u);
            asm volatile("s_waitcnt vmcnt(0)" ::: "memory");
        } else {
            XB_SPIN(xb_ld(&bar[XB_XGEN(b.x)]) == gen, bar);
            __builtin_amdgcn_fence(__ATOMIC_ACQUIRE, "agent");
            asm volatile("s_waitcnt vmcnt(0)" ::: "memory");
        }
    }
    __syncthreads();
}

struct Args { const float* in[N_IN]; float* out; unsigned char* ws; int ph_lo, ph_hi, li, pad; };
struct Frame {
    LAS unsigned char* lds;
    volatile LAS unsigned* MISC;
    gu32* ctl;
    int tid, lane, wave, G, bid;
    unsigned char* ws;
};

template <bool I8> __device__ __forceinline__ void cvt_row_store(const f32x4 (&v)[4], int row, unsigned char* dst, float* inv_scale, int lane) {
    float m = 0.f;
#pragma unroll
    for (int j = 0; j < 4; ++j) m = fmaxf(m, fmaxf(fmaxf(fabsf(v[j].x), fabsf(v[j].y)), fmaxf(fabsf(v[j].z), fabsf(v[j].w))));
#pragma unroll
    for (int o = 1; o < 64; o <<= 1) m = fmaxf(m, __shfl_xor(m, o));
    unsigned ww[4]; float isc;
    if (I8) { const float sc = m > 0.f ? 127.0f / m : 0.f; isc = m * (1.0f / 127.0f);
#pragma unroll
        for (int j = 0; j < 4; ++j) { const int q0 = (int)rintf(v[j].x * sc), q1 = (int)rintf(v[j].y * sc), q2 = (int)rintf(v[j].z * sc), q3 = (int)rintf(v[j].w * sc);
            ww[j] = ((unsigned)q0 & 0xffu) | (((unsigned)q1 & 0xffu) << 8) | (((unsigned)q2 & 0xffu) << 16) | (((unsigned)q3 & 0xffu) << 24); } }
    else { const unsigned E = (__builtin_bit_cast(unsigned, m) >> 23) & 0xffu; float sc = 1.f; isc = 1.f;
        if (E >= 8u && E <= 250u) { sc = __builtin_bit_cast(float, (261u - E) << 23); isc = __builtin_bit_cast(float, (E - 7u) << 23); }
#pragma unroll
        for (int j = 0; j < 4; ++j) { int t = __builtin_amdgcn_cvt_pk_fp8_f32(v[j].x * sc, v[j].y * sc, 0, false); t = __builtin_amdgcn_cvt_pk_fp8_f32(v[j].z * sc, v[j].w * sc, t, true); ww[j] = (unsigned)t; } }
    *(GAS v4u*)(dst + (size_t)(lane >> 3) * NEXP * 128 + (size_t)row * 128 + 16 * (lane & 7)) = (v4u){ww[0], ww[1], ww[2], ww[3]};
    if (lane == 0) inv_scale[row] = isc;
}
template <bool I8> __device__ __forceinline__ void cvt_rows_8bit(const float* src, unsigned char* dst, float* inv_scale, int gw, int NGW, int lane) {
    for (int row = gw; row < NEXP; row += 2 * NGW) {
        const int row1 = row + NGW; const bool has1 = row1 < NEXP;
        f32x4 v0[4], v1[4];
#pragma unroll
        for (int j = 0; j < 4; ++j) v0[j] = *(const GAS f32x4*)(src + (size_t)row * D + 16 * lane + 4 * j);
#pragma unroll
        for (int j = 0; j < 4; ++j) v1[j] = has1 ? *(const GAS f32x4*)(src + (size_t)row1 * D + 16 * lane + 4 * j) : (f32x4){0.f, 0.f, 0.f, 0.f};
        cvt_row_store<I8>(v0, row, dst, inv_scale, lane);
        if (has1) cvt_row_store<I8>(v1, row1, dst, inv_scale, lane);
    }
}
__device__ __forceinline__ void p0_transpose_item(const float* W, int ldw, int src_col0, int valid, int K, bf16* WT, int dst_row0, int k0, LAS float* scr, int lane) {
    const int n_ = lane & 31;
#pragma unroll 8
    for (int i = 0; i < 32; ++i) { const int kk = 2 * i + (lane >> 5); scr[kk * 33 + n_] = (n_ < valid) ? W[(size_t)(k0 + kk) * ldw + src_col0 + n_] : 0.f; }
    LDS_WAIT(); asm volatile("" ::: "memory");
    const int c = lane & 7;
#pragma unroll
    for (int j = 0; j < 4; ++j) { const int n = (lane >> 3) + 8 * j; const LAS float* s = scr + (8 * c) * 33 + n;
        v4u o; o.x = pk2(s[0 * 33], s[1 * 33]); o.y = pk2(s[2 * 33], s[3 * 33]); o.z = pk2(s[4 * 33], s[5 * 33]); o.w = pk2(s[6 * 33], s[7 * 33]);
        *(GAS v4u*)(WT + (size_t)(dst_row0 + n) * K + k0 + 8 * c) = o; }
    LDS_WAIT(); asm volatile("" ::: "memory");
}
__device__ __forceinline__ bool p0_mat(int& r, const float* W, int K, int N, bf16* WT, LAS float* scr, int lane) {
    const int ng = N / 32, items = ng * (K / 64);
    if (r < items) { const int kb = r / ng, nb = r % ng; p0_transpose_item(W, N, 32 * nb, 32, K, WT, 32 * nb, 64 * kb, scr, lane); return true; }
    r -= items; return false;
}
__device__ __forceinline__ void cvt_f32_bf16_stream(const float* src, bf16* dst, size_t n8, size_t gtid, size_t gthreads) {
    for (size_t i = gtid; i < n8; i += gthreads) {
        const f32x4 a = *(const GAS f32x4*)(src + 8 * i), b = *(const GAS f32x4*)(src + 8 * i + 4);
        v4u o; o.x = pk2(a.x, a.y); o.y = pk2(a.z, a.w); o.z = pk2(b.x, b.y); o.w = pk2(b.z, b.w);
        *(GAS v4u*)(dst + 8 * i) = o; }
}

__device__ __forceinline__ void p0_prologue(Frame& F, const Args& args) {
    unsigned char* ws = F.ws;
    const int gw = F.bid * NWAVES + F.wave, NGW = F.G * NWAVES;
    const size_t gtid = (size_t)F.bid * NTHREADS + F.tid, gthreads = (size_t)F.G * NTHREADS;
    {
        LAS float* sl = (LAS float*)(F.lds);
        LAS float* red = (LAS float*)(F.lds + 32768);
        const float* c = args.in[I_C];
        for (int i = F.tid; i < BATCH * D; i += NTHREADS) { const float v = c[i]; sl[i] = v / (1.0f + __expf(-v)); }
        __syncthreads();
        for (int cb = F.bid; cb < 6 * D / 24; cb += F.G) {
            const int j0 = cb * 24;
            if (F.tid < 504) {
                const int kk = F.tid / 24, jj = F.tid % 24;
                float a[BATCH];
#pragma unroll
                for (int b = 0; b < BATCH; ++b) a[b] = 0.f;
                const float* w = args.in[I_ADAW] + j0 + jj;
                for (int k = kk; k < D; k += 21) { const float wv = w[(size_t)k * (6 * D)];
#pragma unroll
                    for (int b = 0; b < BATCH; ++b) a[b] += sl[b * D + k] * wv; }
#pragma unroll
                for (int b = 0; b < BATCH; ++b) red[(kk * 24 + jj) * BATCH + b] = a[b];
            }
            __syncthreads();
            if (F.tid < 24 * BATCH) { const int jj = F.tid / BATCH, b = F.tid % BATCH; float s = 0.f;
                for (int kk = 0; kk < 21; ++kk) s += red[(kk * 24 + jj) * BATCH + b];
                ((float*)(ws + WS_ADA))[b * (6 * D) + j0 + jj] = s + args.in[I_ADAB][j0 + jj]; }
            __syncthreads();
        }
    }
    if (F.bid >= 8 && F.bid < 40) {
        const int bb = F.bid - 8, kv = bb & 1, ch = bb >> 1;
        const float* pe = args.in[kv == 0 ? I_CPEK : I_CPEV]; const float* w1 = args.in[kv == 0 ? I_CW1K : I_CW1V];
        LAS float* red = (LAS float*)(F.lds);
        const int j = F.tid & 127, ic = F.tid >> 7; float s = 0.f;
        const int i0 = ch * 128 + ic * 32;
#pragma unroll 8
        for (int i = i0; i < i0 + 32; ++i) s += pe[i] * w1[(size_t)i * 128 + j];
        red[ic * 128 + j] = s; __syncthreads();
        if (F.tid < 128) atomicAdd((float*)(ws + (kv == 0 ? WS_CB1K : WS_CB1V)) + F.tid, (red[F.tid] + red[128 + F.tid]) + (red[256 + F.tid] + red[384 + F.tid]));
        __syncthreads();
    } else if (F.bid == 2) {
        for (int i = F.tid; i < 8 * 128; i += NTHREADS) { const int h = i >> 7, rel = i & 127;
            int bk = rel;
            if (rel >= 16) bk = 16 + (rel >= 19) + (rel >= 21) + (rel >= 24) + (rel >= 27) + (rel >= 31) + (rel >= 35) + (rel >= 40) + (rel >= 46) + (rel >= 52) + (rel >= 59) + (rel >= 67) + (rel >= 77) + (rel >= 87) + (rel >= 99) + (rel >= 113);
            ((float*)(ws + WS_BIASL))[i] = args.in[I_RELB][bk * 8 + h]; }
        if (F.tid < 64) {
            float mq = fabsf(args.in[I_QNG][F.tid]), mk = fmaxf(fmaxf(fabsf(args.in[I_KNG][F.tid]), fabsf(args.in[I_KNG][64 + F.tid])), fabsf(args.in[I_KNG][128 + F.tid]));
            float mb = fmaxf(fmaxf(fabsf(args.in[I_RELB][F.tid]), fabsf(args.in[I_RELB][64 + F.tid])), fmaxf(fabsf(args.in[I_RELB][128 + F.tid]), fabsf(args.in[I_RELB][192 + F.tid])));
#pragma unroll
            for (int o = 1; o < 64; o <<= 1) { mq = fmaxf(mq, __shfl_xor(mq, o)); mk = fmaxf(mk, __shfl_xor(mk, o)); mb = fmaxf(mb, __shfl_xor(mb, o)); }
            if (F.tid == 0) ((float*)(ws + WS_BIASL))[8 * 128] = 8.0f * mq * mk + mb; }
    }
    {
        LAS float* scr = (LAS float*)(F.lds + F.wave * 16384);
        constexpr int I_WINT = (NIN / 32) * (D / 64);
        constexpr int NITEMS = I_WINT + (1024 / 32) * (512 / 64) + (1024 / 32) * (1024 / 64) + (2048 / 32) * (1024 / 64) + 2 * (128 / 32) * (2048 / 64) + 2 * (64 / 32) * (128 / 64);
        for (int it = gw; it < NITEMS; it += NGW) {
            int r = it;
            if (r < I_WINT) {
                const int grp = r % (NIN / 32), kb = r / (NIN / 32);
                const int tile = grp >> 3, ct0 = (grp & 7) * 32;
                const int L0 = 64 * ((ct0 >> 5) & 3) + 32 * (ct0 >> 7);
                int src0, valid = 32;
                if (tile < 7) src0 = 256 * tile + L0; else if (tile < 15) src0 = 1816 + 256 * (tile - 7) + L0; else { src0 = 1792 + L0; valid = (L0 == 0) ? 24 : 0; }
                if (valid == 0) src0 = 0;
                p0_transpose_item(args.in[I_WIN], IN_COLS, src0, valid, D, (bf16*)(ws + WS_WIN_T), 32 * grp, 64 * kb, scr, F.lane);
                continue; }
            r -= I_WINT;
            if (p0_mat(r, args.in[I_WBA], 512, 1024, (bf16*)(ws + WS_WBA_T), scr, F.lane)) continue;
            if (p0_mat(r, args.in[I_WOUT], 1024, 1024, (bf16*)(ws + WS_WOUT_T), scr, F.lane)) continue;
            if (p0_mat(r, args.in[I_PWQ], 1024, 2048, (bf16*)(ws + WS_WQ_T), scr, F.lane)) continue;
            if (p0_mat(r, args.in[I_CW1K], 2048, 128, (bf16*)(ws + WS_CW1K_T), scr, F.lane)) continue;
            if (p0_mat(r, args.in[I_CW1V], 2048, 128, (bf16*)(ws + WS_CW1V_T), scr, F.lane)) continue;
            if (p0_mat(r, args.in[I_CW2K], 128, 64, (bf16*)(ws + WS_CW2K_T), scr, F.lane)) continue;
            p0_mat(r, args.in[I_CW2V], 128, 64, (bf16*)(ws + WS_CW2V_T), scr, F.lane);
        }
    }
    {
        const float* pw = args.in[I_POOLW]; const float* ps = args.in[I_POOLS]; const float* wbp = args.in[I_WBP];
        bf16* weff = (bf16*)(ws + WS_WEFF_T);
        LAS float* PWl = (LAS float*)(F.lds);
        LAS float* WBl = (LAS float*)(F.lds + 128 * 129 * 4);
        __syncthreads();
        for (int bb = F.bid; bb < 256; bb += F.G) {
            const int g = bb >> 6, d0 = (bb & 63) * 16;
            for (int i = F.tid; i < 128 * 128; i += NTHREADS) PWl[(i >> 7) * 129 + (i & 127)] = pw[(size_t)g * 16384 + i];
            for (int i = F.tid; i < 128 * 16; i += NTHREADS) { const int cc = i >> 4, dd = i & 15; WBl[cc * 17 + dd] = wbp[(size_t)(g * 128 + cc) * D + d0 + dd] * ps[g * 128 + cc]; }
            __syncthreads();
            const int c = F.tid & 127, q = F.tid >> 7;
            float acc4[4] = {0.f, 0.f, 0.f, 0.f};
#pragma unroll 4
            for (int cc = 0; cc < 128; ++cc) { const float a = PWl[c * 129 + cc];
#pragma unroll
                for (int e = 0; e < 4; ++e) acc4[e] += a * WBl[cc * 17 + 4 * q + e]; }
#pragma unroll
            for (int e = 0; e < 4; ++e) weff[(size_t)(d0 + 4 * q + e) * POOLW + g * 128 + c] = (bf16)f2bf(acc4[e]);
            __syncthreads();
        }
    }
    cvt_f32_bf16_stream(args.in[I_PSK], (bf16*)(ws + WS_SUBK), (size_t)16 * 128 * 128 / 8, gtid, gthreads);
    cvt_rows_8bit<true>(args.in[I_PU], ws + WS_UB, (float*)(ws + WS_SCLU), gw, NGW, F.lane);
    cvt_rows_8bit<false>(args.in[I_PV], ws + WS_VB, (float*)(ws + WS_SCLV), gw, NGW, F.lane);
}

template <bool Q8> __device__ __forceinline__ void modnorm_rows(Frame& F, const float* x, const float* g, const float* ada, int shift_idx, bf16* out) {
    const int gw = F.bid * NWAVES + F.wave, NGW = F.G * NWAVES;
    for (int m = gw; m < M; m += NGW) {
        const int b = m >> 12;
        const GAS f32x4* xr = (const GAS f32x4*)(x + (size_t)m * D) + F.lane;
        const GAS f32x4* gr = (const GAS f32x4*)g + F.lane;
        const GAS f32x4* sh = (const GAS f32x4*)(ada + (size_t)b * 6 * D + shift_idx * D) + F.lane;
        const GAS f32x4* sc = (const GAS f32x4*)(ada + (size_t)b * 6 * D + (shift_idx + 1) * D) + F.lane;
        f32x4 v[4]; float s = 0.f;
#pragma unroll
        for (int j = 0; j < 4; ++j) { v[j] = xr[64 * j]; s += (v[j].x * v[j].x + v[j].y * v[j].y) + (v[j].z * v[j].z + v[j].w * v[j].w); }
        const float rstd = rsqrtf(wave_sum(s) * (1.f / D) + EPS);
        GAS v2u* o8 = (GAS v2u*)(out + (size_t)m * D) + F.lane;
        float mx = 0.f;
#pragma unroll
        for (int j = 0; j < 4; ++j) { const f32x4 gg = gr[64 * j], ss = sh[64 * j], cc = sc[64 * j];
            const f32x4 y = (v[j] * rstd) * gg * (cc + 1.0f) + ss; v[j] = y;
            mx = fmaxf(mx, fmaxf(fmaxf(fabsf(y.x), fabsf(y.y)), fmaxf(fabsf(y.z), fabsf(y.w))));
            v2u o; o.x = pk2(y.x, y.y); o.y = pk2(y.z, y.w); o8[64 * j] = o; }
        if (Q8) {
#pragma unroll
            for (int o = 1; o < 64; o <<= 1) mx = fmaxf(mx, __shfl_xor(mx, o));
            const float qs = mx > 0.f ? 127.0f / mx : 0.f;
            GAS unsigned* h8 = (GAS unsigned*)(F.ws + WS_H8 + (size_t)m * D) + F.lane;
#pragma unroll
            for (int j = 0; j < 4; ++j) { const int q0 = (int)rintf(v[j].x * qs), q1 = (int)rintf(v[j].y * qs), q2 = (int)rintf(v[j].z * qs), q3 = (int)rintf(v[j].w * qs);
                h8[64 * j] = ((unsigned)q0 & 0xffu) | (((unsigned)q1 & 0xffu) << 8) | (((unsigned)q2 & 0xffu) << 16) | (((unsigned)q3 & 0xffu) << 24); }
            if (F.lane == 0) ((float*)(F.ws + WS_HS))[m] = mx * (1.0f / 127.0f);
        }
    }
}

struct EpiIn {
    static constexpr bool PERM = true, AFTER_DRAIN = false;
    unsigned char* ws; const float* qg; const float* kg;
    __device__ __forceinline__ void operator()(const pg8::f32x4 (&acc)[2][2][4][2], const pg8::Unit& u, int wr, int wc, int fr, int fq) const {
        const int pn = u.pn;
#pragma unroll
        for (int ai = 0; ai < 2; ++ai)
#pragma unroll
            for (int m = 0; m < 4; ++m) {
                const int row = u.pm * 256 + ai * 128 + wr * 64 + m * 16 + fr;
                float v[2][8];
#pragma unroll
                for (int bj = 0; bj < 2; ++bj)
#pragma unroll
                    for (int n = 0; n < 2; ++n)
#pragma unroll
                        for (int i = 0; i < 4; ++i) v[bj][4 * n + i] = acc[ai][bj][m][n][i];
                bf16* dst = nullptr; bool norm = false; const float* gain = nullptr; float mul = 1.f; bool sig = false;
                if (pn < 2) { dst = (bf16*)(ws + WS_ZP) + (size_t)row * 512 + 256 * pn + 64 * wc; }
                else if (pn < 4) { dst = (bf16*)(ws + WS_Q) + (size_t)row * 512 + 256 * (pn - 2) + 64 * wc; norm = true; gain = qg; mul = 0.125f * 1.4426950408889634f; }
                else if (pn < 7) { const int kind = pn - 4, isv = wc >> 1, g = wc & 1, b = row >> 12, t = row & 4095;
                    const size_t base = ((size_t)(b * 2 + g) * SEQ + t) * 64;
                    const size_t off = kind == 0 ? (isv ? WS_VCR : WS_KCR) : kind == 1 ? (isv ? WS_VS : WS_KS) : (isv ? WS_VW : WS_KW);
                    dst = (bf16*)(ws + off) + base; if (!isv && kind > 0) { norm = true; gain = kg + kind * 64; } }
                else if (pn < 15) { dst = (bf16*)(ws + WS_GM) + (size_t)row * 2048 + 256 * (pn - 7) + 64 * wc; sig = true; }
                else {
                    if (wc == 0 && fq < 3) { float* gp = (float*)(ws + WS_GATE) + (size_t)row * 24 + 8 * fq;
                        *(GAS f32x4*)gp = (f32x4){sigmoidf_(v[0][0]), sigmoidf_(v[0][1]), sigmoidf_(v[0][2]), sigmoidf_(v[0][3])};
                        *(GAS f32x4*)(gp + 4) = (f32x4){sigmoidf_(v[0][4]), sigmoidf_(v[0][5]), sigmoidf_(v[0][6]), sigmoidf_(v[0][7])}; }
                    continue; }
                if (norm) { float ss = 0.f;
#pragma unroll
                    for (int bj = 0; bj < 2; ++bj)
#pragma unroll
                        for (int e = 0; e < 8; ++e) ss += v[bj][e] * v[bj][e];
                    ss += __shfl_xor(ss, 16); ss += __shfl_xor(ss, 32);
                    const float rs = rsqrtf(ss * (1.f / 64.f) + EPS) * mul;
#pragma unroll
                    for (int bj = 0; bj < 2; ++bj)
#pragma unroll
                        for (int e = 0; e < 8; ++e) v[bj][e] = v[bj][e] * rs * gain[32 * bj + 8 * fq + e]; }
                if (sig) {
#pragma unroll
                    for (int bj = 0; bj < 2; ++bj)
#pragma unroll
                        for (int e = 0; e < 8; ++e) v[bj][e] = sigmoidf_(v[bj][e]); }
#pragma unroll
                for (int bj = 0; bj < 2; ++bj) { v4u o; o.x = pkh(v[bj][0], v[bj][1]); o.y = pkh(v[bj][2], v[bj][3]); o.z = pkh(v[bj][4], v[bj][5]); o.w = pkh(v[bj][6], v[bj][7]);
                    *(GAS v4u*)(dst + 32 * bj + 8 * fq) = o; }
            }
    }
};
template <bool ADD> struct EpiMix {
    static constexpr bool PERM = true, AFTER_DRAIN = false;
    bf16* MIX; const bf16* GM; int gmoff;
    __device__ __forceinline__ void operator()(const pg8::f32x4 (&acc)[2][2][4][2], const pg8::Unit& u, int wr, int wc, int fr, int fq) const {
#pragma unroll
        for (int ai = 0; ai < 2; ++ai)
#pragma unroll
            for (int m = 0; m < 4; ++m) {
                const int row = u.pm * 256 + ai * 128 + wr * 64 + m * 16 + fr;
#pragma unroll
                for (int bj = 0; bj < 2; ++bj) {
                    const int col = u.pn * 256 + bj * 128 + wc * 32 + 8 * fq;
                    const v4u gmv = *(const GAS v4u*)(GM + (size_t)row * 2048 + gmoff + col);
                    float r[8];
                    r[0] = acc[ai][bj][m][0][0] * bflo(gmv.x); r[1] = acc[ai][bj][m][0][1] * bfhi(gmv.x); r[2] = acc[ai][bj][m][0][2] * bflo(gmv.y); r[3] = acc[ai][bj][m][0][3] * bfhi(gmv.y);
                    r[4] = acc[ai][bj][m][1][0] * bflo(gmv.z); r[5] = acc[ai][bj][m][1][1] * bfhi(gmv.z); r[6] = acc[ai][bj][m][1][2] * bflo(gmv.w); r[7] = acc[ai][bj][m][1][3] * bfhi(gmv.w);
                    GAS v4u* dp = (GAS v4u*)(MIX + (size_t)row * 1024 + col);
                    if (ADD) { const v4u old = *dp; r[0] += bflo(old.x); r[1] += bfhi(old.x); r[2] += bflo(old.y); r[3] += bfhi(old.y); r[4] += bflo(old.z); r[5] += bfhi(old.z); r[6] += bflo(old.w); r[7] += bfhi(old.w); }
                    v4u o; o.x = pkh(r[0], r[1]); o.y = pkh(r[2], r[3]); o.z = pkh(r[4], r[5]); o.w = pkh(r[6], r[7]); *dp = o; }
            }
    }
};
struct EpiRes {
    static constexpr bool PERM = false, AFTER_DRAIN = false;
    const float* x; float* out; const float* ada; int gate_idx;
    __device__ __forceinline__ void operator()(const pg8::f32x4 (&acc)[2][2][4][2], const pg8::Unit& u, int wr, int wc, int fr, int fq) const {
#pragma unroll
        for (int ai = 0; ai < 2; ++ai)
#pragma unroll
            for (int m = 0; m < 4; ++m) {
                const int row = u.pm * 256 + ai * 128 + wr * 64 + m * 16 + fr, b = row >> 12;
#pragma unroll
                for (int bj = 0; bj < 2; ++bj)
#pragma unroll
                    for (int n = 0; n < 2; ++n) {
                        const int col = u.pn * 256 + bj * 128 + wc * 32 + 16 * n + 4 * fq;
                        const f32x4 gt = *(const GAS f32x4*)(ada + (size_t)b * 6 * D + gate_idx * D + col);
                        const f32x4 xv = *(const GAS f32x4*)(x + (size_t)row * D + col);
                        *(GAS f32x4*)(out + (size_t)row * D + col) = xv + gt * acc[ai][bj][m][n]; }
            }
    }
};

template <int W> __device__ __forceinline__ void pool_item(const bf16* zp, bf16* pl, int row, int col) {
    const int t = row & 4095;
    float s[8], self[8];
#pragma unroll
    for (int e = 0; e < 8; ++e) { s[e] = 0.f; self[e] = 0.f; }
    v4u z[W];
#pragma unroll
    for (int j = 0; j < W; ++j) z[j] = (j <= t) ? *(const GAS v4u*)(zp + (size_t)(row - j) * 512 + col) : (v4u){0u, 0u, 0u, 0u};
#pragma unroll
    for (int j = 0; j < W; ++j) { const float f[8] = {bflo(z[j].x), bfhi(z[j].x), bflo(z[j].y), bfhi(z[j].y), bflo(z[j].z), bfhi(z[j].z), bflo(z[j].w), bfhi(z[j].w)};
#pragma unroll
        for (int e = 0; e < 8; ++e) { s[e] += f[e]; if (j == 0) self[e] = f[e]; } }
    const float inv = 1.0f / (float)((t + 1 < W) ? (t + 1) : W);
    v4u o; o.x = pk2(s[0] * inv - self[0], s[1] * inv - self[1]); o.y = pk2(s[2] * inv - self[2], s[3] * inv - self[3]);
    o.z = pk2(s[4] * inv - self[4], s[5] * inv - self[5]); o.w = pk2(s[6] * inv - self[6], s[7] * inv - self[7]);
    *(GAS v4u*)(pl + (size_t)row * 512 + col) = o;
}
__device__ __forceinline__ void pool_phase(Frame& F) {
    const bf16* zp = (const bf16*)(F.ws + WS_ZP); bf16* pl = (bf16*)(F.ws + WS_PL);
    const int gw = F.bid * NWAVES + F.wave, NGW = F.G * NWAVES;
    for (int item = gw; item < 4 * (M / 4); item += NGW) {
        const int gi = item & 3, r4 = item >> 2, row = 4 * r4 + (F.lane >> 4), col = 128 * gi + 8 * (F.lane & 15);
        if (gi == 0) pool_item<2>(zp, pl, row, col); else if (gi == 1) pool_item<4>(zp, pl, row, col); else if (gi == 2) pool_item<8>(zp, pl, row, col); else pool_item<16>(zp, pl, row, col);
    }
}

typedef int v4i __attribute__((ext_vector_type(4)));
struct EpiStoreBf16 {
    static constexpr bool PERM = true, AFTER_DRAIN = false;
    bf16* O; int ldc;
    __device__ __forceinline__ void operator()(const pg8::f32x4 (&acc)[2][2][4][2], const pg8::Unit& u, int wr, int wc, int fr, int fq) const {
#pragma unroll
        for (int ai = 0; ai < 2; ++ai)
#pragma unroll
            for (int m = 0; m < 4; ++m) {
                const int row = u.pm * 256 + ai * 128 + wr * 64 + m * 16 + fr;
#pragma unroll
                for (int bj = 0; bj < 2; ++bj) {
                    const int col = u.pn * 256 + bj * 128 + wc * 32 + 8 * fq;
                    v4u o; o.x = pkh(acc[ai][bj][m][0][0], acc[ai][bj][m][0][1]); o.y = pkh(acc[ai][bj][m][0][2], acc[ai][bj][m][0][3]);
                    o.z = pkh(acc[ai][bj][m][1][0], acc[ai][bj][m][1][1]); o.w = pkh(acc[ai][bj][m][1][2], acc[ai][bj][m][1][3]);
                    *(GAS v4u*)(O + (size_t)row * ldc + col) = o; }
            }
    }
};

__device__ __forceinline__ unsigned fkey(float f) { const unsigned u = __builtin_bit_cast(unsigned, f); return (u >> 31) ? ~u : (u | 0x80000000u); }
__device__ __forceinline__ float funkey(unsigned k) { const unsigned u = (k >> 31) ? (k & 0x7fffffffu) : ~k; return __builtin_bit_cast(float, u); }
__device__ __forceinline__ unsigned umax_(unsigned a, unsigned b) { return a > b ? a : b; }
__device__ __forceinline__ unsigned umin_(unsigned a, unsigned b) { return a > b ? b : a; }
#define TOP16_INSERT(L, xin) do { unsigned _x = (xin); _Pragma("unroll") for (int _i = 0; _i < 16; ++_i) { const unsigned _h = umax_(L[_i], _x); _x = umin_(L[_i], _x); L[_i] = _h; } } while (0)
template <int MASK> __device__ __forceinline__ void top16_merge(unsigned (&L)[16]) {
    unsigned o[16];
#pragma unroll
    for (int i = 0; i < 16; ++i) o[i] = (unsigned)__shfl_xor((int)L[i], MASK);
#pragma unroll
    for (int i = 0; i < 16; ++i) L[i] = umax_(L[i], o[15 - i]);
#pragma unroll
    for (int d = 8; d >= 1; d >>= 1)
#pragma unroll
        for (int i = 0; i < 16; ++i) if ((i & d) == 0) { const unsigned hi = umax_(L[i], L[i + d]), lo = umin_(L[i], L[i + d]); L[i] = hi; L[i + d] = lo; }
}
constexpr int SST = 132;
constexpr int P9_LIST_OFF = 2 * 64 * SST * 4;
__device__ __forceinline__ void peer_select_phase(Frame& F) {
    const bf16* QV = (const bf16*)(F.ws + WS_QV); const bf16* SK = (const bf16*)(F.ws + WS_SUBK);
    int* EID = (int*)(F.ws + WS_EID); float* GW = (float*)(F.ws + WS_GW);
    LAS float* S = (LAS float*)(F.lds);
    LAS unsigned* LIST = (LAS unsigned*)(F.lds + P9_LIST_OFF);
    const int lane = F.lane, w = F.wave, l15 = lane & 15, lq = lane >> 4;
    const int p = w >> 2, kb = w & 3;
    constexpr int NU = (M / 64) * PH;
    bf16x8 a[4][4], bq[2][4];
#define P9_LOAD(u_) do { const int _tt = (u_) >> 3, _h = (u_) & 7; \
        const bf16* qa = QV + (size_t)(_tt * 64 + l15) * PQW + _h * 256 + p * 128 + 8 * lq; \
        const bf16* kbp = SK + (size_t)((_h * 2 + p) * 128 + 32 * kb + l15) * 128 + 8 * lq; \
        _Pragma("unroll") for (int ks = 0; ks < 4; ++ks) { \
            _Pragma("unroll") for (int rb = 0; rb < 4; ++rb) a[rb][ks] = *(const GAS bf16x8*)(qa + (size_t)(16 * rb) * PQW + 32 * ks); \
            _Pragma("unroll") for (int cb = 0; cb < 2; ++cb) bq[cb][ks] = *(const GAS bf16x8*)(kbp + (size_t)(16 * cb) * 128 + 32 * ks); } } while (0)
    if (F.bid < NU) P9_LOAD(F.bid);
    for (int u = F.bid; u < NU; u += F.G) {
        const int tt = u >> 3, h = u & 7, tok0 = tt * 64;
        {
            pg8::f32x4 acc[4][2];
#pragma unroll
            for (int rb = 0; rb < 4; ++rb)
#pragma unroll
                for (int cb = 0; cb < 2; ++cb) acc[rb][cb] = (pg8::f32x4){0.f, 0.f, 0.f, 0.f};
#pragma unroll
            for (int ks = 0; ks < 4; ++ks)
#pragma unroll
                for (int rb = 0; rb < 4; ++rb)
#pragma unroll
                    for (int cb = 0; cb < 2; ++cb) acc[rb][cb] = __builtin_amdgcn_mfma_f32_16x16x32_bf16(a[rb][ks], bq[cb][ks], acc[rb][cb], 0, 0, 0);
#pragma unroll
            for (int rb = 0; rb < 4; ++rb)
#pragma unroll
                for (int cb = 0; cb < 2; ++cb)
#pragma unroll
                    for (int r = 0; r < 4; ++r) S[(p * 64 + 16 * rb + 4 * lq + r) * SST + 32 * kb + 16 * cb + l15] = acc[rb][cb][r];
        }
        __syncthreads();
        if (u + F.G < NU) P9_LOAD(u + F.G);
        {
            const int row = F.tid >> 2, sub = F.tid & 3;
            const LAS float* sr = S + row * SST + sub;
            unsigned L[16];
#pragma unroll
            for (int i = 0; i < 16; ++i) L[i] = 0u;
#pragma unroll 4
            for (int i = 0; i < 32; ++i) { const unsigned key = (fkey(sr[4 * i]) & ~127u) | (unsigned)(4 * i + sub); TOP16_INSERT(L, key); }
            top16_merge<1>(L); top16_merge<2>(L);
            if (sub == 0) {
#pragma unroll
                for (int i = 0; i < 4; ++i) *(LAS v4u*)(LIST + row * 16 + 4 * i) = (v4u){L[4 * i], L[4 * i + 1], L[4 * i + 2], L[4 * i + 3]}; }
        }
        __syncthreads();
        if (F.tid < 256) {
            const int tok = F.tid >> 2, sub = F.tid & 3;
            float va[16], vb[16];
#pragma unroll
            for (int i = 0; i < 4; ++i) { const v4u x = *(const LAS v4u*)(LIST + tok * 16 + 4 * i), y = *(const LAS v4u*)(LIST + (64 + tok) * 16 + 4 * i);
                va[4 * i] = funkey(x.x & ~127u); va[4 * i + 1] = funkey(x.y & ~127u); va[4 * i + 2] = funkey(x.z & ~127u); va[4 * i + 3] = funkey(x.w & ~127u);
                vb[4 * i] = funkey(y.x & ~127u); vb[4 * i + 1] = funkey(y.y & ~127u); vb[4 * i + 2] = funkey(y.z & ~127u); vb[4 * i + 3] = funkey(y.w & ~127u); }
            unsigned L[16];
#pragma unroll
            for (int i = 0; i < 16; ++i) L[i] = 0u;
            {
                constexpr int NC = 50;
                constexpr unsigned char CI[52] = {0,0,0,0,0,0,0,0,0,0,0,0,0,0,0,0, 1,1,1,1,1,1,1,1, 2,2,2,2,2, 3,3,3,3, 4,4,4, 5,5, 6,6, 7,7, 8,9,10,11,12,13,14,15, 0,0};
                constexpr unsigned char CJ[52] = {0,1,2,3,4,5,6,7,8,9,10,11,12,13,14,15, 0,1,2,3,4,5,6,7, 0,1,2,3,4, 0,1,2,3, 0,1,2, 0,1, 0,1, 0,1, 0,0,0,0,0,0,0,0, 0,0};
#pragma unroll
                for (int g4 = 0; g4 < 13; ++g4) {
                    float sa = 0.f, sb = 0.f; unsigned id = 0u; bool ok = false;
#pragma unroll
                    for (int q = 0; q < 4; ++q) { const int n = 4 * g4 + q; if (n < NC) { const bool me = (sub == q); sa = me ? va[CI[n]] : sa; sb = me ? vb[CJ[n]] : sb; id = me ? (unsigned)(CI[n] * 16 + CJ[n]) : id; ok = ok || me; } }
                    const unsigned key = ok ? ((fkey(sa + sb) & ~255u) | id) : 0u;
                    TOP16_INSERT(L, key);
                }
            }
            top16_merge<1>(L); top16_merge<2>(L);
            const float mx = funkey(L[0] & ~255u);
            float e[16], sum = 0.f;
#pragma unroll
            for (int k = 0; k < 16; ++k) { e[k] = __expf(funkey(L[k] & ~255u) - mx); sum += e[k]; }
            const float inv = 1.0f / sum;
            const size_t ob = (size_t)(tok0 + tok) * 128;
#pragma unroll
            for (int k4 = 0; k4 < 4; ++k4) if (sub == k4) {
#pragma unroll
                for (int q = 0; q < 4; ++q) { const unsigned cid = L[4 * k4 + q] & 255u;
                    const unsigned ia = LIST[tok * 16 + (cid >> 4)] & 127u, ib = LIST[(64 + tok) * 16 + (cid & 15u)] & 127u;
                    const int slot = h * 16 + 4 * k4 + q;
                    EID[ob + slot] = (int)(ia * 128u + ib); GW[ob + slot] = e[4 * k4 + q] * inv; }
            }
        }
        __syncthreads();
    }
#undef P9_LOAD
}

__device__ __forceinline__ void unpack8(const v4u w, float (&f)[8]) { f[0] = bflo(w.x); f[1] = bfhi(w.x); f[2] = bflo(w.y); f[3] = bfhi(w.y); f[4] = bflo(w.z); f[5] = bfhi(w.z); f[6] = bflo(w.w); f[7] = bfhi(w.w); }
typedef float f32x2 __attribute__((ext_vector_type(2)));
__device__ __forceinline__ void unpack16_fp8(const v4u w, float (&f)[16]) {
    const unsigned ww[4] = {w.x, w.y, w.z, w.w};
#pragma unroll
    for (int d = 0; d < 4; ++d) { const f32x2 a = __builtin_amdgcn_cvt_pk_f32_fp8((int)ww[d], false), b = __builtin_amdgcn_cvt_pk_f32_fp8((int)ww[d], true);
        f[4 * d] = a.x; f[4 * d + 1] = a.y; f[4 * d + 2] = b.x; f[4 * d + 3] = b.y; }
}
template <int PV_> __device__ __forceinline__ void peer_dot_phase(Frame& F) {
    const unsigned char* H8 = F.ws + WS_H8; const int* EID = (const int*)(F.ws + WS_EID); float* PART = (float*)(F.ws + WS_PART);
    const int lane = F.lane, g = lane >> 3, j = lane & 7, x = F.bid & 7;
    const int nbx = (F.G - x + 7) >> 3, NW = nbx * NWAVES, gwv = (F.bid >> 3) * NWAVES + F.wave;
    const unsigned char* US = F.ws + WS_UB + (size_t)x * NEXP * 128; const unsigned j16 = 16u * (unsigned)j;
    int token = gwv;
    if (token >= M) return;
    v4i e4[4]; v4i hb;
#define PD_LOAD_E(tok_) do { _Pragma("unroll") for (int q = 0; q < 4; ++q) e4[q] = *(const GAS v4i*)(EID + (size_t)(tok_) * 128 + 16 * g + 4 * q); } while (0)
#define PD_ISSUE4(buf_, e_, b0_) do { buf_[b0_] = *(const GAS v4i*)(US + ((unsigned)e_.x * 128u + j16)); buf_[b0_ + 1] = *(const GAS v4i*)(US + ((unsigned)e_.y * 128u + j16)); \
        buf_[b0_ + 2] = *(const GAS v4i*)(US + ((unsigned)e_.z * 128u + j16)); buf_[b0_ + 3] = *(const GAS v4i*)(US + ((unsigned)e_.w * 128u + j16)); } while (0)
#define PD_DOT1(w_, dst_) do { int t = __builtin_amdgcn_sdot4(w_.x, hc.x, 0, false); t = __builtin_amdgcn_sdot4(w_.y, hc.y, t, false); t = __builtin_amdgcn_sdot4(w_.z, hc.z, t, false); t = __builtin_amdgcn_sdot4(w_.w, hc.w, t, false); \
        t += __shfl_xor(t, 1); t += __shfl_xor(t, 2); t += __shfl_xor(t, 4); dst_ = (float)t; } while (0)
    PD_LOAD_E(token); hb = *(const GAS v4i*)(H8 + (size_t)token * D + 128 * x + j16);
    v4i bA[8], bB[8];
    PD_ISSUE4(bA, e4[0], 0); PD_ISSUE4(bA, e4[1], 4);
    for (; token < M; token += NW) {
        const bool more = token + NW < M;
        PD_ISSUE4(bB, e4[2], 0); PD_ISSUE4(bB, e4[3], 4);
        const v4i hc = hb;
        if (more) { PD_LOAD_E(token + NW); hb = *(const GAS v4i*)(H8 + (size_t)(token + NW) * D + 128 * x + j16); }
        float s[16];
#pragma unroll
        for (int i = 0; i < 8; ++i) PD_DOT1(bA[i], s[i]);
        if (more) { PD_ISSUE4(bA, e4[0], 0); PD_ISSUE4(bA, e4[1], 4); }
#pragma unroll
        for (int i = 0; i < 8; ++i) PD_DOT1(bB[i], s[8 + i]);
        if (j == 0) { float* pp = PART + ((size_t)x * M + token) * 128 + g * 16;
#pragma unroll
            for (int i4 = 0; i4 < 4; ++i4) *(GAS f32x4*)(pp + 4 * i4) = (f32x4){s[4 * i4], s[4 * i4 + 1], s[4 * i4 + 2], s[4 * i4 + 3]}; }
    }
#undef PD_LOAD_E
#undef PD_ISSUE4
#undef PD_DOT1
}
__device__ __forceinline__ void peer_coef_phase(Frame& F) {
    const float* PART = (const float*)(F.ws + WS_PART); const int* EID = (const int*)(F.ws + WS_EID); const float* GW = (const float*)(F.ws + WS_GW); float* CF = (float*)(F.ws + WS_CF);
    const float* SCU = (const float*)(F.ws + WS_SCLU); const float* SCV = (const float*)(F.ws + WS_SCLV); const float* HS = (const float*)(F.ws + WS_HS);
    const size_t gtid = (size_t)F.bid * NTHREADS + F.tid, gthreads = (size_t)F.G * NTHREADS, n4 = (size_t)M * 128 / 4;
    for (size_t i4 = gtid; i4 < n4; i4 += gthreads) {
        f32x4 d = *(const GAS f32x4*)(PART + 4 * i4);
#pragma unroll
        for (int xx = 1; xx < 8; ++xx) d = d + *(const GAS f32x4*)(PART + (size_t)xx * M * 128 + 4 * i4);
        const v4i e = *(const GAS v4i*)(EID + 4 * i4); const f32x4 gw = *(const GAS f32x4*)(GW + 4 * i4);
        const float hs = HS[i4 >> 5];
        f32x4 r; r.x = gw.x * SCV[e.x] * gelu_tanh_safe(d.x * (SCU[e.x] * hs)); r.y = gw.y * SCV[e.y] * gelu_tanh_safe(d.y * (SCU[e.y] * hs));
        r.z = gw.z * SCV[e.z] * gelu_tanh_safe(d.z * (SCU[e.z] * hs)); r.w = gw.w * SCV[e.w] * gelu_tanh_safe(d.w * (SCU[e.w] * hs));
        *(GAS f32x4*)(CF + 4 * i4) = r; }
}
template <bool DRY> __device__ __forceinline__ void peer_out_phase(Frame& F, const float* ada, float* out) {
    const int* EID = (const int*)(F.ws + WS_EID); const float* CF = (const float*)(F.ws + WS_CF);
    const int lane = F.lane, g = lane >> 3, j = lane & 7, x = F.bid & 7;
    const int nbx = (F.G - x + 7) >> 3, NW = nbx * NWAVES, gwv = (F.bid >> 3) * NWAVES + F.wave;
    const unsigned char* VS = F.ws + WS_VB + (size_t)x * NEXP * 128; const unsigned j16 = 16u * (unsigned)j;
    if (gwv >= M) return;
    const int ntok = (M - 1 - gwv) / NW + 1;
#define PO_ISSUE4(buf_, e_, b0_) do { buf_[b0_] = *(const GAS v4u*)(VS + ((unsigned)e_.x * 128u + j16)); buf_[b0_ + 1] = *(const GAS v4u*)(VS + ((unsigned)e_.y * 128u + j16)); \
        buf_[b0_ + 2] = *(const GAS v4u*)(VS + ((unsigned)e_.z * 128u + j16)); buf_[b0_ + 3] = *(const GAS v4u*)(VS + ((unsigned)e_.w * 128u + j16)); } while (0)
#define PO_ROW(w_, c_) do { float f[16]; unpack16_fp8(w_, f); _Pragma("unroll") for (int k = 0; k < 16; ++k) o[k] += (c_) * f[k]; } while (0)
#define PO_ACC4(buf_, c4_, b0_) do { PO_ROW(buf_[b0_], c4_.x); PO_ROW(buf_[b0_ + 1], c4_.y); PO_ROW(buf_[b0_ + 2], c4_.z); PO_ROW(buf_[b0_ + 3], c4_.w); } while (0)
    v4i e4[4]; f32x4 c4[4]; v4u bA[8], bB[8];
#pragma unroll
    for (int q = 0; q < 4; ++q) { e4[q] = *(const GAS v4i*)(EID + (size_t)gwv * 128 + g * 16 + 4 * q); c4[q] = *(const GAS f32x4*)(CF + (size_t)gwv * 128 + g * 16 + 4 * q); }
    PO_ISSUE4(bA, e4[0], 0); PO_ISSUE4(bA, e4[1], 4);
    for (int it = 0; it < ntok; ++it) {
        const int token = gwv + it * NW, tn = gwv + (it + 1 < ntok ? it + 1 : it) * NW;
        PO_ISSUE4(bB, e4[2], 0); PO_ISSUE4(bB, e4[3], 4);
#pragma unroll
        for (int q = 0; q < 4; ++q) e4[q] = *(const GAS v4i*)(EID + (size_t)tn * 128 + g * 16 + 4 * q);
        float o[16];
#pragma unroll
        for (int k = 0; k < 16; ++k) o[k] = 0.f;
        PO_ACC4(bA, c4[0], 0); PO_ACC4(bA, c4[1], 4);
        PO_ISSUE4(bA, e4[0], 0); PO_ISSUE4(bA, e4[1], 4);
        PO_ACC4(bB, c4[2], 0); PO_ACC4(bB, c4[3], 4);
#pragma unroll
        for (int q = 0; q < 4; ++q) c4[q] = *(const GAS f32x4*)(CF + (size_t)tn * 128 + g * 16 + 4 * q);
#pragma unroll
        for (int k = 0; k < 16; ++k) { float t = o[k]; t += __shfl_xor(t, 8); t += __shfl_xor(t, 16); t += __shfl_xor(t, 32); o[k] = t; }
        if (g == 0) { const int b = token >> 12;
            const float* gt = ada + (size_t)b * 6 * D + 5 * D + 128 * x + 16 * j;
            float* xo = out + (size_t)token * D + 128 * x + 16 * j;
#pragma unroll
            for (int q = 0; q < 4; ++q) { const f32x4 xv = *(const GAS f32x4*)(xo + 4 * q), gv = *(const GAS f32x4*)(gt + 4 * q);
                const f32x4 res = xv + gv * (f32x4){o[4 * q], o[4 * q + 1], o[4 * q + 2], o[4 * q + 3]};
                if (DRY) { asm volatile("" :: "v"(res.x), "v"(res.y), "v"(res.z), "v"(res.w)); } else *(GAS f32x4*)(xo + 4 * q) = res; } }
    }
#undef PO_ISSUE4
#undef PO_ROW
#undef PO_ACC4
}

__device__ __forceinline__ void compress_phase(Frame& F, const float* kng) {
    LAS bf16* H2 = (LAS bf16*)(F.lds);
    LAS float* OUTS = (LAS float*)(F.lds + 16384);
    const int lane = F.lane, w = F.wave, l15 = lane & 15, lq = lane >> 4;
    for (int u = F.bid; u < NBG * 2 * 8; u += F.G) {
        const int ns = u & 7, kv = (u >> 3) & 1, bg = u >> 4, n0 = ns * 32;
        const bf16* A = (const bf16*)(F.ws + (kv ? WS_VCR : WS_KCR)) + (size_t)bg * SEQ * 64;
        const bf16* W1T = (const bf16*)(F.ws + (kv ? WS_CW1V_T : WS_CW1K_T));
        const bf16* W2T = (const bf16*)(F.ws + (kv ? WS_CW2V_T : WS_CW2K_T));
        const float* b1 = (const float*)(F.ws + (kv ? WS_CB1V : WS_CB1K));
        pg8::f32x4 acc[2];
        acc[0] = (pg8::f32x4){0.f, 0.f, 0.f, 0.f}; acc[1] = acc[0];
        const bf16* ap = A + (size_t)(n0 + l15) * 1024 + 8 * lq;
        const bf16* bp = W1T + (size_t)(16 * w + l15) * 2048 + 8 * lq;
#pragma unroll 4
        for (int ks = 0; ks < 64; ++ks) {
            const bf16x8 a0 = *(const GAS bf16x8*)(ap + 32 * ks), a1 = *(const GAS bf16x8*)(ap + 16 * 1024 + 32 * ks), b = *(const GAS bf16x8*)(bp + 32 * ks);
            acc[0] = __builtin_amdgcn_mfma_f32_16x16x32_bf16(a0, b, acc[0], 0, 0, 0);
            acc[1] = __builtin_amdgcn_mfma_f32_16x16x32_bf16(a1, b, acc[1], 0, 0, 0);
        }
        { const float bb = b1[16 * w + l15];
#pragma unroll
          for (int rb = 0; rb < 2; ++rb)
#pragma unroll
            for (int r = 0; r < 4; ++r) H2[(16 * rb + 4 * lq + r) * 136 + 16 * w + l15] = (bf16)f2bf(gelu_tanh_safe(acc[rb][r] + bb)); }
        __syncthreads();
        { const int rb = w >> 2, db = w & 3;
          pg8::f32x4 o = (pg8::f32x4){0.f, 0.f, 0.f, 0.f};
#pragma unroll
          for (int ks = 0; ks < 4; ++ks) {
              const bf16x8 a = *(const LAS bf16x8*)(H2 + (16 * rb + l15) * 136 + 32 * ks + 8 * lq);
              const bf16x8 b = *(const GAS bf16x8*)(W2T + (size_t)(16 * db + l15) * 128 + 32 * ks + 8 * lq);
              o = __builtin_amdgcn_mfma_f32_16x16x32_bf16(a, b, o, 0, 0, 0); }
#pragma unroll
          for (int r = 0; r < 4; ++r) OUTS[(16 * rb + 4 * lq + r) * 65 + 16 * db + l15] = o[r]; }
        __syncthreads();
        { const int n = F.tid >> 4, d4 = (F.tid & 15) * 4, ng = n0 + n;
          float v[4]; float ss = 0.f;
#pragma unroll
          for (int i = 0; i < 4; ++i) { v[i] = OUTS[n * 65 + d4 + i]; ss += v[i] * v[i]; }
          ss += __shfl_xor(ss, 1); ss += __shfl_xor(ss, 2); ss += __shfl_xor(ss, 4); ss += __shfl_xor(ss, 8);
          const bool pad = (ng >= NCMP);
          if (kv == 0) { const float rs = rsqrtf(ss * (1.f / 64.f) + EPS);
              v2u o; o.x = pad ? 0u : pk2(v[0] * rs * kng[d4], v[1] * rs * kng[d4 + 1]); o.y = pad ? 0u : pk2(v[2] * rs * kng[d4 + 2], v[3] * rs * kng[d4 + 3]);
              *(GAS v2u*)((bf16*)(F.ws + WS_KC) + ((size_t)bg * 256 + ng) * 64 + d4) = o; }
          else { bf16* vt = (bf16*)(F.ws + WS_VCT) + (size_t)bg * 64 * 256 + ng;
#pragma unroll
              for (int i = 0; i < 4; ++i) vt[(size_t)(d4 + i) * 256] = pad ? (bf16)0 : (bf16)f2bf(v[i]); } }
        __syncthreads();
    }
}
__device__ __forceinline__ void vtranspose_phase(Frame& F) {
    LAS bf16* T = (LAS bf16*)(F.lds + F.wave * 9216);
    const int gw = F.bid * NWAVES + F.wave, NGW = F.G * NWAVES, lane = F.lane;
    for (int job = gw; job < 2 * NBG * 64; job += NGW) {
        const int s = job & 63, bg = (job >> 6) & 15, which = job >> 10;
        const bf16* X = (const bf16*)(F.ws + (which ? WS_VW : WS_VS)) + ((size_t)bg * SEQ + 64 * s) * 64;
        bf16* XT = (bf16*)(F.ws + (which ? WS_VWT : WS_VST)) + (size_t)bg * 64 * SEQ + 64 * s;
#pragma unroll
        for (int i = 0; i < 8; ++i) { const int tok = (lane >> 3) + 8 * i, ch = lane & 7;
            const v4u x = *(const GAS v4u*)(X + (size_t)tok * 64 + 8 * ch);
            const unsigned ww[4] = {x.x, x.y, x.z, x.w};
#pragma unroll
            for (int e = 0; e < 4; ++e) { T[(8 * ch + 2 * e) * 72 + tok] = (bf16)(ww[e] & 0xffffu); T[(8 * ch + 2 * e + 1) * 72 + tok] = (bf16)(ww[e] >> 16); } }
        LDS_WAIT(); asm volatile("" ::: "memory");
#pragma unroll
        for (int i = 0; i < 8; ++i) { const int dim = (lane >> 3) + 8 * i, ch = lane & 7;
            const v4u y = *(const LAS v4u*)(T + dim * 72 + 8 * ch);
            *(GAS v4u*)(XT + (size_t)dim * SEQ + 8 * ch) = y; }
        LDS_WAIT(); asm volatile("" ::: "memory");
    }
}

constexpr int AT_KSTR = 72;
constexpr int AT_KBUF = 64 * AT_KSTR * 2;
constexpr int AT_OFF_K = 0, AT_OFF_V = 4 * AT_KBUF;
constexpr int AT_OFF_IMP1 = 8 * AT_KBUF, AT_OFF_IMP2 = AT_OFF_IMP1 + 64 * 65 * 4, AT_OFF_SEL = AT_OFF_IMP2 + 64 * 65 * 4;
constexpr int AT_OFF_LUT = AT_OFF_SEL + 4096, AT_OFF_LROW = AT_OFF_LUT + 4 * 128 * 4;
constexpr int AT_OFF_TD = AT_OFF_LROW + 8 * 32 * 4;
constexpr int AT_LDS_END = AT_OFF_TD + 96 * 32;
static_assert(AT_LDS_END <= RING_BYTES, "attention LDS");

struct AtTile { const bf16* k; const bf16* vt; int vstride; };
enum { TM_CMP1 = 0, TM_CMP2, TM_SELN, TM_SELF, TM_WINN, TM_WINF, TM_WINE };
__device__ __forceinline__ float fexp2(float x) { return __builtin_amdgcn_exp2f(x); }
template <int TM, int VAR, int RB = 3>
__device__ __forceinline__ void at_tile(const LAS unsigned char* kb_, const LAS unsigned char* vb_, const LAS float* LUTJ, LAS float* IMP1, LAS float* IMP2,
                                        const bf16x8 (&qf)[2][2], pg8::f32x4 (&oacc)[2][4], float (&lsum)[2], float (&lpart)[2], const float (&linv)[2],
                                        const int (&tok_r)[2], const unsigned (&selb)[2], float cfar, int relbase, int idx, int l15, int lq) {
    constexpr bool FAR = (TM == TM_SELF || TM == TM_WINF || TM == TM_WINE);
    v4u pfr[2][2];
#pragma unroll
    for (int cb = 0; cb < 4; ++cb) {
        pg8::f32x4 st[2];
        st[0] = FAR ? (pg8::f32x4){cfar, cfar, cfar, cfar} : (pg8::f32x4){0.f, 0.f, 0.f, 0.f}; st[1] = st[0];
        if (!(VAR & 64)) {
#pragma unroll
        for (int ks = 0; ks < 2; ++ks) { const bf16x8 kf = *(const LAS bf16x8*)(kb_ + (16 * cb + l15) * 144 + 64 * ks + 16 * lq);
#pragma unroll
            for (int rb = 0; rb < 2; ++rb) if (RB & (1 << rb)) st[rb] = __builtin_amdgcn_mfma_f32_16x16x32_bf16(kf, qf[rb][ks], st[rb], 0, 0, 0); } }
#pragma unroll
        for (int rb = 0; rb < 2; ++rb) if (RB & (1 << rb)) {
            const int tokc = tok_r[rb];
            float p[4];
#pragma unroll
            for (int r = 0; r < 4; ++r) {
                const int kl = 16 * cb + 4 * lq + r;
                if (VAR & 16) { p[r] = st[rb][r]; }
                else if (TM == TM_SELF) { const float e = fexp2(st[rb][r]); p[r] = selb[rb] ? e : 0.f; }
                else if (TM == TM_WINF) { p[r] = fexp2(st[rb][r]); }
                else if (TM == TM_WINE) { const float e = fexp2(st[rb][r]); p[r] = (kl > tokc) ? e : 0.f; }
                else {
                    const int rel = (TM == TM_CMP1 || TM == TM_CMP2) ? (relbase + tokc - 16 * kl) : (relbase + tokc - kl);
                    bool valid = rel >= 0; if (TM == TM_SELN) valid = valid && (selb[rb] != 0u);
                    const int ri = rel < 0 ? 0 : (rel > 127 ? 127 : rel);
                    const float e = fexp2(st[rb][r] + LUTJ[ri]);
                    p[r] = valid ? e : 0.f; }
            }
            if (TM == TM_CMP1) { lpart[rb] += (p[0] + p[1]) + (p[2] + p[3]); }
            else {
                if (TM == TM_CMP2) {
#pragma unroll
                    for (int r = 0; r < 4; ++r) p[r] *= linv[rb];
                    float h0 = p[0], h1 = p[1], h2 = p[2], h3 = p[3];
                    h0 += __shfl_xor(h0, 1); h1 += __shfl_xor(h1, 1); h2 += __shfl_xor(h2, 1); h3 += __shfl_xor(h3, 1);
                    h0 += __shfl_xor(h0, 2); h1 += __shfl_xor(h1, 2); h2 += __shfl_xor(h2, 2); h3 += __shfl_xor(h3, 2);
                    if ((l15 & 3) == 0) { const int sp = 16 * idx + 4 * cb + lq;
                        IMP1[tokc * 65 + sp] = (h0 + h1) + (h2 + 0.5f * h3);
                        if (sp + 1 < 64) IMP2[tokc * 65 + sp + 1] = 0.5f * h3; }
                } else lsum[rb] += (p[0] + p[1]) + (p[2] + p[3]);
                const unsigned lo = pg8::cvt_pk_bf16(p[0], p[1]), hi = pg8::cvt_pk_bf16(p[2], p[3]);
                if (cb & 1) { pfr[rb][cb >> 1].z = lo; pfr[rb][cb >> 1].w = hi; } else { pfr[rb][cb >> 1].x = lo; pfr[rb][cb >> 1].y = hi; } }
        }
    }
    if (TM != TM_CMP1 && !(VAR & 8)) {
#pragma unroll
        for (int ks = 0; ks < 2; ++ks)
#pragma unroll
            for (int db = 0; db < 4; ++db) {
                const LAS unsigned char* vp = vb_ + (16 * db + l15) * 144 + 64 * ks + 8 * lq;
                const v2u v0 = *(const LAS v2u*)vp, v1 = *(const LAS v2u*)(vp + 32);
                const v4u vv = (v4u){v0.x, v0.y, v1.x, v1.y};
#pragma unroll
                for (int rb = 0; rb < 2; ++rb) if (RB & (1 << rb)) oacc[rb][db] = __builtin_amdgcn_mfma_f32_16x16x32_bf16(__builtin_bit_cast(bf16x8, pfr[rb][ks]), __builtin_bit_cast(bf16x8, vv), oacc[rb][db], 0, 0, 0); }
    }
}

template <int VAR> __device__ __forceinline__ void attention_phase(Frame& F, const Args& args) {
    unsigned char* ws = F.ws;
    const int lane = F.lane, w = F.wave, l15 = lane & 15, lq = lane >> 4, tid = F.tid;
    LAS unsigned char* L = F.lds;
    LAS float* IMP1 = (LAS float*)(L + AT_OFF_IMP1); LAS float* IMP2 = (LAS float*)(L + AT_OFF_IMP2);
    LAS unsigned char* SEL = L + AT_OFF_SEL; LAS float* LUT = (LAS float*)(L + AT_OFF_LUT); LAS float* LROW = (LAS float*)(L + AT_OFF_LROW) + w * 32;
    LAS int* TD = (LAS int*)(L + AT_OFF_TD);
    const float M0 = ((const float*)(ws + WS_BIASL))[8 * 128];
    const bf16* Qg = (const bf16*)(ws + WS_Q); const float* GATE = (const float*)(ws + WS_GATE); bf16* YA = (bf16*)(ws + WS_YA); float* YAF = (float*)(ws + WS_H);
    const int jq = l15 & 3;
    const LAS float* LUTJ = LUT + jq * 128;
    const int nrounds = (F.G == 256) ? 4 : (1024 + F.G - 1) / F.G;
    for (int round = 0; round < nrounds; ++round) {
        const int ui = (F.G == 256) ? ((round & 1) ? ((round >> 1) * 512 + 511 - F.bid) : ((round >> 1) * 512 + F.bid)) : (round * F.G + F.bid);
        if (ui >= 1024) break;
        const int c = 63 - (ui >> 4), bg = ui & 15, b = bg >> 1, g = bg & 1;
        const int m0 = b * SEQ + 64 * c;
        __syncthreads();
        for (int i = tid; i < 512; i += NTHREADS) LUT[i] = (((const float*)(ws + WS_BIASL))[(4 * g + (i >> 7)) * 128 + (i & 127)] - M0) * 1.4426950408889634f;
        for (int i = tid; i < 64 * 65; i += NTHREADS) { IMP1[i] = 0.f; IMP2[i] = 0.f; }
        bf16x8 qf[2][2];
#pragma unroll
        for (int rb = 0; rb < 2; ++rb)
#pragma unroll
            for (int ks = 0; ks < 2; ++ks) qf[rb][ks] = *(const GAS bf16x8*)(Qg + (size_t)(m0 + 8 * w + 4 * rb + (l15 >> 2)) * 512 + g * 256 + jq * 64 + 32 * ks + 8 * lq);
        asm volatile("" :: "v"(qf[0][0]), "v"(qf[0][1]), "v"(qf[1][0]), "v"(qf[1][1]));
        const int ncmp = 4 * c + 3, n1 = (ncmp + 63) >> 6, nsel = c + 1, w0 = c >= 8 ? c - 8 : 0, nwin = c - w0 + 1;
        const int ntiles = 2 * n1 + nsel + nwin;
        if (tid < ntiles) { const int i = tid; int kind, idx; unsigned ko, vo, vs;
            if (i < n1) { kind = 0; idx = i; } else if (i < 2 * n1) { kind = 1; idx = i - n1; } else if (i < 2 * n1 + nsel) { kind = 2; idx = i - 2 * n1; } else { kind = 3; idx = w0 + (i - 2 * n1 - nsel); }
            if (kind < 2) { ko = (unsigned)(WS_KC + ((size_t)bg * 256 * 64 + (size_t)idx * 4096) * 2); vo = (unsigned)(WS_VCT + ((size_t)bg * 64 * 256 + 64 * idx) * 2); vs = 512u; }
            else if (kind == 2) { ko = (unsigned)(WS_KS + ((size_t)bg * SEQ * 64 + (size_t)idx * 4096) * 2); vo = (unsigned)(WS_VST + ((size_t)bg * 64 * SEQ + 64 * idx) * 2); vs = 2u * SEQ; }
            else { ko = (unsigned)(WS_KW + ((size_t)bg * SEQ * 64 + (size_t)idx * 4096) * 2); vo = (unsigned)(WS_VWT + ((size_t)bg * 64 * SEQ + 64 * idx) * 2); vs = 2u * SEQ; }
            const int dd = c - idx;
            int mode, relbase;
            if (kind == 0) { mode = TM_CMP1; relbase = 64 * c - 31 - 1024 * idx; } else if (kind == 1) { mode = TM_CMP2; relbase = 64 * c - 31 - 1024 * idx; }
            else if (kind == 2) { mode = dd <= 2 ? TM_SELN : TM_SELF; relbase = 64 * dd; } else { mode = dd <= 2 ? TM_WINN : (dd == 8 ? TM_WINE : TM_WINF); relbase = 64 * dd; }
            const int endf = ((kind == 1 && idx == n1 - 1) || (kind == 2 && idx == nsel - 1) || (kind == 3 && idx == c)) ? kind : 0;
            LAS int* td = TD + 8 * i; td[0] = mode; td[1] = idx; td[2] = relbase; td[3] = endf; td[4] = (int)ko; td[5] = (int)vo; td[6] = (int)vs; td[7] = (kind == 2 && idx == 0) ? 1 : 0; }
        const int srow = tid >> 3, sch = tid & 7;
        __syncthreads();
        v4u kreg[2], vreg[2];
#pragma unroll
        for (int q = 0; q < 2; ++q) if (q < ntiles) { const unsigned ko = (unsigned)TD[8 * q + 4], vo = (unsigned)TD[8 * q + 5], vs = (unsigned)TD[8 * q + 6];
          kreg[q] = *(const GAS v4u*)(ws + (size_t)(ko + srow * 128 + 16 * sch)); vreg[q] = *(const GAS v4u*)(ws + (size_t)(vo + srow * vs + 16 * sch));
          *(LAS v4u*)(L + AT_OFF_K + q * AT_KBUF + srow * 144 + 16 * sch) = kreg[q]; *(LAS v4u*)(L + AT_OFF_V + q * AT_KBUF + srow * 144 + 16 * sch) = vreg[q]; }
        __syncthreads();
        const float cfar = LUTJ[127];
        float lpart[2] = {0.f, 0.f};
        float linv[2] = {0.f, 0.f};
        pg8::f32x4 oacc[2][4];
        float lsum[2] = {0.f, 0.f};
#pragma unroll
        for (int rb = 0; rb < 2; ++rb)
#pragma unroll
            for (int db = 0; db < 4; ++db) oacc[rb][db] = (pg8::f32x4){0.f, 0.f, 0.f, 0.f};
        const int tok_r[2] = {8 * w + (l15 >> 2), 8 * w + 4 + (l15 >> 2)};
        for (int it0 = 0; it0 < ((VAR & 32) ? 0 : ntiles); it0 += 2) {
            const int pb = (it0 >> 1) & 1;
            if (!(VAR & 2)) {
#pragma unroll
                for (int q = 0; q < 2; ++q) if (it0 + 2 + q < ntiles) { const LAS int* tn = TD + 8 * (it0 + 2 + q); const unsigned ko = (unsigned)tn[4], vo = (unsigned)tn[5], vs = (unsigned)tn[6];
                    kreg[q] = *(const GAS v4u*)(ws + (size_t)(ko + srow * 128 + 16 * sch)); vreg[q] = *(const GAS v4u*)(ws + (size_t)(vo + srow * vs + 16 * sch)); } }
#pragma unroll 1
            for (int sub = 0; sub < 2; ++sub) {
            const int it = it0 + sub; if (it >= ntiles) break;
            const LAS int* td = TD + 8 * it;
            const int mode = __builtin_amdgcn_readfirstlane(td[0]), idx = __builtin_amdgcn_readfirstlane(td[1]), relbase = __builtin_amdgcn_readfirstlane(td[2]);
            const int endf = __builtin_amdgcn_readfirstlane(td[3]), selfirst = __builtin_amdgcn_readfirstlane(td[7]);
            const int buf = 2 * pb + sub;
            if (selfirst) {
                for (int tq = 0; tq < 8; ++tq) { const int tok = 8 * w + tq, sB = lane;
                    const bool vis = sB <= c, forced = (sB == 0) || (sB == c) || (sB == c - 1);
                    const float sc = vis ? (IMP1[tok * 65 + sB] + IMP2[tok * 65 + sB] + (forced ? 1000.f : 0.f)) : -1.f;
                    unsigned char flag;
                    if (c < 16) flag = vis ? 1 : 0;
                    else { const unsigned u = __builtin_bit_cast(unsigned, sc); const unsigned fk = (u >> 31) ? ~u : (u | 0x80000000u);
                        const unsigned key = (fk & ~63u) | (unsigned)(63 - sB);
                        int rank = 0;
#pragma unroll 8
                        for (int s2 = 0; s2 < 64; ++s2) { const unsigned k2 = (unsigned)__builtin_amdgcn_readlane((int)key, s2); rank += (k2 > key) ? 1 : 0; }
                        flag = (rank < 16 && vis) ? 1 : 0; }
                    SEL[tok * 64 + sB] = flag; }
                __syncthreads();
            }
            const LAS unsigned char* kb_ = L + AT_OFF_K + buf * AT_KBUF; const LAS unsigned char* vb_ = L + AT_OFF_V + buf * AT_KBUF;
            unsigned selb[2] = {1u, 1u};
#define AT_CALL(TMX) at_tile<TMX, VAR>(kb_, vb_, LUTJ, IMP1, IMP2, qf, oacc, lsum, lpart, linv, tok_r, selb, cfar, relbase, idx, l15, lq)
            if (mode == TM_SELF || mode == TM_SELN) { selb[0] = SEL[tok_r[0] * 64 + idx]; selb[1] = SEL[tok_r[1] * 64 + idx]; }
            if (mode == TM_SELF) {
                const bool a0 = __ballot(selb[0] != 0u) != 0ull, a1 = __ballot(selb[1] != 0u) != 0ull;
                if (a0 && a1) AT_CALL(TM_SELF);
                else if (a0) at_tile<TM_SELF, VAR, 1>(kb_, vb_, LUTJ, IMP1, IMP2, qf, oacc, lsum, lpart, linv, tok_r, selb, cfar, relbase, idx, l15, lq);
                else if (a1) at_tile<TM_SELF, VAR, 2>(kb_, vb_, LUTJ, IMP1, IMP2, qf, oacc, lsum, lpart, linv, tok_r, selb, cfar, relbase, idx, l15, lq); }
            else if (mode == TM_WINF) AT_CALL(TM_WINF);
            else if (mode == TM_SELN) AT_CALL(TM_SELN);
            else if (mode == TM_WINN) AT_CALL(TM_WINN);
            else if (mode == TM_WINE) AT_CALL(TM_WINE);
            else if (mode == TM_CMP2) AT_CALL(TM_CMP2);
            else { if (idx == 0) { lpart[0] = 0.f; lpart[1] = 0.f; }
                AT_CALL(TM_CMP1);
                if (idx == n1 - 1) {
#pragma unroll
                    for (int rb = 0; rb < 2; ++rb) { float s = lpart[rb]; s += __shfl_xor(s, 16); s += __shfl_xor(s, 32); linv[rb] = s > 0.f ? 1.0f / s : 0.f; } } }
#undef AT_CALL
            {
                if (endf) {
                    const int br = endf - 1;
                    if (endf == 1) { LROW[l15] = 1.0f; LROW[16 + l15] = 1.0f; }
                    else {
#pragma unroll
                        for (int rb = 0; rb < 2; ++rb) { float s = lsum[rb]; s += __shfl_xor(s, 16); s += __shfl_xor(s, 32); if (lq == 0) LROW[16 * rb + l15] = s > 0.f ? 1.0f / s : 0.f; lsum[rb] = 0.f; } }
                    LDS_WAIT(); asm volatile("" ::: "memory");
                    int trow0 = m0 + 8 * w + lq;
                    asm volatile("" : "+v"(trow0));
                    const float* gp = GATE + (size_t)trow0 * 24 + g * 12 + br;
                    float* yf0 = YAF + (size_t)trow0 * 512 + g * 256 + l15;
                    bf16* ya0 = YA + (size_t)trow0 * 512 + g * 256 + l15;
#pragma unroll
                    for (int rb = 0; rb < 2; ++rb)
#pragma unroll
                        for (int r = 0; r < 4; ++r) { const int qrow = 16 * rb + 4 * lq + r;
                            const float gt = gp[rb * 96 + r * 3] * LROW[qrow];
#pragma unroll
                            for (int db = 0; db < 4; ++db) { float v = gt * oacc[rb][db][r]; oacc[rb][db][r] = 0.f;
                                const int off = rb * 2048 + r * 64 + 16 * db;
                                if (br > 0) v += yf0[off];
                                if (VAR & 1) { asm volatile("" :: "v"(v)); } else { if (br < 2) yf0[off] = v; else ya0[off] = (bf16)f2bf(v); } } }
                }
            }
            }
            if (!(VAR & 2)) {
#pragma unroll
                for (int q = 0; q < 2; ++q) if (it0 + 2 + q < ntiles) { *(LAS v4u*)(L + AT_OFF_K + (2 * (pb ^ 1) + q) * AT_KBUF + srow * 144 + 16 * sch) = kreg[q]; *(LAS v4u*)(L + AT_OFF_V + (2 * (pb ^ 1) + q) * AT_KBUF + srow * 144 + 16 * sch) = vreg[q]; } }
            if (!(VAR & 4)) __syncthreads();
        }
    }
}

constexpr int N_PHASES = 13;
#ifndef MK_ONE_LAUNCH
#define MK_ONE_LAUNCH 1
#endif
#ifndef REP_P0
#define REP_P0 1
#endif
#ifndef REP_P1
#define REP_P1 1
#endif
#ifndef REP_P2
#define REP_P2 1
#endif
#ifndef REP_P3
#define REP_P3 1
#endif
#ifndef REP_P5
#define REP_P5 1
#endif
#ifndef REP_P6
#define REP_P6 1
#endif
#ifndef REP_P8
#define REP_P8 1
#endif
#ifndef REP_P4
#define REP_P4 1
#endif
#ifndef REP_P9
#define REP_P9 1
#endif
#ifndef REP_P10
#define REP_P10 1
#endif
#ifndef MK_BUILD
#define MK_BUILD 0
#endif

__global__ void __launch_bounds__(NTHREADS, 2) fwd_kernel(Args args) {
    extern __shared__ __attribute__((aligned(16))) unsigned char lds[];
    Frame F;
    F.lds = (LAS unsigned char*)lds;
    F.MISC = (volatile LAS unsigned*)(F.lds + MISC_OFF);
    F.tid = threadIdx.x; F.lane = F.tid & 63; F.wave = __builtin_amdgcn_readfirstlane(F.tid >> 6);
    F.G = gridDim.x; F.bid = blockIdx.x; F.ws = args.ws;
    F.ctl = (gu32*)(args.ws + WS_CTL);
    for (int u = F.tid; u < (LDS_BYTES - LDSCTL_OFF) / 4; u += NTHREADS) ((LAS unsigned*)(F.lds + LDSCTL_OFF))[u] = 0u;
    __syncthreads();
    XcdBarrier bar; bar.bar = (unsigned*)(F.ctl + CW_BAR); bar.x = 0; bar.st = nullptr;
    if (MK_ONE_LAUNCH) bar = xcd_barrier_post((unsigned*)(F.ctl + CW_BAR), F.MISC + 8);
    const int lo = args.ph_lo, hi = args.ph_hi;
#define IN(k) (lo <= (k) && (k) < hi)
#define SEAM(k) do { if (IN(k) && IN((k) + 1)) xcd_barrier(bar); } while (0)
    unsigned char* ws = args.ws;
    const float* ada = (const float*)(ws + WS_ADA);

    if (IN(0)) { for (int rep = 0; rep < REP_P0; ++rep) { p0_prologue(F, args); __syncthreads(); } } SEAM(0);
    if (IN(1)) { for (int rep = 0; rep < REP_P1; ++rep) modnorm_rows<false>(F, args.in[I_X], args.in[I_N1G], ada, 0, (bf16*)(ws + WS_H)); } SEAM(1);
    if (IN(2)) { {
        pg8::Gemm g{(const bf16*)(ws + WS_H), (const bf16*)(ws + WS_WIN_T), M, NIN, D, D, D}; pg8::StaticOrder S; S.init(M, NIN, F.G, F.bid);
        EpiIn E{ws, args.in[I_QNG], args.in[I_KNG]};
        pg8::gemm_phase<EpiIn, pg8::StaticOrder, true, true>(F.lds + RING_OFF, g, S, E);
#if REP_P2 > 1
        __syncthreads(); pg8::gemm_phase<EpiIn, pg8::StaticOrder, true, true>(F.lds + RING_OFF, g, S, E);
#endif
        }
    } SEAM(2);
    if (IN(3)) { for (int rep = 0; rep < REP_P3; ++rep) { __syncthreads(); pool_phase(F); __syncthreads(); compress_phase(F, args.in[I_KNG]); __syncthreads(); vtranspose_phase(F); } } SEAM(3);
    if (IN(4)) {
#ifdef PROBE_P4
        attention_phase<PROBE_P4>(F, args); __syncthreads();
#endif
        attention_phase<0>(F, args); } SEAM(4);
    if (IN(5)) { {
        { pg8::Gemm g{(const bf16*)(ws + WS_PL), (const bf16*)(ws + WS_WEFF_T), M, D, POOLW, POOLW, POOLW}; pg8::StaticOrder S; S.init(M, D, F.G, F.bid);
          EpiMix<false> E{(bf16*)(ws + WS_MIX), (const bf16*)(ws + WS_GM), 0};
          pg8::gemm_phase<EpiMix<false>, pg8::StaticOrder, true, true>(F.lds + RING_OFF, g, S, E); }
        { pg8::Gemm g{(const bf16*)(ws + WS_YA), (const bf16*)(ws + WS_WBA_T), M, D, QW, QW, QW}; pg8::StaticOrder S; S.init(M, D, F.G, F.bid);
          EpiMix<true> E{(bf16*)(ws + WS_MIX), (const bf16*)(ws + WS_GM), 1024};
          pg8::gemm_phase<EpiMix<true>, pg8::StaticOrder, true, true>(F.lds + RING_OFF, g, S, E); } }
    } SEAM(5);
    if (IN(6)) { {
        pg8::Gemm g{(const bf16*)(ws + WS_MIX), (const bf16*)(ws + WS_WOUT_T), M, D, D, D, D}; pg8::StaticOrder S; S.init(M, D, F.G, F.bid);
        EpiRes E{args.in[I_X], args.out, ada, 2};
        pg8::gemm_phase<EpiRes, pg8::StaticOrder, true, true>(F.lds + RING_OFF, g, S, E); }
    } SEAM(6);
    if (IN(7)) { modnorm_rows<true>(F, args.out, args.in[I_N2G], ada, 3, (bf16*)(ws + WS_H)); } SEAM(7);
    if (IN(8)) { {
        pg8::Gemm g{(const bf16*)(ws + WS_H), (const bf16*)(ws + WS_WQ_T), M, PQW, D, D, D}; pg8::StaticOrder S; S.init(M, PQW, F.G, F.bid);
        EpiStoreBf16 E{(bf16*)(ws + WS_QV), PQW};
        pg8::gemm_phase<EpiStoreBf16, pg8::StaticOrder, true, true>(F.lds + RING_OFF, g, S, E);
#if REP_P8 > 1
        __syncthreads(); pg8::gemm_phase<EpiStoreBf16, pg8::StaticOrder, true, true>(F.lds + RING_OFF, g, S, E);
#endif
        }
    } SEAM(8);
    if (IN(9)) { for (int rep = 0; rep < REP_P9; ++rep) peer_select_phase(F); } SEAM(9);
#ifdef PROBE_XCD
    if (IN(10)) { if (F.tid == 0) __hip_atomic_store((unsigned*)(F.ctl + 2048 + F.bid), 100u + xb_xcc_id(), RLX_AGENT); }
#endif
    if (IN(10)) {
#ifdef PROBE_DOT
        peer_dot_phase<PROBE_DOT>(F); __syncthreads();
#endif
        peer_dot_phase<0>(F); } SEAM(10);
    if (IN(11)) { peer_coef_phase(F); } SEAM(11);
#ifdef PROBE_XCD
    if (IN(12) && F.bid == 0 && F.tid == 0) { bool ok = true; for (int i = 0; i < F.G; ++i) { const unsigned a = __hip_atomic_load((unsigned*)(F.ctl + 2048 + i), RLX_AGENT), b0 = __hip_atomic_load((unsigned*)(F.ctl + 2048 + (i & 7)), RLX_AGENT); if (a != b0 || a < 100u) ok = false; }
        for (int i = 0; i < 8; ++i) for (int q = 0; q < i; ++q) if (__hip_atomic_load((unsigned*)(F.ctl + 2048 + i), RLX_AGENT) == __hip_atomic_load((unsigned*)(F.ctl + 2048 + q), RLX_AGENT)) ok = false;
        if (!ok) args.out[12345] = 1.0e9f; }
    __syncthreads();
#endif
    if (IN(12)) { for (int rep = 1; rep < REP_P10; ++rep) peer_out_phase<true>(F, ada, args.out); peer_out_phase<false>(F, ada, args.out); }
#undef IN
#undef SEAM
}

extern "C" void kernel_launch(void* const* d_in, const int* in_sizes, int n_in, void* d_out, int out_size, void* d_ws, size_t ws_size, hipStream_t stream) {
    static int grid = 0;
    if (grid == 0) {
        if (n_in != N_IN || in_sizes[0] != M * D || out_size != M * D || ws_size < WS_END) {
            fprintf(stderr, "kernel_launch: unexpected shapes: n_in %d in0 %d out %d ws %zu (need %zu)\n", n_in, n_in > 0 ? in_sizes[0] : -1, out_size, ws_size, (size_t)WS_END); grid = -1; return; }
        int dev = 0, cus = 0, per_cu = 0;
        if (hipGetDevice(&dev) != hipSuccess || hipDeviceGetAttribute(&cus, hipDeviceAttributeMultiprocessorCount, dev) != hipSuccess) { grid = -1; return; }
        if (hipFuncSetAttribute((const void*)fwd_kernel, hipFuncAttributeMaxDynamicSharedMemorySize, LDS_BYTES) != hipSuccess) { fprintf(stderr, "kernel_launch: hipFuncSetAttribute failed\n"); grid = -1; return; }
        if (hipOccupancyMaxActiveBlocksPerMultiprocessor(&per_cu, (const void*)fwd_kernel, NTHREADS, LDS_BYTES) != hipSuccess || per_cu < 1)
            fprintf(stderr, "kernel_launch: occupancy query reports %d workgroups per CU\n", per_cu);
        (void)hipGetLastError();
        grid = cus;
    }
    if (grid < 0) return;
    if (hipMemsetAsync((char*)d_ws + WS_CTL, 0, CTL_ZERO_BYTES, stream) != hipSuccess) return;
    Args a{};
    for (int i = 0; i < N_IN; ++i) a.in[i] = (const float*)d_in[i];
    a.out = (float*)d_out; a.ws = (unsigned char*)d_ws;
    if (MK_ONE_LAUNCH) {
        a.ph_lo = 0; a.ph_hi = N_PHASES; a.li = 0;
        hipLaunchKernelGGL(fwd_kernel, dim3(grid), dim3(NTHREADS), LDS_BYTES, stream, a);
    } else {
        for (int p = 0; p < N_PHASES; ++p) {
            a.ph_lo = p; a.ph_hi = p + 1; a.li = p;
            hipLaunchKernelGGL(fwd_kernel, dim3(grid), dim3(NTHREADS), LDS_BYTES, stream, a);
        }
    }
}
```

```cpp
#include <hip/hip_runtime.h>
#include <cstdio>
#include <cstdint>
namespace pg8 {
#define PG8_LAS __attribute__((address_space(3)))
typedef unsigned short bf16_t;
typedef short bf16x8 __attribute__((ext_vector_type(8)));
typedef float f32x4 __attribute__((ext_vector_type(4)));
typedef unsigned u32x4 __attribute__((ext_vector_type(4)));
constexpr int BM = 256, BK = 64, HALF = 128, HTB = HALF * BK * 2  , STAGE_BYTES = 8 * HTB, NXCD = 8, WGM = 8;

__host__ __device__ __forceinline__ int lds_byte(int r, int c) { const int st = (r >> 4) * 2 + (c >> 5), rr = r & 15, cc = c & 31, ob = rr * 64 + cc * 2; return st * 1024 + (ob ^ (((ob >> 9) & 1) << 5)); }
__host__ __device__ __forceinline__ void stage_rc(int b, int& R, int& C) { const int st = b / 1024, sb = b % 1024, swz = sb ^ (((sb >> 9) & 1) << 5); R = (st >> 1) * 16 + swz / 64; C = (st & 1) * 32 + (swz % 64) / 2; }
__host__ __device__ __forceinline__ int perm32(int rho) { const int n = rho >> 4, i = rho & 15; return 8 * (i >> 2) + 4 * n + (i & 3); }

struct Unit { int pm, pn; };
struct Gemm { const bf16_t* A; const bf16_t* Bt; int M, N, K, lda, ldb; };

struct StaticOrder {
    int nM, nN, nwg, G, c;
    __host__ __device__ void init(int M, int N, int G_, int c_) { nM = M / BM; nN = N / BM; nwg = nM * nN; G = G_; c = c_; }
    __host__ __device__ bool next(int i, Unit& u) const {
        const long L = (long)i * G + c; if (L >= nwg) return false;
        int wgid = (int)L; { const int q = nwg / NXCD, r = nwg % NXCD, xcd = wgid % NXCD, off = wgid / NXCD; wgid = (xcd < r ? xcd * (q + 1) : r * (q + 1) + (xcd - r) * q) + off; }
        const int nig = WGM * nN, gid = wgid / nig, fm = gid * WGM, gsz = (nM - fm) < WGM ? (nM - fm) : WGM;
        u.pm = fm + ((wgid % nig) % gsz); u.pn = (wgid % nig) / gsz; return true;
    }
    __device__ __forceinline__ void a_ready(const Unit&) const {}
    __device__ __forceinline__ void done(const Unit&) const {}
};

__device__ __forceinline__ unsigned cvt_pk_bf16(float lo, float hi) { unsigned r; asm volatile("v_cvt_pk_bf16_f32 %0, %1, %2" : "=v"(r) : "v"(lo), "v"(hi)); return r; }
template <class Epi, class Sched, bool ALIGN_EPI = false, bool SP2 = false>
__device__ __forceinline__ void gemm_phase(PG8_LAS unsigned char* lds, const Gemm g, const Sched& S, const Epi& E) {
    const int tid = threadIdx.x, wid = __builtin_amdgcn_readfirstlane(tid >> 6), lane = tid & 63, wr = wid >> 2, wc = wid & 3, fr = lane & 15, fq = lane >> 4;
    const int K = g.K, nt = K / BK;
    unsigned voffA[2], voffB[2];
#pragma unroll
    for (int i = 0; i < 2; ++i) { int R, C; stage_rc(tid * 16 + i * 8192, R, C); const int Rb = Epi::PERM ? ((R & ~31) + perm32(R & 31)) : R;
        voffA[i] = (unsigned)(R * g.lda + C) * 2u; voffB[i] = (unsigned)(Rb * g.ldb + C) * 2u; }
    const size_t kstep = (size_t)(BK * 2);
    const size_t hstepA = (size_t)HALF * g.lda * 2, hstepB = (size_t)HALF * g.ldb * 2;
    const size_t tstepA = 2 * hstepA, tstepB = 2 * hstepB;
    const unsigned ldsw = (unsigned)wid * 1024u;
    const int aoff = lds_byte(wr * 64 + fr, fq * 8), boff = lds_byte(wc * 32 + fr, fq * 8);
#define PG8_SA(b, h) (((b) * 2 + (h)) * HTB)
#define PG8_SB(b, h) ((4 + (b) * 2 + (h)) * HTB)
#define PG8_STAGE(bufoff, gbase, voff) do { _Pragma("unroll") for (int _i = 0; _i < 2; ++_i) \
        __builtin_amdgcn_global_load_lds((const unsigned*)((const char*)(gbase) + (voff)[_i]), (PG8_LAS unsigned*)(lds + (bufoff) + ldsw + _i * 8192), 16, 0, 0); } while (0)
#define PG8_LDA(dst, b, h) do { _Pragma("unroll") for (int m = 0; m < 4; ++m) _Pragma("unroll") for (int k = 0; k < 2; ++k) dst[m][k] = *(const PG8_LAS bf16x8*)(lds + PG8_SA(b, h) + aoff + m * 2048 + k * 1024); } while (0)
#define PG8_LDB(dst, b, h) do { _Pragma("unroll") for (int n = 0; n < 2; ++n) _Pragma("unroll") for (int k = 0; k < 2; ++k) dst[n][k] = *(const PG8_LAS bf16x8*)(lds + PG8_SB(b, h) + boff + n * 2048 + k * 1024); } while (0)
#define PG8_MMA(ai, bj, At, Bt) do { __builtin_amdgcn_s_setprio(1); _Pragma("unroll") for (int m = 0; m < 4; ++m) _Pragma("unroll") for (int n = 0; n < 2; ++n) _Pragma("unroll") for (int k = 0; k < 2; ++k) \
        acc[ai][bj][m][n] = __builtin_amdgcn_mfma_f32_16x16x32_bf16(Bt[n][k], At[m][k], acc[ai][bj][m][n], 0, 0, 0); __builtin_amdgcn_s_setprio(0); } while (0)
#define PG8_WAIT_V(n) asm volatile("s_waitcnt vmcnt(" #n ")" ::: "memory")
#define PG8_WAIT_L(n) asm volatile("s_waitcnt lgkmcnt(" #n ")" ::: "memory")
#define PG8_BAR __builtin_amdgcn_s_barrier()
#define PG8_SCHED __builtin_amdgcn_sched_barrier(0)
    Unit cur, nxt; int ui = 0;
    if (!S.next(0, cur)) return;
    f32x4 acc[2][2][4][2];
#pragma unroll
    for (int a = 0; a < 2; ++a)
#pragma unroll
        for (int b = 0; b < 2; ++b)
#pragma unroll
            for (int m = 0; m < 4; ++m)
#pragma unroll
                for (int n = 0; n < 2; ++n) acc[a][b][m][n] = (f32x4){0.f, 0.f, 0.f, 0.f};
    bf16x8 At[4][2], B0[2][2], B1[2][2];
    const char* cA = (const char*)g.A + (size_t)cur.pm * tstepA; const char* cB = (const char*)g.Bt + (size_t)cur.pn * tstepB;
    S.a_ready(cur);
    if constexpr (SP2) {
        PG8_STAGE(PG8_SB(0, 0), cB, voffB); PG8_STAGE(PG8_SB(0, 1), cB + hstepB, voffB); PG8_STAGE(PG8_SA(0, 0), cA, voffA); PG8_STAGE(PG8_SA(0, 1), cA + hstepA, voffA);
        if (wr == 1) PG8_BAR;
        PG8_WAIT_V(2); PG8_BAR;
        PG8_STAGE(PG8_SB(1, 0), cB + kstep, voffB); PG8_STAGE(PG8_SA(1, 0), cA + kstep, voffA); PG8_STAGE(PG8_SB(1, 1), cB + hstepB + kstep, voffB);
        PG8_WAIT_V(6); PG8_BAR;
    } else {
        PG8_STAGE(PG8_SB(0, 0), cB, voffB); PG8_STAGE(PG8_SA(0, 0), cA, voffA); PG8_STAGE(PG8_SB(0, 1), cB + hstepB, voffB); PG8_STAGE(PG8_SA(0, 1), cA + hstepA, voffA);
        if (wr == 1) PG8_BAR;
        PG8_WAIT_V(4); PG8_BAR;
        PG8_STAGE(PG8_SB(1, 0), cB + kstep, voffB); PG8_STAGE(PG8_SA(1, 0), cA + kstep, voffA); PG8_STAGE(PG8_SB(1, 1), cB + hstepB + kstep, voffB);
        PG8_WAIT_V(6); PG8_BAR;
    }
    for (;;) {
        const bool has_next = S.next(ui + 1, nxt);
        const char* nA = has_next ? (const char*)g.A + (size_t)nxt.pm * tstepA : cA; const char* nB = has_next ? (const char*)g.Bt + (size_t)nxt.pn * tstepB : cB;
        for (int t = 0; t < nt; t += 2) {
            const bool last = (t == nt - 2);
            const char* a1 = cA + (size_t)(t + 1) * kstep;
            const char* a2 = last ? nA : cA + (size_t)(t + 2) * kstep; const char* b2 = last ? nB : cB + (size_t)(t + 2) * kstep;
            const char* a3 = a2 + kstep; const char* b3 = b2 + kstep;
            if (last && has_next) S.a_ready(nxt);
            if constexpr (SP2) {
            PG8_LDB(B0, 0, 0); PG8_LDB(B1, 0, 1); PG8_SCHED; PG8_LDA(At, 0, 0); PG8_STAGE(PG8_SA(1, 1), a1 + hstepA, voffA);
            PG8_WAIT_V(8); PG8_WAIT_L(0); PG8_BAR; PG8_MMA(0, 0, At, B0); PG8_MMA(0, 1, At, B1); PG8_BAR; PG8_SCHED;
            PG8_LDA(At, 0, 1); PG8_STAGE(PG8_SB(0, 0), b2, voffB); PG8_STAGE(PG8_SB(0, 1), b2 + hstepB, voffB); PG8_STAGE(PG8_SA(0, 0), a2, voffA);
            PG8_WAIT_V(8); PG8_WAIT_L(0); PG8_BAR; PG8_MMA(1, 0, At, B0); PG8_MMA(1, 1, At, B1); PG8_BAR; PG8_SCHED;
            PG8_LDB(B0, 1, 0); PG8_LDB(B1, 1, 1); PG8_SCHED; PG8_LDA(At, 1, 0); PG8_STAGE(PG8_SA(0, 1), a2 + hstepA, voffA);
            PG8_WAIT_V(8); PG8_WAIT_L(0); PG8_BAR; PG8_MMA(0, 0, At, B0); PG8_MMA(0, 1, At, B1); PG8_BAR; PG8_SCHED;
            PG8_LDA(At, 1, 1); PG8_STAGE(PG8_SB(1, 0), b3, voffB); PG8_STAGE(PG8_SB(1, 1), b3 + hstepB, voffB); PG8_STAGE(PG8_SA(1, 0), a3, voffA);
            PG8_WAIT_V(8); PG8_WAIT_L(0); PG8_BAR; PG8_MMA(1, 0, At, B0); PG8_MMA(1, 1, At, B1); PG8_BAR; PG8_SCHED;
            } else {
            PG8_LDB(B0, 0, 0); PG8_SCHED; PG8_LDA(At, 0, 0); PG8_STAGE(PG8_SA(1, 1), a1 + hstepA, voffA);
            PG8_WAIT_L(8); PG8_BAR; PG8_WAIT_L(0); PG8_MMA(0, 0, At, B0); PG8_BAR; PG8_SCHED;
            PG8_LDB(B1, 0, 1); PG8_STAGE(PG8_SB(0, 0), b2, voffB);
            PG8_BAR; PG8_WAIT_L(0); PG8_MMA(0, 1, At, B1); PG8_BAR;
            PG8_LDA(At, 0, 1); PG8_STAGE(PG8_SA(0, 0), a2, voffA);
            PG8_BAR; PG8_WAIT_L(0); PG8_MMA(1, 0, At, B0); PG8_BAR; PG8_SCHED;
            PG8_STAGE(PG8_SB(0, 1), b2 + hstepB, voffB);
            PG8_WAIT_V(6); PG8_BAR; PG8_MMA(1, 1, At, B1); PG8_BAR;
            PG8_LDB(B0, 1, 0); PG8_SCHED; PG8_LDA(At, 1, 0); PG8_STAGE(PG8_SA(0, 1), a2 + hstepA, voffA);
            PG8_WAIT_L(8); PG8_BAR; PG8_WAIT_L(0); PG8_MMA(0, 0, At, B0); PG8_BAR; PG8_SCHED;
            PG8_LDB(B1, 1, 1); PG8_STAGE(PG8_SB(1, 0), b3, voffB);
            PG8_BAR; PG8_WAIT_L(0); PG8_MMA(0, 1, At, B1); PG8_BAR;
            PG8_LDA(At, 1, 1); PG8_STAGE(PG8_SA(1, 0), a3, voffA);
            PG8_BAR; PG8_WAIT_L(0); PG8_MMA(1, 0, At, B0); PG8_BAR; PG8_SCHED;
            PG8_STAGE(PG8_SB(1, 1), b3 + hstepB, voffB);
            PG8_WAIT_V(6); PG8_BAR; PG8_MMA(1, 1, At, B1); PG8_BAR;
            }
        }
        if constexpr (ALIGN_EPI) { if (wr == 0) PG8_BAR; }
        if constexpr (!Epi::AFTER_DRAIN) { E(acc, cur, wr, wc, fr, fq); S.done(cur); }
        if (!has_next) break;
#pragma unroll
        for (int a = 0; a < 2; ++a)
#pragma unroll
            for (int b = 0; b < 2; ++b)
#pragma unroll
                for (int m = 0; m < 4; ++m)
#pragma unroll
                    for (int n = 0; n < 2; ++n) acc[a][b][m][n] = (f32x4){0.f, 0.f, 0.f, 0.f};
        cur = nxt; cA = nA; cB = nB; ++ui;
        if constexpr (ALIGN_EPI) { if (wr == 1) PG8_BAR; }
    }
    PG8_WAIT_V(0);
    if constexpr (!ALIGN_EPI) { if (wr == 0) PG8_BAR; }
    PG8_BAR;
    if constexpr (Epi::AFTER_DRAIN) { E.fused(acc, cur, wr, wc, fr, fq, lds, wid, lane); S.done(cur); }
#undef PG8_SA
#undef PG8_SB
#undef PG8_STAGE
#undef PG8_LDA
#undef PG8_LDB
#undef PG8_MMA
#undef PG8_WAIT_V
#undef PG8_WAIT_L
#undef PG8_BAR
#undef PG8_SCHED
}
}

constexpr int NWAVES = 8, NTHREADS = NWAVES * 64;
constexpr int BATCH = 8, SEQ = 4096, D = 1024, M = BATCH * SEQ;
constexpr int POOLW = 512, QW = 512, NG = 2, HD = 64, NBG = BATCH * NG;
constexpr int IN_COLS = 3864, NIN = 4096;
constexpr int NCMP = 255, NCMP_PAD = 256, NSEL = 64;
constexpr int PH = 8, PK = 128, PTOP = 16, PQD = 256, PQW = PH * PQD;
constexpr int NEXP = PK * PK;
constexpr float EPS = 1e-6f;
enum { I_X = 0, I_C, I_RELB, I_ADAW, I_ADAB, I_N1G, I_N2G, I_WIN, I_POOLW, I_POOLS, I_CPEK, I_CW1K, I_CW2K, I_CPEV, I_CW1V, I_CW2V, I_QNG, I_KNG, I_WBP, I_WBA, I_WOUT, I_PWQ, I_PSK, I_PU, I_PV, N_IN };

constexpr size_t MiB = 1u << 20, KiB = 1u << 10;
constexpr size_t WS_CTL = 0, CTL_ZERO_BYTES = 1 * MiB;
constexpr size_t WS_ADA = 1 * MiB;
constexpr size_t WS_CB1K = 64 * KiB;
constexpr size_t WS_CB1V = WS_CB1K + 1 * KiB;
constexpr size_t WS_BIASL = WS_ADA + 256 * KiB;
constexpr size_t WS_WIN_T = 2 * MiB;
constexpr size_t WS_WEFF_T = 10 * MiB;
constexpr size_t WS_WBA_T = 11 * MiB;
constexpr size_t WS_WOUT_T = 12 * MiB;
constexpr size_t WS_WQ_T = 14 * MiB;
constexpr size_t WS_SUBK = 18 * MiB;
constexpr size_t WS_CW1K_T = 18 * MiB + 512 * KiB;
constexpr size_t WS_CW1V_T = 19 * MiB;
constexpr size_t WS_CW2K_T = 19 * MiB + 512 * KiB;
constexpr size_t WS_CW2V_T = WS_CW2K_T + 64 * KiB;
constexpr size_t WS_KC = 20 * MiB;
constexpr size_t WS_VCT = 20 * MiB + 512 * KiB;
constexpr size_t WS_GATE = 21 * MiB;
constexpr size_t WS_UB = 24 * MiB;
constexpr size_t WS_VB = 56 * MiB;
constexpr size_t WS_SCLU = WS_UB + 16 * MiB, WS_SCLV = WS_SCLU + 64 * KiB;
constexpr size_t WS_H = 88 * MiB;
constexpr size_t WS_ZP = 152 * MiB;
constexpr size_t WS_Q = 184 * MiB;
constexpr size_t WS_KCR = 216 * MiB;
constexpr size_t WS_VCR = 225 * MiB;
constexpr size_t WS_KS = 234 * MiB, WS_VS = 242 * MiB, WS_KW = 250 * MiB, WS_VW = 258 * MiB;
constexpr size_t WS_VST = 266 * MiB, WS_VWT = 274 * MiB;
constexpr size_t WS_PL = 282 * MiB;
constexpr size_t WS_YA = 314 * MiB;
constexpr size_t WS_GM = 346 * MiB;
constexpr size_t WS_MIX = WS_ZP;
constexpr size_t WS_QV = WS_GM;
constexpr size_t WS_EID = WS_PL;
constexpr size_t WS_GW = WS_PL + 16 * MiB;
constexpr size_t WS_PART = WS_GM;
constexpr size_t WS_CF = WS_YA;
constexpr size_t WS_H8 = WS_ZP;
constexpr size_t WS_HS = WS_ZP + 32 * MiB;
constexpr size_t WS_END = 474 * MiB;
constexpr int CW_TMO = 0, CW_CODE = 1, CW_BAR = 4096;

constexpr int RING_OFF = 0, RING_BYTES = 131072;
constexpr int LDSCTL_OFF = RING_BYTES, MISC_OFF = LDSCTL_OFF + 320;
constexpr int LDS_BYTES = 147456;

#define GAS __attribute__((address_space(1)))
#define LAS __attribute__((address_space(3)))
typedef unsigned short bf16;
typedef unsigned v4u __attribute__((ext_vector_type(4)));
typedef unsigned v2u __attribute__((ext_vector_type(2)));
typedef float f32x4 __attribute__((ext_vector_type(4)));
typedef short bf16x8 __attribute__((ext_vector_type(8)));
typedef GAS unsigned gu32;
#define RLX_AGENT __ATOMIC_RELAXED, __HIP_MEMORY_SCOPE_AGENT
#define LDS_WAIT() asm volatile("s_waitcnt lgkmcnt(0)" ::: "memory")
#define VM_WAIT() asm volatile("s_waitcnt vmcnt(0)" ::: "memory")
__device__ __forceinline__ unsigned f2bf(float f) { unsigned u = __builtin_bit_cast(unsigned, f); return (u + 0x7fffu + ((u >> 16) & 1u)) >> 16; }
__device__ __forceinline__ unsigned pk2(float lo, float hi) { return f2bf(lo) | (f2bf(hi) << 16); }
__device__ __forceinline__ float bflo(unsigned w) { return __builtin_bit_cast(float, w << 16); }
__device__ __forceinline__ float bfhi(unsigned w) { return __builtin_bit_cast(float, w & 0xffff0000u); }
__device__ __forceinline__ float sigmoidf_(float v) { return __builtin_amdgcn_rcpf(1.0f + __builtin_amdgcn_exp2f(v * -1.4426950408889634f)); }
__device__ __forceinline__ unsigned pkh(float lo, float hi) { unsigned r; asm volatile("v_cvt_pk_bf16_f32 %0, %1, %2" : "=v"(r) : "v"(lo), "v"(hi)); return r; }
__device__ __forceinline__ float gelu_tanh_safe(float v) { const float u = 0.7978845608028654f * (v + 0.044715f * v * v * v); return 0.5f * v * (1.0f + tanhf(u)); }
__device__ __forceinline__ float wave_sum(float v) {
#pragma unroll
    for (int o = 1; o < 64; o <<= 1) v += __shfl_xor(v, o);
    return v;
}

#define XB_TMO      128
#define XB_XCNT(j)  (256  + 64 * (j))
#define XB_XSUB(j)  (1280 + 64 * (j))
#define XB_XGEN(j)  (2304 + 64 * (j))
#define XB_TOP      3328
#define XB_TOPGEN   3392
#define XCD_BAR_WORDS 3456
#define XB_SPIN_CAP (1u << 18)
__device__ __forceinline__ unsigned xb_ld(unsigned* p)              { return __hip_atomic_load(p, __ATOMIC_RELAXED, __HIP_MEMORY_SCOPE_AGENT); }
__device__ __forceinline__ unsigned xb_add(unsigned* p, unsigned v) { return __hip_atomic_fetch_add(p, v, __ATOMIC_RELAXED, __HIP_MEMORY_SCOPE_AGENT); }
__device__ __forceinline__ unsigned xb_xcc_id() { return (unsigned)__builtin_amdgcn_s_getreg((3 << 11) | 20) & 0xFu; }
#define XB_SPIN(cond, bar) do { unsigned _sp = 0; while (cond) { __builtin_amdgcn_s_sleep(1); \
    if ((++_sp & 255u) == 0u) { if (xb_ld(&(bar)[XB_TMO])) break; if (_sp > XB_SPIN_CAP) { atomicAdd(&(bar)[XB_TMO], 1u); break; } } } } while (0)
struct XcdBarrier { unsigned* bar; unsigned x; volatile LAS unsigned* st; };
__device__ __forceinline__ XcdBarrier xcd_barrier_post(unsigned* bar, volatile LAS unsigned* st) {
    XcdBarrier b; b.bar = bar; b.x = xb_xcc_id(); b.st = st;
    if (threadIdx.x == 0) (void)xb_add(&bar[XB_XCNT(b.x)], 1u);
    return b;
}
__device__ __forceinline__ void xcd_barrier_complete(unsigned* bar, unsigned x, unsigned& nloc, unsigned& nx) {
    const unsigned G = gridDim.x * gridDim.y * gridDim.z;
    unsigned sum, cnt, mine, sp = 0u;
    for (;;) {
        sum = 0u; cnt = 0u; mine = 0u;
#pragma unroll
        for (unsigned j = 0; j < 16; ++j) { const unsigned c = xb_ld(&bar[XB_XCNT(j)]); sum += c; cnt += (c > 0u) ? 1u : 0u; mine = (j == x) ? c : mine; }
        if (sum == G) break;
        __builtin_amdgcn_s_sleep(1);
        if ((++sp & 255u) == 0u) { if (xb_ld(&bar[XB_TMO])) break; if (sp > XB_SPIN_CAP) { atomicAdd(&bar[XB_TMO], 1u); break; } }
    }
    nloc = mine > 0u ? mine : 1u; nx = cnt > 0u ? cnt : 1u;
}
__device__ __forceinline__ void xcd_barrier(const XcdBarrier& b) {
    asm volatile("s_waitcnt vmcnt(0)" ::: "memory");
    __syncthreads();
    if (threadIdx.x == 0) {
        unsigned* bar = b.bar;
        __builtin_amdgcn_s_waitcnt(0);
        unsigned nloc = b.st[0], nx = b.st[1];
        if (nloc == 0u) { xcd_barrier_complete(bar, b.x, nloc, nx); b.st[0] = nloc; b.st[1] = nx; }
        const unsigned old = xb_add(&bar[XB_XSUB(b.x)], 1u);
        const unsigned gen = old / nloc;
        if (old + 1u == (gen + 1u) * nloc) {
            __builtin_amdgcn_fence(__ATOMIC_RELEASE, "agent");
            asm volatile("s_waitcnt vmcnt(0)" ::: "memory");
            const unsigned og = xb_add(&bar[XB_TOP], 1u);
            const unsigned tg = og / nx;
            if (og + 1u == (tg + 1u) * nx) xb_add(&bar[XB_TOPGEN], 1u);
            else XB_SPIN(xb_ld(&bar[XB_TOPGEN]) == tg, bar);
            __builtin_amdgcn_fence(__ATOMIC_ACQUIRE, "agent");
            xb_add(&bar[XB_XGEN(b.x)], 1u);
            asm volatile("s_waitcnt vmcnt(0)" ::: "memory");
        } else {
            XB_SPIN(xb_ld(&bar[XB_XGEN(b.x)]) == gen, bar);
            __builtin_amdgcn_fence(__ATOMIC_ACQUIRE, "agent");
            asm volatile("s_waitcnt vmcnt(0)" ::: "memory");
        }
    }
    __syncthreads();
}

struct Args { const float* in[N_IN]; float* out; unsigned char* ws; int ph_lo, ph_hi, li, pad; };
struct Frame {
    LAS unsigned char* lds;
    volatile LAS unsigned* MISC;
    gu32* ctl;
    int tid, lane, wave, G, bid;
    unsigned char* ws;
};

template <bool I8> __device__ __forceinline__ void cvt_row_store(const f32x4 (&v)[4], int row, unsigned char* dst, float* inv_scale, int lane) {
    float m = 0.f;
#pragma unroll
    for (int j = 0; j < 4; ++j) m = fmaxf(m, fmaxf(fmaxf(fabsf(v[j].x), fabsf(v[j].y)), fmaxf(fabsf(v[j].z), fabsf(v[j].w))));
#pragma unroll
    for (int o = 1; o < 64; o <<= 1) m = fmaxf(m, __shfl_xor(m, o));
    unsigned ww[4]; float isc;
    if (I8) { const float sc = m > 0.f ? 127.0f / m : 0.f; isc = m * (1.0f / 127.0f);
#pragma unroll
        for (int j = 0; j < 4; ++j) { const int q0 = (int)rintf(v[j].x * sc), q1 = (int)rintf(v[j].y * sc), q2 = (int)rintf(v[j].z * sc), q3 = (int)rintf(v[j].w * sc);
            ww[j] = ((unsigned)q0 & 0xffu) | (((unsigned)q1 & 0xffu) << 8) | (((unsigned)q2 & 0xffu) << 16) | (((unsigned)q3 & 0xffu) << 24); } }
    else { const unsigned E = (__builtin_bit_cast(unsigned, m) >> 23) & 0xffu; float sc = 1.f; isc = 1.f;
        if (E >= 8u && E <= 250u) { sc = __builtin_bit_cast(float, (261u - E) << 23); isc = __builtin_bit_cast(float, (E - 7u) << 23); }
#pragma unroll
        for (int j = 0; j < 4; ++j) { int t = __builtin_amdgcn_cvt_pk_fp8_f32(v[j].x * sc, v[j].y * sc, 0, false); t = __builtin_amdgcn_cvt_pk_fp8_f32(v[j].z * sc, v[j].w * sc, t, true); ww[j] = (unsigned)t; } }
    *(GAS v4u*)(dst + (size_t)(lane >> 3) * NEXP * 128 + (size_t)row * 128 + 16 * (lane & 7)) = (v4u){ww[0], ww[1], ww[2], ww[3]};
    if (lane == 0) inv_scale[row] = isc;
}
template <bool I8> __device__ __forceinline__ void cvt_rows_8bit(const float* src, unsigned char* dst, float* inv_scale, int gw, int NGW, int lane) {
    for (int row = gw; row < NEXP; row += 2 * NGW) {
        const int row1 = row + NGW; const bool has1 = row1 < NEXP;
        f32x4 v0[4], v1[4];
#pragma unroll
        for (int j = 0; j < 4; ++j) v0[j] = *(const GAS f32x4*)(src + (size_t)row * D + 16 * lane + 4 * j);
#pragma unroll
        for (int j = 0; j < 4; ++j) v1[j] = has1 ? *(const GAS f32x4*)(src + (size_t)row1 * D + 16 * lane + 4 * j) : (f32x4){0.f, 0.f, 0.f, 0.f};
        cvt_row_store<I8>(v0, row, dst, inv_scale, lane);
        if (has1) cvt_row_store<I8>(v1, row1, dst, inv_scale, lane);
    }
}
__device__ __forceinline__ void p0_transpose_item(const float* W, int ldw, int src_col0, int valid, int K, bf16* WT, int dst_row0, int k0, LAS float* scr, int lane) {
    const int n_ = lane & 31;
#pragma unroll 8
    for (int i = 0; i < 32; ++i) { const int kk = 2 * i + (lane >> 5); scr[kk * 33 + n_] = (n_ < valid) ? W[(size_t)(k0 + kk) * ldw + src_col0 + n_] : 0.f; }
    LDS_WAIT(); asm volatile("" ::: "memory");
    const int c = lane & 7;
#pragma unroll
    for (int j = 0; j < 4; ++j) { const int n = (lane >> 3) + 8 * j; const LAS float* s = scr + (8 * c) * 33 + n;
        v4u o; o.x = pk2(s[0 * 33], s[1 * 33]); o.y = pk2(s[2 * 33], s[3 * 33]); o.z = pk2(s[4 * 33], s[5 * 33]); o.w = pk2(s[6 * 33], s[7 * 33]);
        *(GAS v4u*)(WT + (size_t)(dst_row0 + n) * K + k0 + 8 * c) = o; }
    LDS_WAIT(); asm volatile("" ::: "memory");
}
__device__ __forceinline__ bool p0_mat(int& r, const float* W, int K, int N, bf16* WT, LAS float* scr, int lane) {
    const int ng = N / 32, items = ng * (K / 64);
    if (r < items) { const int kb = r / ng, nb = r % ng; p0_transpose_item(W, N, 32 * nb, 32, K, WT, 32 * nb, 64 * kb, scr, lane); return true; }
    r -= items; return false;
}
__device__ __forceinline__ void cvt_f32_bf16_stream(const float* src, bf16* dst, size_t n8, size_t gtid, size_t gthreads) {
    for (size_t i = gtid; i < n8; i += gthreads) {
        const f32x4 a = *(const GAS f32x4*)(src + 8 * i), b = *(const GAS f32x4*)(src + 8 * i + 4);
        v4u o; o.x = pk2(a.x, a.y); o.y = pk2(a.z, a.w); o.z = pk2(b.x, b.y); o.w = pk2(b.z, b.w);
        *(GAS v4u*)(dst + 8 * i) = o; }
}

__device__ __forceinline__ void p0_prologue(Frame& F, const Args& args) {
    unsigned char* ws = F.ws;
    const int gw = F.bid * NWAVES + F.wave, NGW = F.G * NWAVES;
    const size_t gtid = (size_t)F.bid * NTHREADS + F.tid, gthreads = (size_t)F.G * NTHREADS;
    {
        LAS float* sl = (LAS float*)(F.lds);
        LAS float* red = (LAS float*)(F.lds + 32768);
        const float* c = args.in[I_C];
        for (int i = F.tid; i < BATCH * D; i += NTHREADS) { const float v = c[i]; sl[i] = v / (1.0f + __expf(-v)); }
        __syncthreads();
        for (int cb = F.bid; cb < 6 * D / 24; cb += F.G) {
            const int j0 = cb * 24;
            if (F.tid < 504) {
                const int kk = F.tid / 24, jj = F.tid % 24;
                float a[BATCH];
#pragma unroll
                for (int b = 0; b < BATCH; ++b) a[b] = 0.f;
                const float* w = args.in[I_ADAW] + j0 + jj;
                for (int k = kk; k < D; k += 21) { const float wv = w[(size_t)k * (6 * D)];
#pragma unroll
                    for (int b = 0; b < BATCH; ++b) a[b] += sl[b * D + k] * wv; }
#pragma unroll
                for (int b = 0; b < BATCH; ++b) red[(kk * 24 + jj) * BATCH + b] = a[b];
            }
            __syncthreads();
            if (F.tid < 24 * BATCH) { const int jj = F.tid / BATCH, b = F.tid % BATCH; float s = 0.f;
                for (int kk = 0; kk < 21; ++kk) s += red[(kk * 24 + jj) * BATCH + b];
                ((float*)(ws + WS_ADA))[b * (6 * D) + j0 + jj] = s + args.in[I_ADAB][j0 + jj]; }
            __syncthreads();
        }
    }
    if (F.bid >= 8 && F.bid < 40) {
        const int bb = F.bid - 8, kv = bb & 1, ch = bb >> 1;
        const float* pe = args.in[kv == 0 ? I_CPEK : I_CPEV]; const float* w1 = args.in[kv == 0 ? I_CW1K : I_CW1V];
        LAS float* red = (LAS float*)(F.lds);
        const int j = F.tid & 127, ic = F.tid >> 7; float s = 0.f;
        const int i0 = ch * 128 + ic * 32;
#pragma unroll 8
        for (int i = i0; i < i0 + 32; ++i) s += pe[i] * w1[(size_t)i * 128 + j];
        red[ic * 128 + j] = s; __syncthreads();
        if (F.tid < 128) atomicAdd((float*)(ws + (kv == 0 ? WS_CB1K : WS_CB1V)) + F.tid, (red[F.tid] + red[128 + F.tid]) + (red[256 + F.tid] + red[384 + F.tid]));
        __syncthreads();
    } else if (F.bid == 2) {
        for (int i = F.tid; i < 8 * 128; i += NTHREADS) { const int h = i >> 7, rel = i & 127;
            int bk = rel;
            if (rel >= 16) bk = 16 + (rel >= 19) + (rel >= 21) + (rel >= 24) + (rel >= 27) + (rel >= 31) + (rel >= 35) + (rel >= 40) + (rel >= 46) + (rel >= 52) + (rel >= 59) + (rel >= 67) + (rel >= 77) + (rel >= 87) + (rel >= 99) + (rel >= 113);
            ((float*)(ws + WS_BIASL))[i] = args.in[I_RELB][bk * 8 + h]; }
        if (F.tid < 64) {
            float mq = fabsf(args.in[I_QNG][F.tid]), mk = fmaxf(fmaxf(fabsf(args.in[I_KNG][F.tid]), fabsf(args.in[I_KNG][64 + F.tid])), fabsf(args.in[I_KNG][128 + F.tid]));
            float mb = fmaxf(fmaxf(fabsf(args.in[I_RELB][F.tid]), fabsf(args.in[I_RELB][64 + F.tid])), fmaxf(fabsf(args.in[I_RELB][128 + F.tid]), fabsf(args.in[I_RELB][192 + F.tid])));
#pragma unroll
            for (int o = 1; o < 64; o <<= 1) { mq = fmaxf(mq, __shfl_xor(mq, o)); mk = fmaxf(mk, __shfl_xor(mk, o)); mb = fmaxf(mb, __shfl_xor(mb, o)); }
            if (F.tid == 0) ((float*)(ws + WS_BIASL))[8 * 128] = 8.0f * mq * mk + mb; }
    }
    {
        LAS float* scr = (LAS float*)(F.lds + F.wave * 16384);
        constexpr int I_WINT = (NIN / 32) * (D / 64);
        constexpr int NITEMS = I_WINT + (1024 / 32) * (512 / 64) + (1024 / 32) * (1024 / 64) + (2048 / 32) * (1024 / 64) + 2 * (128 / 32) * (2048 / 64) + 2 * (64 / 32) * (128 / 64);
        for (int it = gw; it < NITEMS; it += NGW) {
            int r = it;
            if (r < I_WINT) {
                const int grp = r % (NIN / 32), kb = r / (NIN / 32);
                const int tile = grp >> 3, ct0 = (grp & 7) * 32;
                const int L0 = 64 * ((ct0 >> 5) & 3) + 32 * (ct0 >> 7);
                int src0, valid = 32;
                if (tile < 7) src0 = 256 * tile + L0; else if (tile < 15) src0 = 1816 + 256 * (tile - 7) + L0; else { src0 = 1792 + L0; valid = (L0 == 0) ? 24 : 0; }
                if (valid == 0) src0 = 0;
                p0_transpose_item(args.in[I_WIN], IN_COLS, src0, valid, D, (bf16*)(ws + WS_WIN_T), 32 * grp, 64 * kb, scr, F.lane);
                continue; }
            r -= I_WINT;
            if (p0_mat(r, args.in[I_WBA], 512, 1024, (bf16*)(ws + WS_WBA_T), scr, F.lane)) continue;
            if (p0_mat(r, args.in[I_WOUT], 1024, 1024, (bf16*)(ws + WS_WOUT_T), scr, F.lane)) continue;
            if (p0_mat(r, args.in[I_PWQ], 1024, 2048, (bf16*)(ws + WS_WQ_T), scr, F.lane)) continue;
            if (p0_mat(r, args.in[I_CW1K], 2048, 128, (bf16*)(ws + WS_CW1K_T), scr, F.lane)) continue;
            if (p0_mat(r, args.in[I_CW1V], 2048, 128, (bf16*)(ws + WS_CW1V_T), scr, F.lane)) continue;
            if (p0_mat(r, args.in[I_CW2K], 128, 64, (bf16*)(ws + WS_CW2K_T), scr, F.lane)) continue;
            p0_mat(r, args.in[I_CW2V], 128, 64, (bf16*)(ws + WS_CW2V_T), scr, F.lane);
        }
    }
    {
        const float* pw = args.in[I_POOLW]; const float* ps = args.in[I_POOLS]; const float* wbp = args.in[I_WBP];
        bf16* weff = (bf16*)(ws + WS_WEFF_T);
        LAS float* PWl = (LAS float*)(F.lds);
        LAS float* WBl = (LAS float*)(F.lds + 128 * 129 * 4);
        __syncthreads();
        for (int bb = F.bid; bb < 256; bb += F.G) {
            const int g = bb >> 6, d0 = (bb & 63) * 16;
            for (int i = F.tid; i < 128 * 128; i += NTHREADS) PWl[(i >> 7) * 129 + (i & 127)] = pw[(size_t)g * 16384 + i];
            for (int i = F.tid; i < 128 * 16; i += NTHREADS) { const int cc = i >> 4, dd = i & 15; WBl[cc * 17 + dd] = wbp[(size_t)(g * 128 + cc) * D + d0 + dd] * ps[g * 128 + cc]; }
            __syncthreads();
            const int c = F.tid & 127, q = F.tid >> 7;
            float acc4[4] = {0.f, 0.f, 0.f, 0.f};
#pragma unroll 4
            for (int cc = 0; cc < 128; ++cc) { const float a = PWl[c * 129 + cc];
#pragma unroll
                for (int e = 0; e < 4; ++e) acc4[e] += a * WBl[cc * 17 + 4 * q + e]; }
#pragma unroll
            for (int e = 0; e < 4; ++e) weff[(size_t)(d0 + 4 * q + e) * POOLW + g * 128 + c] = (bf16)f2bf(acc4[e]);
            __syncthreads();
        }
    }
    cvt_f32_bf16_stream(args.in[I_PSK], (bf16*)(ws + WS_SUBK), (size_t)16 * 128 * 128 / 8, gtid, gthreads);
    cvt_rows_8bit<true>(args.in[I_PU], ws + WS_UB, (float*)(ws + WS_SCLU), gw, NGW, F.lane);
    cvt_rows_8bit<false>(args.in[I_PV], ws + WS_VB, (float*)(ws + WS_SCLV), gw, NGW, F.lane);
}

template <bool Q8> __device__ __forceinline__ void modnorm_rows(Frame& F, const float* x, const float* g, const float* ada, int shift_idx, bf16* out) {
    const int gw = F.bid * NWAVES + F.wave, NGW = F.G * NWAVES;
    for (int m = gw; m < M; m += NGW) {
        const int b = m >> 12;
        const GAS f32x4* xr = (const GAS f32x4*)(x + (size_t)m * D) + F.lane;
        const GAS f32x4* gr = (const GAS f32x4*)g + F.lane;
        const GAS f32x4* sh = (const GAS f32x4*)(ada + (size_t)b * 6 * D + shift_idx * D) + F.lane;
        const GAS f32x4* sc = (const GAS f32x4*)(ada + (size_t)b * 6 * D + (shift_idx + 1) * D) + F.lane;
        f32x4 v[4]; float s = 0.f;
#pragma unroll
        for (int j = 0; j < 4; ++j) { v[j] = xr[64 * j]; s += (v[j].x * v[j].x + v[j].y * v[j].y) + (v[j].z * v[j].z + v[j].w * v[j].w); }
        const float rstd = rsqrtf(wave_sum(s) * (1.f / D) + EPS);
        GAS v2u* o8 = (GAS v2u*)(out + (size_t)m * D) + F.lane;
        float mx = 0.f;
#pragma unroll
        for (int j = 0; j < 4; ++j) { const f32x4 gg = gr[64 * j], ss = sh[64 * j], cc = sc[64 * j];
            const f32x4 y = (v[j] * rstd) * gg * (cc + 1.0f) + ss; v[j] = y;
            mx = fmaxf(mx, fmaxf(fmaxf(fabsf(y.x), fabsf(y.y)), fmaxf(fabsf(y.z), fabsf(y.w))));
            v2u o; o.x = pk2(y.x, y.y); o.y = pk2(y.z, y.w); o8[64 * j] = o; }
        if (Q8) {
#pragma unroll
            for (int o = 1; o < 64; o <<= 1) mx = fmaxf(mx, __shfl_xor(mx, o));
            const float qs = mx > 0.f ? 127.0f / mx : 0.f;
            GAS unsigned* h8 = (GAS unsigned*)(F.ws + WS_H8 + (size_t)m * D) + F.lane;
#pragma unroll
            for (int j = 0; j < 4; ++j) { const int q0 = (int)rintf(v[j].x * qs), q1 = (int)rintf(v[j].y * qs), q2 = (int)rintf(v[j].z * qs), q3 = (int)rintf(v[j].w * qs);
                h8[64 * j] = ((unsigned)q0 & 0xffu) | (((unsigned)q1 & 0xffu) << 8) | (((unsigned)q2 & 0xffu) << 16) | (((unsigned)q3 & 0xffu) << 24); }
            if (F.lane == 0) ((float*)(F.ws + WS_HS))[m] = mx * (1.0f / 127.0f);
        }
    }
}

struct EpiIn {
    static constexpr bool PERM = true, AFTER_DRAIN = false;
    unsigned char* ws; const float* qg; const float* kg;
    __device__ __forceinline__ void operator()(const pg8::f32x4 (&acc)[2][2][4][2], const pg8::Unit& u, int wr, int wc, int fr, int fq) const {
        const int pn = u.pn;
#pragma unroll
        for (int ai = 0; ai < 2; ++ai)
#pragma unroll
            for (int m = 0; m < 4; ++m) {
                const int row = u.pm * 256 + ai * 128 + wr * 64 + m * 16 + fr;
                float v[2][8];
#pragma unroll
                for (int bj = 0; bj < 2; ++bj)
#pragma unroll
                    for (int n = 0; n < 2; ++n)
#pragma unroll
                        for (int i = 0; i < 4; ++i) v[bj][4 * n + i] = acc[ai][bj][m][n][i];
                bf16* dst = nullptr; bool norm = false; const float* gain = nullptr; float mul = 1.f; bool sig = false;
                if (pn < 2) { dst = (bf16*)(ws + WS_ZP) + (size_t)row * 512 + 256 * pn + 64 * wc; }
                else if (pn < 4) { dst = (bf16*)(ws + WS_Q) + (size_t)row * 512 + 256 * (pn - 2) + 64 * wc; norm = true; gain = qg; mul = 0.125f * 1.4426950408889634f; }
                else if (pn < 7) { const int kind = pn - 4, isv = wc >> 1, g = wc & 1, b = row >> 12, t = row & 4095;
                    const size_t base = ((size_t)(b * 2 + g) * SEQ + t) * 64;
                    const size_t off = kind == 0 ? (isv ? WS_VCR : WS_KCR) : kind == 1 ? (isv ? WS_VS : WS_KS) : (isv ? WS_VW : WS_KW);
                    dst = (bf16*)(ws + off) + base; if (!isv && kind > 0) { norm = true; gain = kg + kind * 64; } }
                else if (pn < 15) { dst = (bf16*)(ws + WS_GM) + (size_t)row * 2048 + 256 * (pn - 7) + 64 * wc; sig = true; }
                else {
                    if (wc == 0 && fq < 3) { float* gp = (float*)(ws + WS_GATE) + (size_t)row * 24 + 8 * fq;
                        *(GAS f32x4*)gp = (f32x4){sigmoidf_(v[0][0]), sigmoidf_(v[0][1]), sigmoidf_(v[0][2]), sigmoidf_(v[0][3])};
                        *(GAS f32x4*)(gp + 4) = (f32x4){sigmoidf_(v[0][4]), sigmoidf_(v[0][5]), sigmoidf_(v[0][6]), sigmoidf_(v[0][7])}; }
                    continue; }
                if (norm) { float ss = 0.f;
#pragma unroll
                    for (int bj = 0; bj < 2; ++bj)
#pragma unroll
                        for (int e = 0; e < 8; ++e) ss += v[bj][e] * v[bj][e];
                    ss += __shfl_xor(ss, 16); ss += __shfl_xor(ss, 32);
                    const float rs = rsqrtf(ss * (1.f / 64.f) + EPS) * mul;
#pragma unroll
                    for (int bj = 0; bj < 2; ++bj)
#pragma unroll
                        for (int e = 0; e < 8; ++e) v[bj][e] = v[bj][e] * rs * gain[32 * bj + 8 * fq + e]; }
                if (sig) {
#pragma unroll
                    for (int bj = 0; bj < 2; ++bj)
#pragma unroll
                        for (int e = 0; e < 8; ++e) v[bj][e] = sigmoidf_(v[bj][e]); }
#pragma unroll
                for (int bj = 0; bj < 2; ++bj) { v4u o; o.x = pkh(v[bj][0], v[bj][1]); o.y = pkh(v[bj][2], v[bj][3]); o.z = pkh(v[bj][4], v[bj][5]); o.w = pkh(v[bj][6], v[bj][7]);
                    *(GAS v4u*)(dst + 32 * bj + 8 * fq) = o; }
            }
    }
};
template <bool ADD> struct EpiMix {
    static constexpr bool PERM = true, AFTER_DRAIN = false;
    bf16* MIX; const bf16* GM; int gmoff;
    __device__ __forceinline__ void operator()(const pg8::f32x4 (&acc)[2][2][4][2], const pg8::Unit& u, int wr, int wc, int fr, int fq) const {
#pragma unroll
        for (int ai = 0; ai < 2; ++ai)
#pragma unroll
            for (int m = 0; m < 4; ++m) {
                const int row = u.pm * 256 + ai * 128 + wr * 64 + m * 16 + fr;
#pragma unroll
                for (int bj = 0; bj < 2; ++bj) {
                    const int col = u.pn * 256 + bj * 128 + wc * 32 + 8 * fq;
                    const v4u gmv = *(const GAS v4u*)(GM + (size_t)row * 2048 + gmoff + col);
                    float r[8];
                    r[0] = acc[ai][bj][m][0][0] * bflo(gmv.x); r[1] = acc[ai][bj][m][0][1] * bfhi(gmv.x); r[2] = acc[ai][bj][m][0][2] * bflo(gmv.y); r[3] = acc[ai][bj][m][0][3] * bfhi(gmv.y);
                    r[4] = acc[ai][bj][m][1][0] * bflo(gmv.z); r[5] = acc[ai][bj][m][1][1] * bfhi(gmv.z); r[6] = acc[ai][bj][m][1][2] * bflo(gmv.w); r[7] = acc[ai][bj][m][1][3] * bfhi(gmv.w);
                    GAS v4u* dp = (GAS v4u*)(MIX + (size_t)row * 1024 + col);
                    if (ADD) { const v4u old = *dp; r[0] += bflo(old.x); r[1] += bfhi(old.x); r[2] += bflo(old.y); r[3] += bfhi(old.y); r[4] += bflo(old.z); r[5] += bfhi(old.z); r[6] += bflo(old.w); r[7] += bfhi(old.w); }
                    v4u o; o.x = pkh(r[0], r[1]); o.y = pkh(r[2], r[3]); o.z = pkh(r[4], r[5]); o.w = pkh(r[6], r[7]); *dp = o; }
            }
    }
};
struct EpiRes {
    static constexpr bool PERM = false, AFTER_DRAIN = false;
    const float* x; float* out; const float* ada; int gate_idx;
    __device__ __forceinline__ void operator()(const pg8::f32x4 (&acc)[2][2][4][2], const pg8::Unit& u, int wr, int wc, int fr, int fq) const {
#pragma unroll
        for (int ai = 0; ai < 2; ++ai)
#pragma unroll
            for (int m = 0; m < 4; ++m) {
                const int row = u.pm * 256 + ai * 128 + wr * 64 + m * 16 + fr, b = row >> 12;
#pragma unroll
                for (int bj = 0; bj < 2; ++bj)
#pragma unroll
                    for (int n = 0; n < 2; ++n) {
                        const int col = u.pn * 256 + bj * 128 + wc * 32 + 16 * n + 4 * fq;
                        const f32x4 gt = *(const GAS f32x4*)(ada + (size_t)b * 6 * D + gate_idx * D + col);
                        const f32x4 xv = *(const GAS f32x4*)(x + (size_t)row * D + col);
                        *(GAS f32x4*)(out + (size_t)row * D + col) = xv + gt * acc[ai][bj][m][n]; }
            }
    }
};

template <int W> __device__ __forceinline__ void pool_item(const bf16* zp, bf16* pl, int row, int col) {
    const int t = row & 4095;
    float s[8], self[8];
#pragma unroll
    for (int e = 0; e < 8; ++e) { s[e] = 0.f; self[e] = 0.f; }
    v4u z[W];
#pragma unroll
    for (int j = 0; j < W; ++j) z[j] = (j <= t) ? *(const GAS v4u*)(zp + (size_t)(row - j) * 512 + col) : (v4u){0u, 0u, 0u, 0u};
#pragma unroll
    for (int j = 0; j < W; ++j) { const float f[8] = {bflo(z[j].x), bfhi(z[j].x), bflo(z[j].y), bfhi(z[j].y), bflo(z[j].z), bfhi(z[j].z), bflo(z[j].w), bfhi(z[j].w)};
#pragma unroll
        for (int e = 0; e < 8; ++e) { s[e] += f[e]; if (j == 0) self[e] = f[e]; } }
    const float inv = 1.0f / (float)((t + 1 < W) ? (t + 1) : W);
    v4u o; o.x = pk2(s[0] * inv - self[0], s[1] * inv - self[1]); o.y = pk2(s[2] * inv - self[2], s[3] * inv - self[3]);
    o.z = pk2(s[4] * inv - self[4], s[5] * inv - self[5]); o.w = pk2(s[6] * inv - self[6], s[7] * inv - self[7]);
    *(GAS v4u*)(pl + (size_t)row * 512 + col) = o;
}
__device__ __forceinline__ void pool_phase(Frame& F) {
    const bf16* zp = (const bf16*)(F.ws + WS_ZP); bf16* pl = (bf16*)(F.ws + WS_PL);
    const int gw = F.bid * NWAVES + F.wave, NGW = F.G * NWAVES;
    for (int item = gw; item < 4 * (M / 4); item += NGW) {
        const int gi = item & 3, r4 = item >> 2, row = 4 * r4 + (F.lane >> 4), col = 128 * gi + 8 * (F.lane & 15);
        if (gi == 0) pool_item<2>(zp, pl, row, col); else if (gi == 1) pool_item<4>(zp, pl, row, col); else if (gi == 2) pool_item<8>(zp, pl, row, col); else pool_item<16>(zp, pl, row, col);
    }
}

typedef int v4i __attribute__((ext_vector_type(4)));
struct EpiStoreBf16 {
    static constexpr bool PERM = true, AFTER_DRAIN = false;
    bf16* O; int ldc;
    __device__ __forceinline__ void operator()(const pg8::f32x4 (&acc)[2][2][4][2], const pg8::Unit& u, int wr, int wc, int fr, int fq) const {
#pragma unroll
        for (int ai = 0; ai < 2; ++ai)
#pragma unroll
            for (int m = 0; m < 4; ++m) {
                const int row = u.pm * 256 + ai * 128 + wr * 64 + m * 16 + fr;
#pragma unroll
                for (int bj = 0; bj < 2; ++bj) {
                    const int col = u.pn * 256 + bj * 128 + wc * 32 + 8 * fq;
                    v4u o; o.x = pkh(acc[ai][bj][m][0][0], acc[ai][bj][m][0][1]); o.y = pkh(acc[ai][bj][m][0][2], acc[ai][bj][m][0][3]);
                    o.z = pkh(acc[ai][bj][m][1][0], acc[ai][bj][m][1][1]); o.w = pkh(acc[ai][bj][m][1][2], acc[ai][bj][m][1][3]);
                    *(GAS v4u*)(O + (size_t)row * ldc + col) = o; }
            }
    }
};

__device__ __forceinline__ unsigned fkey(float f) { const unsigned u = __builtin_bit_cast(unsigned, f); return (u >> 31) ? ~u : (u | 0x80000000u); }
__device__ __forceinline__ float funkey(unsigned k) { const unsigned u = (k >> 31) ? (k & 0x7fffffffu) : ~k; return __builtin_bit_cast(float, u); }
__device__ __forceinline__ unsigned umax_(unsigned a, unsigned b) { return a > b ? a : b; }
__device__ __forceinline__ unsigned umin_(unsigned a, unsigned b) { return a > b ? b : a; }
#define TOP16_INSERT(L, xin) do { unsigned _x = (xin); _Pragma("unroll") for (int _i = 0; _i < 16; ++_i) { const unsigned _h = umax_(L[_i], _x); _x = umin_(L[_i], _x); L[_i] = _h; } } while (0)
template <int MASK> __device__ __forceinline__ void top16_merge(unsigned (&L)[16]) {
    unsigned o[16];
#pragma unroll
    for (int i = 0; i < 16; ++i) o[i] = (unsigned)__shfl_xor((int)L[i], MASK);
#pragma unroll
    for (int i = 0; i < 16; ++i) L[i] = umax_(L[i], o[15 - i]);
#pragma unroll
    for (int d = 8; d >= 1; d >>= 1)
#pragma unroll
        for (int i = 0; i < 16; ++i) if ((i & d) == 0) { const unsigned hi = umax_(L[i], L[i + d]), lo = umin_(L[i], L[i + d]); L[i] = hi; L[i + d] = lo; }
}
constexpr int SST = 132;
constexpr int P9_LIST_OFF = 2 * 64 * SST * 4;
__device__ __forceinline__ void peer_select_phase(Frame& F) {
    const bf16* QV = (const bf16*)(F.ws + WS_QV); const bf16* SK = (const bf16*)(F.ws + WS_SUBK);
    int* EID = (int*)(F.ws + WS_EID); float* GW = (float*)(F.ws + WS_GW);
    LAS float* S = (LAS float*)(F.lds);
    LAS unsigned* LIST = (LAS unsigned*)(F.lds + P9_LIST_OFF);
    const int lane = F.lane, w = F.wave, l15 = lane & 15, lq = lane >> 4;
    const int p = w >> 2, kb = w & 3;
    constexpr int NU = (M / 64) * PH;
    bf16x8 a[4][4], bq[2][4];
#define P9_LOAD(u_) do { const int _tt = (u_) >> 3, _h = (u_) & 7; \
        const bf16* qa = QV + (size_t)(_tt * 64 + l15) * PQW + _h * 256 + p * 128 + 8 * lq; \
        const bf16* kbp = SK + (size_t)((_h * 2 + p) * 128 + 32 * kb + l15) * 128 + 8 * lq; \
        _Pragma("unroll") for (int ks = 0; ks < 4; ++ks) { \
            _Pragma("unroll") for (int rb = 0; rb < 4; ++rb) a[rb][ks] = *(const GAS bf16x8*)(qa + (size_t)(16 * rb) * PQW + 32 * ks); \
            _Pragma("unroll") for (int cb = 0; cb < 2; ++cb) bq[cb][ks] = *(const GAS bf16x8*)(kbp + (size_t)(16 * cb) * 128 + 32 * ks); } } while (0)
    if (F.bid < NU) P9_LOAD(F.bid);
    for (int u = F.bid; u < NU; u += F.G) {
        const int tt = u >> 3, h = u & 7, tok0 = tt * 64;
        {
            pg8::f32x4 acc[4][2];
#pragma unroll
            for (int rb = 0; rb < 4; ++rb)
#pragma unroll
                for (int cb = 0; cb < 2; ++cb) acc[rb][cb] = (pg8::f32x4){0.f, 0.f, 0.f, 0.f};
#pragma unroll
            for (int ks = 0; ks < 4; ++ks)
#pragma unroll
                for (int rb = 0; rb < 4; ++rb)
#pragma unroll
                    for (int cb = 0; cb < 2; ++cb) acc[rb][cb] = __builtin_amdgcn_mfma_f32_16x16x32_bf16(a[rb][ks], bq[cb][ks], acc[rb][cb], 0, 0, 0);
#pragma unroll
            for (int rb = 0; rb < 4; ++rb)
#pragma unroll
                for (int cb = 0; cb < 2; ++cb)
#pragma unroll
                    for (int r = 0; r < 4; ++r) S[(p * 64 + 16 * rb + 4 * lq + r) * SST + 32 * kb + 16 * cb + l15] = acc[rb][cb][r];
        }
        __syncthreads();
        if (u + F.G < NU) P9_LOAD(u + F.G);
        {
            const int row = F.tid >> 2, sub = F.tid & 3;
            const LAS float* sr = S + row * SST + sub;
            unsigned L[16];
#pragma unroll
            for (int i = 0; i < 16; ++i) L[i] = 0u;
#pragma unroll 4
            for (int i = 0; i < 32; ++i) { const unsigned key = (fkey(sr[4 * i]) & ~127u) | (unsigned)(4 * i + sub); TOP16_INSERT(L, key); }
            top16_merge<1>(L); top16_merge<2>(L);
            if (sub == 0) {
#pragma unroll
                for (int i = 0; i < 4; ++i) *(LAS v4u*)(LIST + row * 16 + 4 * i) = (v4u){L[4 * i], L[4 * i + 1], L[4 * i + 2], L[4 * i + 3]}; }
        }
        __syncthreads();
        if (F.tid < 256) {
            const int tok = F.tid >> 2, sub = F.tid & 3;
            float va[16], vb[16];
#pragma unroll
            for (int i = 0; i < 4; ++i) { const v4u x = *(const LAS v4u*)(LIST + tok * 16 + 4 * i), y = *(const LAS v4u*)(LIST + (64 + tok) * 16 + 4 * i);
                va[4 * i] = funkey(x.x & ~127u); va[4 * i + 1] = funkey(x.y & ~127u); va[4 * i + 2] = funkey(x.z & ~127u); va[4 * i + 3] = funkey(x.w & ~127u);
                vb[4 * i] = funkey(y.x & ~127u); vb[4 * i + 1] = funkey(y.y & ~127u); vb[4 * i + 2] = funkey(y.z & ~127u); vb[4 * i + 3] = funkey(y.w & ~127u); }
            unsigned L[16];
#pragma unroll
            for (int i = 0; i < 16; ++i) L[i] = 0u;
            {
                constexpr int NC = 50;
                constexpr unsigned char CI[52] = {0,0,0,0,0,0,0,0,0,0,0,0,0,0,0,0, 1,1,1,1,1,1,1,1, 2,2,2,2,2, 3,3,3,3, 4,4,4, 5,5, 6,6, 7,7, 8,9,10,11,12,13,14,15, 0,0};
                constexpr unsigned char CJ[52] = {0,1,2,3,4,5,6,7,8,9,10,11,12,13,14,15, 0,1,2,3,4,5,6,7, 0,1,2,3,4, 0,1,2,3, 0,1,2, 0,1, 0,1, 0,1, 0,0,0,0,0,0,0,0, 0,0};
#pragma unroll
                for (int g4 = 0; g4 < 13; ++g4) {
                    float sa = 0.f, sb = 0.f; unsigned id = 0u; bool ok = false;
#pragma unroll
                    for (int q = 0; q < 4; ++q) { const int n = 4 * g4 + q; if (n < NC) { const bool me = (sub == q); sa = me ? va[CI[n]] : sa; sb = me ? vb[CJ[n]] : sb; id = me ? (unsigned)(CI[n] * 16 + CJ[n]) : id; ok = ok || me; } }
                    const unsigned key = ok ? ((fkey(sa + sb) & ~255u) | id) : 0u;
                    TOP16_INSERT(L, key);
                }
            }
            top16_merge<1>(L); top16_merge<2>(L);
            const float mx = funkey(L[0] & ~255u);
            float e[16], sum = 0.f;
#pragma unroll
            for (int k = 0; k < 16; ++k) { e[k] = __expf(funkey(L[k] & ~255u) - mx); sum += e[k]; }
            const float inv = 1.0f / sum;
            const size_t ob = (size_t)(tok0 + tok) * 128;
#pragma unroll
            for (int k4 = 0; k4 < 4; ++k4) if (sub == k4) {
#pragma unroll
                for (int q = 0; q < 4; ++q) { const unsigned cid = L[4 * k4 + q] & 255u;
                    const unsigned ia = LIST[tok * 16 + (cid >> 4)] & 127u, ib = LIST[(64 + tok) * 16 + (cid & 15u)] & 127u;
                    const int slot = h * 16 + 4 * k4 + q;
                    EID[ob + slot] = (int)(ia * 128u + ib); GW[ob + slot] = e[4 * k4 + q] * inv; }
            }
        }
        __syncthreads();
    }
#undef P9_LOAD
}

__device__ __forceinline__ void unpack8(const v4u w, float (&f)[8]) { f[0] = bflo(w.x); f[1] = bfhi(w.x); f[2] = bflo(w.y); f[3] = bfhi(w.y); f[4] = bflo(w.z); f[5] = bfhi(w.z); f[6] = bflo(w.w); f[7] = bfhi(w.w); }
typedef float f32x2 __attribute__((ext_vector_type(2)));
__device__ __forceinline__ void unpack16_fp8(const v4u w, float (&f)[16]) {
    const unsigned ww[4] = {w.x, w.y, w.z, w.w};
#pragma unroll
    for (int d = 0; d < 4; ++d) { const f32x2 a = __builtin_amdgcn_cvt_pk_f32_fp8((int)ww[d], false), b = __builtin_amdgcn_cvt_pk_f32_fp8((int)ww[d], true);
        f[4 * d] = a.x; f[4 * d + 1] = a.y; f[4 * d + 2] = b.x; f[4 * d + 3] = b.y; }
}
template <int PV_> __device__ __forceinline__ void peer_dot_phase(Frame& F) {
    const unsigned char* H8 = F.ws + WS_H8; const int* EID = (const int*)(F.ws + WS_EID); float* PART = (float*)(F.ws + WS_PART);
    const int lane = F.lane, g = lane >> 3, j = lane & 7, x = F.bid & 7;
    const int nbx = (F.G - x + 7) >> 3, NW = nbx * NWAVES, gwv = (F.bid >> 3) * NWAVES + F.wave;
    const unsigned char* US = F.ws + WS_UB + (size_t)x * NEXP * 128; const unsigned j16 = 16u * (unsigned)j;
    int token = gwv;
    if (token >= M) return;
    v4i e4[4]; v4i hb;
#define PD_LOAD_E(tok_) do { _Pragma("unroll") for (int q = 0; q < 4; ++q) e4[q] = *(const GAS v4i*)(EID + (size_t)(tok_) * 128 + 16 * g + 4 * q); } while (0)
#define PD_ISSUE4(buf_, e_, b0_) do { buf_[b0_] = *(const GAS v4i*)(US + ((unsigned)e_.x * 128u + j16)); buf_[b0_ + 1] = *(const GAS v4i*)(US + ((unsigned)e_.y * 128u + j16)); \
        buf_[b0_ + 2] = *(const GAS v4i*)(US + ((unsigned)e_.z * 128u + j16)); buf_[b0_ + 3] = *(const GAS v4i*)(US + ((unsigned)e_.w * 128u + j16)); } while (0)
#define PD_DOT1(w_, dst_) do { int t = __builtin_amdgcn_sdot4(w_.x, hc.x, 0, false); t = __builtin_amdgcn_sdot4(w_.y, hc.y, t, false); t = __builtin_amdgcn_sdot4(w_.z, hc.z, t, false); t = __builtin_amdgcn_sdot4(w_.w, hc.w, t, false); \
        t += __shfl_xor(t, 1); t += __shfl_xor(t, 2); t += __shfl_xor(t, 4); dst_ = (float)t; } while (0)
    PD_LOAD_E(token); hb = *(const GAS v4i*)(H8 + (size_t)token * D + 128 * x + j16);
    v4i bA[8], bB[8];
    PD_ISSUE4(bA, e4[0], 0); PD_ISSUE4(bA, e4[1], 4);
    for (; token < M; token += NW) {
        const bool more = token + NW < M;
        PD_ISSUE4(bB, e4[2], 0); PD_ISSUE4(bB, e4[3], 4);
        const v4i hc = hb;
        if (more) { PD_LOAD_E(token + NW); hb = *(const GAS v4i*)(H8 + (size_t)(token + NW) * D + 128 * x + j16); }
        float s[16];
#pragma unroll
        for (int i = 0; i < 8; ++i) PD_DOT1(bA[i], s[i]);
        if (more) { PD_ISSUE4(bA, e4[0], 0); PD_ISSUE4(bA, e4[1], 4); }
#pragma unroll
        for (int i = 0; i < 8; ++i) PD_DOT1(bB[i], s[8 + i]);
        if (j == 0) { float* pp = PART + ((size_t)x * M + token) * 128 + g * 16;
#pragma unroll
            for (int i4 = 0; i4 < 4; ++i4) *(GAS f32x4*)(pp + 4 * i4) = (f32x4){s[4 * i4], s[4 * i4 + 1], s[4 * i4 + 2], s[4 * i4 + 3]}; }
    }
#undef PD_LOAD_E
#undef PD_ISSUE4
#undef PD_DOT1
}
__device__ __forceinline__ void peer_coef_phase(Frame& F) {
    const float* PART = (const float*)(F.ws + WS_PART); const int* EID = (const int*)(F.ws + WS_EID); const float* GW = (const float*)(F.ws + WS_GW); float* CF = (float*)(F.ws + WS_CF);
    const float* SCU = (const float*)(F.ws + WS_SCLU); const float* SCV = (const float*)(F.ws + WS_SCLV); const float* HS = (const float*)(F.ws + WS_HS);
    const size_t gtid = (size_t)F.bid * NTHREADS + F.tid, gthreads = (size_t)F.G * NTHREADS, n4 = (size_t)M * 128 / 4;
    for (size_t i4 = gtid; i4 < n4; i4 += gthreads) {
        f32x4 d = *(const GAS f32x4*)(PART + 4 * i4);
#pragma unroll
        for (int xx = 1; xx < 8; ++xx) d = d + *(const GAS f32x4*)(PART + (size_t)xx * M * 128 + 4 * i4);
        const v4i e = *(const GAS v4i*)(EID + 4 * i4); const f32x4 gw = *(const GAS f32x4*)(GW + 4 * i4);
        const float hs = HS[i4 >> 5];
        f32x4 r; r.x = gw.x * SCV[e.x] * gelu_tanh_safe(d.x * (SCU[e.x] * hs)); r.y = gw.y * SCV[e.y] * gelu_tanh_safe(d.y * (SCU[e.y] * hs));
        r.z = gw.z * SCV[e.z] * gelu_tanh_safe(d.z * (SCU[e.z] * hs)); r.w = gw.w * SCV[e.w] * gelu_tanh_safe(d.w * (SCU[e.w] * hs));
        *(GAS f32x4*)(CF + 4 * i4) = r; }
}
template <bool DRY> __device__ __forceinline__ void peer_out_phase(Frame& F, const float* ada, float* out) {
    const int* EID = (const int*)(F.ws + WS_EID); const float* CF = (const float*)(F.ws + WS_CF);
    const int lane = F.lane, g = lane >> 3, j = lane & 7, x = F.bid & 7;
    const int nbx = (F.G - x + 7) >> 3, NW = nbx * NWAVES, gwv = (F.bid >> 3) * NWAVES + F.wave;
    const unsigned char* VS = F.ws + WS_VB + (size_t)x * NEXP * 128; const unsigned j16 = 16u * (unsigned)j;
    if (gwv >= M) return;
    const int ntok = (M - 1 - gwv) / NW + 1;
#define PO_ISSUE4(buf_, e_, b0_) do { buf_[b0_] = *(const GAS v4u*)(VS + ((unsigned)e_.x * 128u + j16)); buf_[b0_ + 1] = *(const GAS v4u*)(VS + ((unsigned)e_.y * 128u + j16)); \
        buf_[b0_ + 2] = *(const GAS v4u*)(VS + ((unsigned)e_.z * 128u + j16)); buf_[b0_ + 3] = *(const GAS v4u*)(VS + ((unsigned)e_.w * 128u + j16)); } while (0)
#define PO_ROW(w_, c_) do { float f[16]; unpack16_fp8(w_, f); _Pragma("unroll") for (int k = 0; k < 16; ++k) o[k] += (c_) * f[k]; } while (0)
#define PO_ACC4(buf_, c4_, b0_) do { PO_ROW(buf_[b0_], c4_.x); PO_ROW(buf_[b0_ + 1], c4_.y); PO_ROW(buf_[b0_ + 2], c4_.z); PO_ROW(buf_[b0_ + 3], c4_.w); } while (0)
    v4i e4[4]; f32x4 c4[4]; v4u bA[8], bB[8];
#pragma unroll
    for (int q = 0; q < 4; ++q) { e4[q] = *(const GAS v4i*)(EID + (size_t)gwv * 128 + g * 16 + 4 * q); c4[q] = *(const GAS f32x4*)(CF + (size_t)gwv * 128 + g * 16 + 4 * q); }
    PO_ISSUE4(bA, e4[0], 0); PO_ISSUE4(bA, e4[1], 4);
    for (int it = 0; it < ntok; ++it) {
        const int token = gwv + it * NW, tn = gwv + (it + 1 < ntok ? it + 1 : it) * NW;
        PO_ISSUE4(bB, e4[2], 0); PO_ISSUE4(bB, e4[3], 4);
#pragma unroll
        for (int q = 0; q < 4; ++q) e4[q] = *(const GAS v4i*)(EID + (size_t)tn * 128 + g * 16 + 4 * q);
        float o[16];
#pragma unroll
        for (int k = 0; k < 16; ++k) o[k] = 0.f;
        PO_ACC4(bA, c4[0], 0); PO_ACC4(bA, c4[1], 4);
        PO_ISSUE4(bA, e4[0], 0); PO_ISSUE4(bA, e4[1], 4);
        PO_ACC4(bB, c4[2], 0); PO_ACC4(bB, c4[3], 4);
#pragma unroll
        for (int q = 0; q < 4; ++q) c4[q] = *(const GAS f32x4*)(CF + (size_t)tn * 128 + g * 16 + 4 * q);
#pragma unroll
        for (int k = 0; k < 16; ++k) { float t = o[k]; t += __shfl_xor(t, 8); t += __shfl_xor(t, 16); t += __shfl_xor(t, 32); o[k] = t; }
        if (g == 0) { const int b = token >> 12;
            const float* gt = ada + (size_t)b * 6 * D + 5 * D + 128 * x + 16 * j;
            float* xo = out + (size_t)token * D + 128 * x + 16 * j;
#pragma unroll
            for (int q = 0; q < 4; ++q) { const f32x4 xv = *(const GAS f32x4*)(xo + 4 * q), gv = *(const GAS f32x4*)(gt + 4 * q);
                const f32x4 res = xv + gv * (f32x4){o[4 * q], o[4 * q + 1], o[4 * q + 2], o[4 * q + 3]};
                if (DRY) { asm volatile("" :: "v"(res.x), "v"(res.y), "v"(res.z), "v"(res.w)); } else *(GAS f32x4*)(xo + 4 * q) = res; } }
    }
#undef PO_ISSUE4
#undef PO_ROW
#undef PO_ACC4
}

__device__ __forceinline__ void compress_phase(Frame& F, const float* kng) {
    LAS bf16* H2 = (LAS bf16*)(F.lds);
    LAS float* OUTS = (LAS float*)(F.lds + 16384);
    const int lane = F.lane, w = F.wave, l15 = lane & 15, lq = lane >> 4;
    for (int u = F.bid; u < NBG * 2 * 8; u += F.G) {
        const int ns = u & 7, kv = (u >> 3) & 1, bg = u >> 4, n0 = ns * 32;
        const bf16* A = (const bf16*)(F.ws + (kv ? WS_VCR : WS_KCR)) + (size_t)bg * SEQ * 64;
        const bf16* W1T = (const bf16*)(F.ws + (kv ? WS_CW1V_T : WS_CW1K_T));
        const bf16* W2T = (const bf16*)(F.ws + (kv ? WS_CW2V_T : WS_CW2K_T));
        const float* b1 = (const float*)(F.ws + (kv ? WS_CB1V : WS_CB1K));
        pg8::f32x4 acc[2];
        acc[0] = (pg8::f32x4){0.f, 0.f, 0.f, 0.f}; acc[1] = acc[0];
        const bf16* ap = A + (size_t)(n0 + l15) * 1024 + 8 * lq;
        const bf16* bp = W1T + (size_t)(16 * w + l15) * 2048 + 8 * lq;
#pragma unroll 4
        for (int ks = 0; ks < 64; ++ks) {
            const bf16x8 a0 = *(const GAS bf16x8*)(ap + 32 * ks), a1 = *(const GAS bf16x8*)(ap + 16 * 1024 + 32 * ks), b = *(const GAS bf16x8*)(bp + 32 * ks);
            acc[0] = __builtin_amdgcn_mfma_f32_16x16x32_bf16(a0, b, acc[0], 0, 0, 0);
            acc[1] = __builtin_amdgcn_mfma_f32_16x16x32_bf16(a1, b, acc[1], 0, 0, 0);
        }
        { const float bb = b1[16 * w + l15];
#pragma unroll
          for (int rb = 0; rb < 2; ++rb)
#pragma unroll
            for (int r = 0; r < 4; ++r) H2[(16 * rb + 4 * lq + r) * 136 + 16 * w + l15] = (bf16)f2bf(gelu_tanh_safe(acc[rb][r] + bb)); }
        __syncthreads();
        { const int rb = w >> 2, db = w & 3;
          pg8::f32x4 o = (pg8::f32x4){0.f, 0.f, 0.f, 0.f};
#pragma unroll
          for (int ks = 0; ks < 4; ++ks) {
              const bf16x8 a = *(const LAS bf16x8*)(H2 + (16 * rb + l15) * 136 + 32 * ks + 8 * lq);
              const bf16x8 b = *(const GAS bf16x8*)(W2T + (size_t)(16 * db + l15) * 128 + 32 * ks + 8 * lq);
              o = __builtin_amdgcn_mfma_f32_16x16x32_bf16(a, b, o, 0, 0, 0); }
#pragma unroll
          for (int r = 0; r < 4; ++r) OUTS[(16 * rb + 4 * lq + r) * 65 + 16 * db + l15] = o[r]; }
        __syncthreads();
        { const int n = F.tid >> 4, d4 = (F.tid & 15) * 4, ng = n0 + n;
          float v[4]; float ss = 0.f;
#pragma unroll
          for (int i = 0; i < 4; ++i) { v[i] = OUTS[n * 65 + d4 + i]; ss += v[i] * v[i]; }
          ss += __shfl_xor(ss, 1); ss += __shfl_xor(ss, 2); ss += __shfl_xor(ss, 4); ss += __shfl_xor(ss, 8);
          const bool pad = (ng >= NCMP);
          if (kv == 0) { const float rs = rsqrtf(ss * (1.f / 64.f) + EPS);
              v2u o; o.x = pad ? 0u : pk2(v[0] * rs * kng[d4], v[1] * rs * kng[d4 + 1]); o.y = pad ? 0u : pk2(v[2] * rs * kng[d4 + 2], v[3] * rs * kng[d4 + 3]);
              *(GAS v2u*)((bf16*)(F.ws + WS_KC) + ((size_t)bg * 256 + ng) * 64 + d4) = o; }
          else { bf16* vt = (bf16*)(F.ws + WS_VCT) + (size_t)bg * 64 * 256 + ng;
#pragma unroll
              for (int i = 0; i < 4; ++i) vt[(size_t)(d4 + i) * 256] = pad ? (bf16)0 : (bf16)f2bf(v[i]); } }
        __syncthreads();
    }
}
__device__ __forceinline__ void vtranspose_phase(Frame& F) {
    LAS bf16* T = (LAS bf16*)(F.lds + F.wave * 9216);
    const int gw = F.bid * NWAVES + F.wave, NGW = F.G * NWAVES, lane = F.lane;
    for (int job = gw; job < 2 * NBG * 64; job += NGW) {
        const int s = job & 63, bg = (job >> 6) & 15, which = job >> 10;
        const bf16* X = (const bf16*)(F.ws + (which ? WS_VW : WS_VS)) + ((size_t)bg * SEQ + 64 * s) * 64;
        bf16* XT = (bf16*)(F.ws + (which ? WS_VWT : WS_VST)) + (size_t)bg * 64 * SEQ + 64 * s;
#pragma unroll
        for (int i = 0; i < 8; ++i) { const int tok = (lane >> 3) + 8 * i, ch = lane & 7;
            const v4u x = *(const GAS v4u*)(X + (size_t)tok * 64 + 8 * ch);
            const unsigned ww[4] = {x.x, x.y, x.z, x.w};
#pragma unroll
            for (int e = 0; e < 4; ++e) { T[(8 * ch + 2 * e) * 72 + tok] = (bf16)(ww[e] & 0xffffu); T[(8 * ch + 2 * e + 1) * 72 + tok] = (bf16)(ww[e] >> 16); } }
        LDS_WAIT(); asm volatile("" ::: "memory");
#pragma unroll
        for (int i = 0; i < 8; ++i) { const int dim = (lane >> 3) + 8 * i, ch = lane & 7;
            const v4u y = *(const LAS v4u*)(T + dim * 72 + 8 * ch);
            *(GAS v4u*)(XT + (size_t)dim * SEQ + 8 * ch) = y; }
        LDS_WAIT(); asm volatile("" ::: "memory");
    }
}

constexpr int AT_KSTR = 72;
constexpr int AT_KBUF = 64 * AT_KSTR * 2;
constexpr int AT_OFF_K = 0, AT_OFF_V = 2 * AT_KBUF;
constexpr int AT_OFF_IMP1 = 4 * AT_KBUF, AT_OFF_IMP2 = AT_OFF_IMP1 + 64 * 65 * 4, AT_OFF_SEL = AT_OFF_IMP2 + 64 * 65 * 4;
constexpr int AT_OFF_LUT = AT_OFF_SEL + 4096, AT_OFF_LROW = AT_OFF_LUT + 4 * 128 * 4;
constexpr int AT_OFF_TD = AT_OFF_LROW + 8 * 32 * 4;
constexpr int AT_OFF_OUT = AT_OFF_TD + 96 * 32;
constexpr int AT_OFF_GATL = AT_OFF_OUT + 256 * 144;
constexpr int AT_LDS_END = AT_OFF_GATL + 64 * 12 * 4;
static_assert(AT_LDS_END <= RING_BYTES, "attention LDS");

struct AtTile { const bf16* k; const bf16* vt; int vstride; };
enum { TM_CMP1 = 0, TM_CMP2, TM_SELN, TM_SELF, TM_WINN, TM_WINF, TM_WINE };
__device__ __forceinline__ float fexp2(float x) { return __builtin_amdgcn_exp2f(x); }
template <int TM, int VAR, int RB = 3>
__device__ __forceinline__ void at_tile(const LAS unsigned char* kb_, const LAS unsigned char* vb_, const LAS float* LUTJ, LAS float* IMP1, LAS float* IMP2,
                                        const bf16x8 (&qf)[2][2], pg8::f32x4 (&oacc)[2][4], float (&lsum)[2], float (&lpart)[2], const float (&linv)[2],
                                        const int (&tok_r)[2], const unsigned (&selb)[2], float cfar, int relbase, int idx, int l15, int lq) {
    constexpr bool FAR = (TM == TM_SELF || TM == TM_WINF || TM == TM_WINE);
    v4u pfr[2][2];
#pragma unroll
    for (int cb = 0; cb < 4; ++cb) {
        pg8::f32x4 st[2];
        st[0] = FAR ? (pg8::f32x4){cfar, cfar, cfar, cfar} : (pg8::f32x4){0.f, 0.f, 0.f, 0.f}; st[1] = st[0];
        if (!(VAR & 64)) {
#pragma unroll
        for (int ks = 0; ks < 2; ++ks) { const bf16x8 kf = *(const LAS bf16x8*)(kb_ + (16 * cb + l15) * 144 + 64 * ks + 16 * lq);
#pragma unroll
            for (int rb = 0; rb < 2; ++rb) if (RB & (1 << rb)) st[rb] = __builtin_amdgcn_mfma_f32_16x16x32_bf16(kf, qf[rb][ks], st[rb], 0, 0, 0); } }
#pragma unroll
        for (int rb = 0; rb < 2; ++rb) if (RB & (1 << rb)) {
            const int tokc = tok_r[rb];
            float p[4];
#pragma unroll
            for (int r = 0; r < 4; ++r) {
                const int kl = 16 * cb + 4 * lq + r;
                if (VAR & 16) { p[r] = st[rb][r]; }
                else if (TM == TM_SELF) { const float e = fexp2(st[rb][r]); p[r] = selb[rb] ? e : 0.f; }
                else if (TM == TM_WINF) { p[r] = fexp2(st[rb][r]); }
                else if (TM == TM_WINE) { const float e = fexp2(st[rb][r]); p[r] = (kl > tokc) ? e : 0.f; }
                else {
                    const int rel = (TM == TM_CMP1 || TM == TM_CMP2) ? (relbase + tokc - 16 * kl) : (relbase + tokc - kl);
                    bool valid = rel >= 0; if (TM == TM_SELN) valid = valid && (selb[rb] != 0u);
                    const int ri = rel < 0 ? 0 : (rel > 127 ? 127 : rel);
                    const float e = fexp2(st[rb][r] + LUTJ[ri]);
                    p[r] = valid ? e : 0.f; }
            }
            if (TM == TM_CMP1) { lpart[rb] += (p[0] + p[1]) + (p[2] + p[3]); }
            else {
                if (TM == TM_CMP2) {
#pragma unroll
                    for (int r = 0; r < 4; ++r) p[r] *= linv[rb];
                    float h0 = p[0], h1 = p[1], h2 = p[2], h3 = p[3];
                    h0 += __shfl_xor(h0, 1); h1 += __shfl_xor(h1, 1); h2 += __shfl_xor(h2, 1); h3 += __shfl_xor(h3, 1);
                    h0 += __shfl_xor(h0, 2); h1 += __shfl_xor(h1, 2); h2 += __shfl_xor(h2, 2); h3 += __shfl_xor(h3, 2);
                    if ((l15 & 3) == 0) { const int sp = 16 * idx + 4 * cb + lq;
                        IMP1[tokc * 65 + sp] = (h0 + h1) + (h2 + 0.5f * h3);
                        if (sp + 1 < 64) IMP2[tokc * 65 + sp + 1] = 0.5f * h3; }
                } else lsum[rb] += (p[0] + p[1]) + (p[2] + p[3]);
                const unsigned lo = pg8::cvt_pk_bf16(p[0], p[1]), hi = pg8::cvt_pk_bf16(p[2], p[3]);
                if (cb & 1) { pfr[rb][cb >> 1].z = lo; pfr[rb][cb >> 1].w = hi; } else { pfr[rb][cb >> 1].x = lo; pfr[rb][cb >> 1].y = hi; } }
        }
    }
    if (TM != TM_CMP1 && !(VAR & 8)) {
#pragma unroll
        for (int ks = 0; ks < 2; ++ks)
#pragma unroll
            for (int db = 0; db < 4; ++db) {
                const LAS unsigned char* vp = vb_ + (16 * db + l15) * 144 + 64 * ks + 8 * lq;
                const v2u v0 = *(const LAS v2u*)vp, v1 = *(const LAS v2u*)(vp + 32);
                const v4u vv = (v4u){v0.x, v0.y, v1.x, v1.y};
#pragma unroll
                for (int rb = 0; rb < 2; ++rb) if (RB & (1 << rb)) oacc[rb][db] = __builtin_amdgcn_mfma_f32_16x16x32_bf16(__builtin_bit_cast(bf16x8, pfr[rb][ks]), __builtin_bit_cast(bf16x8, vv), oacc[rb][db], 0, 0, 0); }
    }
}

template <int VAR> __device__ __forceinline__ void attention_phase(Frame& F, const Args& args) {
    unsigned char* ws = F.ws;
    const int lane = F.lane, w = F.wave, l15 = lane & 15, lq = lane >> 4, tid = F.tid;
    LAS unsigned char* L = F.lds;
    LAS float* IMP1 = (LAS float*)(L + AT_OFF_IMP1); LAS float* IMP2 = (LAS float*)(L + AT_OFF_IMP2);
    LAS unsigned long long* SELM = (LAS unsigned long long*)(L + AT_OFF_SEL); LAS float* LUT = (LAS float*)(L + AT_OFF_LUT); LAS float* LROW = (LAS float*)(L + AT_OFF_LROW) + w * 32;
    LAS int* TD = (LAS int*)(L + AT_OFF_TD); LAS bf16* OUTL = (LAS bf16*)(L + AT_OFF_OUT) + (32 * w) * 72; LAS float* GATL = (LAS float*)(L + AT_OFF_GATL);
    const float M0 = ((const float*)(ws + WS_BIASL))[8 * 128];
    const bf16* Qg = (const bf16*)(ws + WS_Q); const float* GATE = (const float*)(ws + WS_GATE); bf16* YA = (bf16*)(ws + WS_YA); float* YAF = (float*)(ws + WS_H);
    const int jq = l15 & 3;
    const LAS float* LUTJ = LUT + jq * 128;
    const int nrounds = (F.G == 256) ? 4 : (1024 + F.G - 1) / F.G;
    for (int round = 0; round < nrounds; ++round) {
        const int ui = (F.G == 256) ? ((round & 1) ? ((round >> 1) * 512 + 511 - F.bid) : ((round >> 1) * 512 + F.bid)) : (round * F.G + F.bid);
        if (ui >= 1024) break;
        const int c = 63 - (ui >> 4), bg = ui & 15, b = bg >> 1, g = bg & 1;
        const int m0 = b * SEQ + 64 * c;
        __syncthreads();
        for (int i = tid; i < 512; i += NTHREADS) LUT[i] = (((const float*)(ws + WS_BIASL))[(4 * g + (i >> 7)) * 128 + (i & 127)] - M0) * 1.4426950408889634f;
        for (int i = tid; i < 64 * 65; i += NTHREADS) { IMP1[i] = 0.f; IMP2[i] = 0.f; }
        for (int i = tid; i < 64 * 12; i += NTHREADS) GATL[i] = GATE[(size_t)(m0 + i / 12) * 24 + g * 12 + (i % 12)];
        bf16x8 qf[2][2];
#pragma unroll
        for (int rb = 0; rb < 2; ++rb)
#pragma unroll
            for (int ks = 0; ks < 2; ++ks) qf[rb][ks] = *(const GAS bf16x8*)(Qg + (size_t)(m0 + 8 * w + 4 * rb + (l15 >> 2)) * 512 + g * 256 + jq * 64 + 32 * ks + 8 * lq);
        asm volatile("" :: "v"(qf[0][0]), "v"(qf[0][1]), "v"(qf[1][0]), "v"(qf[1][1]));
        const int ncmp = 4 * c + 3, n1 = (ncmp + 63) >> 6, nsel = c + 1, w0 = c >= 8 ? c - 8 : 0, nwin = c - w0 + 1;
        const int ntiles = 2 * n1 + nsel + nwin;
        if (tid < ntiles) { const int i = tid; int kind, idx; unsigned ko, vo, vs;
            if (i < n1) { kind = 0; idx = i; } else if (i < 2 * n1) { kind = 1; idx = i - n1; } else if (i < 2 * n1 + nsel) { kind = 2; idx = i - 2 * n1; } else { kind = 3; idx = w0 + (i - 2 * n1 - nsel); }
            if (kind < 2) { ko = (unsigned)(WS_KC + ((size_t)bg * 256 * 64 + (size_t)idx * 4096) * 2); vo = (unsigned)(WS_VCT + ((size_t)bg * 64 * 256 + 64 * idx) * 2); vs = 512u; }
            else if (kind == 2) { ko = (unsigned)(WS_KS + ((size_t)bg * SEQ * 64 + (size_t)idx * 4096) * 2); vo = (unsigned)(WS_VST + ((size_t)bg * 64 * SEQ + 64 * idx) * 2); vs = 2u * SEQ; }
            else { ko = (unsigned)(WS_KW + ((size_t)bg * SEQ * 64 + (size_t)idx * 4096) * 2); vo = (unsigned)(WS_VWT + ((size_t)bg * 64 * SEQ + 64 * idx) * 2); vs = 2u * SEQ; }
            const int dd = c - idx;
            int mode, relbase;
            if (kind == 0) { mode = TM_CMP1; relbase = 64 * c - 31 - 1024 * idx; } else if (kind == 1) { mode = TM_CMP2; relbase = 64 * c - 31 - 1024 * idx; }
            else if (kind == 2) { mode = dd <= 2 ? TM_SELN : TM_SELF; relbase = 64 * dd; } else { mode = dd <= 2 ? TM_WINN : (dd == 8 ? TM_WINE : TM_WINF); relbase = 64 * dd; }
            const int endf = ((kind == 1 && idx == n1 - 1) || (kind == 2 && idx == nsel - 1) || (kind == 3 && idx == c)) ? kind : 0;
            LAS int* td = TD + 8 * i; td[0] = mode; td[1] = idx; td[2] = relbase; td[3] = endf; td[4] = (int)ko; td[5] = (int)vo; td[6] = (int)vs; td[7] = (kind == 2 && idx == 0) ? 1 : 0; }
        const int srow = tid >> 3, sch = tid & 7;
        __syncthreads();
        v4u kreg, vreg;
        { const unsigned ko = (unsigned)TD[4], vo = (unsigned)TD[5], vs = (unsigned)TD[6];
          kreg = *(const GAS v4u*)(ws + (size_t)(ko + srow * 128 + 16 * sch)); vreg = *(const GAS v4u*)(ws + (size_t)(vo + srow * vs + 16 * sch));
          *(LAS v4u*)(L + AT_OFF_K + srow * 144 + 16 * sch) = kreg; *(LAS v4u*)(L + AT_OFF_V + srow * 144 + 16 * sch) = vreg; }
        __syncthreads();
        const float cfar = LUTJ[127];
        float lpart[2] = {0.f, 0.f};
        float linv[2] = {0.f, 0.f};
        pg8::f32x4 oacc[2][4];
        float lsum[2] = {0.f, 0.f};
#pragma unroll
        for (int rb = 0; rb < 2; ++rb)
#pragma unroll
            for (int db = 0; db < 4; ++db) oacc[rb][db] = (pg8::f32x4){0.f, 0.f, 0.f, 0.f};
        const int tok_r[2] = {8 * w + (l15 >> 2), 8 * w + 4 + (l15 >> 2)};
        v4i dnx = *(const LAS v4i*)(TD); int sfnx = TD[7];
        unsigned long long selm[2] = {~0ull, ~0ull};
        for (int it = 0; it < ((VAR & 32) ? 0 : ntiles); ++it) {
            if (!(VAR & 2) && it + 1 < ntiles) { const LAS int* tn = TD + 8 * (it + 1); const unsigned ko = (unsigned)tn[4], vo = (unsigned)tn[5], vs = (unsigned)tn[6];
                kreg = *(const GAS v4u*)(ws + (size_t)(ko + srow * 128 + 16 * sch)); vreg = *(const GAS v4u*)(ws + (size_t)(vo + srow * vs + 16 * sch)); }
            {
            const int mode = __builtin_amdgcn_readfirstlane(dnx.x), idx = __builtin_amdgcn_readfirstlane(dnx.y), relbase = __builtin_amdgcn_readfirstlane(dnx.z);
            const int endf = __builtin_amdgcn_readfirstlane(dnx.w), selfirst = __builtin_amdgcn_readfirstlane(sfnx);
            { const int itn = it + 1 < ntiles ? it + 1 : it; dnx = *(const LAS v4i*)(TD + 8 * itn); sfnx = TD[8 * itn + 7]; }
            const int buf = it & 1;
            if (selfirst) {
                { const int tok = 8 * w + (lane >> 3), s0 = 8 * (lane & 7);
                  unsigned key[8]; int rank[8];
#pragma unroll
                  for (int q = 0; q < 8; ++q) { const int sB = s0 + q; const bool vis = sB <= c, forced = (sB == 0) || (sB == c) || (sB == c - 1);
                      const float sc = vis ? (IMP1[tok * 65 + sB] + IMP2[tok * 65 + sB] + (forced ? 1000.f : 0.f)) : -1.f;
                      const unsigned u = __builtin_bit_cast(unsigned, sc); const unsigned fk = (u >> 31) ? ~u : (u | 0x80000000u);
                      key[q] = (fk & ~63u) | (unsigned)(63 - sB); rank[q] = 0; }
                  LAS unsigned* KEYS = (LAS unsigned*)IMP1;
#pragma unroll
                  for (int q = 0; q < 8; ++q) KEYS[tok * 65 + s0 + q] = key[q];
                  if (c >= 16 && !(VAR & 128)) {
#pragma unroll 8
                      for (int s2 = 0; s2 < 64; ++s2) { const unsigned k2 = KEYS[tok * 65 + s2];
#pragma unroll
                          for (int q = 0; q < 8; ++q) rank[q] += (k2 > key[q]) ? 1 : 0; } }
                  unsigned byte = 0u;
#pragma unroll
                  for (int q = 0; q < 8; ++q) byte |= ((rank[q] < 16 && (s0 + q) <= c) ? 1u : 0u) << q;
                  ((LAS unsigned char*)SELM)[tok * 8 + (lane & 7)] = (unsigned char)byte; }
                selm[0] = SELM[tok_r[0]]; selm[1] = SELM[tok_r[1]];
            }
            const LAS unsigned char* kb_ = L + AT_OFF_K + buf * AT_KBUF; const LAS unsigned char* vb_ = L + AT_OFF_V + buf * AT_KBUF;
            unsigned selb[2] = {1u, 1u};
#define AT_CALL(TMX) at_tile<TMX, VAR>(kb_, vb_, LUTJ, IMP1, IMP2, qf, oacc, lsum, lpart, linv, tok_r, selb, cfar, relbase, idx, l15, lq)
            if (mode == TM_SELF || mode == TM_SELN) { selb[0] = (unsigned)(selm[0] >> idx) & 1u; selb[1] = (unsigned)(selm[1] >> idx) & 1u; }
            if (mode == TM_SELF) {
                const bool a0 = __ballot(selb[0] != 0u) != 0ull, a1 = __ballot(selb[1] != 0u) != 0ull;
                if (a0 && a1) AT_CALL(TM_SELF);
                else if (a0) at_tile<TM_SELF, VAR, 1>(kb_, vb_, LUTJ, IMP1, IMP2, qf, oacc, lsum, lpart, linv, tok_r, selb, cfar, relbase, idx, l15, lq);
                else if (a1) at_tile<TM_SELF, VAR, 2>(kb_, vb_, LUTJ, IMP1, IMP2, qf, oacc, lsum, lpart, linv, tok_r, selb, cfar, relbase, idx, l15, lq); }
            else if (mode == TM_WINF) AT_CALL(TM_WINF);
            else if (mode == TM_SELN) AT_CALL(TM_SELN);
            else if (mode == TM_WINN) AT_CALL(TM_WINN);
            else if (mode == TM_WINE) AT_CALL(TM_WINE);
            else if (mode == TM_CMP2) AT_CALL(TM_CMP2);
            else { if (idx == 0) { lpart[0] = 0.f; lpart[1] = 0.f; }
                AT_CALL(TM_CMP1);
                if (idx == n1 - 1) {
#pragma unroll
                    for (int rb = 0; rb < 2; ++rb) { float s = lpart[rb]; s += __shfl_xor(s, 16); s += __shfl_xor(s, 32); linv[rb] = s > 0.f ? 1.0f / s : 0.f; } } }
#undef AT_CALL
            {
                if (endf && !(VAR & 256)) {
                    const int br = endf - 1;
                    if (endf == 1) { LROW[l15] = 1.0f; LROW[16 + l15] = 1.0f; }
                    else {
#pragma unroll
                        for (int rb = 0; rb < 2; ++rb) { float s = lsum[rb]; s += __shfl_xor(s, 16); s += __shfl_xor(s, 32); if (lq == 0) LROW[16 * rb + l15] = s > 0.f ? 1.0f / s : 0.f; lsum[rb] = 0.f; } }
                    LDS_WAIT(); asm volatile("" ::: "memory");
#pragma unroll
                    for (int rb = 0; rb < 2; ++rb)
#pragma unroll
                        for (int r = 0; r < 4; ++r) { const int qrow = 16 * rb + 4 * lq + r;
                            const float gt = GATL[(8 * w + 4 * rb + lq) * 12 + r * 3 + br] * LROW[qrow];
#pragma unroll
                            for (int db = 0; db < 4; ++db) { float v = gt * oacc[rb][db][r]; oacc[rb][db][r] = 0.f;
                                LAS bf16* po = OUTL + qrow * 72 + 16 * db + l15;
                                if (br > 0) v += __builtin_bit_cast(float, (unsigned)(*po) << 16);
                                *po = (bf16)f2bf(v); } }
                    if (br == 2 && !(VAR & 1)) {
                        LDS_WAIT(); asm volatile("" ::: "memory");
#pragma unroll
                        for (int i = 0; i < 4; ++i) { const int ch = i * 64 + lane, row = ch >> 3, c16 = ch & 7;
                            const v4u o = *(const LAS v4u*)((const LAS unsigned char*)OUTL + row * 144 + 16 * c16);
                            *(GAS v4u*)(YA + (size_t)(m0 + 8 * w + (row >> 2)) * 512 + g * 256 + (row & 3) * 64 + 8 * c16) = o; }
                    }
                }
            }
            }
            if (!(VAR & 2) && it + 1 < ntiles) { const int nb = (it & 1) ^ 1; *(LAS v4u*)(L + AT_OFF_K + nb * AT_KBUF + srow * 144 + 16 * sch) = kreg; *(LAS v4u*)(L + AT_OFF_V + nb * AT_KBUF + srow * 144 + 16 * sch) = vreg; }
            if (!(VAR & 4)) __syncthreads();
        }
    }
}

constexpr int N_PHASES = 13;
#ifndef MK_ONE_LAUNCH
#define MK_ONE_LAUNCH 1
#endif
#ifndef REP_P0
#define REP_P0 1
#endif
#ifndef REP_P1
#define REP_P1 1
#endif
#ifndef REP_P2
#define REP_P2 1
#endif
#ifndef REP_P3
#define REP_P3 1
#endif
#ifndef REP_P5
#define REP_P5 1
#endif
#ifndef REP_P6
#define REP_P6 1
#endif
#ifndef REP_P8
#define REP_P8 1
#endif
#ifndef REP_P7
#define REP_P7 1
#endif
#ifndef REP_P11
#define REP_P11 1
#endif
#ifndef REP_P4
#define REP_P4 1
#endif
#ifndef REP_P9
#define REP_P9 1
#endif
#ifndef REP_P10
#define REP_P10 1
#endif
#ifndef MK_BUILD
#define MK_BUILD 0
#endif

__global__ void __launch_bounds__(NTHREADS, 2) fwd_kernel(Args args) {
    extern __shared__ __attribute__((aligned(16))) unsigned char lds[];
    Frame F;
    F.lds = (LAS unsigned char*)lds;
    F.MISC = (volatile LAS unsigned*)(F.lds + MISC_OFF);
    F.tid = threadIdx.x; F.lane = F.tid & 63; F.wave = __builtin_amdgcn_readfirstlane(F.tid >> 6);
    F.G = gridDim.x; F.bid = blockIdx.x; F.ws = args.ws;
    F.ctl = (gu32*)(args.ws + WS_CTL);
    for (int u = F.tid; u < (LDS_BYTES - LDSCTL_OFF) / 4; u += NTHREADS) ((LAS unsigned*)(F.lds + LDSCTL_OFF))[u] = 0u;
    __syncthreads();
    XcdBarrier bar; bar.bar = (unsigned*)(F.ctl + CW_BAR); bar.x = 0; bar.st = nullptr;
    if (MK_ONE_LAUNCH) bar = xcd_barrier_post((unsigned*)(F.ctl + CW_BAR), F.MISC + 8);
    const int lo = args.ph_lo, hi = args.ph_hi;
#define IN(k) (lo <= (k) && (k) < hi)
#define SEAM(k) do { if (IN(k) && IN((k) + 1)) xcd_barrier(bar); } while (0)
    unsigned char* ws = args.ws;
    const float* ada = (const float*)(ws + WS_ADA);

    if (IN(0)) { for (int rep = 0; rep < REP_P0; ++rep) { p0_prologue(F, args); __syncthreads(); } } SEAM(0);
    if (IN(1)) { for (int rep = 0; rep < REP_P1; ++rep) modnorm_rows<false>(F, args.in[I_X], args.in[I_N1G], ada, 0, (bf16*)(ws + WS_H)); } SEAM(1);
    if (IN(2)) { {
        pg8::Gemm g{(const bf16*)(ws + WS_H), (const bf16*)(ws + WS_WIN_T), M, NIN, D, D, D}; pg8::StaticOrder S; S.init(M, NIN, F.G, F.bid);
        EpiIn E{ws, args.in[I_QNG], args.in[I_KNG]};
        pg8::gemm_phase<EpiIn, pg8::StaticOrder, true, true>(F.lds + RING_OFF, g, S, E);
#if REP_P2 > 1
        __syncthreads(); pg8::gemm_phase<EpiIn, pg8::StaticOrder, true, true>(F.lds + RING_OFF, g, S, E);
#endif
        }
    } SEAM(2);
    if (IN(3)) { for (int rep = 0; rep < REP_P3; ++rep) { __syncthreads(); pool_phase(F); __syncthreads(); compress_phase(F, args.in[I_KNG]); __syncthreads(); vtranspose_phase(F); } } SEAM(3);
    if (IN(4)) {
#ifdef PROBE_P4
        attention_phase<PROBE_P4>(F, args); __syncthreads();
#endif
        attention_phase<0>(F, args); } SEAM(4);
    if (IN(5)) { {
        { pg8::Gemm g{(const bf16*)(ws + WS_PL), (const bf16*)(ws + WS_WEFF_T), M, D, POOLW, POOLW, POOLW}; pg8::StaticOrder S; S.init(M, D, F.G, F.bid);
          EpiMix<false> E{(bf16*)(ws + WS_MIX), (const bf16*)(ws + WS_GM), 0};
          pg8::gemm_phase<EpiMix<false>, pg8::StaticOrder, true, true>(F.lds + RING_OFF, g, S, E); }
        { pg8::Gemm g{(const bf16*)(ws + WS_YA), (const bf16*)(ws + WS_WBA_T), M, D, QW, QW, QW}; pg8::StaticOrder S; S.init(M, D, F.G, F.bid);
          EpiMix<true> E{(bf16*)(ws + WS_MIX), (const bf16*)(ws + WS_GM), 1024};
          pg8::gemm_phase<EpiMix<true>, pg8::StaticOrder, true, true>(F.lds + RING_OFF, g, S, E); } }
#if REP_P5 > 1
        { __syncthreads(); { pg8::Gemm g{(const bf16*)(ws + WS_PL), (const bf16*)(ws + WS_WEFF_T), M, D, POOLW, POOLW, POOLW}; pg8::StaticOrder S; S.init(M, D, F.G, F.bid);
          EpiMix<false> E{(bf16*)(ws + WS_MIX), (const bf16*)(ws + WS_GM), 0};
          pg8::gemm_phase<EpiMix<false>, pg8::StaticOrder, true, true>(F.lds + RING_OFF, g, S, E); }
        { pg8::Gemm g{(const bf16*)(ws + WS_YA), (const bf16*)(ws + WS_WBA_T), M, D, QW, QW, QW}; pg8::StaticOrder S; S.init(M, D, F.G, F.bid);
          EpiMix<true> E{(bf16*)(ws + WS_MIX), (const bf16*)(ws + WS_GM), 1024};
          pg8::gemm_phase<EpiMix<true>, pg8::StaticOrder, true, true>(F.lds + RING_OFF, g, S, E); } }
#endif
    } SEAM(5);
    if (IN(6)) { {
        pg8::Gemm g{(const bf16*)(ws + WS_MIX), (const bf16*)(ws + WS_WOUT_T), M, D, D, D, D}; pg8::StaticOrder S; S.init(M, D, F.G, F.bid);
        EpiRes E{args.in[I_X], args.out, ada, 2};
        pg8::gemm_phase<EpiRes, pg8::StaticOrder, true, true>(F.lds + RING_OFF, g, S, E);
#if REP_P6 > 1
        __syncthreads(); pg8::gemm_phase<EpiRes, pg8::StaticOrder, true, true>(F.lds + RING_OFF, g, S, E);
#endif
        }
    } SEAM(6);
    if (IN(7)) { for (int rep = 0; rep < REP_P7; ++rep) modnorm_rows<true>(F, args.out, args.in[I_N2G], ada, 3, (bf16*)(ws + WS_H)); } SEAM(7);
    if (IN(8)) { {
        pg8::Gemm g{(const bf16*)(ws + WS_H), (const bf16*)(ws + WS_WQ_T), M, PQW, D, D, D}; pg8::StaticOrder S; S.init(M, PQW, F.G, F.bid);
        EpiStoreBf16 E{(bf16*)(ws + WS_QV), PQW};
        pg8::gemm_phase<EpiStoreBf16, pg8::StaticOrder, true, true>(F.lds + RING_OFF, g, S, E);
#if REP_P8 > 1
        __syncthreads(); pg8::gemm_phase<EpiStoreBf16, pg8::StaticOrder, true, true>(F.lds + RING_OFF, g, S, E);
#endif
        }
    } SEAM(8);
    if (IN(9)) { for (int rep = 0; rep < REP_P9; ++rep) peer_select_phase(F); } SEAM(9);
#ifdef PROBE_XCD
    if (IN(10)) { if (F.tid == 0) __hip_atomic_store((unsigned*)(F.ctl + 2048 + F.bid), 100u + xb_xcc_id(), RLX_AGENT); }
#endif
    if (IN(10)) {
#ifdef PROBE_DOT
        peer_dot_phase<PROBE_DOT>(F); __syncthreads();
#endif
        peer_dot_phase<0>(F); } SEAM(10);
    if (IN(11)) { for (int rep = 0; rep < REP_P11; ++rep) peer_coef_phase(F); } SEAM(11);
#ifdef PROBE_XCD
    if (IN(12) && F.bid == 0 && F.tid == 0) { bool ok = true; for (int i = 0; i < F.G; ++i) { const unsigned a = __hip_atomic_load((unsigned*)(F.ctl + 2048 + i), RLX_AGENT), b0 = __hip_atomic_load((unsigned*)(F.ctl + 2048 + (i & 7)), RLX_AGENT); if (a != b0 || a < 100u) ok = false; }
        for (int i = 0; i < 8; ++i) for (int q = 0; q < i; ++q) if (__hip_atomic_load((unsigned*)(F.ctl + 2048 + i), RLX_AGENT) == __hip_atomic_load((unsigned*)(F.ctl + 2048 + q), RLX_AGENT)) ok = false;
        if (!ok) args.out[12345] = 1.0e9f; }
    __syncthreads();
#endif
    if (IN(12)) { for (int rep = 1; rep < REP_P10; ++rep) peer_out_phase<true>(F, ada, args.out); peer_out_phase<false>(F, ada, args.out); }
#undef IN
#undef SEAM
}

extern "C" void kernel_launch(void* const* d_in, const int* in_sizes, int n_in, void* d_out, int out_size, void* d_ws, size_t ws_size, hipStream_t stream) {
    static int grid = 0;
    if (grid == 0) {
        if (n_in != N_IN || in_sizes[0] != M * D || out_size != M * D || ws_size < WS_END) {
            fprintf(stderr, "kernel_launch: unexpected shapes: n_in %d in0 %d out %d ws %zu (need %zu)\n", n_in, n_in > 0 ? in_sizes[0] : -1, out_size, ws_size, (size_t)WS_END); grid = -1; return; }
        int dev = 0, cus = 0, per_cu = 0;
        if (hipGetDevice(&dev) != hipSuccess || hipDeviceGetAttribute(&cus, hipDeviceAttributeMultiprocessorCount, dev) != hipSuccess) { grid = -1; return; }
        if (hipFuncSetAttribute((const void*)fwd_kernel, hipFuncAttributeMaxDynamicSharedMemorySize, LDS_BYTES) != hipSuccess) { fprintf(stderr, "kernel_launch: hipFuncSetAttribute failed\n"); grid = -1; return; }
        if (hipOccupancyMaxActiveBlocksPerMultiprocessor(&per_cu, (const void*)fwd_kernel, NTHREADS, LDS_BYTES) != hipSuccess || per_cu < 1)
            fprintf(stderr, "kernel_launch: occupancy query reports %d workgroups per CU\n", per_cu);
        (void)hipGetLastError();
        grid = cus;
    }
    if (grid < 0) return;
    if (hipMemsetAsync((char*)d_ws + WS_CTL, 0, CTL_ZERO_BYTES, stream) != hipSuccess) return;
    Args a{};
    for (int i = 0; i < N_IN; ++i) a.in[i] = (const float*)d_in[i];
    a.out = (float*)d_out; a.ws = (unsigned char*)d_ws;
    if (MK_ONE_LAUNCH) {
        a.ph_lo = 0; a.ph_hi = N_PHASES; a.li = 0;
        hipLaunchKernelGGL(fwd_kernel, dim3(grid), dim3(NTHREADS), LDS_BYTES, stream, a);
    } else {
        for (int p = 0; p < N_PHASES; ++p) {
            a.ph_lo = p; a.ph_hi = p + 1; a.li = p;
            hipLaunchKernelGGL(fwd_kernel, dim3(grid), dim3(NTHREADS), LDS_BYTES, stream, a);
        }
    }
}
```

```cpp
#include <hip/hip_runtime.h>
#include <cstdio>
#include <cstdint>
namespace pg8 {
#define PG8_LAS __attribute__((address_space(3)))
typedef unsigned short bf16_t;
typedef short bf16x8 __attribute__((ext_vector_type(8)));
typedef float f32x4 __attribute__((ext_vector_type(4)));
typedef unsigned u32x4 __attribute__((ext_vector_type(4)));
constexpr int BM = 256, BK = 64, HALF = 128, HTB = HALF * BK * 2  , STAGE_BYTES = 8 * HTB, NXCD = 8, WGM = 8;

__host__ __device__ __forceinline__ int lds_byte(int r, int c) { const int st = (r >> 4) * 2 + (c >> 5), rr = r & 15, cc = c & 31, ob = rr * 64 + cc * 2; return st * 1024 + (ob ^ (((ob >> 9) & 1) << 5)); }
__host__ __device__ __forceinline__ void stage_rc(int b, int& R, int& C) { const int st = b / 1024, sb = b % 1024, swz = sb ^ (((sb >> 9) & 1) << 5); R = (st >> 1) * 16 + swz / 64; C = (st & 1) * 32 + (swz % 64) / 2; }
__host__ __device__ __forceinline__ int perm32(int rho) { const int n = rho >> 4, i = rho & 15; return 8 * (i >> 2) + 4 * n + (i & 3); }

struct Unit { int pm, pn; };
struct Gemm { const bf16_t* A; const bf16_t* Bt; int M, N, K, lda, ldb; };

struct StaticOrder {
    int nM, nN, nwg, G, c;
    __host__ __device__ void init(int M, int N, int G_, int c_) { nM = M / BM; nN = N / BM; nwg = nM * nN; G = G_; c = c_; }
    __host__ __device__ bool next(int i, Unit& u) const {
        const long L = (long)i * G + c; if (L >= nwg) return false;
        int wgid = (int)L; { const int q = nwg / NXCD, r = nwg % NXCD, xcd = wgid % NXCD, off = wgid / NXCD; wgid = (xcd < r ? xcd * (q + 1) : r * (q + 1) + (xcd - r) * q) + off; }
        const int nig = WGM * nN, gid = wgid / nig, fm = gid * WGM, gsz = (nM - fm) < WGM ? (nM - fm) : WGM;
        u.pm = fm + ((wgid % nig) % gsz); u.pn = (wgid % nig) / gsz; return true;
    }
    __device__ __forceinline__ void a_ready(const Unit&) const {}
    __device__ __forceinline__ void done(const Unit&) const {}
};

__device__ __forceinline__ unsigned cvt_pk_bf16(float lo, float hi) { unsigned r; asm volatile("v_cvt_pk_bf16_f32 %0, %1, %2" : "=v"(r) : "v"(lo), "v"(hi)); return r; }
template <class Epi, class Sched, bool ALIGN_EPI = false, bool SP2 = false>
__device__ __forceinline__ void gemm_phase(PG8_LAS unsigned char* lds, const Gemm g, const Sched& S, const Epi& E) {
    const int tid = threadIdx.x, wid = __builtin_amdgcn_readfirstlane(tid >> 6), lane = tid & 63, wr = wid >> 2, wc = wid & 3, fr = lane & 15, fq = lane >> 4;
    const int K = g.K, nt = K / BK;
    unsigned voffA[2], voffB[2];
#pragma unroll
    for (int i = 0; i < 2; ++i) { int R, C; stage_rc(tid * 16 + i * 8192, R, C); const int Rb = Epi::PERM ? ((R & ~31) + perm32(R & 31)) : R;
        voffA[i] = (unsigned)(R * g.lda + C) * 2u; voffB[i] = (unsigned)(Rb * g.ldb + C) * 2u; }
    const size_t kstep = (size_t)(BK * 2);
    const size_t hstepA = (size_t)HALF * g.lda * 2, hstepB = (size_t)HALF * g.ldb * 2;
    const size_t tstepA = 2 * hstepA, tstepB = 2 * hstepB;
    const unsigned ldsw = (unsigned)wid * 1024u;
    const int aoff = lds_byte(wr * 64 + fr, fq * 8), boff = lds_byte(wc * 32 + fr, fq * 8);
#define PG8_SA(b, h) (((b) * 2 + (h)) * HTB)
#define PG8_SB(b, h) ((4 + (b) * 2 + (h)) * HTB)
#define PG8_STAGE(bufoff, gbase, voff) do { _Pragma("unroll") for (int _i = 0; _i < 2; ++_i) \
        __builtin_amdgcn_global_load_lds((const unsigned*)((const char*)(gbase) + (voff)[_i]), (PG8_LAS unsigned*)(lds + (bufoff) + ldsw + _i * 8192), 16, 0, 0); } while (0)
#define PG8_LDA(dst, b, h) do { _Pragma("unroll") for (int m = 0; m < 4; ++m) _Pragma("unroll") for (int k = 0; k < 2; ++k) dst[m][k] = *(const PG8_LAS bf16x8*)(lds + PG8_SA(b, h) + aoff + m * 2048 + k * 1024); } while (0)
#define PG8_LDB(dst, b, h) do { _Pragma("unroll") for (int n = 0; n < 2; ++n) _Pragma("unroll") for (int k = 0; k < 2; ++k) dst[n][k] = *(const PG8_LAS bf16x8*)(lds + PG8_SB(b, h) + boff + n * 2048 + k * 1024); } while (0)
#define PG8_MMA(ai, bj, At, Bt) do { __builtin_amdgcn_s_setprio(1); _Pragma("unroll") for (int m = 0; m < 4; ++m) _Pragma("unroll") for (int n = 0; n < 2; ++n) _Pragma("unroll") for (int k = 0; k < 2; ++k) \
        acc[ai][bj][m][n] = __builtin_amdgcn_mfma_f32_16x16x32_bf16(Bt[n][k], At[m][k], acc[ai][bj][m][n], 0, 0, 0); __builtin_amdgcn_s_setprio(0); } while (0)
#define PG8_WAIT_V(n) asm volatile("s_waitcnt vmcnt(" #n ")" ::: "memory")
#define PG8_WAIT_L(n) asm volatile("s_waitcnt lgkmcnt(" #n ")" ::: "memory")
#define PG8_BAR __builtin_amdgcn_s_barrier()
#define PG8_SCHED __builtin_amdgcn_sched_barrier(0)
    Unit cur, nxt; int ui = 0;
    if (!S.next(0, cur)) return;
    f32x4 acc[2][2][4][2];
#pragma unroll
    for (int a = 0; a < 2; ++a)
#pragma unroll
        for (int b = 0; b < 2; ++b)
#pragma unroll
            for (int m = 0; m < 4; ++m)
#pragma unroll
                for (int n = 0; n < 2; ++n) acc[a][b][m][n] = (f32x4){0.f, 0.f, 0.f, 0.f};
    bf16x8 At[4][2], B0[2][2], B1[2][2];
    const char* cA = (const char*)g.A + (size_t)cur.pm * tstepA; const char* cB = (const char*)g.Bt + (size_t)cur.pn * tstepB;
    S.a_ready(cur);
    if constexpr (SP2) {
        PG8_STAGE(PG8_SB(0, 0), cB, voffB); PG8_STAGE(PG8_SB(0, 1), cB + hstepB, voffB); PG8_STAGE(PG8_SA(0, 0), cA, voffA); PG8_STAGE(PG8_SA(0, 1), cA + hstepA, voffA);
        if (wr == 1) PG8_BAR;
        PG8_WAIT_V(2); PG8_BAR;
        PG8_STAGE(PG8_SB(1, 0), cB + kstep, voffB); PG8_STAGE(PG8_SA(1, 0), cA + kstep, voffA); PG8_STAGE(PG8_SB(1, 1), cB + hstepB + kstep, voffB);
        PG8_WAIT_V(6); PG8_BAR;
    } else {
        PG8_STAGE(PG8_SB(0, 0), cB, voffB); PG8_STAGE(PG8_SA(0, 0), cA, voffA); PG8_STAGE(PG8_SB(0, 1), cB + hstepB, voffB); PG8_STAGE(PG8_SA(0, 1), cA + hstepA, voffA);
        if (wr == 1) PG8_BAR;
        PG8_WAIT_V(4); PG8_BAR;
        PG8_STAGE(PG8_SB(1, 0), cB + kstep, voffB); PG8_STAGE(PG8_SA(1, 0), cA + kstep, voffA); PG8_STAGE(PG8_SB(1, 1), cB + hstepB + kstep, voffB);
        PG8_WAIT_V(6); PG8_BAR;
    }
    for (;;) {
        const bool has_next = S.next(ui + 1, nxt);
        const char* nA = has_next ? (const char*)g.A + (size_t)nxt.pm * tstepA : cA; const char* nB = has_next ? (const char*)g.Bt + (size_t)nxt.pn * tstepB : cB;
        for (int t = 0; t < nt; t += 2) {
            const bool last = (t == nt - 2);
            const char* a1 = cA + (size_t)(t + 1) * kstep;
            const char* a2 = last ? nA : cA + (size_t)(t + 2) * kstep; const char* b2 = last ? nB : cB + (size_t)(t + 2) * kstep;
            const char* a3 = a2 + kstep; const char* b3 = b2 + kstep;
            if (last && has_next) S.a_ready(nxt);
            if constexpr (SP2) {
            PG8_LDB(B0, 0, 0); PG8_LDB(B1, 0, 1); PG8_SCHED; PG8_LDA(At, 0, 0); PG8_STAGE(PG8_SA(1, 1), a1 + hstepA, voffA);
            PG8_WAIT_V(8); PG8_WAIT_L(0); PG8_BAR; PG8_MMA(0, 0, At, B0); PG8_MMA(0, 1, At, B1); PG8_BAR; PG8_SCHED;
            PG8_LDA(At, 0, 1); PG8_STAGE(PG8_SB(0, 0), b2, voffB); PG8_STAGE(PG8_SB(0, 1), b2 + hstepB, voffB); PG8_STAGE(PG8_SA(0, 0), a2, voffA);
            PG8_WAIT_V(8); PG8_WAIT_L(0); PG8_BAR; PG8_MMA(1, 0, At, B0); PG8_MMA(1, 1, At, B1); PG8_BAR; PG8_SCHED;
            PG8_LDB(B0, 1, 0); PG8_LDB(B1, 1, 1); PG8_SCHED; PG8_LDA(At, 1, 0); PG8_STAGE(PG8_SA(0, 1), a2 + hstepA, voffA);
            PG8_WAIT_V(8); PG8_WAIT_L(0); PG8_BAR; PG8_MMA(0, 0, At, B0); PG8_MMA(0, 1, At, B1); PG8_BAR; PG8_SCHED;
            PG8_LDA(At, 1, 1); PG8_STAGE(PG8_SB(1, 0), b3, voffB); PG8_STAGE(PG8_SB(1, 1), b3 + hstepB, voffB); PG8_STAGE(PG8_SA(1, 0), a3, voffA);
            PG8_WAIT_V(8); PG8_WAIT_L(0); PG8_BAR; PG8_MMA(1, 0, At, B0); PG8_MMA(1, 1, At, B1); PG8_BAR; PG8_SCHED;
            } else {
            PG8_LDB(B0, 0, 0); PG8_SCHED; PG8_LDA(At, 0, 0); PG8_STAGE(PG8_SA(1, 1), a1 + hstepA, voffA);
            PG8_WAIT_L(8); PG8_BAR; PG8_WAIT_L(0); PG8_MMA(0, 0, At, B0); PG8_BAR; PG8_SCHED;
            PG8_LDB(B1, 0, 1); PG8_STAGE(PG8_SB(0, 0), b2, voffB);
            PG8_BAR; PG8_WAIT_L(0); PG8_MMA(0, 1, At, B1); PG8_BAR;
            PG8_LDA(At, 0, 1); PG8_STAGE(PG8_SA(0, 0), a2, voffA);
            PG8_BAR; PG8_WAIT_L(0); PG8_MMA(1, 0, At, B0); PG8_BAR; PG8_SCHED;
            PG8_STAGE(PG8_SB(0, 1), b2 + hstepB, voffB);
            PG8_WAIT_V(6); PG8_BAR; PG8_MMA(1, 1, At, B1); PG8_BAR;
            PG8_LDB(B0, 1, 0); PG8_SCHED; PG8_LDA(At, 1, 0); PG8_STAGE(PG8_SA(0, 1), a2 + hstepA, voffA);
            PG8_WAIT_L(8); PG8_BAR; PG8_WAIT_L(0); PG8_MMA(0, 0, At, B0); PG8_BAR; PG8_SCHED;
            PG8_LDB(B1, 1, 1); PG8_STAGE(PG8_SB(1, 0), b3, voffB);
            PG8_BAR; PG8_WAIT_L(0); PG8_MMA(0, 1, At, B1); PG8_BAR;
            PG8_LDA(At, 1, 1); PG8_STAGE(PG8_SA(1, 0), a3, voffA);
            PG8_BAR; PG8_WAIT_L(0); PG8_MMA(1, 0, At, B0); PG8_BAR; PG8_SCHED;
            PG8_STAGE(PG8_SB(1, 1), b3 + hstepB, voffB);
            PG8_WAIT_V(6); PG8_BAR; PG8_MMA(1, 1, At, B1); PG8_BAR;
            }
        }
        if constexpr (ALIGN_EPI) { if (wr == 0) PG8_BAR; }
        if constexpr (!Epi::AFTER_DRAIN) { E(acc, cur, wr, wc, fr, fq); S.done(cur); }
        if (!has_next) break;
#pragma unroll
        for (int a = 0; a < 2; ++a)
#pragma unroll
            for (int b = 0; b < 2; ++b)
#pragma unroll
                for (int m = 0; m < 4; ++m)
#pragma unroll
                    for (int n = 0; n < 2; ++n) acc[a][b][m][n] = (f32x4){0.f, 0.f, 0.f, 0.f};
        cur = nxt; cA = nA; cB = nB; ++ui;
        if constexpr (ALIGN_EPI) { if (wr == 1) PG8_BAR; }
    }
    PG8_WAIT_V(0);
    if constexpr (!ALIGN_EPI) { if (wr == 0) PG8_BAR; }
    PG8_BAR;
    if constexpr (Epi::AFTER_DRAIN) { E.fused(acc, cur, wr, wc, fr, fq, lds, wid, lane); S.done(cur); }
#undef PG8_SA
#undef PG8_SB
#undef PG8_STAGE
#undef PG8_LDA
#undef PG8_LDB
#undef PG8_MMA
#undef PG8_WAIT_V
#undef PG8_WAIT_L
#undef PG8_BAR
#undef PG8_SCHED
}
}

constexpr int NWAVES = 8, NTHREADS = NWAVES * 64;
constexpr int BATCH = 8, SEQ = 4096, D = 1024, M = BATCH * SEQ;
constexpr int POOLW = 512, QW = 512, NG = 2, HD = 64, NBG = BATCH * NG;
constexpr int IN_COLS = 3864, NIN = 4096;
constexpr int NCMP = 255, NCMP_PAD = 256, NSEL = 64;
constexpr int PH = 8, PK = 128, PTOP = 16, PQD = 256, PQW = PH * PQD;
constexpr int NEXP = PK * PK;
constexpr float EPS = 1e-6f;
enum { I_X = 0, I_C, I_RELB, I_ADAW, I_ADAB, I_N1G, I_N2G, I_WIN, I_POOLW, I_POOLS, I_CPEK, I_CW1K, I_CW2K, I_CPEV, I_CW1V, I_CW2V, I_QNG, I_KNG, I_WBP, I_WBA, I_WOUT, I_PWQ, I_PSK, I_PU, I_PV, N_IN };

constexpr size_t MiB = 1u << 20, KiB = 1u << 10;
constexpr size_t WS_CTL = 0, CTL_ZERO_BYTES = 1 * MiB;
constexpr size_t WS_ADA = 1 * MiB;
constexpr size_t WS_CB1K = 64 * KiB;
constexpr size_t WS_CB1V = WS_CB1K + 1 * KiB;
constexpr size_t WS_BIASL = WS_ADA + 256 * KiB;
constexpr size_t WS_WIN_T = 2 * MiB;
constexpr size_t WS_WEFF_T = 10 * MiB;
constexpr size_t WS_WBA_T = 11 * MiB;
constexpr size_t WS_WOUT_T = 12 * MiB;
constexpr size_t WS_WQ_T = 14 * MiB;
constexpr size_t WS_SUBK = 18 * MiB;
constexpr size_t WS_CW1K_T = 18 * MiB + 512 * KiB;
constexpr size_t WS_CW1V_T = 19 * MiB;
constexpr size_t WS_CW2K_T = 19 * MiB + 512 * KiB;
constexpr size_t WS_CW2V_T = WS_CW2K_T + 64 * KiB;
constexpr size_t WS_KC = 20 * MiB;
constexpr size_t WS_VCT = 20 * MiB + 512 * KiB;
constexpr size_t WS_GATE = 21 * MiB;
constexpr size_t WS_UB = 24 * MiB;
constexpr size_t WS_VB = 56 * MiB;
constexpr size_t WS_SCLU = WS_UB + 16 * MiB, WS_SCLV = WS_SCLU + 64 * KiB;
constexpr size_t WS_H = 88 * MiB;
constexpr size_t WS_ZP = 152 * MiB;
constexpr size_t WS_Q = 184 * MiB;
constexpr size_t WS_KCR = 216 * MiB;
constexpr size_t WS_VCR = 225 * MiB;
constexpr size_t WS_KS = 234 * MiB, WS_VS = 242 * MiB, WS_KW = 250 * MiB, WS_VW = 258 * MiB;
constexpr size_t WS_VST = 266 * MiB, WS_VWT = 274 * MiB;
constexpr size_t WS_PL = 282 * MiB;
constexpr size_t WS_YA = 314 * MiB;
constexpr size_t WS_GM = 346 * MiB;
constexpr size_t WS_MIX = WS_ZP;
constexpr size_t WS_QV = WS_GM;
constexpr size_t WS_EID = WS_PL;
constexpr size_t WS_GW = WS_PL + 16 * MiB;
constexpr size_t WS_PART = WS_GM;
constexpr size_t WS_CF = WS_YA;
constexpr size_t WS_CFS = WS_YA + 8 * MiB;
constexpr size_t WS_H8 = WS_ZP;
constexpr size_t WS_HS = WS_ZP + 32 * MiB;
constexpr size_t WS_END = 474 * MiB;
constexpr int CW_TMO = 0, CW_CODE = 1, CW_BAR = 4096;

constexpr int RING_OFF = 0, RING_BYTES = 131072;
constexpr int LDSCTL_OFF = RING_BYTES, MISC_OFF = LDSCTL_OFF + 320;
constexpr int LDS_BYTES = 147456;

#define GAS __attribute__((address_space(1)))
#define LAS __attribute__((address_space(3)))
typedef unsigned short bf16;
typedef unsigned v4u __attribute__((ext_vector_type(4)));
typedef unsigned v2u __attribute__((ext_vector_type(2)));
typedef int v2i __attribute__((ext_vector_type(2)));
typedef float f32x4 __attribute__((ext_vector_type(4)));
typedef short bf16x8 __attribute__((ext_vector_type(8)));
typedef GAS unsigned gu32;
#define RLX_AGENT __ATOMIC_RELAXED, __HIP_MEMORY_SCOPE_AGENT
#define LDS_WAIT() asm volatile("s_waitcnt lgkmcnt(0)" ::: "memory")
#define VM_WAIT() asm volatile("s_waitcnt vmcnt(0)" ::: "memory")
__device__ __forceinline__ unsigned f2bf(float f) { unsigned u = __builtin_bit_cast(unsigned, f); return (u + 0x7fffu + ((u >> 16) & 1u)) >> 16; }
__device__ __forceinline__ unsigned pk2(float lo, float hi) { return f2bf(lo) | (f2bf(hi) << 16); }
__device__ __forceinline__ float bflo(unsigned w) { return __builtin_bit_cast(float, w << 16); }
__device__ __forceinline__ float bfhi(unsigned w) { return __builtin_bit_cast(float, w & 0xffff0000u); }
__device__ __forceinline__ float sigmoidf_(float v) { return __builtin_amdgcn_rcpf(1.0f + __builtin_amdgcn_exp2f(v * -1.4426950408889634f)); }
__device__ __forceinline__ unsigned pkh(float lo, float hi) { unsigned r; asm volatile("v_cvt_pk_bf16_f32 %0, %1, %2" : "=v"(r) : "v"(lo), "v"(hi)); return r; }
__device__ __forceinline__ float gelu_tanh_safe(float v) { const float u = 0.7978845608028654f * (v + 0.044715f * v * v * v); return 0.5f * v * (1.0f + tanhf(u)); }
template <int CTRL> __device__ __forceinline__ float dppf(float v) { return __builtin_bit_cast(float, __builtin_amdgcn_update_dpp(0, __builtin_bit_cast(int, v), CTRL, 0xF, 0xF, true)); }
template <int CTRL> __device__ __forceinline__ int dppi(int v) { return __builtin_amdgcn_update_dpp(0, v, CTRL, 0xF, 0xF, true); }
#define DPP_XOR1 0xB1
#define DPP_XOR2 0x4E
#define DPP_HMIR 0x141
#define DPP_ROR8 0x128
__device__ __forceinline__ void swap16_(float& a, float& b) { asm volatile("v_nop\n\tv_nop\n\tv_permlane16_swap_b32 %0, %1" : "+v"(a), "+v"(b)); }
__device__ __forceinline__ void swap32_(float& a, float& b) { asm volatile("v_nop\n\tv_nop\n\tv_permlane32_swap_b32 %0, %1" : "+v"(a), "+v"(b)); }
__device__ __forceinline__ float sum_xor16(float v) { float a = v, b = v; swap16_(a, b); return a + b; }
__device__ __forceinline__ float sum_xor32(float v) { float a = v, b = v; swap32_(a, b); return a + b; }
__device__ __forceinline__ float max_xor16(float v) { float a = v, b = v; swap16_(a, b); return fmaxf(a, b); }
__device__ __forceinline__ float max_xor32(float v) { float a = v, b = v; swap32_(a, b); return fmaxf(a, b); }
__device__ __forceinline__ float wave_sum(float v) {
    v += dppf<DPP_XOR1>(v); v += dppf<DPP_XOR2>(v); v += dppf<DPP_HMIR>(v); v += dppf<DPP_ROR8>(v);
    return sum_xor32(sum_xor16(v));
}
__device__ __forceinline__ float wave_max(float v) {
    v = fmaxf(v, dppf<DPP_XOR1>(v)); v = fmaxf(v, dppf<DPP_XOR2>(v)); v = fmaxf(v, dppf<DPP_HMIR>(v)); v = fmaxf(v, dppf<DPP_ROR8>(v));
    return max_xor32(max_xor16(v));
}

#define XB_TMO      128
#define XB_XCNT(j)  (256  + 64 * (j))
#define XB_XSUB(j)  (1280 + 64 * (j))
#define XB_XGEN(j)  (2304 + 64 * (j))
#define XB_TOP      3328
#define XB_TOPGEN   3392
#define XCD_BAR_WORDS 3456
#define XB_SPIN_CAP (1u << 18)
__device__ __forceinline__ unsigned xb_ld(unsigned* p)              { return __hip_atomic_load(p, __ATOMIC_RELAXED, __HIP_MEMORY_SCOPE_AGENT); }
__device__ __forceinline__ unsigned xb_add(unsigned* p, unsigned v) { return __hip_atomic_fetch_add(p, v, __ATOMIC_RELAXED, __HIP_MEMORY_SCOPE_AGENT); }
__device__ __forceinline__ unsigned xb_xcc_id() { return (unsigned)__builtin_amdgcn_s_getreg((3 << 11) | 20) & 0xFu; }
#define XB_SPIN(cond, bar) do { unsigned _sp = 0; while (cond) { __builtin_amdgcn_s_sleep(1); \
    if ((++_sp & 255u) == 0u) { if (xb_ld(&(bar)[XB_TMO])) break; if (_sp > XB_SPIN_CAP) { atomicAdd(&(bar)[XB_TMO], 1u); break; } } } } while (0)
struct XcdBarrier { unsigned* bar; unsigned x; volatile LAS unsigned* st; };
__device__ __forceinline__ XcdBarrier xcd_barrier_post(unsigned* bar, volatile LAS unsigned* st) {
    XcdBarrier b; b.bar = bar; b.x = xb_xcc_id(); b.st = st;
    if (threadIdx.x == 0) (void)xb_add(&bar[XB_XCNT(b.x)], 1u);
    return b;
}
__device__ __forceinline__ void xcd_barrier_complete(unsigned* bar, unsigned x, unsigned& nloc, unsigned& nx) {
    const unsigned G = gridDim.x * gridDim.y * gridDim.z;
    unsigned sum, cnt, mine, sp = 0u;
    for (;;) {
        sum = 0u; cnt = 0u; mine = 0u;
#pragma unroll
        for (unsigned j = 0; j < 16; ++j) { const unsigned c = xb_ld(&bar[XB_XCNT(j)]); sum += c; cnt += (c > 0u) ? 1u : 0u; mine = (j == x) ? c : mine; }
        if (sum == G) break;
        __builtin_amdgcn_s_sleep(1);
        if ((++sp & 255u) == 0u) { if (xb_ld(&bar[XB_TMO])) break; if (sp > XB_SPIN_CAP) { atomicAdd(&bar[XB_TMO], 1u); break; } }
    }
    nloc = mine > 0u ? mine : 1u; nx = cnt > 0u ? cnt : 1u;
}
__device__ __forceinline__ void xcd_barrier(const XcdBarrier& b) {
    asm volatile("s_waitcnt vmcnt(0)" ::: "memory");
    __syncthreads();
    if (threadIdx.x == 0) {
        unsigned* bar = b.bar;
        __builtin_amdgcn_s_waitcnt(0);
        unsigned nloc = b.st[0], nx = b.st[1];
        if (nloc == 0u) { xcd_barrier_complete(bar, b.x, nloc, nx); b.st[0] = nloc; b.st[1] = nx; }
        const unsigned old = xb_add(&bar[XB_XSUB(b.x)], 1u);
        const unsigned gen = old / nloc;
        if (old + 1u == (gen + 1u) * nloc) {
            __builtin_amdgcn_fence(__ATOMIC_RELEASE, "agent");
            asm volatile("s_waitcnt vmcnt(0)" ::: "memory");
            const unsigned og = xb_add(&bar[XB_TOP], 1u);
            const unsigned tg = og / nx;
            if (og + 1u == (tg + 1u) * nx) xb_add(&bar[XB_TOPGEN], 1u);
            else XB_SPIN(xb_ld(&bar[XB_TOPGEN]) == tg, bar);
            __builtin_amdgcn_fence(__ATOMIC_ACQUIRE, "agent");
            xb_add(&bar[XB_XGEN(b.x)], 1u);
            asm volatile("s_waitcnt vmcnt(0)" ::: "memory");
        } else {
            XB_SPIN(xb_ld(&bar[XB_XGEN(b.x)]) == gen, bar);
            __builtin_amdgcn_fence(__ATOMIC_ACQUIRE, "agent");
            asm volatile("s_waitcnt vmcnt(0)" ::: "memory");
        }
    }
    __syncthreads();
}

struct Args { const float* in[N_IN]; float* out; unsigned char* ws; int ph_lo, ph_hi, li, pad; };
struct Frame {
    LAS unsigned char* lds;
    volatile LAS unsigned* MISC;
    gu32* ctl;
    int tid, lane, wave, G, bid;
    unsigned char* ws;
};

template <bool I8> __device__ __forceinline__ void cvt_row_store(const f32x4 (&v)[4], int row, unsigned char* dst, float* inv_scale, int lane) {
    float m = 0.f;
#pragma unroll
    for (int j = 0; j < 4; ++j) m = fmaxf(m, fmaxf(fmaxf(fabsf(v[j].x), fabsf(v[j].y)), fmaxf(fabsf(v[j].z), fabsf(v[j].w))));
    m = wave_max(m);
    unsigned ww[4]; float isc;
    if (I8) { const float sc = m > 0.f ? 127.0f / m : 0.f; isc = m * (1.0f / 127.0f);
#pragma unroll
        for (int j = 0; j < 4; ++j) { const int q0 = (int)rintf(v[j].x * sc), q1 = (int)rintf(v[j].y * sc), q2 = (int)rintf(v[j].z * sc), q3 = (int)rintf(v[j].w * sc);
            ww[j] = ((unsigned)q0 & 0xffu) | (((unsigned)q1 & 0xffu) << 8) | (((unsigned)q2 & 0xffu) << 16) | (((unsigned)q3 & 0xffu) << 24); } }
    else { const unsigned E = (__builtin_bit_cast(unsigned, m) >> 23) & 0xffu; float sc = 1.f; isc = 1.f;
        if (E >= 8u && E <= 250u) { sc = __builtin_bit_cast(float, (261u - E) << 23); isc = __builtin_bit_cast(float, (E - 7u) << 23); }
#pragma unroll
        for (int j = 0; j < 4; ++j) { int t = __builtin_amdgcn_cvt_pk_fp8_f32(v[j].x * sc, v[j].y * sc, 0, false); t = __builtin_amdgcn_cvt_pk_fp8_f32(v[j].z * sc, v[j].w * sc, t, true); ww[j] = (unsigned)t; } }
    *(GAS v4u*)(dst + (size_t)(lane >> 3) * NEXP * 128 + (size_t)row * 128 + 16 * (lane & 7)) = (v4u){ww[0], ww[1], ww[2], ww[3]};
    if (lane == 0) inv_scale[row] = isc;
}
template <bool I8> __device__ __forceinline__ void cvt_rows_8bit(const float* src, unsigned char* dst, float* inv_scale, int gw, int NGW, int lane) {
    for (int row = gw; row < NEXP; row += 2 * NGW) {
        const int row1 = row + NGW; const bool has1 = row1 < NEXP;
        f32x4 v0[4], v1[4];
#pragma unroll
        for (int j = 0; j < 4; ++j) v0[j] = *(const GAS f32x4*)(src + (size_t)row * D + 16 * lane + 4 * j);
#pragma unroll
        for (int j = 0; j < 4; ++j) v1[j] = has1 ? *(const GAS f32x4*)(src + (size_t)row1 * D + 16 * lane + 4 * j) : (f32x4){0.f, 0.f, 0.f, 0.f};
        cvt_row_store<I8>(v0, row, dst, inv_scale, lane);
        if (has1) cvt_row_store<I8>(v1, row1, dst, inv_scale, lane);
    }
}
__device__ __forceinline__ void p0_transpose_item(const float* W, int ldw, int src_col0, int valid, int K, bf16* WT, int dst_row0, int k0, LAS float* scr, int lane) {
    const int n_ = lane & 31;
#pragma unroll 8
    for (int i = 0; i < 32; ++i) { const int kk = 2 * i + (lane >> 5); scr[kk * 33 + n_] = (n_ < valid) ? W[(size_t)(k0 + kk) * ldw + src_col0 + n_] : 0.f; }
    LDS_WAIT(); asm volatile("" ::: "memory");
    const int c = lane & 7;
#pragma unroll
    for (int j = 0; j < 4; ++j) { const int n = (lane >> 3) + 8 * j; const LAS float* s = scr + (8 * c) * 33 + n;
        v4u o; o.x = pk2(s[0 * 33], s[1 * 33]); o.y = pk2(s[2 * 33], s[3 * 33]); o.z = pk2(s[4 * 33], s[5 * 33]); o.w = pk2(s[6 * 33], s[7 * 33]);
        *(GAS v4u*)(WT + (size_t)(dst_row0 + n) * K + k0 + 8 * c) = o; }
    LDS_WAIT(); asm volatile("" ::: "memory");
}
__device__ __forceinline__ bool p0_mat(int& r, const float* W, int K, int N, bf16* WT, LAS float* scr, int lane) {
    const int ng = N / 32, items = ng * (K / 64);
    if (r < items) { const int kb = r / ng, nb = r % ng; p0_transpose_item(W, N, 32 * nb, 32, K, WT, 32 * nb, 64 * kb, scr, lane); return true; }
    r -= items; return false;
}
__device__ __forceinline__ void cvt_f32_bf16_stream(const float* src, bf16* dst, size_t n8, size_t gtid, size_t gthreads) {
    for (size_t i = gtid; i < n8; i += gthreads) {
        const f32x4 a = *(const GAS f32x4*)(src + 8 * i), b = *(const GAS f32x4*)(src + 8 * i + 4);
        v4u o; o.x = pk2(a.x, a.y); o.y = pk2(a.z, a.w); o.z = pk2(b.x, b.y); o.w = pk2(b.z, b.w);
        *(GAS v4u*)(dst + 8 * i) = o; }
}

__device__ __forceinline__ void p0_prologue(Frame& F, const Args& args) {
    unsigned char* ws = F.ws;
    const int gw = F.bid * NWAVES + F.wave, NGW = F.G * NWAVES;
    const size_t gtid = (size_t)F.bid * NTHREADS + F.tid, gthreads = (size_t)F.G * NTHREADS;
    {
        LAS float* sl = (LAS float*)(F.lds);
        LAS float* red = (LAS float*)(F.lds + 32768);
        const float* c = args.in[I_C];
        { f32x4 cv[4];
#pragma unroll
          for (int q = 0; q < 4; ++q) cv[q] = *(const GAS f32x4*)(c + 4 * (F.tid + NTHREADS * q));
#pragma unroll
          for (int q = 0; q < 4; ++q) { f32x4 o; o.x = cv[q].x / (1.0f + __expf(-cv[q].x)); o.y = cv[q].y / (1.0f + __expf(-cv[q].y)); o.z = cv[q].z / (1.0f + __expf(-cv[q].z)); o.w = cv[q].w / (1.0f + __expf(-cv[q].w));
              *(LAS f32x4*)(sl + 4 * (F.tid + NTHREADS * q)) = o; } }
        __syncthreads();
        for (int cb = F.bid; cb < 6 * D / 24; cb += F.G) {
            const int j0 = cb * 24;
            if (F.tid < 510) {
                const int kk = F.tid / 6, c4 = F.tid % 6;
                const float* w = args.in[I_ADAW] + j0 + 4 * c4;
                f32x4 wv[13];
#pragma unroll
                for (int m = 0; m < 13; ++m) { const int k = kk + 85 * m; wv[m] = (k < D) ? *(const GAS f32x4*)(w + (size_t)k * (6 * D)) : (f32x4){0.f, 0.f, 0.f, 0.f}; }
                f32x4 a[BATCH];
#pragma unroll
                for (int b = 0; b < BATCH; ++b) a[b] = (f32x4){0.f, 0.f, 0.f, 0.f};
#pragma unroll
                for (int m = 0; m < 13; ++m) { const int k = kk + 85 * m; const int kc = k < D ? k : 0;
#pragma unroll
                    for (int b = 0; b < BATCH; ++b) a[b] = a[b] + wv[m] * sl[b * D + kc]; }
#pragma unroll
                for (int b = 0; b < BATCH; ++b) { LAS float* rp = red + (kk * 24 + 4 * c4) * BATCH + b; rp[0] = a[b].x; rp[BATCH] = a[b].y; rp[2 * BATCH] = a[b].z; rp[3 * BATCH] = a[b].w; }
            }
            __syncthreads();
            if (F.tid < 24 * BATCH) { const int jj = F.tid / BATCH, b = F.tid % BATCH; float s = 0.f;
#pragma unroll 5
                for (int kk = 0; kk < 85; ++kk) s += red[(kk * 24 + jj) * BATCH + b];
                ((float*)(ws + WS_ADA))[b * (6 * D) + j0 + jj] = s + args.in[I_ADAB][j0 + jj]; }
            __syncthreads();
        }
    }
    if (F.bid >= 8 && F.bid < 40) {
        const int bb = F.bid - 8, kv = bb & 1, ch = bb >> 1;
        const float* pe = args.in[kv == 0 ? I_CPEK : I_CPEV]; const float* w1 = args.in[kv == 0 ? I_CW1K : I_CW1V];
        LAS float* red = (LAS float*)(F.lds);
        const int j = F.tid & 127, ic = F.tid >> 7; float s = 0.f;
        const int i0 = ch * 128 + ic * 32;
#pragma unroll 8
        for (int i = i0; i < i0 + 32; ++i) s += pe[i] * w1[(size_t)i * 128 + j];
        red[ic * 128 + j] = s; __syncthreads();
        if (F.tid < 128) atomicAdd((float*)(ws + (kv == 0 ? WS_CB1K : WS_CB1V)) + F.tid, (red[F.tid] + red[128 + F.tid]) + (red[256 + F.tid] + red[384 + F.tid]));
        __syncthreads();
    } else if (F.bid == 2) {
        for (int i = F.tid; i < 8 * 128; i += NTHREADS) { const int h = i >> 7, rel = i & 127;
            int bk = rel;
            if (rel >= 16) bk = 16 + (rel >= 19) + (rel >= 21) + (rel >= 24) + (rel >= 27) + (rel >= 31) + (rel >= 35) + (rel >= 40) + (rel >= 46) + (rel >= 52) + (rel >= 59) + (rel >= 67) + (rel >= 77) + (rel >= 87) + (rel >= 99) + (rel >= 113);
            ((float*)(ws + WS_BIASL))[i] = args.in[I_RELB][bk * 8 + h]; }
        if (F.tid < 64) {
            float mq = fabsf(args.in[I_QNG][F.tid]), mk = fmaxf(fmaxf(fabsf(args.in[I_KNG][F.tid]), fabsf(args.in[I_KNG][64 + F.tid])), fabsf(args.in[I_KNG][128 + F.tid]));
            float mb = fmaxf(fmaxf(fabsf(args.in[I_RELB][F.tid]), fabsf(args.in[I_RELB][64 + F.tid])), fmaxf(fabsf(args.in[I_RELB][128 + F.tid]), fabsf(args.in[I_RELB][192 + F.tid])));
            mq = wave_max(mq); mk = wave_max(mk); mb = wave_max(mb);
            if (F.tid == 0) ((float*)(ws + WS_BIASL))[8 * 128] = 8.0f * mq * mk + mb; }
    }
    {
        LAS float* scr = (LAS float*)(F.lds + F.wave * 16384);
        constexpr int I_WINT = (NIN / 32) * (D / 64);
        constexpr int NITEMS = I_WINT + (1024 / 32) * (512 / 64) + (1024 / 32) * (1024 / 64) + (2048 / 32) * (1024 / 64) + 2 * (128 / 32) * (2048 / 64) + 2 * (64 / 32) * (128 / 64);
        for (int it = gw; it < NITEMS; it += NGW) {
            int r = it;
            if (r < I_WINT) {
                const int grp = r % (NIN / 32), kb = r / (NIN / 32);
                const int tile = grp >> 3, ct0 = (grp & 7) * 32;
                const int L0 = 64 * ((ct0 >> 5) & 3) + 32 * (ct0 >> 7);
                int src0, valid = 32;
                if (tile < 7) src0 = 256 * tile + L0; else if (tile < 15) src0 = 1816 + 256 * (tile - 7) + L0; else { src0 = 1792 + L0; valid = (L0 == 0) ? 24 : 0; }
                if (valid == 0) src0 = 0;
                p0_transpose_item(args.in[I_WIN], IN_COLS, src0, valid, D, (bf16*)(ws + WS_WIN_T), 32 * grp, 64 * kb, scr, F.lane);
                continue; }
            r -= I_WINT;
            if (p0_mat(r, args.in[I_WBA], 512, 1024, (bf16*)(ws + WS_WBA_T), scr, F.lane)) continue;
            if (p0_mat(r, args.in[I_WOUT], 1024, 1024, (bf16*)(ws + WS_WOUT_T), scr, F.lane)) continue;
            if (p0_mat(r, args.in[I_PWQ], 1024, 2048, (bf16*)(ws + WS_WQ_T), scr, F.lane)) continue;
            if (p0_mat(r, args.in[I_CW1K], 2048, 128, (bf16*)(ws + WS_CW1K_T), scr, F.lane)) continue;
            if (p0_mat(r, args.in[I_CW1V], 2048, 128, (bf16*)(ws + WS_CW1V_T), scr, F.lane)) continue;
            if (p0_mat(r, args.in[I_CW2K], 128, 64, (bf16*)(ws + WS_CW2K_T), scr, F.lane)) continue;
            p0_mat(r, args.in[I_CW2V], 128, 64, (bf16*)(ws + WS_CW2V_T), scr, F.lane);
        }
    }
    {
        const float* pw = args.in[I_POOLW]; const float* ps = args.in[I_POOLS]; const float* wbp = args.in[I_WBP];
        bf16* weff = (bf16*)(ws + WS_WEFF_T);
        LAS float* PWl = (LAS float*)(F.lds);
        LAS float* WBl = (LAS float*)(F.lds + 128 * 129 * 4);
        __syncthreads();
        for (int bb = F.bid; bb < 256; bb += F.G) {
            const int g = bb >> 6, d0 = (bb & 63) * 16;
            { f32x4 t[8];
#pragma unroll
              for (int q = 0; q < 8; ++q) t[q] = *(const GAS f32x4*)(pw + (size_t)g * 16384 + 4 * (F.tid + NTHREADS * q));
#pragma unroll
              for (int q = 0; q < 8; ++q) { const int i = 4 * (F.tid + NTHREADS * q); LAS float* d = PWl + (i >> 7) * 129 + (i & 127); d[0] = t[q].x; d[1] = t[q].y; d[2] = t[q].z; d[3] = t[q].w; }
              const int cc = F.tid >> 2, d4 = (F.tid & 3) * 4;
              const f32x4 wv = *(const GAS f32x4*)(wbp + (size_t)(g * 128 + cc) * D + d0 + d4); const float pv = ps[g * 128 + cc];
              LAS float* d = WBl + cc * 17 + d4; d[0] = wv.x * pv; d[1] = wv.y * pv; d[2] = wv.z * pv; d[3] = wv.w * pv; }
            __syncthreads();
            const int c = F.tid & 127, q = F.tid >> 7;
            float acc4[4] = {0.f, 0.f, 0.f, 0.f};
#pragma unroll 4
            for (int cc = 0; cc < 128; ++cc) { const float a = PWl[c * 129 + cc];
#pragma unroll
                for (int e = 0; e < 4; ++e) acc4[e] += a * WBl[cc * 17 + 4 * q + e]; }
#pragma unroll
            for (int e = 0; e < 4; ++e) weff[(size_t)(d0 + 4 * q + e) * POOLW + g * 128 + c] = (bf16)f2bf(acc4[e]);
            __syncthreads();
        }
    }
    cvt_f32_bf16_stream(args.in[I_PSK], (bf16*)(ws + WS_SUBK), (size_t)16 * 128 * 128 / 8, gtid, gthreads);
    cvt_rows_8bit<true>(args.in[I_PU], ws + WS_UB, (float*)(ws + WS_SCLU), gw, NGW, F.lane);
    cvt_rows_8bit<false>(args.in[I_PV], ws + WS_VB, (float*)(ws + WS_SCLV), gw, NGW, F.lane);
}

template <bool Q8> __device__ __forceinline__ void modnorm_rows(Frame& F, const float* x, const float* g, const float* ada, int shift_idx, bf16* out) {
    const int gw = F.bid * NWAVES + F.wave, NGW = F.G * NWAVES;
    for (int m = gw; m < M; m += NGW) {
        const int b = m >> 12;
        const GAS f32x4* xr = (const GAS f32x4*)(x + (size_t)m * D) + F.lane;
        const GAS f32x4* gr = (const GAS f32x4*)g + F.lane;
        const GAS f32x4* sh = (const GAS f32x4*)(ada + (size_t)b * 6 * D + shift_idx * D) + F.lane;
        const GAS f32x4* sc = (const GAS f32x4*)(ada + (size_t)b * 6 * D + (shift_idx + 1) * D) + F.lane;
        f32x4 v[4]; float s = 0.f;
#pragma unroll
        for (int j = 0; j < 4; ++j) { v[j] = xr[64 * j]; s += (v[j].x * v[j].x + v[j].y * v[j].y) + (v[j].z * v[j].z + v[j].w * v[j].w); }
        const float rstd = rsqrtf(wave_sum(s) * (1.f / D) + EPS);
        GAS v2u* o8 = (GAS v2u*)(out + (size_t)m * D) + F.lane;
        float mx = 0.f;
#pragma unroll
        for (int j = 0; j < 4; ++j) { const f32x4 gg = gr[64 * j], ss = sh[64 * j], cc = sc[64 * j];
            const f32x4 y = (v[j] * rstd) * gg * (cc + 1.0f) + ss; v[j] = y;
            mx = fmaxf(mx, fmaxf(fmaxf(fabsf(y.x), fabsf(y.y)), fmaxf(fabsf(y.z), fabsf(y.w))));
            v2u o; o.x = pk2(y.x, y.y); o.y = pk2(y.z, y.w); o8[64 * j] = o; }
        if (Q8) {
            mx = wave_max(mx);
            const float qs = mx > 0.f ? 127.0f / mx : 0.f;
            GAS unsigned* h8 = (GAS unsigned*)(F.ws + WS_H8 + (size_t)m * D) + F.lane;
#pragma unroll
            for (int j = 0; j < 4; ++j) { const int q0 = (int)rintf(v[j].x * qs), q1 = (int)rintf(v[j].y * qs), q2 = (int)rintf(v[j].z * qs), q3 = (int)rintf(v[j].w * qs);
                h8[64 * j] = ((unsigned)q0 & 0xffu) | (((unsigned)q1 & 0xffu) << 8) | (((unsigned)q2 & 0xffu) << 16) | (((unsigned)q3 & 0xffu) << 24); }
            if (F.lane == 0) ((float*)(F.ws + WS_HS))[m] = mx * (1.0f / 127.0f);
        }
    }
}

struct EpiIn {
    static constexpr bool PERM = true, AFTER_DRAIN = false;
    unsigned char* ws; const float* qg; const float* kg;
    __device__ __forceinline__ void operator()(const pg8::f32x4 (&acc)[2][2][4][2], const pg8::Unit& u, int wr, int wc, int fr, int fq) const {
        const int pn = u.pn;
#pragma unroll
        for (int ai = 0; ai < 2; ++ai)
#pragma unroll
            for (int m = 0; m < 4; ++m) {
                const int row = u.pm * 256 + ai * 128 + wr * 64 + m * 16 + fr;
                float v[2][8];
#pragma unroll
                for (int bj = 0; bj < 2; ++bj)
#pragma unroll
                    for (int n = 0; n < 2; ++n)
#pragma unroll
                        for (int i = 0; i < 4; ++i) v[bj][4 * n + i] = acc[ai][bj][m][n][i];
                bf16* dst = nullptr; bool norm = false; const float* gain = nullptr; float mul = 1.f; bool sig = false;
                if (pn < 2) { dst = (bf16*)(ws + WS_ZP) + (size_t)row * 512 + 256 * pn + 64 * wc; }
                else if (pn < 4) { dst = (bf16*)(ws + WS_Q) + (size_t)row * 512 + 256 * (pn - 2) + 64 * wc; norm = true; gain = qg; mul = 0.125f * 1.4426950408889634f; }
                else if (pn < 7) { const int kind = pn - 4, isv = wc >> 1, g = wc & 1, b = row >> 12, t = row & 4095;
                    const size_t base = ((size_t)(b * 2 + g) * SEQ + t) * 64;
                    const size_t off = kind == 0 ? (isv ? WS_VCR : WS_KCR) : kind == 1 ? (isv ? WS_VS : WS_KS) : (isv ? WS_VW : WS_KW);
                    dst = (bf16*)(ws + off) + base; if (!isv && kind > 0) { norm = true; gain = kg + kind * 64; } }
                else if (pn < 15) { dst = (bf16*)(ws + WS_GM) + (size_t)row * 2048 + 256 * (pn - 7) + 64 * wc; sig = true; }
                else {
                    if (wc == 0 && fq < 3) { float* gp = (float*)(ws + WS_GATE) + (size_t)row * 24 + 8 * fq;
                        *(GAS f32x4*)gp = (f32x4){sigmoidf_(v[0][0]), sigmoidf_(v[0][1]), sigmoidf_(v[0][2]), sigmoidf_(v[0][3])};
                        *(GAS f32x4*)(gp + 4) = (f32x4){sigmoidf_(v[0][4]), sigmoidf_(v[0][5]), sigmoidf_(v[0][6]), sigmoidf_(v[0][7])}; }
                    continue; }
                if (norm) { float ss = 0.f;
#pragma unroll
                    for (int bj = 0; bj < 2; ++bj)
#pragma unroll
                        for (int e = 0; e < 8; ++e) ss += v[bj][e] * v[bj][e];
                    ss = sum_xor32(sum_xor16(ss));
                    const float rs = rsqrtf(ss * (1.f / 64.f) + EPS) * mul;
#pragma unroll
                    for (int bj = 0; bj < 2; ++bj)
#pragma unroll
                        for (int e = 0; e < 8; ++e) v[bj][e] = v[bj][e] * rs * gain[32 * bj + 8 * fq + e]; }
                if (sig) {
#pragma unroll
                    for (int bj = 0; bj < 2; ++bj)
#pragma unroll
                        for (int e = 0; e < 8; ++e) v[bj][e] = sigmoidf_(v[bj][e]); }
#pragma unroll
                for (int bj = 0; bj < 2; ++bj) { v4u o; o.x = pkh(v[bj][0], v[bj][1]); o.y = pkh(v[bj][2], v[bj][3]); o.z = pkh(v[bj][4], v[bj][5]); o.w = pkh(v[bj][6], v[bj][7]);
                    *(GAS v4u*)(dst + 32 * bj + 8 * fq) = o; }
            }
    }
};
template <bool ADD> struct EpiMix {
    static constexpr bool PERM = true, AFTER_DRAIN = false;
    bf16* MIX; const bf16* GM; int gmoff;
    __device__ __forceinline__ void operator()(const pg8::f32x4 (&acc)[2][2][4][2], const pg8::Unit& u, int wr, int wc, int fr, int fq) const {
#pragma unroll
        for (int ai = 0; ai < 2; ++ai)
#pragma unroll
            for (int m = 0; m < 4; ++m) {
                const int row = u.pm * 256 + ai * 128 + wr * 64 + m * 16 + fr;
#pragma unroll
                for (int bj = 0; bj < 2; ++bj) {
                    const int col = u.pn * 256 + bj * 128 + wc * 32 + 8 * fq;
                    const v4u gmv = *(const GAS v4u*)(GM + (size_t)row * 2048 + gmoff + col);
                    float r[8];
                    r[0] = acc[ai][bj][m][0][0] * bflo(gmv.x); r[1] = acc[ai][bj][m][0][1] * bfhi(gmv.x); r[2] = acc[ai][bj][m][0][2] * bflo(gmv.y); r[3] = acc[ai][bj][m][0][3] * bfhi(gmv.y);
                    r[4] = acc[ai][bj][m][1][0] * bflo(gmv.z); r[5] = acc[ai][bj][m][1][1] * bfhi(gmv.z); r[6] = acc[ai][bj][m][1][2] * bflo(gmv.w); r[7] = acc[ai][bj][m][1][3] * bfhi(gmv.w);
                    GAS v4u* dp = (GAS v4u*)(MIX + (size_t)row * 1024 + col);
                    if (ADD) { const v4u old = *dp; r[0] += bflo(old.x); r[1] += bfhi(old.x); r[2] += bflo(old.y); r[3] += bfhi(old.y); r[4] += bflo(old.z); r[5] += bfhi(old.z); r[6] += bflo(old.w); r[7] += bfhi(old.w); }
                    v4u o; o.x = pkh(r[0], r[1]); o.y = pkh(r[2], r[3]); o.z = pkh(r[4], r[5]); o.w = pkh(r[6], r[7]); *dp = o; }
            }
    }
};
struct EpiRes {
    static constexpr bool PERM = false, AFTER_DRAIN = false;
    const float* x; float* out; const float* ada; int gate_idx;
    __device__ __forceinline__ void operator()(const pg8::f32x4 (&acc)[2][2][4][2], const pg8::Unit& u, int wr, int wc, int fr, int fq) const {
#pragma unroll
        for (int ai = 0; ai < 2; ++ai)
#pragma unroll
            for (int m = 0; m < 4; ++m) {
                const int row = u.pm * 256 + ai * 128 + wr * 64 + m * 16 + fr, b = row >> 12;
#pragma unroll
                for (int bj = 0; bj < 2; ++bj)
#pragma unroll
                    for (int n = 0; n < 2; ++n) {
                        const int col = u.pn * 256 + bj * 128 + wc * 32 + 16 * n + 4 * fq;
                        const f32x4 gt = *(const GAS f32x4*)(ada + (size_t)b * 6 * D + gate_idx * D + col);
                        const f32x4 xv = *(const GAS f32x4*)(x + (size_t)row * D + col);
                        *(GAS f32x4*)(out + (size_t)row * D + col) = xv + gt * acc[ai][bj][m][n]; }
            }
    }
};

template <int W> __device__ __forceinline__ void pool_item(const bf16* zp, bf16* pl, int row, int col) {
    const int t = row & 4095;
    float s[8], self[8];
#pragma unroll
    for (int e = 0; e < 8; ++e) { s[e] = 0.f; self[e] = 0.f; }
    v4u z[W];
#pragma unroll
    for (int j = 0; j < W; ++j) z[j] = (j <= t) ? *(const GAS v4u*)(zp + (size_t)(row - j) * 512 + col) : (v4u){0u, 0u, 0u, 0u};
#pragma unroll
    for (int j = 0; j < W; ++j) { const float f[8] = {bflo(z[j].x), bfhi(z[j].x), bflo(z[j].y), bfhi(z[j].y), bflo(z[j].z), bfhi(z[j].z), bflo(z[j].w), bfhi(z[j].w)};
#pragma unroll
        for (int e = 0; e < 8; ++e) { s[e] += f[e]; if (j == 0) self[e] = f[e]; } }
    const float inv = 1.0f / (float)((t + 1 < W) ? (t + 1) : W);
    v4u o; o.x = pk2(s[0] * inv - self[0], s[1] * inv - self[1]); o.y = pk2(s[2] * inv - self[2], s[3] * inv - self[3]);
    o.z = pk2(s[4] * inv - self[4], s[5] * inv - self[5]); o.w = pk2(s[6] * inv - self[6], s[7] * inv - self[7]);
    *(GAS v4u*)(pl + (size_t)row * 512 + col) = o;
}
__device__ __forceinline__ void pool_phase(Frame& F) {
    const bf16* zp = (const bf16*)(F.ws + WS_ZP); bf16* pl = (bf16*)(F.ws + WS_PL);
    const int gw = F.bid * NWAVES + F.wave, NGW = F.G * NWAVES;
    for (int item = gw; item < 4 * (M / 4); item += NGW) {
        const int gi = item & 3, r4 = item >> 2, row = 4 * r4 + (F.lane >> 4), col = 128 * gi + 8 * (F.lane & 15);
        if (gi == 0) pool_item<2>(zp, pl, row, col); else if (gi == 1) pool_item<4>(zp, pl, row, col); else if (gi == 2) pool_item<8>(zp, pl, row, col); else pool_item<16>(zp, pl, row, col);
    }
}

typedef int v4i __attribute__((ext_vector_type(4)));
struct EpiStoreBf16 {
    static constexpr bool PERM = true, AFTER_DRAIN = false;
    bf16* O; int ldc;
    __device__ __forceinline__ void operator()(const pg8::f32x4 (&acc)[2][2][4][2], const pg8::Unit& u, int wr, int wc, int fr, int fq) const {
#pragma unroll
        for (int ai = 0; ai < 2; ++ai)
#pragma unroll
            for (int m = 0; m < 4; ++m) {
                const int row = u.pm * 256 + ai * 128 + wr * 64 + m * 16 + fr;
#pragma unroll
                for (int bj = 0; bj < 2; ++bj) {
                    const int col = u.pn * 256 + bj * 128 + wc * 32 + 8 * fq;
                    v4u o; o.x = pkh(acc[ai][bj][m][0][0], acc[ai][bj][m][0][1]); o.y = pkh(acc[ai][bj][m][0][2], acc[ai][bj][m][0][3]);
                    o.z = pkh(acc[ai][bj][m][1][0], acc[ai][bj][m][1][1]); o.w = pkh(acc[ai][bj][m][1][2], acc[ai][bj][m][1][3]);
                    *(GAS v4u*)(O + (size_t)row * ldc + col) = o; }
            }
    }
};

__device__ __forceinline__ unsigned fkey(float f) { const unsigned u = __builtin_bit_cast(unsigned, f); return (u >> 31) ? ~u : (u | 0x80000000u); }
__device__ __forceinline__ float funkey(unsigned k) { const unsigned u = (k >> 31) ? (k & 0x7fffffffu) : ~k; return __builtin_bit_cast(float, u); }
__device__ __forceinline__ unsigned umax_(unsigned a, unsigned b) { return a > b ? a : b; }
__device__ __forceinline__ unsigned umin_(unsigned a, unsigned b) { return a > b ? b : a; }
#define TOP16_INSERT(L, xin) do { unsigned _x = (xin); _Pragma("unroll") for (int _i = 0; _i < 16; ++_i) { const unsigned _h = umax_(L[_i], _x); _x = umin_(L[_i], _x); L[_i] = _h; } } while (0)
template <int MASK> __device__ __forceinline__ void top16_merge(unsigned (&L)[16]) {
    unsigned o[16];
#pragma unroll
    for (int i = 0; i < 16; ++i) o[i] = (unsigned)dppi<MASK == 1 ? DPP_XOR1 : DPP_XOR2>((int)L[i]);
#pragma unroll
    for (int i = 0; i < 16; ++i) L[i] = umax_(L[i], o[15 - i]);
#pragma unroll
    for (int d = 8; d >= 1; d >>= 1)
#pragma unroll
        for (int i = 0; i < 16; ++i) if ((i & d) == 0) { const unsigned hi = umax_(L[i], L[i + d]), lo = umin_(L[i], L[i + d]); L[i] = hi; L[i + d] = lo; }
}
#define CE_DESC(a_, b_) do { const unsigned _h = umax_(a_, b_), _l = umin_(a_, b_); a_ = _h; b_ = _l; } while (0)
template <int OFF> __device__ __forceinline__ void bitonic_sort16_desc(unsigned (&v)[32]) {
#pragma unroll
    for (int k = 2; k <= 16; k <<= 1)
#pragma unroll
        for (int j = k >> 1; j > 0; j >>= 1)
#pragma unroll
            for (int i = 0; i < 16; ++i) { const int l = i ^ j; if (l > i) { if ((i & k) == 0) CE_DESC(v[OFF + i], v[OFF + l]); else CE_DESC(v[OFF + l], v[OFF + i]); } }
}
__device__ __forceinline__ void bitonic_merge16_desc(unsigned (&L)[16]) {
#pragma unroll
    for (int d = 8; d >= 1; d >>= 1)
#pragma unroll
        for (int i = 0; i < 16; ++i) if ((i & d) == 0) CE_DESC(L[i], L[i + d]);
}
constexpr int SST = 132;
constexpr int P9_LIST_OFF = 2 * 64 * SST * 4;
__device__ __forceinline__ void peer_select_phase(Frame& F) {
    const bf16* QV = (const bf16*)(F.ws + WS_QV); const bf16* SK = (const bf16*)(F.ws + WS_SUBK);
    int* EID = (int*)(F.ws + WS_EID); float* GW = (float*)(F.ws + WS_GW);
    LAS float* S = (LAS float*)(F.lds);
    LAS unsigned* LIST = (LAS unsigned*)(F.lds + P9_LIST_OFF);
    const int lane = F.lane, w = F.wave, l15 = lane & 15, lq = lane >> 4;
    const int p = w >> 2, kb = w & 3;
    constexpr int NU = (M / 64) * PH;
    bf16x8 a[4][4], bq[2][4];
#define P9_LOAD(u_) do { const int _tt = (u_) >> 3, _h = (u_) & 7; \
        const bf16* qa = QV + (size_t)(_tt * 64 + l15) * PQW + _h * 256 + p * 128 + 8 * lq; \
        const bf16* kbp = SK + (size_t)((_h * 2 + p) * 128 + 32 * kb + l15) * 128 + 8 * lq; \
        _Pragma("unroll") for (int ks = 0; ks < 4; ++ks) { \
            _Pragma("unroll") for (int rb = 0; rb < 4; ++rb) a[rb][ks] = *(const GAS bf16x8*)(qa + (size_t)(16 * rb) * PQW + 32 * ks); \
            _Pragma("unroll") for (int cb = 0; cb < 2; ++cb) bq[cb][ks] = *(const GAS bf16x8*)(kbp + (size_t)(16 * cb) * 128 + 32 * ks); } } while (0)
    if (F.bid < NU) P9_LOAD(F.bid);
    for (int u = F.bid; u < NU; u += F.G) {
        const int tt = u >> 3, h = u & 7, tok0 = tt * 64;
        {
            pg8::f32x4 acc[4][2];
#pragma unroll
            for (int rb = 0; rb < 4; ++rb)
#pragma unroll
                for (int cb = 0; cb < 2; ++cb) acc[rb][cb] = (pg8::f32x4){0.f, 0.f, 0.f, 0.f};
#pragma unroll
            for (int ks = 0; ks < 4; ++ks)
#pragma unroll
                for (int rb = 0; rb < 4; ++rb)
#pragma unroll
                    for (int cb = 0; cb < 2; ++cb) acc[rb][cb] = __builtin_amdgcn_mfma_f32_16x16x32_bf16(a[rb][ks], bq[cb][ks], acc[rb][cb], 0, 0, 0);
#pragma unroll
            for (int rb = 0; rb < 4; ++rb)
#pragma unroll
                for (int cb = 0; cb < 2; ++cb)
#pragma unroll
                    for (int r = 0; r < 4; ++r) S[(p * 64 + 16 * rb + 4 * lq + r) * SST + 32 * kb + 16 * cb + l15] = acc[rb][cb][r];
        }
        __syncthreads();
        if (u + F.G < NU) P9_LOAD(u + F.G);
        {
            const int row = F.tid >> 2, sub = F.tid & 3;
            const LAS float* sr = S + row * SST + sub;
            unsigned kv[32];
#pragma unroll
            for (int i = 0; i < 32; ++i) kv[i] = (fkey(sr[4 * i]) & ~127u) | (unsigned)(4 * i + sub);
            bitonic_sort16_desc<0>(kv); bitonic_sort16_desc<16>(kv);
            unsigned L[16];
#pragma unroll
            for (int i = 0; i < 16; ++i) L[i] = umax_(kv[i], kv[31 - i]);
            bitonic_merge16_desc(L);
            top16_merge<1>(L); top16_merge<2>(L);
            if (sub == 0) {
#pragma unroll
                for (int i = 0; i < 4; ++i) *(LAS v4u*)(LIST + row * 16 + 4 * i) = (v4u){L[4 * i], L[4 * i + 1], L[4 * i + 2], L[4 * i + 3]}; }
        }
        __syncthreads();
        if (F.tid < 256) {
            const int tok = F.tid >> 2, sub = F.tid & 3;
            float va[16], vb[16];
#pragma unroll
            for (int i = 0; i < 4; ++i) { const v4u x = *(const LAS v4u*)(LIST + tok * 16 + 4 * i), y = *(const LAS v4u*)(LIST + (64 + tok) * 16 + 4 * i);
                va[4 * i] = funkey(x.x & ~127u); va[4 * i + 1] = funkey(x.y & ~127u); va[4 * i + 2] = funkey(x.z & ~127u); va[4 * i + 3] = funkey(x.w & ~127u);
                vb[4 * i] = funkey(y.x & ~127u); vb[4 * i + 1] = funkey(y.y & ~127u); vb[4 * i + 2] = funkey(y.z & ~127u); vb[4 * i + 3] = funkey(y.w & ~127u); }
            unsigned cand[32];
#pragma unroll
            for (int i = 0; i < 32; ++i) cand[i] = 0u;
            {
                constexpr int NC = 50;
                constexpr unsigned char CI[52] = {0,0,0,0,0,0,0,0,0,0,0,0,0,0,0,0, 1,1,1,1,1,1,1,1, 2,2,2,2,2, 3,3,3,3, 4,4,4, 5,5, 6,6, 7,7, 8,9,10,11,12,13,14,15, 0,0};
                constexpr unsigned char CJ[52] = {0,1,2,3,4,5,6,7,8,9,10,11,12,13,14,15, 0,1,2,3,4,5,6,7, 0,1,2,3,4, 0,1,2,3, 0,1,2, 0,1, 0,1, 0,1, 0,0,0,0,0,0,0,0, 0,0};
#pragma unroll
                for (int g4 = 0; g4 < 13; ++g4) {
                    float sa = 0.f, sb = 0.f; unsigned id = 0u; bool ok = false;
#pragma unroll
                    for (int q = 0; q < 4; ++q) { const int n = 4 * g4 + q; if (n < NC) { const bool me = (sub == q); sa = me ? va[CI[n]] : sa; sb = me ? vb[CJ[n]] : sb; id = me ? (unsigned)(CI[n] * 16 + CJ[n]) : id; ok = ok || me; } }
                    cand[g4] = ok ? ((fkey(sa + sb) & ~255u) | id) : 0u;
                }
            }
            bitonic_sort16_desc<0>(cand);
            unsigned L[16];
#pragma unroll
            for (int i = 0; i < 16; ++i) L[i] = cand[i];
            top16_merge<1>(L); top16_merge<2>(L);
            const float mx = funkey(L[0] & ~255u);
            float e[16], sum = 0.f;
#pragma unroll
            for (int k = 0; k < 16; ++k) { e[k] = __expf(funkey(L[k] & ~255u) - mx); sum += e[k]; }
            const float inv = 1.0f / sum;
            const size_t ob = (size_t)(tok0 + tok) * 128;
#pragma unroll
            for (int k4 = 0; k4 < 4; ++k4) if (sub == k4) {
#pragma unroll
                for (int q = 0; q < 4; ++q) { const unsigned cid = L[4 * k4 + q] & 255u;
                    const unsigned ia = LIST[tok * 16 + (cid >> 4)] & 127u, ib = LIST[(64 + tok) * 16 + (cid & 15u)] & 127u;
                    const int slot = h * 16 + 4 * k4 + q;
                    EID[ob + slot] = (int)(ia * 128u + ib); GW[ob + slot] = e[4 * k4 + q] * inv; }
            }
        }
        __syncthreads();
    }
#undef P9_LOAD
}

__device__ __forceinline__ void unpack8(const v4u w, float (&f)[8]) { f[0] = bflo(w.x); f[1] = bfhi(w.x); f[2] = bflo(w.y); f[3] = bfhi(w.y); f[4] = bflo(w.z); f[5] = bfhi(w.z); f[6] = bflo(w.w); f[7] = bfhi(w.w); }
typedef float f32x2 __attribute__((ext_vector_type(2)));
__device__ __forceinline__ void unpack16_fp8(const v4u w, float (&f)[16]) {
    const unsigned ww[4] = {w.x, w.y, w.z, w.w};
#pragma unroll
    for (int d = 0; d < 4; ++d) { const f32x2 a = __builtin_amdgcn_cvt_pk_f32_fp8((int)ww[d], false), b = __builtin_amdgcn_cvt_pk_f32_fp8((int)ww[d], true);
        f[4 * d] = a.x; f[4 * d + 1] = a.y; f[4 * d + 2] = b.x; f[4 * d + 3] = b.y; }
}
template <int PV_> __device__ __forceinline__ void peer_dot_phase(Frame& F) {
    const unsigned char* H8 = F.ws + WS_H8; const int* EID = (const int*)(F.ws + WS_EID); float* PART = (float*)(F.ws + WS_PART);
    const int lane = F.lane, g = lane >> 3, j = lane & 7, x = F.bid & 7;
    const int nbx = (F.G - x + 7) >> 3, NW = nbx * NWAVES, gwv = (F.bid >> 3) * NWAVES + F.wave;
    const unsigned char* US = F.ws + WS_UB + (size_t)x * NEXP * 128; const unsigned j16 = 16u * (unsigned)j;
    int token = gwv;
    if (token >= M) return;
    v4i e4[4]; v4i hb;
#define PD_LOAD_E(tok_) do { _Pragma("unroll") for (int q = 0; q < 4; ++q) e4[q] = *(const GAS v4i*)(EID + (size_t)(tok_) * 128 + 16 * g + 4 * q); } while (0)
#define PD_ISSUE4(buf_, e_, b0_) do { buf_[b0_] = *(const GAS v4i*)(US + ((unsigned)e_.x * 128u + j16)); buf_[b0_ + 1] = *(const GAS v4i*)(US + ((unsigned)e_.y * 128u + j16)); \
        buf_[b0_ + 2] = *(const GAS v4i*)(US + ((unsigned)e_.z * 128u + j16)); buf_[b0_ + 3] = *(const GAS v4i*)(US + ((unsigned)e_.w * 128u + j16)); } while (0)
#define PD_DOT1(w_, dst_) do { int t = __builtin_amdgcn_sdot4(w_.x, hc.x, 0, false); t = __builtin_amdgcn_sdot4(w_.y, hc.y, t, false); t = __builtin_amdgcn_sdot4(w_.z, hc.z, t, false); t = __builtin_amdgcn_sdot4(w_.w, hc.w, t, false); \
        t += dppi<DPP_XOR1>(t); t += dppi<DPP_XOR2>(t); t += dppi<DPP_HMIR>(t); dst_ = (float)t; } while (0)
    PD_LOAD_E(token); hb = *(const GAS v4i*)(H8 + (size_t)token * D + 128 * x + j16);
    v4i bA[8], bB[8];
    PD_ISSUE4(bA, e4[0], 0); PD_ISSUE4(bA, e4[1], 4);
    for (; token < M; token += NW) {
        const bool more = token + NW < M;
        PD_ISSUE4(bB, e4[2], 0); PD_ISSUE4(bB, e4[3], 4);
        const v4i hc = hb;
        if (more) { PD_LOAD_E(token + NW); hb = *(const GAS v4i*)(H8 + (size_t)(token + NW) * D + 128 * x + j16); }
        float s[16];
#pragma unroll
        for (int i = 0; i < 8; ++i) PD_DOT1(bA[i], s[i]);
        if (more) { PD_ISSUE4(bA, e4[0], 0); PD_ISSUE4(bA, e4[1], 4); }
#pragma unroll
        for (int i = 0; i < 8; ++i) PD_DOT1(bB[i], s[8 + i]);
        if (j == 0) { float* pp = PART + ((size_t)x * M + token) * 128 + g * 16;
#pragma unroll
            for (int i4 = 0; i4 < 4; ++i4) *(GAS f32x4*)(pp + 4 * i4) = (f32x4){s[4 * i4], s[4 * i4 + 1], s[4 * i4 + 2], s[4 * i4 + 3]}; }
    }
#undef PD_LOAD_E
#undef PD_ISSUE4
#undef PD_DOT1
}
template <int NTOK> __device__ __forceinline__ void peer_loadrate_probe(Frame& F) {
    const int* EID = (const int*)(F.ws + WS_EID);
    const int lane = F.lane, g = lane >> 3, j = lane & 7, x = F.bid & 7;
    const int nbx = (F.G - x + 7) >> 3, NW = nbx * NWAVES, gwv = (F.bid >> 3) * NWAVES + F.wave;
    const unsigned char* US = F.ws + WS_UB + (size_t)x * NEXP * 128; const unsigned j16 = 16u * (unsigned)j;
    unsigned acc = 0u;
    for (int token = gwv; token + (NTOK - 1) * NW < M; token += NTOK * NW) {
        v4i e4[NTOK][4];
#pragma unroll
        for (int t = 0; t < NTOK; ++t)
#pragma unroll
            for (int q = 0; q < 4; ++q) e4[t][q] = *(const GAS v4i*)(EID + (size_t)(token + t * NW) * 128 + 16 * g + 4 * q);
        v4i b[NTOK][16];
#pragma unroll
        for (int t = 0; t < NTOK; ++t)
#pragma unroll
            for (int q = 0; q < 4; ++q) { b[t][4 * q] = *(const GAS v4i*)(US + ((unsigned)e4[t][q].x * 128u + j16)); b[t][4 * q + 1] = *(const GAS v4i*)(US + ((unsigned)e4[t][q].y * 128u + j16));
                b[t][4 * q + 2] = *(const GAS v4i*)(US + ((unsigned)e4[t][q].z * 128u + j16)); b[t][4 * q + 3] = *(const GAS v4i*)(US + ((unsigned)e4[t][q].w * 128u + j16)); }
#pragma unroll
        for (int t = 0; t < NTOK; ++t)
#pragma unroll
            for (int i = 0; i < 16; ++i) acc ^= (unsigned)(b[t][i].x ^ b[t][i].y ^ b[t][i].z ^ b[t][i].w);
    }
    asm volatile("" :: "v"(acc));
}
__device__ __forceinline__ void peer_coef_phase(Frame& F) {
    const float* PART = (const float*)(F.ws + WS_PART); const int* EID = (const int*)(F.ws + WS_EID); const float* GW = (const float*)(F.ws + WS_GW);
    const float* SCU = (const float*)(F.ws + WS_SCLU); const float* SCV = (const float*)(F.ws + WS_SCLV); const float* HS = (const float*)(F.ws + WS_HS);
    unsigned* CF8 = (unsigned*)(F.ws + WS_CF); float* CFS = (float*)(F.ws + WS_CFS);
    const size_t gtid = (size_t)F.bid * NTHREADS + F.tid, gthreads = (size_t)F.G * NTHREADS, n4 = (size_t)M * 128 / 4;
    for (size_t i4 = gtid; i4 < n4; i4 += gthreads) {
        f32x4 d = *(const GAS f32x4*)(PART + 4 * i4);
#pragma unroll
        for (int xx = 1; xx < 8; ++xx) d = d + *(const GAS f32x4*)(PART + (size_t)xx * M * 128 + 4 * i4);
        const v4i e = *(const GAS v4i*)(EID + 4 * i4); const f32x4 gw = *(const GAS f32x4*)(GW + 4 * i4);
        const float hs = HS[i4 >> 5];
        f32x4 r; r.x = gw.x * SCV[e.x] * gelu_tanh_safe(d.x * (SCU[e.x] * hs)); r.y = gw.y * SCV[e.y] * gelu_tanh_safe(d.y * (SCU[e.y] * hs));
        r.z = gw.z * SCV[e.z] * gelu_tanh_safe(d.z * (SCU[e.z] * hs)); r.w = gw.w * SCV[e.w] * gelu_tanh_safe(d.w * (SCU[e.w] * hs));
        float m = fmaxf(fmaxf(fabsf(r.x), fabsf(r.y)), fmaxf(fabsf(r.z), fabsf(r.w)));
        m = fmaxf(m, dppf<DPP_XOR1>(m)); m = fmaxf(m, dppf<DPP_XOR2>(m)); m = fmaxf(m, dppf<DPP_HMIR>(m)); m = fmaxf(m, dppf<DPP_ROR8>(m)); m = max_xor16(m);
        const unsigned E = (__builtin_bit_cast(unsigned, m) >> 23) & 0xffu; float sc = 1.f, isc = 1.f;
        if (E >= 8u && E <= 250u) { sc = __builtin_bit_cast(float, (261u - E) << 23); isc = __builtin_bit_cast(float, (E - 7u) << 23); }
        int t = __builtin_amdgcn_cvt_pk_fp8_f32(r.x * sc, r.y * sc, 0, false); t = __builtin_amdgcn_cvt_pk_fp8_f32(r.z * sc, r.w * sc, t, true);
        CF8[i4] = (unsigned)t;
        if ((F.lane & 31) == 0) CFS[i4 >> 5] = isc; }
}
template <bool DRY, bool CHECK = false> __device__ __forceinline__ void peer_out_phase(Frame& F, const float* ada, float* out) {
    const int* EID = (const int*)(F.ws + WS_EID); const unsigned char* CF8 = (const unsigned char*)(F.ws + WS_CF); const float* CFS = (const float*)(F.ws + WS_CFS);
    const int lane = F.lane, g = lane >> 3, j = lane & 7, x = F.bid & 7;
    const int nbx = (F.G - x + 7) >> 3, NW = nbx * NWAVES, gwv = (F.bid >> 3) * NWAVES + F.wave;
    const unsigned char* VS = F.ws + WS_VB + (size_t)x * NEXP * 128; const unsigned j16 = 16u * (unsigned)j;
    if (gwv >= M) return;
    const int ntok = (M - 1 - gwv) / NW + 1;
#define PO_ISSUE4(buf_, e_, b0_) do { buf_[b0_] = *(const GAS v4u*)(VS + ((unsigned)e_.x * 128u + j16)); buf_[b0_ + 1] = *(const GAS v4u*)(VS + ((unsigned)e_.y * 128u + j16)); \
        buf_[b0_ + 2] = *(const GAS v4u*)(VS + ((unsigned)e_.z * 128u + j16)); buf_[b0_ + 3] = *(const GAS v4u*)(VS + ((unsigned)e_.w * 128u + j16)); } while (0)
#define PO_ROW(w_, c_) do { float f[16]; unpack16_fp8(w_, f); _Pragma("unroll") for (int k = 0; k < 16; ++k) o[k] += (c_) * f[k]; } while (0)
#define PO_ACC4(buf_, c4_, b0_) do { PO_ROW(buf_[b0_], c4_.x); PO_ROW(buf_[b0_ + 1], c4_.y); PO_ROW(buf_[b0_ + 2], c4_.z); PO_ROW(buf_[b0_ + 3], c4_.w); } while (0)
    v4i e4[4]; f32x4 c4[4]; v4u bA[8], bB[8];
#define PO_LOADC(tok_) do { const float cs_ = CFS[tok_]; _Pragma("unroll") for (int q = 0; q < 4; ++q) { const unsigned w_ = *(const GAS unsigned*)(CF8 + (size_t)(tok_) * 128 + g * 16 + 4 * q); \
        const f32x2 lo_ = __builtin_amdgcn_cvt_pk_f32_fp8((int)w_, false), hi_ = __builtin_amdgcn_cvt_pk_f32_fp8((int)w_, true); c4[q] = (f32x4){lo_.x * cs_, lo_.y * cs_, hi_.x * cs_, hi_.y * cs_}; } } while (0)
#pragma unroll
    for (int q = 0; q < 4; ++q) e4[q] = *(const GAS v4i*)(EID + (size_t)gwv * 128 + g * 16 + 4 * q);
    PO_LOADC(gwv);
    PO_ISSUE4(bA, e4[0], 0); PO_ISSUE4(bA, e4[1], 4);
    for (int it = 0; it < ntok; ++it) {
        const int token = gwv + it * NW, tn = gwv + (it + 1 < ntok ? it + 1 : it) * NW;
        PO_ISSUE4(bB, e4[2], 0); PO_ISSUE4(bB, e4[3], 4);
#pragma unroll
        for (int q = 0; q < 4; ++q) e4[q] = *(const GAS v4i*)(EID + (size_t)tn * 128 + g * 16 + 4 * q);
        float o[16];
#pragma unroll
        for (int k = 0; k < 16; ++k) o[k] = 0.f;
        PO_ACC4(bA, c4[0], 0); PO_ACC4(bA, c4[1], 4);
        PO_ISSUE4(bA, e4[0], 0); PO_ISSUE4(bA, e4[1], 4);
        PO_ACC4(bB, c4[2], 0); PO_ACC4(bB, c4[3], 4);
        PO_LOADC(tn);
#pragma unroll
        for (int k = 0; k < 16; ++k) { float t = o[k]; t += dppf<DPP_ROR8>(t); o[k] = sum_xor32(sum_xor16(t)); }
        if (g == 0) { const int b = token >> 12;
            const float* gt = ada + (size_t)b * 6 * D + 5 * D + 128 * x + 16 * j;
            float* xo = out + (size_t)token * D + 128 * x + 16 * j;
#pragma unroll
            for (int q = 0; q < 4; ++q) { const f32x4 xv = *(const GAS f32x4*)(xo + 4 * q), gv = *(const GAS f32x4*)(gt + 4 * q);
                f32x4 res = xv + gv * (f32x4){o[4 * q], o[4 * q + 1], o[4 * q + 2], o[4 * q + 3]};
                if (CHECK) { const f32x4 mf = *(const GAS f32x4*)((const float*)(F.ws + WS_PART) + (size_t)token * D + 128 * x + 16 * j + 4 * q);
                    const float rr[4] = {o[4 * q], o[4 * q + 1], o[4 * q + 2], o[4 * q + 3]}, mm[4] = {mf.x, mf.y, mf.z, mf.w}; bool bad = false;
#pragma unroll
                    for (int z = 0; z < 4; ++z) bad = bad || !(fabsf(rr[z] - mm[z]) <= 0.01f * fabsf(rr[z]) + 1.0e-3f);
                    if (bad) res.x = 1.0e9f; }
                if (DRY) { asm volatile("" :: "v"(res.x), "v"(res.y), "v"(res.z), "v"(res.w)); } else *(GAS f32x4*)(xo + 4 * q) = res; } }
    }
#undef PO_LOADC
#undef PO_ISSUE4
#undef PO_ROW
#undef PO_ACC4
}

constexpr int PO_TILE = 64 * 144;
template <int MODE> __device__ __forceinline__ void peer_out_mfma_phase(Frame& F, const float* ada, float* out) {
    const int* EID = (const int*)(F.ws + WS_EID); const unsigned char* CF8 = (const unsigned char*)(F.ws + WS_CF); const float* CFS = (const float*)(F.ws + WS_CFS);
    const int lane = F.lane, g = lane >> 3, j = lane & 7, l15 = lane & 15, lq = lane >> 4, x = F.bid & 7;
    const int nbx = (F.G - x + 7) >> 3, NW = nbx * NWAVES, gwv = (F.bid >> 3) * NWAVES + F.wave;
    const unsigned char* VS = F.ws + WS_VB + (size_t)x * NEXP * 128; const unsigned j16 = 16u * (unsigned)j;
    LAS unsigned char* TL = F.lds + F.wave * PO_TILE;
    if (gwv >= M) return;
    const int nst = 2 * ((M - 1 - gwv) / NW + 1);
    const int trow = l15 >> 1, tcol = 8 * (l15 & 1);
#define PM_IDS(e_, a_, tok_) do { const size_t base = (size_t)(tok_) * 128; \
        _Pragma("unroll") for (int m = 0; m < 16; ++m) e_[m] = EID[base + 8 * m + g]; \
        _Pragma("unroll") for (int q = 0; q < 4; ++q) a_[q] = *(const GAS long*)(CF8 + base + 32 * q + 8 * lq); } while (0)
#define PM_GATHER(vv_, e_, h_) do { _Pragma("unroll") for (int m = 0; m < 8; ++m) vv_[m] = *(const GAS v4u*)(VS + ((unsigned)e_[8 * (h_) + m] * 128u + j16)); } while (0)
#define PM_HALF(vv_, aq0_, aq1_) do { _Pragma("unroll") for (int m = 0; m < 8; ++m) *(LAS v4u*)(TL + (8 * m + g) * 144 + 16 * j) = vv_[m]; } while (0)
#define PM_MMA(aq0_, aq1_) do { LDS_WAIT(); asm volatile("" ::: "memory"); \
        _Pragma("unroll") for (int ks = 0; ks < 2; ++ks) _Pragma("unroll") for (int cb = 0; cb < 8; ++cb) { \
            const v2i bb = __builtin_amdgcn_ds_read_tr8_b64_v2i32((LAS v2i*)(TL + (32 * ks + 8 * lq + trow) * 144 + 16 * cb + tcol)); \
            acc[cb] = __builtin_amdgcn_mfma_f32_16x16x32_fp8_fp8(ks ? (aq1_) : (aq0_), __builtin_bit_cast(long, bb), acc[cb], 0, 0, 0); } \
        LDS_WAIT(); asm volatile("" ::: "memory"); } while (0)
    const int ntok = nst >> 1;
    int e1[16], e2[16]; long a0[4], a1[4], a2[4]; v4u vvA[8], vvB[8];
    PM_IDS(e1, a0, gwv);
    PM_GATHER(vvA, e1, 0); PM_GATHER(vvB, e1, 1);
    { const int t1 = ntok > 1 ? 1 : 0; PM_IDS(e1, a1, gwv + t1 * NW); }
    f32x4 acc[8];
    for (int it = 0; it < ntok; ++it) {
        const int token = gwv + it * NW;
        { const int t2 = it + 2 < ntok ? it + 2 : ntok - 1; PM_IDS(e2, a2, gwv + t2 * NW); }
#pragma unroll
        for (int cb = 0; cb < 8; ++cb) acc[cb] = (f32x4){0.f, 0.f, 0.f, 0.f};
        PM_HALF(vvA, 0, 0); PM_GATHER(vvA, e1, 0); PM_MMA(a0[0], a0[1]);
        PM_HALF(vvB, 0, 0); PM_GATHER(vvB, e1, 1); PM_MMA(a0[2], a0[3]);
        if (lq == 0) {
            const float cs = CFS[token];
            if (MODE == 1) { float* oc = (float*)(F.ws + WS_PART) + (size_t)token * D + 128 * x + l15;
#pragma unroll
                for (int cb = 0; cb < 8; ++cb) oc[16 * cb] = acc[cb][0] * cs; }
            else { const int b = token >> 12;
                const float* gt = ada + (size_t)b * 6 * D + 5 * D + 128 * x + l15;
                float* xo = out + (size_t)token * D + 128 * x + l15;
#pragma unroll
                for (int cb = 0; cb < 8; ++cb) xo[16 * cb] = xo[16 * cb] + gt[16 * cb] * (acc[cb][0] * cs); }
        }
#pragma unroll
        for (int m = 0; m < 16; ++m) e1[m] = e2[m];
#pragma unroll
        for (int q = 0; q < 4; ++q) { a0[q] = a1[q]; a1[q] = a2[q]; }
    }
#undef PM_HALF
#undef PM_MMA
#undef PM_IDS
#undef PM_GATHER
}

__device__ __forceinline__ void compress_phase(Frame& F, const float* kng) {
    LAS bf16* H2 = (LAS bf16*)(F.lds);
    LAS float* OUTS = (LAS float*)(F.lds + 16384);
    const int lane = F.lane, w = F.wave, l15 = lane & 15, lq = lane >> 4;
    for (int u = F.bid; u < NBG * 2 * 8; u += F.G) {
        const int ns = u & 7, kv = (u >> 3) & 1, bg = u >> 4, n0 = ns * 32;
        const bf16* A = (const bf16*)(F.ws + (kv ? WS_VCR : WS_KCR)) + (size_t)bg * SEQ * 64;
        const bf16* W1T = (const bf16*)(F.ws + (kv ? WS_CW1V_T : WS_CW1K_T));
        const bf16* W2T = (const bf16*)(F.ws + (kv ? WS_CW2V_T : WS_CW2K_T));
        const float* b1 = (const float*)(F.ws + (kv ? WS_CB1V : WS_CB1K));
        pg8::f32x4 acc[2];
        acc[0] = (pg8::f32x4){0.f, 0.f, 0.f, 0.f}; acc[1] = acc[0];
        const bf16* ap = A + (size_t)(n0 + l15) * 1024 + 8 * lq;
        const bf16* bp = W1T + (size_t)(16 * w + l15) * 2048 + 8 * lq;
#pragma unroll 4
        for (int ks = 0; ks < 64; ++ks) {
            const bf16x8 a0 = *(const GAS bf16x8*)(ap + 32 * ks), a1 = *(const GAS bf16x8*)(ap + 16 * 1024 + 32 * ks), b = *(const GAS bf16x8*)(bp + 32 * ks);
            acc[0] = __builtin_amdgcn_mfma_f32_16x16x32_bf16(a0, b, acc[0], 0, 0, 0);
            acc[1] = __builtin_amdgcn_mfma_f32_16x16x32_bf16(a1, b, acc[1], 0, 0, 0);
        }
        { const float bb = b1[16 * w + l15];
#pragma unroll
          for (int rb = 0; rb < 2; ++rb)
#pragma unroll
            for (int r = 0; r < 4; ++r) H2[(16 * rb + 4 * lq + r) * 136 + 16 * w + l15] = (bf16)f2bf(gelu_tanh_safe(acc[rb][r] + bb)); }
        __syncthreads();
        { const int rb = w >> 2, db = w & 3;
          pg8::f32x4 o = (pg8::f32x4){0.f, 0.f, 0.f, 0.f};
#pragma unroll
          for (int ks = 0; ks < 4; ++ks) {
              const bf16x8 a = *(const LAS bf16x8*)(H2 + (16 * rb + l15) * 136 + 32 * ks + 8 * lq);
              const bf16x8 b = *(const GAS bf16x8*)(W2T + (size_t)(16 * db + l15) * 128 + 32 * ks + 8 * lq);
              o = __builtin_amdgcn_mfma_f32_16x16x32_bf16(a, b, o, 0, 0, 0); }
#pragma unroll
          for (int r = 0; r < 4; ++r) OUTS[(16 * rb + 4 * lq + r) * 65 + 16 * db + l15] = o[r]; }
        __syncthreads();
        { const int n = F.tid >> 4, d4 = (F.tid & 15) * 4, ng = n0 + n;
          float v[4]; float ss = 0.f;
#pragma unroll
          for (int i = 0; i < 4; ++i) { v[i] = OUTS[n * 65 + d4 + i]; ss += v[i] * v[i]; }
          ss += dppf<DPP_XOR1>(ss); ss += dppf<DPP_XOR2>(ss); ss += dppf<DPP_HMIR>(ss); ss += dppf<DPP_ROR8>(ss);
          const bool pad = (ng >= NCMP);
          if (kv == 0) { const float rs = rsqrtf(ss * (1.f / 64.f) + EPS);
              v2u o; o.x = pad ? 0u : pk2(v[0] * rs * kng[d4], v[1] * rs * kng[d4 + 1]); o.y = pad ? 0u : pk2(v[2] * rs * kng[d4 + 2], v[3] * rs * kng[d4 + 3]);
              *(GAS v2u*)((bf16*)(F.ws + WS_KC) + ((size_t)bg * 256 + ng) * 64 + d4) = o; }
          else { bf16* vt = (bf16*)(F.ws + WS_VCT) + (size_t)bg * 64 * 256 + ng;
#pragma unroll
              for (int i = 0; i < 4; ++i) vt[(size_t)(d4 + i) * 256] = pad ? (bf16)0 : (bf16)f2bf(v[i]); } }
        __syncthreads();
    }
}
__device__ __forceinline__ void vtranspose_phase(Frame& F) {
    LAS bf16* T = (LAS bf16*)(F.lds + F.wave * 9216);
    const int gw = F.bid * NWAVES + F.wave, NGW = F.G * NWAVES, lane = F.lane;
    for (int job = gw; job < 2 * NBG * 64; job += NGW) {
        const int s = job & 63, bg = (job >> 6) & 15, which = job >> 10;
        const bf16* X = (const bf16*)(F.ws + (which ? WS_VW : WS_VS)) + ((size_t)bg * SEQ + 64 * s) * 64;
        bf16* XT = (bf16*)(F.ws + (which ? WS_VWT : WS_VST)) + (size_t)bg * 64 * SEQ + 64 * s;
#pragma unroll
        for (int i = 0; i < 8; ++i) { const int tok = (lane >> 3) + 8 * i, ch = lane & 7;
            const v4u x = *(const GAS v4u*)(X + (size_t)tok * 64 + 8 * ch);
            const unsigned ww[4] = {x.x, x.y, x.z, x.w};
#pragma unroll
            for (int e = 0; e < 4; ++e) { T[(8 * ch + 2 * e) * 72 + tok] = (bf16)(ww[e] & 0xffffu); T[(8 * ch + 2 * e + 1) * 72 + tok] = (bf16)(ww[e] >> 16); } }
        LDS_WAIT(); asm volatile("" ::: "memory");
#pragma unroll
        for (int i = 0; i < 8; ++i) { const int dim = (lane >> 3) + 8 * i, ch = lane & 7;
            const v4u y = *(const LAS v4u*)(T + dim * 72 + 8 * ch);
            *(GAS v4u*)(XT + (size_t)dim * SEQ + 8 * ch) = y; }
        LDS_WAIT(); asm volatile("" ::: "memory");
    }
}

constexpr int AT_KSTR = 72;
constexpr int AT_KBUF = 64 * AT_KSTR * 2;
constexpr int AT_OFF_K = 0, AT_OFF_V = 2 * AT_KBUF;
constexpr int AT_OFF_IMP1 = 4 * AT_KBUF, AT_OFF_IMP2 = AT_OFF_IMP1 + 64 * 65 * 4, AT_OFF_SEL = AT_OFF_IMP2 + 64 * 65 * 4;
constexpr int AT_OFF_LUT = AT_OFF_SEL + 4096, AT_OFF_LROW = AT_OFF_LUT + 4 * 128 * 4;
constexpr int AT_OFF_TD = AT_OFF_LROW + 8 * 32 * 4;
constexpr int AT_OFF_OUT = AT_OFF_TD + 96 * 32;
constexpr int AT_OFF_GATL = AT_OFF_OUT + 256 * 144;
constexpr int AT_LDS_END = AT_OFF_GATL + 64 * 12 * 4;
static_assert(AT_LDS_END <= RING_BYTES, "attention LDS");

struct AtTile { const bf16* k; const bf16* vt; int vstride; };
enum { TM_CMP1 = 0, TM_CMP2, TM_SELN, TM_SELF, TM_WINN, TM_WINF, TM_WINE };
__device__ __forceinline__ float fexp2(float x) { return __builtin_amdgcn_exp2f(x); }
template <int TM, int VAR, int RB = 3>
__device__ __forceinline__ void at_tile(const LAS unsigned char* kb_, const LAS unsigned char* vb_, const LAS float* LUTJ, LAS float* IMP1, LAS float* IMP2,
                                        const bf16x8 (&qf)[2][2], pg8::f32x4 (&oacc)[2][4], float (&lsum)[2], float (&lpart)[2], const float (&linv)[2],
                                        const int (&tok_r)[2], const unsigned (&selb)[2], float cfar, int relbase, int idx, int l15, int lq) {
    constexpr bool FAR = (TM == TM_SELF || TM == TM_WINF || TM == TM_WINE);
    v4u pfr[2][2];
#pragma unroll
    for (int cb = 0; cb < 4; ++cb) {
        pg8::f32x4 st[2];
        st[0] = FAR ? (pg8::f32x4){cfar, cfar, cfar, cfar} : (pg8::f32x4){0.f, 0.f, 0.f, 0.f}; st[1] = st[0];
        if (!(VAR & 64)) {
#pragma unroll
        for (int ks = 0; ks < 2; ++ks) { const bf16x8 kf = *(const LAS bf16x8*)(kb_ + (16 * cb + l15) * 144 + 64 * ks + 16 * lq);
#pragma unroll
            for (int rb = 0; rb < 2; ++rb) if (RB & (1 << rb)) st[rb] = __builtin_amdgcn_mfma_f32_16x16x32_bf16(kf, qf[rb][ks], st[rb], 0, 0, 0); } }
#pragma unroll
        for (int rb = 0; rb < 2; ++rb) if (RB & (1 << rb)) {
            const int tokc = tok_r[rb];
            float p[4];
#pragma unroll
            for (int r = 0; r < 4; ++r) {
                const int kl = 16 * cb + 4 * lq + r;
                if (VAR & 16) { p[r] = st[rb][r]; }
                else if (TM == TM_SELF) { const float e = fexp2(st[rb][r]); p[r] = selb[rb] ? e : 0.f; }
                else if (TM == TM_WINF) { p[r] = fexp2(st[rb][r]); }
                else if (TM == TM_WINE) { const float e = fexp2(st[rb][r]); p[r] = (kl > tokc) ? e : 0.f; }
                else {
                    const int rel = (TM == TM_CMP1 || TM == TM_CMP2) ? (relbase + tokc - 16 * kl) : (relbase + tokc - kl);
                    bool valid = rel >= 0; if (TM == TM_SELN) valid = valid && (selb[rb] != 0u);
                    const int ri = rel < 0 ? 0 : (rel > 127 ? 127 : rel);
                    const float e = fexp2(st[rb][r] + LUTJ[ri]);
                    p[r] = valid ? e : 0.f; }
            }
            if (TM == TM_CMP1) { lpart[rb] += (p[0] + p[1]) + (p[2] + p[3]); }
            else {
                if (TM == TM_CMP2) {
#pragma unroll
                    for (int r = 0; r < 4; ++r) p[r] *= linv[rb];
                    float h0 = p[0], h1 = p[1], h2 = p[2], h3 = p[3];
                    h0 += dppf<DPP_XOR1>(h0); h1 += dppf<DPP_XOR1>(h1); h2 += dppf<DPP_XOR1>(h2); h3 += dppf<DPP_XOR1>(h3);
                    h0 += dppf<DPP_XOR2>(h0); h1 += dppf<DPP_XOR2>(h1); h2 += dppf<DPP_XOR2>(h2); h3 += dppf<DPP_XOR2>(h3);
                    if ((l15 & 3) == 0) { const int sp = 16 * idx + 4 * cb + lq;
                        IMP1[tokc * 65 + sp] = (h0 + h1) + (h2 + 0.5f * h3);
                        if (sp + 1 < 64) IMP2[tokc * 65 + sp + 1] = 0.5f * h3; }
                } else lsum[rb] += (p[0] + p[1]) + (p[2] + p[3]);
                const unsigned lo = pg8::cvt_pk_bf16(p[0], p[1]), hi = pg8::cvt_pk_bf16(p[2], p[3]);
                if (cb & 1) { pfr[rb][cb >> 1].z = lo; pfr[rb][cb >> 1].w = hi; } else { pfr[rb][cb >> 1].x = lo; pfr[rb][cb >> 1].y = hi; } }
        }
    }
    if (TM != TM_CMP1 && !(VAR & 8)) {
#pragma unroll
        for (int ks = 0; ks < 2; ++ks)
#pragma unroll
            for (int db = 0; db < 4; ++db) {
                const LAS unsigned char* vp = vb_ + (16 * db + l15) * 144 + 64 * ks + 8 * lq;
                const v2u v0 = *(const LAS v2u*)vp, v1 = *(const LAS v2u*)(vp + 32);
                const v4u vv = (v4u){v0.x, v0.y, v1.x, v1.y};
#pragma unroll
                for (int rb = 0; rb < 2; ++rb) if (RB & (1 << rb)) oacc[rb][db] = __builtin_amdgcn_mfma_f32_16x16x32_bf16(__builtin_bit_cast(bf16x8, pfr[rb][ks]), __builtin_bit_cast(bf16x8, vv), oacc[rb][db], 0, 0, 0); }
    }
}

template <int VAR> __device__ __forceinline__ void attention_phase(Frame& F, const Args& args) {
    unsigned char* ws = F.ws;
    const int lane = F.lane, w = F.wave, l15 = lane & 15, lq = lane >> 4, tid = F.tid;
    LAS unsigned char* L = F.lds;
    LAS float* IMP1 = (LAS float*)(L + AT_OFF_IMP1); LAS float* IMP2 = (LAS float*)(L + AT_OFF_IMP2);
    LAS unsigned long long* SELM = (LAS unsigned long long*)(L + AT_OFF_SEL); LAS float* LUT = (LAS float*)(L + AT_OFF_LUT); LAS float* LROW = (LAS float*)(L + AT_OFF_LROW) + w * 32;
    LAS int* TD = (LAS int*)(L + AT_OFF_TD); LAS bf16* OUTL = (LAS bf16*)(L + AT_OFF_OUT) + (32 * w) * 72; LAS float* GATL = (LAS float*)(L + AT_OFF_GATL);
    const float M0 = ((const float*)(ws + WS_BIASL))[8 * 128];
    const bf16* Qg = (const bf16*)(ws + WS_Q); const float* GATE = (const float*)(ws + WS_GATE); bf16* YA = (bf16*)(ws + WS_YA); float* YAF = (float*)(ws + WS_H);
    const int jq = l15 & 3;
    const LAS float* LUTJ = LUT + jq * 128;
    const int nrounds = (F.G == 256) ? 4 : (1024 + F.G - 1) / F.G;
    for (int round = 0; round < nrounds; ++round) {
        const int ui = (F.G == 256) ? ((round & 1) ? ((round >> 1) * 512 + 511 - F.bid) : ((round >> 1) * 512 + F.bid)) : (round * F.G + F.bid);
        if (ui >= 1024) break;
        const int c = 63 - (ui >> 4), bg = ui & 15, b = bg >> 1, g = bg & 1;
        const int m0 = b * SEQ + 64 * c;
        __syncthreads();
        for (int i = tid; i < 512; i += NTHREADS) LUT[i] = (((const float*)(ws + WS_BIASL))[(4 * g + (i >> 7)) * 128 + (i & 127)] - M0) * 1.4426950408889634f;
        for (int i = tid; i < 64 * 65; i += NTHREADS) { IMP1[i] = 0.f; IMP2[i] = 0.f; }
        for (int i = tid; i < 64 * 12; i += NTHREADS) GATL[i] = GATE[(size_t)(m0 + i / 12) * 24 + g * 12 + (i % 12)];
        bf16x8 qf[2][2];
#pragma unroll
        for (int rb = 0; rb < 2; ++rb)
#pragma unroll
            for (int ks = 0; ks < 2; ++ks) qf[rb][ks] = *(const GAS bf16x8*)(Qg + (size_t)(m0 + 8 * w + 4 * rb + (l15 >> 2)) * 512 + g * 256 + jq * 64 + 32 * ks + 8 * lq);
        asm volatile("" :: "v"(qf[0][0]), "v"(qf[0][1]), "v"(qf[1][0]), "v"(qf[1][1]));
        const int ncmp = 4 * c + 3, n1 = (ncmp + 63) >> 6, nsel = c + 1, w0 = c >= 8 ? c - 8 : 0, nwin = c - w0 + 1;
        const int ntiles = 2 * n1 + nsel + nwin;
        if (tid < ntiles) { const int i = tid; int kind, idx; unsigned ko, vo, vs;
            if (i < n1) { kind = 0; idx = i; } else if (i < 2 * n1) { kind = 1; idx = i - n1; } else if (i < 2 * n1 + nsel) { kind = 2; idx = i - 2 * n1; } else { kind = 3; idx = w0 + (i - 2 * n1 - nsel); }
            if (kind < 2) { ko = (unsigned)(WS_KC + ((size_t)bg * 256 * 64 + (size_t)idx * 4096) * 2); vo = (unsigned)(WS_VCT + ((size_t)bg * 64 * 256 + 64 * idx) * 2); vs = 512u; }
            else if (kind == 2) { ko = (unsigned)(WS_KS + ((size_t)bg * SEQ * 64 + (size_t)idx * 4096) * 2); vo = (unsigned)(WS_VST + ((size_t)bg * 64 * SEQ + 64 * idx) * 2); vs = 2u * SEQ; }
            else { ko = (unsigned)(WS_KW + ((size_t)bg * SEQ * 64 + (size_t)idx * 4096) * 2); vo = (unsigned)(WS_VWT + ((size_t)bg * 64 * SEQ + 64 * idx) * 2); vs = 2u * SEQ; }
            const int dd = c - idx;
            int mode, relbase;
            if (kind == 0) { mode = TM_CMP1; relbase = 64 * c - 31 - 1024 * idx; } else if (kind == 1) { mode = TM_CMP2; relbase = 64 * c - 31 - 1024 * idx; }
            else if (kind == 2) { mode = dd <= 2 ? TM_SELN : TM_SELF; relbase = 64 * dd; } else { mode = dd <= 2 ? TM_WINN : (dd == 8 ? TM_WINE : TM_WINF); relbase = 64 * dd; }
            const int endf = ((kind == 1 && idx == n1 - 1) || (kind == 2 && idx == nsel - 1) || (kind == 3 && idx == c)) ? kind : 0;
            LAS int* td = TD + 8 * i; td[0] = mode; td[1] = idx; td[2] = relbase; td[3] = endf; td[4] = (int)ko; td[5] = (int)vo; td[6] = (int)vs; td[7] = (kind == 2 && idx == 0) ? 1 : 0; }
        const int srow = tid >> 3, sch = tid & 7;
        __syncthreads();
        v4u kreg, vreg;
        { const unsigned ko = (unsigned)TD[4], vo = (unsigned)TD[5], vs = (unsigned)TD[6];
          kreg = *(const GAS v4u*)(ws + (size_t)(ko + srow * 128 + 16 * sch)); vreg = *(const GAS v4u*)(ws + (size_t)(vo + srow * vs + 16 * sch));
          *(LAS v4u*)(L + AT_OFF_K + srow * 144 + 16 * sch) = kreg; *(LAS v4u*)(L + AT_OFF_V + srow * 144 + 16 * sch) = vreg; }
        __syncthreads();
        const float cfar = LUTJ[127];
        float lpart[2] = {0.f, 0.f};
        float linv[2] = {0.f, 0.f};
        pg8::f32x4 oacc[2][4];
        float lsum[2] = {0.f, 0.f};
#pragma unroll
        for (int rb = 0; rb < 2; ++rb)
#pragma unroll
            for (int db = 0; db < 4; ++db) oacc[rb][db] = (pg8::f32x4){0.f, 0.f, 0.f, 0.f};
        const int tok_r[2] = {8 * w + (l15 >> 2), 8 * w + 4 + (l15 >> 2)};
        v4i dnx = *(const LAS v4i*)(TD); int sfnx = TD[7];
        unsigned long long selm[2] = {~0ull, ~0ull};
        for (int it = 0; it < ((VAR & 32) ? 0 : ntiles); ++it) {
            if (!(VAR & 2) && it + 1 < ntiles) { const LAS int* tn = TD + 8 * (it + 1); const unsigned ko = (unsigned)tn[4], vo = (unsigned)tn[5], vs = (unsigned)tn[6];
                kreg = *(const GAS v4u*)(ws + (size_t)(ko + srow * 128 + 16 * sch)); vreg = *(const GAS v4u*)(ws + (size_t)(vo + srow * vs + 16 * sch)); }
            {
            const int mode = __builtin_amdgcn_readfirstlane(dnx.x), idx = __builtin_amdgcn_readfirstlane(dnx.y), relbase = __builtin_amdgcn_readfirstlane(dnx.z);
            const int endf = __builtin_amdgcn_readfirstlane(dnx.w), selfirst = __builtin_amdgcn_readfirstlane(sfnx);
            { const int itn = it + 1 < ntiles ? it + 1 : it; dnx = *(const LAS v4i*)(TD + 8 * itn); sfnx = TD[8 * itn + 7]; }
            const int buf = it & 1;
            if (selfirst) {
                { const int tok = 8 * w + (lane >> 3), s0 = 8 * (lane & 7);
                  unsigned key[8]; int rank[8];
#pragma unroll
                  for (int q = 0; q < 8; ++q) { const int sB = s0 + q; const bool vis = sB <= c, forced = (sB == 0) || (sB == c) || (sB == c - 1);
                      const float sc = vis ? (IMP1[tok * 65 + sB] + IMP2[tok * 65 + sB] + (forced ? 1000.f : 0.f)) : -1.f;
                      const unsigned u = __builtin_bit_cast(unsigned, sc); const unsigned fk = (u >> 31) ? ~u : (u | 0x80000000u);
                      key[q] = (fk & ~63u) | (unsigned)(63 - sB); rank[q] = 0; }
                  LAS unsigned* KEYS = (LAS unsigned*)IMP1;
#pragma unroll
                  for (int q = 0; q < 8; ++q) KEYS[tok * 65 + s0 + q] = key[q];
                  if (c >= 16 && !(VAR & 128)) {
#pragma unroll 8
                      for (int s2 = 0; s2 < 64; ++s2) { const unsigned k2 = KEYS[tok * 65 + s2];
#pragma unroll
                          for (int q = 0; q < 8; ++q) rank[q] += (k2 > key[q]) ? 1 : 0; } }
                  unsigned byte = 0u;
#pragma unroll
                  for (int q = 0; q < 8; ++q) byte |= ((rank[q] < 16 && (s0 + q) <= c) ? 1u : 0u) << q;
                  ((LAS unsigned char*)SELM)[tok * 8 + (lane & 7)] = (unsigned char)byte; }
                selm[0] = SELM[tok_r[0]]; selm[1] = SELM[tok_r[1]];
            }
            const LAS unsigned char* kb_ = L + AT_OFF_K + buf * AT_KBUF; const LAS unsigned char* vb_ = L + AT_OFF_V + buf * AT_KBUF;
            unsigned selb[2] = {1u, 1u};
#define AT_CALL(TMX) at_tile<TMX, VAR>(kb_, vb_, LUTJ, IMP1, IMP2, qf, oacc, lsum, lpart, linv, tok_r, selb, cfar, relbase, idx, l15, lq)
            if (mode == TM_SELF || mode == TM_SELN) { selb[0] = (unsigned)(selm[0] >> idx) & 1u; selb[1] = (unsigned)(selm[1] >> idx) & 1u; }
            if (mode == TM_SELF) {
                const bool a0 = __ballot(selb[0] != 0u) != 0ull, a1 = __ballot(selb[1] != 0u) != 0ull;
                if (a0 && a1) AT_CALL(TM_SELF);
                else if (a0) at_tile<TM_SELF, VAR, 1>(kb_, vb_, LUTJ, IMP1, IMP2, qf, oacc, lsum, lpart, linv, tok_r, selb, cfar, relbase, idx, l15, lq);
                else if (a1) at_tile<TM_SELF, VAR, 2>(kb_, vb_, LUTJ, IMP1, IMP2, qf, oacc, lsum, lpart, linv, tok_r, selb, cfar, relbase, idx, l15, lq); }
            else if (mode == TM_WINF) AT_CALL(TM_WINF);
            else if (mode == TM_SELN) AT_CALL(TM_SELN);
            else if (mode == TM_WINN) AT_CALL(TM_WINN);
            else if (mode == TM_WINE) AT_CALL(TM_WINE);
            else if (mode == TM_CMP2) AT_CALL(TM_CMP2);
            else { if (idx == 0) { lpart[0] = 0.f; lpart[1] = 0.f; }
                AT_CALL(TM_CMP1);
                if (idx == n1 - 1) {
#pragma unroll
                    for (int rb = 0; rb < 2; ++rb) { float s = sum_xor32(sum_xor16(lpart[rb])); linv[rb] = s > 0.f ? 1.0f / s : 0.f; } } }
#undef AT_CALL
            {
                if (endf && !(VAR & 256)) {
                    const int br = endf - 1;
                    if (endf == 1) { LROW[l15] = 1.0f; LROW[16 + l15] = 1.0f; }
                    else {
#pragma unroll
                        for (int rb = 0; rb < 2; ++rb) { const float s = sum_xor32(sum_xor16(lsum[rb])); if (lq == 0) LROW[16 * rb + l15] = s > 0.f ? 1.0f / s : 0.f; lsum[rb] = 0.f; } }
                    LDS_WAIT(); asm volatile("" ::: "memory");
#pragma unroll
                    for (int rb = 0; rb < 2; ++rb)
#pragma unroll
                        for (int r = 0; r < 4; ++r) { const int qrow = 16 * rb + 4 * lq + r;
                            const float gt = GATL[(8 * w + 4 * rb + lq) * 12 + r * 3 + br] * LROW[qrow];
#pragma unroll
                            for (int db = 0; db < 4; ++db) { float v = gt * oacc[rb][db][r]; oacc[rb][db][r] = 0.f;
                                LAS bf16* po = OUTL + qrow * 72 + 16 * db + l15;
                                if (br > 0) v += __builtin_bit_cast(float, (unsigned)(*po) << 16);
                                *po = (bf16)f2bf(v); } }
                    if (br == 2 && !(VAR & 1)) {
                        LDS_WAIT(); asm volatile("" ::: "memory");
#pragma unroll
                        for (int i = 0; i < 4; ++i) { const int ch = i * 64 + lane, row = ch >> 3, c16 = ch & 7;
                            const v4u o = *(const LAS v4u*)((const LAS unsigned char*)OUTL + row * 144 + 16 * c16);
                            *(GAS v4u*)(YA + (size_t)(m0 + 8 * w + (row >> 2)) * 512 + g * 256 + (row & 3) * 64 + 8 * c16) = o; }
                    }
                }
            }
            }
            if (!(VAR & 2) && it + 1 < ntiles) { const int nb = (it & 1) ^ 1; *(LAS v4u*)(L + AT_OFF_K + nb * AT_KBUF + srow * 144 + 16 * sch) = kreg; *(LAS v4u*)(L + AT_OFF_V + nb * AT_KBUF + srow * 144 + 16 * sch) = vreg; }
            if (!(VAR & 4)) __syncthreads();
        }
    }
}

constexpr int N_PHASES = 13;
#ifndef MK_ONE_LAUNCH
#define MK_ONE_LAUNCH 1
#endif
#ifndef REP_P0
#define REP_P0 1
#endif
#ifndef REP_P1
#define REP_P1 1
#endif
#ifndef REP_P2
#define REP_P2 1
#endif
#ifndef REP_P3
#define REP_P3 1
#endif
#ifndef REP_P5
#define REP_P5 1
#endif
#ifndef REP_P6
#define REP_P6 1
#endif
#ifndef REP_P8
#define REP_P8 1
#endif
#ifndef REP_P7
#define REP_P7 1
#endif
#ifndef REP_P11
#define REP_P11 1
#endif
#ifndef REP_P4
#define REP_P4 1
#endif
#ifndef REP_P9
#define REP_P9 1
#endif
#ifndef REP_P10
#define REP_P10 1
#endif
#ifndef MK_BUILD
#define MK_BUILD 0
#endif

__global__ void __launch_bounds__(NTHREADS, 2) fwd_kernel(Args args) {
    extern __shared__ __attribute__((aligned(16))) unsigned char lds[];
    Frame F;
    F.lds = (LAS unsigned char*)lds;
    F.MISC = (volatile LAS unsigned*)(F.lds + MISC_OFF);
    F.tid = threadIdx.x; F.lane = F.tid & 63; F.wave = __builtin_amdgcn_readfirstlane(F.tid >> 6);
    F.G = gridDim.x; F.bid = blockIdx.x; F.ws = args.ws;
    F.ctl = (gu32*)(args.ws + WS_CTL);
    for (int u = F.tid; u < (LDS_BYTES - LDSCTL_OFF) / 4; u += NTHREADS) ((LAS unsigned*)(F.lds + LDSCTL_OFF))[u] = 0u;
    __syncthreads();
    XcdBarrier bar; bar.bar = (unsigned*)(F.ctl + CW_BAR); bar.x = 0; bar.st = nullptr;
    if (MK_ONE_LAUNCH) bar = xcd_barrier_post((unsigned*)(F.ctl + CW_BAR), F.MISC + 8);
    const int lo = args.ph_lo, hi = args.ph_hi;
#define IN(k) (lo <= (k) && (k) < hi)
#define SEAM(k) do { if (IN(k) && IN((k) + 1)) xcd_barrier(bar); } while (0)
    unsigned char* ws = args.ws;
    const float* ada = (const float*)(ws + WS_ADA);

    if (IN(0)) { for (int rep = 0; rep < REP_P0; ++rep) { p0_prologue(F, args); __syncthreads(); } } SEAM(0);
    if (IN(1)) { for (int rep = 0; rep < REP_P1; ++rep) modnorm_rows<false>(F, args.in[I_X], args.in[I_N1G], ada, 0, (bf16*)(ws + WS_H)); } SEAM(1);
    if (IN(2)) { {
        pg8::Gemm g{(const bf16*)(ws + WS_H), (const bf16*)(ws + WS_WIN_T), M, NIN, D, D, D}; pg8::StaticOrder S; S.init(M, NIN, F.G, F.bid);
        EpiIn E{ws, args.in[I_QNG], args.in[I_KNG]};
        pg8::gemm_phase<EpiIn, pg8::StaticOrder, true, true>(F.lds + RING_OFF, g, S, E);
#if REP_P2 > 1
        __syncthreads(); pg8::gemm_phase<EpiIn, pg8::StaticOrder, true, true>(F.lds + RING_OFF, g, S, E);
#endif
        }
    } SEAM(2);
    if (IN(3)) { for (int rep = 0; rep < REP_P3; ++rep) { __syncthreads(); pool_phase(F); __syncthreads(); compress_phase(F, args.in[I_KNG]); __syncthreads(); vtranspose_phase(F); } } SEAM(3);
    if (IN(4)) {
#ifdef PROBE_P4
        attention_phase<PROBE_P4>(F, args); __syncthreads();
#endif
        attention_phase<0>(F, args); } SEAM(4);
    if (IN(5)) { {
        { pg8::Gemm g{(const bf16*)(ws + WS_PL), (const bf16*)(ws + WS_WEFF_T), M, D, POOLW, POOLW, POOLW}; pg8::StaticOrder S; S.init(M, D, F.G, F.bid);
          EpiMix<false> E{(bf16*)(ws + WS_MIX), (const bf16*)(ws + WS_GM), 0};
          pg8::gemm_phase<EpiMix<false>, pg8::StaticOrder, true, true>(F.lds + RING_OFF, g, S, E); }
        { pg8::Gemm g{(const bf16*)(ws + WS_YA), (const bf16*)(ws + WS_WBA_T), M, D, QW, QW, QW}; pg8::StaticOrder S; S.init(M, D, F.G, F.bid);
          EpiMix<true> E{(bf16*)(ws + WS_MIX), (const bf16*)(ws + WS_GM), 1024};
          pg8::gemm_phase<EpiMix<true>, pg8::StaticOrder, true, true>(F.lds + RING_OFF, g, S, E); } }
#if REP_P5 > 1
        { __syncthreads(); { pg8::Gemm g{(const bf16*)(ws + WS_PL), (const bf16*)(ws + WS_WEFF_T), M, D, POOLW, POOLW, POOLW}; pg8::StaticOrder S; S.init(M, D, F.G, F.bid);
          EpiMix<false> E{(bf16*)(ws + WS_MIX), (const bf16*)(ws + WS_GM), 0};
          pg8::gemm_phase<EpiMix<false>, pg8::StaticOrder, true, true>(F.lds + RING_OFF, g, S, E); }
        { pg8::Gemm g{(const bf16*)(ws + WS_YA), (const bf16*)(ws + WS_WBA_T), M, D, QW, QW, QW}; pg8::StaticOrder S; S.init(M, D, F.G, F.bid);
          EpiMix<true> E{(bf16*)(ws + WS_MIX), (const bf16*)(ws + WS_GM), 1024};
          pg8::gemm_phase<EpiMix<true>, pg8::StaticOrder, true, true>(F.lds + RING_OFF, g, S, E); } }
#endif
    } SEAM(5);
    if (IN(6)) { {
        pg8::Gemm g{(const bf16*)(ws + WS_MIX), (const bf16*)(ws + WS_WOUT_T), M, D, D, D, D}; pg8::StaticOrder S; S.init(M, D, F.G, F.bid);
        EpiRes E{args.in[I_X], args.out, ada, 2};
        pg8::gemm_phase<EpiRes, pg8::StaticOrder, true, true>(F.lds + RING_OFF, g, S, E);
#if REP_P6 > 1
        __syncthreads(); pg8::gemm_phase<EpiRes, pg8::StaticOrder, true, true>(F.lds + RING_OFF, g, S, E);
#endif
        }
    } SEAM(6);
    if (IN(7)) { for (int rep = 0; rep < REP_P7; ++rep) modnorm_rows<true>(F, args.out, args.in[I_N2G], ada, 3, (bf16*)(ws + WS_H)); } SEAM(7);
    if (IN(8)) { {
        pg8::Gemm g{(const bf16*)(ws + WS_H), (const bf16*)(ws + WS_WQ_T), M, PQW, D, D, D}; pg8::StaticOrder S; S.init(M, PQW, F.G, F.bid);
        EpiStoreBf16 E{(bf16*)(ws + WS_QV), PQW};
        pg8::gemm_phase<EpiStoreBf16, pg8::StaticOrder, true, true>(F.lds + RING_OFF, g, S, E);
#if REP_P8 > 1
        __syncthreads(); pg8::gemm_phase<EpiStoreBf16, pg8::StaticOrder, true, true>(F.lds + RING_OFF, g, S, E);
#endif
        }
    } SEAM(8);
    if (IN(9)) { for (int rep = 0; rep < REP_P9; ++rep) peer_select_phase(F); } SEAM(9);
#ifdef PROBE_XCD
    if (IN(10)) { if (F.tid == 0) __hip_atomic_store((unsigned*)(F.ctl + 2048 + F.bid), 100u + xb_xcc_id(), RLX_AGENT); }
#endif
    if (IN(10)) {
#ifdef PROBE_DOT
        peer_dot_phase<PROBE_DOT>(F); __syncthreads();
#endif
#ifdef PROBE_LOADRATE
        peer_loadrate_probe<PROBE_LOADRATE>(F); __syncthreads();
#endif
        peer_dot_phase<0>(F); } SEAM(10);
    if (IN(11)) { for (int rep = 0; rep < REP_P11; ++rep) peer_coef_phase(F); } SEAM(11);
#ifdef PROBE_XCD
    if (IN(12) && F.bid == 0 && F.tid == 0) { bool ok = true; for (int i = 0; i < F.G; ++i) { const unsigned a = __hip_atomic_load((unsigned*)(F.ctl + 2048 + i), RLX_AGENT), b0 = __hip_atomic_load((unsigned*)(F.ctl + 2048 + (i & 7)), RLX_AGENT); if (a != b0 || a < 100u) ok = false; }
        for (int i = 0; i < 8; ++i) for (int q = 0; q < i; ++q) if (__hip_atomic_load((unsigned*)(F.ctl + 2048 + i), RLX_AGENT) == __hip_atomic_load((unsigned*)(F.ctl + 2048 + q), RLX_AGENT)) ok = false;
        if (!ok) args.out[12345] = 1.0e9f; }
    __syncthreads();
#endif
    if (IN(12)) {
#if defined(CHECK_OUT_MFMA)
        peer_out_mfma_phase<1>(F, ada, args.out); __syncthreads(); VM_WAIT(); __syncthreads(); peer_out_phase<false, true>(F, ada, args.out);
#elif defined(OUT_VALU)
        for (int rep = 1; rep < REP_P10; ++rep) peer_out_phase<true>(F, ada, args.out); peer_out_phase<false>(F, ada, args.out);
#else
        peer_out_mfma_phase<0>(F, ada, args.out);
#endif
    }
#undef IN
#undef SEAM
}

extern "C" void kernel_launch(void* const* d_in, const int* in_sizes, int n_in, void* d_out, int out_size, void* d_ws, size_t ws_size, hipStream_t stream) {
    static int grid = 0;
    if (grid == 0) {
        if (n_in != N_IN || in_sizes[0] != M * D || out_size != M * D || ws_size < WS_END) {
            fprintf(stderr, "kernel_launch: unexpected shapes: n_in %d in0 %d out %d ws %zu (need %zu)\n", n_in, n_in > 0 ? in_sizes[0] : -1, out_size, ws_size, (size_t)WS_END); grid = -1; return; }
        int dev = 0, cus = 0, per_cu = 0;
        if (hipGetDevice(&dev) != hipSuccess || hipDeviceGetAttribute(&cus, hipDeviceAttributeMultiprocessorCount, dev) != hipSuccess) { grid = -1; return; }
        if (hipFuncSetAttribute((const void*)fwd_kernel, hipFuncAttributeMaxDynamicSharedMemorySize, LDS_BYTES) != hipSuccess) { fprintf(stderr, "kernel_launch: hipFuncSetAttribute failed\n"); grid = -1; return; }
        if (hipOccupancyMaxActiveBlocksPerMultiprocessor(&per_cu, (const void*)fwd_kernel, NTHREADS, LDS_BYTES) != hipSuccess || per_cu < 1)
            fprintf(stderr, "kernel_launch: occupancy query reports %d workgroups per CU\n", per_cu);
        (void)hipGetLastError();
        grid = cus;
    }
    if (grid < 0) return;
    if (hipMemsetAsync((char*)d_ws + WS_CTL, 0, CTL_ZERO_BYTES, stream) != hipSuccess) return;
    Args a{};
    for (int i = 0; i < N_IN; ++i) a.in[i] = (const float*)d_in[i];
    a.out = (float*)d_out; a.ws = (unsigned char*)d_ws;
    if (MK_ONE_LAUNCH) {
        a.ph_lo = 0; a.ph_hi = N_PHASES; a.li = 0;
        hipLaunchKernelGGL(fwd_kernel, dim3(grid), dim3(NTHREADS), LDS_BYTES, stream, a);
    } else {
        for (int p = 0; p < N_PHASES; ++p) {
            a.ph_lo = p; a.ph_hi = p + 1; a.li = p;
            hipLaunchKernelGGL(fwd_kernel, dim3(grid), dim3(NTHREADS), LDS_BYTES, stream, a);
        }
    }
}
```

```cpp
#include <hip/hip_runtime.h>
#include <cstdio>
#include <cstdint>
namespace pg8 {
#define PG8_LAS __attribute__((address_space(3)))
typedef unsigned short bf16_t;
typedef short bf16x8 __attribute__((ext_vector_type(8)));
typedef float f32x4 __attribute__((ext_vector_type(4)));
typedef unsigned u32x4 __attribute__((ext_vector_type(4)));
constexpr int BM = 256, BK = 64, HALF = 128, HTB = HALF * BK * 2  , STAGE_BYTES = 8 * HTB, NXCD = 8, WGM = 8;

__host__ __device__ __forceinline__ int lds_byte(int r, int c) { const int st = (r >> 4) * 2 + (c >> 5), rr = r & 15, cc = c & 31, ob = rr * 64 + cc * 2; return st * 1024 + (ob ^ (((ob >> 9) & 1) << 5)); }
__host__ __device__ __forceinline__ void stage_rc(int b, int& R, int& C) { const int st = b / 1024, sb = b % 1024, swz = sb ^ (((sb >> 9) & 1) << 5); R = (st >> 1) * 16 + swz / 64; C = (st & 1) * 32 + (swz % 64) / 2; }
__host__ __device__ __forceinline__ int perm32(int rho) { const int n = rho >> 4, i = rho & 15; return 8 * (i >> 2) + 4 * n + (i & 3); }

struct Unit { int pm, pn; };
struct Gemm { const bf16_t* A; const bf16_t* Bt; int M, N, K, lda, ldb; };

struct StaticOrder {
    int nM, nN, nwg, G, c;
    __host__ __device__ void init(int M, int N, int G_, int c_) { nM = M / BM; nN = N / BM; nwg = nM * nN; G = G_; c = c_; }
    __host__ __device__ bool next(int i, Unit& u) const {
        const long L = (long)i * G + c; if (L >= nwg) return false;
        int wgid = (int)L; { const int q = nwg / NXCD, r = nwg % NXCD, xcd = wgid % NXCD, off = wgid / NXCD; wgid = (xcd < r ? xcd * (q + 1) : r * (q + 1) + (xcd - r) * q) + off; }
        const int nig = WGM * nN, gid = wgid / nig, fm = gid * WGM, gsz = (nM - fm) < WGM ? (nM - fm) : WGM;
        u.pm = fm + ((wgid % nig) % gsz); u.pn = (wgid % nig) / gsz; return true;
    }
    __device__ __forceinline__ void a_ready(const Unit&) const {}
    __device__ __forceinline__ void done(const Unit&) const {}
};

__device__ __forceinline__ unsigned cvt_pk_bf16(float lo, float hi) { unsigned r; asm volatile("v_cvt_pk_bf16_f32 %0, %1, %2" : "=v"(r) : "v"(lo), "v"(hi)); return r; }
template <class Epi, class Sched, bool ALIGN_EPI = false, bool SP2 = false>
__device__ __forceinline__ void gemm_phase(PG8_LAS unsigned char* lds, const Gemm g, const Sched& S, const Epi& E) {
    const int tid = threadIdx.x, wid = __builtin_amdgcn_readfirstlane(tid >> 6), lane = tid & 63, wr = wid >> 2, wc = wid & 3, fr = lane & 15, fq = lane >> 4;
    const int K = g.K, nt = K / BK;
    unsigned voffA[2], voffB[2];
#pragma unroll
    for (int i = 0; i < 2; ++i) { int R, C; stage_rc(tid * 16 + i * 8192, R, C); const int Rb = Epi::PERM ? ((R & ~31) + perm32(R & 31)) : R;
        voffA[i] = (unsigned)(R * g.lda + C) * 2u; voffB[i] = (unsigned)(Rb * g.ldb + C) * 2u; }
    const size_t kstep = (size_t)(BK * 2);
    const size_t hstepA = (size_t)HALF * g.lda * 2, hstepB = (size_t)HALF * g.ldb * 2;
    const size_t tstepA = 2 * hstepA, tstepB = 2 * hstepB;
    const unsigned ldsw = (unsigned)wid * 1024u;
    const int aoff = lds_byte(wr * 64 + fr, fq * 8), boff = lds_byte(wc * 32 + fr, fq * 8);
#define PG8_SA(b, h) (((b) * 2 + (h)) * HTB)
#define PG8_SB(b, h) ((4 + (b) * 2 + (h)) * HTB)
#define PG8_STAGE(bufoff, gbase, voff) do { _Pragma("unroll") for (int _i = 0; _i < 2; ++_i) \
        __builtin_amdgcn_global_load_lds((const unsigned*)((const char*)(gbase) + (voff)[_i]), (PG8_LAS unsigned*)(lds + (bufoff) + ldsw + _i * 8192), 16, 0, 0); } while (0)
#define PG8_LDA(dst, b, h) do { _Pragma("unroll") for (int m = 0; m < 4; ++m) _Pragma("unroll") for (int k = 0; k < 2; ++k) dst[m][k] = *(const PG8_LAS bf16x8*)(lds + PG8_SA(b, h) + aoff + m * 2048 + k * 1024); } while (0)
#define PG8_LDB(dst, b, h) do { _Pragma("unroll") for (int n = 0; n < 2; ++n) _Pragma("unroll") for (int k = 0; k < 2; ++k) dst[n][k] = *(const PG8_LAS bf16x8*)(lds + PG8_SB(b, h) + boff + n * 2048 + k * 1024); } while (0)
#define PG8_MMA(ai, bj, At, Bt) do { __builtin_amdgcn_s_setprio(1); _Pragma("unroll") for (int m = 0; m < 4; ++m) _Pragma("unroll") for (int n = 0; n < 2; ++n) _Pragma("unroll") for (int k = 0; k < 2; ++k) \
        acc[ai][bj][m][n] = __builtin_amdgcn_mfma_f32_16x16x32_bf16(Bt[n][k], At[m][k], acc[ai][bj][m][n], 0, 0, 0); __builtin_amdgcn_s_setprio(0); } while (0)
#define PG8_WAIT_V(n) asm volatile("s_waitcnt vmcnt(" #n ")" ::: "memory")
#define PG8_WAIT_L(n) asm volatile("s_waitcnt lgkmcnt(" #n ")" ::: "memory")
#define PG8_BAR __builtin_amdgcn_s_barrier()
#define PG8_SCHED __builtin_amdgcn_sched_barrier(0)
    Unit cur, nxt; int ui = 0;
    if (!S.next(0, cur)) return;
    f32x4 acc[2][2][4][2];
#pragma unroll
    for (int a = 0; a < 2; ++a)
#pragma unroll
        for (int b = 0; b < 2; ++b)
#pragma unroll
            for (int m = 0; m < 4; ++m)
#pragma unroll
                for (int n = 0; n < 2; ++n) acc[a][b][m][n] = (f32x4){0.f, 0.f, 0.f, 0.f};
    bf16x8 At[4][2], B0[2][2], B1[2][2];
    const char* cA = (const char*)g.A + (size_t)cur.pm * tstepA; const char* cB = (const char*)g.Bt + (size_t)cur.pn * tstepB;
    S.a_ready(cur);
    if constexpr (SP2) {
        PG8_STAGE(PG8_SB(0, 0), cB, voffB); PG8_STAGE(PG8_SB(0, 1), cB + hstepB, voffB); PG8_STAGE(PG8_SA(0, 0), cA, voffA); PG8_STAGE(PG8_SA(0, 1), cA + hstepA, voffA);
        if (wr == 1) PG8_BAR;
        PG8_WAIT_V(2); PG8_BAR;
        PG8_STAGE(PG8_SB(1, 0), cB + kstep, voffB); PG8_STAGE(PG8_SA(1, 0), cA + kstep, voffA); PG8_STAGE(PG8_SB(1, 1), cB + hstepB + kstep, voffB);
        PG8_WAIT_V(6); PG8_BAR;
    } else {
        PG8_STAGE(PG8_SB(0, 0), cB, voffB); PG8_STAGE(PG8_SA(0, 0), cA, voffA); PG8_STAGE(PG8_SB(0, 1), cB + hstepB, voffB); PG8_STAGE(PG8_SA(0, 1), cA + hstepA, voffA);
        if (wr == 1) PG8_BAR;
        PG8_WAIT_V(4); PG8_BAR;
        PG8_STAGE(PG8_SB(1, 0), cB + kstep, voffB); PG8_STAGE(PG8_SA(1, 0), cA + kstep, voffA); PG8_STAGE(PG8_SB(1, 1), cB + hstepB + kstep, voffB);
        PG8_WAIT_V(6); PG8_BAR;
    }
    for (;;) {
        const bool has_next = S.next(ui + 1, nxt);
        const char* nA = has_next ? (const char*)g.A + (size_t)nxt.pm * tstepA : cA; const char* nB = has_next ? (const char*)g.Bt + (size_t)nxt.pn * tstepB : cB;
        for (int t = 0; t < nt; t += 2) {
            const bool last = (t == nt - 2);
            const char* a1 = cA + (size_t)(t + 1) * kstep;
            const char* a2 = last ? nA : cA + (size_t)(t + 2) * kstep; const char* b2 = last ? nB : cB + (size_t)(t + 2) * kstep;
            const char* a3 = a2 + kstep; const char* b3 = b2 + kstep;
            if (last && has_next) S.a_ready(nxt);
            if constexpr (SP2) {
            PG8_LDB(B0, 0, 0); PG8_LDB(B1, 0, 1); PG8_SCHED; PG8_LDA(At, 0, 0); PG8_STAGE(PG8_SA(1, 1), a1 + hstepA, voffA);
            PG8_WAIT_V(8); PG8_WAIT_L(0); PG8_BAR; PG8_MMA(0, 0, At, B0); PG8_MMA(0, 1, At, B1); PG8_BAR; PG8_SCHED;
            PG8_LDA(At, 0, 1); PG8_STAGE(PG8_SB(0, 0), b2, voffB); PG8_STAGE(PG8_SB(0, 1), b2 + hstepB, voffB); PG8_STAGE(PG8_SA(0, 0), a2, voffA);
            PG8_WAIT_V(8); PG8_WAIT_L(0); PG8_BAR; PG8_MMA(1, 0, At, B0); PG8_MMA(1, 1, At, B1); PG8_BAR; PG8_SCHED;
            PG8_LDB(B0, 1, 0); PG8_LDB(B1, 1, 1); PG8_SCHED; PG8_LDA(At, 1, 0); PG8_STAGE(PG8_SA(0, 1), a2 + hstepA, voffA);
            PG8_WAIT_V(8); PG8_WAIT_L(0); PG8_BAR; PG8_MMA(0, 0, At, B0); PG8_MMA(0, 1, At, B1); PG8_BAR; PG8_SCHED;
            PG8_LDA(At, 1, 1); PG8_STAGE(PG8_SB(1, 0), b3, voffB); PG8_STAGE(PG8_SB(1, 1), b3 + hstepB, voffB); PG8_STAGE(PG8_SA(1, 0), a3, voffA);
            PG8_WAIT_V(8); PG8_WAIT_L(0); PG8_BAR; PG8_MMA(1, 0, At, B0); PG8_MMA(1, 1, At, B1); PG8_BAR; PG8_SCHED;
            } else {
            PG8_LDB(B0, 0, 0); PG8_SCHED; PG8_LDA(At, 0, 0); PG8_STAGE(PG8_SA(1, 1), a1 + hstepA, voffA);
            PG8_WAIT_L(8); PG8_BAR; PG8_WAIT_L(0); PG8_MMA(0, 0, At, B0); PG8_BAR; PG8_SCHED;
            PG8_LDB(B1, 0, 1); PG8_STAGE(PG8_SB(0, 0), b2, voffB);
            PG8_BAR; PG8_WAIT_L(0); PG8_MMA(0, 1, At, B1); PG8_BAR;
            PG8_LDA(At, 0, 1); PG8_STAGE(PG8_SA(0, 0), a2, voffA);
            PG8_BAR; PG8_WAIT_L(0); PG8_MMA(1, 0, At, B0); PG8_BAR; PG8_SCHED;
            PG8_STAGE(PG8_SB(0, 1), b2 + hstepB, voffB);
            PG8_WAIT_V(6); PG8_BAR; PG8_MMA(1, 1, At, B1); PG8_BAR;
            PG8_LDB(B0, 1, 0); PG8_SCHED; PG8_LDA(At, 1, 0); PG8_STAGE(PG8_SA(0, 1), a2 + hstepA, voffA);
            PG8_WAIT_L(8); PG8_BAR; PG8_WAIT_L(0); PG8_MMA(0, 0, At, B0); PG8_BAR; PG8_SCHED;
            PG8_LDB(B1, 1, 1); PG8_STAGE(PG8_SB(1, 0), b3, voffB);
            PG8_BAR; PG8_WAIT_L(0); PG8_MMA(0, 1, At, B1); PG8_BAR;
            PG8_LDA(At, 1, 1); PG8_STAGE(PG8_SA(1, 0), a3, voffA);
            PG8_BAR; PG8_WAIT_L(0); PG8_MMA(1, 0, At, B0); PG8_BAR; PG8_SCHED;
            PG8_STAGE(PG8_SB(1, 1), b3 + hstepB, voffB);
            PG8_WAIT_V(6); PG8_BAR; PG8_MMA(1, 1, At, B1); PG8_BAR;
            }
        }
        if constexpr (ALIGN_EPI) { if (wr == 0) PG8_BAR; }
        if constexpr (!Epi::AFTER_DRAIN) { E(acc, cur, wr, wc, fr, fq); S.done(cur); }
        if (!has_next) break;
#pragma unroll
        for (int a = 0; a < 2; ++a)
#pragma unroll
            for (int b = 0; b < 2; ++b)
#pragma unroll
                for (int m = 0; m < 4; ++m)
#pragma unroll
                    for (int n = 0; n < 2; ++n) acc[a][b][m][n] = (f32x4){0.f, 0.f, 0.f, 0.f};
        cur = nxt; cA = nA; cB = nB; ++ui;
        if constexpr (ALIGN_EPI) { if (wr == 1) PG8_BAR; }
    }
    PG8_WAIT_V(0);
    if constexpr (!ALIGN_EPI) { if (wr == 0) PG8_BAR; }
    PG8_BAR;
    if constexpr (Epi::AFTER_DRAIN) { E.fused(acc, cur, wr, wc, fr, fq, lds, wid, lane); S.done(cur); }
#undef PG8_SA
#undef PG8_SB
#undef PG8_STAGE
#undef PG8_LDA
#undef PG8_LDB
#undef PG8_MMA
#undef PG8_WAIT_V
#undef PG8_WAIT_L
#undef PG8_BAR
#undef PG8_SCHED
}
}

constexpr int NWAVES = 8, NTHREADS = NWAVES * 64;
constexpr int BATCH = 8, SEQ = 4096, D = 1024, M = BATCH * SEQ;
constexpr int POOLW = 512, QW = 512, NG = 2, HD = 64, NBG = BATCH * NG;
constexpr int IN_COLS = 3864, NIN = 4096;
constexpr int NCMP = 255, NCMP_PAD = 256, NSEL = 64;
constexpr int PH = 8, PK = 128, PTOP = 16, PQD = 256, PQW = PH * PQD;
constexpr int NEXP = PK * PK;
constexpr float EPS = 1e-6f;
enum { I_X = 0, I_C, I_RELB, I_ADAW, I_ADAB, I_N1G, I_N2G, I_WIN, I_POOLW, I_POOLS, I_CPEK, I_CW1K, I_CW2K, I_CPEV, I_CW1V, I_CW2V, I_QNG, I_KNG, I_WBP, I_WBA, I_WOUT, I_PWQ, I_PSK, I_PU, I_PV, N_IN };

constexpr size_t MiB = 1u << 20, KiB = 1u << 10;
constexpr size_t WS_CTL = 0, CTL_ZERO_BYTES = 1 * MiB;
constexpr size_t WS_ADA = 1 * MiB;
constexpr size_t WS_CB1K = 64 * KiB;
constexpr size_t WS_CB1V = WS_CB1K + 1 * KiB;
constexpr size_t WS_BIASL = WS_ADA + 256 * KiB;
constexpr size_t WS_WIN_T = 2 * MiB;
constexpr size_t WS_WEFF_T = 10 * MiB;
constexpr size_t WS_WBA_T = 11 * MiB;
constexpr size_t WS_WOUT_T = 12 * MiB;
constexpr size_t WS_WQ_T = 14 * MiB;
constexpr size_t WS_SUBK = 18 * MiB;
constexpr size_t WS_CW1K_T = 18 * MiB + 512 * KiB;
constexpr size_t WS_CW1V_T = 19 * MiB;
constexpr size_t WS_CW2K_T = 19 * MiB + 512 * KiB;
constexpr size_t WS_CW2V_T = WS_CW2K_T + 64 * KiB;
constexpr size_t WS_KC = 20 * MiB;
constexpr size_t WS_VCT = 20 * MiB + 512 * KiB;
constexpr size_t WS_GATE = 21 * MiB;
constexpr size_t WS_UB = 24 * MiB;
constexpr size_t WS_VB = 56 * MiB;
constexpr size_t WS_SCLU = WS_UB + 16 * MiB, WS_SCLV = WS_SCLU + 64 * KiB;
constexpr size_t WS_H = 88 * MiB;
constexpr size_t WS_ZP = 152 * MiB;
constexpr size_t WS_Q = 184 * MiB;
constexpr size_t WS_KCR = 216 * MiB;
constexpr size_t WS_VCR = 225 * MiB;
constexpr size_t WS_KS = 234 * MiB, WS_VS = 242 * MiB, WS_KW = 250 * MiB, WS_VW = 258 * MiB;
constexpr size_t WS_VST = 266 * MiB, WS_VWT = 274 * MiB;
constexpr size_t WS_PL = 282 * MiB;
constexpr size_t WS_YA = 314 * MiB;
constexpr size_t WS_GM = 346 * MiB;
constexpr size_t WS_MIX = WS_ZP;
constexpr size_t WS_QV = WS_GM;
constexpr size_t WS_EID = WS_PL;
constexpr size_t WS_GW = WS_PL + 16 * MiB;
constexpr size_t WS_PART = WS_GM;
constexpr size_t WS_CF = WS_YA;
constexpr size_t WS_CFS = WS_YA + 8 * MiB;
constexpr size_t WS_H8 = WS_ZP;
constexpr size_t WS_HS = WS_ZP + 32 * MiB;
constexpr size_t WS_END = 474 * MiB;
constexpr int CW_TMO = 0, CW_CODE = 1, CW_BAR = 4096;

constexpr int RING_OFF = 0, RING_BYTES = 131072;
constexpr int LDSCTL_OFF = RING_BYTES, MISC_OFF = LDSCTL_OFF + 320;
constexpr int LDS_BYTES = 147456;

#define GAS __attribute__((address_space(1)))
#define LAS __attribute__((address_space(3)))
typedef unsigned short bf16;
typedef unsigned v4u __attribute__((ext_vector_type(4)));
typedef unsigned v2u __attribute__((ext_vector_type(2)));
typedef int v2i __attribute__((ext_vector_type(2)));
typedef float f32x4 __attribute__((ext_vector_type(4)));
typedef short bf16x8 __attribute__((ext_vector_type(8)));
typedef GAS unsigned gu32;
#define RLX_AGENT __ATOMIC_RELAXED, __HIP_MEMORY_SCOPE_AGENT
#define LDS_WAIT() asm volatile("s_waitcnt lgkmcnt(0)" ::: "memory")
#define VM_WAIT() asm volatile("s_waitcnt vmcnt(0)" ::: "memory")
__device__ __forceinline__ unsigned f2bf(float f) { unsigned u = __builtin_bit_cast(unsigned, f); return (u + 0x7fffu + ((u >> 16) & 1u)) >> 16; }
__device__ __forceinline__ unsigned pk2(float lo, float hi) { return f2bf(lo) | (f2bf(hi) << 16); }
__device__ __forceinline__ float bflo(unsigned w) { return __builtin_bit_cast(float, w << 16); }
__device__ __forceinline__ float bfhi(unsigned w) { return __builtin_bit_cast(float, w & 0xffff0000u); }
__device__ __forceinline__ float sigmoidf_(float v) { return __builtin_amdgcn_rcpf(1.0f + __builtin_amdgcn_exp2f(v * -1.4426950408889634f)); }
typedef __bf16 bf16x2_hw __attribute__((ext_vector_type(2)));
typedef float f32x2_hw __attribute__((ext_vector_type(2)));
__device__ __forceinline__ unsigned pkh(float lo, float hi) { return __builtin_bit_cast(unsigned, __builtin_convertvector((f32x2_hw){lo, hi}, bf16x2_hw)); }
__device__ __forceinline__ float gelu_tanh_safe(float v) { const float u = 0.7978845608028654f * (v + 0.044715f * v * v * v); return 0.5f * v * (1.0f + tanhf(u)); }
template <int CTRL> __device__ __forceinline__ float dppf(float v) { return __builtin_bit_cast(float, __builtin_amdgcn_update_dpp(0, __builtin_bit_cast(int, v), CTRL, 0xF, 0xF, true)); }
template <int CTRL> __device__ __forceinline__ int dppi(int v) { return __builtin_amdgcn_update_dpp(0, v, CTRL, 0xF, 0xF, true); }
#define DPP_XOR1 0xB1
#define DPP_XOR2 0x4E
#define DPP_HMIR 0x141
#define DPP_ROR8 0x128
__device__ __forceinline__ void swap16_(float& a, float& b) { asm volatile("v_nop\n\tv_nop\n\tv_permlane16_swap_b32 %0, %1" : "+v"(a), "+v"(b)); }
__device__ __forceinline__ void swap32_(float& a, float& b) { asm volatile("v_nop\n\tv_nop\n\tv_permlane32_swap_b32 %0, %1" : "+v"(a), "+v"(b)); }
__device__ __forceinline__ float sum_xor16(float v) { float a = v, b = v; swap16_(a, b); return a + b; }
__device__ __forceinline__ float sum_xor32(float v) { float a = v, b = v; swap32_(a, b); return a + b; }
__device__ __forceinline__ float max_xor16(float v) { float a = v, b = v; swap16_(a, b); return fmaxf(a, b); }
__device__ __forceinline__ float max_xor32(float v) { float a = v, b = v; swap32_(a, b); return fmaxf(a, b); }
__device__ __forceinline__ float wave_sum(float v) {
    v += dppf<DPP_XOR1>(v); v += dppf<DPP_XOR2>(v); v += dppf<DPP_HMIR>(v); v += dppf<DPP_ROR8>(v);
    return sum_xor32(sum_xor16(v));
}
__device__ __forceinline__ float wave_max(float v) {
    v = fmaxf(v, dppf<DPP_XOR1>(v)); v = fmaxf(v, dppf<DPP_XOR2>(v)); v = fmaxf(v, dppf<DPP_HMIR>(v)); v = fmaxf(v, dppf<DPP_ROR8>(v));
    return max_xor32(max_xor16(v));
}

#define XB_TMO      128
#define XB_XCNT(j)  (256  + 64 * (j))
#define XB_XSUB(j)  (1280 + 64 * (j))
#define XB_XGEN(j)  (2304 + 64 * (j))
#define XB_TOP      3328
#define XB_TOPGEN   3392
#define XCD_BAR_WORDS 3456
#define XB_SPIN_CAP (1u << 18)
__device__ __forceinline__ unsigned xb_ld(unsigned* p)              { return __hip_atomic_load(p, __ATOMIC_RELAXED, __HIP_MEMORY_SCOPE_AGENT); }
__device__ __forceinline__ unsigned xb_add(unsigned* p, unsigned v) { return __hip_atomic_fetch_add(p, v, __ATOMIC_RELAXED, __HIP_MEMORY_SCOPE_AGENT); }
__device__ __forceinline__ unsigned xb_xcc_id() { return (unsigned)__builtin_amdgcn_s_getreg((3 << 11) | 20) & 0xFu; }
#define XB_SPIN(cond, bar) do { unsigned _sp = 0; while (cond) { __builtin_amdgcn_s_sleep(1); \
    if ((++_sp & 255u) == 0u) { if (xb_ld(&(bar)[XB_TMO])) break; if (_sp > XB_SPIN_CAP) { atomicAdd(&(bar)[XB_TMO], 1u); break; } } } } while (0)
struct XcdBarrier { unsigned* bar; unsigned x; volatile LAS unsigned* st; };
__device__ __forceinline__ XcdBarrier xcd_barrier_post(unsigned* bar, volatile LAS unsigned* st) {
    XcdBarrier b; b.bar = bar; b.x = xb_xcc_id(); b.st = st;
    if (threadIdx.x == 0) (void)xb_add(&bar[XB_XCNT(b.x)], 1u);
    return b;
}
__device__ __forceinline__ void xcd_barrier_complete(unsigned* bar, unsigned x, unsigned& nloc, unsigned& nx) {
    const unsigned G = gridDim.x * gridDim.y * gridDim.z;
    unsigned sum, cnt, mine, sp = 0u;
    for (;;) {
        sum = 0u; cnt = 0u; mine = 0u;
#pragma unroll
        for (unsigned j = 0; j < 16; ++j) { const unsigned c = xb_ld(&bar[XB_XCNT(j)]); sum += c; cnt += (c > 0u) ? 1u : 0u; mine = (j == x) ? c : mine; }
        if (sum == G) break;
        __builtin_amdgcn_s_sleep(1);
        if ((++sp & 255u) == 0u) { if (xb_ld(&bar[XB_TMO])) break; if (sp > XB_SPIN_CAP) { atomicAdd(&bar[XB_TMO], 1u); break; } }
    }
    nloc = mine > 0u ? mine : 1u; nx = cnt > 0u ? cnt : 1u;
}
__device__ __forceinline__ void xcd_barrier(const XcdBarrier& b) {
    asm volatile("s_waitcnt vmcnt(0)" ::: "memory");
    __syncthreads();
    if (threadIdx.x == 0) {
        unsigned* bar = b.bar;
        __builtin_amdgcn_s_waitcnt(0);
        unsigned nloc = b.st[0], nx = b.st[1];
        if (nloc == 0u) { xcd_barrier_complete(bar, b.x, nloc, nx); b.st[0] = nloc; b.st[1] = nx; }
        const unsigned old = xb_add(&bar[XB_XSUB(b.x)], 1u);
        const unsigned gen = old / nloc;
        if (old + 1u == (gen + 1u) * nloc) {
            __builtin_amdgcn_fence(__ATOMIC_RELEASE, "agent");
            asm volatile("s_waitcnt vmcnt(0)" ::: "memory");
            const unsigned og = xb_add(&bar[XB_TOP], 1u);
            const unsigned tg = og / nx;
            if (og + 1u == (tg + 1u) * nx) xb_add(&bar[XB_TOPGEN], 1u);
            else XB_SPIN(xb_ld(&bar[XB_TOPGEN]) == tg, bar);
            __builtin_amdgcn_fence(__ATOMIC_ACQUIRE, "agent");
            xb_add(&bar[XB_XGEN(b.x)], 1u);
            asm volatile("s_waitcnt vmcnt(0)" ::: "memory");
        } else {
            XB_SPIN(xb_ld(&bar[XB_XGEN(b.x)]) == gen, bar);
            __builtin_amdgcn_fence(__ATOMIC_ACQUIRE, "agent");
            asm volatile("s_waitcnt vmcnt(0)" ::: "memory");
        }
    }
    __syncthreads();
}

struct Args { const float* in[N_IN]; float* out; unsigned char* ws; int ph_lo, ph_hi, li, pad; };
struct Frame {
    LAS unsigned char* lds;
    volatile LAS unsigned* MISC;
    gu32* ctl;
    int tid, lane, wave, G, bid;
    unsigned char* ws;
};

template <bool I8> __device__ __forceinline__ void cvt_row_store(const f32x4 (&v)[4], int row, unsigned char* dst, float* inv_scale, int lane) {
    float m = 0.f;
#pragma unroll
    for (int j = 0; j < 4; ++j) m = fmaxf(m, fmaxf(fmaxf(fabsf(v[j].x), fabsf(v[j].y)), fmaxf(fabsf(v[j].z), fabsf(v[j].w))));
    m = wave_max(m);
    unsigned ww[4]; float isc;
    if (I8) { const float sc = m > 0.f ? 127.0f / m : 0.f; isc = m * (1.0f / 127.0f);
#pragma unroll
        for (int j = 0; j < 4; ++j) { const int q0 = (int)rintf(v[j].x * sc), q1 = (int)rintf(v[j].y * sc), q2 = (int)rintf(v[j].z * sc), q3 = (int)rintf(v[j].w * sc);
            ww[j] = ((unsigned)q0 & 0xffu) | (((unsigned)q1 & 0xffu) << 8) | (((unsigned)q2 & 0xffu) << 16) | (((unsigned)q3 & 0xffu) << 24); } }
    else { const unsigned E = (__builtin_bit_cast(unsigned, m) >> 23) & 0xffu; float sc = 1.f; isc = 1.f;
        if (E >= 8u && E <= 250u) { sc = __builtin_bit_cast(float, (261u - E) << 23); isc = __builtin_bit_cast(float, (E - 7u) << 23); }
#pragma unroll
        for (int j = 0; j < 4; ++j) { int t = __builtin_amdgcn_cvt_pk_fp8_f32(v[j].x * sc, v[j].y * sc, 0, false); t = __builtin_amdgcn_cvt_pk_fp8_f32(v[j].z * sc, v[j].w * sc, t, true); ww[j] = (unsigned)t; } }
    *(GAS v4u*)(dst + (size_t)(lane >> 3) * NEXP * 128 + (size_t)row * 128 + 16 * (lane & 7)) = (v4u){ww[0], ww[1], ww[2], ww[3]};
    if (lane == 0) inv_scale[row] = isc;
}
template <bool I8> __device__ __forceinline__ void cvt_rows_8bit(const float* src, unsigned char* dst, float* inv_scale, int gw, int NGW, int lane) {
    for (int row = gw; row < NEXP; row += 2 * NGW) {
        const int row1 = row + NGW; const bool has1 = row1 < NEXP;
        f32x4 v0[4], v1[4];
#pragma unroll
        for (int j = 0; j < 4; ++j) v0[j] = *(const GAS f32x4*)(src + (size_t)row * D + 16 * lane + 4 * j);
#pragma unroll
        for (int j = 0; j < 4; ++j) v1[j] = has1 ? *(const GAS f32x4*)(src + (size_t)row1 * D + 16 * lane + 4 * j) : (f32x4){0.f, 0.f, 0.f, 0.f};
        cvt_row_store<I8>(v0, row, dst, inv_scale, lane);
        if (has1) cvt_row_store<I8>(v1, row1, dst, inv_scale, lane);
    }
}
__device__ __forceinline__ void p0_transpose_item(const float* W, int ldw, int src_col0, int valid, int K, bf16* WT, int dst_row0, int k0, LAS float* scr, int lane) {
    const int n_ = lane & 31;
#pragma unroll 8
    for (int i = 0; i < 32; ++i) { const int kk = 2 * i + (lane >> 5); scr[kk * 33 + n_] = (n_ < valid) ? W[(size_t)(k0 + kk) * ldw + src_col0 + n_] : 0.f; }
    LDS_WAIT(); asm volatile("" ::: "memory");
    const int c = lane & 7;
#pragma unroll
    for (int j = 0; j < 4; ++j) { const int n = (lane >> 3) + 8 * j; const LAS float* s = scr + (8 * c) * 33 + n;
        v4u o; o.x = pk2(s[0 * 33], s[1 * 33]); o.y = pk2(s[2 * 33], s[3 * 33]); o.z = pk2(s[4 * 33], s[5 * 33]); o.w = pk2(s[6 * 33], s[7 * 33]);
        *(GAS v4u*)(WT + (size_t)(dst_row0 + n) * K + k0 + 8 * c) = o; }
    LDS_WAIT(); asm volatile("" ::: "memory");
}
__device__ __forceinline__ bool p0_mat(int& r, const float* W, int K, int N, bf16* WT, LAS float* scr, int lane) {
    const int ng = N / 32, items = ng * (K / 64);
    if (r < items) { const int kb = r / ng, nb = r % ng; p0_transpose_item(W, N, 32 * nb, 32, K, WT, 32 * nb, 64 * kb, scr, lane); return true; }
    r -= items; return false;
}
__device__ __forceinline__ void cvt_f32_bf16_stream(const float* src, bf16* dst, size_t n8, size_t gtid, size_t gthreads) {
    for (size_t i = gtid; i < n8; i += gthreads) {
        const f32x4 a = *(const GAS f32x4*)(src + 8 * i), b = *(const GAS f32x4*)(src + 8 * i + 4);
        v4u o; o.x = pk2(a.x, a.y); o.y = pk2(a.z, a.w); o.z = pk2(b.x, b.y); o.w = pk2(b.z, b.w);
        *(GAS v4u*)(dst + 8 * i) = o; }
}

__device__ __forceinline__ void p0_prologue(Frame& F, const Args& args, bool do_bias = true) {
    unsigned char* ws = F.ws;
    const int gw = F.bid * NWAVES + F.wave, NGW = F.G * NWAVES;
    const size_t gtid = (size_t)F.bid * NTHREADS + F.tid, gthreads = (size_t)F.G * NTHREADS;
    {
        LAS float* sl = (LAS float*)(F.lds);
        LAS float* red = (LAS float*)(F.lds + 32768);
        const float* c = args.in[I_C];
        { f32x4 cv[4];
#pragma unroll
          for (int q = 0; q < 4; ++q) cv[q] = *(const GAS f32x4*)(c + 4 * (F.tid + NTHREADS * q));
#pragma unroll
          for (int q = 0; q < 4; ++q) { f32x4 o; o.x = cv[q].x / (1.0f + __expf(-cv[q].x)); o.y = cv[q].y / (1.0f + __expf(-cv[q].y)); o.z = cv[q].z / (1.0f + __expf(-cv[q].z)); o.w = cv[q].w / (1.0f + __expf(-cv[q].w));
              *(LAS f32x4*)(sl + 4 * (F.tid + NTHREADS * q)) = o; } }
        __syncthreads();
        for (int cb = F.bid; cb < 6 * D / 24; cb += F.G) {
            const int j0 = cb * 24;
            if (F.tid < 510) {
                const int kk = F.tid / 6, c4 = F.tid % 6;
                const float* w = args.in[I_ADAW] + j0 + 4 * c4;
                f32x4 wv[13];
#pragma unroll
                for (int m = 0; m < 13; ++m) { const int k = kk + 85 * m; wv[m] = (k < D) ? *(const GAS f32x4*)(w + (size_t)k * (6 * D)) : (f32x4){0.f, 0.f, 0.f, 0.f}; }
                f32x4 a[BATCH];
#pragma unroll
                for (int b = 0; b < BATCH; ++b) a[b] = (f32x4){0.f, 0.f, 0.f, 0.f};
#pragma unroll
                for (int m = 0; m < 13; ++m) { const int k = kk + 85 * m; const int kc = k < D ? k : 0;
#pragma unroll
                    for (int b = 0; b < BATCH; ++b) a[b] = a[b] + wv[m] * sl[b * D + kc]; }
#pragma unroll
                for (int b = 0; b < BATCH; ++b) { LAS float* rp = red + (kk * 24 + 4 * c4) * BATCH + b; rp[0] = a[b].x; rp[BATCH] = a[b].y; rp[2 * BATCH] = a[b].z; rp[3 * BATCH] = a[b].w; }
            }
            __syncthreads();
            if (F.tid < 24 * BATCH) { const int jj = F.tid / BATCH, b = F.tid % BATCH; float s = 0.f;
#pragma unroll 5
                for (int kk = 0; kk < 85; ++kk) s += red[(kk * 24 + jj) * BATCH + b];
                ((float*)(ws + WS_ADA))[b * (6 * D) + j0 + jj] = s + args.in[I_ADAB][j0 + jj]; }
            __syncthreads();
        }
    }
    if (F.bid >= 8 && F.bid < 40 && do_bias) {
        const int bb = F.bid - 8, kv = bb & 1, ch = bb >> 1;
        const float* pe = args.in[kv == 0 ? I_CPEK : I_CPEV]; const float* w1 = args.in[kv == 0 ? I_CW1K : I_CW1V];
        LAS float* red = (LAS float*)(F.lds);
        const int j = F.tid & 127, ic = F.tid >> 7; float s = 0.f;
        const int i0 = ch * 128 + ic * 32;
#pragma unroll 8
        for (int i = i0; i < i0 + 32; ++i) s += pe[i] * w1[(size_t)i * 128 + j];
        red[ic * 128 + j] = s; __syncthreads();
        if (F.tid < 128) atomicAdd((float*)(ws + (kv == 0 ? WS_CB1K : WS_CB1V)) + F.tid, (red[F.tid] + red[128 + F.tid]) + (red[256 + F.tid] + red[384 + F.tid]));
        __syncthreads();
    } else if (F.bid == 2) {
        for (int i = F.tid; i < 8 * 128; i += NTHREADS) { const int h = i >> 7, rel = i & 127;
            int bk = rel;
            if (rel >= 16) bk = 16 + (rel >= 19) + (rel >= 21) + (rel >= 24) + (rel >= 27) + (rel >= 31) + (rel >= 35) + (rel >= 40) + (rel >= 46) + (rel >= 52) + (rel >= 59) + (rel >= 67) + (rel >= 77) + (rel >= 87) + (rel >= 99) + (rel >= 113);
            ((float*)(ws + WS_BIASL))[i] = args.in[I_RELB][bk * 8 + h]; }
        if (F.tid < 64) {
            float mq = fabsf(args.in[I_QNG][F.tid]), mk = fmaxf(fmaxf(fabsf(args.in[I_KNG][F.tid]), fabsf(args.in[I_KNG][64 + F.tid])), fabsf(args.in[I_KNG][128 + F.tid]));
            float mb = fmaxf(fmaxf(fabsf(args.in[I_RELB][F.tid]), fabsf(args.in[I_RELB][64 + F.tid])), fmaxf(fabsf(args.in[I_RELB][128 + F.tid]), fabsf(args.in[I_RELB][192 + F.tid])));
            mq = wave_max(mq); mk = wave_max(mk); mb = wave_max(mb);
            if (F.tid == 0) ((float*)(ws + WS_BIASL))[8 * 128] = 8.0f * mq * mk + mb; }
    }
    {
        LAS float* scr = (LAS float*)(F.lds + F.wave * 16384);
        constexpr int I_WINT = (NIN / 32) * (D / 64);
        constexpr int NITEMS = I_WINT + (1024 / 32) * (512 / 64) + (1024 / 32) * (1024 / 64) + (2048 / 32) * (1024 / 64) + 2 * (128 / 32) * (2048 / 64) + 2 * (64 / 32) * (128 / 64);
        for (int it = gw; it < NITEMS; it += NGW) {
            int r = it;
            if (r < I_WINT) {
                const int grp = r % (NIN / 32), kb = r / (NIN / 32);
                const int tile = grp >> 3, ct0 = (grp & 7) * 32;
                const int L0 = 64 * ((ct0 >> 5) & 3) + 32 * (ct0 >> 7);
                int src0, valid = 32;
                if (tile < 7) src0 = 256 * tile + L0; else if (tile < 15) src0 = 1816 + 256 * (tile - 7) + L0; else { src0 = 1792 + L0; valid = (L0 == 0) ? 24 : 0; }
                if (valid == 0) src0 = 0;
                p0_transpose_item(args.in[I_WIN], IN_COLS, src0, valid, D, (bf16*)(ws + WS_WIN_T), 32 * grp, 64 * kb, scr, F.lane);
                continue; }
            r -= I_WINT;
            if (p0_mat(r, args.in[I_WBA], 512, 1024, (bf16*)(ws + WS_WBA_T), scr, F.lane)) continue;
            if (p0_mat(r, args.in[I_WOUT], 1024, 1024, (bf16*)(ws + WS_WOUT_T), scr, F.lane)) continue;
            if (p0_mat(r, args.in[I_PWQ], 1024, 2048, (bf16*)(ws + WS_WQ_T), scr, F.lane)) continue;
            if (p0_mat(r, args.in[I_CW1K], 2048, 128, (bf16*)(ws + WS_CW1K_T), scr, F.lane)) continue;
            if (p0_mat(r, args.in[I_CW1V], 2048, 128, (bf16*)(ws + WS_CW1V_T), scr, F.lane)) continue;
            if (p0_mat(r, args.in[I_CW2K], 128, 64, (bf16*)(ws + WS_CW2K_T), scr, F.lane)) continue;
            p0_mat(r, args.in[I_CW2V], 128, 64, (bf16*)(ws + WS_CW2V_T), scr, F.lane);
        }
    }
    {
        const float* pw = args.in[I_POOLW]; const float* ps = args.in[I_POOLS]; const float* wbp = args.in[I_WBP];
        bf16* weff = (bf16*)(ws + WS_WEFF_T);
        LAS float* PWl = (LAS float*)(F.lds);
        LAS float* WBl = (LAS float*)(F.lds + 128 * 129 * 4);
        __syncthreads();
        for (int bb = F.bid; bb < 256; bb += F.G) {
            const int g = bb >> 6, d0 = (bb & 63) * 16;
            { f32x4 t[8];
#pragma unroll
              for (int q = 0; q < 8; ++q) t[q] = *(const GAS f32x4*)(pw + (size_t)g * 16384 + 4 * (F.tid + NTHREADS * q));
#pragma unroll
              for (int q = 0; q < 8; ++q) { const int i = 4 * (F.tid + NTHREADS * q); LAS float* d = PWl + (i >> 7) * 129 + (i & 127); d[0] = t[q].x; d[1] = t[q].y; d[2] = t[q].z; d[3] = t[q].w; }
              const int cc = F.tid >> 2, d4 = (F.tid & 3) * 4;
              const f32x4 wv = *(const GAS f32x4*)(wbp + (size_t)(g * 128 + cc) * D + d0 + d4); const float pv = ps[g * 128 + cc];
              LAS float* d = WBl + cc * 17 + d4; d[0] = wv.x * pv; d[1] = wv.y * pv; d[2] = wv.z * pv; d[3] = wv.w * pv; }
            __syncthreads();
            const int c = F.tid & 127, q = F.tid >> 7;
            float acc4[4] = {0.f, 0.f, 0.f, 0.f};
#pragma unroll 4
            for (int cc = 0; cc < 128; ++cc) { const float a = PWl[c * 129 + cc];
#pragma unroll
                for (int e = 0; e < 4; ++e) acc4[e] += a * WBl[cc * 17 + 4 * q + e]; }
#pragma unroll
            for (int e = 0; e < 4; ++e) weff[(size_t)(d0 + 4 * q + e) * POOLW + g * 128 + c] = (bf16)f2bf(acc4[e]);
            __syncthreads();
        }
    }
    cvt_f32_bf16_stream(args.in[I_PSK], (bf16*)(ws + WS_SUBK), (size_t)16 * 128 * 128 / 8, gtid, gthreads);
    cvt_rows_8bit<true>(args.in[I_PU], ws + WS_UB, (float*)(ws + WS_SCLU), gw, NGW, F.lane);
    cvt_rows_8bit<false>(args.in[I_PV], ws + WS_VB, (float*)(ws + WS_SCLV), gw, NGW, F.lane);
}

template <bool Q8> __device__ __forceinline__ void modnorm_rows(Frame& F, const float* x, const float* g, const float* ada, int shift_idx, bf16* out) {
    const int gw = F.bid * NWAVES + F.wave, NGW = F.G * NWAVES;
    for (int m = gw; m < M; m += NGW) {
        const int b = m >> 12;
        const GAS f32x4* xr = (const GAS f32x4*)(x + (size_t)m * D) + F.lane;
        const GAS f32x4* gr = (const GAS f32x4*)g + F.lane;
        const GAS f32x4* sh = (const GAS f32x4*)(ada + (size_t)b * 6 * D + shift_idx * D) + F.lane;
        const GAS f32x4* sc = (const GAS f32x4*)(ada + (size_t)b * 6 * D + (shift_idx + 1) * D) + F.lane;
        f32x4 v[4]; float s = 0.f;
#pragma unroll
        for (int j = 0; j < 4; ++j) { v[j] = xr[64 * j]; s += (v[j].x * v[j].x + v[j].y * v[j].y) + (v[j].z * v[j].z + v[j].w * v[j].w); }
        const float rstd = rsqrtf(wave_sum(s) * (1.f / D) + EPS);
        GAS v2u* o8 = (GAS v2u*)(out + (size_t)m * D) + F.lane;
        float mx = 0.f;
#pragma unroll
        for (int j = 0; j < 4; ++j) { const f32x4 gg = gr[64 * j], ss = sh[64 * j], cc = sc[64 * j];
            const f32x4 y = (v[j] * rstd) * gg * (cc + 1.0f) + ss; v[j] = y;
            mx = fmaxf(mx, fmaxf(fmaxf(fabsf(y.x), fabsf(y.y)), fmaxf(fabsf(y.z), fabsf(y.w))));
            v2u o; o.x = pk2(y.x, y.y); o.y = pk2(y.z, y.w); o8[64 * j] = o; }
        if (Q8) {
            mx = wave_max(mx);
            const float qs = mx > 0.f ? 127.0f / mx : 0.f;
            GAS unsigned* h8 = (GAS unsigned*)(F.ws + WS_H8 + (size_t)m * D) + F.lane;
#pragma unroll
            for (int j = 0; j < 4; ++j) { const int q0 = (int)rintf(v[j].x * qs), q1 = (int)rintf(v[j].y * qs), q2 = (int)rintf(v[j].z * qs), q3 = (int)rintf(v[j].w * qs);
                h8[64 * j] = ((unsigned)q0 & 0xffu) | (((unsigned)q1 & 0xffu) << 8) | (((unsigned)q2 & 0xffu) << 16) | (((unsigned)q3 & 0xffu) << 24); }
            if (F.lane == 0) ((float*)(F.ws + WS_HS))[m] = mx * (1.0f / 127.0f);
        }
    }
}

struct EpiIn {
    static constexpr bool PERM = true, AFTER_DRAIN = false;
    unsigned char* ws; const float* qg; const float* kg;
    __device__ __forceinline__ void operator()(const pg8::f32x4 (&acc)[2][2][4][2], const pg8::Unit& u, int wr, int wc, int fr, int fq) const {
        const int pn = u.pn;
#pragma unroll
        for (int ai = 0; ai < 2; ++ai)
#pragma unroll
            for (int m = 0; m < 4; ++m) {
                const int row = u.pm * 256 + ai * 128 + wr * 64 + m * 16 + fr;
                float v[2][8];
#pragma unroll
                for (int bj = 0; bj < 2; ++bj)
#pragma unroll
                    for (int n = 0; n < 2; ++n)
#pragma unroll
                        for (int i = 0; i < 4; ++i) v[bj][4 * n + i] = acc[ai][bj][m][n][i];
                bf16* dst = nullptr; bool norm = false; const float* gain = nullptr; float mul = 1.f; bool sig = false;
                if (pn < 2) { dst = (bf16*)(ws + WS_ZP) + (size_t)row * 512 + 256 * pn + 64 * wc; }
                else if (pn < 4) { dst = (bf16*)(ws + WS_Q) + (size_t)row * 512 + 256 * (pn - 2) + 64 * wc; norm = true; gain = qg; mul = 0.125f * 1.4426950408889634f; }
                else if (pn < 7) { const int kind = pn - 4, isv = wc >> 1, g = wc & 1, b = row >> 12, t = row & 4095;
                    const size_t base = ((size_t)(b * 2 + g) * SEQ + t) * 64;
                    const size_t off = kind == 0 ? (isv ? WS_VCR : WS_KCR) : kind == 1 ? (isv ? WS_VS : WS_KS) : (isv ? WS_VW : WS_KW);
                    dst = (bf16*)(ws + off) + base; if (!isv && kind > 0) { norm = true; gain = kg + kind * 64; } }
                else if (pn < 15) { dst = (bf16*)(ws + WS_GM) + (size_t)row * 2048 + 256 * (pn - 7) + 64 * wc; sig = true; }
                else {
                    if (wc == 0 && fq < 3) { float* gp = (float*)(ws + WS_GATE) + (size_t)row * 24 + 8 * fq;
                        *(GAS f32x4*)gp = (f32x4){sigmoidf_(v[0][0]), sigmoidf_(v[0][1]), sigmoidf_(v[0][2]), sigmoidf_(v[0][3])};
                        *(GAS f32x4*)(gp + 4) = (f32x4){sigmoidf_(v[0][4]), sigmoidf_(v[0][5]), sigmoidf_(v[0][6]), sigmoidf_(v[0][7])}; }
                    continue; }
                if (norm) { float ss = 0.f;
#pragma unroll
                    for (int bj = 0; bj < 2; ++bj)
#pragma unroll
                        for (int e = 0; e < 8; ++e) ss += v[bj][e] * v[bj][e];
                    ss = sum_xor32(sum_xor16(ss));
                    const float rs = rsqrtf(ss * (1.f / 64.f) + EPS) * mul;
#pragma unroll
                    for (int bj = 0; bj < 2; ++bj)
#pragma unroll
                        for (int e = 0; e < 8; ++e) v[bj][e] = v[bj][e] * rs * gain[32 * bj + 8 * fq + e]; }
                if (sig) {
#pragma unroll
                    for (int bj = 0; bj < 2; ++bj)
#pragma unroll
                        for (int e = 0; e < 8; ++e) v[bj][e] = sigmoidf_(v[bj][e]); }
#pragma unroll
                for (int bj = 0; bj < 2; ++bj) { v4u o; o.x = pkh(v[bj][0], v[bj][1]); o.y = pkh(v[bj][2], v[bj][3]); o.z = pkh(v[bj][4], v[bj][5]); o.w = pkh(v[bj][6], v[bj][7]);
                    *(GAS v4u*)(dst + 32 * bj + 8 * fq) = o; }
            }
    }
};
template <bool ADD> struct EpiMix {
    static constexpr bool PERM = true, AFTER_DRAIN = false;
    bf16* MIX; const bf16* GM; int gmoff;
    __device__ __forceinline__ void operator()(const pg8::f32x4 (&acc)[2][2][4][2], const pg8::Unit& u, int wr, int wc, int fr, int fq) const {
#pragma unroll
        for (int ai = 0; ai < 2; ++ai)
#pragma unroll
            for (int m = 0; m < 4; ++m) {
                const int row = u.pm * 256 + ai * 128 + wr * 64 + m * 16 + fr;
#pragma unroll
                for (int bj = 0; bj < 2; ++bj) {
                    const int col = u.pn * 256 + bj * 128 + wc * 32 + 8 * fq;
                    const v4u gmv = *(const GAS v4u*)(GM + (size_t)row * 2048 + gmoff + col);
                    float r[8];
                    r[0] = acc[ai][bj][m][0][0] * bflo(gmv.x); r[1] = acc[ai][bj][m][0][1] * bfhi(gmv.x); r[2] = acc[ai][bj][m][0][2] * bflo(gmv.y); r[3] = acc[ai][bj][m][0][3] * bfhi(gmv.y);
                    r[4] = acc[ai][bj][m][1][0] * bflo(gmv.z); r[5] = acc[ai][bj][m][1][1] * bfhi(gmv.z); r[6] = acc[ai][bj][m][1][2] * bflo(gmv.w); r[7] = acc[ai][bj][m][1][3] * bfhi(gmv.w);
                    GAS v4u* dp = (GAS v4u*)(MIX + (size_t)row * 1024 + col);
                    if (ADD) { const v4u old = *dp; r[0] += bflo(old.x); r[1] += bfhi(old.x); r[2] += bflo(old.y); r[3] += bfhi(old.y); r[4] += bflo(old.z); r[5] += bfhi(old.z); r[6] += bflo(old.w); r[7] += bfhi(old.w); }
                    v4u o; o.x = pkh(r[0], r[1]); o.y = pkh(r[2], r[3]); o.z = pkh(r[4], r[5]); o.w = pkh(r[6], r[7]); *dp = o; }
            }
    }
};
struct EpiRes {
    static constexpr bool PERM = false, AFTER_DRAIN = false;
    const float* x; float* out; const float* ada; int gate_idx;
    __device__ __forceinline__ void operator()(const pg8::f32x4 (&acc)[2][2][4][2], const pg8::Unit& u, int wr, int wc, int fr, int fq) const {
#pragma unroll
        for (int ai = 0; ai < 2; ++ai)
#pragma unroll
            for (int m = 0; m < 4; ++m) {
                const int row = u.pm * 256 + ai * 128 + wr * 64 + m * 16 + fr, b = row >> 12;
#pragma unroll
                for (int bj = 0; bj < 2; ++bj)
#pragma unroll
                    for (int n = 0; n < 2; ++n) {
                        const int col = u.pn * 256 + bj * 128 + wc * 32 + 16 * n + 4 * fq;
                        const f32x4 gt = *(const GAS f32x4*)(ada + (size_t)b * 6 * D + gate_idx * D + col);
                        const f32x4 xv = *(const GAS f32x4*)(x + (size_t)row * D + col);
                        *(GAS f32x4*)(out + (size_t)row * D + col) = xv + gt * acc[ai][bj][m][n]; }
            }
    }
};

template <int W> __device__ __forceinline__ void pool_item(const bf16* zp, bf16* pl, int row, int col) {
    const int t = row & 4095;
    float s[8], self[8];
#pragma unroll
    for (int e = 0; e < 8; ++e) { s[e] = 0.f; self[e] = 0.f; }
    v4u z[W];
#pragma unroll
    for (int j = 0; j < W; ++j) z[j] = (j <= t) ? *(const GAS v4u*)(zp + (size_t)(row - j) * 512 + col) : (v4u){0u, 0u, 0u, 0u};
#pragma unroll
    for (int j = 0; j < W; ++j) { const float f[8] = {bflo(z[j].x), bfhi(z[j].x), bflo(z[j].y), bfhi(z[j].y), bflo(z[j].z), bfhi(z[j].z), bflo(z[j].w), bfhi(z[j].w)};
#pragma unroll
        for (int e = 0; e < 8; ++e) { s[e] += f[e]; if (j == 0) self[e] = f[e]; } }
    const float inv = 1.0f / (float)((t + 1 < W) ? (t + 1) : W);
    v4u o; o.x = pk2(s[0] * inv - self[0], s[1] * inv - self[1]); o.y = pk2(s[2] * inv - self[2], s[3] * inv - self[3]);
    o.z = pk2(s[4] * inv - self[4], s[5] * inv - self[5]); o.w = pk2(s[6] * inv - self[6], s[7] * inv - self[7]);
    *(GAS v4u*)(pl + (size_t)row * 512 + col) = o;
}
__device__ __forceinline__ void pool_phase(Frame& F) {
    const bf16* zp = (const bf16*)(F.ws + WS_ZP); bf16* pl = (bf16*)(F.ws + WS_PL);
    const int gw = F.bid * NWAVES + F.wave, NGW = F.G * NWAVES;
    for (int item = gw; item < 4 * (M / 4); item += NGW) {
        const int gi = item & 3, r4 = item >> 2, row = 4 * r4 + (F.lane >> 4), col = 128 * gi + 8 * (F.lane & 15);
        if (gi == 0) pool_item<2>(zp, pl, row, col); else if (gi == 1) pool_item<4>(zp, pl, row, col); else if (gi == 2) pool_item<8>(zp, pl, row, col); else pool_item<16>(zp, pl, row, col);
    }
}

typedef int v4i __attribute__((ext_vector_type(4)));
struct EpiStoreBf16 {
    static constexpr bool PERM = true, AFTER_DRAIN = false;
    bf16* O; int ldc;
    __device__ __forceinline__ void operator()(const pg8::f32x4 (&acc)[2][2][4][2], const pg8::Unit& u, int wr, int wc, int fr, int fq) const {
#pragma unroll
        for (int ai = 0; ai < 2; ++ai)
#pragma unroll
            for (int m = 0; m < 4; ++m) {
                const int row = u.pm * 256 + ai * 128 + wr * 64 + m * 16 + fr;
#pragma unroll
                for (int bj = 0; bj < 2; ++bj) {
                    const int col = u.pn * 256 + bj * 128 + wc * 32 + 8 * fq;
                    v4u o; o.x = pkh(acc[ai][bj][m][0][0], acc[ai][bj][m][0][1]); o.y = pkh(acc[ai][bj][m][0][2], acc[ai][bj][m][0][3]);
                    o.z = pkh(acc[ai][bj][m][1][0], acc[ai][bj][m][1][1]); o.w = pkh(acc[ai][bj][m][1][2], acc[ai][bj][m][1][3]);
                    *(GAS v4u*)(O + (size_t)row * ldc + col) = o; }
            }
    }
};

__device__ __forceinline__ unsigned fkey(float f) { const unsigned u = __builtin_bit_cast(unsigned, f); return (u >> 31) ? ~u : (u | 0x80000000u); }
__device__ __forceinline__ float funkey(unsigned k) { const unsigned u = (k >> 31) ? (k & 0x7fffffffu) : ~k; return __builtin_bit_cast(float, u); }
__device__ __forceinline__ unsigned umax_(unsigned a, unsigned b) { return a > b ? a : b; }
__device__ __forceinline__ unsigned umin_(unsigned a, unsigned b) { return a > b ? b : a; }
#define TOP16_INSERT(L, xin) do { unsigned _x = (xin); _Pragma("unroll") for (int _i = 0; _i < 16; ++_i) { const unsigned _h = umax_(L[_i], _x); _x = umin_(L[_i], _x); L[_i] = _h; } } while (0)
template <int MASK> __device__ __forceinline__ void top16_merge(unsigned (&L)[16]) {
    unsigned o[16];
#pragma unroll
    for (int i = 0; i < 16; ++i) o[i] = (unsigned)dppi<MASK == 1 ? DPP_XOR1 : DPP_XOR2>((int)L[i]);
#pragma unroll
    for (int i = 0; i < 16; ++i) L[i] = umax_(L[i], o[15 - i]);
#pragma unroll
    for (int d = 8; d >= 1; d >>= 1)
#pragma unroll
        for (int i = 0; i < 16; ++i) if ((i & d) == 0) { const unsigned hi = umax_(L[i], L[i + d]), lo = umin_(L[i], L[i + d]); L[i] = hi; L[i + d] = lo; }
}
#define CE_DESC(a_, b_) do { const unsigned _h = umax_(a_, b_), _l = umin_(a_, b_); a_ = _h; b_ = _l; } while (0)
template <int OFF> __device__ __forceinline__ void bitonic_sort16_desc(unsigned (&v)[32]) {
#pragma unroll
    for (int k = 2; k <= 16; k <<= 1)
#pragma unroll
        for (int j = k >> 1; j > 0; j >>= 1)
#pragma unroll
            for (int i = 0; i < 16; ++i) { const int l = i ^ j; if (l > i) { if ((i & k) == 0) CE_DESC(v[OFF + i], v[OFF + l]); else CE_DESC(v[OFF + l], v[OFF + i]); } }
}
__device__ __forceinline__ void bitonic_merge16_desc(unsigned (&L)[16]) {
#pragma unroll
    for (int d = 8; d >= 1; d >>= 1)
#pragma unroll
        for (int i = 0; i < 16; ++i) if ((i & d) == 0) CE_DESC(L[i], L[i + d]);
}
constexpr int SST = 132;
constexpr int P9_LIST_OFF = 2 * 64 * SST * 4;
__device__ __forceinline__ void peer_select_phase(Frame& F) {
    const bf16* QV = (const bf16*)(F.ws + WS_QV); const bf16* SK = (const bf16*)(F.ws + WS_SUBK);
    int* EID = (int*)(F.ws + WS_EID); float* GW = (float*)(F.ws + WS_GW);
    LAS float* S = (LAS float*)(F.lds);
    LAS unsigned* LIST = (LAS unsigned*)(F.lds + P9_LIST_OFF);
    const int lane = F.lane, w = F.wave, l15 = lane & 15, lq = lane >> 4;
    const int p = w >> 2, kb = w & 3;
    constexpr int NU = (M / 64) * PH;
    bf16x8 a[4][4], bq[2][4];
#define P9_LOAD(u_) do { const int _tt = (u_) >> 3, _h = (u_) & 7; \
        const bf16* qa = QV + (size_t)(_tt * 64 + l15) * PQW + _h * 256 + p * 128 + 8 * lq; \
        const bf16* kbp = SK + (size_t)((_h * 2 + p) * 128 + 32 * kb + l15) * 128 + 8 * lq; \
        _Pragma("unroll") for (int ks = 0; ks < 4; ++ks) { \
            _Pragma("unroll") for (int rb = 0; rb < 4; ++rb) a[rb][ks] = *(const GAS bf16x8*)(qa + (size_t)(16 * rb) * PQW + 32 * ks); \
            _Pragma("unroll") for (int cb = 0; cb < 2; ++cb) bq[cb][ks] = *(const GAS bf16x8*)(kbp + (size_t)(16 * cb) * 128 + 32 * ks); } } while (0)
    if (F.bid < NU) P9_LOAD(F.bid);
    for (int u = F.bid; u < NU; u += F.G) {
        const int tt = u >> 3, h = u & 7, tok0 = tt * 64;
        {
            pg8::f32x4 acc[4][2];
#pragma unroll
            for (int rb = 0; rb < 4; ++rb)
#pragma unroll
                for (int cb = 0; cb < 2; ++cb) acc[rb][cb] = (pg8::f32x4){0.f, 0.f, 0.f, 0.f};
#pragma unroll
            for (int ks = 0; ks < 4; ++ks)
#pragma unroll
                for (int rb = 0; rb < 4; ++rb)
#pragma unroll
                    for (int cb = 0; cb < 2; ++cb) acc[rb][cb] = __builtin_amdgcn_mfma_f32_16x16x32_bf16(a[rb][ks], bq[cb][ks], acc[rb][cb], 0, 0, 0);
#pragma unroll
            for (int rb = 0; rb < 4; ++rb)
#pragma unroll
                for (int cb = 0; cb < 2; ++cb)
#pragma unroll
                    for (int r = 0; r < 4; ++r) S[(p * 64 + 16 * rb + 4 * lq + r) * SST + 32 * kb + 16 * cb + l15] = acc[rb][cb][r];
        }
        __syncthreads();
        if (u + F.G < NU) P9_LOAD(u + F.G);
        {
            const int row = F.tid >> 2, sub = F.tid & 3;
            const LAS float* sr = S + row * SST + sub;
            unsigned kv[32];
#pragma unroll
            for (int i = 0; i < 32; ++i) kv[i] = (fkey(sr[4 * i]) & ~127u) | (unsigned)(4 * i + sub);
            bitonic_sort16_desc<0>(kv); bitonic_sort16_desc<16>(kv);
            unsigned L[16];
#pragma unroll
            for (int i = 0; i < 16; ++i) L[i] = umax_(kv[i], kv[31 - i]);
            bitonic_merge16_desc(L);
            top16_merge<1>(L); top16_merge<2>(L);
            if (sub == 0) {
#pragma unroll
                for (int i = 0; i < 4; ++i) *(LAS v4u*)(LIST + row * 16 + 4 * i) = (v4u){L[4 * i], L[4 * i + 1], L[4 * i + 2], L[4 * i + 3]}; }
        }
        __syncthreads();
        if (F.tid < 256) {
            const int tok = F.tid >> 2, sub = F.tid & 3;
            float va[16], vb[16];
#pragma unroll
            for (int i = 0; i < 4; ++i) { const v4u x = *(const LAS v4u*)(LIST + tok * 16 + 4 * i), y = *(const LAS v4u*)(LIST + (64 + tok) * 16 + 4 * i);
                va[4 * i] = funkey(x.x & ~127u); va[4 * i + 1] = funkey(x.y & ~127u); va[4 * i + 2] = funkey(x.z & ~127u); va[4 * i + 3] = funkey(x.w & ~127u);
                vb[4 * i] = funkey(y.x & ~127u); vb[4 * i + 1] = funkey(y.y & ~127u); vb[4 * i + 2] = funkey(y.z & ~127u); vb[4 * i + 3] = funkey(y.w & ~127u); }
            unsigned cand[32];
#pragma unroll
            for (int i = 0; i < 32; ++i) cand[i] = 0u;
            {
                constexpr int NC = 50;
                constexpr unsigned char CI[52] = {0,0,0,0,0,0,0,0,0,0,0,0,0,0,0,0, 1,1,1,1,1,1,1,1, 2,2,2,2,2, 3,3,3,3, 4,4,4, 5,5, 6,6, 7,7, 8,9,10,11,12,13,14,15, 0,0};
                constexpr unsigned char CJ[52] = {0,1,2,3,4,5,6,7,8,9,10,11,12,13,14,15, 0,1,2,3,4,5,6,7, 0,1,2,3,4, 0,1,2,3, 0,1,2, 0,1, 0,1, 0,1, 0,0,0,0,0,0,0,0, 0,0};
#pragma unroll
                for (int g4 = 0; g4 < 13; ++g4) {
                    float sa = 0.f, sb = 0.f; unsigned id = 0u; bool ok = false;
#pragma unroll
                    for (int q = 0; q < 4; ++q) { const int n = 4 * g4 + q; if (n < NC) { const bool me = (sub == q); sa = me ? va[CI[n]] : sa; sb = me ? vb[CJ[n]] : sb; id = me ? (unsigned)(CI[n] * 16 + CJ[n]) : id; ok = ok || me; } }
                    cand[g4] = ok ? ((fkey(sa + sb) & ~255u) | id) : 0u;
                }
            }
            bitonic_sort16_desc<0>(cand);
            unsigned L[16];
#pragma unroll
            for (int i = 0; i < 16; ++i) L[i] = cand[i];
            top16_merge<1>(L); top16_merge<2>(L);
            const float mx = funkey(L[0] & ~255u);
            float e[16], sum = 0.f;
#pragma unroll
            for (int k = 0; k < 16; ++k) { e[k] = __expf(funkey(L[k] & ~255u) - mx); sum += e[k]; }
            const float inv = 1.0f / sum;
            const size_t ob = (size_t)(tok0 + tok) * 128;
#pragma unroll
            for (int k4 = 0; k4 < 4; ++k4) if (sub == k4) {
#pragma unroll
                for (int q = 0; q < 4; ++q) { const unsigned cid = L[4 * k4 + q] & 255u;
                    const unsigned ia = LIST[tok * 16 + (cid >> 4)] & 127u, ib = LIST[(64 + tok) * 16 + (cid & 15u)] & 127u;
                    const int slot = h * 16 + 4 * k4 + q;
                    EID[ob + slot] = (int)(ia * 128u + ib); GW[ob + slot] = e[4 * k4 + q] * inv; }
            }
        }
        __syncthreads();
    }
#undef P9_LOAD
}

__device__ __forceinline__ void unpack8(const v4u w, float (&f)[8]) { f[0] = bflo(w.x); f[1] = bfhi(w.x); f[2] = bflo(w.y); f[3] = bfhi(w.y); f[4] = bflo(w.z); f[5] = bfhi(w.z); f[6] = bflo(w.w); f[7] = bfhi(w.w); }
typedef float f32x2 __attribute__((ext_vector_type(2)));
__device__ __forceinline__ void unpack16_fp8(const v4u w, float (&f)[16]) {
    const unsigned ww[4] = {w.x, w.y, w.z, w.w};
#pragma unroll
    for (int d = 0; d < 4; ++d) { const f32x2 a = __builtin_amdgcn_cvt_pk_f32_fp8((int)ww[d], false), b = __builtin_amdgcn_cvt_pk_f32_fp8((int)ww[d], true);
        f[4 * d] = a.x; f[4 * d + 1] = a.y; f[4 * d + 2] = b.x; f[4 * d + 3] = b.y; }
}
template <int PV_> __device__ __forceinline__ void peer_dot_phase(Frame& F) {
    const unsigned char* H8 = F.ws + WS_H8; const int* EID = (const int*)(F.ws + WS_EID); float* PART = (float*)(F.ws + WS_PART);
    const int lane = F.lane, g = lane >> 3, j = lane & 7, x = F.bid & 7;
    const int nbx = (F.G - x + 7) >> 3, NW = nbx * NWAVES, gwv = (F.bid >> 3) * NWAVES + F.wave;
    const unsigned char* US = F.ws + WS_UB + (size_t)x * NEXP * 128; const unsigned j16 = 16u * (unsigned)j;
    int token = gwv;
    if (token >= M) return;
    v4i e4[4]; v4i hb;
#define PD_LOAD_E(tok_) do { _Pragma("unroll") for (int q = 0; q < 4; ++q) e4[q] = *(const GAS v4i*)(EID + (size_t)(tok_) * 128 + 16 * g + 4 * q); } while (0)
#define PD_ISSUE4(buf_, e_, b0_) do { buf_[b0_] = *(const GAS v4i*)(US + ((unsigned)e_.x * 128u + j16)); buf_[b0_ + 1] = *(const GAS v4i*)(US + ((unsigned)e_.y * 128u + j16)); \
        buf_[b0_ + 2] = *(const GAS v4i*)(US + ((unsigned)e_.z * 128u + j16)); buf_[b0_ + 3] = *(const GAS v4i*)(US + ((unsigned)e_.w * 128u + j16)); } while (0)
#define PD_DOT1(w_, dst_) do { int t = __builtin_amdgcn_sdot4(w_.x, hc.x, 0, false); t = __builtin_amdgcn_sdot4(w_.y, hc.y, t, false); t = __builtin_amdgcn_sdot4(w_.z, hc.z, t, false); t = __builtin_amdgcn_sdot4(w_.w, hc.w, t, false); \
        t += dppi<DPP_XOR1>(t); t += dppi<DPP_XOR2>(t); t += dppi<DPP_HMIR>(t); dst_ = (float)t; } while (0)
    PD_LOAD_E(token); hb = *(const GAS v4i*)(H8 + (size_t)token * D + 128 * x + j16);
    v4i bA[8], bB[8];
    PD_ISSUE4(bA, e4[0], 0); PD_ISSUE4(bA, e4[1], 4);
    for (; token < M; token += NW) {
        const bool more = token + NW < M;
        PD_ISSUE4(bB, e4[2], 0); PD_ISSUE4(bB, e4[3], 4);
        const v4i hc = hb;
        if (more) { PD_LOAD_E(token + NW); hb = *(const GAS v4i*)(H8 + (size_t)(token + NW) * D + 128 * x + j16); }
        float s[16];
#pragma unroll
        for (int i = 0; i < 8; ++i) PD_DOT1(bA[i], s[i]);
        if (more) { PD_ISSUE4(bA, e4[0], 0); PD_ISSUE4(bA, e4[1], 4); }
#pragma unroll
        for (int i = 0; i < 8; ++i) PD_DOT1(bB[i], s[8 + i]);
        if (j == 0) { float* pp = PART + ((size_t)x * M + token) * 128 + g * 16;
#pragma unroll
            for (int i4 = 0; i4 < 4; ++i4) *(GAS f32x4*)(pp + 4 * i4) = (f32x4){s[4 * i4], s[4 * i4 + 1], s[4 * i4 + 2], s[4 * i4 + 3]}; }
    }
#undef PD_LOAD_E
#undef PD_ISSUE4
#undef PD_DOT1
}
template <int NTOK> __device__ __forceinline__ void peer_loadrate_probe(Frame& F) {
    const int* EID = (const int*)(F.ws + WS_EID);
    const int lane = F.lane, g = lane >> 3, j = lane & 7, x = F.bid & 7;
    const int nbx = (F.G - x + 7) >> 3, NW = nbx * NWAVES, gwv = (F.bid >> 3) * NWAVES + F.wave;
    const unsigned char* US = F.ws + WS_UB + (size_t)x * NEXP * 128; const unsigned j16 = 16u * (unsigned)j;
    unsigned acc = 0u;
    for (int token = gwv; token + (NTOK - 1) * NW < M; token += NTOK * NW) {
        v4i e4[NTOK][4];
#pragma unroll
        for (int t = 0; t < NTOK; ++t)
#pragma unroll
            for (int q = 0; q < 4; ++q) e4[t][q] = *(const GAS v4i*)(EID + (size_t)(token + t * NW) * 128 + 16 * g + 4 * q);
        v4i b[NTOK][16];
#pragma unroll
        for (int t = 0; t < NTOK; ++t)
#pragma unroll
            for (int q = 0; q < 4; ++q) { b[t][4 * q] = *(const GAS v4i*)(US + ((unsigned)e4[t][q].x * 128u + j16)); b[t][4 * q + 1] = *(const GAS v4i*)(US + ((unsigned)e4[t][q].y * 128u + j16));
                b[t][4 * q + 2] = *(const GAS v4i*)(US + ((unsigned)e4[t][q].z * 128u + j16)); b[t][4 * q + 3] = *(const GAS v4i*)(US + ((unsigned)e4[t][q].w * 128u + j16)); }
#pragma unroll
        for (int t = 0; t < NTOK; ++t)
#pragma unroll
            for (int i = 0; i < 16; ++i) acc ^= (unsigned)(b[t][i].x ^ b[t][i].y ^ b[t][i].z ^ b[t][i].w);
    }
    asm volatile("" :: "v"(acc));
}
__device__ __forceinline__ void peer_coef_phase(Frame& F) {
    const float* PART = (const float*)(F.ws + WS_PART); const int* EID = (const int*)(F.ws + WS_EID); const float* GW = (const float*)(F.ws + WS_GW);
    const float* SCU = (const float*)(F.ws + WS_SCLU); const float* SCV = (const float*)(F.ws + WS_SCLV); const float* HS = (const float*)(F.ws + WS_HS);
    unsigned* CF8 = (unsigned*)(F.ws + WS_CF); float* CFS = (float*)(F.ws + WS_CFS);
    const size_t gtid = (size_t)F.bid * NTHREADS + F.tid, gthreads = (size_t)F.G * NTHREADS, n4 = (size_t)M * 128 / 4;
    for (size_t i4 = gtid; i4 < n4; i4 += gthreads) {
        f32x4 d = *(const GAS f32x4*)(PART + 4 * i4);
#pragma unroll
        for (int xx = 1; xx < 8; ++xx) d = d + *(const GAS f32x4*)(PART + (size_t)xx * M * 128 + 4 * i4);
        const v4i e = *(const GAS v4i*)(EID + 4 * i4); const f32x4 gw = *(const GAS f32x4*)(GW + 4 * i4);
        const float hs = HS[i4 >> 5];
        f32x4 r; r.x = gw.x * SCV[e.x] * gelu_tanh_safe(d.x * (SCU[e.x] * hs)); r.y = gw.y * SCV[e.y] * gelu_tanh_safe(d.y * (SCU[e.y] * hs));
        r.z = gw.z * SCV[e.z] * gelu_tanh_safe(d.z * (SCU[e.z] * hs)); r.w = gw.w * SCV[e.w] * gelu_tanh_safe(d.w * (SCU[e.w] * hs));
        float m = fmaxf(fmaxf(fabsf(r.x), fabsf(r.y)), fmaxf(fabsf(r.z), fabsf(r.w)));
        m = fmaxf(m, dppf<DPP_XOR1>(m)); m = fmaxf(m, dppf<DPP_XOR2>(m)); m = fmaxf(m, dppf<DPP_HMIR>(m)); m = fmaxf(m, dppf<DPP_ROR8>(m)); m = max_xor16(m);
        const unsigned E = (__builtin_bit_cast(unsigned, m) >> 23) & 0xffu; float sc = 1.f, isc = 1.f;
        if (E >= 8u && E <= 250u) { sc = __builtin_bit_cast(float, (261u - E) << 23); isc = __builtin_bit_cast(float, (E - 7u) << 23); }
        int t = __builtin_amdgcn_cvt_pk_fp8_f32(r.x * sc, r.y * sc, 0, false); t = __builtin_amdgcn_cvt_pk_fp8_f32(r.z * sc, r.w * sc, t, true);
        CF8[i4] = (unsigned)t;
        if ((F.lane & 31) == 0) CFS[i4 >> 5] = isc; }
}
template <bool DRY, bool CHECK = false> __device__ __forceinline__ void peer_out_phase(Frame& F, const float* ada, float* out) {
    const int* EID = (const int*)(F.ws + WS_EID); const unsigned char* CF8 = (const unsigned char*)(F.ws + WS_CF); const float* CFS = (const float*)(F.ws + WS_CFS);
    const int lane = F.lane, g = lane >> 3, j = lane & 7, x = F.bid & 7;
    const int nbx = (F.G - x + 7) >> 3, NW = nbx * NWAVES, gwv = (F.bid >> 3) * NWAVES + F.wave;
    const unsigned char* VS = F.ws + WS_VB + (size_t)x * NEXP * 128; const unsigned j16 = 16u * (unsigned)j;
    if (gwv >= M) return;
    const int ntok = (M - 1 - gwv) / NW + 1;
#define PO_ISSUE4(buf_, e_, b0_) do { buf_[b0_] = *(const GAS v4u*)(VS + ((unsigned)e_.x * 128u + j16)); buf_[b0_ + 1] = *(const GAS v4u*)(VS + ((unsigned)e_.y * 128u + j16)); \
        buf_[b0_ + 2] = *(const GAS v4u*)(VS + ((unsigned)e_.z * 128u + j16)); buf_[b0_ + 3] = *(const GAS v4u*)(VS + ((unsigned)e_.w * 128u + j16)); } while (0)
#define PO_ROW(w_, c_) do { float f[16]; unpack16_fp8(w_, f); _Pragma("unroll") for (int k = 0; k < 16; ++k) o[k] += (c_) * f[k]; } while (0)
#define PO_ACC4(buf_, c4_, b0_) do { PO_ROW(buf_[b0_], c4_.x); PO_ROW(buf_[b0_ + 1], c4_.y); PO_ROW(buf_[b0_ + 2], c4_.z); PO_ROW(buf_[b0_ + 3], c4_.w); } while (0)
    v4i e4[4]; f32x4 c4[4]; v4u bA[8], bB[8];
#define PO_LOADC(tok_) do { const float cs_ = CFS[tok_]; _Pragma("unroll") for (int q = 0; q < 4; ++q) { const unsigned w_ = *(const GAS unsigned*)(CF8 + (size_t)(tok_) * 128 + g * 16 + 4 * q); \
        const f32x2 lo_ = __builtin_amdgcn_cvt_pk_f32_fp8((int)w_, false), hi_ = __builtin_amdgcn_cvt_pk_f32_fp8((int)w_, true); c4[q] = (f32x4){lo_.x * cs_, lo_.y * cs_, hi_.x * cs_, hi_.y * cs_}; } } while (0)
#pragma unroll
    for (int q = 0; q < 4; ++q) e4[q] = *(const GAS v4i*)(EID + (size_t)gwv * 128 + g * 16 + 4 * q);
    PO_LOADC(gwv);
    PO_ISSUE4(bA, e4[0], 0); PO_ISSUE4(bA, e4[1], 4);
    for (int it = 0; it < ntok; ++it) {
        const int token = gwv + it * NW, tn = gwv + (it + 1 < ntok ? it + 1 : it) * NW;
        PO_ISSUE4(bB, e4[2], 0); PO_ISSUE4(bB, e4[3], 4);
#pragma unroll
        for (int q = 0; q < 4; ++q) e4[q] = *(const GAS v4i*)(EID + (size_t)tn * 128 + g * 16 + 4 * q);
        float o[16];
#pragma unroll
        for (int k = 0; k < 16; ++k) o[k] = 0.f;
        PO_ACC4(bA, c4[0], 0); PO_ACC4(bA, c4[1], 4);
        PO_ISSUE4(bA, e4[0], 0); PO_ISSUE4(bA, e4[1], 4);
        PO_ACC4(bB, c4[2], 0); PO_ACC4(bB, c4[3], 4);
        PO_LOADC(tn);
#pragma unroll
        for (int k = 0; k < 16; ++k) { float t = o[k]; t += dppf<DPP_ROR8>(t); o[k] = sum_xor32(sum_xor16(t)); }
        if (g == 0) { const int b = token >> 12;
            const float* gt = ada + (size_t)b * 6 * D + 5 * D + 128 * x + 16 * j;
            float* xo = out + (size_t)token * D + 128 * x + 16 * j;
#pragma unroll
            for (int q = 0; q < 4; ++q) { const f32x4 xv = *(const GAS f32x4*)(xo + 4 * q), gv = *(const GAS f32x4*)(gt + 4 * q);
                f32x4 res = xv + gv * (f32x4){o[4 * q], o[4 * q + 1], o[4 * q + 2], o[4 * q + 3]};
                if (CHECK) { const f32x4 mf = *(const GAS f32x4*)((const float*)(F.ws + WS_PART) + (size_t)token * D + 128 * x + 16 * j + 4 * q);
                    const float rr[4] = {o[4 * q], o[4 * q + 1], o[4 * q + 2], o[4 * q + 3]}, mm[4] = {mf.x, mf.y, mf.z, mf.w}; bool bad = false;
#pragma unroll
                    for (int z = 0; z < 4; ++z) bad = bad || !(fabsf(rr[z] - mm[z]) <= 0.01f * fabsf(rr[z]) + 1.0e-3f);
                    if (bad) res.x = 1.0e9f; }
                if (DRY) { asm volatile("" :: "v"(res.x), "v"(res.y), "v"(res.z), "v"(res.w)); } else *(GAS f32x4*)(xo + 4 * q) = res; } }
    }
#undef PO_LOADC
#undef PO_ISSUE4
#undef PO_ROW
#undef PO_ACC4
}

constexpr int PO_TILE = 64 * 144;
template <int MODE> __device__ __forceinline__ void peer_out_mfma_phase(Frame& F, const float* ada, float* out) {
    const int* EID = (const int*)(F.ws + WS_EID); const unsigned char* CF8 = (const unsigned char*)(F.ws + WS_CF); const float* CFS = (const float*)(F.ws + WS_CFS);
    const int lane = F.lane, g = lane >> 3, j = lane & 7, l15 = lane & 15, lq = lane >> 4, x = F.bid & 7;
    const int nbx = (F.G - x + 7) >> 3, NW = nbx * NWAVES, gwv = (F.bid >> 3) * NWAVES + F.wave;
    const unsigned char* VS = F.ws + WS_VB + (size_t)x * NEXP * 128; const unsigned j16 = 16u * (unsigned)j;
    LAS unsigned char* TL = F.lds + F.wave * PO_TILE;
    if (gwv >= M) return;
    const int nst = 2 * ((M - 1 - gwv) / NW + 1);
    const int trow = l15 >> 1, tcol = 8 * (l15 & 1);
#define PM_IDS(e_, a_, tok_) do { const size_t base = (size_t)(tok_) * 128; \
        _Pragma("unroll") for (int m = 0; m < 16; ++m) e_[m] = EID[base + 8 * m + g]; \
        _Pragma("unroll") for (int q = 0; q < 4; ++q) a_[q] = *(const GAS long*)(CF8 + base + 32 * q + 8 * lq); } while (0)
#define PM_GATHER(vv_, e_, h_) do { _Pragma("unroll") for (int m = 0; m < 8; ++m) vv_[m] = *(const GAS v4u*)(VS + ((unsigned)e_[8 * (h_) + m] * 128u + j16)); } while (0)
#define PM_HALF(vv_, aq0_, aq1_) do { _Pragma("unroll") for (int m = 0; m < 8; ++m) *(LAS v4u*)(TL + (8 * m + g) * 144 + 16 * j) = vv_[m]; } while (0)
#define PM_MMA(aq0_, aq1_) do { LDS_WAIT(); asm volatile("" ::: "memory"); \
        _Pragma("unroll") for (int ks = 0; ks < 2; ++ks) _Pragma("unroll") for (int cb = 0; cb < 8; ++cb) { \
            const v2i bb = __builtin_amdgcn_ds_read_tr8_b64_v2i32((LAS v2i*)(TL + (32 * ks + 8 * lq + trow) * 144 + 16 * cb + tcol)); \
            acc[cb] = __builtin_amdgcn_mfma_f32_16x16x32_fp8_fp8(ks ? (aq1_) : (aq0_), __builtin_bit_cast(long, bb), acc[cb], 0, 0, 0); } \
        LDS_WAIT(); asm volatile("" ::: "memory"); } while (0)
    const int ntok = nst >> 1;
    int e1[16], e2[16]; long a0[4], a1[4], a2[4]; v4u vvA[8], vvB[8];
    PM_IDS(e1, a0, gwv);
    PM_GATHER(vvA, e1, 0); PM_GATHER(vvB, e1, 1);
    { const int t1 = ntok > 1 ? 1 : 0; PM_IDS(e1, a1, gwv + t1 * NW); }
    f32x4 acc[8];
    for (int it = 0; it < ntok; ++it) {
        const int token = gwv + it * NW;
        { const int t2 = it + 2 < ntok ? it + 2 : ntok - 1; PM_IDS(e2, a2, gwv + t2 * NW); }
#pragma unroll
        for (int cb = 0; cb < 8; ++cb) acc[cb] = (f32x4){0.f, 0.f, 0.f, 0.f};
        PM_HALF(vvA, 0, 0); PM_GATHER(vvA, e1, 0); PM_MMA(a0[0], a0[1]);
        PM_HALF(vvB, 0, 0); PM_GATHER(vvB, e1, 1); PM_MMA(a0[2], a0[3]);
        if (lq == 0) {
            const float cs = CFS[token];
            if (MODE == 1) { float* oc = (float*)(F.ws + WS_PART) + (size_t)token * D + 128 * x + l15;
#pragma unroll
                for (int cb = 0; cb < 8; ++cb) oc[16 * cb] = acc[cb][0] * cs; }
            else { const int b = token >> 12;
                const float* gt = ada + (size_t)b * 6 * D + 5 * D + 128 * x + l15;
                float* xo = out + (size_t)token * D + 128 * x + l15;
#pragma unroll
                for (int cb = 0; cb < 8; ++cb) xo[16 * cb] = xo[16 * cb] + gt[16 * cb] * (acc[cb][0] * cs); }
        }
#pragma unroll
        for (int m = 0; m < 16; ++m) e1[m] = e2[m];
#pragma unroll
        for (int q = 0; q < 4; ++q) { a0[q] = a1[q]; a1[q] = a2[q]; }
    }
#undef PM_HALF
#undef PM_MMA
#undef PM_IDS
#undef PM_GATHER
}

__device__ __forceinline__ void compress_phase(Frame& F, const float* kng) {
    LAS bf16* H2 = (LAS bf16*)(F.lds);
    LAS float* OUTS = (LAS float*)(F.lds + 16384);
    const int lane = F.lane, w = F.wave, l15 = lane & 15, lq = lane >> 4;
    for (int u = F.bid; u < NBG * 2 * 8; u += F.G) {
        const int ns = u & 7, kv = (u >> 3) & 1, bg = u >> 4, n0 = ns * 32;
        const bf16* A = (const bf16*)(F.ws + (kv ? WS_VCR : WS_KCR)) + (size_t)bg * SEQ * 64;
        const bf16* W1T = (const bf16*)(F.ws + (kv ? WS_CW1V_T : WS_CW1K_T));
        const bf16* W2T = (const bf16*)(F.ws + (kv ? WS_CW2V_T : WS_CW2K_T));
        const float* b1 = (const float*)(F.ws + (kv ? WS_CB1V : WS_CB1K));
        pg8::f32x4 acc[2];
        acc[0] = (pg8::f32x4){0.f, 0.f, 0.f, 0.f}; acc[1] = acc[0];
        const bf16* ap = A + (size_t)(n0 + l15) * 1024 + 8 * lq;
        const bf16* bp = W1T + (size_t)(16 * w + l15) * 2048 + 8 * lq;
#pragma unroll 8
        for (int ks = 0; ks < 64; ++ks) {
            const bf16x8 a0 = *(const GAS bf16x8*)(ap + 32 * ks), a1 = *(const GAS bf16x8*)(ap + 16 * 1024 + 32 * ks), b = *(const GAS bf16x8*)(bp + 32 * ks);
            acc[0] = __builtin_amdgcn_mfma_f32_16x16x32_bf16(a0, b, acc[0], 0, 0, 0);
            acc[1] = __builtin_amdgcn_mfma_f32_16x16x32_bf16(a1, b, acc[1], 0, 0, 0);
        }
        { const float bb = b1[16 * w + l15];
#pragma unroll
          for (int rb = 0; rb < 2; ++rb)
#pragma unroll
            for (int r = 0; r < 4; ++r) H2[(16 * rb + 4 * lq + r) * 136 + 16 * w + l15] = (bf16)f2bf(gelu_tanh_safe(acc[rb][r] + bb)); }
        __syncthreads();
        { const int rb = w >> 2, db = w & 3;
          pg8::f32x4 o = (pg8::f32x4){0.f, 0.f, 0.f, 0.f};
#pragma unroll
          for (int ks = 0; ks < 4; ++ks) {
              const bf16x8 a = *(const LAS bf16x8*)(H2 + (16 * rb + l15) * 136 + 32 * ks + 8 * lq);
              const bf16x8 b = *(const GAS bf16x8*)(W2T + (size_t)(16 * db + l15) * 128 + 32 * ks + 8 * lq);
              o = __builtin_amdgcn_mfma_f32_16x16x32_bf16(a, b, o, 0, 0, 0); }
#pragma unroll
          for (int r = 0; r < 4; ++r) OUTS[(16 * rb + 4 * lq + r) * 65 + 16 * db + l15] = o[r]; }
        __syncthreads();
        { const int n = F.tid >> 4, d4 = (F.tid & 15) * 4, ng = n0 + n;
          float v[4]; float ss = 0.f;
#pragma unroll
          for (int i = 0; i < 4; ++i) { v[i] = OUTS[n * 65 + d4 + i]; ss += v[i] * v[i]; }
          ss += dppf<DPP_XOR1>(ss); ss += dppf<DPP_XOR2>(ss); ss += dppf<DPP_HMIR>(ss); ss += dppf<DPP_ROR8>(ss);
          const bool pad = (ng >= NCMP);
          if (kv == 0) { const float rs = rsqrtf(ss * (1.f / 64.f) + EPS);
              v2u o; o.x = pad ? 0u : pk2(v[0] * rs * kng[d4], v[1] * rs * kng[d4 + 1]); o.y = pad ? 0u : pk2(v[2] * rs * kng[d4 + 2], v[3] * rs * kng[d4 + 3]);
              *(GAS v2u*)((bf16*)(F.ws + WS_KC) + ((size_t)bg * 256 + ng) * 64 + d4) = o; }
          else { bf16* vt = (bf16*)(F.ws + WS_VCT) + (size_t)bg * 64 * 256 + ng;
#pragma unroll
              for (int i = 0; i < 4; ++i) vt[(size_t)(d4 + i) * 256] = pad ? (bf16)0 : (bf16)f2bf(v[i]); } }
        __syncthreads();
    }
}
__device__ __forceinline__ void vtranspose_phase(Frame& F) {
    LAS bf16* T = (LAS bf16*)(F.lds + F.wave * 9216);
    const int gw = F.bid * NWAVES + F.wave, NGW = F.G * NWAVES, lane = F.lane;
    for (int job = gw; job < 2 * NBG * 64; job += NGW) {
        const int s = job & 63, bg = (job >> 6) & 15, which = job >> 10;
        const bf16* X = (const bf16*)(F.ws + (which ? WS_VW : WS_VS)) + ((size_t)bg * SEQ + 64 * s) * 64;
        bf16* XT = (bf16*)(F.ws + (which ? WS_VWT : WS_VST)) + (size_t)bg * 64 * SEQ + 64 * s;
#pragma unroll
        for (int i = 0; i < 8; ++i) { const int tok = (lane >> 3) + 8 * i, ch = lane & 7;
            const v4u x = *(const GAS v4u*)(X + (size_t)tok * 64 + 8 * ch);
            const unsigned ww[4] = {x.x, x.y, x.z, x.w};
#pragma unroll
            for (int e = 0; e < 4; ++e) { T[(8 * ch + 2 * e) * 72 + tok] = (bf16)(ww[e] & 0xffffu); T[(8 * ch + 2 * e + 1) * 72 + tok] = (bf16)(ww[e] >> 16); } }
        LDS_WAIT(); asm volatile("" ::: "memory");
#pragma unroll
        for (int i = 0; i < 8; ++i) { const int dim = (lane >> 3) + 8 * i, ch = lane & 7;
            const v4u y = *(const LAS v4u*)(T + dim * 72 + 8 * ch);
            *(GAS v4u*)(XT + (size_t)dim * SEQ + 8 * ch) = y; }
        LDS_WAIT(); asm volatile("" ::: "memory");
    }
}

constexpr int AT_KBUF = 64 * 128;
constexpr int AT_NBUF = 3;
constexpr int AT_OFF_K = 0, AT_OFF_V = AT_NBUF * AT_KBUF;
constexpr int AT_OFF_IMP1 = 2 * AT_NBUF * AT_KBUF, AT_OFF_IMP2 = AT_OFF_IMP1 + 64 * 65 * 4, AT_OFF_SEL = AT_OFF_IMP2 + 64 * 65 * 4;
constexpr int AT_OFF_LUT = AT_OFF_SEL + 512, AT_OFF_LROW = AT_OFF_LUT + 4 * 128 * 4;
constexpr int AT_OFF_TD = AT_OFF_LROW + 8 * 32 * 4;
constexpr int AT_OFF_OUT = AT_OFF_TD + 96 * 32;
constexpr int AT_OFF_GATL = AT_OFF_OUT + 256 * 144;
constexpr int AT_LDS_END = AT_OFF_GATL + 64 * 12 * 4;
static_assert(AT_LDS_END <= RING_BYTES, "attention LDS");

struct AtTile { const bf16* k; const bf16* vt; int vstride; };
enum { TM_CMP1 = 0, TM_CMP2, TM_SELN, TM_SELF, TM_WINN, TM_WINF, TM_WINE };
__device__ __forceinline__ float fexp2(float x) { return __builtin_amdgcn_exp2f(x); }
template <int TM, int VAR, int RB = 3>
__device__ __forceinline__ void at_tile(const LAS unsigned char* kb_, const LAS unsigned char* vb_, const LAS float* LUTJ, LAS float* IMP1, LAS float* IMP2,
                                        const bf16x8 (&qf)[2][2], pg8::f32x4 (&oacc)[2][4], pg8::f32x4 (&lacc)[2], const LAS float* LINV,
                                        const int (&tok_r_in)[2], const unsigned (&selb)[2], float cfar, int relbase, int idx, int l15_in, int lq_in) {
    constexpr bool FAR = (TM == TM_SELF || TM == TM_WINF || TM == TM_WINE);
    int l15 = l15_in, lq = lq_in; asm volatile("" : "+v"(l15), "+v"(lq));
    int tok_r[2] = {tok_r_in[0], tok_r_in[1]}; asm volatile("" : "+v"(tok_r[0]), "+v"(tok_r[1]));
    v4u pfr[2][2];
    auto qk = [&](int cb, pg8::f32x4 (&st)[2]) __attribute__((always_inline)) {
        st[0] = FAR ? (pg8::f32x4){cfar, cfar, cfar, cfar} : (pg8::f32x4){0.f, 0.f, 0.f, 0.f}; st[1] = st[0];
        if (TM == TM_SELF) {
#pragma unroll
            for (int rb = 0; rb < 2; ++rb) { const float ci = selb[rb] ? cfar : -1.0e30f; st[rb] = (pg8::f32x4){ci, ci, ci, ci}; } }
        if (!(VAR & 64)) {
        const int krow = 8 * (l15 >> 2) + (l15 & 3) + 32 * (cb >> 1) + 4 * (cb & 1), kf_ = ((l15 >> 2) << 1) | ((l15 >> 1) & 1);
#pragma unroll
        for (int ks = 0; ks < 2; ++ks) { const bf16x8 kf = *(const LAS bf16x8*)(kb_ + krow * 128 + 16 * ((4 * ks + lq) ^ kf_));
#pragma unroll
            for (int rb = 0; rb < 2; ++rb) if (RB & (1 << rb)) st[rb] = __builtin_amdgcn_mfma_f32_16x16x32_bf16(kf, qf[rb][ks], st[rb], 0, 0, 0); } }
    };
    float linv_[2] = {0.f, 0.f};
    if (TM == TM_CMP2) { linv_[0] = LINV[l15]; linv_[1] = LINV[16 + l15]; }
    auto prob = [&](int cb, const pg8::f32x4 (&st)[2]) __attribute__((always_inline)) {
#pragma unroll
        for (int rb = 0; rb < 2; ++rb) if (RB & (1 << rb)) {
            const int tokc = tok_r[rb];
            float p[4];
#pragma unroll
            for (int r = 0; r < 4; ++r) {
                const int kl = 32 * (cb >> 1) + 8 * lq + 4 * (cb & 1) + r;
                if (VAR & 16) { p[r] = st[rb][r]; }
                else if (TM == TM_SELF) { p[r] = fexp2(st[rb][r]); }
                else if (TM == TM_WINF) { p[r] = fexp2(st[rb][r]); }
                else if (TM == TM_WINE) { const float e = fexp2(st[rb][r]); p[r] = (kl > tokc) ? e : 0.f; }
                else {
                    const int rel = (TM == TM_CMP1 || TM == TM_CMP2) ? (relbase + tokc - 16 * kl) : (relbase + tokc - kl);
                    bool valid = rel >= 0; if (TM == TM_SELN) valid = valid && (selb[rb] != 0u);
                    const int ri = rel < 0 ? 0 : (rel > 127 ? 127 : rel);
                    const float e = fexp2(st[rb][r] + LUTJ[ri]);
                    p[r] = valid ? e : 0.f; }
            }
            if (TM == TM_CMP1) { lacc[rb][0] += (p[0] + p[1]) + (p[2] + p[3]); }
            else {
                if (TM == TM_CMP2) {
#pragma unroll
                    for (int r = 0; r < 4; ++r) p[r] *= linv_[rb];
                    float h0 = p[0], h1 = p[1], h2 = p[2], h3 = p[3];
                    h0 += dppf<DPP_XOR1>(h0); h1 += dppf<DPP_XOR1>(h1); h2 += dppf<DPP_XOR1>(h2); h3 += dppf<DPP_XOR1>(h3);
                    h0 += dppf<DPP_XOR2>(h0); h1 += dppf<DPP_XOR2>(h1); h2 += dppf<DPP_XOR2>(h2); h3 += dppf<DPP_XOR2>(h3);
                    if ((l15 & 3) == 0) { const int sp = 16 * idx + 8 * (cb >> 1) + 2 * lq + (cb & 1);
                        IMP1[tokc * 65 + sp] = (h0 + h1) + (h2 + 0.5f * h3);
                        if (sp + 1 < 64) IMP2[tokc * 65 + sp + 1] = 0.5f * h3; }
                }
                const unsigned lo = pkh(p[0], p[1]), hi = pkh(p[2], p[3]);
                if (cb & 1) { pfr[rb][cb >> 1].z = lo; pfr[rb][cb >> 1].w = hi; } else { pfr[rb][cb >> 1].x = lo; pfr[rb][cb >> 1].y = hi; } }
        }
    };
    auto pv = [&](int ks) __attribute__((always_inline)) {
        if (TM != TM_CMP1 && !(VAR & 8)) {
#pragma unroll
            for (int db = 0; db < 4; ++db) {
                const v4u vv = *(const LAS v4u*)(vb_ + (16 * db + l15) * 128 + 16 * ((4 * ks + lq) ^ (l15 >> 1)));
#pragma unroll
                for (int rb = 0; rb < 2; ++rb) if (RB & (1 << rb)) oacc[rb][db] = __builtin_amdgcn_mfma_f32_16x16x32_bf16(__builtin_bit_cast(bf16x8, pfr[rb][ks]), __builtin_bit_cast(bf16x8, vv), oacc[rb][db], 0, 0, 0); }
            if (TM != TM_CMP2) { const v4u ones = (v4u){0x3F803F80u, 0x3F803F80u, 0x3F803F80u, 0x3F803F80u};
#pragma unroll
                for (int rb = 0; rb < 2; ++rb) if (RB & (1 << rb)) lacc[rb] = __builtin_amdgcn_mfma_f32_16x16x32_bf16(__builtin_bit_cast(bf16x8, pfr[rb][ks]), __builtin_bit_cast(bf16x8, ones), lacc[rb], 0, 0, 0); }
        }
    };
    pg8::f32x4 sA[2], sB[2];
#define AT_SB __builtin_amdgcn_sched_barrier(0)
    qk(0, sA); AT_SB;
    qk(1, sB); prob(0, sA); AT_SB;
    qk(2, sA); prob(1, sB); AT_SB;
    pv(0); qk(3, sB); prob(2, sA); AT_SB;
    prob(3, sB); AT_SB;
    pv(1);
#undef AT_SB
}

template <int VAR> __device__ __forceinline__ void attention_phase(Frame& F, const Args& args) {
    unsigned char* ws = F.ws;
    const int lane = F.lane, w = F.wave, l15 = lane & 15, lq = lane >> 4, tid = F.tid;
    LAS unsigned char* L = F.lds;
    LAS float* IMP1 = (LAS float*)(L + AT_OFF_IMP1); LAS float* IMP2 = (LAS float*)(L + AT_OFF_IMP2);
    LAS unsigned long long* SELM = (LAS unsigned long long*)(L + AT_OFF_SEL); LAS float* LUT = (LAS float*)(L + AT_OFF_LUT); LAS float* LROW = (LAS float*)(L + AT_OFF_LROW) + w * 32;
    LAS int* TD = (LAS int*)(L + AT_OFF_TD); LAS bf16* OUTL = (LAS bf16*)(L + AT_OFF_OUT) + (32 * w) * 72; LAS float* GATL = (LAS float*)(L + AT_OFF_GATL);
    const bf16* Qg = (const bf16*)(ws + WS_Q); const float* GATE = (const float*)(ws + WS_GATE); bf16* YA = (bf16*)(ws + WS_YA); float* YAF = (float*)(ws + WS_H);
    const int jq = l15 & 3;
    const LAS float* LUTJ = LUT + jq * 128;
    const int nrounds = (F.G == 256) ? 4 : (1024 + F.G - 1) / F.G;
    for (int round = 0; round < nrounds; ++round) {
        const int ui = (F.G == 256) ? ((round & 1) ? ((round >> 1) * 512 + 511 - F.bid) : ((round >> 1) * 512 + F.bid)) : (round * F.G + F.bid);
        if (ui >= 1024) break;
        const int c = 63 - (ui >> 4), bg = ui & 15, b = bg >> 1, g = bg & 1;
        const int m0 = b * SEQ + 64 * c;
        __syncthreads();
        { const float M0 = ((const float*)(ws + WS_BIASL))[8 * 128];
          for (int i = tid; i < 512; i += NTHREADS) LUT[i] = (((const float*)(ws + WS_BIASL))[(4 * g + (i >> 7)) * 128 + (i & 127)] - M0) * 1.4426950408889634f; }
        for (int i = tid; i < 64 * 65; i += NTHREADS) { IMP1[i] = 0.f; IMP2[i] = 0.f; }
        for (int i = tid; i < 64 * 12; i += NTHREADS) GATL[i] = GATE[(size_t)(m0 + i / 12) * 24 + g * 12 + (i % 12)];
        bf16x8 qf[2][2];
#pragma unroll
        for (int rb = 0; rb < 2; ++rb)
#pragma unroll
            for (int ks = 0; ks < 2; ++ks) qf[rb][ks] = *(const GAS bf16x8*)(Qg + (size_t)(m0 + 8 * w + 4 * rb + (l15 >> 2)) * 512 + g * 256 + jq * 64 + 32 * ks + 8 * lq);
        asm volatile("" :: "v"(qf[0][0]), "v"(qf[0][1]), "v"(qf[1][0]), "v"(qf[1][1]));
        const int ncmp = 4 * c + 3, n1 = (ncmp + 63) >> 6, nsel = c + 1, w0 = c >= 8 ? c - 8 : 0, nwin = c - w0 + 1;
        const int ntiles = 2 * n1 + nsel + nwin;
        if (tid < ntiles) { const int i = tid; int kind, idx; unsigned ko, vo, vs;
            if (i < n1) { kind = 0; idx = i; } else if (i < 2 * n1) { kind = 1; idx = i - n1; } else if (i < 2 * n1 + nsel) { kind = 2; idx = i - 2 * n1; } else { kind = 3; idx = w0 + (i - 2 * n1 - nsel); }
            if (kind < 2) { ko = (unsigned)(WS_KC + ((size_t)bg * 256 * 64 + (size_t)idx * 4096) * 2); vo = (unsigned)(WS_VCT + ((size_t)bg * 64 * 256 + 64 * idx) * 2); vs = 512u; }
            else if (kind == 2) { ko = (unsigned)(WS_KS + ((size_t)bg * SEQ * 64 + (size_t)idx * 4096) * 2); vo = (unsigned)(WS_VST + ((size_t)bg * 64 * SEQ + 64 * idx) * 2); vs = 2u * SEQ; }
            else { ko = (unsigned)(WS_KW + ((size_t)bg * SEQ * 64 + (size_t)idx * 4096) * 2); vo = (unsigned)(WS_VWT + ((size_t)bg * 64 * SEQ + 64 * idx) * 2); vs = 2u * SEQ; }
            const int dd = c - idx;
            int mode, relbase;
            if (kind == 0) { mode = TM_CMP1; relbase = 64 * c - 31 - 1024 * idx; } else if (kind == 1) { mode = TM_CMP2; relbase = 64 * c - 31 - 1024 * idx; }
            else if (kind == 2) { mode = dd <= 2 ? TM_SELN : TM_SELF; relbase = 64 * dd; } else { mode = dd <= 2 ? TM_WINN : (dd == 8 ? TM_WINE : TM_WINF); relbase = 64 * dd; }
            const int endf = ((kind == 1 && idx == n1 - 1) || (kind == 2 && idx == nsel - 1) || (kind == 3 && idx == c)) ? kind : 0;
            LAS int* td = TD + 8 * i; td[0] = mode; td[1] = idx; td[2] = relbase; td[3] = endf; td[4] = (int)ko; td[5] = (int)vo; td[6] = (int)vs; td[7] = (kind == 2 && idx == 0) ? 1 : 0; }
        const int drow = 8 * w + (lane >> 3), dsrck = 16 * ((lane & 7) ^ (((w & 3) << 1) | ((lane >> 4) & 1))), dsrcv = 16 * ((lane & 7) ^ ((4 * (w & 1)) | (lane >> 4)));
#define AT_DMA(tile_) do { const LAS int* tn_ = TD + 8 * (tile_); const unsigned ko_ = (unsigned)tn_[4], vo_ = (unsigned)tn_[5], vs_ = (unsigned)tn_[6]; const int nb_ = (tile_) % AT_NBUF; \
        __builtin_amdgcn_global_load_lds((const GAS unsigned*)(ws + (size_t)(ko_ + drow * 128 + dsrck)), (LAS unsigned*)(L + AT_OFF_K + nb_ * AT_KBUF + w * 1024), 16, 0, 0); \
        __builtin_amdgcn_global_load_lds((const GAS unsigned*)(ws + (size_t)(vo_ + drow * vs_ + dsrcv)), (LAS unsigned*)(L + AT_OFF_V + nb_ * AT_KBUF + w * 1024), 16, 0, 0); } while (0)
        __syncthreads();
        if (!(VAR & 2)) { AT_DMA(0); if (ntiles > 1) AT_DMA(1); }
        pg8::f32x4 oacc[2][4];
        pg8::f32x4 lacc[2] = {(pg8::f32x4){0.f, 0.f, 0.f, 0.f}, (pg8::f32x4){0.f, 0.f, 0.f, 0.f}};
#pragma unroll
        for (int rb = 0; rb < 2; ++rb)
#pragma unroll
            for (int db = 0; db < 4; ++db) oacc[rb][db] = (pg8::f32x4){0.f, 0.f, 0.f, 0.f};
        const int tok_r[2] = {8 * w + (l15 >> 2), 8 * w + 4 + (l15 >> 2)};
        for (int it = 0; it < ((VAR & 32) ? 0 : ntiles); ++it) {
            if (it + 1 < ntiles) asm volatile("s_waitcnt vmcnt(2)" ::: "memory"); else asm volatile("s_waitcnt vmcnt(0)" ::: "memory");
            asm volatile("s_waitcnt lgkmcnt(0)" ::: "memory"); __builtin_amdgcn_s_barrier(); asm volatile("" ::: "memory");
            if (!(VAR & 2) && it + 2 < ntiles) AT_DMA(it + 2);
            {
            const LAS int* td = TD + 8 * it;
            const int mode = __builtin_amdgcn_readfirstlane(td[0]), idx = __builtin_amdgcn_readfirstlane(td[1]), relbase = __builtin_amdgcn_readfirstlane(td[2]);
            const int endf = __builtin_amdgcn_readfirstlane(td[3]), selfirst = __builtin_amdgcn_readfirstlane(td[7]);
            const int buf = it % AT_NBUF;
            if (selfirst) {
                { const int tok = 8 * w + (lane >> 3), s0 = 8 * (lane & 7);
                  unsigned key[8]; int rank[8];
#pragma unroll
                  for (int q = 0; q < 8; ++q) { const int sB = s0 + q; const bool vis = sB <= c, forced = (sB == 0) || (sB == c) || (sB == c - 1);
                      const float sc = vis ? (IMP1[tok * 65 + sB] + IMP2[tok * 65 + sB] + (forced ? 1000.f : 0.f)) : -1.f;
                      const unsigned u = __builtin_bit_cast(unsigned, sc); const unsigned fk = (u >> 31) ? ~u : (u | 0x80000000u);
                      key[q] = (fk & ~63u) | (unsigned)(63 - sB); rank[q] = 0; }
                  LAS unsigned* KEYS = (LAS unsigned*)IMP1;
#pragma unroll
                  for (int q = 0; q < 8; ++q) KEYS[tok * 65 + s0 + q] = key[q];
                  if (c >= 16 && !(VAR & 128)) {
#pragma unroll 8
                      for (int s2 = 0; s2 < 64; ++s2) { const unsigned k2 = KEYS[tok * 65 + s2];
#pragma unroll
                          for (int q = 0; q < 8; ++q) rank[q] += (k2 > key[q]) ? 1 : 0; } }
                  unsigned byte = 0u;
#pragma unroll
                  for (int q = 0; q < 8; ++q) byte |= ((rank[q] < 16 && (s0 + q) <= c) ? 1u : 0u) << q;
                  ((LAS unsigned char*)SELM)[tok * 8 + (lane & 7)] = (unsigned char)byte; }
            }
            const LAS unsigned char* kb_ = L + AT_OFF_K + buf * AT_KBUF; const LAS unsigned char* vb_ = L + AT_OFF_V + buf * AT_KBUF;
            const float cfar = LUTJ[127];
            unsigned selb[2] = {1u, 1u};
#define AT_CALL(TMX) at_tile<TMX, VAR>(kb_, vb_, LUTJ, IMP1, IMP2, qf, oacc, lacc, LROW, tok_r, selb, cfar, relbase, idx, l15, lq)
            if (mode == TM_SELF || mode == TM_SELN) { selb[0] = (unsigned)(SELM[tok_r[0]] >> idx) & 1u; selb[1] = (unsigned)(SELM[tok_r[1]] >> idx) & 1u; }
            if (mode == TM_SELF) {
                const bool a0 = __ballot(selb[0] != 0u) != 0ull, a1 = __ballot(selb[1] != 0u) != 0ull;
                if (a0 && a1) AT_CALL(TM_SELF);
                else if (a0) at_tile<TM_SELF, VAR, 1>(kb_, vb_, LUTJ, IMP1, IMP2, qf, oacc, lacc, LROW, tok_r, selb, cfar, relbase, idx, l15, lq);
                else if (a1) at_tile<TM_SELF, VAR, 2>(kb_, vb_, LUTJ, IMP1, IMP2, qf, oacc, lacc, LROW, tok_r, selb, cfar, relbase, idx, l15, lq); }
            else if (mode == TM_WINF) AT_CALL(TM_WINF);
            else if (mode == TM_SELN) AT_CALL(TM_SELN);
            else if (mode == TM_WINN) AT_CALL(TM_WINN);
            else if (mode == TM_WINE) AT_CALL(TM_WINE);
            else if (mode == TM_CMP2) AT_CALL(TM_CMP2);
            else { AT_CALL(TM_CMP1);
                if (idx == n1 - 1) {
#pragma unroll
                    for (int rb = 0; rb < 2; ++rb) { const float s = sum_xor32(sum_xor16(lacc[rb][0])); if (lq == 0) LROW[16 * rb + l15] = s > 0.f ? 1.0f / s : 0.f; lacc[rb] = (pg8::f32x4){0.f, 0.f, 0.f, 0.f}; } } }
#undef AT_CALL
            {
                if (endf && !(VAR & 256)) {
                    const int br = endf - 1;
#pragma unroll
                    for (int rb = 0; rb < 2; ++rb)
#pragma unroll
                        for (int r = 0; r < 4; ++r) { const int qrow = 16 * rb + 4 * lq + r;
                            const float ls_ = lacc[rb][r]; lacc[rb][r] = 0.f;
                            const float gt = GATL[(8 * w + 4 * rb + lq) * 12 + r * 3 + br] * (endf == 1 ? 1.0f : (ls_ > 0.f ? 1.0f / ls_ : 0.f));
#pragma unroll
                            for (int db = 0; db < 4; ++db) { float v = gt * oacc[rb][db][r]; oacc[rb][db][r] = 0.f;
                                LAS bf16* po = OUTL + qrow * 72 + 16 * db + l15;
                                if (br > 0) v += __builtin_bit_cast(float, (unsigned)(*po) << 16);
                                *po = (bf16)f2bf(v); } }
                    if (br == 2 && !(VAR & 1)) {
                        LDS_WAIT(); asm volatile("" ::: "memory");
#pragma unroll
                        for (int i = 0; i < 4; ++i) { const int ch = i * 64 + lane, row = ch >> 3, c16 = ch & 7;
                            const v4u o = *(const LAS v4u*)((const LAS unsigned char*)OUTL + row * 144 + 16 * c16);
                            *(GAS v4u*)(YA + (size_t)(m0 + 8 * w + (row >> 2)) * 512 + g * 256 + (row & 3) * 64 + 8 * c16) = o; }
                    }
                }
            }
            }
        }
#undef AT_DMA
    }
}

constexpr int N_PHASES = 13;
#ifndef MK_ONE_LAUNCH
#define MK_ONE_LAUNCH 1
#endif
#ifndef REP_P0
#define REP_P0 1
#endif
#ifndef REP_P1
#define REP_P1 1
#endif
#ifndef REP_P2
#define REP_P2 1
#endif
#ifndef REP_P3
#define REP_P3 1
#endif
#ifndef REP_P5
#define REP_P5 1
#endif
#ifndef REP_P6
#define REP_P6 1
#endif
#ifndef REP_P8
#define REP_P8 1
#endif
#ifndef REP_P7
#define REP_P7 1
#endif
#ifndef REP_P11
#define REP_P11 1
#endif
#ifndef REP_P4
#define REP_P4 1
#endif
#ifndef REP_P9
#define REP_P9 1
#endif
#ifndef REP_P10
#define REP_P10 1
#endif
#ifndef MK_BUILD
#define MK_BUILD 0
#endif

__global__ void __launch_bounds__(NTHREADS, 2) fwd_kernel(Args args) {
    extern __shared__ __attribute__((aligned(16))) unsigned char lds[];
    Frame F;
    F.lds = (LAS unsigned char*)lds;
    F.MISC = (volatile LAS unsigned*)(F.lds + MISC_OFF);
    F.tid = threadIdx.x; F.lane = F.tid & 63; F.wave = __builtin_amdgcn_readfirstlane(F.tid >> 6);
    F.G = gridDim.x; F.bid = blockIdx.x; F.ws = args.ws;
    F.ctl = (gu32*)(args.ws + WS_CTL);
    for (int u = F.tid; u < (LDS_BYTES - LDSCTL_OFF) / 4; u += NTHREADS) ((LAS unsigned*)(F.lds + LDSCTL_OFF))[u] = 0u;
    __syncthreads();
    XcdBarrier bar; bar.bar = (unsigned*)(F.ctl + CW_BAR); bar.x = 0; bar.st = nullptr;
    if (MK_ONE_LAUNCH) bar = xcd_barrier_post((unsigned*)(F.ctl + CW_BAR), F.MISC + 8);
    const int lo = args.ph_lo, hi = args.ph_hi;
#define IN(k) (lo <= (k) && (k) < hi)
#define SEAM(k) do { if (IN(k) && IN((k) + 1)) xcd_barrier(bar); } while (0)
    unsigned char* ws = args.ws;
    const float* ada = (const float*)(ws + WS_ADA);

    if (IN(0)) { for (int rep = 0; rep < REP_P0; ++rep) { p0_prologue(F, args, rep == REP_P0 - 1); __syncthreads(); } } SEAM(0);
    if (IN(1)) { for (int rep = 0; rep < REP_P1; ++rep) modnorm_rows<false>(F, args.in[I_X], args.in[I_N1G], ada, 0, (bf16*)(ws + WS_H)); } SEAM(1);
    if (IN(2)) { {
        pg8::Gemm g{(const bf16*)(ws + WS_H), (const bf16*)(ws + WS_WIN_T), M, NIN, D, D, D}; pg8::StaticOrder S; S.init(M, NIN, F.G, F.bid);
        EpiIn E{ws, args.in[I_QNG], args.in[I_KNG]};
        pg8::gemm_phase<EpiIn, pg8::StaticOrder, true, true>(F.lds + RING_OFF, g, S, E);
#if REP_P2 > 1
        __syncthreads(); pg8::gemm_phase<EpiIn, pg8::StaticOrder, true, true>(F.lds + RING_OFF, g, S, E);
#endif
        }
    } SEAM(2);
    if (IN(3)) { for (int rep = 0; rep < REP_P3; ++rep) { __syncthreads(); pool_phase(F); __syncthreads(); compress_phase(F, args.in[I_KNG]); __syncthreads(); vtranspose_phase(F); } } SEAM(3);
    if (IN(4)) {
#ifdef PROBE_P4
        attention_phase<PROBE_P4>(F, args); __syncthreads();
#endif
        for (int rep = 0; rep < REP_P4; ++rep) { attention_phase<0>(F, args); __syncthreads(); } } SEAM(4);
    if (IN(5)) { {
        { pg8::Gemm g{(const bf16*)(ws + WS_PL), (const bf16*)(ws + WS_WEFF_T), M, D, POOLW, POOLW, POOLW}; pg8::StaticOrder S; S.init(M, D, F.G, F.bid);
          EpiMix<false> E{(bf16*)(ws + WS_MIX), (const bf16*)(ws + WS_GM), 0};
          pg8::gemm_phase<EpiMix<false>, pg8::StaticOrder, true, true>(F.lds + RING_OFF, g, S, E); }
        { pg8::Gemm g{(const bf16*)(ws + WS_YA), (const bf16*)(ws + WS_WBA_T), M, D, QW, QW, QW}; pg8::StaticOrder S; S.init(M, D, F.G, F.bid);
          EpiMix<true> E{(bf16*)(ws + WS_MIX), (const bf16*)(ws + WS_GM), 1024};
          pg8::gemm_phase<EpiMix<true>, pg8::StaticOrder, true, true>(F.lds + RING_OFF, g, S, E); } }
#if REP_P5 > 1
        { __syncthreads(); { pg8::Gemm g{(const bf16*)(ws + WS_PL), (const bf16*)(ws + WS_WEFF_T), M, D, POOLW, POOLW, POOLW}; pg8::StaticOrder S; S.init(M, D, F.G, F.bid);
          EpiMix<false> E{(bf16*)(ws + WS_MIX), (const bf16*)(ws + WS_GM), 0};
          pg8::gemm_phase<EpiMix<false>, pg8::StaticOrder, true, true>(F.lds + RING_OFF, g, S, E); }
        { pg8::Gemm g{(const bf16*)(ws + WS_YA), (const bf16*)(ws + WS_WBA_T), M, D, QW, QW, QW}; pg8::StaticOrder S; S.init(M, D, F.G, F.bid);
          EpiMix<true> E{(bf16*)(ws + WS_MIX), (const bf16*)(ws + WS_GM), 1024};
          pg8::gemm_phase<EpiMix<true>, pg8::StaticOrder, true, true>(F.lds + RING_OFF, g, S, E); } }
#endif
    } SEAM(5);
    if (IN(6)) { {
        pg8::Gemm g{(const bf16*)(ws + WS_MIX), (const bf16*)(ws + WS_WOUT_T), M, D, D, D, D}; pg8::StaticOrder S; S.init(M, D, F.G, F.bid);
        EpiRes E{args.in[I_X], args.out, ada, 2};
        pg8::gemm_phase<EpiRes, pg8::StaticOrder, true, true>(F.lds + RING_OFF, g, S, E);
#if REP_P6 > 1
        __syncthreads(); pg8::gemm_phase<EpiRes, pg8::StaticOrder, true, true>(F.lds + RING_OFF, g, S, E);
#endif
        }
    } SEAM(6);
    if (IN(7)) { for (int rep = 0; rep < REP_P7; ++rep) modnorm_rows<true>(F, args.out, args.in[I_N2G], ada, 3, (bf16*)(ws + WS_H)); } SEAM(7);
    if (IN(8)) { {
        pg8::Gemm g{(const bf16*)(ws + WS_H), (const bf16*)(ws + WS_WQ_T), M, PQW, D, D, D}; pg8::StaticOrder S; S.init(M, PQW, F.G, F.bid);
        EpiStoreBf16 E{(bf16*)(ws + WS_QV), PQW};
        pg8::gemm_phase<EpiStoreBf16, pg8::StaticOrder, true, true>(F.lds + RING_OFF, g, S, E);
#if REP_P8 > 1
        __syncthreads(); pg8::gemm_phase<EpiStoreBf16, pg8::StaticOrder, true, true>(F.lds + RING_OFF, g, S, E);
#endif
        }
    } SEAM(8);
    if (IN(9)) { for (int rep = 0; rep < REP_P9; ++rep) peer_select_phase(F); } SEAM(9);
#ifdef PROBE_XCD
    if (IN(10)) { if (F.tid == 0) __hip_atomic_store((unsigned*)(F.ctl + 2048 + F.bid), 100u + xb_xcc_id(), RLX_AGENT); }
#endif
    if (IN(10)) {
#ifdef PROBE_DOT
        peer_dot_phase<PROBE_DOT>(F); __syncthreads();
#endif
#ifdef PROBE_LOADRATE
        peer_loadrate_probe<PROBE_LOADRATE>(F); __syncthreads();
#endif
        peer_dot_phase<0>(F); } SEAM(10);
    if (IN(11)) { for (int rep = 0; rep < REP_P11; ++rep) peer_coef_phase(F); } SEAM(11);
#ifdef PROBE_XCD
    if (IN(12) && F.bid == 0 && F.tid == 0) { bool ok = true; for (int i = 0; i < F.G; ++i) { const unsigned a = __hip_atomic_load((unsigned*)(F.ctl + 2048 + i), RLX_AGENT), b0 = __hip_atomic_load((unsigned*)(F.ctl + 2048 + (i & 7)), RLX_AGENT); if (a != b0 || a < 100u) ok = false; }
        for (int i = 0; i < 8; ++i) for (int q = 0; q < i; ++q) if (__hip_atomic_load((unsigned*)(F.ctl + 2048 + i), RLX_AGENT) == __hip_atomic_load((unsigned*)(F.ctl + 2048 + q), RLX_AGENT)) ok = false;
        if (!ok) args.out[12345] = 1.0e9f; }
    __syncthreads();
#endif
    if (IN(12)) {
#if defined(CHECK_OUT_MFMA)
        peer_out_mfma_phase<1>(F, ada, args.out); __syncthreads(); VM_WAIT(); __syncthreads(); peer_out_phase<false, true>(F, ada, args.out);
#elif defined(OUT_VALU)
        for (int rep = 1; rep < REP_P10; ++rep) peer_out_phase<true>(F, ada, args.out); peer_out_phase<false>(F, ada, args.out);
#else
#ifdef PROBE_OUT
        peer_out_mfma_phase<1>(F, ada, args.out); __syncthreads();
#endif
        peer_out_mfma_phase<0>(F, ada, args.out);
#endif
    }
#undef IN
#undef SEAM
}

extern "C" void kernel_launch(void* const* d_in, const int* in_sizes, int n_in, void* d_out, int out_size, void* d_ws, size_t ws_size, hipStream_t stream) {
    static int grid = 0;
    if (grid == 0) {
        if (n_in != N_IN || in_sizes[0] != M * D || out_size != M * D || ws_size < WS_END) {
            fprintf(stderr, "kernel_launch: unexpected shapes: n_in %d in0 %d out %d ws %zu (need %zu)\n", n_in, n_in > 0 ? in_sizes[0] : -1, out_size, ws_size, (size_t)WS_END); grid = -1; return; }
        int dev = 0, cus = 0, per_cu = 0;
        if (hipGetDevice(&dev) != hipSuccess || hipDeviceGetAttribute(&cus, hipDeviceAttributeMultiprocessorCount, dev) != hipSuccess) { grid = -1; return; }
        if (hipFuncSetAttribute((const void*)fwd_kernel, hipFuncAttributeMaxDynamicSharedMemorySize, LDS_BYTES) != hipSuccess) { fprintf(stderr, "kernel_launch: hipFuncSetAttribute failed\n"); grid = -1; return; }
        if (hipOccupancyMaxActiveBlocksPerMultiprocessor(&per_cu, (const void*)fwd_kernel, NTHREADS, LDS_BYTES) != hipSuccess || per_cu < 1)
            fprintf(stderr, "kernel_launch: occupancy query reports %d workgroups per CU\n", per_cu);
        (void)hipGetLastError();
        grid = cus;
    }
    if (grid < 0) return;
    if (hipMemsetAsync((char*)d_ws + WS_CTL, 0, CTL_ZERO_BYTES, stream) != hipSuccess) return;
    Args a{};
    for (int i = 0; i < N_IN; ++i) a.in[i] = (const float*)d_in[i];
    a.out = (float*)d_out; a.ws = (unsigned char*)d_ws;
    if (MK_ONE_LAUNCH) {
        a.ph_lo = 0; a.ph_hi = N_PHASES; a.li = 0;
        hipLaunchKernelGGL(fwd_kernel, dim3(grid), dim3(NTHREADS), LDS_BYTES, stream, a);
    } else {
        for (int p = 0; p < N_PHASES; ++p) {
            a.ph_lo = p; a.ph_hi = p + 1; a.li = p;
            hipLaunchKernelGGL(fwd_kernel, dim3(grid), dim3(NTHREADS), LDS_BYTES, stream, a);
        }
    }
}
```

```cpp
#include <hip/hip_runtime.h>
#include <cstdio>
#include <cstdint>
namespace pg8 {
#define PG8_LAS __attribute__((address_space(3)))
typedef unsigned short bf16_t;
typedef short bf16x8 __attribute__((ext_vector_type(8)));
typedef float f32x4 __attribute__((ext_vector_type(4)));
typedef unsigned u32x4 __attribute__((ext_vector_type(4)));
constexpr int BM = 256, BK = 64, HALF = 128, HTB = HALF * BK * 2  , STAGE_BYTES = 8 * HTB, NXCD = 8, WGM = 8;

__host__ __device__ __forceinline__ int lds_byte(int r, int c) { const int st = (r >> 4) * 2 + (c >> 5), rr = r & 15, cc = c & 31, ob = rr * 64 + cc * 2; return st * 1024 + (ob ^ (((ob >> 9) & 1) << 5)); }
__host__ __device__ __forceinline__ void stage_rc(int b, int& R, int& C) { const int st = b / 1024, sb = b % 1024, swz = sb ^ (((sb >> 9) & 1) << 5); R = (st >> 1) * 16 + swz / 64; C = (st & 1) * 32 + (swz % 64) / 2; }
__host__ __device__ __forceinline__ int perm32(int rho) { const int n = rho >> 4, i = rho & 15; return 8 * (i >> 2) + 4 * n + (i & 3); }

struct Unit { int pm, pn; };
struct Gemm { const bf16_t* A; const bf16_t* Bt; int M, N, K, lda, ldb; };

struct StaticOrder {
    int nM, nN, nwg, G, c;
    __host__ __device__ void init(int M, int N, int G_, int c_) { nM = M / BM; nN = N / BM; nwg = nM * nN; G = G_; c = c_; }
    __host__ __device__ bool next(int i, Unit& u) const {
        const long L = (long)i * G + c; if (L >= nwg) return false;
        int wgid = (int)L; { const int q = nwg / NXCD, r = nwg % NXCD, xcd = wgid % NXCD, off = wgid / NXCD; wgid = (xcd < r ? xcd * (q + 1) : r * (q + 1) + (xcd - r) * q) + off; }
        const int nig = WGM * nN, gid = wgid / nig, fm = gid * WGM, gsz = (nM - fm) < WGM ? (nM - fm) : WGM;
        u.pm = fm + ((wgid % nig) % gsz); u.pn = (wgid % nig) / gsz; return true;
    }
    __device__ __forceinline__ void a_ready(const Unit&) const {}
    __device__ __forceinline__ void done(const Unit&) const {}
};

__device__ __forceinline__ unsigned cvt_pk_bf16(float lo, float hi) { unsigned r; asm volatile("v_cvt_pk_bf16_f32 %0, %1, %2" : "=v"(r) : "v"(lo), "v"(hi)); return r; }
template <class Epi, class Sched, bool ALIGN_EPI = false, bool SP2 = false>
__device__ __forceinline__ void gemm_phase(PG8_LAS unsigned char* lds, const Gemm g, const Sched& S, const Epi& E) {
    const int tid = threadIdx.x, wid = __builtin_amdgcn_readfirstlane(tid >> 6), lane = tid & 63, wr = wid >> 2, wc = wid & 3, fr = lane & 15, fq = lane >> 4;
    const int K = g.K, nt = K / BK;
    unsigned voffA[2], voffB[2];
#pragma unroll
    for (int i = 0; i < 2; ++i) { int R, C; stage_rc(tid * 16 + i * 8192, R, C); const int Rb = Epi::PERM ? ((R & ~31) + perm32(R & 31)) : R;
        voffA[i] = (unsigned)(R * g.lda + C) * 2u; voffB[i] = (unsigned)(Rb * g.ldb + C) * 2u; }
    const size_t kstep = (size_t)(BK * 2);
    const size_t hstepA = (size_t)HALF * g.lda * 2, hstepB = (size_t)HALF * g.ldb * 2;
    const size_t tstepA = 2 * hstepA, tstepB = 2 * hstepB;
    const unsigned ldsw = (unsigned)wid * 1024u;
    const int aoff = lds_byte(wr * 64 + fr, fq * 8), boff = lds_byte(wc * 32 + fr, fq * 8);
#define PG8_SA(b, h) (((b) * 2 + (h)) * HTB)
#define PG8_SB(b, h) ((4 + (b) * 2 + (h)) * HTB)
#define PG8_STAGE(bufoff, gbase, voff) do { _Pragma("unroll") for (int _i = 0; _i < 2; ++_i) \
        __builtin_amdgcn_global_load_lds((const unsigned*)((const char*)(gbase) + (voff)[_i]), (PG8_LAS unsigned*)(lds + (bufoff) + ldsw + _i * 8192), 16, 0, 0); } while (0)
#define PG8_LDA(dst, b, h) do { _Pragma("unroll") for (int m = 0; m < 4; ++m) _Pragma("unroll") for (int k = 0; k < 2; ++k) dst[m][k] = *(const PG8_LAS bf16x8*)(lds + PG8_SA(b, h) + aoff + m * 2048 + k * 1024); } while (0)
#define PG8_LDB(dst, b, h) do { _Pragma("unroll") for (int n = 0; n < 2; ++n) _Pragma("unroll") for (int k = 0; k < 2; ++k) dst[n][k] = *(const PG8_LAS bf16x8*)(lds + PG8_SB(b, h) + boff + n * 2048 + k * 1024); } while (0)
#define PG8_MMA(ai, bj, At, Bt) do { __builtin_amdgcn_s_setprio(1); _Pragma("unroll") for (int m = 0; m < 4; ++m) _Pragma("unroll") for (int n = 0; n < 2; ++n) _Pragma("unroll") for (int k = 0; k < 2; ++k) \
        acc[ai][bj][m][n] = __builtin_amdgcn_mfma_f32_16x16x32_bf16(Bt[n][k], At[m][k], acc[ai][bj][m][n], 0, 0, 0); __builtin_amdgcn_s_setprio(0); } while (0)
#define PG8_WAIT_V(n) asm volatile("s_waitcnt vmcnt(" #n ")" ::: "memory")
#define PG8_WAIT_L(n) asm volatile("s_waitcnt lgkmcnt(" #n ")" ::: "memory")
#define PG8_BAR __builtin_amdgcn_s_barrier()
#define PG8_SCHED __builtin_amdgcn_sched_barrier(0)
    Unit cur, nxt; int ui = 0;
    if (!S.next(0, cur)) return;
    f32x4 acc[2][2][4][2];
#pragma unroll
    for (int a = 0; a < 2; ++a)
#pragma unroll
        for (int b = 0; b < 2; ++b)
#pragma unroll
            for (int m = 0; m < 4; ++m)
#pragma unroll
                for (int n = 0; n < 2; ++n) acc[a][b][m][n] = (f32x4){0.f, 0.f, 0.f, 0.f};
    bf16x8 At[4][2], B0[2][2], B1[2][2];
    const char* cA = (const char*)g.A + (size_t)cur.pm * tstepA; const char* cB = (const char*)g.Bt + (size_t)cur.pn * tstepB;
    S.a_ready(cur);
    if constexpr (SP2) {
        PG8_STAGE(PG8_SB(0, 0), cB, voffB); PG8_STAGE(PG8_SB(0, 1), cB + hstepB, voffB); PG8_STAGE(PG8_SA(0, 0), cA, voffA); PG8_STAGE(PG8_SA(0, 1), cA + hstepA, voffA);
        if (wr == 1) PG8_BAR;
        PG8_WAIT_V(2); PG8_BAR;
        PG8_STAGE(PG8_SB(1, 0), cB + kstep, voffB); PG8_STAGE(PG8_SA(1, 0), cA + kstep, voffA); PG8_STAGE(PG8_SB(1, 1), cB + hstepB + kstep, voffB);
        PG8_WAIT_V(6); PG8_BAR;
    } else {
        PG8_STAGE(PG8_SB(0, 0), cB, voffB); PG8_STAGE(PG8_SA(0, 0), cA, voffA); PG8_STAGE(PG8_SB(0, 1), cB + hstepB, voffB); PG8_STAGE(PG8_SA(0, 1), cA + hstepA, voffA);
        if (wr == 1) PG8_BAR;
        PG8_WAIT_V(4); PG8_BAR;
        PG8_STAGE(PG8_SB(1, 0), cB + kstep, voffB); PG8_STAGE(PG8_SA(1, 0), cA + kstep, voffA); PG8_STAGE(PG8_SB(1, 1), cB + hstepB + kstep, voffB);
        PG8_WAIT_V(6); PG8_BAR;
    }
    for (;;) {
        const bool has_next = S.next(ui + 1, nxt);
        const char* nA = has_next ? (const char*)g.A + (size_t)nxt.pm * tstepA : cA; const char* nB = has_next ? (const char*)g.Bt + (size_t)nxt.pn * tstepB : cB;
        for (int t = 0; t < nt; t += 2) {
            const bool last = (t == nt - 2);
            const char* a1 = cA + (size_t)(t + 1) * kstep;
            const char* a2 = last ? nA : cA + (size_t)(t + 2) * kstep; const char* b2 = last ? nB : cB + (size_t)(t + 2) * kstep;
            const char* a3 = a2 + kstep; const char* b3 = b2 + kstep;
            if (last && has_next) S.a_ready(nxt);
            if constexpr (SP2) {
            PG8_LDB(B0, 0, 0); PG8_LDB(B1, 0, 1); PG8_SCHED; PG8_LDA(At, 0, 0); PG8_STAGE(PG8_SA(1, 1), a1 + hstepA, voffA);
            PG8_WAIT_V(8); PG8_WAIT_L(0); PG8_BAR; PG8_MMA(0, 0, At, B0); PG8_MMA(0, 1, At, B1); PG8_BAR; PG8_SCHED;
            PG8_LDA(At, 0, 1); PG8_STAGE(PG8_SB(0, 0), b2, voffB); PG8_STAGE(PG8_SB(0, 1), b2 + hstepB, voffB); PG8_STAGE(PG8_SA(0, 0), a2, voffA);
            PG8_WAIT_V(8); PG8_WAIT_L(0); PG8_BAR; PG8_MMA(1, 0, At, B0); PG8_MMA(1, 1, At, B1); PG8_BAR; PG8_SCHED;
            PG8_LDB(B0, 1, 0); PG8_LDB(B1, 1, 1); PG8_SCHED; PG8_LDA(At, 1, 0); PG8_STAGE(PG8_SA(0, 1), a2 + hstepA, voffA);
            PG8_WAIT_V(8); PG8_WAIT_L(0); PG8_BAR; PG8_MMA(0, 0, At, B0); PG8_MMA(0, 1, At, B1); PG8_BAR; PG8_SCHED;
            PG8_LDA(At, 1, 1); PG8_STAGE(PG8_SB(1, 0), b3, voffB); PG8_STAGE(PG8_SB(1, 1), b3 + hstepB, voffB); PG8_STAGE(PG8_SA(1, 0), a3, voffA);
            PG8_WAIT_V(8); PG8_WAIT_L(0); PG8_BAR; PG8_MMA(1, 0, At, B0); PG8_MMA(1, 1, At, B1); PG8_BAR; PG8_SCHED;
            } else {
            PG8_LDB(B0, 0, 0); PG8_SCHED; PG8_LDA(At, 0, 0); PG8_STAGE(PG8_SA(1, 1), a1 + hstepA, voffA);
            PG8_WAIT_L(8); PG8_BAR; PG8_WAIT_L(0); PG8_MMA(0, 0, At, B0); PG8_BAR; PG8_SCHED;
            PG8_LDB(B1, 0, 1); PG8_STAGE(PG8_SB(0, 0), b2, voffB);
            PG8_BAR; PG8_WAIT_L(0); PG8_MMA(0, 1, At, B1); PG8_BAR;
            PG8_LDA(At, 0, 1); PG8_STAGE(PG8_SA(0, 0), a2, voffA);
            PG8_BAR; PG8_WAIT_L(0); PG8_MMA(1, 0, At, B0); PG8_BAR; PG8_SCHED;
            PG8_STAGE(PG8_SB(0, 1), b2 + hstepB, voffB);
            PG8_WAIT_V(6); PG8_BAR; PG8_MMA(1, 1, At, B1); PG8_BAR;
            PG8_LDB(B0, 1, 0); PG8_SCHED; PG8_LDA(At, 1, 0); PG8_STAGE(PG8_SA(0, 1), a2 + hstepA, voffA);
            PG8_WAIT_L(8); PG8_BAR; PG8_WAIT_L(0); PG8_MMA(0, 0, At, B0); PG8_BAR; PG8_SCHED;
            PG8_LDB(B1, 1, 1); PG8_STAGE(PG8_SB(1, 0), b3, voffB);
            PG8_BAR; PG8_WAIT_L(0); PG8_MMA(0, 1, At, B1); PG8_BAR;
            PG8_LDA(At, 1, 1); PG8_STAGE(PG8_SA(1, 0), a3, voffA);
            PG8_BAR; PG8_WAIT_L(0); PG8_MMA(1, 0, At, B0); PG8_BAR; PG8_SCHED;
            PG8_STAGE(PG8_SB(1, 1), b3 + hstepB, voffB);
            PG8_WAIT_V(6); PG8_BAR; PG8_MMA(1, 1, At, B1); PG8_BAR;
            }
        }
        if constexpr (ALIGN_EPI) { if (wr == 0) PG8_BAR; }
        if constexpr (!Epi::AFTER_DRAIN) { E(acc, cur, wr, wc, fr, fq); S.done(cur); }
        if (!has_next) break;
#pragma unroll
        for (int a = 0; a < 2; ++a)
#pragma unroll
            for (int b = 0; b < 2; ++b)
#pragma unroll
                for (int m = 0; m < 4; ++m)
#pragma unroll
                    for (int n = 0; n < 2; ++n) acc[a][b][m][n] = (f32x4){0.f, 0.f, 0.f, 0.f};
        cur = nxt; cA = nA; cB = nB; ++ui;
        if constexpr (ALIGN_EPI) { if (wr == 1) PG8_BAR; }
    }
    PG8_WAIT_V(0);
    if constexpr (!ALIGN_EPI) { if (wr == 0) PG8_BAR; }
    PG8_BAR;
    if constexpr (Epi::AFTER_DRAIN) { E.fused(acc, cur, wr, wc, fr, fq, lds, wid, lane); S.done(cur); }
#undef PG8_SA
#undef PG8_SB
#undef PG8_STAGE
#undef PG8_LDA
#undef PG8_LDB
#undef PG8_MMA
#undef PG8_WAIT_V
#undef PG8_WAIT_L
#undef PG8_BAR
#undef PG8_SCHED
}
}

constexpr int NWAVES = 8, NTHREADS = NWAVES * 64;
constexpr int BATCH = 8, SEQ = 4096, D = 1024, M = BATCH * SEQ;
constexpr int POOLW = 512, QW = 512, NG = 2, HD = 64, NBG = BATCH * NG;
constexpr int IN_COLS = 3864, NIN = 4096;
constexpr int NCMP = 255, NCMP_PAD = 256, NSEL = 64;
constexpr int PH = 8, PK = 128, PTOP = 16, PQD = 256, PQW = PH * PQD;
constexpr int NEXP = PK * PK;
constexpr float EPS = 1e-6f;
enum { I_X = 0, I_C, I_RELB, I_ADAW, I_ADAB, I_N1G, I_N2G, I_WIN, I_POOLW, I_POOLS, I_CPEK, I_CW1K, I_CW2K, I_CPEV, I_CW1V, I_CW2V, I_QNG, I_KNG, I_WBP, I_WBA, I_WOUT, I_PWQ, I_PSK, I_PU, I_PV, N_IN };

constexpr size_t MiB = 1u << 20, KiB = 1u << 10;
constexpr size_t WS_CTL = 0, CTL_ZERO_BYTES = 1 * MiB;
constexpr size_t WS_ADA = 1 * MiB;
constexpr size_t WS_CB1K = 64 * KiB;
constexpr size_t WS_CB1V = WS_CB1K + 1 * KiB;
constexpr size_t WS_BIASL = WS_ADA + 256 * KiB;
constexpr size_t WS_WIN_T = 2 * MiB;
constexpr size_t WS_WEFF_T = 10 * MiB;
constexpr size_t WS_WBA_T = 11 * MiB;
constexpr size_t WS_WOUT_T = 12 * MiB;
constexpr size_t WS_WQ_T = 14 * MiB;
constexpr size_t WS_SUBK = 18 * MiB;
constexpr size_t WS_CW1K_T = 18 * MiB + 512 * KiB;
constexpr size_t WS_CW1V_T = 19 * MiB;
constexpr size_t WS_CW2K_T = 19 * MiB + 512 * KiB;
constexpr size_t WS_CW2V_T = WS_CW2K_T + 64 * KiB;
constexpr size_t WS_KC = 20 * MiB;
constexpr size_t WS_VCT = 20 * MiB + 512 * KiB;
constexpr size_t WS_GATE = 21 * MiB;
constexpr size_t WS_UB = 24 * MiB;
constexpr size_t WS_VB = 56 * MiB;
constexpr size_t WS_SCLU = WS_UB + 16 * MiB, WS_SCLV = WS_SCLU + 64 * KiB;
constexpr size_t WS_H = 88 * MiB;
constexpr size_t WS_ZP = 152 * MiB;
constexpr size_t WS_Q = 184 * MiB;
constexpr size_t WS_KCR = 216 * MiB;
constexpr size_t WS_VCR = 225 * MiB;
constexpr size_t WS_KS = 234 * MiB, WS_VS = 242 * MiB, WS_KW = 250 * MiB, WS_VW = 258 * MiB;
constexpr size_t WS_VST = 266 * MiB, WS_VWT = 274 * MiB;
constexpr size_t WS_PL = 282 * MiB;
constexpr size_t WS_YA = 314 * MiB;
constexpr size_t WS_GM = 346 * MiB;
constexpr size_t WS_MIX = WS_ZP;
constexpr size_t WS_QV = WS_GM;
constexpr size_t WS_EID = WS_PL;
constexpr size_t WS_GW = WS_PL + 16 * MiB;
constexpr size_t WS_PART = WS_GM;
constexpr size_t WS_CF = WS_YA;
constexpr size_t WS_CFS = WS_YA + 8 * MiB;
constexpr size_t WS_H8 = WS_ZP;
constexpr size_t WS_HS = WS_ZP + 32 * MiB;
constexpr size_t WS_END = 474 * MiB;
constexpr int CW_TMO = 0, CW_CODE = 1, CW_BAR = 4096;

constexpr int RING_OFF = 0, RING_BYTES = 131072;
constexpr int LDSCTL_OFF = RING_BYTES, MISC_OFF = LDSCTL_OFF + 320;
constexpr int LDS_BYTES = 147456;

#define GAS __attribute__((address_space(1)))
#define LAS __attribute__((address_space(3)))
typedef unsigned short bf16;
typedef unsigned v4u __attribute__((ext_vector_type(4)));
typedef unsigned v2u __attribute__((ext_vector_type(2)));
typedef int v2i __attribute__((ext_vector_type(2)));
typedef float f32x4 __attribute__((ext_vector_type(4)));
typedef short bf16x8 __attribute__((ext_vector_type(8)));
typedef GAS unsigned gu32;
#define RLX_AGENT __ATOMIC_RELAXED, __HIP_MEMORY_SCOPE_AGENT
#define LDS_WAIT() asm volatile("s_waitcnt lgkmcnt(0)" ::: "memory")
#define VM_WAIT() asm volatile("s_waitcnt vmcnt(0)" ::: "memory")
__device__ __forceinline__ unsigned f2bf(float f) { unsigned u = __builtin_bit_cast(unsigned, f); return (u + 0x7fffu + ((u >> 16) & 1u)) >> 16; }
__device__ __forceinline__ unsigned pk2(float lo, float hi) { return f2bf(lo) | (f2bf(hi) << 16); }
__device__ __forceinline__ float bflo(unsigned w) { return __builtin_bit_cast(float, w << 16); }
__device__ __forceinline__ float bfhi(unsigned w) { return __builtin_bit_cast(float, w & 0xffff0000u); }
__device__ __forceinline__ float sigmoidf_(float v) { return __builtin_amdgcn_rcpf(1.0f + __builtin_amdgcn_exp2f(v * -1.4426950408889634f)); }
typedef __bf16 bf16x2_hw __attribute__((ext_vector_type(2)));
typedef float f32x2_hw __attribute__((ext_vector_type(2)));
__device__ __forceinline__ unsigned pkh(float lo, float hi) { return __builtin_bit_cast(unsigned, __builtin_convertvector((f32x2_hw){lo, hi}, bf16x2_hw)); }
__device__ __forceinline__ float gelu_tanh_safe(float v) { const float u = 0.7978845608028654f * (v + 0.044715f * v * v * v); return 0.5f * v * (1.0f + tanhf(u)); }
template <int CTRL> __device__ __forceinline__ float dppf(float v) { return __builtin_bit_cast(float, __builtin_amdgcn_update_dpp(0, __builtin_bit_cast(int, v), CTRL, 0xF, 0xF, true)); }
template <int CTRL> __device__ __forceinline__ int dppi(int v) { return __builtin_amdgcn_update_dpp(0, v, CTRL, 0xF, 0xF, true); }
#define DPP_XOR1 0xB1
#define DPP_XOR2 0x4E
#define DPP_HMIR 0x141
#define DPP_ROR8 0x128
__device__ __forceinline__ void swap16_(float& a, float& b) { asm volatile("v_nop\n\tv_nop\n\tv_permlane16_swap_b32 %0, %1" : "+v"(a), "+v"(b)); }
__device__ __forceinline__ void swap32_(float& a, float& b) { asm volatile("v_nop\n\tv_nop\n\tv_permlane32_swap_b32 %0, %1" : "+v"(a), "+v"(b)); }
__device__ __forceinline__ float sum_xor16(float v) { float a = v, b = v; swap16_(a, b); return a + b; }
__device__ __forceinline__ float sum_xor32(float v) { float a = v, b = v; swap32_(a, b); return a + b; }
__device__ __forceinline__ float max_xor16(float v) { float a = v, b = v; swap16_(a, b); return fmaxf(a, b); }
__device__ __forceinline__ float max_xor32(float v) { float a = v, b = v; swap32_(a, b); return fmaxf(a, b); }
__device__ __forceinline__ float wave_sum(float v) {
    v += dppf<DPP_XOR1>(v); v += dppf<DPP_XOR2>(v); v += dppf<DPP_HMIR>(v); v += dppf<DPP_ROR8>(v);
    return sum_xor32(sum_xor16(v));
}
__device__ __forceinline__ float wave_max(float v) {
    v = fmaxf(v, dppf<DPP_XOR1>(v)); v = fmaxf(v, dppf<DPP_XOR2>(v)); v = fmaxf(v, dppf<DPP_HMIR>(v)); v = fmaxf(v, dppf<DPP_ROR8>(v));
    return max_xor32(max_xor16(v));
}

#define XB_TMO      128
#define XB_XCNT(j)  (256  + 64 * (j))
#define XB_XSUB(j)  (1280 + 64 * (j))
#define XB_XGEN(j)  (2304 + 64 * (j))
#define XB_TOP      3328
#define XB_TOPGEN   3392
#define XCD_BAR_WORDS 3456
#define XB_SPIN_CAP (1u << 18)
__device__ __forceinline__ unsigned xb_ld(unsigned* p)              { return __hip_atomic_load(p, __ATOMIC_RELAXED, __HIP_MEMORY_SCOPE_AGENT); }
__device__ __forceinline__ unsigned xb_add(unsigned* p, unsigned v) { return __hip_atomic_fetch_add(p, v, __ATOMIC_RELAXED, __HIP_MEMORY_SCOPE_AGENT); }
__device__ __forceinline__ unsigned xb_xcc_id() { return (unsigned)__builtin_amdgcn_s_getreg((3 << 11) | 20) & 0xFu; }
#define XB_SPIN(cond, bar) do { unsigned _sp = 0; while (cond) { __builtin_amdgcn_s_sleep(1); \
    if ((++_sp & 255u) == 0u) { if (xb_ld(&(bar)[XB_TMO])) break; if (_sp > XB_SPIN_CAP) { atomicAdd(&(bar)[XB_TMO], 1u); break; } } } } while (0)
struct XcdBarrier { unsigned* bar; unsigned x; volatile LAS unsigned* st; };
__device__ __forceinline__ XcdBarrier xcd_barrier_post(unsigned* bar, volatile LAS unsigned* st) {
    XcdBarrier b; b.bar = bar; b.x = xb_xcc_id(); b.st = st;
    if (threadIdx.x == 0) (void)xb_add(&bar[XB_XCNT(b.x)], 1u);
    return b;
}
__device__ __forceinline__ void xcd_barrier_complete(unsigned* bar, unsigned x, unsigned& nloc, unsigned& nx) {
    const unsigned G = gridDim.x * gridDim.y * gridDim.z;
    unsigned sum, cnt, mine, sp = 0u;
    for (;;) {
        sum = 0u; cnt = 0u; mine = 0u;
#pragma unroll
        for (unsigned j = 0; j < 16; ++j) { const unsigned c = xb_ld(&bar[XB_XCNT(j)]); sum += c; cnt += (c > 0u) ? 1u : 0u; mine = (j == x) ? c : mine; }
        if (sum == G) break;
        __builtin_amdgcn_s_sleep(1);
        if ((++sp & 255u) == 0u) { if (xb_ld(&bar[XB_TMO])) break; if (sp > XB_SPIN_CAP) { atomicAdd(&bar[XB_TMO], 1u); break; } }
    }
    nloc = mine > 0u ? mine : 1u; nx = cnt > 0u ? cnt : 1u;
}
__device__ __forceinline__ void xcd_barrier(const XcdBarrier& b) {
    asm volatile("s_waitcnt vmcnt(0)" ::: "memory");
    __syncthreads();
    if (threadIdx.x == 0) {
        unsigned* bar = b.bar;
        __builtin_amdgcn_s_waitcnt(0);
        unsigned nloc = b.st[0], nx = b.st[1];
        if (nloc == 0u) { xcd_barrier_complete(bar, b.x, nloc, nx); b.st[0] = nloc; b.st[1] = nx; }
        const unsigned old = xb_add(&bar[XB_XSUB(b.x)], 1u);
        const unsigned gen = old / nloc;
        if (old + 1u == (gen + 1u) * nloc) {
            __builtin_amdgcn_fence(__ATOMIC_RELEASE, "agent");
            asm volatile("s_waitcnt vmcnt(0)" ::: "memory");
            const unsigned og = xb_add(&bar[XB_TOP], 1u);
            const unsigned tg = og / nx;
            if (og + 1u == (tg + 1u) * nx) xb_add(&bar[XB_TOPGEN], 1u);
            else XB_SPIN(xb_ld(&bar[XB_TOPGEN]) == tg, bar);
            __builtin_amdgcn_fence(__ATOMIC_ACQUIRE, "agent");
            xb_add(&bar[XB_XGEN(b.x)], 1u);
            asm volatile("s_waitcnt vmcnt(0)" ::: "memory");
        } else {
            XB_SPIN(xb_ld(&bar[XB_XGEN(b.x)]) == gen, bar);
            __builtin_amdgcn_fence(__ATOMIC_ACQUIRE, "agent");
            asm volatile("s_waitcnt vmcnt(0)" ::: "memory");
        }
    }
    __syncthreads();
}

struct Args { const float* in[N_IN]; float* out; unsigned char* ws; int ph_lo, ph_hi, li, pad; };
struct Frame {
    LAS unsigned char* lds;
    volatile LAS unsigned* MISC;
    gu32* ctl;
    int tid, lane, wave, G, bid;
    unsigned char* ws;
};

template <bool I8> __device__ __forceinline__ void cvt_row_store(const f32x4 (&v)[4], int row, unsigned char* dst, float* inv_scale, int lane) {
    float m = 0.f;
#pragma unroll
    for (int j = 0; j < 4; ++j) m = fmaxf(m, fmaxf(fmaxf(fabsf(v[j].x), fabsf(v[j].y)), fmaxf(fabsf(v[j].z), fabsf(v[j].w))));
    m = wave_max(m);
    unsigned ww[4]; float isc;
    if (I8) { const float sc = m > 0.f ? 127.0f / m : 0.f; isc = m * (1.0f / 127.0f);
#pragma unroll
        for (int j = 0; j < 4; ++j) { const int q0 = (int)rintf(v[j].x * sc), q1 = (int)rintf(v[j].y * sc), q2 = (int)rintf(v[j].z * sc), q3 = (int)rintf(v[j].w * sc);
            ww[j] = ((unsigned)q0 & 0xffu) | (((unsigned)q1 & 0xffu) << 8) | (((unsigned)q2 & 0xffu) << 16) | (((unsigned)q3 & 0xffu) << 24); } }
    else { const unsigned E = (__builtin_bit_cast(unsigned, m) >> 23) & 0xffu; float sc = 1.f; isc = 1.f;
        if (E >= 8u && E <= 250u) { sc = __builtin_bit_cast(float, (261u - E) << 23); isc = __builtin_bit_cast(float, (E - 7u) << 23); }
#pragma unroll
        for (int j = 0; j < 4; ++j) { int t = __builtin_amdgcn_cvt_pk_fp8_f32(v[j].x * sc, v[j].y * sc, 0, false); t = __builtin_amdgcn_cvt_pk_fp8_f32(v[j].z * sc, v[j].w * sc, t, true); ww[j] = (unsigned)t; } }
    *(GAS v4u*)(dst + (size_t)(lane >> 3) * NEXP * 128 + (size_t)row * 128 + 16 * (lane & 7)) = (v4u){ww[0], ww[1], ww[2], ww[3]};
    if (lane == 0) inv_scale[row] = isc;
}
template <bool I8> __device__ __forceinline__ void cvt_rows_8bit(const float* src, unsigned char* dst, float* inv_scale, int gw, int NGW, int lane) {
    for (int row = gw; row < NEXP; row += 2 * NGW) {
        const int row1 = row + NGW; const bool has1 = row1 < NEXP;
        f32x4 v0[4], v1[4];
#pragma unroll
        for (int j = 0; j < 4; ++j) v0[j] = *(const GAS f32x4*)(src + (size_t)row * D + 16 * lane + 4 * j);
#pragma unroll
        for (int j = 0; j < 4; ++j) v1[j] = has1 ? *(const GAS f32x4*)(src + (size_t)row1 * D + 16 * lane + 4 * j) : (f32x4){0.f, 0.f, 0.f, 0.f};
        cvt_row_store<I8>(v0, row, dst, inv_scale, lane);
        if (has1) cvt_row_store<I8>(v1, row1, dst, inv_scale, lane);
    }
}
__device__ __forceinline__ void p0_transpose_item(const float* W, int ldw, int src_col0, int valid, int K, bf16* WT, int dst_row0, int k0, LAS float* scr, int lane) {
    const int n_ = lane & 31;
#pragma unroll 8
    for (int i = 0; i < 32; ++i) { const int kk = 2 * i + (lane >> 5); scr[kk * 33 + n_] = (n_ < valid) ? W[(size_t)(k0 + kk) * ldw + src_col0 + n_] : 0.f; }
    LDS_WAIT(); asm volatile("" ::: "memory");
    const int c = lane & 7;
#pragma unroll
    for (int j = 0; j < 4; ++j) { const int n = (lane >> 3) + 8 * j; const LAS float* s = scr + (8 * c) * 33 + n;
        v4u o; o.x = pk2(s[0 * 33], s[1 * 33]); o.y = pk2(s[2 * 33], s[3 * 33]); o.z = pk2(s[4 * 33], s[5 * 33]); o.w = pk2(s[6 * 33], s[7 * 33]);
        *(GAS v4u*)(WT + (size_t)(dst_row0 + n) * K + k0 + 8 * c) = o; }
    LDS_WAIT(); asm volatile("" ::: "memory");
}
__device__ __forceinline__ bool p0_mat(int& r, const float* W, int K, int N, bf16* WT, LAS float* scr, int lane) {
    const int ng = N / 32, items = ng * (K / 64);
    if (r < items) { const int kb = r / ng, nb = r % ng; p0_transpose_item(W, N, 32 * nb, 32, K, WT, 32 * nb, 64 * kb, scr, lane); return true; }
    r -= items; return false;
}
__device__ __forceinline__ void cvt_f32_bf16_stream(const float* src, bf16* dst, size_t n8, size_t gtid, size_t gthreads) {
    for (size_t i = gtid; i < n8; i += gthreads) {
        const f32x4 a = *(const GAS f32x4*)(src + 8 * i), b = *(const GAS f32x4*)(src + 8 * i + 4);
        v4u o; o.x = pk2(a.x, a.y); o.y = pk2(a.z, a.w); o.z = pk2(b.x, b.y); o.w = pk2(b.z, b.w);
        *(GAS v4u*)(dst + 8 * i) = o; }
}

__device__ __forceinline__ void p0_prologue(Frame& F, const Args& args, bool do_bias = true) {
    unsigned char* ws = F.ws;
    const int gw = F.bid * NWAVES + F.wave, NGW = F.G * NWAVES;
    const size_t gtid = (size_t)F.bid * NTHREADS + F.tid, gthreads = (size_t)F.G * NTHREADS;
    {
        LAS float* sl = (LAS float*)(F.lds);
        LAS float* red = (LAS float*)(F.lds + 32768);
        const float* c = args.in[I_C];
        { f32x4 cv[4];
#pragma unroll
          for (int q = 0; q < 4; ++q) cv[q] = *(const GAS f32x4*)(c + 4 * (F.tid + NTHREADS * q));
#pragma unroll
          for (int q = 0; q < 4; ++q) { f32x4 o; o.x = cv[q].x / (1.0f + __expf(-cv[q].x)); o.y = cv[q].y / (1.0f + __expf(-cv[q].y)); o.z = cv[q].z / (1.0f + __expf(-cv[q].z)); o.w = cv[q].w / (1.0f + __expf(-cv[q].w));
              *(LAS f32x4*)(sl + 4 * (F.tid + NTHREADS * q)) = o; } }
        __syncthreads();
        for (int cb = F.bid; cb < 6 * D / 24; cb += F.G) {
            const int j0 = cb * 24;
            if (F.tid < 510) {
                const int kk = F.tid / 6, c4 = F.tid % 6;
                const float* w = args.in[I_ADAW] + j0 + 4 * c4;
                f32x4 wv[13];
#pragma unroll
                for (int m = 0; m < 13; ++m) { const int k = kk + 85 * m; wv[m] = (k < D) ? *(const GAS f32x4*)(w + (size_t)k * (6 * D)) : (f32x4){0.f, 0.f, 0.f, 0.f}; }
                f32x4 a[BATCH];
#pragma unroll
                for (int b = 0; b < BATCH; ++b) a[b] = (f32x4){0.f, 0.f, 0.f, 0.f};
#pragma unroll
                for (int m = 0; m < 13; ++m) { const int k = kk + 85 * m; const int kc = k < D ? k : 0;
#pragma unroll
                    for (int b = 0; b < BATCH; ++b) a[b] = a[b] + wv[m] * sl[b * D + kc]; }
#pragma unroll
                for (int b = 0; b < BATCH; ++b) { LAS float* rp = red + (kk * 24 + 4 * c4) * BATCH + b; rp[0] = a[b].x; rp[BATCH] = a[b].y; rp[2 * BATCH] = a[b].z; rp[3 * BATCH] = a[b].w; }
            }
            __syncthreads();
            if (F.tid < 24 * BATCH) { const int jj = F.tid / BATCH, b = F.tid % BATCH; float s = 0.f;
#pragma unroll 5
                for (int kk = 0; kk < 85; ++kk) s += red[(kk * 24 + jj) * BATCH + b];
                ((float*)(ws + WS_ADA))[b * (6 * D) + j0 + jj] = s + args.in[I_ADAB][j0 + jj]; }
            __syncthreads();
        }
    }
    if (F.bid >= 8 && F.bid < 40 && do_bias) {
        const int bb = F.bid - 8, kv = bb & 1, ch = bb >> 1;
        const float* pe = args.in[kv == 0 ? I_CPEK : I_CPEV]; const float* w1 = args.in[kv == 0 ? I_CW1K : I_CW1V];
        LAS float* red = (LAS float*)(F.lds);
        const int j = F.tid & 127, ic = F.tid >> 7; float s = 0.f;
        const int i0 = ch * 128 + ic * 32;
#pragma unroll 8
        for (int i = i0; i < i0 + 32; ++i) s += pe[i] * w1[(size_t)i * 128 + j];
        red[ic * 128 + j] = s; __syncthreads();
        if (F.tid < 128) atomicAdd((float*)(ws + (kv == 0 ? WS_CB1K : WS_CB1V)) + F.tid, (red[F.tid] + red[128 + F.tid]) + (red[256 + F.tid] + red[384 + F.tid]));
        __syncthreads();
    } else if (F.bid == 2) {
        for (int i = F.tid; i < 8 * 128; i += NTHREADS) { const int h = i >> 7, rel = i & 127;
            int bk = rel;
            if (rel >= 16) bk = 16 + (rel >= 19) + (rel >= 21) + (rel >= 24) + (rel >= 27) + (rel >= 31) + (rel >= 35) + (rel >= 40) + (rel >= 46) + (rel >= 52) + (rel >= 59) + (rel >= 67) + (rel >= 77) + (rel >= 87) + (rel >= 99) + (rel >= 113);
            ((float*)(ws + WS_BIASL))[i] = args.in[I_RELB][bk * 8 + h]; }
        if (F.tid < 64) {
            float mq = fabsf(args.in[I_QNG][F.tid]), mk = fmaxf(fmaxf(fabsf(args.in[I_KNG][F.tid]), fabsf(args.in[I_KNG][64 + F.tid])), fabsf(args.in[I_KNG][128 + F.tid]));
            float mb = fmaxf(fmaxf(fabsf(args.in[I_RELB][F.tid]), fabsf(args.in[I_RELB][64 + F.tid])), fmaxf(fabsf(args.in[I_RELB][128 + F.tid]), fabsf(args.in[I_RELB][192 + F.tid])));
            mq = wave_max(mq); mk = wave_max(mk); mb = wave_max(mb);
            if (F.tid == 0) ((float*)(ws + WS_BIASL))[8 * 128] = 8.0f * mq * mk + mb; }
    }
    {
        LAS float* scr = (LAS float*)(F.lds + F.wave * 16384);
        constexpr int I_WINT = (NIN / 32) * (D / 64);
        constexpr int NITEMS = I_WINT + (1024 / 32) * (512 / 64) + (1024 / 32) * (1024 / 64) + (2048 / 32) * (1024 / 64) + 2 * (128 / 32) * (2048 / 64) + 2 * (64 / 32) * (128 / 64);
        for (int it = gw; it < NITEMS; it += NGW) {
            int r = it;
            if (r < I_WINT) {
                const int grp = r % (NIN / 32), kb = r / (NIN / 32);
                const int tile = grp >> 3, ct0 = (grp & 7) * 32;
                const int L0 = 64 * ((ct0 >> 5) & 3) + 32 * (ct0 >> 7);
                int src0, valid = 32;
                if (tile < 7) src0 = 256 * tile + L0; else if (tile < 15) src0 = 1816 + 256 * (tile - 7) + L0; else { src0 = 1792 + L0; valid = (L0 == 0) ? 24 : 0; }
                if (valid == 0) src0 = 0;
                p0_transpose_item(args.in[I_WIN], IN_COLS, src0, valid, D, (bf16*)(ws + WS_WIN_T), 32 * grp, 64 * kb, scr, F.lane);
                continue; }
            r -= I_WINT;
            if (p0_mat(r, args.in[I_WBA], 512, 1024, (bf16*)(ws + WS_WBA_T), scr, F.lane)) continue;
            if (p0_mat(r, args.in[I_WOUT], 1024, 1024, (bf16*)(ws + WS_WOUT_T), scr, F.lane)) continue;
            if (p0_mat(r, args.in[I_PWQ], 1024, 2048, (bf16*)(ws + WS_WQ_T), scr, F.lane)) continue;
            if (p0_mat(r, args.in[I_CW1K], 2048, 128, (bf16*)(ws + WS_CW1K_T), scr, F.lane)) continue;
            if (p0_mat(r, args.in[I_CW1V], 2048, 128, (bf16*)(ws + WS_CW1V_T), scr, F.lane)) continue;
            if (p0_mat(r, args.in[I_CW2K], 128, 64, (bf16*)(ws + WS_CW2K_T), scr, F.lane)) continue;
            p0_mat(r, args.in[I_CW2V], 128, 64, (bf16*)(ws + WS_CW2V_T), scr, F.lane);
        }
    }
    {
        const float* pw = args.in[I_POOLW]; const float* ps = args.in[I_POOLS]; const float* wbp = args.in[I_WBP];
        bf16* weff = (bf16*)(ws + WS_WEFF_T);
        LAS float* PWl = (LAS float*)(F.lds);
        LAS float* WBl = (LAS float*)(F.lds + 128 * 129 * 4);
        __syncthreads();
        for (int bb = F.bid; bb < 256; bb += F.G) {
            const int g = bb >> 6, d0 = (bb & 63) * 16;
            { f32x4 t[8];
#pragma unroll
              for (int q = 0; q < 8; ++q) t[q] = *(const GAS f32x4*)(pw + (size_t)g * 16384 + 4 * (F.tid + NTHREADS * q));
#pragma unroll
              for (int q = 0; q < 8; ++q) { const int i = 4 * (F.tid + NTHREADS * q); LAS float* d = PWl + (i >> 7) * 129 + (i & 127); d[0] = t[q].x; d[1] = t[q].y; d[2] = t[q].z; d[3] = t[q].w; }
              const int cc = F.tid >> 2, d4 = (F.tid & 3) * 4;
              const f32x4 wv = *(const GAS f32x4*)(wbp + (size_t)(g * 128 + cc) * D + d0 + d4); const float pv = ps[g * 128 + cc];
              LAS float* d = WBl + cc * 17 + d4; d[0] = wv.x * pv; d[1] = wv.y * pv; d[2] = wv.z * pv; d[3] = wv.w * pv; }
            __syncthreads();
            const int c = F.tid & 127, q = F.tid >> 7;
            float acc4[4] = {0.f, 0.f, 0.f, 0.f};
#pragma unroll 4
            for (int cc = 0; cc < 128; ++cc) { const float a = PWl[c * 129 + cc];
#pragma unroll
                for (int e = 0; e < 4; ++e) acc4[e] += a * WBl[cc * 17 + 4 * q + e]; }
#pragma unroll
            for (int e = 0; e < 4; ++e) weff[(size_t)(d0 + 4 * q + e) * POOLW + g * 128 + c] = (bf16)f2bf(acc4[e]);
            __syncthreads();
        }
    }
    cvt_f32_bf16_stream(args.in[I_PSK], (bf16*)(ws + WS_SUBK), (size_t)16 * 128 * 128 / 8, gtid, gthreads);
    cvt_rows_8bit<true>(args.in[I_PU], ws + WS_UB, (float*)(ws + WS_SCLU), gw, NGW, F.lane);
    cvt_rows_8bit<false>(args.in[I_PV], ws + WS_VB, (float*)(ws + WS_SCLV), gw, NGW, F.lane);
}

template <bool Q8> __device__ __forceinline__ void modnorm_rows(Frame& F, const float* x, const float* g, const float* ada, int shift_idx, bf16* out) {
    const int gw = F.bid * NWAVES + F.wave, NGW = F.G * NWAVES;
    for (int m = gw; m < M; m += NGW) {
        const int b = m >> 12;
        const GAS f32x4* xr = (const GAS f32x4*)(x + (size_t)m * D) + F.lane;
        const GAS f32x4* gr = (const GAS f32x4*)g + F.lane;
        const GAS f32x4* sh = (const GAS f32x4*)(ada + (size_t)b * 6 * D + shift_idx * D) + F.lane;
        const GAS f32x4* sc = (const GAS f32x4*)(ada + (size_t)b * 6 * D + (shift_idx + 1) * D) + F.lane;
        f32x4 v[4]; float s = 0.f;
#pragma unroll
        for (int j = 0; j < 4; ++j) { v[j] = xr[64 * j]; s += (v[j].x * v[j].x + v[j].y * v[j].y) + (v[j].z * v[j].z + v[j].w * v[j].w); }
        const float rstd = rsqrtf(wave_sum(s) * (1.f / D) + EPS);
        GAS v2u* o8 = (GAS v2u*)(out + (size_t)m * D) + F.lane;
        float mx = 0.f;
#pragma unroll
        for (int j = 0; j < 4; ++j) { const f32x4 gg = gr[64 * j], ss = sh[64 * j], cc = sc[64 * j];
            const f32x4 y = (v[j] * rstd) * gg * (cc + 1.0f) + ss; v[j] = y;
            mx = fmaxf(mx, fmaxf(fmaxf(fabsf(y.x), fabsf(y.y)), fmaxf(fabsf(y.z), fabsf(y.w))));
            v2u o; o.x = pk2(y.x, y.y); o.y = pk2(y.z, y.w); o8[64 * j] = o; }
        if (Q8) {
            mx = wave_max(mx);
            const float qs = mx > 0.f ? 127.0f / mx : 0.f;
            GAS unsigned* h8 = (GAS unsigned*)(F.ws + WS_H8 + (size_t)m * D) + F.lane;
#pragma unroll
            for (int j = 0; j < 4; ++j) { const int q0 = (int)rintf(v[j].x * qs), q1 = (int)rintf(v[j].y * qs), q2 = (int)rintf(v[j].z * qs), q3 = (int)rintf(v[j].w * qs);
                h8[64 * j] = ((unsigned)q0 & 0xffu) | (((unsigned)q1 & 0xffu) << 8) | (((unsigned)q2 & 0xffu) << 16) | (((unsigned)q3 & 0xffu) << 24); }
            if (F.lane == 0) ((float*)(F.ws + WS_HS))[m] = mx * (1.0f / 127.0f);
        }
    }
}

struct EpiIn {
    static constexpr bool PERM = true, AFTER_DRAIN = false;
    unsigned char* ws; const float* qg; const float* kg;
    __device__ __forceinline__ void operator()(const pg8::f32x4 (&acc)[2][2][4][2], const pg8::Unit& u, int wr, int wc, int fr, int fq) const {
        const int pn = u.pn;
#pragma unroll
        for (int ai = 0; ai < 2; ++ai)
#pragma unroll
            for (int m = 0; m < 4; ++m) {
                const int row = u.pm * 256 + ai * 128 + wr * 64 + m * 16 + fr;
                float v[2][8];
#pragma unroll
                for (int bj = 0; bj < 2; ++bj)
#pragma unroll
                    for (int n = 0; n < 2; ++n)
#pragma unroll
                        for (int i = 0; i < 4; ++i) v[bj][4 * n + i] = acc[ai][bj][m][n][i];
                bf16* dst = nullptr; bool norm = false; const float* gain = nullptr; float mul = 1.f; bool sig = false;
                if (pn < 2) { dst = (bf16*)(ws + WS_ZP) + (size_t)row * 512 + 256 * pn + 64 * wc; }
                else if (pn < 4) { dst = (bf16*)(ws + WS_Q) + (size_t)row * 512 + 256 * (pn - 2) + 64 * wc; norm = true; gain = qg; mul = 0.125f * 1.4426950408889634f; }
                else if (pn < 7) { const int kind = pn - 4, isv = wc >> 1, g = wc & 1, b = row >> 12, t = row & 4095;
                    const size_t base = ((size_t)(b * 2 + g) * SEQ + t) * 64;
                    const size_t off = kind == 0 ? (isv ? WS_VCR : WS_KCR) : kind == 1 ? (isv ? WS_VS : WS_KS) : (isv ? WS_VW : WS_KW);
                    dst = (bf16*)(ws + off) + base; if (!isv && kind > 0) { norm = true; gain = kg + kind * 64; } }
                else if (pn < 15) { dst = (bf16*)(ws + WS_GM) + (size_t)row * 2048 + 256 * (pn - 7) + 64 * wc; sig = true; }
                else {
                    if (wc == 0 && fq < 3) { float* gp = (float*)(ws + WS_GATE) + (size_t)row * 24 + 8 * fq;
                        *(GAS f32x4*)gp = (f32x4){sigmoidf_(v[0][0]), sigmoidf_(v[0][1]), sigmoidf_(v[0][2]), sigmoidf_(v[0][3])};
                        *(GAS f32x4*)(gp + 4) = (f32x4){sigmoidf_(v[0][4]), sigmoidf_(v[0][5]), sigmoidf_(v[0][6]), sigmoidf_(v[0][7])}; }
                    continue; }
                if (norm) { float ss = 0.f;
#pragma unroll
                    for (int bj = 0; bj < 2; ++bj)
#pragma unroll
                        for (int e = 0; e < 8; ++e) ss += v[bj][e] * v[bj][e];
                    ss = sum_xor32(sum_xor16(ss));
                    const float rs = rsqrtf(ss * (1.f / 64.f) + EPS) * mul;
#pragma unroll
                    for (int bj = 0; bj < 2; ++bj)
#pragma unroll
                        for (int e = 0; e < 8; ++e) v[bj][e] = v[bj][e] * rs * gain[32 * bj + 8 * fq + e]; }
                if (sig) {
#pragma unroll
                    for (int bj = 0; bj < 2; ++bj)
#pragma unroll
                        for (int e = 0; e < 8; ++e) v[bj][e] = sigmoidf_(v[bj][e]); }
#pragma unroll
                for (int bj = 0; bj < 2; ++bj) { v4u o; o.x = pkh(v[bj][0], v[bj][1]); o.y = pkh(v[bj][2], v[bj][3]); o.z = pkh(v[bj][4], v[bj][5]); o.w = pkh(v[bj][6], v[bj][7]);
                    *(GAS v4u*)(dst + 32 * bj + 8 * fq) = o; }
            }
    }
};
template <bool ADD> struct EpiMix {
    static constexpr bool PERM = true, AFTER_DRAIN = false;
    bf16* MIX; const bf16* GM; int gmoff;
    __device__ __forceinline__ void operator()(const pg8::f32x4 (&acc)[2][2][4][2], const pg8::Unit& u, int wr, int wc, int fr, int fq) const {
#pragma unroll
        for (int ai = 0; ai < 2; ++ai)
#pragma unroll
            for (int m = 0; m < 4; ++m) {
                const int row = u.pm * 256 + ai * 128 + wr * 64 + m * 16 + fr;
#pragma unroll
                for (int bj = 0; bj < 2; ++bj) {
                    const int col = u.pn * 256 + bj * 128 + wc * 32 + 8 * fq;
                    const v4u gmv = *(const GAS v4u*)(GM + (size_t)row * 2048 + gmoff + col);
                    float r[8];
                    r[0] = acc[ai][bj][m][0][0] * bflo(gmv.x); r[1] = acc[ai][bj][m][0][1] * bfhi(gmv.x); r[2] = acc[ai][bj][m][0][2] * bflo(gmv.y); r[3] = acc[ai][bj][m][0][3] * bfhi(gmv.y);
                    r[4] = acc[ai][bj][m][1][0] * bflo(gmv.z); r[5] = acc[ai][bj][m][1][1] * bfhi(gmv.z); r[6] = acc[ai][bj][m][1][2] * bflo(gmv.w); r[7] = acc[ai][bj][m][1][3] * bfhi(gmv.w);
                    GAS v4u* dp = (GAS v4u*)(MIX + (size_t)row * 1024 + col);
                    if (ADD) { const v4u old = *dp; r[0] += bflo(old.x); r[1] += bfhi(old.x); r[2] += bflo(old.y); r[3] += bfhi(old.y); r[4] += bflo(old.z); r[5] += bfhi(old.z); r[6] += bflo(old.w); r[7] += bfhi(old.w); }
                    v4u o; o.x = pkh(r[0], r[1]); o.y = pkh(r[2], r[3]); o.z = pkh(r[4], r[5]); o.w = pkh(r[6], r[7]); *dp = o; }
            }
    }
};
struct EpiRes {
    static constexpr bool PERM = false, AFTER_DRAIN = false;
    const float* x; float* out; const float* ada; int gate_idx;
    __device__ __forceinline__ void operator()(const pg8::f32x4 (&acc)[2][2][4][2], const pg8::Unit& u, int wr, int wc, int fr, int fq) const {
#pragma unroll
        for (int ai = 0; ai < 2; ++ai)
#pragma unroll
            for (int m = 0; m < 4; ++m) {
                const int row = u.pm * 256 + ai * 128 + wr * 64 + m * 16 + fr, b = row >> 12;
#pragma unroll
                for (int bj = 0; bj < 2; ++bj)
#pragma unroll
                    for (int n = 0; n < 2; ++n) {
                        const int col = u.pn * 256 + bj * 128 + wc * 32 + 16 * n + 4 * fq;
                        const f32x4 gt = *(const GAS f32x4*)(ada + (size_t)b * 6 * D + gate_idx * D + col);
                        const f32x4 xv = *(const GAS f32x4*)(x + (size_t)row * D + col);
                        *(GAS f32x4*)(out + (size_t)row * D + col) = xv + gt * acc[ai][bj][m][n]; }
            }
    }
};

template <int W> __device__ __forceinline__ void pool_item(const bf16* zp, bf16* pl, int row, int col) {
    const int t = row & 4095;
    float s[8], self[8];
#pragma unroll
    for (int e = 0; e < 8; ++e) { s[e] = 0.f; self[e] = 0.f; }
    v4u z[W];
#pragma unroll
    for (int j = 0; j < W; ++j) z[j] = (j <= t) ? *(const GAS v4u*)(zp + (size_t)(row - j) * 512 + col) : (v4u){0u, 0u, 0u, 0u};
#pragma unroll
    for (int j = 0; j < W; ++j) { const float f[8] = {bflo(z[j].x), bfhi(z[j].x), bflo(z[j].y), bfhi(z[j].y), bflo(z[j].z), bfhi(z[j].z), bflo(z[j].w), bfhi(z[j].w)};
#pragma unroll
        for (int e = 0; e < 8; ++e) { s[e] += f[e]; if (j == 0) self[e] = f[e]; } }
    const float inv = 1.0f / (float)((t + 1 < W) ? (t + 1) : W);
    v4u o; o.x = pk2(s[0] * inv - self[0], s[1] * inv - self[1]); o.y = pk2(s[2] * inv - self[2], s[3] * inv - self[3]);
    o.z = pk2(s[4] * inv - self[4], s[5] * inv - self[5]); o.w = pk2(s[6] * inv - self[6], s[7] * inv - self[7]);
    *(GAS v4u*)(pl + (size_t)row * 512 + col) = o;
}
__device__ __forceinline__ void pool_phase(Frame& F) {
    const bf16* zp = (const bf16*)(F.ws + WS_ZP); bf16* pl = (bf16*)(F.ws + WS_PL);
    const int gw = F.bid * NWAVES + F.wave, NGW = F.G * NWAVES;
    for (int item = gw; item < 4 * (M / 4); item += NGW) {
        const int gi = item & 3, r4 = item >> 2, row = 4 * r4 + (F.lane >> 4), col = 128 * gi + 8 * (F.lane & 15);
        if (gi == 0) pool_item<2>(zp, pl, row, col); else if (gi == 1) pool_item<4>(zp, pl, row, col); else if (gi == 2) pool_item<8>(zp, pl, row, col); else pool_item<16>(zp, pl, row, col);
    }
}

typedef int v4i __attribute__((ext_vector_type(4)));
struct EpiStoreBf16 {
    static constexpr bool PERM = true, AFTER_DRAIN = false;
    bf16* O; int ldc;
    __device__ __forceinline__ void operator()(const pg8::f32x4 (&acc)[2][2][4][2], const pg8::Unit& u, int wr, int wc, int fr, int fq) const {
#pragma unroll
        for (int ai = 0; ai < 2; ++ai)
#pragma unroll
            for (int m = 0; m < 4; ++m) {
                const int row = u.pm * 256 + ai * 128 + wr * 64 + m * 16 + fr;
#pragma unroll
                for (int bj = 0; bj < 2; ++bj) {
                    const int col = u.pn * 256 + bj * 128 + wc * 32 + 8 * fq;
                    v4u o; o.x = pkh(acc[ai][bj][m][0][0], acc[ai][bj][m][0][1]); o.y = pkh(acc[ai][bj][m][0][2], acc[ai][bj][m][0][3]);
                    o.z = pkh(acc[ai][bj][m][1][0], acc[ai][bj][m][1][1]); o.w = pkh(acc[ai][bj][m][1][2], acc[ai][bj][m][1][3]);
                    *(GAS v4u*)(O + (size_t)row * ldc + col) = o; }
            }
    }
};

__device__ __forceinline__ unsigned fkey(float f) { const unsigned u = __builtin_bit_cast(unsigned, f); return (u >> 31) ? ~u : (u | 0x80000000u); }
__device__ __forceinline__ float funkey(unsigned k) { const unsigned u = (k >> 31) ? (k & 0x7fffffffu) : ~k; return __builtin_bit_cast(float, u); }
__device__ __forceinline__ unsigned umax_(unsigned a, unsigned b) { return a > b ? a : b; }
__device__ __forceinline__ unsigned umin_(unsigned a, unsigned b) { return a > b ? b : a; }
#define TOP16_INSERT(L, xin) do { unsigned _x = (xin); _Pragma("unroll") for (int _i = 0; _i < 16; ++_i) { const unsigned _h = umax_(L[_i], _x); _x = umin_(L[_i], _x); L[_i] = _h; } } while (0)
template <int MASK> __device__ __forceinline__ void top16_merge(unsigned (&L)[16]) {
    unsigned o[16];
#pragma unroll
    for (int i = 0; i < 16; ++i) o[i] = (unsigned)dppi<MASK == 1 ? DPP_XOR1 : DPP_XOR2>((int)L[i]);
#pragma unroll
    for (int i = 0; i < 16; ++i) L[i] = umax_(L[i], o[15 - i]);
#pragma unroll
    for (int d = 8; d >= 1; d >>= 1)
#pragma unroll
        for (int i = 0; i < 16; ++i) if ((i & d) == 0) { const unsigned hi = umax_(L[i], L[i + d]), lo = umin_(L[i], L[i + d]); L[i] = hi; L[i + d] = lo; }
}
#define CE_DESC(a_, b_) do { const unsigned _h = umax_(a_, b_), _l = umin_(a_, b_); a_ = _h; b_ = _l; } while (0)
template <int OFF> __device__ __forceinline__ void bitonic_sort16_desc(unsigned (&v)[32]) {
#pragma unroll
    for (int k = 2; k <= 16; k <<= 1)
#pragma unroll
        for (int j = k >> 1; j > 0; j >>= 1)
#pragma unroll
            for (int i = 0; i < 16; ++i) { const int l = i ^ j; if (l > i) { if ((i & k) == 0) CE_DESC(v[OFF + i], v[OFF + l]); else CE_DESC(v[OFF + l], v[OFF + i]); } }
}
__device__ __forceinline__ void bitonic_merge16_desc(unsigned (&L)[16]) {
#pragma unroll
    for (int d = 8; d >= 1; d >>= 1)
#pragma unroll
        for (int i = 0; i < 16; ++i) if ((i & d) == 0) CE_DESC(L[i], L[i + d]);
}
constexpr int SST = 132;
constexpr int P9_LIST_OFF = 2 * 64 * SST * 4;
__device__ __forceinline__ void peer_select_phase(Frame& F) {
    const bf16* QV = (const bf16*)(F.ws + WS_QV); const bf16* SK = (const bf16*)(F.ws + WS_SUBK);
    int* EID = (int*)(F.ws + WS_EID); float* GW = (float*)(F.ws + WS_GW);
    LAS float* S = (LAS float*)(F.lds);
    LAS unsigned* LIST = (LAS unsigned*)(F.lds + P9_LIST_OFF);
    const int lane = F.lane, w = F.wave, l15 = lane & 15, lq = lane >> 4;
    const int p = w >> 2, kb = w & 3;
    constexpr int NU = (M / 64) * PH;
    bf16x8 a[4][4], bq[2][4];
#define P9_LOAD(u_) do { const int _tt = (u_) >> 3, _h = (u_) & 7; \
        const bf16* qa = QV + (size_t)(_tt * 64 + l15) * PQW + _h * 256 + p * 128 + 8 * lq; \
        const bf16* kbp = SK + (size_t)((_h * 2 + p) * 128 + 32 * kb + l15) * 128 + 8 * lq; \
        _Pragma("unroll") for (int ks = 0; ks < 4; ++ks) { \
            _Pragma("unroll") for (int rb = 0; rb < 4; ++rb) a[rb][ks] = *(const GAS bf16x8*)(qa + (size_t)(16 * rb) * PQW + 32 * ks); \
            _Pragma("unroll") for (int cb = 0; cb < 2; ++cb) bq[cb][ks] = *(const GAS bf16x8*)(kbp + (size_t)(16 * cb) * 128 + 32 * ks); } } while (0)
    if (F.bid < NU) P9_LOAD(F.bid);
    for (int u = F.bid; u < NU; u += F.G) {
        const int tt = u >> 3, h = u & 7, tok0 = tt * 64;
        {
            pg8::f32x4 acc[4][2];
#pragma unroll
            for (int rb = 0; rb < 4; ++rb)
#pragma unroll
                for (int cb = 0; cb < 2; ++cb) acc[rb][cb] = (pg8::f32x4){0.f, 0.f, 0.f, 0.f};
#pragma unroll
            for (int ks = 0; ks < 4; ++ks)
#pragma unroll
                for (int rb = 0; rb < 4; ++rb)
#pragma unroll
                    for (int cb = 0; cb < 2; ++cb) acc[rb][cb] = __builtin_amdgcn_mfma_f32_16x16x32_bf16(a[rb][ks], bq[cb][ks], acc[rb][cb], 0, 0, 0);
#pragma unroll
            for (int rb = 0; rb < 4; ++rb)
#pragma unroll
                for (int cb = 0; cb < 2; ++cb)
#pragma unroll
                    for (int r = 0; r < 4; ++r) S[(p * 64 + 16 * rb + 4 * lq + r) * SST + 32 * kb + 16 * cb + l15] = acc[rb][cb][r];
        }
        __syncthreads();
        if (u + F.G < NU) P9_LOAD(u + F.G);
        {
            const int row = F.tid >> 2, sub = F.tid & 3;
            const LAS float* sr = S + row * SST + sub;
            unsigned kv[32];
#pragma unroll
            for (int i = 0; i < 32; ++i) kv[i] = (fkey(sr[4 * i]) & ~127u) | (unsigned)(4 * i + sub);
            bitonic_sort16_desc<0>(kv); bitonic_sort16_desc<16>(kv);
            unsigned L[16];
#pragma unroll
            for (int i = 0; i < 16; ++i) L[i] = umax_(kv[i], kv[31 - i]);
            bitonic_merge16_desc(L);
            top16_merge<1>(L); top16_merge<2>(L);
            if (sub == 0) {
#pragma unroll
                for (int i = 0; i < 4; ++i) *(LAS v4u*)(LIST + row * 16 + 4 * i) = (v4u){L[4 * i], L[4 * i + 1], L[4 * i + 2], L[4 * i + 3]}; }
        }
        __syncthreads();
        if (F.tid < 256) {
            const int tok = F.tid >> 2, sub = F.tid & 3;
            float va[16], vb[16];
#pragma unroll
            for (int i = 0; i < 4; ++i) { const v4u x = *(const LAS v4u*)(LIST + tok * 16 + 4 * i), y = *(const LAS v4u*)(LIST + (64 + tok) * 16 + 4 * i);
                va[4 * i] = funkey(x.x & ~127u); va[4 * i + 1] = funkey(x.y & ~127u); va[4 * i + 2] = funkey(x.z & ~127u); va[4 * i + 3] = funkey(x.w & ~127u);
                vb[4 * i] = funkey(y.x & ~127u); vb[4 * i + 1] = funkey(y.y & ~127u); vb[4 * i + 2] = funkey(y.z & ~127u); vb[4 * i + 3] = funkey(y.w & ~127u); }
            unsigned cand[32];
#pragma unroll
            for (int i = 0; i < 32; ++i) cand[i] = 0u;
            {
                constexpr int NC = 50;
                constexpr unsigned char CI[52] = {0,0,0,0,0,0,0,0,0,0,0,0,0,0,0,0, 1,1,1,1,1,1,1,1, 2,2,2,2,2, 3,3,3,3, 4,4,4, 5,5, 6,6, 7,7, 8,9,10,11,12,13,14,15, 0,0};
                constexpr unsigned char CJ[52] = {0,1,2,3,4,5,6,7,8,9,10,11,12,13,14,15, 0,1,2,3,4,5,6,7, 0,1,2,3,4, 0,1,2,3, 0,1,2, 0,1, 0,1, 0,1, 0,0,0,0,0,0,0,0, 0,0};
#pragma unroll
                for (int g4 = 0; g4 < 13; ++g4) {
                    float sa = 0.f, sb = 0.f; unsigned id = 0u; bool ok = false;
#pragma unroll
                    for (int q = 0; q < 4; ++q) { const int n = 4 * g4 + q; if (n < NC) { const bool me = (sub == q); sa = me ? va[CI[n]] : sa; sb = me ? vb[CJ[n]] : sb; id = me ? (unsigned)(CI[n] * 16 + CJ[n]) : id; ok = ok || me; } }
                    cand[g4] = ok ? ((fkey(sa + sb) & ~255u) | id) : 0u;
                }
            }
            bitonic_sort16_desc<0>(cand);
            unsigned L[16];
#pragma unroll
            for (int i = 0; i < 16; ++i) L[i] = cand[i];
            top16_merge<1>(L); top16_merge<2>(L);
            const float mx = funkey(L[0] & ~255u);
            float e[16], sum = 0.f;
#pragma unroll
            for (int k = 0; k < 16; ++k) { e[k] = __expf(funkey(L[k] & ~255u) - mx); sum += e[k]; }
            const float inv = 1.0f / sum;
            const size_t ob = (size_t)(tok0 + tok) * 128;
#pragma unroll
            for (int k4 = 0; k4 < 4; ++k4) if (sub == k4) {
#pragma unroll
                for (int q = 0; q < 4; ++q) { const unsigned cid = L[4 * k4 + q] & 255u;
                    const unsigned ia = LIST[tok * 16 + (cid >> 4)] & 127u, ib = LIST[(64 + tok) * 16 + (cid & 15u)] & 127u;
                    const int slot = h * 16 + 4 * k4 + q;
                    EID[ob + slot] = (int)(ia * 128u + ib); GW[ob + slot] = e[4 * k4 + q] * inv; }
            }
        }
        __syncthreads();
    }
#undef P9_LOAD
}

__device__ __forceinline__ void unpack8(const v4u w, float (&f)[8]) { f[0] = bflo(w.x); f[1] = bfhi(w.x); f[2] = bflo(w.y); f[3] = bfhi(w.y); f[4] = bflo(w.z); f[5] = bfhi(w.z); f[6] = bflo(w.w); f[7] = bfhi(w.w); }
typedef float f32x2 __attribute__((ext_vector_type(2)));
__device__ __forceinline__ void unpack16_fp8(const v4u w, float (&f)[16]) {
    const unsigned ww[4] = {w.x, w.y, w.z, w.w};
#pragma unroll
    for (int d = 0; d < 4; ++d) { const f32x2 a = __builtin_amdgcn_cvt_pk_f32_fp8((int)ww[d], false), b = __builtin_amdgcn_cvt_pk_f32_fp8((int)ww[d], true);
        f[4 * d] = a.x; f[4 * d + 1] = a.y; f[4 * d + 2] = b.x; f[4 * d + 3] = b.y; }
}
template <int PV_> __device__ __forceinline__ void peer_dot_phase(Frame& F) {
    const unsigned char* H8 = F.ws + WS_H8; const int* EID = (const int*)(F.ws + WS_EID); float* PART = (float*)(F.ws + WS_PART);
    const int lane = F.lane, g = lane >> 3, j = lane & 7, x = F.bid & 7;
    const int nbx = (F.G - x + 7) >> 3, NW = nbx * NWAVES, gwv = (F.bid >> 3) * NWAVES + F.wave;
    const unsigned char* US = F.ws + WS_UB + (size_t)x * NEXP * 128; const unsigned j16 = 16u * (unsigned)j;
    int token = gwv;
    if (token >= M) return;
    v4i e4[4]; v4i hb;
#define PD_LOAD_E(tok_) do { _Pragma("unroll") for (int q = 0; q < 4; ++q) e4[q] = *(const GAS v4i*)(EID + (size_t)(tok_) * 128 + 16 * g + 4 * q); } while (0)
#define PD_ISSUE4(buf_, e_, b0_) do { buf_[b0_] = *(const GAS v4i*)(US + ((unsigned)e_.x * 128u + j16)); buf_[b0_ + 1] = *(const GAS v4i*)(US + ((unsigned)e_.y * 128u + j16)); \
        buf_[b0_ + 2] = *(const GAS v4i*)(US + ((unsigned)e_.z * 128u + j16)); buf_[b0_ + 3] = *(const GAS v4i*)(US + ((unsigned)e_.w * 128u + j16)); } while (0)
#define PD_DOT1(w_, dst_) do { int t = __builtin_amdgcn_sdot4(w_.x, hc.x, 0, false); t = __builtin_amdgcn_sdot4(w_.y, hc.y, t, false); t = __builtin_amdgcn_sdot4(w_.z, hc.z, t, false); t = __builtin_amdgcn_sdot4(w_.w, hc.w, t, false); \
        t += dppi<DPP_XOR1>(t); t += dppi<DPP_XOR2>(t); t += dppi<DPP_HMIR>(t); dst_ = (float)t; } while (0)
    PD_LOAD_E(token); hb = *(const GAS v4i*)(H8 + (size_t)token * D + 128 * x + j16);
    v4i bA[8], bB[8];
    PD_ISSUE4(bA, e4[0], 0); PD_ISSUE4(bA, e4[1], 4);
    for (; token < M; token += NW) {
        const bool more = token + NW < M;
        PD_ISSUE4(bB, e4[2], 0); PD_ISSUE4(bB, e4[3], 4);
        const v4i hc = hb;
        if (more) { PD_LOAD_E(token + NW); hb = *(const GAS v4i*)(H8 + (size_t)(token + NW) * D + 128 * x + j16); }
        float s[16];
#pragma unroll
        for (int i = 0; i < 8; ++i) PD_DOT1(bA[i], s[i]);
        if (more) { PD_ISSUE4(bA, e4[0], 0); PD_ISSUE4(bA, e4[1], 4); }
#pragma unroll
        for (int i = 0; i < 8; ++i) PD_DOT1(bB[i], s[8 + i]);
        if (j == 0) { float* pp = PART + ((size_t)x * M + token) * 128 + g * 16;
#pragma unroll
            for (int i4 = 0; i4 < 4; ++i4) *(GAS f32x4*)(pp + 4 * i4) = (f32x4){s[4 * i4], s[4 * i4 + 1], s[4 * i4 + 2], s[4 * i4 + 3]}; }
    }
#undef PD_LOAD_E
#undef PD_ISSUE4
#undef PD_DOT1
}
template <int NTOK> __device__ __forceinline__ void peer_loadrate_probe(Frame& F) {
    const int* EID = (const int*)(F.ws + WS_EID);
    const int lane = F.lane, g = lane >> 3, j = lane & 7, x = F.bid & 7;
    const int nbx = (F.G - x + 7) >> 3, NW = nbx * NWAVES, gwv = (F.bid >> 3) * NWAVES + F.wave;
    const unsigned char* US = F.ws + WS_UB + (size_t)x * NEXP * 128; const unsigned j16 = 16u * (unsigned)j;
    unsigned acc = 0u;
    for (int token = gwv; token + (NTOK - 1) * NW < M; token += NTOK * NW) {
        v4i e4[NTOK][4];
#pragma unroll
        for (int t = 0; t < NTOK; ++t)
#pragma unroll
            for (int q = 0; q < 4; ++q) e4[t][q] = *(const GAS v4i*)(EID + (size_t)(token + t * NW) * 128 + 16 * g + 4 * q);
        v4i b[NTOK][16];
#pragma unroll
        for (int t = 0; t < NTOK; ++t)
#pragma unroll
            for (int q = 0; q < 4; ++q) { b[t][4 * q] = *(const GAS v4i*)(US + ((unsigned)e4[t][q].x * 128u + j16)); b[t][4 * q + 1] = *(const GAS v4i*)(US + ((unsigned)e4[t][q].y * 128u + j16));
                b[t][4 * q + 2] = *(const GAS v4i*)(US + ((unsigned)e4[t][q].z * 128u + j16)); b[t][4 * q + 3] = *(const GAS v4i*)(US + ((unsigned)e4[t][q].w * 128u + j16)); }
#pragma unroll
        for (int t = 0; t < NTOK; ++t)
#pragma unroll
            for (int i = 0; i < 16; ++i) acc ^= (unsigned)(b[t][i].x ^ b[t][i].y ^ b[t][i].z ^ b[t][i].w);
    }
    asm volatile("" :: "v"(acc));
}
__device__ __forceinline__ void peer_coef_phase(Frame& F) {
    const float* PART = (const float*)(F.ws + WS_PART); const int* EID = (const int*)(F.ws + WS_EID); const float* GW = (const float*)(F.ws + WS_GW);
    const float* SCU = (const float*)(F.ws + WS_SCLU); const float* SCV = (const float*)(F.ws + WS_SCLV); const float* HS = (const float*)(F.ws + WS_HS);
    unsigned* CF8 = (unsigned*)(F.ws + WS_CF); float* CFS = (float*)(F.ws + WS_CFS);
    const size_t gtid = (size_t)F.bid * NTHREADS + F.tid, gthreads = (size_t)F.G * NTHREADS, n4 = (size_t)M * 128 / 4;
    for (size_t i4 = gtid; i4 < n4; i4 += gthreads) {
        f32x4 d = *(const GAS f32x4*)(PART + 4 * i4);
#pragma unroll
        for (int xx = 1; xx < 8; ++xx) d = d + *(const GAS f32x4*)(PART + (size_t)xx * M * 128 + 4 * i4);
        const v4i e = *(const GAS v4i*)(EID + 4 * i4); const f32x4 gw = *(const GAS f32x4*)(GW + 4 * i4);
        const float hs = HS[i4 >> 5];
        f32x4 r; r.x = gw.x * SCV[e.x] * gelu_tanh_safe(d.x * (SCU[e.x] * hs)); r.y = gw.y * SCV[e.y] * gelu_tanh_safe(d.y * (SCU[e.y] * hs));
        r.z = gw.z * SCV[e.z] * gelu_tanh_safe(d.z * (SCU[e.z] * hs)); r.w = gw.w * SCV[e.w] * gelu_tanh_safe(d.w * (SCU[e.w] * hs));
        float m = fmaxf(fmaxf(fabsf(r.x), fabsf(r.y)), fmaxf(fabsf(r.z), fabsf(r.w)));
        m = fmaxf(m, dppf<DPP_XOR1>(m)); m = fmaxf(m, dppf<DPP_XOR2>(m)); m = fmaxf(m, dppf<DPP_HMIR>(m)); m = fmaxf(m, dppf<DPP_ROR8>(m)); m = max_xor16(m);
        const unsigned E = (__builtin_bit_cast(unsigned, m) >> 23) & 0xffu; float sc = 1.f, isc = 1.f;
        if (E >= 8u && E <= 250u) { sc = __builtin_bit_cast(float, (261u - E) << 23); isc = __builtin_bit_cast(float, (E - 7u) << 23); }
        int t = __builtin_amdgcn_cvt_pk_fp8_f32(r.x * sc, r.y * sc, 0, false); t = __builtin_amdgcn_cvt_pk_fp8_f32(r.z * sc, r.w * sc, t, true);
        CF8[i4] = (unsigned)t;
        if ((F.lane & 31) == 0) CFS[i4 >> 5] = isc; }
}
template <bool DRY, bool CHECK = false> __device__ __forceinline__ void peer_out_phase(Frame& F, const float* ada, float* out) {
    const int* EID = (const int*)(F.ws + WS_EID); const unsigned char* CF8 = (const unsigned char*)(F.ws + WS_CF); const float* CFS = (const float*)(F.ws + WS_CFS);
    const int lane = F.lane, g = lane >> 3, j = lane & 7, x = F.bid & 7;
    const int nbx = (F.G - x + 7) >> 3, NW = nbx * NWAVES, gwv = (F.bid >> 3) * NWAVES + F.wave;
    const unsigned char* VS = F.ws + WS_VB + (size_t)x * NEXP * 128; const unsigned j16 = 16u * (unsigned)j;
    if (gwv >= M) return;
    const int ntok = (M - 1 - gwv) / NW + 1;
#define PO_ISSUE4(buf_, e_, b0_) do { buf_[b0_] = *(const GAS v4u*)(VS + ((unsigned)e_.x * 128u + j16)); buf_[b0_ + 1] = *(const GAS v4u*)(VS + ((unsigned)e_.y * 128u + j16)); \
        buf_[b0_ + 2] = *(const GAS v4u*)(VS + ((unsigned)e_.z * 128u + j16)); buf_[b0_ + 3] = *(const GAS v4u*)(VS + ((unsigned)e_.w * 128u + j16)); } while (0)
#define PO_ROW(w_, c_) do { float f[16]; unpack16_fp8(w_, f); _Pragma("unroll") for (int k = 0; k < 16; ++k) o[k] += (c_) * f[k]; } while (0)
#define PO_ACC4(buf_, c4_, b0_) do { PO_ROW(buf_[b0_], c4_.x); PO_ROW(buf_[b0_ + 1], c4_.y); PO_ROW(buf_[b0_ + 2], c4_.z); PO_ROW(buf_[b0_ + 3], c4_.w); } while (0)
    v4i e4[4]; f32x4 c4[4]; v4u bA[8], bB[8];
#define PO_LOADC(tok_) do { const float cs_ = CFS[tok_]; _Pragma("unroll") for (int q = 0; q < 4; ++q) { const unsigned w_ = *(const GAS unsigned*)(CF8 + (size_t)(tok_) * 128 + g * 16 + 4 * q); \
        const f32x2 lo_ = __builtin_amdgcn_cvt_pk_f32_fp8((int)w_, false), hi_ = __builtin_amdgcn_cvt_pk_f32_fp8((int)w_, true); c4[q] = (f32x4){lo_.x * cs_, lo_.y * cs_, hi_.x * cs_, hi_.y * cs_}; } } while (0)
#pragma unroll
    for (int q = 0; q < 4; ++q) e4[q] = *(const GAS v4i*)(EID + (size_t)gwv * 128 + g * 16 + 4 * q);
    PO_LOADC(gwv);
    PO_ISSUE4(bA, e4[0], 0); PO_ISSUE4(bA, e4[1], 4);
    for (int it = 0; it < ntok; ++it) {
        const int token = gwv + it * NW, tn = gwv + (it + 1 < ntok ? it + 1 : it) * NW;
        PO_ISSUE4(bB, e4[2], 0); PO_ISSUE4(bB, e4[3], 4);
#pragma unroll
        for (int q = 0; q < 4; ++q) e4[q] = *(const GAS v4i*)(EID + (size_t)tn * 128 + g * 16 + 4 * q);
        float o[16];
#pragma unroll
        for (int k = 0; k < 16; ++k) o[k] = 0.f;
        PO_ACC4(bA, c4[0], 0); PO_ACC4(bA, c4[1], 4);
        PO_ISSUE4(bA, e4[0], 0); PO_ISSUE4(bA, e4[1], 4);
        PO_ACC4(bB, c4[2], 0); PO_ACC4(bB, c4[3], 4);
        PO_LOADC(tn);
#pragma unroll
        for (int k = 0; k < 16; ++k) { float t = o[k]; t += dppf<DPP_ROR8>(t); o[k] = sum_xor32(sum_xor16(t)); }
        if (g == 0) { const int b = token >> 12;
            const float* gt = ada + (size_t)b * 6 * D + 5 * D + 128 * x + 16 * j;
            float* xo = out + (size_t)token * D + 128 * x + 16 * j;
#pragma unroll
            for (int q = 0; q < 4; ++q) { const f32x4 xv = *(const GAS f32x4*)(xo + 4 * q), gv = *(const GAS f32x4*)(gt + 4 * q);
                f32x4 res = xv + gv * (f32x4){o[4 * q], o[4 * q + 1], o[4 * q + 2], o[4 * q + 3]};
                if (CHECK) { const f32x4 mf = *(const GAS f32x4*)((const float*)(F.ws + WS_PART) + (size_t)token * D + 128 * x + 16 * j + 4 * q);
                    const float rr[4] = {o[4 * q], o[4 * q + 1], o[4 * q + 2], o[4 * q + 3]}, mm[4] = {mf.x, mf.y, mf.z, mf.w}; bool bad = false;
#pragma unroll
                    for (int z = 0; z < 4; ++z) bad = bad || !(fabsf(rr[z] - mm[z]) <= 0.01f * fabsf(rr[z]) + 1.0e-3f);
                    if (bad) res.x = 1.0e9f; }
                if (DRY) { asm volatile("" :: "v"(res.x), "v"(res.y), "v"(res.z), "v"(res.w)); } else *(GAS f32x4*)(xo + 4 * q) = res; } }
    }
#undef PO_LOADC
#undef PO_ISSUE4
#undef PO_ROW
#undef PO_ACC4
}

constexpr int PO_TILE = 64 * 144;
template <int MODE> __device__ __forceinline__ void peer_out_mfma_phase(Frame& F, const float* ada, float* out) {
    const int* EID = (const int*)(F.ws + WS_EID); const unsigned char* CF8 = (const unsigned char*)(F.ws + WS_CF); const float* CFS = (const float*)(F.ws + WS_CFS);
    const int lane = F.lane, g = lane >> 3, j = lane & 7, l15 = lane & 15, lq = lane >> 4, x = F.bid & 7;
    const int nbx = (F.G - x + 7) >> 3, NW = nbx * NWAVES, gwv = (F.bid >> 3) * NWAVES + F.wave;
    const unsigned char* VS = F.ws + WS_VB + (size_t)x * NEXP * 128; const unsigned j16 = 16u * (unsigned)j;
    LAS unsigned char* TL = F.lds + F.wave * PO_TILE;
    if (gwv >= M) return;
    const int nst = 2 * ((M - 1 - gwv) / NW + 1);
    const int trow = l15 >> 1, tcol = 8 * (l15 & 1);
#define PM_IDS(e_, a_, tok_) do { const size_t base = (size_t)(tok_) * 128; \
        _Pragma("unroll") for (int m = 0; m < 16; ++m) e_[m] = EID[base + 8 * m + g]; \
        _Pragma("unroll") for (int q = 0; q < 4; ++q) a_[q] = *(const GAS long*)(CF8 + base + 32 * q + 8 * lq); } while (0)
#define PM_GATHER(vv_, e_, h_) do { _Pragma("unroll") for (int m = 0; m < 8; ++m) vv_[m] = *(const GAS v4u*)(VS + ((unsigned)e_[8 * (h_) + m] * 128u + j16)); } while (0)
#define PM_HALF(vv_, aq0_, aq1_) do { _Pragma("unroll") for (int m = 0; m < 8; ++m) *(LAS v4u*)(TL + (8 * m + g) * 144 + 16 * j) = vv_[m]; } while (0)
#define PM_MMA(aq0_, aq1_) do { LDS_WAIT(); asm volatile("" ::: "memory"); \
        _Pragma("unroll") for (int ks = 0; ks < 2; ++ks) _Pragma("unroll") for (int cb = 0; cb < 8; ++cb) { \
            const v2i bb = __builtin_amdgcn_ds_read_tr8_b64_v2i32((LAS v2i*)(TL + (32 * ks + 8 * lq + trow) * 144 + 16 * cb + tcol)); \
            acc[cb] = __builtin_amdgcn_mfma_f32_16x16x32_fp8_fp8(ks ? (aq1_) : (aq0_), __builtin_bit_cast(long, bb), acc[cb], 0, 0, 0); } \
        LDS_WAIT(); asm volatile("" ::: "memory"); } while (0)
    const int ntok = nst >> 1;
    int e1[16], e2[16]; long a0[4], a1[4], a2[4]; v4u vvA[8], vvB[8];
    PM_IDS(e1, a0, gwv);
    PM_GATHER(vvA, e1, 0); PM_GATHER(vvB, e1, 1);
    { const int t1 = ntok > 1 ? 1 : 0; PM_IDS(e1, a1, gwv + t1 * NW); }
    f32x4 acc[8];
    for (int it = 0; it < ntok; ++it) {
        const int token = gwv + it * NW;
        { const int t2 = it + 2 < ntok ? it + 2 : ntok - 1; PM_IDS(e2, a2, gwv + t2 * NW); }
#pragma unroll
        for (int cb = 0; cb < 8; ++cb) acc[cb] = (f32x4){0.f, 0.f, 0.f, 0.f};
        PM_HALF(vvA, 0, 0); PM_GATHER(vvA, e1, 0); PM_MMA(a0[0], a0[1]);
        PM_HALF(vvB, 0, 0); PM_GATHER(vvB, e1, 1); PM_MMA(a0[2], a0[3]);
        if (lq == 0) {
            const float cs = CFS[token];
            if (MODE == 1) { float* oc = (float*)(F.ws + WS_PART) + (size_t)token * D + 128 * x + l15;
#pragma unroll
                for (int cb = 0; cb < 8; ++cb) oc[16 * cb] = acc[cb][0] * cs; }
            else { const int b = token >> 12;
                const float* gt = ada + (size_t)b * 6 * D + 5 * D + 128 * x + l15;
                float* xo = out + (size_t)token * D + 128 * x + l15;
#pragma unroll
                for (int cb = 0; cb < 8; ++cb) xo[16 * cb] = xo[16 * cb] + gt[16 * cb] * (acc[cb][0] * cs); }
        }
#pragma unroll
        for (int m = 0; m < 16; ++m) e1[m] = e2[m];
#pragma unroll
        for (int q = 0; q < 4; ++q) { a0[q] = a1[q]; a1[q] = a2[q]; }
    }
#undef PM_HALF
#undef PM_MMA
#undef PM_IDS
#undef PM_GATHER
}

__device__ __forceinline__ void compress_phase(Frame& F, const float* kng) {
    LAS bf16* H2 = (LAS bf16*)(F.lds);
    LAS float* OUTS = (LAS float*)(F.lds + 16384);
    const int lane = F.lane, w = F.wave, l15 = lane & 15, lq = lane >> 4;
    for (int u = F.bid; u < NBG * 2 * 8; u += F.G) {
        const int ns = u & 7, kv = (u >> 3) & 1, bg = u >> 4, n0 = ns * 32;
        const bf16* A = (const bf16*)(F.ws + (kv ? WS_VCR : WS_KCR)) + (size_t)bg * SEQ * 64;
        const bf16* W1T = (const bf16*)(F.ws + (kv ? WS_CW1V_T : WS_CW1K_T));
        const bf16* W2T = (const bf16*)(F.ws + (kv ? WS_CW2V_T : WS_CW2K_T));
        const float* b1 = (const float*)(F.ws + (kv ? WS_CB1V : WS_CB1K));
        pg8::f32x4 acc[2];
        acc[0] = (pg8::f32x4){0.f, 0.f, 0.f, 0.f}; acc[1] = acc[0];
        const bf16* ap = A + (size_t)(n0 + l15) * 1024 + 8 * lq;
        const bf16* bp = W1T + (size_t)(16 * w + l15) * 2048 + 8 * lq;
#pragma unroll 8
        for (int ks = 0; ks < 64; ++ks) {
            const bf16x8 a0 = *(const GAS bf16x8*)(ap + 32 * ks), a1 = *(const GAS bf16x8*)(ap + 16 * 1024 + 32 * ks), b = *(const GAS bf16x8*)(bp + 32 * ks);
            acc[0] = __builtin_amdgcn_mfma_f32_16x16x32_bf16(a0, b, acc[0], 0, 0, 0);
            acc[1] = __builtin_amdgcn_mfma_f32_16x16x32_bf16(a1, b, acc[1], 0, 0, 0);
        }
        { const float bb = b1[16 * w + l15];
#pragma unroll
          for (int rb = 0; rb < 2; ++rb)
#pragma unroll
            for (int r = 0; r < 4; ++r) H2[(16 * rb + 4 * lq + r) * 136 + 16 * w + l15] = (bf16)f2bf(gelu_tanh_safe(acc[rb][r] + bb)); }
        __syncthreads();
        { const int rb = w >> 2, db = w & 3;
          pg8::f32x4 o = (pg8::f32x4){0.f, 0.f, 0.f, 0.f};
#pragma unroll
          for (int ks = 0; ks < 4; ++ks) {
              const bf16x8 a = *(const LAS bf16x8*)(H2 + (16 * rb + l15) * 136 + 32 * ks + 8 * lq);
              const bf16x8 b = *(const GAS bf16x8*)(W2T + (size_t)(16 * db + l15) * 128 + 32 * ks + 8 * lq);
              o = __builtin_amdgcn_mfma_f32_16x16x32_bf16(a, b, o, 0, 0, 0); }
#pragma unroll
          for (int r = 0; r < 4; ++r) OUTS[(16 * rb + 4 * lq + r) * 65 + 16 * db + l15] = o[r]; }
        __syncthreads();
        { const int n = F.tid >> 4, d4 = (F.tid & 15) * 4, ng = n0 + n;
          float v[4]; float ss = 0.f;
#pragma unroll
          for (int i = 0; i < 4; ++i) { v[i] = OUTS[n * 65 + d4 + i]; ss += v[i] * v[i]; }
          ss += dppf<DPP_XOR1>(ss); ss += dppf<DPP_XOR2>(ss); ss += dppf<DPP_HMIR>(ss); ss += dppf<DPP_ROR8>(ss);
          const bool pad = (ng >= NCMP);
          if (kv == 0) { const float rs = rsqrtf(ss * (1.f / 64.f) + EPS);
              v2u o; o.x = pad ? 0u : pk2(v[0] * rs * kng[d4], v[1] * rs * kng[d4 + 1]); o.y = pad ? 0u : pk2(v[2] * rs * kng[d4 + 2], v[3] * rs * kng[d4 + 3]);
              *(GAS v2u*)((bf16*)(F.ws + WS_KC) + ((size_t)bg * 256 + ng) * 64 + d4) = o; }
          else { bf16* vt = (bf16*)(F.ws + WS_VCT) + (size_t)bg * 64 * 256 + ng;
#pragma unroll
              for (int i = 0; i < 4; ++i) vt[(size_t)(d4 + i) * 256] = pad ? (bf16)0 : (bf16)f2bf(v[i]); } }
        __syncthreads();
    }
}
__device__ __forceinline__ void vtranspose_phase(Frame& F) {
    LAS bf16* T = (LAS bf16*)(F.lds + F.wave * 9216);
    const int gw = F.bid * NWAVES + F.wave, NGW = F.G * NWAVES, lane = F.lane;
    for (int job = gw; job < 2 * NBG * 64; job += NGW) {
        const int s = job & 63, bg = (job >> 6) & 15, which = job >> 10;
        const bf16* X = (const bf16*)(F.ws + (which ? WS_VW : WS_VS)) + ((size_t)bg * SEQ + 64 * s) * 64;
        bf16* XT = (bf16*)(F.ws + (which ? WS_VWT : WS_VST)) + (size_t)bg * 64 * SEQ + 64 * s;
#pragma unroll
        for (int i = 0; i < 8; ++i) { const int tok = (lane >> 3) + 8 * i, ch = lane & 7;
            const v4u x = *(const GAS v4u*)(X + (size_t)tok * 64 + 8 * ch);
            const unsigned ww[4] = {x.x, x.y, x.z, x.w};
#pragma unroll
            for (int e = 0; e < 4; ++e) { T[(8 * ch + 2 * e) * 72 + tok] = (bf16)(ww[e] & 0xffffu); T[(8 * ch + 2 * e + 1) * 72 + tok] = (bf16)(ww[e] >> 16); } }
        LDS_WAIT(); asm volatile("" ::: "memory");
#pragma unroll
        for (int i = 0; i < 8; ++i) { const int dim = (lane >> 3) + 8 * i, ch = lane & 7;
            const v4u y = *(const LAS v4u*)(T + dim * 72 + 8 * ch);
            *(GAS v4u*)(XT + (size_t)dim * SEQ + 8 * ch) = y; }
        LDS_WAIT(); asm volatile("" ::: "memory");
    }
}

constexpr int AT_KBUF = 64 * 128;
constexpr int AT_NBUF = 2;
constexpr int AT_OFF_K = 0, AT_OFF_V = AT_NBUF * AT_KBUF;
constexpr int AT_OFF_IMP1 = 2 * AT_NBUF * AT_KBUF, AT_OFF_IMP2 = AT_OFF_IMP1 + 64 * 65 * 4, AT_OFF_SEL = AT_OFF_IMP2 + 64 * 65 * 4;
constexpr int AT_OFF_LUT = AT_OFF_SEL + 512, AT_OFF_LROW = AT_OFF_LUT + 4 * 128 * 4;
constexpr int AT_OFF_TD = AT_OFF_LROW + 8 * 32 * 4;
constexpr int AT_OFF_OUT = AT_OFF_TD + 96 * 32;
constexpr int AT_OFF_GATL = AT_OFF_OUT + 256 * 144;
constexpr int AT_OFF_TS = AT_OFF_GATL + 64 * 12 * 4;
constexpr int AT_TS_ROW = 65 * 16;
constexpr int AT_LDS_END = AT_OFF_TS + 16 * AT_TS_ROW;
static_assert(AT_LDS_END <= RING_BYTES, "attention LDS");

struct AtTile { const bf16* k; const bf16* vt; int vstride; };
enum { TM_CMP1 = 0, TM_CMP2, TM_SELN, TM_SELF, TM_WINN, TM_WINF, TM_WINE };
__device__ __forceinline__ float fexp2(float x) { return __builtin_amdgcn_exp2f(x); }
template <int TM, int VAR, int RB = 3>
__device__ __forceinline__ void at_tile(const LAS unsigned char* kb_, const LAS unsigned char* vb_, const LAS float* LUTJ, LAS float* IMP1, LAS float* IMP2,
                                        const bf16x8 (&qf)[2][2], pg8::f32x4 (&oacc)[2][4], pg8::f32x4 (&lacc)[2], const LAS float* LINV,
                                        const int (&tok_r_in)[2], const unsigned (&selb)[2], float cfar, int relbase, int idx, int l15_in, int lq_in, const LAS unsigned char* tsw, const LAS unsigned char* tsn) {
    constexpr bool FAR = (TM == TM_SELF || TM == TM_WINF || TM == TM_WINE);
    int l15 = l15_in, lq = lq_in; asm volatile("" : "+v"(l15), "+v"(lq));
    int tok_r[2] = {tok_r_in[0], tok_r_in[1]}; asm volatile("" : "+v"(tok_r[0]), "+v"(tok_r[1]));
    v4u pfr[2][2];
    const LAS unsigned char* tsp[2] = {tsw, tsw};
    if (TM == TM_SELN || TM == TM_WINN) {
#pragma unroll
        for (int rb = 0; rb < 2; ++rb) { const LAS unsigned char* pa = tsw + l15 * AT_TS_ROW + 16 * (2 * lq - rb) - 4 * relbase;
            const LAS unsigned char* pn = tsn + l15 * AT_TS_ROW;
            tsp[rb] = (TM == TM_SELN && !selb[rb]) ? pn : pa; } }
    auto qk = [&](int cb, pg8::f32x4 (&st)[2]) __attribute__((always_inline)) {
        st[0] = FAR ? (pg8::f32x4){cfar, cfar, cfar, cfar} : (pg8::f32x4){0.f, 0.f, 0.f, 0.f}; st[1] = st[0];
        if (TM == TM_SELN || TM == TM_WINN) {
#pragma unroll
            for (int rb = 0; rb < 2; ++rb) st[rb] = *(const LAS pg8::f32x4*)(tsp[rb] + 16 * (8 * (cb >> 1) + (cb & 1))); }
        if (TM == TM_SELF) {
#pragma unroll
            for (int rb = 0; rb < 2; ++rb) { const float ci = selb[rb] ? cfar : -1.0e30f; st[rb] = (pg8::f32x4){ci, ci, ci, ci}; } }
        if (!(VAR & 64)) {
        const int krow = 8 * (l15 >> 2) + (l15 & 3) + 32 * (cb >> 1) + 4 * (cb & 1), kf_ = ((l15 >> 2) << 1) | ((l15 >> 1) & 1);
#pragma unroll
        for (int ks = 0; ks < 2; ++ks) { const bf16x8 kf = *(const LAS bf16x8*)(kb_ + krow * 128 + 16 * ((4 * ks + lq) ^ kf_));
#pragma unroll
            for (int rb = 0; rb < 2; ++rb) if (RB & (1 << rb)) st[rb] = __builtin_amdgcn_mfma_f32_16x16x32_bf16(kf, qf[rb][ks], st[rb], 0, 0, 0); } }
    };
    float linv_[2] = {0.f, 0.f};
    if (TM == TM_CMP2) { linv_[0] = LINV[l15]; linv_[1] = LINV[16 + l15]; }
    auto prob = [&](int cb, const pg8::f32x4 (&st)[2]) __attribute__((always_inline)) {
#pragma unroll
        for (int rb = 0; rb < 2; ++rb) if (RB & (1 << rb)) {
            const int tokc = tok_r[rb];
            float p[4];
#pragma unroll
            for (int r = 0; r < 4; ++r) {
                const int kl = 32 * (cb >> 1) + 8 * lq + 4 * (cb & 1) + r;
                if (VAR & 16) { p[r] = st[rb][r]; }
                else if (TM == TM_SELF) { p[r] = fexp2(st[rb][r]); }
                else if (TM == TM_WINF || TM == TM_SELN || TM == TM_WINN) { p[r] = fexp2(st[rb][r]); }
                else if (TM == TM_WINE) { const float e = fexp2(st[rb][r]); p[r] = (kl > tokc) ? e : 0.f; }
                else {
                    const int rel = (TM == TM_CMP1 || TM == TM_CMP2) ? (relbase + tokc - 16 * kl) : (relbase + tokc - kl);
                    const bool valid = rel >= 0;
                    const int ri = rel < 0 ? 0 : (rel > 127 ? 127 : rel);
                    const float e = fexp2(st[rb][r] + LUTJ[ri]);
                    p[r] = valid ? e : 0.f; }
            }
            if (TM == TM_CMP1) { lacc[rb][0] += (p[0] + p[1]) + (p[2] + p[3]); }
            else {
                if (TM == TM_CMP2) {
#pragma unroll
                    for (int r = 0; r < 4; ++r) p[r] *= linv_[rb];
                    float h0 = p[0], h1 = p[1], h2 = p[2], h3 = p[3];
                    h0 += dppf<DPP_XOR1>(h0); h1 += dppf<DPP_XOR1>(h1); h2 += dppf<DPP_XOR1>(h2); h3 += dppf<DPP_XOR1>(h3);
                    h0 += dppf<DPP_XOR2>(h0); h1 += dppf<DPP_XOR2>(h1); h2 += dppf<DPP_XOR2>(h2); h3 += dppf<DPP_XOR2>(h3);
                    if ((l15 & 3) == 0) { const int sp = 16 * idx + 8 * (cb >> 1) + 2 * lq + (cb & 1);
                        IMP1[tokc * 65 + sp] = (h0 + h1) + (h2 + 0.5f * h3);
                        if (sp + 1 < 64) IMP2[tokc * 65 + sp + 1] = 0.5f * h3; }
                }
                const unsigned lo = pkh(p[0], p[1]), hi = pkh(p[2], p[3]);
                if (cb & 1) { pfr[rb][cb >> 1].z = lo; pfr[rb][cb >> 1].w = hi; } else { pfr[rb][cb >> 1].x = lo; pfr[rb][cb >> 1].y = hi; } }
        }
    };
    auto pv = [&](int ks) __attribute__((always_inline)) {
        if (TM != TM_CMP1 && !(VAR & 8)) {
#pragma unroll
            for (int db = 0; db < 4; ++db) {
                const v4u vv = *(const LAS v4u*)(vb_ + (16 * db + l15) * 128 + 16 * ((4 * ks + lq) ^ (l15 >> 1)));
#pragma unroll
                for (int rb = 0; rb < 2; ++rb) if (RB & (1 << rb)) oacc[rb][db] = __builtin_amdgcn_mfma_f32_16x16x32_bf16(__builtin_bit_cast(bf16x8, pfr[rb][ks]), __builtin_bit_cast(bf16x8, vv), oacc[rb][db], 0, 0, 0); }
            if (TM != TM_CMP2) { const v4u ones = (v4u){0x3F803F80u, 0x3F803F80u, 0x3F803F80u, 0x3F803F80u};
#pragma unroll
                for (int rb = 0; rb < 2; ++rb) if (RB & (1 << rb)) lacc[rb] = __builtin_amdgcn_mfma_f32_16x16x32_bf16(__builtin_bit_cast(bf16x8, pfr[rb][ks]), __builtin_bit_cast(bf16x8, ones), lacc[rb], 0, 0, 0); }
        }
    };
    pg8::f32x4 sA[2], sB[2];
#define AT_SB __builtin_amdgcn_sched_barrier(0)
    qk(0, sA); AT_SB;
    qk(1, sB); prob(0, sA); AT_SB;
    qk(2, sA); prob(1, sB); AT_SB;
    pv(0); qk(3, sB); prob(2, sA); AT_SB;
    prob(3, sB); AT_SB;
    pv(1);
#undef AT_SB
}

template <int VAR> __device__ __forceinline__ void attention_phase(Frame& F, const Args& args) {
    unsigned char* ws = F.ws;
    const int lane = F.lane, w = F.wave, l15 = lane & 15, lq = lane >> 4, tid = F.tid;
    LAS unsigned char* L = F.lds;
    LAS float* IMP1 = (LAS float*)(L + AT_OFF_IMP1); LAS float* IMP2 = (LAS float*)(L + AT_OFF_IMP2);
    LAS unsigned long long* SELM = (LAS unsigned long long*)(L + AT_OFF_SEL); LAS float* LUT = (LAS float*)(L + AT_OFF_LUT); LAS float* LROW = (LAS float*)(L + AT_OFF_LROW) + w * 32;
    LAS int* TD = (LAS int*)(L + AT_OFF_TD); LAS bf16* OUTL = (LAS bf16*)(L + AT_OFF_OUT) + (32 * w) * 72; LAS float* GATL = (LAS float*)(L + AT_OFF_GATL);
    const bf16* Qg = (const bf16*)(ws + WS_Q); const float* GATE = (const float*)(ws + WS_GATE); bf16* YA = (bf16*)(ws + WS_YA); float* YAF = (float*)(ws + WS_H);
    const int jq = l15 & 3;
    const LAS float* LUTJ = LUT + jq * 128;
    const int nrounds = (F.G == 256) ? 4 : (1024 + F.G - 1) / F.G;
    for (int round = 0; round < nrounds; ++round) {
        const int ui = (F.G == 256) ? ((round & 1) ? ((round >> 1) * 512 + 511 - F.bid) : ((round >> 1) * 512 + F.bid)) : (round * F.G + F.bid);
        if (ui >= 1024) break;
        const int c = 63 - (ui >> 4), bg = ui & 15, b = bg >> 1, g = bg & 1;
        const int m0 = b * SEQ + 64 * c;
        __syncthreads();
        { const float M0 = ((const float*)(ws + WS_BIASL))[8 * 128];
          for (int i = tid; i < 512; i += NTHREADS) LUT[i] = (((const float*)(ws + WS_BIASL))[(4 * g + (i >> 7)) * 128 + (i & 127)] - M0) * 1.4426950408889634f; }
        for (int i = tid; i < 64 * 65; i += NTHREADS) { IMP1[i] = 0.f; IMP2[i] = 0.f; }
        { const float M0 = ((const float*)(ws + WS_BIASL))[8 * 128]; const float* BL = (const float*)(ws + WS_BIASL) + (size_t)(4 * g) * 128;
          for (int i = tid; i < 16 * 63 * 4; i += NTHREADS) { const int r = i & 3, yi = (i >> 2) % 63, row = i / 252, rel = 4 * (47 - yi) + (row >> 2) - r;
              ((LAS float*)(L + AT_OFF_TS + row * AT_TS_ROW))[4 * yi + r] = rel < 0 ? -1.0e30f : (BL[(row & 3) * 128 + (rel > 127 ? 127 : rel)] - M0) * 1.4426950408889634f; } }
        for (int i = tid; i < 64 * 12; i += NTHREADS) GATL[i] = GATE[(size_t)(m0 + i / 12) * 24 + g * 12 + (i % 12)];
        bf16x8 qf[2][2];
#pragma unroll
        for (int rb = 0; rb < 2; ++rb)
#pragma unroll
            for (int ks = 0; ks < 2; ++ks) qf[rb][ks] = *(const GAS bf16x8*)(Qg + (size_t)(m0 + 8 * w + 4 * rb + (l15 >> 2)) * 512 + g * 256 + jq * 64 + 32 * ks + 8 * lq);
        asm volatile("" :: "v"(qf[0][0]), "v"(qf[0][1]), "v"(qf[1][0]), "v"(qf[1][1]));
        const int ncmp = 4 * c + 3, n1 = (ncmp + 63) >> 6, nsel = c + 1, w0 = c >= 8 ? c - 8 : 0, nwin = c - w0 + 1;
        const int ntiles = 2 * n1 + nsel + nwin;
        if (tid < ntiles) { const int i = tid; int kind, idx; unsigned ko, vo, vs;
            if (i < n1) { kind = 0; idx = i; } else if (i < 2 * n1) { kind = 1; idx = i - n1; } else if (i < 2 * n1 + nsel) { kind = 2; idx = i - 2 * n1; } else { kind = 3; idx = w0 + (i - 2 * n1 - nsel); }
            if (kind < 2) { ko = (unsigned)(WS_KC + ((size_t)bg * 256 * 64 + (size_t)idx * 4096) * 2); vo = (unsigned)(WS_VCT + ((size_t)bg * 64 * 256 + 64 * idx) * 2); vs = 512u; }
            else if (kind == 2) { ko = (unsigned)(WS_KS + ((size_t)bg * SEQ * 64 + (size_t)idx * 4096) * 2); vo = (unsigned)(WS_VST + ((size_t)bg * 64 * SEQ + 64 * idx) * 2); vs = 2u * SEQ; }
            else { ko = (unsigned)(WS_KW + ((size_t)bg * SEQ * 64 + (size_t)idx * 4096) * 2); vo = (unsigned)(WS_VWT + ((size_t)bg * 64 * SEQ + 64 * idx) * 2); vs = 2u * SEQ; }
            const int dd = c - idx;
            int mode, relbase;
            if (kind == 0) { mode = TM_CMP1; relbase = 64 * c - 31 - 1024 * idx; } else if (kind == 1) { mode = TM_CMP2; relbase = 64 * c - 31 - 1024 * idx; }
            else if (kind == 2) { mode = dd <= 2 ? TM_SELN : TM_SELF; relbase = 64 * dd; } else { mode = dd <= 2 ? TM_WINN : (dd == 8 ? TM_WINE : TM_WINF); relbase = 64 * dd; }
            const int endf = ((kind == 1 && idx == n1 - 1) || (kind == 2 && idx == nsel - 1) || (kind == 3 && idx == c)) ? kind : 0;
            LAS int* td = TD + 8 * i; td[0] = mode; td[1] = idx; td[2] = relbase; td[3] = endf; td[4] = (int)ko; td[5] = (int)vo; td[6] = (int)vs; td[7] = (kind == 2 && idx == 0) ? 1 : 0; }
        const int drow = 8 * w + (lane >> 3), dsrck = 16 * ((lane & 7) ^ (((w & 3) << 1) | ((lane >> 4) & 1))), dsrcv = 16 * ((lane & 7) ^ ((4 * (w & 1)) | (lane >> 4)));
#define AT_DMA(tile_) do { const LAS int* tn_ = TD + 8 * (tile_); const unsigned ko_ = (unsigned)tn_[4], vo_ = (unsigned)tn_[5], vs_ = (unsigned)tn_[6]; const int nb_ = (tile_) % AT_NBUF; \
        __builtin_amdgcn_global_load_lds((const GAS unsigned*)(ws + (size_t)(ko_ + drow * 128 + dsrck)), (LAS unsigned*)(L + AT_OFF_K + nb_ * AT_KBUF + w * 1024), 16, 0, 0); \
        __builtin_amdgcn_global_load_lds((const GAS unsigned*)(ws + (size_t)(vo_ + drow * vs_ + dsrcv)), (LAS unsigned*)(L + AT_OFF_V + nb_ * AT_KBUF + w * 1024), 16, 0, 0); } while (0)
        __syncthreads();
        if (!(VAR & 2)) { AT_DMA(0); }
        pg8::f32x4 oacc[2][4];
        pg8::f32x4 lacc[2] = {(pg8::f32x4){0.f, 0.f, 0.f, 0.f}, (pg8::f32x4){0.f, 0.f, 0.f, 0.f}};
#pragma unroll
        for (int rb = 0; rb < 2; ++rb)
#pragma unroll
            for (int db = 0; db < 4; ++db) oacc[rb][db] = (pg8::f32x4){0.f, 0.f, 0.f, 0.f};
        const int tok_r[2] = {8 * w + (l15 >> 2), 8 * w + 4 + (l15 >> 2)};
        const LAS unsigned char* tsw = L + AT_OFF_TS + 16 * (47 - 2 * w); const LAS unsigned char* tsn = L + AT_OFF_TS + 16 * 48;
        for (int it = 0; it < ((VAR & 32) ? 0 : ntiles); ++it) {
            asm volatile("s_waitcnt vmcnt(0)" ::: "memory");
            asm volatile("s_waitcnt lgkmcnt(0)" ::: "memory"); __builtin_amdgcn_s_barrier(); asm volatile("" ::: "memory");
            if (!(VAR & 2) && it + 1 < ntiles) AT_DMA(it + 1);
            {
            const LAS int* td = TD + 8 * it;
            const int mode = __builtin_amdgcn_readfirstlane(td[0]), idx = __builtin_amdgcn_readfirstlane(td[1]), relbase = __builtin_amdgcn_readfirstlane(td[2]);
            const int endf = __builtin_amdgcn_readfirstlane(td[3]), selfirst = __builtin_amdgcn_readfirstlane(td[7]);
            const int buf = it % AT_NBUF;
            if (selfirst) {
                { const int tok = 8 * w + (lane >> 3), s0 = 8 * (lane & 7);
                  unsigned key[8]; int rank[8];
#pragma unroll
                  for (int q = 0; q < 8; ++q) { const int sB = s0 + q; const bool vis = sB <= c, forced = (sB == 0) || (sB == c) || (sB == c - 1);
                      const float sc = vis ? (IMP1[tok * 65 + sB] + IMP2[tok * 65 + sB] + (forced ? 1000.f : 0.f)) : -1.f;
                      const unsigned u = __builtin_bit_cast(unsigned, sc); const unsigned fk = (u >> 31) ? ~u : (u | 0x80000000u);
                      key[q] = (fk & ~63u) | (unsigned)(63 - sB); rank[q] = 0; }
                  LAS unsigned* KEYS = (LAS unsigned*)IMP1;
#pragma unroll
                  for (int q = 0; q < 8; ++q) KEYS[tok * 65 + s0 + q] = key[q];
                  if (c >= 16 && !(VAR & 128)) {
#pragma unroll 8
                      for (int s2 = 0; s2 < 64; ++s2) { const unsigned k2 = KEYS[tok * 65 + s2];
#pragma unroll
                          for (int q = 0; q < 8; ++q) rank[q] += (k2 > key[q]) ? 1 : 0; } }
                  unsigned byte = 0u;
#pragma unroll
                  for (int q = 0; q < 8; ++q) byte |= ((rank[q] < 16 && (s0 + q) <= c) ? 1u : 0u) << q;
                  ((LAS unsigned char*)SELM)[tok * 8 + (lane & 7)] = (unsigned char)byte; }
            }
            const LAS unsigned char* kb_ = L + AT_OFF_K + buf * AT_KBUF; const LAS unsigned char* vb_ = L + AT_OFF_V + buf * AT_KBUF;
            const float cfar = LUTJ[127];
            unsigned selb[2] = {1u, 1u};
#define AT_CALL(TMX) at_tile<TMX, VAR>(kb_, vb_, LUTJ, IMP1, IMP2, qf, oacc, lacc, LROW, tok_r, selb, cfar, relbase, idx, l15, lq, tsw, tsn)
            if (mode == TM_SELF || mode == TM_SELN) { selb[0] = (unsigned)(SELM[tok_r[0]] >> idx) & 1u; selb[1] = (unsigned)(SELM[tok_r[1]] >> idx) & 1u; }
            if (mode == TM_SELF) {
                const bool a0 = __ballot(selb[0] != 0u) != 0ull, a1 = __ballot(selb[1] != 0u) != 0ull;
                if (a0 && a1) AT_CALL(TM_SELF);
                else if (a0) at_tile<TM_SELF, VAR, 1>(kb_, vb_, LUTJ, IMP1, IMP2, qf, oacc, lacc, LROW, tok_r, selb, cfar, relbase, idx, l15, lq, tsw, tsn);
                else if (a1) at_tile<TM_SELF, VAR, 2>(kb_, vb_, LUTJ, IMP1, IMP2, qf, oacc, lacc, LROW, tok_r, selb, cfar, relbase, idx, l15, lq, tsw, tsn); }
            else if (mode == TM_WINF) AT_CALL(TM_WINF);
            else if (mode == TM_SELN) AT_CALL(TM_SELN);
            else if (mode == TM_WINN) AT_CALL(TM_WINN);
            else if (mode == TM_WINE) AT_CALL(TM_WINE);
            else if (mode == TM_CMP2) AT_CALL(TM_CMP2);
            else { AT_CALL(TM_CMP1);
                if (idx == n1 - 1) {
#pragma unroll
                    for (int rb = 0; rb < 2; ++rb) { const float s = sum_xor32(sum_xor16(lacc[rb][0])); if (lq == 0) LROW[16 * rb + l15] = s > 0.f ? 1.0f / s : 0.f; lacc[rb] = (pg8::f32x4){0.f, 0.f, 0.f, 0.f}; } } }
#undef AT_CALL
            {
                if (endf && !(VAR & 256)) {
                    const int br = endf - 1;
#pragma unroll
                    for (int rb = 0; rb < 2; ++rb)
#pragma unroll
                        for (int r = 0; r < 4; ++r) { const int qrow = 16 * rb + 4 * lq + r;
                            const float ls_ = lacc[rb][r]; lacc[rb][r] = 0.f;
                            const float gt = GATL[(8 * w + 4 * rb + lq) * 12 + r * 3 + br] * (endf == 1 ? 1.0f : (ls_ > 0.f ? 1.0f / ls_ : 0.f));
#pragma unroll
                            for (int db = 0; db < 4; ++db) { float v = gt * oacc[rb][db][r]; oacc[rb][db][r] = 0.f;
                                LAS bf16* po = OUTL + qrow * 72 + 16 * db + l15;
                                if (br > 0) v += __builtin_bit_cast(float, (unsigned)(*po) << 16);
                                *po = (bf16)f2bf(v); } }
                    if (br == 2 && !(VAR & 1)) {
                        LDS_WAIT(); asm volatile("" ::: "memory");
#pragma unroll
                        for (int i = 0; i < 4; ++i) { const int ch = i * 64 + lane, row = ch >> 3, c16 = ch & 7;
                            const v4u o = *(const LAS v4u*)((const LAS unsigned char*)OUTL + row * 144 + 16 * c16);
                            *(GAS v4u*)(YA + (size_t)(m0 + 8 * w + (row >> 2)) * 512 + g * 256 + (row & 3) * 64 + 8 * c16) = o; }
                    }
                }
            }
            }
        }
#undef AT_DMA
    }
}

constexpr int N_PHASES = 13;
#ifndef MK_ONE_LAUNCH
#define MK_ONE_LAUNCH 1
#endif
#ifndef REP_P0
#define REP_P0 1
#endif
#ifndef REP_P1
#define REP_P1 1
#endif
#ifndef REP_P2
#define REP_P2 1
#endif
#ifndef REP_P3
#define REP_P3 1
#endif
#ifndef REP_P5
#define REP_P5 1
#endif
#ifndef REP_P6
#define REP_P6 1
#endif
#ifndef REP_P8
#define REP_P8 1
#endif
#ifndef REP_P7
#define REP_P7 1
#endif
#ifndef REP_P11
#define REP_P11 1
#endif
#ifndef REP_P4
#define REP_P4 1
#endif
#ifndef REP_P9
#define REP_P9 1
#endif
#ifndef REP_P10
#define REP_P10 1
#endif
#ifndef MK_BUILD
#define MK_BUILD 0
#endif

__global__ void __launch_bounds__(NTHREADS, 2) fwd_kernel(Args args) {
    extern __shared__ __attribute__((aligned(16))) unsigned char lds[];
    Frame F;
    F.lds = (LAS unsigned char*)lds;
    F.MISC = (volatile LAS unsigned*)(F.lds + MISC_OFF);
    F.tid = threadIdx.x; F.lane = F.tid & 63; F.wave = __builtin_amdgcn_readfirstlane(F.tid >> 6);
    F.G = gridDim.x; F.bid = blockIdx.x; F.ws = args.ws;
    F.ctl = (gu32*)(args.ws + WS_CTL);
    for (int u = F.tid; u < (LDS_BYTES - LDSCTL_OFF) / 4; u += NTHREADS) ((LAS unsigned*)(F.lds + LDSCTL_OFF))[u] = 0u;
    __syncthreads();
    XcdBarrier bar; bar.bar = (unsigned*)(F.ctl + CW_BAR); bar.x = 0; bar.st = nullptr;
    if (MK_ONE_LAUNCH) bar = xcd_barrier_post((unsigned*)(F.ctl + CW_BAR), F.MISC + 8);
    const int lo = args.ph_lo, hi = args.ph_hi;
#define IN(k) (lo <= (k) && (k) < hi)
#define SEAM(k) do { if (IN(k) && IN((k) + 1)) xcd_barrier(bar); } while (0)
    unsigned char* ws = args.ws;
    const float* ada = (const float*)(ws + WS_ADA);

    if (IN(0)) { for (int rep = 0; rep < REP_P0; ++rep) { p0_prologue(F, args, rep == REP_P0 - 1); __syncthreads(); } } SEAM(0);
    if (IN(1)) { for (int rep = 0; rep < REP_P1; ++rep) modnorm_rows<false>(F, args.in[I_X], args.in[I_N1G], ada, 0, (bf16*)(ws + WS_H)); } SEAM(1);
    if (IN(2)) { {
        pg8::Gemm g{(const bf16*)(ws + WS_H), (const bf16*)(ws + WS_WIN_T), M, NIN, D, D, D}; pg8::StaticOrder S; S.init(M, NIN, F.G, F.bid);
        EpiIn E{ws, args.in[I_QNG], args.in[I_KNG]};
        pg8::gemm_phase<EpiIn, pg8::StaticOrder, true, true>(F.lds + RING_OFF, g, S, E);
#if REP_P2 > 1
        __syncthreads(); pg8::gemm_phase<EpiIn, pg8::StaticOrder, true, true>(F.lds + RING_OFF, g, S, E);
#endif
        }
    } SEAM(2);
    if (IN(3)) { for (int rep = 0; rep < REP_P3; ++rep) { __syncthreads(); pool_phase(F); __syncthreads(); compress_phase(F, args.in[I_KNG]); __syncthreads(); vtranspose_phase(F); } } SEAM(3);
    if (IN(4)) {
#ifdef PROBE_P4
        attention_phase<PROBE_P4>(F, args); __syncthreads();
#endif
        for (int rep = 0; rep < REP_P4; ++rep) { attention_phase<0>(F, args); __syncthreads(); } } SEAM(4);
    if (IN(5)) { {
        { pg8::Gemm g{(const bf16*)(ws + WS_PL), (const bf16*)(ws + WS_WEFF_T), M, D, POOLW, POOLW, POOLW}; pg8::StaticOrder S; S.init(M, D, F.G, F.bid);
          EpiMix<false> E{(bf16*)(ws + WS_MIX), (const bf16*)(ws + WS_GM), 0};
          pg8::gemm_phase<EpiMix<false>, pg8::StaticOrder, true, true>(F.lds + RING_OFF, g, S, E); }
        { pg8::Gemm g{(const bf16*)(ws + WS_YA), (const bf16*)(ws + WS_WBA_T), M, D, QW, QW, QW}; pg8::StaticOrder S; S.init(M, D, F.G, F.bid);
          EpiMix<true> E{(bf16*)(ws + WS_MIX), (const bf16*)(ws + WS_GM), 1024};
          pg8::gemm_phase<EpiMix<true>, pg8::StaticOrder, true, true>(F.lds + RING_OFF, g, S, E); } }
#if REP_P5 > 1
        { __syncthreads(); { pg8::Gemm g{(const bf16*)(ws + WS_PL), (const bf16*)(ws + WS_WEFF_T), M, D, POOLW, POOLW, POOLW}; pg8::StaticOrder S; S.init(M, D, F.G, F.bid);
          EpiMix<false> E{(bf16*)(ws + WS_MIX), (const bf16*)(ws + WS_GM), 0};
          pg8::gemm_phase<EpiMix<false>, pg8::StaticOrder, true, true>(F.lds + RING_OFF, g, S, E); }
        { pg8::Gemm g{(const bf16*)(ws + WS_YA), (const bf16*)(ws + WS_WBA_T), M, D, QW, QW, QW}; pg8::StaticOrder S; S.init(M, D, F.G, F.bid);
          EpiMix<true> E{(bf16*)(ws + WS_MIX), (const bf16*)(ws + WS_GM), 1024};
          pg8::gemm_phase<EpiMix<true>, pg8::StaticOrder, true, true>(F.lds + RING_OFF, g, S, E); } }
#endif
    } SEAM(5);
    if (IN(6)) { {
        pg8::Gemm g{(const bf16*)(ws + WS_MIX), (const bf16*)(ws + WS_WOUT_T), M, D, D, D, D}; pg8::StaticOrder S; S.init(M, D, F.G, F.bid);
        EpiRes E{args.in[I_X], args.out, ada, 2};
        pg8::gemm_phase<EpiRes, pg8::StaticOrder, true, true>(F.lds + RING_OFF, g, S, E);
#if REP_P6 > 1
        __syncthreads(); pg8::gemm_phase<EpiRes, pg8::StaticOrder, true, true>(F.lds + RING_OFF, g, S, E);
#endif
        }
    } SEAM(6);
    if (IN(7)) { for (int rep = 0; rep < REP_P7; ++rep) modnorm_rows<true>(F, args.out, args.in[I_N2G], ada, 3, (bf16*)(ws + WS_H)); } SEAM(7);
    if (IN(8)) { {
        pg8::Gemm g{(const bf16*)(ws + WS_H), (const bf16*)(ws + WS_WQ_T), M, PQW, D, D, D}; pg8::StaticOrder S; S.init(M, PQW, F.G, F.bid);
        EpiStoreBf16 E{(bf16*)(ws + WS_QV), PQW};
        pg8::gemm_phase<EpiStoreBf16, pg8::StaticOrder, true, true>(F.lds + RING_OFF, g, S, E);
#if REP_P8 > 1
        __syncthreads(); pg8::gemm_phase<EpiStoreBf16, pg8::StaticOrder, true, true>(F.lds + RING_OFF, g, S, E);
#endif
        }
    } SEAM(8);
    if (IN(9)) { for (int rep = 0; rep < REP_P9; ++rep) peer_select_phase(F); } SEAM(9);
#ifdef PROBE_XCD
    if (IN(10)) { if (F.tid == 0) __hip_atomic_store((unsigned*)(F.ctl + 2048 + F.bid), 100u + xb_xcc_id(), RLX_AGENT); }
#endif
    if (IN(10)) {
#ifdef PROBE_DOT
        peer_dot_phase<PROBE_DOT>(F); __syncthreads();
#endif
#ifdef PROBE_LOADRATE
        peer_loadrate_probe<PROBE_LOADRATE>(F); __syncthreads();
#endif
        peer_dot_phase<0>(F); } SEAM(10);
    if (IN(11)) { for (int rep = 0; rep < REP_P11; ++rep) peer_coef_phase(F); } SEAM(11);
#ifdef PROBE_XCD
    if (IN(12) && F.bid == 0 && F.tid == 0) { bool ok = true; for (int i = 0; i < F.G; ++i) { const unsigned a = __hip_atomic_load((unsigned*)(F.ctl + 2048 + i), RLX_AGENT), b0 = __hip_atomic_load((unsigned*)(F.ctl + 2048 + (i & 7)), RLX_AGENT); if (a != b0 || a < 100u) ok = false; }
        for (int i = 0; i < 8; ++i) for (int q = 0; q < i; ++q) if (__hip_atomic_load((unsigned*)(F.ctl + 2048 + i), RLX_AGENT) == __hip_atomic_load((unsigned*)(F.ctl + 2048 + q), RLX_AGENT)) ok = false;
        if (!ok) args.out[12345] = 1.0e9f; }
    __syncthreads();
#endif
    if (IN(12)) {
#if defined(CHECK_OUT_MFMA)
        peer_out_mfma_phase<1>(F, ada, args.out); __syncthreads(); VM_WAIT(); __syncthreads(); peer_out_phase<false, true>(F, ada, args.out);
#elif defined(OUT_VALU)
        for (int rep = 1; rep < REP_P10; ++rep) peer_out_phase<true>(F, ada, args.out); peer_out_phase<false>(F, ada, args.out);
#else
#ifdef PROBE_OUT
        peer_out_mfma_phase<1>(F, ada, args.out); __syncthreads();
#endif
        peer_out_mfma_phase<0>(F, ada, args.out);
#endif
    }
#undef IN
#undef SEAM
}

extern "C" void kernel_launch(void* const* d_in, const int* in_sizes, int n_in, void* d_out, int out_size, void* d_ws, size_t ws_size, hipStream_t stream) {
    static int grid = 0;
    if (grid == 0) {
        if (n_in != N_IN || in_sizes[0] != M * D || out_size != M * D || ws_size < WS_END) {
            fprintf(stderr, "kernel_launch: unexpected shapes: n_in %d in0 %d out %d ws %zu (need %zu)\n", n_in, n_in > 0 ? in_sizes[0] : -1, out_size, ws_size, (size_t)WS_END); grid = -1; return; }
        int dev = 0, cus = 0, per_cu = 0;
        if (hipGetDevice(&dev) != hipSuccess || hipDeviceGetAttribute(&cus, hipDeviceAttributeMultiprocessorCount, dev) != hipSuccess) { grid = -1; return; }
        if (hipFuncSetAttribute((const void*)fwd_kernel, hipFuncAttributeMaxDynamicSharedMemorySize, LDS_BYTES) != hipSuccess) { fprintf(stderr, "kernel_launch: hipFuncSetAttribute failed\n"); grid = -1; return; }
        if (hipOccupancyMaxActiveBlocksPerMultiprocessor(&per_cu, (const void*)fwd_kernel, NTHREADS, LDS_BYTES) != hipSuccess || per_cu < 1)
            fprintf(stderr, "kernel_launch: occupancy query reports %d workgroups per CU\n", per_cu);
        (void)hipGetLastError();
        grid = cus;
    }
    if (grid < 0) return;
    if (hipMemsetAsync((char*)d_ws + WS_CTL, 0, CTL_ZERO_BYTES, stream) != hipSuccess) return;
    Args a{};
    for (int i = 0; i < N_IN; ++i) a.in[i] = (const float*)d_in[i];
    a.out = (float*)d_out; a.ws = (unsigned char*)d_ws;
    if (MK_ONE_LAUNCH) {
        a.ph_lo = 0; a.ph_hi = N_PHASES; a.li = 0;
        hipLaunchKernelGGL(fwd_kernel, dim3(grid), dim3(NTHREADS), LDS_BYTES, stream, a);
    } else {
        for (int p = 0; p < N_PHASES; ++p) {
            a.ph_lo = p; a.ph_hi = p + 1; a.li = p;
            hipLaunchKernelGGL(fwd_kernel, dim3(grid), dim3(NTHREADS), LDS_BYTES, stream, a);
        }
    }
}
```

```cpp
#include <hip/hip_runtime.h>
#include <cstdio>
#include <cstdint>
namespace pg8 {
#define PG8_LAS __attribute__((address_space(3)))
typedef unsigned short bf16_t;
typedef short bf16x8 __attribute__((ext_vector_type(8)));
typedef float f32x4 __attribute__((ext_vector_type(4)));
typedef unsigned u32x4 __attribute__((ext_vector_type(4)));
constexpr int BM = 256, BK = 64, HALF = 128, HTB = HALF * BK * 2  , STAGE_BYTES = 8 * HTB, NXCD = 8, WGM = 8;

__host__ __device__ __forceinline__ int lds_byte(int r, int c) { const int st = (r >> 4) * 2 + (c >> 5), rr = r & 15, cc = c & 31, ob = rr * 64 + cc * 2; return st * 1024 + (ob ^ (((ob >> 9) & 1) << 5)); }
__host__ __device__ __forceinline__ void stage_rc(int b, int& R, int& C) { const int st = b / 1024, sb = b % 1024, swz = sb ^ (((sb >> 9) & 1) << 5); R = (st >> 1) * 16 + swz / 64; C = (st & 1) * 32 + (swz % 64) / 2; }
__host__ __device__ __forceinline__ int perm32(int rho) { const int n = rho >> 4, i = rho & 15; return 8 * (i >> 2) + 4 * n + (i & 3); }

struct Unit { int pm, pn; };
struct Gemm { const bf16_t* A; const bf16_t* Bt; int M, N, K, lda, ldb; };

struct StaticOrder {
    int nM, nN, nwg, G, c;
    __host__ __device__ void init(int M, int N, int G_, int c_) { nM = M / BM; nN = N / BM; nwg = nM * nN; G = G_; c = c_; }
    __host__ __device__ bool next(int i, Unit& u) const {
        const long L = (long)i * G + c; if (L >= nwg) return false;
        int wgid = (int)L; { const int q = nwg / NXCD, r = nwg % NXCD, xcd = wgid % NXCD, off = wgid / NXCD; wgid = (xcd < r ? xcd * (q + 1) : r * (q + 1) + (xcd - r) * q) + off; }
        const int nig = WGM * nN, gid = wgid / nig, fm = gid * WGM, gsz = (nM - fm) < WGM ? (nM - fm) : WGM;
        u.pm = fm + ((wgid % nig) % gsz); u.pn = (wgid % nig) / gsz; return true;
    }
    __device__ __forceinline__ void a_ready(const Unit&) const {}
    __device__ __forceinline__ void done(const Unit&) const {}
};

__device__ __forceinline__ unsigned cvt_pk_bf16(float lo, float hi) { unsigned r; asm volatile("v_cvt_pk_bf16_f32 %0, %1, %2" : "=v"(r) : "v"(lo), "v"(hi)); return r; }
template <class Epi, class Sched, bool ALIGN_EPI = false, bool SP2 = false>
__device__ __forceinline__ void gemm_phase(PG8_LAS unsigned char* lds, const Gemm g, const Sched& S, const Epi& E) {
    const int tid = threadIdx.x, wid = __builtin_amdgcn_readfirstlane(tid >> 6), lane = tid & 63, wr = wid >> 2, wc = wid & 3, fr = lane & 15, fq = lane >> 4;
    const int K = g.K, nt = K / BK;
    unsigned voffA[2], voffB[2];
#pragma unroll
    for (int i = 0; i < 2; ++i) { int R, C; stage_rc(tid * 16 + i * 8192, R, C); const int Rb = Epi::PERM ? ((R & ~31) + perm32(R & 31)) : R;
        voffA[i] = (unsigned)(R * g.lda + C) * 2u; voffB[i] = (unsigned)(Rb * g.ldb + C) * 2u; }
    const size_t kstep = (size_t)(BK * 2);
    const size_t hstepA = (size_t)HALF * g.lda * 2, hstepB = (size_t)HALF * g.ldb * 2;
    const size_t tstepA = 2 * hstepA, tstepB = 2 * hstepB;
    const unsigned ldsw = (unsigned)wid * 1024u;
    const int aoff = lds_byte(wr * 64 + fr, fq * 8), boff = lds_byte(wc * 32 + fr, fq * 8);
#define PG8_SA(b, h) (((b) * 2 + (h)) * HTB)
#define PG8_SB(b, h) ((4 + (b) * 2 + (h)) * HTB)
#define PG8_STAGE(bufoff, gbase, voff) do { _Pragma("unroll") for (int _i = 0; _i < 2; ++_i) \
        __builtin_amdgcn_global_load_lds((const unsigned*)((const char*)(gbase) + (voff)[_i]), (PG8_LAS unsigned*)(lds + (bufoff) + ldsw + _i * 8192), 16, 0, 0); } while (0)
#define PG8_LDA(dst, b, h) do { _Pragma("unroll") for (int m = 0; m < 4; ++m) _Pragma("unroll") for (int k = 0; k < 2; ++k) dst[m][k] = *(const PG8_LAS bf16x8*)(lds + PG8_SA(b, h) + aoff + m * 2048 + k * 1024); } while (0)
#define PG8_LDB(dst, b, h) do { _Pragma("unroll") for (int n = 0; n < 2; ++n) _Pragma("unroll") for (int k = 0; k < 2; ++k) dst[n][k] = *(const PG8_LAS bf16x8*)(lds + PG8_SB(b, h) + boff + n * 2048 + k * 1024); } while (0)
#define PG8_MMA(ai, bj, At, Bt) do { __builtin_amdgcn_s_setprio(1); _Pragma("unroll") for (int m = 0; m < 4; ++m) _Pragma("unroll") for (int n = 0; n < 2; ++n) _Pragma("unroll") for (int k = 0; k < 2; ++k) \
        acc[ai][bj][m][n] = __builtin_amdgcn_mfma_f32_16x16x32_bf16(Bt[n][k], At[m][k], acc[ai][bj][m][n], 0, 0, 0); __builtin_amdgcn_s_setprio(0); } while (0)
#define PG8_WAIT_V(n) asm volatile("s_waitcnt vmcnt(" #n ")" ::: "memory")
#define PG8_WAIT_L(n) asm volatile("s_waitcnt lgkmcnt(" #n ")" ::: "memory")
#define PG8_BAR __builtin_amdgcn_s_barrier()
#define PG8_SCHED __builtin_amdgcn_sched_barrier(0)
    Unit cur, nxt; int ui = 0;
    if (!S.next(0, cur)) return;
    f32x4 acc[2][2][4][2];
#pragma unroll
    for (int a = 0; a < 2; ++a)
#pragma unroll
        for (int b = 0; b < 2; ++b)
#pragma unroll
            for (int m = 0; m < 4; ++m)
#pragma unroll
                for (int n = 0; n < 2; ++n) acc[a][b][m][n] = (f32x4){0.f, 0.f, 0.f, 0.f};
    bf16x8 At[4][2], B0[2][2], B1[2][2];
    const char* cA = (const char*)g.A + (size_t)cur.pm * tstepA; const char* cB = (const char*)g.Bt + (size_t)cur.pn * tstepB;
    S.a_ready(cur);
    if constexpr (SP2) {
        PG8_STAGE(PG8_SB(0, 0), cB, voffB); PG8_STAGE(PG8_SB(0, 1), cB + hstepB, voffB); PG8_STAGE(PG8_SA(0, 0), cA, voffA); PG8_STAGE(PG8_SA(0, 1), cA + hstepA, voffA);
        if (wr == 1) PG8_BAR;
        PG8_WAIT_V(2); PG8_BAR;
        PG8_STAGE(PG8_SB(1, 0), cB + kstep, voffB); PG8_STAGE(PG8_SA(1, 0), cA + kstep, voffA); PG8_STAGE(PG8_SB(1, 1), cB + hstepB + kstep, voffB);
        PG8_WAIT_V(6); PG8_BAR;
    } else {
        PG8_STAGE(PG8_SB(0, 0), cB, voffB); PG8_STAGE(PG8_SA(0, 0), cA, voffA); PG8_STAGE(PG8_SB(0, 1), cB + hstepB, voffB); PG8_STAGE(PG8_SA(0, 1), cA + hstepA, voffA);
        if (wr == 1) PG8_BAR;
        PG8_WAIT_V(4); PG8_BAR;
        PG8_STAGE(PG8_SB(1, 0), cB + kstep, voffB); PG8_STAGE(PG8_SA(1, 0), cA + kstep, voffA); PG8_STAGE(PG8_SB(1, 1), cB + hstepB + kstep, voffB);
        PG8_WAIT_V(6); PG8_BAR;
    }
    for (;;) {
        const bool has_next = S.next(ui + 1, nxt);
        const char* nA = has_next ? (const char*)g.A + (size_t)nxt.pm * tstepA : cA; const char* nB = has_next ? (const char*)g.Bt + (size_t)nxt.pn * tstepB : cB;
        for (int t = 0; t < nt; t += 2) {
            const bool last = (t == nt - 2);
            const char* a1 = cA + (size_t)(t + 1) * kstep;
            const char* a2 = last ? nA : cA + (size_t)(t + 2) * kstep; const char* b2 = last ? nB : cB + (size_t)(t + 2) * kstep;
            const char* a3 = a2 + kstep; const char* b3 = b2 + kstep;
            if (last && has_next) S.a_ready(nxt);
            if constexpr (SP2) {
            PG8_LDB(B0, 0, 0); PG8_LDB(B1, 0, 1); PG8_SCHED; PG8_LDA(At, 0, 0); PG8_STAGE(PG8_SA(1, 1), a1 + hstepA, voffA);
            PG8_WAIT_V(8); PG8_WAIT_L(0); PG8_BAR; PG8_MMA(0, 0, At, B0); PG8_MMA(0, 1, At, B1); PG8_BAR; PG8_SCHED;
            PG8_LDA(At, 0, 1); PG8_STAGE(PG8_SB(0, 0), b2, voffB); PG8_STAGE(PG8_SB(0, 1), b2 + hstepB, voffB); PG8_STAGE(PG8_SA(0, 0), a2, voffA);
            PG8_WAIT_V(8); PG8_WAIT_L(0); PG8_BAR; PG8_MMA(1, 0, At, B0); PG8_MMA(1, 1, At, B1); PG8_BAR; PG8_SCHED;
            PG8_LDB(B0, 1, 0); PG8_LDB(B1, 1, 1); PG8_SCHED; PG8_LDA(At, 1, 0); PG8_STAGE(PG8_SA(0, 1), a2 + hstepA, voffA);
            PG8_WAIT_V(8); PG8_WAIT_L(0); PG8_BAR; PG8_MMA(0, 0, At, B0); PG8_MMA(0, 1, At, B1); PG8_BAR; PG8_SCHED;
            PG8_LDA(At, 1, 1); PG8_STAGE(PG8_SB(1, 0), b3, voffB); PG8_STAGE(PG8_SB(1, 1), b3 + hstepB, voffB); PG8_STAGE(PG8_SA(1, 0), a3, voffA);
            PG8_WAIT_V(8); PG8_WAIT_L(0); PG8_BAR; PG8_MMA(1, 0, At, B0); PG8_MMA(1, 1, At, B1); PG8_BAR; PG8_SCHED;
            } else {
            PG8_LDB(B0, 0, 0); PG8_SCHED; PG8_LDA(At, 0, 0); PG8_STAGE(PG8_SA(1, 1), a1 + hstepA, voffA);
            PG8_WAIT_L(8); PG8_BAR; PG8_WAIT_L(0); PG8_MMA(0, 0, At, B0); PG8_BAR; PG8_SCHED;
            PG8_LDB(B1, 0, 1); PG8_STAGE(PG8_SB(0, 0), b2, voffB);
            PG8_BAR; PG8_WAIT_L(0); PG8_MMA(0, 1, At, B1); PG8_BAR;
            PG8_LDA(At, 0, 1); PG8_STAGE(PG8_SA(0, 0), a2, voffA);
            PG8_BAR; PG8_WAIT_L(0); PG8_MMA(1, 0, At, B0); PG8_BAR; PG8_SCHED;
            PG8_STAGE(PG8_SB(0, 1), b2 + hstepB, voffB);
            PG8_WAIT_V(6); PG8_BAR; PG8_MMA(1, 1, At, B1); PG8_BAR;
            PG8_LDB(B0, 1, 0); PG8_SCHED; PG8_LDA(At, 1, 0); PG8_STAGE(PG8_SA(0, 1), a2 + hstepA, voffA);
            PG8_WAIT_L(8); PG8_BAR; PG8_WAIT_L(0); PG8_MMA(0, 0, At, B0); PG8_BAR; PG8_SCHED;
            PG8_LDB(B1, 1, 1); PG8_STAGE(PG8_SB(1, 0), b3, voffB);
            PG8_BAR; PG8_WAIT_L(0); PG8_MMA(0, 1, At, B1); PG8_BAR;
            PG8_LDA(At, 1, 1); PG8_STAGE(PG8_SA(1, 0), a3, voffA);
            PG8_BAR; PG8_WAIT_L(0); PG8_MMA(1, 0, At, B0); PG8_BAR; PG8_SCHED;
            PG8_STAGE(PG8_SB(1, 1), b3 + hstepB, voffB);
            PG8_WAIT_V(6); PG8_BAR; PG8_MMA(1, 1, At, B1); PG8_BAR;
            }
        }
        if constexpr (ALIGN_EPI) { if (wr == 0) PG8_BAR; }
        if constexpr (!Epi::AFTER_DRAIN) { E(acc, cur, wr, wc, fr, fq); S.done(cur); }
        if (!has_next) break;
#pragma unroll
        for (int a = 0; a < 2; ++a)
#pragma unroll
            for (int b = 0; b < 2; ++b)
#pragma unroll
                for (int m = 0; m < 4; ++m)
#pragma unroll
                    for (int n = 0; n < 2; ++n) acc[a][b][m][n] = (f32x4){0.f, 0.f, 0.f, 0.f};
        cur = nxt; cA = nA; cB = nB; ++ui;
        if constexpr (ALIGN_EPI) { if (wr == 1) PG8_BAR; }
    }
    PG8_WAIT_V(0);
    if constexpr (!ALIGN_EPI) { if (wr == 0) PG8_BAR; }
    PG8_BAR;
    if constexpr (Epi::AFTER_DRAIN) { E.fused(acc, cur, wr, wc, fr, fq, lds, wid, lane); S.done(cur); }
#undef PG8_SA
#undef PG8_SB
#undef PG8_STAGE
#undef PG8_LDA
#undef PG8_LDB
#undef PG8_MMA
#undef PG8_WAIT_V
#undef PG8_WAIT_L
#undef PG8_BAR
#undef PG8_SCHED
}
}

constexpr int NWAVES = 8, NTHREADS = NWAVES * 64;
constexpr int BATCH = 8, SEQ = 4096, D = 1024, M = BATCH * SEQ;
constexpr int POOLW = 512, QW = 512, NG = 2, HD = 64, NBG = BATCH * NG;
constexpr int IN_COLS = 3864, NIN = 4096;
constexpr int NCMP = 255, NCMP_PAD = 256, NSEL = 64;
constexpr int PH = 8, PK = 128, PTOP = 16, PQD = 256, PQW = PH * PQD;
constexpr int NEXP = PK * PK;
constexpr float EPS = 1e-6f;
enum { I_X = 0, I_C, I_RELB, I_ADAW, I_ADAB, I_N1G, I_N2G, I_WIN, I_POOLW, I_POOLS, I_CPEK, I_CW1K, I_CW2K, I_CPEV, I_CW1V, I_CW2V, I_QNG, I_KNG, I_WBP, I_WBA, I_WOUT, I_PWQ, I_PSK, I_PU, I_PV, N_IN };

constexpr size_t MiB = 1u << 20, KiB = 1u << 10;
constexpr size_t WS_CTL = 0, CTL_ZERO_BYTES = 1 * MiB;
constexpr size_t WS_ADA = 1 * MiB;
constexpr size_t WS_CB1K = 64 * KiB;
constexpr size_t WS_CB1V = WS_CB1K + 1 * KiB;
constexpr size_t WS_BIASL = WS_ADA + 256 * KiB;
constexpr size_t WS_WIN_T = 2 * MiB;
constexpr size_t WS_WEFF_T = 10 * MiB;
constexpr size_t WS_WBA_T = 11 * MiB;
constexpr size_t WS_WOUT_T = 12 * MiB;
constexpr size_t WS_WQ_T = 14 * MiB;
constexpr size_t WS_SUBK = 18 * MiB;
constexpr size_t WS_CW1K_T = 18 * MiB + 512 * KiB;
constexpr size_t WS_CW1V_T = 19 * MiB;
constexpr size_t WS_CW2K_T = 19 * MiB + 512 * KiB;
constexpr size_t WS_CW2V_T = WS_CW2K_T + 64 * KiB;
constexpr size_t WS_KC = 20 * MiB;
constexpr size_t WS_VCT = 20 * MiB + 512 * KiB;
constexpr size_t WS_GATE = 21 * MiB;
constexpr size_t WS_UB = 24 * MiB;
constexpr size_t WS_VB = 56 * MiB;
constexpr size_t WS_SCLU = WS_UB + 16 * MiB, WS_SCLV = WS_SCLU + 64 * KiB;
constexpr size_t WS_H = 88 * MiB;
constexpr size_t WS_ZP = 152 * MiB;
constexpr size_t WS_Q = 184 * MiB;
constexpr size_t WS_KCR = 216 * MiB;
constexpr size_t WS_VCR = 225 * MiB;
constexpr size_t WS_KS = 234 * MiB, WS_VS = 242 * MiB, WS_KW = 250 * MiB, WS_VW = 258 * MiB;
constexpr size_t WS_VST = 266 * MiB, WS_VWT = 274 * MiB;
constexpr size_t WS_PL = 282 * MiB;
constexpr size_t WS_YA = 314 * MiB;
constexpr size_t WS_GM = 346 * MiB;
constexpr size_t WS_MIX = WS_ZP;
constexpr size_t WS_QV = WS_GM;
constexpr size_t WS_EID = WS_PL;
constexpr size_t WS_GW = WS_PL + 16 * MiB;
constexpr size_t WS_PART = WS_GM;
constexpr size_t WS_CF = WS_YA;
constexpr size_t WS_CFS = WS_YA + 8 * MiB;
constexpr size_t WS_H8 = WS_ZP;
constexpr size_t WS_HS = WS_ZP + 32 * MiB;
constexpr size_t WS_END = 474 * MiB;
constexpr int CW_TMO = 0, CW_CODE = 1, CW_BAR = 4096;

constexpr int RING_OFF = 0, RING_BYTES = 131072;
constexpr int LDSCTL_OFF = RING_BYTES, MISC_OFF = LDSCTL_OFF + 320;
constexpr int LDS_BYTES = 147456;

#define GAS __attribute__((address_space(1)))
#define LAS __attribute__((address_space(3)))
typedef unsigned short bf16;
typedef unsigned v4u __attribute__((ext_vector_type(4)));
typedef unsigned v2u __attribute__((ext_vector_type(2)));
typedef int v2i __attribute__((ext_vector_type(2)));
typedef float f32x4 __attribute__((ext_vector_type(4)));
typedef short bf16x8 __attribute__((ext_vector_type(8)));
typedef GAS unsigned gu32;
#define RLX_AGENT __ATOMIC_RELAXED, __HIP_MEMORY_SCOPE_AGENT
#define LDS_WAIT() asm volatile("s_waitcnt lgkmcnt(0)" ::: "memory")
#define VM_WAIT() asm volatile("s_waitcnt vmcnt(0)" ::: "memory")
__device__ __forceinline__ unsigned f2bf(float f) { unsigned u = __builtin_bit_cast(unsigned, f); return (u + 0x7fffu + ((u >> 16) & 1u)) >> 16; }
__device__ __forceinline__ unsigned pk2(float lo, float hi) { return f2bf(lo) | (f2bf(hi) << 16); }
__device__ __forceinline__ float bflo(unsigned w) { return __builtin_bit_cast(float, w << 16); }
__device__ __forceinline__ float bfhi(unsigned w) { return __builtin_bit_cast(float, w & 0xffff0000u); }
__device__ __forceinline__ float sigmoidf_(float v) { return __builtin_amdgcn_rcpf(1.0f + __builtin_amdgcn_exp2f(v * -1.4426950408889634f)); }
typedef __bf16 bf16x2_hw __attribute__((ext_vector_type(2)));
typedef float f32x2_hw __attribute__((ext_vector_type(2)));
__device__ __forceinline__ unsigned pkh(float lo, float hi) { return __builtin_bit_cast(unsigned, __builtin_convertvector((f32x2_hw){lo, hi}, bf16x2_hw)); }
__device__ __forceinline__ float gelu_tanh_safe(float v) { const float u = 0.7978845608028654f * (v + 0.044715f * v * v * v); return 0.5f * v * (1.0f + tanhf(u)); }
template <int CTRL> __device__ __forceinline__ float dppf(float v) { return __builtin_bit_cast(float, __builtin_amdgcn_update_dpp(0, __builtin_bit_cast(int, v), CTRL, 0xF, 0xF, true)); }
template <int CTRL> __device__ __forceinline__ int dppi(int v) { return __builtin_amdgcn_update_dpp(0, v, CTRL, 0xF, 0xF, true); }
#define DPP_XOR1 0xB1
#define DPP_XOR2 0x4E
#define DPP_HMIR 0x141
#define DPP_ROR8 0x128
__device__ __forceinline__ void swap16_(float& a, float& b) { asm volatile("v_nop\n\tv_nop\n\tv_permlane16_swap_b32 %0, %1" : "+v"(a), "+v"(b)); }
__device__ __forceinline__ void swap32_(float& a, float& b) { asm volatile("v_nop\n\tv_nop\n\tv_permlane32_swap_b32 %0, %1" : "+v"(a), "+v"(b)); }
__device__ __forceinline__ float sum_xor16(float v) { float a = v, b = v; swap16_(a, b); return a + b; }
__device__ __forceinline__ float sum_xor32(float v) { float a = v, b = v; swap32_(a, b); return a + b; }
__device__ __forceinline__ float max_xor16(float v) { float a = v, b = v; swap16_(a, b); return fmaxf(a, b); }
__device__ __forceinline__ float max_xor32(float v) { float a = v, b = v; swap32_(a, b); return fmaxf(a, b); }
__device__ __forceinline__ float wave_sum(float v) {
    v += dppf<DPP_XOR1>(v); v += dppf<DPP_XOR2>(v); v += dppf<DPP_HMIR>(v); v += dppf<DPP_ROR8>(v);
    return sum_xor32(sum_xor16(v));
}
__device__ __forceinline__ float wave_max(float v) {
    v = fmaxf(v, dppf<DPP_XOR1>(v)); v = fmaxf(v, dppf<DPP_XOR2>(v)); v = fmaxf(v, dppf<DPP_HMIR>(v)); v = fmaxf(v, dppf<DPP_ROR8>(v));
    return max_xor32(max_xor16(v));
}

#define XB_TMO      128
#define XB_XCNT(j)  (256  + 64 * (j))
#define XB_XSUB(j)  (1280 + 64 * (j))
#define XB_XGEN(j)  (2304 + 64 * (j))
#define XB_TOP      3328
#define XB_TOPGEN   3392
#define XCD_BAR_WORDS 3456
#define XB_SPIN_CAP (1u << 18)
__device__ __forceinline__ unsigned xb_ld(unsigned* p)              { return __hip_atomic_load(p, __ATOMIC_RELAXED, __HIP_MEMORY_SCOPE_AGENT); }
__device__ __forceinline__ unsigned xb_add(unsigned* p, unsigned v) { return __hip_atomic_fetch_add(p, v, __ATOMIC_RELAXED, __HIP_MEMORY_SCOPE_AGENT); }
__device__ __forceinline__ unsigned xb_xcc_id() { return (unsigned)__builtin_amdgcn_s_getreg((3 << 11) | 20) & 0xFu; }
#define XB_SPIN(cond, bar) do { unsigned _sp = 0; while (cond) { __builtin_amdgcn_s_sleep(1); \
    if ((++_sp & 255u) == 0u) { if (xb_ld(&(bar)[XB_TMO])) break; if (_sp > XB_SPIN_CAP) { atomicAdd(&(bar)[XB_TMO], 1u); break; } } } } while (0)
struct XcdBarrier { unsigned* bar; unsigned x; volatile LAS unsigned* st; };
__device__ __forceinline__ XcdBarrier xcd_barrier_post(unsigned* bar, volatile LAS unsigned* st) {
    XcdBarrier b; b.bar = bar; b.x = xb_xcc_id(); b.st = st;
    if (threadIdx.x == 0) (void)xb_add(&bar[XB_XCNT(b.x)], 1u);
    return b;
}
__device__ __forceinline__ void xcd_barrier_complete(unsigned* bar, unsigned x, unsigned& nloc, unsigned& nx) {
    const unsigned G = gridDim.x * gridDim.y * gridDim.z;
    unsigned sum, cnt, mine, sp = 0u;
    for (;;) {
        sum = 0u; cnt = 0u; mine = 0u;
#pragma unroll
        for (unsigned j = 0; j < 16; ++j) { const unsigned c = xb_ld(&bar[XB_XCNT(j)]); sum += c; cnt += (c > 0u) ? 1u : 0u; mine = (j == x) ? c : mine; }
        if (sum == G) break;
        __builtin_amdgcn_s_sleep(1);
        if ((++sp & 255u) == 0u) { if (xb_ld(&bar[XB_TMO])) break; if (sp > XB_SPIN_CAP) { atomicAdd(&bar[XB_TMO], 1u); break; } }
    }
    nloc = mine > 0u ? mine : 1u; nx = cnt > 0u ? cnt : 1u;
}
__device__ __forceinline__ void xcd_barrier(const XcdBarrier& b) {
    asm volatile("s_waitcnt vmcnt(0)" ::: "memory");
    __syncthreads();
    if (threadIdx.x == 0) {
        unsigned* bar = b.bar;
        __builtin_amdgcn_s_waitcnt(0);
        unsigned nloc = b.st[0], nx = b.st[1];
        if (nloc == 0u) { xcd_barrier_complete(bar, b.x, nloc, nx); b.st[0] = nloc; b.st[1] = nx; }
        const unsigned old = xb_add(&bar[XB_XSUB(b.x)], 1u);
        const unsigned gen = old / nloc;
        if (old + 1u == (gen + 1u) * nloc) {
            __builtin_amdgcn_fence(__ATOMIC_RELEASE, "agent");
            asm volatile("s_waitcnt vmcnt(0)" ::: "memory");
            const unsigned og = xb_add(&bar[XB_TOP], 1u);
            const unsigned tg = og / nx;
            if (og + 1u == (tg + 1u) * nx) xb_add(&bar[XB_TOPGEN], 1u);
            else XB_SPIN(xb_ld(&bar[XB_TOPGEN]) == tg, bar);
            __builtin_amdgcn_fence(__ATOMIC_ACQUIRE, "agent");
            xb_add(&bar[XB_XGEN(b.x)], 1u);
            asm volatile("s_waitcnt vmcnt(0)" ::: "memory");
        } else {
            XB_SPIN(xb_ld(&bar[XB_XGEN(b.x)]) == gen, bar);
            __builtin_amdgcn_fence(__ATOMIC_ACQUIRE, "agent");
            asm volatile("s_waitcnt vmcnt(0)" ::: "memory");
        }
    }
    __syncthreads();
}

struct Args { const float* in[N_IN]; float* out; unsigned char* ws; int ph_lo, ph_hi, li, pad; };
struct Frame {
    LAS unsigned char* lds;
    volatile LAS unsigned* MISC;
    gu32* ctl;
    int tid, lane, wave, G, bid;
    unsigned char* ws;
};

template <bool I8> __device__ __forceinline__ void cvt_row_store(const f32x4 (&v)[4], int row, unsigned char* dst, float* inv_scale, int lane) {
    float m = 0.f;
#pragma unroll
    for (int j = 0; j < 4; ++j) m = fmaxf(m, fmaxf(fmaxf(fabsf(v[j].x), fabsf(v[j].y)), fmaxf(fabsf(v[j].z), fabsf(v[j].w))));
    m = wave_max(m);
    unsigned ww[4]; float isc;
    if (I8) { const float sc = m > 0.f ? 127.0f / m : 0.f; isc = m * (1.0f / 127.0f);
#pragma unroll
        for (int j = 0; j < 4; ++j) { const int q0 = (int)rintf(v[j].x * sc), q1 = (int)rintf(v[j].y * sc), q2 = (int)rintf(v[j].z * sc), q3 = (int)rintf(v[j].w * sc);
            ww[j] = ((unsigned)q0 & 0xffu) | (((unsigned)q1 & 0xffu) << 8) | (((unsigned)q2 & 0xffu) << 16) | (((unsigned)q3 & 0xffu) << 24); } }
    else { const unsigned E = (__builtin_bit_cast(unsigned, m) >> 23) & 0xffu; float sc = 1.f; isc = 1.f;
        if (E >= 8u && E <= 250u) { sc = __builtin_bit_cast(float, (261u - E) << 23); isc = __builtin_bit_cast(float, (E - 7u) << 23); }
#pragma unroll
        for (int j = 0; j < 4; ++j) { int t = __builtin_amdgcn_cvt_pk_fp8_f32(v[j].x * sc, v[j].y * sc, 0, false); t = __builtin_amdgcn_cvt_pk_fp8_f32(v[j].z * sc, v[j].w * sc, t, true); ww[j] = (unsigned)t; } }
    *(GAS v4u*)(dst + (size_t)(lane >> 3) * NEXP * 128 + (size_t)row * 128 + 16 * (lane & 7)) = (v4u){ww[0], ww[1], ww[2], ww[3]};
    if (lane == 0) inv_scale[row] = isc;
}
template <bool I8> __device__ __forceinline__ void cvt_rows_8bit(const float* src, unsigned char* dst, float* inv_scale, int gw, int NGW, int lane) {
    for (int row = gw; row < NEXP; row += 2 * NGW) {
        const int row1 = row + NGW; const bool has1 = row1 < NEXP;
        f32x4 v0[4], v1[4];
#pragma unroll
        for (int j = 0; j < 4; ++j) v0[j] = *(const GAS f32x4*)(src + (size_t)row * D + 16 * lane + 4 * j);
#pragma unroll
        for (int j = 0; j < 4; ++j) v1[j] = has1 ? *(const GAS f32x4*)(src + (size_t)row1 * D + 16 * lane + 4 * j) : (f32x4){0.f, 0.f, 0.f, 0.f};
        cvt_row_store<I8>(v0, row, dst, inv_scale, lane);
        if (has1) cvt_row_store<I8>(v1, row1, dst, inv_scale, lane);
    }
}
__device__ __forceinline__ void p0_transpose_item(const float* W, int ldw, int src_col0, int valid, int K, bf16* WT, int dst_row0, int k0, LAS float* scr, int lane) {
    const int n_ = lane & 31;
#pragma unroll 8
    for (int i = 0; i < 32; ++i) { const int kk = 2 * i + (lane >> 5); scr[kk * 33 + n_] = (n_ < valid) ? W[(size_t)(k0 + kk) * ldw + src_col0 + n_] : 0.f; }
    LDS_WAIT(); asm volatile("" ::: "memory");
    const int c = lane & 7;
#pragma unroll
    for (int j = 0; j < 4; ++j) { const int n = (lane >> 3) + 8 * j; const LAS float* s = scr + (8 * c) * 33 + n;
        v4u o; o.x = pk2(s[0 * 33], s[1 * 33]); o.y = pk2(s[2 * 33], s[3 * 33]); o.z = pk2(s[4 * 33], s[5 * 33]); o.w = pk2(s[6 * 33], s[7 * 33]);
        *(GAS v4u*)(WT + (size_t)(dst_row0 + n) * K + k0 + 8 * c) = o; }
    LDS_WAIT(); asm volatile("" ::: "memory");
}
__device__ __forceinline__ bool p0_mat(int& r, const float* W, int K, int N, bf16* WT, LAS float* scr, int lane) {
    const int ng = N / 32, items = ng * (K / 64);
    if (r < items) { const int kb = r / ng, nb = r % ng; p0_transpose_item(W, N, 32 * nb, 32, K, WT, 32 * nb, 64 * kb, scr, lane); return true; }
    r -= items; return false;
}
__device__ __forceinline__ void cvt_f32_bf16_stream(const float* src, bf16* dst, size_t n8, size_t gtid, size_t gthreads) {
    for (size_t i = gtid; i < n8; i += gthreads) {
        const f32x4 a = *(const GAS f32x4*)(src + 8 * i), b = *(const GAS f32x4*)(src + 8 * i + 4);
        v4u o; o.x = pk2(a.x, a.y); o.y = pk2(a.z, a.w); o.z = pk2(b.x, b.y); o.w = pk2(b.z, b.w);
        *(GAS v4u*)(dst + 8 * i) = o; }
}

__device__ __forceinline__ void p0_prologue(Frame& F, const Args& args, bool do_bias = true) {
    unsigned char* ws = F.ws;
    const int gw = F.bid * NWAVES + F.wave, NGW = F.G * NWAVES;
    const size_t gtid = (size_t)F.bid * NTHREADS + F.tid, gthreads = (size_t)F.G * NTHREADS;
    {
        LAS float* sl = (LAS float*)(F.lds);
        LAS float* red = (LAS float*)(F.lds + 32768);
        const float* c = args.in[I_C];
        { f32x4 cv[4];
#pragma unroll
          for (int q = 0; q < 4; ++q) cv[q] = *(const GAS f32x4*)(c + 4 * (F.tid + NTHREADS * q));
#pragma unroll
          for (int q = 0; q < 4; ++q) { f32x4 o; o.x = cv[q].x / (1.0f + __expf(-cv[q].x)); o.y = cv[q].y / (1.0f + __expf(-cv[q].y)); o.z = cv[q].z / (1.0f + __expf(-cv[q].z)); o.w = cv[q].w / (1.0f + __expf(-cv[q].w));
              *(LAS f32x4*)(sl + 4 * (F.tid + NTHREADS * q)) = o; } }
        __syncthreads();
        for (int cb = F.bid; cb < 6 * D / 24; cb += F.G) {
            const int j0 = cb * 24;
            if (F.tid < 510) {
                const int kk = F.tid / 6, c4 = F.tid % 6;
                const float* w = args.in[I_ADAW] + j0 + 4 * c4;
                f32x4 wv[13];
#pragma unroll
                for (int m = 0; m < 13; ++m) { const int k = kk + 85 * m; wv[m] = (k < D) ? *(const GAS f32x4*)(w + (size_t)k * (6 * D)) : (f32x4){0.f, 0.f, 0.f, 0.f}; }
                f32x4 a[BATCH];
#pragma unroll
                for (int b = 0; b < BATCH; ++b) a[b] = (f32x4){0.f, 0.f, 0.f, 0.f};
#pragma unroll
                for (int m = 0; m < 13; ++m) { const int k = kk + 85 * m; const int kc = k < D ? k : 0;
#pragma unroll
                    for (int b = 0; b < BATCH; ++b) a[b] = a[b] + wv[m] * sl[b * D + kc]; }
#pragma unroll
                for (int b = 0; b < BATCH; ++b) { LAS float* rp = red + (kk * 24 + 4 * c4) * BATCH + b; rp[0] = a[b].x; rp[BATCH] = a[b].y; rp[2 * BATCH] = a[b].z; rp[3 * BATCH] = a[b].w; }
            }
            __syncthreads();
            if (F.tid < 24 * BATCH) { const int jj = F.tid / BATCH, b = F.tid % BATCH; float s = 0.f;
#pragma unroll 5
                for (int kk = 0; kk < 85; ++kk) s += red[(kk * 24 + jj) * BATCH + b];
                ((float*)(ws + WS_ADA))[b * (6 * D) + j0 + jj] = s + args.in[I_ADAB][j0 + jj]; }
            __syncthreads();
        }
    }
    if (F.bid >= 8 && F.bid < 40 && do_bias) {
        const int bb = F.bid - 8, kv = bb & 1, ch = bb >> 1;
        const float* pe = args.in[kv == 0 ? I_CPEK : I_CPEV]; const float* w1 = args.in[kv == 0 ? I_CW1K : I_CW1V];
        LAS float* red = (LAS float*)(F.lds);
        const int j = F.tid & 127, ic = F.tid >> 7; float s = 0.f;
        const int i0 = ch * 128 + ic * 32;
#pragma unroll 8
        for (int i = i0; i < i0 + 32; ++i) s += pe[i] * w1[(size_t)i * 128 + j];
        red[ic * 128 + j] = s; __syncthreads();
        if (F.tid < 128) atomicAdd((float*)(ws + (kv == 0 ? WS_CB1K : WS_CB1V)) + F.tid, (red[F.tid] + red[128 + F.tid]) + (red[256 + F.tid] + red[384 + F.tid]));
        __syncthreads();
    } else if (F.bid == 2) {
        for (int i = F.tid; i < 8 * 128; i += NTHREADS) { const int h = i >> 7, rel = i & 127;
            int bk = rel;
            if (rel >= 16) bk = 16 + (rel >= 19) + (rel >= 21) + (rel >= 24) + (rel >= 27) + (rel >= 31) + (rel >= 35) + (rel >= 40) + (rel >= 46) + (rel >= 52) + (rel >= 59) + (rel >= 67) + (rel >= 77) + (rel >= 87) + (rel >= 99) + (rel >= 113);
            ((float*)(ws + WS_BIASL))[i] = args.in[I_RELB][bk * 8 + h]; }
        if (F.tid < 64) {
            float mq = fabsf(args.in[I_QNG][F.tid]), mk = fmaxf(fmaxf(fabsf(args.in[I_KNG][F.tid]), fabsf(args.in[I_KNG][64 + F.tid])), fabsf(args.in[I_KNG][128 + F.tid]));
            float mb = fmaxf(fmaxf(fabsf(args.in[I_RELB][F.tid]), fabsf(args.in[I_RELB][64 + F.tid])), fmaxf(fabsf(args.in[I_RELB][128 + F.tid]), fabsf(args.in[I_RELB][192 + F.tid])));
            mq = wave_max(mq); mk = wave_max(mk); mb = wave_max(mb);
            if (F.tid == 0) ((float*)(ws + WS_BIASL))[8 * 128] = 8.0f * mq * mk + mb; }
    }
    {
        LAS float* scr = (LAS float*)(F.lds + F.wave * 16384);
        constexpr int I_WINT = (NIN / 32) * (D / 64);
        constexpr int NITEMS = I_WINT + (1024 / 32) * (512 / 64) + (1024 / 32) * (1024 / 64) + (2048 / 32) * (1024 / 64) + 2 * (128 / 32) * (2048 / 64) + 2 * (64 / 32) * (128 / 64);
        for (int it = gw; it < NITEMS; it += NGW) {
            int r = it;
            if (r < I_WINT) {
                const int grp = r % (NIN / 32), kb = r / (NIN / 32);
                const int tile = grp >> 3, ct0 = (grp & 7) * 32;
                const int L0 = 64 * ((ct0 >> 5) & 3) + 32 * (ct0 >> 7);
                int src0, valid = 32;
                if (tile < 7) src0 = 256 * tile + L0; else if (tile < 15) src0 = 1816 + 256 * (tile - 7) + L0; else { src0 = 1792 + L0; valid = (L0 == 0) ? 24 : 0; }
                if (valid == 0) src0 = 0;
                p0_transpose_item(args.in[I_WIN], IN_COLS, src0, valid, D, (bf16*)(ws + WS_WIN_T), 32 * grp, 64 * kb, scr, F.lane);
                continue; }
            r -= I_WINT;
            if (p0_mat(r, args.in[I_WBA], 512, 1024, (bf16*)(ws + WS_WBA_T), scr, F.lane)) continue;
            if (p0_mat(r, args.in[I_WOUT], 1024, 1024, (bf16*)(ws + WS_WOUT_T), scr, F.lane)) continue;
            if (p0_mat(r, args.in[I_PWQ], 1024, 2048, (bf16*)(ws + WS_WQ_T), scr, F.lane)) continue;
            if (p0_mat(r, args.in[I_CW1K], 2048, 128, (bf16*)(ws + WS_CW1K_T), scr, F.lane)) continue;
            if (p0_mat(r, args.in[I_CW1V], 2048, 128, (bf16*)(ws + WS_CW1V_T), scr, F.lane)) continue;
            if (p0_mat(r, args.in[I_CW2K], 128, 64, (bf16*)(ws + WS_CW2K_T), scr, F.lane)) continue;
            p0_mat(r, args.in[I_CW2V], 128, 64, (bf16*)(ws + WS_CW2V_T), scr, F.lane);
        }
    }
    {
        const float* pw = args.in[I_POOLW]; const float* ps = args.in[I_POOLS]; const float* wbp = args.in[I_WBP];
        bf16* weff = (bf16*)(ws + WS_WEFF_T);
        LAS float* PWl = (LAS float*)(F.lds);
        LAS float* WBl = (LAS float*)(F.lds + 128 * 129 * 4);
        __syncthreads();
        for (int bb = F.bid; bb < 256; bb += F.G) {
            const int g = bb >> 6, d0 = (bb & 63) * 16;
            { f32x4 t[8];
#pragma unroll
              for (int q = 0; q < 8; ++q) t[q] = *(const GAS f32x4*)(pw + (size_t)g * 16384 + 4 * (F.tid + NTHREADS * q));
#pragma unroll
              for (int q = 0; q < 8; ++q) { const int i = 4 * (F.tid + NTHREADS * q); LAS float* d = PWl + (i >> 7) * 129 + (i & 127); d[0] = t[q].x; d[1] = t[q].y; d[2] = t[q].z; d[3] = t[q].w; }
              const int cc = F.tid >> 2, d4 = (F.tid & 3) * 4;
              const f32x4 wv = *(const GAS f32x4*)(wbp + (size_t)(g * 128 + cc) * D + d0 + d4); const float pv = ps[g * 128 + cc];
              LAS float* d = WBl + cc * 17 + d4; d[0] = wv.x * pv; d[1] = wv.y * pv; d[2] = wv.z * pv; d[3] = wv.w * pv; }
            __syncthreads();
            const int c = F.tid & 127, q = F.tid >> 7;
            float acc4[4] = {0.f, 0.f, 0.f, 0.f};
#pragma unroll 4
            for (int cc = 0; cc < 128; ++cc) { const float a = PWl[c * 129 + cc];
#pragma unroll
                for (int e = 0; e < 4; ++e) acc4[e] += a * WBl[cc * 17 + 4 * q + e]; }
#pragma unroll
            for (int e = 0; e < 4; ++e) weff[(size_t)(d0 + 4 * q + e) * POOLW + g * 128 + c] = (bf16)f2bf(acc4[e]);
            __syncthreads();
        }
    }
    cvt_f32_bf16_stream(args.in[I_PSK], (bf16*)(ws + WS_SUBK), (size_t)16 * 128 * 128 / 8, gtid, gthreads);
    cvt_rows_8bit<true>(args.in[I_PU], ws + WS_UB, (float*)(ws + WS_SCLU), gw, NGW, F.lane);
    cvt_rows_8bit<false>(args.in[I_PV], ws + WS_VB, (float*)(ws + WS_SCLV), gw, NGW, F.lane);
}

template <bool Q8> __device__ __forceinline__ void modnorm_rows(Frame& F, const float* x, const float* g, const float* ada, int shift_idx, bf16* out) {
    const int gw = F.bid * NWAVES + F.wave, NGW = F.G * NWAVES;
    for (int m = gw; m < M; m += NGW) {
        const int b = m >> 12;
        const GAS f32x4* xr = (const GAS f32x4*)(x + (size_t)m * D) + F.lane;
        const GAS f32x4* gr = (const GAS f32x4*)g + F.lane;
        const GAS f32x4* sh = (const GAS f32x4*)(ada + (size_t)b * 6 * D + shift_idx * D) + F.lane;
        const GAS f32x4* sc = (const GAS f32x4*)(ada + (size_t)b * 6 * D + (shift_idx + 1) * D) + F.lane;
        f32x4 v[4]; float s = 0.f;
#pragma unroll
        for (int j = 0; j < 4; ++j) { v[j] = xr[64 * j]; s += (v[j].x * v[j].x + v[j].y * v[j].y) + (v[j].z * v[j].z + v[j].w * v[j].w); }
        const float rstd = rsqrtf(wave_sum(s) * (1.f / D) + EPS);
        GAS v2u* o8 = (GAS v2u*)(out + (size_t)m * D) + F.lane;
        float mx = 0.f;
#pragma unroll
        for (int j = 0; j < 4; ++j) { const f32x4 gg = gr[64 * j], ss = sh[64 * j], cc = sc[64 * j];
            const f32x4 y = (v[j] * rstd) * gg * (cc + 1.0f) + ss; v[j] = y;
            mx = fmaxf(mx, fmaxf(fmaxf(fabsf(y.x), fabsf(y.y)), fmaxf(fabsf(y.z), fabsf(y.w))));
            v2u o; o.x = pk2(y.x, y.y); o.y = pk2(y.z, y.w); o8[64 * j] = o; }
        if (Q8) {
            mx = wave_max(mx);
            const float qs = mx > 0.f ? 127.0f / mx : 0.f;
            GAS unsigned* h8 = (GAS unsigned*)(F.ws + WS_H8 + (size_t)m * D) + F.lane;
#pragma unroll
            for (int j = 0; j < 4; ++j) { const int q0 = (int)rintf(v[j].x * qs), q1 = (int)rintf(v[j].y * qs), q2 = (int)rintf(v[j].z * qs), q3 = (int)rintf(v[j].w * qs);
                h8[64 * j] = ((unsigned)q0 & 0xffu) | (((unsigned)q1 & 0xffu) << 8) | (((unsigned)q2 & 0xffu) << 16) | (((unsigned)q3 & 0xffu) << 24); }
            if (F.lane == 0) ((float*)(F.ws + WS_HS))[m] = mx * (1.0f / 127.0f);
        }
    }
}

struct EpiIn {
    static constexpr bool PERM = true, AFTER_DRAIN = false;
    unsigned char* ws; const float* qg; const float* kg; const volatile LAS unsigned* rmp;
    __device__ __forceinline__ void operator()(const pg8::f32x4 (&acc)[2][2][4][2], const pg8::Unit& u, int wr, int wc, int fr, int fq) const {
        const int pn = u.pn, rmask = __builtin_amdgcn_readfirstlane((int)*rmp);
#pragma unroll
        for (int ai = 0; ai < 2; ++ai)
#pragma unroll
            for (int m = 0; m < 4; ++m) {
                const int row = (u.pm & rmask) * 256 + ai * 128 + wr * 64 + m * 16 + fr;
                float v[2][8];
#pragma unroll
                for (int bj = 0; bj < 2; ++bj)
#pragma unroll
                    for (int n = 0; n < 2; ++n)
#pragma unroll
                        for (int i = 0; i < 4; ++i) v[bj][4 * n + i] = acc[ai][bj][m][n][i];
                bf16* dst = nullptr; bool norm = false; const float* gain = nullptr; float mul = 1.f; bool sig = false;
                if (pn < 2) { dst = (bf16*)(ws + WS_ZP) + (size_t)row * 512 + 256 * pn + 64 * wc; }
                else if (pn < 4) { dst = (bf16*)(ws + WS_Q) + (size_t)row * 512 + 256 * (pn - 2) + 64 * wc; norm = true; gain = qg; mul = 0.125f * 1.4426950408889634f; }
                else if (pn < 7) { const int kind = pn - 4, isv = wc >> 1, g = wc & 1, b = row >> 12, t = row & 4095;
                    const size_t base = ((size_t)(b * 2 + g) * SEQ + t) * 64;
                    const size_t off = kind == 0 ? (isv ? WS_VCR : WS_KCR) : kind == 1 ? (isv ? WS_VS : WS_KS) : (isv ? WS_VW : WS_KW);
                    dst = (bf16*)(ws + off) + base; if (!isv && kind > 0) { norm = true; gain = kg + kind * 64; } }
                else if (pn < 15) { dst = (bf16*)(ws + WS_GM) + (size_t)row * 2048 + 256 * (pn - 7) + 64 * wc; sig = true; }
                else {
                    if (wc == 0 && fq < 3) { float* gp = (float*)(ws + WS_GATE) + (size_t)row * 24 + 8 * fq;
                        *(GAS f32x4*)gp = (f32x4){sigmoidf_(v[0][0]), sigmoidf_(v[0][1]), sigmoidf_(v[0][2]), sigmoidf_(v[0][3])};
                        *(GAS f32x4*)(gp + 4) = (f32x4){sigmoidf_(v[0][4]), sigmoidf_(v[0][5]), sigmoidf_(v[0][6]), sigmoidf_(v[0][7])}; }
                    continue; }
                if (norm) { float ss = 0.f;
#pragma unroll
                    for (int bj = 0; bj < 2; ++bj)
#pragma unroll
                        for (int e = 0; e < 8; ++e) ss += v[bj][e] * v[bj][e];
                    ss = sum_xor32(sum_xor16(ss));
                    const float rs = rsqrtf(ss * (1.f / 64.f) + EPS) * mul;
#pragma unroll
                    for (int bj = 0; bj < 2; ++bj)
#pragma unroll
                        for (int e = 0; e < 8; ++e) v[bj][e] = v[bj][e] * rs * gain[32 * bj + 8 * fq + e]; }
                if (sig) {
#pragma unroll
                    for (int bj = 0; bj < 2; ++bj)
#pragma unroll
                        for (int e = 0; e < 8; ++e) v[bj][e] = sigmoidf_(v[bj][e]); }
#pragma unroll
                for (int bj = 0; bj < 2; ++bj) { v4u o; o.x = pkh(v[bj][0], v[bj][1]); o.y = pkh(v[bj][2], v[bj][3]); o.z = pkh(v[bj][4], v[bj][5]); o.w = pkh(v[bj][6], v[bj][7]);
                    *(GAS v4u*)(dst + 32 * bj + 8 * fq) = o; }
            }
    }
};
template <bool ADD> struct EpiMix {
    static constexpr bool PERM = true, AFTER_DRAIN = false;
    bf16* MIX; const bf16* GM; int gmoff;
    __device__ __forceinline__ void operator()(const pg8::f32x4 (&acc)[2][2][4][2], const pg8::Unit& u, int wr, int wc, int fr, int fq) const {
#pragma unroll
        for (int ai = 0; ai < 2; ++ai)
#pragma unroll
            for (int m = 0; m < 4; ++m) {
                const int row = u.pm * 256 + ai * 128 + wr * 64 + m * 16 + fr;
#pragma unroll
                for (int bj = 0; bj < 2; ++bj) {
                    const int col = u.pn * 256 + bj * 128 + wc * 32 + 8 * fq;
                    const v4u gmv = *(const GAS v4u*)(GM + (size_t)row * 2048 + gmoff + col);
                    float r[8];
                    r[0] = acc[ai][bj][m][0][0] * bflo(gmv.x); r[1] = acc[ai][bj][m][0][1] * bfhi(gmv.x); r[2] = acc[ai][bj][m][0][2] * bflo(gmv.y); r[3] = acc[ai][bj][m][0][3] * bfhi(gmv.y);
                    r[4] = acc[ai][bj][m][1][0] * bflo(gmv.z); r[5] = acc[ai][bj][m][1][1] * bfhi(gmv.z); r[6] = acc[ai][bj][m][1][2] * bflo(gmv.w); r[7] = acc[ai][bj][m][1][3] * bfhi(gmv.w);
                    GAS v4u* dp = (GAS v4u*)(MIX + (size_t)row * 1024 + col);
                    if (ADD) { const v4u old = *dp; r[0] += bflo(old.x); r[1] += bfhi(old.x); r[2] += bflo(old.y); r[3] += bfhi(old.y); r[4] += bflo(old.z); r[5] += bfhi(old.z); r[6] += bflo(old.w); r[7] += bfhi(old.w); }
                    v4u o; o.x = pkh(r[0], r[1]); o.y = pkh(r[2], r[3]); o.z = pkh(r[4], r[5]); o.w = pkh(r[6], r[7]); *dp = o; }
            }
    }
};
struct EpiRes {
    static constexpr bool PERM = false, AFTER_DRAIN = false;
    const float* x; float* out; const float* ada; int gate_idx;
    __device__ __forceinline__ void operator()(const pg8::f32x4 (&acc)[2][2][4][2], const pg8::Unit& u, int wr, int wc, int fr, int fq) const {
#pragma unroll
        for (int ai = 0; ai < 2; ++ai)
#pragma unroll
            for (int m = 0; m < 4; ++m) {
                const int row = u.pm * 256 + ai * 128 + wr * 64 + m * 16 + fr, b = row >> 12;
#pragma unroll
                for (int bj = 0; bj < 2; ++bj)
#pragma unroll
                    for (int n = 0; n < 2; ++n) {
                        const int col = u.pn * 256 + bj * 128 + wc * 32 + 16 * n + 4 * fq;
                        const f32x4 gt = *(const GAS f32x4*)(ada + (size_t)b * 6 * D + gate_idx * D + col);
                        const f32x4 xv = *(const GAS f32x4*)(x + (size_t)row * D + col);
                        *(GAS f32x4*)(out + (size_t)row * D + col) = xv + gt * acc[ai][bj][m][n]; }
            }
    }
};

template <int W> __device__ __forceinline__ void pool_item(const bf16* zp, bf16* pl, int row, int col) {
    const int t = row & 4095;
    float s[8], self[8];
#pragma unroll
    for (int e = 0; e < 8; ++e) { s[e] = 0.f; self[e] = 0.f; }
    v4u z[W];
#pragma unroll
    for (int j = 0; j < W; ++j) z[j] = (j <= t) ? *(const GAS v4u*)(zp + (size_t)(row - j) * 512 + col) : (v4u){0u, 0u, 0u, 0u};
#pragma unroll
    for (int j = 0; j < W; ++j) { const float f[8] = {bflo(z[j].x), bfhi(z[j].x), bflo(z[j].y), bfhi(z[j].y), bflo(z[j].z), bfhi(z[j].z), bflo(z[j].w), bfhi(z[j].w)};
#pragma unroll
        for (int e = 0; e < 8; ++e) { s[e] += f[e]; if (j == 0) self[e] = f[e]; } }
    const float inv = 1.0f / (float)((t + 1 < W) ? (t + 1) : W);
    v4u o; o.x = pk2(s[0] * inv - self[0], s[1] * inv - self[1]); o.y = pk2(s[2] * inv - self[2], s[3] * inv - self[3]);
    o.z = pk2(s[4] * inv - self[4], s[5] * inv - self[5]); o.w = pk2(s[6] * inv - self[6], s[7] * inv - self[7]);
    *(GAS v4u*)(pl + (size_t)row * 512 + col) = o;
}
__device__ __forceinline__ void pool_phase(Frame& F) {
    const bf16* zp = (const bf16*)(F.ws + WS_ZP); bf16* pl = (bf16*)(F.ws + WS_PL);
    const int gw = F.bid * NWAVES + F.wave, NGW = F.G * NWAVES;
    for (int item = gw; item < 4 * (M / 4); item += NGW) {
        const int gi = item & 3, r4 = item >> 2, row = 4 * r4 + (F.lane >> 4), col = 128 * gi + 8 * (F.lane & 15);
        if (gi == 0) pool_item<2>(zp, pl, row, col); else if (gi == 1) pool_item<4>(zp, pl, row, col); else if (gi == 2) pool_item<8>(zp, pl, row, col); else pool_item<16>(zp, pl, row, col);
    }
}

typedef int v4i __attribute__((ext_vector_type(4)));
struct EpiStoreBf16 {
    static constexpr bool PERM = true, AFTER_DRAIN = false;
    bf16* O; int ldc;
    __device__ __forceinline__ void operator()(const pg8::f32x4 (&acc)[2][2][4][2], const pg8::Unit& u, int wr, int wc, int fr, int fq) const {
#pragma unroll
        for (int ai = 0; ai < 2; ++ai)
#pragma unroll
            for (int m = 0; m < 4; ++m) {
                const int row = u.pm * 256 + ai * 128 + wr * 64 + m * 16 + fr;
#pragma unroll
                for (int bj = 0; bj < 2; ++bj) {
                    const int col = u.pn * 256 + bj * 128 + wc * 32 + 8 * fq;
                    v4u o; o.x = pkh(acc[ai][bj][m][0][0], acc[ai][bj][m][0][1]); o.y = pkh(acc[ai][bj][m][0][2], acc[ai][bj][m][0][3]);
                    o.z = pkh(acc[ai][bj][m][1][0], acc[ai][bj][m][1][1]); o.w = pkh(acc[ai][bj][m][1][2], acc[ai][bj][m][1][3]);
                    *(GAS v4u*)(O + (size_t)row * ldc + col) = o; }
            }
    }
};

__device__ __forceinline__ unsigned fkey(float f) { const unsigned u = __builtin_bit_cast(unsigned, f); return (u >> 31) ? ~u : (u | 0x80000000u); }
__device__ __forceinline__ float funkey(unsigned k) { const unsigned u = (k >> 31) ? (k & 0x7fffffffu) : ~k; return __builtin_bit_cast(float, u); }
__device__ __forceinline__ unsigned umax_(unsigned a, unsigned b) { return a > b ? a : b; }
__device__ __forceinline__ unsigned umin_(unsigned a, unsigned b) { return a > b ? b : a; }
#define TOP16_INSERT(L, xin) do { unsigned _x = (xin); _Pragma("unroll") for (int _i = 0; _i < 16; ++_i) { const unsigned _h = umax_(L[_i], _x); _x = umin_(L[_i], _x); L[_i] = _h; } } while (0)
template <int MASK> __device__ __forceinline__ void top16_merge(unsigned (&L)[16]) {
    unsigned o[16];
#pragma unroll
    for (int i = 0; i < 16; ++i) o[i] = (unsigned)dppi<MASK == 1 ? DPP_XOR1 : DPP_XOR2>((int)L[i]);
#pragma unroll
    for (int i = 0; i < 16; ++i) L[i] = umax_(L[i], o[15 - i]);
#pragma unroll
    for (int d = 8; d >= 1; d >>= 1)
#pragma unroll
        for (int i = 0; i < 16; ++i) if ((i & d) == 0) { const unsigned hi = umax_(L[i], L[i + d]), lo = umin_(L[i], L[i + d]); L[i] = hi; L[i + d] = lo; }
}
#define CE_DESC(a_, b_) do { const unsigned _h = umax_(a_, b_), _l = umin_(a_, b_); a_ = _h; b_ = _l; } while (0)
template <int OFF> __device__ __forceinline__ void bitonic_sort16_desc(unsigned (&v)[32]) {
#pragma unroll
    for (int k = 2; k <= 16; k <<= 1)
#pragma unroll
        for (int j = k >> 1; j > 0; j >>= 1)
#pragma unroll
            for (int i = 0; i < 16; ++i) { const int l = i ^ j; if (l > i) { if ((i & k) == 0) CE_DESC(v[OFF + i], v[OFF + l]); else CE_DESC(v[OFF + l], v[OFF + i]); } }
}
__device__ __forceinline__ void bitonic_merge16_desc(unsigned (&L)[16]) {
#pragma unroll
    for (int d = 8; d >= 1; d >>= 1)
#pragma unroll
        for (int i = 0; i < 16; ++i) if ((i & d) == 0) CE_DESC(L[i], L[i + d]);
}
constexpr int SST = 132;
constexpr int P9_LIST_OFF = 2 * 64 * SST * 4;
__device__ __forceinline__ void peer_select_phase(Frame& F) {
    const bf16* QV = (const bf16*)(F.ws + WS_QV); const bf16* SK = (const bf16*)(F.ws + WS_SUBK);
    int* EID = (int*)(F.ws + WS_EID); float* GW = (float*)(F.ws + WS_GW);
    LAS float* S = (LAS float*)(F.lds);
    LAS unsigned* LIST = (LAS unsigned*)(F.lds + P9_LIST_OFF);
    const int lane = F.lane, w = F.wave, l15 = lane & 15, lq = lane >> 4;
    const int p = w >> 2, kb = w & 3;
    constexpr int NU = (M / 64) * PH;
    bf16x8 a[4][4], bq[2][4];
#define P9_LOAD(u_) do { const int _tt = (u_) >> 3, _h = (u_) & 7; \
        const bf16* qa = QV + (size_t)(_tt * 64 + l15) * PQW + _h * 256 + p * 128 + 8 * lq; \
        const bf16* kbp = SK + (size_t)((_h * 2 + p) * 128 + 32 * kb + l15) * 128 + 8 * lq; \
        _Pragma("unroll") for (int ks = 0; ks < 4; ++ks) { \
            _Pragma("unroll") for (int rb = 0; rb < 4; ++rb) a[rb][ks] = *(const GAS bf16x8*)(qa + (size_t)(16 * rb) * PQW + 32 * ks); \
            _Pragma("unroll") for (int cb = 0; cb < 2; ++cb) bq[cb][ks] = *(const GAS bf16x8*)(kbp + (size_t)(16 * cb) * 128 + 32 * ks); } } while (0)
    if (F.bid < NU) P9_LOAD(F.bid);
    for (int u = F.bid; u < NU; u += F.G) {
        const int tt = u >> 3, h = u & 7, tok0 = tt * 64;
        {
            pg8::f32x4 acc[4][2];
#pragma unroll
            for (int rb = 0; rb < 4; ++rb)
#pragma unroll
                for (int cb = 0; cb < 2; ++cb) acc[rb][cb] = (pg8::f32x4){0.f, 0.f, 0.f, 0.f};
#pragma unroll
            for (int ks = 0; ks < 4; ++ks)
#pragma unroll
                for (int rb = 0; rb < 4; ++rb)
#pragma unroll
                    for (int cb = 0; cb < 2; ++cb) acc[rb][cb] = __builtin_amdgcn_mfma_f32_16x16x32_bf16(a[rb][ks], bq[cb][ks], acc[rb][cb], 0, 0, 0);
#pragma unroll
            for (int rb = 0; rb < 4; ++rb)
#pragma unroll
                for (int cb = 0; cb < 2; ++cb)
#pragma unroll
                    for (int r = 0; r < 4; ++r) S[(p * 64 + 16 * rb + 4 * lq + r) * SST + 32 * kb + 16 * cb + l15] = acc[rb][cb][r];
        }
        __syncthreads();
        if (u + F.G < NU) P9_LOAD(u + F.G);
        {
            const int row = F.tid >> 2, sub = F.tid & 3;
            const LAS float* sr = S + row * SST + sub;
            unsigned kv[32];
#pragma unroll
            for (int i = 0; i < 32; ++i) kv[i] = (fkey(sr[4 * i]) & ~127u) | (unsigned)(4 * i + sub);
            bitonic_sort16_desc<0>(kv); bitonic_sort16_desc<16>(kv);
            unsigned L[16];
#pragma unroll
            for (int i = 0; i < 16; ++i) L[i] = umax_(kv[i], kv[31 - i]);
            bitonic_merge16_desc(L);
            top16_merge<1>(L); top16_merge<2>(L);
            if (sub == 0) {
#pragma unroll
                for (int i = 0; i < 4; ++i) *(LAS v4u*)(LIST + row * 16 + 4 * i) = (v4u){L[4 * i], L[4 * i + 1], L[4 * i + 2], L[4 * i + 3]}; }
        }
        __syncthreads();
        if (F.tid < 256) {
            const int tok = F.tid >> 2, sub = F.tid & 3;
            float va[16], vb[16];
#pragma unroll
            for (int i = 0; i < 4; ++i) { const v4u x = *(const LAS v4u*)(LIST + tok * 16 + 4 * i), y = *(const LAS v4u*)(LIST + (64 + tok) * 16 + 4 * i);
                va[4 * i] = funkey(x.x & ~127u); va[4 * i + 1] = funkey(x.y & ~127u); va[4 * i + 2] = funkey(x.z & ~127u); va[4 * i + 3] = funkey(x.w & ~127u);
                vb[4 * i] = funkey(y.x & ~127u); vb[4 * i + 1] = funkey(y.y & ~127u); vb[4 * i + 2] = funkey(y.z & ~127u); vb[4 * i + 3] = funkey(y.w & ~127u); }
            unsigned cand[32];
#pragma unroll
            for (int i = 0; i < 32; ++i) cand[i] = 0u;
            {
                constexpr int NC = 50;
                constexpr unsigned char CI[52] = {0,0,0,0,0,0,0,0,0,0,0,0,0,0,0,0, 1,1,1,1,1,1,1,1, 2,2,2,2,2, 3,3,3,3, 4,4,4, 5,5, 6,6, 7,7, 8,9,10,11,12,13,14,15, 0,0};
                constexpr unsigned char CJ[52] = {0,1,2,3,4,5,6,7,8,9,10,11,12,13,14,15, 0,1,2,3,4,5,6,7, 0,1,2,3,4, 0,1,2,3, 0,1,2, 0,1, 0,1, 0,1, 0,0,0,0,0,0,0,0, 0,0};
#pragma unroll
                for (int g4 = 0; g4 < 13; ++g4) {
                    float sa = 0.f, sb = 0.f; unsigned id = 0u; bool ok = false;
#pragma unroll
                    for (int q = 0; q < 4; ++q) { const int n = 4 * g4 + q; if (n < NC) { const bool me = (sub == q); sa = me ? va[CI[n]] : sa; sb = me ? vb[CJ[n]] : sb; id = me ? (unsigned)(CI[n] * 16 + CJ[n]) : id; ok = ok || me; } }
                    cand[g4] = ok ? ((fkey(sa + sb) & ~255u) | id) : 0u;
                }
            }
            bitonic_sort16_desc<0>(cand);
            unsigned L[16];
#pragma unroll
            for (int i = 0; i < 16; ++i) L[i] = cand[i];
            top16_merge<1>(L); top16_merge<2>(L);
            const float mx = funkey(L[0] & ~255u);
            float e[16], sum = 0.f;
#pragma unroll
            for (int k = 0; k < 16; ++k) { e[k] = __expf(funkey(L[k] & ~255u) - mx); sum += e[k]; }
            const float inv = 1.0f / sum;
            const size_t ob = (size_t)(tok0 + tok) * 128;
#pragma unroll
            for (int k4 = 0; k4 < 4; ++k4) if (sub == k4) {
#pragma unroll
                for (int q = 0; q < 4; ++q) { const unsigned cid = L[4 * k4 + q] & 255u;
                    const unsigned ia = LIST[tok * 16 + (cid >> 4)] & 127u, ib = LIST[(64 + tok) * 16 + (cid & 15u)] & 127u;
                    const int slot = h * 16 + 4 * k4 + q;
                    EID[ob + slot] = (int)(ia * 128u + ib); GW[ob + slot] = e[4 * k4 + q] * inv; }
            }
        }
        __syncthreads();
    }
#undef P9_LOAD
}

__device__ __forceinline__ void unpack8(const v4u w, float (&f)[8]) { f[0] = bflo(w.x); f[1] = bfhi(w.x); f[2] = bflo(w.y); f[3] = bfhi(w.y); f[4] = bflo(w.z); f[5] = bfhi(w.z); f[6] = bflo(w.w); f[7] = bfhi(w.w); }
typedef float f32x2 __attribute__((ext_vector_type(2)));
__device__ __forceinline__ void unpack16_fp8(const v4u w, float (&f)[16]) {
    const unsigned ww[4] = {w.x, w.y, w.z, w.w};
#pragma unroll
    for (int d = 0; d < 4; ++d) { const f32x2 a = __builtin_amdgcn_cvt_pk_f32_fp8((int)ww[d], false), b = __builtin_amdgcn_cvt_pk_f32_fp8((int)ww[d], true);
        f[4 * d] = a.x; f[4 * d + 1] = a.y; f[4 * d + 2] = b.x; f[4 * d + 3] = b.y; }
}
template <int PV_> __device__ __forceinline__ void peer_dot_phase(Frame& F) {
    const unsigned char* H8 = F.ws + WS_H8; const int* EID = (const int*)(F.ws + WS_EID); float* PART = (float*)(F.ws + WS_PART);
    const int lane = F.lane, g = lane >> 3, j = lane & 7, x = F.bid & 7;
    const int nbx = (F.G - x + 7) >> 3, NW = nbx * NWAVES, gwv = (F.bid >> 3) * NWAVES + F.wave;
    const unsigned char* US = F.ws + WS_UB + (size_t)x * NEXP * 128; const unsigned j16 = 16u * (unsigned)j;
    int token = gwv;
    if (token >= M) return;
    v4i e4[4]; v4i hb;
#define PD_LOAD_E(tok_) do { _Pragma("unroll") for (int q = 0; q < 4; ++q) e4[q] = *(const GAS v4i*)(EID + (size_t)(tok_) * 128 + 16 * g + 4 * q); } while (0)
#define PD_ISSUE4(buf_, e_, b0_) do { buf_[b0_] = *(const GAS v4i*)(US + ((unsigned)e_.x * 128u + j16)); buf_[b0_ + 1] = *(const GAS v4i*)(US + ((unsigned)e_.y * 128u + j16)); \
        buf_[b0_ + 2] = *(const GAS v4i*)(US + ((unsigned)e_.z * 128u + j16)); buf_[b0_ + 3] = *(const GAS v4i*)(US + ((unsigned)e_.w * 128u + j16)); } while (0)
#define PD_DOT1(w_, dst_) do { int t = __builtin_amdgcn_sdot4(w_.x, hc.x, 0, false); t = __builtin_amdgcn_sdot4(w_.y, hc.y, t, false); t = __builtin_amdgcn_sdot4(w_.z, hc.z, t, false); t = __builtin_amdgcn_sdot4(w_.w, hc.w, t, false); \
        t += dppi<DPP_XOR1>(t); t += dppi<DPP_XOR2>(t); t += dppi<DPP_HMIR>(t); dst_ = (float)t; } while (0)
    PD_LOAD_E(token); hb = *(const GAS v4i*)(H8 + (size_t)token * D + 128 * x + j16);
    v4i bA[8], bB[8];
    PD_ISSUE4(bA, e4[0], 0); PD_ISSUE4(bA, e4[1], 4);
    for (; token < M; token += NW) {
        const bool more = token + NW < M;
        PD_ISSUE4(bB, e4[2], 0); PD_ISSUE4(bB, e4[3], 4);
        const v4i hc = hb;
        if (more) { PD_LOAD_E(token + NW); hb = *(const GAS v4i*)(H8 + (size_t)(token + NW) * D + 128 * x + j16); }
        float s[16];
#pragma unroll
        for (int i = 0; i < 8; ++i) PD_DOT1(bA[i], s[i]);
        if (more) { PD_ISSUE4(bA, e4[0], 0); PD_ISSUE4(bA, e4[1], 4); }
#pragma unroll
        for (int i = 0; i < 8; ++i) PD_DOT1(bB[i], s[8 + i]);
        if (j == 0) { float* pp = PART + ((size_t)x * M + token) * 128 + g * 16;
#pragma unroll
            for (int i4 = 0; i4 < 4; ++i4) *(GAS f32x4*)(pp + 4 * i4) = (f32x4){s[4 * i4], s[4 * i4 + 1], s[4 * i4 + 2], s[4 * i4 + 3]}; }
    }
#undef PD_LOAD_E
#undef PD_ISSUE4
#undef PD_DOT1
}
template <int NTOK> __device__ __forceinline__ void peer_loadrate_probe(Frame& F) {
    const int* EID = (const int*)(F.ws + WS_EID);
    const int lane = F.lane, g = lane >> 3, j = lane & 7, x = F.bid & 7;
    const int nbx = (F.G - x + 7) >> 3, NW = nbx * NWAVES, gwv = (F.bid >> 3) * NWAVES + F.wave;
    const unsigned char* US = F.ws + WS_UB + (size_t)x * NEXP * 128; const unsigned j16 = 16u * (unsigned)j;
    unsigned acc = 0u;
    for (int token = gwv; token + (NTOK - 1) * NW < M; token += NTOK * NW) {
        v4i e4[NTOK][4];
#pragma unroll
        for (int t = 0; t < NTOK; ++t)
#pragma unroll
            for (int q = 0; q < 4; ++q) e4[t][q] = *(const GAS v4i*)(EID + (size_t)(token + t * NW) * 128 + 16 * g + 4 * q);
        v4i b[NTOK][16];
#pragma unroll
        for (int t = 0; t < NTOK; ++t)
#pragma unroll
            for (int q = 0; q < 4; ++q) { b[t][4 * q] = *(const GAS v4i*)(US + ((unsigned)e4[t][q].x * 128u + j16)); b[t][4 * q + 1] = *(const GAS v4i*)(US + ((unsigned)e4[t][q].y * 128u + j16));
                b[t][4 * q + 2] = *(const GAS v4i*)(US + ((unsigned)e4[t][q].z * 128u + j16)); b[t][4 * q + 3] = *(const GAS v4i*)(US + ((unsigned)e4[t][q].w * 128u + j16)); }
#pragma unroll
        for (int t = 0; t < NTOK; ++t)
#pragma unroll
            for (int i = 0; i < 16; ++i) acc ^= (unsigned)(b[t][i].x ^ b[t][i].y ^ b[t][i].z ^ b[t][i].w);
    }
    asm volatile("" :: "v"(acc));
}
__device__ __forceinline__ void peer_coef_phase(Frame& F) {
    const float* PART = (const float*)(F.ws + WS_PART); const int* EID = (const int*)(F.ws + WS_EID); const float* GW = (const float*)(F.ws + WS_GW);
    const float* SCU = (const float*)(F.ws + WS_SCLU); const float* SCV = (const float*)(F.ws + WS_SCLV); const float* HS = (const float*)(F.ws + WS_HS);
    unsigned* CF8 = (unsigned*)(F.ws + WS_CF); float* CFS = (float*)(F.ws + WS_CFS);
    const size_t gtid = (size_t)F.bid * NTHREADS + F.tid, gthreads = (size_t)F.G * NTHREADS, n4 = (size_t)M * 128 / 4;
    for (size_t i4 = gtid; i4 < n4; i4 += gthreads) {
        f32x4 d = *(const GAS f32x4*)(PART + 4 * i4);
#pragma unroll
        for (int xx = 1; xx < 8; ++xx) d = d + *(const GAS f32x4*)(PART + (size_t)xx * M * 128 + 4 * i4);
        const v4i e = *(const GAS v4i*)(EID + 4 * i4); const f32x4 gw = *(const GAS f32x4*)(GW + 4 * i4);
        const float hs = HS[i4 >> 5];
        f32x4 r; r.x = gw.x * SCV[e.x] * gelu_tanh_safe(d.x * (SCU[e.x] * hs)); r.y = gw.y * SCV[e.y] * gelu_tanh_safe(d.y * (SCU[e.y] * hs));
        r.z = gw.z * SCV[e.z] * gelu_tanh_safe(d.z * (SCU[e.z] * hs)); r.w = gw.w * SCV[e.w] * gelu_tanh_safe(d.w * (SCU[e.w] * hs));
        float m = fmaxf(fmaxf(fabsf(r.x), fabsf(r.y)), fmaxf(fabsf(r.z), fabsf(r.w)));
        m = fmaxf(m, dppf<DPP_XOR1>(m)); m = fmaxf(m, dppf<DPP_XOR2>(m)); m = fmaxf(m, dppf<DPP_HMIR>(m)); m = fmaxf(m, dppf<DPP_ROR8>(m)); m = max_xor16(m);
        const unsigned E = (__builtin_bit_cast(unsigned, m) >> 23) & 0xffu; float sc = 1.f, isc = 1.f;
        if (E >= 8u && E <= 250u) { sc = __builtin_bit_cast(float, (261u - E) << 23); isc = __builtin_bit_cast(float, (E - 7u) << 23); }
        int t = __builtin_amdgcn_cvt_pk_fp8_f32(r.x * sc, r.y * sc, 0, false); t = __builtin_amdgcn_cvt_pk_fp8_f32(r.z * sc, r.w * sc, t, true);
        CF8[i4] = (unsigned)t;
        if ((F.lane & 31) == 0) CFS[i4 >> 5] = isc; }
}
template <bool DRY, bool CHECK = false> __device__ __forceinline__ void peer_out_phase(Frame& F, const float* ada, float* out) {
    const int* EID = (const int*)(F.ws + WS_EID); const unsigned char* CF8 = (const unsigned char*)(F.ws + WS_CF); const float* CFS = (const float*)(F.ws + WS_CFS);
    const int lane = F.lane, g = lane >> 3, j = lane & 7, x = F.bid & 7;
    const int nbx = (F.G - x + 7) >> 3, NW = nbx * NWAVES, gwv = (F.bid >> 3) * NWAVES + F.wave;
    const unsigned char* VS = F.ws + WS_VB + (size_t)x * NEXP * 128; const unsigned j16 = 16u * (unsigned)j;
    if (gwv >= M) return;
    const int ntok = (M - 1 - gwv) / NW + 1;
#define PO_ISSUE4(buf_, e_, b0_) do { buf_[b0_] = *(const GAS v4u*)(VS + ((unsigned)e_.x * 128u + j16)); buf_[b0_ + 1] = *(const GAS v4u*)(VS + ((unsigned)e_.y * 128u + j16)); \
        buf_[b0_ + 2] = *(const GAS v4u*)(VS + ((unsigned)e_.z * 128u + j16)); buf_[b0_ + 3] = *(const GAS v4u*)(VS + ((unsigned)e_.w * 128u + j16)); } while (0)
#define PO_ROW(w_, c_) do { float f[16]; unpack16_fp8(w_, f); _Pragma("unroll") for (int k = 0; k < 16; ++k) o[k] += (c_) * f[k]; } while (0)
#define PO_ACC4(buf_, c4_, b0_) do { PO_ROW(buf_[b0_], c4_.x); PO_ROW(buf_[b0_ + 1], c4_.y); PO_ROW(buf_[b0_ + 2], c4_.z); PO_ROW(buf_[b0_ + 3], c4_.w); } while (0)
    v4i e4[4]; f32x4 c4[4]; v4u bA[8], bB[8];
#define PO_LOADC(tok_) do { const float cs_ = CFS[tok_]; _Pragma("unroll") for (int q = 0; q < 4; ++q) { const unsigned w_ = *(const GAS unsigned*)(CF8 + (size_t)(tok_) * 128 + g * 16 + 4 * q); \
        const f32x2 lo_ = __builtin_amdgcn_cvt_pk_f32_fp8((int)w_, false), hi_ = __builtin_amdgcn_cvt_pk_f32_fp8((int)w_, true); c4[q] = (f32x4){lo_.x * cs_, lo_.y * cs_, hi_.x * cs_, hi_.y * cs_}; } } while (0)
#pragma unroll
    for (int q = 0; q < 4; ++q) e4[q] = *(const GAS v4i*)(EID + (size_t)gwv * 128 + g * 16 + 4 * q);
    PO_LOADC(gwv);
    PO_ISSUE4(bA, e4[0], 0); PO_ISSUE4(bA, e4[1], 4);
    for (int it = 0; it < ntok; ++it) {
        const int token = gwv + it * NW, tn = gwv + (it + 1 < ntok ? it + 1 : it) * NW;
        PO_ISSUE4(bB, e4[2], 0); PO_ISSUE4(bB, e4[3], 4);
#pragma unroll
        for (int q = 0; q < 4; ++q) e4[q] = *(const GAS v4i*)(EID + (size_t)tn * 128 + g * 16 + 4 * q);
        float o[16];
#pragma unroll
        for (int k = 0; k < 16; ++k) o[k] = 0.f;
        PO_ACC4(bA, c4[0], 0); PO_ACC4(bA, c4[1], 4);
        PO_ISSUE4(bA, e4[0], 0); PO_ISSUE4(bA, e4[1], 4);
        PO_ACC4(bB, c4[2], 0); PO_ACC4(bB, c4[3], 4);
        PO_LOADC(tn);
#pragma unroll
        for (int k = 0; k < 16; ++k) { float t = o[k]; t += dppf<DPP_ROR8>(t); o[k] = sum_xor32(sum_xor16(t)); }
        if (g == 0) { const int b = token >> 12;
            const float* gt = ada + (size_t)b * 6 * D + 5 * D + 128 * x + 16 * j;
            float* xo = out + (size_t)token * D + 128 * x + 16 * j;
#pragma unroll
            for (int q = 0; q < 4; ++q) { const f32x4 xv = *(const GAS f32x4*)(xo + 4 * q), gv = *(const GAS f32x4*)(gt + 4 * q);
                f32x4 res = xv + gv * (f32x4){o[4 * q], o[4 * q + 1], o[4 * q + 2], o[4 * q + 3]};
                if (CHECK) { const f32x4 mf = *(const GAS f32x4*)((const float*)(F.ws + WS_PART) + (size_t)token * D + 128 * x + 16 * j + 4 * q);
                    const float rr[4] = {o[4 * q], o[4 * q + 1], o[4 * q + 2], o[4 * q + 3]}, mm[4] = {mf.x, mf.y, mf.z, mf.w}; bool bad = false;
#pragma unroll
                    for (int z = 0; z < 4; ++z) bad = bad || !(fabsf(rr[z] - mm[z]) <= 0.01f * fabsf(rr[z]) + 1.0e-3f);
                    if (bad) res.x = 1.0e9f; }
                if (DRY) { asm volatile("" :: "v"(res.x), "v"(res.y), "v"(res.z), "v"(res.w)); } else *(GAS f32x4*)(xo + 4 * q) = res; } }
    }
#undef PO_LOADC
#undef PO_ISSUE4
#undef PO_ROW
#undef PO_ACC4
}

constexpr int PO_TILE = 64 * 144;
template <int MODE> __device__ __forceinline__ void peer_out_mfma_phase(Frame& F, const float* ada, float* out) {
    const int* EID = (const int*)(F.ws + WS_EID); const unsigned char* CF8 = (const unsigned char*)(F.ws + WS_CF); const float* CFS = (const float*)(F.ws + WS_CFS);
    const int lane = F.lane, g = lane >> 3, j = lane & 7, l15 = lane & 15, lq = lane >> 4, x = F.bid & 7;
    const int nbx = (F.G - x + 7) >> 3, NW = nbx * NWAVES, gwv = (F.bid >> 3) * NWAVES + F.wave;
    const unsigned char* VS = F.ws + WS_VB + (size_t)x * NEXP * 128; const unsigned j16 = 16u * (unsigned)j;
    LAS unsigned char* TL = F.lds + F.wave * PO_TILE;
    if (gwv >= M) return;
    const int nst = 2 * ((M - 1 - gwv) / NW + 1);
    const int trow = l15 >> 1, tcol = 8 * (l15 & 1);
#define PM_IDS(e_, a_, tok_) do { const size_t base = (size_t)(tok_) * 128; \
        _Pragma("unroll") for (int m = 0; m < 16; ++m) e_[m] = EID[base + 8 * m + g]; \
        _Pragma("unroll") for (int q = 0; q < 4; ++q) a_[q] = *(const GAS long*)(CF8 + base + 32 * q + 8 * lq); } while (0)
#define PM_GATHER(vv_, e_, h_) do { _Pragma("unroll") for (int m = 0; m < 8; ++m) vv_[m] = *(const GAS v4u*)(VS + ((unsigned)e_[8 * (h_) + m] * 128u + j16)); } while (0)
#define PM_HALF(vv_, aq0_, aq1_) do { _Pragma("unroll") for (int m = 0; m < 8; ++m) *(LAS v4u*)(TL + (8 * m + g) * 144 + 16 * j) = vv_[m]; } while (0)
#define PM_MMA(aq0_, aq1_) do { LDS_WAIT(); asm volatile("" ::: "memory"); \
        _Pragma("unroll") for (int ks = 0; ks < 2; ++ks) _Pragma("unroll") for (int cb = 0; cb < 8; ++cb) { \
            const v2i bb = __builtin_amdgcn_ds_read_tr8_b64_v2i32((LAS v2i*)(TL + (32 * ks + 8 * lq + trow) * 144 + 16 * cb + tcol)); \
            acc[cb] = __builtin_amdgcn_mfma_f32_16x16x32_fp8_fp8(ks ? (aq1_) : (aq0_), __builtin_bit_cast(long, bb), acc[cb], 0, 0, 0); } \
        LDS_WAIT(); asm volatile("" ::: "memory"); } while (0)
    const int ntok = nst >> 1;
    int e1[16], e2[16]; long a0[4], a1[4], a2[4]; v4u vvA[8], vvB[8];
    PM_IDS(e1, a0, gwv);
    PM_GATHER(vvA, e1, 0); PM_GATHER(vvB, e1, 1);
    { const int t1 = ntok > 1 ? 1 : 0; PM_IDS(e1, a1, gwv + t1 * NW); }
    f32x4 acc[8];
    for (int it = 0; it < ntok; ++it) {
        const int token = gwv + it * NW;
        { const int t2 = it + 2 < ntok ? it + 2 : ntok - 1; PM_IDS(e2, a2, gwv + t2 * NW); }
#pragma unroll
        for (int cb = 0; cb < 8; ++cb) acc[cb] = (f32x4){0.f, 0.f, 0.f, 0.f};
        float xv[8], gv[8]; float cs;
        { const int b = token >> 12; const float* gt = ada + (size_t)b * 6 * D + 5 * D + 128 * x + l15; const float* xi = out + (size_t)token * D + 128 * x + l15;
          cs = CFS[token];
#pragma unroll
          for (int cb = 0; cb < 8; ++cb) { xv[cb] = xi[16 * cb]; gv[cb] = gt[16 * cb]; } }
        PM_HALF(vvA, 0, 0); PM_GATHER(vvA, e1, 0); PM_MMA(a0[0], a0[1]);
        PM_HALF(vvB, 0, 0); PM_GATHER(vvB, e1, 1); PM_MMA(a0[2], a0[3]);
        if (lq == 0) {
            if (MODE == 1) { float* oc = (float*)(F.ws + WS_PART) + (size_t)token * D + 128 * x + l15;
#pragma unroll
                for (int cb = 0; cb < 8; ++cb) oc[16 * cb] = acc[cb][0] * cs; }
            else { float* xo = out + (size_t)token * D + 128 * x + l15;
#pragma unroll
                for (int cb = 0; cb < 8; ++cb) xo[16 * cb] = xv[cb] + gv[cb] * (acc[cb][0] * cs); }
        }
#pragma unroll
        for (int m = 0; m < 16; ++m) e1[m] = e2[m];
#pragma unroll
        for (int q = 0; q < 4; ++q) { a0[q] = a1[q]; a1[q] = a2[q]; }
    }
#undef PM_HALF
#undef PM_MMA
#undef PM_IDS
#undef PM_GATHER
}

__device__ __forceinline__ void compress_phase(Frame& F, const float* kng) {
    LAS bf16* H2 = (LAS bf16*)(F.lds);
    LAS float* OUTS = (LAS float*)(F.lds + 16384);
    const int lane = F.lane, w = F.wave, l15 = lane & 15, lq = lane >> 4;
    for (int u = F.bid; u < NBG * 2 * 8; u += F.G) {
        const int ns = u & 7, kv = (u >> 3) & 1, bg = u >> 4, n0 = ns * 32;
        const bf16* A = (const bf16*)(F.ws + (kv ? WS_VCR : WS_KCR)) + (size_t)bg * SEQ * 64;
        const bf16* W1T = (const bf16*)(F.ws + (kv ? WS_CW1V_T : WS_CW1K_T));
        const bf16* W2T = (const bf16*)(F.ws + (kv ? WS_CW2V_T : WS_CW2K_T));
        const float* b1 = (const float*)(F.ws + (kv ? WS_CB1V : WS_CB1K));
        pg8::f32x4 acc[2];
        acc[0] = (pg8::f32x4){0.f, 0.f, 0.f, 0.f}; acc[1] = acc[0];
        const bf16* ap = A + (size_t)(n0 + l15) * 1024 + 8 * lq;
        const bf16* bp = W1T + (size_t)(16 * w + l15) * 2048 + 8 * lq;
#pragma unroll 8
        for (int ks = 0; ks < 64; ++ks) {
            const bf16x8 a0 = *(const GAS bf16x8*)(ap + 32 * ks), a1 = *(const GAS bf16x8*)(ap + 16 * 1024 + 32 * ks), b = *(const GAS bf16x8*)(bp + 32 * ks);
            acc[0] = __builtin_amdgcn_mfma_f32_16x16x32_bf16(a0, b, acc[0], 0, 0, 0);
            acc[1] = __builtin_amdgcn_mfma_f32_16x16x32_bf16(a1, b, acc[1], 0, 0, 0);
        }
        { const float bb = b1[16 * w + l15];
#pragma unroll
          for (int rb = 0; rb < 2; ++rb)
#pragma unroll
            for (int r = 0; r < 4; ++r) H2[(16 * rb + 4 * lq + r) * 136 + 16 * w + l15] = (bf16)f2bf(gelu_tanh_safe(acc[rb][r] + bb)); }
        __syncthreads();
        { const int rb = w >> 2, db = w & 3;
          pg8::f32x4 o = (pg8::f32x4){0.f, 0.f, 0.f, 0.f};
#pragma unroll
          for (int ks = 0; ks < 4; ++ks) {
              const bf16x8 a = *(const LAS bf16x8*)(H2 + (16 * rb + l15) * 136 + 32 * ks + 8 * lq);
              const bf16x8 b = *(const GAS bf16x8*)(W2T + (size_t)(16 * db + l15) * 128 + 32 * ks + 8 * lq);
              o = __builtin_amdgcn_mfma_f32_16x16x32_bf16(a, b, o, 0, 0, 0); }
#pragma unroll
          for (int r = 0; r < 4; ++r) OUTS[(16 * rb + 4 * lq + r) * 65 + 16 * db + l15] = o[r]; }
        __syncthreads();
        { const int n = F.tid >> 4, d4 = (F.tid & 15) * 4, ng = n0 + n;
          float v[4]; float ss = 0.f;
#pragma unroll
          for (int i = 0; i < 4; ++i) { v[i] = OUTS[n * 65 + d4 + i]; ss += v[i] * v[i]; }
          ss += dppf<DPP_XOR1>(ss); ss += dppf<DPP_XOR2>(ss); ss += dppf<DPP_HMIR>(ss); ss += dppf<DPP_ROR8>(ss);
          const bool pad = (ng >= NCMP);
          if (kv == 0) { const float rs = rsqrtf(ss * (1.f / 64.f) + EPS);
              v2u o; o.x = pad ? 0u : pk2(v[0] * rs * kng[d4], v[1] * rs * kng[d4 + 1]); o.y = pad ? 0u : pk2(v[2] * rs * kng[d4 + 2], v[3] * rs * kng[d4 + 3]);
              *(GAS v2u*)((bf16*)(F.ws + WS_KC) + ((size_t)bg * 256 + ng) * 64 + d4) = o; }
          else { bf16* vt = (bf16*)(F.ws + WS_VCT) + (size_t)bg * 64 * 256 + ng;
#pragma unroll
              for (int i = 0; i < 4; ++i) vt[(size_t)(d4 + i) * 256] = pad ? (bf16)0 : (bf16)f2bf(v[i]); } }
        __syncthreads();
    }
}
__device__ __forceinline__ void vtranspose_phase(Frame& F) {
    LAS bf16* T = (LAS bf16*)(F.lds + F.wave * 9216);
    const int gw = F.bid * NWAVES + F.wave, NGW = F.G * NWAVES, lane = F.lane;
    for (int job = gw; job < 2 * NBG * 64; job += NGW) {
        const int s = job & 63, bg = (job >> 6) & 15, which = job >> 10;
        const bf16* X = (const bf16*)(F.ws + (which ? WS_VW : WS_VS)) + ((size_t)bg * SEQ + 64 * s) * 64;
        bf16* XT = (bf16*)(F.ws + (which ? WS_VWT : WS_VST)) + (size_t)bg * 64 * SEQ + 64 * s;
#pragma unroll
        for (int i = 0; i < 8; ++i) { const int tok = (lane >> 3) + 8 * i, ch = lane & 7;
            const v4u x = *(const GAS v4u*)(X + (size_t)tok * 64 + 8 * ch);
            const unsigned ww[4] = {x.x, x.y, x.z, x.w};
#pragma unroll
            for (int e = 0; e < 4; ++e) { T[(8 * ch + 2 * e) * 72 + tok] = (bf16)(ww[e] & 0xffffu); T[(8 * ch + 2 * e + 1) * 72 + tok] = (bf16)(ww[e] >> 16); } }
        LDS_WAIT(); asm volatile("" ::: "memory");
#pragma unroll
        for (int i = 0; i < 8; ++i) { const int dim = (lane >> 3) + 8 * i, ch = lane & 7;
            const v4u y = *(const LAS v4u*)(T + dim * 72 + 8 * ch);
            *(GAS v4u*)(XT + (size_t)dim * SEQ + 8 * ch) = y; }
        LDS_WAIT(); asm volatile("" ::: "memory");
    }
}

constexpr int AT_KBUF = 64 * 128;
constexpr int AT_NBUF = 2;
constexpr int AT_OFF_K = 0, AT_OFF_V = AT_NBUF * AT_KBUF;
constexpr int AT_OFF_IMP1 = 2 * AT_NBUF * AT_KBUF, AT_OFF_IMP2 = AT_OFF_IMP1 + 64 * 65 * 4, AT_OFF_SEL = AT_OFF_IMP2 + 64 * 65 * 4;
constexpr int AT_OFF_LUT = AT_OFF_SEL + 512, AT_OFF_LROW = AT_OFF_LUT + 4 * 128 * 4;
constexpr int AT_OFF_TD = AT_OFF_LROW + 8 * 32 * 4;
constexpr int AT_OFF_OUT = AT_OFF_TD + 96 * 32;
constexpr int AT_OFF_GATL = AT_OFF_OUT + 256 * 144;
constexpr int AT_OFF_TS = AT_OFF_GATL + 64 * 12 * 4;
constexpr int AT_TS_ROW = 65 * 16;
constexpr int AT_LDS_END = AT_OFF_TS + 16 * AT_TS_ROW;
static_assert(AT_LDS_END <= RING_BYTES, "attention LDS");

struct AtTile { const bf16* k; const bf16* vt; int vstride; };
enum { TM_CMP1 = 0, TM_CMP2, TM_SELN, TM_SELF, TM_WINN, TM_WINF, TM_WINE, TM_CMP1F, TM_CMP2F };
__device__ __forceinline__ float fexp2(float x) { return __builtin_amdgcn_exp2f(x); }
template <int TM, int VAR, int RB = 3>
__device__ __forceinline__ void at_tile(const LAS unsigned char* kb_, const LAS unsigned char* vb_, const LAS float* LUTJ, LAS float* IMP1, LAS float* IMP2,
                                        const bf16x8 (&qf)[2][2], pg8::f32x4 (&oacc)[2][4], pg8::f32x4 (&lacc)[2], const LAS float* LINV,
                                        const int (&tok_r_in)[2], const unsigned (&selb)[2], float cfar, int relbase, int idx, int l15_in, int lq_in, const LAS unsigned char* tsw, const LAS unsigned char* tsn) {
    constexpr bool FAR = (TM == TM_SELF || TM == TM_WINF || TM == TM_WINE || TM == TM_CMP1F || TM == TM_CMP2F);
    constexpr bool C1 = (TM == TM_CMP1 || TM == TM_CMP1F), C2 = (TM == TM_CMP2 || TM == TM_CMP2F);
    int l15 = l15_in, lq = lq_in; asm volatile("" : "+v"(l15), "+v"(lq));
    int tok_r[2] = {tok_r_in[0], tok_r_in[1]}; asm volatile("" : "+v"(tok_r[0]), "+v"(tok_r[1]));
    v4u pfr[2][2];
    const LAS unsigned char* tsp[2] = {tsw, tsw};
    if (TM == TM_SELN || TM == TM_WINN) {
#pragma unroll
        for (int rb = 0; rb < 2; ++rb) { const LAS unsigned char* pa = tsw + l15 * AT_TS_ROW + 16 * (2 * lq - rb) - 4 * relbase;
            const LAS unsigned char* pn = tsn + l15 * AT_TS_ROW;
            tsp[rb] = (TM == TM_SELN && !selb[rb]) ? pn : pa; } }
    auto kld = [&](int cb, bf16x8 (&kf)[2], pg8::f32x4 (&cq)[2]) __attribute__((always_inline)) {
        if (TM == TM_SELN || TM == TM_WINN) {
#pragma unroll
            for (int rb = 0; rb < 2; ++rb) cq[rb] = *(const LAS pg8::f32x4*)(tsp[rb] + 16 * (8 * (cb >> 1) + (cb & 1))); }
        if (!(VAR & 64)) {
        const int krow = 8 * (l15 >> 2) + (l15 & 3) + 32 * (cb >> 1) + 4 * (cb & 1), kf_ = ((l15 >> 2) << 1) | ((l15 >> 1) & 1);
#pragma unroll
        for (int ks = 0; ks < 2; ++ks) kf[ks] = *(const LAS bf16x8*)(kb_ + krow * 128 + 16 * ((4 * ks + lq) ^ kf_)); }
    };
    auto qkm = [&](int cb, const bf16x8 (&kf)[2], const pg8::f32x4 (&cq)[2], pg8::f32x4 (&st)[2]) __attribute__((always_inline)) {
        st[0] = FAR ? (pg8::f32x4){cfar, cfar, cfar, cfar} : (pg8::f32x4){0.f, 0.f, 0.f, 0.f}; st[1] = st[0];
        if (TM == TM_SELN || TM == TM_WINN) { st[0] = cq[0]; st[1] = cq[1]; }
        if (TM == TM_SELF) {
#pragma unroll
            for (int rb = 0; rb < 2; ++rb) { const float ci = selb[rb] ? cfar : -1.0e30f; st[rb] = (pg8::f32x4){ci, ci, ci, ci}; } }
        if (!(VAR & 64)) {
#pragma unroll
        for (int ks = 0; ks < 2; ++ks) {
#pragma unroll
            for (int rb = 0; rb < 2; ++rb) if (RB & (1 << rb)) st[rb] = __builtin_amdgcn_mfma_f32_16x16x32_bf16(kf[ks], qf[rb][ks], st[rb], 0, 0, 0); } }
    };
    float linv_[2] = {0.f, 0.f};
    if (C2) { linv_[0] = LINV[l15]; linv_[1] = LINV[16 + l15]; }
    auto prob = [&](int cb, const pg8::f32x4 (&st)[2]) __attribute__((always_inline)) {
#pragma unroll
        for (int rb = 0; rb < 2; ++rb) if (RB & (1 << rb)) {
            const int tokc = tok_r[rb];
            float p[4];
#pragma unroll
            for (int r = 0; r < 4; ++r) {
                const int kl = 32 * (cb >> 1) + 8 * lq + 4 * (cb & 1) + r;
                if (VAR & 16) { p[r] = st[rb][r]; }
                else if (TM == TM_SELF) { p[r] = fexp2(st[rb][r]); }
                else if (TM == TM_WINF || TM == TM_SELN || TM == TM_WINN || TM == TM_CMP1F || TM == TM_CMP2F) { p[r] = fexp2(st[rb][r]); }
                else if (TM == TM_WINE) { const float e = fexp2(st[rb][r]); p[r] = (kl > tokc) ? e : 0.f; }
                else {
                    const int rel = (TM == TM_CMP1 || TM == TM_CMP2) ? (relbase + tokc - 16 * kl) : (relbase + tokc - kl);
                    const bool valid = rel >= 0;
                    const int ri = rel < 0 ? 0 : (rel > 127 ? 127 : rel);
                    const float e = fexp2(st[rb][r] + LUTJ[ri]);
                    p[r] = valid ? e : 0.f; }
            }
            if (C1) { lacc[rb][0] += (p[0] + p[1]) + (p[2] + p[3]); }
            else {
                if (C2) {
#pragma unroll
                    for (int r = 0; r < 4; ++r) p[r] *= linv_[rb];
                    float h0 = p[0], h1 = p[1], h2 = p[2], h3 = p[3];
                    h0 += dppf<DPP_XOR1>(h0); h1 += dppf<DPP_XOR1>(h1); h2 += dppf<DPP_XOR1>(h2); h3 += dppf<DPP_XOR1>(h3);
                    h0 += dppf<DPP_XOR2>(h0); h1 += dppf<DPP_XOR2>(h1); h2 += dppf<DPP_XOR2>(h2); h3 += dppf<DPP_XOR2>(h3);
                    if ((l15 & 3) == 0) { const int sp = 16 * idx + 8 * (cb >> 1) + 2 * lq + (cb & 1);
                        IMP1[tokc * 65 + sp] = (h0 + h1) + (h2 + 0.5f * h3);
                        if (sp + 1 < 64) IMP2[tokc * 65 + sp + 1] = 0.5f * h3; }
                }
                const unsigned lo = pkh(p[0], p[1]), hi = pkh(p[2], p[3]);
                if (cb & 1) { pfr[rb][cb >> 1].z = lo; pfr[rb][cb >> 1].w = hi; } else { pfr[rb][cb >> 1].x = lo; pfr[rb][cb >> 1].y = hi; } }
        }
    };
    auto vld = [&](int ks, v4u (&vv)[4]) __attribute__((always_inline)) {
        if (!C1 && !(VAR & 8)) {
#pragma unroll
            for (int db = 0; db < 4; ++db) vv[db] = *(const LAS v4u*)(vb_ + (16 * db + l15) * 128 + 16 * ((4 * ks + lq) ^ (l15 >> 1))); }
    };
    auto pvm = [&](int ks, const v4u (&vv)[4]) __attribute__((always_inline)) {
        if (!C1 && !(VAR & 8)) {
#pragma unroll
            for (int db = 0; db < 4; ++db) {
#pragma unroll
                for (int rb = 0; rb < 2; ++rb) if (RB & (1 << rb)) oacc[rb][db] = __builtin_amdgcn_mfma_f32_16x16x32_bf16(__builtin_bit_cast(bf16x8, pfr[rb][ks]), __builtin_bit_cast(bf16x8, vv[db]), oacc[rb][db], 0, 0, 0); }
            if (!C2) { const v4u ones = (v4u){0x3F803F80u, 0x3F803F80u, 0x3F803F80u, 0x3F803F80u};
#pragma unroll
                for (int rb = 0; rb < 2; ++rb) if (RB & (1 << rb)) lacc[rb] = __builtin_amdgcn_mfma_f32_16x16x32_bf16(__builtin_bit_cast(bf16x8, pfr[rb][ks]), __builtin_bit_cast(bf16x8, ones), lacc[rb], 0, 0, 0); }
        }
    };
    pg8::f32x4 sA[2], sB[2], cA[2], cB[2]; bf16x8 kA[2], kB[2]; v4u vA[4], vB[4];
#define AT_SB __builtin_amdgcn_sched_barrier(0)
    kld(0, kA, cA); kld(1, kB, cB); AT_SB;
    qkm(0, kA, cA, sA); kld(2, kA, cA); AT_SB;
    qkm(1, kB, cB, sB); kld(3, kB, cB); prob(0, sA); AT_SB;
    qkm(2, kA, cA, sA); vld(0, vA); prob(1, sB); AT_SB;
    qkm(3, kB, cB, sB); pvm(0, vA); vld(1, vB); prob(2, sA); AT_SB;
    prob(3, sB); AT_SB;
    pvm(1, vB);
#undef AT_SB
}

template <int VAR> __device__ __forceinline__ void attention_phase(Frame& F, const Args& args) {
    unsigned char* ws = F.ws;
    const int lane = F.lane, w = F.wave, l15 = lane & 15, lq = lane >> 4, tid = F.tid;
    LAS unsigned char* L = F.lds;
    LAS float* IMP1 = (LAS float*)(L + AT_OFF_IMP1); LAS float* IMP2 = (LAS float*)(L + AT_OFF_IMP2);
    LAS unsigned long long* SELM = (LAS unsigned long long*)(L + AT_OFF_SEL); LAS float* LUT = (LAS float*)(L + AT_OFF_LUT); LAS float* LROW = (LAS float*)(L + AT_OFF_LROW) + w * 32;
    LAS int* TD = (LAS int*)(L + AT_OFF_TD); LAS bf16* OUTL = (LAS bf16*)(L + AT_OFF_OUT) + (32 * w) * 72; LAS float* GATL = (LAS float*)(L + AT_OFF_GATL);
    const bf16* Qg = (const bf16*)(ws + WS_Q); const float* GATE = (const float*)(ws + WS_GATE); bf16* YA = (bf16*)(ws + WS_YA); float* YAF = (float*)(ws + WS_H);
    const int jq = l15 & 3;
    const LAS float* LUTJ = LUT + jq * 128;
    const int nrounds = (F.G == 256) ? 4 : (1024 + F.G - 1) / F.G;
    for (int round = 0; round < nrounds; ++round) {
        const int ui = (F.G == 256) ? ((round & 1) ? ((round >> 1) * 512 + 511 - F.bid) : ((round >> 1) * 512 + F.bid)) : (round * F.G + F.bid);
        if (ui >= 1024) break;
        const int c = 63 - (ui >> 4), bg = ui & 15, b = bg >> 1, g = bg & 1;
        const int m0 = b * SEQ + 64 * c;
        __syncthreads();
        { const float M0 = ((const float*)(ws + WS_BIASL))[8 * 128];
          for (int i = tid; i < 512; i += NTHREADS) LUT[i] = (((const float*)(ws + WS_BIASL))[(4 * g + (i >> 7)) * 128 + (i & 127)] - M0) * 1.4426950408889634f; }
        for (int i = tid; i < 64 * 65; i += NTHREADS) { IMP1[i] = 0.f; IMP2[i] = 0.f; }
        { const float M0 = ((const float*)(ws + WS_BIASL))[8 * 128]; const float* BL = (const float*)(ws + WS_BIASL) + (size_t)(4 * g) * 128;
          for (int i = tid; i < 16 * 63 * 4; i += NTHREADS) { const int r = i & 3, yi = (i >> 2) % 63, row = i / 252, rel = 4 * (47 - yi) + (row >> 2) - r;
              ((LAS float*)(L + AT_OFF_TS + row * AT_TS_ROW))[4 * yi + r] = rel < 0 ? -1.0e30f : (BL[(row & 3) * 128 + (rel > 127 ? 127 : rel)] - M0) * 1.4426950408889634f; } }
        for (int i = tid; i < 64 * 12; i += NTHREADS) GATL[i] = GATE[(size_t)(m0 + i / 12) * 24 + g * 12 + (i % 12)];
        bf16x8 qf[2][2];
#pragma unroll
        for (int rb = 0; rb < 2; ++rb)
#pragma unroll
            for (int ks = 0; ks < 2; ++ks) qf[rb][ks] = *(const GAS bf16x8*)(Qg + (size_t)(m0 + 8 * w + 4 * rb + (l15 >> 2)) * 512 + g * 256 + jq * 64 + 32 * ks + 8 * lq);
        asm volatile("" :: "v"(qf[0][0]), "v"(qf[0][1]), "v"(qf[1][0]), "v"(qf[1][1]));
        const int ncmp = 4 * c + 3, n1 = (ncmp + 63) >> 6, nsel = c + 1, w0 = c >= 8 ? c - 8 : 0, nwin = c - w0 + 1;
        const int ntiles = 2 * n1 + nsel + nwin;
        if (tid < ntiles) { const int i = tid;
            auto kindof = [&](int t, int& kind, int& idx) { if (t < n1) { kind = 0; idx = t; } else if (t < 2 * n1) { kind = 1; idx = t - n1; } else if (t < 2 * n1 + nsel) { kind = 2; idx = t - 2 * n1; } else { kind = 3; idx = w0 + (t - 2 * n1 - nsel); } };
            int kind, idx, kn, in_; kindof(i, kind, idx); kindof(i + 1 < ntiles ? i + 1 : i, kn, in_);
            unsigned ko, vo;
            if (kn < 2) { ko = (unsigned)(WS_KC + ((size_t)bg * 256 * 64 + (size_t)in_ * 4096) * 2); vo = (unsigned)(WS_VCT + ((size_t)bg * 64 * 256 + 64 * in_) * 2); }
            else if (kn == 2) { ko = (unsigned)(WS_KS + ((size_t)bg * SEQ * 64 + (size_t)in_ * 4096) * 2); vo = (unsigned)(WS_VST + ((size_t)bg * 64 * SEQ + 64 * in_) * 2); }
            else { ko = (unsigned)(WS_KW + ((size_t)bg * SEQ * 64 + (size_t)in_ * 4096) * 2); vo = (unsigned)(WS_VWT + ((size_t)bg * 64 * SEQ + 64 * in_) * 2); }
            const int dd = c - idx;
            int mode, relbase;
            if (kind == 0) { relbase = 64 * c - 31 - 1024 * idx; mode = relbase >= 1135 ? TM_CMP1F : TM_CMP1; } else if (kind == 1) { relbase = 64 * c - 31 - 1024 * idx; mode = relbase >= 1135 ? TM_CMP2F : TM_CMP2; }
            else if (kind == 2) { mode = dd <= 2 ? TM_SELN : TM_SELF; relbase = 64 * dd; } else { mode = dd <= 2 ? TM_WINN : (dd == 8 ? TM_WINE : TM_WINF); relbase = 64 * dd; }
            const int endf = ((kind == 1 && idx == n1 - 1) || (kind == 2 && idx == nsel - 1) || (kind == 3 && idx == c)) ? kind : 0;
            v4i e; e.x = mode | (idx << 8) | (endf << 16) | ((kind == 2 && idx == 0) ? (1 << 24) : 0) | (kn >= 2 ? (1 << 25) : 0); e.y = relbase; e.z = (int)ko; e.w = (int)vo;
            *(LAS v4i*)(TD + 4 * i) = e; }
        const int drow = 8 * w + (lane >> 3), dsrck = 16 * ((lane & 7) ^ (((w & 3) << 1) | ((lane >> 4) & 1))), dsrcv = 16 * ((lane & 7) ^ ((4 * (w & 1)) | (lane >> 4)));
#define AT_DMA(tile_, ko_, vo_, vs_) do { const int nb_ = (tile_) % AT_NBUF; \
        __builtin_amdgcn_global_load_lds((const GAS unsigned*)(ws + (size_t)((ko_) + drow * 128 + dsrck)), (LAS unsigned*)(L + AT_OFF_K + nb_ * AT_KBUF + w * 1024), 16, 0, 0); \
        __builtin_amdgcn_global_load_lds((const GAS unsigned*)(ws + (size_t)((vo_) + drow * (vs_) + dsrcv)), (LAS unsigned*)(L + AT_OFF_V + nb_ * AT_KBUF + w * 1024), 16, 0, 0); } while (0)
        __syncthreads();
        if (!(VAR & 2)) { AT_DMA(0, (unsigned)(WS_KC + (size_t)bg * 256 * 64 * 2), (unsigned)(WS_VCT + (size_t)bg * 64 * 256 * 2), 512u); }
        int d0, d1, d2, d3;
        { const v4i e = *(const LAS v4i*)TD; d0 = __builtin_amdgcn_readfirstlane(e.x); d1 = __builtin_amdgcn_readfirstlane(e.y); d2 = __builtin_amdgcn_readfirstlane(e.z); d3 = __builtin_amdgcn_readfirstlane(e.w); }
        pg8::f32x4 oacc[2][4];
        pg8::f32x4 lacc[2] = {(pg8::f32x4){0.f, 0.f, 0.f, 0.f}, (pg8::f32x4){0.f, 0.f, 0.f, 0.f}};
#pragma unroll
        for (int rb = 0; rb < 2; ++rb)
#pragma unroll
            for (int db = 0; db < 4; ++db) oacc[rb][db] = (pg8::f32x4){0.f, 0.f, 0.f, 0.f};
        const int tok_r[2] = {8 * w + (l15 >> 2), 8 * w + 4 + (l15 >> 2)};
        const LAS unsigned char* tsw = L + AT_OFF_TS + 16 * (47 - 2 * w); const LAS unsigned char* tsn = L + AT_OFF_TS + 16 * 48;
        for (int it = 0; it < ((VAR & 32) ? 0 : ntiles); ++it) {
            if (!(VAR & 512)) { asm volatile("s_waitcnt vmcnt(0)" ::: "memory");
            asm volatile("s_waitcnt lgkmcnt(0)" ::: "memory"); __builtin_amdgcn_s_barrier(); asm volatile("" ::: "memory"); }
            if (!(VAR & 2) && it + 1 < ntiles) AT_DMA(it + 1, (unsigned)d2, (unsigned)d3, ((d0 >> 25) & 1) ? 2u * SEQ : 512u);
            v4i tdn;
            { const LAS int* tn_ = TD + 4 * (it + 1); asm volatile("ds_read_b128 %0, %1" : "=v"(tdn) : "v"(tn_) : "memory"); }
            {
            const int mode = d0 & 255, idx = (d0 >> 8) & 255, relbase = d1, endf = (d0 >> 16) & 3, selfirst = (d0 >> 24) & 1;
            const int buf = it % AT_NBUF;
            if (selfirst) {
                { const int tok = 8 * w + (lane >> 3), s0 = 8 * (lane & 7);
                  unsigned key[8]; int rank[8];
#pragma unroll
                  for (int q = 0; q < 8; ++q) { const int sB = s0 + q; const bool vis = sB <= c, forced = (sB == 0) || (sB == c) || (sB == c - 1);
                      const float sc = vis ? (IMP1[tok * 65 + sB] + IMP2[tok * 65 + sB] + (forced ? 1000.f : 0.f)) : -1.f;
                      const unsigned u = __builtin_bit_cast(unsigned, sc); const unsigned fk = (u >> 31) ? ~u : (u | 0x80000000u);
                      key[q] = (fk & ~63u) | (unsigned)(63 - sB); rank[q] = 0; }
                  LAS unsigned* KEYS = (LAS unsigned*)IMP1;
#pragma unroll
                  for (int q = 0; q < 8; ++q) KEYS[tok * 65 + s0 + q] = key[q];
                  if (c >= 16 && !(VAR & 128)) {
#pragma unroll 8
                      for (int s2 = 0; s2 < 64; ++s2) { const unsigned k2 = KEYS[tok * 65 + s2];
#pragma unroll
                          for (int q = 0; q < 8; ++q) rank[q] += (k2 > key[q]) ? 1 : 0; } }
                  unsigned byte = 0u;
#pragma unroll
                  for (int q = 0; q < 8; ++q) byte |= ((rank[q] < 16 && (s0 + q) <= c) ? 1u : 0u) << q;
                  ((LAS unsigned char*)SELM)[tok * 8 + (lane & 7)] = (unsigned char)byte; }
            }
            const LAS unsigned char* kb_ = L + AT_OFF_K + buf * AT_KBUF; const LAS unsigned char* vb_ = L + AT_OFF_V + buf * AT_KBUF;
            const float cfar = LUTJ[127];
            unsigned selb[2] = {1u, 1u};
#define AT_CALL(TMX) at_tile<TMX, VAR>(kb_, vb_, LUTJ, IMP1, IMP2, qf, oacc, lacc, LROW, tok_r, selb, cfar, relbase, idx, l15, lq, tsw, tsn)
            if (mode == TM_SELF || mode == TM_SELN) { selb[0] = (unsigned)(SELM[tok_r[0]] >> idx) & 1u; selb[1] = (unsigned)(SELM[tok_r[1]] >> idx) & 1u; }
            if (mode == TM_SELF) {
                const bool a0 = __ballot(selb[0] != 0u) != 0ull, a1 = __ballot(selb[1] != 0u) != 0ull;
                if (a0 && a1) AT_CALL(TM_SELF);
                else if (a0) at_tile<TM_SELF, VAR, 1>(kb_, vb_, LUTJ, IMP1, IMP2, qf, oacc, lacc, LROW, tok_r, selb, cfar, relbase, idx, l15, lq, tsw, tsn);
                else if (a1) at_tile<TM_SELF, VAR, 2>(kb_, vb_, LUTJ, IMP1, IMP2, qf, oacc, lacc, LROW, tok_r, selb, cfar, relbase, idx, l15, lq, tsw, tsn); }
            else if (mode == TM_WINF) AT_CALL(TM_WINF);
            else if (mode == TM_SELN) AT_CALL(TM_SELN);
            else if (mode == TM_WINN) AT_CALL(TM_WINN);
            else if (mode == TM_WINE) AT_CALL(TM_WINE);
            else if (mode == TM_CMP2) AT_CALL(TM_CMP2);
            else if (mode == TM_CMP2F) AT_CALL(TM_CMP2F);
            else if (mode == TM_CMP1F) AT_CALL(TM_CMP1F);
            else { AT_CALL(TM_CMP1);
                if (idx == n1 - 1) {
#pragma unroll
                    for (int rb = 0; rb < 2; ++rb) { const float s = sum_xor32(sum_xor16(lacc[rb][0])); if (lq == 0) LROW[16 * rb + l15] = s > 0.f ? 1.0f / s : 0.f; lacc[rb] = (pg8::f32x4){0.f, 0.f, 0.f, 0.f}; } } }
#undef AT_CALL
            {
                if (endf && !(VAR & 256)) {
                    const int br = endf - 1;
#pragma unroll
                    for (int rb = 0; rb < 2; ++rb)
#pragma unroll
                        for (int r = 0; r < 4; ++r) { const int qrow = 16 * rb + 4 * lq + r;
                            const float ls_ = lacc[rb][r]; lacc[rb][r] = 0.f;
                            const float gt = GATL[(8 * w + 4 * rb + lq) * 12 + r * 3 + br] * (endf == 1 ? 1.0f : (ls_ > 0.f ? 1.0f / ls_ : 0.f));
#pragma unroll
                            for (int db = 0; db < 4; ++db) { float v = gt * oacc[rb][db][r]; oacc[rb][db][r] = 0.f;
                                LAS bf16* po = OUTL + qrow * 72 + 16 * db + l15;
                                if (br > 0) v += __builtin_bit_cast(float, (unsigned)(*po) << 16);
                                *po = (bf16)f2bf(v); } }
                    if (br == 2 && !(VAR & 1)) {
                        LDS_WAIT(); asm volatile("" ::: "memory");
#pragma unroll
                        for (int i = 0; i < 4; ++i) { const int ch = i * 64 + lane, row = ch >> 3, c16 = ch & 7;
                            const v4u o = *(const LAS v4u*)((const LAS unsigned char*)OUTL + row * 144 + 16 * c16);
                            *(GAS v4u*)(YA + (size_t)(m0 + 8 * w + (row >> 2)) * 512 + g * 256 + (row & 3) * 64 + 8 * c16) = o; }
                    }
                }
            }
            }
            asm volatile("s_waitcnt lgkmcnt(0)" : "+v"(tdn) :: "memory");
            d0 = __builtin_amdgcn_readfirstlane(tdn.x); d1 = __builtin_amdgcn_readfirstlane(tdn.y); d2 = __builtin_amdgcn_readfirstlane(tdn.z); d3 = __builtin_amdgcn_readfirstlane(tdn.w);
        }
#undef AT_DMA
    }
}

constexpr int N_PHASES = 13;
#ifndef MK_ONE_LAUNCH
#define MK_ONE_LAUNCH 1
#endif
#ifndef REP_P0
#define REP_P0 1
#endif
#ifndef REP_P1
#define REP_P1 1
#endif
#ifndef REP_P2
#define REP_P2 1
#endif
#ifndef REP_P3
#define REP_P3 1
#endif
#ifndef REP_P5
#define REP_P5 1
#endif
#ifndef REP_P6
#define REP_P6 1
#endif
#ifndef REP_P8
#define REP_P8 1
#endif
#ifndef REP_P7
#define REP_P7 1
#endif
#ifndef REP_P11
#define REP_P11 1
#endif
#ifndef REP_P4
#define REP_P4 1
#endif
#ifndef REP_P9
#define REP_P9 1
#endif
#ifndef REP_P10
#define REP_P10 1
#endif
#ifndef MK_BUILD
#define MK_BUILD 0
#endif

#ifndef STAG_P2
#define STAG_P2 0
#endif
__device__ __forceinline__ void phase_stagger(const Frame& F, int step_ns) {
    const int grp = (F.bid >> 3) & 7;
    if (step_ns > 0 && grp > 0) { const unsigned long long t0 = wall_clock64(), dt = (unsigned long long)(grp * step_ns) / 10ull;
        while (wall_clock64() - t0 < dt) __builtin_amdgcn_s_sleep(8); }
}
struct EpiNull {
    static constexpr bool PERM = true, AFTER_DRAIN = false;
    __device__ __forceinline__ void operator()(const pg8::f32x4 (&acc)[2][2][4][2], const pg8::Unit& u, int wr, int wc, int fr, int fq) const {
#pragma unroll
        for (int ai = 0; ai < 2; ++ai)
#pragma unroll
            for (int bj = 0; bj < 2; ++bj)
#pragma unroll
                for (int m = 0; m < 4; ++m) { asm volatile("" :: "v"(acc[ai][bj][m][0]), "v"(acc[ai][bj][m][1])); }
    }
};
__global__ void __launch_bounds__(NTHREADS, 2) fwd_kernel(Args args) {
    extern __shared__ __attribute__((aligned(16))) unsigned char lds[];
    Frame F;
    F.lds = (LAS unsigned char*)lds;
    F.MISC = (volatile LAS unsigned*)(F.lds + MISC_OFF);
    F.tid = threadIdx.x; F.lane = F.tid & 63; F.wave = __builtin_amdgcn_readfirstlane(F.tid >> 6);
    F.G = gridDim.x; F.bid = blockIdx.x; F.ws = args.ws;
    F.ctl = (gu32*)(args.ws + WS_CTL);
    for (int u = F.tid; u < (LDS_BYTES - LDSCTL_OFF) / 4; u += NTHREADS) ((LAS unsigned*)(F.lds + LDSCTL_OFF))[u] = 0u;
    __syncthreads();
    XcdBarrier bar; bar.bar = (unsigned*)(F.ctl + CW_BAR); bar.x = 0; bar.st = nullptr;
    if (MK_ONE_LAUNCH) bar = xcd_barrier_post((unsigned*)(F.ctl + CW_BAR), F.MISC + 8);
    const int lo = args.ph_lo, hi = args.ph_hi;
#define IN(k) (lo <= (k) && (k) < hi)
#define SEAM(k) do { if (IN(k) && IN((k) + 1)) xcd_barrier(bar); } while (0)
    unsigned char* ws = args.ws;
    const float* ada = (const float*)(ws + WS_ADA);

    if (IN(0)) { for (int rep = 0; rep < REP_P0; ++rep) { p0_prologue(F, args, rep == REP_P0 - 1); __syncthreads(); } } SEAM(0);
    if (IN(1)) { for (int rep = 0; rep < REP_P1; ++rep) modnorm_rows<false>(F, args.in[I_X], args.in[I_N1G], ada, 0, (bf16*)(ws + WS_H)); } SEAM(1);
    if (IN(2)) { {
        phase_stagger(F, STAG_P2);
        pg8::Gemm g{(const bf16*)(ws + WS_H), (const bf16*)(ws + WS_WIN_T), M, NIN, D, D, D}; pg8::StaticOrder S; S.init(M, NIN, F.G, F.bid);
        if (F.tid == 0) F.MISC[40] = 0xffffffffu; __syncthreads();
        EpiIn E{ws, args.in[I_QNG], args.in[I_KNG], F.MISC + 40};
#if defined(PROBE_P2) && PROBE_P2 == 1
        { EpiNull EN; pg8::gemm_phase<EpiNull, pg8::StaticOrder, true, true>(F.lds + RING_OFF, g, S, EN); __syncthreads(); }
#elif defined(PROBE_P2) && PROBE_P2 == 2
        { if (F.tid == 0) F.MISC[40] = 0u; __syncthreads(); pg8::gemm_phase<EpiIn, pg8::StaticOrder, true, true>(F.lds + RING_OFF, g, S, E); __syncthreads(); if (F.tid == 0) F.MISC[40] = 0xffffffffu; __syncthreads(); }
#endif
        pg8::gemm_phase<EpiIn, pg8::StaticOrder, true, true>(F.lds + RING_OFF, g, S, E);
#if REP_P2 > 1
        __syncthreads(); pg8::gemm_phase<EpiIn, pg8::StaticOrder, true, true>(F.lds + RING_OFF, g, S, E);
#endif
        }
    } SEAM(2);
    if (IN(3)) { for (int rep = 0; rep < REP_P3; ++rep) { __syncthreads(); pool_phase(F); __syncthreads(); compress_phase(F, args.in[I_KNG]); __syncthreads(); vtranspose_phase(F); } } SEAM(3);
    if (IN(4)) {
#ifdef PROBE_P4
        attention_phase<PROBE_P4>(F, args); __syncthreads();
#endif
        for (int rep = 0; rep < REP_P4; ++rep) { attention_phase<0>(F, args); __syncthreads(); } } SEAM(4);
    if (IN(5)) { {
        { pg8::Gemm g{(const bf16*)(ws + WS_PL), (const bf16*)(ws + WS_WEFF_T), M, D, POOLW, POOLW, POOLW}; pg8::StaticOrder S; S.init(M, D, F.G, F.bid);
          EpiMix<false> E{(bf16*)(ws + WS_MIX), (const bf16*)(ws + WS_GM), 0};
          pg8::gemm_phase<EpiMix<false>, pg8::StaticOrder, true, true>(F.lds + RING_OFF, g, S, E); }
        { pg8::Gemm g{(const bf16*)(ws + WS_YA), (const bf16*)(ws + WS_WBA_T), M, D, QW, QW, QW}; pg8::StaticOrder S; S.init(M, D, F.G, F.bid);
          EpiMix<true> E{(bf16*)(ws + WS_MIX), (const bf16*)(ws + WS_GM), 1024};
          pg8::gemm_phase<EpiMix<true>, pg8::StaticOrder, true, true>(F.lds + RING_OFF, g, S, E); } }
#if REP_P5 > 1
        { __syncthreads(); { pg8::Gemm g{(const bf16*)(ws + WS_PL), (const bf16*)(ws + WS_WEFF_T), M, D, POOLW, POOLW, POOLW}; pg8::StaticOrder S; S.init(M, D, F.G, F.bid);
          EpiMix<false> E{(bf16*)(ws + WS_MIX), (const bf16*)(ws + WS_GM), 0};
          pg8::gemm_phase<EpiMix<false>, pg8::StaticOrder, true, true>(F.lds + RING_OFF, g, S, E); }
        { pg8::Gemm g{(const bf16*)(ws + WS_YA), (const bf16*)(ws + WS_WBA_T), M, D, QW, QW, QW}; pg8::StaticOrder S; S.init(M, D, F.G, F.bid);
          EpiMix<true> E{(bf16*)(ws + WS_MIX), (const bf16*)(ws + WS_GM), 1024};
          pg8::gemm_phase<EpiMix<true>, pg8::StaticOrder, true, true>(F.lds + RING_OFF, g, S, E); } }
#endif
    } SEAM(5);
    if (IN(6)) { {
        pg8::Gemm g{(const bf16*)(ws + WS_MIX), (const bf16*)(ws + WS_WOUT_T), M, D, D, D, D}; pg8::StaticOrder S; S.init(M, D, F.G, F.bid);
        EpiRes E{args.in[I_X], args.out, ada, 2};
        pg8::gemm_phase<EpiRes, pg8::StaticOrder, true, true>(F.lds + RING_OFF, g, S, E);
#if REP_P6 > 1
        __syncthreads(); pg8::gemm_phase<EpiRes, pg8::StaticOrder, true, true>(F.lds + RING_OFF, g, S, E);
#endif
        }
    } SEAM(6);
    if (IN(7)) { for (int rep = 0; rep < REP_P7; ++rep) modnorm_rows<true>(F, args.out, args.in[I_N2G], ada, 3, (bf16*)(ws + WS_H)); } SEAM(7);
    if (IN(8)) { {
        pg8::Gemm g{(const bf16*)(ws + WS_H), (const bf16*)(ws + WS_WQ_T), M, PQW, D, D, D}; pg8::StaticOrder S; S.init(M, PQW, F.G, F.bid);
        EpiStoreBf16 E{(bf16*)(ws + WS_QV), PQW};
        pg8::gemm_phase<EpiStoreBf16, pg8::StaticOrder, true, true>(F.lds + RING_OFF, g, S, E);
#if REP_P8 > 1
        __syncthreads(); pg8::gemm_phase<EpiStoreBf16, pg8::StaticOrder, true, true>(F.lds + RING_OFF, g, S, E);
#endif
        }
    } SEAM(8);
    if (IN(9)) { for (int rep = 0; rep < REP_P9; ++rep) peer_select_phase(F); } SEAM(9);
#ifdef PROBE_XCD
    if (IN(10)) { if (F.tid == 0) __hip_atomic_store((unsigned*)(F.ctl + 2048 + F.bid), 100u + xb_xcc_id(), RLX_AGENT); }
#endif
    if (IN(10)) {
#ifdef PROBE_DOT
        peer_dot_phase<PROBE_DOT>(F); __syncthreads();
#endif
#ifdef PROBE_LOADRATE
        peer_loadrate_probe<PROBE_LOADRATE>(F); __syncthreads();
#endif
        peer_dot_phase<0>(F); } SEAM(10);
    if (IN(11)) { for (int rep = 0; rep < REP_P11; ++rep) peer_coef_phase(F); } SEAM(11);
#ifdef PROBE_XCD
    if (IN(12) && F.bid == 0 && F.tid == 0) { bool ok = true; for (int i = 0; i < F.G; ++i) { const unsigned a = __hip_atomic_load((unsigned*)(F.ctl + 2048 + i), RLX_AGENT), b0 = __hip_atomic_load((unsigned*)(F.ctl + 2048 + (i & 7)), RLX_AGENT); if (a != b0 || a < 100u) ok = false; }
        for (int i = 0; i < 8; ++i) for (int q = 0; q < i; ++q) if (__hip_atomic_load((unsigned*)(F.ctl + 2048 + i), RLX_AGENT) == __hip_atomic_load((unsigned*)(F.ctl + 2048 + q), RLX_AGENT)) ok = false;
        if (!ok) args.out[12345] = 1.0e9f; }
    __syncthreads();
#endif
    if (IN(12)) {
#if defined(CHECK_OUT_MFMA)
        peer_out_mfma_phase<1>(F, ada, args.out); __syncthreads(); VM_WAIT(); __syncthreads(); peer_out_phase<false, true>(F, ada, args.out);
#elif defined(OUT_VALU)
        for (int rep = 1; rep < REP_P10; ++rep) peer_out_phase<true>(F, ada, args.out); peer_out_phase<false>(F, ada, args.out);
#else
#ifdef PROBE_OUT
        peer_out_mfma_phase<1>(F, ada, args.out); __syncthreads();
#endif
        peer_out_mfma_phase<0>(F, ada, args.out);
#endif
    }
#undef IN
#undef SEAM
}

extern "C" void kernel_launch(void* const* d_in, const int* in_sizes, int n_in, void* d_out, int out_size, void* d_ws, size_t ws_size, hipStream_t stream) {
    static int grid = 0;
    if (grid == 0) {
        if (n_in != N_IN || in_sizes[0] != M * D || out_size != M * D || ws_size < WS_END) {
            fprintf(stderr, "kernel_launch: unexpected shapes: n_in %d in0 %d out %d ws %zu (need %zu)\n", n_in, n_in > 0 ? in_sizes[0] : -1, out_size, ws_size, (size_t)WS_END); grid = -1; return; }
        int dev = 0, cus = 0, per_cu = 0;
        if (hipGetDevice(&dev) != hipSuccess || hipDeviceGetAttribute(&cus, hipDeviceAttributeMultiprocessorCount, dev) != hipSuccess) { grid = -1; return; }
        if (hipFuncSetAttribute((const void*)fwd_kernel, hipFuncAttributeMaxDynamicSharedMemorySize, LDS_BYTES) != hipSuccess) { fprintf(stderr, "kernel_launch: hipFuncSetAttribute failed\n"); grid = -1; return; }
        if (hipOccupancyMaxActiveBlocksPerMultiprocessor(&per_cu, (const void*)fwd_kernel, NTHREADS, LDS_BYTES) != hipSuccess || per_cu < 1)
            fprintf(stderr, "kernel_launch: occupancy query reports %d workgroups per CU\n", per_cu);
        (void)hipGetLastError();
        grid = cus;
    }
    if (grid < 0) return;
    if (hipMemsetAsync((char*)d_ws + WS_CTL, 0, CTL_ZERO_BYTES, stream) != hipSuccess) return;
    Args a{};
    for (int i = 0; i < N_IN; ++i) a.in[i] = (const float*)d_in[i];
    a.out = (float*)d_out; a.ws = (unsigned char*)d_ws;
    if (MK_ONE_LAUNCH) {
        a.ph_lo = 0; a.ph_hi = N_PHASES; a.li = 0;
        hipLaunchKernelGGL(fwd_kernel, dim3(grid), dim3(NTHREADS), LDS_BYTES, stream, a);
    } else {
        for (int p = 0; p < N_PHASES; ++p) {
            a.ph_lo = p; a.ph_hi = p + 1; a.li = p;
            hipLaunchKernelGGL(fwd_kernel, dim3(grid), dim3(NTHREADS), LDS_BYTES, stream, a);
        }
    }
}
```

```cpp
#include <hip/hip_runtime.h>
#include <cstdio>
#include <cstdint>
namespace pg8 {
#define PG8_LAS __attribute__((address_space(3)))
typedef unsigned short bf16_t;
typedef short bf16x8 __attribute__((ext_vector_type(8)));
typedef float f32x4 __attribute__((ext_vector_type(4)));
typedef unsigned u32x4 __attribute__((ext_vector_type(4)));
constexpr int BM = 256, BK = 64, HALF = 128, HTB = HALF * BK * 2  , STAGE_BYTES = 8 * HTB, NXCD = 8, WGM = 8;

__host__ __device__ __forceinline__ int lds_byte(int r, int c) { const int st = (r >> 4) * 2 + (c >> 5), rr = r & 15, cc = c & 31, ob = rr * 64 + cc * 2; return st * 1024 + (ob ^ (((ob >> 9) & 1) << 5)); }
__host__ __device__ __forceinline__ void stage_rc(int b, int& R, int& C) { const int st = b / 1024, sb = b % 1024, swz = sb ^ (((sb >> 9) & 1) << 5); R = (st >> 1) * 16 + swz / 64; C = (st & 1) * 32 + (swz % 64) / 2; }
__host__ __device__ __forceinline__ int perm32(int rho) { const int n = rho >> 4, i = rho & 15; return 8 * (i >> 2) + 4 * n + (i & 3); }

struct Unit { int pm, pn; };
struct Gemm { const bf16_t* A; const bf16_t* Bt; int M, N, K, lda, ldb; };

struct StaticOrder {
    int nM, nN, nwg, G, c;
    __host__ __device__ void init(int M, int N, int G_, int c_) { nM = M / BM; nN = N / BM; nwg = nM * nN; G = G_; c = c_; }
    __host__ __device__ bool next(int i, Unit& u) const {
        const long L = (long)i * G + c; if (L >= nwg) return false;
        int wgid = (int)L; { const int q = nwg / NXCD, r = nwg % NXCD, xcd = wgid % NXCD, off = wgid / NXCD; wgid = (xcd < r ? xcd * (q + 1) : r * (q + 1) + (xcd - r) * q) + off; }
        const int nig = WGM * nN, gid = wgid / nig, fm = gid * WGM, gsz = (nM - fm) < WGM ? (nM - fm) : WGM;
        u.pm = fm + ((wgid % nig) % gsz); u.pn = (wgid % nig) / gsz; return true;
    }
    __device__ __forceinline__ void a_ready(const Unit&) const {}
    __device__ __forceinline__ void done(const Unit&) const {}
};

__device__ __forceinline__ unsigned cvt_pk_bf16(float lo, float hi) { unsigned r; asm volatile("v_cvt_pk_bf16_f32 %0, %1, %2" : "=v"(r) : "v"(lo), "v"(hi)); return r; }
template <class Epi, class Sched, bool ALIGN_EPI = false, bool SP2 = false>
__device__ __forceinline__ void gemm_phase(PG8_LAS unsigned char* lds, const Gemm g, const Sched& S, const Epi& E) {
    const int tid = threadIdx.x, wid = __builtin_amdgcn_readfirstlane(tid >> 6), lane = tid & 63, wr = wid >> 2, wc = wid & 3, fr = lane & 15, fq = lane >> 4;
    const int K = g.K, nt = K / BK;
    unsigned voffA[2], voffB[2];
#pragma unroll
    for (int i = 0; i < 2; ++i) { int R, C; stage_rc(tid * 16 + i * 8192, R, C); const int Rb = Epi::PERM ? ((R & ~31) + perm32(R & 31)) : R;
        voffA[i] = (unsigned)(R * g.lda + C) * 2u; voffB[i] = (unsigned)(Rb * g.ldb + C) * 2u; }
    const size_t kstep = (size_t)(BK * 2);
    const size_t hstepA = (size_t)HALF * g.lda * 2, hstepB = (size_t)HALF * g.ldb * 2;
    const size_t tstepA = 2 * hstepA, tstepB = 2 * hstepB;
    const unsigned ldsw = (unsigned)wid * 1024u;
    const int aoff = lds_byte(wr * 64 + fr, fq * 8), boff = lds_byte(wc * 32 + fr, fq * 8);
#define PG8_SA(b, h) (((b) * 2 + (h)) * HTB)
#define PG8_SB(b, h) ((4 + (b) * 2 + (h)) * HTB)
#define PG8_STAGE(bufoff, gbase, voff) do { _Pragma("unroll") for (int _i = 0; _i < 2; ++_i) \
        __builtin_amdgcn_global_load_lds((const unsigned*)((const char*)(gbase) + (voff)[_i]), (PG8_LAS unsigned*)(lds + (bufoff) + ldsw + _i * 8192), 16, 0, 0); } while (0)
#define PG8_LDA(dst, b, h) do { _Pragma("unroll") for (int m = 0; m < 4; ++m) _Pragma("unroll") for (int k = 0; k < 2; ++k) dst[m][k] = *(const PG8_LAS bf16x8*)(lds + PG8_SA(b, h) + aoff + m * 2048 + k * 1024); } while (0)
#define PG8_LDB(dst, b, h) do { _Pragma("unroll") for (int n = 0; n < 2; ++n) _Pragma("unroll") for (int k = 0; k < 2; ++k) dst[n][k] = *(const PG8_LAS bf16x8*)(lds + PG8_SB(b, h) + boff + n * 2048 + k * 1024); } while (0)
#define PG8_MMA(ai, bj, At, Bt) do { __builtin_amdgcn_s_setprio(1); _Pragma("unroll") for (int m = 0; m < 4; ++m) _Pragma("unroll") for (int n = 0; n < 2; ++n) _Pragma("unroll") for (int k = 0; k < 2; ++k) \
        acc[ai][bj][m][n] = __builtin_amdgcn_mfma_f32_16x16x32_bf16(Bt[n][k], At[m][k], acc[ai][bj][m][n], 0, 0, 0); __builtin_amdgcn_s_setprio(0); } while (0)
#define PG8_WAIT_V(n) asm volatile("s_waitcnt vmcnt(" #n ")" ::: "memory")
#define PG8_WAIT_L(n) asm volatile("s_waitcnt lgkmcnt(" #n ")" ::: "memory")
#define PG8_BAR __builtin_amdgcn_s_barrier()
#define PG8_SCHED __builtin_amdgcn_sched_barrier(0)
    Unit cur, nxt; int ui = 0;
    if (!S.next(0, cur)) return;
    f32x4 acc[2][2][4][2];
#pragma unroll
    for (int a = 0; a < 2; ++a)
#pragma unroll
        for (int b = 0; b < 2; ++b)
#pragma unroll
            for (int m = 0; m < 4; ++m)
#pragma unroll
                for (int n = 0; n < 2; ++n) acc[a][b][m][n] = (f32x4){0.f, 0.f, 0.f, 0.f};
    bf16x8 At[4][2], B0[2][2], B1[2][2];
    const char* cA = (const char*)g.A + (size_t)cur.pm * tstepA; const char* cB = (const char*)g.Bt + (size_t)cur.pn * tstepB;
    S.a_ready(cur);
    if constexpr (SP2) {
        PG8_STAGE(PG8_SB(0, 0), cB, voffB); PG8_STAGE(PG8_SB(0, 1), cB + hstepB, voffB); PG8_STAGE(PG8_SA(0, 0), cA, voffA); PG8_STAGE(PG8_SA(0, 1), cA + hstepA, voffA);
        if (wr == 1) PG8_BAR;
        PG8_WAIT_V(2); PG8_BAR;
        PG8_STAGE(PG8_SB(1, 0), cB + kstep, voffB); PG8_STAGE(PG8_SA(1, 0), cA + kstep, voffA); PG8_STAGE(PG8_SB(1, 1), cB + hstepB + kstep, voffB);
        PG8_WAIT_V(6); PG8_BAR;
    } else {
        PG8_STAGE(PG8_SB(0, 0), cB, voffB); PG8_STAGE(PG8_SA(0, 0), cA, voffA); PG8_STAGE(PG8_SB(0, 1), cB + hstepB, voffB); PG8_STAGE(PG8_SA(0, 1), cA + hstepA, voffA);
        if (wr == 1) PG8_BAR;
        PG8_WAIT_V(4); PG8_BAR;
        PG8_STAGE(PG8_SB(1, 0), cB + kstep, voffB); PG8_STAGE(PG8_SA(1, 0), cA + kstep, voffA); PG8_STAGE(PG8_SB(1, 1), cB + hstepB + kstep, voffB);
        PG8_WAIT_V(6); PG8_BAR;
    }
    for (;;) {
        const bool has_next = S.next(ui + 1, nxt);
        const char* nA = has_next ? (const char*)g.A + (size_t)nxt.pm * tstepA : cA; const char* nB = has_next ? (const char*)g.Bt + (size_t)nxt.pn * tstepB : cB;
        for (int t = 0; t < nt; t += 2) {
            const bool last = (t == nt - 2);
            const char* a1 = cA + (size_t)(t + 1) * kstep;
            const char* a2 = last ? nA : cA + (size_t)(t + 2) * kstep; const char* b2 = last ? nB : cB + (size_t)(t + 2) * kstep;
            const char* a3 = a2 + kstep; const char* b3 = b2 + kstep;
            if (last && has_next) S.a_ready(nxt);
            if constexpr (SP2) {
            PG8_LDB(B0, 0, 0); PG8_LDB(B1, 0, 1); PG8_SCHED; PG8_LDA(At, 0, 0); PG8_STAGE(PG8_SA(1, 1), a1 + hstepA, voffA);
            PG8_WAIT_V(8); PG8_WAIT_L(0); PG8_BAR; PG8_MMA(0, 0, At, B0); PG8_MMA(0, 1, At, B1); PG8_BAR; PG8_SCHED;
            PG8_LDA(At, 0, 1); PG8_STAGE(PG8_SB(0, 0), b2, voffB); PG8_STAGE(PG8_SB(0, 1), b2 + hstepB, voffB); PG8_STAGE(PG8_SA(0, 0), a2, voffA);
            PG8_WAIT_V(8); PG8_WAIT_L(0); PG8_BAR; PG8_MMA(1, 0, At, B0); PG8_MMA(1, 1, At, B1); PG8_BAR; PG8_SCHED;
            PG8_LDB(B0, 1, 0); PG8_LDB(B1, 1, 1); PG8_SCHED; PG8_LDA(At, 1, 0); PG8_STAGE(PG8_SA(0, 1), a2 + hstepA, voffA);
            PG8_WAIT_V(8); PG8_WAIT_L(0); PG8_BAR; PG8_MMA(0, 0, At, B0); PG8_MMA(0, 1, At, B1); PG8_BAR; PG8_SCHED;
            PG8_LDA(At, 1, 1); PG8_STAGE(PG8_SB(1, 0), b3, voffB); PG8_STAGE(PG8_SB(1, 1), b3 + hstepB, voffB); PG8_STAGE(PG8_SA(1, 0), a3, voffA);
            PG8_WAIT_V(8); PG8_WAIT_L(0); PG8_BAR; PG8_MMA(1, 0, At, B0); PG8_MMA(1, 1, At, B1); PG8_BAR; PG8_SCHED;
            } else {
            PG8_LDB(B0, 0, 0); PG8_SCHED; PG8_LDA(At, 0, 0); PG8_STAGE(PG8_SA(1, 1), a1 + hstepA, voffA);
            PG8_WAIT_L(8); PG8_BAR; PG8_WAIT_L(0); PG8_MMA(0, 0, At, B0); PG8_BAR; PG8_SCHED;
            PG8_LDB(B1, 0, 1); PG8_STAGE(PG8_SB(0, 0), b2, voffB);
            PG8_BAR; PG8_WAIT_L(0); PG8_MMA(0, 1, At, B1); PG8_BAR;
            PG8_LDA(At, 0, 1); PG8_STAGE(PG8_SA(0, 0), a2, voffA);
            PG8_BAR; PG8_WAIT_L(0); PG8_MMA(1, 0, At, B0); PG8_BAR; PG8_SCHED;
            PG8_STAGE(PG8_SB(0, 1), b2 + hstepB, voffB);
            PG8_WAIT_V(6); PG8_BAR; PG8_MMA(1, 1, At, B1); PG8_BAR;
            PG8_LDB(B0, 1, 0); PG8_SCHED; PG8_LDA(At, 1, 0); PG8_STAGE(PG8_SA(0, 1), a2 + hstepA, voffA);
            PG8_WAIT_L(8); PG8_BAR; PG8_WAIT_L(0); PG8_MMA(0, 0, At, B0); PG8_BAR; PG8_SCHED;
            PG8_LDB(B1, 1, 1); PG8_STAGE(PG8_SB(1, 0), b3, voffB);
            PG8_BAR; PG8_WAIT_L(0); PG8_MMA(0, 1, At, B1); PG8_BAR;
            PG8_LDA(At, 1, 1); PG8_STAGE(PG8_SA(1, 0), a3, voffA);
            PG8_BAR; PG8_WAIT_L(0); PG8_MMA(1, 0, At, B0); PG8_BAR; PG8_SCHED;
            PG8_STAGE(PG8_SB(1, 1), b3 + hstepB, voffB);
            PG8_WAIT_V(6); PG8_BAR; PG8_MMA(1, 1, At, B1); PG8_BAR;
            }
        }
        if constexpr (ALIGN_EPI) { if (wr == 0) PG8_BAR; }
        if constexpr (!Epi::AFTER_DRAIN) { E(acc, cur, wr, wc, fr, fq); S.done(cur); }
        if (!has_next) break;
#pragma unroll
        for (int a = 0; a < 2; ++a)
#pragma unroll
            for (int b = 0; b < 2; ++b)
#pragma unroll
                for (int m = 0; m < 4; ++m)
#pragma unroll
                    for (int n = 0; n < 2; ++n) acc[a][b][m][n] = (f32x4){0.f, 0.f, 0.f, 0.f};
        cur = nxt; cA = nA; cB = nB; ++ui;
        if constexpr (ALIGN_EPI) { if (wr == 1) PG8_BAR; }
    }
    PG8_WAIT_V(0);
    if constexpr (!ALIGN_EPI) { if (wr == 0) PG8_BAR; }
    PG8_BAR;
    if constexpr (Epi::AFTER_DRAIN) { E.fused(acc, cur, wr, wc, fr, fq, lds, wid, lane); S.done(cur); }
#undef PG8_SA
#undef PG8_SB
#undef PG8_STAGE
#undef PG8_LDA
#undef PG8_LDB
#undef PG8_MMA
#undef PG8_WAIT_V
#undef PG8_WAIT_L
#undef PG8_BAR
#undef PG8_SCHED
}
}

constexpr int NWAVES = 8, NTHREADS = NWAVES * 64;
constexpr int BATCH = 8, SEQ = 4096, D = 1024, M = BATCH * SEQ;
constexpr int POOLW = 512, QW = 512, NG = 2, HD = 64, NBG = BATCH * NG;
constexpr int IN_COLS = 3864, NIN = 4096;
constexpr int NCMP = 255, NCMP_PAD = 256, NSEL = 64;
constexpr int PH = 8, PK = 128, PTOP = 16, PQD = 256, PQW = PH * PQD;
constexpr int NEXP = PK * PK;
constexpr float EPS = 1e-6f;
enum { I_X = 0, I_C, I_RELB, I_ADAW, I_ADAB, I_N1G, I_N2G, I_WIN, I_POOLW, I_POOLS, I_CPEK, I_CW1K, I_CW2K, I_CPEV, I_CW1V, I_CW2V, I_QNG, I_KNG, I_WBP, I_WBA, I_WOUT, I_PWQ, I_PSK, I_PU, I_PV, N_IN };

constexpr size_t MiB = 1u << 20, KiB = 1u << 10;
constexpr size_t WS_CTL = 0, CTL_ZERO_BYTES = 1 * MiB;
constexpr size_t WS_ADA = 1 * MiB;
constexpr size_t WS_CB1K = 64 * KiB;
constexpr size_t WS_CB1V = WS_CB1K + 1 * KiB;
constexpr size_t WS_BIASL = WS_ADA + 256 * KiB;
constexpr size_t WS_WIN_T = 2 * MiB;
constexpr size_t WS_WEFF_T = 10 * MiB;
constexpr size_t WS_WBA_T = 11 * MiB;
constexpr size_t WS_WOUT_T = 12 * MiB;
constexpr size_t WS_WQ_T = 14 * MiB;
constexpr size_t WS_SUBK = 18 * MiB;
constexpr size_t WS_CW1K_T = 18 * MiB + 512 * KiB;
constexpr size_t WS_CW1V_T = 19 * MiB;
constexpr size_t WS_CW2K_T = 19 * MiB + 512 * KiB;
constexpr size_t WS_CW2V_T = WS_CW2K_T + 64 * KiB;
constexpr size_t WS_KC = 20 * MiB;
constexpr size_t WS_VCT = 20 * MiB + 512 * KiB;
constexpr size_t WS_GATE = 21 * MiB;
constexpr size_t WS_UB = 24 * MiB;
constexpr size_t WS_VB = 56 * MiB;
constexpr size_t WS_SCLU = WS_UB + 16 * MiB, WS_SCLV = WS_SCLU + 64 * KiB;
constexpr size_t WS_H = 88 * MiB;
constexpr size_t WS_ZP = 152 * MiB;
constexpr size_t WS_Q = 184 * MiB;
constexpr size_t WS_KCR = 216 * MiB;
constexpr size_t WS_VCR = 225 * MiB;
constexpr size_t WS_KS = 234 * MiB, WS_VS = 242 * MiB, WS_KW = 250 * MiB, WS_VW = 258 * MiB;
constexpr size_t WS_VST = 266 * MiB, WS_VWT = 274 * MiB;
constexpr size_t WS_PL = 282 * MiB;
constexpr size_t WS_YA = 314 * MiB;
constexpr size_t WS_GM = 346 * MiB;
constexpr size_t WS_MIX = WS_ZP;
constexpr size_t WS_QV = WS_GM;
constexpr size_t WS_EID = WS_PL;
constexpr size_t WS_GW = WS_PL + 16 * MiB;
constexpr size_t WS_PART = WS_GM;
constexpr size_t WS_CF = WS_YA;
constexpr size_t WS_CFS = WS_YA + 8 * MiB;
constexpr size_t WS_H8 = WS_ZP;
constexpr size_t WS_HS = WS_ZP + 32 * MiB;
constexpr size_t WS_END = 474 * MiB;
constexpr int CW_TMO = 0, CW_CODE = 1, CW_BAR = 4096;

constexpr int RING_OFF = 0, RING_BYTES = 131072;
constexpr int LDSCTL_OFF = RING_BYTES, MISC_OFF = LDSCTL_OFF + 320;
constexpr int LDS_BYTES = 147456;

#define GAS __attribute__((address_space(1)))
#define LAS __attribute__((address_space(3)))
typedef unsigned short bf16;
typedef unsigned v4u __attribute__((ext_vector_type(4)));
typedef unsigned v2u __attribute__((ext_vector_type(2)));
typedef int v2i __attribute__((ext_vector_type(2)));
typedef float f32x4 __attribute__((ext_vector_type(4)));
typedef short bf16x8 __attribute__((ext_vector_type(8)));
typedef GAS unsigned gu32;
#define RLX_AGENT __ATOMIC_RELAXED, __HIP_MEMORY_SCOPE_AGENT
#define LDS_WAIT() asm volatile("s_waitcnt lgkmcnt(0)" ::: "memory")
#define VM_WAIT() asm volatile("s_waitcnt vmcnt(0)" ::: "memory")
__device__ __forceinline__ unsigned f2bf(float f) { unsigned u = __builtin_bit_cast(unsigned, f); return (u + 0x7fffu + ((u >> 16) & 1u)) >> 16; }
__device__ __forceinline__ unsigned pk2(float lo, float hi) { return f2bf(lo) | (f2bf(hi) << 16); }
__device__ __forceinline__ float bflo(unsigned w) { return __builtin_bit_cast(float, w << 16); }
__device__ __forceinline__ float bfhi(unsigned w) { return __builtin_bit_cast(float, w & 0xffff0000u); }
__device__ __forceinline__ float sigmoidf_(float v) { return __builtin_amdgcn_rcpf(1.0f + __builtin_amdgcn_exp2f(v * -1.4426950408889634f)); }
typedef __bf16 bf16x2_hw __attribute__((ext_vector_type(2)));
typedef float f32x2_hw __attribute__((ext_vector_type(2)));
__device__ __forceinline__ unsigned pkh(float lo, float hi) { return __builtin_bit_cast(unsigned, __builtin_convertvector((f32x2_hw){lo, hi}, bf16x2_hw)); }
__device__ __forceinline__ float gelu_tanh_safe(float v) { const float u = 0.7978845608028654f * (v + 0.044715f * v * v * v); return 0.5f * v * (1.0f + tanhf(u)); }
template <int CTRL> __device__ __forceinline__ float dppf(float v) { return __builtin_bit_cast(float, __builtin_amdgcn_update_dpp(0, __builtin_bit_cast(int, v), CTRL, 0xF, 0xF, true)); }
template <int CTRL> __device__ __forceinline__ int dppi(int v) { return __builtin_amdgcn_update_dpp(0, v, CTRL, 0xF, 0xF, true); }
#define DPP_XOR1 0xB1
#define DPP_XOR2 0x4E
#define DPP_HMIR 0x141
#define DPP_ROR8 0x128
__device__ __forceinline__ void swap16_(float& a, float& b) { asm volatile("v_nop\n\tv_nop\n\tv_permlane16_swap_b32 %0, %1" : "+v"(a), "+v"(b)); }
__device__ __forceinline__ void swap32_(float& a, float& b) { asm volatile("v_nop\n\tv_nop\n\tv_permlane32_swap_b32 %0, %1" : "+v"(a), "+v"(b)); }
__device__ __forceinline__ float sum_xor16(float v) { float a = v, b = v; swap16_(a, b); return a + b; }
__device__ __forceinline__ float sum_xor32(float v) { float a = v, b = v; swap32_(a, b); return a + b; }
__device__ __forceinline__ float max_xor16(float v) { float a = v, b = v; swap16_(a, b); return fmaxf(a, b); }
__device__ __forceinline__ float max_xor32(float v) { float a = v, b = v; swap32_(a, b); return fmaxf(a, b); }
__device__ __forceinline__ float wave_sum(float v) {
    v += dppf<DPP_XOR1>(v); v += dppf<DPP_XOR2>(v); v += dppf<DPP_HMIR>(v); v += dppf<DPP_ROR8>(v);
    return sum_xor32(sum_xor16(v));
}
__device__ __forceinline__ float wave_max(float v) {
    v = fmaxf(v, dppf<DPP_XOR1>(v)); v = fmaxf(v, dppf<DPP_XOR2>(v)); v = fmaxf(v, dppf<DPP_HMIR>(v)); v = fmaxf(v, dppf<DPP_ROR8>(v));
    return max_xor32(max_xor16(v));
}

#define XB_TMO      128
#define XB_XCNT(j)  (256  + 64 * (j))
#define XB_XSUB(j)  (1280 + 64 * (j))
#define XB_XGEN(j)  (2304 + 64 * (j))
#define XB_TOP      3328
#define XB_TOPGEN   3392
#define XCD_BAR_WORDS 3456
#define XB_SPIN_CAP (1u << 18)
__device__ __forceinline__ unsigned xb_ld(unsigned* p)              { return __hip_atomic_load(p, __ATOMIC_RELAXED, __HIP_MEMORY_SCOPE_AGENT); }
__device__ __forceinline__ unsigned xb_add(unsigned* p, unsigned v) { return __hip_atomic_fetch_add(p, v, __ATOMIC_RELAXED, __HIP_MEMORY_SCOPE_AGENT); }
__device__ __forceinline__ unsigned xb_xcc_id() { return (unsigned)__builtin_amdgcn_s_getreg((3 << 11) | 20) & 0xFu; }
#define XB_SPIN(cond, bar) do { unsigned _sp = 0; while (cond) { __builtin_amdgcn_s_sleep(1); \
    if ((++_sp & 255u) == 0u) { if (xb_ld(&(bar)[XB_TMO])) break; if (_sp > XB_SPIN_CAP) { atomicAdd(&(bar)[XB_TMO], 1u); break; } } } } while (0)
struct XcdBarrier { unsigned* bar; unsigned x; volatile LAS unsigned* st; };
__device__ __forceinline__ XcdBarrier xcd_barrier_post(unsigned* bar, volatile LAS unsigned* st) {
    XcdBarrier b; b.bar = bar; b.x = xb_xcc_id(); b.st = st;
    if (threadIdx.x == 0) (void)xb_add(&bar[XB_XCNT(b.x)], 1u);
    return b;
}
__device__ __forceinline__ void xcd_barrier_complete(unsigned* bar, unsigned x, unsigned& nloc, unsigned& nx) {
    const unsigned G = gridDim.x * gridDim.y * gridDim.z;
    unsigned sum, cnt, mine, sp = 0u;
    for (;;) {
        sum = 0u; cnt = 0u; mine = 0u;
#pragma unroll
        for (unsigned j = 0; j < 16; ++j) { const unsigned c = xb_ld(&bar[XB_XCNT(j)]); sum += c; cnt += (c > 0u) ? 1u : 0u; mine = (j == x) ? c : mine; }
        if (sum == G) break;
        __builtin_amdgcn_s_sleep(1);
        if ((++sp & 255u) == 0u) { if (xb_ld(&bar[XB_TMO])) break; if (sp > XB_SPIN_CAP) { atomicAdd(&bar[XB_TMO], 1u); break; } }
    }
    nloc = mine > 0u ? mine : 1u; nx = cnt > 0u ? cnt : 1u;
}
__device__ __forceinline__ void xcd_barrier(const XcdBarrier& b) {
    asm volatile("s_waitcnt vmcnt(0)" ::: "memory");
    __syncthreads();
    if (threadIdx.x == 0) {
        unsigned* bar = b.bar;
        __builtin_amdgcn_s_waitcnt(0);
        unsigned nloc = b.st[0], nx = b.st[1];
        if (nloc == 0u) { xcd_barrier_complete(bar, b.x, nloc, nx); b.st[0] = nloc; b.st[1] = nx; }
        const unsigned old = xb_add(&bar[XB_XSUB(b.x)], 1u);
        const unsigned gen = old / nloc;
        if (old + 1u == (gen + 1u) * nloc) {
            __builtin_amdgcn_fence(__ATOMIC_RELEASE, "agent");
            asm volatile("s_waitcnt vmcnt(0)" ::: "memory");
            const unsigned og = xb_add(&bar[XB_TOP], 1u);
            const unsigned tg = og / nx;
            if (og + 1u == (tg + 1u) * nx) xb_add(&bar[XB_TOPGEN], 1u);
            else XB_SPIN(xb_ld(&bar[XB_TOPGEN]) == tg, bar);
            __builtin_amdgcn_fence(__ATOMIC_ACQUIRE, "agent");
            xb_add(&bar[XB_XGEN(b.x)], 1u);
            asm volatile("s_waitcnt vmcnt(0)" ::: "memory");
        } else {
            XB_SPIN(xb_ld(&bar[XB_XGEN(b.x)]) == gen, bar);
            __builtin_amdgcn_fence(__ATOMIC_ACQUIRE, "agent");
            asm volatile("s_waitcnt vmcnt(0)" ::: "memory");
        }
    }
    __syncthreads();
}

struct Args { const float* in[N_IN]; float* out; unsigned char* ws; int ph_lo, ph_hi, li, pad; };
struct Frame {
    LAS unsigned char* lds;
    volatile LAS unsigned* MISC;
    gu32* ctl;
    int tid, lane, wave, G, bid;
    unsigned char* ws;
};

template <bool I8> __device__ __forceinline__ void cvt_row_store(const f32x4 (&v)[4], int row, unsigned char* dst, float* inv_scale, int lane) {
    float m = 0.f;
#pragma unroll
    for (int j = 0; j < 4; ++j) m = fmaxf(m, fmaxf(fmaxf(fabsf(v[j].x), fabsf(v[j].y)), fmaxf(fabsf(v[j].z), fabsf(v[j].w))));
    m = wave_max(m);
    unsigned ww[4]; float isc;
    if (I8) { const float sc = m > 0.f ? 127.0f / m : 0.f; isc = m * (1.0f / 127.0f);
#pragma unroll
        for (int j = 0; j < 4; ++j) { const int q0 = (int)rintf(v[j].x * sc), q1 = (int)rintf(v[j].y * sc), q2 = (int)rintf(v[j].z * sc), q3 = (int)rintf(v[j].w * sc);
            ww[j] = ((unsigned)q0 & 0xffu) | (((unsigned)q1 & 0xffu) << 8) | (((unsigned)q2 & 0xffu) << 16) | (((unsigned)q3 & 0xffu) << 24); } }
    else { const unsigned E = (__builtin_bit_cast(unsigned, m) >> 23) & 0xffu; float sc = 1.f; isc = 1.f;
        if (E >= 8u && E <= 250u) { sc = __builtin_bit_cast(float, (261u - E) << 23); isc = __builtin_bit_cast(float, (E - 7u) << 23); }
#pragma unroll
        for (int j = 0; j < 4; ++j) { int t = __builtin_amdgcn_cvt_pk_fp8_f32(v[j].x * sc, v[j].y * sc, 0, false); t = __builtin_amdgcn_cvt_pk_fp8_f32(v[j].z * sc, v[j].w * sc, t, true); ww[j] = (unsigned)t; } }
    *(GAS v4u*)(dst + (size_t)(lane >> 3) * NEXP * 128 + (size_t)row * 128 + 16 * (lane & 7)) = (v4u){ww[0], ww[1], ww[2], ww[3]};
    if (lane == 0) inv_scale[row] = isc;
}
template <bool I8> __device__ __forceinline__ void cvt_rows_8bit(const float* src, unsigned char* dst, float* inv_scale, int gw, int NGW, int lane) {
    for (int row = gw; row < NEXP; row += 2 * NGW) {
        const int row1 = row + NGW; const bool has1 = row1 < NEXP;
        f32x4 v0[4], v1[4];
#pragma unroll
        for (int j = 0; j < 4; ++j) v0[j] = *(const GAS f32x4*)(src + (size_t)row * D + 16 * lane + 4 * j);
#pragma unroll
        for (int j = 0; j < 4; ++j) v1[j] = has1 ? *(const GAS f32x4*)(src + (size_t)row1 * D + 16 * lane + 4 * j) : (f32x4){0.f, 0.f, 0.f, 0.f};
        cvt_row_store<I8>(v0, row, dst, inv_scale, lane);
        if (has1) cvt_row_store<I8>(v1, row1, dst, inv_scale, lane);
    }
}
__device__ __forceinline__ void p0_transpose_item(const float* W, int ldw, int src_col0, int valid, int K, bf16* WT, int dst_row0, int k0, LAS float* scr, int lane) {
    const int n_ = lane & 31;
#pragma unroll 8
    for (int i = 0; i < 32; ++i) { const int kk = 2 * i + (lane >> 5); scr[kk * 33 + n_] = (n_ < valid) ? W[(size_t)(k0 + kk) * ldw + src_col0 + n_] : 0.f; }
    LDS_WAIT(); asm volatile("" ::: "memory");
    const int c = lane & 7;
#pragma unroll
    for (int j = 0; j < 4; ++j) { const int n = (lane >> 3) + 8 * j; const LAS float* s = scr + (8 * c) * 33 + n;
        v4u o; o.x = pk2(s[0 * 33], s[1 * 33]); o.y = pk2(s[2 * 33], s[3 * 33]); o.z = pk2(s[4 * 33], s[5 * 33]); o.w = pk2(s[6 * 33], s[7 * 33]);
        *(GAS v4u*)(WT + (size_t)(dst_row0 + n) * K + k0 + 8 * c) = o; }
    LDS_WAIT(); asm volatile("" ::: "memory");
}
__device__ __forceinline__ bool p0_mat(int& r, const float* W, int K, int N, bf16* WT, LAS float* scr, int lane) {
    const int ng = N / 32, items = ng * (K / 64);
    if (r < items) { const int kb = r / ng, nb = r % ng; p0_transpose_item(W, N, 32 * nb, 32, K, WT, 32 * nb, 64 * kb, scr, lane); return true; }
    r -= items; return false;
}
__device__ __forceinline__ void cvt_f32_bf16_stream(const float* src, bf16* dst, size_t n8, size_t gtid, size_t gthreads) {
    for (size_t i = gtid; i < n8; i += gthreads) {
        const f32x4 a = *(const GAS f32x4*)(src + 8 * i), b = *(const GAS f32x4*)(src + 8 * i + 4);
        v4u o; o.x = pk2(a.x, a.y); o.y = pk2(a.z, a.w); o.z = pk2(b.x, b.y); o.w = pk2(b.z, b.w);
        *(GAS v4u*)(dst + 8 * i) = o; }
}

__device__ __forceinline__ void p0_prologue(Frame& F, const Args& args, bool do_bias = true) {
    unsigned char* ws = F.ws;
    const int gw = F.bid * NWAVES + F.wave, NGW = F.G * NWAVES;
    const size_t gtid = (size_t)F.bid * NTHREADS + F.tid, gthreads = (size_t)F.G * NTHREADS;
    {
        LAS float* sl = (LAS float*)(F.lds);
        LAS float* red = (LAS float*)(F.lds + 32768);
        const float* c = args.in[I_C];
        { f32x4 cv[4];
#pragma unroll
          for (int q = 0; q < 4; ++q) cv[q] = *(const GAS f32x4*)(c + 4 * (F.tid + NTHREADS * q));
#pragma unroll
          for (int q = 0; q < 4; ++q) { f32x4 o; o.x = cv[q].x / (1.0f + __expf(-cv[q].x)); o.y = cv[q].y / (1.0f + __expf(-cv[q].y)); o.z = cv[q].z / (1.0f + __expf(-cv[q].z)); o.w = cv[q].w / (1.0f + __expf(-cv[q].w));
              *(LAS f32x4*)(sl + 4 * (F.tid + NTHREADS * q)) = o; } }
        __syncthreads();
        for (int cb = F.bid; cb < 6 * D / 24; cb += F.G) {
            const int j0 = cb * 24;
            if (F.tid < 510) {
                const int kk = F.tid / 6, c4 = F.tid % 6;
                const float* w = args.in[I_ADAW] + j0 + 4 * c4;
                f32x4 wv[13];
#pragma unroll
                for (int m = 0; m < 13; ++m) { const int k = kk + 85 * m; wv[m] = (k < D) ? *(const GAS f32x4*)(w + (size_t)k * (6 * D)) : (f32x4){0.f, 0.f, 0.f, 0.f}; }
                f32x4 a[BATCH];
#pragma unroll
                for (int b = 0; b < BATCH; ++b) a[b] = (f32x4){0.f, 0.f, 0.f, 0.f};
#pragma unroll
                for (int m = 0; m < 13; ++m) { const int k = kk + 85 * m; const int kc = k < D ? k : 0;
#pragma unroll
                    for (int b = 0; b < BATCH; ++b) a[b] = a[b] + wv[m] * sl[b * D + kc]; }
#pragma unroll
                for (int b = 0; b < BATCH; ++b) { LAS float* rp = red + (kk * 24 + 4 * c4) * BATCH + b; rp[0] = a[b].x; rp[BATCH] = a[b].y; rp[2 * BATCH] = a[b].z; rp[3 * BATCH] = a[b].w; }
            }
            __syncthreads();
            if (F.tid < 24 * BATCH) { const int jj = F.tid / BATCH, b = F.tid % BATCH; float s = 0.f;
#pragma unroll 5
                for (int kk = 0; kk < 85; ++kk) s += red[(kk * 24 + jj) * BATCH + b];
                ((float*)(ws + WS_ADA))[b * (6 * D) + j0 + jj] = s + args.in[I_ADAB][j0 + jj]; }
            __syncthreads();
        }
    }
    if (F.bid >= 8 && F.bid < 40 && do_bias) {
        const int bb = F.bid - 8, kv = bb & 1, ch = bb >> 1;
        const float* pe = args.in[kv == 0 ? I_CPEK : I_CPEV]; const float* w1 = args.in[kv == 0 ? I_CW1K : I_CW1V];
        LAS float* red = (LAS float*)(F.lds);
        const int j = F.tid & 127, ic = F.tid >> 7; float s = 0.f;
        const int i0 = ch * 128 + ic * 32;
#pragma unroll 8
        for (int i = i0; i < i0 + 32; ++i) s += pe[i] * w1[(size_t)i * 128 + j];
        red[ic * 128 + j] = s; __syncthreads();
        if (F.tid < 128) atomicAdd((float*)(ws + (kv == 0 ? WS_CB1K : WS_CB1V)) + F.tid, (red[F.tid] + red[128 + F.tid]) + (red[256 + F.tid] + red[384 + F.tid]));
        __syncthreads();
    } else if (F.bid == 2) {
        for (int i = F.tid; i < 8 * 128; i += NTHREADS) { const int h = i >> 7, rel = i & 127;
            int bk = rel;
            if (rel >= 16) bk = 16 + (rel >= 19) + (rel >= 21) + (rel >= 24) + (rel >= 27) + (rel >= 31) + (rel >= 35) + (rel >= 40) + (rel >= 46) + (rel >= 52) + (rel >= 59) + (rel >= 67) + (rel >= 77) + (rel >= 87) + (rel >= 99) + (rel >= 113);
            ((float*)(ws + WS_BIASL))[i] = args.in[I_RELB][bk * 8 + h]; }
        if (F.tid < 64) {
            float mq = fabsf(args.in[I_QNG][F.tid]), mk = fmaxf(fmaxf(fabsf(args.in[I_KNG][F.tid]), fabsf(args.in[I_KNG][64 + F.tid])), fabsf(args.in[I_KNG][128 + F.tid]));
            float mb = fmaxf(fmaxf(fabsf(args.in[I_RELB][F.tid]), fabsf(args.in[I_RELB][64 + F.tid])), fmaxf(fabsf(args.in[I_RELB][128 + F.tid]), fabsf(args.in[I_RELB][192 + F.tid])));
            mq = wave_max(mq); mk = wave_max(mk); mb = wave_max(mb);
            if (F.tid == 0) ((float*)(ws + WS_BIASL))[8 * 128] = 8.0f * mq * mk + mb; }
    }
    {
        LAS float* scr = (LAS float*)(F.lds + F.wave * 16384);
        constexpr int I_WINT = (NIN / 32) * (D / 64);
        constexpr int NITEMS = I_WINT + (1024 / 32) * (512 / 64) + (1024 / 32) * (1024 / 64) + (2048 / 32) * (1024 / 64) + 2 * (128 / 32) * (2048 / 64) + 2 * (64 / 32) * (128 / 64);
        for (int it = gw; it < NITEMS; it += NGW) {
            int r = it;
            if (r < I_WINT) {
                const int grp = r % (NIN / 32), kb = r / (NIN / 32);
                const int tile = grp >> 3, ct0 = (grp & 7) * 32;
                const int L0 = 64 * ((ct0 >> 5) & 3) + 32 * (ct0 >> 7);
                int src0, valid = 32;
                if (tile < 7) src0 = 256 * tile + L0; else if (tile < 15) src0 = 1816 + 256 * (tile - 7) + L0; else { src0 = 1792 + L0; valid = (L0 == 0) ? 24 : 0; }
                if (valid == 0) src0 = 0;
                p0_transpose_item(args.in[I_WIN], IN_COLS, src0, valid, D, (bf16*)(ws + WS_WIN_T), 32 * grp, 64 * kb, scr, F.lane);
                continue; }
            r -= I_WINT;
            if (p0_mat(r, args.in[I_WBA], 512, 1024, (bf16*)(ws + WS_WBA_T), scr, F.lane)) continue;
            if (p0_mat(r, args.in[I_WOUT], 1024, 1024, (bf16*)(ws + WS_WOUT_T), scr, F.lane)) continue;
            if (p0_mat(r, args.in[I_PWQ], 1024, 2048, (bf16*)(ws + WS_WQ_T), scr, F.lane)) continue;
            if (p0_mat(r, args.in[I_CW1K], 2048, 128, (bf16*)(ws + WS_CW1K_T), scr, F.lane)) continue;
            if (p0_mat(r, args.in[I_CW1V], 2048, 128, (bf16*)(ws + WS_CW1V_T), scr, F.lane)) continue;
            if (p0_mat(r, args.in[I_CW2K], 128, 64, (bf16*)(ws + WS_CW2K_T), scr, F.lane)) continue;
            p0_mat(r, args.in[I_CW2V], 128, 64, (bf16*)(ws + WS_CW2V_T), scr, F.lane);
        }
    }
    {
        const float* pw = args.in[I_POOLW]; const float* ps = args.in[I_POOLS]; const float* wbp = args.in[I_WBP];
        bf16* weff = (bf16*)(ws + WS_WEFF_T);
        LAS float* PWl = (LAS float*)(F.lds);
        LAS float* WBl = (LAS float*)(F.lds + 128 * 129 * 4);
        __syncthreads();
        for (int bb = F.bid; bb < 256; bb += F.G) {
            const int g = bb >> 6, d0 = (bb & 63) * 16;
            { f32x4 t[8];
#pragma unroll
              for (int q = 0; q < 8; ++q) t[q] = *(const GAS f32x4*)(pw + (size_t)g * 16384 + 4 * (F.tid + NTHREADS * q));
#pragma unroll
              for (int q = 0; q < 8; ++q) { const int i = 4 * (F.tid + NTHREADS * q); LAS float* d = PWl + (i >> 7) * 129 + (i & 127); d[0] = t[q].x; d[1] = t[q].y; d[2] = t[q].z; d[3] = t[q].w; }
              const int cc = F.tid >> 2, d4 = (F.tid & 3) * 4;
              const f32x4 wv = *(const GAS f32x4*)(wbp + (size_t)(g * 128 + cc) * D + d0 + d4); const float pv = ps[g * 128 + cc];
              LAS float* d = WBl + cc * 17 + d4; d[0] = wv.x * pv; d[1] = wv.y * pv; d[2] = wv.z * pv; d[3] = wv.w * pv; }
            __syncthreads();
            const int c = F.tid & 127, q = F.tid >> 7;
            float acc4[4] = {0.f, 0.f, 0.f, 0.f};
#pragma unroll 4
            for (int cc = 0; cc < 128; ++cc) { const float a = PWl[c * 129 + cc];
#pragma unroll
                for (int e = 0; e < 4; ++e) acc4[e] += a * WBl[cc * 17 + 4 * q + e]; }
#pragma unroll
            for (int e = 0; e < 4; ++e) weff[(size_t)(d0 + 4 * q + e) * POOLW + g * 128 + c] = (bf16)f2bf(acc4[e]);
            __syncthreads();
        }
    }
    cvt_f32_bf16_stream(args.in[I_PSK], (bf16*)(ws + WS_SUBK), (size_t)16 * 128 * 128 / 8, gtid, gthreads);
    cvt_rows_8bit<true>(args.in[I_PU], ws + WS_UB, (float*)(ws + WS_SCLU), gw, NGW, F.lane);
    cvt_rows_8bit<false>(args.in[I_PV], ws + WS_VB, (float*)(ws + WS_SCLV), gw, NGW, F.lane);
}

template <bool Q8> __device__ __forceinline__ void modnorm_rows(Frame& F, const float* x, const float* g, const float* ada, int shift_idx, bf16* out) {
    const int gw = F.bid * NWAVES + F.wave, NGW = F.G * NWAVES;
    for (int m = gw; m < M; m += NGW) {
        const int b = m >> 12;
        const GAS f32x4* xr = (const GAS f32x4*)(x + (size_t)m * D) + F.lane;
        const GAS f32x4* gr = (const GAS f32x4*)g + F.lane;
        const GAS f32x4* sh = (const GAS f32x4*)(ada + (size_t)b * 6 * D + shift_idx * D) + F.lane;
        const GAS f32x4* sc = (const GAS f32x4*)(ada + (size_t)b * 6 * D + (shift_idx + 1) * D) + F.lane;
        f32x4 v[4]; float s = 0.f;
#pragma unroll
        for (int j = 0; j < 4; ++j) { v[j] = xr[64 * j]; s += (v[j].x * v[j].x + v[j].y * v[j].y) + (v[j].z * v[j].z + v[j].w * v[j].w); }
        const float rstd = rsqrtf(wave_sum(s) * (1.f / D) + EPS);
        GAS v2u* o8 = (GAS v2u*)(out + (size_t)m * D) + F.lane;
        float mx = 0.f;
#pragma unroll
        for (int j = 0; j < 4; ++j) { const f32x4 gg = gr[64 * j], ss = sh[64 * j], cc = sc[64 * j];
            const f32x4 y = (v[j] * rstd) * gg * (cc + 1.0f) + ss; v[j] = y;
            mx = fmaxf(mx, fmaxf(fmaxf(fabsf(y.x), fabsf(y.y)), fmaxf(fabsf(y.z), fabsf(y.w))));
            v2u o; o.x = pk2(y.x, y.y); o.y = pk2(y.z, y.w); o8[64 * j] = o; }
        if (Q8) {
            mx = wave_max(mx);
            const float qs = mx > 0.f ? 127.0f / mx : 0.f;
            GAS unsigned* h8 = (GAS unsigned*)(F.ws + WS_H8 + (size_t)m * D) + F.lane;
#pragma unroll
            for (int j = 0; j < 4; ++j) { const int q0 = (int)rintf(v[j].x * qs), q1 = (int)rintf(v[j].y * qs), q2 = (int)rintf(v[j].z * qs), q3 = (int)rintf(v[j].w * qs);
                h8[64 * j] = ((unsigned)q0 & 0xffu) | (((unsigned)q1 & 0xffu) << 8) | (((unsigned)q2 & 0xffu) << 16) | (((unsigned)q3 & 0xffu) << 24); }
            if (F.lane == 0) ((float*)(F.ws + WS_HS))[m] = mx * (1.0f / 127.0f);
        }
    }
}

struct EpiIn {
    static constexpr bool PERM = true, AFTER_DRAIN = false;
    unsigned char* ws; const float* qg; const float* kg; const volatile LAS unsigned* rmp;
    __device__ __forceinline__ void operator()(const pg8::f32x4 (&acc)[2][2][4][2], const pg8::Unit& u, int wr, int wc, int fr, int fq) const {
        const int pn = u.pn, rmask = __builtin_amdgcn_readfirstlane((int)*rmp);
#pragma unroll
        for (int ai = 0; ai < 2; ++ai)
#pragma unroll
            for (int m = 0; m < 4; ++m) {
                const int row = (u.pm & rmask) * 256 + ai * 128 + wr * 64 + m * 16 + fr;
                float v[2][8];
#pragma unroll
                for (int bj = 0; bj < 2; ++bj)
#pragma unroll
                    for (int n = 0; n < 2; ++n)
#pragma unroll
                        for (int i = 0; i < 4; ++i) v[bj][4 * n + i] = acc[ai][bj][m][n][i];
                bf16* dst = nullptr; bool norm = false; const float* gain = nullptr; float mul = 1.f; bool sig = false;
                if (pn < 2) { dst = (bf16*)(ws + WS_ZP) + (size_t)row * 512 + 256 * pn + 64 * wc; }
                else if (pn < 4) { dst = (bf16*)(ws + WS_Q) + (size_t)row * 512 + 256 * (pn - 2) + 64 * wc; norm = true; gain = qg; mul = 0.125f * 1.4426950408889634f; }
                else if (pn < 7) { const int kind = pn - 4, isv = wc >> 1, g = wc & 1, b = row >> 12, t = row & 4095;
                    const size_t base = ((size_t)(b * 2 + g) * SEQ + t) * 64;
                    const size_t off = kind == 0 ? (isv ? WS_VCR : WS_KCR) : kind == 1 ? (isv ? WS_VS : WS_KS) : (isv ? WS_VW : WS_KW);
                    dst = (bf16*)(ws + off) + base; if (!isv && kind > 0) { norm = true; gain = kg + kind * 64; } }
                else if (pn < 15) { dst = (bf16*)(ws + WS_GM) + (size_t)row * 2048 + 256 * (pn - 7) + 64 * wc; sig = true; }
                else {
                    if (wc == 0 && fq < 3) { float* gp = (float*)(ws + WS_GATE) + (size_t)row * 24 + 8 * fq;
                        *(GAS f32x4*)gp = (f32x4){sigmoidf_(v[0][0]), sigmoidf_(v[0][1]), sigmoidf_(v[0][2]), sigmoidf_(v[0][3])};
                        *(GAS f32x4*)(gp + 4) = (f32x4){sigmoidf_(v[0][4]), sigmoidf_(v[0][5]), sigmoidf_(v[0][6]), sigmoidf_(v[0][7])}; }
                    continue; }
                if (norm) { float ss = 0.f;
#pragma unroll
                    for (int bj = 0; bj < 2; ++bj)
#pragma unroll
                        for (int e = 0; e < 8; ++e) ss += v[bj][e] * v[bj][e];
                    ss = sum_xor32(sum_xor16(ss));
                    const float rs = rsqrtf(ss * (1.f / 64.f) + EPS) * mul;
#pragma unroll
                    for (int bj = 0; bj < 2; ++bj)
#pragma unroll
                        for (int e = 0; e < 8; ++e) v[bj][e] = v[bj][e] * rs * gain[32 * bj + 8 * fq + e]; }
                if (sig) {
#pragma unroll
                    for (int bj = 0; bj < 2; ++bj)
#pragma unroll
                        for (int e = 0; e < 8; ++e) v[bj][e] = sigmoidf_(v[bj][e]); }
#pragma unroll
                for (int bj = 0; bj < 2; ++bj) { v4u o; o.x = pkh(v[bj][0], v[bj][1]); o.y = pkh(v[bj][2], v[bj][3]); o.z = pkh(v[bj][4], v[bj][5]); o.w = pkh(v[bj][6], v[bj][7]);
                    *(GAS v4u*)(dst + 32 * bj + 8 * fq) = o; }
            }
    }
};
template <bool ADD> struct EpiMix {
    static constexpr bool PERM = true, AFTER_DRAIN = false;
    bf16* MIX; const bf16* GM; int gmoff;
    __device__ __forceinline__ void operator()(const pg8::f32x4 (&acc)[2][2][4][2], const pg8::Unit& u, int wr, int wc, int fr, int fq) const {
#pragma unroll
        for (int ai = 0; ai < 2; ++ai)
#pragma unroll
            for (int m = 0; m < 4; ++m) {
                const int row = u.pm * 256 + ai * 128 + wr * 64 + m * 16 + fr;
#pragma unroll
                for (int bj = 0; bj < 2; ++bj) {
                    const int col = u.pn * 256 + bj * 128 + wc * 32 + 8 * fq;
                    const v4u gmv = *(const GAS v4u*)(GM + (size_t)row * 2048 + gmoff + col);
                    float r[8];
                    r[0] = acc[ai][bj][m][0][0] * bflo(gmv.x); r[1] = acc[ai][bj][m][0][1] * bfhi(gmv.x); r[2] = acc[ai][bj][m][0][2] * bflo(gmv.y); r[3] = acc[ai][bj][m][0][3] * bfhi(gmv.y);
                    r[4] = acc[ai][bj][m][1][0] * bflo(gmv.z); r[5] = acc[ai][bj][m][1][1] * bfhi(gmv.z); r[6] = acc[ai][bj][m][1][2] * bflo(gmv.w); r[7] = acc[ai][bj][m][1][3] * bfhi(gmv.w);
                    GAS v4u* dp = (GAS v4u*)(MIX + (size_t)row * 1024 + col);
                    if (ADD) { const v4u old = *dp; r[0] += bflo(old.x); r[1] += bfhi(old.x); r[2] += bflo(old.y); r[3] += bfhi(old.y); r[4] += bflo(old.z); r[5] += bfhi(old.z); r[6] += bflo(old.w); r[7] += bfhi(old.w); }
                    v4u o; o.x = pkh(r[0], r[1]); o.y = pkh(r[2], r[3]); o.z = pkh(r[4], r[5]); o.w = pkh(r[6], r[7]); *dp = o; }
            }
    }
};
struct EpiRes {
    static constexpr bool PERM = false, AFTER_DRAIN = false;
    const float* x; float* out; const float* ada; int gate_idx;
    __device__ __forceinline__ void operator()(const pg8::f32x4 (&acc)[2][2][4][2], const pg8::Unit& u, int wr, int wc, int fr, int fq) const {
#pragma unroll
        for (int ai = 0; ai < 2; ++ai)
#pragma unroll
            for (int m = 0; m < 4; ++m) {
                const int row = u.pm * 256 + ai * 128 + wr * 64 + m * 16 + fr, b = row >> 12;
#pragma unroll
                for (int bj = 0; bj < 2; ++bj)
#pragma unroll
                    for (int n = 0; n < 2; ++n) {
                        const int col = u.pn * 256 + bj * 128 + wc * 32 + 16 * n + 4 * fq;
                        const f32x4 gt = *(const GAS f32x4*)(ada + (size_t)b * 6 * D + gate_idx * D + col);
                        const f32x4 xv = *(const GAS f32x4*)(x + (size_t)row * D + col);
                        *(GAS f32x4*)(out + (size_t)row * D + col) = xv + gt * acc[ai][bj][m][n]; }
            }
    }
};

template <int W> __device__ __forceinline__ void pool_item(const bf16* zp, bf16* pl, int row, int col) {
    const int t = row & 4095;
    float s[8], self[8];
#pragma unroll
    for (int e = 0; e < 8; ++e) { s[e] = 0.f; self[e] = 0.f; }
    v4u z[W];
#pragma unroll
    for (int j = 0; j < W; ++j) z[j] = (j <= t) ? *(const GAS v4u*)(zp + (size_t)(row - j) * 512 + col) : (v4u){0u, 0u, 0u, 0u};
#pragma unroll
    for (int j = 0; j < W; ++j) { const float f[8] = {bflo(z[j].x), bfhi(z[j].x), bflo(z[j].y), bfhi(z[j].y), bflo(z[j].z), bfhi(z[j].z), bflo(z[j].w), bfhi(z[j].w)};
#pragma unroll
        for (int e = 0; e < 8; ++e) { s[e] += f[e]; if (j == 0) self[e] = f[e]; } }
    const float inv = 1.0f / (float)((t + 1 < W) ? (t + 1) : W);
    v4u o; o.x = pk2(s[0] * inv - self[0], s[1] * inv - self[1]); o.y = pk2(s[2] * inv - self[2], s[3] * inv - self[3]);
    o.z = pk2(s[4] * inv - self[4], s[5] * inv - self[5]); o.w = pk2(s[6] * inv - self[6], s[7] * inv - self[7]);
    *(GAS v4u*)(pl + (size_t)row * 512 + col) = o;
}
__device__ __forceinline__ void pool_phase(Frame& F) {
    const bf16* zp = (const bf16*)(F.ws + WS_ZP); bf16* pl = (bf16*)(F.ws + WS_PL);
    const int gw = F.bid * NWAVES + F.wave, NGW = F.G * NWAVES;
    for (int item = gw; item < 4 * (M / 4); item += NGW) {
        const int gi = item & 3, r4 = item >> 2, row = 4 * r4 + (F.lane >> 4), col = 128 * gi + 8 * (F.lane & 15);
        if (gi == 0) pool_item<2>(zp, pl, row, col); else if (gi == 1) pool_item<4>(zp, pl, row, col); else if (gi == 2) pool_item<8>(zp, pl, row, col); else pool_item<16>(zp, pl, row, col);
    }
}

typedef int v4i __attribute__((ext_vector_type(4)));
struct EpiStoreBf16 {
    static constexpr bool PERM = true, AFTER_DRAIN = false;
    bf16* O; int ldc;
    __device__ __forceinline__ void operator()(const pg8::f32x4 (&acc)[2][2][4][2], const pg8::Unit& u, int wr, int wc, int fr, int fq) const {
#pragma unroll
        for (int ai = 0; ai < 2; ++ai)
#pragma unroll
            for (int m = 0; m < 4; ++m) {
                const int row = u.pm * 256 + ai * 128 + wr * 64 + m * 16 + fr;
#pragma unroll
                for (int bj = 0; bj < 2; ++bj) {
                    const int col = u.pn * 256 + bj * 128 + wc * 32 + 8 * fq;
                    v4u o; o.x = pkh(acc[ai][bj][m][0][0], acc[ai][bj][m][0][1]); o.y = pkh(acc[ai][bj][m][0][2], acc[ai][bj][m][0][3]);
                    o.z = pkh(acc[ai][bj][m][1][0], acc[ai][bj][m][1][1]); o.w = pkh(acc[ai][bj][m][1][2], acc[ai][bj][m][1][3]);
                    *(GAS v4u*)(O + (size_t)row * ldc + col) = o; }
            }
    }
};

__device__ __forceinline__ unsigned fkey(float f) { const unsigned u = __builtin_bit_cast(unsigned, f); return (u >> 31) ? ~u : (u | 0x80000000u); }
__device__ __forceinline__ float funkey(unsigned k) { const unsigned u = (k >> 31) ? (k & 0x7fffffffu) : ~k; return __builtin_bit_cast(float, u); }
__device__ __forceinline__ unsigned umax_(unsigned a, unsigned b) { return a > b ? a : b; }
__device__ __forceinline__ unsigned umin_(unsigned a, unsigned b) { return a > b ? b : a; }
#define TOP16_INSERT(L, xin) do { unsigned _x = (xin); _Pragma("unroll") for (int _i = 0; _i < 16; ++_i) { const unsigned _h = umax_(L[_i], _x); _x = umin_(L[_i], _x); L[_i] = _h; } } while (0)
template <int MASK> __device__ __forceinline__ void top16_merge(unsigned (&L)[16]) {
    unsigned o[16];
#pragma unroll
    for (int i = 0; i < 16; ++i) o[i] = (unsigned)dppi<MASK == 1 ? DPP_XOR1 : DPP_XOR2>((int)L[i]);
#pragma unroll
    for (int i = 0; i < 16; ++i) L[i] = umax_(L[i], o[15 - i]);
#pragma unroll
    for (int d = 8; d >= 1; d >>= 1)
#pragma unroll
        for (int i = 0; i < 16; ++i) if ((i & d) == 0) { const unsigned hi = umax_(L[i], L[i + d]), lo = umin_(L[i], L[i + d]); L[i] = hi; L[i + d] = lo; }
}
#define CE_DESC(a_, b_) do { const unsigned _h = umax_(a_, b_), _l = umin_(a_, b_); a_ = _h; b_ = _l; } while (0)
template <int OFF> __device__ __forceinline__ void bitonic_sort16_desc(unsigned (&v)[32]) {
#pragma unroll
    for (int k = 2; k <= 16; k <<= 1)
#pragma unroll
        for (int j = k >> 1; j > 0; j >>= 1)
#pragma unroll
            for (int i = 0; i < 16; ++i) { const int l = i ^ j; if (l > i) { if ((i & k) == 0) CE_DESC(v[OFF + i], v[OFF + l]); else CE_DESC(v[OFF + l], v[OFF + i]); } }
}
__device__ __forceinline__ void bitonic_merge16_desc(unsigned (&L)[16]) {
#pragma unroll
    for (int d = 8; d >= 1; d >>= 1)
#pragma unroll
        for (int i = 0; i < 16; ++i) if ((i & d) == 0) CE_DESC(L[i], L[i + d]);
}
constexpr int SST = 132;
constexpr int P9_LIST_OFF = 2 * 64 * SST * 4;
__device__ __forceinline__ void peer_select_phase(Frame& F) {
    const bf16* QV = (const bf16*)(F.ws + WS_QV); const bf16* SK = (const bf16*)(F.ws + WS_SUBK);
    int* EID = (int*)(F.ws + WS_EID); float* GW = (float*)(F.ws + WS_GW);
    LAS float* S = (LAS float*)(F.lds);
    LAS unsigned* LIST = (LAS unsigned*)(F.lds + P9_LIST_OFF);
    const int lane = F.lane, w = F.wave, l15 = lane & 15, lq = lane >> 4;
    const int p = w >> 2, kb = w & 3;
    constexpr int NU = (M / 64) * PH;
    bf16x8 a[4][4], bq[2][4];
#define P9_LOAD(u_) do { const int _tt = (u_) >> 3, _h = (u_) & 7; \
        const bf16* qa = QV + (size_t)(_tt * 64 + l15) * PQW + _h * 256 + p * 128 + 8 * lq; \
        const bf16* kbp = SK + (size_t)((_h * 2 + p) * 128 + 32 * kb + l15) * 128 + 8 * lq; \
        _Pragma("unroll") for (int ks = 0; ks < 4; ++ks) { \
            _Pragma("unroll") for (int rb = 0; rb < 4; ++rb) a[rb][ks] = *(const GAS bf16x8*)(qa + (size_t)(16 * rb) * PQW + 32 * ks); \
            _Pragma("unroll") for (int cb = 0; cb < 2; ++cb) bq[cb][ks] = *(const GAS bf16x8*)(kbp + (size_t)(16 * cb) * 128 + 32 * ks); } } while (0)
    if (F.bid < NU) P9_LOAD(F.bid);
    for (int u = F.bid; u < NU; u += F.G) {
        const int tt = u >> 3, h = u & 7, tok0 = tt * 64;
        {
            pg8::f32x4 acc[4][2];
#pragma unroll
            for (int rb = 0; rb < 4; ++rb)
#pragma unroll
                for (int cb = 0; cb < 2; ++cb) acc[rb][cb] = (pg8::f32x4){0.f, 0.f, 0.f, 0.f};
#pragma unroll
            for (int ks = 0; ks < 4; ++ks)
#pragma unroll
                for (int rb = 0; rb < 4; ++rb)
#pragma unroll
                    for (int cb = 0; cb < 2; ++cb) acc[rb][cb] = __builtin_amdgcn_mfma_f32_16x16x32_bf16(a[rb][ks], bq[cb][ks], acc[rb][cb], 0, 0, 0);
#pragma unroll
            for (int rb = 0; rb < 4; ++rb)
#pragma unroll
                for (int cb = 0; cb < 2; ++cb)
#pragma unroll
                    for (int r = 0; r < 4; ++r) S[(p * 64 + 16 * rb + 4 * lq + r) * SST + 32 * kb + 16 * cb + l15] = acc[rb][cb][r];
        }
        __syncthreads();
        if (u + F.G < NU) P9_LOAD(u + F.G);
        {
            const int row = F.tid >> 2, sub = F.tid & 3;
            const LAS float* sr = S + row * SST + sub;
            unsigned kv[32];
#pragma unroll
            for (int i = 0; i < 32; ++i) kv[i] = (fkey(sr[4 * i]) & ~127u) | (unsigned)(4 * i + sub);
            bitonic_sort16_desc<0>(kv); bitonic_sort16_desc<16>(kv);
            unsigned L[16];
#pragma unroll
            for (int i = 0; i < 16; ++i) L[i] = umax_(kv[i], kv[31 - i]);
            bitonic_merge16_desc(L);
            top16_merge<1>(L); top16_merge<2>(L);
            if (sub == 0) {
#pragma unroll
                for (int i = 0; i < 4; ++i) *(LAS v4u*)(LIST + row * 16 + 4 * i) = (v4u){L[4 * i], L[4 * i + 1], L[4 * i + 2], L[4 * i + 3]}; }
        }
        __syncthreads();
        if (F.tid < 256) {
            const int tok = F.tid >> 2, sub = F.tid & 3;
            float va[16], vb[16];
#pragma unroll
            for (int i = 0; i < 4; ++i) { const v4u x = *(const LAS v4u*)(LIST + tok * 16 + 4 * i), y = *(const LAS v4u*)(LIST + (64 + tok) * 16 + 4 * i);
                va[4 * i] = funkey(x.x & ~127u); va[4 * i + 1] = funkey(x.y & ~127u); va[4 * i + 2] = funkey(x.z & ~127u); va[4 * i + 3] = funkey(x.w & ~127u);
                vb[4 * i] = funkey(y.x & ~127u); vb[4 * i + 1] = funkey(y.y & ~127u); vb[4 * i + 2] = funkey(y.z & ~127u); vb[4 * i + 3] = funkey(y.w & ~127u); }
            unsigned cand[32];
#pragma unroll
            for (int i = 0; i < 32; ++i) cand[i] = 0u;
            {
                constexpr int NC = 50;
                constexpr unsigned char CI[52] = {0,0,0,0,0,0,0,0,0,0,0,0,0,0,0,0, 1,1,1,1,1,1,1,1, 2,2,2,2,2, 3,3,3,3, 4,4,4, 5,5, 6,6, 7,7, 8,9,10,11,12,13,14,15, 0,0};
                constexpr unsigned char CJ[52] = {0,1,2,3,4,5,6,7,8,9,10,11,12,13,14,15, 0,1,2,3,4,5,6,7, 0,1,2,3,4, 0,1,2,3, 0,1,2, 0,1, 0,1, 0,1, 0,0,0,0,0,0,0,0, 0,0};
#pragma unroll
                for (int g4 = 0; g4 < 13; ++g4) {
                    float sa = 0.f, sb = 0.f; unsigned id = 0u; bool ok = false;
#pragma unroll
                    for (int q = 0; q < 4; ++q) { const int n = 4 * g4 + q; if (n < NC) { const bool me = (sub == q); sa = me ? va[CI[n]] : sa; sb = me ? vb[CJ[n]] : sb; id = me ? (unsigned)(CI[n] * 16 + CJ[n]) : id; ok = ok || me; } }
                    cand[g4] = ok ? ((fkey(sa + sb) & ~255u) | id) : 0u;
                }
            }
            bitonic_sort16_desc<0>(cand);
            unsigned L[16];
#pragma unroll
            for (int i = 0; i < 16; ++i) L[i] = cand[i];
            top16_merge<1>(L); top16_merge<2>(L);
            const float mx = funkey(L[0] & ~255u);
            float e[16], sum = 0.f;
#pragma unroll
            for (int k = 0; k < 16; ++k) { e[k] = __expf(funkey(L[k] & ~255u) - mx); sum += e[k]; }
            const float inv = 1.0f / sum;
            const size_t ob = (size_t)(tok0 + tok) * 128;
#pragma unroll
            for (int k4 = 0; k4 < 4; ++k4) if (sub == k4) {
#pragma unroll
                for (int q = 0; q < 4; ++q) { const unsigned cid = L[4 * k4 + q] & 255u;
                    const unsigned ia = LIST[tok * 16 + (cid >> 4)] & 127u, ib = LIST[(64 + tok) * 16 + (cid & 15u)] & 127u;
                    const int slot = h * 16 + 4 * k4 + q;
                    EID[ob + slot] = (int)(ia * 128u + ib); GW[ob + slot] = e[4 * k4 + q] * inv; }
            }
        }
        __syncthreads();
    }
#undef P9_LOAD
}

__device__ __forceinline__ void unpack8(const v4u w, float (&f)[8]) { f[0] = bflo(w.x); f[1] = bfhi(w.x); f[2] = bflo(w.y); f[3] = bfhi(w.y); f[4] = bflo(w.z); f[5] = bfhi(w.z); f[6] = bflo(w.w); f[7] = bfhi(w.w); }
typedef float f32x2 __attribute__((ext_vector_type(2)));
__device__ __forceinline__ void unpack16_fp8(const v4u w, float (&f)[16]) {
    const unsigned ww[4] = {w.x, w.y, w.z, w.w};
#pragma unroll
    for (int d = 0; d < 4; ++d) { const f32x2 a = __builtin_amdgcn_cvt_pk_f32_fp8((int)ww[d], false), b = __builtin_amdgcn_cvt_pk_f32_fp8((int)ww[d], true);
        f[4 * d] = a.x; f[4 * d + 1] = a.y; f[4 * d + 2] = b.x; f[4 * d + 3] = b.y; }
}
template <int PV_> __device__ __forceinline__ void peer_dot_phase(Frame& F) {
    const unsigned char* H8 = F.ws + WS_H8; const int* EID = (const int*)(F.ws + WS_EID); float* PART = (float*)(F.ws + WS_PART);
    const int lane = F.lane, g = lane >> 3, j = lane & 7, x = F.bid & 7;
    const int nbx = (F.G - x + 7) >> 3, NW = nbx * NWAVES, gwv = (F.bid >> 3) * NWAVES + F.wave;
    const unsigned char* US = F.ws + WS_UB + (size_t)x * NEXP * 128; const unsigned j16 = 16u * (unsigned)j;
    int token = gwv;
    if (token >= M) return;
    const int lasttok = gwv + ((M - 1 - gwv) / NW) * NW;
    v4i eA[4], eB[4]; v4i hA, hB;
#define PD_CL(t_) ((t_) < M ? (t_) : lasttok)
#define PD_LOAD_E(e_, tok_) do { _Pragma("unroll") for (int q = 0; q < 4; ++q) e_[q] = *(const GAS v4i*)(EID + (size_t)(tok_) * 128 + 16 * g + 4 * q); } while (0)
#define PD_ISSUE4(buf_, e_, b0_) do { buf_[b0_] = *(const GAS v4i*)(US + ((unsigned)e_.x * 128u + j16)); buf_[b0_ + 1] = *(const GAS v4i*)(US + ((unsigned)e_.y * 128u + j16)); \
        buf_[b0_ + 2] = *(const GAS v4i*)(US + ((unsigned)e_.z * 128u + j16)); buf_[b0_ + 3] = *(const GAS v4i*)(US + ((unsigned)e_.w * 128u + j16)); } while (0)
#define PD_DOT1(w_, hc_, dst_) do { int t = __builtin_amdgcn_sdot4(w_.x, hc_.x, 0, false); t = __builtin_amdgcn_sdot4(w_.y, hc_.y, t, false); t = __builtin_amdgcn_sdot4(w_.z, hc_.z, t, false); t = __builtin_amdgcn_sdot4(w_.w, hc_.w, t, false); \
        t += dppi<DPP_XOR1>(t); t += dppi<DPP_XOR2>(t); t += dppi<DPP_HMIR>(t); dst_ = (float)t; } while (0)
#define PD_BODY(eC, eN, hC, hN, tok_) do { const int tk_ = PD_CL(tok_); \
        PD_ISSUE4(bB, eC[2], 0); PD_ISSUE4(bB, eC[3], 4); \
        PD_LOAD_E(eC, PD_CL(tk_ + 2 * NW)); \
        hN = *(const GAS v4i*)(H8 + (size_t)PD_CL(tk_ + NW) * D + 128 * x + j16); \
        float s[16]; \
        _Pragma("unroll") for (int i = 0; i < 8; ++i) PD_DOT1(bA[i], hC, s[i]); \
        PD_ISSUE4(bA, eN[0], 0); PD_ISSUE4(bA, eN[1], 4); \
        _Pragma("unroll") for (int i = 0; i < 8; ++i) PD_DOT1(bB[i], hC, s[8 + i]); \
        { float* pp = PART + ((size_t)x * M + tk_) * 128 + g * 16;       \
          _Pragma("unroll") for (int i4 = 0; i4 < 4; ++i4) *(GAS f32x4*)(pp + 4 * i4) = (f32x4){s[4 * i4], s[4 * i4 + 1], s[4 * i4 + 2], s[4 * i4 + 3]}; } } while (0)
    PD_LOAD_E(eA, token); hA = *(const GAS v4i*)(H8 + (size_t)token * D + 128 * x + j16);
    PD_LOAD_E(eB, PD_CL(token + NW));
    v4i bA[8], bB[8];
    PD_ISSUE4(bA, eA[0], 0); PD_ISSUE4(bA, eA[1], 4);
    __builtin_amdgcn_s_waitcnt(0x0F70);
    for (; token < M; token += 2 * NW) {
        PD_BODY(eA, eB, hA, hB, token);
        PD_BODY(eB, eA, hB, hA, token + NW);
    }
#undef PD_BODY
#undef PD_CL
#undef PD_LOAD_E
#undef PD_ISSUE4
#undef PD_DOT1
}
template <int NTOK> __device__ __forceinline__ void peer_loadrate_probe(Frame& F) {
    const int* EID = (const int*)(F.ws + WS_EID);
    const int lane = F.lane, g = lane >> 3, j = lane & 7, x = F.bid & 7;
    const int nbx = (F.G - x + 7) >> 3, NW = nbx * NWAVES, gwv = (F.bid >> 3) * NWAVES + F.wave;
    const unsigned char* US = F.ws + WS_UB + (size_t)x * NEXP * 128; const unsigned j16 = 16u * (unsigned)j;
    unsigned acc = 0u;
    for (int token = gwv; token + (NTOK - 1) * NW < M; token += NTOK * NW) {
        v4i e4[NTOK][4];
#pragma unroll
        for (int t = 0; t < NTOK; ++t)
#pragma unroll
            for (int q = 0; q < 4; ++q) e4[t][q] = *(const GAS v4i*)(EID + (size_t)(token + t * NW) * 128 + 16 * g + 4 * q);
        v4i b[NTOK][16];
#pragma unroll
        for (int t = 0; t < NTOK; ++t)
#pragma unroll
            for (int q = 0; q < 4; ++q) { b[t][4 * q] = *(const GAS v4i*)(US + ((unsigned)e4[t][q].x * 128u + j16)); b[t][4 * q + 1] = *(const GAS v4i*)(US + ((unsigned)e4[t][q].y * 128u + j16));
                b[t][4 * q + 2] = *(const GAS v4i*)(US + ((unsigned)e4[t][q].z * 128u + j16)); b[t][4 * q + 3] = *(const GAS v4i*)(US + ((unsigned)e4[t][q].w * 128u + j16)); }
#pragma unroll
        for (int t = 0; t < NTOK; ++t)
#pragma unroll
            for (int i = 0; i < 16; ++i) acc ^= (unsigned)(b[t][i].x ^ b[t][i].y ^ b[t][i].z ^ b[t][i].w);
    }
    asm volatile("" :: "v"(acc));
}
__device__ __forceinline__ void peer_coef_phase(Frame& F) {
    const float* PART = (const float*)(F.ws + WS_PART); const int* EID = (const int*)(F.ws + WS_EID); const float* GW = (const float*)(F.ws + WS_GW);
    const float* SCU = (const float*)(F.ws + WS_SCLU); const float* SCV = (const float*)(F.ws + WS_SCLV); const float* HS = (const float*)(F.ws + WS_HS);
    unsigned* CF8 = (unsigned*)(F.ws + WS_CF); float* CFS = (float*)(F.ws + WS_CFS);
    const size_t gtid = (size_t)F.bid * NTHREADS + F.tid, gthreads = (size_t)F.G * NTHREADS, n4 = (size_t)M * 128 / 4;
    for (size_t i4 = gtid; i4 < n4; i4 += gthreads) {
        f32x4 d = *(const GAS f32x4*)(PART + 4 * i4);
#pragma unroll
        for (int xx = 1; xx < 8; ++xx) d = d + *(const GAS f32x4*)(PART + (size_t)xx * M * 128 + 4 * i4);
        const v4i e = *(const GAS v4i*)(EID + 4 * i4); const f32x4 gw = *(const GAS f32x4*)(GW + 4 * i4);
        const float hs = HS[i4 >> 5];
        f32x4 r; r.x = gw.x * SCV[e.x] * gelu_tanh_safe(d.x * (SCU[e.x] * hs)); r.y = gw.y * SCV[e.y] * gelu_tanh_safe(d.y * (SCU[e.y] * hs));
        r.z = gw.z * SCV[e.z] * gelu_tanh_safe(d.z * (SCU[e.z] * hs)); r.w = gw.w * SCV[e.w] * gelu_tanh_safe(d.w * (SCU[e.w] * hs));
        float m = fmaxf(fmaxf(fabsf(r.x), fabsf(r.y)), fmaxf(fabsf(r.z), fabsf(r.w)));
        m = fmaxf(m, dppf<DPP_XOR1>(m)); m = fmaxf(m, dppf<DPP_XOR2>(m)); m = fmaxf(m, dppf<DPP_HMIR>(m)); m = fmaxf(m, dppf<DPP_ROR8>(m)); m = max_xor16(m);
        const unsigned E = (__builtin_bit_cast(unsigned, m) >> 23) & 0xffu; float sc = 1.f, isc = 1.f;
        if (E >= 8u && E <= 250u) { sc = __builtin_bit_cast(float, (261u - E) << 23); isc = __builtin_bit_cast(float, (E - 7u) << 23); }
        int t = __builtin_amdgcn_cvt_pk_fp8_f32(r.x * sc, r.y * sc, 0, false); t = __builtin_amdgcn_cvt_pk_fp8_f32(r.z * sc, r.w * sc, t, true);
        CF8[i4] = (unsigned)t;
        if ((F.lane & 31) == 0) CFS[i4 >> 5] = isc; }
}
template <bool DRY, bool CHECK = false> __device__ __forceinline__ void peer_out_phase(Frame& F, const float* ada, float* out) {
    const int* EID = (const int*)(F.ws + WS_EID); const unsigned char* CF8 = (const unsigned char*)(F.ws + WS_CF); const float* CFS = (const float*)(F.ws + WS_CFS);
    const int lane = F.lane, g = lane >> 3, j = lane & 7, x = F.bid & 7;
    const int nbx = (F.G - x + 7) >> 3, NW = nbx * NWAVES, gwv = (F.bid >> 3) * NWAVES + F.wave;
    const unsigned char* VS = F.ws + WS_VB + (size_t)x * NEXP * 128; const unsigned j16 = 16u * (unsigned)j;
    if (gwv >= M) return;
    const int ntok = (M - 1 - gwv) / NW + 1;
#define PO_ISSUE4(buf_, e_, b0_) do { buf_[b0_] = *(const GAS v4u*)(VS + ((unsigned)e_.x * 128u + j16)); buf_[b0_ + 1] = *(const GAS v4u*)(VS + ((unsigned)e_.y * 128u + j16)); \
        buf_[b0_ + 2] = *(const GAS v4u*)(VS + ((unsigned)e_.z * 128u + j16)); buf_[b0_ + 3] = *(const GAS v4u*)(VS + ((unsigned)e_.w * 128u + j16)); } while (0)
#define PO_ROW(w_, c_) do { float f[16]; unpack16_fp8(w_, f); _Pragma("unroll") for (int k = 0; k < 16; ++k) o[k] += (c_) * f[k]; } while (0)
#define PO_ACC4(buf_, c4_, b0_) do { PO_ROW(buf_[b0_], c4_.x); PO_ROW(buf_[b0_ + 1], c4_.y); PO_ROW(buf_[b0_ + 2], c4_.z); PO_ROW(buf_[b0_ + 3], c4_.w); } while (0)
    v4i e4[4]; f32x4 c4[4]; v4u bA[8], bB[8];
#define PO_LOADC(tok_) do { const float cs_ = CFS[tok_]; _Pragma("unroll") for (int q = 0; q < 4; ++q) { const unsigned w_ = *(const GAS unsigned*)(CF8 + (size_t)(tok_) * 128 + g * 16 + 4 * q); \
        const f32x2 lo_ = __builtin_amdgcn_cvt_pk_f32_fp8((int)w_, false), hi_ = __builtin_amdgcn_cvt_pk_f32_fp8((int)w_, true); c4[q] = (f32x4){lo_.x * cs_, lo_.y * cs_, hi_.x * cs_, hi_.y * cs_}; } } while (0)
#pragma unroll
    for (int q = 0; q < 4; ++q) e4[q] = *(const GAS v4i*)(EID + (size_t)gwv * 128 + g * 16 + 4 * q);
    PO_LOADC(gwv);
    PO_ISSUE4(bA, e4[0], 0); PO_ISSUE4(bA, e4[1], 4);
    for (int it = 0; it < ntok; ++it) {
        const int token = gwv + it * NW, tn = gwv + (it + 1 < ntok ? it + 1 : it) * NW;
        PO_ISSUE4(bB, e4[2], 0); PO_ISSUE4(bB, e4[3], 4);
#pragma unroll
        for (int q = 0; q < 4; ++q) e4[q] = *(const GAS v4i*)(EID + (size_t)tn * 128 + g * 16 + 4 * q);
        float o[16];
#pragma unroll
        for (int k = 0; k < 16; ++k) o[k] = 0.f;
        PO_ACC4(bA, c4[0], 0); PO_ACC4(bA, c4[1], 4);
        PO_ISSUE4(bA, e4[0], 0); PO_ISSUE4(bA, e4[1], 4);
        PO_ACC4(bB, c4[2], 0); PO_ACC4(bB, c4[3], 4);
        PO_LOADC(tn);
#pragma unroll
        for (int k = 0; k < 16; ++k) { float t = o[k]; t += dppf<DPP_ROR8>(t); o[k] = sum_xor32(sum_xor16(t)); }
        if (g == 0) { const int b = token >> 12;
            const float* gt = ada + (size_t)b * 6 * D + 5 * D + 128 * x + 16 * j;
            float* xo = out + (size_t)token * D + 128 * x + 16 * j;
#pragma unroll
            for (int q = 0; q < 4; ++q) { const f32x4 xv = *(const GAS f32x4*)(xo + 4 * q), gv = *(const GAS f32x4*)(gt + 4 * q);
                f32x4 res = xv + gv * (f32x4){o[4 * q], o[4 * q + 1], o[4 * q + 2], o[4 * q + 3]};
                if (CHECK) { const f32x4 mf = *(const GAS f32x4*)((const float*)(F.ws + WS_PART) + (size_t)token * D + 128 * x + 16 * j + 4 * q);
                    const float rr[4] = {o[4 * q], o[4 * q + 1], o[4 * q + 2], o[4 * q + 3]}, mm[4] = {mf.x, mf.y, mf.z, mf.w}; bool bad = false;
#pragma unroll
                    for (int z = 0; z < 4; ++z) bad = bad || !(fabsf(rr[z] - mm[z]) <= 0.01f * fabsf(rr[z]) + 1.0e-3f);
                    if (bad) res.x = 1.0e9f; }
                if (DRY) { asm volatile("" :: "v"(res.x), "v"(res.y), "v"(res.z), "v"(res.w)); } else *(GAS f32x4*)(xo + 4 * q) = res; } }
    }
#undef PO_LOADC
#undef PO_ISSUE4
#undef PO_ROW
#undef PO_ACC4
}

constexpr int PO_TILE = 64 * 144;
template <int MODE> __device__ __forceinline__ void peer_out_mfma_phase(Frame& F, const float* ada, float* out) {
    const int* EID = (const int*)(F.ws + WS_EID); const unsigned char* CF8 = (const unsigned char*)(F.ws + WS_CF); const float* CFS = (const float*)(F.ws + WS_CFS);
    const int lane = F.lane, g = lane >> 3, j = lane & 7, l15 = lane & 15, lq = lane >> 4, x = F.bid & 7;
    const int nbx = (F.G - x + 7) >> 3, NW = nbx * NWAVES, gwv = (F.bid >> 3) * NWAVES + F.wave;
    const unsigned char* VS = F.ws + WS_VB + (size_t)x * NEXP * 128; const unsigned j16 = 16u * (unsigned)j;
    LAS unsigned char* TL = F.lds + F.wave * PO_TILE;
    if (gwv >= M) return;
    const int nst = 2 * ((M - 1 - gwv) / NW + 1);
    const int trow = l15 >> 1, tcol = 8 * (l15 & 1);
#define PM_IDS(e_, a_, tok_) do { const size_t base = (size_t)(tok_) * 128; \
        _Pragma("unroll") for (int m = 0; m < 16; ++m) e_[m] = EID[base + 8 * m + g]; \
        _Pragma("unroll") for (int q = 0; q < 4; ++q) a_[q] = *(const GAS long*)(CF8 + base + 32 * q + 8 * lq); } while (0)
#define PM_GATHER(vv_, e_, h_) do { _Pragma("unroll") for (int m = 0; m < 8; ++m) vv_[m] = *(const GAS v4u*)(VS + ((unsigned)e_[8 * (h_) + m] * 128u + j16)); } while (0)
#define PM_HALF(vv_, aq0_, aq1_) do { _Pragma("unroll") for (int m = 0; m < 8; ++m) *(LAS v4u*)(TL + (8 * m + g) * 144 + 16 * j) = vv_[m]; } while (0)
#define PM_MMA(aq0_, aq1_) do { LDS_WAIT(); asm volatile("" ::: "memory"); \
        _Pragma("unroll") for (int ks = 0; ks < 2; ++ks) _Pragma("unroll") for (int cb = 0; cb < 8; ++cb) { \
            const v2i bb = __builtin_amdgcn_ds_read_tr8_b64_v2i32((LAS v2i*)(TL + (32 * ks + 8 * lq + trow) * 144 + 16 * cb + tcol)); \
            acc[cb] = __builtin_amdgcn_mfma_f32_16x16x32_fp8_fp8(ks ? (aq1_) : (aq0_), __builtin_bit_cast(long, bb), acc[cb], 0, 0, 0); } \
        LDS_WAIT(); asm volatile("" ::: "memory"); } while (0)
    const int ntok = nst >> 1;
    int e1[16], e2[16]; long a0[4], a1[4], a2[4]; v4u vvA[8], vvB[8];
    PM_IDS(e1, a0, gwv);
    PM_GATHER(vvA, e1, 0); PM_GATHER(vvB, e1, 1);
    { const int t1 = ntok > 1 ? 1 : 0; PM_IDS(e1, a1, gwv + t1 * NW); }
    f32x4 acc[8];
    for (int it = 0; it < ntok; ++it) {
        const int token = gwv + it * NW;
        { const int t2 = it + 2 < ntok ? it + 2 : ntok - 1; PM_IDS(e2, a2, gwv + t2 * NW); }
#pragma unroll
        for (int cb = 0; cb < 8; ++cb) acc[cb] = (f32x4){0.f, 0.f, 0.f, 0.f};
        float xv[8], gv[8]; float cs;
        { const int b = token >> 12; const float* gt = ada + (size_t)b * 6 * D + 5 * D + 128 * x + l15; const float* xi = out + (size_t)token * D + 128 * x + l15;
          cs = CFS[token];
#pragma unroll
          for (int cb = 0; cb < 8; ++cb) { xv[cb] = xi[16 * cb]; gv[cb] = gt[16 * cb]; } }
        PM_HALF(vvA, 0, 0); PM_GATHER(vvA, e1, 0); PM_MMA(a0[0], a0[1]);
        PM_HALF(vvB, 0, 0); PM_GATHER(vvB, e1, 1); PM_MMA(a0[2], a0[3]);
        if (lq == 0) {
            if (MODE == 1) { float* oc = (float*)(F.ws + WS_PART) + (size_t)token * D + 128 * x + l15;
#pragma unroll
                for (int cb = 0; cb < 8; ++cb) oc[16 * cb] = acc[cb][0] * cs; }
            else { float* xo = out + (size_t)token * D + 128 * x + l15;
#pragma unroll
                for (int cb = 0; cb < 8; ++cb) xo[16 * cb] = xv[cb] + gv[cb] * (acc[cb][0] * cs); }
        }
#pragma unroll
        for (int m = 0; m < 16; ++m) e1[m] = e2[m];
#pragma unroll
        for (int q = 0; q < 4; ++q) { a0[q] = a1[q]; a1[q] = a2[q]; }
    }
#undef PM_HALF
#undef PM_MMA
#undef PM_IDS
#undef PM_GATHER
}

__device__ __forceinline__ void compress_phase(Frame& F, const float* kng) {
    LAS bf16* H2 = (LAS bf16*)(F.lds);
    LAS float* OUTS = (LAS float*)(F.lds + 16384);
    const int lane = F.lane, w = F.wave, l15 = lane & 15, lq = lane >> 4;
    for (int u = F.bid; u < NBG * 2 * 8; u += F.G) {
        const int ns = u & 7, kv = (u >> 3) & 1, bg = u >> 4, n0 = ns * 32;
        const bf16* A = (const bf16*)(F.ws + (kv ? WS_VCR : WS_KCR)) + (size_t)bg * SEQ * 64;
        const bf16* W1T = (const bf16*)(F.ws + (kv ? WS_CW1V_T : WS_CW1K_T));
        const bf16* W2T = (const bf16*)(F.ws + (kv ? WS_CW2V_T : WS_CW2K_T));
        const float* b1 = (const float*)(F.ws + (kv ? WS_CB1V : WS_CB1K));
        pg8::f32x4 acc[2];
        acc[0] = (pg8::f32x4){0.f, 0.f, 0.f, 0.f}; acc[1] = acc[0];
        const bf16* ap = A + (size_t)(n0 + l15) * 1024 + 8 * lq;
        const bf16* bp = W1T + (size_t)(16 * w + l15) * 2048 + 8 * lq;
#pragma unroll 8
        for (int ks = 0; ks < 64; ++ks) {
            const bf16x8 a0 = *(const GAS bf16x8*)(ap + 32 * ks), a1 = *(const GAS bf16x8*)(ap + 16 * 1024 + 32 * ks), b = *(const GAS bf16x8*)(bp + 32 * ks);
            acc[0] = __builtin_amdgcn_mfma_f32_16x16x32_bf16(a0, b, acc[0], 0, 0, 0);
            acc[1] = __builtin_amdgcn_mfma_f32_16x16x32_bf16(a1, b, acc[1], 0, 0, 0);
        }
        { const float bb = b1[16 * w + l15];
#pragma unroll
          for (int rb = 0; rb < 2; ++rb)
#pragma unroll
            for (int r = 0; r < 4; ++r) H2[(16 * rb + 4 * lq + r) * 136 + 16 * w + l15] = (bf16)f2bf(gelu_tanh_safe(acc[rb][r] + bb)); }
        __syncthreads();
        { const int rb = w >> 2, db = w & 3;
          pg8::f32x4 o = (pg8::f32x4){0.f, 0.f, 0.f, 0.f};
#pragma unroll
          for (int ks = 0; ks < 4; ++ks) {
              const bf16x8 a = *(const LAS bf16x8*)(H2 + (16 * rb + l15) * 136 + 32 * ks + 8 * lq);
              const bf16x8 b = *(const GAS bf16x8*)(W2T + (size_t)(16 * db + l15) * 128 + 32 * ks + 8 * lq);
              o = __builtin_amdgcn_mfma_f32_16x16x32_bf16(a, b, o, 0, 0, 0); }
#pragma unroll
          for (int r = 0; r < 4; ++r) OUTS[(16 * rb + 4 * lq + r) * 65 + 16 * db + l15] = o[r]; }
        __syncthreads();
        { const int n = F.tid >> 4, d4 = (F.tid & 15) * 4, ng = n0 + n;
          float v[4]; float ss = 0.f;
#pragma unroll
          for (int i = 0; i < 4; ++i) { v[i] = OUTS[n * 65 + d4 + i]; ss += v[i] * v[i]; }
          ss += dppf<DPP_XOR1>(ss); ss += dppf<DPP_XOR2>(ss); ss += dppf<DPP_HMIR>(ss); ss += dppf<DPP_ROR8>(ss);
          const bool pad = (ng >= NCMP);
          if (kv == 0) { const float rs = rsqrtf(ss * (1.f / 64.f) + EPS);
              v2u o; o.x = pad ? 0u : pk2(v[0] * rs * kng[d4], v[1] * rs * kng[d4 + 1]); o.y = pad ? 0u : pk2(v[2] * rs * kng[d4 + 2], v[3] * rs * kng[d4 + 3]);
              *(GAS v2u*)((bf16*)(F.ws + WS_KC) + ((size_t)bg * 256 + ng) * 64 + d4) = o; }
          else { bf16* vt = (bf16*)(F.ws + WS_VCT) + (size_t)bg * 64 * 256 + ng;
#pragma unroll
              for (int i = 0; i < 4; ++i) vt[(size_t)(d4 + i) * 256] = pad ? (bf16)0 : (bf16)f2bf(v[i]); } }
        __syncthreads();
    }
}
__device__ __forceinline__ void vtranspose_phase(Frame& F) {
    LAS bf16* T = (LAS bf16*)(F.lds + F.wave * 9216);
    const int gw = F.bid * NWAVES + F.wave, NGW = F.G * NWAVES, lane = F.lane;
    for (int job = gw; job < 2 * NBG * 64; job += NGW) {
        const int s = job & 63, bg = (job >> 6) & 15, which = job >> 10;
        const bf16* X = (const bf16*)(F.ws + (which ? WS_VW : WS_VS)) + ((size_t)bg * SEQ + 64 * s) * 64;
        bf16* XT = (bf16*)(F.ws + (which ? WS_VWT : WS_VST)) + (size_t)bg * 64 * SEQ + 64 * s;
#pragma unroll
        for (int i = 0; i < 8; ++i) { const int tok = (lane >> 3) + 8 * i, ch = lane & 7;
            const v4u x = *(const GAS v4u*)(X + (size_t)tok * 64 + 8 * ch);
            const unsigned ww[4] = {x.x, x.y, x.z, x.w};
#pragma unroll
            for (int e = 0; e < 4; ++e) { T[(8 * ch + 2 * e) * 72 + tok] = (bf16)(ww[e] & 0xffffu); T[(8 * ch + 2 * e + 1) * 72 + tok] = (bf16)(ww[e] >> 16); } }
        LDS_WAIT(); asm volatile("" ::: "memory");
#pragma unroll
        for (int i = 0; i < 8; ++i) { const int dim = (lane >> 3) + 8 * i, ch = lane & 7;
            const v4u y = *(const LAS v4u*)(T + dim * 72 + 8 * ch);
            *(GAS v4u*)(XT + (size_t)dim * SEQ + 8 * ch) = y; }
        LDS_WAIT(); asm volatile("" ::: "memory");
    }
}

constexpr int AT_KBUF = 64 * 128;
constexpr int AT_NBUF = 2;
constexpr int AT_OFF_K = 0, AT_OFF_V = AT_NBUF * AT_KBUF;
constexpr int AT_OFF_IMP1 = 2 * AT_NBUF * AT_KBUF, AT_OFF_IMP2 = AT_OFF_IMP1 + 64 * 65 * 4, AT_OFF_SEL = AT_OFF_IMP2 + 64 * 65 * 4;
constexpr int AT_OFF_LUT = AT_OFF_SEL + 512, AT_OFF_LROW = AT_OFF_LUT + 4 * 128 * 4;
constexpr int AT_OFF_TD = AT_OFF_LROW + 8 * 32 * 4;
constexpr int AT_OFF_OUT = AT_OFF_TD + 96 * 32;
constexpr int AT_OFF_GATL = AT_OFF_OUT + 256 * 144;
constexpr int AT_OFF_TS = AT_OFF_GATL + 64 * 12 * 4;
constexpr int AT_TS_ROW = 65 * 16;
constexpr int AT_LDS_END = AT_OFF_TS + 16 * AT_TS_ROW;
static_assert(AT_LDS_END <= RING_BYTES, "attention LDS");

struct AtTile { const bf16* k; const bf16* vt; int vstride; };
enum { TM_CMP1 = 0, TM_CMP2, TM_SELN, TM_SELF, TM_WINN, TM_WINF, TM_WINE, TM_CMP1F, TM_CMP2F };
__device__ __forceinline__ float fexp2(float x) { return __builtin_amdgcn_exp2f(x); }
template <int TM, int VAR, int RB = 3>
__device__ __forceinline__ void at_tile(const LAS unsigned char* kb_, const LAS unsigned char* vb_, const LAS float* LUTJ, LAS float* IMP1, LAS float* IMP2,
                                        const bf16x8 (&qf)[2][2], pg8::f32x4 (&oacc)[2][4], pg8::f32x4 (&lacc)[2], const LAS float* LINV,
                                        const int (&tok_r_in)[2], const unsigned (&selb)[2], float cfar, int relbase, int idx, int l15_in, int lq_in, const LAS unsigned char* tsw, const LAS unsigned char* tsn) {
    constexpr bool FAR = (TM == TM_SELF || TM == TM_WINF || TM == TM_WINE || TM == TM_CMP1F || TM == TM_CMP2F);
    constexpr bool C1 = (TM == TM_CMP1 || TM == TM_CMP1F), C2 = (TM == TM_CMP2 || TM == TM_CMP2F);
    int l15 = l15_in, lq = lq_in; asm volatile("" : "+v"(l15), "+v"(lq));
    int tok_r[2] = {tok_r_in[0], tok_r_in[1]}; asm volatile("" : "+v"(tok_r[0]), "+v"(tok_r[1]));
    v4u pfr[2][2];
    const LAS unsigned char* tsp[2] = {tsw, tsw};
    if (TM == TM_SELN || TM == TM_WINN) {
#pragma unroll
        for (int rb = 0; rb < 2; ++rb) { const LAS unsigned char* pa = tsw + l15 * AT_TS_ROW + 16 * (2 * lq - rb) - 4 * relbase;
            const LAS unsigned char* pn = tsn + l15 * AT_TS_ROW;
            tsp[rb] = (TM == TM_SELN && !selb[rb]) ? pn : pa; } }
    auto kld = [&](int cb, bf16x8 (&kf)[2], pg8::f32x4 (&cq)[2]) __attribute__((always_inline)) {
        if (TM == TM_SELN || TM == TM_WINN) {
#pragma unroll
            for (int rb = 0; rb < 2; ++rb) cq[rb] = *(const LAS pg8::f32x4*)(tsp[rb] + 16 * (8 * (cb >> 1) + (cb & 1))); }
        if (!(VAR & 64)) {
        const int krow = 8 * (l15 >> 2) + (l15 & 3) + 32 * (cb >> 1) + 4 * (cb & 1), kf_ = ((l15 >> 2) << 1) | ((l15 >> 1) & 1);
#pragma unroll
        for (int ks = 0; ks < 2; ++ks) kf[ks] = *(const LAS bf16x8*)(kb_ + krow * 128 + 16 * ((4 * ks + lq) ^ kf_)); }
    };
    auto qkm = [&](int cb, const bf16x8 (&kf)[2], const pg8::f32x4 (&cq)[2], pg8::f32x4 (&st)[2]) __attribute__((always_inline)) {
        st[0] = FAR ? (pg8::f32x4){cfar, cfar, cfar, cfar} : (pg8::f32x4){0.f, 0.f, 0.f, 0.f}; st[1] = st[0];
        if (TM == TM_SELN || TM == TM_WINN) { st[0] = cq[0]; st[1] = cq[1]; }
        if (TM == TM_SELF) {
#pragma unroll
            for (int rb = 0; rb < 2; ++rb) { const float ci = selb[rb] ? cfar : -1.0e30f; st[rb] = (pg8::f32x4){ci, ci, ci, ci}; } }
        if (!(VAR & 64)) {
#pragma unroll
        for (int ks = 0; ks < 2; ++ks) {
#pragma unroll
            for (int rb = 0; rb < 2; ++rb) if (RB & (1 << rb)) st[rb] = __builtin_amdgcn_mfma_f32_16x16x32_bf16(kf[ks], qf[rb][ks], st[rb], 0, 0, 0); } }
    };
    float linv_[2] = {0.f, 0.f};
    if (C2) { linv_[0] = LINV[l15]; linv_[1] = LINV[16 + l15]; }
    auto prob = [&](int cb, const pg8::f32x4 (&st)[2]) __attribute__((always_inline)) {
#pragma unroll
        for (int rb = 0; rb < 2; ++rb) if (RB & (1 << rb)) {
            const int tokc = tok_r[rb];
            float p[4];
#pragma unroll
            for (int r = 0; r < 4; ++r) {
                const int kl = 32 * (cb >> 1) + 8 * lq + 4 * (cb & 1) + r;
                if (VAR & 16) { p[r] = st[rb][r]; }
                else if (TM == TM_SELF) { p[r] = fexp2(st[rb][r]); }
                else if (TM == TM_WINF || TM == TM_SELN || TM == TM_WINN || TM == TM_CMP1F || TM == TM_CMP2F) { p[r] = fexp2(st[rb][r]); }
                else if (TM == TM_WINE) { const float e = fexp2(st[rb][r]); p[r] = (kl > tokc) ? e : 0.f; }
                else {
                    const int rel = (TM == TM_CMP1 || TM == TM_CMP2) ? (relbase + tokc - 16 * kl) : (relbase + tokc - kl);
                    const bool valid = rel >= 0;
                    const int ri = rel < 0 ? 0 : (rel > 127 ? 127 : rel);
                    const float e = fexp2(st[rb][r] + LUTJ[ri]);
                    p[r] = valid ? e : 0.f; }
            }
            if (C1) { lacc[rb][0] += (p[0] + p[1]) + (p[2] + p[3]); }
            else {
                if (C2) {
#pragma unroll
                    for (int r = 0; r < 4; ++r) p[r] *= linv_[rb];
                    float h0 = p[0], h1 = p[1], h2 = p[2], h3 = p[3];
                    h0 += dppf<DPP_XOR1>(h0); h1 += dppf<DPP_XOR1>(h1); h2 += dppf<DPP_XOR1>(h2); h3 += dppf<DPP_XOR1>(h3);
                    h0 += dppf<DPP_XOR2>(h0); h1 += dppf<DPP_XOR2>(h1); h2 += dppf<DPP_XOR2>(h2); h3 += dppf<DPP_XOR2>(h3);
                    if ((l15 & 3) == 0) { const int sp = 16 * idx + 8 * (cb >> 1) + 2 * lq + (cb & 1);
                        IMP1[tokc * 65 + sp] = (h0 + h1) + (h2 + 0.5f * h3);
                        if (sp + 1 < 64) IMP2[tokc * 65 + sp + 1] = 0.5f * h3; }
                }
                const unsigned lo = pkh(p[0], p[1]), hi = pkh(p[2], p[3]);
                if (cb & 1) { pfr[rb][cb >> 1].z = lo; pfr[rb][cb >> 1].w = hi; } else { pfr[rb][cb >> 1].x = lo; pfr[rb][cb >> 1].y = hi; } }
        }
    };
    auto vld = [&](int ks, v4u (&vv)[4]) __attribute__((always_inline)) {
        if (!C1 && !(VAR & 8)) {
#pragma unroll
            for (int db = 0; db < 4; ++db) vv[db] = *(const LAS v4u*)(vb_ + (16 * db + l15) * 128 + 16 * ((4 * ks + lq) ^ (l15 >> 1))); }
    };
    auto pvm = [&](int ks, const v4u (&vv)[4]) __attribute__((always_inline)) {
        if (!C1 && !(VAR & 8)) {
#pragma unroll
            for (int db = 0; db < 4; ++db) {
#pragma unroll
                for (int rb = 0; rb < 2; ++rb) if (RB & (1 << rb)) oacc[rb][db] = __builtin_amdgcn_mfma_f32_16x16x32_bf16(__builtin_bit_cast(bf16x8, pfr[rb][ks]), __builtin_bit_cast(bf16x8, vv[db]), oacc[rb][db], 0, 0, 0); }
            if (!C2) { const v4u ones = (v4u){0x3F803F80u, 0x3F803F80u, 0x3F803F80u, 0x3F803F80u};
#pragma unroll
                for (int rb = 0; rb < 2; ++rb) if (RB & (1 << rb)) lacc[rb] = __builtin_amdgcn_mfma_f32_16x16x32_bf16(__builtin_bit_cast(bf16x8, pfr[rb][ks]), __builtin_bit_cast(bf16x8, ones), lacc[rb], 0, 0, 0); }
        }
    };
    pg8::f32x4 sA[2], sB[2], cA[2], cB[2]; bf16x8 kA[2], kB[2]; v4u vA[4], vB[4];
#define AT_SB __builtin_amdgcn_sched_barrier(0)
    kld(0, kA, cA); kld(1, kB, cB); AT_SB;
    qkm(0, kA, cA, sA); kld(2, kA, cA); AT_SB;
    qkm(1, kB, cB, sB); kld(3, kB, cB); prob(0, sA); AT_SB;
    qkm(2, kA, cA, sA); vld(0, vA); prob(1, sB); AT_SB;
    qkm(3, kB, cB, sB); pvm(0, vA); vld(1, vB); prob(2, sA); AT_SB;
    prob(3, sB); AT_SB;
    pvm(1, vB);
#undef AT_SB
}

template <int VAR> __device__ __forceinline__ void attention_phase(Frame& F, const Args& args) {
    unsigned char* ws = F.ws;
    const int lane = F.lane, w = F.wave, l15 = lane & 15, lq = lane >> 4, tid = F.tid;
    LAS unsigned char* L = F.lds;
    LAS float* IMP1 = (LAS float*)(L + AT_OFF_IMP1); LAS float* IMP2 = (LAS float*)(L + AT_OFF_IMP2);
    LAS unsigned long long* SELM = (LAS unsigned long long*)(L + AT_OFF_SEL); LAS float* LUT = (LAS float*)(L + AT_OFF_LUT); LAS float* LROW = (LAS float*)(L + AT_OFF_LROW) + w * 32;
    LAS int* TD = (LAS int*)(L + AT_OFF_TD); LAS bf16* OUTL = (LAS bf16*)(L + AT_OFF_OUT) + (32 * w) * 72; LAS float* GATL = (LAS float*)(L + AT_OFF_GATL);
    const bf16* Qg = (const bf16*)(ws + WS_Q); const float* GATE = (const float*)(ws + WS_GATE); bf16* YA = (bf16*)(ws + WS_YA); float* YAF = (float*)(ws + WS_H);
    const int jq = l15 & 3;
    const LAS float* LUTJ = LUT + jq * 128;
    const int nrounds = (F.G == 256) ? 4 : (1024 + F.G - 1) / F.G;
    for (int round = 0; round < nrounds; ++round) {
        const int ui = (F.G == 256) ? ((round & 1) ? ((round >> 1) * 512 + 511 - F.bid) : ((round >> 1) * 512 + F.bid)) : (round * F.G + F.bid);
        if (ui >= 1024) break;
        const int c = 63 - (ui >> 4), bg = ui & 15, b = bg >> 1, g = bg & 1;
        const int m0 = b * SEQ + 64 * c;
        __syncthreads();
        { const float M0 = ((const float*)(ws + WS_BIASL))[8 * 128];
          for (int i = tid; i < 512; i += NTHREADS) LUT[i] = (((const float*)(ws + WS_BIASL))[(4 * g + (i >> 7)) * 128 + (i & 127)] - M0) * 1.4426950408889634f; }
        for (int i = tid; i < 64 * 65; i += NTHREADS) { IMP1[i] = 0.f; IMP2[i] = 0.f; }
        { const float M0 = ((const float*)(ws + WS_BIASL))[8 * 128]; const float* BL = (const float*)(ws + WS_BIASL) + (size_t)(4 * g) * 128;
          for (int i = tid; i < 16 * 63 * 4; i += NTHREADS) { const int r = i & 3, yi = (i >> 2) % 63, row = i / 252, rel = 4 * (47 - yi) + (row >> 2) - r;
              ((LAS float*)(L + AT_OFF_TS + row * AT_TS_ROW))[4 * yi + r] = rel < 0 ? -1.0e30f : (BL[(row & 3) * 128 + (rel > 127 ? 127 : rel)] - M0) * 1.4426950408889634f; } }
        for (int i = tid; i < 64 * 12; i += NTHREADS) GATL[i] = GATE[(size_t)(m0 + i / 12) * 24 + g * 12 + (i % 12)];
        bf16x8 qf[2][2];
#pragma unroll
        for (int rb = 0; rb < 2; ++rb)
#pragma unroll
            for (int ks = 0; ks < 2; ++ks) qf[rb][ks] = *(const GAS bf16x8*)(Qg + (size_t)(m0 + 8 * w + 4 * rb + (l15 >> 2)) * 512 + g * 256 + jq * 64 + 32 * ks + 8 * lq);
        asm volatile("" :: "v"(qf[0][0]), "v"(qf[0][1]), "v"(qf[1][0]), "v"(qf[1][1]));
        const int ncmp = 4 * c + 3, n1 = (ncmp + 63) >> 6, nsel = c + 1, w0 = c >= 8 ? c - 8 : 0, nwin = c - w0 + 1;
        const int ntiles = 2 * n1 + nsel + nwin;
        if (tid < ntiles) { const int i = tid;
            auto kindof = [&](int t, int& kind, int& idx) { if (t < n1) { kind = 0; idx = t; } else if (t < 2 * n1) { kind = 1; idx = t - n1; } else if (t < 2 * n1 + nsel) { kind = 2; idx = t - 2 * n1; } else { kind = 3; idx = w0 + (t - 2 * n1 - nsel); } };
            int kind, idx, kn, in_; kindof(i, kind, idx); kindof(i + 1 < ntiles ? i + 1 : i, kn, in_);
            unsigned ko, vo;
            if (kn < 2) { ko = (unsigned)(WS_KC + ((size_t)bg * 256 * 64 + (size_t)in_ * 4096) * 2); vo = (unsigned)(WS_VCT + ((size_t)bg * 64 * 256 + 64 * in_) * 2); }
            else if (kn == 2) { ko = (unsigned)(WS_KS + ((size_t)bg * SEQ * 64 + (size_t)in_ * 4096) * 2); vo = (unsigned)(WS_VST + ((size_t)bg * 64 * SEQ + 64 * in_) * 2); }
            else { ko = (unsigned)(WS_KW + ((size_t)bg * SEQ * 64 + (size_t)in_ * 4096) * 2); vo = (unsigned)(WS_VWT + ((size_t)bg * 64 * SEQ + 64 * in_) * 2); }
            const int dd = c - idx;
            int mode, relbase;
            if (kind == 0) { relbase = 64 * c - 31 - 1024 * idx; mode = relbase >= 1135 ? TM_CMP1F : TM_CMP1; } else if (kind == 1) { relbase = 64 * c - 31 - 1024 * idx; mode = relbase >= 1135 ? TM_CMP2F : TM_CMP2; }
            else if (kind == 2) { mode = dd <= 2 ? TM_SELN : TM_SELF; relbase = 64 * dd; } else { mode = dd <= 2 ? TM_WINN : (dd == 8 ? TM_WINE : TM_WINF); relbase = 64 * dd; }
            const int endf = ((kind == 1 && idx == n1 - 1) || (kind == 2 && idx == nsel - 1) || (kind == 3 && idx == c)) ? kind : 0;
            v4i e; e.x = mode | (idx << 8) | (endf << 16) | ((kind == 2 && idx == 0) ? (1 << 24) : 0) | (kn >= 2 ? (1 << 25) : 0); e.y = relbase; e.z = (int)ko; e.w = (int)vo;
            *(LAS v4i*)(TD + 4 * i) = e; }
        const int drow = 8 * w + (lane >> 3), dsrck = 16 * ((lane & 7) ^ (((w & 3) << 1) | ((lane >> 4) & 1))), dsrcv = 16 * ((lane & 7) ^ ((4 * (w & 1)) | (lane >> 4)));
#define AT_DMA(tile_, ko_, vo_, vs_) do { const int nb_ = (tile_) % AT_NBUF; \
        __builtin_amdgcn_global_load_lds((const GAS unsigned*)(ws + (size_t)((ko_) + drow * 128 + dsrck)), (LAS unsigned*)(L + AT_OFF_K + nb_ * AT_KBUF + w * 1024), 16, 0, 0); \
        __builtin_amdgcn_global_load_lds((const GAS unsigned*)(ws + (size_t)((vo_) + drow * (vs_) + dsrcv)), (LAS unsigned*)(L + AT_OFF_V + nb_ * AT_KBUF + w * 1024), 16, 0, 0); } while (0)
        __syncthreads();
        if (!(VAR & 2)) { AT_DMA(0, (unsigned)(WS_KC + (size_t)bg * 256 * 64 * 2), (unsigned)(WS_VCT + (size_t)bg * 64 * 256 * 2), 512u); }
        int d0, d1, d2, d3;
        { const v4i e = *(const LAS v4i*)TD; d0 = __builtin_amdgcn_readfirstlane(e.x); d1 = __builtin_amdgcn_readfirstlane(e.y); d2 = __builtin_amdgcn_readfirstlane(e.z); d3 = __builtin_amdgcn_readfirstlane(e.w); }
        pg8::f32x4 oacc[2][4];
        pg8::f32x4 lacc[2] = {(pg8::f32x4){0.f, 0.f, 0.f, 0.f}, (pg8::f32x4){0.f, 0.f, 0.f, 0.f}};
#pragma unroll
        for (int rb = 0; rb < 2; ++rb)
#pragma unroll
            for (int db = 0; db < 4; ++db) oacc[rb][db] = (pg8::f32x4){0.f, 0.f, 0.f, 0.f};
        const int tok_r[2] = {8 * w + (l15 >> 2), 8 * w + 4 + (l15 >> 2)};
        const LAS unsigned char* tsw = L + AT_OFF_TS + 16 * (47 - 2 * w); const LAS unsigned char* tsn = L + AT_OFF_TS + 16 * 48;
        for (int it = 0; it < ((VAR & 32) ? 0 : ntiles); ++it) {
            if (!(VAR & 512)) { asm volatile("s_waitcnt vmcnt(0)" ::: "memory");
            asm volatile("s_waitcnt lgkmcnt(0)" ::: "memory"); __builtin_amdgcn_s_barrier(); asm volatile("" ::: "memory"); }
            if (!(VAR & 2) && it + 1 < ntiles) AT_DMA(it + 1, (unsigned)d2, (unsigned)d3, ((d0 >> 25) & 1) ? 2u * SEQ : 512u);
            v4i tdn;
            { const LAS int* tn_ = TD + 4 * (it + 1); asm volatile("ds_read_b128 %0, %1" : "=v"(tdn) : "v"(tn_) : "memory"); }
            {
            const int mode = d0 & 255, idx = (d0 >> 8) & 255, relbase = d1, endf = (d0 >> 16) & 3, selfirst = (d0 >> 24) & 1;
            const int buf = it % AT_NBUF;
            if (selfirst) {
                { const int tok = 8 * w + (lane >> 3), s0 = 8 * (lane & 7);
                  unsigned key[8]; int rank[8];
#pragma unroll
                  for (int q = 0; q < 8; ++q) { const int sB = s0 + q; const bool vis = sB <= c, forced = (sB == 0) || (sB == c) || (sB == c - 1);
                      const float sc = vis ? (IMP1[tok * 65 + sB] + IMP2[tok * 65 + sB] + (forced ? 1000.f : 0.f)) : -1.f;
                      const unsigned u = __builtin_bit_cast(unsigned, sc); const unsigned fk = (u >> 31) ? ~u : (u | 0x80000000u);
                      key[q] = (fk & ~63u) | (unsigned)(63 - sB); rank[q] = 0; }
                  LAS unsigned* KEYS = (LAS unsigned*)IMP1;
#pragma unroll
                  for (int q = 0; q < 8; ++q) KEYS[tok * 65 + s0 + q] = key[q];
                  if (c >= 16 && !(VAR & 128)) {
#pragma unroll 8
                      for (int s2 = 0; s2 < 64; ++s2) { const unsigned k2 = KEYS[tok * 65 + s2];
#pragma unroll
                          for (int q = 0; q < 8; ++q) rank[q] += (k2 > key[q]) ? 1 : 0; } }
                  unsigned byte = 0u;
#pragma unroll
                  for (int q = 0; q < 8; ++q) byte |= ((rank[q] < 16 && (s0 + q) <= c) ? 1u : 0u) << q;
                  ((LAS unsigned char*)SELM)[tok * 8 + (lane & 7)] = (unsigned char)byte; }
            }
            const LAS unsigned char* kb_ = L + AT_OFF_K + buf * AT_KBUF; const LAS unsigned char* vb_ = L + AT_OFF_V + buf * AT_KBUF;
            const float cfar = LUTJ[127];
            unsigned selb[2] = {1u, 1u};
#define AT_CALL(TMX) at_tile<TMX, VAR>(kb_, vb_, LUTJ, IMP1, IMP2, qf, oacc, lacc, LROW, tok_r, selb, cfar, relbase, idx, l15, lq, tsw, tsn)
            if (mode == TM_SELF || mode == TM_SELN) { selb[0] = (unsigned)(SELM[tok_r[0]] >> idx) & 1u; selb[1] = (unsigned)(SELM[tok_r[1]] >> idx) & 1u; }
            if (mode == TM_SELF) {
                const bool a0 = __ballot(selb[0] != 0u) != 0ull, a1 = __ballot(selb[1] != 0u) != 0ull;
                if (a0 && a1) AT_CALL(TM_SELF);
                else if (a0) at_tile<TM_SELF, VAR, 1>(kb_, vb_, LUTJ, IMP1, IMP2, qf, oacc, lacc, LROW, tok_r, selb, cfar, relbase, idx, l15, lq, tsw, tsn);
                else if (a1) at_tile<TM_SELF, VAR, 2>(kb_, vb_, LUTJ, IMP1, IMP2, qf, oacc, lacc, LROW, tok_r, selb, cfar, relbase, idx, l15, lq, tsw, tsn); }
            else if (mode == TM_WINF) AT_CALL(TM_WINF);
            else if (mode == TM_SELN) AT_CALL(TM_SELN);
            else if (mode == TM_WINN) AT_CALL(TM_WINN);
            else if (mode == TM_WINE) AT_CALL(TM_WINE);
            else if (mode == TM_CMP2) AT_CALL(TM_CMP2);
            else if (mode == TM_CMP2F) AT_CALL(TM_CMP2F);
            else if (mode == TM_CMP1F) AT_CALL(TM_CMP1F);
            else { AT_CALL(TM_CMP1);
                if (idx == n1 - 1) {
#pragma unroll
                    for (int rb = 0; rb < 2; ++rb) { const float s = sum_xor32(sum_xor16(lacc[rb][0])); if (lq == 0) LROW[16 * rb + l15] = s > 0.f ? 1.0f / s : 0.f; lacc[rb] = (pg8::f32x4){0.f, 0.f, 0.f, 0.f}; } } }
#undef AT_CALL
            {
                if (endf && !(VAR & 256)) {
                    const int br = endf - 1;
#pragma unroll
                    for (int rb = 0; rb < 2; ++rb)
#pragma unroll
                        for (int r = 0; r < 4; ++r) { const int qrow = 16 * rb + 4 * lq + r;
                            const float ls_ = lacc[rb][r]; lacc[rb][r] = 0.f;
                            const float gt = GATL[(8 * w + 4 * rb + lq) * 12 + r * 3 + br] * (endf == 1 ? 1.0f : (ls_ > 0.f ? 1.0f / ls_ : 0.f));
#pragma unroll
                            for (int db = 0; db < 4; ++db) { float v = gt * oacc[rb][db][r]; oacc[rb][db][r] = 0.f;
                                LAS bf16* po = OUTL + qrow * 72 + 16 * db + l15;
                                if (br > 0) v += __builtin_bit_cast(float, (unsigned)(*po) << 16);
                                *po = (bf16)f2bf(v); } }
                    if (br == 2 && !(VAR & 1)) {
                        LDS_WAIT(); asm volatile("" ::: "memory");
#pragma unroll
                        for (int i = 0; i < 4; ++i) { const int ch = i * 64 + lane, row = ch >> 3, c16 = ch & 7;
                            const v4u o = *(const LAS v4u*)((const LAS unsigned char*)OUTL + row * 144 + 16 * c16);
                            *(GAS v4u*)(YA + (size_t)(m0 + 8 * w + (row >> 2)) * 512 + g * 256 + (row & 3) * 64 + 8 * c16) = o; }
                    }
                }
            }
            }
            asm volatile("s_waitcnt lgkmcnt(0)" : "+v"(tdn) :: "memory");
            d0 = __builtin_amdgcn_readfirstlane(tdn.x); d1 = __builtin_amdgcn_readfirstlane(tdn.y); d2 = __builtin_amdgcn_readfirstlane(tdn.z); d3 = __builtin_amdgcn_readfirstlane(tdn.w);
        }
#undef AT_DMA
    }
}

constexpr int N_PHASES = 13;
#ifndef MK_ONE_LAUNCH
#define MK_ONE_LAUNCH 1
#endif
#ifndef REP_P0
#define REP_P0 1
#endif
#ifndef REP_P1
#define REP_P1 1
#endif
#ifndef REP_P2
#define REP_P2 1
#endif
#ifndef REP_P3
#define REP_P3 1
#endif
#ifndef REP_P5
#define REP_P5 1
#endif
#ifndef REP_P6
#define REP_P6 1
#endif
#ifndef REP_P8
#define REP_P8 1
#endif
#ifndef REP_P7
#define REP_P7 1
#endif
#ifndef REP_P11
#define REP_P11 1
#endif
#ifndef REP_P4
#define REP_P4 1
#endif
#ifndef REP_P9
#define REP_P9 1
#endif
#ifndef REP_P10
#define REP_P10 1
#endif
#ifndef MK_BUILD
#define MK_BUILD 0
#endif

#ifndef STAG_P2
#define STAG_P2 0
#endif
__device__ __forceinline__ void phase_stagger(const Frame& F, int step_ns) {
    const int grp = (F.bid >> 3) & 7;
    if (step_ns > 0 && grp > 0) { const unsigned long long t0 = wall_clock64(), dt = (unsigned long long)(grp * step_ns) / 10ull;
        while (wall_clock64() - t0 < dt) __builtin_amdgcn_s_sleep(8); }
}
struct EpiNull {
    static constexpr bool PERM = true, AFTER_DRAIN = false;
    __device__ __forceinline__ void operator()(const pg8::f32x4 (&acc)[2][2][4][2], const pg8::Unit& u, int wr, int wc, int fr, int fq) const {
#pragma unroll
        for (int ai = 0; ai < 2; ++ai)
#pragma unroll
            for (int bj = 0; bj < 2; ++bj)
#pragma unroll
                for (int m = 0; m < 4; ++m) { asm volatile("" :: "v"(acc[ai][bj][m][0]), "v"(acc[ai][bj][m][1])); }
    }
};
__global__ void __launch_bounds__(NTHREADS, 2) fwd_kernel(Args args) {
    extern __shared__ __attribute__((aligned(16))) unsigned char lds[];
    Frame F;
    F.lds = (LAS unsigned char*)lds;
    F.MISC = (volatile LAS unsigned*)(F.lds + MISC_OFF);
    F.tid = threadIdx.x; F.lane = F.tid & 63; F.wave = __builtin_amdgcn_readfirstlane(F.tid >> 6);
    F.G = gridDim.x; F.bid = blockIdx.x; F.ws = args.ws;
    F.ctl = (gu32*)(args.ws + WS_CTL);
    for (int u = F.tid; u < (LDS_BYTES - LDSCTL_OFF) / 4; u += NTHREADS) ((LAS unsigned*)(F.lds + LDSCTL_OFF))[u] = 0u;
    __syncthreads();
    XcdBarrier bar; bar.bar = (unsigned*)(F.ctl + CW_BAR); bar.x = 0; bar.st = nullptr;
    if (MK_ONE_LAUNCH) bar = xcd_barrier_post((unsigned*)(F.ctl + CW_BAR), F.MISC + 8);
    const int lo = args.ph_lo, hi = args.ph_hi;
#define IN(k) (lo <= (k) && (k) < hi)
#define SEAM(k) do { if (IN(k) && IN((k) + 1)) xcd_barrier(bar); } while (0)
    unsigned char* ws = args.ws;
    const float* ada = (const float*)(ws + WS_ADA);

    if (IN(0)) { for (int rep = 0; rep < REP_P0; ++rep) { p0_prologue(F, args, rep == REP_P0 - 1); __syncthreads(); } } SEAM(0);
    if (IN(1)) { for (int rep = 0; rep < REP_P1; ++rep) modnorm_rows<false>(F, args.in[I_X], args.in[I_N1G], ada, 0, (bf16*)(ws + WS_H)); } SEAM(1);
    if (IN(2)) { {
        phase_stagger(F, STAG_P2);
        pg8::Gemm g{(const bf16*)(ws + WS_H), (const bf16*)(ws + WS_WIN_T), M, NIN, D, D, D}; pg8::StaticOrder S; S.init(M, NIN, F.G, F.bid);
        if (F.tid == 0) F.MISC[40] = 0xffffffffu; __syncthreads();
        EpiIn E{ws, args.in[I_QNG], args.in[I_KNG], F.MISC + 40};
#if defined(PROBE_P2) && PROBE_P2 == 1
        { EpiNull EN; pg8::gemm_phase<EpiNull, pg8::StaticOrder, true, true>(F.lds + RING_OFF, g, S, EN); __syncthreads(); }
#elif defined(PROBE_P2) && PROBE_P2 == 2
        { if (F.tid == 0) F.MISC[40] = 0u; __syncthreads(); pg8::gemm_phase<EpiIn, pg8::StaticOrder, true, true>(F.lds + RING_OFF, g, S, E); __syncthreads(); if (F.tid == 0) F.MISC[40] = 0xffffffffu; __syncthreads(); }
#endif
        pg8::gemm_phase<EpiIn, pg8::StaticOrder, true, true>(F.lds + RING_OFF, g, S, E);
#if REP_P2 > 1
        __syncthreads(); pg8::gemm_phase<EpiIn, pg8::StaticOrder, true, true>(F.lds + RING_OFF, g, S, E);
#endif
        }
    } SEAM(2);
    if (IN(3)) { for (int rep = 0; rep < REP_P3; ++rep) { __syncthreads(); pool_phase(F); __syncthreads(); compress_phase(F, args.in[I_KNG]); __syncthreads(); vtranspose_phase(F); } } SEAM(3);
    if (IN(4)) {
#ifdef PROBE_P4
        attention_phase<PROBE_P4>(F, args); __syncthreads();
#endif
        for (int rep = 0; rep < REP_P4; ++rep) { attention_phase<0>(F, args); __syncthreads(); } } SEAM(4);
    if (IN(5)) { {
        { pg8::Gemm g{(const bf16*)(ws + WS_PL), (const bf16*)(ws + WS_WEFF_T), M, D, POOLW, POOLW, POOLW}; pg8::StaticOrder S; S.init(M, D, F.G, F.bid);
          EpiMix<false> E{(bf16*)(ws + WS_MIX), (const bf16*)(ws + WS_GM), 0};
          pg8::gemm_phase<EpiMix<false>, pg8::StaticOrder, true, true>(F.lds + RING_OFF, g, S, E); }
        { pg8::Gemm g{(const bf16*)(ws + WS_YA), (const bf16*)(ws + WS_WBA_T), M, D, QW, QW, QW}; pg8::StaticOrder S; S.init(M, D, F.G, F.bid);
          EpiMix<true> E{(bf16*)(ws + WS_MIX), (const bf16*)(ws + WS_GM), 1024};
          pg8::gemm_phase<EpiMix<true>, pg8::StaticOrder, true, true>(F.lds + RING_OFF, g, S, E); } }
#if REP_P5 > 1
        { __syncthreads(); { pg8::Gemm g{(const bf16*)(ws + WS_PL), (const bf16*)(ws + WS_WEFF_T), M, D, POOLW, POOLW, POOLW}; pg8::StaticOrder S; S.init(M, D, F.G, F.bid);
          EpiMix<false> E{(bf16*)(ws + WS_MIX), (const bf16*)(ws + WS_GM), 0};
          pg8::gemm_phase<EpiMix<false>, pg8::StaticOrder, true, true>(F.lds + RING_OFF, g, S, E); }
        { pg8::Gemm g{(const bf16*)(ws + WS_YA), (const bf16*)(ws + WS_WBA_T), M, D, QW, QW, QW}; pg8::StaticOrder S; S.init(M, D, F.G, F.bid);
          EpiMix<true> E{(bf16*)(ws + WS_MIX), (const bf16*)(ws + WS_GM), 1024};
          pg8::gemm_phase<EpiMix<true>, pg8::StaticOrder, true, true>(F.lds + RING_OFF, g, S, E); } }
#endif
    } SEAM(5);
    if (IN(6)) { {
        pg8::Gemm g{(const bf16*)(ws + WS_MIX), (const bf16*)(ws + WS_WOUT_T), M, D, D, D, D}; pg8::StaticOrder S; S.init(M, D, F.G, F.bid);
        EpiRes E{args.in[I_X], args.out, ada, 2};
        pg8::gemm_phase<EpiRes, pg8::StaticOrder, true, true>(F.lds + RING_OFF, g, S, E);
#if REP_P6 > 1
        __syncthreads(); pg8::gemm_phase<EpiRes, pg8::StaticOrder, true, true>(F.lds + RING_OFF, g, S, E);
#endif
        }
    } SEAM(6);
    if (IN(7)) { for (int rep = 0; rep < REP_P7; ++rep) modnorm_rows<true>(F, args.out, args.in[I_N2G], ada, 3, (bf16*)(ws + WS_H)); } SEAM(7);
    if (IN(8)) { {
        pg8::Gemm g{(const bf16*)(ws + WS_H), (const bf16*)(ws + WS_WQ_T), M, PQW, D, D, D}; pg8::StaticOrder S; S.init(M, PQW, F.G, F.bid);
        EpiStoreBf16 E{(bf16*)(ws + WS_QV), PQW};
        pg8::gemm_phase<EpiStoreBf16, pg8::StaticOrder, true, true>(F.lds + RING_OFF, g, S, E);
#if REP_P8 > 1
        __syncthreads(); pg8::gemm_phase<EpiStoreBf16, pg8::StaticOrder, true, true>(F.lds + RING_OFF, g, S, E);
#endif
        }
    } SEAM(8);
    if (IN(9)) { for (int rep = 0; rep < REP_P9; ++rep) peer_select_phase(F); } SEAM(9);
#ifdef PROBE_XCD
    if (IN(10)) { if (F.tid == 0) __hip_atomic_store((unsigned*)(F.ctl + 2048 + F.bid), 100u + xb_xcc_id(), RLX_AGENT); }
#endif
    if (IN(10)) {
#ifdef PROBE_DOT
        peer_dot_phase<PROBE_DOT>(F); __syncthreads();
#endif
#ifdef PROBE_LOADRATE
        peer_loadrate_probe<PROBE_LOADRATE>(F); __syncthreads();
#endif
        peer_dot_phase<0>(F); } SEAM(10);
    if (IN(11)) { for (int rep = 0; rep < REP_P11; ++rep) peer_coef_phase(F); } SEAM(11);
#ifdef PROBE_XCD
    if (IN(12) && F.bid == 0 && F.tid == 0) { bool ok = true; for (int i = 0; i < F.G; ++i) { const unsigned a = __hip_atomic_load((unsigned*)(F.ctl + 2048 + i), RLX_AGENT), b0 = __hip_atomic_load((unsigned*)(F.ctl + 2048 + (i & 7)), RLX_AGENT); if (a != b0 || a < 100u) ok = false; }
        for (int i = 0; i < 8; ++i) for (int q = 0; q < i; ++q) if (__hip_atomic_load((unsigned*)(F.ctl + 2048 + i), RLX_AGENT) == __hip_atomic_load((unsigned*)(F.ctl + 2048 + q), RLX_AGENT)) ok = false;
        if (!ok) args.out[12345] = 1.0e9f; }
    __syncthreads();
#endif
    if (IN(12)) {
#if defined(CHECK_OUT_MFMA)
        peer_out_mfma_phase<1>(F, ada, args.out); __syncthreads(); VM_WAIT(); __syncthreads(); peer_out_phase<false, true>(F, ada, args.out);
#elif defined(OUT_VALU)
        for (int rep = 1; rep < REP_P10; ++rep) peer_out_phase<true>(F, ada, args.out); peer_out_phase<false>(F, ada, args.out);
#else
#ifdef PROBE_OUT
        peer_out_mfma_phase<1>(F, ada, args.out); __syncthreads();
#endif
        peer_out_mfma_phase<0>(F, ada, args.out);
#endif
    }
#undef IN
#undef SEAM
}

extern "C" void kernel_launch(void* const* d_in, const int* in_sizes, int n_in, void* d_out, int out_size, void* d_ws, size_t ws_size, hipStream_t stream) {
    static int grid = 0;
    if (grid == 0) {
        if (n_in != N_IN || in_sizes[0] != M * D || out_size != M * D || ws_size < WS_END) {
            fprintf(stderr, "kernel_launch: unexpected shapes: n_in %d in0 %d out %d ws %zu (need %zu)\n", n_in, n_in > 0 ? in_sizes[0] : -1, out_size, ws_size, (size_t)WS_END); grid = -1; return; }
        int dev = 0, cus = 0, per_cu = 0;
        if (hipGetDevice(&dev) != hipSuccess || hipDeviceGetAttribute(&cus, hipDeviceAttributeMultiprocessorCount, dev) != hipSuccess) { grid = -1; return; }
        if (hipFuncSetAttribute((const void*)fwd_kernel, hipFuncAttributeMaxDynamicSharedMemorySize, LDS_BYTES) != hipSuccess) { fprintf(stderr, "kernel_launch: hipFuncSetAttribute failed\n"); grid = -1; return; }
        if (hipOccupancyMaxActiveBlocksPerMultiprocessor(&per_cu, (const void*)fwd_kernel, NTHREADS, LDS_BYTES) != hipSuccess || per_cu < 1)
            fprintf(stderr, "kernel_launch: occupancy query reports %d workgroups per CU\n", per_cu);
        (void)hipGetLastError();
        grid = cus;
    }
    if (grid < 0) return;
    if (hipMemsetAsync((char*)d_ws + WS_CTL, 0, CTL_ZERO_BYTES, stream) != hipSuccess) return;
    Args a{};
    for (int i = 0; i < N_IN; ++i) a.in[i] = (const float*)d_in[i];
    a.out = (float*)d_out; a.ws = (unsigned char*)d_ws;
    if (MK_ONE_LAUNCH) {
        a.ph_lo = 0; a.ph_hi = N_PHASES; a.li = 0;
        hipLaunchKernelGGL(fwd_kernel, dim3(grid), dim3(NTHREADS), LDS_BYTES, stream, a);
    } else {
        for (int p = 0; p < N_PHASES; ++p) {
            a.ph_lo = p; a.ph_hi = p + 1; a.li = p;
            hipLaunchKernelGGL(fwd_kernel, dim3(grid), dim3(NTHREADS), LDS_BYTES, stream, a);
        }
    }
}
```

```cpp
#include <hip/hip_runtime.h>
#include <cstdio>
#include <cstdint>
namespace pg8 {
#define PG8_LAS __attribute__((address_space(3)))
typedef unsigned short bf16_t;
typedef short bf16x8 __attribute__((ext_vector_type(8)));
typedef float f32x4 __attribute__((ext_vector_type(4)));
typedef unsigned u32x4 __attribute__((ext_vector_type(4)));
constexpr int BM = 256, BK = 64, HALF = 128, HTB = HALF * BK * 2  , STAGE_BYTES = 8 * HTB, NXCD = 8, WGM = 8;

__host__ __device__ __forceinline__ int lds_byte(int r, int c) { const int st = (r >> 4) * 2 + (c >> 5), rr = r & 15, cc = c & 31, ob = rr * 64 + cc * 2; return st * 1024 + (ob ^ (((ob >> 9) & 1) << 5)); }
__host__ __device__ __forceinline__ void stage_rc(int b, int& R, int& C) { const int st = b / 1024, sb = b % 1024, swz = sb ^ (((sb >> 9) & 1) << 5); R = (st >> 1) * 16 + swz / 64; C = (st & 1) * 32 + (swz % 64) / 2; }
__host__ __device__ __forceinline__ int perm32(int rho) { const int n = rho >> 4, i = rho & 15; return 8 * (i >> 2) + 4 * n + (i & 3); }

struct Unit { int pm, pn; };
struct Gemm { const bf16_t* A; const bf16_t* Bt; int M, N, K, lda, ldb; };

struct StaticOrder {
    int nM, nN, nwg, G, c;
    __host__ __device__ void init(int M, int N, int G_, int c_) { nM = M / BM; nN = N / BM; nwg = nM * nN; G = G_; c = c_; }
    __host__ __device__ bool next(int i, Unit& u) const {
        const long L = (long)i * G + c; if (L >= nwg) return false;
        int wgid = (int)L; { const int q = nwg / NXCD, r = nwg % NXCD, xcd = wgid % NXCD, off = wgid / NXCD; wgid = (xcd < r ? xcd * (q + 1) : r * (q + 1) + (xcd - r) * q) + off; }
        const int nig = WGM * nN, gid = wgid / nig, fm = gid * WGM, gsz = (nM - fm) < WGM ? (nM - fm) : WGM;
        u.pm = fm + ((wgid % nig) % gsz); u.pn = (wgid % nig) / gsz; return true;
    }
    __device__ __forceinline__ void a_ready(const Unit&) const {}
    __device__ __forceinline__ void done(const Unit&) const {}
};

__device__ __forceinline__ unsigned cvt_pk_bf16(float lo, float hi) { unsigned r; asm volatile("v_cvt_pk_bf16_f32 %0, %1, %2" : "=v"(r) : "v"(lo), "v"(hi)); return r; }
template <class Epi, class Sched, bool ALIGN_EPI = false, bool SP2 = false>
__device__ __forceinline__ void gemm_phase(PG8_LAS unsigned char* lds, const Gemm g, const Sched& S, const Epi& E) {
    const int tid = threadIdx.x, wid = __builtin_amdgcn_readfirstlane(tid >> 6), lane = tid & 63, wr = wid >> 2, wc = wid & 3, fr = lane & 15, fq = lane >> 4;
    const int K = g.K, nt = K / BK;
    unsigned voffA[2], voffB[2];
#pragma unroll
    for (int i = 0; i < 2; ++i) { int R, C; stage_rc(tid * 16 + i * 8192, R, C); const int Rb = Epi::PERM ? ((R & ~31) + perm32(R & 31)) : R;
        voffA[i] = (unsigned)(R * g.lda + C) * 2u; voffB[i] = (unsigned)(Rb * g.ldb + C) * 2u; }
    const size_t kstep = (size_t)(BK * 2);
    const size_t hstepA = (size_t)HALF * g.lda * 2, hstepB = (size_t)HALF * g.ldb * 2;
    const size_t tstepA = 2 * hstepA, tstepB = 2 * hstepB;
    const unsigned ldsw = (unsigned)wid * 1024u;
    const int aoff = lds_byte(wr * 64 + fr, fq * 8), boff = lds_byte(wc * 32 + fr, fq * 8);
#define PG8_SA(b, h) (((b) * 2 + (h)) * HTB)
#define PG8_SB(b, h) ((4 + (b) * 2 + (h)) * HTB)
#define PG8_STAGE(bufoff, gbase, voff) do { _Pragma("unroll") for (int _i = 0; _i < 2; ++_i) \
        __builtin_amdgcn_global_load_lds((const unsigned*)((const char*)(gbase) + (voff)[_i]), (PG8_LAS unsigned*)(lds + (bufoff) + ldsw + _i * 8192), 16, 0, 0); } while (0)
#define PG8_LDA(dst, b, h) do { _Pragma("unroll") for (int m = 0; m < 4; ++m) _Pragma("unroll") for (int k = 0; k < 2; ++k) dst[m][k] = *(const PG8_LAS bf16x8*)(lds + PG8_SA(b, h) + aoff + m * 2048 + k * 1024); } while (0)
#define PG8_LDB(dst, b, h) do { _Pragma("unroll") for (int n = 0; n < 2; ++n) _Pragma("unroll") for (int k = 0; k < 2; ++k) dst[n][k] = *(const PG8_LAS bf16x8*)(lds + PG8_SB(b, h) + boff + n * 2048 + k * 1024); } while (0)
#define PG8_MMA(ai, bj, At, Bt) do { __builtin_amdgcn_s_setprio(1); _Pragma("unroll") for (int m = 0; m < 4; ++m) _Pragma("unroll") for (int n = 0; n < 2; ++n) _Pragma("unroll") for (int k = 0; k < 2; ++k) \
        acc[ai][bj][m][n] = __builtin_amdgcn_mfma_f32_16x16x32_bf16(Bt[n][k], At[m][k], acc[ai][bj][m][n], 0, 0, 0); __builtin_amdgcn_s_setprio(0); } while (0)
#define PG8_WAIT_V(n) asm volatile("s_waitcnt vmcnt(" #n ")" ::: "memory")
#define PG8_WAIT_L(n) asm volatile("s_waitcnt lgkmcnt(" #n ")" ::: "memory")
#define PG8_BAR __builtin_amdgcn_s_barrier()
#define PG8_SCHED __builtin_amdgcn_sched_barrier(0)
    Unit cur, nxt; int ui = 0;
    if (!S.next(0, cur)) return;
    f32x4 acc[2][2][4][2];
#pragma unroll
    for (int a = 0; a < 2; ++a)
#pragma unroll
        for (int b = 0; b < 2; ++b)
#pragma unroll
            for (int m = 0; m < 4; ++m)
#pragma unroll
                for (int n = 0; n < 2; ++n) acc[a][b][m][n] = (f32x4){0.f, 0.f, 0.f, 0.f};
    bf16x8 At[4][2], B0[2][2], B1[2][2];
    const char* cA = (const char*)g.A + (size_t)cur.pm * tstepA; const char* cB = (const char*)g.Bt + (size_t)cur.pn * tstepB;
    S.a_ready(cur);
    if constexpr (SP2) {
        PG8_STAGE(PG8_SB(0, 0), cB, voffB); PG8_STAGE(PG8_SB(0, 1), cB + hstepB, voffB); PG8_STAGE(PG8_SA(0, 0), cA, voffA); PG8_STAGE(PG8_SA(0, 1), cA + hstepA, voffA);
        if (wr == 1) PG8_BAR;
        PG8_WAIT_V(2); PG8_BAR;
        PG8_STAGE(PG8_SB(1, 0), cB + kstep, voffB); PG8_STAGE(PG8_SA(1, 0), cA + kstep, voffA); PG8_STAGE(PG8_SB(1, 1), cB + hstepB + kstep, voffB);
        PG8_WAIT_V(6); PG8_BAR;
    } else {
        PG8_STAGE(PG8_SB(0, 0), cB, voffB); PG8_STAGE(PG8_SA(0, 0), cA, voffA); PG8_STAGE(PG8_SB(0, 1), cB + hstepB, voffB); PG8_STAGE(PG8_SA(0, 1), cA + hstepA, voffA);
        if (wr == 1) PG8_BAR;
        PG8_WAIT_V(4); PG8_BAR;
        PG8_STAGE(PG8_SB(1, 0), cB + kstep, voffB); PG8_STAGE(PG8_SA(1, 0), cA + kstep, voffA); PG8_STAGE(PG8_SB(1, 1), cB + hstepB + kstep, voffB);
        PG8_WAIT_V(6); PG8_BAR;
    }
    for (;;) {
        const bool has_next = S.next(ui + 1, nxt);
        const char* nA = has_next ? (const char*)g.A + (size_t)nxt.pm * tstepA : cA; const char* nB = has_next ? (const char*)g.Bt + (size_t)nxt.pn * tstepB : cB;
        for (int t = 0; t < nt; t += 2) {
            const bool last = (t == nt - 2);
            const char* a1 = cA + (size_t)(t + 1) * kstep;
            const char* a2 = last ? nA : cA + (size_t)(t + 2) * kstep; const char* b2 = last ? nB : cB + (size_t)(t + 2) * kstep;
            const char* a3 = a2 + kstep; const char* b3 = b2 + kstep;
            if (last && has_next) S.a_ready(nxt);
            if constexpr (SP2) {
            PG8_LDB(B0, 0, 0); PG8_LDB(B1, 0, 1); PG8_SCHED; PG8_LDA(At, 0, 0); PG8_STAGE(PG8_SA(1, 1), a1 + hstepA, voffA);
            PG8_WAIT_V(8); PG8_WAIT_L(0); PG8_BAR; PG8_MMA(0, 0, At, B0); PG8_MMA(0, 1, At, B1); PG8_BAR; PG8_SCHED;
            PG8_LDA(At, 0, 1); PG8_STAGE(PG8_SB(0, 0), b2, voffB); PG8_STAGE(PG8_SB(0, 1), b2 + hstepB, voffB); PG8_STAGE(PG8_SA(0, 0), a2, voffA);
            PG8_WAIT_V(8); PG8_WAIT_L(0); PG8_BAR; PG8_MMA(1, 0, At, B0); PG8_MMA(1, 1, At, B1); PG8_BAR; PG8_SCHED;
            PG8_LDB(B0, 1, 0); PG8_LDB(B1, 1, 1); PG8_SCHED; PG8_LDA(At, 1, 0); PG8_STAGE(PG8_SA(0, 1), a2 + hstepA, voffA);
            PG8_WAIT_V(8); PG8_WAIT_L(0); PG8_BAR; PG8_MMA(0, 0, At, B0); PG8_MMA(0, 1, At, B1); PG8_BAR; PG8_SCHED;
            PG8_LDA(At, 1, 1); PG8_STAGE(PG8_SB(1, 0), b3, voffB); PG8_STAGE(PG8_SB(1, 1), b3 + hstepB, voffB); PG8_STAGE(PG8_SA(1, 0), a3, voffA);
            PG8_WAIT_V(8); PG8_WAIT_L(0); PG8_BAR; PG8_MMA(1, 0, At, B0); PG8_MMA(1, 1, At, B1); PG8_BAR; PG8_SCHED;
            } else {
            PG8_LDB(B0, 0, 0); PG8_SCHED; PG8_LDA(At, 0, 0); PG8_STAGE(PG8_SA(1, 1), a1 + hstepA, voffA);
            PG8_WAIT_L(8); PG8_BAR; PG8_WAIT_L(0); PG8_MMA(0, 0, At, B0); PG8_BAR; PG8_SCHED;
            PG8_LDB(B1, 0, 1); PG8_STAGE(PG8_SB(0, 0), b2, voffB);
            PG8_BAR; PG8_WAIT_L(0); PG8_MMA(0, 1, At, B1); PG8_BAR;
            PG8_LDA(At, 0, 1); PG8_STAGE(PG8_SA(0, 0), a2, voffA);
            PG8_BAR; PG8_WAIT_L(0); PG8_MMA(1, 0, At, B0); PG8_BAR; PG8_SCHED;
            PG8_STAGE(PG8_SB(0, 1), b2 + hstepB, voffB);
            PG8_WAIT_V(6); PG8_BAR; PG8_MMA(1, 1, At, B1); PG8_BAR;
            PG8_LDB(B0, 1, 0); PG8_SCHED; PG8_LDA(At, 1, 0); PG8_STAGE(PG8_SA(0, 1), a2 + hstepA, voffA);
            PG8_WAIT_L(8); PG8_BAR; PG8_WAIT_L(0); PG8_MMA(0, 0, At, B0); PG8_BAR; PG8_SCHED;
            PG8_LDB(B1, 1, 1); PG8_STAGE(PG8_SB(1, 0), b3, voffB);
            PG8_BAR; PG8_WAIT_L(0); PG8_MMA(0, 1, At, B1); PG8_BAR;
            PG8_LDA(At, 1, 1); PG8_STAGE(PG8_SA(1, 0), a3, voffA);
            PG8_BAR; PG8_WAIT_L(0); PG8_MMA(1, 0, At, B0); PG8_BAR; PG8_SCHED;
            PG8_STAGE(PG8_SB(1, 1), b3 + hstepB, voffB);
            PG8_WAIT_V(6); PG8_BAR; PG8_MMA(1, 1, At, B1); PG8_BAR;
            }
        }
        if constexpr (ALIGN_EPI) { if (wr == 0) PG8_BAR; }
        if constexpr (!Epi::AFTER_DRAIN) { E(acc, cur, wr, wc, fr, fq); S.done(cur); }
        if (!has_next) break;
#pragma unroll
        for (int a = 0; a < 2; ++a)
#pragma unroll
            for (int b = 0; b < 2; ++b)
#pragma unroll
                for (int m = 0; m < 4; ++m)
#pragma unroll
                    for (int n = 0; n < 2; ++n) acc[a][b][m][n] = (f32x4){0.f, 0.f, 0.f, 0.f};
        cur = nxt; cA = nA; cB = nB; ++ui;
        if constexpr (ALIGN_EPI) { if (wr == 1) PG8_BAR; }
    }
    PG8_WAIT_V(0);
    if constexpr (!ALIGN_EPI) { if (wr == 0) PG8_BAR; }
    PG8_BAR;
    if constexpr (Epi::AFTER_DRAIN) { E.fused(acc, cur, wr, wc, fr, fq, lds, wid, lane); S.done(cur); }
#undef PG8_SA
#undef PG8_SB
#undef PG8_STAGE
#undef PG8_LDA
#undef PG8_LDB
#undef PG8_MMA
#undef PG8_WAIT_V
#undef PG8_WAIT_L
#undef PG8_BAR
#undef PG8_SCHED
}
}

constexpr int NWAVES = 8, NTHREADS = NWAVES * 64;
constexpr int BATCH = 8, SEQ = 4096, D = 1024, M = BATCH * SEQ;
constexpr int POOLW = 512, QW = 512, NG = 2, HD = 64, NBG = BATCH * NG;
constexpr int IN_COLS = 3864, NIN = 4096;
constexpr int NCMP = 255, NCMP_PAD = 256, NSEL = 64;
constexpr int PH = 8, PK = 128, PTOP = 16, PQD = 256, PQW = PH * PQD;
constexpr int NEXP = PK * PK;
constexpr float EPS = 1e-6f;
enum { I_X = 0, I_C, I_RELB, I_ADAW, I_ADAB, I_N1G, I_N2G, I_WIN, I_POOLW, I_POOLS, I_CPEK, I_CW1K, I_CW2K, I_CPEV, I_CW1V, I_CW2V, I_QNG, I_KNG, I_WBP, I_WBA, I_WOUT, I_PWQ, I_PSK, I_PU, I_PV, N_IN };

constexpr size_t MiB = 1u << 20, KiB = 1u << 10;
constexpr size_t WS_CTL = 0, CTL_ZERO_BYTES = 1 * MiB;
constexpr size_t WS_ADA = 1 * MiB;
constexpr size_t WS_CB1K = 64 * KiB;
constexpr size_t WS_CB1V = WS_CB1K + 1 * KiB;
constexpr size_t WS_BIASL = WS_ADA + 256 * KiB;
constexpr size_t WS_WIN_T = 2 * MiB;
constexpr size_t WS_WEFF_T = 10 * MiB;
constexpr size_t WS_WBA_T = 11 * MiB;
constexpr size_t WS_WOUT_T = 12 * MiB;
constexpr size_t WS_WQ_T = 14 * MiB;
constexpr size_t WS_SUBK = 18 * MiB;
constexpr size_t WS_CW1K_T = 18 * MiB + 512 * KiB;
constexpr size_t WS_CW1V_T = 19 * MiB;
constexpr size_t WS_CW2K_T = 19 * MiB + 512 * KiB;
constexpr size_t WS_CW2V_T = WS_CW2K_T + 64 * KiB;
constexpr size_t WS_KC = 20 * MiB;
constexpr size_t WS_VCT = 20 * MiB + 512 * KiB;
constexpr size_t WS_GATE = 21 * MiB;
constexpr size_t WS_UB = 24 * MiB;
constexpr size_t WS_VB = 56 * MiB;
constexpr size_t WS_SCLU = WS_UB + 16 * MiB, WS_SCLV = WS_SCLU + 64 * KiB;
constexpr size_t WS_H = 88 * MiB;
constexpr size_t WS_ZP = 152 * MiB;
constexpr size_t WS_Q = 184 * MiB;
constexpr size_t WS_KCR = 216 * MiB;
constexpr size_t WS_VCR = 225 * MiB;
constexpr size_t WS_KS = 234 * MiB, WS_VS = 242 * MiB, WS_KW = 250 * MiB, WS_VW = 258 * MiB;
constexpr size_t WS_VST = 266 * MiB, WS_VWT = 274 * MiB;
constexpr size_t WS_PL = 282 * MiB;
constexpr size_t WS_YA = 314 * MiB;
constexpr size_t WS_GM = 346 * MiB;
constexpr size_t WS_MIX = WS_ZP;
constexpr size_t WS_QV = WS_GM;
constexpr size_t WS_EID = WS_PL;
constexpr size_t WS_GW = WS_PL + 16 * MiB;
constexpr size_t WS_PART = WS_GM;
constexpr size_t WS_CF = WS_YA;
constexpr size_t WS_CFS = WS_YA + 8 * MiB;
constexpr size_t WS_H8 = WS_ZP;
constexpr size_t WS_HS = WS_ZP + 32 * MiB;
constexpr size_t WS_END = 474 * MiB;
constexpr int CW_TMO = 0, CW_CODE = 1, CW_BAR = 4096;

constexpr int RING_OFF = 0, RING_BYTES = 131072;
constexpr int LDSCTL_OFF = RING_BYTES, MISC_OFF = LDSCTL_OFF + 320;
constexpr int LDS_BYTES = 147456;

#define GAS __attribute__((address_space(1)))
#define LAS __attribute__((address_space(3)))
typedef unsigned short bf16;
typedef unsigned v4u __attribute__((ext_vector_type(4)));
typedef unsigned v2u __attribute__((ext_vector_type(2)));
typedef int v2i __attribute__((ext_vector_type(2)));
typedef float f32x4 __attribute__((ext_vector_type(4)));
typedef short bf16x8 __attribute__((ext_vector_type(8)));
typedef GAS unsigned gu32;
#define RLX_AGENT __ATOMIC_RELAXED, __HIP_MEMORY_SCOPE_AGENT
#define LDS_WAIT() asm volatile("s_waitcnt lgkmcnt(0)" ::: "memory")
#define VM_WAIT() asm volatile("s_waitcnt vmcnt(0)" ::: "memory")
__device__ __forceinline__ unsigned f2bf(float f) { unsigned u = __builtin_bit_cast(unsigned, f); return (u + 0x7fffu + ((u >> 16) & 1u)) >> 16; }
__device__ __forceinline__ unsigned pk2(float lo, float hi) { return f2bf(lo) | (f2bf(hi) << 16); }
__device__ __forceinline__ float bflo(unsigned w) { return __builtin_bit_cast(float, w << 16); }
__device__ __forceinline__ float bfhi(unsigned w) { return __builtin_bit_cast(float, w & 0xffff0000u); }
__device__ __forceinline__ float sigmoidf_(float v) { return __builtin_amdgcn_rcpf(1.0f + __builtin_amdgcn_exp2f(v * -1.4426950408889634f)); }
typedef __bf16 bf16x2_hw __attribute__((ext_vector_type(2)));
typedef float f32x2_hw __attribute__((ext_vector_type(2)));
__device__ __forceinline__ unsigned pkh(float lo, float hi) { return __builtin_bit_cast(unsigned, __builtin_convertvector((f32x2_hw){lo, hi}, bf16x2_hw)); }
__device__ __forceinline__ float gelu_tanh_safe(float v) { const float u = 0.7978845608028654f * (v + 0.044715f * v * v * v); return 0.5f * v * (1.0f + tanhf(u)); }
template <int CTRL> __device__ __forceinline__ float dppf(float v) { return __builtin_bit_cast(float, __builtin_amdgcn_update_dpp(0, __builtin_bit_cast(int, v), CTRL, 0xF, 0xF, true)); }
template <int CTRL> __device__ __forceinline__ int dppi(int v) { return __builtin_amdgcn_update_dpp(0, v, CTRL, 0xF, 0xF, true); }
#define DPP_XOR1 0xB1
#define DPP_XOR2 0x4E
#define DPP_HMIR 0x141
#define DPP_ROR8 0x128
__device__ __forceinline__ void swap16_(float& a, float& b) { asm volatile("v_nop\n\tv_nop\n\tv_permlane16_swap_b32 %0, %1" : "+v"(a), "+v"(b)); }
__device__ __forceinline__ void swap32_(float& a, float& b) { asm volatile("v_nop\n\tv_nop\n\tv_permlane32_swap_b32 %0, %1" : "+v"(a), "+v"(b)); }
__device__ __forceinline__ float sum_xor16(float v) { float a = v, b = v; swap16_(a, b); return a + b; }
__device__ __forceinline__ float sum_xor32(float v) { float a = v, b = v; swap32_(a, b); return a + b; }
__device__ __forceinline__ float max_xor16(float v) { float a = v, b = v; swap16_(a, b); return fmaxf(a, b); }
__device__ __forceinline__ float max_xor32(float v) { float a = v, b = v; swap32_(a, b); return fmaxf(a, b); }
__device__ __forceinline__ float wave_sum(float v) {
    v += dppf<DPP_XOR1>(v); v += dppf<DPP_XOR2>(v); v += dppf<DPP_HMIR>(v); v += dppf<DPP_ROR8>(v);
    return sum_xor32(sum_xor16(v));
}
__device__ __forceinline__ float wave_max(float v) {
    v = fmaxf(v, dppf<DPP_XOR1>(v)); v = fmaxf(v, dppf<DPP_XOR2>(v)); v = fmaxf(v, dppf<DPP_HMIR>(v)); v = fmaxf(v, dppf<DPP_ROR8>(v));
    return max_xor32(max_xor16(v));
}

#define XB_TMO      128
#define XB_XCNT(j)  (256  + 64 * (j))
#define XB_XSUB(j)  (1280 + 64 * (j))
#define XB_XGEN(j)  (2304 + 64 * (j))
#define XB_TOP      3328
#define XB_TOPGEN   3392
#define XCD_BAR_WORDS 3456
#define XB_SPIN_CAP (1u << 18)
__device__ __forceinline__ unsigned xb_ld(unsigned* p)              { return __hip_atomic_load(p, __ATOMIC_RELAXED, __HIP_MEMORY_SCOPE_AGENT); }
__device__ __forceinline__ unsigned xb_add(unsigned* p, unsigned v) { return __hip_atomic_fetch_add(p, v, __ATOMIC_RELAXED, __HIP_MEMORY_SCOPE_AGENT); }
__device__ __forceinline__ unsigned xb_xcc_id() { return (unsigned)__builtin_amdgcn_s_getreg((3 << 11) | 20) & 0xFu; }
#define XB_SPIN(cond, bar) do { unsigned _sp = 0; while (cond) { __builtin_amdgcn_s_sleep(1); \
    if ((++_sp & 255u) == 0u) { if (xb_ld(&(bar)[XB_TMO])) break; if (_sp > XB_SPIN_CAP) { atomicAdd(&(bar)[XB_TMO], 1u); break; } } } } while (0)
struct XcdBarrier { unsigned* bar; unsigned x; volatile LAS unsigned* st; };
__device__ __forceinline__ XcdBarrier xcd_barrier_post(unsigned* bar, volatile LAS unsigned* st) {
    XcdBarrier b; b.bar = bar; b.x = xb_xcc_id(); b.st = st;
    if (threadIdx.x == 0) (void)xb_add(&bar[XB_XCNT(b.x)], 1u);
    return b;
}
__device__ __forceinline__ void xcd_barrier_complete(unsigned* bar, unsigned x, unsigned& nloc, unsigned& nx) {
    const unsigned G = gridDim.x * gridDim.y * gridDim.z;
    unsigned sum, cnt, mine, sp = 0u;
    for (;;) {
        sum = 0u; cnt = 0u; mine = 0u;
#pragma unroll
        for (unsigned j = 0; j < 16; ++j) { const unsigned c = xb_ld(&bar[XB_XCNT(j)]); sum += c; cnt += (c > 0u) ? 1u : 0u; mine = (j == x) ? c : mine; }
        if (sum == G) break;
        __builtin_amdgcn_s_sleep(1);
        if ((++sp & 255u) == 0u) { if (xb_ld(&bar[XB_TMO])) break; if (sp > XB_SPIN_CAP) { atomicAdd(&bar[XB_TMO], 1u); break; } }
    }
    nloc = mine > 0u ? mine : 1u; nx = cnt > 0u ? cnt : 1u;
}
__device__ __forceinline__ void xcd_barrier(const XcdBarrier& b) {
    asm volatile("s_waitcnt vmcnt(0)" ::: "memory");
    __syncthreads();
    if (threadIdx.x == 0) {
        unsigned* bar = b.bar;
        __builtin_amdgcn_s_waitcnt(0);
        unsigned nloc = b.st[0], nx = b.st[1];
        if (nloc == 0u) { xcd_barrier_complete(bar, b.x, nloc, nx); b.st[0] = nloc; b.st[1] = nx; }
        const unsigned old = xb_add(&bar[XB_XSUB(b.x)], 1u);
        const unsigned gen = old / nloc;
        if (old + 1u == (gen + 1u) * nloc) {
            __builtin_amdgcn_fence(__ATOMIC_RELEASE, "agent");
            asm volatile("s_waitcnt vmcnt(0)" ::: "memory");
            const unsigned og = xb_add(&bar[XB_TOP], 1u);
            const unsigned tg = og / nx;
            if (og + 1u == (tg + 1u) * nx) xb_add(&bar[XB_TOPGEN], 1u);
            else XB_SPIN(xb_ld(&bar[XB_TOPGEN]) == tg, bar);
            __builtin_amdgcn_fence(__ATOMIC_ACQUIRE, "agent");
            xb_add(&bar[XB_XGEN(b.x)], 1u);
            asm volatile("s_waitcnt vmcnt(0)" ::: "memory");
        } else {
            XB_SPIN(xb_ld(&bar[XB_XGEN(b.x)]) == gen, bar);
            __builtin_amdgcn_fence(__ATOMIC_ACQUIRE, "agent");
            asm volatile("s_waitcnt vmcnt(0)" ::: "memory");
        }
    }
    __syncthreads();
}

struct Args { const float* in[N_IN]; float* out; unsigned char* ws; int ph_lo, ph_hi, li, pad; };
struct Frame {
    LAS unsigned char* lds;
    volatile LAS unsigned* MISC;
    gu32* ctl;
    int tid, lane, wave, G, bid;
    unsigned char* ws;
};

template <bool I8> __device__ __forceinline__ void cvt_row_store(const f32x4 (&v)[4], int row, unsigned char* dst, float* inv_scale, int lane) {
    float m = 0.f;
#pragma unroll
    for (int j = 0; j < 4; ++j) m = fmaxf(m, fmaxf(fmaxf(fabsf(v[j].x), fabsf(v[j].y)), fmaxf(fabsf(v[j].z), fabsf(v[j].w))));
    m = wave_max(m);
    unsigned ww[4]; float isc;
    if (I8) { const float sc = m > 0.f ? 127.0f / m : 0.f; isc = m * (1.0f / 127.0f);
#pragma unroll
        for (int j = 0; j < 4; ++j) { const int q0 = (int)rintf(v[j].x * sc), q1 = (int)rintf(v[j].y * sc), q2 = (int)rintf(v[j].z * sc), q3 = (int)rintf(v[j].w * sc);
            ww[j] = ((unsigned)q0 & 0xffu) | (((unsigned)q1 & 0xffu) << 8) | (((unsigned)q2 & 0xffu) << 16) | (((unsigned)q3 & 0xffu) << 24); } }
    else { const unsigned E = (__builtin_bit_cast(unsigned, m) >> 23) & 0xffu; float sc = 1.f; isc = 1.f;
        if (E >= 8u && E <= 250u) { sc = __builtin_bit_cast(float, (261u - E) << 23); isc = __builtin_bit_cast(float, (E - 7u) << 23); }
#pragma unroll
        for (int j = 0; j < 4; ++j) { int t = __builtin_amdgcn_cvt_pk_fp8_f32(v[j].x * sc, v[j].y * sc, 0, false); t = __builtin_amdgcn_cvt_pk_fp8_f32(v[j].z * sc, v[j].w * sc, t, true); ww[j] = (unsigned)t; } }
    *(GAS v4u*)(dst + (size_t)(lane >> 3) * NEXP * 128 + (size_t)row * 128 + 16 * (lane & 7)) = (v4u){ww[0], ww[1], ww[2], ww[3]};
    if (lane == 0) inv_scale[row] = isc;
}
template <bool I8> __device__ __forceinline__ void cvt_rows_8bit(const float* src, unsigned char* dst, float* inv_scale, int gw, int NGW, int lane) {
    for (int row = gw; row < NEXP; row += 2 * NGW) {
        const int row1 = row + NGW; const bool has1 = row1 < NEXP;
        f32x4 v0[4], v1[4];
#pragma unroll
        for (int j = 0; j < 4; ++j) v0[j] = *(const GAS f32x4*)(src + (size_t)row * D + 16 * lane + 4 * j);
#pragma unroll
        for (int j = 0; j < 4; ++j) v1[j] = has1 ? *(const GAS f32x4*)(src + (size_t)row1 * D + 16 * lane + 4 * j) : (f32x4){0.f, 0.f, 0.f, 0.f};
        cvt_row_store<I8>(v0, row, dst, inv_scale, lane);
        if (has1) cvt_row_store<I8>(v1, row1, dst, inv_scale, lane);
    }
}
__device__ __forceinline__ void p0_transpose_item(const float* W, int ldw, int src_col0, int valid, int K, bf16* WT, int dst_row0, int k0, LAS float* scr, int lane) {
    const int n_ = lane & 31;
#pragma unroll 8
    for (int i = 0; i < 32; ++i) { const int kk = 2 * i + (lane >> 5); scr[kk * 33 + n_] = (n_ < valid) ? W[(size_t)(k0 + kk) * ldw + src_col0 + n_] : 0.f; }
    LDS_WAIT(); asm volatile("" ::: "memory");
    const int c = lane & 7;
#pragma unroll
    for (int j = 0; j < 4; ++j) { const int n = (lane >> 3) + 8 * j; const LAS float* s = scr + (8 * c) * 33 + n;
        v4u o; o.x = pk2(s[0 * 33], s[1 * 33]); o.y = pk2(s[2 * 33], s[3 * 33]); o.z = pk2(s[4 * 33], s[5 * 33]); o.w = pk2(s[6 * 33], s[7 * 33]);
        *(GAS v4u*)(WT + (size_t)(dst_row0 + n) * K + k0 + 8 * c) = o; }
    LDS_WAIT(); asm volatile("" ::: "memory");
}
__device__ __forceinline__ bool p0_mat(int& r, const float* W, int K, int N, bf16* WT, LAS float* scr, int lane) {
    const int ng = N / 32, items = ng * (K / 64);
    if (r < items) { const int kb = r / ng, nb = r % ng; p0_transpose_item(W, N, 32 * nb, 32, K, WT, 32 * nb, 64 * kb, scr, lane); return true; }
    r -= items; return false;
}
__device__ __forceinline__ void cvt_f32_bf16_stream(const float* src, bf16* dst, size_t n8, size_t gtid, size_t gthreads) {
    for (size_t i = gtid; i < n8; i += gthreads) {
        const f32x4 a = *(const GAS f32x4*)(src + 8 * i), b = *(const GAS f32x4*)(src + 8 * i + 4);
        v4u o; o.x = pk2(a.x, a.y); o.y = pk2(a.z, a.w); o.z = pk2(b.x, b.y); o.w = pk2(b.z, b.w);
        *(GAS v4u*)(dst + 8 * i) = o; }
}

__device__ __forceinline__ void p0_prologue(Frame& F, const Args& args, bool do_bias = true) {
    unsigned char* ws = F.ws;
    const int gw = F.bid * NWAVES + F.wave, NGW = F.G * NWAVES;
    const size_t gtid = (size_t)F.bid * NTHREADS + F.tid, gthreads = (size_t)F.G * NTHREADS;
    {
        LAS float* sl = (LAS float*)(F.lds);
        LAS float* red = (LAS float*)(F.lds + 32768);
        const float* c = args.in[I_C];
        { f32x4 cv[4];
#pragma unroll
          for (int q = 0; q < 4; ++q) cv[q] = *(const GAS f32x4*)(c + 4 * (F.tid + NTHREADS * q));
#pragma unroll
          for (int q = 0; q < 4; ++q) { f32x4 o; o.x = cv[q].x / (1.0f + __expf(-cv[q].x)); o.y = cv[q].y / (1.0f + __expf(-cv[q].y)); o.z = cv[q].z / (1.0f + __expf(-cv[q].z)); o.w = cv[q].w / (1.0f + __expf(-cv[q].w));
              *(LAS f32x4*)(sl + 4 * (F.tid + NTHREADS * q)) = o; } }
        __syncthreads();
        for (int cb = F.bid; cb < 6 * D / 24; cb += F.G) {
            const int j0 = cb * 24;
            if (F.tid < 510) {
                const int kk = F.tid / 6, c4 = F.tid % 6;
                const float* w = args.in[I_ADAW] + j0 + 4 * c4;
                f32x4 wv[13];
#pragma unroll
                for (int m = 0; m < 13; ++m) { const int k = kk + 85 * m; wv[m] = (k < D) ? *(const GAS f32x4*)(w + (size_t)k * (6 * D)) : (f32x4){0.f, 0.f, 0.f, 0.f}; }
                f32x4 a[BATCH];
#pragma unroll
                for (int b = 0; b < BATCH; ++b) a[b] = (f32x4){0.f, 0.f, 0.f, 0.f};
#pragma unroll
                for (int m = 0; m < 13; ++m) { const int k = kk + 85 * m; const int kc = k < D ? k : 0;
#pragma unroll
                    for (int b = 0; b < BATCH; ++b) a[b] = a[b] + wv[m] * sl[b * D + kc]; }
#pragma unroll
                for (int b = 0; b < BATCH; ++b) { LAS float* rp = red + (kk * 24 + 4 * c4) * BATCH + b; rp[0] = a[b].x; rp[BATCH] = a[b].y; rp[2 * BATCH] = a[b].z; rp[3 * BATCH] = a[b].w; }
            }
            __syncthreads();
            if (F.tid < 24 * BATCH) { const int jj = F.tid / BATCH, b = F.tid % BATCH; float s = 0.f;
#pragma unroll 5
                for (int kk = 0; kk < 85; ++kk) s += red[(kk * 24 + jj) * BATCH + b];
                ((float*)(ws + WS_ADA))[b * (6 * D) + j0 + jj] = s + args.in[I_ADAB][j0 + jj]; }
            __syncthreads();
        }
    }
    if (F.bid >= 8 && F.bid < 40 && do_bias) {
        const int bb = F.bid - 8, kv = bb & 1, ch = bb >> 1;
        const float* pe = args.in[kv == 0 ? I_CPEK : I_CPEV]; const float* w1 = args.in[kv == 0 ? I_CW1K : I_CW1V];
        LAS float* red = (LAS float*)(F.lds);
        const int j = F.tid & 127, ic = F.tid >> 7; float s = 0.f;
        const int i0 = ch * 128 + ic * 32;
#pragma unroll 8
        for (int i = i0; i < i0 + 32; ++i) s += pe[i] * w1[(size_t)i * 128 + j];
        red[ic * 128 + j] = s; __syncthreads();
        if (F.tid < 128) atomicAdd((float*)(ws + (kv == 0 ? WS_CB1K : WS_CB1V)) + F.tid, (red[F.tid] + red[128 + F.tid]) + (red[256 + F.tid] + red[384 + F.tid]));
        __syncthreads();
    } else if (F.bid == 2) {
        for (int i = F.tid; i < 8 * 128; i += NTHREADS) { const int h = i >> 7, rel = i & 127;
            int bk = rel;
            if (rel >= 16) bk = 16 + (rel >= 19) + (rel >= 21) + (rel >= 24) + (rel >= 27) + (rel >= 31) + (rel >= 35) + (rel >= 40) + (rel >= 46) + (rel >= 52) + (rel >= 59) + (rel >= 67) + (rel >= 77) + (rel >= 87) + (rel >= 99) + (rel >= 113);
            ((float*)(ws + WS_BIASL))[i] = args.in[I_RELB][bk * 8 + h]; }
        if (F.tid < 64) {
            float mq = fabsf(args.in[I_QNG][F.tid]), mk = fmaxf(fmaxf(fabsf(args.in[I_KNG][F.tid]), fabsf(args.in[I_KNG][64 + F.tid])), fabsf(args.in[I_KNG][128 + F.tid]));
            float mb = fmaxf(fmaxf(fabsf(args.in[I_RELB][F.tid]), fabsf(args.in[I_RELB][64 + F.tid])), fmaxf(fabsf(args.in[I_RELB][128 + F.tid]), fabsf(args.in[I_RELB][192 + F.tid])));
            mq = wave_max(mq); mk = wave_max(mk); mb = wave_max(mb);
            if (F.tid == 0) ((float*)(ws + WS_BIASL))[8 * 128] = 8.0f * mq * mk + mb; }
    }
    {
        LAS float* scr = (LAS float*)(F.lds + F.wave * 16384);
        constexpr int I_WINT = (NIN / 32) * (D / 64);
        constexpr int NITEMS = I_WINT + (1024 / 32) * (512 / 64) + (1024 / 32) * (1024 / 64) + (2048 / 32) * (1024 / 64) + 2 * (128 / 32) * (2048 / 64) + 2 * (64 / 32) * (128 / 64);
        for (int it = gw; it < NITEMS; it += NGW) {
            int r = it;
            if (r < I_WINT) {
                const int grp = r % (NIN / 32), kb = r / (NIN / 32);
                const int tile = grp >> 3, ct0 = (grp & 7) * 32;
                const int L0 = 64 * ((ct0 >> 5) & 3) + 32 * (ct0 >> 7);
                int src0, valid = 32;
                if (tile < 7) src0 = 256 * tile + L0; else if (tile < 15) src0 = 1816 + 256 * (tile - 7) + L0; else { src0 = 1792 + L0; valid = (L0 == 0) ? 24 : 0; }
                if (valid == 0) src0 = 0;
                p0_transpose_item(args.in[I_WIN], IN_COLS, src0, valid, D, (bf16*)(ws + WS_WIN_T), 32 * grp, 64 * kb, scr, F.lane);
                continue; }
            r -= I_WINT;
            if (p0_mat(r, args.in[I_WBA], 512, 1024, (bf16*)(ws + WS_WBA_T), scr, F.lane)) continue;
            if (p0_mat(r, args.in[I_WOUT], 1024, 1024, (bf16*)(ws + WS_WOUT_T), scr, F.lane)) continue;
            if (p0_mat(r, args.in[I_PWQ], 1024, 2048, (bf16*)(ws + WS_WQ_T), scr, F.lane)) continue;
            if (p0_mat(r, args.in[I_CW1K], 2048, 128, (bf16*)(ws + WS_CW1K_T), scr, F.lane)) continue;
            if (p0_mat(r, args.in[I_CW1V], 2048, 128, (bf16*)(ws + WS_CW1V_T), scr, F.lane)) continue;
            if (p0_mat(r, args.in[I_CW2K], 128, 64, (bf16*)(ws + WS_CW2K_T), scr, F.lane)) continue;
            p0_mat(r, args.in[I_CW2V], 128, 64, (bf16*)(ws + WS_CW2V_T), scr, F.lane);
        }
    }
    {
        const float* pw = args.in[I_POOLW]; const float* ps = args.in[I_POOLS]; const float* wbp = args.in[I_WBP];
        bf16* weff = (bf16*)(ws + WS_WEFF_T);
        LAS float* PWl = (LAS float*)(F.lds);
        LAS float* WBl = (LAS float*)(F.lds + 128 * 129 * 4);
        __syncthreads();
        for (int bb = F.bid; bb < 256; bb += F.G) {
            const int g = bb >> 6, d0 = (bb & 63) * 16;
            { f32x4 t[8];
#pragma unroll
              for (int q = 0; q < 8; ++q) t[q] = *(const GAS f32x4*)(pw + (size_t)g * 16384 + 4 * (F.tid + NTHREADS * q));
#pragma unroll
              for (int q = 0; q < 8; ++q) { const int i = 4 * (F.tid + NTHREADS * q); LAS float* d = PWl + (i >> 7) * 129 + (i & 127); d[0] = t[q].x; d[1] = t[q].y; d[2] = t[q].z; d[3] = t[q].w; }
              const int cc = F.tid >> 2, d4 = (F.tid & 3) * 4;
              const f32x4 wv = *(const GAS f32x4*)(wbp + (size_t)(g * 128 + cc) * D + d0 + d4); const float pv = ps[g * 128 + cc];
              LAS float* d = WBl + cc * 17 + d4; d[0] = wv.x * pv; d[1] = wv.y * pv; d[2] = wv.z * pv; d[3] = wv.w * pv; }
            __syncthreads();
            const int c = F.tid & 127, q = F.tid >> 7;
            float acc4[4] = {0.f, 0.f, 0.f, 0.f};
#pragma unroll 4
            for (int cc = 0; cc < 128; ++cc) { const float a = PWl[c * 129 + cc];
#pragma unroll
                for (int e = 0; e < 4; ++e) acc4[e] += a * WBl[cc * 17 + 4 * q + e]; }
#pragma unroll
            for (int e = 0; e < 4; ++e) weff[(size_t)(d0 + 4 * q + e) * POOLW + g * 128 + c] = (bf16)f2bf(acc4[e]);
            __syncthreads();
        }
    }
    cvt_f32_bf16_stream(args.in[I_PSK], (bf16*)(ws + WS_SUBK), (size_t)16 * 128 * 128 / 8, gtid, gthreads);
    cvt_rows_8bit<true>(args.in[I_PU], ws + WS_UB, (float*)(ws + WS_SCLU), gw, NGW, F.lane);
    cvt_rows_8bit<false>(args.in[I_PV], ws + WS_VB, (float*)(ws + WS_SCLV), gw, NGW, F.lane);
}

template <bool Q8> __device__ __forceinline__ void modnorm_rows(Frame& F, const float* x, const float* g, const float* ada, int shift_idx, bf16* out) {
    const int gw = F.bid * NWAVES + F.wave, NGW = F.G * NWAVES;
    for (int m = gw; m < M; m += NGW) {
        const int b = m >> 12;
        const GAS f32x4* xr = (const GAS f32x4*)(x + (size_t)m * D) + F.lane;
        const GAS f32x4* gr = (const GAS f32x4*)g + F.lane;
        const GAS f32x4* sh = (const GAS f32x4*)(ada + (size_t)b * 6 * D + shift_idx * D) + F.lane;
        const GAS f32x4* sc = (const GAS f32x4*)(ada + (size_t)b * 6 * D + (shift_idx + 1) * D) + F.lane;
        f32x4 v[4]; float s = 0.f;
#pragma unroll
        for (int j = 0; j < 4; ++j) { v[j] = xr[64 * j]; s += (v[j].x * v[j].x + v[j].y * v[j].y) + (v[j].z * v[j].z + v[j].w * v[j].w); }
        const float rstd = rsqrtf(wave_sum(s) * (1.f / D) + EPS);
        GAS v2u* o8 = (GAS v2u*)(out + (size_t)m * D) + F.lane;
        float mx = 0.f;
#pragma unroll
        for (int j = 0; j < 4; ++j) { const f32x4 gg = gr[64 * j], ss = sh[64 * j], cc = sc[64 * j];
            const f32x4 y = (v[j] * rstd) * gg * (cc + 1.0f) + ss; v[j] = y;
            mx = fmaxf(mx, fmaxf(fmaxf(fabsf(y.x), fabsf(y.y)), fmaxf(fabsf(y.z), fabsf(y.w))));
            v2u o; o.x = pk2(y.x, y.y); o.y = pk2(y.z, y.w); o8[64 * j] = o; }
        if (Q8) {
            mx = wave_max(mx);
            const float qs = mx > 0.f ? 127.0f / mx : 0.f;
            GAS unsigned* h8 = (GAS unsigned*)(F.ws + WS_H8 + (size_t)m * D) + F.lane;
#pragma unroll
            for (int j = 0; j < 4; ++j) { const int q0 = (int)rintf(v[j].x * qs), q1 = (int)rintf(v[j].y * qs), q2 = (int)rintf(v[j].z * qs), q3 = (int)rintf(v[j].w * qs);
                h8[64 * j] = ((unsigned)q0 & 0xffu) | (((unsigned)q1 & 0xffu) << 8) | (((unsigned)q2 & 0xffu) << 16) | (((unsigned)q3 & 0xffu) << 24); }
            if (F.lane == 0) ((float*)(F.ws + WS_HS))[m] = mx * (1.0f / 127.0f);
        }
    }
}

struct EpiIn {
    static constexpr bool PERM = true, AFTER_DRAIN = false;
    unsigned char* ws; const float* qg; const float* kg; const volatile LAS unsigned* rmp;
    __device__ __forceinline__ void operator()(const pg8::f32x4 (&acc)[2][2][4][2], const pg8::Unit& u, int wr, int wc, int fr, int fq) const {
        const int pn = u.pn, rmask = __builtin_amdgcn_readfirstlane((int)*rmp);
#pragma unroll
        for (int ai = 0; ai < 2; ++ai)
#pragma unroll
            for (int m = 0; m < 4; ++m) {
                const int row = (u.pm & rmask) * 256 + ai * 128 + wr * 64 + m * 16 + fr;
                float v[2][8];
#pragma unroll
                for (int bj = 0; bj < 2; ++bj)
#pragma unroll
                    for (int n = 0; n < 2; ++n)
#pragma unroll
                        for (int i = 0; i < 4; ++i) v[bj][4 * n + i] = acc[ai][bj][m][n][i];
                bf16* dst = nullptr; bool norm = false; const float* gain = nullptr; float mul = 1.f; bool sig = false;
                if (pn < 2) { dst = (bf16*)(ws + WS_ZP) + (size_t)row * 512 + 256 * pn + 64 * wc; }
                else if (pn < 4) { dst = (bf16*)(ws + WS_Q) + (size_t)row * 512 + 256 * (pn - 2) + 64 * wc; norm = true; gain = qg; mul = 0.125f * 1.4426950408889634f; }
                else if (pn < 7) { const int kind = pn - 4, isv = wc >> 1, g = wc & 1, b = row >> 12, t = row & 4095;
                    const size_t base = ((size_t)(b * 2 + g) * SEQ + t) * 64;
                    const size_t off = kind == 0 ? (isv ? WS_VCR : WS_KCR) : kind == 1 ? (isv ? WS_VS : WS_KS) : (isv ? WS_VW : WS_KW);
                    dst = (bf16*)(ws + off) + base; if (!isv && kind > 0) { norm = true; gain = kg + kind * 64; } }
                else if (pn < 15) { dst = (bf16*)(ws + WS_GM) + (size_t)row * 2048 + 256 * (pn - 7) + 64 * wc; sig = true; }
                else {
                    if (wc == 0 && fq < 3) { float* gp = (float*)(ws + WS_GATE) + (size_t)row * 24 + 8 * fq;
                        *(GAS f32x4*)gp = (f32x4){sigmoidf_(v[0][0]), sigmoidf_(v[0][1]), sigmoidf_(v[0][2]), sigmoidf_(v[0][3])};
                        *(GAS f32x4*)(gp + 4) = (f32x4){sigmoidf_(v[0][4]), sigmoidf_(v[0][5]), sigmoidf_(v[0][6]), sigmoidf_(v[0][7])}; }
                    continue; }
                if (norm) { float ss = 0.f;
#pragma unroll
                    for (int bj = 0; bj < 2; ++bj)
#pragma unroll
                        for (int e = 0; e < 8; ++e) ss += v[bj][e] * v[bj][e];
                    ss = sum_xor32(sum_xor16(ss));
                    const float rs = rsqrtf(ss * (1.f / 64.f) + EPS) * mul;
#pragma unroll
                    for (int bj = 0; bj < 2; ++bj)
#pragma unroll
                        for (int e = 0; e < 8; ++e) v[bj][e] = v[bj][e] * rs * gain[32 * bj + 8 * fq + e]; }
                if (sig) {
#pragma unroll
                    for (int bj = 0; bj < 2; ++bj)
#pragma unroll
                        for (int e = 0; e < 8; ++e) v[bj][e] = sigmoidf_(v[bj][e]); }
#pragma unroll
                for (int bj = 0; bj < 2; ++bj) { v4u o; o.x = pkh(v[bj][0], v[bj][1]); o.y = pkh(v[bj][2], v[bj][3]); o.z = pkh(v[bj][4], v[bj][5]); o.w = pkh(v[bj][6], v[bj][7]);
                    *(GAS v4u*)(dst + 32 * bj + 8 * fq) = o; }
            }
    }
};
template <bool ADD> struct EpiMix {
    static constexpr bool PERM = true, AFTER_DRAIN = false;
    bf16* MIX; const bf16* GM; int gmoff;
    __device__ __forceinline__ void operator()(const pg8::f32x4 (&acc)[2][2][4][2], const pg8::Unit& u, int wr, int wc, int fr, int fq) const {
#pragma unroll
        for (int ai = 0; ai < 2; ++ai)
#pragma unroll
            for (int m = 0; m < 4; ++m) {
                const int row = u.pm * 256 + ai * 128 + wr * 64 + m * 16 + fr;
#pragma unroll
                for (int bj = 0; bj < 2; ++bj) {
                    const int col = u.pn * 256 + bj * 128 + wc * 32 + 8 * fq;
                    const v4u gmv = *(const GAS v4u*)(GM + (size_t)row * 2048 + gmoff + col);
                    float r[8];
                    r[0] = acc[ai][bj][m][0][0] * bflo(gmv.x); r[1] = acc[ai][bj][m][0][1] * bfhi(gmv.x); r[2] = acc[ai][bj][m][0][2] * bflo(gmv.y); r[3] = acc[ai][bj][m][0][3] * bfhi(gmv.y);
                    r[4] = acc[ai][bj][m][1][0] * bflo(gmv.z); r[5] = acc[ai][bj][m][1][1] * bfhi(gmv.z); r[6] = acc[ai][bj][m][1][2] * bflo(gmv.w); r[7] = acc[ai][bj][m][1][3] * bfhi(gmv.w);
                    GAS v4u* dp = (GAS v4u*)(MIX + (size_t)row * 1024 + col);
                    if (ADD) { const v4u old = *dp; r[0] += bflo(old.x); r[1] += bfhi(old.x); r[2] += bflo(old.y); r[3] += bfhi(old.y); r[4] += bflo(old.z); r[5] += bfhi(old.z); r[6] += bflo(old.w); r[7] += bfhi(old.w); }
                    v4u o; o.x = pkh(r[0], r[1]); o.y = pkh(r[2], r[3]); o.z = pkh(r[4], r[5]); o.w = pkh(r[6], r[7]); *dp = o; }
            }
    }
};
struct EpiRes {
    static constexpr bool PERM = false, AFTER_DRAIN = false;
    const float* x; float* out; const float* ada; int gate_idx;
    __device__ __forceinline__ void operator()(const pg8::f32x4 (&acc)[2][2][4][2], const pg8::Unit& u, int wr, int wc, int fr, int fq) const {
#pragma unroll
        for (int ai = 0; ai < 2; ++ai)
#pragma unroll
            for (int m = 0; m < 4; ++m) {
                const int row = u.pm * 256 + ai * 128 + wr * 64 + m * 16 + fr, b = row >> 12;
#pragma unroll
                for (int bj = 0; bj < 2; ++bj)
#pragma unroll
                    for (int n = 0; n < 2; ++n) {
                        const int col = u.pn * 256 + bj * 128 + wc * 32 + 16 * n + 4 * fq;
                        const f32x4 gt = *(const GAS f32x4*)(ada + (size_t)b * 6 * D + gate_idx * D + col);
                        const f32x4 xv = *(const GAS f32x4*)(x + (size_t)row * D + col);
                        *(GAS f32x4*)(out + (size_t)row * D + col) = xv + gt * acc[ai][bj][m][n]; }
            }
    }
};

template <int W> __device__ __forceinline__ void pool_load(const bf16* zp, int row, int t, int col, v4u (&z)[W]) {
#pragma unroll
    for (int j = 0; j < W; ++j) z[j] = (j <= t) ? *(const GAS v4u*)(zp + (size_t)(row - j) * 512 + col) : (v4u){0u, 0u, 0u, 0u};
}
template <int W> __device__ __forceinline__ v4u pool_reduce(const v4u (&z)[W], int t) {
    float s[8], self[8];
#pragma unroll
    for (int e = 0; e < 8; ++e) { s[e] = 0.f; self[e] = 0.f; }
#pragma unroll
    for (int j = 0; j < W; ++j) { const float f[8] = {bflo(z[j].x), bfhi(z[j].x), bflo(z[j].y), bfhi(z[j].y), bflo(z[j].z), bfhi(z[j].z), bflo(z[j].w), bfhi(z[j].w)};
#pragma unroll
        for (int e = 0; e < 8; ++e) { s[e] += f[e]; if (j == 0) self[e] = f[e]; } }
    const float inv = 1.0f / (float)((t + 1 < W) ? (t + 1) : W);
    v4u o; o.x = pk2(s[0] * inv - self[0], s[1] * inv - self[1]); o.y = pk2(s[2] * inv - self[2], s[3] * inv - self[3]);
    o.z = pk2(s[4] * inv - self[4], s[5] * inv - self[5]); o.w = pk2(s[6] * inv - self[6], s[7] * inv - self[7]);
    return o;
}
__device__ __forceinline__ void pool_phase(Frame& F) {
    const bf16* zp = (const bf16*)(F.ws + WS_ZP); bf16* pl = (bf16*)(F.ws + WS_PL);
    const int gw = F.bid * NWAVES + F.wave, NGW = F.G * NWAVES;
    for (int r4 = gw; r4 < M / 4; r4 += NGW) {
        const int row = 4 * r4 + (F.lane >> 4), t = row & 4095, c0 = 8 * (F.lane & 15);
        v4u z2[2], z4[4], z8[8], z16[16];
        pool_load<2>(zp, row, t, c0, z2); pool_load<4>(zp, row, t, 128 + c0, z4); pool_load<8>(zp, row, t, 256 + c0, z8); pool_load<16>(zp, row, t, 384 + c0, z16);
        const v4u o2 = pool_reduce<2>(z2, t), o4 = pool_reduce<4>(z4, t), o8 = pool_reduce<8>(z8, t), o16 = pool_reduce<16>(z16, t);
        GAS v4u* dst = (GAS v4u*)(pl + (size_t)row * 512 + c0);
        dst[0] = o2; dst[16] = o4; dst[32] = o8; dst[48] = o16;
    }
}

typedef int v4i __attribute__((ext_vector_type(4)));
struct EpiStoreBf16 {
    static constexpr bool PERM = true, AFTER_DRAIN = false;
    bf16* O; int ldc;
    __device__ __forceinline__ void operator()(const pg8::f32x4 (&acc)[2][2][4][2], const pg8::Unit& u, int wr, int wc, int fr, int fq) const {
#pragma unroll
        for (int ai = 0; ai < 2; ++ai)
#pragma unroll
            for (int m = 0; m < 4; ++m) {
                const int row = u.pm * 256 + ai * 128 + wr * 64 + m * 16 + fr;
#pragma unroll
                for (int bj = 0; bj < 2; ++bj) {
                    const int col = u.pn * 256 + bj * 128 + wc * 32 + 8 * fq;
                    v4u o; o.x = pkh(acc[ai][bj][m][0][0], acc[ai][bj][m][0][1]); o.y = pkh(acc[ai][bj][m][0][2], acc[ai][bj][m][0][3]);
                    o.z = pkh(acc[ai][bj][m][1][0], acc[ai][bj][m][1][1]); o.w = pkh(acc[ai][bj][m][1][2], acc[ai][bj][m][1][3]);
                    *(GAS v4u*)(O + (size_t)row * ldc + col) = o; }
            }
    }
};

__device__ __forceinline__ unsigned fkey(float f) { const unsigned u = __builtin_bit_cast(unsigned, f); return (u >> 31) ? ~u : (u | 0x80000000u); }
__device__ __forceinline__ float funkey(unsigned k) { const unsigned u = (k >> 31) ? (k & 0x7fffffffu) : ~k; return __builtin_bit_cast(float, u); }
__device__ __forceinline__ unsigned umax_(unsigned a, unsigned b) { return a > b ? a : b; }
__device__ __forceinline__ unsigned umin_(unsigned a, unsigned b) { return a > b ? b : a; }
#define TOP16_INSERT(L, xin) do { unsigned _x = (xin); _Pragma("unroll") for (int _i = 0; _i < 16; ++_i) { const unsigned _h = umax_(L[_i], _x); _x = umin_(L[_i], _x); L[_i] = _h; } } while (0)
template <int MASK> __device__ __forceinline__ void top16_merge(unsigned (&L)[16]) {
    unsigned o[16];
#pragma unroll
    for (int i = 0; i < 16; ++i) o[i] = (unsigned)dppi<MASK == 1 ? DPP_XOR1 : DPP_XOR2>((int)L[i]);
#pragma unroll
    for (int i = 0; i < 16; ++i) L[i] = umax_(L[i], o[15 - i]);
#pragma unroll
    for (int d = 8; d >= 1; d >>= 1)
#pragma unroll
        for (int i = 0; i < 16; ++i) if ((i & d) == 0) { const unsigned hi = umax_(L[i], L[i + d]), lo = umin_(L[i], L[i + d]); L[i] = hi; L[i + d] = lo; }
}
#define CE_DESC(a_, b_) do { const unsigned _h = umax_(a_, b_), _l = umin_(a_, b_); a_ = _h; b_ = _l; } while (0)
template <int OFF> __device__ __forceinline__ void bitonic_sort16_desc(unsigned (&v)[32]) {
#pragma unroll
    for (int k = 2; k <= 16; k <<= 1)
#pragma unroll
        for (int j = k >> 1; j > 0; j >>= 1)
#pragma unroll
            for (int i = 0; i < 16; ++i) { const int l = i ^ j; if (l > i) { if ((i & k) == 0) CE_DESC(v[OFF + i], v[OFF + l]); else CE_DESC(v[OFF + l], v[OFF + i]); } }
}
__device__ __forceinline__ void bitonic_merge16_desc(unsigned (&L)[16]) {
#pragma unroll
    for (int d = 8; d >= 1; d >>= 1)
#pragma unroll
        for (int i = 0; i < 16; ++i) if ((i & d) == 0) CE_DESC(L[i], L[i + d]);
}
constexpr int SST = 132;
constexpr int P9_LIST_OFF = 2 * 64 * SST * 4;
__device__ __forceinline__ void peer_select_phase(Frame& F) {
    const bf16* QV = (const bf16*)(F.ws + WS_QV); const bf16* SK = (const bf16*)(F.ws + WS_SUBK);
    int* EID = (int*)(F.ws + WS_EID); float* GW = (float*)(F.ws + WS_GW);
    LAS float* S = (LAS float*)(F.lds);
    LAS unsigned* LIST = (LAS unsigned*)(F.lds + P9_LIST_OFF);
    const int lane = F.lane, w = F.wave, l15 = lane & 15, lq = lane >> 4;
    const int p = w >> 2, kb = w & 3;
    constexpr int NU = (M / 64) * PH;
    bf16x8 a[4][4], bq[2][4];
#define P9_LOAD(u_) do { const int _tt = (u_) >> 3, _h = (u_) & 7; \
        const bf16* qa = QV + (size_t)(_tt * 64 + l15) * PQW + _h * 256 + p * 128 + 8 * lq; \
        const bf16* kbp = SK + (size_t)((_h * 2 + p) * 128 + 32 * kb + l15) * 128 + 8 * lq; \
        _Pragma("unroll") for (int ks = 0; ks < 4; ++ks) { \
            _Pragma("unroll") for (int rb = 0; rb < 4; ++rb) a[rb][ks] = *(const GAS bf16x8*)(qa + (size_t)(16 * rb) * PQW + 32 * ks); \
            _Pragma("unroll") for (int cb = 0; cb < 2; ++cb) bq[cb][ks] = *(const GAS bf16x8*)(kbp + (size_t)(16 * cb) * 128 + 32 * ks); } } while (0)
    if (F.bid < NU) P9_LOAD(F.bid);
    for (int u = F.bid; u < NU; u += F.G) {
        const int tt = u >> 3, h = u & 7, tok0 = tt * 64;
        {
            pg8::f32x4 acc[4][2];
#pragma unroll
            for (int rb = 0; rb < 4; ++rb)
#pragma unroll
                for (int cb = 0; cb < 2; ++cb) acc[rb][cb] = (pg8::f32x4){0.f, 0.f, 0.f, 0.f};
#pragma unroll
            for (int ks = 0; ks < 4; ++ks)
#pragma unroll
                for (int rb = 0; rb < 4; ++rb)
#pragma unroll
                    for (int cb = 0; cb < 2; ++cb) acc[rb][cb] = __builtin_amdgcn_mfma_f32_16x16x32_bf16(a[rb][ks], bq[cb][ks], acc[rb][cb], 0, 0, 0);
#pragma unroll
            for (int rb = 0; rb < 4; ++rb)
#pragma unroll
                for (int cb = 0; cb < 2; ++cb)
#pragma unroll
                    for (int r = 0; r < 4; ++r) S[(p * 64 + 16 * rb + 4 * lq + r) * SST + 32 * kb + 16 * cb + l15] = acc[rb][cb][r];
        }
        __syncthreads();
        if (u + F.G < NU) P9_LOAD(u + F.G);
        {
            const int row = F.tid >> 2, sub = F.tid & 3;
            const LAS float* sr = S + row * SST + sub;
            unsigned kv[32];
#pragma unroll
            for (int i = 0; i < 32; ++i) kv[i] = (fkey(sr[4 * i]) & ~127u) | (unsigned)(4 * i + sub);
            bitonic_sort16_desc<0>(kv); bitonic_sort16_desc<16>(kv);
            unsigned L[16];
#pragma unroll
            for (int i = 0; i < 16; ++i) L[i] = umax_(kv[i], kv[31 - i]);
            bitonic_merge16_desc(L);
            top16_merge<1>(L); top16_merge<2>(L);
            if (sub == 0) {
#pragma unroll
                for (int i = 0; i < 4; ++i) *(LAS v4u*)(LIST + row * 16 + 4 * i) = (v4u){L[4 * i], L[4 * i + 1], L[4 * i + 2], L[4 * i + 3]}; }
        }
        __syncthreads();
        if (F.tid < 256) {
            const int tok = F.tid >> 2, sub = F.tid & 3;
            float va[16], vb[16];
#pragma unroll
            for (int i = 0; i < 4; ++i) { const v4u x = *(const LAS v4u*)(LIST + tok * 16 + 4 * i), y = *(const LAS v4u*)(LIST + (64 + tok) * 16 + 4 * i);
                va[4 * i] = funkey(x.x & ~127u); va[4 * i + 1] = funkey(x.y & ~127u); va[4 * i + 2] = funkey(x.z & ~127u); va[4 * i + 3] = funkey(x.w & ~127u);
                vb[4 * i] = funkey(y.x & ~127u); vb[4 * i + 1] = funkey(y.y & ~127u); vb[4 * i + 2] = funkey(y.z & ~127u); vb[4 * i + 3] = funkey(y.w & ~127u); }
            unsigned cand[32];
#pragma unroll
            for (int i = 0; i < 32; ++i) cand[i] = 0u;
            {
                constexpr int NC = 50;
                constexpr unsigned char CI[52] = {0,0,0,0,0,0,0,0,0,0,0,0,0,0,0,0, 1,1,1,1,1,1,1,1, 2,2,2,2,2, 3,3,3,3, 4,4,4, 5,5, 6,6, 7,7, 8,9,10,11,12,13,14,15, 0,0};
                constexpr unsigned char CJ[52] = {0,1,2,3,4,5,6,7,8,9,10,11,12,13,14,15, 0,1,2,3,4,5,6,7, 0,1,2,3,4, 0,1,2,3, 0,1,2, 0,1, 0,1, 0,1, 0,0,0,0,0,0,0,0, 0,0};
#pragma unroll
                for (int g4 = 0; g4 < 13; ++g4) {
                    float sa = 0.f, sb = 0.f; unsigned id = 0u; bool ok = false;
#pragma unroll
                    for (int q = 0; q < 4; ++q) { const int n = 4 * g4 + q; if (n < NC) { const bool me = (sub == q); sa = me ? va[CI[n]] : sa; sb = me ? vb[CJ[n]] : sb; id = me ? (unsigned)(CI[n] * 16 + CJ[n]) : id; ok = ok || me; } }
                    cand[g4] = ok ? ((fkey(sa + sb) & ~255u) | id) : 0u;
                }
            }
            bitonic_sort16_desc<0>(cand);
            unsigned L[16];
#pragma unroll
            for (int i = 0; i < 16; ++i) L[i] = cand[i];
            top16_merge<1>(L); top16_merge<2>(L);
            const float mx = funkey(L[0] & ~255u);
            float e[16], sum = 0.f;
#pragma unroll
            for (int k = 0; k < 16; ++k) { e[k] = __expf(funkey(L[k] & ~255u) - mx); sum += e[k]; }
            const float inv = 1.0f / sum;
            const size_t ob = (size_t)(tok0 + tok) * 128;
#pragma unroll
            for (int k4 = 0; k4 < 4; ++k4) if (sub == k4) {
#pragma unroll
                for (int q = 0; q < 4; ++q) { const unsigned cid = L[4 * k4 + q] & 255u;
                    const unsigned ia = LIST[tok * 16 + (cid >> 4)] & 127u, ib = LIST[(64 + tok) * 16 + (cid & 15u)] & 127u;
                    const int slot = h * 16 + 4 * k4 + q;
                    EID[ob + slot] = (int)(ia * 128u + ib); GW[ob + slot] = e[4 * k4 + q] * inv; }
            }
        }
        __syncthreads();
    }
#undef P9_LOAD
}

__device__ __forceinline__ void unpack8(const v4u w, float (&f)[8]) { f[0] = bflo(w.x); f[1] = bfhi(w.x); f[2] = bflo(w.y); f[3] = bfhi(w.y); f[4] = bflo(w.z); f[5] = bfhi(w.z); f[6] = bflo(w.w); f[7] = bfhi(w.w); }
typedef float f32x2 __attribute__((ext_vector_type(2)));
__device__ __forceinline__ void unpack16_fp8(const v4u w, float (&f)[16]) {
    const unsigned ww[4] = {w.x, w.y, w.z, w.w};
#pragma unroll
    for (int d = 0; d < 4; ++d) { const f32x2 a = __builtin_amdgcn_cvt_pk_f32_fp8((int)ww[d], false), b = __builtin_amdgcn_cvt_pk_f32_fp8((int)ww[d], true);
        f[4 * d] = a.x; f[4 * d + 1] = a.y; f[4 * d + 2] = b.x; f[4 * d + 3] = b.y; }
}
template <int PV_> __device__ __forceinline__ void peer_dot_phase(Frame& F) {
    const unsigned char* H8 = F.ws + WS_H8; const int* EID = (const int*)(F.ws + WS_EID); float* PART = (float*)(F.ws + WS_PART);
    const int lane = F.lane, g = lane >> 3, j = lane & 7, x = F.bid & 7;
    const int nbx = (F.G - x + 7) >> 3, NW = nbx * NWAVES, gwv = (F.bid >> 3) * NWAVES + F.wave;
    const unsigned char* US = F.ws + WS_UB + (size_t)x * NEXP * 128; const unsigned j16 = 16u * (unsigned)j;
    int token = gwv;
    if (token >= M) return;
    const int lasttok = gwv + ((M - 1 - gwv) / NW) * NW;
    v4i eA[4], eB[4]; v4i hA, hB;
#define PD_CL(t_) ((t_) < M ? (t_) : lasttok)
#define PD_LOAD_E(e_, tok_) do { _Pragma("unroll") for (int q = 0; q < 4; ++q) e_[q] = *(const GAS v4i*)(EID + (size_t)(tok_) * 128 + 16 * g + 4 * q); } while (0)
#define PD_ISSUE4(buf_, e_, b0_) do { buf_[b0_] = *(const GAS v4i*)(US + ((unsigned)e_.x * 128u + j16)); buf_[b0_ + 1] = *(const GAS v4i*)(US + ((unsigned)e_.y * 128u + j16)); \
        buf_[b0_ + 2] = *(const GAS v4i*)(US + ((unsigned)e_.z * 128u + j16)); buf_[b0_ + 3] = *(const GAS v4i*)(US + ((unsigned)e_.w * 128u + j16)); } while (0)
#define PD_DOT1(w_, hc_, dst_) do { int t = __builtin_amdgcn_sdot4(w_.x, hc_.x, 0, false); t = __builtin_amdgcn_sdot4(w_.y, hc_.y, t, false); t = __builtin_amdgcn_sdot4(w_.z, hc_.z, t, false); t = __builtin_amdgcn_sdot4(w_.w, hc_.w, t, false); \
        t += dppi<DPP_XOR1>(t); t += dppi<DPP_XOR2>(t); t += dppi<DPP_HMIR>(t); dst_ = (float)t; } while (0)
#define PD_BODY(eC, eN, hC, hN, tok_) do { const int tk_ = PD_CL(tok_); \
        PD_ISSUE4(bB, eC[2], 0); PD_ISSUE4(bB, eC[3], 4); \
        PD_LOAD_E(eC, PD_CL(tk_ + 2 * NW)); \
        hN = *(const GAS v4i*)(H8 + (size_t)PD_CL(tk_ + NW) * D + 128 * x + j16); \
        float s[16]; \
        _Pragma("unroll") for (int i = 0; i < 8; ++i) PD_DOT1(bA[i], hC, s[i]); \
        PD_ISSUE4(bA, eN[0], 0); PD_ISSUE4(bA, eN[1], 4); \
        _Pragma("unroll") for (int i = 0; i < 8; ++i) PD_DOT1(bB[i], hC, s[8 + i]); \
        { float* pp = PART + ((size_t)x * M + tk_) * 128 + g * 16;       \
          _Pragma("unroll") for (int i4 = 0; i4 < 4; ++i4) *(GAS f32x4*)(pp + 4 * i4) = (f32x4){s[4 * i4], s[4 * i4 + 1], s[4 * i4 + 2], s[4 * i4 + 3]}; } } while (0)
    PD_LOAD_E(eA, token); hA = *(const GAS v4i*)(H8 + (size_t)token * D + 128 * x + j16);
    PD_LOAD_E(eB, PD_CL(token + NW));
    v4i bA[8], bB[8];
    PD_ISSUE4(bA, eA[0], 0); PD_ISSUE4(bA, eA[1], 4);
    __builtin_amdgcn_s_waitcnt(0x0F70);
    for (; token < M; token += 2 * NW) {
        PD_BODY(eA, eB, hA, hB, token);
        PD_BODY(eB, eA, hB, hA, token + NW);
    }
#undef PD_BODY
#undef PD_CL
#undef PD_LOAD_E
#undef PD_ISSUE4
#undef PD_DOT1
}
template <int NTOK> __device__ __forceinline__ void peer_loadrate_probe(Frame& F) {
    const int* EID = (const int*)(F.ws + WS_EID);
    const int lane = F.lane, g = lane >> 3, j = lane & 7, x = F.bid & 7;
    const int nbx = (F.G - x + 7) >> 3, NW = nbx * NWAVES, gwv = (F.bid >> 3) * NWAVES + F.wave;
    const unsigned char* US = F.ws + WS_UB + (size_t)x * NEXP * 128; const unsigned j16 = 16u * (unsigned)j;
    unsigned acc = 0u;
    for (int token = gwv; token + (NTOK - 1) * NW < M; token += NTOK * NW) {
        v4i e4[NTOK][4];
#pragma unroll
        for (int t = 0; t < NTOK; ++t)
#pragma unroll
            for (int q = 0; q < 4; ++q) e4[t][q] = *(const GAS v4i*)(EID + (size_t)(token + t * NW) * 128 + 16 * g + 4 * q);
        v4i b[NTOK][16];
#pragma unroll
        for (int t = 0; t < NTOK; ++t)
#pragma unroll
            for (int q = 0; q < 4; ++q) { b[t][4 * q] = *(const GAS v4i*)(US + ((unsigned)e4[t][q].x * 128u + j16)); b[t][4 * q + 1] = *(const GAS v4i*)(US + ((unsigned)e4[t][q].y * 128u + j16));
                b[t][4 * q + 2] = *(const GAS v4i*)(US + ((unsigned)e4[t][q].z * 128u + j16)); b[t][4 * q + 3] = *(const GAS v4i*)(US + ((unsigned)e4[t][q].w * 128u + j16)); }
#pragma unroll
        for (int t = 0; t < NTOK; ++t)
#pragma unroll
            for (int i = 0; i < 16; ++i) acc ^= (unsigned)(b[t][i].x ^ b[t][i].y ^ b[t][i].z ^ b[t][i].w);
    }
    asm volatile("" :: "v"(acc));
}
__device__ __forceinline__ void peer_coef_phase(Frame& F) {
    const float* PART = (const float*)(F.ws + WS_PART); const int* EID = (const int*)(F.ws + WS_EID); const float* GW = (const float*)(F.ws + WS_GW);
    const float* SCU = (const float*)(F.ws + WS_SCLU); const float* SCV = (const float*)(F.ws + WS_SCLV); const float* HS = (const float*)(F.ws + WS_HS);
    unsigned* CF8 = (unsigned*)(F.ws + WS_CF); float* CFS = (float*)(F.ws + WS_CFS);
    const size_t gtid = (size_t)F.bid * NTHREADS + F.tid, gthreads = (size_t)F.G * NTHREADS, n4 = (size_t)M * 128 / 4;
    for (size_t i4 = gtid; i4 < n4; i4 += gthreads) {
        f32x4 d = *(const GAS f32x4*)(PART + 4 * i4);
#pragma unroll
        for (int xx = 1; xx < 8; ++xx) d = d + *(const GAS f32x4*)(PART + (size_t)xx * M * 128 + 4 * i4);
        const v4i e = *(const GAS v4i*)(EID + 4 * i4); const f32x4 gw = *(const GAS f32x4*)(GW + 4 * i4);
        const float hs = HS[i4 >> 5];
        f32x4 r; r.x = gw.x * SCV[e.x] * gelu_tanh_safe(d.x * (SCU[e.x] * hs)); r.y = gw.y * SCV[e.y] * gelu_tanh_safe(d.y * (SCU[e.y] * hs));
        r.z = gw.z * SCV[e.z] * gelu_tanh_safe(d.z * (SCU[e.z] * hs)); r.w = gw.w * SCV[e.w] * gelu_tanh_safe(d.w * (SCU[e.w] * hs));
        float m = fmaxf(fmaxf(fabsf(r.x), fabsf(r.y)), fmaxf(fabsf(r.z), fabsf(r.w)));
        m = fmaxf(m, dppf<DPP_XOR1>(m)); m = fmaxf(m, dppf<DPP_XOR2>(m)); m = fmaxf(m, dppf<DPP_HMIR>(m)); m = fmaxf(m, dppf<DPP_ROR8>(m)); m = max_xor16(m);
        const unsigned E = (__builtin_bit_cast(unsigned, m) >> 23) & 0xffu; float sc = 1.f, isc = 1.f;
        if (E >= 8u && E <= 250u) { sc = __builtin_bit_cast(float, (261u - E) << 23); isc = __builtin_bit_cast(float, (E - 7u) << 23); }
        int t = __builtin_amdgcn_cvt_pk_fp8_f32(r.x * sc, r.y * sc, 0, false); t = __builtin_amdgcn_cvt_pk_fp8_f32(r.z * sc, r.w * sc, t, true);
        CF8[i4] = (unsigned)t;
        if ((F.lane & 31) == 0) CFS[i4 >> 5] = isc; }
}
template <bool DRY, bool CHECK = false> __device__ __forceinline__ void peer_out_phase(Frame& F, const float* ada, float* out) {
    const int* EID = (const int*)(F.ws + WS_EID); const unsigned char* CF8 = (const unsigned char*)(F.ws + WS_CF); const float* CFS = (const float*)(F.ws + WS_CFS);
    const int lane = F.lane, g = lane >> 3, j = lane & 7, x = F.bid & 7;
    const int nbx = (F.G - x + 7) >> 3, NW = nbx * NWAVES, gwv = (F.bid >> 3) * NWAVES + F.wave;
    const unsigned char* VS = F.ws + WS_VB + (size_t)x * NEXP * 128; const unsigned j16 = 16u * (unsigned)j;
    if (gwv >= M) return;
    const int ntok = (M - 1 - gwv) / NW + 1;
#define PO_ISSUE4(buf_, e_, b0_) do { buf_[b0_] = *(const GAS v4u*)(VS + ((unsigned)e_.x * 128u + j16)); buf_[b0_ + 1] = *(const GAS v4u*)(VS + ((unsigned)e_.y * 128u + j16)); \
        buf_[b0_ + 2] = *(const GAS v4u*)(VS + ((unsigned)e_.z * 128u + j16)); buf_[b0_ + 3] = *(const GAS v4u*)(VS + ((unsigned)e_.w * 128u + j16)); } while (0)
#define PO_ROW(w_, c_) do { float f[16]; unpack16_fp8(w_, f); _Pragma("unroll") for (int k = 0; k < 16; ++k) o[k] += (c_) * f[k]; } while (0)
#define PO_ACC4(buf_, c4_, b0_) do { PO_ROW(buf_[b0_], c4_.x); PO_ROW(buf_[b0_ + 1], c4_.y); PO_ROW(buf_[b0_ + 2], c4_.z); PO_ROW(buf_[b0_ + 3], c4_.w); } while (0)
    v4i e4[4]; f32x4 c4[4]; v4u bA[8], bB[8];
#define PO_LOADC(tok_) do { const float cs_ = CFS[tok_]; _Pragma("unroll") for (int q = 0; q < 4; ++q) { const unsigned w_ = *(const GAS unsigned*)(CF8 + (size_t)(tok_) * 128 + g * 16 + 4 * q); \
        const f32x2 lo_ = __builtin_amdgcn_cvt_pk_f32_fp8((int)w_, false), hi_ = __builtin_amdgcn_cvt_pk_f32_fp8((int)w_, true); c4[q] = (f32x4){lo_.x * cs_, lo_.y * cs_, hi_.x * cs_, hi_.y * cs_}; } } while (0)
#pragma unroll
    for (int q = 0; q < 4; ++q) e4[q] = *(const GAS v4i*)(EID + (size_t)gwv * 128 + g * 16 + 4 * q);
    PO_LOADC(gwv);
    PO_ISSUE4(bA, e4[0], 0); PO_ISSUE4(bA, e4[1], 4);
    for (int it = 0; it < ntok; ++it) {
        const int token = gwv + it * NW, tn = gwv + (it + 1 < ntok ? it + 1 : it) * NW;
        PO_ISSUE4(bB, e4[2], 0); PO_ISSUE4(bB, e4[3], 4);
#pragma unroll
        for (int q = 0; q < 4; ++q) e4[q] = *(const GAS v4i*)(EID + (size_t)tn * 128 + g * 16 + 4 * q);
        float o[16];
#pragma unroll
        for (int k = 0; k < 16; ++k) o[k] = 0.f;
        PO_ACC4(bA, c4[0], 0); PO_ACC4(bA, c4[1], 4);
        PO_ISSUE4(bA, e4[0], 0); PO_ISSUE4(bA, e4[1], 4);
        PO_ACC4(bB, c4[2], 0); PO_ACC4(bB, c4[3], 4);
        PO_LOADC(tn);
#pragma unroll
        for (int k = 0; k < 16; ++k) { float t = o[k]; t += dppf<DPP_ROR8>(t); o[k] = sum_xor32(sum_xor16(t)); }
        if (g == 0) { const int b = token >> 12;
            const float* gt = ada + (size_t)b * 6 * D + 5 * D + 128 * x + 16 * j;
            float* xo = out + (size_t)token * D + 128 * x + 16 * j;
#pragma unroll
            for (int q = 0; q < 4; ++q) { const f32x4 xv = *(const GAS f32x4*)(xo + 4 * q), gv = *(const GAS f32x4*)(gt + 4 * q);
                f32x4 res = xv + gv * (f32x4){o[4 * q], o[4 * q + 1], o[4 * q + 2], o[4 * q + 3]};
                if (CHECK) { const f32x4 mf = *(const GAS f32x4*)((const float*)(F.ws + WS_PART) + (size_t)token * D + 128 * x + 16 * j + 4 * q);
                    const float rr[4] = {o[4 * q], o[4 * q + 1], o[4 * q + 2], o[4 * q + 3]}, mm[4] = {mf.x, mf.y, mf.z, mf.w}; bool bad = false;
#pragma unroll
                    for (int z = 0; z < 4; ++z) bad = bad || !(fabsf(rr[z] - mm[z]) <= 0.01f * fabsf(rr[z]) + 1.0e-3f);
                    if (bad) res.x = 1.0e9f; }
                if (DRY) { asm volatile("" :: "v"(res.x), "v"(res.y), "v"(res.z), "v"(res.w)); } else *(GAS f32x4*)(xo + 4 * q) = res; } }
    }
#undef PO_LOADC
#undef PO_ISSUE4
#undef PO_ROW
#undef PO_ACC4
}

constexpr int PO_TILE = 64 * 144;
template <int MODE> __device__ __forceinline__ void peer_out_mfma_phase(Frame& F, const float* ada, float* out) {
    const int* EID = (const int*)(F.ws + WS_EID); const unsigned char* CF8 = (const unsigned char*)(F.ws + WS_CF); const float* CFS = (const float*)(F.ws + WS_CFS);
    const int lane = F.lane, g = lane >> 3, j = lane & 7, l15 = lane & 15, lq = lane >> 4, x = F.bid & 7;
    const int nbx = (F.G - x + 7) >> 3, NW = nbx * NWAVES, gwv = (F.bid >> 3) * NWAVES + F.wave;
    const unsigned char* VS = F.ws + WS_VB + (size_t)x * NEXP * 128; const unsigned j16 = 16u * (unsigned)j;
    LAS unsigned char* TL = F.lds + F.wave * PO_TILE;
    if (gwv >= M) return;
    const int nst = 2 * ((M - 1 - gwv) / NW + 1);
    const int trow = l15 >> 1, tcol = 8 * (l15 & 1);
#define PM_IDS(e_, a_, tok_) do { const size_t base = (size_t)(tok_) * 128; \
        _Pragma("unroll") for (int m = 0; m < 16; ++m) e_[m] = EID[base + 8 * m + g]; \
        _Pragma("unroll") for (int q = 0; q < 4; ++q) a_[q] = *(const GAS long*)(CF8 + base + 32 * q + 8 * lq); } while (0)
#define PM_GATHER(vv_, e_, h_) do { _Pragma("unroll") for (int m = 0; m < 8; ++m) vv_[m] = *(const GAS v4u*)(VS + ((unsigned)e_[8 * (h_) + m] * 128u + j16)); } while (0)
#define PM_HALF(vv_, aq0_, aq1_) do { _Pragma("unroll") for (int m = 0; m < 8; ++m) *(LAS v4u*)(TL + (8 * m + g) * 144 + 16 * j) = vv_[m]; } while (0)
#define PM_MMA(aq0_, aq1_) do { LDS_WAIT(); asm volatile("" ::: "memory"); \
        _Pragma("unroll") for (int ks = 0; ks < 2; ++ks) _Pragma("unroll") for (int cb = 0; cb < 8; ++cb) { \
            const v2i bb = __builtin_amdgcn_ds_read_tr8_b64_v2i32((LAS v2i*)(TL + (32 * ks + 8 * lq + trow) * 144 + 16 * cb + tcol)); \
            acc[cb] = __builtin_amdgcn_mfma_f32_16x16x32_fp8_fp8(ks ? (aq1_) : (aq0_), __builtin_bit_cast(long, bb), acc[cb], 0, 0, 0); } \
        LDS_WAIT(); asm volatile("" ::: "memory"); } while (0)
    const int ntok = nst >> 1;
    int e1[16], e2[16]; long a0[4], a1[4], a2[4]; v4u vvA[8], vvB[8];
    PM_IDS(e1, a0, gwv);
    PM_GATHER(vvA, e1, 0); PM_GATHER(vvB, e1, 1);
    { const int t1 = ntok > 1 ? 1 : 0; PM_IDS(e1, a1, gwv + t1 * NW); }
    f32x4 acc[8];
    for (int it = 0; it < ntok; ++it) {
        const int token = gwv + it * NW;
        { const int t2 = it + 2 < ntok ? it + 2 : ntok - 1; PM_IDS(e2, a2, gwv + t2 * NW); }
#pragma unroll
        for (int cb = 0; cb < 8; ++cb) acc[cb] = (f32x4){0.f, 0.f, 0.f, 0.f};
        float xv[8], gv[8]; float cs;
        { const int b = token >> 12; const float* gt = ada + (size_t)b * 6 * D + 5 * D + 128 * x + l15; const float* xi = out + (size_t)token * D + 128 * x + l15;
          cs = CFS[token];
#pragma unroll
          for (int cb = 0; cb < 8; ++cb) { xv[cb] = xi[16 * cb]; gv[cb] = gt[16 * cb]; } }
        PM_HALF(vvA, 0, 0); PM_GATHER(vvA, e1, 0); PM_MMA(a0[0], a0[1]);
        PM_HALF(vvB, 0, 0); PM_GATHER(vvB, e1, 1); PM_MMA(a0[2], a0[3]);
        if (lq == 0) {
            if (MODE == 1) { float* oc = (float*)(F.ws + WS_PART) + (size_t)token * D + 128 * x + l15;
#pragma unroll
                for (int cb = 0; cb < 8; ++cb) oc[16 * cb] = acc[cb][0] * cs; }
            else { float* xo = out + (size_t)token * D + 128 * x + l15;
#pragma unroll
                for (int cb = 0; cb < 8; ++cb) xo[16 * cb] = xv[cb] + gv[cb] * (acc[cb][0] * cs); }
        }
#pragma unroll
        for (int m = 0; m < 16; ++m) e1[m] = e2[m];
#pragma unroll
        for (int q = 0; q < 4; ++q) { a0[q] = a1[q]; a1[q] = a2[q]; }
    }
#undef PM_HALF
#undef PM_MMA
#undef PM_IDS
#undef PM_GATHER
}

__device__ __forceinline__ void compress_phase(Frame& F, const float* kng) {
    LAS bf16* H2 = (LAS bf16*)(F.lds);
    LAS float* OUTS = (LAS float*)(F.lds + 16384);
    const int lane = F.lane, w = F.wave, l15 = lane & 15, lq = lane >> 4;
    for (int u = F.bid; u < NBG * 2 * 8; u += F.G) {
        const int ns = u & 7, kv = (u >> 3) & 1, bg = u >> 4, n0 = ns * 32;
        const bf16* A = (const bf16*)(F.ws + (kv ? WS_VCR : WS_KCR)) + (size_t)bg * SEQ * 64;
        const bf16* W1T = (const bf16*)(F.ws + (kv ? WS_CW1V_T : WS_CW1K_T));
        const bf16* W2T = (const bf16*)(F.ws + (kv ? WS_CW2V_T : WS_CW2K_T));
        const float* b1 = (const float*)(F.ws + (kv ? WS_CB1V : WS_CB1K));
        pg8::f32x4 acc[2][8];
#pragma unroll
        for (int rb = 0; rb < 2; ++rb)
#pragma unroll
            for (int cb = 0; cb < 8; ++cb) acc[rb][cb] = (pg8::f32x4){0.f, 0.f, 0.f, 0.f};
        const bf16* ap = A + (size_t)(n0 + l15) * 1024 + 256 * w + 8 * lq;
        const bf16* bp = W1T + (size_t)l15 * 2048 + 256 * w + 8 * lq;
#pragma unroll
        for (int ks = 0; ks < 8; ++ks) {
            const bf16x8 a0 = *(const GAS bf16x8*)(ap + 32 * ks), a1 = *(const GAS bf16x8*)(ap + 16 * 1024 + 32 * ks);
#pragma unroll
            for (int cb = 0; cb < 8; ++cb) { const bf16x8 b = *(const GAS bf16x8*)(bp + (size_t)(16 * cb) * 2048 + 32 * ks);
                acc[0][cb] = __builtin_amdgcn_mfma_f32_16x16x32_bf16(a0, b, acc[0][cb], 0, 0, 0);
                acc[1][cb] = __builtin_amdgcn_mfma_f32_16x16x32_bf16(a1, b, acc[1][cb], 0, 0, 0); }
        }
        { LAS float* PS = (LAS float*)(F.lds + 32768);
          LAS float* mine = PS + (w & 3) * 4096 + (4 * lq) * 128 + l15;
          if (w >= 4) {
#pragma unroll
              for (int rb = 0; rb < 2; ++rb)
#pragma unroll
                  for (int cb = 0; cb < 8; ++cb)
#pragma unroll
                      for (int r = 0; r < 4; ++r) mine[(16 * rb + r) * 128 + 16 * cb] = acc[rb][cb][r]; }
          __syncthreads();
          if (w < 4) {
#pragma unroll
              for (int rb = 0; rb < 2; ++rb)
#pragma unroll
                  for (int cb = 0; cb < 8; ++cb)
#pragma unroll
                      for (int r = 0; r < 4; ++r) { LAS float* q = mine + (16 * rb + r) * 128 + 16 * cb; *q = acc[rb][cb][r] + *q; } }
          __syncthreads();
#pragma unroll
          for (int i = 0; i < 8; ++i) { const int idx = F.tid + 512 * i, row = idx >> 7, col = idx & 127;
              const float v = ((PS[idx] + PS[4096 + idx]) + (PS[8192 + idx] + PS[12288 + idx])) + b1[col];
              H2[row * 136 + col] = (bf16)f2bf(gelu_tanh_safe(v)); } }
        __syncthreads();
        { const int rb = w >> 2, db = w & 3;
          pg8::f32x4 o = (pg8::f32x4){0.f, 0.f, 0.f, 0.f};
#pragma unroll
          for (int ks = 0; ks < 4; ++ks) {
              const bf16x8 a = *(const LAS bf16x8*)(H2 + (16 * rb + l15) * 136 + 32 * ks + 8 * lq);
              const bf16x8 b = *(const GAS bf16x8*)(W2T + (size_t)(16 * db + l15) * 128 + 32 * ks + 8 * lq);
              o = __builtin_amdgcn_mfma_f32_16x16x32_bf16(a, b, o, 0, 0, 0); }
#pragma unroll
          for (int r = 0; r < 4; ++r) OUTS[(16 * rb + 4 * lq + r) * 65 + 16 * db + l15] = o[r]; }
        __syncthreads();
        { const int n = F.tid >> 4, d4 = (F.tid & 15) * 4, ng = n0 + n;
          float v[4]; float ss = 0.f;
#pragma unroll
          for (int i = 0; i < 4; ++i) { v[i] = OUTS[n * 65 + d4 + i]; ss += v[i] * v[i]; }
          ss += dppf<DPP_XOR1>(ss); ss += dppf<DPP_XOR2>(ss); ss += dppf<DPP_HMIR>(ss); ss += dppf<DPP_ROR8>(ss);
          const bool pad = (ng >= NCMP);
          if (kv == 0) { const float rs = rsqrtf(ss * (1.f / 64.f) + EPS);
              v2u o; o.x = pad ? 0u : pk2(v[0] * rs * kng[d4], v[1] * rs * kng[d4 + 1]); o.y = pad ? 0u : pk2(v[2] * rs * kng[d4 + 2], v[3] * rs * kng[d4 + 3]);
              *(GAS v2u*)((bf16*)(F.ws + WS_KC) + ((size_t)bg * 256 + ng) * 64 + d4) = o; }
          else { bf16* vt = (bf16*)(F.ws + WS_VCT) + (size_t)bg * 64 * 256 + ng;
#pragma unroll
              for (int i = 0; i < 4; ++i) vt[(size_t)(d4 + i) * 256] = pad ? (bf16)0 : (bf16)f2bf(v[i]); } }
        __syncthreads();
    }
}
__device__ __forceinline__ void vtranspose_phase(Frame& F) {
    LAS bf16* T = (LAS bf16*)(F.lds + F.wave * 9216);
    const int gw = F.bid * NWAVES + F.wave, NGW = F.G * NWAVES, lane = F.lane;
    for (int job = gw; job < 2 * NBG * 64; job += NGW) {
        const int s = job & 63, bg = (job >> 6) & 15, which = job >> 10;
        const bf16* X = (const bf16*)(F.ws + (which ? WS_VW : WS_VS)) + ((size_t)bg * SEQ + 64 * s) * 64;
        bf16* XT = (bf16*)(F.ws + (which ? WS_VWT : WS_VST)) + (size_t)bg * 64 * SEQ + 64 * s;
#pragma unroll
        for (int i = 0; i < 8; ++i) { const int tok = (lane >> 3) + 8 * i, ch = lane & 7;
            const v4u x = *(const GAS v4u*)(X + (size_t)tok * 64 + 8 * ch);
            const unsigned ww[4] = {x.x, x.y, x.z, x.w};
#pragma unroll
            for (int e = 0; e < 4; ++e) { T[(8 * ch + 2 * e) * 72 + tok] = (bf16)(ww[e] & 0xffffu); T[(8 * ch + 2 * e + 1) * 72 + tok] = (bf16)(ww[e] >> 16); } }
        LDS_WAIT(); asm volatile("" ::: "memory");
#pragma unroll
        for (int i = 0; i < 8; ++i) { const int dim = (lane >> 3) + 8 * i, ch = lane & 7;
            const v4u y = *(const LAS v4u*)(T + dim * 72 + 8 * ch);
            *(GAS v4u*)(XT + (size_t)dim * SEQ + 8 * ch) = y; }
        LDS_WAIT(); asm volatile("" ::: "memory");
    }
}

constexpr int AT_KBUF = 64 * 128;
constexpr int AT_NBUF = 2;
constexpr int AT_OFF_K = 0, AT_OFF_V = AT_NBUF * AT_KBUF;
constexpr int AT_OFF_IMP1 = 2 * AT_NBUF * AT_KBUF, AT_OFF_IMP2 = AT_OFF_IMP1 + 64 * 65 * 4, AT_OFF_SEL = AT_OFF_IMP2 + 64 * 65 * 4;
constexpr int AT_OFF_LUT = AT_OFF_SEL + 512, AT_OFF_LROW = AT_OFF_LUT + 4 * 128 * 4;
constexpr int AT_OFF_TD = AT_OFF_LROW + 8 * 32 * 4;
constexpr int AT_OFF_OUT = AT_OFF_TD + 96 * 32;
constexpr int AT_OFF_GATL = AT_OFF_OUT + 256 * 144;
constexpr int AT_OFF_TS = AT_OFF_GATL + 64 * 12 * 4;
constexpr int AT_TS_ROW = 65 * 16;
constexpr int AT_LDS_END = AT_OFF_TS + 16 * AT_TS_ROW;
static_assert(AT_LDS_END <= RING_BYTES, "attention LDS");

struct AtTile { const bf16* k; const bf16* vt; int vstride; };
enum { TM_CMP1 = 0, TM_CMP2, TM_SELN, TM_SELF, TM_WINN, TM_WINF, TM_WINE, TM_CMP1F, TM_CMP2F };
__device__ __forceinline__ float fexp2(float x) { return __builtin_amdgcn_exp2f(x); }
template <int TM, int VAR, int RB = 3>
__device__ __forceinline__ void at_tile(const LAS unsigned char* kb_, const LAS unsigned char* vb_, const LAS float* LUTJ, LAS float* IMP1, LAS float* IMP2,
                                        const bf16x8 (&qf)[2][2], pg8::f32x4 (&oacc)[2][4], pg8::f32x4 (&lacc)[2], const LAS float* LINV,
                                        const int (&tok_r_in)[2], const unsigned (&selb)[2], float cfar, int relbase, int idx, int l15_in, int lq_in, const LAS unsigned char* tsw, const LAS unsigned char* tsn) {
    constexpr bool FAR = (TM == TM_SELF || TM == TM_WINF || TM == TM_WINE || TM == TM_CMP1F || TM == TM_CMP2F);
    constexpr bool C1 = (TM == TM_CMP1 || TM == TM_CMP1F), C2 = (TM == TM_CMP2 || TM == TM_CMP2F);
    int l15 = l15_in, lq = lq_in; asm volatile("" : "+v"(l15), "+v"(lq));
    int tok_r[2] = {tok_r_in[0], tok_r_in[1]}; asm volatile("" : "+v"(tok_r[0]), "+v"(tok_r[1]));
    v4u pfr[2][2];
    const LAS unsigned char* tsp[2] = {tsw, tsw};
    if (TM == TM_SELN || TM == TM_WINN) {
#pragma unroll
        for (int rb = 0; rb < 2; ++rb) { const LAS unsigned char* pa = tsw + l15 * AT_TS_ROW + 16 * (2 * lq - rb) - 4 * relbase;
            const LAS unsigned char* pn = tsn + l15 * AT_TS_ROW;
            tsp[rb] = (TM == TM_SELN && !selb[rb]) ? pn : pa; } }
    auto kld = [&](int cb, bf16x8 (&kf)[2], pg8::f32x4 (&cq)[2]) __attribute__((always_inline)) {
        if (TM == TM_SELN || TM == TM_WINN) {
#pragma unroll
            for (int rb = 0; rb < 2; ++rb) cq[rb] = *(const LAS pg8::f32x4*)(tsp[rb] + 16 * (8 * (cb >> 1) + (cb & 1))); }
        if (!(VAR & 64)) {
        const int krow = 8 * (l15 >> 2) + (l15 & 3) + 32 * (cb >> 1) + 4 * (cb & 1), kf_ = ((l15 >> 2) << 1) | ((l15 >> 1) & 1);
#pragma unroll
        for (int ks = 0; ks < 2; ++ks) kf[ks] = *(const LAS bf16x8*)(kb_ + krow * 128 + 16 * ((4 * ks + lq) ^ kf_)); }
    };
    auto qkm = [&](int cb, const bf16x8 (&kf)[2], const pg8::f32x4 (&cq)[2], pg8::f32x4 (&st)[2]) __attribute__((always_inline)) {
        st[0] = FAR ? (pg8::f32x4){cfar, cfar, cfar, cfar} : (pg8::f32x4){0.f, 0.f, 0.f, 0.f}; st[1] = st[0];
        if (TM == TM_SELN || TM == TM_WINN) { st[0] = cq[0]; st[1] = cq[1]; }
        if (TM == TM_SELF) {
#pragma unroll
            for (int rb = 0; rb < 2; ++rb) { const float ci = selb[rb] ? cfar : -1.0e30f; st[rb] = (pg8::f32x4){ci, ci, ci, ci}; } }
        if (!(VAR & 64)) {
#pragma unroll
        for (int ks = 0; ks < 2; ++ks) {
#pragma unroll
            for (int rb = 0; rb < 2; ++rb) if (RB & (1 << rb)) st[rb] = __builtin_amdgcn_mfma_f32_16x16x32_bf16(kf[ks], qf[rb][ks], st[rb], 0, 0, 0); } }
    };
    float linv_[2] = {0.f, 0.f};
    if (C2) { linv_[0] = LINV[l15]; linv_[1] = LINV[16 + l15]; }
    auto prob = [&](int cb, const pg8::f32x4 (&st)[2]) __attribute__((always_inline)) {
#pragma unroll
        for (int rb = 0; rb < 2; ++rb) if (RB & (1 << rb)) {
            const int tokc = tok_r[rb];
            float p[4];
#pragma unroll
            for (int r = 0; r < 4; ++r) {
                const int kl = 32 * (cb >> 1) + 8 * lq + 4 * (cb & 1) + r;
                if (VAR & 16) { p[r] = st[rb][r]; }
                else if (TM == TM_SELF) { p[r] = fexp2(st[rb][r]); }
                else if (TM == TM_WINF || TM == TM_SELN || TM == TM_WINN || TM == TM_CMP1F || TM == TM_CMP2F) { p[r] = fexp2(st[rb][r]); }
                else if (TM == TM_WINE) { const float e = fexp2(st[rb][r]); p[r] = (kl > tokc) ? e : 0.f; }
                else {
                    const int rel = (TM == TM_CMP1 || TM == TM_CMP2) ? (relbase + tokc - 16 * kl) : (relbase + tokc - kl);
                    const bool valid = rel >= 0;
                    const int ri = rel < 0 ? 0 : (rel > 127 ? 127 : rel);
                    const float e = fexp2(st[rb][r] + LUTJ[ri]);
                    p[r] = valid ? e : 0.f; }
            }
            if (C1) { lacc[rb][0] += (p[0] + p[1]) + (p[2] + p[3]); }
            else {
                if (C2) {
#pragma unroll
                    for (int r = 0; r < 4; ++r) p[r] *= linv_[rb];
                    float h0 = p[0], h1 = p[1], h2 = p[2], h3 = p[3];
                    h0 += dppf<DPP_XOR1>(h0); h1 += dppf<DPP_XOR1>(h1); h2 += dppf<DPP_XOR1>(h2); h3 += dppf<DPP_XOR1>(h3);
                    h0 += dppf<DPP_XOR2>(h0); h1 += dppf<DPP_XOR2>(h1); h2 += dppf<DPP_XOR2>(h2); h3 += dppf<DPP_XOR2>(h3);
                    if ((l15 & 3) == 0) { const int sp = 16 * idx + 8 * (cb >> 1) + 2 * lq + (cb & 1);
                        IMP1[tokc * 65 + sp] = (h0 + h1) + (h2 + 0.5f * h3);
                        if (sp + 1 < 64) IMP2[tokc * 65 + sp + 1] = 0.5f * h3; }
                }
                const unsigned lo = pkh(p[0], p[1]), hi = pkh(p[2], p[3]);
                if (cb & 1) { pfr[rb][cb >> 1].z = lo; pfr[rb][cb >> 1].w = hi; } else { pfr[rb][cb >> 1].x = lo; pfr[rb][cb >> 1].y = hi; } }
        }
    };
    auto vld = [&](int ks, v4u (&vv)[4]) __attribute__((always_inline)) {
        if (!C1 && !(VAR & 8)) {
#pragma unroll
            for (int db = 0; db < 4; ++db) vv[db] = *(const LAS v4u*)(vb_ + (16 * db + l15) * 128 + 16 * ((4 * ks + lq) ^ (l15 >> 1))); }
    };
    auto pvm = [&](int ks, const v4u (&vv)[4]) __attribute__((always_inline)) {
        if (!C1 && !(VAR & 8)) {
#pragma unroll
            for (int db = 0; db < 4; ++db) {
#pragma unroll
                for (int rb = 0; rb < 2; ++rb) if (RB & (1 << rb)) oacc[rb][db] = __builtin_amdgcn_mfma_f32_16x16x32_bf16(__builtin_bit_cast(bf16x8, pfr[rb][ks]), __builtin_bit_cast(bf16x8, vv[db]), oacc[rb][db], 0, 0, 0); }
            if (!C2) { const v4u ones = (v4u){0x3F803F80u, 0x3F803F80u, 0x3F803F80u, 0x3F803F80u};
#pragma unroll
                for (int rb = 0; rb < 2; ++rb) if (RB & (1 << rb)) lacc[rb] = __builtin_amdgcn_mfma_f32_16x16x32_bf16(__builtin_bit_cast(bf16x8, pfr[rb][ks]), __builtin_bit_cast(bf16x8, ones), lacc[rb], 0, 0, 0); }
        }
    };
    pg8::f32x4 sA[2], sB[2], cA[2], cB[2]; bf16x8 kA[2], kB[2]; v4u vA[4], vB[4];
#define AT_SB __builtin_amdgcn_sched_barrier(0)
    kld(0, kA, cA); kld(1, kB, cB); AT_SB;
    qkm(0, kA, cA, sA); kld(2, kA, cA); AT_SB;
    qkm(1, kB, cB, sB); kld(3, kB, cB); prob(0, sA); AT_SB;
    qkm(2, kA, cA, sA); vld(0, vA); prob(1, sB); AT_SB;
    qkm(3, kB, cB, sB); pvm(0, vA); vld(1, vB); prob(2, sA); AT_SB;
    prob(3, sB); AT_SB;
    pvm(1, vB);
#undef AT_SB
}

template <int VAR> __device__ __forceinline__ void attention_phase(Frame& F, const Args& args) {
    unsigned char* ws = F.ws;
    const int lane = F.lane, w = F.wave, l15 = lane & 15, lq = lane >> 4, tid = F.tid;
    LAS unsigned char* L = F.lds;
    LAS float* IMP1 = (LAS float*)(L + AT_OFF_IMP1); LAS float* IMP2 = (LAS float*)(L + AT_OFF_IMP2);
    LAS unsigned long long* SELM = (LAS unsigned long long*)(L + AT_OFF_SEL); LAS float* LUT = (LAS float*)(L + AT_OFF_LUT); LAS float* LROW = (LAS float*)(L + AT_OFF_LROW) + w * 32;
    LAS int* TD = (LAS int*)(L + AT_OFF_TD); LAS bf16* OUTL = (LAS bf16*)(L + AT_OFF_OUT) + (32 * w) * 72; LAS float* GATL = (LAS float*)(L + AT_OFF_GATL);
    const bf16* Qg = (const bf16*)(ws + WS_Q); const float* GATE = (const float*)(ws + WS_GATE); bf16* YA = (bf16*)(ws + WS_YA); float* YAF = (float*)(ws + WS_H);
    const int jq = l15 & 3;
    const LAS float* LUTJ = LUT + jq * 128;
    const int nrounds = (F.G == 256) ? 4 : (1024 + F.G - 1) / F.G;
    for (int round = 0; round < nrounds; ++round) {
        const int ui = (F.G == 256) ? ((round & 1) ? ((round >> 1) * 512 + 511 - F.bid) : ((round >> 1) * 512 + F.bid)) : (round * F.G + F.bid);
        if (ui >= 1024) break;
        const int c = 63 - (ui >> 4), bg = ui & 15, b = bg >> 1, g = bg & 1;
        const int m0 = b * SEQ + 64 * c;
        __syncthreads();
        { const float M0 = ((const float*)(ws + WS_BIASL))[8 * 128];
          for (int i = tid; i < 512; i += NTHREADS) LUT[i] = (((const float*)(ws + WS_BIASL))[(4 * g + (i >> 7)) * 128 + (i & 127)] - M0) * 1.4426950408889634f; }
        for (int i = tid; i < 64 * 65; i += NTHREADS) { IMP1[i] = 0.f; IMP2[i] = 0.f; }
        { const float M0 = ((const float*)(ws + WS_BIASL))[8 * 128]; const float* BL = (const float*)(ws + WS_BIASL) + (size_t)(4 * g) * 128;
          for (int i = tid; i < 16 * 63 * 4; i += NTHREADS) { const int r = i & 3, yi = (i >> 2) % 63, row = i / 252, rel = 4 * (47 - yi) + (row >> 2) - r;
              ((LAS float*)(L + AT_OFF_TS + row * AT_TS_ROW))[4 * yi + r] = rel < 0 ? -1.0e30f : (BL[(row & 3) * 128 + (rel > 127 ? 127 : rel)] - M0) * 1.4426950408889634f; } }
        for (int i = tid; i < 64 * 12; i += NTHREADS) GATL[i] = GATE[(size_t)(m0 + i / 12) * 24 + g * 12 + (i % 12)];
        bf16x8 qf[2][2];
#pragma unroll
        for (int rb = 0; rb < 2; ++rb)
#pragma unroll
            for (int ks = 0; ks < 2; ++ks) qf[rb][ks] = *(const GAS bf16x8*)(Qg + (size_t)(m0 + 8 * w + 4 * rb + (l15 >> 2)) * 512 + g * 256 + jq * 64 + 32 * ks + 8 * lq);
        asm volatile("" :: "v"(qf[0][0]), "v"(qf[0][1]), "v"(qf[1][0]), "v"(qf[1][1]));
        const int ncmp = 4 * c + 3, n1 = (ncmp + 63) >> 6, nsel = c + 1, w0 = c >= 8 ? c - 8 : 0, nwin = c - w0 + 1;
        const int ntiles = 2 * n1 + nsel + nwin;
        if (tid < ntiles) { const int i = tid;
            auto kindof = [&](int t, int& kind, int& idx) { if (t < n1) { kind = 0; idx = t; } else if (t < 2 * n1) { kind = 1; idx = t - n1; } else if (t < 2 * n1 + nsel) { kind = 2; idx = t - 2 * n1; } else { kind = 3; idx = w0 + (t - 2 * n1 - nsel); } };
            int kind, idx, kn, in_; kindof(i, kind, idx); kindof(i + 1 < ntiles ? i + 1 : i, kn, in_);
            unsigned ko, vo;
            if (kn < 2) { ko = (unsigned)(WS_KC + ((size_t)bg * 256 * 64 + (size_t)in_ * 4096) * 2); vo = (unsigned)(WS_VCT + ((size_t)bg * 64 * 256 + 64 * in_) * 2); }
            else if (kn == 2) { ko = (unsigned)(WS_KS + ((size_t)bg * SEQ * 64 + (size_t)in_ * 4096) * 2); vo = (unsigned)(WS_VST + ((size_t)bg * 64 * SEQ + 64 * in_) * 2); }
            else { ko = (unsigned)(WS_KW + ((size_t)bg * SEQ * 64 + (size_t)in_ * 4096) * 2); vo = (unsigned)(WS_VWT + ((size_t)bg * 64 * SEQ + 64 * in_) * 2); }
            const int dd = c - idx;
            int mode, relbase;
            if (kind == 0) { relbase = 64 * c - 31 - 1024 * idx; mode = relbase >= 1135 ? TM_CMP1F : TM_CMP1; } else if (kind == 1) { relbase = 64 * c - 31 - 1024 * idx; mode = relbase >= 1135 ? TM_CMP2F : TM_CMP2; }
            else if (kind == 2) { mode = dd <= 2 ? TM_SELN : TM_SELF; relbase = 64 * dd; } else { mode = dd <= 2 ? TM_WINN : (dd == 8 ? TM_WINE : TM_WINF); relbase = 64 * dd; }
            const int endf = ((kind == 1 && idx == n1 - 1) || (kind == 2 && idx == nsel - 1) || (kind == 3 && idx == c)) ? kind : 0;
            v4i e; e.x = mode | (idx << 8) | (endf << 16) | ((kind == 2 && idx == 0) ? (1 << 24) : 0) | (kn >= 2 ? (1 << 25) : 0); e.y = relbase; e.z = (int)ko; e.w = (int)vo;
            *(LAS v4i*)(TD + 4 * i) = e; }
        const int drow = 8 * w + (lane >> 3), dsrck = 16 * ((lane & 7) ^ (((w & 3) << 1) | ((lane >> 4) & 1))), dsrcv = 16 * ((lane & 7) ^ ((4 * (w & 1)) | (lane >> 4)));
#define AT_DMA(tile_, ko_, vo_, vs_) do { const int nb_ = (tile_) % AT_NBUF; \
        __builtin_amdgcn_global_load_lds((const GAS unsigned*)(ws + (size_t)((ko_) + drow * 128 + dsrck)), (LAS unsigned*)(L + AT_OFF_K + nb_ * AT_KBUF + w * 1024), 16, 0, 0); \
        __builtin_amdgcn_global_load_lds((const GAS unsigned*)(ws + (size_t)((vo_) + drow * (vs_) + dsrcv)), (LAS unsigned*)(L + AT_OFF_V + nb_ * AT_KBUF + w * 1024), 16, 0, 0); } while (0)
        __syncthreads();
        if (!(VAR & 2)) { AT_DMA(0, (unsigned)(WS_KC + (size_t)bg * 256 * 64 * 2), (unsigned)(WS_VCT + (size_t)bg * 64 * 256 * 2), 512u); }
        int d0, d1, d2, d3;
        { const v4i e = *(const LAS v4i*)TD; d0 = __builtin_amdgcn_readfirstlane(e.x); d1 = __builtin_amdgcn_readfirstlane(e.y); d2 = __builtin_amdgcn_readfirstlane(e.z); d3 = __builtin_amdgcn_readfirstlane(e.w); }
        pg8::f32x4 oacc[2][4];
        pg8::f32x4 lacc[2] = {(pg8::f32x4){0.f, 0.f, 0.f, 0.f}, (pg8::f32x4){0.f, 0.f, 0.f, 0.f}};
#pragma unroll
        for (int rb = 0; rb < 2; ++rb)
#pragma unroll
            for (int db = 0; db < 4; ++db) oacc[rb][db] = (pg8::f32x4){0.f, 0.f, 0.f, 0.f};
        const int tok_r[2] = {8 * w + (l15 >> 2), 8 * w + 4 + (l15 >> 2)};
        const LAS unsigned char* tsw = L + AT_OFF_TS + 16 * (47 - 2 * w); const LAS unsigned char* tsn = L + AT_OFF_TS + 16 * 48;
        for (int it = 0; it < ((VAR & 32) ? 0 : ntiles); ++it) {
            if (!(VAR & 512)) { asm volatile("s_waitcnt vmcnt(0)" ::: "memory");
            asm volatile("s_waitcnt lgkmcnt(0)" ::: "memory"); __builtin_amdgcn_s_barrier(); asm volatile("" ::: "memory"); }
            if (!(VAR & 2) && it + 1 < ntiles) AT_DMA(it + 1, (unsigned)d2, (unsigned)d3, ((d0 >> 25) & 1) ? 2u * SEQ : 512u);
            v4i tdn;
            { const LAS int* tn_ = TD + 4 * (it + 1); asm volatile("ds_read_b128 %0, %1" : "=v"(tdn) : "v"(tn_) : "memory"); }
            {
            const int mode = d0 & 255, idx = (d0 >> 8) & 255, relbase = d1, endf = (d0 >> 16) & 3, selfirst = (d0 >> 24) & 1;
            const int buf = it % AT_NBUF;
            if (selfirst) {
                { const int tok = 8 * w + (lane >> 3), s0 = 8 * (lane & 7);
                  unsigned key[8]; int rank[8];
#pragma unroll
                  for (int q = 0; q < 8; ++q) { const int sB = s0 + q; const bool vis = sB <= c, forced = (sB == 0) || (sB == c) || (sB == c - 1);
                      const float sc = vis ? (IMP1[tok * 65 + sB] + IMP2[tok * 65 + sB] + (forced ? 1000.f : 0.f)) : -1.f;
                      const unsigned u = __builtin_bit_cast(unsigned, sc); const unsigned fk = (u >> 31) ? ~u : (u | 0x80000000u);
                      key[q] = (fk & ~63u) | (unsigned)(63 - sB); rank[q] = 0; }
                  LAS unsigned* KEYS = (LAS unsigned*)IMP1;
#pragma unroll
                  for (int q = 0; q < 8; ++q) KEYS[tok * 65 + s0 + q] = key[q];
                  if (c >= 16 && !(VAR & 128)) {
#pragma unroll 8
                      for (int s2 = 0; s2 < 64; ++s2) { const unsigned k2 = KEYS[tok * 65 + s2];
#pragma unroll
                          for (int q = 0; q < 8; ++q) rank[q] += (k2 > key[q]) ? 1 : 0; } }
                  unsigned byte = 0u;
#pragma unroll
                  for (int q = 0; q < 8; ++q) byte |= ((rank[q] < 16 && (s0 + q) <= c) ? 1u : 0u) << q;
                  ((LAS unsigned char*)SELM)[tok * 8 + (lane & 7)] = (unsigned char)byte; }
            }
            const LAS unsigned char* kb_ = L + AT_OFF_K + buf * AT_KBUF; const LAS unsigned char* vb_ = L + AT_OFF_V + buf * AT_KBUF;
            const float cfar = LUTJ[127];
            unsigned selb[2] = {1u, 1u};
#define AT_CALL(TMX) at_tile<TMX, VAR>(kb_, vb_, LUTJ, IMP1, IMP2, qf, oacc, lacc, LROW, tok_r, selb, cfar, relbase, idx, l15, lq, tsw, tsn)
            if (mode == TM_SELF || mode == TM_SELN) { selb[0] = (unsigned)(SELM[tok_r[0]] >> idx) & 1u; selb[1] = (unsigned)(SELM[tok_r[1]] >> idx) & 1u; }
            if (mode == TM_SELF) {
                const bool a0 = __ballot(selb[0] != 0u) != 0ull, a1 = __ballot(selb[1] != 0u) != 0ull;
                if (a0 && a1) AT_CALL(TM_SELF);
                else if (a0) at_tile<TM_SELF, VAR, 1>(kb_, vb_, LUTJ, IMP1, IMP2, qf, oacc, lacc, LROW, tok_r, selb, cfar, relbase, idx, l15, lq, tsw, tsn);
                else if (a1) at_tile<TM_SELF, VAR, 2>(kb_, vb_, LUTJ, IMP1, IMP2, qf, oacc, lacc, LROW, tok_r, selb, cfar, relbase, idx, l15, lq, tsw, tsn); }
            else if (mode == TM_WINF) AT_CALL(TM_WINF);
            else if (mode == TM_SELN) AT_CALL(TM_SELN);
            else if (mode == TM_WINN) AT_CALL(TM_WINN);
            else if (mode == TM_WINE) AT_CALL(TM_WINE);
            else if (mode == TM_CMP2) AT_CALL(TM_CMP2);
            else if (mode == TM_CMP2F) AT_CALL(TM_CMP2F);
            else if (mode == TM_CMP1F) AT_CALL(TM_CMP1F);
            else { AT_CALL(TM_CMP1);
                if (idx == n1 - 1) {
#pragma unroll
                    for (int rb = 0; rb < 2; ++rb) { const float s = sum_xor32(sum_xor16(lacc[rb][0])); if (lq == 0) LROW[16 * rb + l15] = s > 0.f ? 1.0f / s : 0.f; lacc[rb] = (pg8::f32x4){0.f, 0.f, 0.f, 0.f}; } } }
#undef AT_CALL
            {
                if (endf && !(VAR & 256)) {
                    const int br = endf - 1;
#pragma unroll
                    for (int rb = 0; rb < 2; ++rb)
#pragma unroll
                        for (int r = 0; r < 4; ++r) { const int qrow = 16 * rb + 4 * lq + r;
                            const float ls_ = lacc[rb][r]; lacc[rb][r] = 0.f;
                            const float gt = GATL[(8 * w + 4 * rb + lq) * 12 + r * 3 + br] * (endf == 1 ? 1.0f : (ls_ > 0.f ? 1.0f / ls_ : 0.f));
#pragma unroll
                            for (int db = 0; db < 4; ++db) { float v = gt * oacc[rb][db][r]; oacc[rb][db][r] = 0.f;
                                LAS bf16* po = OUTL + qrow * 72 + 16 * db + l15;
                                if (br > 0) v += __builtin_bit_cast(float, (unsigned)(*po) << 16);
                                *po = (bf16)f2bf(v); } }
                    if (br == 2 && !(VAR & 1)) {
                        LDS_WAIT(); asm volatile("" ::: "memory");
#pragma unroll
                        for (int i = 0; i < 4; ++i) { const int ch = i * 64 + lane, row = ch >> 3, c16 = ch & 7;
                            const v4u o = *(const LAS v4u*)((const LAS unsigned char*)OUTL + row * 144 + 16 * c16);
                            *(GAS v4u*)(YA + (size_t)(m0 + 8 * w + (row >> 2)) * 512 + g * 256 + (row & 3) * 64 + 8 * c16) = o; }
                    }
                }
            }
            }
            asm volatile("s_waitcnt lgkmcnt(0)" : "+v"(tdn) :: "memory");
            d0 = __builtin_amdgcn_readfirstlane(tdn.x); d1 = __builtin_amdgcn_readfirstlane(tdn.y); d2 = __builtin_amdgcn_readfirstlane(tdn.z); d3 = __builtin_amdgcn_readfirstlane(tdn.w);
        }
#undef AT_DMA
    }
}

constexpr int N_PHASES = 13;
#ifndef MK_ONE_LAUNCH
#define MK_ONE_LAUNCH 1
#endif
#ifndef REP_P0
#define REP_P0 1
#endif
#ifndef REP_P1
#define REP_P1 1
#endif
#ifndef REP_P2
#define REP_P2 1
#endif
#ifndef REP_P3
#define REP_P3 1
#endif
#ifndef REP_P5
#define REP_P5 1
#endif
#ifndef REP_P6
#define REP_P6 1
#endif
#ifndef REP_P8
#define REP_P8 1
#endif
#ifndef REP_P7
#define REP_P7 1
#endif
#ifndef REP_P11
#define REP_P11 1
#endif
#ifndef REP_P4
#define REP_P4 1
#endif
#ifndef REP_P9
#define REP_P9 1
#endif
#ifndef REP_P10
#define REP_P10 1
#endif
#ifndef MK_BUILD
#define MK_BUILD 0
#endif

#ifndef STAG_P2
#define STAG_P2 0
#endif
__device__ __forceinline__ void phase_stagger(const Frame& F, int step_ns) {
    const int grp = (F.bid >> 3) & 7;
    if (step_ns > 0 && grp > 0) { const unsigned long long t0 = wall_clock64(), dt = (unsigned long long)(grp * step_ns) / 10ull;
        while (wall_clock64() - t0 < dt) __builtin_amdgcn_s_sleep(8); }
}
struct EpiNull {
    static constexpr bool PERM = true, AFTER_DRAIN = false;
    __device__ __forceinline__ void operator()(const pg8::f32x4 (&acc)[2][2][4][2], const pg8::Unit& u, int wr, int wc, int fr, int fq) const {
#pragma unroll
        for (int ai = 0; ai < 2; ++ai)
#pragma unroll
            for (int bj = 0; bj < 2; ++bj)
#pragma unroll
                for (int m = 0; m < 4; ++m) { asm volatile("" :: "v"(acc[ai][bj][m][0]), "v"(acc[ai][bj][m][1])); }
    }
};
__global__ void __launch_bounds__(NTHREADS, 2) fwd_kernel(Args args) {
    extern __shared__ __attribute__((aligned(16))) unsigned char lds[];
    Frame F;
    F.lds = (LAS unsigned char*)lds;
    F.MISC = (volatile LAS unsigned*)(F.lds + MISC_OFF);
    F.tid = threadIdx.x; F.lane = F.tid & 63; F.wave = __builtin_amdgcn_readfirstlane(F.tid >> 6);
    F.G = gridDim.x; F.bid = blockIdx.x; F.ws = args.ws;
    F.ctl = (gu32*)(args.ws + WS_CTL);
    for (int u = F.tid; u < (LDS_BYTES - LDSCTL_OFF) / 4; u += NTHREADS) ((LAS unsigned*)(F.lds + LDSCTL_OFF))[u] = 0u;
    __syncthreads();
    XcdBarrier bar; bar.bar = (unsigned*)(F.ctl + CW_BAR); bar.x = 0; bar.st = nullptr;
    if (MK_ONE_LAUNCH) bar = xcd_barrier_post((unsigned*)(F.ctl + CW_BAR), F.MISC + 8);
    const int lo = args.ph_lo, hi = args.ph_hi;
#define IN(k) (lo <= (k) && (k) < hi)
#define SEAM(k) do { if (IN(k) && IN((k) + 1)) xcd_barrier(bar); } while (0)
    unsigned char* ws = args.ws;
    const float* ada = (const float*)(ws + WS_ADA);

    if (IN(0)) { for (int rep = 0; rep < REP_P0; ++rep) { p0_prologue(F, args, rep == REP_P0 - 1); __syncthreads(); } } SEAM(0);
    if (IN(1)) { for (int rep = 0; rep < REP_P1; ++rep) modnorm_rows<false>(F, args.in[I_X], args.in[I_N1G], ada, 0, (bf16*)(ws + WS_H)); } SEAM(1);
    if (IN(2)) { {
        phase_stagger(F, STAG_P2);
        pg8::Gemm g{(const bf16*)(ws + WS_H), (const bf16*)(ws + WS_WIN_T), M, NIN, D, D, D}; pg8::StaticOrder S; S.init(M, NIN, F.G, F.bid);
        if (F.tid == 0) F.MISC[40] = 0xffffffffu; __syncthreads();
        EpiIn E{ws, args.in[I_QNG], args.in[I_KNG], F.MISC + 40};
#if defined(PROBE_P2) && PROBE_P2 == 1
        { EpiNull EN; pg8::gemm_phase<EpiNull, pg8::StaticOrder, true, true>(F.lds + RING_OFF, g, S, EN); __syncthreads(); }
#elif defined(PROBE_P2) && PROBE_P2 == 2
        { if (F.tid == 0) F.MISC[40] = 0u; __syncthreads(); pg8::gemm_phase<EpiIn, pg8::StaticOrder, true, true>(F.lds + RING_OFF, g, S, E); __syncthreads(); if (F.tid == 0) F.MISC[40] = 0xffffffffu; __syncthreads(); }
#endif
        pg8::gemm_phase<EpiIn, pg8::StaticOrder, true, true>(F.lds + RING_OFF, g, S, E);
#if REP_P2 > 1
        __syncthreads(); pg8::gemm_phase<EpiIn, pg8::StaticOrder, true, true>(F.lds + RING_OFF, g, S, E);
#endif
        }
    } SEAM(2);
#ifndef PROBE_P3
#define PROBE_P3 0
#endif
    if (IN(3)) { for (int rep = 0; rep < REP_P3; ++rep) { __syncthreads(); pool_phase(F); if (PROBE_P3 == 1) { __syncthreads(); pool_phase(F); }
        __syncthreads(); compress_phase(F, args.in[I_KNG]); if (PROBE_P3 == 2) { __syncthreads(); compress_phase(F, args.in[I_KNG]); }
        __syncthreads(); vtranspose_phase(F); if (PROBE_P3 == 3) { __syncthreads(); vtranspose_phase(F); } } } SEAM(3);
    if (IN(4)) {
#ifdef PROBE_P4
        attention_phase<PROBE_P4>(F, args); __syncthreads();
#endif
        for (int rep = 0; rep < REP_P4; ++rep) { attention_phase<0>(F, args); __syncthreads(); } } SEAM(4);
    if (IN(5)) { {
        { pg8::Gemm g{(const bf16*)(ws + WS_PL), (const bf16*)(ws + WS_WEFF_T), M, D, POOLW, POOLW, POOLW}; pg8::StaticOrder S; S.init(M, D, F.G, F.bid);
          EpiMix<false> E{(bf16*)(ws + WS_MIX), (const bf16*)(ws + WS_GM), 0};
          pg8::gemm_phase<EpiMix<false>, pg8::StaticOrder, true, true>(F.lds + RING_OFF, g, S, E); }
        { pg8::Gemm g{(const bf16*)(ws + WS_YA), (const bf16*)(ws + WS_WBA_T), M, D, QW, QW, QW}; pg8::StaticOrder S; S.init(M, D, F.G, F.bid);
          EpiMix<true> E{(bf16*)(ws + WS_MIX), (const bf16*)(ws + WS_GM), 1024};
          pg8::gemm_phase<EpiMix<true>, pg8::StaticOrder, true, true>(F.lds + RING_OFF, g, S, E); } }
#if REP_P5 > 1
        { __syncthreads(); { pg8::Gemm g{(const bf16*)(ws + WS_PL), (const bf16*)(ws + WS_WEFF_T), M, D, POOLW, POOLW, POOLW}; pg8::StaticOrder S; S.init(M, D, F.G, F.bid);
          EpiMix<false> E{(bf16*)(ws + WS_MIX), (const bf16*)(ws + WS_GM), 0};
          pg8::gemm_phase<EpiMix<false>, pg8::StaticOrder, true, true>(F.lds + RING_OFF, g, S, E); }
        { pg8::Gemm g{(const bf16*)(ws + WS_YA), (const bf16*)(ws + WS_WBA_T), M, D, QW, QW, QW}; pg8::StaticOrder S; S.init(M, D, F.G, F.bid);
          EpiMix<true> E{(bf16*)(ws + WS_MIX), (const bf16*)(ws + WS_GM), 1024};
          pg8::gemm_phase<EpiMix<true>, pg8::StaticOrder, true, true>(F.lds + RING_OFF, g, S, E); } }
#endif
    } SEAM(5);
    if (IN(6)) { {
        pg8::Gemm g{(const bf16*)(ws + WS_MIX), (const bf16*)(ws + WS_WOUT_T), M, D, D, D, D}; pg8::StaticOrder S; S.init(M, D, F.G, F.bid);
        EpiRes E{args.in[I_X], args.out, ada, 2};
        pg8::gemm_phase<EpiRes, pg8::StaticOrder, true, true>(F.lds + RING_OFF, g, S, E);
#if REP_P6 > 1
        __syncthreads(); pg8::gemm_phase<EpiRes, pg8::StaticOrder, true, true>(F.lds + RING_OFF, g, S, E);
#endif
        }
    } SEAM(6);
    if (IN(7)) { for (int rep = 0; rep < REP_P7; ++rep) modnorm_rows<true>(F, args.out, args.in[I_N2G], ada, 3, (bf16*)(ws + WS_H)); } SEAM(7);
    if (IN(8)) { {
        pg8::Gemm g{(const bf16*)(ws + WS_H), (const bf16*)(ws + WS_WQ_T), M, PQW, D, D, D}; pg8::StaticOrder S; S.init(M, PQW, F.G, F.bid);
        EpiStoreBf16 E{(bf16*)(ws + WS_QV), PQW};
        pg8::gemm_phase<EpiStoreBf16, pg8::StaticOrder, true, true>(F.lds + RING_OFF, g, S, E);
#if REP_P8 > 1
        __syncthreads(); pg8::gemm_phase<EpiStoreBf16, pg8::StaticOrder, true, true>(F.lds + RING_OFF, g, S, E);
#endif
        }
    } SEAM(8);
    if (IN(9)) { for (int rep = 0; rep < REP_P9; ++rep) peer_select_phase(F); } SEAM(9);
#ifdef PROBE_XCD
    if (IN(10)) { if (F.tid == 0) __hip_atomic_store((unsigned*)(F.ctl + 2048 + F.bid), 100u + xb_xcc_id(), RLX_AGENT); }
#endif
    if (IN(10)) {
#ifdef PROBE_DOT
        peer_dot_phase<PROBE_DOT>(F); __syncthreads();
#endif
#ifdef PROBE_LOADRATE
        peer_loadrate_probe<PROBE_LOADRATE>(F); __syncthreads();
#endif
        peer_dot_phase<0>(F); } SEAM(10);
    if (IN(11)) { for (int rep = 0; rep < REP_P11; ++rep) peer_coef_phase(F); } SEAM(11);
#ifdef PROBE_XCD
    if (IN(12) && F.bid == 0 && F.tid == 0) { bool ok = true; for (int i = 0; i < F.G; ++i) { const unsigned a = __hip_atomic_load((unsigned*)(F.ctl + 2048 + i), RLX_AGENT), b0 = __hip_atomic_load((unsigned*)(F.ctl + 2048 + (i & 7)), RLX_AGENT); if (a != b0 || a < 100u) ok = false; }
        for (int i = 0; i < 8; ++i) for (int q = 0; q < i; ++q) if (__hip_atomic_load((unsigned*)(F.ctl + 2048 + i), RLX_AGENT) == __hip_atomic_load((unsigned*)(F.ctl + 2048 + q), RLX_AGENT)) ok = false;
        if (!ok) args.out[12345] = 1.0e9f; }
    __syncthreads();
#endif
    if (IN(12)) {
#if defined(CHECK_OUT_MFMA)
        peer_out_mfma_phase<1>(F, ada, args.out); __syncthreads(); VM_WAIT(); __syncthreads(); peer_out_phase<false, true>(F, ada, args.out);
#elif defined(OUT_VALU)
        for (int rep = 1; rep < REP_P10; ++rep) peer_out_phase<true>(F, ada, args.out); peer_out_phase<false>(F, ada, args.out);
#else
#ifdef PROBE_OUT
        peer_out_mfma_phase<1>(F, ada, args.out); __syncthreads();
#endif
        peer_out_mfma_phase<0>(F, ada, args.out);
#endif
    }
#undef IN
#undef SEAM
}

extern "C" void kernel_launch(void* const* d_in, const int* in_sizes, int n_in, void* d_out, int out_size, void* d_ws, size_t ws_size, hipStream_t stream) {
    static int grid = 0;
    if (grid == 0) {
        if (n_in != N_IN || in_sizes[0] != M * D || out_size != M * D || ws_size < WS_END) {
            fprintf(stderr, "kernel_launch: unexpected shapes: n_in %d in0 %d out %d ws %zu (need %zu)\n", n_in, n_in > 0 ? in_sizes[0] : -1, out_size, ws_size, (size_t)WS_END); grid = -1; return; }
        int dev = 0, cus = 0, per_cu = 0;
        if (hipGetDevice(&dev) != hipSuccess || hipDeviceGetAttribute(&cus, hipDeviceAttributeMultiprocessorCount, dev) != hipSuccess) { grid = -1; return; }
        if (hipFuncSetAttribute((const void*)fwd_kernel, hipFuncAttributeMaxDynamicSharedMemorySize, LDS_BYTES) != hipSuccess) { fprintf(stderr, "kernel_launch: hipFuncSetAttribute failed\n"); grid = -1; return; }
        if (hipOccupancyMaxActiveBlocksPerMultiprocessor(&per_cu, (const void*)fwd_kernel, NTHREADS, LDS_BYTES) != hipSuccess || per_cu < 1)
            fprintf(stderr, "kernel_launch: occupancy query reports %d workgroups per CU\n", per_cu);
        (void)hipGetLastError();
        grid = cus;
    }
    if (grid < 0) return;
    if (hipMemsetAsync((char*)d_ws + WS_CTL, 0, CTL_ZERO_BYTES, stream) != hipSuccess) return;
    Args a{};
    for (int i = 0; i < N_IN; ++i) a.in[i] = (const float*)d_in[i];
    a.out = (float*)d_out; a.ws = (unsigned char*)d_ws;
    if (MK_ONE_LAUNCH) {
        a.ph_lo = 0; a.ph_hi = N_PHASES; a.li = 0;
        hipLaunchKernelGGL(fwd_kernel, dim3(grid), dim3(NTHREADS), LDS_BYTES, stream, a);
    } else {
        for (int p = 0; p < N_PHASES; ++p) {
            a.ph_lo = p; a.ph_hi = p + 1; a.li = p;
            hipLaunchKernelGGL(fwd_kernel, dim3(grid), dim3(NTHREADS), LDS_BYTES, stream, a);
        }
    }
}
```

```cpp
#include <hip/hip_runtime.h>
#include <cstdio>
#include <cstdint>
namespace pg8 {
#define PG8_LAS __attribute__((address_space(3)))
typedef unsigned short bf16_t;
typedef short bf16x8 __attribute__((ext_vector_type(8)));
typedef float f32x4 __attribute__((ext_vector_type(4)));
typedef unsigned u32x4 __attribute__((ext_vector_type(4)));
constexpr int BM = 256, BK = 64, HALF = 128, HTB = HALF * BK * 2  , STAGE_BYTES = 8 * HTB, NXCD = 8, WGM = 8;

__host__ __device__ __forceinline__ int lds_byte(int r, int c) { const int st = (r >> 4) * 2 + (c >> 5), rr = r & 15, cc = c & 31, ob = rr * 64 + cc * 2; return st * 1024 + (ob ^ (((ob >> 9) & 1) << 5)); }
__host__ __device__ __forceinline__ void stage_rc(int b, int& R, int& C) { const int st = b / 1024, sb = b % 1024, swz = sb ^ (((sb >> 9) & 1) << 5); R = (st >> 1) * 16 + swz / 64; C = (st & 1) * 32 + (swz % 64) / 2; }
__host__ __device__ __forceinline__ int perm32(int rho) { const int n = rho >> 4, i = rho & 15; return 8 * (i >> 2) + 4 * n + (i & 3); }

struct Unit { int pm, pn; };
struct Gemm { const bf16_t* A; const bf16_t* Bt; int M, N, K, lda, ldb; };

struct StaticOrder {
    int nM, nN, nwg, G, c;
    __host__ __device__ void init(int M, int N, int G_, int c_) { nM = M / BM; nN = N / BM; nwg = nM * nN; G = G_; c = c_; }
    __host__ __device__ bool next(int i, Unit& u) const {
        const long L = (long)i * G + c; if (L >= nwg) return false;
        int wgid = (int)L; { const int q = nwg / NXCD, r = nwg % NXCD, xcd = wgid % NXCD, off = wgid / NXCD; wgid = (xcd < r ? xcd * (q + 1) : r * (q + 1) + (xcd - r) * q) + off; }
        const int nig = WGM * nN, gid = wgid / nig, fm = gid * WGM, gsz = (nM - fm) < WGM ? (nM - fm) : WGM;
        u.pm = fm + ((wgid % nig) % gsz); u.pn = (wgid % nig) / gsz; return true;
    }
    __device__ __forceinline__ void a_ready(const Unit&) const {}
    __device__ __forceinline__ void done(const Unit&) const {}
};

__device__ __forceinline__ unsigned cvt_pk_bf16(float lo, float hi) { unsigned r; asm volatile("v_cvt_pk_bf16_f32 %0, %1, %2" : "=v"(r) : "v"(lo), "v"(hi)); return r; }
template <class Epi, class Sched, bool ALIGN_EPI = false, bool SP2 = false>
__device__ __forceinline__ void gemm_phase(PG8_LAS unsigned char* lds, const Gemm g, const Sched& S, const Epi& E) {
    const int tid = threadIdx.x, wid = __builtin_amdgcn_readfirstlane(tid >> 6), lane = tid & 63, wr = wid >> 2, wc = wid & 3, fr = lane & 15, fq = lane >> 4;
    const int K = g.K, nt = K / BK;
    unsigned voffA[2], voffB[2];
#pragma unroll
    for (int i = 0; i < 2; ++i) { int R, C; stage_rc(tid * 16 + i * 8192, R, C); const int Rb = Epi::PERM ? ((R & ~31) + perm32(R & 31)) : R;
        voffA[i] = (unsigned)(R * g.lda + C) * 2u; voffB[i] = (unsigned)(Rb * g.ldb + C) * 2u; }
    const size_t kstep = (size_t)(BK * 2);
    const size_t hstepA = (size_t)HALF * g.lda * 2, hstepB = (size_t)HALF * g.ldb * 2;
    const size_t tstepA = 2 * hstepA, tstepB = 2 * hstepB;
    const unsigned ldsw = (unsigned)wid * 1024u;
    const int aoff = lds_byte(wr * 64 + fr, fq * 8), boff = lds_byte(wc * 32 + fr, fq * 8);
#define PG8_SA(b, h) (((b) * 2 + (h)) * HTB)
#define PG8_SB(b, h) ((4 + (b) * 2 + (h)) * HTB)
#define PG8_STAGE(bufoff, gbase, voff) do { _Pragma("unroll") for (int _i = 0; _i < 2; ++_i) \
        __builtin_amdgcn_global_load_lds((const unsigned*)((const char*)(gbase) + (voff)[_i]), (PG8_LAS unsigned*)(lds + (bufoff) + ldsw + _i * 8192), 16, 0, 0); } while (0)
#define PG8_LDA(dst, b, h) do { _Pragma("unroll") for (int m = 0; m < 4; ++m) _Pragma("unroll") for (int k = 0; k < 2; ++k) dst[m][k] = *(const PG8_LAS bf16x8*)(lds + PG8_SA(b, h) + aoff + m * 2048 + k * 1024); } while (0)
#define PG8_LDB(dst, b, h) do { _Pragma("unroll") for (int n = 0; n < 2; ++n) _Pragma("unroll") for (int k = 0; k < 2; ++k) dst[n][k] = *(const PG8_LAS bf16x8*)(lds + PG8_SB(b, h) + boff + n * 2048 + k * 1024); } while (0)
#define PG8_MMA(ai, bj, At, Bt) do { __builtin_amdgcn_s_setprio(1); _Pragma("unroll") for (int m = 0; m < 4; ++m) _Pragma("unroll") for (int n = 0; n < 2; ++n) _Pragma("unroll") for (int k = 0; k < 2; ++k) \
        acc[ai][bj][m][n] = __builtin_amdgcn_mfma_f32_16x16x32_bf16(Bt[n][k], At[m][k], acc[ai][bj][m][n], 0, 0, 0); __builtin_amdgcn_s_setprio(0); } while (0)
#define PG8_WAIT_V(n) asm volatile("s_waitcnt vmcnt(" #n ")" ::: "memory")
#define PG8_WAIT_L(n) asm volatile("s_waitcnt lgkmcnt(" #n ")" ::: "memory")
#define PG8_BAR __builtin_amdgcn_s_barrier()
#define PG8_SCHED __builtin_amdgcn_sched_barrier(0)
    Unit cur, nxt; int ui = 0;
    if (!S.next(0, cur)) return;
    f32x4 acc[2][2][4][2];
#pragma unroll
    for (int a = 0; a < 2; ++a)
#pragma unroll
        for (int b = 0; b < 2; ++b)
#pragma unroll
            for (int m = 0; m < 4; ++m)
#pragma unroll
                for (int n = 0; n < 2; ++n) acc[a][b][m][n] = (f32x4){0.f, 0.f, 0.f, 0.f};
    bf16x8 At[4][2], B0[2][2], B1[2][2];
    const char* cA = (const char*)g.A + (size_t)cur.pm * tstepA; const char* cB = (const char*)g.Bt + (size_t)cur.pn * tstepB;
    S.a_ready(cur);
    if constexpr (SP2) {
        PG8_STAGE(PG8_SB(0, 0), cB, voffB); PG8_STAGE(PG8_SB(0, 1), cB + hstepB, voffB); PG8_STAGE(PG8_SA(0, 0), cA, voffA); PG8_STAGE(PG8_SA(0, 1), cA + hstepA, voffA);
        if (wr == 1) PG8_BAR;
        PG8_WAIT_V(2); PG8_BAR;
        PG8_STAGE(PG8_SB(1, 0), cB + kstep, voffB); PG8_STAGE(PG8_SA(1, 0), cA + kstep, voffA); PG8_STAGE(PG8_SB(1, 1), cB + hstepB + kstep, voffB);
        PG8_WAIT_V(6); PG8_BAR;
    } else {
        PG8_STAGE(PG8_SB(0, 0), cB, voffB); PG8_STAGE(PG8_SA(0, 0), cA, voffA); PG8_STAGE(PG8_SB(0, 1), cB + hstepB, voffB); PG8_STAGE(PG8_SA(0, 1), cA + hstepA, voffA);
        if (wr == 1) PG8_BAR;
        PG8_WAIT_V(4); PG8_BAR;
        PG8_STAGE(PG8_SB(1, 0), cB + kstep, voffB); PG8_STAGE(PG8_SA(1, 0), cA + kstep, voffA); PG8_STAGE(PG8_SB(1, 1), cB + hstepB + kstep, voffB);
        PG8_WAIT_V(6); PG8_BAR;
    }
    for (;;) {
        const bool has_next = S.next(ui + 1, nxt);
        const char* nA = has_next ? (const char*)g.A + (size_t)nxt.pm * tstepA : cA; const char* nB = has_next ? (const char*)g.Bt + (size_t)nxt.pn * tstepB : cB;
        for (int t = 0; t < nt; t += 2) {
            const bool last = (t == nt - 2);
            const char* a1 = cA + (size_t)(t + 1) * kstep;
            const char* a2 = last ? nA : cA + (size_t)(t + 2) * kstep; const char* b2 = last ? nB : cB + (size_t)(t + 2) * kstep;
            const char* a3 = a2 + kstep; const char* b3 = b2 + kstep;
            if (last && has_next) S.a_ready(nxt);
            if constexpr (SP2) {
            PG8_LDB(B0, 0, 0); PG8_LDB(B1, 0, 1); PG8_SCHED; PG8_LDA(At, 0, 0); PG8_STAGE(PG8_SA(1, 1), a1 + hstepA, voffA);
            PG8_WAIT_V(8); PG8_WAIT_L(0); PG8_BAR; PG8_MMA(0, 0, At, B0); PG8_MMA(0, 1, At, B1); PG8_BAR; PG8_SCHED;
            PG8_LDA(At, 0, 1); PG8_STAGE(PG8_SB(0, 0), b2, voffB); PG8_STAGE(PG8_SB(0, 1), b2 + hstepB, voffB); PG8_STAGE(PG8_SA(0, 0), a2, voffA);
            PG8_WAIT_V(8); PG8_WAIT_L(0); PG8_BAR; PG8_MMA(1, 0, At, B0); PG8_MMA(1, 1, At, B1); PG8_BAR; PG8_SCHED;
            PG8_LDB(B0, 1, 0); PG8_LDB(B1, 1, 1); PG8_SCHED; PG8_LDA(At, 1, 0); PG8_STAGE(PG8_SA(0, 1), a2 + hstepA, voffA);
            PG8_WAIT_V(8); PG8_WAIT_L(0); PG8_BAR; PG8_MMA(0, 0, At, B0); PG8_MMA(0, 1, At, B1); PG8_BAR; PG8_SCHED;
            PG8_LDA(At, 1, 1); PG8_STAGE(PG8_SB(1, 0), b3, voffB); PG8_STAGE(PG8_SB(1, 1), b3 + hstepB, voffB); PG8_STAGE(PG8_SA(1, 0), a3, voffA);
            PG8_WAIT_V(8); PG8_WAIT_L(0); PG8_BAR; PG8_MMA(1, 0, At, B0); PG8_MMA(1, 1, At, B1); PG8_BAR; PG8_SCHED;
            } else {
            PG8_LDB(B0, 0, 0); PG8_SCHED; PG8_LDA(At, 0, 0); PG8_STAGE(PG8_SA(1, 1), a1 + hstepA, voffA);
            PG8_WAIT_L(8); PG8_BAR; PG8_WAIT_L(0); PG8_MMA(0, 0, At, B0); PG8_BAR; PG8_SCHED;
            PG8_LDB(B1, 0, 1); PG8_STAGE(PG8_SB(0, 0), b2, voffB);
            PG8_BAR; PG8_WAIT_L(0); PG8_MMA(0, 1, At, B1); PG8_BAR;
            PG8_LDA(At, 0, 1); PG8_STAGE(PG8_SA(0, 0), a2, voffA);
            PG8_BAR; PG8_WAIT_L(0); PG8_MMA(1, 0, At, B0); PG8_BAR; PG8_SCHED;
            PG8_STAGE(PG8_SB(0, 1), b2 + hstepB, voffB);
            PG8_WAIT_V(6); PG8_BAR; PG8_MMA(1, 1, At, B1); PG8_BAR;
            PG8_LDB(B0, 1, 0); PG8_SCHED; PG8_LDA(At, 1, 0); PG8_STAGE(PG8_SA(0, 1), a2 + hstepA, voffA);
            PG8_WAIT_L(8); PG8_BAR; PG8_WAIT_L(0); PG8_MMA(0, 0, At, B0); PG8_BAR; PG8_SCHED;
            PG8_LDB(B1, 1, 1); PG8_STAGE(PG8_SB(1, 0), b3, voffB);
            PG8_BAR; PG8_WAIT_L(0); PG8_MMA(0, 1, At, B1); PG8_BAR;
            PG8_LDA(At, 1, 1); PG8_STAGE(PG8_SA(1, 0), a3, voffA);
            PG8_BAR; PG8_WAIT_L(0); PG8_MMA(1, 0, At, B0); PG8_BAR; PG8_SCHED;
            PG8_STAGE(PG8_SB(1, 1), b3 + hstepB, voffB);
            PG8_WAIT_V(6); PG8_BAR; PG8_MMA(1, 1, At, B1); PG8_BAR;
            }
        }
        if constexpr (ALIGN_EPI) { if (wr == 0) PG8_BAR; }
        if constexpr (!Epi::AFTER_DRAIN) { E(acc, cur, wr, wc, fr, fq); S.done(cur); }
        if (!has_next) break;
#pragma unroll
        for (int a = 0; a < 2; ++a)
#pragma unroll
            for (int b = 0; b < 2; ++b)
#pragma unroll
                for (int m = 0; m < 4; ++m)
#pragma unroll
                    for (int n = 0; n < 2; ++n) acc[a][b][m][n] = (f32x4){0.f, 0.f, 0.f, 0.f};
        cur = nxt; cA = nA; cB = nB; ++ui;
        if constexpr (ALIGN_EPI) { if (wr == 1) PG8_BAR; }
    }
    PG8_WAIT_V(0);
    if constexpr (!ALIGN_EPI) { if (wr == 0) PG8_BAR; }
    PG8_BAR;
    if constexpr (Epi::AFTER_DRAIN) { E.fused(acc, cur, wr, wc, fr, fq, lds, wid, lane); S.done(cur); }
#undef PG8_SA
#undef PG8_SB
#undef PG8_STAGE
#undef PG8_LDA
#undef PG8_LDB
#undef PG8_MMA
#undef PG8_WAIT_V
#undef PG8_WAIT_L
#undef PG8_BAR
#undef PG8_SCHED
}
}

constexpr int NWAVES = 8, NTHREADS = NWAVES * 64;
constexpr int BATCH = 8, SEQ = 4096, D = 1024, M = BATCH * SEQ;
constexpr int POOLW = 512, QW = 512, NG = 2, HD = 64, NBG = BATCH * NG;
constexpr int IN_COLS = 3864, NIN = 4096;
constexpr int NCMP = 255, NCMP_PAD = 256, NSEL = 64;
constexpr int PH = 8, PK = 128, PTOP = 16, PQD = 256, PQW = PH * PQD;
constexpr int NEXP = PK * PK;
constexpr float EPS = 1e-6f;
enum { I_X = 0, I_C, I_RELB, I_ADAW, I_ADAB, I_N1G, I_N2G, I_WIN, I_POOLW, I_POOLS, I_CPEK, I_CW1K, I_CW2K, I_CPEV, I_CW1V, I_CW2V, I_QNG, I_KNG, I_WBP, I_WBA, I_WOUT, I_PWQ, I_PSK, I_PU, I_PV, N_IN };

constexpr size_t MiB = 1u << 20, KiB = 1u << 10;
constexpr size_t WS_CTL = 0, CTL_ZERO_BYTES = 1 * MiB;
constexpr size_t WS_ADA = 1 * MiB;
constexpr size_t WS_CB1K = 64 * KiB;
constexpr size_t WS_CB1V = WS_CB1K + 1 * KiB;
constexpr size_t WS_BIASL = WS_ADA + 256 * KiB;
constexpr size_t WS_WIN_T = 2 * MiB;
constexpr size_t WS_WEFF_T = 10 * MiB;
constexpr size_t WS_WBA_T = 11 * MiB;
constexpr size_t WS_WOUT_T = 12 * MiB;
constexpr size_t WS_WQ_T = 14 * MiB;
constexpr size_t WS_SUBK = 18 * MiB;
constexpr size_t WS_CW1K_T = 18 * MiB + 512 * KiB;
constexpr size_t WS_CW1V_T = 19 * MiB;
constexpr size_t WS_CW2K_T = 19 * MiB + 512 * KiB;
constexpr size_t WS_CW2V_T = WS_CW2K_T + 64 * KiB;
constexpr size_t WS_KC = 20 * MiB;
constexpr size_t WS_VCT = 20 * MiB + 512 * KiB;
constexpr size_t WS_GATE = 21 * MiB;
constexpr size_t WS_UB = 24 * MiB;
constexpr size_t WS_VB = 56 * MiB;
constexpr size_t WS_SCLU = WS_UB + 16 * MiB, WS_SCLV = WS_SCLU + 64 * KiB;
constexpr size_t WS_H = 88 * MiB;
constexpr size_t WS_ZP = 152 * MiB;
constexpr size_t WS_Q = 184 * MiB;
constexpr size_t WS_KCR = 216 * MiB;
constexpr size_t WS_VCR = 225 * MiB;
constexpr size_t WS_KS = 234 * MiB, WS_VS = 242 * MiB, WS_KW = 250 * MiB, WS_VW = 258 * MiB;
constexpr size_t WS_VST = 266 * MiB, WS_VWT = 274 * MiB;
constexpr size_t WS_PL = 282 * MiB;
constexpr size_t WS_YA = 314 * MiB;
constexpr size_t WS_GM = 346 * MiB;
constexpr size_t WS_MIX = WS_ZP;
constexpr size_t WS_QV = WS_GM;
constexpr size_t WS_EID = WS_PL;
constexpr size_t WS_GW = WS_PL + 16 * MiB;
constexpr size_t WS_PART = WS_GM;
constexpr size_t WS_CF = WS_YA;
constexpr size_t WS_CFS = WS_YA + 8 * MiB;
constexpr size_t WS_H8 = WS_ZP;
constexpr size_t WS_HS = WS_ZP + 32 * MiB;
constexpr size_t WS_X1 = WS_KCR;
constexpr size_t WS_END = 474 * MiB;
constexpr int CW_TMO = 0, CW_CODE = 1, CW_BAR = 4096;

constexpr int RING_OFF = 0, RING_BYTES = 131072;
constexpr int LDSCTL_OFF = RING_BYTES, MISC_OFF = LDSCTL_OFF + 320;
constexpr int LDS_BYTES = 147456;

#define GAS __attribute__((address_space(1)))
#define LAS __attribute__((address_space(3)))
typedef unsigned short bf16;
typedef unsigned v4u __attribute__((ext_vector_type(4)));
typedef unsigned v2u __attribute__((ext_vector_type(2)));
typedef int v2i __attribute__((ext_vector_type(2)));
typedef float f32x4 __attribute__((ext_vector_type(4)));
typedef short bf16x8 __attribute__((ext_vector_type(8)));
typedef GAS unsigned gu32;
#define RLX_AGENT __ATOMIC_RELAXED, __HIP_MEMORY_SCOPE_AGENT
#define LDS_WAIT() asm volatile("s_waitcnt lgkmcnt(0)" ::: "memory")
#define VM_WAIT() asm volatile("s_waitcnt vmcnt(0)" ::: "memory")
__device__ __forceinline__ unsigned f2bf(float f) { unsigned u = __builtin_bit_cast(unsigned, f); return (u + 0x7fffu + ((u >> 16) & 1u)) >> 16; }
__device__ __forceinline__ unsigned pk2(float lo, float hi) { return f2bf(lo) | (f2bf(hi) << 16); }
__device__ __forceinline__ float bflo(unsigned w) { return __builtin_bit_cast(float, w << 16); }
__device__ __forceinline__ float bfhi(unsigned w) { return __builtin_bit_cast(float, w & 0xffff0000u); }
__device__ __forceinline__ float sigmoidf_(float v) { return __builtin_amdgcn_rcpf(1.0f + __builtin_amdgcn_exp2f(v * -1.4426950408889634f)); }
typedef __bf16 bf16x2_hw __attribute__((ext_vector_type(2)));
typedef float f32x2_hw __attribute__((ext_vector_type(2)));
__device__ __forceinline__ unsigned pkh(float lo, float hi) { return __builtin_bit_cast(unsigned, __builtin_convertvector((f32x2_hw){lo, hi}, bf16x2_hw)); }
__device__ __forceinline__ float gelu_tanh_safe(float v) { const float u = 0.7978845608028654f * (v + 0.044715f * v * v * v); return 0.5f * v * (1.0f + tanhf(u)); }
template <int CTRL> __device__ __forceinline__ float dppf(float v) { return __builtin_bit_cast(float, __builtin_amdgcn_update_dpp(0, __builtin_bit_cast(int, v), CTRL, 0xF, 0xF, true)); }
template <int CTRL> __device__ __forceinline__ int dppi(int v) { return __builtin_amdgcn_update_dpp(0, v, CTRL, 0xF, 0xF, true); }
#define DPP_XOR1 0xB1
#define DPP_XOR2 0x4E
#define DPP_HMIR 0x141
#define DPP_ROR8 0x128
__device__ __forceinline__ void swap16_(float& a, float& b) { asm volatile("v_nop\n\tv_nop\n\tv_permlane16_swap_b32 %0, %1" : "+v"(a), "+v"(b)); }
__device__ __forceinline__ void swap32_(float& a, float& b) { asm volatile("v_nop\n\tv_nop\n\tv_permlane32_swap_b32 %0, %1" : "+v"(a), "+v"(b)); }
__device__ __forceinline__ float sum_xor16(float v) { float a = v, b = v; swap16_(a, b); return a + b; }
__device__ __forceinline__ float sum_xor32(float v) { float a = v, b = v; swap32_(a, b); return a + b; }
__device__ __forceinline__ float max_xor16(float v) { float a = v, b = v; swap16_(a, b); return fmaxf(a, b); }
__device__ __forceinline__ float max_xor32(float v) { float a = v, b = v; swap32_(a, b); return fmaxf(a, b); }
__device__ __forceinline__ float wave_sum(float v) {
    v += dppf<DPP_XOR1>(v); v += dppf<DPP_XOR2>(v); v += dppf<DPP_HMIR>(v); v += dppf<DPP_ROR8>(v);
    return sum_xor32(sum_xor16(v));
}
__device__ __forceinline__ float wave_max(float v) {
    v = fmaxf(v, dppf<DPP_XOR1>(v)); v = fmaxf(v, dppf<DPP_XOR2>(v)); v = fmaxf(v, dppf<DPP_HMIR>(v)); v = fmaxf(v, dppf<DPP_ROR8>(v));
    return max_xor32(max_xor16(v));
}

#define XB_TMO      128
#define XB_XCNT(j)  (256  + 64 * (j))
#define XB_XSUB(j)  (1280 + 64 * (j))
#define XB_XGEN(j)  (2304 + 64 * (j))
#define XB_TOP      3328
#define XB_TOPGEN   3392
#define XCD_BAR_WORDS 3456
#define XB_SPIN_CAP (1u << 18)
__device__ __forceinline__ unsigned xb_ld(unsigned* p)              { return __hip_atomic_load(p, __ATOMIC_RELAXED, __HIP_MEMORY_SCOPE_AGENT); }
__device__ __forceinline__ unsigned xb_add(unsigned* p, unsigned v) { return __hip_atomic_fetch_add(p, v, __ATOMIC_RELAXED, __HIP_MEMORY_SCOPE_AGENT); }
__device__ __forceinline__ unsigned xb_xcc_id() { return (unsigned)__builtin_amdgcn_s_getreg((3 << 11) | 20) & 0xFu; }
#define XB_SPIN(cond, bar) do { unsigned _sp = 0; while (cond) { __builtin_amdgcn_s_sleep(1); \
    if ((++_sp & 255u) == 0u) { if (xb_ld(&(bar)[XB_TMO])) break; if (_sp > XB_SPIN_CAP) { atomicAdd(&(bar)[XB_TMO], 1u); break; } } } } while (0)
struct XcdBarrier { unsigned* bar; unsigned x; volatile LAS unsigned* st; };
__device__ __forceinline__ XcdBarrier xcd_barrier_post(unsigned* bar, volatile LAS unsigned* st) {
    XcdBarrier b; b.bar = bar; b.x = xb_xcc_id(); b.st = st;
    if (threadIdx.x == 0) (void)xb_add(&bar[XB_XCNT(b.x)], 1u);
    return b;
}
__device__ __forceinline__ void xcd_barrier_complete(unsigned* bar, unsigned x, unsigned& nloc, unsigned& nx) {
    const unsigned G = gridDim.x * gridDim.y * gridDim.z;
    unsigned sum, cnt, mine, sp = 0u;
    for (;;) {
        sum = 0u; cnt = 0u; mine = 0u;
#pragma unroll
        for (unsigned j = 0; j < 16; ++j) { const unsigned c = xb_ld(&bar[XB_XCNT(j)]); sum += c; cnt += (c > 0u) ? 1u : 0u; mine = (j == x) ? c : mine; }
        if (sum == G) break;
        __builtin_amdgcn_s_sleep(1);
        if ((++sp & 255u) == 0u) { if (xb_ld(&bar[XB_TMO])) break; if (sp > XB_SPIN_CAP) { atomicAdd(&bar[XB_TMO], 1u); break; } }
    }
    nloc = mine > 0u ? mine : 1u; nx = cnt > 0u ? cnt : 1u;
}
__device__ __forceinline__ void xcd_barrier(const XcdBarrier& b) {
    asm volatile("s_waitcnt vmcnt(0)" ::: "memory");
    __syncthreads();
    if (threadIdx.x == 0) {
        unsigned* bar = b.bar;
        __builtin_amdgcn_s_waitcnt(0);
        unsigned nloc = b.st[0], nx = b.st[1];
        if (nloc == 0u) { xcd_barrier_complete(bar, b.x, nloc, nx); b.st[0] = nloc; b.st[1] = nx; }
        const unsigned old = xb_add(&bar[XB_XSUB(b.x)], 1u);
        const unsigned gen = old / nloc;
        if (old + 1u == (gen + 1u) * nloc) {
            __builtin_amdgcn_fence(__ATOMIC_RELEASE, "agent");
            asm volatile("s_waitcnt vmcnt(0)" ::: "memory");
            const unsigned og = xb_add(&bar[XB_TOP], 1u);
            const unsigned tg = og / nx;
            if (og + 1u == (tg + 1u) * nx) xb_add(&bar[XB_TOPGEN], 1u);
            else XB_SPIN(xb_ld(&bar[XB_TOPGEN]) == tg, bar);
            __builtin_amdgcn_fence(__ATOMIC_ACQUIRE, "agent");
            xb_add(&bar[XB_XGEN(b.x)], 1u);
            asm volatile("s_waitcnt vmcnt(0)" ::: "memory");
        } else {
            XB_SPIN(xb_ld(&bar[XB_XGEN(b.x)]) == gen, bar);
            __builtin_amdgcn_fence(__ATOMIC_ACQUIRE, "agent");
            asm volatile("s_waitcnt vmcnt(0)" ::: "memory");
        }
    }
    __syncthreads();
}

struct Args { const float* in[N_IN]; float* out; unsigned char* ws; int ph_lo, ph_hi, li, pad; };
struct Frame {
    LAS unsigned char* lds;
    volatile LAS unsigned* MISC;
    gu32* ctl;
    int tid, lane, wave, G, bid;
    unsigned char* ws;
};

template <bool I8> __device__ __forceinline__ void cvt_row_store(const f32x4 (&v)[4], int row, unsigned char* dst, float* inv_scale, int lane) {
    float m = 0.f;
#pragma unroll
    for (int j = 0; j < 4; ++j) m = fmaxf(m, fmaxf(fmaxf(fabsf(v[j].x), fabsf(v[j].y)), fmaxf(fabsf(v[j].z), fabsf(v[j].w))));
    m = wave_max(m);
    unsigned ww[4]; float isc;
    if (I8) { const float sc = m > 0.f ? 127.0f / m : 0.f; isc = m * (1.0f / 127.0f);
#pragma unroll
        for (int j = 0; j < 4; ++j) { const int q0 = (int)rintf(v[j].x * sc), q1 = (int)rintf(v[j].y * sc), q2 = (int)rintf(v[j].z * sc), q3 = (int)rintf(v[j].w * sc);
            ww[j] = ((unsigned)q0 & 0xffu) | (((unsigned)q1 & 0xffu) << 8) | (((unsigned)q2 & 0xffu) << 16) | (((unsigned)q3 & 0xffu) << 24); } }
    else { const unsigned E = (__builtin_bit_cast(unsigned, m) >> 23) & 0xffu; float sc = 1.f; isc = 1.f;
        if (E >= 8u && E <= 250u) { sc = __builtin_bit_cast(float, (261u - E) << 23); isc = __builtin_bit_cast(float, (E - 7u) << 23); }
#pragma unroll
        for (int j = 0; j < 4; ++j) { int t = __builtin_amdgcn_cvt_pk_fp8_f32(v[j].x * sc, v[j].y * sc, 0, false); t = __builtin_amdgcn_cvt_pk_fp8_f32(v[j].z * sc, v[j].w * sc, t, true); ww[j] = (unsigned)t; } }
    *(GAS v4u*)(dst + (size_t)(lane >> 3) * NEXP * 128 + (size_t)row * 128 + 16 * (lane & 7)) = (v4u){ww[0], ww[1], ww[2], ww[3]};
    if (lane == 0) inv_scale[row] = isc;
}
template <bool I8> __device__ __forceinline__ void cvt_rows_8bit(const float* src, unsigned char* dst, float* inv_scale, int gw, int NGW, int lane) {
    for (int row = gw; row < NEXP; row += 2 * NGW) {
        const int row1 = row + NGW; const bool has1 = row1 < NEXP;
        f32x4 v0[4], v1[4];
#pragma unroll
        for (int j = 0; j < 4; ++j) v0[j] = *(const GAS f32x4*)(src + (size_t)row * D + 16 * lane + 4 * j);
#pragma unroll
        for (int j = 0; j < 4; ++j) v1[j] = has1 ? *(const GAS f32x4*)(src + (size_t)row1 * D + 16 * lane + 4 * j) : (f32x4){0.f, 0.f, 0.f, 0.f};
        cvt_row_store<I8>(v0, row, dst, inv_scale, lane);
        if (has1) cvt_row_store<I8>(v1, row1, dst, inv_scale, lane);
    }
}
__device__ __forceinline__ void p0_transpose_item(const float* W, int ldw, int src_col0, int valid, int K, bf16* WT, int dst_row0, int k0, LAS float* scr, int lane) {
    const int n_ = lane & 31;
#pragma unroll 8
    for (int i = 0; i < 32; ++i) { const int kk = 2 * i + (lane >> 5); scr[kk * 33 + n_] = (n_ < valid) ? W[(size_t)(k0 + kk) * ldw + src_col0 + n_] : 0.f; }
    LDS_WAIT(); asm volatile("" ::: "memory");
    const int c = lane & 7;
#pragma unroll
    for (int j = 0; j < 4; ++j) { const int n = (lane >> 3) + 8 * j; const LAS float* s = scr + (8 * c) * 33 + n;
        v4u o; o.x = pk2(s[0 * 33], s[1 * 33]); o.y = pk2(s[2 * 33], s[3 * 33]); o.z = pk2(s[4 * 33], s[5 * 33]); o.w = pk2(s[6 * 33], s[7 * 33]);
        *(GAS v4u*)(WT + (size_t)(dst_row0 + n) * K + k0 + 8 * c) = o; }
    LDS_WAIT(); asm volatile("" ::: "memory");
}
__device__ __forceinline__ bool p0_mat(int& r, const float* W, int K, int N, bf16* WT, LAS float* scr, int lane) {
    const int ng = N / 32, items = ng * (K / 64);
    if (r < items) { const int kb = r / ng, nb = r % ng; p0_transpose_item(W, N, 32 * nb, 32, K, WT, 32 * nb, 64 * kb, scr, lane); return true; }
    r -= items; return false;
}
__device__ __forceinline__ void cvt_f32_bf16_stream(const float* src, bf16* dst, size_t n8, size_t gtid, size_t gthreads) {
    for (size_t i = gtid; i < n8; i += gthreads) {
        const f32x4 a = *(const GAS f32x4*)(src + 8 * i), b = *(const GAS f32x4*)(src + 8 * i + 4);
        v4u o; o.x = pk2(a.x, a.y); o.y = pk2(a.z, a.w); o.z = pk2(b.x, b.y); o.w = pk2(b.z, b.w);
        *(GAS v4u*)(dst + 8 * i) = o; }
}

__device__ __forceinline__ void p0_prologue(Frame& F, const Args& args, bool do_bias = true) {
    unsigned char* ws = F.ws;
    const int gw = F.bid * NWAVES + F.wave, NGW = F.G * NWAVES;
    const size_t gtid = (size_t)F.bid * NTHREADS + F.tid, gthreads = (size_t)F.G * NTHREADS;
    {
        LAS float* sl = (LAS float*)(F.lds);
        LAS float* red = (LAS float*)(F.lds + 32768);
        const float* c = args.in[I_C];
        { f32x4 cv[4];
#pragma unroll
          for (int q = 0; q < 4; ++q) cv[q] = *(const GAS f32x4*)(c + 4 * (F.tid + NTHREADS * q));
#pragma unroll
          for (int q = 0; q < 4; ++q) { f32x4 o; o.x = cv[q].x / (1.0f + __expf(-cv[q].x)); o.y = cv[q].y / (1.0f + __expf(-cv[q].y)); o.z = cv[q].z / (1.0f + __expf(-cv[q].z)); o.w = cv[q].w / (1.0f + __expf(-cv[q].w));
              *(LAS f32x4*)(sl + 4 * (F.tid + NTHREADS * q)) = o; } }
        __syncthreads();
        for (int cb = F.bid; cb < 6 * D / 24; cb += F.G) {
            const int j0 = cb * 24;
            if (F.tid < 510) {
                const int kk = F.tid / 6, c4 = F.tid % 6;
                const float* w = args.in[I_ADAW] + j0 + 4 * c4;
                f32x4 wv[13];
#pragma unroll
                for (int m = 0; m < 13; ++m) { const int k = kk + 85 * m; wv[m] = (k < D) ? *(const GAS f32x4*)(w + (size_t)k * (6 * D)) : (f32x4){0.f, 0.f, 0.f, 0.f}; }
                f32x4 a[BATCH];
#pragma unroll
                for (int b = 0; b < BATCH; ++b) a[b] = (f32x4){0.f, 0.f, 0.f, 0.f};
#pragma unroll
                for (int m = 0; m < 13; ++m) { const int k = kk + 85 * m; const int kc = k < D ? k : 0;
#pragma unroll
                    for (int b = 0; b < BATCH; ++b) a[b] = a[b] + wv[m] * sl[b * D + kc]; }
#pragma unroll
                for (int b = 0; b < BATCH; ++b) { LAS float* rp = red + (kk * 24 + 4 * c4) * BATCH + b; rp[0] = a[b].x; rp[BATCH] = a[b].y; rp[2 * BATCH] = a[b].z; rp[3 * BATCH] = a[b].w; }
            }
            __syncthreads();
            if (F.tid < 24 * BATCH) { const int jj = F.tid / BATCH, b = F.tid % BATCH; float s = 0.f;
#pragma unroll 5
                for (int kk = 0; kk < 85; ++kk) s += red[(kk * 24 + jj) * BATCH + b];
                ((float*)(ws + WS_ADA))[b * (6 * D) + j0 + jj] = s + args.in[I_ADAB][j0 + jj]; }
            __syncthreads();
        }
    }
    if (F.bid >= 8 && F.bid < 40 && do_bias) {
        const int bb = F.bid - 8, kv = bb & 1, ch = bb >> 1;
        const float* pe = args.in[kv == 0 ? I_CPEK : I_CPEV]; const float* w1 = args.in[kv == 0 ? I_CW1K : I_CW1V];
        LAS float* red = (LAS float*)(F.lds);
        const int j = F.tid & 127, ic = F.tid >> 7; float s = 0.f;
        const int i0 = ch * 128 + ic * 32;
#pragma unroll 8
        for (int i = i0; i < i0 + 32; ++i) s += pe[i] * w1[(size_t)i * 128 + j];
        red[ic * 128 + j] = s; __syncthreads();
        if (F.tid < 128) atomicAdd((float*)(ws + (kv == 0 ? WS_CB1K : WS_CB1V)) + F.tid, (red[F.tid] + red[128 + F.tid]) + (red[256 + F.tid] + red[384 + F.tid]));
        __syncthreads();
    } else if (F.bid == 2) {
        for (int i = F.tid; i < 8 * 128; i += NTHREADS) { const int h = i >> 7, rel = i & 127;
            int bk = rel;
            if (rel >= 16) bk = 16 + (rel >= 19) + (rel >= 21) + (rel >= 24) + (rel >= 27) + (rel >= 31) + (rel >= 35) + (rel >= 40) + (rel >= 46) + (rel >= 52) + (rel >= 59) + (rel >= 67) + (rel >= 77) + (rel >= 87) + (rel >= 99) + (rel >= 113);
            ((float*)(ws + WS_BIASL))[i] = args.in[I_RELB][bk * 8 + h]; }
        if (F.tid < 64) {
            float mq = fabsf(args.in[I_QNG][F.tid]), mk = fmaxf(fmaxf(fabsf(args.in[I_KNG][F.tid]), fabsf(args.in[I_KNG][64 + F.tid])), fabsf(args.in[I_KNG][128 + F.tid]));
            float mb = fmaxf(fmaxf(fabsf(args.in[I_RELB][F.tid]), fabsf(args.in[I_RELB][64 + F.tid])), fmaxf(fabsf(args.in[I_RELB][128 + F.tid]), fabsf(args.in[I_RELB][192 + F.tid])));
            mq = wave_max(mq); mk = wave_max(mk); mb = wave_max(mb);
            if (F.tid == 0) ((float*)(ws + WS_BIASL))[8 * 128] = 8.0f * mq * mk + mb; }
    }
    {
        LAS float* scr = (LAS float*)(F.lds + F.wave * 16384);
        constexpr int I_WINT = (NIN / 32) * (D / 64);
        constexpr int NITEMS = I_WINT + (1024 / 32) * (512 / 64) + (1024 / 32) * (1024 / 64) + (2048 / 32) * (1024 / 64) + 2 * (128 / 32) * (2048 / 64) + 2 * (64 / 32) * (128 / 64);
        for (int it = gw; it < NITEMS; it += NGW) {
            int r = it;
            if (r < I_WINT) {
                const int grp = r % (NIN / 32), kb = r / (NIN / 32);
                const int tile = grp >> 3, ct0 = (grp & 7) * 32;
                const int L0 = 64 * ((ct0 >> 5) & 3) + 32 * (ct0 >> 7);
                int src0, valid = 32;
                if (tile < 7) src0 = 256 * tile + L0; else if (tile < 15) src0 = 1816 + 256 * (tile - 7) + L0; else { src0 = 1792 + L0; valid = (L0 == 0) ? 24 : 0; }
                if (valid == 0) src0 = 0;
                p0_transpose_item(args.in[I_WIN], IN_COLS, src0, valid, D, (bf16*)(ws + WS_WIN_T), 32 * grp, 64 * kb, scr, F.lane);
                continue; }
            r -= I_WINT;
            if (p0_mat(r, args.in[I_WBA], 512, 1024, (bf16*)(ws + WS_WBA_T), scr, F.lane)) continue;
            if (p0_mat(r, args.in[I_WOUT], 1024, 1024, (bf16*)(ws + WS_WOUT_T), scr, F.lane)) continue;
            if (p0_mat(r, args.in[I_PWQ], 1024, 2048, (bf16*)(ws + WS_WQ_T), scr, F.lane)) continue;
            if (p0_mat(r, args.in[I_CW1K], 2048, 128, (bf16*)(ws + WS_CW1K_T), scr, F.lane)) continue;
            if (p0_mat(r, args.in[I_CW1V], 2048, 128, (bf16*)(ws + WS_CW1V_T), scr, F.lane)) continue;
            if (p0_mat(r, args.in[I_CW2K], 128, 64, (bf16*)(ws + WS_CW2K_T), scr, F.lane)) continue;
            p0_mat(r, args.in[I_CW2V], 128, 64, (bf16*)(ws + WS_CW2V_T), scr, F.lane);
        }
    }
    {
        const float* pw = args.in[I_POOLW]; const float* ps = args.in[I_POOLS]; const float* wbp = args.in[I_WBP];
        bf16* weff = (bf16*)(ws + WS_WEFF_T);
        LAS float* PWl = (LAS float*)(F.lds);
        LAS float* WBl = (LAS float*)(F.lds + 128 * 129 * 4);
        __syncthreads();
        for (int bb = F.bid; bb < 256; bb += F.G) {
            const int g = bb >> 6, d0 = (bb & 63) * 16;
            { f32x4 t[8];
#pragma unroll
              for (int q = 0; q < 8; ++q) t[q] = *(const GAS f32x4*)(pw + (size_t)g * 16384 + 4 * (F.tid + NTHREADS * q));
#pragma unroll
              for (int q = 0; q < 8; ++q) { const int i = 4 * (F.tid + NTHREADS * q); LAS float* d = PWl + (i >> 7) * 129 + (i & 127); d[0] = t[q].x; d[1] = t[q].y; d[2] = t[q].z; d[3] = t[q].w; }
              const int cc = F.tid >> 2, d4 = (F.tid & 3) * 4;
              const f32x4 wv = *(const GAS f32x4*)(wbp + (size_t)(g * 128 + cc) * D + d0 + d4); const float pv = ps[g * 128 + cc];
              LAS float* d = WBl + cc * 17 + d4; d[0] = wv.x * pv; d[1] = wv.y * pv; d[2] = wv.z * pv; d[3] = wv.w * pv; }
            __syncthreads();
            const int c = F.tid & 127, q = F.tid >> 7;
            float acc4[4] = {0.f, 0.f, 0.f, 0.f};
#pragma unroll 4
            for (int cc = 0; cc < 128; ++cc) { const float a = PWl[c * 129 + cc];
#pragma unroll
                for (int e = 0; e < 4; ++e) acc4[e] += a * WBl[cc * 17 + 4 * q + e]; }
#pragma unroll
            for (int e = 0; e < 4; ++e) weff[(size_t)(d0 + 4 * q + e) * POOLW + g * 128 + c] = (bf16)f2bf(acc4[e]);
            __syncthreads();
        }
    }
    cvt_f32_bf16_stream(args.in[I_PSK], (bf16*)(ws + WS_SUBK), (size_t)16 * 128 * 128 / 8, gtid, gthreads);
    cvt_rows_8bit<true>(args.in[I_PU], ws + WS_UB, (float*)(ws + WS_SCLU), gw, NGW, F.lane);
    cvt_rows_8bit<false>(args.in[I_PV], ws + WS_VB, (float*)(ws + WS_SCLV), gw, NGW, F.lane);
}

template <bool Q8> __device__ __forceinline__ void modnorm_rows(Frame& F, const void* xin, const float* g, const float* ada, int shift_idx, bf16* out) {
    const int gw = F.bid * NWAVES + F.wave, NGW = F.G * NWAVES;
    for (int m = gw; m < M; m += NGW) {
        const int b = m >> 12;
        const GAS f32x4* gr = (const GAS f32x4*)g + F.lane;
        const GAS f32x4* sh = (const GAS f32x4*)(ada + (size_t)b * 6 * D + shift_idx * D) + F.lane;
        const GAS f32x4* sc = (const GAS f32x4*)(ada + (size_t)b * 6 * D + (shift_idx + 1) * D) + F.lane;
        f32x4 v[4]; float s = 0.f;
#pragma unroll
        for (int j = 0; j < 4; ++j) {
            if (Q8) { const v2u xb = ((const GAS v2u*)((const bf16*)xin + (size_t)m * D))[F.lane + 64 * j]; v[j] = (f32x4){bflo(xb.x), bfhi(xb.x), bflo(xb.y), bfhi(xb.y)}; }
            else v[j] = ((const GAS f32x4*)((const float*)xin + (size_t)m * D))[F.lane + 64 * j];
            s += (v[j].x * v[j].x + v[j].y * v[j].y) + (v[j].z * v[j].z + v[j].w * v[j].w); }
        const float rstd = rsqrtf(wave_sum(s) * (1.f / D) + EPS);
        GAS v2u* o8 = (GAS v2u*)(out + (size_t)m * D) + F.lane;
        float mx = 0.f;
#pragma unroll
        for (int j = 0; j < 4; ++j) { const f32x4 gg = gr[64 * j], ss = sh[64 * j], cc = sc[64 * j];
            const f32x4 y = (v[j] * rstd) * gg * (cc + 1.0f) + ss; v[j] = y;
            mx = fmaxf(mx, fmaxf(fmaxf(fabsf(y.x), fabsf(y.y)), fmaxf(fabsf(y.z), fabsf(y.w))));
            v2u o; o.x = pk2(y.x, y.y); o.y = pk2(y.z, y.w); o8[64 * j] = o; }
        if (Q8) {
            mx = wave_max(mx);
            const float qs = mx > 0.f ? 127.0f / mx : 0.f;
            GAS unsigned* h8 = (GAS unsigned*)(F.ws + WS_H8 + (size_t)m * D) + F.lane;
#pragma unroll
            for (int j = 0; j < 4; ++j) { const int q0 = (int)rintf(v[j].x * qs), q1 = (int)rintf(v[j].y * qs), q2 = (int)rintf(v[j].z * qs), q3 = (int)rintf(v[j].w * qs);
                h8[64 * j] = ((unsigned)q0 & 0xffu) | (((unsigned)q1 & 0xffu) << 8) | (((unsigned)q2 & 0xffu) << 16) | (((unsigned)q3 & 0xffu) << 24); }
            if (F.lane == 0) ((float*)(F.ws + WS_HS))[m] = mx * (1.0f / 127.0f);
        }
    }
}

struct EpiIn {
    static constexpr bool PERM = true, AFTER_DRAIN = false;
    unsigned char* ws; const float* qg; const float* kg; const volatile LAS unsigned* rmp;
    __device__ __forceinline__ void operator()(const pg8::f32x4 (&acc)[2][2][4][2], const pg8::Unit& u, int wr, int wc, int fr, int fq) const {
        const int pn = u.pn, rmask = __builtin_amdgcn_readfirstlane((int)*rmp);
#pragma unroll
        for (int ai = 0; ai < 2; ++ai)
#pragma unroll
            for (int m = 0; m < 4; ++m) {
                const int row = (u.pm & rmask) * 256 + ai * 128 + wr * 64 + m * 16 + fr;
                float v[2][8];
#pragma unroll
                for (int bj = 0; bj < 2; ++bj)
#pragma unroll
                    for (int n = 0; n < 2; ++n)
#pragma unroll
                        for (int i = 0; i < 4; ++i) v[bj][4 * n + i] = acc[ai][bj][m][n][i];
                bf16* dst = nullptr; bool norm = false; const float* gain = nullptr; float mul = 1.f; bool sig = false;
                if (pn < 2) { dst = (bf16*)(ws + WS_ZP) + (size_t)row * 512 + 256 * pn + 64 * wc; }
                else if (pn < 4) { dst = (bf16*)(ws + WS_Q) + (size_t)row * 512 + 256 * (pn - 2) + 64 * wc; norm = true; gain = qg; mul = 0.125f * 1.4426950408889634f; }
                else if (pn < 7) { const int kind = pn - 4, isv = wc >> 1, g = wc & 1, b = row >> 12, t = row & 4095;
                    const size_t base = ((size_t)(b * 2 + g) * SEQ + t) * 64;
                    const size_t off = kind == 0 ? (isv ? WS_VCR : WS_KCR) : kind == 1 ? (isv ? WS_VS : WS_KS) : (isv ? WS_VW : WS_KW);
                    dst = (bf16*)(ws + off) + base; if (!isv && kind > 0) { norm = true; gain = kg + kind * 64; } }
                else if (pn < 15) { dst = (bf16*)(ws + WS_GM) + (size_t)row * 2048 + 256 * (pn - 7) + 64 * wc; sig = true; }
                else {
                    if (wc == 0 && fq < 3) { float* gp = (float*)(ws + WS_GATE) + (size_t)row * 24 + 8 * fq;
                        *(GAS f32x4*)gp = (f32x4){sigmoidf_(v[0][0]), sigmoidf_(v[0][1]), sigmoidf_(v[0][2]), sigmoidf_(v[0][3])};
                        *(GAS f32x4*)(gp + 4) = (f32x4){sigmoidf_(v[0][4]), sigmoidf_(v[0][5]), sigmoidf_(v[0][6]), sigmoidf_(v[0][7])}; }
                    continue; }
                if (norm) { float ss = 0.f;
#pragma unroll
                    for (int bj = 0; bj < 2; ++bj)
#pragma unroll
                        for (int e = 0; e < 8; ++e) ss += v[bj][e] * v[bj][e];
                    ss = sum_xor32(sum_xor16(ss));
                    const float rs = rsqrtf(ss * (1.f / 64.f) + EPS) * mul;
#pragma unroll
                    for (int bj = 0; bj < 2; ++bj)
#pragma unroll
                        for (int e = 0; e < 8; ++e) v[bj][e] = v[bj][e] * rs * gain[32 * bj + 8 * fq + e]; }
                if (sig) {
#pragma unroll
                    for (int bj = 0; bj < 2; ++bj)
#pragma unroll
                        for (int e = 0; e < 8; ++e) v[bj][e] = sigmoidf_(v[bj][e]); }
#pragma unroll
                for (int bj = 0; bj < 2; ++bj) { v4u o; o.x = pkh(v[bj][0], v[bj][1]); o.y = pkh(v[bj][2], v[bj][3]); o.z = pkh(v[bj][4], v[bj][5]); o.w = pkh(v[bj][6], v[bj][7]);
                    *(GAS v4u*)(dst + 32 * bj + 8 * fq) = o; }
            }
    }
};
template <bool ADD> struct EpiMix {
    static constexpr bool PERM = true, AFTER_DRAIN = false;
    bf16* MIX; const bf16* GM; int gmoff;
    __device__ __forceinline__ void operator()(const pg8::f32x4 (&acc)[2][2][4][2], const pg8::Unit& u, int wr, int wc, int fr, int fq) const {
#pragma unroll
        for (int ai = 0; ai < 2; ++ai)
#pragma unroll
            for (int m = 0; m < 4; ++m) {
                const int row = u.pm * 256 + ai * 128 + wr * 64 + m * 16 + fr;
#pragma unroll
                for (int bj = 0; bj < 2; ++bj) {
                    const int col = u.pn * 256 + bj * 128 + wc * 32 + 8 * fq;
                    const v4u gmv = *(const GAS v4u*)(GM + (size_t)row * 2048 + gmoff + col);
                    float r[8];
                    r[0] = acc[ai][bj][m][0][0] * bflo(gmv.x); r[1] = acc[ai][bj][m][0][1] * bfhi(gmv.x); r[2] = acc[ai][bj][m][0][2] * bflo(gmv.y); r[3] = acc[ai][bj][m][0][3] * bfhi(gmv.y);
                    r[4] = acc[ai][bj][m][1][0] * bflo(gmv.z); r[5] = acc[ai][bj][m][1][1] * bfhi(gmv.z); r[6] = acc[ai][bj][m][1][2] * bflo(gmv.w); r[7] = acc[ai][bj][m][1][3] * bfhi(gmv.w);
                    GAS v4u* dp = (GAS v4u*)(MIX + (size_t)row * 1024 + col);
                    if (ADD) { const v4u old = *dp; r[0] += bflo(old.x); r[1] += bfhi(old.x); r[2] += bflo(old.y); r[3] += bfhi(old.y); r[4] += bflo(old.z); r[5] += bfhi(old.z); r[6] += bflo(old.w); r[7] += bfhi(old.w); }
                    v4u o; o.x = pkh(r[0], r[1]); o.y = pkh(r[2], r[3]); o.z = pkh(r[4], r[5]); o.w = pkh(r[6], r[7]); *dp = o; }
            }
    }
};
struct EpiRes {
    static constexpr bool PERM = true, AFTER_DRAIN = false;
    const float* x; bf16* x1; const float* ada; int gate_idx;
    __device__ __forceinline__ void operator()(const pg8::f32x4 (&acc)[2][2][4][2], const pg8::Unit& u, int wr, int wc, int fr, int fq) const {
#pragma unroll
        for (int ai = 0; ai < 2; ++ai)
#pragma unroll
            for (int m = 0; m < 4; ++m) {
                const int row = u.pm * 256 + ai * 128 + wr * 64 + m * 16 + fr, b = row >> 12;
#pragma unroll
                for (int bj = 0; bj < 2; ++bj) {
                    const int col = u.pn * 256 + bj * 128 + wc * 32 + 8 * fq;
                    const float* gp = ada + (size_t)b * 6 * D + gate_idx * D + col; const float* xp = x + (size_t)row * D + col;
                    const f32x4 g0 = *(const GAS f32x4*)gp, g1 = *(const GAS f32x4*)(gp + 4), x0 = *(const GAS f32x4*)xp, x1v = *(const GAS f32x4*)(xp + 4);
                    const f32x4 r0 = x0 + g0 * acc[ai][bj][m][0], r1 = x1v + g1 * acc[ai][bj][m][1];
                    v4u o; o.x = pkh(r0.x, r0.y); o.y = pkh(r0.z, r0.w); o.z = pkh(r1.x, r1.y); o.w = pkh(r1.z, r1.w);
                    *(GAS v4u*)(x1 + (size_t)row * D + col) = o; }
            }
    }
};

template <int W> __device__ __forceinline__ void pool_load(const bf16* zp, int row, int t, int col, v4u (&z)[W]) {
#pragma unroll
    for (int j = 0; j < W; ++j) z[j] = (j <= t) ? *(const GAS v4u*)(zp + (size_t)(row - j) * 512 + col) : (v4u){0u, 0u, 0u, 0u};
}
template <int W> __device__ __forceinline__ v4u pool_reduce(const v4u (&z)[W], int t) {
    float s[8], self[8];
#pragma unroll
    for (int e = 0; e < 8; ++e) { s[e] = 0.f; self[e] = 0.f; }
#pragma unroll
    for (int j = 0; j < W; ++j) { const float f[8] = {bflo(z[j].x), bfhi(z[j].x), bflo(z[j].y), bfhi(z[j].y), bflo(z[j].z), bfhi(z[j].z), bflo(z[j].w), bfhi(z[j].w)};
#pragma unroll
        for (int e = 0; e < 8; ++e) { s[e] += f[e]; if (j == 0) self[e] = f[e]; } }
    const float inv = 1.0f / (float)((t + 1 < W) ? (t + 1) : W);
    v4u o; o.x = pk2(s[0] * inv - self[0], s[1] * inv - self[1]); o.y = pk2(s[2] * inv - self[2], s[3] * inv - self[3]);
    o.z = pk2(s[4] * inv - self[4], s[5] * inv - self[5]); o.w = pk2(s[6] * inv - self[6], s[7] * inv - self[7]);
    return o;
}
__device__ __forceinline__ void pool_phase(Frame& F) {
    const bf16* zp = (const bf16*)(F.ws + WS_ZP); bf16* pl = (bf16*)(F.ws + WS_PL);
    const int gw = F.bid * NWAVES + F.wave, NGW = F.G * NWAVES;
    for (int r4 = gw; r4 < M / 4; r4 += NGW) {
        const int row = 4 * r4 + (F.lane >> 4), t = row & 4095, c0 = 8 * (F.lane & 15);
        v4u z2[2], z4[4], z8[8], z16[16];
        pool_load<2>(zp, row, t, c0, z2); pool_load<4>(zp, row, t, 128 + c0, z4); pool_load<8>(zp, row, t, 256 + c0, z8); pool_load<16>(zp, row, t, 384 + c0, z16);
        const v4u o2 = pool_reduce<2>(z2, t), o4 = pool_reduce<4>(z4, t), o8 = pool_reduce<8>(z8, t), o16 = pool_reduce<16>(z16, t);
        GAS v4u* dst = (GAS v4u*)(pl + (size_t)row * 512 + c0);
        dst[0] = o2; dst[16] = o4; dst[32] = o8; dst[48] = o16;
    }
}

typedef int v4i __attribute__((ext_vector_type(4)));
struct EpiStoreBf16 {
    static constexpr bool PERM = true, AFTER_DRAIN = false;
    bf16* O; int ldc;
    __device__ __forceinline__ void operator()(const pg8::f32x4 (&acc)[2][2][4][2], const pg8::Unit& u, int wr, int wc, int fr, int fq) const {
#pragma unroll
        for (int ai = 0; ai < 2; ++ai)
#pragma unroll
            for (int m = 0; m < 4; ++m) {
                const int row = u.pm * 256 + ai * 128 + wr * 64 + m * 16 + fr;
#pragma unroll
                for (int bj = 0; bj < 2; ++bj) {
                    const int col = u.pn * 256 + bj * 128 + wc * 32 + 8 * fq;
                    v4u o; o.x = pkh(acc[ai][bj][m][0][0], acc[ai][bj][m][0][1]); o.y = pkh(acc[ai][bj][m][0][2], acc[ai][bj][m][0][3]);
                    o.z = pkh(acc[ai][bj][m][1][0], acc[ai][bj][m][1][1]); o.w = pkh(acc[ai][bj][m][1][2], acc[ai][bj][m][1][3]);
                    *(GAS v4u*)(O + (size_t)row * ldc + col) = o; }
            }
    }
};

__device__ __forceinline__ unsigned fkey(float f) { const unsigned u = __builtin_bit_cast(unsigned, f); return (u >> 31) ? ~u : (u | 0x80000000u); }
__device__ __forceinline__ float funkey(unsigned k) { const unsigned u = (k >> 31) ? (k & 0x7fffffffu) : ~k; return __builtin_bit_cast(float, u); }
__device__ __forceinline__ unsigned umax_(unsigned a, unsigned b) { return a > b ? a : b; }
__device__ __forceinline__ unsigned umin_(unsigned a, unsigned b) { return a > b ? b : a; }
#define TOP16_INSERT(L, xin) do { unsigned _x = (xin); _Pragma("unroll") for (int _i = 0; _i < 16; ++_i) { const unsigned _h = umax_(L[_i], _x); _x = umin_(L[_i], _x); L[_i] = _h; } } while (0)
template <int MASK> __device__ __forceinline__ void top16_merge(unsigned (&L)[16]) {
    unsigned o[16];
#pragma unroll
    for (int i = 0; i < 16; ++i) o[i] = (unsigned)dppi<MASK == 1 ? DPP_XOR1 : DPP_XOR2>((int)L[i]);
#pragma unroll
    for (int i = 0; i < 16; ++i) L[i] = umax_(L[i], o[15 - i]);
#pragma unroll
    for (int d = 8; d >= 1; d >>= 1)
#pragma unroll
        for (int i = 0; i < 16; ++i) if ((i & d) == 0) { const unsigned hi = umax_(L[i], L[i + d]), lo = umin_(L[i], L[i + d]); L[i] = hi; L[i + d] = lo; }
}
#define CE_DESC(a_, b_) do { const unsigned _h = umax_(a_, b_), _l = umin_(a_, b_); a_ = _h; b_ = _l; } while (0)
template <int OFF> __device__ __forceinline__ void bitonic_sort16_desc(unsigned (&v)[32]) {
#pragma unroll
    for (int k = 2; k <= 16; k <<= 1)
#pragma unroll
        for (int j = k >> 1; j > 0; j >>= 1)
#pragma unroll
            for (int i = 0; i < 16; ++i) { const int l = i ^ j; if (l > i) { if ((i & k) == 0) CE_DESC(v[OFF + i], v[OFF + l]); else CE_DESC(v[OFF + l], v[OFF + i]); } }
}
__device__ __forceinline__ void bitonic_merge16_desc(unsigned (&L)[16]) {
#pragma unroll
    for (int d = 8; d >= 1; d >>= 1)
#pragma unroll
        for (int i = 0; i < 16; ++i) if ((i & d) == 0) CE_DESC(L[i], L[i + d]);
}
constexpr int SST = 132;
constexpr int P9_LIST_OFF = 2 * 64 * SST * 4;
__device__ __forceinline__ void peer_select_phase(Frame& F) {
    const bf16* QV = (const bf16*)(F.ws + WS_QV); const bf16* SK = (const bf16*)(F.ws + WS_SUBK);
    int* EID = (int*)(F.ws + WS_EID); float* GW = (float*)(F.ws + WS_GW);
    LAS float* S = (LAS float*)(F.lds);
    LAS unsigned* LIST = (LAS unsigned*)(F.lds + P9_LIST_OFF);
    const int lane = F.lane, w = F.wave, l15 = lane & 15, lq = lane >> 4;
    const int p = w >> 2, kb = w & 3;
    constexpr int NU = (M / 64) * PH;
    bf16x8 a[4][4], bq[2][4];
#define P9_LOAD(u_) do { const int _tt = (u_) >> 3, _h = (u_) & 7; \
        const bf16* qa = QV + (size_t)(_tt * 64 + l15) * PQW + _h * 256 + p * 128 + 8 * lq; \
        const bf16* kbp = SK + (size_t)((_h * 2 + p) * 128 + 32 * kb + l15) * 128 + 8 * lq; \
        _Pragma("unroll") for (int ks = 0; ks < 4; ++ks) { \
            _Pragma("unroll") for (int rb = 0; rb < 4; ++rb) a[rb][ks] = *(const GAS bf16x8*)(qa + (size_t)(16 * rb) * PQW + 32 * ks); \
            _Pragma("unroll") for (int cb = 0; cb < 2; ++cb) bq[cb][ks] = *(const GAS bf16x8*)(kbp + (size_t)(16 * cb) * 128 + 32 * ks); } } while (0)
    if (F.bid < NU) P9_LOAD(F.bid);
    for (int u = F.bid; u < NU; u += F.G) {
        const int tt = u >> 3, h = u & 7, tok0 = tt * 64;
        {
            pg8::f32x4 acc[4][2];
#pragma unroll
            for (int rb = 0; rb < 4; ++rb)
#pragma unroll
                for (int cb = 0; cb < 2; ++cb) acc[rb][cb] = (pg8::f32x4){0.f, 0.f, 0.f, 0.f};
#pragma unroll
            for (int ks = 0; ks < 4; ++ks)
#pragma unroll
                for (int rb = 0; rb < 4; ++rb)
#pragma unroll
                    for (int cb = 0; cb < 2; ++cb) acc[rb][cb] = __builtin_amdgcn_mfma_f32_16x16x32_bf16(a[rb][ks], bq[cb][ks], acc[rb][cb], 0, 0, 0);
#pragma unroll
            for (int rb = 0; rb < 4; ++rb)
#pragma unroll
                for (int cb = 0; cb < 2; ++cb)
#pragma unroll
                    for (int r = 0; r < 4; ++r) S[(p * 64 + 16 * rb + 4 * lq + r) * SST + 32 * kb + 16 * cb + l15] = acc[rb][cb][r];
        }
        __syncthreads();
        if (u + F.G < NU) P9_LOAD(u + F.G);
        {
            const int row = F.tid >> 2, sub = F.tid & 3;
            const LAS float* sr = S + row * SST + sub;
            unsigned kv[32];
#pragma unroll
            for (int i = 0; i < 32; ++i) kv[i] = (fkey(sr[4 * i]) & ~127u) | (unsigned)(4 * i + sub);
            bitonic_sort16_desc<0>(kv); bitonic_sort16_desc<16>(kv);
            unsigned L[16];
#pragma unroll
            for (int i = 0; i < 16; ++i) L[i] = umax_(kv[i], kv[31 - i]);
            bitonic_merge16_desc(L);
            top16_merge<1>(L); top16_merge<2>(L);
            if (sub == 0) {
#pragma unroll
                for (int i = 0; i < 4; ++i) *(LAS v4u*)(LIST + row * 16 + 4 * i) = (v4u){L[4 * i], L[4 * i + 1], L[4 * i + 2], L[4 * i + 3]}; }
        }
        __syncthreads();
        if (F.tid < 256) {
            const int tok = F.tid >> 2, sub = F.tid & 3;
            float va[16], vb[16];
#pragma unroll
            for (int i = 0; i < 4; ++i) { const v4u x = *(const LAS v4u*)(LIST + tok * 16 + 4 * i), y = *(const LAS v4u*)(LIST + (64 + tok) * 16 + 4 * i);
                va[4 * i] = funkey(x.x & ~127u); va[4 * i + 1] = funkey(x.y & ~127u); va[4 * i + 2] = funkey(x.z & ~127u); va[4 * i + 3] = funkey(x.w & ~127u);
                vb[4 * i] = funkey(y.x & ~127u); vb[4 * i + 1] = funkey(y.y & ~127u); vb[4 * i + 2] = funkey(y.z & ~127u); vb[4 * i + 3] = funkey(y.w & ~127u); }
            unsigned cand[32];
#pragma unroll
            for (int i = 0; i < 32; ++i) cand[i] = 0u;
            {
                constexpr int NC = 50;
                constexpr unsigned char CI[52] = {0,0,0,0,0,0,0,0,0,0,0,0,0,0,0,0, 1,1,1,1,1,1,1,1, 2,2,2,2,2, 3,3,3,3, 4,4,4, 5,5, 6,6, 7,7, 8,9,10,11,12,13,14,15, 0,0};
                constexpr unsigned char CJ[52] = {0,1,2,3,4,5,6,7,8,9,10,11,12,13,14,15, 0,1,2,3,4,5,6,7, 0,1,2,3,4, 0,1,2,3, 0,1,2, 0,1, 0,1, 0,1, 0,0,0,0,0,0,0,0, 0,0};
#pragma unroll
                for (int g4 = 0; g4 < 13; ++g4) {
                    float sa = 0.f, sb = 0.f; unsigned id = 0u; bool ok = false;
#pragma unroll
                    for (int q = 0; q < 4; ++q) { const int n = 4 * g4 + q; if (n < NC) { const bool me = (sub == q); sa = me ? va[CI[n]] : sa; sb = me ? vb[CJ[n]] : sb; id = me ? (unsigned)(CI[n] * 16 + CJ[n]) : id; ok = ok || me; } }
                    cand[g4] = ok ? ((fkey(sa + sb) & ~255u) | id) : 0u;
                }
            }
            bitonic_sort16_desc<0>(cand);
            unsigned L[16];
#pragma unroll
            for (int i = 0; i < 16; ++i) L[i] = cand[i];
            top16_merge<1>(L); top16_merge<2>(L);
            const float mx = funkey(L[0] & ~255u);
            float e[16], sum = 0.f;
#pragma unroll
            for (int k = 0; k < 16; ++k) { e[k] = __expf(funkey(L[k] & ~255u) - mx); sum += e[k]; }
            const float inv = 1.0f / sum;
            const size_t ob = (size_t)(tok0 + tok) * 128;
#pragma unroll
            for (int k4 = 0; k4 < 4; ++k4) if (sub == k4) {
#pragma unroll
                for (int q = 0; q < 4; ++q) { const unsigned cid = L[4 * k4 + q] & 255u;
                    const unsigned ia = LIST[tok * 16 + (cid >> 4)] & 127u, ib = LIST[(64 + tok) * 16 + (cid & 15u)] & 127u;
                    const int slot = h * 16 + 4 * k4 + q;
                    EID[ob + slot] = (int)(ia * 128u + ib); GW[ob + slot] = e[4 * k4 + q] * inv; }
            }
        }
        __syncthreads();
    }
#undef P9_LOAD
}

__device__ __forceinline__ void unpack8(const v4u w, float (&f)[8]) { f[0] = bflo(w.x); f[1] = bfhi(w.x); f[2] = bflo(w.y); f[3] = bfhi(w.y); f[4] = bflo(w.z); f[5] = bfhi(w.z); f[6] = bflo(w.w); f[7] = bfhi(w.w); }
typedef float f32x2 __attribute__((ext_vector_type(2)));
__device__ __forceinline__ void unpack16_fp8(const v4u w, float (&f)[16]) {
    const unsigned ww[4] = {w.x, w.y, w.z, w.w};
#pragma unroll
    for (int d = 0; d < 4; ++d) { const f32x2 a = __builtin_amdgcn_cvt_pk_f32_fp8((int)ww[d], false), b = __builtin_amdgcn_cvt_pk_f32_fp8((int)ww[d], true);
        f[4 * d] = a.x; f[4 * d + 1] = a.y; f[4 * d + 2] = b.x; f[4 * d + 3] = b.y; }
}
template <int PV_> __device__ __forceinline__ void peer_dot_phase(Frame& F) {
    const unsigned char* H8 = F.ws + WS_H8; const int* EID = (const int*)(F.ws + WS_EID); float* PART = (float*)(F.ws + WS_PART);
    const int lane = F.lane, g = lane >> 3, j = lane & 7, x = F.bid & 7;
    const int nbx = (F.G - x + 7) >> 3, NW = nbx * NWAVES, gwv = (F.bid >> 3) * NWAVES + F.wave;
    const unsigned char* US = F.ws + WS_UB + (size_t)x * NEXP * 128; const unsigned j16 = 16u * (unsigned)j;
    int token = gwv;
    if (token >= M) return;
    const int lasttok = gwv + ((M - 1 - gwv) / NW) * NW;
    v4i eA[4], eB[4]; v4i hA, hB;
#define PD_CL(t_) ((t_) < M ? (t_) : lasttok)
#define PD_LOAD_E(e_, tok_) do { _Pragma("unroll") for (int q = 0; q < 4; ++q) e_[q] = *(const GAS v4i*)(EID + (size_t)(tok_) * 128 + 16 * g + 4 * q); } while (0)
#define PD_ISSUE4(buf_, e_, b0_) do { buf_[b0_] = *(const GAS v4i*)(US + ((unsigned)e_.x * 128u + j16)); buf_[b0_ + 1] = *(const GAS v4i*)(US + ((unsigned)e_.y * 128u + j16)); \
        buf_[b0_ + 2] = *(const GAS v4i*)(US + ((unsigned)e_.z * 128u + j16)); buf_[b0_ + 3] = *(const GAS v4i*)(US + ((unsigned)e_.w * 128u + j16)); } while (0)
#define PD_DOT1(w_, hc_, dst_) do { int t = __builtin_amdgcn_sdot4(w_.x, hc_.x, 0, false); t = __builtin_amdgcn_sdot4(w_.y, hc_.y, t, false); t = __builtin_amdgcn_sdot4(w_.z, hc_.z, t, false); t = __builtin_amdgcn_sdot4(w_.w, hc_.w, t, false); \
        t += dppi<DPP_XOR1>(t); t += dppi<DPP_XOR2>(t); t += dppi<DPP_HMIR>(t); dst_ = (float)t; } while (0)
#define PD_BODY(eC, eN, hC, hN, tok_) do { const int tk_ = PD_CL(tok_); \
        PD_ISSUE4(bB, eC[2], 0); PD_ISSUE4(bB, eC[3], 4); \
        PD_LOAD_E(eC, PD_CL(tk_ + 2 * NW)); \
        hN = *(const GAS v4i*)(H8 + (size_t)PD_CL(tk_ + NW) * D + 128 * x + j16); \
        float s[16]; \
        _Pragma("unroll") for (int i = 0; i < 8; ++i) PD_DOT1(bA[i], hC, s[i]); \
        PD_ISSUE4(bA, eN[0], 0); PD_ISSUE4(bA, eN[1], 4); \
        _Pragma("unroll") for (int i = 0; i < 8; ++i) PD_DOT1(bB[i], hC, s[8 + i]); \
        { float* pp = PART + ((size_t)x * M + tk_) * 128 + g * 16;       \
          _Pragma("unroll") for (int i4 = 0; i4 < 4; ++i4) *(GAS f32x4*)(pp + 4 * i4) = (f32x4){s[4 * i4], s[4 * i4 + 1], s[4 * i4 + 2], s[4 * i4 + 3]}; } } while (0)
    PD_LOAD_E(eA, token); hA = *(const GAS v4i*)(H8 + (size_t)token * D + 128 * x + j16);
    PD_LOAD_E(eB, PD_CL(token + NW));
    v4i bA[8], bB[8];
    PD_ISSUE4(bA, eA[0], 0); PD_ISSUE4(bA, eA[1], 4);
    __builtin_amdgcn_s_waitcnt(0x0F70);
    for (; token < M; token += 2 * NW) {
        PD_BODY(eA, eB, hA, hB, token);
        PD_BODY(eB, eA, hB, hA, token + NW);
    }
#undef PD_BODY
#undef PD_CL
#undef PD_LOAD_E
#undef PD_ISSUE4
#undef PD_DOT1
}
template <int NTOK> __device__ __forceinline__ void peer_loadrate_probe(Frame& F) {
    const int* EID = (const int*)(F.ws + WS_EID);
    const int lane = F.lane, g = lane >> 3, j = lane & 7, x = F.bid & 7;
    const int nbx = (F.G - x + 7) >> 3, NW = nbx * NWAVES, gwv = (F.bid >> 3) * NWAVES + F.wave;
    const unsigned char* US = F.ws + WS_UB + (size_t)x * NEXP * 128; const unsigned j16 = 16u * (unsigned)j;
    unsigned acc = 0u;
    for (int token = gwv; token + (NTOK - 1) * NW < M; token += NTOK * NW) {
        v4i e4[NTOK][4];
#pragma unroll
        for (int t = 0; t < NTOK; ++t)
#pragma unroll
            for (int q = 0; q < 4; ++q) e4[t][q] = *(const GAS v4i*)(EID + (size_t)(token + t * NW) * 128 + 16 * g + 4 * q);
        v4i b[NTOK][16];
#pragma unroll
        for (int t = 0; t < NTOK; ++t)
#pragma unroll
            for (int q = 0; q < 4; ++q) { b[t][4 * q] = *(const GAS v4i*)(US + ((unsigned)e4[t][q].x * 128u + j16)); b[t][4 * q + 1] = *(const GAS v4i*)(US + ((unsigned)e4[t][q].y * 128u + j16));
                b[t][4 * q + 2] = *(const GAS v4i*)(US + ((unsigned)e4[t][q].z * 128u + j16)); b[t][4 * q + 3] = *(const GAS v4i*)(US + ((unsigned)e4[t][q].w * 128u + j16)); }
#pragma unroll
        for (int t = 0; t < NTOK; ++t)
#pragma unroll
            for (int i = 0; i < 16; ++i) acc ^= (unsigned)(b[t][i].x ^ b[t][i].y ^ b[t][i].z ^ b[t][i].w);
    }
    asm volatile("" :: "v"(acc));
}
__device__ __forceinline__ void peer_coef_phase(Frame& F) {
    const float* PART = (const float*)(F.ws + WS_PART); const int* EID = (const int*)(F.ws + WS_EID); const float* GW = (const float*)(F.ws + WS_GW);
    const float* SCU = (const float*)(F.ws + WS_SCLU); const float* SCV = (const float*)(F.ws + WS_SCLV); const float* HS = (const float*)(F.ws + WS_HS);
    unsigned* CF8 = (unsigned*)(F.ws + WS_CF); float* CFS = (float*)(F.ws + WS_CFS);
    const size_t gtid = (size_t)F.bid * NTHREADS + F.tid, gthreads = (size_t)F.G * NTHREADS, n4 = (size_t)M * 128 / 4;
    for (size_t i4 = gtid; i4 < n4; i4 += gthreads) {
        f32x4 d = *(const GAS f32x4*)(PART + 4 * i4);
#pragma unroll
        for (int xx = 1; xx < 8; ++xx) d = d + *(const GAS f32x4*)(PART + (size_t)xx * M * 128 + 4 * i4);
        const v4i e = *(const GAS v4i*)(EID + 4 * i4); const f32x4 gw = *(const GAS f32x4*)(GW + 4 * i4);
        const float hs = HS[i4 >> 5];
        f32x4 r; r.x = gw.x * SCV[e.x] * gelu_tanh_safe(d.x * (SCU[e.x] * hs)); r.y = gw.y * SCV[e.y] * gelu_tanh_safe(d.y * (SCU[e.y] * hs));
        r.z = gw.z * SCV[e.z] * gelu_tanh_safe(d.z * (SCU[e.z] * hs)); r.w = gw.w * SCV[e.w] * gelu_tanh_safe(d.w * (SCU[e.w] * hs));
        float m = fmaxf(fmaxf(fabsf(r.x), fabsf(r.y)), fmaxf(fabsf(r.z), fabsf(r.w)));
        m = fmaxf(m, dppf<DPP_XOR1>(m)); m = fmaxf(m, dppf<DPP_XOR2>(m)); m = fmaxf(m, dppf<DPP_HMIR>(m)); m = fmaxf(m, dppf<DPP_ROR8>(m)); m = max_xor16(m);
        const unsigned E = (__builtin_bit_cast(unsigned, m) >> 23) & 0xffu; float sc = 1.f, isc = 1.f;
        if (E >= 8u && E <= 250u) { sc = __builtin_bit_cast(float, (261u - E) << 23); isc = __builtin_bit_cast(float, (E - 7u) << 23); }
        int t = __builtin_amdgcn_cvt_pk_fp8_f32(r.x * sc, r.y * sc, 0, false); t = __builtin_amdgcn_cvt_pk_fp8_f32(r.z * sc, r.w * sc, t, true);
        CF8[i4] = (unsigned)t;
        if ((F.lane & 31) == 0) CFS[i4 >> 5] = isc; }
}
template <bool DRY, bool CHECK = false> __device__ __forceinline__ void peer_out_phase(Frame& F, const float* ada, float* out) {
    const int* EID = (const int*)(F.ws + WS_EID); const unsigned char* CF8 = (const unsigned char*)(F.ws + WS_CF); const float* CFS = (const float*)(F.ws + WS_CFS);
    const int lane = F.lane, g = lane >> 3, j = lane & 7, x = F.bid & 7;
    const int nbx = (F.G - x + 7) >> 3, NW = nbx * NWAVES, gwv = (F.bid >> 3) * NWAVES + F.wave;
    const unsigned char* VS = F.ws + WS_VB + (size_t)x * NEXP * 128; const unsigned j16 = 16u * (unsigned)j;
    if (gwv >= M) return;
    const int ntok = (M - 1 - gwv) / NW + 1;
#define PO_ISSUE4(buf_, e_, b0_) do { buf_[b0_] = *(const GAS v4u*)(VS + ((unsigned)e_.x * 128u + j16)); buf_[b0_ + 1] = *(const GAS v4u*)(VS + ((unsigned)e_.y * 128u + j16)); \
        buf_[b0_ + 2] = *(const GAS v4u*)(VS + ((unsigned)e_.z * 128u + j16)); buf_[b0_ + 3] = *(const GAS v4u*)(VS + ((unsigned)e_.w * 128u + j16)); } while (0)
#define PO_ROW(w_, c_) do { float f[16]; unpack16_fp8(w_, f); _Pragma("unroll") for (int k = 0; k < 16; ++k) o[k] += (c_) * f[k]; } while (0)
#define PO_ACC4(buf_, c4_, b0_) do { PO_ROW(buf_[b0_], c4_.x); PO_ROW(buf_[b0_ + 1], c4_.y); PO_ROW(buf_[b0_ + 2], c4_.z); PO_ROW(buf_[b0_ + 3], c4_.w); } while (0)
    v4i e4[4]; f32x4 c4[4]; v4u bA[8], bB[8];
#define PO_LOADC(tok_) do { const float cs_ = CFS[tok_]; _Pragma("unroll") for (int q = 0; q < 4; ++q) { const unsigned w_ = *(const GAS unsigned*)(CF8 + (size_t)(tok_) * 128 + g * 16 + 4 * q); \
        const f32x2 lo_ = __builtin_amdgcn_cvt_pk_f32_fp8((int)w_, false), hi_ = __builtin_amdgcn_cvt_pk_f32_fp8((int)w_, true); c4[q] = (f32x4){lo_.x * cs_, lo_.y * cs_, hi_.x * cs_, hi_.y * cs_}; } } while (0)
#pragma unroll
    for (int q = 0; q < 4; ++q) e4[q] = *(const GAS v4i*)(EID + (size_t)gwv * 128 + g * 16 + 4 * q);
    PO_LOADC(gwv);
    PO_ISSUE4(bA, e4[0], 0); PO_ISSUE4(bA, e4[1], 4);
    for (int it = 0; it < ntok; ++it) {
        const int token = gwv + it * NW, tn = gwv + (it + 1 < ntok ? it + 1 : it) * NW;
        PO_ISSUE4(bB, e4[2], 0); PO_ISSUE4(bB, e4[3], 4);
#pragma unroll
        for (int q = 0; q < 4; ++q) e4[q] = *(const GAS v4i*)(EID + (size_t)tn * 128 + g * 16 + 4 * q);
        float o[16];
#pragma unroll
        for (int k = 0; k < 16; ++k) o[k] = 0.f;
        PO_ACC4(bA, c4[0], 0); PO_ACC4(bA, c4[1], 4);
        PO_ISSUE4(bA, e4[0], 0); PO_ISSUE4(bA, e4[1], 4);
        PO_ACC4(bB, c4[2], 0); PO_ACC4(bB, c4[3], 4);
        PO_LOADC(tn);
#pragma unroll
        for (int k = 0; k < 16; ++k) { float t = o[k]; t += dppf<DPP_ROR8>(t); o[k] = sum_xor32(sum_xor16(t)); }
        if (g == 0) { const int b = token >> 12;
            const float* gt = ada + (size_t)b * 6 * D + 5 * D + 128 * x + 16 * j;
            float* xo = out + (size_t)token * D + 128 * x + 16 * j;
#pragma unroll
            for (int q = 0; q < 4; ++q) { const f32x4 xv = *(const GAS f32x4*)(xo + 4 * q), gv = *(const GAS f32x4*)(gt + 4 * q);
                f32x4 res = xv + gv * (f32x4){o[4 * q], o[4 * q + 1], o[4 * q + 2], o[4 * q + 3]};
                if (CHECK) { const f32x4 mf = *(const GAS f32x4*)((const float*)(F.ws + WS_PART) + (size_t)token * D + 128 * x + 16 * j + 4 * q);
                    const float rr[4] = {o[4 * q], o[4 * q + 1], o[4 * q + 2], o[4 * q + 3]}, mm[4] = {mf.x, mf.y, mf.z, mf.w}; bool bad = false;
#pragma unroll
                    for (int z = 0; z < 4; ++z) bad = bad || !(fabsf(rr[z] - mm[z]) <= 0.01f * fabsf(rr[z]) + 1.0e-3f);
                    if (bad) res.x = 1.0e9f; }
                if (DRY) { asm volatile("" :: "v"(res.x), "v"(res.y), "v"(res.z), "v"(res.w)); } else *(GAS f32x4*)(xo + 4 * q) = res; } }
    }
#undef PO_LOADC
#undef PO_ISSUE4
#undef PO_ROW
#undef PO_ACC4
}

constexpr int PO_TILE = 64 * 144;
template <int MODE> __device__ __forceinline__ void peer_out_mfma_phase(Frame& F, const float* ada, float* out) {
    const int* EID = (const int*)(F.ws + WS_EID); const unsigned char* CF8 = (const unsigned char*)(F.ws + WS_CF); const float* CFS = (const float*)(F.ws + WS_CFS);
    const int lane = F.lane, g = lane >> 3, j = lane & 7, l15 = lane & 15, lq = lane >> 4, x = F.bid & 7;
    const int nbx = (F.G - x + 7) >> 3, NW = nbx * NWAVES, gwv = (F.bid >> 3) * NWAVES + F.wave;
    const unsigned char* VS = F.ws + WS_VB + (size_t)x * NEXP * 128; const unsigned j16 = 16u * (unsigned)j;
    LAS unsigned char* TL = F.lds + F.wave * PO_TILE;
    if (gwv >= M) return;
    const int nst = 2 * ((M - 1 - gwv) / NW + 1);
    const int trow = l15 >> 1, tcol = 8 * (l15 & 1);
#define PM_IDS(e_, a_, tok_) do { const size_t base = (size_t)(tok_) * 128; \
        _Pragma("unroll") for (int m = 0; m < 16; ++m) e_[m] = EID[base + 8 * m + g]; \
        _Pragma("unroll") for (int q = 0; q < 4; ++q) a_[q] = *(const GAS long*)(CF8 + base + 32 * q + 8 * lq); } while (0)
#define PM_GATHER(vv_, e_, h_) do { _Pragma("unroll") for (int m = 0; m < 8; ++m) vv_[m] = *(const GAS v4u*)(VS + ((unsigned)e_[8 * (h_) + m] * 128u + j16)); } while (0)
#define PM_HALF(vv_, aq0_, aq1_) do { _Pragma("unroll") for (int m = 0; m < 8; ++m) *(LAS v4u*)(TL + (8 * m + g) * 144 + 16 * j) = vv_[m]; } while (0)
#define PM_MMA(aq0_, aq1_) do { LDS_WAIT(); asm volatile("" ::: "memory"); \
        _Pragma("unroll") for (int ks = 0; ks < 2; ++ks) _Pragma("unroll") for (int cb = 0; cb < 8; ++cb) { \
            const v2i bb = __builtin_amdgcn_ds_read_tr8_b64_v2i32((LAS v2i*)(TL + (32 * ks + 8 * lq + trow) * 144 + 16 * cb + tcol)); \
            acc[cb] = __builtin_amdgcn_mfma_f32_16x16x32_fp8_fp8(ks ? (aq1_) : (aq0_), __builtin_bit_cast(long, bb), acc[cb], 0, 0, 0); } \
        LDS_WAIT(); asm volatile("" ::: "memory"); } while (0)
    const int ntok = nst >> 1;
    int e1[16], e2[16]; long a0[4], a1[4], a2[4]; v4u vvA[8], vvB[8];
    PM_IDS(e1, a0, gwv);
    PM_GATHER(vvA, e1, 0); PM_GATHER(vvB, e1, 1);
    { const int t1 = ntok > 1 ? 1 : 0; PM_IDS(e1, a1, gwv + t1 * NW); }
    f32x4 acc[8];
    for (int it = 0; it < ntok; ++it) {
        const int token = gwv + it * NW;
        { const int t2 = it + 2 < ntok ? it + 2 : ntok - 1; PM_IDS(e2, a2, gwv + t2 * NW); }
#pragma unroll
        for (int cb = 0; cb < 8; ++cb) acc[cb] = (f32x4){0.f, 0.f, 0.f, 0.f};
        float xv[8], gv[8]; float cs;
        { const int b = token >> 12; const float* gt = ada + (size_t)b * 6 * D + 5 * D + 128 * x + l15; const bf16* xi = (const bf16*)(F.ws + WS_X1) + (size_t)token * D + 128 * x + l15;
          cs = CFS[token];
#pragma unroll
          for (int cb = 0; cb < 8; ++cb) { xv[cb] = bflo((unsigned)xi[16 * cb]); gv[cb] = gt[16 * cb]; } }
        PM_HALF(vvA, 0, 0); PM_GATHER(vvA, e1, 0); PM_MMA(a0[0], a0[1]);
        PM_HALF(vvB, 0, 0); PM_GATHER(vvB, e1, 1); PM_MMA(a0[2], a0[3]);
        if (lq == 0) {
            if (MODE == 1) { float* oc = (float*)(F.ws + WS_PART) + (size_t)token * D + 128 * x + l15;
#pragma unroll
                for (int cb = 0; cb < 8; ++cb) oc[16 * cb] = acc[cb][0] * cs; }
            else { float* xo = out + (size_t)token * D + 128 * x + l15;
#pragma unroll
                for (int cb = 0; cb < 8; ++cb) xo[16 * cb] = xv[cb] + gv[cb] * (acc[cb][0] * cs); }
        }
#pragma unroll
        for (int m = 0; m < 16; ++m) e1[m] = e2[m];
#pragma unroll
        for (int q = 0; q < 4; ++q) { a0[q] = a1[q]; a1[q] = a2[q]; }
    }
#undef PM_HALF
#undef PM_MMA
#undef PM_IDS
#undef PM_GATHER
}

__device__ __forceinline__ void compress_phase(Frame& F, const float* kng) {
    LAS bf16* H2 = (LAS bf16*)(F.lds);
    LAS float* OUTS = (LAS float*)(F.lds + 16384);
    const int lane = F.lane, w = F.wave, l15 = lane & 15, lq = lane >> 4;
    for (int u = F.bid; u < NBG * 2 * 8; u += F.G) {
        const int ns = u & 7, kv = (u >> 3) & 1, bg = u >> 4, n0 = ns * 32;
        const bf16* A = (const bf16*)(F.ws + (kv ? WS_VCR : WS_KCR)) + (size_t)bg * SEQ * 64;
        const bf16* W1T = (const bf16*)(F.ws + (kv ? WS_CW1V_T : WS_CW1K_T));
        const bf16* W2T = (const bf16*)(F.ws + (kv ? WS_CW2V_T : WS_CW2K_T));
        const float* b1 = (const float*)(F.ws + (kv ? WS_CB1V : WS_CB1K));
        pg8::f32x4 acc[2][8];
#pragma unroll
        for (int rb = 0; rb < 2; ++rb)
#pragma unroll
            for (int cb = 0; cb < 8; ++cb) acc[rb][cb] = (pg8::f32x4){0.f, 0.f, 0.f, 0.f};
        const bf16* ap = A + (size_t)(n0 + l15) * 1024 + 256 * w + 8 * lq;
        const bf16* bp = W1T + (size_t)l15 * 2048 + 256 * w + 8 * lq;
#pragma unroll
        for (int ks = 0; ks < 8; ++ks) {
            const bf16x8 a0 = *(const GAS bf16x8*)(ap + 32 * ks), a1 = *(const GAS bf16x8*)(ap + 16 * 1024 + 32 * ks);
#pragma unroll
            for (int cb = 0; cb < 8; ++cb) { const bf16x8 b = *(const GAS bf16x8*)(bp + (size_t)(16 * cb) * 2048 + 32 * ks);
                acc[0][cb] = __builtin_amdgcn_mfma_f32_16x16x32_bf16(a0, b, acc[0][cb], 0, 0, 0);
                acc[1][cb] = __builtin_amdgcn_mfma_f32_16x16x32_bf16(a1, b, acc[1][cb], 0, 0, 0); }
        }
        { LAS float* PS = (LAS float*)(F.lds + 32768);
          LAS float* mine = PS + (w & 3) * 4096 + (4 * lq) * 128 + l15;
          if (w >= 4) {
#pragma unroll
              for (int rb = 0; rb < 2; ++rb)
#pragma unroll
                  for (int cb = 0; cb < 8; ++cb)
#pragma unroll
                      for (int r = 0; r < 4; ++r) mine[(16 * rb + r) * 128 + 16 * cb] = acc[rb][cb][r]; }
          __syncthreads();
          if (w < 4) {
#pragma unroll
              for (int rb = 0; rb < 2; ++rb)
#pragma unroll
                  for (int cb = 0; cb < 8; ++cb)
#pragma unroll
                      for (int r = 0; r < 4; ++r) { LAS float* q = mine + (16 * rb + r) * 128 + 16 * cb; *q = acc[rb][cb][r] + *q; } }
          __syncthreads();
#pragma unroll
          for (int i = 0; i < 8; ++i) { const int idx = F.tid + 512 * i, row = idx >> 7, col = idx & 127;
              const float v = ((PS[idx] + PS[4096 + idx]) + (PS[8192 + idx] + PS[12288 + idx])) + b1[col];
              H2[row * 136 + col] = (bf16)f2bf(gelu_tanh_safe(v)); } }
        __syncthreads();
        { const int rb = w >> 2, db = w & 3;
          pg8::f32x4 o = (pg8::f32x4){0.f, 0.f, 0.f, 0.f};
#pragma unroll
          for (int ks = 0; ks < 4; ++ks) {
              const bf16x8 a = *(const LAS bf16x8*)(H2 + (16 * rb + l15) * 136 + 32 * ks + 8 * lq);
              const bf16x8 b = *(const GAS bf16x8*)(W2T + (size_t)(16 * db + l15) * 128 + 32 * ks + 8 * lq);
              o = __builtin_amdgcn_mfma_f32_16x16x32_bf16(a, b, o, 0, 0, 0); }
#pragma unroll
          for (int r = 0; r < 4; ++r) OUTS[(16 * rb + 4 * lq + r) * 65 + 16 * db + l15] = o[r]; }
        __syncthreads();
        { const int n = F.tid >> 4, d4 = (F.tid & 15) * 4, ng = n0 + n;
          float v[4]; float ss = 0.f;
#pragma unroll
          for (int i = 0; i < 4; ++i) { v[i] = OUTS[n * 65 + d4 + i]; ss += v[i] * v[i]; }
          ss += dppf<DPP_XOR1>(ss); ss += dppf<DPP_XOR2>(ss); ss += dppf<DPP_HMIR>(ss); ss += dppf<DPP_ROR8>(ss);
          const bool pad = (ng >= NCMP);
          if (kv == 0) { const float rs = rsqrtf(ss * (1.f / 64.f) + EPS);
              v2u o; o.x = pad ? 0u : pk2(v[0] * rs * kng[d4], v[1] * rs * kng[d4 + 1]); o.y = pad ? 0u : pk2(v[2] * rs * kng[d4 + 2], v[3] * rs * kng[d4 + 3]);
              *(GAS v2u*)((bf16*)(F.ws + WS_KC) + ((size_t)bg * 256 + ng) * 64 + d4) = o; }
          else { bf16* vt = (bf16*)(F.ws + WS_VCT) + (size_t)bg * 64 * 256 + ng;
#pragma unroll
              for (int i = 0; i < 4; ++i) vt[(size_t)(d4 + i) * 256] = pad ? (bf16)0 : (bf16)f2bf(v[i]); } }
        __syncthreads();
    }
}
__device__ __forceinline__ void vtranspose_phase(Frame& F) {
    LAS bf16* T = (LAS bf16*)(F.lds + F.wave * 9216);
    const int gw = F.bid * NWAVES + F.wave, NGW = F.G * NWAVES, lane = F.lane;
    for (int job = gw; job < 2 * NBG * 64; job += NGW) {
        const int s = job & 63, bg = (job >> 6) & 15, which = job >> 10;
        const bf16* X = (const bf16*)(F.ws + (which ? WS_VW : WS_VS)) + ((size_t)bg * SEQ + 64 * s) * 64;
        bf16* XT = (bf16*)(F.ws + (which ? WS_VWT : WS_VST)) + (size_t)bg * 64 * SEQ + 64 * s;
#pragma unroll
        for (int i = 0; i < 8; ++i) { const int tok = (lane >> 3) + 8 * i, ch = lane & 7;
            const v4u x = *(const GAS v4u*)(X + (size_t)tok * 64 + 8 * ch);
            const unsigned ww[4] = {x.x, x.y, x.z, x.w};
#pragma unroll
            for (int e = 0; e < 4; ++e) { T[(8 * ch + 2 * e) * 72 + tok] = (bf16)(ww[e] & 0xffffu); T[(8 * ch + 2 * e + 1) * 72 + tok] = (bf16)(ww[e] >> 16); } }
        LDS_WAIT(); asm volatile("" ::: "memory");
#pragma unroll
        for (int i = 0; i < 8; ++i) { const int dim = (lane >> 3) + 8 * i, ch = lane & 7;
            const v4u y = *(const LAS v4u*)(T + dim * 72 + 8 * ch);
            *(GAS v4u*)(XT + (size_t)dim * SEQ + 8 * ch) = y; }
        LDS_WAIT(); asm volatile("" ::: "memory");
    }
}

constexpr int AT_KBUF = 64 * 128;
constexpr int AT_NBUF = 2;
constexpr int AT_OFF_K = 0, AT_OFF_V = AT_NBUF * AT_KBUF;
constexpr int AT_OFF_IMP1 = 2 * AT_NBUF * AT_KBUF, AT_OFF_IMP2 = AT_OFF_IMP1 + 64 * 65 * 4, AT_OFF_SEL = AT_OFF_IMP2 + 64 * 65 * 4;
constexpr int AT_OFF_LUT = AT_OFF_SEL + 512, AT_OFF_LROW = AT_OFF_LUT + 4 * 128 * 4;
constexpr int AT_OFF_TD = AT_OFF_LROW + 8 * 32 * 4;
constexpr int AT_OFF_OUT = AT_OFF_TD + 96 * 32;
constexpr int AT_OFF_GATL = AT_OFF_OUT + 256 * 144;
constexpr int AT_OFF_TS = AT_OFF_GATL + 64 * 12 * 4;
constexpr int AT_TS_ROW = 65 * 16;
constexpr int AT_LDS_END = AT_OFF_TS + 16 * AT_TS_ROW;
static_assert(AT_LDS_END <= RING_BYTES, "attention LDS");

struct AtTile { const bf16* k; const bf16* vt; int vstride; };
enum { TM_CMP1 = 0, TM_CMP2, TM_SELN, TM_SELF, TM_WINN, TM_WINF, TM_WINE, TM_CMP1F, TM_CMP2F };
__device__ __forceinline__ float fexp2(float x) { return __builtin_amdgcn_exp2f(x); }
template <int TM, int VAR, int RB = 3>
__device__ __forceinline__ void at_tile(const LAS unsigned char* kb_, const LAS unsigned char* vb_, const LAS float* LUTJ, LAS float* IMP1, LAS float* IMP2,
                                        const bf16x8 (&qf)[2][2], pg8::f32x4 (&oacc)[2][4], pg8::f32x4 (&lacc)[2], const LAS float* LINV,
                                        const int (&tok_r_in)[2], const unsigned (&selb)[2], float cfar, int relbase, int idx, int l15_in, int lq_in, const LAS unsigned char* tsw, const LAS unsigned char* tsn) {
    constexpr bool FAR = (TM == TM_SELF || TM == TM_WINF || TM == TM_WINE || TM == TM_CMP1F || TM == TM_CMP2F);
    constexpr bool C1 = (TM == TM_CMP1 || TM == TM_CMP1F), C2 = (TM == TM_CMP2 || TM == TM_CMP2F);
    int l15 = l15_in, lq = lq_in; asm volatile("" : "+v"(l15), "+v"(lq));
    int tok_r[2] = {tok_r_in[0], tok_r_in[1]}; asm volatile("" : "+v"(tok_r[0]), "+v"(tok_r[1]));
    v4u pfr[2][2];
    const LAS unsigned char* tsp[2] = {tsw, tsw};
    if (TM == TM_SELN || TM == TM_WINN) {
#pragma unroll
        for (int rb = 0; rb < 2; ++rb) { const LAS unsigned char* pa = tsw + l15 * AT_TS_ROW + 16 * (2 * lq - rb) - 4 * relbase;
            const LAS unsigned char* pn = tsn + l15 * AT_TS_ROW;
            tsp[rb] = (TM == TM_SELN && !selb[rb]) ? pn : pa; } }
    auto kld = [&](int cb, bf16x8 (&kf)[2], pg8::f32x4 (&cq)[2]) __attribute__((always_inline)) {
        if (TM == TM_SELN || TM == TM_WINN) {
#pragma unroll
            for (int rb = 0; rb < 2; ++rb) cq[rb] = *(const LAS pg8::f32x4*)(tsp[rb] + 16 * (8 * (cb >> 1) + (cb & 1))); }
        if (!(VAR & 64)) {
        const int krow = 8 * (l15 >> 2) + (l15 & 3) + 32 * (cb >> 1) + 4 * (cb & 1), kf_ = ((l15 >> 2) << 1) | ((l15 >> 1) & 1);
#pragma unroll
        for (int ks = 0; ks < 2; ++ks) kf[ks] = *(const LAS bf16x8*)(kb_ + krow * 128 + 16 * ((4 * ks + lq) ^ kf_)); }
    };
    auto qkm = [&](int cb, const bf16x8 (&kf)[2], const pg8::f32x4 (&cq)[2], pg8::f32x4 (&st)[2]) __attribute__((always_inline)) {
        st[0] = FAR ? (pg8::f32x4){cfar, cfar, cfar, cfar} : (pg8::f32x4){0.f, 0.f, 0.f, 0.f}; st[1] = st[0];
        if (TM == TM_SELN || TM == TM_WINN) { st[0] = cq[0]; st[1] = cq[1]; }
        if (TM == TM_SELF) {
#pragma unroll
            for (int rb = 0; rb < 2; ++rb) { const float ci = selb[rb] ? cfar : -1.0e30f; st[rb] = (pg8::f32x4){ci, ci, ci, ci}; } }
        if (!(VAR & 64)) {
#pragma unroll
        for (int ks = 0; ks < 2; ++ks) {
#pragma unroll
            for (int rb = 0; rb < 2; ++rb) if (RB & (1 << rb)) st[rb] = __builtin_amdgcn_mfma_f32_16x16x32_bf16(kf[ks], qf[rb][ks], st[rb], 0, 0, 0); } }
    };
    float linv_[2] = {0.f, 0.f};
    if (C2) { linv_[0] = LINV[l15]; linv_[1] = LINV[16 + l15]; }
    auto prob = [&](int cb, const pg8::f32x4 (&st)[2]) __attribute__((always_inline)) {
#pragma unroll
        for (int rb = 0; rb < 2; ++rb) if (RB & (1 << rb)) {
            const int tokc = tok_r[rb];
            float p[4];
#pragma unroll
            for (int r = 0; r < 4; ++r) {
                const int kl = 32 * (cb >> 1) + 8 * lq + 4 * (cb & 1) + r;
                if (VAR & 16) { p[r] = st[rb][r]; }
                else if (TM == TM_SELF) { p[r] = fexp2(st[rb][r]); }
                else if (TM == TM_WINF || TM == TM_SELN || TM == TM_WINN || TM == TM_CMP1F || TM == TM_CMP2F) { p[r] = fexp2(st[rb][r]); }
                else if (TM == TM_WINE) { const float e = fexp2(st[rb][r]); p[r] = (kl > tokc) ? e : 0.f; }
                else {
                    const int rel = (TM == TM_CMP1 || TM == TM_CMP2) ? (relbase + tokc - 16 * kl) : (relbase + tokc - kl);
                    const bool valid = rel >= 0;
                    const int ri = rel < 0 ? 0 : (rel > 127 ? 127 : rel);
                    const float e = fexp2(st[rb][r] + LUTJ[ri]);
                    p[r] = valid ? e : 0.f; }
            }
            if (C1) { lacc[rb][0] += (p[0] + p[1]) + (p[2] + p[3]); }
            else {
                if (C2) {
#pragma unroll
                    for (int r = 0; r < 4; ++r) p[r] *= linv_[rb];
                    float h0 = p[0], h1 = p[1], h2 = p[2], h3 = p[3];
                    h0 += dppf<DPP_XOR1>(h0); h1 += dppf<DPP_XOR1>(h1); h2 += dppf<DPP_XOR1>(h2); h3 += dppf<DPP_XOR1>(h3);
                    h0 += dppf<DPP_XOR2>(h0); h1 += dppf<DPP_XOR2>(h1); h2 += dppf<DPP_XOR2>(h2); h3 += dppf<DPP_XOR2>(h3);
                    if ((l15 & 3) == 0) { const int sp = 16 * idx + 8 * (cb >> 1) + 2 * lq + (cb & 1);
                        IMP1[tokc * 65 + sp] = (h0 + h1) + (h2 + 0.5f * h3);
                        if (sp + 1 < 64) IMP2[tokc * 65 + sp + 1] = 0.5f * h3; }
                }
                const unsigned lo = pkh(p[0], p[1]), hi = pkh(p[2], p[3]);
                if (cb & 1) { pfr[rb][cb >> 1].z = lo; pfr[rb][cb >> 1].w = hi; } else { pfr[rb][cb >> 1].x = lo; pfr[rb][cb >> 1].y = hi; } }
        }
    };
    auto vld = [&](int ks, v4u (&vv)[4]) __attribute__((always_inline)) {
        if (!C1 && !(VAR & 8)) {
#pragma unroll
            for (int db = 0; db < 4; ++db) vv[db] = *(const LAS v4u*)(vb_ + (16 * db + l15) * 128 + 16 * ((4 * ks + lq) ^ (l15 >> 1))); }
    };
    auto pvm = [&](int ks, const v4u (&vv)[4]) __attribute__((always_inline)) {
        if (!C1 && !(VAR & 8)) {
#pragma unroll
            for (int db = 0; db < 4; ++db) {
#pragma unroll
                for (int rb = 0; rb < 2; ++rb) if (RB & (1 << rb)) oacc[rb][db] = __builtin_amdgcn_mfma_f32_16x16x32_bf16(__builtin_bit_cast(bf16x8, pfr[rb][ks]), __builtin_bit_cast(bf16x8, vv[db]), oacc[rb][db], 0, 0, 0); }
            if (!C2) { const v4u ones = (v4u){0x3F803F80u, 0x3F803F80u, 0x3F803F80u, 0x3F803F80u};
#pragma unroll
                for (int rb = 0; rb < 2; ++rb) if (RB & (1 << rb)) lacc[rb] = __builtin_amdgcn_mfma_f32_16x16x32_bf16(__builtin_bit_cast(bf16x8, pfr[rb][ks]), __builtin_bit_cast(bf16x8, ones), lacc[rb], 0, 0, 0); }
        }
    };
    pg8::f32x4 sA[2], sB[2], cA[2], cB[2]; bf16x8 kA[2], kB[2]; v4u vA[4], vB[4];
#define AT_SB __builtin_amdgcn_sched_barrier(0)
    kld(0, kA, cA); kld(1, kB, cB); AT_SB;
    qkm(0, kA, cA, sA); kld(2, kA, cA); AT_SB;
    qkm(1, kB, cB, sB); kld(3, kB, cB); prob(0, sA); AT_SB;
    qkm(2, kA, cA, sA); vld(0, vA); prob(1, sB); AT_SB;
    qkm(3, kB, cB, sB); pvm(0, vA); vld(1, vB); prob(2, sA); AT_SB;
    prob(3, sB); AT_SB;
    pvm(1, vB);
#undef AT_SB
}

template <int VAR> __device__ __forceinline__ void attention_phase(Frame& F, const Args& args) {
    unsigned char* ws = F.ws;
    const int lane = F.lane, w = F.wave, l15 = lane & 15, lq = lane >> 4, tid = F.tid;
    LAS unsigned char* L = F.lds;
    LAS float* IMP1 = (LAS float*)(L + AT_OFF_IMP1); LAS float* IMP2 = (LAS float*)(L + AT_OFF_IMP2);
    LAS unsigned long long* SELM = (LAS unsigned long long*)(L + AT_OFF_SEL); LAS float* LUT = (LAS float*)(L + AT_OFF_LUT); LAS float* LROW = (LAS float*)(L + AT_OFF_LROW) + w * 32;
    LAS int* TD = (LAS int*)(L + AT_OFF_TD); LAS bf16* OUTL = (LAS bf16*)(L + AT_OFF_OUT) + (32 * w) * 72; LAS float* GATL = (LAS float*)(L + AT_OFF_GATL);
    const bf16* Qg = (const bf16*)(ws + WS_Q); const float* GATE = (const float*)(ws + WS_GATE); bf16* YA = (bf16*)(ws + WS_YA); float* YAF = (float*)(ws + WS_H);
    const int jq = l15 & 3;
    const LAS float* LUTJ = LUT + jq * 128;
    const int nrounds = (F.G == 256) ? 4 : (1024 + F.G - 1) / F.G;
    for (int round = 0; round < nrounds; ++round) {
        const int ui = (F.G == 256) ? ((round & 1) ? ((round >> 1) * 512 + 511 - F.bid) : ((round >> 1) * 512 + F.bid)) : (round * F.G + F.bid);
        if (ui >= 1024) break;
        const int c = 63 - (ui >> 4), bg = ui & 15, b = bg >> 1, g = bg & 1;
        const int m0 = b * SEQ + 64 * c;
        __syncthreads();
        { const float M0 = ((const float*)(ws + WS_BIASL))[8 * 128];
          for (int i = tid; i < 512; i += NTHREADS) LUT[i] = (((const float*)(ws + WS_BIASL))[(4 * g + (i >> 7)) * 128 + (i & 127)] - M0) * 1.4426950408889634f; }
        for (int i = tid; i < 64 * 65; i += NTHREADS) { IMP1[i] = 0.f; IMP2[i] = 0.f; }
        { const float M0 = ((const float*)(ws + WS_BIASL))[8 * 128]; const float* BL = (const float*)(ws + WS_BIASL) + (size_t)(4 * g) * 128;
          for (int i = tid; i < 16 * 63 * 4; i += NTHREADS) { const int r = i & 3, yi = (i >> 2) % 63, row = i / 252, rel = 4 * (47 - yi) + (row >> 2) - r;
              ((LAS float*)(L + AT_OFF_TS + row * AT_TS_ROW))[4 * yi + r] = rel < 0 ? -1.0e30f : (BL[(row & 3) * 128 + (rel > 127 ? 127 : rel)] - M0) * 1.4426950408889634f; } }
        for (int i = tid; i < 64 * 12; i += NTHREADS) GATL[i] = GATE[(size_t)(m0 + i / 12) * 24 + g * 12 + (i % 12)];
        bf16x8 qf[2][2];
#pragma unroll
        for (int rb = 0; rb < 2; ++rb)
#pragma unroll
            for (int ks = 0; ks < 2; ++ks) qf[rb][ks] = *(const GAS bf16x8*)(Qg + (size_t)(m0 + 8 * w + 4 * rb + (l15 >> 2)) * 512 + g * 256 + jq * 64 + 32 * ks + 8 * lq);
        asm volatile("" :: "v"(qf[0][0]), "v"(qf[0][1]), "v"(qf[1][0]), "v"(qf[1][1]));
        const int ncmp = 4 * c + 3, n1 = (ncmp + 63) >> 6, nsel = c + 1, w0 = c >= 8 ? c - 8 : 0, nwin = c - w0 + 1;
        const int ntiles = 2 * n1 + nsel + nwin;
        if (tid < ntiles) { const int i = tid;
            auto kindof = [&](int t, int& kind, int& idx) { if (t < n1) { kind = 0; idx = t; } else if (t < 2 * n1) { kind = 1; idx = t - n1; } else if (t < 2 * n1 + nsel) { kind = 2; idx = t - 2 * n1; } else { kind = 3; idx = w0 + (t - 2 * n1 - nsel); } };
            int kind, idx, kn, in_; kindof(i, kind, idx); kindof(i + 1 < ntiles ? i + 1 : i, kn, in_);
            unsigned ko, vo;
            if (kn < 2) { ko = (unsigned)(WS_KC + ((size_t)bg * 256 * 64 + (size_t)in_ * 4096) * 2); vo = (unsigned)(WS_VCT + ((size_t)bg * 64 * 256 + 64 * in_) * 2); }
            else if (kn == 2) { ko = (unsigned)(WS_KS + ((size_t)bg * SEQ * 64 + (size_t)in_ * 4096) * 2); vo = (unsigned)(WS_VST + ((size_t)bg * 64 * SEQ + 64 * in_) * 2); }
            else { ko = (unsigned)(WS_KW + ((size_t)bg * SEQ * 64 + (size_t)in_ * 4096) * 2); vo = (unsigned)(WS_VWT + ((size_t)bg * 64 * SEQ + 64 * in_) * 2); }
            const int dd = c - idx;
            int mode, relbase;
            if (kind == 0) { relbase = 64 * c - 31 - 1024 * idx; mode = relbase >= 1135 ? TM_CMP1F : TM_CMP1; } else if (kind == 1) { relbase = 64 * c - 31 - 1024 * idx; mode = relbase >= 1135 ? TM_CMP2F : TM_CMP2; }
            else if (kind == 2) { mode = dd <= 2 ? TM_SELN : TM_SELF; relbase = 64 * dd; } else { mode = dd <= 2 ? TM_WINN : (dd == 8 ? TM_WINE : TM_WINF); relbase = 64 * dd; }
            const int endf = ((kind == 1 && idx == n1 - 1) || (kind == 2 && idx == nsel - 1) || (kind == 3 && idx == c)) ? kind : 0;
            v4i e; e.x = mode | (idx << 8) | (endf << 16) | ((kind == 2 && idx == 0) ? (1 << 24) : 0) | (kn >= 2 ? (1 << 25) : 0); e.y = relbase; e.z = (int)ko; e.w = (int)vo;
            *(LAS v4i*)(TD + 4 * i) = e; }
        const int drow = 8 * w + (lane >> 3), dsrck = 16 * ((lane & 7) ^ (((w & 3) << 1) | ((lane >> 4) & 1))), dsrcv = 16 * ((lane & 7) ^ ((4 * (w & 1)) | (lane >> 4)));
#define AT_DMA(tile_, ko_, vo_, vs_) do { const int nb_ = (tile_) % AT_NBUF; \
        __builtin_amdgcn_global_load_lds((const GAS unsigned*)(ws + (size_t)((ko_) + drow * 128 + dsrck)), (LAS unsigned*)(L + AT_OFF_K + nb_ * AT_KBUF + w * 1024), 16, 0, 0); \
        __builtin_amdgcn_global_load_lds((const GAS unsigned*)(ws + (size_t)((vo_) + drow * (vs_) + dsrcv)), (LAS unsigned*)(L + AT_OFF_V + nb_ * AT_KBUF + w * 1024), 16, 0, 0); } while (0)
        __syncthreads();
        if (!(VAR & 2)) { AT_DMA(0, (unsigned)(WS_KC + (size_t)bg * 256 * 64 * 2), (unsigned)(WS_VCT + (size_t)bg * 64 * 256 * 2), 512u); }
        int d0, d1, d2, d3;
        { const v4i e = *(const LAS v4i*)TD; d0 = __builtin_amdgcn_readfirstlane(e.x); d1 = __builtin_amdgcn_readfirstlane(e.y); d2 = __builtin_amdgcn_readfirstlane(e.z); d3 = __builtin_amdgcn_readfirstlane(e.w); }
        pg8::f32x4 oacc[2][4];
        pg8::f32x4 lacc[2] = {(pg8::f32x4){0.f, 0.f, 0.f, 0.f}, (pg8::f32x4){0.f, 0.f, 0.f, 0.f}};
#pragma unroll
        for (int rb = 0; rb < 2; ++rb)
#pragma unroll
            for (int db = 0; db < 4; ++db) oacc[rb][db] = (pg8::f32x4){0.f, 0.f, 0.f, 0.f};
        const int tok_r[2] = {8 * w + (l15 >> 2), 8 * w + 4 + (l15 >> 2)};
        const LAS unsigned char* tsw = L + AT_OFF_TS + 16 * (47 - 2 * w); const LAS unsigned char* tsn = L + AT_OFF_TS + 16 * 48;
        for (int it = 0; it < ((VAR & 32) ? 0 : ntiles); ++it) {
            if (!(VAR & 512)) { asm volatile("s_waitcnt vmcnt(0)" ::: "memory");
            asm volatile("s_waitcnt lgkmcnt(0)" ::: "memory"); __builtin_amdgcn_s_barrier(); asm volatile("" ::: "memory"); }
            if (!(VAR & 2) && it + 1 < ntiles) AT_DMA(it + 1, (unsigned)d2, (unsigned)d3, ((d0 >> 25) & 1) ? 2u * SEQ : 512u);
            v4i tdn;
            { const LAS int* tn_ = TD + 4 * (it + 1); asm volatile("ds_read_b128 %0, %1" : "=v"(tdn) : "v"(tn_) : "memory"); }
            {
            const int mode = d0 & 255, idx = (d0 >> 8) & 255, relbase = d1, endf = (d0 >> 16) & 3, selfirst = (d0 >> 24) & 1;
            const int buf = it % AT_NBUF;
            if (selfirst) {
                { const int tok = 8 * w + (lane >> 3), s0 = 8 * (lane & 7);
                  unsigned key[8]; int rank[8];
#pragma unroll
                  for (int q = 0; q < 8; ++q) { const int sB = s0 + q; const bool vis = sB <= c, forced = (sB == 0) || (sB == c) || (sB == c - 1);
                      const float sc = vis ? (IMP1[tok * 65 + sB] + IMP2[tok * 65 + sB] + (forced ? 1000.f : 0.f)) : -1.f;
                      const unsigned u = __builtin_bit_cast(unsigned, sc); const unsigned fk = (u >> 31) ? ~u : (u | 0x80000000u);
                      key[q] = (fk & ~63u) | (unsigned)(63 - sB); rank[q] = 0; }
                  LAS unsigned* KEYS = (LAS unsigned*)IMP1;
#pragma unroll
                  for (int q = 0; q < 8; ++q) KEYS[tok * 65 + s0 + q] = key[q];
                  if (c >= 16 && !(VAR & 128)) {
#pragma unroll 8
                      for (int s2 = 0; s2 < 64; ++s2) { const unsigned k2 = KEYS[tok * 65 + s2];
#pragma unroll
                          for (int q = 0; q < 8; ++q) rank[q] += (k2 > key[q]) ? 1 : 0; } }
                  unsigned byte = 0u;
#pragma unroll
                  for (int q = 0; q < 8; ++q) byte |= ((rank[q] < 16 && (s0 + q) <= c) ? 1u : 0u) << q;
                  ((LAS unsigned char*)SELM)[tok * 8 + (lane & 7)] = (unsigned char)byte; }
            }
            const LAS unsigned char* kb_ = L + AT_OFF_K + buf * AT_KBUF; const LAS unsigned char* vb_ = L + AT_OFF_V + buf * AT_KBUF;
            const float cfar = LUTJ[127];
            unsigned selb[2] = {1u, 1u};
#define AT_CALL(TMX) at_tile<TMX, VAR>(kb_, vb_, LUTJ, IMP1, IMP2, qf, oacc, lacc, LROW, tok_r, selb, cfar, relbase, idx, l15, lq, tsw, tsn)
            if (mode == TM_SELF || mode == TM_SELN) { selb[0] = (unsigned)(SELM[tok_r[0]] >> idx) & 1u; selb[1] = (unsigned)(SELM[tok_r[1]] >> idx) & 1u; }
            if (mode == TM_SELF) {
                const bool a0 = __ballot(selb[0] != 0u) != 0ull, a1 = __ballot(selb[1] != 0u) != 0ull;
                if (a0 && a1) AT_CALL(TM_SELF);
                else if (a0) at_tile<TM_SELF, VAR, 1>(kb_, vb_, LUTJ, IMP1, IMP2, qf, oacc, lacc, LROW, tok_r, selb, cfar, relbase, idx, l15, lq, tsw, tsn);
                else if (a1) at_tile<TM_SELF, VAR, 2>(kb_, vb_, LUTJ, IMP1, IMP2, qf, oacc, lacc, LROW, tok_r, selb, cfar, relbase, idx, l15, lq, tsw, tsn); }
            else if (mode == TM_WINF) AT_CALL(TM_WINF);
            else if (mode == TM_SELN) AT_CALL(TM_SELN);
            else if (mode == TM_WINN) AT_CALL(TM_WINN);
            else if (mode == TM_WINE) AT_CALL(TM_WINE);
            else if (mode == TM_CMP2) AT_CALL(TM_CMP2);
            else if (mode == TM_CMP2F) AT_CALL(TM_CMP2F);
            else if (mode == TM_CMP1F) AT_CALL(TM_CMP1F);
            else { AT_CALL(TM_CMP1);
                if (idx == n1 - 1) {
#pragma unroll
                    for (int rb = 0; rb < 2; ++rb) { const float s = sum_xor32(sum_xor16(lacc[rb][0])); if (lq == 0) LROW[16 * rb + l15] = s > 0.f ? 1.0f / s : 0.f; lacc[rb] = (pg8::f32x4){0.f, 0.f, 0.f, 0.f}; } } }
#undef AT_CALL
            {
                if (endf && !(VAR & 256)) {
                    const int br = endf - 1;
#pragma unroll
                    for (int rb = 0; rb < 2; ++rb)
#pragma unroll
                        for (int r = 0; r < 4; ++r) { const int qrow = 16 * rb + 4 * lq + r;
                            const float ls_ = lacc[rb][r]; lacc[rb][r] = 0.f;
                            const float gt = GATL[(8 * w + 4 * rb + lq) * 12 + r * 3 + br] * (endf == 1 ? 1.0f : (ls_ > 0.f ? 1.0f / ls_ : 0.f));
#pragma unroll
                            for (int db = 0; db < 4; ++db) { float v = gt * oacc[rb][db][r]; oacc[rb][db][r] = 0.f;
                                LAS bf16* po = OUTL + qrow * 72 + 16 * db + l15;
                                if (br > 0) v += __builtin_bit_cast(float, (unsigned)(*po) << 16);
                                *po = (bf16)f2bf(v); } }
                    if (br == 2 && !(VAR & 1)) {
                        LDS_WAIT(); asm volatile("" ::: "memory");
#pragma unroll
                        for (int i = 0; i < 4; ++i) { const int ch = i * 64 + lane, row = ch >> 3, c16 = ch & 7;
                            const v4u o = *(const LAS v4u*)((const LAS unsigned char*)OUTL + row * 144 + 16 * c16);
                            *(GAS v4u*)(YA + (size_t)(m0 + 8 * w + (row >> 2)) * 512 + g * 256 + (row & 3) * 64 + 8 * c16) = o; }
                    }
                }
            }
            }
            asm volatile("s_waitcnt lgkmcnt(0)" : "+v"(tdn) :: "memory");
            d0 = __builtin_amdgcn_readfirstlane(tdn.x); d1 = __builtin_amdgcn_readfirstlane(tdn.y); d2 = __builtin_amdgcn_readfirstlane(tdn.z); d3 = __builtin_amdgcn_readfirstlane(tdn.w);
        }
#undef AT_DMA
    }
}

constexpr int N_PHASES = 13;
#ifndef MK_ONE_LAUNCH
#define MK_ONE_LAUNCH 1
#endif
#ifndef REP_P0
#define REP_P0 1
#endif
#ifndef REP_P1
#define REP_P1 1
#endif
#ifndef REP_P2
#define REP_P2 1
#endif
#ifndef REP_P3
#define REP_P3 1
#endif
#ifndef REP_P5
#define REP_P5 1
#endif
#ifndef REP_P6
#define REP_P6 1
#endif
#ifndef REP_P8
#define REP_P8 1
#endif
#ifndef REP_P7
#define REP_P7 1
#endif
#ifndef REP_P11
#define REP_P11 1
#endif
#ifndef REP_P4
#define REP_P4 1
#endif
#ifndef REP_P9
#define REP_P9 1
#endif
#ifndef REP_P10
#define REP_P10 1
#endif
#ifndef MK_BUILD
#define MK_BUILD 0
#endif

#ifndef STAG_P2
#define STAG_P2 0
#endif
__device__ __forceinline__ void phase_stagger(const Frame& F, int step_ns) {
    const int grp = (F.bid >> 3) & 7;
    if (step_ns > 0 && grp > 0) { const unsigned long long t0 = wall_clock64(), dt = (unsigned long long)(grp * step_ns) / 10ull;
        while (wall_clock64() - t0 < dt) __builtin_amdgcn_s_sleep(8); }
}
struct EpiNull {
    static constexpr bool PERM = true, AFTER_DRAIN = false;
    __device__ __forceinline__ void operator()(const pg8::f32x4 (&acc)[2][2][4][2], const pg8::Unit& u, int wr, int wc, int fr, int fq) const {
#pragma unroll
        for (int ai = 0; ai < 2; ++ai)
#pragma unroll
            for (int bj = 0; bj < 2; ++bj)
#pragma unroll
                for (int m = 0; m < 4; ++m) { asm volatile("" :: "v"(acc[ai][bj][m][0]), "v"(acc[ai][bj][m][1])); }
    }
};
__global__ void __launch_bounds__(NTHREADS, 2) fwd_kernel(Args args) {
    extern __shared__ __attribute__((aligned(16))) unsigned char lds[];
    Frame F;
    F.lds = (LAS unsigned char*)lds;
    F.MISC = (volatile LAS unsigned*)(F.lds + MISC_OFF);
    F.tid = threadIdx.x; F.lane = F.tid & 63; F.wave = __builtin_amdgcn_readfirstlane(F.tid >> 6);
    F.G = gridDim.x; F.bid = blockIdx.x; F.ws = args.ws;
    F.ctl = (gu32*)(args.ws + WS_CTL);
    for (int u = F.tid; u < (LDS_BYTES - LDSCTL_OFF) / 4; u += NTHREADS) ((LAS unsigned*)(F.lds + LDSCTL_OFF))[u] = 0u;
    __syncthreads();
    XcdBarrier bar; bar.bar = (unsigned*)(F.ctl + CW_BAR); bar.x = 0; bar.st = nullptr;
    if (MK_ONE_LAUNCH) bar = xcd_barrier_post((unsigned*)(F.ctl + CW_BAR), F.MISC + 8);
    const int lo = args.ph_lo, hi = args.ph_hi;
#define IN(k) (lo <= (k) && (k) < hi)
#define SEAM(k) do { if (IN(k) && IN((k) + 1)) xcd_barrier(bar); } while (0)
    unsigned char* ws = args.ws;
    const float* ada = (const float*)(ws + WS_ADA);

    if (IN(0)) { for (int rep = 0; rep < REP_P0; ++rep) { p0_prologue(F, args, rep == REP_P0 - 1); __syncthreads(); } } SEAM(0);
    if (IN(1)) { for (int rep = 0; rep < REP_P1; ++rep) modnorm_rows<false>(F, args.in[I_X], args.in[I_N1G], ada, 0, (bf16*)(ws + WS_H)); } SEAM(1);
    if (IN(2)) { {
        phase_stagger(F, STAG_P2);
        pg8::Gemm g{(const bf16*)(ws + WS_H), (const bf16*)(ws + WS_WIN_T), M, NIN, D, D, D}; pg8::StaticOrder S; S.init(M, NIN, F.G, F.bid);
        if (F.tid == 0) F.MISC[40] = 0xffffffffu; __syncthreads();
        EpiIn E{ws, args.in[I_QNG], args.in[I_KNG], F.MISC + 40};
#if defined(PROBE_P2) && PROBE_P2 == 1
        { EpiNull EN; pg8::gemm_phase<EpiNull, pg8::StaticOrder, true, true>(F.lds + RING_OFF, g, S, EN); __syncthreads(); }
#elif defined(PROBE_P2) && PROBE_P2 == 2
        { if (F.tid == 0) F.MISC[40] = 0u; __syncthreads(); pg8::gemm_phase<EpiIn, pg8::StaticOrder, true, true>(F.lds + RING_OFF, g, S, E); __syncthreads(); if (F.tid == 0) F.MISC[40] = 0xffffffffu; __syncthreads(); }
#endif
        pg8::gemm_phase<EpiIn, pg8::StaticOrder, true, true>(F.lds + RING_OFF, g, S, E);
#if REP_P2 > 1
        __syncthreads(); pg8::gemm_phase<EpiIn, pg8::StaticOrder, true, true>(F.lds + RING_OFF, g, S, E);
#endif
        }
    } SEAM(2);
#ifndef PROBE_P3
#define PROBE_P3 0
#endif
    if (IN(3)) { for (int rep = 0; rep < REP_P3; ++rep) { __syncthreads(); pool_phase(F); if (PROBE_P3 == 1) { __syncthreads(); pool_phase(F); }
        __syncthreads(); compress_phase(F, args.in[I_KNG]); if (PROBE_P3 == 2) { __syncthreads(); compress_phase(F, args.in[I_KNG]); }
        __syncthreads(); vtranspose_phase(F); if (PROBE_P3 == 3) { __syncthreads(); vtranspose_phase(F); } } } SEAM(3);
    if (IN(4)) {
#ifdef PROBE_P4
        attention_phase<PROBE_P4>(F, args); __syncthreads();
#endif
        for (int rep = 0; rep < REP_P4; ++rep) { attention_phase<0>(F, args); __syncthreads(); } } SEAM(4);
    if (IN(5)) { {
        { pg8::Gemm g{(const bf16*)(ws + WS_PL), (const bf16*)(ws + WS_WEFF_T), M, D, POOLW, POOLW, POOLW}; pg8::StaticOrder S; S.init(M, D, F.G, F.bid);
          EpiMix<false> E{(bf16*)(ws + WS_MIX), (const bf16*)(ws + WS_GM), 0};
          pg8::gemm_phase<EpiMix<false>, pg8::StaticOrder, true, true>(F.lds + RING_OFF, g, S, E); }
        { pg8::Gemm g{(const bf16*)(ws + WS_YA), (const bf16*)(ws + WS_WBA_T), M, D, QW, QW, QW}; pg8::StaticOrder S; S.init(M, D, F.G, F.bid);
          EpiMix<true> E{(bf16*)(ws + WS_MIX), (const bf16*)(ws + WS_GM), 1024};
          pg8::gemm_phase<EpiMix<true>, pg8::StaticOrder, true, true>(F.lds + RING_OFF, g, S, E); } }
#if REP_P5 > 1
        { __syncthreads(); { pg8::Gemm g{(const bf16*)(ws + WS_PL), (const bf16*)(ws + WS_WEFF_T), M, D, POOLW, POOLW, POOLW}; pg8::StaticOrder S; S.init(M, D, F.G, F.bid);
          EpiMix<false> E{(bf16*)(ws + WS_MIX), (const bf16*)(ws + WS_GM), 0};
          pg8::gemm_phase<EpiMix<false>, pg8::StaticOrder, true, true>(F.lds + RING_OFF, g, S, E); }
        { pg8::Gemm g{(const bf16*)(ws + WS_YA), (const bf16*)(ws + WS_WBA_T), M, D, QW, QW, QW}; pg8::StaticOrder S; S.init(M, D, F.G, F.bid);
          EpiMix<true> E{(bf16*)(ws + WS_MIX), (const bf16*)(ws + WS_GM), 1024};
          pg8::gemm_phase<EpiMix<true>, pg8::StaticOrder, true, true>(F.lds + RING_OFF, g, S, E); } }
#endif
    } SEAM(5);
    if (IN(6)) { {
        pg8::Gemm g{(const bf16*)(ws + WS_MIX), (const bf16*)(ws + WS_WOUT_T), M, D, D, D, D}; pg8::StaticOrder S; S.init(M, D, F.G, F.bid);
        EpiRes E{args.in[I_X], (bf16*)(ws + WS_X1), ada, 2};
        pg8::gemm_phase<EpiRes, pg8::StaticOrder, true, true>(F.lds + RING_OFF, g, S, E);
#if REP_P6 > 1
        __syncthreads(); pg8::gemm_phase<EpiRes, pg8::StaticOrder, true, true>(F.lds + RING_OFF, g, S, E);
#endif
        }
    } SEAM(6);
    if (IN(7)) { for (int rep = 0; rep < REP_P7; ++rep) modnorm_rows<true>(F, ws + WS_X1, args.in[I_N2G], ada, 3, (bf16*)(ws + WS_H)); } SEAM(7);
    if (IN(8)) { {
        pg8::Gemm g{(const bf16*)(ws + WS_H), (const bf16*)(ws + WS_WQ_T), M, PQW, D, D, D}; pg8::StaticOrder S; S.init(M, PQW, F.G, F.bid);
        EpiStoreBf16 E{(bf16*)(ws + WS_QV), PQW};
        pg8::gemm_phase<EpiStoreBf16, pg8::StaticOrder, true, true>(F.lds + RING_OFF, g, S, E);
#if REP_P8 > 1
        __syncthreads(); pg8::gemm_phase<EpiStoreBf16, pg8::StaticOrder, true, true>(F.lds + RING_OFF, g, S, E);
#endif
        }
    } SEAM(8);
    if (IN(9)) { for (int rep = 0; rep < REP_P9; ++rep) peer_select_phase(F); } SEAM(9);
#ifdef PROBE_XCD
    if (IN(10)) { if (F.tid == 0) __hip_atomic_store((unsigned*)(F.ctl + 2048 + F.bid), 100u + xb_xcc_id(), RLX_AGENT); }
#endif
    if (IN(10)) {
#ifdef PROBE_DOT
        peer_dot_phase<PROBE_DOT>(F); __syncthreads();
#endif
#ifdef PROBE_LOADRATE
        peer_loadrate_probe<PROBE_LOADRATE>(F); __syncthreads();
#endif
        peer_dot_phase<0>(F); } SEAM(10);
    if (IN(11)) { for (int rep = 0; rep < REP_P11; ++rep) peer_coef_phase(F); } SEAM(11);
#ifdef PROBE_XCD
    if (IN(12) && F.bid == 0 && F.tid == 0) { bool ok = true; for (int i = 0; i < F.G; ++i) { const unsigned a = __hip_atomic_load((unsigned*)(F.ctl + 2048 + i), RLX_AGENT), b0 = __hip_atomic_load((unsigned*)(F.ctl + 2048 + (i & 7)), RLX_AGENT); if (a != b0 || a < 100u) ok = false; }
        for (int i = 0; i < 8; ++i) for (int q = 0; q < i; ++q) if (__hip_atomic_load((unsigned*)(F.ctl + 2048 + i), RLX_AGENT) == __hip_atomic_load((unsigned*)(F.ctl + 2048 + q), RLX_AGENT)) ok = false;
        if (!ok) args.out[12345] = 1.0e9f; }
    __syncthreads();
#endif
    if (IN(12)) {
#if defined(CHECK_OUT_MFMA)
        peer_out_mfma_phase<1>(F, ada, args.out); __syncthreads(); VM_WAIT(); __syncthreads(); peer_out_phase<false, true>(F, ada, args.out);
#elif defined(OUT_VALU)
        for (int rep = 1; rep < REP_P10; ++rep) peer_out_phase<true>(F, ada, args.out); peer_out_phase<false>(F, ada, args.out);
#else
#ifdef PROBE_OUT
        peer_out_mfma_phase<1>(F, ada, args.out); __syncthreads();
#endif
        peer_out_mfma_phase<0>(F, ada, args.out);
#endif
    }
#undef IN
#undef SEAM
}

extern "C" void kernel_launch(void* const* d_in, const int* in_sizes, int n_in, void* d_out, int out_size, void* d_ws, size_t ws_size, hipStream_t stream) {
    static int grid = 0;
    if (grid == 0) {
        if (n_in != N_IN || in_sizes[0] != M * D || out_size != M * D || ws_size < WS_END) {
            fprintf(stderr, "kernel_launch: unexpected shapes: n_in %d in0 %d out %d ws %zu (need %zu)\n", n_in, n_in > 0 ? in_sizes[0] : -1, out_size, ws_size, (size_t)WS_END); grid = -1; return; }
        int dev = 0, cus = 0, per_cu = 0;
        if (hipGetDevice(&dev) != hipSuccess || hipDeviceGetAttribute(&cus, hipDeviceAttributeMultiprocessorCount, dev) != hipSuccess) { grid = -1; return; }
        if (hipFuncSetAttribute((const void*)fwd_kernel, hipFuncAttributeMaxDynamicSharedMemorySize, LDS_BYTES) != hipSuccess) { fprintf(stderr, "kernel_launch: hipFuncSetAttribute failed\n"); grid = -1; return; }
        if (hipOccupancyMaxActiveBlocksPerMultiprocessor(&per_cu, (const void*)fwd_kernel, NTHREADS, LDS_BYTES) != hipSuccess || per_cu < 1)
            fprintf(stderr, "kernel_launch: occupancy query reports %d workgroups per CU\n", per_cu);
        (void)hipGetLastError();
        grid = cus;
    }
    if (grid < 0) return;
    if (hipMemsetAsync((char*)d_ws + WS_CTL, 0, CTL_ZERO_BYTES, stream) != hipSuccess) return;
    Args a{};
    for (int i = 0; i < N_IN; ++i) a.in[i] = (const float*)d_in[i];
    a.out = (float*)d_out; a.ws = (unsigned char*)d_ws;
    if (MK_ONE_LAUNCH) {
        a.ph_lo = 0; a.ph_hi = N_PHASES; a.li = 0;
        hipLaunchKernelGGL(fwd_kernel, dim3(grid), dim3(NTHREADS), LDS_BYTES, stream, a);
    } else {
        for (int p = 0; p < N_PHASES; ++p) {
            a.ph_lo = p; a.ph_hi = p + 1; a.li = p;
            hipLaunchKernelGGL(fwd_kernel, dim3(grid), dim3(NTHREADS), LDS_BYTES, stream, a);
        }
    }
}
```

```cpp
#include <hip/hip_runtime.h>
#include <cstdio>
#include <cstdint>
namespace pg8 {
#define PG8_LAS __attribute__((address_space(3)))
typedef unsigned short bf16_t;
typedef short bf16x8 __attribute__((ext_vector_type(8)));
typedef float f32x4 __attribute__((ext_vector_type(4)));
typedef unsigned u32x4 __attribute__((ext_vector_type(4)));
constexpr int BM = 256, BK = 64, HALF = 128, HTB = HALF * BK * 2  , STAGE_BYTES = 8 * HTB, NXCD = 8, WGM = 8;

__host__ __device__ __forceinline__ int lds_byte(int r, int c) { const int st = (r >> 4) * 2 + (c >> 5), rr = r & 15, cc = c & 31, ob = rr * 64 + cc * 2; return st * 1024 + (ob ^ (((ob >> 9) & 1) << 5)); }
__host__ __device__ __forceinline__ void stage_rc(int b, int& R, int& C) { const int st = b / 1024, sb = b % 1024, swz = sb ^ (((sb >> 9) & 1) << 5); R = (st >> 1) * 16 + swz / 64; C = (st & 1) * 32 + (swz % 64) / 2; }
__host__ __device__ __forceinline__ int perm32(int rho) { const int n = rho >> 4, i = rho & 15; return 8 * (i >> 2) + 4 * n + (i & 3); }

struct Unit { int pm, pn; };
struct Gemm { const bf16_t* A; const bf16_t* Bt; int M, N, K, lda, ldb; };

struct StaticOrder {
    int nM, nN, nwg, G, c;
    __host__ __device__ void init(int M, int N, int G_, int c_) { nM = M / BM; nN = N / BM; nwg = nM * nN; G = G_; c = c_; }
    __host__ __device__ bool next(int i, Unit& u) const {
        const long L = (long)i * G + c; if (L >= nwg) return false;
        int wgid = (int)L; { const int q = nwg / NXCD, r = nwg % NXCD, xcd = wgid % NXCD, off = wgid / NXCD; wgid = (xcd < r ? xcd * (q + 1) : r * (q + 1) + (xcd - r) * q) + off; }
        const int nig = WGM * nN, gid = wgid / nig, fm = gid * WGM, gsz = (nM - fm) < WGM ? (nM - fm) : WGM;
        u.pm = fm + ((wgid % nig) % gsz); u.pn = (wgid % nig) / gsz; return true;
    }
    __device__ __forceinline__ void a_ready(const Unit&) const {}
    __device__ __forceinline__ void done(const Unit&) const {}
};

__device__ __forceinline__ unsigned cvt_pk_bf16(float lo, float hi) { unsigned r; asm volatile("v_cvt_pk_bf16_f32 %0, %1, %2" : "=v"(r) : "v"(lo), "v"(hi)); return r; }
template <class Epi, class Sched, bool ALIGN_EPI = false, bool SP2 = false>
__device__ __forceinline__ void gemm_phase(PG8_LAS unsigned char* lds, const Gemm g, const Sched& S, const Epi& E) {
    const int tid = threadIdx.x, wid = __builtin_amdgcn_readfirstlane(tid >> 6), lane = tid & 63, wr = wid >> 2, wc = wid & 3, fr = lane & 15, fq = lane >> 4;
    const int K = g.K, nt = K / BK;
    unsigned voffA[2], voffB[2];
#pragma unroll
    for (int i = 0; i < 2; ++i) { int R, C; stage_rc(tid * 16 + i * 8192, R, C); const int Rb = Epi::PERM ? ((R & ~31) + perm32(R & 31)) : R;
        voffA[i] = (unsigned)(R * g.lda + C) * 2u; voffB[i] = (unsigned)(Rb * g.ldb + C) * 2u; }
    const size_t kstep = (size_t)(BK * 2);
    const size_t hstepA = (size_t)HALF * g.lda * 2, hstepB = (size_t)HALF * g.ldb * 2;
    const size_t tstepA = 2 * hstepA, tstepB = 2 * hstepB;
    const unsigned ldsw = (unsigned)wid * 1024u;
    const int aoff = lds_byte(wr * 64 + fr, fq * 8), boff = lds_byte(wc * 32 + fr, fq * 8);
#define PG8_SA(b, h) (((b) * 2 + (h)) * HTB)
#define PG8_SB(b, h) ((4 + (b) * 2 + (h)) * HTB)
#define PG8_STAGE(bufoff, gbase, voff) do { _Pragma("unroll") for (int _i = 0; _i < 2; ++_i) \
        __builtin_amdgcn_global_load_lds((const unsigned*)((const char*)(gbase) + (voff)[_i]), (PG8_LAS unsigned*)(lds + (bufoff) + ldsw + _i * 8192), 16, 0, 0); } while (0)
#define PG8_LDA(dst, b, h) do { _Pragma("unroll") for (int m = 0; m < 4; ++m) _Pragma("unroll") for (int k = 0; k < 2; ++k) dst[m][k] = *(const PG8_LAS bf16x8*)(lds + PG8_SA(b, h) + aoff + m * 2048 + k * 1024); } while (0)
#define PG8_LDB(dst, b, h) do { _Pragma("unroll") for (int n = 0; n < 2; ++n) _Pragma("unroll") for (int k = 0; k < 2; ++k) dst[n][k] = *(const PG8_LAS bf16x8*)(lds + PG8_SB(b, h) + boff + n * 2048 + k * 1024); } while (0)
#define PG8_MMA(ai, bj, At, Bt) do { __builtin_amdgcn_s_setprio(1); _Pragma("unroll") for (int m = 0; m < 4; ++m) _Pragma("unroll") for (int n = 0; n < 2; ++n) _Pragma("unroll") for (int k = 0; k < 2; ++k) \
        acc[ai][bj][m][n] = __builtin_amdgcn_mfma_f32_16x16x32_bf16(Bt[n][k], At[m][k], acc[ai][bj][m][n], 0, 0, 0); __builtin_amdgcn_s_setprio(0); } while (0)
#define PG8_WAIT_V(n) asm volatile("s_waitcnt vmcnt(" #n ")" ::: "memory")
#define PG8_WAIT_L(n) asm volatile("s_waitcnt lgkmcnt(" #n ")" ::: "memory")
#define PG8_BAR __builtin_amdgcn_s_barrier()
#define PG8_SCHED __builtin_amdgcn_sched_barrier(0)
    Unit cur, nxt; int ui = 0;
    if (!S.next(0, cur)) return;
    f32x4 acc[2][2][4][2];
#pragma unroll
    for (int a = 0; a < 2; ++a)
#pragma unroll
        for (int b = 0; b < 2; ++b)
#pragma unroll
            for (int m = 0; m < 4; ++m)
#pragma unroll
                for (int n = 0; n < 2; ++n) acc[a][b][m][n] = (f32x4){0.f, 0.f, 0.f, 0.f};
    bf16x8 At[4][2], B0[2][2], B1[2][2];
    const char* cA = (const char*)g.A + (size_t)cur.pm * tstepA; const char* cB = (const char*)g.Bt + (size_t)cur.pn * tstepB;
    S.a_ready(cur);
    if constexpr (SP2) {
        PG8_STAGE(PG8_SB(0, 0), cB, voffB); PG8_STAGE(PG8_SB(0, 1), cB + hstepB, voffB); PG8_STAGE(PG8_SA(0, 0), cA, voffA); PG8_STAGE(PG8_SA(0, 1), cA + hstepA, voffA);
        if (wr == 1) PG8_BAR;
        PG8_WAIT_V(2); PG8_BAR;
        PG8_STAGE(PG8_SB(1, 0), cB + kstep, voffB); PG8_STAGE(PG8_SA(1, 0), cA + kstep, voffA); PG8_STAGE(PG8_SB(1, 1), cB + hstepB + kstep, voffB);
        PG8_WAIT_V(6); PG8_BAR;
    } else {
        PG8_STAGE(PG8_SB(0, 0), cB, voffB); PG8_STAGE(PG8_SA(0, 0), cA, voffA); PG8_STAGE(PG8_SB(0, 1), cB + hstepB, voffB); PG8_STAGE(PG8_SA(0, 1), cA + hstepA, voffA);
        if (wr == 1) PG8_BAR;
        PG8_WAIT_V(4); PG8_BAR;
        PG8_STAGE(PG8_SB(1, 0), cB + kstep, voffB); PG8_STAGE(PG8_SA(1, 0), cA + kstep, voffA); PG8_STAGE(PG8_SB(1, 1), cB + hstepB + kstep, voffB);
        PG8_WAIT_V(6); PG8_BAR;
    }
    for (;;) {
        const bool has_next = S.next(ui + 1, nxt);
        const char* nA = has_next ? (const char*)g.A + (size_t)nxt.pm * tstepA : cA; const char* nB = has_next ? (const char*)g.Bt + (size_t)nxt.pn * tstepB : cB;
        for (int t = 0; t < nt; t += 2) {
            if constexpr (Epi::MID) { if (t == nt / 2) E.mid(acc, cur, wr, wc, fr, fq); }
            const bool last = (t == nt - 2);
            const char* a1 = cA + (size_t)(t + 1) * kstep;
            const char* a2 = last ? nA : cA + (size_t)(t + 2) * kstep; const char* b2 = last ? nB : cB + (size_t)(t + 2) * kstep;
            const char* a3 = a2 + kstep; const char* b3 = b2 + kstep;
            if (last && has_next) S.a_ready(nxt);
            if constexpr (SP2) {
            PG8_LDB(B0, 0, 0); PG8_LDB(B1, 0, 1); PG8_SCHED; PG8_LDA(At, 0, 0); PG8_STAGE(PG8_SA(1, 1), a1 + hstepA, voffA);
            PG8_WAIT_V(8); PG8_WAIT_L(0); PG8_BAR; PG8_MMA(0, 0, At, B0); PG8_MMA(0, 1, At, B1); PG8_BAR; PG8_SCHED;
            PG8_LDA(At, 0, 1); PG8_STAGE(PG8_SB(0, 0), b2, voffB); PG8_STAGE(PG8_SB(0, 1), b2 + hstepB, voffB); PG8_STAGE(PG8_SA(0, 0), a2, voffA);
            PG8_WAIT_V(8); PG8_WAIT_L(0); PG8_BAR; PG8_MMA(1, 0, At, B0); PG8_MMA(1, 1, At, B1); PG8_BAR; PG8_SCHED;
            PG8_LDB(B0, 1, 0); PG8_LDB(B1, 1, 1); PG8_SCHED; PG8_LDA(At, 1, 0); PG8_STAGE(PG8_SA(0, 1), a2 + hstepA, voffA);
            PG8_WAIT_V(8); PG8_WAIT_L(0); PG8_BAR; PG8_MMA(0, 0, At, B0); PG8_MMA(0, 1, At, B1); PG8_BAR; PG8_SCHED;
            PG8_LDA(At, 1, 1); PG8_STAGE(PG8_SB(1, 0), b3, voffB); PG8_STAGE(PG8_SB(1, 1), b3 + hstepB, voffB); PG8_STAGE(PG8_SA(1, 0), a3, voffA);
            PG8_WAIT_V(8); PG8_WAIT_L(0); PG8_BAR; PG8_MMA(1, 0, At, B0); PG8_MMA(1, 1, At, B1); PG8_BAR; PG8_SCHED;
            } else {
            PG8_LDB(B0, 0, 0); PG8_SCHED; PG8_LDA(At, 0, 0); PG8_STAGE(PG8_SA(1, 1), a1 + hstepA, voffA);
            PG8_WAIT_L(8); PG8_BAR; PG8_WAIT_L(0); PG8_MMA(0, 0, At, B0); PG8_BAR; PG8_SCHED;
            PG8_LDB(B1, 0, 1); PG8_STAGE(PG8_SB(0, 0), b2, voffB);
            PG8_BAR; PG8_WAIT_L(0); PG8_MMA(0, 1, At, B1); PG8_BAR;
            PG8_LDA(At, 0, 1); PG8_STAGE(PG8_SA(0, 0), a2, voffA);
            PG8_BAR; PG8_WAIT_L(0); PG8_MMA(1, 0, At, B0); PG8_BAR; PG8_SCHED;
            PG8_STAGE(PG8_SB(0, 1), b2 + hstepB, voffB);
            PG8_WAIT_V(6); PG8_BAR; PG8_MMA(1, 1, At, B1); PG8_BAR;
            PG8_LDB(B0, 1, 0); PG8_SCHED; PG8_LDA(At, 1, 0); PG8_STAGE(PG8_SA(0, 1), a2 + hstepA, voffA);
            PG8_WAIT_L(8); PG8_BAR; PG8_WAIT_L(0); PG8_MMA(0, 0, At, B0); PG8_BAR; PG8_SCHED;
            PG8_LDB(B1, 1, 1); PG8_STAGE(PG8_SB(1, 0), b3, voffB);
            PG8_BAR; PG8_WAIT_L(0); PG8_MMA(0, 1, At, B1); PG8_BAR;
            PG8_LDA(At, 1, 1); PG8_STAGE(PG8_SA(1, 0), a3, voffA);
            PG8_BAR; PG8_WAIT_L(0); PG8_MMA(1, 0, At, B0); PG8_BAR; PG8_SCHED;
            PG8_STAGE(PG8_SB(1, 1), b3 + hstepB, voffB);
            PG8_WAIT_V(6); PG8_BAR; PG8_MMA(1, 1, At, B1); PG8_BAR;
            }
        }
        if constexpr (ALIGN_EPI) { if (wr == 0) PG8_BAR; }
        if constexpr (!Epi::AFTER_DRAIN) { E(acc, cur, wr, wc, fr, fq); S.done(cur); }
        if (!has_next) break;
#pragma unroll
        for (int a = 0; a < 2; ++a)
#pragma unroll
            for (int b = 0; b < 2; ++b)
#pragma unroll
                for (int m = 0; m < 4; ++m)
#pragma unroll
                    for (int n = 0; n < 2; ++n) acc[a][b][m][n] = (f32x4){0.f, 0.f, 0.f, 0.f};
        cur = nxt; cA = nA; cB = nB; ++ui;
        if constexpr (ALIGN_EPI) { if (wr == 1) PG8_BAR; }
    }
    PG8_WAIT_V(0);
    if constexpr (!ALIGN_EPI) { if (wr == 0) PG8_BAR; }
    PG8_BAR;
    if constexpr (Epi::AFTER_DRAIN) { E.fused(acc, cur, wr, wc, fr, fq, lds, wid, lane); S.done(cur); }
#undef PG8_SA
#undef PG8_SB
#undef PG8_STAGE
#undef PG8_LDA
#undef PG8_LDB
#undef PG8_MMA
#undef PG8_WAIT_V
#undef PG8_WAIT_L
#undef PG8_BAR
#undef PG8_SCHED
}
}

constexpr int NWAVES = 8, NTHREADS = NWAVES * 64;
constexpr int BATCH = 8, SEQ = 4096, D = 1024, M = BATCH * SEQ;
constexpr int POOLW = 512, QW = 512, NG = 2, HD = 64, NBG = BATCH * NG;
constexpr int IN_COLS = 3864, NIN = 4096;
constexpr int NCMP = 255, NCMP_PAD = 256, NSEL = 64;
constexpr int PH = 8, PK = 128, PTOP = 16, PQD = 256, PQW = PH * PQD;
constexpr int NEXP = PK * PK;
constexpr float EPS = 1e-6f;
enum { I_X = 0, I_C, I_RELB, I_ADAW, I_ADAB, I_N1G, I_N2G, I_WIN, I_POOLW, I_POOLS, I_CPEK, I_CW1K, I_CW2K, I_CPEV, I_CW1V, I_CW2V, I_QNG, I_KNG, I_WBP, I_WBA, I_WOUT, I_PWQ, I_PSK, I_PU, I_PV, N_IN };

constexpr size_t MiB = 1u << 20, KiB = 1u << 10;
constexpr size_t WS_CTL = 0, CTL_ZERO_BYTES = 1 * MiB;
constexpr size_t WS_ADA = 1 * MiB;
constexpr size_t WS_CB1K = 64 * KiB;
constexpr size_t WS_CB1V = WS_CB1K + 1 * KiB;
constexpr size_t WS_BIASL = WS_ADA + 256 * KiB;
constexpr size_t WS_WIN_T = 2 * MiB;
constexpr size_t WS_WEFF_T = 10 * MiB;
constexpr size_t WS_WBA_T = 11 * MiB;
constexpr size_t WS_WOUT_T = 12 * MiB;
constexpr size_t WS_WQ_T = 14 * MiB;
constexpr size_t WS_SUBK = 18 * MiB;
constexpr size_t WS_CW1K_T = 18 * MiB + 512 * KiB;
constexpr size_t WS_CW1V_T = 19 * MiB;
constexpr size_t WS_CW2K_T = 19 * MiB + 512 * KiB;
constexpr size_t WS_CW2V_T = WS_CW2K_T + 64 * KiB;
constexpr size_t WS_KC = 20 * MiB;
constexpr size_t WS_VCT = 20 * MiB + 512 * KiB;
constexpr size_t WS_GATE = 21 * MiB;
constexpr size_t WS_UB = 24 * MiB;
constexpr size_t WS_VB = 56 * MiB;
constexpr size_t WS_SCLU = WS_UB + 16 * MiB, WS_SCLV = WS_SCLU + 64 * KiB;
constexpr size_t WS_H = 88 * MiB;
constexpr size_t WS_ZP = 152 * MiB;
constexpr size_t WS_Q = 184 * MiB;
constexpr size_t WS_KCR = 216 * MiB;
constexpr size_t WS_VCR = 225 * MiB;
constexpr size_t WS_KS = 234 * MiB, WS_VS = 242 * MiB, WS_KW = 250 * MiB, WS_VW = 258 * MiB;
constexpr size_t WS_VST = 266 * MiB, WS_VWT = 274 * MiB;
constexpr size_t WS_PL = 282 * MiB;
constexpr size_t WS_YA = 314 * MiB;
constexpr size_t WS_GM = 346 * MiB;
constexpr size_t WS_MIX = WS_ZP;
constexpr size_t WS_QV = WS_GM;
constexpr size_t WS_EID = WS_PL;
constexpr size_t WS_GW = WS_PL + 16 * MiB;
constexpr size_t WS_PART = WS_GM;
constexpr size_t WS_CF = WS_YA;
constexpr size_t WS_CFS = WS_YA + 8 * MiB;
constexpr size_t WS_H8 = WS_ZP;
constexpr size_t WS_HS = WS_ZP + 32 * MiB;
constexpr size_t WS_X1 = WS_KCR;
constexpr size_t WS_END = 474 * MiB;
constexpr int CW_TMO = 0, CW_CODE = 1, CW_BAR = 4096;

constexpr int RING_OFF = 0, RING_BYTES = 131072;
constexpr int LDSCTL_OFF = RING_BYTES, MISC_OFF = LDSCTL_OFF + 320;
constexpr int LDS_BYTES = 147456;

#define GAS __attribute__((address_space(1)))
#define LAS __attribute__((address_space(3)))
typedef unsigned short bf16;
typedef unsigned v4u __attribute__((ext_vector_type(4)));
typedef unsigned v2u __attribute__((ext_vector_type(2)));
typedef int v2i __attribute__((ext_vector_type(2)));
typedef float f32x4 __attribute__((ext_vector_type(4)));
typedef short bf16x8 __attribute__((ext_vector_type(8)));
typedef GAS unsigned gu32;
#define RLX_AGENT __ATOMIC_RELAXED, __HIP_MEMORY_SCOPE_AGENT
#define LDS_WAIT() asm volatile("s_waitcnt lgkmcnt(0)" ::: "memory")
#define VM_WAIT() asm volatile("s_waitcnt vmcnt(0)" ::: "memory")
__device__ __forceinline__ unsigned f2bf(float f) { unsigned u = __builtin_bit_cast(unsigned, f); return (u + 0x7fffu + ((u >> 16) & 1u)) >> 16; }
__device__ __forceinline__ unsigned pk2(float lo, float hi) { return f2bf(lo) | (f2bf(hi) << 16); }
__device__ __forceinline__ float bflo(unsigned w) { return __builtin_bit_cast(float, w << 16); }
__device__ __forceinline__ float bfhi(unsigned w) { return __builtin_bit_cast(float, w & 0xffff0000u); }
__device__ __forceinline__ float sigmoidf_(float v) { return __builtin_amdgcn_rcpf(1.0f + __builtin_amdgcn_exp2f(v * -1.4426950408889634f)); }
typedef __bf16 bf16x2_hw __attribute__((ext_vector_type(2)));
typedef float f32x2_hw __attribute__((ext_vector_type(2)));
__device__ __forceinline__ unsigned pkh(float lo, float hi) { return __builtin_bit_cast(unsigned, __builtin_convertvector((f32x2_hw){lo, hi}, bf16x2_hw)); }
__device__ __forceinline__ float gelu_tanh_safe(float v) { const float u = 0.7978845608028654f * (v + 0.044715f * v * v * v); return 0.5f * v * (1.0f + tanhf(u)); }
template <int CTRL> __device__ __forceinline__ float dppf(float v) { return __builtin_bit_cast(float, __builtin_amdgcn_update_dpp(0, __builtin_bit_cast(int, v), CTRL, 0xF, 0xF, true)); }
template <int CTRL> __device__ __forceinline__ int dppi(int v) { return __builtin_amdgcn_update_dpp(0, v, CTRL, 0xF, 0xF, true); }
#define DPP_XOR1 0xB1
#define DPP_XOR2 0x4E
#define DPP_HMIR 0x141
#define DPP_ROR8 0x128
__device__ __forceinline__ void swap16_(float& a, float& b) { asm volatile("v_nop\n\tv_nop\n\tv_permlane16_swap_b32 %0, %1" : "+v"(a), "+v"(b)); }
__device__ __forceinline__ void swap32_(float& a, float& b) { asm volatile("v_nop\n\tv_nop\n\tv_permlane32_swap_b32 %0, %1" : "+v"(a), "+v"(b)); }
__device__ __forceinline__ float sum_xor16(float v) { float a = v, b = v; swap16_(a, b); return a + b; }
__device__ __forceinline__ float sum_xor32(float v) { float a = v, b = v; swap32_(a, b); return a + b; }
__device__ __forceinline__ float max_xor16(float v) { float a = v, b = v; swap16_(a, b); return fmaxf(a, b); }
__device__ __forceinline__ float max_xor32(float v) { float a = v, b = v; swap32_(a, b); return fmaxf(a, b); }
__device__ __forceinline__ float wave_sum(float v) {
    v += dppf<DPP_XOR1>(v); v += dppf<DPP_XOR2>(v); v += dppf<DPP_HMIR>(v); v += dppf<DPP_ROR8>(v);
    return sum_xor32(sum_xor16(v));
}
__device__ __forceinline__ float wave_max(float v) {
    v = fmaxf(v, dppf<DPP_XOR1>(v)); v = fmaxf(v, dppf<DPP_XOR2>(v)); v = fmaxf(v, dppf<DPP_HMIR>(v)); v = fmaxf(v, dppf<DPP_ROR8>(v));
    return max_xor32(max_xor16(v));
}

#define XB_TMO      128
#define XB_XCNT(j)  (256  + 64 * (j))
#define XB_XSUB(j)  (1280 + 64 * (j))
#define XB_XGEN(j)  (2304 + 64 * (j))
#define XB_TOP      3328
#define XB_TOPGEN   3392
#define XCD_BAR_WORDS 3456
#define XB_SPIN_CAP (1u << 18)
__device__ __forceinline__ unsigned xb_ld(unsigned* p)              { return __hip_atomic_load(p, __ATOMIC_RELAXED, __HIP_MEMORY_SCOPE_AGENT); }
__device__ __forceinline__ unsigned xb_add(unsigned* p, unsigned v) { return __hip_atomic_fetch_add(p, v, __ATOMIC_RELAXED, __HIP_MEMORY_SCOPE_AGENT); }
__device__ __forceinline__ unsigned xb_xcc_id() { return (unsigned)__builtin_amdgcn_s_getreg((3 << 11) | 20) & 0xFu; }
#define XB_SPIN(cond, bar) do { unsigned _sp = 0; while (cond) { __builtin_amdgcn_s_sleep(1); \
    if ((++_sp & 255u) == 0u) { if (xb_ld(&(bar)[XB_TMO])) break; if (_sp > XB_SPIN_CAP) { atomicAdd(&(bar)[XB_TMO], 1u); break; } } } } while (0)
struct XcdBarrier { unsigned* bar; unsigned x; volatile LAS unsigned* st; };
__device__ __forceinline__ XcdBarrier xcd_barrier_post(unsigned* bar, volatile LAS unsigned* st) {
    XcdBarrier b; b.bar = bar; b.x = xb_xcc_id(); b.st = st;
    if (threadIdx.x == 0) (void)xb_add(&bar[XB_XCNT(b.x)], 1u);
    return b;
}
__device__ __forceinline__ void xcd_barrier_complete(unsigned* bar, unsigned x, unsigned& nloc, unsigned& nx) {
    const unsigned G = gridDim.x * gridDim.y * gridDim.z;
    unsigned sum, cnt, mine, sp = 0u;
    for (;;) {
        sum = 0u; cnt = 0u; mine = 0u;
#pragma unroll
        for (unsigned j = 0; j < 16; ++j) { const unsigned c = xb_ld(&bar[XB_XCNT(j)]); sum += c; cnt += (c > 0u) ? 1u : 0u; mine = (j == x) ? c : mine; }
        if (sum == G) break;
        __builtin_amdgcn_s_sleep(1);
        if ((++sp & 255u) == 0u) { if (xb_ld(&bar[XB_TMO])) break; if (sp > XB_SPIN_CAP) { atomicAdd(&bar[XB_TMO], 1u); break; } }
    }
    nloc = mine > 0u ? mine : 1u; nx = cnt > 0u ? cnt : 1u;
}
__device__ __forceinline__ void xcd_barrier(const XcdBarrier& b) {
    asm volatile("s_waitcnt vmcnt(0)" ::: "memory");
    __syncthreads();
    if (threadIdx.x == 0) {
        unsigned* bar = b.bar;
        __builtin_amdgcn_s_waitcnt(0);
        unsigned nloc = b.st[0], nx = b.st[1];
        if (nloc == 0u) { xcd_barrier_complete(bar, b.x, nloc, nx); b.st[0] = nloc; b.st[1] = nx; }
        const unsigned old = xb_add(&bar[XB_XSUB(b.x)], 1u);
        const unsigned gen = old / nloc;
        if (old + 1u == (gen + 1u) * nloc) {
            __builtin_amdgcn_fence(__ATOMIC_RELEASE, "agent");
            asm volatile("s_waitcnt vmcnt(0)" ::: "memory");
            const unsigned og = xb_add(&bar[XB_TOP], 1u);
            const unsigned tg = og / nx;
            if (og + 1u == (tg + 1u) * nx) xb_add(&bar[XB_TOPGEN], 1u);
            else XB_SPIN(xb_ld(&bar[XB_TOPGEN]) == tg, bar);
            __builtin_amdgcn_fence(__ATOMIC_ACQUIRE, "agent");
            xb_add(&bar[XB_XGEN(b.x)], 1u);
            asm volatile("s_waitcnt vmcnt(0)" ::: "memory");
        } else {
            XB_SPIN(xb_ld(&bar[XB_XGEN(b.x)]) == gen, bar);
            __builtin_amdgcn_fence(__ATOMIC_ACQUIRE, "agent");
            asm volatile("s_waitcnt vmcnt(0)" ::: "memory");
        }
    }
    __syncthreads();
}

struct Args { const float* in[N_IN]; float* out; unsigned char* ws; int ph_lo, ph_hi, li, pad; };
struct Frame {
    LAS unsigned char* lds;
    volatile LAS unsigned* MISC;
    gu32* ctl;
    int tid, lane, wave, G, bid;
    unsigned char* ws;
};

template <bool I8> __device__ __forceinline__ void cvt_row_store(const f32x4 (&v)[4], int row, unsigned char* dst, float* inv_scale, int lane) {
    float m = 0.f;
#pragma unroll
    for (int j = 0; j < 4; ++j) m = fmaxf(m, fmaxf(fmaxf(fabsf(v[j].x), fabsf(v[j].y)), fmaxf(fabsf(v[j].z), fabsf(v[j].w))));
    m = wave_max(m);
    unsigned ww[4]; float isc;
    if (I8) { const float sc = m > 0.f ? 127.0f / m : 0.f; isc = m * (1.0f / 127.0f);
#pragma unroll
        for (int j = 0; j < 4; ++j) { const int q0 = (int)rintf(v[j].x * sc), q1 = (int)rintf(v[j].y * sc), q2 = (int)rintf(v[j].z * sc), q3 = (int)rintf(v[j].w * sc);
            ww[j] = ((unsigned)q0 & 0xffu) | (((unsigned)q1 & 0xffu) << 8) | (((unsigned)q2 & 0xffu) << 16) | (((unsigned)q3 & 0xffu) << 24); } }
    else { const unsigned E = (__builtin_bit_cast(unsigned, m) >> 23) & 0xffu; float sc = 1.f; isc = 1.f;
        if (E >= 8u && E <= 250u) { sc = __builtin_bit_cast(float, (261u - E) << 23); isc = __builtin_bit_cast(float, (E - 7u) << 23); }
#pragma unroll
        for (int j = 0; j < 4; ++j) { int t = __builtin_amdgcn_cvt_pk_fp8_f32(v[j].x * sc, v[j].y * sc, 0, false); t = __builtin_amdgcn_cvt_pk_fp8_f32(v[j].z * sc, v[j].w * sc, t, true); ww[j] = (unsigned)t; } }
    *(GAS v4u*)(dst + (size_t)(lane >> 3) * NEXP * 128 + (size_t)row * 128 + 16 * (lane & 7)) = (v4u){ww[0], ww[1], ww[2], ww[3]};
    if (lane == 0) inv_scale[row] = isc;
}
template <bool I8> __device__ __forceinline__ void cvt_rows_8bit(const float* src, unsigned char* dst, float* inv_scale, int gw, int NGW, int lane) {
    for (int row = gw; row < NEXP; row += 2 * NGW) {
        const int row1 = row + NGW; const bool has1 = row1 < NEXP;
        f32x4 v0[4], v1[4];
#pragma unroll
        for (int j = 0; j < 4; ++j) v0[j] = *(const GAS f32x4*)(src + (size_t)row * D + 16 * lane + 4 * j);
#pragma unroll
        for (int j = 0; j < 4; ++j) v1[j] = has1 ? *(const GAS f32x4*)(src + (size_t)row1 * D + 16 * lane + 4 * j) : (f32x4){0.f, 0.f, 0.f, 0.f};
        cvt_row_store<I8>(v0, row, dst, inv_scale, lane);
        if (has1) cvt_row_store<I8>(v1, row1, dst, inv_scale, lane);
    }
}
__device__ __forceinline__ void p0_transpose_item(const float* W, int ldw, int src_col0, int valid, int K, bf16* WT, int dst_row0, int k0, LAS float* scr, int lane, int ldt = -1) {
    if (ldt < 0) ldt = K;
    const int n_ = lane & 31;
#pragma unroll 8
    for (int i = 0; i < 32; ++i) { const int kk = 2 * i + (lane >> 5); scr[kk * 33 + n_] = (n_ < valid) ? W[(size_t)(k0 + kk) * ldw + src_col0 + n_] : 0.f; }
    LDS_WAIT(); asm volatile("" ::: "memory");
    const int c = lane & 7;
#pragma unroll
    for (int j = 0; j < 4; ++j) { const int n = (lane >> 3) + 8 * j; const LAS float* s = scr + (8 * c) * 33 + n;
        v4u o; o.x = pk2(s[0 * 33], s[1 * 33]); o.y = pk2(s[2 * 33], s[3 * 33]); o.z = pk2(s[4 * 33], s[5 * 33]); o.w = pk2(s[6 * 33], s[7 * 33]);
        *(GAS v4u*)(WT + (size_t)(dst_row0 + n) * ldt + k0 + 8 * c) = o; }
    LDS_WAIT(); asm volatile("" ::: "memory");
}
__device__ __forceinline__ bool p0_mat(int& r, const float* W, int K, int N, bf16* WT, LAS float* scr, int lane, int ldt = -1) {
    const int ng = N / 32, items = ng * (K / 64);
    if (r < items) { const int kb = r / ng, nb = r % ng; p0_transpose_item(W, N, 32 * nb, 32, K, WT, 32 * nb, 64 * kb, scr, lane, ldt); return true; }
    r -= items; return false;
}
__device__ __forceinline__ void cvt_f32_bf16_stream(const float* src, bf16* dst, size_t n8, size_t gtid, size_t gthreads) {
    for (size_t i = gtid; i < n8; i += gthreads) {
        const f32x4 a = *(const GAS f32x4*)(src + 8 * i), b = *(const GAS f32x4*)(src + 8 * i + 4);
        v4u o; o.x = pk2(a.x, a.y); o.y = pk2(a.z, a.w); o.z = pk2(b.x, b.y); o.w = pk2(b.z, b.w);
        *(GAS v4u*)(dst + 8 * i) = o; }
}

__device__ __forceinline__ void p0_prologue(Frame& F, const Args& args, bool do_bias = true) {
    unsigned char* ws = F.ws;
    const int gw = F.bid * NWAVES + F.wave, NGW = F.G * NWAVES;
    const size_t gtid = (size_t)F.bid * NTHREADS + F.tid, gthreads = (size_t)F.G * NTHREADS;
    {
        LAS float* sl = (LAS float*)(F.lds);
        LAS float* red = (LAS float*)(F.lds + 32768);
        const float* c = args.in[I_C];
        { f32x4 cv[4];
#pragma unroll
          for (int q = 0; q < 4; ++q) cv[q] = *(const GAS f32x4*)(c + 4 * (F.tid + NTHREADS * q));
#pragma unroll
          for (int q = 0; q < 4; ++q) { f32x4 o; o.x = cv[q].x / (1.0f + __expf(-cv[q].x)); o.y = cv[q].y / (1.0f + __expf(-cv[q].y)); o.z = cv[q].z / (1.0f + __expf(-cv[q].z)); o.w = cv[q].w / (1.0f + __expf(-cv[q].w));
              *(LAS f32x4*)(sl + 4 * (F.tid + NTHREADS * q)) = o; } }
        __syncthreads();
        for (int cb = F.bid; cb < 6 * D / 24; cb += F.G) {
            const int j0 = cb * 24;
            if (F.tid < 510) {
                const int kk = F.tid / 6, c4 = F.tid % 6;
                const float* w = args.in[I_ADAW] + j0 + 4 * c4;
                f32x4 wv[13];
#pragma unroll
                for (int m = 0; m < 13; ++m) { const int k = kk + 85 * m; wv[m] = (k < D) ? *(const GAS f32x4*)(w + (size_t)k * (6 * D)) : (f32x4){0.f, 0.f, 0.f, 0.f}; }
                f32x4 a[BATCH];
#pragma unroll
                for (int b = 0; b < BATCH; ++b) a[b] = (f32x4){0.f, 0.f, 0.f, 0.f};
#pragma unroll
                for (int m = 0; m < 13; ++m) { const int k = kk + 85 * m; const int kc = k < D ? k : 0;
#pragma unroll
                    for (int b = 0; b < BATCH; ++b) a[b] = a[b] + wv[m] * sl[b * D + kc]; }
#pragma unroll
                for (int b = 0; b < BATCH; ++b) { LAS float* rp = red + (kk * 24 + 4 * c4) * BATCH + b; rp[0] = a[b].x; rp[BATCH] = a[b].y; rp[2 * BATCH] = a[b].z; rp[3 * BATCH] = a[b].w; }
            }
            __syncthreads();
            if (F.tid < 24 * BATCH) { const int jj = F.tid / BATCH, b = F.tid % BATCH; float s = 0.f;
#pragma unroll 5
                for (int kk = 0; kk < 85; ++kk) s += red[(kk * 24 + jj) * BATCH + b];
                ((float*)(ws + WS_ADA))[b * (6 * D) + j0 + jj] = s + args.in[I_ADAB][j0 + jj]; }
            __syncthreads();
        }
    }
    if (F.bid >= 8 && F.bid < 40 && do_bias) {
        const int bb = F.bid - 8, kv = bb & 1, ch = bb >> 1;
        const float* pe = args.in[kv == 0 ? I_CPEK : I_CPEV]; const float* w1 = args.in[kv == 0 ? I_CW1K : I_CW1V];
        LAS float* red = (LAS float*)(F.lds);
        const int j = F.tid & 127, ic = F.tid >> 7; float s = 0.f;
        const int i0 = ch * 128 + ic * 32;
#pragma unroll 8
        for (int i = i0; i < i0 + 32; ++i) s += pe[i] * w1[(size_t)i * 128 + j];
        red[ic * 128 + j] = s; __syncthreads();
        if (F.tid < 128) atomicAdd((float*)(ws + (kv == 0 ? WS_CB1K : WS_CB1V)) + F.tid, (red[F.tid] + red[128 + F.tid]) + (red[256 + F.tid] + red[384 + F.tid]));
        __syncthreads();
    } else if (F.bid == 2) {
        for (int i = F.tid; i < 8 * 128; i += NTHREADS) { const int h = i >> 7, rel = i & 127;
            int bk = rel;
            if (rel >= 16) bk = 16 + (rel >= 19) + (rel >= 21) + (rel >= 24) + (rel >= 27) + (rel >= 31) + (rel >= 35) + (rel >= 40) + (rel >= 46) + (rel >= 52) + (rel >= 59) + (rel >= 67) + (rel >= 77) + (rel >= 87) + (rel >= 99) + (rel >= 113);
            ((float*)(ws + WS_BIASL))[i] = args.in[I_RELB][bk * 8 + h]; }
        if (F.tid < 64) {
            float mq = fabsf(args.in[I_QNG][F.tid]), mk = fmaxf(fmaxf(fabsf(args.in[I_KNG][F.tid]), fabsf(args.in[I_KNG][64 + F.tid])), fabsf(args.in[I_KNG][128 + F.tid]));
            float mb = fmaxf(fmaxf(fabsf(args.in[I_RELB][F.tid]), fabsf(args.in[I_RELB][64 + F.tid])), fmaxf(fabsf(args.in[I_RELB][128 + F.tid]), fabsf(args.in[I_RELB][192 + F.tid])));
            mq = wave_max(mq); mk = wave_max(mk); mb = wave_max(mb);
            if (F.tid == 0) ((float*)(ws + WS_BIASL))[8 * 128] = 8.0f * mq * mk + mb; }
    }
    {
        LAS float* scr = (LAS float*)(F.lds + F.wave * 16384);
        constexpr int I_WINT = (NIN / 32) * (D / 64);
        constexpr int NITEMS = I_WINT + (1024 / 32) * (512 / 64) + (1024 / 32) * (1024 / 64) + (2048 / 32) * (1024 / 64) + 2 * (128 / 32) * (2048 / 64) + 2 * (64 / 32) * (128 / 64);
        for (int it = gw; it < NITEMS; it += NGW) {
            int r = it;
            if (r < I_WINT) {
                const int grp = r % (NIN / 32), kb = r / (NIN / 32);
                const int tile = grp >> 3, ct0 = (grp & 7) * 32;
                const int L0 = 64 * ((ct0 >> 5) & 3) + 32 * (ct0 >> 7);
                int src0, valid = 32;
                if (tile < 7) src0 = 256 * tile + L0; else if (tile < 15) src0 = 1816 + 256 * (tile - 7) + L0; else { src0 = 1792 + L0; valid = (L0 == 0) ? 24 : 0; }
                if (valid == 0) src0 = 0;
                p0_transpose_item(args.in[I_WIN], IN_COLS, src0, valid, D, (bf16*)(ws + WS_WIN_T), 32 * grp, 64 * kb, scr, F.lane);
                continue; }
            r -= I_WINT;
            if (p0_mat(r, args.in[I_WBA], 512, 1024, (bf16*)(ws + WS_WEFF_T) + 512, scr, F.lane, 1024)) continue;
            if (p0_mat(r, args.in[I_WOUT], 1024, 1024, (bf16*)(ws + WS_WOUT_T), scr, F.lane)) continue;
            if (p0_mat(r, args.in[I_PWQ], 1024, 2048, (bf16*)(ws + WS_WQ_T), scr, F.lane)) continue;
            if (p0_mat(r, args.in[I_CW1K], 2048, 128, (bf16*)(ws + WS_CW1K_T), scr, F.lane)) continue;
            if (p0_mat(r, args.in[I_CW1V], 2048, 128, (bf16*)(ws + WS_CW1V_T), scr, F.lane)) continue;
            if (p0_mat(r, args.in[I_CW2K], 128, 64, (bf16*)(ws + WS_CW2K_T), scr, F.lane)) continue;
            p0_mat(r, args.in[I_CW2V], 128, 64, (bf16*)(ws + WS_CW2V_T), scr, F.lane);
        }
    }
    {
        const float* pw = args.in[I_POOLW]; const float* ps = args.in[I_POOLS]; const float* wbp = args.in[I_WBP];
        bf16* weff = (bf16*)(ws + WS_WEFF_T);
        LAS float* PWl = (LAS float*)(F.lds);
        LAS float* WBl = (LAS float*)(F.lds + 128 * 129 * 4);
        __syncthreads();
        for (int bb = F.bid; bb < 256; bb += F.G) {
            const int g = bb >> 6, d0 = (bb & 63) * 16;
            { f32x4 t[8];
#pragma unroll
              for (int q = 0; q < 8; ++q) t[q] = *(const GAS f32x4*)(pw + (size_t)g * 16384 + 4 * (F.tid + NTHREADS * q));
#pragma unroll
              for (int q = 0; q < 8; ++q) { const int i = 4 * (F.tid + NTHREADS * q); LAS float* d = PWl + (i >> 7) * 129 + (i & 127); d[0] = t[q].x; d[1] = t[q].y; d[2] = t[q].z; d[3] = t[q].w; }
              const int cc = F.tid >> 2, d4 = (F.tid & 3) * 4;
              const f32x4 wv = *(const GAS f32x4*)(wbp + (size_t)(g * 128 + cc) * D + d0 + d4); const float pv = ps[g * 128 + cc];
              LAS float* d = WBl + cc * 17 + d4; d[0] = wv.x * pv; d[1] = wv.y * pv; d[2] = wv.z * pv; d[3] = wv.w * pv; }
            __syncthreads();
            const int c = F.tid & 127, q = F.tid >> 7;
            float acc4[4] = {0.f, 0.f, 0.f, 0.f};
#pragma unroll 4
            for (int cc = 0; cc < 128; ++cc) { const float a = PWl[c * 129 + cc];
#pragma unroll
                for (int e = 0; e < 4; ++e) acc4[e] += a * WBl[cc * 17 + 4 * q + e]; }
#pragma unroll
            for (int e = 0; e < 4; ++e) weff[(size_t)(d0 + 4 * q + e) * 1024 + g * 128 + c] = (bf16)f2bf(acc4[e]);
            __syncthreads();
        }
    }
    cvt_f32_bf16_stream(args.in[I_PSK], (bf16*)(ws + WS_SUBK), (size_t)16 * 128 * 128 / 8, gtid, gthreads);
    cvt_rows_8bit<true>(args.in[I_PU], ws + WS_UB, (float*)(ws + WS_SCLU), gw, NGW, F.lane);
    cvt_rows_8bit<false>(args.in[I_PV], ws + WS_VB, (float*)(ws + WS_SCLV), gw, NGW, F.lane);
}

template <bool Q8> __device__ __forceinline__ void modnorm_rows(Frame& F, const void* xin, const float* g, const float* ada, int shift_idx, bf16* out) {
    const int gw = F.bid * NWAVES + F.wave, NGW = F.G * NWAVES;
    for (int m = gw; m < M; m += NGW) {
        const int b = m >> 12;
        const GAS f32x4* gr = (const GAS f32x4*)g + F.lane;
        const GAS f32x4* sh = (const GAS f32x4*)(ada + (size_t)b * 6 * D + shift_idx * D) + F.lane;
        const GAS f32x4* sc = (const GAS f32x4*)(ada + (size_t)b * 6 * D + (shift_idx + 1) * D) + F.lane;
        f32x4 v[4]; float s = 0.f;
#pragma unroll
        for (int j = 0; j < 4; ++j) {
            if (Q8) { const v2u xb = ((const GAS v2u*)((const bf16*)xin + (size_t)m * D))[F.lane + 64 * j]; v[j] = (f32x4){bflo(xb.x), bfhi(xb.x), bflo(xb.y), bfhi(xb.y)}; }
            else v[j] = ((const GAS f32x4*)((const float*)xin + (size_t)m * D))[F.lane + 64 * j];
            s += (v[j].x * v[j].x + v[j].y * v[j].y) + (v[j].z * v[j].z + v[j].w * v[j].w); }
        const float rstd = rsqrtf(wave_sum(s) * (1.f / D) + EPS);
        GAS v2u* o8 = (GAS v2u*)(out + (size_t)m * D) + F.lane;
        float mx = 0.f;
#pragma unroll
        for (int j = 0; j < 4; ++j) { const f32x4 gg = gr[64 * j], ss = sh[64 * j], cc = sc[64 * j];
            const f32x4 y = (v[j] * rstd) * gg * (cc + 1.0f) + ss; v[j] = y;
            mx = fmaxf(mx, fmaxf(fmaxf(fabsf(y.x), fabsf(y.y)), fmaxf(fabsf(y.z), fabsf(y.w))));
            v2u o; o.x = pk2(y.x, y.y); o.y = pk2(y.z, y.w); o8[64 * j] = o; }
        if (Q8) {
            mx = wave_max(mx);
            const float qs = mx > 0.f ? 127.0f / mx : 0.f;
            GAS unsigned* h8 = (GAS unsigned*)(F.ws + WS_H8 + (size_t)m * D) + F.lane;
#pragma unroll
            for (int j = 0; j < 4; ++j) { const int q0 = (int)rintf(v[j].x * qs), q1 = (int)rintf(v[j].y * qs), q2 = (int)rintf(v[j].z * qs), q3 = (int)rintf(v[j].w * qs);
                h8[64 * j] = ((unsigned)q0 & 0xffu) | (((unsigned)q1 & 0xffu) << 8) | (((unsigned)q2 & 0xffu) << 16) | (((unsigned)q3 & 0xffu) << 24); }
            if (F.lane == 0) ((float*)(F.ws + WS_HS))[m] = mx * (1.0f / 127.0f);
        }
    }
}

struct EpiIn {
    static constexpr bool PERM = true, AFTER_DRAIN = false, MID = false;
    unsigned char* ws; const float* qg; const float* kg; const volatile LAS unsigned* rmp;
    __device__ __forceinline__ void operator()(const pg8::f32x4 (&acc)[2][2][4][2], const pg8::Unit& u, int wr, int wc, int fr, int fq) const {
        const int pn = u.pn, rmask = __builtin_amdgcn_readfirstlane((int)*rmp);
#pragma unroll
        for (int ai = 0; ai < 2; ++ai)
#pragma unroll
            for (int m = 0; m < 4; ++m) {
                const int row = (u.pm & rmask) * 256 + ai * 128 + wr * 64 + m * 16 + fr;
                float v[2][8];
#pragma unroll
                for (int bj = 0; bj < 2; ++bj)
#pragma unroll
                    for (int n = 0; n < 2; ++n)
#pragma unroll
                        for (int i = 0; i < 4; ++i) v[bj][4 * n + i] = acc[ai][bj][m][n][i];
                bf16* dst = nullptr; bool norm = false; const float* gain = nullptr; float mul = 1.f; bool sig = false;
                if (pn < 2) { dst = (bf16*)(ws + WS_ZP) + (size_t)row * 512 + 256 * pn + 64 * wc; }
                else if (pn < 4) { dst = (bf16*)(ws + WS_Q) + (size_t)row * 512 + 256 * (pn - 2) + 64 * wc; norm = true; gain = qg; mul = 0.125f * 1.4426950408889634f; }
                else if (pn < 7) { const int kind = pn - 4, isv = wc >> 1, g = wc & 1, b = row >> 12, t = row & 4095;
                    const size_t base = ((size_t)(b * 2 + g) * SEQ + t) * 64;
                    const size_t off = kind == 0 ? (isv ? WS_VCR : WS_KCR) : kind == 1 ? (isv ? WS_VS : WS_KS) : (isv ? WS_VW : WS_KW);
                    dst = (bf16*)(ws + off) + base; if (!isv && kind > 0) { norm = true; gain = kg + kind * 64; } }
                else if (pn < 15) { dst = (bf16*)(ws + WS_GM) + (size_t)row * 2048 + 256 * (pn - 7) + 64 * wc; sig = true; }
                else {
                    if (wc == 0 && fq < 3) { float* gp = (float*)(ws + WS_GATE) + (size_t)row * 24 + 8 * fq;
                        *(GAS f32x4*)gp = (f32x4){sigmoidf_(v[0][0]), sigmoidf_(v[0][1]), sigmoidf_(v[0][2]), sigmoidf_(v[0][3])};
                        *(GAS f32x4*)(gp + 4) = (f32x4){sigmoidf_(v[0][4]), sigmoidf_(v[0][5]), sigmoidf_(v[0][6]), sigmoidf_(v[0][7])}; }
                    continue; }
                if (norm) { float ss = 0.f;
#pragma unroll
                    for (int bj = 0; bj < 2; ++bj)
#pragma unroll
                        for (int e = 0; e < 8; ++e) ss += v[bj][e] * v[bj][e];
                    ss = sum_xor32(sum_xor16(ss));
                    const float rs = rsqrtf(ss * (1.f / 64.f) + EPS) * mul;
#pragma unroll
                    for (int bj = 0; bj < 2; ++bj)
#pragma unroll
                        for (int e = 0; e < 8; ++e) v[bj][e] = v[bj][e] * rs * gain[32 * bj + 8 * fq + e]; }
                if (sig) {
#pragma unroll
                    for (int bj = 0; bj < 2; ++bj)
#pragma unroll
                        for (int e = 0; e < 8; ++e) v[bj][e] = sigmoidf_(v[bj][e]); }
#pragma unroll
                for (int bj = 0; bj < 2; ++bj) { v4u o; o.x = pkh(v[bj][0], v[bj][1]); o.y = pkh(v[bj][2], v[bj][3]); o.z = pkh(v[bj][4], v[bj][5]); o.w = pkh(v[bj][6], v[bj][7]);
                    *(GAS v4u*)(dst + 32 * bj + 8 * fq) = o; }
            }
    }
};
template <bool ADD> struct EpiMix {
    static constexpr bool PERM = true, AFTER_DRAIN = false, MID = false;
    bf16* MIX; const bf16* GM; int gmoff;
    __device__ __forceinline__ void operator()(const pg8::f32x4 (&acc)[2][2][4][2], const pg8::Unit& u, int wr, int wc, int fr, int fq) const {
#pragma unroll
        for (int ai = 0; ai < 2; ++ai)
#pragma unroll
            for (int m = 0; m < 4; ++m) {
                const int row = u.pm * 256 + ai * 128 + wr * 64 + m * 16 + fr;
#pragma unroll
                for (int bj = 0; bj < 2; ++bj) {
                    const int col = u.pn * 256 + bj * 128 + wc * 32 + 8 * fq;
                    const v4u gmv = *(const GAS v4u*)(GM + (size_t)row * 2048 + gmoff + col);
                    float r[8];
                    r[0] = acc[ai][bj][m][0][0] * bflo(gmv.x); r[1] = acc[ai][bj][m][0][1] * bfhi(gmv.x); r[2] = acc[ai][bj][m][0][2] * bflo(gmv.y); r[3] = acc[ai][bj][m][0][3] * bfhi(gmv.y);
                    r[4] = acc[ai][bj][m][1][0] * bflo(gmv.z); r[5] = acc[ai][bj][m][1][1] * bfhi(gmv.z); r[6] = acc[ai][bj][m][1][2] * bflo(gmv.w); r[7] = acc[ai][bj][m][1][3] * bfhi(gmv.w);
                    GAS v4u* dp = (GAS v4u*)(MIX + (size_t)row * 1024 + col);
                    if (ADD) { const v4u old = *dp; r[0] += bflo(old.x); r[1] += bfhi(old.x); r[2] += bflo(old.y); r[3] += bfhi(old.y); r[4] += bflo(old.z); r[5] += bfhi(old.z); r[6] += bflo(old.w); r[7] += bfhi(old.w); }
                    v4u o; o.x = pkh(r[0], r[1]); o.y = pkh(r[2], r[3]); o.z = pkh(r[4], r[5]); o.w = pkh(r[6], r[7]); *dp = o; }
            }
    }
};
struct EpiMix2 {
    static constexpr bool PERM = true, AFTER_DRAIN = false, MID = true;
    bf16* MIX; const bf16* GM;
    __device__ __forceinline__ void mid(pg8::f32x4 (&acc)[2][2][4][2], const pg8::Unit& u, int wr, int wc, int fr, int fq) const {
#pragma unroll
        for (int ai = 0; ai < 2; ++ai)
#pragma unroll
            for (int m = 0; m < 4; ++m) {
                const int row = u.pm * 256 + ai * 128 + wr * 64 + m * 16 + fr;
#pragma unroll
                for (int bj = 0; bj < 2; ++bj) {
                    const int col = u.pn * 256 + bj * 128 + wc * 32 + 8 * fq;
                    const v4u g1 = *(const GAS v4u*)(GM + (size_t)row * 2048 + col), g2 = *(const GAS v4u*)(GM + (size_t)row * 2048 + 1024 + col);
                    const unsigned w1[4] = {g1.x, g1.y, g1.z, g1.w}, w2[4] = {g2.x, g2.y, g2.z, g2.w};
#pragma unroll
                    for (int n = 0; n < 2; ++n)
#pragma unroll
                        for (int i = 0; i < 4; ++i) { const unsigned a = w1[2 * n + (i >> 1)], b = w2[2 * n + (i >> 1)];
                            const float ga = (i & 1) ? bfhi(a) : bflo(a), gb = fmaxf((i & 1) ? bfhi(b) : bflo(b), 9.5367431640625e-07f);
                            acc[ai][bj][m][n][i] *= ga * __builtin_amdgcn_rcpf(gb); } }
            }
    }
    __device__ __forceinline__ void operator()(const pg8::f32x4 (&acc)[2][2][4][2], const pg8::Unit& u, int wr, int wc, int fr, int fq) const {
#pragma unroll
        for (int ai = 0; ai < 2; ++ai)
#pragma unroll
            for (int m = 0; m < 4; ++m) {
                const int row = u.pm * 256 + ai * 128 + wr * 64 + m * 16 + fr;
#pragma unroll
                for (int bj = 0; bj < 2; ++bj) {
                    const int col = u.pn * 256 + bj * 128 + wc * 32 + 8 * fq;
                    const v4u g2 = *(const GAS v4u*)(GM + (size_t)row * 2048 + 1024 + col);
                    const unsigned w2[4] = {g2.x, g2.y, g2.z, g2.w};
                    float r[8];
#pragma unroll
                    for (int n = 0; n < 2; ++n)
#pragma unroll
                        for (int i = 0; i < 4; ++i) { const unsigned b = w2[2 * n + (i >> 1)];
                            r[4 * n + i] = acc[ai][bj][m][n][i] * fmaxf((i & 1) ? bfhi(b) : bflo(b), 9.5367431640625e-07f); }
                    v4u o; o.x = pkh(r[0], r[1]); o.y = pkh(r[2], r[3]); o.z = pkh(r[4], r[5]); o.w = pkh(r[6], r[7]);
                    *(GAS v4u*)(MIX + (size_t)row * 1024 + col) = o; }
            }
    }
};
struct EpiRes {
    static constexpr bool PERM = true, AFTER_DRAIN = false, MID = false;
    const float* x; bf16* x1; const float* ada; int gate_idx;
    __device__ __forceinline__ void operator()(const pg8::f32x4 (&acc)[2][2][4][2], const pg8::Unit& u, int wr, int wc, int fr, int fq) const {
#pragma unroll
        for (int ai = 0; ai < 2; ++ai)
#pragma unroll
            for (int m = 0; m < 4; ++m) {
                const int row = u.pm * 256 + ai * 128 + wr * 64 + m * 16 + fr, b = row >> 12;
#pragma unroll
                for (int bj = 0; bj < 2; ++bj) {
                    const int col = u.pn * 256 + bj * 128 + wc * 32 + 8 * fq;
                    const float* gp = ada + (size_t)b * 6 * D + gate_idx * D + col; const float* xp = x + (size_t)row * D + col;
                    const f32x4 g0 = *(const GAS f32x4*)gp, g1 = *(const GAS f32x4*)(gp + 4), x0 = *(const GAS f32x4*)xp, x1v = *(const GAS f32x4*)(xp + 4);
                    const f32x4 r0 = x0 + g0 * acc[ai][bj][m][0], r1 = x1v + g1 * acc[ai][bj][m][1];
                    v4u o; o.x = pkh(r0.x, r0.y); o.y = pkh(r0.z, r0.w); o.z = pkh(r1.x, r1.y); o.w = pkh(r1.z, r1.w);
                    *(GAS v4u*)(x1 + (size_t)row * D + col) = o; }
            }
    }
};

template <int W> __device__ __forceinline__ void pool_load(const bf16* zp, int row, int t, int col, v4u (&z)[W]) {
#pragma unroll
    for (int j = 0; j < W; ++j) z[j] = (j <= t) ? *(const GAS v4u*)(zp + (size_t)(row - j) * 512 + col) : (v4u){0u, 0u, 0u, 0u};
}
template <int W> __device__ __forceinline__ v4u pool_reduce(const v4u (&z)[W], int t) {
    float s[8], self[8];
#pragma unroll
    for (int e = 0; e < 8; ++e) { s[e] = 0.f; self[e] = 0.f; }
#pragma unroll
    for (int j = 0; j < W; ++j) { const float f[8] = {bflo(z[j].x), bfhi(z[j].x), bflo(z[j].y), bfhi(z[j].y), bflo(z[j].z), bfhi(z[j].z), bflo(z[j].w), bfhi(z[j].w)};
#pragma unroll
        for (int e = 0; e < 8; ++e) { s[e] += f[e]; if (j == 0) self[e] = f[e]; } }
    const float inv = 1.0f / (float)((t + 1 < W) ? (t + 1) : W);
    v4u o; o.x = pk2(s[0] * inv - self[0], s[1] * inv - self[1]); o.y = pk2(s[2] * inv - self[2], s[3] * inv - self[3]);
    o.z = pk2(s[4] * inv - self[4], s[5] * inv - self[5]); o.w = pk2(s[6] * inv - self[6], s[7] * inv - self[7]);
    return o;
}
__device__ __forceinline__ void pool_phase(Frame& F) {
    const bf16* zp = (const bf16*)(F.ws + WS_ZP); bf16* pl = (bf16*)(F.ws + WS_PL);
    const int gw = F.bid * NWAVES + F.wave, NGW = F.G * NWAVES;
    for (int r4 = gw; r4 < M / 4; r4 += NGW) {
        const int row = 4 * r4 + (F.lane >> 4), t = row & 4095, c0 = 8 * (F.lane & 15);
        v4u z2[2], z4[4], z8[8], z16[16];
        pool_load<2>(zp, row, t, c0, z2); pool_load<4>(zp, row, t, 128 + c0, z4); pool_load<8>(zp, row, t, 256 + c0, z8); pool_load<16>(zp, row, t, 384 + c0, z16);
        const v4u o2 = pool_reduce<2>(z2, t), o4 = pool_reduce<4>(z4, t), o8 = pool_reduce<8>(z8, t), o16 = pool_reduce<16>(z16, t);
        GAS v4u* dst = (GAS v4u*)(pl + (size_t)row * 1024 + c0);
        dst[0] = o2; dst[16] = o4; dst[32] = o8; dst[48] = o16;
    }
}

typedef int v4i __attribute__((ext_vector_type(4)));
struct EpiStoreBf16 {
    static constexpr bool PERM = true, AFTER_DRAIN = false, MID = false;
    bf16* O; int ldc;
    __device__ __forceinline__ void operator()(const pg8::f32x4 (&acc)[2][2][4][2], const pg8::Unit& u, int wr, int wc, int fr, int fq) const {
#pragma unroll
        for (int ai = 0; ai < 2; ++ai)
#pragma unroll
            for (int m = 0; m < 4; ++m) {
                const int row = u.pm * 256 + ai * 128 + wr * 64 + m * 16 + fr;
#pragma unroll
                for (int bj = 0; bj < 2; ++bj) {
                    const int col = u.pn * 256 + bj * 128 + wc * 32 + 8 * fq;
                    v4u o; o.x = pkh(acc[ai][bj][m][0][0], acc[ai][bj][m][0][1]); o.y = pkh(acc[ai][bj][m][0][2], acc[ai][bj][m][0][3]);
                    o.z = pkh(acc[ai][bj][m][1][0], acc[ai][bj][m][1][1]); o.w = pkh(acc[ai][bj][m][1][2], acc[ai][bj][m][1][3]);
                    *(GAS v4u*)(O + (size_t)row * ldc + col) = o; }
            }
    }
};

__device__ __forceinline__ unsigned fkey(float f) { const unsigned u = __builtin_bit_cast(unsigned, f); return (u >> 31) ? ~u : (u | 0x80000000u); }
__device__ __forceinline__ float funkey(unsigned k) { const unsigned u = (k >> 31) ? (k & 0x7fffffffu) : ~k; return __builtin_bit_cast(float, u); }
__device__ __forceinline__ unsigned umax_(unsigned a, unsigned b) { return a > b ? a : b; }
__device__ __forceinline__ unsigned umin_(unsigned a, unsigned b) { return a > b ? b : a; }
#define TOP16_INSERT(L, xin) do { unsigned _x = (xin); _Pragma("unroll") for (int _i = 0; _i < 16; ++_i) { const unsigned _h = umax_(L[_i], _x); _x = umin_(L[_i], _x); L[_i] = _h; } } while (0)
template <int MASK> __device__ __forceinline__ void top16_merge(unsigned (&L)[16]) {
    unsigned o[16];
#pragma unroll
    for (int i = 0; i < 16; ++i) o[i] = (unsigned)dppi<MASK == 1 ? DPP_XOR1 : DPP_XOR2>((int)L[i]);
#pragma unroll
    for (int i = 0; i < 16; ++i) L[i] = umax_(L[i], o[15 - i]);
#pragma unroll
    for (int d = 8; d >= 1; d >>= 1)
#pragma unroll
        for (int i = 0; i < 16; ++i) if ((i & d) == 0) { const unsigned hi = umax_(L[i], L[i + d]), lo = umin_(L[i], L[i + d]); L[i] = hi; L[i + d] = lo; }
}
#define CE_DESC(a_, b_) do { const unsigned _h = umax_(a_, b_), _l = umin_(a_, b_); a_ = _h; b_ = _l; } while (0)
template <int OFF> __device__ __forceinline__ void bitonic_sort16_desc(unsigned (&v)[32]) {
#pragma unroll
    for (int k = 2; k <= 16; k <<= 1)
#pragma unroll
        for (int j = k >> 1; j > 0; j >>= 1)
#pragma unroll
            for (int i = 0; i < 16; ++i) { const int l = i ^ j; if (l > i) { if ((i & k) == 0) CE_DESC(v[OFF + i], v[OFF + l]); else CE_DESC(v[OFF + l], v[OFF + i]); } }
}
__device__ __forceinline__ void bitonic_merge16_desc(unsigned (&L)[16]) {
#pragma unroll
    for (int d = 8; d >= 1; d >>= 1)
#pragma unroll
        for (int i = 0; i < 16; ++i) if ((i & d) == 0) CE_DESC(L[i], L[i + d]);
}
constexpr int SST = 132;
constexpr int P9_LIST_OFF = 2 * 64 * SST * 4;
__device__ __forceinline__ void peer_select_phase(Frame& F) {
    const bf16* QV = (const bf16*)(F.ws + WS_QV); const bf16* SK = (const bf16*)(F.ws + WS_SUBK);
    int* EID = (int*)(F.ws + WS_EID); float* GW = (float*)(F.ws + WS_GW);
    LAS float* S = (LAS float*)(F.lds);
    LAS unsigned* LIST = (LAS unsigned*)(F.lds + P9_LIST_OFF);
    const int lane = F.lane, w = F.wave, l15 = lane & 15, lq = lane >> 4;
    const int p = w >> 2, kb = w & 3;
    constexpr int NU = (M / 64) * PH;
    bf16x8 a[4][4], bq[2][4];
#define P9_LOAD(u_) do { const int _tt = (u_) >> 3, _h = (u_) & 7; \
        const bf16* qa = QV + (size_t)(_tt * 64 + l15) * PQW + _h * 256 + p * 128 + 8 * lq; \
        const bf16* kbp = SK + (size_t)((_h * 2 + p) * 128 + 32 * kb + l15) * 128 + 8 * lq; \
        _Pragma("unroll") for (int ks = 0; ks < 4; ++ks) { \
            _Pragma("unroll") for (int rb = 0; rb < 4; ++rb) a[rb][ks] = *(const GAS bf16x8*)(qa + (size_t)(16 * rb) * PQW + 32 * ks); \
            _Pragma("unroll") for (int cb = 0; cb < 2; ++cb) bq[cb][ks] = *(const GAS bf16x8*)(kbp + (size_t)(16 * cb) * 128 + 32 * ks); } } while (0)
    if (F.bid < NU) P9_LOAD(F.bid);
    for (int u = F.bid; u < NU; u += F.G) {
        const int tt = u >> 3, h = u & 7, tok0 = tt * 64;
        {
            pg8::f32x4 acc[4][2];
#pragma unroll
            for (int rb = 0; rb < 4; ++rb)
#pragma unroll
                for (int cb = 0; cb < 2; ++cb) acc[rb][cb] = (pg8::f32x4){0.f, 0.f, 0.f, 0.f};
#pragma unroll
            for (int ks = 0; ks < 4; ++ks)
#pragma unroll
                for (int rb = 0; rb < 4; ++rb)
#pragma unroll
                    for (int cb = 0; cb < 2; ++cb) acc[rb][cb] = __builtin_amdgcn_mfma_f32_16x16x32_bf16(a[rb][ks], bq[cb][ks], acc[rb][cb], 0, 0, 0);
#pragma unroll
            for (int rb = 0; rb < 4; ++rb)
#pragma unroll
                for (int cb = 0; cb < 2; ++cb)
#pragma unroll
                    for (int r = 0; r < 4; ++r) S[(p * 64 + 16 * rb + 4 * lq + r) * SST + 32 * kb + 16 * cb + l15] = acc[rb][cb][r];
        }
        __syncthreads();
        if (u + F.G < NU) P9_LOAD(u + F.G);
        {
            const int row = F.tid >> 2, sub = F.tid & 3;
            const LAS float* sr = S + row * SST + sub;
            unsigned kv[32];
#pragma unroll
            for (int i = 0; i < 32; ++i) kv[i] = (fkey(sr[4 * i]) & ~127u) | (unsigned)(4 * i + sub);
            bitonic_sort16_desc<0>(kv); bitonic_sort16_desc<16>(kv);
            unsigned L[16];
#pragma unroll
            for (int i = 0; i < 16; ++i) L[i] = umax_(kv[i], kv[31 - i]);
            bitonic_merge16_desc(L);
            top16_merge<1>(L); top16_merge<2>(L);
            if (sub == 0) {
#pragma unroll
                for (int i = 0; i < 4; ++i) *(LAS v4u*)(LIST + row * 16 + 4 * i) = (v4u){L[4 * i], L[4 * i + 1], L[4 * i + 2], L[4 * i + 3]}; }
        }
        __syncthreads();
        if (F.tid < 256) {
            const int tok = F.tid >> 2, sub = F.tid & 3;
            float va[16], vb[16];
#pragma unroll
            for (int i = 0; i < 4; ++i) { const v4u x = *(const LAS v4u*)(LIST + tok * 16 + 4 * i), y = *(const LAS v4u*)(LIST + (64 + tok) * 16 + 4 * i);
                va[4 * i] = funkey(x.x & ~127u); va[4 * i + 1] = funkey(x.y & ~127u); va[4 * i + 2] = funkey(x.z & ~127u); va[4 * i + 3] = funkey(x.w & ~127u);
                vb[4 * i] = funkey(y.x & ~127u); vb[4 * i + 1] = funkey(y.y & ~127u); vb[4 * i + 2] = funkey(y.z & ~127u); vb[4 * i + 3] = funkey(y.w & ~127u); }
            unsigned cand[32];
#pragma unroll
            for (int i = 0; i < 32; ++i) cand[i] = 0u;
            {
                constexpr int NC = 50;
                constexpr unsigned char CI[52] = {0,0,0,0,0,0,0,0,0,0,0,0,0,0,0,0, 1,1,1,1,1,1,1,1, 2,2,2,2,2, 3,3,3,3, 4,4,4, 5,5, 6,6, 7,7, 8,9,10,11,12,13,14,15, 0,0};
                constexpr unsigned char CJ[52] = {0,1,2,3,4,5,6,7,8,9,10,11,12,13,14,15, 0,1,2,3,4,5,6,7, 0,1,2,3,4, 0,1,2,3, 0,1,2, 0,1, 0,1, 0,1, 0,0,0,0,0,0,0,0, 0,0};
#pragma unroll
                for (int g4 = 0; g4 < 13; ++g4) {
                    float sa = 0.f, sb = 0.f; unsigned id = 0u; bool ok = false;
#pragma unroll
                    for (int q = 0; q < 4; ++q) { const int n = 4 * g4 + q; if (n < NC) { const bool me = (sub == q); sa = me ? va[CI[n]] : sa; sb = me ? vb[CJ[n]] : sb; id = me ? (unsigned)(CI[n] * 16 + CJ[n]) : id; ok = ok || me; } }
                    cand[g4] = ok ? ((fkey(sa + sb) & ~255u) | id) : 0u;
                }
            }
            bitonic_sort16_desc<0>(cand);
            unsigned L[16];
#pragma unroll
            for (int i = 0; i < 16; ++i) L[i] = cand[i];
            top16_merge<1>(L); top16_merge<2>(L);
            const float mx = funkey(L[0] & ~255u);
            float e[16], sum = 0.f;
#pragma unroll
            for (int k = 0; k < 16; ++k) { e[k] = __expf(funkey(L[k] & ~255u) - mx); sum += e[k]; }
            const float inv = 1.0f / sum;
            const size_t ob = (size_t)(tok0 + tok) * 128;
#pragma unroll
            for (int k4 = 0; k4 < 4; ++k4) if (sub == k4) {
#pragma unroll
                for (int q = 0; q < 4; ++q) { const unsigned cid = L[4 * k4 + q] & 255u;
                    const unsigned ia = LIST[tok * 16 + (cid >> 4)] & 127u, ib = LIST[(64 + tok) * 16 + (cid & 15u)] & 127u;
                    const int slot = h * 16 + 4 * k4 + q;
                    EID[ob + slot] = (int)(ia * 128u + ib); GW[ob + slot] = e[4 * k4 + q] * inv; }
            }
        }
        __syncthreads();
    }
#undef P9_LOAD
}

__device__ __forceinline__ void unpack8(const v4u w, float (&f)[8]) { f[0] = bflo(w.x); f[1] = bfhi(w.x); f[2] = bflo(w.y); f[3] = bfhi(w.y); f[4] = bflo(w.z); f[5] = bfhi(w.z); f[6] = bflo(w.w); f[7] = bfhi(w.w); }
typedef float f32x2 __attribute__((ext_vector_type(2)));
__device__ __forceinline__ void unpack16_fp8(const v4u w, float (&f)[16]) {
    const unsigned ww[4] = {w.x, w.y, w.z, w.w};
#pragma unroll
    for (int d = 0; d < 4; ++d) { const f32x2 a = __builtin_amdgcn_cvt_pk_f32_fp8((int)ww[d], false), b = __builtin_amdgcn_cvt_pk_f32_fp8((int)ww[d], true);
        f[4 * d] = a.x; f[4 * d + 1] = a.y; f[4 * d + 2] = b.x; f[4 * d + 3] = b.y; }
}
template <int PV_> __device__ __forceinline__ void peer_dot_phase(Frame& F) {
    const unsigned char* H8 = F.ws + WS_H8; const int* EID = (const int*)(F.ws + WS_EID); float* PART = (float*)(F.ws + WS_PART);
    const int lane = F.lane, g = lane >> 3, j = lane & 7, x = F.bid & 7;
    const int nbx = (F.G - x + 7) >> 3, NW = nbx * NWAVES, gwv = (F.bid >> 3) * NWAVES + F.wave;
    const unsigned char* US = F.ws + WS_UB + (size_t)x * NEXP * 128; const unsigned j16 = 16u * (unsigned)j;
    int token = gwv;
    if (token >= M) return;
    const int lasttok = gwv + ((M - 1 - gwv) / NW) * NW;
    v4i eA[4], eB[4]; v4i hA, hB;
#define PD_CL(t_) ((t_) < M ? (t_) : lasttok)
#define PD_LOAD_E(e_, tok_) do { _Pragma("unroll") for (int q = 0; q < 4; ++q) e_[q] = *(const GAS v4i*)(EID + (size_t)(tok_) * 128 + 16 * g + 4 * q); } while (0)
#define PD_ISSUE4(buf_, e_, b0_) do { buf_[b0_] = *(const GAS v4i*)(US + ((unsigned)e_.x * 128u + j16)); buf_[b0_ + 1] = *(const GAS v4i*)(US + ((unsigned)e_.y * 128u + j16)); \
        buf_[b0_ + 2] = *(const GAS v4i*)(US + ((unsigned)e_.z * 128u + j16)); buf_[b0_ + 3] = *(const GAS v4i*)(US + ((unsigned)e_.w * 128u + j16)); } while (0)
#define PD_DOT1(w_, hc_, dst_) do { int t = __builtin_amdgcn_sdot4(w_.x, hc_.x, 0, false); t = __builtin_amdgcn_sdot4(w_.y, hc_.y, t, false); t = __builtin_amdgcn_sdot4(w_.z, hc_.z, t, false); t = __builtin_amdgcn_sdot4(w_.w, hc_.w, t, false); \
        t += dppi<DPP_XOR1>(t); t += dppi<DPP_XOR2>(t); t += dppi<DPP_HMIR>(t); dst_ = (float)t; } while (0)
#define PD_BODY(eC, eN, hC, hN, tok_) do { const int tk_ = PD_CL(tok_); \
        PD_ISSUE4(bB, eC[2], 0); PD_ISSUE4(bB, eC[3], 4); \
        PD_LOAD_E(eC, PD_CL(tk_ + 2 * NW)); \
        hN = *(const GAS v4i*)(H8 + (size_t)PD_CL(tk_ + NW) * D + 128 * x + j16); \
        float s[16]; \
        _Pragma("unroll") for (int i = 0; i < 8; ++i) PD_DOT1(bA[i], hC, s[i]); \
        PD_ISSUE4(bA, eN[0], 0); PD_ISSUE4(bA, eN[1], 4); \
        _Pragma("unroll") for (int i = 0; i < 8; ++i) PD_DOT1(bB[i], hC, s[8 + i]); \
        { float* pp = PART + ((size_t)x * M + tk_) * 128 + g * 16;       \
          _Pragma("unroll") for (int i4 = 0; i4 < 4; ++i4) *(GAS f32x4*)(pp + 4 * i4) = (f32x4){s[4 * i4], s[4 * i4 + 1], s[4 * i4 + 2], s[4 * i4 + 3]}; } } while (0)
    PD_LOAD_E(eA, token); hA = *(const GAS v4i*)(H8 + (size_t)token * D + 128 * x + j16);
    PD_LOAD_E(eB, PD_CL(token + NW));
    v4i bA[8], bB[8];
    PD_ISSUE4(bA, eA[0], 0); PD_ISSUE4(bA, eA[1], 4);
    __builtin_amdgcn_s_waitcnt(0x0F70);
    for (; token < M; token += 2 * NW) {
        PD_BODY(eA, eB, hA, hB, token);
        PD_BODY(eB, eA, hB, hA, token + NW);
    }
#undef PD_BODY
#undef PD_CL
#undef PD_LOAD_E
#undef PD_ISSUE4
#undef PD_DOT1
}
template <int NTOK> __device__ __forceinline__ void peer_loadrate_probe(Frame& F) {
    const int* EID = (const int*)(F.ws + WS_EID);
    const int lane = F.lane, g = lane >> 3, j = lane & 7, x = F.bid & 7;
    const int nbx = (F.G - x + 7) >> 3, NW = nbx * NWAVES, gwv = (F.bid >> 3) * NWAVES + F.wave;
    const unsigned char* US = F.ws + WS_UB + (size_t)x * NEXP * 128; const unsigned j16 = 16u * (unsigned)j;
    unsigned acc = 0u;
    for (int token = gwv; token + (NTOK - 1) * NW < M; token += NTOK * NW) {
        v4i e4[NTOK][4];
#pragma unroll
        for (int t = 0; t < NTOK; ++t)
#pragma unroll
            for (int q = 0; q < 4; ++q) e4[t][q] = *(const GAS v4i*)(EID + (size_t)(token + t * NW) * 128 + 16 * g + 4 * q);
        v4i b[NTOK][16];
#pragma unroll
        for (int t = 0; t < NTOK; ++t)
#pragma unroll
            for (int q = 0; q < 4; ++q) { b[t][4 * q] = *(const GAS v4i*)(US + ((unsigned)e4[t][q].x * 128u + j16)); b[t][4 * q + 1] = *(const GAS v4i*)(US + ((unsigned)e4[t][q].y * 128u + j16));
                b[t][4 * q + 2] = *(const GAS v4i*)(US + ((unsigned)e4[t][q].z * 128u + j16)); b[t][4 * q + 3] = *(const GAS v4i*)(US + ((unsigned)e4[t][q].w * 128u + j16)); }
#pragma unroll
        for (int t = 0; t < NTOK; ++t)
#pragma unroll
            for (int i = 0; i < 16; ++i) acc ^= (unsigned)(b[t][i].x ^ b[t][i].y ^ b[t][i].z ^ b[t][i].w);
    }
    asm volatile("" :: "v"(acc));
}
__device__ __forceinline__ void peer_coef_phase(Frame& F) {
    const float* PART = (const float*)(F.ws + WS_PART); const int* EID = (const int*)(F.ws + WS_EID); const float* GW = (const float*)(F.ws + WS_GW);
    const float* SCU = (const float*)(F.ws + WS_SCLU); const float* SCV = (const float*)(F.ws + WS_SCLV); const float* HS = (const float*)(F.ws + WS_HS);
    unsigned* CF8 = (unsigned*)(F.ws + WS_CF); float* CFS = (float*)(F.ws + WS_CFS);
    const size_t gtid = (size_t)F.bid * NTHREADS + F.tid, gthreads = (size_t)F.G * NTHREADS, n4 = (size_t)M * 128 / 4;
    for (size_t i4 = gtid; i4 < n4; i4 += gthreads) {
        f32x4 d = *(const GAS f32x4*)(PART + 4 * i4);
#pragma unroll
        for (int xx = 1; xx < 8; ++xx) d = d + *(const GAS f32x4*)(PART + (size_t)xx * M * 128 + 4 * i4);
        const v4i e = *(const GAS v4i*)(EID + 4 * i4); const f32x4 gw = *(const GAS f32x4*)(GW + 4 * i4);
        const float hs = HS[i4 >> 5];
        f32x4 r; r.x = gw.x * SCV[e.x] * gelu_tanh_safe(d.x * (SCU[e.x] * hs)); r.y = gw.y * SCV[e.y] * gelu_tanh_safe(d.y * (SCU[e.y] * hs));
        r.z = gw.z * SCV[e.z] * gelu_tanh_safe(d.z * (SCU[e.z] * hs)); r.w = gw.w * SCV[e.w] * gelu_tanh_safe(d.w * (SCU[e.w] * hs));
        float m = fmaxf(fmaxf(fabsf(r.x), fabsf(r.y)), fmaxf(fabsf(r.z), fabsf(r.w)));
        m = fmaxf(m, dppf<DPP_XOR1>(m)); m = fmaxf(m, dppf<DPP_XOR2>(m)); m = fmaxf(m, dppf<DPP_HMIR>(m)); m = fmaxf(m, dppf<DPP_ROR8>(m)); m = max_xor16(m);
        const unsigned E = (__builtin_bit_cast(unsigned, m) >> 23) & 0xffu; float sc = 1.f, isc = 1.f;
        if (E >= 8u && E <= 250u) { sc = __builtin_bit_cast(float, (261u - E) << 23); isc = __builtin_bit_cast(float, (E - 7u) << 23); }
        int t = __builtin_amdgcn_cvt_pk_fp8_f32(r.x * sc, r.y * sc, 0, false); t = __builtin_amdgcn_cvt_pk_fp8_f32(r.z * sc, r.w * sc, t, true);
        CF8[i4] = (unsigned)t;
        if ((F.lane & 31) == 0) CFS[i4 >> 5] = isc; }
}
template <bool DRY, bool CHECK = false> __device__ __forceinline__ void peer_out_phase(Frame& F, const float* ada, float* out) {
    const int* EID = (const int*)(F.ws + WS_EID); const unsigned char* CF8 = (const unsigned char*)(F.ws + WS_CF); const float* CFS = (const float*)(F.ws + WS_CFS);
    const int lane = F.lane, g = lane >> 3, j = lane & 7, x = F.bid & 7;
    const int nbx = (F.G - x + 7) >> 3, NW = nbx * NWAVES, gwv = (F.bid >> 3) * NWAVES + F.wave;
    const unsigned char* VS = F.ws + WS_VB + (size_t)x * NEXP * 128; const unsigned j16 = 16u * (unsigned)j;
    if (gwv >= M) return;
    const int ntok = (M - 1 - gwv) / NW + 1;
#define PO_ISSUE4(buf_, e_, b0_) do { buf_[b0_] = *(const GAS v4u*)(VS + ((unsigned)e_.x * 128u + j16)); buf_[b0_ + 1] = *(const GAS v4u*)(VS + ((unsigned)e_.y * 128u + j16)); \
        buf_[b0_ + 2] = *(const GAS v4u*)(VS + ((unsigned)e_.z * 128u + j16)); buf_[b0_ + 3] = *(const GAS v4u*)(VS + ((unsigned)e_.w * 128u + j16)); } while (0)
#define PO_ROW(w_, c_) do { float f[16]; unpack16_fp8(w_, f); _Pragma("unroll") for (int k = 0; k < 16; ++k) o[k] += (c_) * f[k]; } while (0)
#define PO_ACC4(buf_, c4_, b0_) do { PO_ROW(buf_[b0_], c4_.x); PO_ROW(buf_[b0_ + 1], c4_.y); PO_ROW(buf_[b0_ + 2], c4_.z); PO_ROW(buf_[b0_ + 3], c4_.w); } while (0)
    v4i e4[4]; f32x4 c4[4]; v4u bA[8], bB[8];
#define PO_LOADC(tok_) do { const float cs_ = CFS[tok_]; _Pragma("unroll") for (int q = 0; q < 4; ++q) { const unsigned w_ = *(const GAS unsigned*)(CF8 + (size_t)(tok_) * 128 + g * 16 + 4 * q); \
        const f32x2 lo_ = __builtin_amdgcn_cvt_pk_f32_fp8((int)w_, false), hi_ = __builtin_amdgcn_cvt_pk_f32_fp8((int)w_, true); c4[q] = (f32x4){lo_.x * cs_, lo_.y * cs_, hi_.x * cs_, hi_.y * cs_}; } } while (0)
#pragma unroll
    for (int q = 0; q < 4; ++q) e4[q] = *(const GAS v4i*)(EID + (size_t)gwv * 128 + g * 16 + 4 * q);
    PO_LOADC(gwv);
    PO_ISSUE4(bA, e4[0], 0); PO_ISSUE4(bA, e4[1], 4);
    for (int it = 0; it < ntok; ++it) {
        const int token = gwv + it * NW, tn = gwv + (it + 1 < ntok ? it + 1 : it) * NW;
        PO_ISSUE4(bB, e4[2], 0); PO_ISSUE4(bB, e4[3], 4);
#pragma unroll
        for (int q = 0; q < 4; ++q) e4[q] = *(const GAS v4i*)(EID + (size_t)tn * 128 + g * 16 + 4 * q);
        float o[16];
#pragma unroll
        for (int k = 0; k < 16; ++k) o[k] = 0.f;
        PO_ACC4(bA, c4[0], 0); PO_ACC4(bA, c4[1], 4);
        PO_ISSUE4(bA, e4[0], 0); PO_ISSUE4(bA, e4[1], 4);
        PO_ACC4(bB, c4[2], 0); PO_ACC4(bB, c4[3], 4);
        PO_LOADC(tn);
#pragma unroll
        for (int k = 0; k < 16; ++k) { float t = o[k]; t += dppf<DPP_ROR8>(t); o[k] = sum_xor32(sum_xor16(t)); }
        if (g == 0) { const int b = token >> 12;
            const float* gt = ada + (size_t)b * 6 * D + 5 * D + 128 * x + 16 * j;
            float* xo = out + (size_t)token * D + 128 * x + 16 * j;
#pragma unroll
            for (int q = 0; q < 4; ++q) { const f32x4 xv = *(const GAS f32x4*)(xo + 4 * q), gv = *(const GAS f32x4*)(gt + 4 * q);
                f32x4 res = xv + gv * (f32x4){o[4 * q], o[4 * q + 1], o[4 * q + 2], o[4 * q + 3]};
                if (CHECK) { const f32x4 mf = *(const GAS f32x4*)((const float*)(F.ws + WS_PART) + (size_t)token * D + 128 * x + 16 * j + 4 * q);
                    const float rr[4] = {o[4 * q], o[4 * q + 1], o[4 * q + 2], o[4 * q + 3]}, mm[4] = {mf.x, mf.y, mf.z, mf.w}; bool bad = false;
#pragma unroll
                    for (int z = 0; z < 4; ++z) bad = bad || !(fabsf(rr[z] - mm[z]) <= 0.01f * fabsf(rr[z]) + 1.0e-3f);
                    if (bad) res.x = 1.0e9f; }
                if (DRY) { asm volatile("" :: "v"(res.x), "v"(res.y), "v"(res.z), "v"(res.w)); } else *(GAS f32x4*)(xo + 4 * q) = res; } }
    }
#undef PO_LOADC
#undef PO_ISSUE4
#undef PO_ROW
#undef PO_ACC4
}

constexpr int PO_TILE = 64 * 144;
template <int MODE> __device__ __forceinline__ void peer_out_mfma_phase(Frame& F, const float* ada, float* out) {
    const int* EID = (const int*)(F.ws + WS_EID); const unsigned char* CF8 = (const unsigned char*)(F.ws + WS_CF); const float* CFS = (const float*)(F.ws + WS_CFS);
    const int lane = F.lane, g = lane >> 3, j = lane & 7, l15 = lane & 15, lq = lane >> 4, x = F.bid & 7;
    const int nbx = (F.G - x + 7) >> 3, NW = nbx * NWAVES, gwv = (F.bid >> 3) * NWAVES + F.wave;
    const unsigned char* VS = F.ws + WS_VB + (size_t)x * NEXP * 128; const unsigned j16 = 16u * (unsigned)j;
    LAS unsigned char* TL = F.lds + F.wave * PO_TILE;
    if (gwv >= M) return;
    const int nst = 2 * ((M - 1 - gwv) / NW + 1);
    const int trow = l15 >> 1, tcol = 8 * (l15 & 1);
#define PM_IDS(e_, a_, tok_) do { const size_t base = (size_t)(tok_) * 128; \
        _Pragma("unroll") for (int m = 0; m < 16; ++m) e_[m] = EID[base + 8 * m + g]; \
        _Pragma("unroll") for (int q = 0; q < 4; ++q) a_[q] = *(const GAS long*)(CF8 + base + 32 * q + 8 * lq); } while (0)
#define PM_GATHER(vv_, e_, h_) do { _Pragma("unroll") for (int m = 0; m < 8; ++m) vv_[m] = *(const GAS v4u*)(VS + ((unsigned)e_[8 * (h_) + m] * 128u + j16)); } while (0)
#define PM_HALF(vv_, aq0_, aq1_) do { _Pragma("unroll") for (int m = 0; m < 8; ++m) *(LAS v4u*)(TL + (8 * m + g) * 144 + 16 * j) = vv_[m]; } while (0)
#define PM_MMA(aq0_, aq1_) do { LDS_WAIT(); asm volatile("" ::: "memory"); \
        _Pragma("unroll") for (int ks = 0; ks < 2; ++ks) _Pragma("unroll") for (int cb = 0; cb < 8; ++cb) { \
            const v2i bb = __builtin_amdgcn_ds_read_tr8_b64_v2i32((LAS v2i*)(TL + (32 * ks + 8 * lq + trow) * 144 + 16 * cb + tcol)); \
            acc[cb] = __builtin_amdgcn_mfma_f32_16x16x32_fp8_fp8(ks ? (aq1_) : (aq0_), __builtin_bit_cast(long, bb), acc[cb], 0, 0, 0); } \
        LDS_WAIT(); asm volatile("" ::: "memory"); } while (0)
    const int ntok = nst >> 1;
    int e1[16], e2[16]; long a0[4], a1[4], a2[4]; v4u vvA[8], vvB[8];
    PM_IDS(e1, a0, gwv);
    PM_GATHER(vvA, e1, 0); PM_GATHER(vvB, e1, 1);
    { const int t1 = ntok > 1 ? 1 : 0; PM_IDS(e1, a1, gwv + t1 * NW); }
    f32x4 acc[8];
    for (int it = 0; it < ntok; ++it) {
        const int token = gwv + it * NW;
        { const int t2 = it + 2 < ntok ? it + 2 : ntok - 1; PM_IDS(e2, a2, gwv + t2 * NW); }
#pragma unroll
        for (int cb = 0; cb < 8; ++cb) acc[cb] = (f32x4){0.f, 0.f, 0.f, 0.f};
        float xv[8], gv[8]; float cs;
        { const int b = token >> 12; const float* gt = ada + (size_t)b * 6 * D + 5 * D + 128 * x + l15; const bf16* xi = (const bf16*)(F.ws + WS_X1) + (size_t)token * D + 128 * x + l15;
          cs = CFS[token];
#pragma unroll
          for (int cb = 0; cb < 8; ++cb) { xv[cb] = bflo((unsigned)xi[16 * cb]); gv[cb] = gt[16 * cb]; } }
        PM_HALF(vvA, 0, 0); PM_GATHER(vvA, e1, 0); PM_MMA(a0[0], a0[1]);
        PM_HALF(vvB, 0, 0); PM_GATHER(vvB, e1, 1); PM_MMA(a0[2], a0[3]);
        if (lq == 0) {
            if (MODE == 1) { float* oc = (float*)(F.ws + WS_PART) + (size_t)token * D + 128 * x + l15;
#pragma unroll
                for (int cb = 0; cb < 8; ++cb) oc[16 * cb] = acc[cb][0] * cs; }
            else { float* xo = out + (size_t)token * D + 128 * x + l15;
#pragma unroll
                for (int cb = 0; cb < 8; ++cb) xo[16 * cb] = xv[cb] + gv[cb] * (acc[cb][0] * cs); }
        }
#pragma unroll
        for (int m = 0; m < 16; ++m) e1[m] = e2[m];
#pragma unroll
        for (int q = 0; q < 4; ++q) { a0[q] = a1[q]; a1[q] = a2[q]; }
    }
#undef PM_HALF
#undef PM_MMA
#undef PM_IDS
#undef PM_GATHER
}

__device__ __forceinline__ void compress_phase(Frame& F, const float* kng) {
    LAS bf16* H2 = (LAS bf16*)(F.lds);
    LAS float* OUTS = (LAS float*)(F.lds + 16384);
    const int lane = F.lane, w = F.wave, l15 = lane & 15, lq = lane >> 4;
    for (int u = F.bid; u < NBG * 2 * 8; u += F.G) {
        const int ns = u & 7, kv = (u >> 3) & 1, bg = u >> 4, n0 = ns * 32;
        const bf16* A = (const bf16*)(F.ws + (kv ? WS_VCR : WS_KCR)) + (size_t)bg * SEQ * 64;
        const bf16* W1T = (const bf16*)(F.ws + (kv ? WS_CW1V_T : WS_CW1K_T));
        const bf16* W2T = (const bf16*)(F.ws + (kv ? WS_CW2V_T : WS_CW2K_T));
        const float* b1 = (const float*)(F.ws + (kv ? WS_CB1V : WS_CB1K));
        pg8::f32x4 acc[2][8];
#pragma unroll
        for (int rb = 0; rb < 2; ++rb)
#pragma unroll
            for (int cb = 0; cb < 8; ++cb) acc[rb][cb] = (pg8::f32x4){0.f, 0.f, 0.f, 0.f};
        const bf16* ap = A + (size_t)(n0 + l15) * 1024 + 256 * w + 8 * lq;
        const bf16* bp = W1T + (size_t)l15 * 2048 + 256 * w + 8 * lq;
#pragma unroll
        for (int ks = 0; ks < 8; ++ks) {
            const bf16x8 a0 = *(const GAS bf16x8*)(ap + 32 * ks), a1 = *(const GAS bf16x8*)(ap + 16 * 1024 + 32 * ks);
#pragma unroll
            for (int cb = 0; cb < 8; ++cb) { const bf16x8 b = *(const GAS bf16x8*)(bp + (size_t)(16 * cb) * 2048 + 32 * ks);
                acc[0][cb] = __builtin_amdgcn_mfma_f32_16x16x32_bf16(a0, b, acc[0][cb], 0, 0, 0);
                acc[1][cb] = __builtin_amdgcn_mfma_f32_16x16x32_bf16(a1, b, acc[1][cb], 0, 0, 0); }
        }
        { LAS float* PS = (LAS float*)(F.lds + 32768);
          LAS float* mine = PS + (w & 3) * 4096 + (4 * lq) * 128 + l15;
          if (w >= 4) {
#pragma unroll
              for (int rb = 0; rb < 2; ++rb)
#pragma unroll
                  for (int cb = 0; cb < 8; ++cb)
#pragma unroll
                      for (int r = 0; r < 4; ++r) mine[(16 * rb + r) * 128 + 16 * cb] = acc[rb][cb][r]; }
          __syncthreads();
          if (w < 4) {
#pragma unroll
              for (int rb = 0; rb < 2; ++rb)
#pragma unroll
                  for (int cb = 0; cb < 8; ++cb)
#pragma unroll
                      for (int r = 0; r < 4; ++r) { LAS float* q = mine + (16 * rb + r) * 128 + 16 * cb; *q = acc[rb][cb][r] + *q; } }
          __syncthreads();
#pragma unroll
          for (int i = 0; i < 8; ++i) { const int idx = F.tid + 512 * i, row = idx >> 7, col = idx & 127;
              const float v = ((PS[idx] + PS[4096 + idx]) + (PS[8192 + idx] + PS[12288 + idx])) + b1[col];
              H2[row * 136 + col] = (bf16)f2bf(gelu_tanh_safe(v)); } }
        __syncthreads();
        { const int rb = w >> 2, db = w & 3;
          pg8::f32x4 o = (pg8::f32x4){0.f, 0.f, 0.f, 0.f};
#pragma unroll
          for (int ks = 0; ks < 4; ++ks) {
              const bf16x8 a = *(const LAS bf16x8*)(H2 + (16 * rb + l15) * 136 + 32 * ks + 8 * lq);
              const bf16x8 b = *(const GAS bf16x8*)(W2T + (size_t)(16 * db + l15) * 128 + 32 * ks + 8 * lq);
              o = __builtin_amdgcn_mfma_f32_16x16x32_bf16(a, b, o, 0, 0, 0); }
#pragma unroll
          for (int r = 0; r < 4; ++r) OUTS[(16 * rb + 4 * lq + r) * 65 + 16 * db + l15] = o[r]; }
        __syncthreads();
        { const int n = F.tid >> 4, d4 = (F.tid & 15) * 4, ng = n0 + n;
          float v[4]; float ss = 0.f;
#pragma unroll
          for (int i = 0; i < 4; ++i) { v[i] = OUTS[n * 65 + d4 + i]; ss += v[i] * v[i]; }
          ss += dppf<DPP_XOR1>(ss); ss += dppf<DPP_XOR2>(ss); ss += dppf<DPP_HMIR>(ss); ss += dppf<DPP_ROR8>(ss);
          const bool pad = (ng >= NCMP);
          if (kv == 0) { const float rs = rsqrtf(ss * (1.f / 64.f) + EPS);
              v2u o; o.x = pad ? 0u : pk2(v[0] * rs * kng[d4], v[1] * rs * kng[d4 + 1]); o.y = pad ? 0u : pk2(v[2] * rs * kng[d4 + 2], v[3] * rs * kng[d4 + 3]);
              *(GAS v2u*)((bf16*)(F.ws + WS_KC) + ((size_t)bg * 256 + ng) * 64 + d4) = o; }
          else { bf16* vt = (bf16*)(F.ws + WS_VCT) + (size_t)bg * 64 * 256 + ng;
#pragma unroll
              for (int i = 0; i < 4; ++i) vt[(size_t)(d4 + i) * 256] = pad ? (bf16)0 : (bf16)f2bf(v[i]); } }
        __syncthreads();
    }
}
__device__ __forceinline__ void vtranspose_phase(Frame& F) {
    LAS bf16* T = (LAS bf16*)(F.lds + F.wave * 9216);
    const int gw = F.bid * NWAVES + F.wave, NGW = F.G * NWAVES, lane = F.lane;
    for (int job = gw; job < 2 * NBG * 64; job += NGW) {
        const int s = job & 63, bg = (job >> 6) & 15, which = job >> 10;
        const bf16* X = (const bf16*)(F.ws + (which ? WS_VW : WS_VS)) + ((size_t)bg * SEQ + 64 * s) * 64;
        bf16* XT = (bf16*)(F.ws + (which ? WS_VWT : WS_VST)) + (size_t)bg * 64 * SEQ + 64 * s;
#pragma unroll
        for (int i = 0; i < 8; ++i) { const int tok = (lane >> 3) + 8 * i, ch = lane & 7;
            const v4u x = *(const GAS v4u*)(X + (size_t)tok * 64 + 8 * ch);
            const unsigned ww[4] = {x.x, x.y, x.z, x.w};
#pragma unroll
            for (int e = 0; e < 4; ++e) { T[(8 * ch + 2 * e) * 72 + tok] = (bf16)(ww[e] & 0xffffu); T[(8 * ch + 2 * e + 1) * 72 + tok] = (bf16)(ww[e] >> 16); } }
        LDS_WAIT(); asm volatile("" ::: "memory");
#pragma unroll
        for (int i = 0; i < 8; ++i) { const int dim = (lane >> 3) + 8 * i, ch = lane & 7;
            const v4u y = *(const LAS v4u*)(T + dim * 72 + 8 * ch);
            *(GAS v4u*)(XT + (size_t)dim * SEQ + 8 * ch) = y; }
        LDS_WAIT(); asm volatile("" ::: "memory");
    }
}

constexpr int AT_KBUF = 64 * 128;
constexpr int AT_NBUF = 2;
constexpr int AT_OFF_K = 0, AT_OFF_V = AT_NBUF * AT_KBUF;
constexpr int AT_OFF_IMP1 = 2 * AT_NBUF * AT_KBUF, AT_OFF_IMP2 = AT_OFF_IMP1 + 64 * 65 * 4, AT_OFF_SEL = AT_OFF_IMP2 + 64 * 65 * 4;
constexpr int AT_OFF_LUT = AT_OFF_SEL + 512, AT_OFF_LROW = AT_OFF_LUT + 4 * 128 * 4;
constexpr int AT_OFF_TD = AT_OFF_LROW + 8 * 32 * 4;
constexpr int AT_OFF_OUT = AT_OFF_TD + 96 * 32;
constexpr int AT_OFF_GATL = AT_OFF_OUT + 256 * 144;
constexpr int AT_OFF_TS = AT_OFF_GATL + 64 * 12 * 4;
constexpr int AT_TS_ROW = 65 * 16;
constexpr int AT_LDS_END = AT_OFF_TS + 16 * AT_TS_ROW;
static_assert(AT_LDS_END <= RING_BYTES, "attention LDS");

struct AtTile { const bf16* k; const bf16* vt; int vstride; };
enum { TM_CMP1 = 0, TM_CMP2, TM_SELN, TM_SELF, TM_WINN, TM_WINF, TM_WINE, TM_CMP1F, TM_CMP2F };
__device__ __forceinline__ float fexp2(float x) { return __builtin_amdgcn_exp2f(x); }
template <int TM, int VAR, int RB = 3>
__device__ __forceinline__ void at_tile(const LAS unsigned char* kb_, const LAS unsigned char* vb_, const LAS float* LUTJ, LAS float* IMP1, LAS float* IMP2,
                                        const bf16x8 (&qf)[2][2], pg8::f32x4 (&oacc)[2][4], pg8::f32x4 (&lacc)[2], const LAS float* LINV,
                                        const int (&tok_r_in)[2], const unsigned (&selb)[2], float cfar, int relbase, int idx, int l15_in, int lq_in, const LAS unsigned char* tsw, const LAS unsigned char* tsn) {
    constexpr bool FAR = (TM == TM_SELF || TM == TM_WINF || TM == TM_WINE || TM == TM_CMP1F || TM == TM_CMP2F);
    constexpr bool C1 = (TM == TM_CMP1 || TM == TM_CMP1F), C2 = (TM == TM_CMP2 || TM == TM_CMP2F);
    int l15 = l15_in, lq = lq_in; asm volatile("" : "+v"(l15), "+v"(lq));
    int tok_r[2] = {tok_r_in[0], tok_r_in[1]}; asm volatile("" : "+v"(tok_r[0]), "+v"(tok_r[1]));
    v4u pfr[2][2];
    const LAS unsigned char* tsp[2] = {tsw, tsw};
    if (TM == TM_SELN || TM == TM_WINN) {
#pragma unroll
        for (int rb = 0; rb < 2; ++rb) { const LAS unsigned char* pa = tsw + l15 * AT_TS_ROW + 16 * (2 * lq - rb) - 4 * relbase;
            const LAS unsigned char* pn = tsn + l15 * AT_TS_ROW;
            tsp[rb] = (TM == TM_SELN && !selb[rb]) ? pn : pa; } }
    auto kld = [&](int cb, bf16x8 (&kf)[2], pg8::f32x4 (&cq)[2]) __attribute__((always_inline)) {
        if (TM == TM_SELN || TM == TM_WINN) {
#pragma unroll
            for (int rb = 0; rb < 2; ++rb) cq[rb] = *(const LAS pg8::f32x4*)(tsp[rb] + 16 * (8 * (cb >> 1) + (cb & 1))); }
        if (!(VAR & 64)) {
        const int krow = 8 * (l15 >> 2) + (l15 & 3) + 32 * (cb >> 1) + 4 * (cb & 1), kf_ = ((l15 >> 2) << 1) | ((l15 >> 1) & 1);
#pragma unroll
        for (int ks = 0; ks < 2; ++ks) kf[ks] = *(const LAS bf16x8*)(kb_ + krow * 128 + 16 * ((4 * ks + lq) ^ kf_)); }
    };
    auto qkm = [&](int cb, const bf16x8 (&kf)[2], const pg8::f32x4 (&cq)[2], pg8::f32x4 (&st)[2]) __attribute__((always_inline)) {
        st[0] = FAR ? (pg8::f32x4){cfar, cfar, cfar, cfar} : (pg8::f32x4){0.f, 0.f, 0.f, 0.f}; st[1] = st[0];
        if (TM == TM_SELN || TM == TM_WINN) { st[0] = cq[0]; st[1] = cq[1]; }
        if (TM == TM_SELF) {
#pragma unroll
            for (int rb = 0; rb < 2; ++rb) { const float ci = selb[rb] ? cfar : -1.0e30f; st[rb] = (pg8::f32x4){ci, ci, ci, ci}; } }
        if (!(VAR & 64)) {
#pragma unroll
        for (int ks = 0; ks < 2; ++ks) {
#pragma unroll
            for (int rb = 0; rb < 2; ++rb) if (RB & (1 << rb)) st[rb] = __builtin_amdgcn_mfma_f32_16x16x32_bf16(kf[ks], qf[rb][ks], st[rb], 0, 0, 0); } }
    };
    float linv_[2] = {0.f, 0.f};
    if (C2) { linv_[0] = LINV[l15]; linv_[1] = LINV[16 + l15]; }
    auto prob = [&](int cb, const pg8::f32x4 (&st)[2]) __attribute__((always_inline)) {
#pragma unroll
        for (int rb = 0; rb < 2; ++rb) if (RB & (1 << rb)) {
            const int tokc = tok_r[rb];
            float p[4];
#pragma unroll
            for (int r = 0; r < 4; ++r) {
                const int kl = 32 * (cb >> 1) + 8 * lq + 4 * (cb & 1) + r;
                if (VAR & 16) { p[r] = st[rb][r]; }
                else if (TM == TM_SELF) { p[r] = fexp2(st[rb][r]); }
                else if (TM == TM_WINF || TM == TM_SELN || TM == TM_WINN || TM == TM_CMP1F || TM == TM_CMP2F) { p[r] = fexp2(st[rb][r]); }
                else if (TM == TM_WINE) { const float e = fexp2(st[rb][r]); p[r] = (kl > tokc) ? e : 0.f; }
                else {
                    const int rel = (TM == TM_CMP1 || TM == TM_CMP2) ? (relbase + tokc - 16 * kl) : (relbase + tokc - kl);
                    const bool valid = rel >= 0;
                    const int ri = rel < 0 ? 0 : (rel > 127 ? 127 : rel);
                    const float e = fexp2(st[rb][r] + LUTJ[ri]);
                    p[r] = valid ? e : 0.f; }
            }
            if (C1) { lacc[rb][0] += (p[0] + p[1]) + (p[2] + p[3]); }
            else {
                if (C2) {
#pragma unroll
                    for (int r = 0; r < 4; ++r) p[r] *= linv_[rb];
                    float h0 = p[0], h1 = p[1], h2 = p[2], h3 = p[3];
                    h0 += dppf<DPP_XOR1>(h0); h1 += dppf<DPP_XOR1>(h1); h2 += dppf<DPP_XOR1>(h2); h3 += dppf<DPP_XOR1>(h3);
                    h0 += dppf<DPP_XOR2>(h0); h1 += dppf<DPP_XOR2>(h1); h2 += dppf<DPP_XOR2>(h2); h3 += dppf<DPP_XOR2>(h3);
                    if ((l15 & 3) == 0) { const int sp = 16 * idx + 8 * (cb >> 1) + 2 * lq + (cb & 1);
                        IMP1[tokc * 65 + sp] = (h0 + h1) + (h2 + 0.5f * h3);
                        if (sp + 1 < 64) IMP2[tokc * 65 + sp + 1] = 0.5f * h3; }
                }
                const unsigned lo = pkh(p[0], p[1]), hi = pkh(p[2], p[3]);
                if (cb & 1) { pfr[rb][cb >> 1].z = lo; pfr[rb][cb >> 1].w = hi; } else { pfr[rb][cb >> 1].x = lo; pfr[rb][cb >> 1].y = hi; } }
        }
    };
    auto vld = [&](int ks, v4u (&vv)[4]) __attribute__((always_inline)) {
        if (!C1 && !(VAR & 8)) {
#pragma unroll
            for (int db = 0; db < 4; ++db) vv[db] = *(const LAS v4u*)(vb_ + (16 * db + l15) * 128 + 16 * ((4 * ks + lq) ^ (l15 >> 1))); }
    };
    auto pvm = [&](int ks, const v4u (&vv)[4]) __attribute__((always_inline)) {
        if (!C1 && !(VAR & 8)) {
#pragma unroll
            for (int db = 0; db < 4; ++db) {
#pragma unroll
                for (int rb = 0; rb < 2; ++rb) if (RB & (1 << rb)) oacc[rb][db] = __builtin_amdgcn_mfma_f32_16x16x32_bf16(__builtin_bit_cast(bf16x8, pfr[rb][ks]), __builtin_bit_cast(bf16x8, vv[db]), oacc[rb][db], 0, 0, 0); }
            if (!C2) { const v4u ones = (v4u){0x3F803F80u, 0x3F803F80u, 0x3F803F80u, 0x3F803F80u};
#pragma unroll
                for (int rb = 0; rb < 2; ++rb) if (RB & (1 << rb)) lacc[rb] = __builtin_amdgcn_mfma_f32_16x16x32_bf16(__builtin_bit_cast(bf16x8, pfr[rb][ks]), __builtin_bit_cast(bf16x8, ones), lacc[rb], 0, 0, 0); }
        }
    };
    pg8::f32x4 sA[2], sB[2], cA[2], cB[2]; bf16x8 kA[2], kB[2]; v4u vA[4], vB[4];
#define AT_SB __builtin_amdgcn_sched_barrier(0)
    kld(0, kA, cA); kld(1, kB, cB); AT_SB;
    qkm(0, kA, cA, sA); kld(2, kA, cA); AT_SB;
    qkm(1, kB, cB, sB); kld(3, kB, cB); prob(0, sA); AT_SB;
    qkm(2, kA, cA, sA); vld(0, vA); prob(1, sB); AT_SB;
    qkm(3, kB, cB, sB); pvm(0, vA); vld(1, vB); prob(2, sA); AT_SB;
    prob(3, sB); AT_SB;
    pvm(1, vB);
#undef AT_SB
}

template <int VAR> __device__ __forceinline__ void attention_phase(Frame& F, const Args& args) {
    unsigned char* ws = F.ws;
    const int lane = F.lane, w = F.wave, l15 = lane & 15, lq = lane >> 4, tid = F.tid;
    LAS unsigned char* L = F.lds;
    LAS float* IMP1 = (LAS float*)(L + AT_OFF_IMP1); LAS float* IMP2 = (LAS float*)(L + AT_OFF_IMP2);
    LAS unsigned long long* SELM = (LAS unsigned long long*)(L + AT_OFF_SEL); LAS float* LUT = (LAS float*)(L + AT_OFF_LUT); LAS float* LROW = (LAS float*)(L + AT_OFF_LROW) + w * 32;
    LAS int* TD = (LAS int*)(L + AT_OFF_TD); LAS bf16* OUTL = (LAS bf16*)(L + AT_OFF_OUT) + (32 * w) * 72; LAS float* GATL = (LAS float*)(L + AT_OFF_GATL);
    const bf16* Qg = (const bf16*)(ws + WS_Q); const float* GATE = (const float*)(ws + WS_GATE); bf16* YA = (bf16*)(ws + WS_PL) + 512;
    const int jq = l15 & 3;
    const LAS float* LUTJ = LUT + jq * 128;
    const int nrounds = (F.G == 256) ? 4 : (1024 + F.G - 1) / F.G;
    for (int round = 0; round < nrounds; ++round) {
        const int ui = (F.G == 256) ? ((round & 1) ? ((round >> 1) * 512 + 511 - F.bid) : ((round >> 1) * 512 + F.bid)) : (round * F.G + F.bid);
        if (ui >= 1024) break;
        const int c = 63 - (ui >> 4), bg = ui & 15, b = bg >> 1, g = bg & 1;
        const int m0 = b * SEQ + 64 * c;
        __syncthreads();
        { const float M0 = ((const float*)(ws + WS_BIASL))[8 * 128];
          for (int i = tid; i < 512; i += NTHREADS) LUT[i] = (((const float*)(ws + WS_BIASL))[(4 * g + (i >> 7)) * 128 + (i & 127)] - M0) * 1.4426950408889634f; }
        for (int i = tid; i < 64 * 65; i += NTHREADS) { IMP1[i] = 0.f; IMP2[i] = 0.f; }
        { const float M0 = ((const float*)(ws + WS_BIASL))[8 * 128]; const float* BL = (const float*)(ws + WS_BIASL) + (size_t)(4 * g) * 128;
          for (int i = tid; i < 16 * 63 * 4; i += NTHREADS) { const int r = i & 3, yi = (i >> 2) % 63, row = i / 252, rel = 4 * (47 - yi) + (row >> 2) - r;
              ((LAS float*)(L + AT_OFF_TS + row * AT_TS_ROW))[4 * yi + r] = rel < 0 ? -1.0e30f : (BL[(row & 3) * 128 + (rel > 127 ? 127 : rel)] - M0) * 1.4426950408889634f; } }
        for (int i = tid; i < 64 * 12; i += NTHREADS) GATL[i] = GATE[(size_t)(m0 + i / 12) * 24 + g * 12 + (i % 12)];
        bf16x8 qf[2][2];
#pragma unroll
        for (int rb = 0; rb < 2; ++rb)
#pragma unroll
            for (int ks = 0; ks < 2; ++ks) qf[rb][ks] = *(const GAS bf16x8*)(Qg + (size_t)(m0 + 8 * w + 4 * rb + (l15 >> 2)) * 512 + g * 256 + jq * 64 + 32 * ks + 8 * lq);
        asm volatile("" :: "v"(qf[0][0]), "v"(qf[0][1]), "v"(qf[1][0]), "v"(qf[1][1]));
        const int ncmp = 4 * c + 3, n1 = (ncmp + 63) >> 6, nsel = c + 1, w0 = c >= 8 ? c - 8 : 0, nwin = c - w0 + 1;
        const int ntiles = 2 * n1 + nsel + nwin;
        if (tid < ntiles) { const int i = tid;
            auto kindof = [&](int t, int& kind, int& idx) { if (t < n1) { kind = 0; idx = t; } else if (t < 2 * n1) { kind = 1; idx = t - n1; } else if (t < 2 * n1 + nsel) { kind = 2; idx = t - 2 * n1; } else { kind = 3; idx = w0 + (t - 2 * n1 - nsel); } };
            int kind, idx, kn, in_; kindof(i, kind, idx); kindof(i + 1 < ntiles ? i + 1 : i, kn, in_);
            unsigned ko, vo;
            if (kn < 2) { ko = (unsigned)(WS_KC + ((size_t)bg * 256 * 64 + (size_t)in_ * 4096) * 2); vo = (unsigned)(WS_VCT + ((size_t)bg * 64 * 256 + 64 * in_) * 2); }
            else if (kn == 2) { ko = (unsigned)(WS_KS + ((size_t)bg * SEQ * 64 + (size_t)in_ * 4096) * 2); vo = (unsigned)(WS_VST + ((size_t)bg * 64 * SEQ + 64 * in_) * 2); }
            else { ko = (unsigned)(WS_KW + ((size_t)bg * SEQ * 64 + (size_t)in_ * 4096) * 2); vo = (unsigned)(WS_VWT + ((size_t)bg * 64 * SEQ + 64 * in_) * 2); }
            const int dd = c - idx;
            int mode, relbase;
            if (kind == 0) { relbase = 64 * c - 31 - 1024 * idx; mode = relbase >= 1135 ? TM_CMP1F : TM_CMP1; } else if (kind == 1) { relbase = 64 * c - 31 - 1024 * idx; mode = relbase >= 1135 ? TM_CMP2F : TM_CMP2; }
            else if (kind == 2) { mode = dd <= 2 ? TM_SELN : TM_SELF; relbase = 64 * dd; } else { mode = dd <= 2 ? TM_WINN : (dd == 8 ? TM_WINE : TM_WINF); relbase = 64 * dd; }
            const int endf = ((kind == 1 && idx == n1 - 1) || (kind == 2 && idx == nsel - 1) || (kind == 3 && idx == c)) ? kind : 0;
            v4i e; e.x = mode | (idx << 8) | (endf << 16) | ((kind == 2 && idx == 0) ? (1 << 24) : 0) | (kn >= 2 ? (1 << 25) : 0); e.y = relbase; e.z = (int)ko; e.w = (int)vo;
            *(LAS v4i*)(TD + 4 * i) = e; }
        const int drow = 8 * w + (lane >> 3), dsrck = 16 * ((lane & 7) ^ (((w & 3) << 1) | ((lane >> 4) & 1))), dsrcv = 16 * ((lane & 7) ^ ((4 * (w & 1)) | (lane >> 4)));
#define AT_DMA(tile_, ko_, vo_, vs_) do { const int nb_ = (tile_) % AT_NBUF; \
        __builtin_amdgcn_global_load_lds((const GAS unsigned*)(ws + (size_t)((ko_) + drow * 128 + dsrck)), (LAS unsigned*)(L + AT_OFF_K + nb_ * AT_KBUF + w * 1024), 16, 0, 0); \
        __builtin_amdgcn_global_load_lds((const GAS unsigned*)(ws + (size_t)((vo_) + drow * (vs_) + dsrcv)), (LAS unsigned*)(L + AT_OFF_V + nb_ * AT_KBUF + w * 1024), 16, 0, 0); } while (0)
        __syncthreads();
        if (!(VAR & 2)) { AT_DMA(0, (unsigned)(WS_KC + (size_t)bg * 256 * 64 * 2), (unsigned)(WS_VCT + (size_t)bg * 64 * 256 * 2), 512u); }
        int d0, d1, d2, d3;
        { const v4i e = *(const LAS v4i*)TD; d0 = __builtin_amdgcn_readfirstlane(e.x); d1 = __builtin_amdgcn_readfirstlane(e.y); d2 = __builtin_amdgcn_readfirstlane(e.z); d3 = __builtin_amdgcn_readfirstlane(e.w); }
        pg8::f32x4 oacc[2][4];
        pg8::f32x4 lacc[2] = {(pg8::f32x4){0.f, 0.f, 0.f, 0.f}, (pg8::f32x4){0.f, 0.f, 0.f, 0.f}};
#pragma unroll
        for (int rb = 0; rb < 2; ++rb)
#pragma unroll
            for (int db = 0; db < 4; ++db) oacc[rb][db] = (pg8::f32x4){0.f, 0.f, 0.f, 0.f};
        const int tok_r[2] = {8 * w + (l15 >> 2), 8 * w + 4 + (l15 >> 2)};
        const LAS unsigned char* tsw = L + AT_OFF_TS + 16 * (47 - 2 * w); const LAS unsigned char* tsn = L + AT_OFF_TS + 16 * 48;
        for (int it = 0; it < ((VAR & 32) ? 0 : ntiles); ++it) {
            if (!(VAR & 512)) { asm volatile("s_waitcnt vmcnt(0)" ::: "memory");
            asm volatile("s_waitcnt lgkmcnt(0)" ::: "memory"); __builtin_amdgcn_s_barrier(); asm volatile("" ::: "memory"); }
            if (!(VAR & 2) && it + 1 < ntiles) AT_DMA(it + 1, (unsigned)d2, (unsigned)d3, ((d0 >> 25) & 1) ? 2u * SEQ : 512u);
            v4i tdn;
            { const LAS int* tn_ = TD + 4 * (it + 1); asm volatile("ds_read_b128 %0, %1" : "=v"(tdn) : "v"(tn_) : "memory"); }
            {
            const int mode = d0 & 255, idx = (d0 >> 8) & 255, relbase = d1, endf = (d0 >> 16) & 3, selfirst = (d0 >> 24) & 1;
            const int buf = it % AT_NBUF;
            if (selfirst) {
                { const int tok = 8 * w + (lane >> 3), s0 = 8 * (lane & 7);
                  unsigned key[8]; int rank[8];
#pragma unroll
                  for (int q = 0; q < 8; ++q) { const int sB = s0 + q; const bool vis = sB <= c, forced = (sB == 0) || (sB == c) || (sB == c - 1);
                      const float sc = vis ? (IMP1[tok * 65 + sB] + IMP2[tok * 65 + sB] + (forced ? 1000.f : 0.f)) : -1.f;
                      const unsigned u = __builtin_bit_cast(unsigned, sc); const unsigned fk = (u >> 31) ? ~u : (u | 0x80000000u);
                      key[q] = (fk & ~63u) | (unsigned)(63 - sB); rank[q] = 0; }
                  LAS unsigned* KEYS = (LAS unsigned*)IMP1;
#pragma unroll
                  for (int q = 0; q < 8; ++q) KEYS[tok * 65 + s0 + q] = key[q];
                  if (c >= 16 && !(VAR & 128)) {
#pragma unroll 8
                      for (int s2 = 0; s2 < 64; ++s2) { const unsigned k2 = KEYS[tok * 65 + s2];
#pragma unroll
                          for (int q = 0; q < 8; ++q) rank[q] += (k2 > key[q]) ? 1 : 0; } }
                  unsigned byte = 0u;
#pragma unroll
                  for (int q = 0; q < 8; ++q) byte |= ((rank[q] < 16 && (s0 + q) <= c) ? 1u : 0u) << q;
                  ((LAS unsigned char*)SELM)[tok * 8 + (lane & 7)] = (unsigned char)byte; }
            }
            const LAS unsigned char* kb_ = L + AT_OFF_K + buf * AT_KBUF; const LAS unsigned char* vb_ = L + AT_OFF_V + buf * AT_KBUF;
            const float cfar = LUTJ[127];
            unsigned selb[2] = {1u, 1u};
#define AT_CALL(TMX) at_tile<TMX, VAR>(kb_, vb_, LUTJ, IMP1, IMP2, qf, oacc, lacc, LROW, tok_r, selb, cfar, relbase, idx, l15, lq, tsw, tsn)
            if (mode == TM_SELF || mode == TM_SELN) { selb[0] = (unsigned)(SELM[tok_r[0]] >> idx) & 1u; selb[1] = (unsigned)(SELM[tok_r[1]] >> idx) & 1u; }
            if (mode == TM_SELF) {
                const bool a0 = __ballot(selb[0] != 0u) != 0ull, a1 = __ballot(selb[1] != 0u) != 0ull;
                if (a0 && a1) AT_CALL(TM_SELF);
                else if (a0) at_tile<TM_SELF, VAR, 1>(kb_, vb_, LUTJ, IMP1, IMP2, qf, oacc, lacc, LROW, tok_r, selb, cfar, relbase, idx, l15, lq, tsw, tsn);
                else if (a1) at_tile<TM_SELF, VAR, 2>(kb_, vb_, LUTJ, IMP1, IMP2, qf, oacc, lacc, LROW, tok_r, selb, cfar, relbase, idx, l15, lq, tsw, tsn); }
            else if (mode == TM_WINF) AT_CALL(TM_WINF);
            else if (mode == TM_SELN) AT_CALL(TM_SELN);
            else if (mode == TM_WINN) AT_CALL(TM_WINN);
            else if (mode == TM_WINE) AT_CALL(TM_WINE);
            else if (mode == TM_CMP2) AT_CALL(TM_CMP2);
            else if (mode == TM_CMP2F) AT_CALL(TM_CMP2F);
            else if (mode == TM_CMP1F) AT_CALL(TM_CMP1F);
            else { AT_CALL(TM_CMP1);
                if (idx == n1 - 1) {
#pragma unroll
                    for (int rb = 0; rb < 2; ++rb) { const float s = sum_xor32(sum_xor16(lacc[rb][0])); if (lq == 0) LROW[16 * rb + l15] = s > 0.f ? 1.0f / s : 0.f; lacc[rb] = (pg8::f32x4){0.f, 0.f, 0.f, 0.f}; } } }
#undef AT_CALL
            {
                if (endf && !(VAR & 256)) {
                    const int br = endf - 1;
#pragma unroll
                    for (int rb = 0; rb < 2; ++rb)
#pragma unroll
                        for (int r = 0; r < 4; ++r) { const int qrow = 16 * rb + 4 * lq + r;
                            const float ls_ = lacc[rb][r]; lacc[rb][r] = 0.f;
                            const float gt = GATL[(8 * w + 4 * rb + lq) * 12 + r * 3 + br] * (endf == 1 ? 1.0f : (ls_ > 0.f ? 1.0f / ls_ : 0.f));
#pragma unroll
                            for (int db = 0; db < 4; ++db) { float v = gt * oacc[rb][db][r]; oacc[rb][db][r] = 0.f;
                                LAS bf16* po = OUTL + qrow * 72 + 16 * db + l15;
                                if (br > 0) v += __builtin_bit_cast(float, (unsigned)(*po) << 16);
                                *po = (bf16)f2bf(v); } }
                    if (br == 2 && !(VAR & 1)) {
                        LDS_WAIT(); asm volatile("" ::: "memory");
#pragma unroll
                        for (int i = 0; i < 4; ++i) { const int ch = i * 64 + lane, row = ch >> 3, c16 = ch & 7;
                            const v4u o = *(const LAS v4u*)((const LAS unsigned char*)OUTL + row * 144 + 16 * c16);
                            *(GAS v4u*)(YA + (size_t)(m0 + 8 * w + (row >> 2)) * 1024 + g * 256 + (row & 3) * 64 + 8 * c16) = o; }
                    }
                }
            }
            }
            asm volatile("s_waitcnt lgkmcnt(0)" : "+v"(tdn) :: "memory");
            d0 = __builtin_amdgcn_readfirstlane(tdn.x); d1 = __builtin_amdgcn_readfirstlane(tdn.y); d2 = __builtin_amdgcn_readfirstlane(tdn.z); d3 = __builtin_amdgcn_readfirstlane(tdn.w);
        }
#undef AT_DMA
    }
}

constexpr int N_PHASES = 13;
#ifndef MK_ONE_LAUNCH
#define MK_ONE_LAUNCH 1
#endif
#ifndef REP_P0
#define REP_P0 1
#endif
#ifndef REP_P1
#define REP_P1 1
#endif
#ifndef REP_P2
#define REP_P2 1
#endif
#ifndef REP_P3
#define REP_P3 1
#endif
#ifndef REP_P5
#define REP_P5 1
#endif
#ifndef REP_P6
#define REP_P6 1
#endif
#ifndef REP_P8
#define REP_P8 1
#endif
#ifndef REP_P7
#define REP_P7 1
#endif
#ifndef REP_P11
#define REP_P11 1
#endif
#ifndef REP_P4
#define REP_P4 1
#endif
#ifndef REP_P9
#define REP_P9 1
#endif
#ifndef REP_P10
#define REP_P10 1
#endif
#ifndef MK_BUILD
#define MK_BUILD 0
#endif

#ifndef STAG_P2
#define STAG_P2 0
#endif
__device__ __forceinline__ void phase_stagger(const Frame& F, int step_ns) {
    const int grp = (F.bid >> 3) & 7;
    if (step_ns > 0 && grp > 0) { const unsigned long long t0 = wall_clock64(), dt = (unsigned long long)(grp * step_ns) / 10ull;
        while (wall_clock64() - t0 < dt) __builtin_amdgcn_s_sleep(8); }
}
struct EpiNull {
    static constexpr bool PERM = true, AFTER_DRAIN = false, MID = false;
    __device__ __forceinline__ void operator()(const pg8::f32x4 (&acc)[2][2][4][2], const pg8::Unit& u, int wr, int wc, int fr, int fq) const {
#pragma unroll
        for (int ai = 0; ai < 2; ++ai)
#pragma unroll
            for (int bj = 0; bj < 2; ++bj)
#pragma unroll
                for (int m = 0; m < 4; ++m) { asm volatile("" :: "v"(acc[ai][bj][m][0]), "v"(acc[ai][bj][m][1])); }
    }
};
__global__ void __launch_bounds__(NTHREADS, 2) fwd_kernel(Args args) {
    extern __shared__ __attribute__((aligned(16))) unsigned char lds[];
    Frame F;
    F.lds = (LAS unsigned char*)lds;
    F.MISC = (volatile LAS unsigned*)(F.lds + MISC_OFF);
    F.tid = threadIdx.x; F.lane = F.tid & 63; F.wave = __builtin_amdgcn_readfirstlane(F.tid >> 6);
    F.G = gridDim.x; F.bid = blockIdx.x; F.ws = args.ws;
    F.ctl = (gu32*)(args.ws + WS_CTL);
    for (int u = F.tid; u < (LDS_BYTES - LDSCTL_OFF) / 4; u += NTHREADS) ((LAS unsigned*)(F.lds + LDSCTL_OFF))[u] = 0u;
    __syncthreads();
    XcdBarrier bar; bar.bar = (unsigned*)(F.ctl + CW_BAR); bar.x = 0; bar.st = nullptr;
    if (MK_ONE_LAUNCH) bar = xcd_barrier_post((unsigned*)(F.ctl + CW_BAR), F.MISC + 8);
    const int lo = args.ph_lo, hi = args.ph_hi;
#define IN(k) (lo <= (k) && (k) < hi)
#define SEAM(k) do { if (IN(k) && IN((k) + 1)) xcd_barrier(bar); } while (0)
    unsigned char* ws = args.ws;
    const float* ada = (const float*)(ws + WS_ADA);

    if (IN(0)) { for (int rep = 0; rep < REP_P0; ++rep) { p0_prologue(F, args, rep == REP_P0 - 1); __syncthreads(); } } SEAM(0);
    if (IN(1)) { for (int rep = 0; rep < REP_P1; ++rep) modnorm_rows<false>(F, args.in[I_X], args.in[I_N1G], ada, 0, (bf16*)(ws + WS_H)); } SEAM(1);
    if (IN(2)) { {
        phase_stagger(F, STAG_P2);
        pg8::Gemm g{(const bf16*)(ws + WS_H), (const bf16*)(ws + WS_WIN_T), M, NIN, D, D, D}; pg8::StaticOrder S; S.init(M, NIN, F.G, F.bid);
        if (F.tid == 0) F.MISC[40] = 0xffffffffu; __syncthreads();
        EpiIn E{ws, args.in[I_QNG], args.in[I_KNG], F.MISC + 40};
#if defined(PROBE_P2) && PROBE_P2 == 1
        { EpiNull EN; pg8::gemm_phase<EpiNull, pg8::StaticOrder, true, true>(F.lds + RING_OFF, g, S, EN); __syncthreads(); }
#elif defined(PROBE_P2) && PROBE_P2 == 2
        { if (F.tid == 0) F.MISC[40] = 0u; __syncthreads(); pg8::gemm_phase<EpiIn, pg8::StaticOrder, true, true>(F.lds + RING_OFF, g, S, E); __syncthreads(); if (F.tid == 0) F.MISC[40] = 0xffffffffu; __syncthreads(); }
#endif
        pg8::gemm_phase<EpiIn, pg8::StaticOrder, true, true>(F.lds + RING_OFF, g, S, E);
#if REP_P2 > 1
        __syncthreads(); pg8::gemm_phase<EpiIn, pg8::StaticOrder, true, true>(F.lds + RING_OFF, g, S, E);
#endif
        }
    } SEAM(2);
#ifndef PROBE_P3
#define PROBE_P3 0
#endif
    if (IN(3)) { for (int rep = 0; rep < REP_P3; ++rep) { __syncthreads(); pool_phase(F); if (PROBE_P3 == 1) { __syncthreads(); pool_phase(F); }
        __syncthreads(); compress_phase(F, args.in[I_KNG]); if (PROBE_P3 == 2) { __syncthreads(); compress_phase(F, args.in[I_KNG]); }
        __syncthreads(); vtranspose_phase(F); if (PROBE_P3 == 3) { __syncthreads(); vtranspose_phase(F); } } } SEAM(3);
    if (IN(4)) {
#ifdef PROBE_P4
        attention_phase<PROBE_P4>(F, args); __syncthreads();
#endif
        for (int rep = 0; rep < REP_P4; ++rep) { attention_phase<0>(F, args); __syncthreads(); } } SEAM(4);
    if (IN(5)) { {
        pg8::Gemm g{(const bf16*)(ws + WS_PL), (const bf16*)(ws + WS_WEFF_T), M, D, 2 * POOLW, 2 * POOLW, 2 * POOLW}; pg8::StaticOrder S; S.init(M, D, F.G, F.bid);
        EpiMix2 E{(bf16*)(ws + WS_MIX), (const bf16*)(ws + WS_GM)};
        pg8::gemm_phase<EpiMix2, pg8::StaticOrder, true, true>(F.lds + RING_OFF, g, S, E);
#if REP_P5 > 1
        __syncthreads(); pg8::gemm_phase<EpiMix2, pg8::StaticOrder, true, true>(F.lds + RING_OFF, g, S, E);
#endif
        }
    } SEAM(5);
    if (IN(6)) { {
        pg8::Gemm g{(const bf16*)(ws + WS_MIX), (const bf16*)(ws + WS_WOUT_T), M, D, D, D, D}; pg8::StaticOrder S; S.init(M, D, F.G, F.bid);
        EpiRes E{args.in[I_X], (bf16*)(ws + WS_X1), ada, 2};
        pg8::gemm_phase<EpiRes, pg8::StaticOrder, true, true>(F.lds + RING_OFF, g, S, E);
#if REP_P6 > 1
        __syncthreads(); pg8::gemm_phase<EpiRes, pg8::StaticOrder, true, true>(F.lds + RING_OFF, g, S, E);
#endif
        }
    } SEAM(6);
    if (IN(7)) { for (int rep = 0; rep < REP_P7; ++rep) modnorm_rows<true>(F, ws + WS_X1, args.in[I_N2G], ada, 3, (bf16*)(ws + WS_H)); } SEAM(7);
    if (IN(8)) { {
        pg8::Gemm g{(const bf16*)(ws + WS_H), (const bf16*)(ws + WS_WQ_T), M, PQW, D, D, D}; pg8::StaticOrder S; S.init(M, PQW, F.G, F.bid);
        EpiStoreBf16 E{(bf16*)(ws + WS_QV), PQW};
        pg8::gemm_phase<EpiStoreBf16, pg8::StaticOrder, true, true>(F.lds + RING_OFF, g, S, E);
#if REP_P8 > 1
        __syncthreads(); pg8::gemm_phase<EpiStoreBf16, pg8::StaticOrder, true, true>(F.lds + RING_OFF, g, S, E);
#endif
        }
    } SEAM(8);
    if (IN(9)) { for (int rep = 0; rep < REP_P9; ++rep) peer_select_phase(F); } SEAM(9);
#ifdef PROBE_XCD
    if (IN(10)) { if (F.tid == 0) __hip_atomic_store((unsigned*)(F.ctl + 2048 + F.bid), 100u + xb_xcc_id(), RLX_AGENT); }
#endif
    if (IN(10)) {
#ifdef PROBE_DOT
        peer_dot_phase<PROBE_DOT>(F); __syncthreads();
#endif
#ifdef PROBE_LOADRATE
        peer_loadrate_probe<PROBE_LOADRATE>(F); __syncthreads();
#endif
        peer_dot_phase<0>(F); } SEAM(10);
    if (IN(11)) { for (int rep = 0; rep < REP_P11; ++rep) peer_coef_phase(F); } SEAM(11);
#ifdef PROBE_XCD
    if (IN(12) && F.bid == 0 && F.tid == 0) { bool ok = true; for (int i = 0; i < F.G; ++i) { const unsigned a = __hip_atomic_load((unsigned*)(F.ctl + 2048 + i), RLX_AGENT), b0 = __hip_atomic_load((unsigned*)(F.ctl + 2048 + (i & 7)), RLX_AGENT); if (a != b0 || a < 100u) ok = false; }
        for (int i = 0; i < 8; ++i) for (int q = 0; q < i; ++q) if (__hip_atomic_load((unsigned*)(F.ctl + 2048 + i), RLX_AGENT) == __hip_atomic_load((unsigned*)(F.ctl + 2048 + q), RLX_AGENT)) ok = false;
        if (!ok) args.out[12345] = 1.0e9f; }
    __syncthreads();
#endif
    if (IN(12)) {
#if defined(CHECK_OUT_MFMA)
        peer_out_mfma_phase<1>(F, ada, args.out); __syncthreads(); VM_WAIT(); __syncthreads(); peer_out_phase<false, true>(F, ada, args.out);
#elif defined(OUT_VALU)
        for (int rep = 1; rep < REP_P10; ++rep) peer_out_phase<true>(F, ada, args.out); peer_out_phase<false>(F, ada, args.out);
#else
#ifdef PROBE_OUT
        peer_out_mfma_phase<1>(F, ada, args.out); __syncthreads();
#endif
        peer_out_mfma_phase<0>(F, ada, args.out);
#endif
    }
#undef IN
#undef SEAM
}

extern "C" void kernel_launch(void* const* d_in, const int* in_sizes, int n_in, void* d_out, int out_size, void* d_ws, size_t ws_size, hipStream_t stream) {
    static int grid = 0;
    if (grid == 0) {
        if (n_in != N_IN || in_sizes[0] != M * D || out_size != M * D || ws_size < WS_END) {
            fprintf(stderr, "kernel_launch: unexpected shapes: n_in %d in0 %d out %d ws %zu (need %zu)\n", n_in, n_in > 0 ? in_sizes[0] : -1, out_size, ws_size, (size_t)WS_END); grid = -1; return; }
        int dev = 0, cus = 0, per_cu = 0;
        if (hipGetDevice(&dev) != hipSuccess || hipDeviceGetAttribute(&cus, hipDeviceAttributeMultiprocessorCount, dev) != hipSuccess) { grid = -1; return; }
        if (hipFuncSetAttribute((const void*)fwd_kernel, hipFuncAttributeMaxDynamicSharedMemorySize, LDS_BYTES) != hipSuccess) { fprintf(stderr, "kernel_launch: hipFuncSetAttribute failed\n"); grid = -1; return; }
        if (hipOccupancyMaxActiveBlocksPerMultiprocessor(&per_cu, (const void*)fwd_kernel, NTHREADS, LDS_BYTES) != hipSuccess || per_cu < 1)
            fprintf(stderr, "kernel_launch: occupancy query reports %d workgroups per CU\n", per_cu);
        (void)hipGetLastError();
        grid = cus;
    }
    if (grid < 0) return;
    if (hipMemsetAsync((char*)d_ws + WS_CTL, 0, CTL_ZERO_BYTES, stream) != hipSuccess) return;
    Args a{};
    for (int i = 0; i < N_IN; ++i) a.in[i] = (const float*)d_in[i];
    a.out = (float*)d_out; a.ws = (unsigned char*)d_ws;
    if (MK_ONE_LAUNCH) {
        a.ph_lo = 0; a.ph_hi = N_PHASES; a.li = 0;
        hipLaunchKernelGGL(fwd_kernel, dim3(grid), dim3(NTHREADS), LDS_BYTES, stream, a);
    } else {
        for (int p = 0; p < N_PHASES; ++p) {
            a.ph_lo = p; a.ph_hi = p + 1; a.li = p;
            hipLaunchKernelGGL(fwd_kernel, dim3(grid), dim3(NTHREADS), LDS_BYTES, stream, a);
        }
    }
}
```

```cpp
#include <hip/hip_runtime.h>
#include <cstdio>
#include <cstdint>
namespace pg8 {
#define PG8_LAS __attribute__((address_space(3)))
typedef unsigned short bf16_t;
typedef short bf16x8 __attribute__((ext_vector_type(8)));
typedef float f32x4 __attribute__((ext_vector_type(4)));
typedef unsigned u32x4 __attribute__((ext_vector_type(4)));
constexpr int BM = 256, BK = 64, HALF = 128, HTB = HALF * BK * 2  , STAGE_BYTES = 8 * HTB, NXCD = 8, WGM = 8;

__host__ __device__ __forceinline__ int lds_byte(int r, int c) { const int st = (r >> 4) * 2 + (c >> 5), rr = r & 15, cc = c & 31, ob = rr * 64 + cc * 2; return st * 1024 + (ob ^ (((ob >> 9) & 1) << 5)); }
__host__ __device__ __forceinline__ void stage_rc(int b, int& R, int& C) { const int st = b / 1024, sb = b % 1024, swz = sb ^ (((sb >> 9) & 1) << 5); R = (st >> 1) * 16 + swz / 64; C = (st & 1) * 32 + (swz % 64) / 2; }
__host__ __device__ __forceinline__ int perm32(int rho) { const int n = rho >> 4, i = rho & 15; return 8 * (i >> 2) + 4 * n + (i & 3); }

struct Unit { int pm, pn; };
struct Gemm { const bf16_t* A; const bf16_t* Bt; int M, N, K, lda, ldb; };

struct StaticOrder {
    int nM, nN, nwg, G, c;
    __host__ __device__ void init(int M, int N, int G_, int c_) { nM = M / BM; nN = N / BM; nwg = nM * nN; G = G_; c = c_; }
    __host__ __device__ bool next(int i, Unit& u) const {
        const long L = (long)i * G + c; if (L >= nwg) return false;
        int wgid = (int)L; { const int q = nwg / NXCD, r = nwg % NXCD, xcd = wgid % NXCD, off = wgid / NXCD; wgid = (xcd < r ? xcd * (q + 1) : r * (q + 1) + (xcd - r) * q) + off; }
        const int nig = WGM * nN, gid = wgid / nig, fm = gid * WGM, gsz = (nM - fm) < WGM ? (nM - fm) : WGM;
        u.pm = fm + ((wgid % nig) % gsz); u.pn = (wgid % nig) / gsz; return true;
    }
    __device__ __forceinline__ void a_ready(const Unit&) const {}
    __device__ __forceinline__ void done(const Unit&) const {}
};

__device__ __forceinline__ unsigned cvt_pk_bf16(float lo, float hi) { unsigned r; asm volatile("v_cvt_pk_bf16_f32 %0, %1, %2" : "=v"(r) : "v"(lo), "v"(hi)); return r; }
template <class Epi, class Sched, bool ALIGN_EPI = false, bool SP2 = false>
__device__ __forceinline__ void gemm_phase(PG8_LAS unsigned char* lds, const Gemm g, const Sched& S, const Epi& E) {
    const int tid = threadIdx.x, wid = __builtin_amdgcn_readfirstlane(tid >> 6), lane = tid & 63, wr = wid >> 2, wc = wid & 3, fr = lane & 15, fq = lane >> 4;
    const int K = g.K, nt = K / BK;
    unsigned voffA[2], voffB[2];
#pragma unroll
    for (int i = 0; i < 2; ++i) { int R, C; stage_rc(tid * 16 + i * 8192, R, C); const int Rb = Epi::PERM ? ((R & ~31) + perm32(R & 31)) : R;
        voffA[i] = (unsigned)(R * g.lda + C) * 2u; voffB[i] = (unsigned)(Rb * g.ldb + C) * 2u; }
    const size_t kstep = (size_t)(BK * 2);
    const size_t hstepA = (size_t)HALF * g.lda * 2, hstepB = (size_t)HALF * g.ldb * 2;
    const size_t tstepA = 2 * hstepA, tstepB = 2 * hstepB;
    const unsigned ldsw = (unsigned)wid * 1024u;
    const int aoff = lds_byte(wr * 64 + fr, fq * 8), boff = lds_byte(wc * 32 + fr, fq * 8);
#define PG8_SA(b, h) (((b) * 2 + (h)) * HTB)
#define PG8_SB(b, h) ((4 + (b) * 2 + (h)) * HTB)
#define PG8_STAGE(bufoff, gbase, voff) do { _Pragma("unroll") for (int _i = 0; _i < 2; ++_i) \
        __builtin_amdgcn_global_load_lds((const unsigned*)((const char*)(gbase) + (voff)[_i]), (PG8_LAS unsigned*)(lds + (bufoff) + ldsw + _i * 8192), 16, 0, 0); } while (0)
#define PG8_LDA(dst, b, h) do { _Pragma("unroll") for (int m = 0; m < 4; ++m) _Pragma("unroll") for (int k = 0; k < 2; ++k) dst[m][k] = *(const PG8_LAS bf16x8*)(lds + PG8_SA(b, h) + aoff + m * 2048 + k * 1024); } while (0)
#define PG8_LDB(dst, b, h) do { _Pragma("unroll") for (int n = 0; n < 2; ++n) _Pragma("unroll") for (int k = 0; k < 2; ++k) dst[n][k] = *(const PG8_LAS bf16x8*)(lds + PG8_SB(b, h) + boff + n * 2048 + k * 1024); } while (0)
#define PG8_MMA(ai, bj, At, Bt) do { __builtin_amdgcn_s_setprio(1); _Pragma("unroll") for (int m = 0; m < 4; ++m) _Pragma("unroll") for (int n = 0; n < 2; ++n) _Pragma("unroll") for (int k = 0; k < 2; ++k) \
        acc[ai][bj][m][n] = __builtin_amdgcn_mfma_f32_16x16x32_bf16(Bt[n][k], At[m][k], acc[ai][bj][m][n], 0, 0, 0); __builtin_amdgcn_s_setprio(0); } while (0)
#define PG8_WAIT_V(n) asm volatile("s_waitcnt vmcnt(" #n ")" ::: "memory")
#define PG8_WAIT_L(n) asm volatile("s_waitcnt lgkmcnt(" #n ")" ::: "memory")
#define PG8_BAR __builtin_amdgcn_s_barrier()
#define PG8_SCHED __builtin_amdgcn_sched_barrier(0)
    Unit cur, nxt; int ui = 0;
    if (!S.next(0, cur)) return;
    f32x4 acc[2][2][4][2];
#pragma unroll
    for (int a = 0; a < 2; ++a)
#pragma unroll
        for (int b = 0; b < 2; ++b)
#pragma unroll
            for (int m = 0; m < 4; ++m)
#pragma unroll
                for (int n = 0; n < 2; ++n) acc[a][b][m][n] = (f32x4){0.f, 0.f, 0.f, 0.f};
    bf16x8 At[4][2], B0[2][2], B1[2][2];
    const char* cA = (const char*)g.A + (size_t)cur.pm * tstepA; const char* cB = (const char*)g.Bt + (size_t)cur.pn * tstepB;
    S.a_ready(cur);
    if constexpr (SP2) {
        PG8_STAGE(PG8_SB(0, 0), cB, voffB); PG8_STAGE(PG8_SB(0, 1), cB + hstepB, voffB); PG8_STAGE(PG8_SA(0, 0), cA, voffA); PG8_STAGE(PG8_SA(0, 1), cA + hstepA, voffA);
        if (wr == 1) PG8_BAR;
        PG8_WAIT_V(2); PG8_BAR;
        PG8_STAGE(PG8_SB(1, 0), cB + kstep, voffB); PG8_STAGE(PG8_SA(1, 0), cA + kstep, voffA); PG8_STAGE(PG8_SB(1, 1), cB + hstepB + kstep, voffB);
        PG8_WAIT_V(6); PG8_BAR;
    } else {
        PG8_STAGE(PG8_SB(0, 0), cB, voffB); PG8_STAGE(PG8_SA(0, 0), cA, voffA); PG8_STAGE(PG8_SB(0, 1), cB + hstepB, voffB); PG8_STAGE(PG8_SA(0, 1), cA + hstepA, voffA);
        if (wr == 1) PG8_BAR;
        PG8_WAIT_V(4); PG8_BAR;
        PG8_STAGE(PG8_SB(1, 0), cB + kstep, voffB); PG8_STAGE(PG8_SA(1, 0), cA + kstep, voffA); PG8_STAGE(PG8_SB(1, 1), cB + hstepB + kstep, voffB);
        PG8_WAIT_V(6); PG8_BAR;
    }
    for (;;) {
        const bool has_next = S.next(ui + 1, nxt);
        const char* nA = has_next ? (const char*)g.A + (size_t)nxt.pm * tstepA : cA; const char* nB = has_next ? (const char*)g.Bt + (size_t)nxt.pn * tstepB : cB;
        for (int t = 0; t < nt; t += 2) {
            if constexpr (Epi::MID) { if (t == nt / 2) E.mid(acc, cur, wr, wc, fr, fq); }
            const bool last = (t == nt - 2);
            const char* a1 = cA + (size_t)(t + 1) * kstep;
            const char* a2 = last ? nA : cA + (size_t)(t + 2) * kstep; const char* b2 = last ? nB : cB + (size_t)(t + 2) * kstep;
            const char* a3 = a2 + kstep; const char* b3 = b2 + kstep;
            if (last && has_next) S.a_ready(nxt);
            if constexpr (SP2) {
            PG8_LDB(B0, 0, 0); PG8_LDB(B1, 0, 1); PG8_SCHED; PG8_LDA(At, 0, 0); PG8_STAGE(PG8_SA(1, 1), a1 + hstepA, voffA);
            PG8_WAIT_V(8); PG8_WAIT_L(0); PG8_BAR; PG8_MMA(0, 0, At, B0); PG8_MMA(0, 1, At, B1); PG8_BAR; PG8_SCHED;
            PG8_LDA(At, 0, 1); PG8_STAGE(PG8_SB(0, 0), b2, voffB); PG8_STAGE(PG8_SB(0, 1), b2 + hstepB, voffB); PG8_STAGE(PG8_SA(0, 0), a2, voffA);
            PG8_WAIT_V(8); PG8_WAIT_L(0); PG8_BAR; PG8_MMA(1, 0, At, B0); PG8_MMA(1, 1, At, B1); PG8_BAR; PG8_SCHED;
            PG8_LDB(B0, 1, 0); PG8_LDB(B1, 1, 1); PG8_SCHED; PG8_LDA(At, 1, 0); PG8_STAGE(PG8_SA(0, 1), a2 + hstepA, voffA);
            PG8_WAIT_V(8); PG8_WAIT_L(0); PG8_BAR; PG8_MMA(0, 0, At, B0); PG8_MMA(0, 1, At, B1); PG8_BAR; PG8_SCHED;
            PG8_LDA(At, 1, 1); PG8_STAGE(PG8_SB(1, 0), b3, voffB); PG8_STAGE(PG8_SB(1, 1), b3 + hstepB, voffB); PG8_STAGE(PG8_SA(1, 0), a3, voffA);
            PG8_WAIT_V(8); PG8_WAIT_L(0); PG8_BAR; PG8_MMA(1, 0, At, B0); PG8_MMA(1, 1, At, B1); PG8_BAR; PG8_SCHED;
            } else {
            PG8_LDB(B0, 0, 0); PG8_SCHED; PG8_LDA(At, 0, 0); PG8_STAGE(PG8_SA(1, 1), a1 + hstepA, voffA);
            PG8_WAIT_L(8); PG8_BAR; PG8_WAIT_L(0); PG8_MMA(0, 0, At, B0); PG8_BAR; PG8_SCHED;
            PG8_LDB(B1, 0, 1); PG8_STAGE(PG8_SB(0, 0), b2, voffB);
            PG8_BAR; PG8_WAIT_L(0); PG8_MMA(0, 1, At, B1); PG8_BAR;
            PG8_LDA(At, 0, 1); PG8_STAGE(PG8_SA(0, 0), a2, voffA);
            PG8_BAR; PG8_WAIT_L(0); PG8_MMA(1, 0, At, B0); PG8_BAR; PG8_SCHED;
            PG8_STAGE(PG8_SB(0, 1), b2 + hstepB, voffB);
            PG8_WAIT_V(6); PG8_BAR; PG8_MMA(1, 1, At, B1); PG8_BAR;
            PG8_LDB(B0, 1, 0); PG8_SCHED; PG8_LDA(At, 1, 0); PG8_STAGE(PG8_SA(0, 1), a2 + hstepA, voffA);
            PG8_WAIT_L(8); PG8_BAR; PG8_WAIT_L(0); PG8_MMA(0, 0, At, B0); PG8_BAR; PG8_SCHED;
            PG8_LDB(B1, 1, 1); PG8_STAGE(PG8_SB(1, 0), b3, voffB);
            PG8_BAR; PG8_WAIT_L(0); PG8_MMA(0, 1, At, B1); PG8_BAR;
            PG8_LDA(At, 1, 1); PG8_STAGE(PG8_SA(1, 0), a3, voffA);
            PG8_BAR; PG8_WAIT_L(0); PG8_MMA(1, 0, At, B0); PG8_BAR; PG8_SCHED;
            PG8_STAGE(PG8_SB(1, 1), b3 + hstepB, voffB);
            PG8_WAIT_V(6); PG8_BAR; PG8_MMA(1, 1, At, B1); PG8_BAR;
            }
        }
        if constexpr (ALIGN_EPI) { if (wr == 0) PG8_BAR; }
        if constexpr (!Epi::AFTER_DRAIN) { E(acc, cur, wr, wc, fr, fq); S.done(cur); }
        if (!has_next) break;
#pragma unroll
        for (int a = 0; a < 2; ++a)
#pragma unroll
            for (int b = 0; b < 2; ++b)
#pragma unroll
                for (int m = 0; m < 4; ++m)
#pragma unroll
                    for (int n = 0; n < 2; ++n) acc[a][b][m][n] = (f32x4){0.f, 0.f, 0.f, 0.f};
        cur = nxt; cA = nA; cB = nB; ++ui;
        if constexpr (ALIGN_EPI) { if (wr == 1) PG8_BAR; }
    }
    PG8_WAIT_V(0);
    if constexpr (!ALIGN_EPI) { if (wr == 0) PG8_BAR; }
    PG8_BAR;
    if constexpr (Epi::AFTER_DRAIN) { E.fused(acc, cur, wr, wc, fr, fq, lds, wid, lane); S.done(cur); }
#undef PG8_SA
#undef PG8_SB
#undef PG8_STAGE
#undef PG8_LDA
#undef PG8_LDB
#undef PG8_MMA
#undef PG8_WAIT_V
#undef PG8_WAIT_L
#undef PG8_BAR
#undef PG8_SCHED
}
}

constexpr int NWAVES = 8, NTHREADS = NWAVES * 64;
constexpr int BATCH = 8, SEQ = 4096, D = 1024, M = BATCH * SEQ;
constexpr int POOLW = 512, QW = 512, NG = 2, HD = 64, NBG = BATCH * NG;
constexpr int IN_COLS = 3864, NIN = 4096;
constexpr int NCMP = 255, NCMP_PAD = 256, NSEL = 64;
constexpr int PH = 8, PK = 128, PTOP = 16, PQD = 256, PQW = PH * PQD;
constexpr int NEXP = PK * PK;
constexpr float EPS = 1e-6f;
enum { I_X = 0, I_C, I_RELB, I_ADAW, I_ADAB, I_N1G, I_N2G, I_WIN, I_POOLW, I_POOLS, I_CPEK, I_CW1K, I_CW2K, I_CPEV, I_CW1V, I_CW2V, I_QNG, I_KNG, I_WBP, I_WBA, I_WOUT, I_PWQ, I_PSK, I_PU, I_PV, N_IN };

constexpr size_t MiB = 1u << 20, KiB = 1u << 10;
constexpr size_t WS_CTL = 0, CTL_ZERO_BYTES = 1 * MiB;
constexpr size_t WS_ADA = 1 * MiB;
constexpr size_t WS_CB1K = 64 * KiB;
constexpr size_t WS_CB1V = WS_CB1K + 1 * KiB;
constexpr size_t WS_BIASL = WS_ADA + 256 * KiB;
constexpr size_t WS_WIN_T = 2 * MiB;
constexpr size_t WS_WEFF_T = 10 * MiB;
constexpr size_t WS_WBA_T = 11 * MiB;
constexpr size_t WS_WOUT_T = 12 * MiB;
constexpr size_t WS_WQ_T = 14 * MiB;
constexpr size_t WS_SUBK = 18 * MiB;
constexpr size_t WS_CW1K_T = 18 * MiB + 512 * KiB;
constexpr size_t WS_CW1V_T = 19 * MiB;
constexpr size_t WS_CW2K_T = 19 * MiB + 512 * KiB;
constexpr size_t WS_CW2V_T = WS_CW2K_T + 64 * KiB;
constexpr size_t WS_KC = 20 * MiB;
constexpr size_t WS_VCT = 20 * MiB + 512 * KiB;
constexpr size_t WS_GATE = 21 * MiB;
constexpr size_t WS_UB = 24 * MiB;
constexpr size_t WS_VB = 56 * MiB;
constexpr size_t WS_SCLU = WS_UB + 16 * MiB, WS_SCLV = WS_SCLU + 64 * KiB;
constexpr size_t WS_H = 88 * MiB;
constexpr size_t WS_ZP = 152 * MiB;
constexpr size_t WS_Q = 184 * MiB;
constexpr size_t WS_KCR = 216 * MiB;
constexpr size_t WS_VCR = 225 * MiB;
constexpr size_t WS_KS = 234 * MiB, WS_VS = 242 * MiB, WS_KW = 250 * MiB, WS_VW = 258 * MiB;
constexpr size_t WS_VST = 266 * MiB, WS_VWT = 274 * MiB;
constexpr size_t WS_PL = 282 * MiB;
constexpr size_t WS_YA = 314 * MiB;
constexpr size_t WS_GM = 346 * MiB;
constexpr size_t WS_MIX = WS_ZP;
constexpr size_t WS_QV = WS_GM;
constexpr size_t WS_EID = WS_PL;
constexpr size_t WS_GW = WS_PL + 16 * MiB;
constexpr size_t WS_PART = WS_GM;
constexpr size_t WS_CF = WS_YA;
constexpr size_t WS_CFS = WS_YA + 8 * MiB;
constexpr size_t WS_H8 = WS_ZP;
constexpr size_t WS_HS = WS_ZP + 32 * MiB;
constexpr size_t WS_X1 = WS_KCR;
constexpr size_t WS_END = 474 * MiB;
constexpr int CW_TMO = 0, CW_CODE = 1, CW_BAR = 4096;

constexpr int RING_OFF = 0, RING_BYTES = 131072;
constexpr int LDSCTL_OFF = RING_BYTES, MISC_OFF = LDSCTL_OFF + 320;
constexpr int LDS_BYTES = 147456;

#define GAS __attribute__((address_space(1)))
#define LAS __attribute__((address_space(3)))
typedef unsigned short bf16;
typedef unsigned v4u __attribute__((ext_vector_type(4)));
typedef unsigned v2u __attribute__((ext_vector_type(2)));
typedef int v2i __attribute__((ext_vector_type(2)));
typedef float f32x4 __attribute__((ext_vector_type(4)));
typedef short bf16x8 __attribute__((ext_vector_type(8)));
typedef GAS unsigned gu32;
#define RLX_AGENT __ATOMIC_RELAXED, __HIP_MEMORY_SCOPE_AGENT
#define LDS_WAIT() asm volatile("s_waitcnt lgkmcnt(0)" ::: "memory")
#define VM_WAIT() asm volatile("s_waitcnt vmcnt(0)" ::: "memory")
__device__ __forceinline__ unsigned f2bf(float f) { unsigned u = __builtin_bit_cast(unsigned, f); return (u + 0x7fffu + ((u >> 16) & 1u)) >> 16; }
__device__ __forceinline__ unsigned pk2(float lo, float hi) { return f2bf(lo) | (f2bf(hi) << 16); }
__device__ __forceinline__ float bflo(unsigned w) { return __builtin_bit_cast(float, w << 16); }
__device__ __forceinline__ float bfhi(unsigned w) { return __builtin_bit_cast(float, w & 0xffff0000u); }
__device__ __forceinline__ float sigmoidf_(float v) { return __builtin_amdgcn_rcpf(1.0f + __builtin_amdgcn_exp2f(v * -1.4426950408889634f)); }
typedef __bf16 bf16x2_hw __attribute__((ext_vector_type(2)));
typedef float f32x2_hw __attribute__((ext_vector_type(2)));
__device__ __forceinline__ unsigned pkh(float lo, float hi) { return __builtin_bit_cast(unsigned, __builtin_convertvector((f32x2_hw){lo, hi}, bf16x2_hw)); }
__device__ __forceinline__ float gelu_tanh_safe(float v) { const float u = 0.7978845608028654f * (v + 0.044715f * v * v * v); return 0.5f * v * (1.0f + tanhf(u)); }
template <int CTRL> __device__ __forceinline__ float dppf(float v) { return __builtin_bit_cast(float, __builtin_amdgcn_update_dpp(0, __builtin_bit_cast(int, v), CTRL, 0xF, 0xF, true)); }
template <int CTRL> __device__ __forceinline__ int dppi(int v) { return __builtin_amdgcn_update_dpp(0, v, CTRL, 0xF, 0xF, true); }
#define DPP_XOR1 0xB1
#define DPP_XOR2 0x4E
#define DPP_HMIR 0x141
#define DPP_ROR8 0x128
__device__ __forceinline__ void swap16_(float& a, float& b) { asm volatile("v_nop\n\tv_nop\n\tv_permlane16_swap_b32 %0, %1" : "+v"(a), "+v"(b)); }
__device__ __forceinline__ void swap32_(float& a, float& b) { asm volatile("v_nop\n\tv_nop\n\tv_permlane32_swap_b32 %0, %1" : "+v"(a), "+v"(b)); }
__device__ __forceinline__ float sum_xor16(float v) { float a = v, b = v; swap16_(a, b); return a + b; }
__device__ __forceinline__ float sum_xor32(float v) { float a = v, b = v; swap32_(a, b); return a + b; }
__device__ __forceinline__ float max_xor16(float v) { float a = v, b = v; swap16_(a, b); return fmaxf(a, b); }
__device__ __forceinline__ float max_xor32(float v) { float a = v, b = v; swap32_(a, b); return fmaxf(a, b); }
__device__ __forceinline__ float wave_sum(float v) {
    v += dppf<DPP_XOR1>(v); v += dppf<DPP_XOR2>(v); v += dppf<DPP_HMIR>(v); v += dppf<DPP_ROR8>(v);
    return sum_xor32(sum_xor16(v));
}
__device__ __forceinline__ float wave_max(float v) {
    v = fmaxf(v, dppf<DPP_XOR1>(v)); v = fmaxf(v, dppf<DPP_XOR2>(v)); v = fmaxf(v, dppf<DPP_HMIR>(v)); v = fmaxf(v, dppf<DPP_ROR8>(v));
    return max_xor32(max_xor16(v));
}

#define XB_TMO      128
#define XB_XCNT(j)  (256  + 64 * (j))
#define XB_XSUB(j)  (1280 + 64 * (j))
#define XB_XGEN(j)  (2304 + 64 * (j))
#define XB_TOP      3328
#define XB_TOPGEN   3392
#define XCD_BAR_WORDS 3456
#define XB_SPIN_CAP (1u << 18)
__device__ __forceinline__ unsigned xb_ld(unsigned* p)              { return __hip_atomic_load(p, __ATOMIC_RELAXED, __HIP_MEMORY_SCOPE_AGENT); }
__device__ __forceinline__ unsigned xb_add(unsigned* p, unsigned v) { return __hip_atomic_fetch_add(p, v, __ATOMIC_RELAXED, __HIP_MEMORY_SCOPE_AGENT); }
__device__ __forceinline__ unsigned xb_xcc_id() { return (unsigned)__builtin_amdgcn_s_getreg((3 << 11) | 20) & 0xFu; }
#define XB_SPIN(cond, bar) do { unsigned _sp = 0; while (cond) { __builtin_amdgcn_s_sleep(1); \
    if ((++_sp & 255u) == 0u) { if (xb_ld(&(bar)[XB_TMO])) break; if (_sp > XB_SPIN_CAP) { atomicAdd(&(bar)[XB_TMO], 1u); break; } } } } while (0)
struct XcdBarrier { unsigned* bar; unsigned x; volatile LAS unsigned* st; };
__device__ __forceinline__ XcdBarrier xcd_barrier_post(unsigned* bar, volatile LAS unsigned* st) {
    XcdBarrier b; b.bar = bar; b.x = xb_xcc_id(); b.st = st;
    if (threadIdx.x == 0) (void)xb_add(&bar[XB_XCNT(b.x)], 1u);
    return b;
}
__device__ __forceinline__ void xcd_barrier_complete(unsigned* bar, unsigned x, unsigned& nloc, unsigned& nx) {
    const unsigned G = gridDim.x * gridDim.y * gridDim.z;
    unsigned sum, cnt, mine, sp = 0u;
    for (;;) {
        sum = 0u; cnt = 0u; mine = 0u;
#pragma unroll
        for (unsigned j = 0; j < 16; ++j) { const unsigned c = xb_ld(&bar[XB_XCNT(j)]); sum += c; cnt += (c > 0u) ? 1u : 0u; mine = (j == x) ? c : mine; }
        if (sum == G) break;
        __builtin_amdgcn_s_sleep(1);
        if ((++sp & 255u) == 0u) { if (xb_ld(&bar[XB_TMO])) break; if (sp > XB_SPIN_CAP) { atomicAdd(&bar[XB_TMO], 1u); break; } }
    }
    nloc = mine > 0u ? mine : 1u; nx = cnt > 0u ? cnt : 1u;
}
__device__ __forceinline__ void xcd_barrier(const XcdBarrier& b) {
    asm volatile("s_waitcnt vmcnt(0)" ::: "memory");
    __syncthreads();
    if (threadIdx.x == 0) {
        unsigned* bar = b.bar;
        __builtin_amdgcn_s_waitcnt(0);
        unsigned nloc = b.st[0], nx = b.st[1];
        if (nloc == 0u) { xcd_barrier_complete(bar, b.x, nloc, nx); b.st[0] = nloc; b.st[1] = nx; }
        const unsigned old = xb_add(&bar[XB_XSUB(b.x)], 1u);
        const unsigned gen = old / nloc;
        if (old + 1u == (gen + 1u) * nloc) {
            __builtin_amdgcn_fence(__ATOMIC_RELEASE, "agent");
            asm volatile("s_waitcnt vmcnt(0)" ::: "memory");
            const unsigned og = xb_add(&bar[XB_TOP], 1u);
            const unsigned tg = og / nx;
            if (og + 1u == (tg + 1u) * nx) xb_add(&bar[XB_TOPGEN], 1u);
            else XB_SPIN(xb_ld(&bar[XB_TOPGEN]) == tg, bar);
            __builtin_amdgcn_fence(__ATOMIC_ACQUIRE, "agent");
            xb_add(&bar[XB_XGEN(b.x)], 1u);
            asm volatile("s_waitcnt vmcnt(0)" ::: "memory");
        } else {
            XB_SPIN(xb_ld(&bar[XB_XGEN(b.x)]) == gen, bar);
            __builtin_amdgcn_fence(__ATOMIC_ACQUIRE, "agent");
            asm volatile("s_waitcnt vmcnt(0)" ::: "memory");
        }
    }
    __syncthreads();
}

struct Args { const float* in[N_IN]; float* out; unsigned char* ws; int ph_lo, ph_hi, li, pad; };
struct Frame {
    LAS unsigned char* lds;
    volatile LAS unsigned* MISC;
    gu32* ctl;
    int tid, lane, wave, G, bid;
    unsigned char* ws;
};

template <bool I8> __device__ __forceinline__ void cvt_row_store(const f32x4 (&v)[4], int row, unsigned char* dst, float* inv_scale, int lane) {
    float m = 0.f;
#pragma unroll
    for (int j = 0; j < 4; ++j) m = fmaxf(m, fmaxf(fmaxf(fabsf(v[j].x), fabsf(v[j].y)), fmaxf(fabsf(v[j].z), fabsf(v[j].w))));
    m = wave_max(m);
    unsigned ww[4]; float isc;
    if (I8) { const float sc = m > 0.f ? 127.0f / m : 0.f; isc = m * (1.0f / 127.0f);
#pragma unroll
        for (int j = 0; j < 4; ++j) { const int q0 = (int)rintf(v[j].x * sc), q1 = (int)rintf(v[j].y * sc), q2 = (int)rintf(v[j].z * sc), q3 = (int)rintf(v[j].w * sc);
            ww[j] = ((unsigned)q0 & 0xffu) | (((unsigned)q1 & 0xffu) << 8) | (((unsigned)q2 & 0xffu) << 16) | (((unsigned)q3 & 0xffu) << 24); } }
    else { const unsigned E = (__builtin_bit_cast(unsigned, m) >> 23) & 0xffu; float sc = 1.f; isc = 1.f;
        if (E >= 8u && E <= 250u) { sc = __builtin_bit_cast(float, (261u - E) << 23); isc = __builtin_bit_cast(float, (E - 7u) << 23); }
#pragma unroll
        for (int j = 0; j < 4; ++j) { int t = __builtin_amdgcn_cvt_pk_fp8_f32(v[j].x * sc, v[j].y * sc, 0, false); t = __builtin_amdgcn_cvt_pk_fp8_f32(v[j].z * sc, v[j].w * sc, t, true); ww[j] = (unsigned)t; } }
    *(GAS v4u*)(dst + (size_t)(lane >> 3) * NEXP * 128 + (size_t)row * 128 + 16 * (lane & 7)) = (v4u){ww[0], ww[1], ww[2], ww[3]};
    if (lane == 0) inv_scale[row] = isc;
}
template <bool I8> __device__ __forceinline__ void cvt_rows_8bit(const float* src, unsigned char* dst, float* inv_scale, int gw, int NGW, int lane) {
    for (int row = gw; row < NEXP; row += 2 * NGW) {
        const int row1 = row + NGW; const bool has1 = row1 < NEXP;
        f32x4 v0[4], v1[4];
#pragma unroll
        for (int j = 0; j < 4; ++j) v0[j] = *(const GAS f32x4*)(src + (size_t)row * D + 16 * lane + 4 * j);
#pragma unroll
        for (int j = 0; j < 4; ++j) v1[j] = has1 ? *(const GAS f32x4*)(src + (size_t)row1 * D + 16 * lane + 4 * j) : (f32x4){0.f, 0.f, 0.f, 0.f};
        cvt_row_store<I8>(v0, row, dst, inv_scale, lane);
        if (has1) cvt_row_store<I8>(v1, row1, dst, inv_scale, lane);
    }
}
__device__ __forceinline__ void p0_transpose_item(const float* W, int ldw, int src_col0, int valid, int K, bf16* WT, int dst_row0, int k0, LAS float* scr, int lane, int ldt = -1) {
    if (ldt < 0) ldt = K;
    const int n_ = lane & 31;
#pragma unroll 8
    for (int i = 0; i < 32; ++i) { const int kk = 2 * i + (lane >> 5); scr[kk * 33 + n_] = (n_ < valid) ? W[(size_t)(k0 + kk) * ldw + src_col0 + n_] : 0.f; }
    LDS_WAIT(); asm volatile("" ::: "memory");
    const int c = lane & 7;
#pragma unroll
    for (int j = 0; j < 4; ++j) { const int n = (lane >> 3) + 8 * j; const LAS float* s = scr + (8 * c) * 33 + n;
        v4u o; o.x = pk2(s[0 * 33], s[1 * 33]); o.y = pk2(s[2 * 33], s[3 * 33]); o.z = pk2(s[4 * 33], s[5 * 33]); o.w = pk2(s[6 * 33], s[7 * 33]);
        *(GAS v4u*)(WT + (size_t)(dst_row0 + n) * ldt + k0 + 8 * c) = o; }
    LDS_WAIT(); asm volatile("" ::: "memory");
}
__device__ __forceinline__ bool p0_mat(int& r, const float* W, int K, int N, bf16* WT, LAS float* scr, int lane, int ldt = -1) {
    const int ng = N / 32, items = ng * (K / 64);
    if (r < items) { const int kb = r / ng, nb = r % ng; p0_transpose_item(W, N, 32 * nb, 32, K, WT, 32 * nb, 64 * kb, scr, lane, ldt); return true; }
    r -= items; return false;
}
__device__ __forceinline__ void cvt_f32_bf16_stream(const float* src, bf16* dst, size_t n8, size_t gtid, size_t gthreads) {
    for (size_t i = gtid; i < n8; i += gthreads) {
        const f32x4 a = *(const GAS f32x4*)(src + 8 * i), b = *(const GAS f32x4*)(src + 8 * i + 4);
        v4u o; o.x = pk2(a.x, a.y); o.y = pk2(a.z, a.w); o.z = pk2(b.x, b.y); o.w = pk2(b.z, b.w);
        *(GAS v4u*)(dst + 8 * i) = o; }
}

__device__ __forceinline__ void p0_prologue(Frame& F, const Args& args, bool do_bias = true) {
    unsigned char* ws = F.ws;
    const int gw = F.bid * NWAVES + F.wave, NGW = F.G * NWAVES;
    const size_t gtid = (size_t)F.bid * NTHREADS + F.tid, gthreads = (size_t)F.G * NTHREADS;
    {
        LAS float* sl = (LAS float*)(F.lds);
        LAS float* red = (LAS float*)(F.lds + 32768);
        const float* c = args.in[I_C];
        { f32x4 cv[4];
#pragma unroll
          for (int q = 0; q < 4; ++q) cv[q] = *(const GAS f32x4*)(c + 4 * (F.tid + NTHREADS * q));
#pragma unroll
          for (int q = 0; q < 4; ++q) { f32x4 o; o.x = cv[q].x / (1.0f + __expf(-cv[q].x)); o.y = cv[q].y / (1.0f + __expf(-cv[q].y)); o.z = cv[q].z / (1.0f + __expf(-cv[q].z)); o.w = cv[q].w / (1.0f + __expf(-cv[q].w));
              *(LAS f32x4*)(sl + 4 * (F.tid + NTHREADS * q)) = o; } }
        __syncthreads();
        for (int cb = F.bid; cb < 6 * D / 24; cb += F.G) {
            const int j0 = cb * 24;
            if (F.tid < 510) {
                const int kk = F.tid / 6, c4 = F.tid % 6;
                const float* w = args.in[I_ADAW] + j0 + 4 * c4;
                f32x4 wv[13];
#pragma unroll
                for (int m = 0; m < 13; ++m) { const int k = kk + 85 * m; wv[m] = (k < D) ? *(const GAS f32x4*)(w + (size_t)k * (6 * D)) : (f32x4){0.f, 0.f, 0.f, 0.f}; }
                f32x4 a[BATCH];
#pragma unroll
                for (int b = 0; b < BATCH; ++b) a[b] = (f32x4){0.f, 0.f, 0.f, 0.f};
#pragma unroll
                for (int m = 0; m < 13; ++m) { const int k = kk + 85 * m; const int kc = k < D ? k : 0;
#pragma unroll
                    for (int b = 0; b < BATCH; ++b) a[b] = a[b] + wv[m] * sl[b * D + kc]; }
#pragma unroll
                for (int b = 0; b < BATCH; ++b) { LAS float* rp = red + (kk * 24 + 4 * c4) * BATCH + b; rp[0] = a[b].x; rp[BATCH] = a[b].y; rp[2 * BATCH] = a[b].z; rp[3 * BATCH] = a[b].w; }
            }
            __syncthreads();
            if (F.tid < 24 * BATCH) { const int jj = F.tid / BATCH, b = F.tid % BATCH; float s = 0.f;
#pragma unroll 5
                for (int kk = 0; kk < 85; ++kk) s += red[(kk * 24 + jj) * BATCH + b];
                ((float*)(ws + WS_ADA))[b * (6 * D) + j0 + jj] = s + args.in[I_ADAB][j0 + jj]; }
            __syncthreads();
        }
    }
    if (F.bid >= 8 && F.bid < 40 && do_bias) {
        const int bb = F.bid - 8, kv = bb & 1, ch = bb >> 1;
        const float* pe = args.in[kv == 0 ? I_CPEK : I_CPEV]; const float* w1 = args.in[kv == 0 ? I_CW1K : I_CW1V];
        LAS float* red = (LAS float*)(F.lds);
        const int j = F.tid & 127, ic = F.tid >> 7; float s = 0.f;
        const int i0 = ch * 128 + ic * 32;
#pragma unroll 8
        for (int i = i0; i < i0 + 32; ++i) s += pe[i] * w1[(size_t)i * 128 + j];
        red[ic * 128 + j] = s; __syncthreads();
        if (F.tid < 128) atomicAdd((float*)(ws + (kv == 0 ? WS_CB1K : WS_CB1V)) + F.tid, (red[F.tid] + red[128 + F.tid]) + (red[256 + F.tid] + red[384 + F.tid]));
        __syncthreads();
    } else if (F.bid == 2) {
        for (int i = F.tid; i < 8 * 128; i += NTHREADS) { const int h = i >> 7, rel = i & 127;
            int bk = rel;
            if (rel >= 16) bk = 16 + (rel >= 19) + (rel >= 21) + (rel >= 24) + (rel >= 27) + (rel >= 31) + (rel >= 35) + (rel >= 40) + (rel >= 46) + (rel >= 52) + (rel >= 59) + (rel >= 67) + (rel >= 77) + (rel >= 87) + (rel >= 99) + (rel >= 113);
            ((float*)(ws + WS_BIASL))[i] = args.in[I_RELB][bk * 8 + h]; }
        if (F.tid < 64) {
            float mq = fabsf(args.in[I_QNG][F.tid]), mk = fmaxf(fmaxf(fabsf(args.in[I_KNG][F.tid]), fabsf(args.in[I_KNG][64 + F.tid])), fabsf(args.in[I_KNG][128 + F.tid]));
            float mb = fmaxf(fmaxf(fabsf(args.in[I_RELB][F.tid]), fabsf(args.in[I_RELB][64 + F.tid])), fmaxf(fabsf(args.in[I_RELB][128 + F.tid]), fabsf(args.in[I_RELB][192 + F.tid])));
            mq = wave_max(mq); mk = wave_max(mk); mb = wave_max(mb);
            if (F.tid == 0) ((float*)(ws + WS_BIASL))[8 * 128] = 8.0f * mq * mk + mb; }
    }
    {
        LAS float* scr = (LAS float*)(F.lds + F.wave * 16384);
        constexpr int I_WINT = (NIN / 32) * (D / 64);
        constexpr int NITEMS = I_WINT + (1024 / 32) * (512 / 64) + (1024 / 32) * (1024 / 64) + 2 * (128 / 32) * (2048 / 64) + 2 * (64 / 32) * (128 / 64);
        for (int it = gw; it < NITEMS; it += NGW) {
            int r = it;
            if (r < I_WINT) {
                const int grp = r % (NIN / 32), kb = r / (NIN / 32);
                const int tile = grp >> 3, ct0 = (grp & 7) * 32;
                const int L0 = 64 * ((ct0 >> 5) & 3) + 32 * (ct0 >> 7);
                int src0, valid = 32;
                if (tile < 7) src0 = 256 * tile + L0; else if (tile < 15) src0 = 1816 + 256 * (tile - 7) + L0; else { src0 = 1792 + L0; valid = (L0 == 0) ? 24 : 0; }
                if (valid == 0) src0 = 0;
                p0_transpose_item(args.in[I_WIN], IN_COLS, src0, valid, D, (bf16*)(ws + WS_WIN_T), 32 * grp, 64 * kb, scr, F.lane);
                continue; }
            r -= I_WINT;
            if (p0_mat(r, args.in[I_WBA], 512, 1024, (bf16*)(ws + WS_WEFF_T) + 512, scr, F.lane, 1024)) continue;
            if (p0_mat(r, args.in[I_WOUT], 1024, 1024, (bf16*)(ws + WS_WOUT_T), scr, F.lane)) continue;
            if (p0_mat(r, args.in[I_CW1K], 2048, 128, (bf16*)(ws + WS_CW1K_T), scr, F.lane)) continue;
            if (p0_mat(r, args.in[I_CW1V], 2048, 128, (bf16*)(ws + WS_CW1V_T), scr, F.lane)) continue;
            if (p0_mat(r, args.in[I_CW2K], 128, 64, (bf16*)(ws + WS_CW2K_T), scr, F.lane)) continue;
            p0_mat(r, args.in[I_CW2V], 128, 64, (bf16*)(ws + WS_CW2V_T), scr, F.lane);
        }
    }
    {
        const float* pw = args.in[I_POOLW]; const float* ps = args.in[I_POOLS]; const float* wbp = args.in[I_WBP];
        bf16* weff = (bf16*)(ws + WS_WEFF_T);
        LAS float* PWl = (LAS float*)(F.lds);
        LAS float* WBl = (LAS float*)(F.lds + 128 * 129 * 4);
        __syncthreads();
        for (int bb = F.bid; bb < 256; bb += F.G) {
            const int g = bb >> 6, d0 = (bb & 63) * 16;
            { f32x4 t[8];
#pragma unroll
              for (int q = 0; q < 8; ++q) t[q] = *(const GAS f32x4*)(pw + (size_t)g * 16384 + 4 * (F.tid + NTHREADS * q));
#pragma unroll
              for (int q = 0; q < 8; ++q) { const int i = 4 * (F.tid + NTHREADS * q); LAS float* d = PWl + (i >> 7) * 129 + (i & 127); d[0] = t[q].x; d[1] = t[q].y; d[2] = t[q].z; d[3] = t[q].w; }
              const int cc = F.tid >> 2, d4 = (F.tid & 3) * 4;
              const f32x4 wv = *(const GAS f32x4*)(wbp + (size_t)(g * 128 + cc) * D + d0 + d4); const float pv = ps[g * 128 + cc];
              LAS float* d = WBl + cc * 17 + d4; d[0] = wv.x * pv; d[1] = wv.y * pv; d[2] = wv.z * pv; d[3] = wv.w * pv; }
            __syncthreads();
            const int c = F.tid & 127, q = F.tid >> 7;
            float acc4[4] = {0.f, 0.f, 0.f, 0.f};
#pragma unroll 4
            for (int cc = 0; cc < 128; ++cc) { const float a = PWl[c * 129 + cc];
#pragma unroll
                for (int e = 0; e < 4; ++e) acc4[e] += a * WBl[cc * 17 + 4 * q + e]; }
#pragma unroll
            for (int e = 0; e < 4; ++e) weff[(size_t)(d0 + 4 * q + e) * 1024 + g * 128 + c] = (bf16)f2bf(acc4[e]);
            __syncthreads();
        }
    }
    {
        const float* wq = args.in[I_PWQ]; const float* sk = args.in[I_PSK]; bf16* wf = (bf16*)(ws + WS_WQ_T);
        const int l15 = F.lane & 15, lq = F.lane >> 4;
        for (int bb = F.bid; bb < 256; bb += F.G) {
            const int hp = bb >> 4, kg = bb & 15;
            bf16x8 bfr[4];
#pragma unroll
            for (int ks = 0; ks < 4; ++ks) { const float* sp = sk + ((size_t)hp * 128 + 16 * F.wave + l15) * 128 + 32 * ks + 8 * lq;
                const f32x4 s0 = *(const GAS f32x4*)sp, s1 = *(const GAS f32x4*)(sp + 4);
                bfr[ks] = __builtin_bit_cast(bf16x8, (v4u){pkh(s0.x, s0.y), pkh(s0.z, s0.w), pkh(s1.x, s1.y), pkh(s1.z, s1.w)}); }
#pragma unroll
            for (int cb = 0; cb < 4; ++cb) {
                pg8::f32x4 acc = (pg8::f32x4){0.f, 0.f, 0.f, 0.f};
#pragma unroll
                for (int ks = 0; ks < 4; ++ks) { const float* ap = wq + (size_t)(64 * kg + 16 * cb + l15) * PQW + hp * 128 + 32 * ks + 8 * lq;
                    const f32x4 a0 = *(const GAS f32x4*)ap, a1 = *(const GAS f32x4*)(ap + 4);
                    const bf16x8 af = __builtin_bit_cast(bf16x8, (v4u){pkh(a0.x, a0.y), pkh(a0.z, a0.w), pkh(a1.x, a1.y), pkh(a1.z, a1.w)});
                    acc = __builtin_amdgcn_mfma_f32_16x16x32_bf16(af, bfr[ks], acc, 0, 0, 0); }
                v2u o; o.x = pkh(acc[0], acc[1]); o.y = pkh(acc[2], acc[3]);
                *(GAS v2u*)(wf + (size_t)(hp * 128 + 16 * F.wave + l15) * D + 64 * kg + 16 * cb + 4 * lq) = o; }
        }
    }
    cvt_rows_8bit<true>(args.in[I_PU], ws + WS_UB, (float*)(ws + WS_SCLU), gw, NGW, F.lane);
    cvt_rows_8bit<false>(args.in[I_PV], ws + WS_VB, (float*)(ws + WS_SCLV), gw, NGW, F.lane);
}

template <bool Q8> __device__ __forceinline__ void modnorm_rows(Frame& F, const void* xin, const float* g, const float* ada, int shift_idx, bf16* out) {
    const int gw = F.bid * NWAVES + F.wave, NGW = F.G * NWAVES;
    for (int m = gw; m < M; m += NGW) {
        const int b = m >> 12;
        const GAS f32x4* gr = (const GAS f32x4*)g + F.lane;
        const GAS f32x4* sh = (const GAS f32x4*)(ada + (size_t)b * 6 * D + shift_idx * D) + F.lane;
        const GAS f32x4* sc = (const GAS f32x4*)(ada + (size_t)b * 6 * D + (shift_idx + 1) * D) + F.lane;
        f32x4 v[4]; float s = 0.f;
#pragma unroll
        for (int j = 0; j < 4; ++j) {
            if (Q8) { const v2u xb = ((const GAS v2u*)((const bf16*)xin + (size_t)m * D))[F.lane + 64 * j]; v[j] = (f32x4){bflo(xb.x), bfhi(xb.x), bflo(xb.y), bfhi(xb.y)}; }
            else v[j] = ((const GAS f32x4*)((const float*)xin + (size_t)m * D))[F.lane + 64 * j];
            s += (v[j].x * v[j].x + v[j].y * v[j].y) + (v[j].z * v[j].z + v[j].w * v[j].w); }
        const float rstd = rsqrtf(wave_sum(s) * (1.f / D) + EPS);
        GAS v2u* o8 = (GAS v2u*)(out + (size_t)m * D) + F.lane;
        float mx = 0.f;
#pragma unroll
        for (int j = 0; j < 4; ++j) { const f32x4 gg = gr[64 * j], ss = sh[64 * j], cc = sc[64 * j];
            const f32x4 y = (v[j] * rstd) * gg * (cc + 1.0f) + ss; v[j] = y;
            mx = fmaxf(mx, fmaxf(fmaxf(fabsf(y.x), fabsf(y.y)), fmaxf(fabsf(y.z), fabsf(y.w))));
            v2u o; o.x = pk2(y.x, y.y); o.y = pk2(y.z, y.w); o8[64 * j] = o; }
        if (Q8) {
            mx = wave_max(mx);
            const float qs = mx > 0.f ? 127.0f / mx : 0.f;
            GAS unsigned* h8 = (GAS unsigned*)(F.ws + WS_H8 + (size_t)m * D) + F.lane;
#pragma unroll
            for (int j = 0; j < 4; ++j) { const int q0 = (int)rintf(v[j].x * qs), q1 = (int)rintf(v[j].y * qs), q2 = (int)rintf(v[j].z * qs), q3 = (int)rintf(v[j].w * qs);
                h8[64 * j] = ((unsigned)q0 & 0xffu) | (((unsigned)q1 & 0xffu) << 8) | (((unsigned)q2 & 0xffu) << 16) | (((unsigned)q3 & 0xffu) << 24); }
            if (F.lane == 0) ((float*)(F.ws + WS_HS))[m] = mx * (1.0f / 127.0f);
        }
    }
}

struct EpiIn {
    static constexpr bool PERM = true, AFTER_DRAIN = false, MID = false;
    unsigned char* ws; const float* qg; const float* kg; const volatile LAS unsigned* rmp;
    __device__ __forceinline__ void operator()(const pg8::f32x4 (&acc)[2][2][4][2], const pg8::Unit& u, int wr, int wc, int fr, int fq) const {
        const int pn = u.pn, rmask = __builtin_amdgcn_readfirstlane((int)*rmp);
#pragma unroll
        for (int ai = 0; ai < 2; ++ai)
#pragma unroll
            for (int m = 0; m < 4; ++m) {
                const int row = (u.pm & rmask) * 256 + ai * 128 + wr * 64 + m * 16 + fr;
                float v[2][8];
#pragma unroll
                for (int bj = 0; bj < 2; ++bj)
#pragma unroll
                    for (int n = 0; n < 2; ++n)
#pragma unroll
                        for (int i = 0; i < 4; ++i) v[bj][4 * n + i] = acc[ai][bj][m][n][i];
                bf16* dst = nullptr; bool norm = false; const float* gain = nullptr; float mul = 1.f; bool sig = false;
                if (pn < 2) { dst = (bf16*)(ws + WS_ZP) + (size_t)row * 512 + 256 * pn + 64 * wc; }
                else if (pn < 4) { dst = (bf16*)(ws + WS_Q) + (size_t)row * 512 + 256 * (pn - 2) + 64 * wc; norm = true; gain = qg; mul = 0.125f * 1.4426950408889634f; }
                else if (pn < 7) { const int kind = pn - 4, isv = wc >> 1, g = wc & 1, b = row >> 12, t = row & 4095;
                    const size_t base = ((size_t)(b * 2 + g) * SEQ + t) * 64;
                    const size_t off = kind == 0 ? (isv ? WS_VCR : WS_KCR) : kind == 1 ? (isv ? WS_VS : WS_KS) : (isv ? WS_VW : WS_KW);
                    dst = (bf16*)(ws + off) + base; if (!isv && kind > 0) { norm = true; gain = kg + kind * 64; } }
                else if (pn < 15) { dst = (bf16*)(ws + WS_GM) + (size_t)row * 2048 + 256 * (pn - 7) + 64 * wc; sig = true; }
                else {
                    if (wc == 0 && fq < 3) { float* gp = (float*)(ws + WS_GATE) + (size_t)row * 24 + 8 * fq;
                        *(GAS f32x4*)gp = (f32x4){sigmoidf_(v[0][0]), sigmoidf_(v[0][1]), sigmoidf_(v[0][2]), sigmoidf_(v[0][3])};
                        *(GAS f32x4*)(gp + 4) = (f32x4){sigmoidf_(v[0][4]), sigmoidf_(v[0][5]), sigmoidf_(v[0][6]), sigmoidf_(v[0][7])}; }
                    continue; }
                if (norm) { float ss = 0.f;
#pragma unroll
                    for (int bj = 0; bj < 2; ++bj)
#pragma unroll
                        for (int e = 0; e < 8; ++e) ss += v[bj][e] * v[bj][e];
                    ss = sum_xor32(sum_xor16(ss));
                    const float rs = rsqrtf(ss * (1.f / 64.f) + EPS) * mul;
#pragma unroll
                    for (int bj = 0; bj < 2; ++bj)
#pragma unroll
                        for (int e = 0; e < 8; ++e) v[bj][e] = v[bj][e] * rs * gain[32 * bj + 8 * fq + e]; }
                if (sig) {
#pragma unroll
                    for (int bj = 0; bj < 2; ++bj)
#pragma unroll
                        for (int e = 0; e < 8; ++e) v[bj][e] = sigmoidf_(v[bj][e]); }
#pragma unroll
                for (int bj = 0; bj < 2; ++bj) { v4u o; o.x = pkh(v[bj][0], v[bj][1]); o.y = pkh(v[bj][2], v[bj][3]); o.z = pkh(v[bj][4], v[bj][5]); o.w = pkh(v[bj][6], v[bj][7]);
                    *(GAS v4u*)(dst + 32 * bj + 8 * fq) = o; }
            }
    }
};
template <bool ADD> struct EpiMix {
    static constexpr bool PERM = true, AFTER_DRAIN = false, MID = false;
    bf16* MIX; const bf16* GM; int gmoff;
    __device__ __forceinline__ void operator()(const pg8::f32x4 (&acc)[2][2][4][2], const pg8::Unit& u, int wr, int wc, int fr, int fq) const {
#pragma unroll
        for (int ai = 0; ai < 2; ++ai)
#pragma unroll
            for (int m = 0; m < 4; ++m) {
                const int row = u.pm * 256 + ai * 128 + wr * 64 + m * 16 + fr;
#pragma unroll
                for (int bj = 0; bj < 2; ++bj) {
                    const int col = u.pn * 256 + bj * 128 + wc * 32 + 8 * fq;
                    const v4u gmv = *(const GAS v4u*)(GM + (size_t)row * 2048 + gmoff + col);
                    float r[8];
                    r[0] = acc[ai][bj][m][0][0] * bflo(gmv.x); r[1] = acc[ai][bj][m][0][1] * bfhi(gmv.x); r[2] = acc[ai][bj][m][0][2] * bflo(gmv.y); r[3] = acc[ai][bj][m][0][3] * bfhi(gmv.y);
                    r[4] = acc[ai][bj][m][1][0] * bflo(gmv.z); r[5] = acc[ai][bj][m][1][1] * bfhi(gmv.z); r[6] = acc[ai][bj][m][1][2] * bflo(gmv.w); r[7] = acc[ai][bj][m][1][3] * bfhi(gmv.w);
                    GAS v4u* dp = (GAS v4u*)(MIX + (size_t)row * 1024 + col);
                    if (ADD) { const v4u old = *dp; r[0] += bflo(old.x); r[1] += bfhi(old.x); r[2] += bflo(old.y); r[3] += bfhi(old.y); r[4] += bflo(old.z); r[5] += bfhi(old.z); r[6] += bflo(old.w); r[7] += bfhi(old.w); }
                    v4u o; o.x = pkh(r[0], r[1]); o.y = pkh(r[2], r[3]); o.z = pkh(r[4], r[5]); o.w = pkh(r[6], r[7]); *dp = o; }
            }
    }
};
struct EpiMix2 {
    static constexpr bool PERM = true, AFTER_DRAIN = false, MID = true;
    bf16* MIX; const bf16* GM;
    __device__ __forceinline__ void mid(pg8::f32x4 (&acc)[2][2][4][2], const pg8::Unit& u, int wr, int wc, int fr, int fq) const {
#pragma unroll
        for (int ai = 0; ai < 2; ++ai)
#pragma unroll
            for (int m = 0; m < 4; ++m) {
                const int row = u.pm * 256 + ai * 128 + wr * 64 + m * 16 + fr;
#pragma unroll
                for (int bj = 0; bj < 2; ++bj) {
                    const int col = u.pn * 256 + bj * 128 + wc * 32 + 8 * fq;
                    const v4u g1 = *(const GAS v4u*)(GM + (size_t)row * 2048 + col), g2 = *(const GAS v4u*)(GM + (size_t)row * 2048 + 1024 + col);
                    const unsigned w1[4] = {g1.x, g1.y, g1.z, g1.w}, w2[4] = {g2.x, g2.y, g2.z, g2.w};
#pragma unroll
                    for (int n = 0; n < 2; ++n)
#pragma unroll
                        for (int i = 0; i < 4; ++i) { const unsigned a = w1[2 * n + (i >> 1)], b = w2[2 * n + (i >> 1)];
                            const float ga = (i & 1) ? bfhi(a) : bflo(a), gb = fmaxf((i & 1) ? bfhi(b) : bflo(b), 9.5367431640625e-07f);
                            acc[ai][bj][m][n][i] *= ga * __builtin_amdgcn_rcpf(gb); } }
            }
    }
    __device__ __forceinline__ void operator()(const pg8::f32x4 (&acc)[2][2][4][2], const pg8::Unit& u, int wr, int wc, int fr, int fq) const {
#pragma unroll
        for (int ai = 0; ai < 2; ++ai)
#pragma unroll
            for (int m = 0; m < 4; ++m) {
                const int row = u.pm * 256 + ai * 128 + wr * 64 + m * 16 + fr;
#pragma unroll
                for (int bj = 0; bj < 2; ++bj) {
                    const int col = u.pn * 256 + bj * 128 + wc * 32 + 8 * fq;
                    const v4u g2 = *(const GAS v4u*)(GM + (size_t)row * 2048 + 1024 + col);
                    const unsigned w2[4] = {g2.x, g2.y, g2.z, g2.w};
                    float r[8];
#pragma unroll
                    for (int n = 0; n < 2; ++n)
#pragma unroll
                        for (int i = 0; i < 4; ++i) { const unsigned b = w2[2 * n + (i >> 1)];
                            r[4 * n + i] = acc[ai][bj][m][n][i] * fmaxf((i & 1) ? bfhi(b) : bflo(b), 9.5367431640625e-07f); }
                    v4u o; o.x = pkh(r[0], r[1]); o.y = pkh(r[2], r[3]); o.z = pkh(r[4], r[5]); o.w = pkh(r[6], r[7]);
                    *(GAS v4u*)(MIX + (size_t)row * 1024 + col) = o; }
            }
    }
};
struct EpiRes {
    static constexpr bool PERM = true, AFTER_DRAIN = false, MID = false;
    const float* x; bf16* x1; const float* ada; int gate_idx;
    __device__ __forceinline__ void operator()(const pg8::f32x4 (&acc)[2][2][4][2], const pg8::Unit& u, int wr, int wc, int fr, int fq) const {
#pragma unroll
        for (int ai = 0; ai < 2; ++ai)
#pragma unroll
            for (int m = 0; m < 4; ++m) {
                const int row = u.pm * 256 + ai * 128 + wr * 64 + m * 16 + fr, b = row >> 12;
#pragma unroll
                for (int bj = 0; bj < 2; ++bj) {
                    const int col = u.pn * 256 + bj * 128 + wc * 32 + 8 * fq;
                    const float* gp = ada + (size_t)b * 6 * D + gate_idx * D + col; const float* xp = x + (size_t)row * D + col;
                    const f32x4 g0 = *(const GAS f32x4*)gp, g1 = *(const GAS f32x4*)(gp + 4), x0 = *(const GAS f32x4*)xp, x1v = *(const GAS f32x4*)(xp + 4);
                    const f32x4 r0 = x0 + g0 * acc[ai][bj][m][0], r1 = x1v + g1 * acc[ai][bj][m][1];
                    v4u o; o.x = pkh(r0.x, r0.y); o.y = pkh(r0.z, r0.w); o.z = pkh(r1.x, r1.y); o.w = pkh(r1.z, r1.w);
                    *(GAS v4u*)(x1 + (size_t)row * D + col) = o; }
            }
    }
};

template <int W> __device__ __forceinline__ void pool_load(const bf16* zp, int row, int t, int col, v4u (&z)[W]) {
#pragma unroll
    for (int j = 0; j < W; ++j) z[j] = (j <= t) ? *(const GAS v4u*)(zp + (size_t)(row - j) * 512 + col) : (v4u){0u, 0u, 0u, 0u};
}
template <int W> __device__ __forceinline__ v4u pool_reduce(const v4u (&z)[W], int t) {
    float s[8], self[8];
#pragma unroll
    for (int e = 0; e < 8; ++e) { s[e] = 0.f; self[e] = 0.f; }
#pragma unroll
    for (int j = 0; j < W; ++j) { const float f[8] = {bflo(z[j].x), bfhi(z[j].x), bflo(z[j].y), bfhi(z[j].y), bflo(z[j].z), bfhi(z[j].z), bflo(z[j].w), bfhi(z[j].w)};
#pragma unroll
        for (int e = 0; e < 8; ++e) { s[e] += f[e]; if (j == 0) self[e] = f[e]; } }
    const float inv = 1.0f / (float)((t + 1 < W) ? (t + 1) : W);
    v4u o; o.x = pk2(s[0] * inv - self[0], s[1] * inv - self[1]); o.y = pk2(s[2] * inv - self[2], s[3] * inv - self[3]);
    o.z = pk2(s[4] * inv - self[4], s[5] * inv - self[5]); o.w = pk2(s[6] * inv - self[6], s[7] * inv - self[7]);
    return o;
}
__device__ __forceinline__ void pool_phase(Frame& F) {
    const bf16* zp = (const bf16*)(F.ws + WS_ZP); bf16* pl = (bf16*)(F.ws + WS_PL);
    const int gw = F.bid * NWAVES + F.wave, NGW = F.G * NWAVES;
    for (int r4 = gw; r4 < M / 4; r4 += NGW) {
        const int row = 4 * r4 + (F.lane >> 4), t = row & 4095, c0 = 8 * (F.lane & 15);
        v4u z2[2], z4[4], z8[8], z16[16];
        pool_load<2>(zp, row, t, c0, z2); pool_load<4>(zp, row, t, 128 + c0, z4); pool_load<8>(zp, row, t, 256 + c0, z8); pool_load<16>(zp, row, t, 384 + c0, z16);
        const v4u o2 = pool_reduce<2>(z2, t), o4 = pool_reduce<4>(z4, t), o8 = pool_reduce<8>(z8, t), o16 = pool_reduce<16>(z16, t);
        GAS v4u* dst = (GAS v4u*)(pl + (size_t)row * 1024 + c0);
        dst[0] = o2; dst[16] = o4; dst[32] = o8; dst[48] = o16;
    }
}

typedef int v4i __attribute__((ext_vector_type(4)));
__device__ __forceinline__ unsigned pkf16(float a, float b) { return __builtin_bit_cast(unsigned, __builtin_amdgcn_cvt_pkrtz(a, b)); }
__device__ __forceinline__ float f16lo(unsigned w) { return (float)__builtin_bit_cast(_Float16, (unsigned short)(w & 0xffffu)); }
__device__ __forceinline__ float f16hi(unsigned w) { return (float)__builtin_bit_cast(_Float16, (unsigned short)(w >> 16)); }
struct EpiStoreBf16 {
    static constexpr bool PERM = true, AFTER_DRAIN = false, MID = false;
    bf16* O; int ldc;
    __device__ __forceinline__ void operator()(const pg8::f32x4 (&acc)[2][2][4][2], const pg8::Unit& u, int wr, int wc, int fr, int fq) const {
#pragma unroll
        for (int ai = 0; ai < 2; ++ai)
#pragma unroll
            for (int m = 0; m < 4; ++m) {
                const int row = u.pm * 256 + ai * 128 + wr * 64 + m * 16 + fr;
#pragma unroll
                for (int bj = 0; bj < 2; ++bj) {
                    const int col = u.pn * 256 + bj * 128 + wc * 32 + 8 * fq;
                    v4u o; o.x = pkf16(acc[ai][bj][m][0][0], acc[ai][bj][m][0][1]); o.y = pkf16(acc[ai][bj][m][0][2], acc[ai][bj][m][0][3]);
                    o.z = pkf16(acc[ai][bj][m][1][0], acc[ai][bj][m][1][1]); o.w = pkf16(acc[ai][bj][m][1][2], acc[ai][bj][m][1][3]);
                    *(GAS v4u*)(O + (size_t)row * ldc + col) = o; }
            }
    }
};

__device__ __forceinline__ unsigned fkey(float f) { const unsigned u = __builtin_bit_cast(unsigned, f); return (u >> 31) ? ~u : (u | 0x80000000u); }
__device__ __forceinline__ float funkey(unsigned k) { const unsigned u = (k >> 31) ? (k & 0x7fffffffu) : ~k; return __builtin_bit_cast(float, u); }
__device__ __forceinline__ unsigned umax_(unsigned a, unsigned b) { return a > b ? a : b; }
__device__ __forceinline__ unsigned umin_(unsigned a, unsigned b) { return a > b ? b : a; }
#define TOP16_INSERT(L, xin) do { unsigned _x = (xin); _Pragma("unroll") for (int _i = 0; _i < 16; ++_i) { const unsigned _h = umax_(L[_i], _x); _x = umin_(L[_i], _x); L[_i] = _h; } } while (0)
template <int MASK> __device__ __forceinline__ void top16_merge(unsigned (&L)[16]) {
    unsigned o[16];
#pragma unroll
    for (int i = 0; i < 16; ++i) o[i] = (unsigned)dppi<MASK == 1 ? DPP_XOR1 : DPP_XOR2>((int)L[i]);
#pragma unroll
    for (int i = 0; i < 16; ++i) L[i] = umax_(L[i], o[15 - i]);
#pragma unroll
    for (int d = 8; d >= 1; d >>= 1)
#pragma unroll
        for (int i = 0; i < 16; ++i) if ((i & d) == 0) { const unsigned hi = umax_(L[i], L[i + d]), lo = umin_(L[i], L[i + d]); L[i] = hi; L[i + d] = lo; }
}
#define CE_DESC(a_, b_) do { const unsigned _h = umax_(a_, b_), _l = umin_(a_, b_); a_ = _h; b_ = _l; } while (0)
template <int OFF> __device__ __forceinline__ void bitonic_sort16_desc(unsigned (&v)[32]) {
#pragma unroll
    for (int k = 2; k <= 16; k <<= 1)
#pragma unroll
        for (int j = k >> 1; j > 0; j >>= 1)
#pragma unroll
            for (int i = 0; i < 16; ++i) { const int l = i ^ j; if (l > i) { if ((i & k) == 0) CE_DESC(v[OFF + i], v[OFF + l]); else CE_DESC(v[OFF + l], v[OFF + i]); } }
}
__device__ __forceinline__ void bitonic_merge16_desc(unsigned (&L)[16]) {
#pragma unroll
    for (int d = 8; d >= 1; d >>= 1)
#pragma unroll
        for (int i = 0; i < 16; ++i) if ((i & d) == 0) CE_DESC(L[i], L[i + d]);
}
constexpr int SST = 132;
constexpr int P9_LIST_OFF = 2 * 64 * SST * 4;
__device__ __forceinline__ void peer_select_phase(Frame& F) {
    const unsigned short* S16 = (const unsigned short*)(F.ws + WS_QV);
    int* EID = (int*)(F.ws + WS_EID); float* GW = (float*)(F.ws + WS_GW);
    LAS unsigned* LIST = (LAS unsigned*)(F.lds + P9_LIST_OFF);
    const int lane = F.lane, w = F.wave;
    constexpr int NU = (M / 64) * PH;
    const int row = F.tid >> 2, sub = F.tid & 3, p1 = row >> 6, tk1 = row & 63;
    v4u sn[4];
#define P9_LOAD(u_) do { const int _tt = (u_) >> 3, _h = (u_) & 7; const unsigned short* sp_ = S16 + (size_t)(_tt * 64 + tk1) * PQW + _h * 256 + p1 * 128 + 32 * sub; \
        _Pragma("unroll") for (int q = 0; q < 4; ++q) sn[q] = *(const GAS v4u*)(sp_ + 8 * q); } while (0)
    if (F.bid < NU) P9_LOAD(F.bid);
    for (int u = F.bid; u < NU; u += F.G) {
        const int tt = u >> 3, h = u & 7, tok0 = tt * 64;
        {
            unsigned kv[32];
#pragma unroll
            for (int q = 0; q < 4; ++q) { const unsigned ww[4] = {sn[q].x, sn[q].y, sn[q].z, sn[q].w};
#pragma unroll
                for (int e = 0; e < 4; ++e) { kv[8 * q + 2 * e] = (fkey(f16lo(ww[e])) & ~127u) | (unsigned)(32 * sub + 8 * q + 2 * e);
                    kv[8 * q + 2 * e + 1] = (fkey(f16hi(ww[e])) & ~127u) | (unsigned)(32 * sub + 8 * q + 2 * e + 1); } }
            if (u + F.G < NU) P9_LOAD(u + F.G);
            bitonic_sort16_desc<0>(kv); bitonic_sort16_desc<16>(kv);
            unsigned L[16];
#pragma unroll
            for (int i = 0; i < 16; ++i) L[i] = umax_(kv[i], kv[31 - i]);
            bitonic_merge16_desc(L);
            top16_merge<1>(L); top16_merge<2>(L);
            if (sub == 0) {
#pragma unroll
                for (int i = 0; i < 4; ++i) *(LAS v4u*)(LIST + row * 16 + 4 * i) = (v4u){L[4 * i], L[4 * i + 1], L[4 * i + 2], L[4 * i + 3]}; }
        }
        __syncthreads();
        if (F.tid < 256) {
            const int tok = F.tid >> 2, sub = F.tid & 3;
            float va[16], vb[16];
#pragma unroll
            for (int i = 0; i < 4; ++i) { const v4u x = *(const LAS v4u*)(LIST + tok * 16 + 4 * i), y = *(const LAS v4u*)(LIST + (64 + tok) * 16 + 4 * i);
                va[4 * i] = funkey(x.x & ~127u); va[4 * i + 1] = funkey(x.y & ~127u); va[4 * i + 2] = funkey(x.z & ~127u); va[4 * i + 3] = funkey(x.w & ~127u);
                vb[4 * i] = funkey(y.x & ~127u); vb[4 * i + 1] = funkey(y.y & ~127u); vb[4 * i + 2] = funkey(y.z & ~127u); vb[4 * i + 3] = funkey(y.w & ~127u); }
            unsigned cand[32];
#pragma unroll
            for (int i = 0; i < 32; ++i) cand[i] = 0u;
            {
                constexpr int NC = 50;
                constexpr unsigned char CI[52] = {0,0,0,0,0,0,0,0,0,0,0,0,0,0,0,0, 1,1,1,1,1,1,1,1, 2,2,2,2,2, 3,3,3,3, 4,4,4, 5,5, 6,6, 7,7, 8,9,10,11,12,13,14,15, 0,0};
                constexpr unsigned char CJ[52] = {0,1,2,3,4,5,6,7,8,9,10,11,12,13,14,15, 0,1,2,3,4,5,6,7, 0,1,2,3,4, 0,1,2,3, 0,1,2, 0,1, 0,1, 0,1, 0,0,0,0,0,0,0,0, 0,0};
#pragma unroll
                for (int g4 = 0; g4 < 13; ++g4) {
                    float sa = 0.f, sb = 0.f; unsigned id = 0u; bool ok = false;
#pragma unroll
                    for (int q = 0; q < 4; ++q) { const int n = 4 * g4 + q; if (n < NC) { const bool me = (sub == q); sa = me ? va[CI[n]] : sa; sb = me ? vb[CJ[n]] : sb; id = me ? (unsigned)(CI[n] * 16 + CJ[n]) : id; ok = ok || me; } }
                    cand[g4] = ok ? ((fkey(sa + sb) & ~255u) | id) : 0u;
                }
            }
            bitonic_sort16_desc<0>(cand);
            unsigned L[16];
#pragma unroll
            for (int i = 0; i < 16; ++i) L[i] = cand[i];
            top16_merge<1>(L); top16_merge<2>(L);
            const float mx = funkey(L[0] & ~255u);
            float e[16], sum = 0.f;
#pragma unroll
            for (int k = 0; k < 16; ++k) { e[k] = __expf(funkey(L[k] & ~255u) - mx); sum += e[k]; }
            const float inv = 1.0f / sum;
            const size_t ob = (size_t)(tok0 + tok) * 128;
#pragma unroll
            for (int k4 = 0; k4 < 4; ++k4) if (sub == k4) {
#pragma unroll
                for (int q = 0; q < 4; ++q) { const unsigned cid = L[4 * k4 + q] & 255u;
                    const unsigned ia = LIST[tok * 16 + (cid >> 4)] & 127u, ib = LIST[(64 + tok) * 16 + (cid & 15u)] & 127u;
                    const int slot = h * 16 + 4 * k4 + q;
                    EID[ob + slot] = (int)(ia * 128u + ib); GW[ob + slot] = e[4 * k4 + q] * inv; }
            }
        }
        __syncthreads();
    }
#undef P9_LOAD
}

__device__ __forceinline__ void unpack8(const v4u w, float (&f)[8]) { f[0] = bflo(w.x); f[1] = bfhi(w.x); f[2] = bflo(w.y); f[3] = bfhi(w.y); f[4] = bflo(w.z); f[5] = bfhi(w.z); f[6] = bflo(w.w); f[7] = bfhi(w.w); }
typedef float f32x2 __attribute__((ext_vector_type(2)));
__device__ __forceinline__ void unpack16_fp8(const v4u w, float (&f)[16]) {
    const unsigned ww[4] = {w.x, w.y, w.z, w.w};
#pragma unroll
    for (int d = 0; d < 4; ++d) { const f32x2 a = __builtin_amdgcn_cvt_pk_f32_fp8((int)ww[d], false), b = __builtin_amdgcn_cvt_pk_f32_fp8((int)ww[d], true);
        f[4 * d] = a.x; f[4 * d + 1] = a.y; f[4 * d + 2] = b.x; f[4 * d + 3] = b.y; }
}
template <int PV_> __device__ __forceinline__ void peer_dot_phase(Frame& F) {
    const unsigned char* H8 = F.ws + WS_H8; const int* EID = (const int*)(F.ws + WS_EID); float* PART = (float*)(F.ws + WS_PART);
    const int lane = F.lane, g = lane >> 3, j = lane & 7, x = F.bid & 7;
    const int nbx = (F.G - x + 7) >> 3, NW = nbx * NWAVES, gwv = (F.bid >> 3) * NWAVES + F.wave;
    const unsigned char* US = F.ws + WS_UB + (size_t)x * NEXP * 128; const unsigned j16 = 16u * (unsigned)j;
    int token = gwv;
    if (token >= M) return;
    const int lasttok = gwv + ((M - 1 - gwv) / NW) * NW;
    v4i eA[4], eB[4]; v4i hA, hB;
#define PD_CL(t_) ((t_) < M ? (t_) : lasttok)
#define PD_LOAD_E(e_, tok_) do { _Pragma("unroll") for (int q = 0; q < 4; ++q) e_[q] = *(const GAS v4i*)(EID + (size_t)(tok_) * 128 + 16 * g + 4 * q); } while (0)
#define PD_ISSUE4(buf_, e_, b0_) do { buf_[b0_] = *(const GAS v4i*)(US + ((unsigned)e_.x * 128u + j16)); buf_[b0_ + 1] = *(const GAS v4i*)(US + ((unsigned)e_.y * 128u + j16)); \
        buf_[b0_ + 2] = *(const GAS v4i*)(US + ((unsigned)e_.z * 128u + j16)); buf_[b0_ + 3] = *(const GAS v4i*)(US + ((unsigned)e_.w * 128u + j16)); } while (0)
#define PD_DOT1(w_, hc_, dst_) do { int t = __builtin_amdgcn_sdot4(w_.x, hc_.x, 0, false); t = __builtin_amdgcn_sdot4(w_.y, hc_.y, t, false); t = __builtin_amdgcn_sdot4(w_.z, hc_.z, t, false); t = __builtin_amdgcn_sdot4(w_.w, hc_.w, t, false); \
        t += dppi<DPP_XOR1>(t); t += dppi<DPP_XOR2>(t); t += dppi<DPP_HMIR>(t); dst_ = (float)t; } while (0)
#define PD_BODY(eC, eN, hC, hN, tok_) do { const int tk_ = PD_CL(tok_); \
        PD_ISSUE4(bB, eC[2], 0); PD_ISSUE4(bB, eC[3], 4); \
        PD_LOAD_E(eC, PD_CL(tk_ + 2 * NW)); \
        hN = *(const GAS v4i*)(H8 + (size_t)PD_CL(tk_ + NW) * D + 128 * x + j16); \
        float s[16]; \
        _Pragma("unroll") for (int i = 0; i < 8; ++i) PD_DOT1(bA[i], hC, s[i]); \
        PD_ISSUE4(bA, eN[0], 0); PD_ISSUE4(bA, eN[1], 4); \
        _Pragma("unroll") for (int i = 0; i < 8; ++i) PD_DOT1(bB[i], hC, s[8 + i]); \
        { float* pp = PART + ((size_t)x * M + tk_) * 128 + g * 16;       \
          _Pragma("unroll") for (int i4 = 0; i4 < 4; ++i4) *(GAS f32x4*)(pp + 4 * i4) = (f32x4){s[4 * i4], s[4 * i4 + 1], s[4 * i4 + 2], s[4 * i4 + 3]}; } } while (0)
    PD_LOAD_E(eA, token); hA = *(const GAS v4i*)(H8 + (size_t)token * D + 128 * x + j16);
    PD_LOAD_E(eB, PD_CL(token + NW));
    v4i bA[8], bB[8];
    PD_ISSUE4(bA, eA[0], 0); PD_ISSUE4(bA, eA[1], 4);
    __builtin_amdgcn_s_waitcnt(0x0F70);
    for (; token < M; token += 2 * NW) {
        PD_BODY(eA, eB, hA, hB, token);
        PD_BODY(eB, eA, hB, hA, token + NW);
    }
#undef PD_BODY
#undef PD_CL
#undef PD_LOAD_E
#undef PD_ISSUE4
#undef PD_DOT1
}
template <int NTOK> __device__ __forceinline__ void peer_loadrate_probe(Frame& F) {
    const int* EID = (const int*)(F.ws + WS_EID);
    const int lane = F.lane, g = lane >> 3, j = lane & 7, x = F.bid & 7;
    const int nbx = (F.G - x + 7) >> 3, NW = nbx * NWAVES, gwv = (F.bid >> 3) * NWAVES + F.wave;
    const unsigned char* US = F.ws + WS_UB + (size_t)x * NEXP * 128; const unsigned j16 = 16u * (unsigned)j;
    unsigned acc = 0u;
    for (int token = gwv; token + (NTOK - 1) * NW < M; token += NTOK * NW) {
        v4i e4[NTOK][4];
#pragma unroll
        for (int t = 0; t < NTOK; ++t)
#pragma unroll
            for (int q = 0; q < 4; ++q) e4[t][q] = *(const GAS v4i*)(EID + (size_t)(token + t * NW) * 128 + 16 * g + 4 * q);
        v4i b[NTOK][16];
#pragma unroll
        for (int t = 0; t < NTOK; ++t)
#pragma unroll
            for (int q = 0; q < 4; ++q) { b[t][4 * q] = *(const GAS v4i*)(US + ((unsigned)e4[t][q].x * 128u + j16)); b[t][4 * q + 1] = *(const GAS v4i*)(US + ((unsigned)e4[t][q].y * 128u + j16));
                b[t][4 * q + 2] = *(const GAS v4i*)(US + ((unsigned)e4[t][q].z * 128u + j16)); b[t][4 * q + 3] = *(const GAS v4i*)(US + ((unsigned)e4[t][q].w * 128u + j16)); }
#pragma unroll
        for (int t = 0; t < NTOK; ++t)
#pragma unroll
            for (int i = 0; i < 16; ++i) acc ^= (unsigned)(b[t][i].x ^ b[t][i].y ^ b[t][i].z ^ b[t][i].w);
    }
    asm volatile("" :: "v"(acc));
}
__device__ __forceinline__ void peer_coef_phase(Frame& F) {
    const float* PART = (const float*)(F.ws + WS_PART); const int* EID = (const int*)(F.ws + WS_EID); const float* GW = (const float*)(F.ws + WS_GW);
    const float* SCU = (const float*)(F.ws + WS_SCLU); const float* SCV = (const float*)(F.ws + WS_SCLV); const float* HS = (const float*)(F.ws + WS_HS);
    unsigned* CF8 = (unsigned*)(F.ws + WS_CF); float* CFS = (float*)(F.ws + WS_CFS);
    const size_t gtid = (size_t)F.bid * NTHREADS + F.tid, gthreads = (size_t)F.G * NTHREADS, n4 = (size_t)M * 128 / 4;
    for (size_t i4 = gtid; i4 < n4; i4 += gthreads) {
        f32x4 d = *(const GAS f32x4*)(PART + 4 * i4);
#pragma unroll
        for (int xx = 1; xx < 8; ++xx) d = d + *(const GAS f32x4*)(PART + (size_t)xx * M * 128 + 4 * i4);
        const v4i e = *(const GAS v4i*)(EID + 4 * i4); const f32x4 gw = *(const GAS f32x4*)(GW + 4 * i4);
        const float hs = HS[i4 >> 5];
        f32x4 r; r.x = gw.x * SCV[e.x] * gelu_tanh_safe(d.x * (SCU[e.x] * hs)); r.y = gw.y * SCV[e.y] * gelu_tanh_safe(d.y * (SCU[e.y] * hs));
        r.z = gw.z * SCV[e.z] * gelu_tanh_safe(d.z * (SCU[e.z] * hs)); r.w = gw.w * SCV[e.w] * gelu_tanh_safe(d.w * (SCU[e.w] * hs));
        float m = fmaxf(fmaxf(fabsf(r.x), fabsf(r.y)), fmaxf(fabsf(r.z), fabsf(r.w)));
        m = fmaxf(m, dppf<DPP_XOR1>(m)); m = fmaxf(m, dppf<DPP_XOR2>(m)); m = fmaxf(m, dppf<DPP_HMIR>(m)); m = fmaxf(m, dppf<DPP_ROR8>(m)); m = max_xor16(m);
        const unsigned E = (__builtin_bit_cast(unsigned, m) >> 23) & 0xffu; float sc = 1.f, isc = 1.f;
        if (E >= 8u && E <= 250u) { sc = __builtin_bit_cast(float, (261u - E) << 23); isc = __builtin_bit_cast(float, (E - 7u) << 23); }
        int t = __builtin_amdgcn_cvt_pk_fp8_f32(r.x * sc, r.y * sc, 0, false); t = __builtin_amdgcn_cvt_pk_fp8_f32(r.z * sc, r.w * sc, t, true);
        CF8[i4] = (unsigned)t;
        if ((F.lane & 31) == 0) CFS[i4 >> 5] = isc; }
}
template <bool DRY, bool CHECK = false> __device__ __forceinline__ void peer_out_phase(Frame& F, const float* ada, float* out) {
    const int* EID = (const int*)(F.ws + WS_EID); const unsigned char* CF8 = (const unsigned char*)(F.ws + WS_CF); const float* CFS = (const float*)(F.ws + WS_CFS);
    const int lane = F.lane, g = lane >> 3, j = lane & 7, x = F.bid & 7;
    const int nbx = (F.G - x + 7) >> 3, NW = nbx * NWAVES, gwv = (F.bid >> 3) * NWAVES + F.wave;
    const unsigned char* VS = F.ws + WS_VB + (size_t)x * NEXP * 128; const unsigned j16 = 16u * (unsigned)j;
    if (gwv >= M) return;
    const int ntok = (M - 1 - gwv) / NW + 1;
#define PO_ISSUE4(buf_, e_, b0_) do { buf_[b0_] = *(const GAS v4u*)(VS + ((unsigned)e_.x * 128u + j16)); buf_[b0_ + 1] = *(const GAS v4u*)(VS + ((unsigned)e_.y * 128u + j16)); \
        buf_[b0_ + 2] = *(const GAS v4u*)(VS + ((unsigned)e_.z * 128u + j16)); buf_[b0_ + 3] = *(const GAS v4u*)(VS + ((unsigned)e_.w * 128u + j16)); } while (0)
#define PO_ROW(w_, c_) do { float f[16]; unpack16_fp8(w_, f); _Pragma("unroll") for (int k = 0; k < 16; ++k) o[k] += (c_) * f[k]; } while (0)
#define PO_ACC4(buf_, c4_, b0_) do { PO_ROW(buf_[b0_], c4_.x); PO_ROW(buf_[b0_ + 1], c4_.y); PO_ROW(buf_[b0_ + 2], c4_.z); PO_ROW(buf_[b0_ + 3], c4_.w); } while (0)
    v4i e4[4]; f32x4 c4[4]; v4u bA[8], bB[8];
#define PO_LOADC(tok_) do { const float cs_ = CFS[tok_]; _Pragma("unroll") for (int q = 0; q < 4; ++q) { const unsigned w_ = *(const GAS unsigned*)(CF8 + (size_t)(tok_) * 128 + g * 16 + 4 * q); \
        const f32x2 lo_ = __builtin_amdgcn_cvt_pk_f32_fp8((int)w_, false), hi_ = __builtin_amdgcn_cvt_pk_f32_fp8((int)w_, true); c4[q] = (f32x4){lo_.x * cs_, lo_.y * cs_, hi_.x * cs_, hi_.y * cs_}; } } while (0)
#pragma unroll
    for (int q = 0; q < 4; ++q) e4[q] = *(const GAS v4i*)(EID + (size_t)gwv * 128 + g * 16 + 4 * q);
    PO_LOADC(gwv);
    PO_ISSUE4(bA, e4[0], 0); PO_ISSUE4(bA, e4[1], 4);
    for (int it = 0; it < ntok; ++it) {
        const int token = gwv + it * NW, tn = gwv + (it + 1 < ntok ? it + 1 : it) * NW;
        PO_ISSUE4(bB, e4[2], 0); PO_ISSUE4(bB, e4[3], 4);
#pragma unroll
        for (int q = 0; q < 4; ++q) e4[q] = *(const GAS v4i*)(EID + (size_t)tn * 128 + g * 16 + 4 * q);
        float o[16];
#pragma unroll
        for (int k = 0; k < 16; ++k) o[k] = 0.f;
        PO_ACC4(bA, c4[0], 0); PO_ACC4(bA, c4[1], 4);
        PO_ISSUE4(bA, e4[0], 0); PO_ISSUE4(bA, e4[1], 4);
        PO_ACC4(bB, c4[2], 0); PO_ACC4(bB, c4[3], 4);
        PO_LOADC(tn);
#pragma unroll
        for (int k = 0; k < 16; ++k) { float t = o[k]; t += dppf<DPP_ROR8>(t); o[k] = sum_xor32(sum_xor16(t)); }
        if (g == 0) { const int b = token >> 12;
            const float* gt = ada + (size_t)b * 6 * D + 5 * D + 128 * x + 16 * j;
            float* xo = out + (size_t)token * D + 128 * x + 16 * j;
#pragma unroll
            for (int q = 0; q < 4; ++q) { const f32x4 xv = *(const GAS f32x4*)(xo + 4 * q), gv = *(const GAS f32x4*)(gt + 4 * q);
                f32x4 res = xv + gv * (f32x4){o[4 * q], o[4 * q + 1], o[4 * q + 2], o[4 * q + 3]};
                if (CHECK) { const f32x4 mf = *(const GAS f32x4*)((const float*)(F.ws + WS_PART) + (size_t)token * D + 128 * x + 16 * j + 4 * q);
                    const float rr[4] = {o[4 * q], o[4 * q + 1], o[4 * q + 2], o[4 * q + 3]}, mm[4] = {mf.x, mf.y, mf.z, mf.w}; bool bad = false;
#pragma unroll
                    for (int z = 0; z < 4; ++z) bad = bad || !(fabsf(rr[z] - mm[z]) <= 0.01f * fabsf(rr[z]) + 1.0e-3f);
                    if (bad) res.x = 1.0e9f; }
                if (DRY) { asm volatile("" :: "v"(res.x), "v"(res.y), "v"(res.z), "v"(res.w)); } else *(GAS f32x4*)(xo + 4 * q) = res; } }
    }
#undef PO_LOADC
#undef PO_ISSUE4
#undef PO_ROW
#undef PO_ACC4
}

constexpr int PO_TILE = 64 * 144;
template <int MODE> __device__ __forceinline__ void peer_out_mfma_phase(Frame& F, const float* ada, float* out) {
    const int* EID = (const int*)(F.ws + WS_EID); const unsigned char* CF8 = (const unsigned char*)(F.ws + WS_CF); const float* CFS = (const float*)(F.ws + WS_CFS);
    const int lane = F.lane, g = lane >> 3, j = lane & 7, l15 = lane & 15, lq = lane >> 4, x = F.bid & 7;
    const int nbx = (F.G - x + 7) >> 3, NW = nbx * NWAVES, gwv = (F.bid >> 3) * NWAVES + F.wave;
    const unsigned char* VS = F.ws + WS_VB + (size_t)x * NEXP * 128; const unsigned j16 = 16u * (unsigned)j;
    LAS unsigned char* TL = F.lds + F.wave * PO_TILE;
    if (gwv >= M) return;
    const int nst = 2 * ((M - 1 - gwv) / NW + 1);
    const int trow = l15 >> 1, tcol = 8 * (l15 & 1);
#define PM_IDS(e_, a_, tok_) do { const size_t base = (size_t)(tok_) * 128; \
        _Pragma("unroll") for (int m = 0; m < 16; ++m) e_[m] = EID[base + 8 * m + g]; \
        _Pragma("unroll") for (int q = 0; q < 4; ++q) a_[q] = *(const GAS long*)(CF8 + base + 32 * q + 8 * lq); } while (0)
#define PM_GATHER(vv_, e_, h_) do { _Pragma("unroll") for (int m = 0; m < 8; ++m) vv_[m] = *(const GAS v4u*)(VS + ((unsigned)e_[8 * (h_) + m] * 128u + j16)); } while (0)
#define PM_HALF(vv_, aq0_, aq1_) do { _Pragma("unroll") for (int m = 0; m < 8; ++m) *(LAS v4u*)(TL + (8 * m + g) * 144 + 16 * j) = vv_[m]; } while (0)
#define PM_MMA(aq0_, aq1_) do { LDS_WAIT(); asm volatile("" ::: "memory"); \
        _Pragma("unroll") for (int ks = 0; ks < 2; ++ks) _Pragma("unroll") for (int cb = 0; cb < 8; ++cb) { \
            const v2i bb = __builtin_amdgcn_ds_read_tr8_b64_v2i32((LAS v2i*)(TL + (32 * ks + 8 * lq + trow) * 144 + 16 * cb + tcol)); \
            acc[cb] = __builtin_amdgcn_mfma_f32_16x16x32_fp8_fp8(ks ? (aq1_) : (aq0_), __builtin_bit_cast(long, bb), acc[cb], 0, 0, 0); } \
        LDS_WAIT(); asm volatile("" ::: "memory"); } while (0)
    const int ntok = nst >> 1;
    int e1[16], e2[16]; long a0[4], a1[4], a2[4]; v4u vvA[8], vvB[8];
    PM_IDS(e1, a0, gwv);
    PM_GATHER(vvA, e1, 0); PM_GATHER(vvB, e1, 1);
    { const int t1 = ntok > 1 ? 1 : 0; PM_IDS(e1, a1, gwv + t1 * NW); }
    f32x4 acc[8];
    for (int it = 0; it < ntok; ++it) {
        const int token = gwv + it * NW;
        { const int t2 = it + 2 < ntok ? it + 2 : ntok - 1; PM_IDS(e2, a2, gwv + t2 * NW); }
#pragma unroll
        for (int cb = 0; cb < 8; ++cb) acc[cb] = (f32x4){0.f, 0.f, 0.f, 0.f};
        float xv[8], gv[8]; float cs;
        { const int b = token >> 12; const float* gt = ada + (size_t)b * 6 * D + 5 * D + 128 * x + l15; const bf16* xi = (const bf16*)(F.ws + WS_X1) + (size_t)token * D + 128 * x + l15;
          cs = CFS[token];
#pragma unroll
          for (int cb = 0; cb < 8; ++cb) { xv[cb] = bflo((unsigned)xi[16 * cb]); gv[cb] = gt[16 * cb]; } }
        PM_HALF(vvA, 0, 0); PM_GATHER(vvA, e1, 0); PM_MMA(a0[0], a0[1]);
        PM_HALF(vvB, 0, 0); PM_GATHER(vvB, e1, 1); PM_MMA(a0[2], a0[3]);
        if (lq == 0) {
            if (MODE == 1) { float* oc = (float*)(F.ws + WS_PART) + (size_t)token * D + 128 * x + l15;
#pragma unroll
                for (int cb = 0; cb < 8; ++cb) oc[16 * cb] = acc[cb][0] * cs; }
            else { float* xo = out + (size_t)token * D + 128 * x + l15;
#pragma unroll
                for (int cb = 0; cb < 8; ++cb) xo[16 * cb] = xv[cb] + gv[cb] * (acc[cb][0] * cs); }
        }
#pragma unroll
        for (int m = 0; m < 16; ++m) e1[m] = e2[m];
#pragma unroll
        for (int q = 0; q < 4; ++q) { a0[q] = a1[q]; a1[q] = a2[q]; }
    }
#undef PM_HALF
#undef PM_MMA
#undef PM_IDS
#undef PM_GATHER
}

__device__ __forceinline__ void compress_phase(Frame& F, const float* kng) {
    LAS bf16* H2 = (LAS bf16*)(F.lds);
    LAS float* OUTS = (LAS float*)(F.lds + 16384);
    const int lane = F.lane, w = F.wave, l15 = lane & 15, lq = lane >> 4;
    for (int u = F.bid; u < NBG * 2 * 8; u += F.G) {
        const int ns = u & 7, kv = (u >> 3) & 1, bg = u >> 4, n0 = ns * 32;
        const bf16* A = (const bf16*)(F.ws + (kv ? WS_VCR : WS_KCR)) + (size_t)bg * SEQ * 64;
        const bf16* W1T = (const bf16*)(F.ws + (kv ? WS_CW1V_T : WS_CW1K_T));
        const bf16* W2T = (const bf16*)(F.ws + (kv ? WS_CW2V_T : WS_CW2K_T));
        const float* b1 = (const float*)(F.ws + (kv ? WS_CB1V : WS_CB1K));
        pg8::f32x4 acc[2][8];
#pragma unroll
        for (int rb = 0; rb < 2; ++rb)
#pragma unroll
            for (int cb = 0; cb < 8; ++cb) acc[rb][cb] = (pg8::f32x4){0.f, 0.f, 0.f, 0.f};
        const bf16* ap = A + (size_t)(n0 + l15) * 1024 + 256 * w + 8 * lq;
        const bf16* bp = W1T + (size_t)l15 * 2048 + 256 * w + 8 * lq;
#pragma unroll
        for (int ks = 0; ks < 8; ++ks) {
            const bf16x8 a0 = *(const GAS bf16x8*)(ap + 32 * ks), a1 = *(const GAS bf16x8*)(ap + 16 * 1024 + 32 * ks);
#pragma unroll
            for (int cb = 0; cb < 8; ++cb) { const bf16x8 b = *(const GAS bf16x8*)(bp + (size_t)(16 * cb) * 2048 + 32 * ks);
                acc[0][cb] = __builtin_amdgcn_mfma_f32_16x16x32_bf16(a0, b, acc[0][cb], 0, 0, 0);
                acc[1][cb] = __builtin_amdgcn_mfma_f32_16x16x32_bf16(a1, b, acc[1][cb], 0, 0, 0); }
        }
        { LAS float* PS = (LAS float*)(F.lds + 32768);
          LAS float* mine = PS + (w & 3) * 4096 + (4 * lq) * 128 + l15;
          if (w >= 4) {
#pragma unroll
              for (int rb = 0; rb < 2; ++rb)
#pragma unroll
                  for (int cb = 0; cb < 8; ++cb)
#pragma unroll
                      for (int r = 0; r < 4; ++r) mine[(16 * rb + r) * 128 + 16 * cb] = acc[rb][cb][r]; }
          __syncthreads();
          if (w < 4) {
#pragma unroll
              for (int rb = 0; rb < 2; ++rb)
#pragma unroll
                  for (int cb = 0; cb < 8; ++cb)
#pragma unroll
                      for (int r = 0; r < 4; ++r) { LAS float* q = mine + (16 * rb + r) * 128 + 16 * cb; *q = acc[rb][cb][r] + *q; } }
          __syncthreads();
#pragma unroll
          for (int i = 0; i < 8; ++i) { const int idx = F.tid + 512 * i, row = idx >> 7, col = idx & 127;
              const float v = ((PS[idx] + PS[4096 + idx]) + (PS[8192 + idx] + PS[12288 + idx])) + b1[col];
              H2[row * 136 + col] = (bf16)f2bf(gelu_tanh_safe(v)); } }
        __syncthreads();
        { const int rb = w >> 2, db = w & 3;
          pg8::f32x4 o = (pg8::f32x4){0.f, 0.f, 0.f, 0.f};
#pragma unroll
          for (int ks = 0; ks < 4; ++ks) {
              const bf16x8 a = *(const LAS bf16x8*)(H2 + (16 * rb + l15) * 136 + 32 * ks + 8 * lq);
              const bf16x8 b = *(const GAS bf16x8*)(W2T + (size_t)(16 * db + l15) * 128 + 32 * ks + 8 * lq);
              o = __builtin_amdgcn_mfma_f32_16x16x32_bf16(a, b, o, 0, 0, 0); }
#pragma unroll
          for (int r = 0; r < 4; ++r) OUTS[(16 * rb + 4 * lq + r) * 65 + 16 * db + l15] = o[r]; }
        __syncthreads();
        { const int n = F.tid >> 4, d4 = (F.tid & 15) * 4, ng = n0 + n;
          float v[4]; float ss = 0.f;
#pragma unroll
          for (int i = 0; i < 4; ++i) { v[i] = OUTS[n * 65 + d4 + i]; ss += v[i] * v[i]; }
          ss += dppf<DPP_XOR1>(ss); ss += dppf<DPP_XOR2>(ss); ss += dppf<DPP_HMIR>(ss); ss += dppf<DPP_ROR8>(ss);
          const bool pad = (ng >= NCMP);
          if (kv == 0) { const float rs = rsqrtf(ss * (1.f / 64.f) + EPS);
              v2u o; o.x = pad ? 0u : pk2(v[0] * rs * kng[d4], v[1] * rs * kng[d4 + 1]); o.y = pad ? 0u : pk2(v[2] * rs * kng[d4 + 2], v[3] * rs * kng[d4 + 3]);
              *(GAS v2u*)((bf16*)(F.ws + WS_KC) + ((size_t)bg * 256 + ng) * 64 + d4) = o; }
          else { bf16* vt = (bf16*)(F.ws + WS_VCT) + (size_t)bg * 64 * 256 + ng;
#pragma unroll
              for (int i = 0; i < 4; ++i) vt[(size_t)(d4 + i) * 256] = pad ? (bf16)0 : (bf16)f2bf(v[i]); } }
        __syncthreads();
    }
}
__device__ __forceinline__ void vtranspose_phase(Frame& F) {
    LAS bf16* T = (LAS bf16*)(F.lds + F.wave * 9216);
    const int gw = F.bid * NWAVES + F.wave, NGW = F.G * NWAVES, lane = F.lane;
    for (int job = gw; job < 2 * NBG * 64; job += NGW) {
        const int s = job & 63, bg = (job >> 6) & 15, which = job >> 10;
        const bf16* X = (const bf16*)(F.ws + (which ? WS_VW : WS_VS)) + ((size_t)bg * SEQ + 64 * s) * 64;
        bf16* XT = (bf16*)(F.ws + (which ? WS_VWT : WS_VST)) + (size_t)bg * 64 * SEQ + 64 * s;
#pragma unroll
        for (int i = 0; i < 8; ++i) { const int tok = (lane >> 3) + 8 * i, ch = lane & 7;
            const v4u x = *(const GAS v4u*)(X + (size_t)tok * 64 + 8 * ch);
            const unsigned ww[4] = {x.x, x.y, x.z, x.w};
#pragma unroll
            for (int e = 0; e < 4; ++e) { T[(8 * ch + 2 * e) * 72 + tok] = (bf16)(ww[e] & 0xffffu); T[(8 * ch + 2 * e + 1) * 72 + tok] = (bf16)(ww[e] >> 16); } }
        LDS_WAIT(); asm volatile("" ::: "memory");
#pragma unroll
        for (int i = 0; i < 8; ++i) { const int dim = (lane >> 3) + 8 * i, ch = lane & 7;
            const v4u y = *(const LAS v4u*)(T + dim * 72 + 8 * ch);
            *(GAS v4u*)(XT + (size_t)dim * SEQ + 8 * ch) = y; }
        LDS_WAIT(); asm volatile("" ::: "memory");
    }
}

constexpr int AT_KBUF = 64 * 128;
constexpr int AT_NBUF = 2;
constexpr int AT_OFF_K = 0, AT_OFF_V = AT_NBUF * AT_KBUF;
constexpr int AT_OFF_IMP1 = 2 * AT_NBUF * AT_KBUF, AT_OFF_IMP2 = AT_OFF_IMP1 + 64 * 65 * 4, AT_OFF_SEL = AT_OFF_IMP2 + 64 * 65 * 4;
constexpr int AT_OFF_LUT = AT_OFF_SEL + 512, AT_OFF_LROW = AT_OFF_LUT + 4 * 128 * 4;
constexpr int AT_OFF_TD = AT_OFF_LROW + 8 * 32 * 4;
constexpr int AT_OFF_OUT = AT_OFF_TD + 96 * 32;
constexpr int AT_OFF_GATL = AT_OFF_OUT + 256 * 144;
constexpr int AT_OFF_TS = AT_OFF_GATL + 64 * 12 * 4;
constexpr int AT_TS_ROW = 65 * 16;
constexpr int AT_LDS_END = AT_OFF_TS + 16 * AT_TS_ROW;
static_assert(AT_LDS_END <= RING_BYTES, "attention LDS");

struct AtTile { const bf16* k; const bf16* vt; int vstride; };
enum { TM_CMP1 = 0, TM_CMP2, TM_SELN, TM_SELF, TM_WINN, TM_WINF, TM_WINE, TM_CMP1F, TM_CMP2F };
__device__ __forceinline__ float fexp2(float x) { return __builtin_amdgcn_exp2f(x); }
template <int TM, int VAR, int RB = 3>
__device__ __forceinline__ void at_tile(const LAS unsigned char* kb_, const LAS unsigned char* vb_, const LAS float* LUTJ, LAS float* IMP1, LAS float* IMP2,
                                        const bf16x8 (&qf)[2][2], pg8::f32x4 (&oacc)[2][4], pg8::f32x4 (&lacc)[2], const LAS float* LINV,
                                        const int (&tok_r_in)[2], const unsigned (&selb)[2], float cfar, int relbase, int idx, int l15_in, int lq_in, const LAS unsigned char* tsw, const LAS unsigned char* tsn) {
    constexpr bool FAR = (TM == TM_SELF || TM == TM_WINF || TM == TM_WINE || TM == TM_CMP1F || TM == TM_CMP2F);
    constexpr bool C1 = (TM == TM_CMP1 || TM == TM_CMP1F), C2 = (TM == TM_CMP2 || TM == TM_CMP2F);
    int l15 = l15_in, lq = lq_in; asm volatile("" : "+v"(l15), "+v"(lq));
    int tok_r[2] = {tok_r_in[0], tok_r_in[1]}; asm volatile("" : "+v"(tok_r[0]), "+v"(tok_r[1]));
    v4u pfr[2][2];
    const LAS unsigned char* tsp[2] = {tsw, tsw};
    if (TM == TM_SELN || TM == TM_WINN) {
#pragma unroll
        for (int rb = 0; rb < 2; ++rb) { const LAS unsigned char* pa = tsw + l15 * AT_TS_ROW + 16 * (2 * lq - rb) - 4 * relbase;
            const LAS unsigned char* pn = tsn + l15 * AT_TS_ROW;
            tsp[rb] = (TM == TM_SELN && !selb[rb]) ? pn : pa; } }
    auto kld = [&](int cb, bf16x8 (&kf)[2], pg8::f32x4 (&cq)[2]) __attribute__((always_inline)) {
        if (TM == TM_SELN || TM == TM_WINN) {
#pragma unroll
            for (int rb = 0; rb < 2; ++rb) cq[rb] = *(const LAS pg8::f32x4*)(tsp[rb] + 16 * (8 * (cb >> 1) + (cb & 1))); }
        if (!(VAR & 64)) {
        const int krow = 8 * (l15 >> 2) + (l15 & 3) + 32 * (cb >> 1) + 4 * (cb & 1), kf_ = ((l15 >> 2) << 1) | ((l15 >> 1) & 1);
#pragma unroll
        for (int ks = 0; ks < 2; ++ks) kf[ks] = *(const LAS bf16x8*)(kb_ + krow * 128 + 16 * ((4 * ks + lq) ^ kf_)); }
    };
    auto qkm = [&](int cb, const bf16x8 (&kf)[2], const pg8::f32x4 (&cq)[2], pg8::f32x4 (&st)[2]) __attribute__((always_inline)) {
        st[0] = FAR ? (pg8::f32x4){cfar, cfar, cfar, cfar} : (pg8::f32x4){0.f, 0.f, 0.f, 0.f}; st[1] = st[0];
        if (TM == TM_SELN || TM == TM_WINN) { st[0] = cq[0]; st[1] = cq[1]; }
        if (TM == TM_SELF) {
#pragma unroll
            for (int rb = 0; rb < 2; ++rb) { const float ci = selb[rb] ? cfar : -1.0e30f; st[rb] = (pg8::f32x4){ci, ci, ci, ci}; } }
        if (!(VAR & 64)) {
#pragma unroll
        for (int ks = 0; ks < 2; ++ks) {
#pragma unroll
            for (int rb = 0; rb < 2; ++rb) if (RB & (1 << rb)) st[rb] = __builtin_amdgcn_mfma_f32_16x16x32_bf16(kf[ks], qf[rb][ks], st[rb], 0, 0, 0); } }
    };
    float linv_[2] = {0.f, 0.f};
    if (C2) { linv_[0] = LINV[l15]; linv_[1] = LINV[16 + l15]; }
    auto prob = [&](int cb, const pg8::f32x4 (&st)[2]) __attribute__((always_inline)) {
#pragma unroll
        for (int rb = 0; rb < 2; ++rb) if (RB & (1 << rb)) {
            const int tokc = tok_r[rb];
            float p[4];
#pragma unroll
            for (int r = 0; r < 4; ++r) {
                const int kl = 32 * (cb >> 1) + 8 * lq + 4 * (cb & 1) + r;
                if (VAR & 16) { p[r] = st[rb][r]; }
                else if (TM == TM_SELF) { p[r] = fexp2(st[rb][r]); }
                else if (TM == TM_WINF || TM == TM_SELN || TM == TM_WINN || TM == TM_CMP1F || TM == TM_CMP2F) { p[r] = fexp2(st[rb][r]); }
                else if (TM == TM_WINE) { const float e = fexp2(st[rb][r]); p[r] = (kl > tokc) ? e : 0.f; }
                else {
                    const int rel = (TM == TM_CMP1 || TM == TM_CMP2) ? (relbase + tokc - 16 * kl) : (relbase + tokc - kl);
                    const bool valid = rel >= 0;
                    const int ri = rel < 0 ? 0 : (rel > 127 ? 127 : rel);
                    const float e = fexp2(st[rb][r] + LUTJ[ri]);
                    p[r] = valid ? e : 0.f; }
            }
            if (C1) { lacc[rb][0] += (p[0] + p[1]) + (p[2] + p[3]); }
            else {
                if (C2) {
#pragma unroll
                    for (int r = 0; r < 4; ++r) p[r] *= linv_[rb];
                    float h0 = p[0], h1 = p[1], h2 = p[2], h3 = p[3];
                    h0 += dppf<DPP_XOR1>(h0); h1 += dppf<DPP_XOR1>(h1); h2 += dppf<DPP_XOR1>(h2); h3 += dppf<DPP_XOR1>(h3);
                    h0 += dppf<DPP_XOR2>(h0); h1 += dppf<DPP_XOR2>(h1); h2 += dppf<DPP_XOR2>(h2); h3 += dppf<DPP_XOR2>(h3);
                    if ((l15 & 3) == 0) { const int sp = 16 * idx + 8 * (cb >> 1) + 2 * lq + (cb & 1);
                        IMP1[tokc * 65 + sp] = (h0 + h1) + (h2 + 0.5f * h3);
                        if (sp + 1 < 64) IMP2[tokc * 65 + sp + 1] = 0.5f * h3; }
                }
                const unsigned lo = pkh(p[0], p[1]), hi = pkh(p[2], p[3]);
                if (cb & 1) { pfr[rb][cb >> 1].z = lo; pfr[rb][cb >> 1].w = hi; } else { pfr[rb][cb >> 1].x = lo; pfr[rb][cb >> 1].y = hi; } }
        }
    };
    auto vld = [&](int ks, v4u (&vv)[4]) __attribute__((always_inline)) {
        if (!C1 && !(VAR & 8)) {
#pragma unroll
            for (int db = 0; db < 4; ++db) vv[db] = *(const LAS v4u*)(vb_ + (16 * db + l15) * 128 + 16 * ((4 * ks + lq) ^ (l15 >> 1))); }
    };
    auto pvm = [&](int ks, const v4u (&vv)[4]) __attribute__((always_inline)) {
        if (!C1 && !(VAR & 8)) {
#pragma unroll
            for (int db = 0; db < 4; ++db) {
#pragma unroll
                for (int rb = 0; rb < 2; ++rb) if (RB & (1 << rb)) oacc[rb][db] = __builtin_amdgcn_mfma_f32_16x16x32_bf16(__builtin_bit_cast(bf16x8, pfr[rb][ks]), __builtin_bit_cast(bf16x8, vv[db]), oacc[rb][db], 0, 0, 0); }
            if (!C2) { const v4u ones = (v4u){0x3F803F80u, 0x3F803F80u, 0x3F803F80u, 0x3F803F80u};
#pragma unroll
                for (int rb = 0; rb < 2; ++rb) if (RB & (1 << rb)) lacc[rb] = __builtin_amdgcn_mfma_f32_16x16x32_bf16(__builtin_bit_cast(bf16x8, pfr[rb][ks]), __builtin_bit_cast(bf16x8, ones), lacc[rb], 0, 0, 0); }
        }
    };
    pg8::f32x4 sA[2], sB[2], cA[2], cB[2]; bf16x8 kA[2], kB[2]; v4u vA[4], vB[4];
#define AT_SB __builtin_amdgcn_sched_barrier(0)
    kld(0, kA, cA); kld(1, kB, cB); AT_SB;
    qkm(0, kA, cA, sA); kld(2, kA, cA); AT_SB;
    qkm(1, kB, cB, sB); kld(3, kB, cB); prob(0, sA); AT_SB;
    qkm(2, kA, cA, sA); vld(0, vA); prob(1, sB); AT_SB;
    qkm(3, kB, cB, sB); pvm(0, vA); vld(1, vB); prob(2, sA); AT_SB;
    prob(3, sB); AT_SB;
    pvm(1, vB);
#undef AT_SB
}

template <int VAR> __device__ __forceinline__ void attention_phase(Frame& F, const Args& args) {
    unsigned char* ws = F.ws;
    const int lane = F.lane, w = F.wave, l15 = lane & 15, lq = lane >> 4, tid = F.tid;
    LAS unsigned char* L = F.lds;
    LAS float* IMP1 = (LAS float*)(L + AT_OFF_IMP1); LAS float* IMP2 = (LAS float*)(L + AT_OFF_IMP2);
    LAS unsigned long long* SELM = (LAS unsigned long long*)(L + AT_OFF_SEL); LAS float* LUT = (LAS float*)(L + AT_OFF_LUT); LAS float* LROW = (LAS float*)(L + AT_OFF_LROW) + w * 32;
    LAS int* TD = (LAS int*)(L + AT_OFF_TD); LAS bf16* OUTL = (LAS bf16*)(L + AT_OFF_OUT) + (32 * w) * 72; LAS float* GATL = (LAS float*)(L + AT_OFF_GATL);
    const bf16* Qg = (const bf16*)(ws + WS_Q); const float* GATE = (const float*)(ws + WS_GATE); bf16* YA = (bf16*)(ws + WS_PL) + 512;
    const int jq = l15 & 3;
    const LAS float* LUTJ = LUT + jq * 128;
    const int nrounds = (F.G == 256) ? 4 : (1024 + F.G - 1) / F.G;
    for (int round = 0; round < nrounds; ++round) {
        const int ui = (F.G == 256) ? ((round & 1) ? ((round >> 1) * 512 + 511 - F.bid) : ((round >> 1) * 512 + F.bid)) : (round * F.G + F.bid);
        if (ui >= 1024) break;
        const int c = 63 - (ui >> 4), bg = ui & 15, b = bg >> 1, g = bg & 1;
        const int m0 = b * SEQ + 64 * c;
        __syncthreads();
        { const float M0 = ((const float*)(ws + WS_BIASL))[8 * 128];
          for (int i = tid; i < 512; i += NTHREADS) LUT[i] = (((const float*)(ws + WS_BIASL))[(4 * g + (i >> 7)) * 128 + (i & 127)] - M0) * 1.4426950408889634f; }
        for (int i = tid; i < 64 * 65; i += NTHREADS) { IMP1[i] = 0.f; IMP2[i] = 0.f; }
        { const float M0 = ((const float*)(ws + WS_BIASL))[8 * 128]; const float* BL = (const float*)(ws + WS_BIASL) + (size_t)(4 * g) * 128;
          for (int i = tid; i < 16 * 63 * 4; i += NTHREADS) { const int r = i & 3, yi = (i >> 2) % 63, row = i / 252, rel = 4 * (47 - yi) + (row >> 2) - r;
              ((LAS float*)(L + AT_OFF_TS + row * AT_TS_ROW))[4 * yi + r] = rel < 0 ? -1.0e30f : (BL[(row & 3) * 128 + (rel > 127 ? 127 : rel)] - M0) * 1.4426950408889634f; } }
        for (int i = tid; i < 64 * 12; i += NTHREADS) GATL[i] = GATE[(size_t)(m0 + i / 12) * 24 + g * 12 + (i % 12)];
        bf16x8 qf[2][2];
#pragma unroll
        for (int rb = 0; rb < 2; ++rb)
#pragma unroll
            for (int ks = 0; ks < 2; ++ks) qf[rb][ks] = *(const GAS bf16x8*)(Qg + (size_t)(m0 + 8 * w + 4 * rb + (l15 >> 2)) * 512 + g * 256 + jq * 64 + 32 * ks + 8 * lq);
        asm volatile("" :: "v"(qf[0][0]), "v"(qf[0][1]), "v"(qf[1][0]), "v"(qf[1][1]));
        const int ncmp = 4 * c + 3, n1 = (ncmp + 63) >> 6, nsel = c + 1, w0 = c >= 8 ? c - 8 : 0, nwin = c - w0 + 1;
        const int ntiles = 2 * n1 + nsel + nwin;
        if (tid < ntiles) { const int i = tid;
            auto kindof = [&](int t, int& kind, int& idx) { if (t < n1) { kind = 0; idx = t; } else if (t < 2 * n1) { kind = 1; idx = t - n1; } else if (t < 2 * n1 + nsel) { kind = 2; idx = t - 2 * n1; } else { kind = 3; idx = w0 + (t - 2 * n1 - nsel); } };
            int kind, idx, kn, in_; kindof(i, kind, idx); kindof(i + 1 < ntiles ? i + 1 : i, kn, in_);
            unsigned ko, vo;
            if (kn < 2) { ko = (unsigned)(WS_KC + ((size_t)bg * 256 * 64 + (size_t)in_ * 4096) * 2); vo = (unsigned)(WS_VCT + ((size_t)bg * 64 * 256 + 64 * in_) * 2); }
            else if (kn == 2) { ko = (unsigned)(WS_KS + ((size_t)bg * SEQ * 64 + (size_t)in_ * 4096) * 2); vo = (unsigned)(WS_VST + ((size_t)bg * 64 * SEQ + 64 * in_) * 2); }
            else { ko = (unsigned)(WS_KW + ((size_t)bg * SEQ * 64 + (size_t)in_ * 4096) * 2); vo = (unsigned)(WS_VWT + ((size_t)bg * 64 * SEQ + 64 * in_) * 2); }
            const int dd = c - idx;
            int mode, relbase;
            if (kind == 0) { relbase = 64 * c - 31 - 1024 * idx; mode = relbase >= 1135 ? TM_CMP1F : TM_CMP1; } else if (kind == 1) { relbase = 64 * c - 31 - 1024 * idx; mode = relbase >= 1135 ? TM_CMP2F : TM_CMP2; }
            else if (kind == 2) { mode = dd <= 2 ? TM_SELN : TM_SELF; relbase = 64 * dd; } else { mode = dd <= 2 ? TM_WINN : (dd == 8 ? TM_WINE : TM_WINF); relbase = 64 * dd; }
            const int endf = ((kind == 1 && idx == n1 - 1) || (kind == 2 && idx == nsel - 1) || (kind == 3 && idx == c)) ? kind : 0;
            v4i e; e.x = mode | (idx << 8) | (endf << 16) | ((kind == 2 && idx == 0) ? (1 << 24) : 0) | (kn >= 2 ? (1 << 25) : 0); e.y = relbase; e.z = (int)ko; e.w = (int)vo;
            *(LAS v4i*)(TD + 4 * i) = e; }
        const int drow = 8 * w + (lane >> 3), dsrck = 16 * ((lane & 7) ^ (((w & 3) << 1) | ((lane >> 4) & 1))), dsrcv = 16 * ((lane & 7) ^ ((4 * (w & 1)) | (lane >> 4)));
#define AT_DMA(tile_, ko_, vo_, vs_) do { const int nb_ = (tile_) % AT_NBUF; \
        __builtin_amdgcn_global_load_lds((const GAS unsigned*)(ws + (size_t)((ko_) + drow * 128 + dsrck)), (LAS unsigned*)(L + AT_OFF_K + nb_ * AT_KBUF + w * 1024), 16, 0, 0); \
        __builtin_amdgcn_global_load_lds((const GAS unsigned*)(ws + (size_t)((vo_) + drow * (vs_) + dsrcv)), (LAS unsigned*)(L + AT_OFF_V + nb_ * AT_KBUF + w * 1024), 16, 0, 0); } while (0)
        __syncthreads();
        if (!(VAR & 2)) { AT_DMA(0, (unsigned)(WS_KC + (size_t)bg * 256 * 64 * 2), (unsigned)(WS_VCT + (size_t)bg * 64 * 256 * 2), 512u); }
        int d0, d1, d2, d3;
        { const v4i e = *(const LAS v4i*)TD; d0 = __builtin_amdgcn_readfirstlane(e.x); d1 = __builtin_amdgcn_readfirstlane(e.y); d2 = __builtin_amdgcn_readfirstlane(e.z); d3 = __builtin_amdgcn_readfirstlane(e.w); }
        pg8::f32x4 oacc[2][4];
        pg8::f32x4 lacc[2] = {(pg8::f32x4){0.f, 0.f, 0.f, 0.f}, (pg8::f32x4){0.f, 0.f, 0.f, 0.f}};
#pragma unroll
        for (int rb = 0; rb < 2; ++rb)
#pragma unroll
            for (int db = 0; db < 4; ++db) oacc[rb][db] = (pg8::f32x4){0.f, 0.f, 0.f, 0.f};
        const int tok_r[2] = {8 * w + (l15 >> 2), 8 * w + 4 + (l15 >> 2)};
        const LAS unsigned char* tsw = L + AT_OFF_TS + 16 * (47 - 2 * w); const LAS unsigned char* tsn = L + AT_OFF_TS + 16 * 48;
        for (int it = 0; it < ((VAR & 32) ? 0 : ntiles); ++it) {
            if (!(VAR & 512)) { asm volatile("s_waitcnt vmcnt(0)" ::: "memory");
            asm volatile("s_waitcnt lgkmcnt(0)" ::: "memory"); __builtin_amdgcn_s_barrier(); asm volatile("" ::: "memory"); }
            if (!(VAR & 2) && it + 1 < ntiles) AT_DMA(it + 1, (unsigned)d2, (unsigned)d3, ((d0 >> 25) & 1) ? 2u * SEQ : 512u);
            v4i tdn;
            { const LAS int* tn_ = TD + 4 * (it + 1); asm volatile("ds_read_b128 %0, %1" : "=v"(tdn) : "v"(tn_) : "memory"); }
            {
            const int mode = d0 & 255, idx = (d0 >> 8) & 255, relbase = d1, endf = (d0 >> 16) & 3, selfirst = (d0 >> 24) & 1;
            const int buf = it % AT_NBUF;
            if (selfirst) {
                { const int tok = 8 * w + (lane >> 3), s0 = 8 * (lane & 7);
                  unsigned key[8]; int rank[8];
#pragma unroll
                  for (int q = 0; q < 8; ++q) { const int sB = s0 + q; const bool vis = sB <= c, forced = (sB == 0) || (sB == c) || (sB == c - 1);
                      const float sc = vis ? (IMP1[tok * 65 + sB] + IMP2[tok * 65 + sB] + (forced ? 1000.f : 0.f)) : -1.f;
                      const unsigned u = __builtin_bit_cast(unsigned, sc); const unsigned fk = (u >> 31) ? ~u : (u | 0x80000000u);
                      key[q] = (fk & ~63u) | (unsigned)(63 - sB); rank[q] = 0; }
                  LAS unsigned* KEYS = (LAS unsigned*)IMP1;
#pragma unroll
                  for (int q = 0; q < 8; ++q) KEYS[tok * 65 + s0 + q] = key[q];
                  if (c >= 16 && !(VAR & 128)) {
#pragma unroll 8
                      for (int s2 = 0; s2 < 64; ++s2) { const unsigned k2 = KEYS[tok * 65 + s2];
#pragma unroll
                          for (int q = 0; q < 8; ++q) rank[q] += (k2 > key[q]) ? 1 : 0; } }
                  unsigned byte = 0u;
#pragma unroll
                  for (int q = 0; q < 8; ++q) byte |= ((rank[q] < 16 && (s0 + q) <= c) ? 1u : 0u) << q;
                  ((LAS unsigned char*)SELM)[tok * 8 + (lane & 7)] = (unsigned char)byte; }
            }
            const LAS unsigned char* kb_ = L + AT_OFF_K + buf * AT_KBUF; const LAS unsigned char* vb_ = L + AT_OFF_V + buf * AT_KBUF;
            const float cfar = LUTJ[127];
            unsigned selb[2] = {1u, 1u};
#define AT_CALL(TMX) at_tile<TMX, VAR>(kb_, vb_, LUTJ, IMP1, IMP2, qf, oacc, lacc, LROW, tok_r, selb, cfar, relbase, idx, l15, lq, tsw, tsn)
            if (mode == TM_SELF || mode == TM_SELN) { selb[0] = (unsigned)(SELM[tok_r[0]] >> idx) & 1u; selb[1] = (unsigned)(SELM[tok_r[1]] >> idx) & 1u; }
            if (mode == TM_SELF) {
                const bool a0 = __ballot(selb[0] != 0u) != 0ull, a1 = __ballot(selb[1] != 0u) != 0ull;
                if (a0 && a1) AT_CALL(TM_SELF);
                else if (a0) at_tile<TM_SELF, VAR, 1>(kb_, vb_, LUTJ, IMP1, IMP2, qf, oacc, lacc, LROW, tok_r, selb, cfar, relbase, idx, l15, lq, tsw, tsn);
                else if (a1) at_tile<TM_SELF, VAR, 2>(kb_, vb_, LUTJ, IMP1, IMP2, qf, oacc, lacc, LROW, tok_r, selb, cfar, relbase, idx, l15, lq, tsw, tsn); }
            else if (mode == TM_WINF) AT_CALL(TM_WINF);
            else if (mode == TM_SELN) AT_CALL(TM_SELN);
            else if (mode == TM_WINN) AT_CALL(TM_WINN);
            else if (mode == TM_WINE) AT_CALL(TM_WINE);
            else if (mode == TM_CMP2) AT_CALL(TM_CMP2);
            else if (mode == TM_CMP2F) AT_CALL(TM_CMP2F);
            else if (mode == TM_CMP1F) AT_CALL(TM_CMP1F);
            else { AT_CALL(TM_CMP1);
                if (idx == n1 - 1) {
#pragma unroll
                    for (int rb = 0; rb < 2; ++rb) { const float s = sum_xor32(sum_xor16(lacc[rb][0])); if (lq == 0) LROW[16 * rb + l15] = s > 0.f ? 1.0f / s : 0.f; lacc[rb] = (pg8::f32x4){0.f, 0.f, 0.f, 0.f}; } } }
#undef AT_CALL
            {
                if (endf && !(VAR & 256)) {
                    const int br = endf - 1;
#pragma unroll
                    for (int rb = 0; rb < 2; ++rb)
#pragma unroll
                        for (int r = 0; r < 4; ++r) { const int qrow = 16 * rb + 4 * lq + r;
                            const float ls_ = lacc[rb][r]; lacc[rb][r] = 0.f;
                            const float gt = GATL[(8 * w + 4 * rb + lq) * 12 + r * 3 + br] * (endf == 1 ? 1.0f : (ls_ > 0.f ? 1.0f / ls_ : 0.f));
#pragma unroll
                            for (int db = 0; db < 4; ++db) { float v = gt * oacc[rb][db][r]; oacc[rb][db][r] = 0.f;
                                LAS bf16* po = OUTL + qrow * 72 + 16 * db + l15;
                                if (br > 0) v += __builtin_bit_cast(float, (unsigned)(*po) << 16);
                                *po = (bf16)f2bf(v); } }
                    if (br == 2 && !(VAR & 1)) {
                        LDS_WAIT(); asm volatile("" ::: "memory");
#pragma unroll
                        for (int i = 0; i < 4; ++i) { const int ch = i * 64 + lane, row = ch >> 3, c16 = ch & 7;
                            const v4u o = *(const LAS v4u*)((const LAS unsigned char*)OUTL + row * 144 + 16 * c16);
                            *(GAS v4u*)(YA + (size_t)(m0 + 8 * w + (row >> 2)) * 1024 + g * 256 + (row & 3) * 64 + 8 * c16) = o; }
                    }
                }
            }
            }
            asm volatile("s_waitcnt lgkmcnt(0)" : "+v"(tdn) :: "memory");
            d0 = __builtin_amdgcn_readfirstlane(tdn.x); d1 = __builtin_amdgcn_readfirstlane(tdn.y); d2 = __builtin_amdgcn_readfirstlane(tdn.z); d3 = __builtin_amdgcn_readfirstlane(tdn.w);
        }
#undef AT_DMA
    }
}

constexpr int N_PHASES = 13;
#ifndef MK_ONE_LAUNCH
#define MK_ONE_LAUNCH 1
#endif
#ifndef REP_P0
#define REP_P0 1
#endif
#ifndef REP_P1
#define REP_P1 1
#endif
#ifndef REP_P2
#define REP_P2 1
#endif
#ifndef REP_P3
#define REP_P3 1
#endif
#ifndef REP_P5
#define REP_P5 1
#endif
#ifndef REP_P6
#define REP_P6 1
#endif
#ifndef REP_P8
#define REP_P8 1
#endif
#ifndef REP_P7
#define REP_P7 1
#endif
#ifndef REP_P11
#define REP_P11 1
#endif
#ifndef REP_P4
#define REP_P4 1
#endif
#ifndef REP_P9
#define REP_P9 1
#endif
#ifndef REP_P10
#define REP_P10 1
#endif
#ifndef MK_BUILD
#define MK_BUILD 0
#endif

#ifndef STAG_P2
#define STAG_P2 0
#endif
__device__ __forceinline__ void phase_stagger(const Frame& F, int step_ns) {
    const int grp = (F.bid >> 3) & 7;
    if (step_ns > 0 && grp > 0) { const unsigned long long t0 = wall_clock64(), dt = (unsigned long long)(grp * step_ns) / 10ull;
        while (wall_clock64() - t0 < dt) __builtin_amdgcn_s_sleep(8); }
}
struct EpiNull {
    static constexpr bool PERM = true, AFTER_DRAIN = false, MID = false;
    __device__ __forceinline__ void operator()(const pg8::f32x4 (&acc)[2][2][4][2], const pg8::Unit& u, int wr, int wc, int fr, int fq) const {
#pragma unroll
        for (int ai = 0; ai < 2; ++ai)
#pragma unroll
            for (int bj = 0; bj < 2; ++bj)
#pragma unroll
                for (int m = 0; m < 4; ++m) { asm volatile("" :: "v"(acc[ai][bj][m][0]), "v"(acc[ai][bj][m][1])); }
    }
};
__global__ void __launch_bounds__(NTHREADS, 2) fwd_kernel(Args args) {
    extern __shared__ __attribute__((aligned(16))) unsigned char lds[];
    Frame F;
    F.lds = (LAS unsigned char*)lds;
    F.MISC = (volatile LAS unsigned*)(F.lds + MISC_OFF);
    F.tid = threadIdx.x; F.lane = F.tid & 63; F.wave = __builtin_amdgcn_readfirstlane(F.tid >> 6);
    F.G = gridDim.x; F.bid = blockIdx.x; F.ws = args.ws;
    F.ctl = (gu32*)(args.ws + WS_CTL);
    for (int u = F.tid; u < (LDS_BYTES - LDSCTL_OFF) / 4; u += NTHREADS) ((LAS unsigned*)(F.lds + LDSCTL_OFF))[u] = 0u;
    __syncthreads();
    XcdBarrier bar; bar.bar = (unsigned*)(F.ctl + CW_BAR); bar.x = 0; bar.st = nullptr;
    if (MK_ONE_LAUNCH) bar = xcd_barrier_post((unsigned*)(F.ctl + CW_BAR), F.MISC + 8);
    const int lo = args.ph_lo, hi = args.ph_hi;
#define IN(k) (lo <= (k) && (k) < hi)
#define SEAM(k) do { if (IN(k) && IN((k) + 1)) xcd_barrier(bar); } while (0)
    unsigned char* ws = args.ws;
    const float* ada = (const float*)(ws + WS_ADA);

    if (IN(0)) { for (int rep = 0; rep < REP_P0; ++rep) { p0_prologue(F, args, rep == REP_P0 - 1); __syncthreads(); } } SEAM(0);
    if (IN(1)) { for (int rep = 0; rep < REP_P1; ++rep) modnorm_rows<false>(F, args.in[I_X], args.in[I_N1G], ada, 0, (bf16*)(ws + WS_H)); } SEAM(1);
    if (IN(2)) { {
        phase_stagger(F, STAG_P2);
        pg8::Gemm g{(const bf16*)(ws + WS_H), (const bf16*)(ws + WS_WIN_T), M, NIN, D, D, D}; pg8::StaticOrder S; S.init(M, NIN, F.G, F.bid);
        if (F.tid == 0) F.MISC[40] = 0xffffffffu; __syncthreads();
        EpiIn E{ws, args.in[I_QNG], args.in[I_KNG], F.MISC + 40};
#if defined(PROBE_P2) && PROBE_P2 == 1
        { EpiNull EN; pg8::gemm_phase<EpiNull, pg8::StaticOrder, true, true>(F.lds + RING_OFF, g, S, EN); __syncthreads(); }
#elif defined(PROBE_P2) && PROBE_P2 == 2
        { if (F.tid == 0) F.MISC[40] = 0u; __syncthreads(); pg8::gemm_phase<EpiIn, pg8::StaticOrder, true, true>(F.lds + RING_OFF, g, S, E); __syncthreads(); if (F.tid == 0) F.MISC[40] = 0xffffffffu; __syncthreads(); }
#endif
        pg8::gemm_phase<EpiIn, pg8::StaticOrder, true, true>(F.lds + RING_OFF, g, S, E);
#if REP_P2 > 1
        __syncthreads(); pg8::gemm_phase<EpiIn, pg8::StaticOrder, true, true>(F.lds + RING_OFF, g, S, E);
#endif
        }
    } SEAM(2);
#ifndef PROBE_P3
#define PROBE_P3 0
#endif
    if (IN(3)) { for (int rep = 0; rep < REP_P3; ++rep) { __syncthreads(); pool_phase(F); if (PROBE_P3 == 1) { __syncthreads(); pool_phase(F); }
        __syncthreads(); compress_phase(F, args.in[I_KNG]); if (PROBE_P3 == 2) { __syncthreads(); compress_phase(F, args.in[I_KNG]); }
        __syncthreads(); vtranspose_phase(F); if (PROBE_P3 == 3) { __syncthreads(); vtranspose_phase(F); } } } SEAM(3);
    if (IN(4)) {
#ifdef PROBE_P4
        attention_phase<PROBE_P4>(F, args); __syncthreads();
#endif
        for (int rep = 0; rep < REP_P4; ++rep) { attention_phase<0>(F, args); __syncthreads(); } } SEAM(4);
    if (IN(5)) { {
        pg8::Gemm g{(const bf16*)(ws + WS_PL), (const bf16*)(ws + WS_WEFF_T), M, D, 2 * POOLW, 2 * POOLW, 2 * POOLW}; pg8::StaticOrder S; S.init(M, D, F.G, F.bid);
        EpiMix2 E{(bf16*)(ws + WS_MIX), (const bf16*)(ws + WS_GM)};
        pg8::gemm_phase<EpiMix2, pg8::StaticOrder, true, true>(F.lds + RING_OFF, g, S, E);
#if REP_P5 > 1
        __syncthreads(); pg8::gemm_phase<EpiMix2, pg8::StaticOrder, true, true>(F.lds + RING_OFF, g, S, E);
#endif
        }
    } SEAM(5);
    if (IN(6)) { {
        pg8::Gemm g{(const bf16*)(ws + WS_MIX), (const bf16*)(ws + WS_WOUT_T), M, D, D, D, D}; pg8::StaticOrder S; S.init(M, D, F.G, F.bid);
        EpiRes E{args.in[I_X], (bf16*)(ws + WS_X1), ada, 2};
        pg8::gemm_phase<EpiRes, pg8::StaticOrder, true, true>(F.lds + RING_OFF, g, S, E);
#if REP_P6 > 1
        __syncthreads(); pg8::gemm_phase<EpiRes, pg8::StaticOrder, true, true>(F.lds + RING_OFF, g, S, E);
#endif
        }
    } SEAM(6);
    if (IN(7)) { for (int rep = 0; rep < REP_P7; ++rep) modnorm_rows<true>(F, ws + WS_X1, args.in[I_N2G], ada, 3, (bf16*)(ws + WS_H)); } SEAM(7);
    if (IN(8)) { {
        pg8::Gemm g{(const bf16*)(ws + WS_H), (const bf16*)(ws + WS_WQ_T), M, PQW, D, D, D}; pg8::StaticOrder S; S.init(M, PQW, F.G, F.bid);
        EpiStoreBf16 E{(bf16*)(ws + WS_QV), PQW};
        pg8::gemm_phase<EpiStoreBf16, pg8::StaticOrder, true, true>(F.lds + RING_OFF, g, S, E);
#if REP_P8 > 1
        __syncthreads(); pg8::gemm_phase<EpiStoreBf16, pg8::StaticOrder, true, true>(F.lds + RING_OFF, g, S, E);
#endif
        }
    } SEAM(8);
    if (IN(9)) { for (int rep = 0; rep < REP_P9; ++rep) peer_select_phase(F); } SEAM(9);
#ifdef PROBE_XCD
    if (IN(10)) { if (F.tid == 0) __hip_atomic_store((unsigned*)(F.ctl + 2048 + F.bid), 100u + xb_xcc_id(), RLX_AGENT); }
#endif
    if (IN(10)) {
#ifdef PROBE_DOT
        peer_dot_phase<PROBE_DOT>(F); __syncthreads();
#endif
#ifdef PROBE_LOADRATE
        peer_loadrate_probe<PROBE_LOADRATE>(F); __syncthreads();
#endif
        peer_dot_phase<0>(F); } SEAM(10);
    if (IN(11)) { for (int rep = 0; rep < REP_P11; ++rep) peer_coef_phase(F); } SEAM(11);
#ifdef PROBE_XCD
    if (IN(12) && F.bid == 0 && F.tid == 0) { bool ok = true; for (int i = 0; i < F.G; ++i) { const unsigned a = __hip_atomic_load((unsigned*)(F.ctl + 2048 + i), RLX_AGENT), b0 = __hip_atomic_load((unsigned*)(F.ctl + 2048 + (i & 7)), RLX_AGENT); if (a != b0 || a < 100u) ok = false; }
        for (int i = 0; i < 8; ++i) for (int q = 0; q < i; ++q) if (__hip_atomic_load((unsigned*)(F.ctl + 2048 + i), RLX_AGENT) == __hip_atomic_load((unsigned*)(F.ctl + 2048 + q), RLX_AGENT)) ok = false;
        if (!ok) args.out[12345] = 1.0e9f; }
    __syncthreads();
#endif
    if (IN(12)) {
#if defined(CHECK_OUT_MFMA)
        peer_out_mfma_phase<1>(F, ada, args.out); __syncthreads(); VM_WAIT(); __syncthreads(); peer_out_phase<false, true>(F, ada, args.out);
#elif defined(OUT_VALU)
        for (int rep = 1; rep < REP_P10; ++rep) peer_out_phase<true>(F, ada, args.out); peer_out_phase<false>(F, ada, args.out);
#else
#ifdef PROBE_OUT
        peer_out_mfma_phase<1>(F, ada, args.out); __syncthreads();
#endif
        peer_out_mfma_phase<0>(F, ada, args.out);
#endif
    }
#undef IN
#undef SEAM
}

extern "C" void kernel_launch(void* const* d_in, const int* in_sizes, int n_in, void* d_out, int out_size, void* d_ws, size_t ws_size, hipStream_t stream) {
    static int grid = 0;
    if (grid == 0) {
        if (n_in != N_IN || in_sizes[0] != M * D || out_size != M * D || ws_size < WS_END) {
            fprintf(stderr, "kernel_launch: unexpected shapes: n_in %d in0 %d out %d ws %zu (need %zu)\n", n_in, n_in > 0 ? in_sizes[0] : -1, out_size, ws_size, (size_t)WS_END); grid = -1; return; }
        int dev = 0, cus = 0, per_cu = 0;
        if (hipGetDevice(&dev) != hipSuccess || hipDeviceGetAttribute(&cus, hipDeviceAttributeMultiprocessorCount, dev) != hipSuccess) { grid = -1; return; }
        if (hipFuncSetAttribute((const void*)fwd_kernel, hipFuncAttributeMaxDynamicSharedMemorySize, LDS_BYTES) != hipSuccess) { fprintf(stderr, "kernel_launch: hipFuncSetAttribute failed\n"); grid = -1; return; }
        if (hipOccupancyMaxActiveBlocksPerMultiprocessor(&per_cu, (const void*)fwd_kernel, NTHREADS, LDS_BYTES) != hipSuccess || per_cu < 1)
            fprintf(stderr, "kernel_launch: occupancy query reports %d workgroups per CU\n", per_cu);
        (void)hipGetLastError();
        grid = cus;
    }
    if (grid < 0) return;
    if (hipMemsetAsync((char*)d_ws + WS_CTL, 0, CTL_ZERO_BYTES, stream) != hipSuccess) return;
    Args a{};
    for (int i = 0; i < N_IN; ++i) a.in[i] = (const float*)d_in[i];
    a.out = (float*)d_out; a.ws = (unsigned char*)d_ws;
    if (MK_ONE_LAUNCH) {
        a.ph_lo = 0; a.ph_hi = N_PHASES; a.li = 0;
        hipLaunchKernelGGL(fwd_kernel, dim3(grid), dim3(NTHREADS), LDS_BYTES, stream, a);
    } else {
        for (int p = 0; p < N_PHASES; ++p) {
            a.ph_lo = p; a.ph_hi = p + 1; a.li = p;
            hipLaunchKernelGGL(fwd_kernel, dim3(grid), dim3(NTHREADS), LDS_BYTES, stream, a);
        }
    }
}
```

```cpp
#include <hip/hip_runtime.h>
#include <cstdio>
#include <cstdint>
namespace pg8 {
#define PG8_LAS __attribute__((address_space(3)))
typedef unsigned short bf16_t;
typedef short bf16x8 __attribute__((ext_vector_type(8)));
typedef float f32x4 __attribute__((ext_vector_type(4)));
typedef unsigned u32x4 __attribute__((ext_vector_type(4)));
constexpr int BM = 256, BK = 64, HALF = 128, HTB = HALF * BK * 2  , STAGE_BYTES = 8 * HTB, NXCD = 8, WGM = 8;

__host__ __device__ __forceinline__ int lds_byte(int r, int c) { const int st = (r >> 4) * 2 + (c >> 5), rr = r & 15, cc = c & 31, ob = rr * 64 + cc * 2; return st * 1024 + (ob ^ (((ob >> 9) & 1) << 5)); }
__host__ __device__ __forceinline__ void stage_rc(int b, int& R, int& C) { const int st = b / 1024, sb = b % 1024, swz = sb ^ (((sb >> 9) & 1) << 5); R = (st >> 1) * 16 + swz / 64; C = (st & 1) * 32 + (swz % 64) / 2; }
__host__ __device__ __forceinline__ int perm32(int rho) { const int n = rho >> 4, i = rho & 15; return 8 * (i >> 2) + 4 * n + (i & 3); }

struct Unit { int pm, pn; };
struct Gemm { const bf16_t* A; const bf16_t* Bt; int M, N, K, lda, ldb; };

struct StaticOrder {
    int nM, nN, nwg, G, c;
    __host__ __device__ void init(int M, int N, int G_, int c_) { nM = M / BM; nN = N / BM; nwg = nM * nN; G = G_; c = c_; }
    __host__ __device__ bool next(int i, Unit& u) const {
        const long L = (long)i * G + c; if (L >= nwg) return false;
        int wgid = (int)L; { const int q = nwg / NXCD, r = nwg % NXCD, xcd = wgid % NXCD, off = wgid / NXCD; wgid = (xcd < r ? xcd * (q + 1) : r * (q + 1) + (xcd - r) * q) + off; }
        const int nig = WGM * nN, gid = wgid / nig, fm = gid * WGM, gsz = (nM - fm) < WGM ? (nM - fm) : WGM;
        u.pm = fm + ((wgid % nig) % gsz); u.pn = (wgid % nig) / gsz; return true;
    }
    __device__ __forceinline__ void a_ready(const Unit&) const {}
    __device__ __forceinline__ void done(const Unit&) const {}
};

__device__ __forceinline__ unsigned cvt_pk_bf16(float lo, float hi) { unsigned r; asm volatile("v_cvt_pk_bf16_f32 %0, %1, %2" : "=v"(r) : "v"(lo), "v"(hi)); return r; }
template <class Epi, class Sched, bool ALIGN_EPI = false, bool SP2 = false>
__device__ __forceinline__ void gemm_phase(PG8_LAS unsigned char* lds, const Gemm g, const Sched& S, const Epi& E) {
    const int tid = threadIdx.x, wid = __builtin_amdgcn_readfirstlane(tid >> 6), lane = tid & 63, wr = wid >> 2, wc = wid & 3, fr = lane & 15, fq = lane >> 4;
    const int K = g.K, nt = K / BK;
    unsigned voffA[2], voffB[2];
#pragma unroll
    for (int i = 0; i < 2; ++i) { int R, C; stage_rc(tid * 16 + i * 8192, R, C); const int Rb = Epi::PERM ? ((R & ~31) + perm32(R & 31)) : R;
        voffA[i] = (unsigned)(R * g.lda + C) * 2u; voffB[i] = (unsigned)(Rb * g.ldb + C) * 2u; }
    const size_t kstep = (size_t)(BK * 2);
    const size_t hstepA = (size_t)HALF * g.lda * 2, hstepB = (size_t)HALF * g.ldb * 2;
    const size_t tstepA = 2 * hstepA, tstepB = 2 * hstepB;
    const unsigned ldsw = (unsigned)wid * 1024u;
    const int aoff = lds_byte(wr * 64 + fr, fq * 8), boff = lds_byte(wc * 32 + fr, fq * 8);
#define PG8_SA(b, h) (((b) * 2 + (h)) * HTB)
#define PG8_SB(b, h) ((4 + (b) * 2 + (h)) * HTB)
#define PG8_STAGE(bufoff, gbase, voff) do { _Pragma("unroll") for (int _i = 0; _i < 2; ++_i) \
        __builtin_amdgcn_global_load_lds((const unsigned*)((const char*)(gbase) + (voff)[_i]), (PG8_LAS unsigned*)(lds + (bufoff) + ldsw + _i * 8192), 16, 0, 0); } while (0)
#define PG8_LDA(dst, b, h) do { _Pragma("unroll") for (int m = 0; m < 4; ++m) _Pragma("unroll") for (int k = 0; k < 2; ++k) dst[m][k] = *(const PG8_LAS bf16x8*)(lds + PG8_SA(b, h) + aoff + m * 2048 + k * 1024); } while (0)
#define PG8_LDB(dst, b, h) do { _Pragma("unroll") for (int n = 0; n < 2; ++n) _Pragma("unroll") for (int k = 0; k < 2; ++k) dst[n][k] = *(const PG8_LAS bf16x8*)(lds + PG8_SB(b, h) + boff + n * 2048 + k * 1024); } while (0)
#define PG8_MMA(ai, bj, At, Bt) do { __builtin_amdgcn_s_setprio(1); _Pragma("unroll") for (int m = 0; m < 4; ++m) _Pragma("unroll") for (int n = 0; n < 2; ++n) _Pragma("unroll") for (int k = 0; k < 2; ++k) \
        acc[ai][bj][m][n] = __builtin_amdgcn_mfma_f32_16x16x32_bf16(Bt[n][k], At[m][k], acc[ai][bj][m][n], 0, 0, 0); __builtin_amdgcn_s_setprio(0); } while (0)
#define PG8_WAIT_V(n) asm volatile("s_waitcnt vmcnt(" #n ")" ::: "memory")
#define PG8_WAIT_L(n) asm volatile("s_waitcnt lgkmcnt(" #n ")" ::: "memory")
#define PG8_BAR __builtin_amdgcn_s_barrier()
#define PG8_SCHED __builtin_amdgcn_sched_barrier(0)
    Unit cur, nxt; int ui = 0;
    if (!S.next(0, cur)) return;
    f32x4 acc[2][2][4][2];
#pragma unroll
    for (int a = 0; a < 2; ++a)
#pragma unroll
        for (int b = 0; b < 2; ++b)
#pragma unroll
            for (int m = 0; m < 4; ++m)
#pragma unroll
                for (int n = 0; n < 2; ++n) acc[a][b][m][n] = (f32x4){0.f, 0.f, 0.f, 0.f};
    bf16x8 At[4][2], B0[2][2], B1[2][2];
    const char* cA = (const char*)g.A + (size_t)cur.pm * tstepA; const char* cB = (const char*)g.Bt + (size_t)cur.pn * tstepB;
    S.a_ready(cur);
    if constexpr (SP2) {
        PG8_STAGE(PG8_SB(0, 0), cB, voffB); PG8_STAGE(PG8_SB(0, 1), cB + hstepB, voffB); PG8_STAGE(PG8_SA(0, 0), cA, voffA); PG8_STAGE(PG8_SA(0, 1), cA + hstepA, voffA);
        if (wr == 1) PG8_BAR;
        PG8_WAIT_V(2); PG8_BAR;
        PG8_STAGE(PG8_SB(1, 0), cB + kstep, voffB); PG8_STAGE(PG8_SA(1, 0), cA + kstep, voffA); PG8_STAGE(PG8_SB(1, 1), cB + hstepB + kstep, voffB);
        PG8_WAIT_V(6); PG8_BAR;
    } else {
        PG8_STAGE(PG8_SB(0, 0), cB, voffB); PG8_STAGE(PG8_SA(0, 0), cA, voffA); PG8_STAGE(PG8_SB(0, 1), cB + hstepB, voffB); PG8_STAGE(PG8_SA(0, 1), cA + hstepA, voffA);
        if (wr == 1) PG8_BAR;
        PG8_WAIT_V(4); PG8_BAR;
        PG8_STAGE(PG8_SB(1, 0), cB + kstep, voffB); PG8_STAGE(PG8_SA(1, 0), cA + kstep, voffA); PG8_STAGE(PG8_SB(1, 1), cB + hstepB + kstep, voffB);
        PG8_WAIT_V(6); PG8_BAR;
    }
    for (;;) {
        const bool has_next = S.next(ui + 1, nxt);
        const char* nA = has_next ? (const char*)g.A + (size_t)nxt.pm * tstepA : cA; const char* nB = has_next ? (const char*)g.Bt + (size_t)nxt.pn * tstepB : cB;
        for (int t = 0; t < nt; t += 2) {
            if constexpr (Epi::MID) { if (t == nt / 2) E.mid(acc, cur, wr, wc, fr, fq); }
            const bool last = (t == nt - 2);
            const char* a1 = cA + (size_t)(t + 1) * kstep;
            const char* a2 = last ? nA : cA + (size_t)(t + 2) * kstep; const char* b2 = last ? nB : cB + (size_t)(t + 2) * kstep;
            const char* a3 = a2 + kstep; const char* b3 = b2 + kstep;
            if (last && has_next) S.a_ready(nxt);
            if constexpr (SP2) {
            PG8_LDB(B0, 0, 0); PG8_LDB(B1, 0, 1); PG8_SCHED; PG8_LDA(At, 0, 0); PG8_STAGE(PG8_SA(1, 1), a1 + hstepA, voffA);
            PG8_WAIT_V(8); PG8_WAIT_L(0); PG8_BAR; PG8_MMA(0, 0, At, B0); PG8_MMA(0, 1, At, B1); PG8_BAR; PG8_SCHED;
            PG8_LDA(At, 0, 1); PG8_STAGE(PG8_SB(0, 0), b2, voffB); PG8_STAGE(PG8_SB(0, 1), b2 + hstepB, voffB); PG8_STAGE(PG8_SA(0, 0), a2, voffA);
            PG8_WAIT_V(8); PG8_WAIT_L(0); PG8_BAR; PG8_MMA(1, 0, At, B0); PG8_MMA(1, 1, At, B1); PG8_BAR; PG8_SCHED;
            PG8_LDB(B0, 1, 0); PG8_LDB(B1, 1, 1); PG8_SCHED; PG8_LDA(At, 1, 0); PG8_STAGE(PG8_SA(0, 1), a2 + hstepA, voffA);
            PG8_WAIT_V(8); PG8_WAIT_L(0); PG8_BAR; PG8_MMA(0, 0, At, B0); PG8_MMA(0, 1, At, B1); PG8_BAR; PG8_SCHED;
            PG8_LDA(At, 1, 1); PG8_STAGE(PG8_SB(1, 0), b3, voffB); PG8_STAGE(PG8_SB(1, 1), b3 + hstepB, voffB); PG8_STAGE(PG8_SA(1, 0), a3, voffA);
            PG8_WAIT_V(8); PG8_WAIT_L(0); PG8_BAR; PG8_MMA(1, 0, At, B0); PG8_MMA(1, 1, At, B1); PG8_BAR; PG8_SCHED;
            } else {
            PG8_LDB(B0, 0, 0); PG8_SCHED; PG8_LDA(At, 0, 0); PG8_STAGE(PG8_SA(1, 1), a1 + hstepA, voffA);
            PG8_WAIT_L(8); PG8_BAR; PG8_WAIT_L(0); PG8_MMA(0, 0, At, B0); PG8_BAR; PG8_SCHED;
            PG8_LDB(B1, 0, 1); PG8_STAGE(PG8_SB(0, 0), b2, voffB);
            PG8_BAR; PG8_WAIT_L(0); PG8_MMA(0, 1, At, B1); PG8_BAR;
            PG8_LDA(At, 0, 1); PG8_STAGE(PG8_SA(0, 0), a2, voffA);
            PG8_BAR; PG8_WAIT_L(0); PG8_MMA(1, 0, At, B0); PG8_BAR; PG8_SCHED;
            PG8_STAGE(PG8_SB(0, 1), b2 + hstepB, voffB);
            PG8_WAIT_V(6); PG8_BAR; PG8_MMA(1, 1, At, B1); PG8_BAR;
            PG8_LDB(B0, 1, 0); PG8_SCHED; PG8_LDA(At, 1, 0); PG8_STAGE(PG8_SA(0, 1), a2 + hstepA, voffA);
            PG8_WAIT_L(8); PG8_BAR; PG8_WAIT_L(0); PG8_MMA(0, 0, At, B0); PG8_BAR; PG8_SCHED;
            PG8_LDB(B1, 1, 1); PG8_STAGE(PG8_SB(1, 0), b3, voffB);
            PG8_BAR; PG8_WAIT_L(0); PG8_MMA(0, 1, At, B1); PG8_BAR;
            PG8_LDA(At, 1, 1); PG8_STAGE(PG8_SA(1, 0), a3, voffA);
            PG8_BAR; PG8_WAIT_L(0); PG8_MMA(1, 0, At, B0); PG8_BAR; PG8_SCHED;
            PG8_STAGE(PG8_SB(1, 1), b3 + hstepB, voffB);
            PG8_WAIT_V(6); PG8_BAR; PG8_MMA(1, 1, At, B1); PG8_BAR;
            }
        }
        if constexpr (ALIGN_EPI) { if (wr == 0) PG8_BAR; }
        if constexpr (!Epi::AFTER_DRAIN) { E(acc, cur, wr, wc, fr, fq); S.done(cur); }
        if (!has_next) break;
#pragma unroll
        for (int a = 0; a < 2; ++a)
#pragma unroll
            for (int b = 0; b < 2; ++b)
#pragma unroll
                for (int m = 0; m < 4; ++m)
#pragma unroll
                    for (int n = 0; n < 2; ++n) acc[a][b][m][n] = (f32x4){0.f, 0.f, 0.f, 0.f};
        cur = nxt; cA = nA; cB = nB; ++ui;
        if constexpr (ALIGN_EPI) { if (wr == 1) PG8_BAR; }
    }
    PG8_WAIT_V(0);
    if constexpr (!ALIGN_EPI) { if (wr == 0) PG8_BAR; }
    PG8_BAR;
    if constexpr (Epi::AFTER_DRAIN) { E.fused(acc, cur, wr, wc, fr, fq, lds, wid, lane); S.done(cur); }
#undef PG8_SA
#undef PG8_SB
#undef PG8_STAGE
#undef PG8_LDA
#undef PG8_LDB
#undef PG8_MMA
#undef PG8_WAIT_V
#undef PG8_WAIT_L
#undef PG8_BAR
#undef PG8_SCHED
}
}

constexpr int NWAVES = 8, NTHREADS = NWAVES * 64;
constexpr int BATCH = 8, SEQ = 4096, D = 1024, M = BATCH * SEQ;
constexpr int POOLW = 512, QW = 512, NG = 2, HD = 64, NBG = BATCH * NG;
constexpr int IN_COLS = 3864, NIN = 4096;
constexpr int NCMP = 255, NCMP_PAD = 256, NSEL = 64;
constexpr int PH = 8, PK = 128, PTOP = 16, PQD = 256, PQW = PH * PQD;
constexpr int NEXP = PK * PK;
constexpr float EPS = 1e-6f;
enum { I_X = 0, I_C, I_RELB, I_ADAW, I_ADAB, I_N1G, I_N2G, I_WIN, I_POOLW, I_POOLS, I_CPEK, I_CW1K, I_CW2K, I_CPEV, I_CW1V, I_CW2V, I_QNG, I_KNG, I_WBP, I_WBA, I_WOUT, I_PWQ, I_PSK, I_PU, I_PV, N_IN };

constexpr size_t MiB = 1u << 20, KiB = 1u << 10;
constexpr size_t WS_CTL = 0, CTL_ZERO_BYTES = 1 * MiB;
constexpr size_t WS_ADA = 1 * MiB;
constexpr size_t WS_CB1K = 64 * KiB;
constexpr size_t WS_CB1V = WS_CB1K + 1 * KiB;
constexpr size_t WS_BIASL = WS_ADA + 256 * KiB;
constexpr size_t WS_WIN_T = 2 * MiB;
constexpr size_t WS_WEFF_T = 10 * MiB;
constexpr size_t WS_WBA_T = 11 * MiB;
constexpr size_t WS_WOUT_T = 12 * MiB;
constexpr size_t WS_WQ_T = 14 * MiB;
constexpr size_t WS_SUBK = 18 * MiB;
constexpr size_t WS_CW1K_T = 18 * MiB + 512 * KiB;
constexpr size_t WS_CW1V_T = 19 * MiB;
constexpr size_t WS_CW2K_T = 19 * MiB + 512 * KiB;
constexpr size_t WS_CW2V_T = WS_CW2K_T + 64 * KiB;
constexpr size_t WS_KC = 20 * MiB;
constexpr size_t WS_VCT = 20 * MiB + 512 * KiB;
constexpr size_t WS_GATE = 21 * MiB;
constexpr size_t WS_UB = 24 * MiB;
constexpr size_t WS_VB = 56 * MiB;
constexpr size_t WS_SCLU = WS_UB + 16 * MiB, WS_SCLV = WS_SCLU + 64 * KiB;
constexpr size_t WS_H = 88 * MiB;
constexpr size_t WS_ZP = 152 * MiB;
constexpr size_t WS_Q = 184 * MiB;
constexpr size_t WS_KCR = 216 * MiB;
constexpr size_t WS_VCR = 225 * MiB;
constexpr size_t WS_KS = 234 * MiB, WS_VS = 242 * MiB, WS_KW = 250 * MiB, WS_VW = 258 * MiB;
constexpr size_t WS_VST = 266 * MiB, WS_VWT = 274 * MiB;
constexpr size_t WS_PL = 282 * MiB;
constexpr size_t WS_YA = 314 * MiB;
constexpr size_t WS_GM = 346 * MiB;
constexpr size_t WS_MIX = WS_ZP;
constexpr size_t WS_QV = WS_GM;
constexpr size_t WS_EID = WS_PL;
constexpr size_t WS_GW = WS_PL + 16 * MiB;
constexpr size_t WS_PART = WS_GM;
constexpr size_t WS_CF = WS_YA;
constexpr size_t WS_CFS = WS_YA + 8 * MiB;
constexpr size_t WS_H8 = WS_ZP;
constexpr size_t WS_HS = WS_ZP + 32 * MiB;
constexpr size_t WS_X1 = WS_KCR;
constexpr size_t WS_END = 474 * MiB;
constexpr int CW_TMO = 0, CW_CODE = 1, CW_BAR = 4096;

constexpr int RING_OFF = 0, RING_BYTES = 131072;
constexpr int LDSCTL_OFF = RING_BYTES, MISC_OFF = LDSCTL_OFF + 320;
constexpr int LDS_BYTES = 147456;

#define GAS __attribute__((address_space(1)))
#define LAS __attribute__((address_space(3)))
typedef unsigned short bf16;
typedef unsigned v4u __attribute__((ext_vector_type(4)));
typedef unsigned v2u __attribute__((ext_vector_type(2)));
typedef int v2i __attribute__((ext_vector_type(2)));
typedef float f32x4 __attribute__((ext_vector_type(4)));
typedef short bf16x8 __attribute__((ext_vector_type(8)));
typedef GAS unsigned gu32;
#define RLX_AGENT __ATOMIC_RELAXED, __HIP_MEMORY_SCOPE_AGENT
#define LDS_WAIT() asm volatile("s_waitcnt lgkmcnt(0)" ::: "memory")
#define VM_WAIT() asm volatile("s_waitcnt vmcnt(0)" ::: "memory")
__device__ __forceinline__ unsigned f2bf(float f) { unsigned u = __builtin_bit_cast(unsigned, f); return (u + 0x7fffu + ((u >> 16) & 1u)) >> 16; }
__device__ __forceinline__ unsigned pk2(float lo, float hi) { return f2bf(lo) | (f2bf(hi) << 16); }
__device__ __forceinline__ float bflo(unsigned w) { return __builtin_bit_cast(float, w << 16); }
__device__ __forceinline__ float bfhi(unsigned w) { return __builtin_bit_cast(float, w & 0xffff0000u); }
__device__ __forceinline__ float sigmoidf_(float v) { return __builtin_amdgcn_rcpf(1.0f + __builtin_amdgcn_exp2f(v * -1.4426950408889634f)); }
typedef __bf16 bf16x2_hw __attribute__((ext_vector_type(2)));
typedef float f32x2_hw __attribute__((ext_vector_type(2)));
__device__ __forceinline__ unsigned pkh(float lo, float hi) { return __builtin_bit_cast(unsigned, __builtin_convertvector((f32x2_hw){lo, hi}, bf16x2_hw)); }
__device__ __forceinline__ float gelu_tanh_safe(float v) { const float u = 0.7978845608028654f * (v + 0.044715f * v * v * v); return 0.5f * v * (1.0f + tanhf(u)); }
template <int CTRL> __device__ __forceinline__ float dppf(float v) { return __builtin_bit_cast(float, __builtin_amdgcn_update_dpp(0, __builtin_bit_cast(int, v), CTRL, 0xF, 0xF, true)); }
template <int CTRL> __device__ __forceinline__ int dppi(int v) { return __builtin_amdgcn_update_dpp(0, v, CTRL, 0xF, 0xF, true); }
#define DPP_XOR1 0xB1
#define DPP_XOR2 0x4E
#define DPP_HMIR 0x141
#define DPP_ROR8 0x128
__device__ __forceinline__ void swap16_(float& a, float& b) { asm volatile("v_nop\n\tv_nop\n\tv_permlane16_swap_b32 %0, %1" : "+v"(a), "+v"(b)); }
__device__ __forceinline__ void swap32_(float& a, float& b) { asm volatile("v_nop\n\tv_nop\n\tv_permlane32_swap_b32 %0, %1" : "+v"(a), "+v"(b)); }
__device__ __forceinline__ float sum_xor16(float v) { float a = v, b = v; swap16_(a, b); return a + b; }
__device__ __forceinline__ float sum_xor32(float v) { float a = v, b = v; swap32_(a, b); return a + b; }
__device__ __forceinline__ float max_xor16(float v) { float a = v, b = v; swap16_(a, b); return fmaxf(a, b); }
__device__ __forceinline__ float max_xor32(float v) { float a = v, b = v; swap32_(a, b); return fmaxf(a, b); }
__device__ __forceinline__ float wave_sum(float v) {
    v += dppf<DPP_XOR1>(v); v += dppf<DPP_XOR2>(v); v += dppf<DPP_HMIR>(v); v += dppf<DPP_ROR8>(v);
    return sum_xor32(sum_xor16(v));
}
__device__ __forceinline__ float wave_max(float v) {
    v = fmaxf(v, dppf<DPP_XOR1>(v)); v = fmaxf(v, dppf<DPP_XOR2>(v)); v = fmaxf(v, dppf<DPP_HMIR>(v)); v = fmaxf(v, dppf<DPP_ROR8>(v));
    return max_xor32(max_xor16(v));
}

#define XB_TMO      128
#define XB_XCNT(j)  (256  + 64 * (j))
#define XB_XSUB(j)  (1280 + 64 * (j))
#define XB_XGEN(j)  (2304 + 64 * (j))
#define XB_TOP      3328
#define XB_TOPGEN   3392
#define XCD_BAR_WORDS 3456
#define XB_SPIN_CAP (1u << 18)
__device__ __forceinline__ unsigned xb_ld(unsigned* p)              { return __hip_atomic_load(p, __ATOMIC_RELAXED, __HIP_MEMORY_SCOPE_AGENT); }
__device__ __forceinline__ unsigned xb_add(unsigned* p, unsigned v) { return __hip_atomic_fetch_add(p, v, __ATOMIC_RELAXED, __HIP_MEMORY_SCOPE_AGENT); }
__device__ __forceinline__ unsigned xb_xcc_id() { return (unsigned)__builtin_amdgcn_s_getreg((3 << 11) | 20) & 0xFu; }
#define XB_SPIN(cond, bar) do { unsigned _sp = 0; while (cond) { __builtin_amdgcn_s_sleep(1); \
    if ((++_sp & 255u) == 0u) { if (xb_ld(&(bar)[XB_TMO])) break; if (_sp > XB_SPIN_CAP) { atomicAdd(&(bar)[XB_TMO], 1u); break; } } } } while (0)
struct XcdBarrier { unsigned* bar; unsigned x; volatile LAS unsigned* st; };
__device__ __forceinline__ XcdBarrier xcd_barrier_post(unsigned* bar, volatile LAS unsigned* st) {
    XcdBarrier b; b.bar = bar; b.x = xb_xcc_id(); b.st = st;
    if (threadIdx.x == 0) (void)xb_add(&bar[XB_XCNT(b.x)], 1u);
    return b;
}
__device__ __forceinline__ void xcd_barrier_complete(unsigned* bar, unsigned x, unsigned& nloc, unsigned& nx) {
    const unsigned G = gridDim.x * gridDim.y * gridDim.z;
    unsigned sum, cnt, mine, sp = 0u;
    for (;;) {
        sum = 0u; cnt = 0u; mine = 0u;
#pragma unroll
        for (unsigned j = 0; j < 16; ++j) { const unsigned c = xb_ld(&bar[XB_XCNT(j)]); sum += c; cnt += (c > 0u) ? 1u : 0u; mine = (j == x) ? c : mine; }
        if (sum == G) break;
        __builtin_amdgcn_s_sleep(1);
        if ((++sp & 255u) == 0u) { if (xb_ld(&bar[XB_TMO])) break; if (sp > XB_SPIN_CAP) { atomicAdd(&bar[XB_TMO], 1u); break; } }
    }
    nloc = mine > 0u ? mine : 1u; nx = cnt > 0u ? cnt : 1u;
}
__device__ __forceinline__ void xcd_barrier(const XcdBarrier& b) {
    asm volatile("s_waitcnt vmcnt(0)" ::: "memory");
    __syncthreads();
    if (threadIdx.x == 0) {
        unsigned* bar = b.bar;
        __builtin_amdgcn_s_waitcnt(0);
        unsigned nloc = b.st[0], nx = b.st[1];
        if (nloc == 0u) { xcd_barrier_complete(bar, b.x, nloc, nx); b.st[0] = nloc; b.st[1] = nx; }
        const unsigned old = xb_add(&bar[XB_XSUB(b.x)], 1u);
        const unsigned gen = old / nloc;
        if (old + 1u == (gen + 1u) * nloc) {
            __builtin_amdgcn_fence(__ATOMIC_RELEASE, "agent");
            asm volatile("s_waitcnt vmcnt(0)" ::: "memory");
            const unsigned og = xb_add(&bar[XB_TOP], 1u);
            const unsigned tg = og / nx;
            if (og + 1u == (tg + 1u) * nx) xb_add(&bar[XB_TOPGEN], 1u);
            else XB_SPIN(xb_ld(&bar[XB_TOPGEN]) == tg, bar);
            __builtin_amdgcn_fence(__ATOMIC_ACQUIRE, "agent");
            xb_add(&bar[XB_XGEN(b.x)], 1u);
            asm volatile("s_waitcnt vmcnt(0)" ::: "memory");
        } else {
            XB_SPIN(xb_ld(&bar[XB_XGEN(b.x)]) == gen, bar);
            __builtin_amdgcn_fence(__ATOMIC_ACQUIRE, "agent");
            asm volatile("s_waitcnt vmcnt(0)" ::: "memory");
        }
    }
    __syncthreads();
}

struct Args { const float* in[N_IN]; float* out; unsigned char* ws; int ph_lo, ph_hi, li, pad; };
struct Frame {
    LAS unsigned char* lds;
    volatile LAS unsigned* MISC;
    gu32* ctl;
    int tid, lane, wave, G, bid;
    unsigned char* ws;
};

template <bool I8> __device__ __forceinline__ void cvt_row_store(const f32x4 (&v)[4], int row, unsigned char* dst, float* inv_scale, int lane) {
    float m = 0.f;
#pragma unroll
    for (int j = 0; j < 4; ++j) m = fmaxf(m, fmaxf(fmaxf(fabsf(v[j].x), fabsf(v[j].y)), fmaxf(fabsf(v[j].z), fabsf(v[j].w))));
    m = wave_max(m);
    unsigned ww[4]; float isc;
    if (I8) { const float sc = m > 0.f ? 127.0f / m : 0.f; isc = m * (1.0f / 127.0f);
#pragma unroll
        for (int j = 0; j < 4; ++j) { const int q0 = (int)rintf(v[j].x * sc), q1 = (int)rintf(v[j].y * sc), q2 = (int)rintf(v[j].z * sc), q3 = (int)rintf(v[j].w * sc);
            ww[j] = ((unsigned)q0 & 0xffu) | (((unsigned)q1 & 0xffu) << 8) | (((unsigned)q2 & 0xffu) << 16) | (((unsigned)q3 & 0xffu) << 24); } }
    else { const unsigned E = (__builtin_bit_cast(unsigned, m) >> 23) & 0xffu; float sc = 1.f; isc = 1.f;
        if (E >= 8u && E <= 250u) { sc = __builtin_bit_cast(float, (261u - E) << 23); isc = __builtin_bit_cast(float, (E - 7u) << 23); }
#pragma unroll
        for (int j = 0; j < 4; ++j) { int t = __builtin_amdgcn_cvt_pk_fp8_f32(v[j].x * sc, v[j].y * sc, 0, false); t = __builtin_amdgcn_cvt_pk_fp8_f32(v[j].z * sc, v[j].w * sc, t, true); ww[j] = (unsigned)t; } }
    *(GAS v4u*)(dst + (size_t)(lane >> 3) * NEXP * 128 + (size_t)row * 128 + 16 * (lane & 7)) = (v4u){ww[0], ww[1], ww[2], ww[3]};
    if (lane == 0) inv_scale[row] = isc;
}
template <bool I8> __device__ __forceinline__ void cvt_rows_8bit(const float* src, unsigned char* dst, float* inv_scale, int gw, int NGW, int lane) {
    for (int row = gw; row < NEXP; row += 2 * NGW) {
        const int row1 = row + NGW; const bool has1 = row1 < NEXP;
        f32x4 v0[4], v1[4];
#pragma unroll
        for (int j = 0; j < 4; ++j) v0[j] = *(const GAS f32x4*)(src + (size_t)row * D + 16 * lane + 4 * j);
#pragma unroll
        for (int j = 0; j < 4; ++j) v1[j] = has1 ? *(const GAS f32x4*)(src + (size_t)row1 * D + 16 * lane + 4 * j) : (f32x4){0.f, 0.f, 0.f, 0.f};
        cvt_row_store<I8>(v0, row, dst, inv_scale, lane);
        if (has1) cvt_row_store<I8>(v1, row1, dst, inv_scale, lane);
    }
}
__device__ __forceinline__ void p0_transpose_item(const float* W, int ldw, int src_col0, int valid, int K, bf16* WT, int dst_row0, int k0, LAS float* scr, int lane, int ldt = -1) {
    if (ldt < 0) ldt = K;
    const int n_ = lane & 31;
#pragma unroll 8
    for (int i = 0; i < 32; ++i) { const int kk = 2 * i + (lane >> 5); scr[kk * 33 + n_] = (n_ < valid) ? W[(size_t)(k0 + kk) * ldw + src_col0 + n_] : 0.f; }
    LDS_WAIT(); asm volatile("" ::: "memory");
    const int c = lane & 7;
#pragma unroll
    for (int j = 0; j < 4; ++j) { const int n = (lane >> 3) + 8 * j; const LAS float* s = scr + (8 * c) * 33 + n;
        v4u o; o.x = pk2(s[0 * 33], s[1 * 33]); o.y = pk2(s[2 * 33], s[3 * 33]); o.z = pk2(s[4 * 33], s[5 * 33]); o.w = pk2(s[6 * 33], s[7 * 33]);
        *(GAS v4u*)(WT + (size_t)(dst_row0 + n) * ldt + k0 + 8 * c) = o; }
    LDS_WAIT(); asm volatile("" ::: "memory");
}
__device__ __forceinline__ bool p0_mat(int& r, const float* W, int K, int N, bf16* WT, LAS float* scr, int lane, int ldt = -1) {
    const int ng = N / 32, items = ng * (K / 64);
    if (r < items) { const int kb = r / ng, nb = r % ng; p0_transpose_item(W, N, 32 * nb, 32, K, WT, 32 * nb, 64 * kb, scr, lane, ldt); return true; }
    r -= items; return false;
}
__device__ __forceinline__ void cvt_f32_bf16_stream(const float* src, bf16* dst, size_t n8, size_t gtid, size_t gthreads) {
    for (size_t i = gtid; i < n8; i += gthreads) {
        const f32x4 a = *(const GAS f32x4*)(src + 8 * i), b = *(const GAS f32x4*)(src + 8 * i + 4);
        v4u o; o.x = pk2(a.x, a.y); o.y = pk2(a.z, a.w); o.z = pk2(b.x, b.y); o.w = pk2(b.z, b.w);
        *(GAS v4u*)(dst + 8 * i) = o; }
}

__device__ __forceinline__ void p0_prologue(Frame& F, const Args& args, bool do_bias = true) {
    unsigned char* ws = F.ws;
    const int gw = F.bid * NWAVES + F.wave, NGW = F.G * NWAVES;
    const size_t gtid = (size_t)F.bid * NTHREADS + F.tid, gthreads = (size_t)F.G * NTHREADS;
    {
        LAS float* sl = (LAS float*)(F.lds);
        LAS float* red = (LAS float*)(F.lds + 32768);
        const float* c = args.in[I_C];
        { f32x4 cv[4];
#pragma unroll
          for (int q = 0; q < 4; ++q) cv[q] = *(const GAS f32x4*)(c + 4 * (F.tid + NTHREADS * q));
#pragma unroll
          for (int q = 0; q < 4; ++q) { f32x4 o; o.x = cv[q].x / (1.0f + __expf(-cv[q].x)); o.y = cv[q].y / (1.0f + __expf(-cv[q].y)); o.z = cv[q].z / (1.0f + __expf(-cv[q].z)); o.w = cv[q].w / (1.0f + __expf(-cv[q].w));
              *(LAS f32x4*)(sl + 4 * (F.tid + NTHREADS * q)) = o; } }
        __syncthreads();
        for (int cb = F.bid; cb < 6 * D / 24; cb += F.G) {
            const int j0 = cb * 24;
            if (F.tid < 510) {
                const int kk = F.tid / 6, c4 = F.tid % 6;
                const float* w = args.in[I_ADAW] + j0 + 4 * c4;
                f32x4 wv[13];
#pragma unroll
                for (int m = 0; m < 13; ++m) { const int k = kk + 85 * m; wv[m] = (k < D) ? *(const GAS f32x4*)(w + (size_t)k * (6 * D)) : (f32x4){0.f, 0.f, 0.f, 0.f}; }
                f32x4 a[BATCH];
#pragma unroll
                for (int b = 0; b < BATCH; ++b) a[b] = (f32x4){0.f, 0.f, 0.f, 0.f};
#pragma unroll
                for (int m = 0; m < 13; ++m) { const int k = kk + 85 * m; const int kc = k < D ? k : 0;
#pragma unroll
                    for (int b = 0; b < BATCH; ++b) a[b] = a[b] + wv[m] * sl[b * D + kc]; }
#pragma unroll
                for (int b = 0; b < BATCH; ++b) { LAS float* rp = red + (kk * 24 + 4 * c4) * BATCH + b; rp[0] = a[b].x; rp[BATCH] = a[b].y; rp[2 * BATCH] = a[b].z; rp[3 * BATCH] = a[b].w; }
            }
            __syncthreads();
            if (F.tid < 24 * BATCH) { const int jj = F.tid / BATCH, b = F.tid % BATCH; float s = 0.f;
#pragma unroll 5
                for (int kk = 0; kk < 85; ++kk) s += red[(kk * 24 + jj) * BATCH + b];
                ((float*)(ws + WS_ADA))[b * (6 * D) + j0 + jj] = s + args.in[I_ADAB][j0 + jj]; }
            __syncthreads();
        }
    }
    if (F.bid >= 8 && F.bid < 40 && do_bias) {
        const int bb = F.bid - 8, kv = bb & 1, ch = bb >> 1;
        const float* pe = args.in[kv == 0 ? I_CPEK : I_CPEV]; const float* w1 = args.in[kv == 0 ? I_CW1K : I_CW1V];
        LAS float* red = (LAS float*)(F.lds);
        const int j = F.tid & 127, ic = F.tid >> 7; float s = 0.f;
        const int i0 = ch * 128 + ic * 32;
#pragma unroll 8
        for (int i = i0; i < i0 + 32; ++i) s += pe[i] * w1[(size_t)i * 128 + j];
        red[ic * 128 + j] = s; __syncthreads();
        if (F.tid < 128) atomicAdd((float*)(ws + (kv == 0 ? WS_CB1K : WS_CB1V)) + F.tid, (red[F.tid] + red[128 + F.tid]) + (red[256 + F.tid] + red[384 + F.tid]));
        __syncthreads();
    } else if (F.bid == 2) {
        for (int i = F.tid; i < 8 * 128; i += NTHREADS) { const int h = i >> 7, rel = i & 127;
            int bk = rel;
            if (rel >= 16) bk = 16 + (rel >= 19) + (rel >= 21) + (rel >= 24) + (rel >= 27) + (rel >= 31) + (rel >= 35) + (rel >= 40) + (rel >= 46) + (rel >= 52) + (rel >= 59) + (rel >= 67) + (rel >= 77) + (rel >= 87) + (rel >= 99) + (rel >= 113);
            ((float*)(ws + WS_BIASL))[i] = args.in[I_RELB][bk * 8 + h]; }
        if (F.tid < 64) {
            float mq = fabsf(args.in[I_QNG][F.tid]), mk = fmaxf(fmaxf(fabsf(args.in[I_KNG][F.tid]), fabsf(args.in[I_KNG][64 + F.tid])), fabsf(args.in[I_KNG][128 + F.tid]));
            float mb = fmaxf(fmaxf(fabsf(args.in[I_RELB][F.tid]), fabsf(args.in[I_RELB][64 + F.tid])), fmaxf(fabsf(args.in[I_RELB][128 + F.tid]), fabsf(args.in[I_RELB][192 + F.tid])));
            mq = wave_max(mq); mk = wave_max(mk); mb = wave_max(mb);
            if (F.tid == 0) ((float*)(ws + WS_BIASL))[8 * 128] = 8.0f * mq * mk + mb; }
    }
    {
        LAS float* scr = (LAS float*)(F.lds + F.wave * 16384);
        constexpr int I_WINT = (NIN / 32) * (D / 64);
        constexpr int NITEMS = I_WINT + (1024 / 32) * (512 / 64) + (1024 / 32) * (1024 / 64) + 2 * (128 / 32) * (2048 / 64) + 2 * (64 / 32) * (128 / 64);
        for (int it = gw; it < NITEMS; it += NGW) {
            int r = it;
            if (r < I_WINT) {
                const int grp = r % (NIN / 32), kb = r / (NIN / 32);
                const int tile = grp >> 3, ct0 = (grp & 7) * 32;
                const int L0 = 64 * ((ct0 >> 5) & 3) + 32 * (ct0 >> 7);
                int src0, valid = 32;
                if (tile < 7) src0 = 256 * tile + L0; else if (tile < 15) src0 = 1816 + 256 * (tile - 7) + L0; else { src0 = 1792 + L0; valid = (L0 == 0) ? 24 : 0; }
                if (valid == 0) src0 = 0;
                p0_transpose_item(args.in[I_WIN], IN_COLS, src0, valid, D, (bf16*)(ws + WS_WIN_T), 32 * grp, 64 * kb, scr, F.lane);
                continue; }
            r -= I_WINT;
            if (p0_mat(r, args.in[I_WBA], 512, 1024, (bf16*)(ws + WS_WEFF_T) + 512, scr, F.lane, 1024)) continue;
            if (p0_mat(r, args.in[I_WOUT], 1024, 1024, (bf16*)(ws + WS_WOUT_T), scr, F.lane)) continue;
            if (p0_mat(r, args.in[I_CW1K], 2048, 128, (bf16*)(ws + WS_CW1K_T), scr, F.lane)) continue;
            if (p0_mat(r, args.in[I_CW1V], 2048, 128, (bf16*)(ws + WS_CW1V_T), scr, F.lane)) continue;
            if (p0_mat(r, args.in[I_CW2K], 128, 64, (bf16*)(ws + WS_CW2K_T), scr, F.lane)) continue;
            p0_mat(r, args.in[I_CW2V], 128, 64, (bf16*)(ws + WS_CW2V_T), scr, F.lane);
        }
    }
    {
        const float* pw = args.in[I_POOLW]; const float* ps = args.in[I_POOLS]; const float* wbp = args.in[I_WBP];
        bf16* weff = (bf16*)(ws + WS_WEFF_T);
        LAS float* PWl = (LAS float*)(F.lds);
        LAS float* WBl = (LAS float*)(F.lds + 128 * 129 * 4);
        __syncthreads();
        for (int bb = F.bid; bb < 256; bb += F.G) {
            const int g = bb >> 6, d0 = (bb & 63) * 16;
            { f32x4 t[8];
#pragma unroll
              for (int q = 0; q < 8; ++q) t[q] = *(const GAS f32x4*)(pw + (size_t)g * 16384 + 4 * (F.tid + NTHREADS * q));
#pragma unroll
              for (int q = 0; q < 8; ++q) { const int i = 4 * (F.tid + NTHREADS * q); LAS float* d = PWl + (i >> 7) * 129 + (i & 127); d[0] = t[q].x; d[1] = t[q].y; d[2] = t[q].z; d[3] = t[q].w; }
              const int cc = F.tid >> 2, d4 = (F.tid & 3) * 4;
              const f32x4 wv = *(const GAS f32x4*)(wbp + (size_t)(g * 128 + cc) * D + d0 + d4); const float pv = ps[g * 128 + cc];
              LAS float* d = WBl + cc * 17 + d4; d[0] = wv.x * pv; d[1] = wv.y * pv; d[2] = wv.z * pv; d[3] = wv.w * pv; }
            __syncthreads();
            const int c = F.tid & 127, q = F.tid >> 7;
            float acc4[4] = {0.f, 0.f, 0.f, 0.f};
#pragma unroll 4
            for (int cc = 0; cc < 128; ++cc) { const float a = PWl[c * 129 + cc];
#pragma unroll
                for (int e = 0; e < 4; ++e) acc4[e] += a * WBl[cc * 17 + 4 * q + e]; }
#pragma unroll
            for (int e = 0; e < 4; ++e) weff[(size_t)(d0 + 4 * q + e) * 1024 + g * 128 + c] = (bf16)f2bf(acc4[e]);
            __syncthreads();
        }
    }
    {
        const float* wq = args.in[I_PWQ]; const float* sk = args.in[I_PSK]; bf16* wf = (bf16*)(ws + WS_WQ_T);
        const int l15 = F.lane & 15, lq = F.lane >> 4;
        for (int bb = F.bid; bb < 256; bb += F.G) {
            const int hp = bb >> 4, kg = bb & 15;
            bf16x8 bfr[4];
#pragma unroll
            for (int ks = 0; ks < 4; ++ks) { const float* sp = sk + ((size_t)hp * 128 + 16 * F.wave + l15) * 128 + 32 * ks + 8 * lq;
                const f32x4 s0 = *(const GAS f32x4*)sp, s1 = *(const GAS f32x4*)(sp + 4);
                bfr[ks] = __builtin_bit_cast(bf16x8, (v4u){pkh(s0.x, s0.y), pkh(s0.z, s0.w), pkh(s1.x, s1.y), pkh(s1.z, s1.w)}); }
#pragma unroll
            for (int cb = 0; cb < 4; ++cb) {
                pg8::f32x4 acc = (pg8::f32x4){0.f, 0.f, 0.f, 0.f};
#pragma unroll
                for (int ks = 0; ks < 4; ++ks) { const float* ap = wq + (size_t)(64 * kg + 16 * cb + l15) * PQW + hp * 128 + 32 * ks + 8 * lq;
                    const f32x4 a0 = *(const GAS f32x4*)ap, a1 = *(const GAS f32x4*)(ap + 4);
                    const bf16x8 af = __builtin_bit_cast(bf16x8, (v4u){pkh(a0.x, a0.y), pkh(a0.z, a0.w), pkh(a1.x, a1.y), pkh(a1.z, a1.w)});
                    acc = __builtin_amdgcn_mfma_f32_16x16x32_bf16(af, bfr[ks], acc, 0, 0, 0); }
                v2u o; o.x = pkh(acc[0], acc[1]); o.y = pkh(acc[2], acc[3]);
                *(GAS v2u*)(wf + (size_t)(hp * 128 + 16 * F.wave + l15) * D + 64 * kg + 16 * cb + 4 * lq) = o; }
        }
    }
    cvt_rows_8bit<true>(args.in[I_PU], ws + WS_UB, (float*)(ws + WS_SCLU), gw, NGW, F.lane);
    cvt_rows_8bit<false>(args.in[I_PV], ws + WS_VB, (float*)(ws + WS_SCLV), gw, NGW, F.lane);
}

template <bool Q8> __device__ __forceinline__ void modnorm_rows(Frame& F, const void* xin, const float* g, const float* ada, int shift_idx, bf16* out) {
    const int gw = F.bid * NWAVES + F.wave, NGW = F.G * NWAVES;
    for (int m = gw; m < M; m += NGW) {
        const int b = m >> 12;
        const GAS f32x4* gr = (const GAS f32x4*)g + F.lane;
        const GAS f32x4* sh = (const GAS f32x4*)(ada + (size_t)b * 6 * D + shift_idx * D) + F.lane;
        const GAS f32x4* sc = (const GAS f32x4*)(ada + (size_t)b * 6 * D + (shift_idx + 1) * D) + F.lane;
        f32x4 v[4]; float s = 0.f;
#pragma unroll
        for (int j = 0; j < 4; ++j) {
            if (Q8) { const v2u xb = ((const GAS v2u*)((const bf16*)xin + (size_t)m * D))[F.lane + 64 * j]; v[j] = (f32x4){bflo(xb.x), bfhi(xb.x), bflo(xb.y), bfhi(xb.y)}; }
            else v[j] = ((const GAS f32x4*)((const float*)xin + (size_t)m * D))[F.lane + 64 * j];
            s += (v[j].x * v[j].x + v[j].y * v[j].y) + (v[j].z * v[j].z + v[j].w * v[j].w); }
        const float rstd = rsqrtf(wave_sum(s) * (1.f / D) + EPS);
        GAS v2u* o8 = (GAS v2u*)(out + (size_t)m * D) + F.lane;
        float mx = 0.f;
#pragma unroll
        for (int j = 0; j < 4; ++j) { const f32x4 gg = gr[64 * j], ss = sh[64 * j], cc = sc[64 * j];
            const f32x4 y = (v[j] * rstd) * gg * (cc + 1.0f) + ss; v[j] = y;
            mx = fmaxf(mx, fmaxf(fmaxf(fabsf(y.x), fabsf(y.y)), fmaxf(fabsf(y.z), fabsf(y.w))));
            v2u o; o.x = pk2(y.x, y.y); o.y = pk2(y.z, y.w); o8[64 * j] = o; }
        if (Q8) {
            mx = wave_max(mx);
            const float qs = mx > 0.f ? 127.0f / mx : 0.f;
            GAS unsigned* h8 = (GAS unsigned*)(F.ws + WS_H8 + (size_t)m * D) + F.lane;
#pragma unroll
            for (int j = 0; j < 4; ++j) { const int q0 = (int)rintf(v[j].x * qs), q1 = (int)rintf(v[j].y * qs), q2 = (int)rintf(v[j].z * qs), q3 = (int)rintf(v[j].w * qs);
                h8[64 * j] = ((unsigned)q0 & 0xffu) | (((unsigned)q1 & 0xffu) << 8) | (((unsigned)q2 & 0xffu) << 16) | (((unsigned)q3 & 0xffu) << 24); }
            if (F.lane == 0) ((float*)(F.ws + WS_HS))[m] = mx * (1.0f / 127.0f);
        }
    }
}

struct EpiIn {
    static constexpr bool PERM = true, AFTER_DRAIN = false, MID = false;
    unsigned char* ws; const float* qg; const float* kg; const volatile LAS unsigned* rmp;
    __device__ __forceinline__ void operator()(const pg8::f32x4 (&acc)[2][2][4][2], const pg8::Unit& u, int wr, int wc, int fr, int fq) const {
        const int pn = u.pn, rmask = __builtin_amdgcn_readfirstlane((int)*rmp);
#pragma unroll
        for (int ai = 0; ai < 2; ++ai)
#pragma unroll
            for (int m = 0; m < 4; ++m) {
                const int row = (u.pm & rmask) * 256 + ai * 128 + wr * 64 + m * 16 + fr;
                float v[2][8];
#pragma unroll
                for (int bj = 0; bj < 2; ++bj)
#pragma unroll
                    for (int n = 0; n < 2; ++n)
#pragma unroll
                        for (int i = 0; i < 4; ++i) v[bj][4 * n + i] = acc[ai][bj][m][n][i];
                bf16* dst = nullptr; bool norm = false; const float* gain = nullptr; float mul = 1.f; bool sig = false;
                if (pn < 2) { dst = (bf16*)(ws + WS_ZP) + (size_t)row * 512 + 256 * pn + 64 * wc; }
                else if (pn < 4) { dst = (bf16*)(ws + WS_Q) + (size_t)row * 512 + 256 * (pn - 2) + 64 * wc; norm = true; gain = qg; mul = 0.125f * 1.4426950408889634f; }
                else if (pn < 7) { const int kind = pn - 4, isv = wc >> 1, g = wc & 1, b = row >> 12, t = row & 4095;
                    const size_t base = ((size_t)(b * 2 + g) * SEQ + t) * 64;
                    const size_t off = kind == 0 ? (isv ? WS_VCR : WS_KCR) : kind == 1 ? (isv ? WS_VS : WS_KS) : (isv ? WS_VW : WS_KW);
                    dst = (bf16*)(ws + off) + base; if (!isv && kind > 0) { norm = true; gain = kg + kind * 64; } }
                else if (pn < 15) { dst = (bf16*)(ws + WS_GM) + (size_t)row * 2048 + 256 * (pn - 7) + 64 * wc; sig = true; }
                else {
                    if (wc == 0 && fq < 3) { float* gp = (float*)(ws + WS_GATE) + (size_t)row * 24 + 8 * fq;
                        *(GAS f32x4*)gp = (f32x4){sigmoidf_(v[0][0]), sigmoidf_(v[0][1]), sigmoidf_(v[0][2]), sigmoidf_(v[0][3])};
                        *(GAS f32x4*)(gp + 4) = (f32x4){sigmoidf_(v[0][4]), sigmoidf_(v[0][5]), sigmoidf_(v[0][6]), sigmoidf_(v[0][7])}; }
                    continue; }
                if (norm) { float ss = 0.f;
#pragma unroll
                    for (int bj = 0; bj < 2; ++bj)
#pragma unroll
                        for (int e = 0; e < 8; ++e) ss += v[bj][e] * v[bj][e];
                    ss = sum_xor32(sum_xor16(ss));
                    const float rs = rsqrtf(ss * (1.f / 64.f) + EPS) * mul;
#pragma unroll
                    for (int bj = 0; bj < 2; ++bj)
#pragma unroll
                        for (int e = 0; e < 8; ++e) v[bj][e] = v[bj][e] * rs * gain[32 * bj + 8 * fq + e]; }
                if (sig) {
#pragma unroll
                    for (int bj = 0; bj < 2; ++bj)
#pragma unroll
                        for (int e = 0; e < 8; ++e) v[bj][e] = sigmoidf_(v[bj][e]); }
#pragma unroll
                for (int bj = 0; bj < 2; ++bj) { v4u o; o.x = pkh(v[bj][0], v[bj][1]); o.y = pkh(v[bj][2], v[bj][3]); o.z = pkh(v[bj][4], v[bj][5]); o.w = pkh(v[bj][6], v[bj][7]);
                    *(GAS v4u*)(dst + 32 * bj + 8 * fq) = o; }
            }
    }
};
template <bool ADD> struct EpiMix {
    static constexpr bool PERM = true, AFTER_DRAIN = false, MID = false;
    bf16* MIX; const bf16* GM; int gmoff;
    __device__ __forceinline__ void operator()(const pg8::f32x4 (&acc)[2][2][4][2], const pg8::Unit& u, int wr, int wc, int fr, int fq) const {
#pragma unroll
        for (int ai = 0; ai < 2; ++ai)
#pragma unroll
            for (int m = 0; m < 4; ++m) {
                const int row = u.pm * 256 + ai * 128 + wr * 64 + m * 16 + fr;
#pragma unroll
                for (int bj = 0; bj < 2; ++bj) {
                    const int col = u.pn * 256 + bj * 128 + wc * 32 + 8 * fq;
                    const v4u gmv = *(const GAS v4u*)(GM + (size_t)row * 2048 + gmoff + col);
                    float r[8];
                    r[0] = acc[ai][bj][m][0][0] * bflo(gmv.x); r[1] = acc[ai][bj][m][0][1] * bfhi(gmv.x); r[2] = acc[ai][bj][m][0][2] * bflo(gmv.y); r[3] = acc[ai][bj][m][0][3] * bfhi(gmv.y);
                    r[4] = acc[ai][bj][m][1][0] * bflo(gmv.z); r[5] = acc[ai][bj][m][1][1] * bfhi(gmv.z); r[6] = acc[ai][bj][m][1][2] * bflo(gmv.w); r[7] = acc[ai][bj][m][1][3] * bfhi(gmv.w);
                    GAS v4u* dp = (GAS v4u*)(MIX + (size_t)row * 1024 + col);
                    if (ADD) { const v4u old = *dp; r[0] += bflo(old.x); r[1] += bfhi(old.x); r[2] += bflo(old.y); r[3] += bfhi(old.y); r[4] += bflo(old.z); r[5] += bfhi(old.z); r[6] += bflo(old.w); r[7] += bfhi(old.w); }
                    v4u o; o.x = pkh(r[0], r[1]); o.y = pkh(r[2], r[3]); o.z = pkh(r[4], r[5]); o.w = pkh(r[6], r[7]); *dp = o; }
            }
    }
};
struct EpiMix2 {
    static constexpr bool PERM = true, AFTER_DRAIN = false, MID = true;
    bf16* MIX; const bf16* GM;
    __device__ __forceinline__ void mid(pg8::f32x4 (&acc)[2][2][4][2], const pg8::Unit& u, int wr, int wc, int fr, int fq) const {
#pragma unroll
        for (int ai = 0; ai < 2; ++ai)
#pragma unroll
            for (int m = 0; m < 4; ++m) {
                const int row = u.pm * 256 + ai * 128 + wr * 64 + m * 16 + fr;
#pragma unroll
                for (int bj = 0; bj < 2; ++bj) {
                    const int col = u.pn * 256 + bj * 128 + wc * 32 + 8 * fq;
                    const v4u g1 = *(const GAS v4u*)(GM + (size_t)row * 2048 + col), g2 = *(const GAS v4u*)(GM + (size_t)row * 2048 + 1024 + col);
                    const unsigned w1[4] = {g1.x, g1.y, g1.z, g1.w}, w2[4] = {g2.x, g2.y, g2.z, g2.w};
#pragma unroll
                    for (int n = 0; n < 2; ++n)
#pragma unroll
                        for (int i = 0; i < 4; ++i) { const unsigned a = w1[2 * n + (i >> 1)], b = w2[2 * n + (i >> 1)];
                            const float ga = (i & 1) ? bfhi(a) : bflo(a), gb = fmaxf((i & 1) ? bfhi(b) : bflo(b), 9.5367431640625e-07f);
                            acc[ai][bj][m][n][i] *= ga * __builtin_amdgcn_rcpf(gb); } }
            }
    }
    __device__ __forceinline__ void operator()(const pg8::f32x4 (&acc)[2][2][4][2], const pg8::Unit& u, int wr, int wc, int fr, int fq) const {
#pragma unroll
        for (int ai = 0; ai < 2; ++ai)
#pragma unroll
            for (int m = 0; m < 4; ++m) {
                const int row = u.pm * 256 + ai * 128 + wr * 64 + m * 16 + fr;
#pragma unroll
                for (int bj = 0; bj < 2; ++bj) {
                    const int col = u.pn * 256 + bj * 128 + wc * 32 + 8 * fq;
                    const v4u g2 = *(const GAS v4u*)(GM + (size_t)row * 2048 + 1024 + col);
                    const unsigned w2[4] = {g2.x, g2.y, g2.z, g2.w};
                    float r[8];
#pragma unroll
                    for (int n = 0; n < 2; ++n)
#pragma unroll
                        for (int i = 0; i < 4; ++i) { const unsigned b = w2[2 * n + (i >> 1)];
                            r[4 * n + i] = acc[ai][bj][m][n][i] * fmaxf((i & 1) ? bfhi(b) : bflo(b), 9.5367431640625e-07f); }
                    v4u o; o.x = pkh(r[0], r[1]); o.y = pkh(r[2], r[3]); o.z = pkh(r[4], r[5]); o.w = pkh(r[6], r[7]);
                    *(GAS v4u*)(MIX + (size_t)row * 1024 + col) = o; }
            }
    }
};
struct EpiRes {
    static constexpr bool PERM = true, AFTER_DRAIN = false, MID = false;
    const float* x; bf16* x1; const float* ada; int gate_idx;
    __device__ __forceinline__ void operator()(const pg8::f32x4 (&acc)[2][2][4][2], const pg8::Unit& u, int wr, int wc, int fr, int fq) const {
#pragma unroll
        for (int ai = 0; ai < 2; ++ai)
#pragma unroll
            for (int m = 0; m < 4; ++m) {
                const int row = u.pm * 256 + ai * 128 + wr * 64 + m * 16 + fr, b = row >> 12;
#pragma unroll
                for (int bj = 0; bj < 2; ++bj) {
                    const int col = u.pn * 256 + bj * 128 + wc * 32 + 8 * fq;
                    const float* gp = ada + (size_t)b * 6 * D + gate_idx * D + col; const float* xp = x + (size_t)row * D + col;
                    const f32x4 g0 = *(const GAS f32x4*)gp, g1 = *(const GAS f32x4*)(gp + 4), x0 = *(const GAS f32x4*)xp, x1v = *(const GAS f32x4*)(xp + 4);
                    const f32x4 r0 = x0 + g0 * acc[ai][bj][m][0], r1 = x1v + g1 * acc[ai][bj][m][1];
                    v4u o; o.x = pkh(r0.x, r0.y); o.y = pkh(r0.z, r0.w); o.z = pkh(r1.x, r1.y); o.w = pkh(r1.z, r1.w);
                    *(GAS v4u*)(x1 + (size_t)row * D + col) = o; }
            }
    }
};

template <int W> __device__ __forceinline__ void pool_load(const bf16* zp, int row, int t, int col, v4u (&z)[W]) {
#pragma unroll
    for (int j = 0; j < W; ++j) z[j] = (j <= t) ? *(const GAS v4u*)(zp + (size_t)(row - j) * 512 + col) : (v4u){0u, 0u, 0u, 0u};
}
template <int W> __device__ __forceinline__ v4u pool_reduce(const v4u (&z)[W], int t) {
    float s[8], self[8];
#pragma unroll
    for (int e = 0; e < 8; ++e) { s[e] = 0.f; self[e] = 0.f; }
#pragma unroll
    for (int j = 0; j < W; ++j) { const float f[8] = {bflo(z[j].x), bfhi(z[j].x), bflo(z[j].y), bfhi(z[j].y), bflo(z[j].z), bfhi(z[j].z), bflo(z[j].w), bfhi(z[j].w)};
#pragma unroll
        for (int e = 0; e < 8; ++e) { s[e] += f[e]; if (j == 0) self[e] = f[e]; } }
    const float inv = 1.0f / (float)((t + 1 < W) ? (t + 1) : W);
    v4u o; o.x = pk2(s[0] * inv - self[0], s[1] * inv - self[1]); o.y = pk2(s[2] * inv - self[2], s[3] * inv - self[3]);
    o.z = pk2(s[4] * inv - self[4], s[5] * inv - self[5]); o.w = pk2(s[6] * inv - self[6], s[7] * inv - self[7]);
    return o;
}
__device__ __forceinline__ void pool_phase(Frame& F) {
    const bf16* zp = (const bf16*)(F.ws + WS_ZP); bf16* pl = (bf16*)(F.ws + WS_PL);
    const int gw = F.bid * NWAVES + F.wave, NGW = F.G * NWAVES;
    for (int r4 = gw; r4 < M / 4; r4 += NGW) {
        const int row = 4 * r4 + (F.lane >> 4), t = row & 4095, c0 = 8 * (F.lane & 15);
        v4u z2[2], z4[4], z8[8], z16[16];
        pool_load<2>(zp, row, t, c0, z2); pool_load<4>(zp, row, t, 128 + c0, z4); pool_load<8>(zp, row, t, 256 + c0, z8); pool_load<16>(zp, row, t, 384 + c0, z16);
        const v4u o2 = pool_reduce<2>(z2, t), o4 = pool_reduce<4>(z4, t), o8 = pool_reduce<8>(z8, t), o16 = pool_reduce<16>(z16, t);
        GAS v4u* dst = (GAS v4u*)(pl + (size_t)row * 1024 + c0);
        dst[0] = o2; dst[16] = o4; dst[32] = o8; dst[48] = o16;
    }
}

typedef int v4i __attribute__((ext_vector_type(4)));
__device__ __forceinline__ unsigned pkf16(float a, float b) { return __builtin_bit_cast(unsigned, __builtin_amdgcn_cvt_pkrtz(a, b)); }
__device__ __forceinline__ float f16lo(unsigned w) { return (float)__builtin_bit_cast(_Float16, (unsigned short)(w & 0xffffu)); }
__device__ __forceinline__ float f16hi(unsigned w) { return (float)__builtin_bit_cast(_Float16, (unsigned short)(w >> 16)); }
struct EpiStoreBf16 {
    static constexpr bool PERM = true, AFTER_DRAIN = false, MID = false;
    bf16* O; int ldc;
    __device__ __forceinline__ void operator()(const pg8::f32x4 (&acc)[2][2][4][2], const pg8::Unit& u, int wr, int wc, int fr, int fq) const {
#pragma unroll
        for (int ai = 0; ai < 2; ++ai)
#pragma unroll
            for (int m = 0; m < 4; ++m) {
                const int row = u.pm * 256 + ai * 128 + wr * 64 + m * 16 + fr;
#pragma unroll
                for (int bj = 0; bj < 2; ++bj) {
                    const int col = u.pn * 256 + bj * 128 + wc * 32 + 8 * fq;
                    v4u o; o.x = pkf16(acc[ai][bj][m][0][0], acc[ai][bj][m][0][1]); o.y = pkf16(acc[ai][bj][m][0][2], acc[ai][bj][m][0][3]);
                    o.z = pkf16(acc[ai][bj][m][1][0], acc[ai][bj][m][1][1]); o.w = pkf16(acc[ai][bj][m][1][2], acc[ai][bj][m][1][3]);
                    *(GAS v4u*)(O + (size_t)row * ldc + col) = o; }
            }
    }
};

__device__ __forceinline__ unsigned fkey(float f) { const unsigned u = __builtin_bit_cast(unsigned, f); return (u >> 31) ? ~u : (u | 0x80000000u); }
__device__ __forceinline__ float funkey(unsigned k) { const unsigned u = (k >> 31) ? (k & 0x7fffffffu) : ~k; return __builtin_bit_cast(float, u); }
__device__ __forceinline__ unsigned umax_(unsigned a, unsigned b) { return a > b ? a : b; }
__device__ __forceinline__ unsigned umin_(unsigned a, unsigned b) { return a > b ? b : a; }
#define TOP16_INSERT(L, xin) do { unsigned _x = (xin); _Pragma("unroll") for (int _i = 0; _i < 16; ++_i) { const unsigned _h = umax_(L[_i], _x); _x = umin_(L[_i], _x); L[_i] = _h; } } while (0)
template <int MASK> __device__ __forceinline__ void top16_merge(unsigned (&L)[16]) {
    unsigned o[16];
#pragma unroll
    for (int i = 0; i < 16; ++i) o[i] = (unsigned)dppi<MASK == 1 ? DPP_XOR1 : DPP_XOR2>((int)L[i]);
#pragma unroll
    for (int i = 0; i < 16; ++i) L[i] = umax_(L[i], o[15 - i]);
#pragma unroll
    for (int d = 8; d >= 1; d >>= 1)
#pragma unroll
        for (int i = 0; i < 16; ++i) if ((i & d) == 0) { const unsigned hi = umax_(L[i], L[i + d]), lo = umin_(L[i], L[i + d]); L[i] = hi; L[i + d] = lo; }
}
#define CE_DESC(a_, b_) do { const unsigned _h = umax_(a_, b_), _l = umin_(a_, b_); a_ = _h; b_ = _l; } while (0)
template <int OFF> __device__ __forceinline__ void bitonic_sort16_desc(unsigned (&v)[32]) {
#pragma unroll
    for (int k = 2; k <= 16; k <<= 1)
#pragma unroll
        for (int j = k >> 1; j > 0; j >>= 1)
#pragma unroll
            for (int i = 0; i < 16; ++i) { const int l = i ^ j; if (l > i) { if ((i & k) == 0) CE_DESC(v[OFF + i], v[OFF + l]); else CE_DESC(v[OFF + l], v[OFF + i]); } }
}
__device__ __forceinline__ void bitonic_merge16_desc(unsigned (&L)[16]) {
#pragma unroll
    for (int d = 8; d >= 1; d >>= 1)
#pragma unroll
        for (int i = 0; i < 16; ++i) if ((i & d) == 0) CE_DESC(L[i], L[i + d]);
}
constexpr int SST = 132;
constexpr int P9_LIST_OFF = 2 * 64 * SST * 4;
__device__ __forceinline__ void peer_select_phase(Frame& F) {
    const unsigned short* S16 = (const unsigned short*)(F.ws + WS_QV);
    int* EID = (int*)(F.ws + WS_EID); float* GW = (float*)(F.ws + WS_GW);
    LAS unsigned* LIST = (LAS unsigned*)(F.lds + P9_LIST_OFF);
    const int lane = F.lane, w = F.wave;
    constexpr int NU = (M / 64) * PH;
    const int row = F.tid >> 2, sub = F.tid & 3, p1 = row >> 6, tk1 = row & 63;
    v4u sn[4], sm[4];
#define P9_LOAD(dst_, u_) do { const int _tt = (u_) >> 3, _h = (u_) & 7; const unsigned short* sp_ = S16 + (size_t)(_tt * 64 + tk1) * PQW + _h * 256 + p1 * 128 + 32 * sub; \
        _Pragma("unroll") for (int q = 0; q < 4; ++q) dst_[q] = *(const GAS v4u*)(sp_ + 8 * q); } while (0)
#define P9_STAGE1(sc_, list_, unext_) do { \
            unsigned kv[32]; \
            _Pragma("unroll") for (int q = 0; q < 4; ++q) { const unsigned ww[4] = {sc_[q].x, sc_[q].y, sc_[q].z, sc_[q].w}; \
                _Pragma("unroll") for (int e = 0; e < 4; ++e) { kv[8 * q + 2 * e] = (fkey(f16lo(ww[e])) & ~127u) | (unsigned)(32 * sub + 8 * q + 2 * e); \
                    kv[8 * q + 2 * e + 1] = (fkey(f16hi(ww[e])) & ~127u) | (unsigned)(32 * sub + 8 * q + 2 * e + 1); } } \
            if ((unext_) < NU) P9_LOAD(sc_, (unext_)); \
            bitonic_sort16_desc<0>(kv); bitonic_sort16_desc<16>(kv); \
            unsigned L[16]; \
            _Pragma("unroll") for (int i = 0; i < 16; ++i) L[i] = umax_(kv[i], kv[31 - i]); \
            bitonic_merge16_desc(L); \
            top16_merge<1>(L); top16_merge<2>(L); \
            if (sub == 0) { _Pragma("unroll") for (int i = 0; i < 4; ++i) *(LAS v4u*)((list_) + row * 16 + 4 * i) = (v4u){L[4 * i], L[4 * i + 1], L[4 * i + 2], L[4 * i + 3]}; } } while (0)
    if (F.bid < NU) P9_LOAD(sn, F.bid);
    if (F.bid + F.G < NU) P9_LOAD(sm, F.bid + F.G);
    for (int u = F.bid; u < NU; u += 2 * F.G) {
        const int u1 = u + F.G;
        P9_STAGE1(sn, LIST, u + 2 * F.G);
        if (u1 < NU) P9_STAGE1(sm, LIST + 2048, u1 + 2 * F.G);
        __syncthreads();
        const int half = F.tid >> 8, uu = half ? u1 : u;
        if (uu < NU) {
            const int tt = uu >> 3, h = uu & 7, tok0 = tt * 64;
            LAS unsigned* LIST = (LAS unsigned*)(F.lds + P9_LIST_OFF) + half * 2048;
            const int tok = (F.tid & 255) >> 2, sub = F.tid & 3;
            float va[16], vb[16];
#pragma unroll
            for (int i = 0; i < 4; ++i) { const v4u x = *(const LAS v4u*)(LIST + tok * 16 + 4 * i), y = *(const LAS v4u*)(LIST + (64 + tok) * 16 + 4 * i);
                va[4 * i] = funkey(x.x & ~127u); va[4 * i + 1] = funkey(x.y & ~127u); va[4 * i + 2] = funkey(x.z & ~127u); va[4 * i + 3] = funkey(x.w & ~127u);
                vb[4 * i] = funkey(y.x & ~127u); vb[4 * i + 1] = funkey(y.y & ~127u); vb[4 * i + 2] = funkey(y.z & ~127u); vb[4 * i + 3] = funkey(y.w & ~127u); }
            unsigned cand[32];
#pragma unroll
            for (int i = 0; i < 32; ++i) cand[i] = 0u;
            {
                constexpr int NC = 50;
                constexpr unsigned char CI[52] = {0,0,0,0,0,0,0,0,0,0,0,0,0,0,0,0, 1,1,1,1,1,1,1,1, 2,2,2,2,2, 3,3,3,3, 4,4,4, 5,5, 6,6, 7,7, 8,9,10,11,12,13,14,15, 0,0};
                constexpr unsigned char CJ[52] = {0,1,2,3,4,5,6,7,8,9,10,11,12,13,14,15, 0,1,2,3,4,5,6,7, 0,1,2,3,4, 0,1,2,3, 0,1,2, 0,1, 0,1, 0,1, 0,0,0,0,0,0,0,0, 0,0};
#pragma unroll
                for (int g4 = 0; g4 < 13; ++g4) {
                    float sa = 0.f, sb = 0.f; unsigned id = 0u; bool ok = false;
#pragma unroll
                    for (int q = 0; q < 4; ++q) { const int n = 4 * g4 + q; if (n < NC) { const bool me = (sub == q); sa = me ? va[CI[n]] : sa; sb = me ? vb[CJ[n]] : sb; id = me ? (unsigned)(CI[n] * 16 + CJ[n]) : id; ok = ok || me; } }
                    cand[g4] = ok ? ((fkey(sa + sb) & ~255u) | id) : 0u;
                }
            }
            bitonic_sort16_desc<0>(cand);
            unsigned L[16];
#pragma unroll
            for (int i = 0; i < 16; ++i) L[i] = cand[i];
            top16_merge<1>(L); top16_merge<2>(L);
            const float mx = funkey(L[0] & ~255u);
            float e[16], sum = 0.f;
#pragma unroll
            for (int k = 0; k < 16; ++k) { e[k] = __expf(funkey(L[k] & ~255u) - mx); sum += e[k]; }
            const float inv = 1.0f / sum;
            const size_t ob = (size_t)(tok0 + tok) * 128;
#pragma unroll
            for (int k4 = 0; k4 < 4; ++k4) if (sub == k4) {
#pragma unroll
                for (int q = 0; q < 4; ++q) { const unsigned cid = L[4 * k4 + q] & 255u;
                    const unsigned ia = LIST[tok * 16 + (cid >> 4)] & 127u, ib = LIST[(64 + tok) * 16 + (cid & 15u)] & 127u;
                    const int slot = h * 16 + 4 * k4 + q;
                    EID[ob + slot] = (int)(ia * 128u + ib); GW[ob + slot] = e[4 * k4 + q] * inv; }
            }
        }
        __syncthreads();
    }
#undef P9_LOAD
#undef P9_STAGE1
}

__device__ __forceinline__ void unpack8(const v4u w, float (&f)[8]) { f[0] = bflo(w.x); f[1] = bfhi(w.x); f[2] = bflo(w.y); f[3] = bfhi(w.y); f[4] = bflo(w.z); f[5] = bfhi(w.z); f[6] = bflo(w.w); f[7] = bfhi(w.w); }
typedef float f32x2 __attribute__((ext_vector_type(2)));
__device__ __forceinline__ void unpack16_fp8(const v4u w, float (&f)[16]) {
    const unsigned ww[4] = {w.x, w.y, w.z, w.w};
#pragma unroll
    for (int d = 0; d < 4; ++d) { const f32x2 a = __builtin_amdgcn_cvt_pk_f32_fp8((int)ww[d], false), b = __builtin_amdgcn_cvt_pk_f32_fp8((int)ww[d], true);
        f[4 * d] = a.x; f[4 * d + 1] = a.y; f[4 * d + 2] = b.x; f[4 * d + 3] = b.y; }
}
template <int PV_> __device__ __forceinline__ void peer_dot_phase(Frame& F) {
    const unsigned char* H8 = F.ws + WS_H8; const int* EID = (const int*)(F.ws + WS_EID); float* PART = (float*)(F.ws + WS_PART);
    const int lane = F.lane, g = lane >> 3, j = lane & 7, x = F.bid & 7;
    const int nbx = (F.G - x + 7) >> 3, NW = nbx * NWAVES, gwv = (F.bid >> 3) * NWAVES + F.wave;
    const unsigned char* US = F.ws + WS_UB + (size_t)x * NEXP * 128; const unsigned j16 = 16u * (unsigned)j;
    int token = gwv;
    if (token >= M) return;
    const int lasttok = gwv + ((M - 1 - gwv) / NW) * NW;
    v4i eA[4], eB[4]; v4i hA, hB;
#define PD_CL(t_) ((t_) < M ? (t_) : lasttok)
#define PD_LOAD_E(e_, tok_) do { _Pragma("unroll") for (int q = 0; q < 4; ++q) e_[q] = *(const GAS v4i*)(EID + (size_t)(tok_) * 128 + 16 * g + 4 * q); } while (0)
#define PD_ISSUE4(buf_, e_, b0_) do { buf_[b0_] = *(const GAS v4i*)(US + ((unsigned)e_.x * 128u + j16)); buf_[b0_ + 1] = *(const GAS v4i*)(US + ((unsigned)e_.y * 128u + j16)); \
        buf_[b0_ + 2] = *(const GAS v4i*)(US + ((unsigned)e_.z * 128u + j16)); buf_[b0_ + 3] = *(const GAS v4i*)(US + ((unsigned)e_.w * 128u + j16)); } while (0)
#define PD_DOT1(w_, hc_, dst_) do { int t = __builtin_amdgcn_sdot4(w_.x, hc_.x, 0, false); t = __builtin_amdgcn_sdot4(w_.y, hc_.y, t, false); t = __builtin_amdgcn_sdot4(w_.z, hc_.z, t, false); t = __builtin_amdgcn_sdot4(w_.w, hc_.w, t, false); \
        t += dppi<DPP_XOR1>(t); t += dppi<DPP_XOR2>(t); t += dppi<DPP_HMIR>(t); dst_ = (float)t; } while (0)
#define PD_BODY(eC, eN, hC, hN, tok_) do { const int tk_ = PD_CL(tok_); \
        PD_ISSUE4(bB, eC[2], 0); PD_ISSUE4(bB, eC[3], 4); \
        PD_LOAD_E(eC, PD_CL(tk_ + 2 * NW)); \
        hN = *(const GAS v4i*)(H8 + (size_t)PD_CL(tk_ + NW) * D + 128 * x + j16); \
        float s[16]; \
        _Pragma("unroll") for (int i = 0; i < 8; ++i) PD_DOT1(bA[i], hC, s[i]); \
        PD_ISSUE4(bA, eN[0], 0); PD_ISSUE4(bA, eN[1], 4); \
        _Pragma("unroll") for (int i = 0; i < 8; ++i) PD_DOT1(bB[i], hC, s[8 + i]); \
        { float* pp = PART + ((size_t)x * M + tk_) * 128 + g * 16;       \
          _Pragma("unroll") for (int i4 = 0; i4 < 4; ++i4) *(GAS f32x4*)(pp + 4 * i4) = (f32x4){s[4 * i4], s[4 * i4 + 1], s[4 * i4 + 2], s[4 * i4 + 3]}; } } while (0)
    PD_LOAD_E(eA, token); hA = *(const GAS v4i*)(H8 + (size_t)token * D + 128 * x + j16);
    PD_LOAD_E(eB, PD_CL(token + NW));
    v4i bA[8], bB[8];
    PD_ISSUE4(bA, eA[0], 0); PD_ISSUE4(bA, eA[1], 4);
    __builtin_amdgcn_s_waitcnt(0x0F70);
    for (; token < M; token += 2 * NW) {
        PD_BODY(eA, eB, hA, hB, token);
        PD_BODY(eB, eA, hB, hA, token + NW);
    }
#undef PD_BODY
#undef PD_CL
#undef PD_LOAD_E
#undef PD_ISSUE4
#undef PD_DOT1
}
template <int NTOK> __device__ __forceinline__ void peer_loadrate_probe(Frame& F) {
    const int* EID = (const int*)(F.ws + WS_EID);
    const int lane = F.lane, g = lane >> 3, j = lane & 7, x = F.bid & 7;
    const int nbx = (F.G - x + 7) >> 3, NW = nbx * NWAVES, gwv = (F.bid >> 3) * NWAVES + F.wave;
    const unsigned char* US = F.ws + WS_UB + (size_t)x * NEXP * 128; const unsigned j16 = 16u * (unsigned)j;
    unsigned acc = 0u;
    for (int token = gwv; token + (NTOK - 1) * NW < M; token += NTOK * NW) {
        v4i e4[NTOK][4];
#pragma unroll
        for (int t = 0; t < NTOK; ++t)
#pragma unroll
            for (int q = 0; q < 4; ++q) e4[t][q] = *(const GAS v4i*)(EID + (size_t)(token + t * NW) * 128 + 16 * g + 4 * q);
        v4i b[NTOK][16];
#pragma unroll
        for (int t = 0; t < NTOK; ++t)
#pragma unroll
            for (int q = 0; q < 4; ++q) { b[t][4 * q] = *(const GAS v4i*)(US + ((unsigned)e4[t][q].x * 128u + j16)); b[t][4 * q + 1] = *(const GAS v4i*)(US + ((unsigned)e4[t][q].y * 128u + j16));
                b[t][4 * q + 2] = *(const GAS v4i*)(US + ((unsigned)e4[t][q].z * 128u + j16)); b[t][4 * q + 3] = *(const GAS v4i*)(US + ((unsigned)e4[t][q].w * 128u + j16)); }
#pragma unroll
        for (int t = 0; t < NTOK; ++t)
#pragma unroll
            for (int i = 0; i < 16; ++i) acc ^= (unsigned)(b[t][i].x ^ b[t][i].y ^ b[t][i].z ^ b[t][i].w);
    }
    asm volatile("" :: "v"(acc));
}
__device__ __forceinline__ void peer_coef_phase(Frame& F) {
    const float* PART = (const float*)(F.ws + WS_PART); const int* EID = (const int*)(F.ws + WS_EID); const float* GW = (const float*)(F.ws + WS_GW);
    const float* SCU = (const float*)(F.ws + WS_SCLU); const float* SCV = (const float*)(F.ws + WS_SCLV); const float* HS = (const float*)(F.ws + WS_HS);
    unsigned* CF8 = (unsigned*)(F.ws + WS_CF); float* CFS = (float*)(F.ws + WS_CFS);
    const size_t gtid = (size_t)F.bid * NTHREADS + F.tid, gthreads = (size_t)F.G * NTHREADS, n4 = (size_t)M * 128 / 4;
    for (size_t i4 = gtid; i4 < n4; i4 += gthreads) {
        f32x4 d = *(const GAS f32x4*)(PART + 4 * i4);
#pragma unroll
        for (int xx = 1; xx < 8; ++xx) d = d + *(const GAS f32x4*)(PART + (size_t)xx * M * 128 + 4 * i4);
        const v4i e = *(const GAS v4i*)(EID + 4 * i4); const f32x4 gw = *(const GAS f32x4*)(GW + 4 * i4);
        const float hs = HS[i4 >> 5];
        f32x4 r; r.x = gw.x * SCV[e.x] * gelu_tanh_safe(d.x * (SCU[e.x] * hs)); r.y = gw.y * SCV[e.y] * gelu_tanh_safe(d.y * (SCU[e.y] * hs));
        r.z = gw.z * SCV[e.z] * gelu_tanh_safe(d.z * (SCU[e.z] * hs)); r.w = gw.w * SCV[e.w] * gelu_tanh_safe(d.w * (SCU[e.w] * hs));
        float m = fmaxf(fmaxf(fabsf(r.x), fabsf(r.y)), fmaxf(fabsf(r.z), fabsf(r.w)));
        m = fmaxf(m, dppf<DPP_XOR1>(m)); m = fmaxf(m, dppf<DPP_XOR2>(m)); m = fmaxf(m, dppf<DPP_HMIR>(m)); m = fmaxf(m, dppf<DPP_ROR8>(m)); m = max_xor16(m);
        const unsigned E = (__builtin_bit_cast(unsigned, m) >> 23) & 0xffu; float sc = 1.f, isc = 1.f;
        if (E >= 8u && E <= 250u) { sc = __builtin_bit_cast(float, (261u - E) << 23); isc = __builtin_bit_cast(float, (E - 7u) << 23); }
        int t = __builtin_amdgcn_cvt_pk_fp8_f32(r.x * sc, r.y * sc, 0, false); t = __builtin_amdgcn_cvt_pk_fp8_f32(r.z * sc, r.w * sc, t, true);
        CF8[i4] = (unsigned)t;
        if ((F.lane & 31) == 0) CFS[i4 >> 5] = isc; }
}
template <bool DRY, bool CHECK = false> __device__ __forceinline__ void peer_out_phase(Frame& F, const float* ada, float* out) {
    const int* EID = (const int*)(F.ws + WS_EID); const unsigned char* CF8 = (const unsigned char*)(F.ws + WS_CF); const float* CFS = (const float*)(F.ws + WS_CFS);
    const int lane = F.lane, g = lane >> 3, j = lane & 7, x = F.bid & 7;
    const int nbx = (F.G - x + 7) >> 3, NW = nbx * NWAVES, gwv = (F.bid >> 3) * NWAVES + F.wave;
    const unsigned char* VS = F.ws + WS_VB + (size_t)x * NEXP * 128; const unsigned j16 = 16u * (unsigned)j;
    if (gwv >= M) return;
    const int ntok = (M - 1 - gwv) / NW + 1;
#define PO_ISSUE4(buf_, e_, b0_) do { buf_[b0_] = *(const GAS v4u*)(VS + ((unsigned)e_.x * 128u + j16)); buf_[b0_ + 1] = *(const GAS v4u*)(VS + ((unsigned)e_.y * 128u + j16)); \
        buf_[b0_ + 2] = *(const GAS v4u*)(VS + ((unsigned)e_.z * 128u + j16)); buf_[b0_ + 3] = *(const GAS v4u*)(VS + ((unsigned)e_.w * 128u + j16)); } while (0)
#define PO_ROW(w_, c_) do { float f[16]; unpack16_fp8(w_, f); _Pragma("unroll") for (int k = 0; k < 16; ++k) o[k] += (c_) * f[k]; } while (0)
#define PO_ACC4(buf_, c4_, b0_) do { PO_ROW(buf_[b0_], c4_.x); PO_ROW(buf_[b0_ + 1], c4_.y); PO_ROW(buf_[b0_ + 2], c4_.z); PO_ROW(buf_[b0_ + 3], c4_.w); } while (0)
    v4i e4[4]; f32x4 c4[4]; v4u bA[8], bB[8];
#define PO_LOADC(tok_) do { const float cs_ = CFS[tok_]; _Pragma("unroll") for (int q = 0; q < 4; ++q) { const unsigned w_ = *(const GAS unsigned*)(CF8 + (size_t)(tok_) * 128 + g * 16 + 4 * q); \
        const f32x2 lo_ = __builtin_amdgcn_cvt_pk_f32_fp8((int)w_, false), hi_ = __builtin_amdgcn_cvt_pk_f32_fp8((int)w_, true); c4[q] = (f32x4){lo_.x * cs_, lo_.y * cs_, hi_.x * cs_, hi_.y * cs_}; } } while (0)
#pragma unroll
    for (int q = 0; q < 4; ++q) e4[q] = *(const GAS v4i*)(EID + (size_t)gwv * 128 + g * 16 + 4 * q);
    PO_LOADC(gwv);
    PO_ISSUE4(bA, e4[0], 0); PO_ISSUE4(bA, e4[1], 4);
    for (int it = 0; it < ntok; ++it) {
        const int token = gwv + it * NW, tn = gwv + (it + 1 < ntok ? it + 1 : it) * NW;
        PO_ISSUE4(bB, e4[2], 0); PO_ISSUE4(bB, e4[3], 4);
#pragma unroll
        for (int q = 0; q < 4; ++q) e4[q] = *(const GAS v4i*)(EID + (size_t)tn * 128 + g * 16 + 4 * q);
        float o[16];
#pragma unroll
        for (int k = 0; k < 16; ++k) o[k] = 0.f;
        PO_ACC4(bA, c4[0], 0); PO_ACC4(bA, c4[1], 4);
        PO_ISSUE4(bA, e4[0], 0); PO_ISSUE4(bA, e4[1], 4);
        PO_ACC4(bB, c4[2], 0); PO_ACC4(bB, c4[3], 4);
        PO_LOADC(tn);
#pragma unroll
        for (int k = 0; k < 16; ++k) { float t = o[k]; t += dppf<DPP_ROR8>(t); o[k] = sum_xor32(sum_xor16(t)); }
        if (g == 0) { const int b = token >> 12;
            const float* gt = ada + (size_t)b * 6 * D + 5 * D + 128 * x + 16 * j;
            float* xo = out + (size_t)token * D + 128 * x + 16 * j;
#pragma unroll
            for (int q = 0; q < 4; ++q) { const f32x4 xv = *(const GAS f32x4*)(xo + 4 * q), gv = *(const GAS f32x4*)(gt + 4 * q);
                f32x4 res = xv + gv * (f32x4){o[4 * q], o[4 * q + 1], o[4 * q + 2], o[4 * q + 3]};
                if (CHECK) { const f32x4 mf = *(const GAS f32x4*)((const float*)(F.ws + WS_PART) + (size_t)token * D + 128 * x + 16 * j + 4 * q);
                    const float rr[4] = {o[4 * q], o[4 * q + 1], o[4 * q + 2], o[4 * q + 3]}, mm[4] = {mf.x, mf.y, mf.z, mf.w}; bool bad = false;
#pragma unroll
                    for (int z = 0; z < 4; ++z) bad = bad || !(fabsf(rr[z] - mm[z]) <= 0.01f * fabsf(rr[z]) + 1.0e-3f);
                    if (bad) res.x = 1.0e9f; }
                if (DRY) { asm volatile("" :: "v"(res.x), "v"(res.y), "v"(res.z), "v"(res.w)); } else *(GAS f32x4*)(xo + 4 * q) = res; } }
    }
#undef PO_LOADC
#undef PO_ISSUE4
#undef PO_ROW
#undef PO_ACC4
}

constexpr int PO_TILE = 64 * 144;
template <int MODE> __device__ __forceinline__ void peer_out_mfma_phase(Frame& F, const float* ada, float* out) {
    const int* EID = (const int*)(F.ws + WS_EID); const unsigned char* CF8 = (const unsigned char*)(F.ws + WS_CF); const float* CFS = (const float*)(F.ws + WS_CFS);
    const int lane = F.lane, g = lane >> 3, j = lane & 7, l15 = lane & 15, lq = lane >> 4, x = F.bid & 7;
    const int nbx = (F.G - x + 7) >> 3, NW = nbx * NWAVES, gwv = (F.bid >> 3) * NWAVES + F.wave;
    const unsigned char* VS = F.ws + WS_VB + (size_t)x * NEXP * 128; const unsigned j16 = 16u * (unsigned)j;
    LAS unsigned char* TL = F.lds + F.wave * PO_TILE;
    if (gwv >= M) return;
    const int nst = 2 * ((M - 1 - gwv) / NW + 1);
    const int trow = l15 >> 1, tcol = 8 * (l15 & 1);
#define PM_IDS(e_, a_, tok_) do { const size_t base = (size_t)(tok_) * 128; \
        _Pragma("unroll") for (int m = 0; m < 16; ++m) e_[m] = EID[base + 8 * m + g]; \
        _Pragma("unroll") for (int q = 0; q < 4; ++q) a_[q] = *(const GAS long*)(CF8 + base + 32 * q + 8 * lq); } while (0)
#define PM_GATHER(vv_, e_, h_) do { _Pragma("unroll") for (int m = 0; m < 8; ++m) vv_[m] = *(const GAS v4u*)(VS + ((unsigned)e_[8 * (h_) + m] * 128u + j16)); } while (0)
#define PM_HALF(vv_, aq0_, aq1_) do { _Pragma("unroll") for (int m = 0; m < 8; ++m) *(LAS v4u*)(TL + (8 * m + g) * 144 + 16 * j) = vv_[m]; } while (0)
#define PM_MMA(aq0_, aq1_) do { LDS_WAIT(); asm volatile("" ::: "memory"); \
        _Pragma("unroll") for (int ks = 0; ks < 2; ++ks) _Pragma("unroll") for (int cb = 0; cb < 8; ++cb) { \
            const v2i bb = __builtin_amdgcn_ds_read_tr8_b64_v2i32((LAS v2i*)(TL + (32 * ks + 8 * lq + trow) * 144 + 16 * cb + tcol)); \
            acc[cb] = __builtin_amdgcn_mfma_f32_16x16x32_fp8_fp8(ks ? (aq1_) : (aq0_), __builtin_bit_cast(long, bb), acc[cb], 0, 0, 0); } \
        LDS_WAIT(); asm volatile("" ::: "memory"); } while (0)
    const int ntok = nst >> 1;
    int e1[16], e2[16]; long a0[4], a1[4], a2[4]; v4u vvA[8], vvB[8];
    PM_IDS(e1, a0, gwv);
    PM_GATHER(vvA, e1, 0); PM_GATHER(vvB, e1, 1);
    { const int t1 = ntok > 1 ? 1 : 0; PM_IDS(e1, a1, gwv + t1 * NW); }
    f32x4 acc[8];
    for (int it = 0; it < ntok; ++it) {
        const int token = gwv + it * NW;
        { const int t2 = it + 2 < ntok ? it + 2 : ntok - 1; PM_IDS(e2, a2, gwv + t2 * NW); }
#pragma unroll
        for (int cb = 0; cb < 8; ++cb) acc[cb] = (f32x4){0.f, 0.f, 0.f, 0.f};
        float xv[8], gv[8]; float cs;
        { const int b = token >> 12; const float* gt = ada + (size_t)b * 6 * D + 5 * D + 128 * x + l15; const bf16* xi = (const bf16*)(F.ws + WS_X1) + (size_t)token * D + 128 * x + l15;
          cs = CFS[token];
#pragma unroll
          for (int cb = 0; cb < 8; ++cb) { xv[cb] = bflo((unsigned)xi[16 * cb]); gv[cb] = gt[16 * cb]; } }
        PM_HALF(vvA, 0, 0); PM_GATHER(vvA, e1, 0); PM_MMA(a0[0], a0[1]);
        PM_HALF(vvB, 0, 0); PM_GATHER(vvB, e1, 1); PM_MMA(a0[2], a0[3]);
        if (lq == 0) {
            if (MODE == 1) { float* oc = (float*)(F.ws + WS_PART) + (size_t)token * D + 128 * x + l15;
#pragma unroll
                for (int cb = 0; cb < 8; ++cb) oc[16 * cb] = acc[cb][0] * cs; }
            else { float* xo = out + (size_t)token * D + 128 * x + l15;
#pragma unroll
                for (int cb = 0; cb < 8; ++cb) xo[16 * cb] = xv[cb] + gv[cb] * (acc[cb][0] * cs); }
        }
#pragma unroll
        for (int m = 0; m < 16; ++m) e1[m] = e2[m];
#pragma unroll
        for (int q = 0; q < 4; ++q) { a0[q] = a1[q]; a1[q] = a2[q]; }
    }
#undef PM_HALF
#undef PM_MMA
#undef PM_IDS
#undef PM_GATHER
}

__device__ __forceinline__ void compress_phase(Frame& F, const float* kng) {
    LAS bf16* H2 = (LAS bf16*)(F.lds);
    LAS float* OUTS = (LAS float*)(F.lds + 16384);
    const int lane = F.lane, w = F.wave, l15 = lane & 15, lq = lane >> 4;
    for (int u = F.bid; u < NBG * 2 * 8; u += F.G) {
        const int ns = u & 7, kv = (u >> 3) & 1, bg = u >> 4, n0 = ns * 32;
        const bf16* A = (const bf16*)(F.ws + (kv ? WS_VCR : WS_KCR)) + (size_t)bg * SEQ * 64;
        const bf16* W1T = (const bf16*)(F.ws + (kv ? WS_CW1V_T : WS_CW1K_T));
        const bf16* W2T = (const bf16*)(F.ws + (kv ? WS_CW2V_T : WS_CW2K_T));
        const float* b1 = (const float*)(F.ws + (kv ? WS_CB1V : WS_CB1K));
        pg8::f32x4 acc[2][8];
#pragma unroll
        for (int rb = 0; rb < 2; ++rb)
#pragma unroll
            for (int cb = 0; cb < 8; ++cb) acc[rb][cb] = (pg8::f32x4){0.f, 0.f, 0.f, 0.f};
        const bf16* ap = A + (size_t)(n0 + l15) * 1024 + 256 * w + 8 * lq;
        const bf16* bp = W1T + (size_t)l15 * 2048 + 256 * w + 8 * lq;
#pragma unroll
        for (int ks = 0; ks < 8; ++ks) {
            const bf16x8 a0 = *(const GAS bf16x8*)(ap + 32 * ks), a1 = *(const GAS bf16x8*)(ap + 16 * 1024 + 32 * ks);
#pragma unroll
            for (int cb = 0; cb < 8; ++cb) { const bf16x8 b = *(const GAS bf16x8*)(bp + (size_t)(16 * cb) * 2048 + 32 * ks);
                acc[0][cb] = __builtin_amdgcn_mfma_f32_16x16x32_bf16(a0, b, acc[0][cb], 0, 0, 0);
                acc[1][cb] = __builtin_amdgcn_mfma_f32_16x16x32_bf16(a1, b, acc[1][cb], 0, 0, 0); }
        }
        { LAS float* PS = (LAS float*)(F.lds + 32768);
          LAS float* mine = PS + (w & 3) * 4096 + (4 * lq) * 128 + l15;
          if (w >= 4) {
#pragma unroll
              for (int rb = 0; rb < 2; ++rb)
#pragma unroll
                  for (int cb = 0; cb < 8; ++cb)
#pragma unroll
                      for (int r = 0; r < 4; ++r) mine[(16 * rb + r) * 128 + 16 * cb] = acc[rb][cb][r]; }
          __syncthreads();
          if (w < 4) {
#pragma unroll
              for (int rb = 0; rb < 2; ++rb)
#pragma unroll
                  for (int cb = 0; cb < 8; ++cb)
#pragma unroll
                      for (int r = 0; r < 4; ++r) { LAS float* q = mine + (16 * rb + r) * 128 + 16 * cb; *q = acc[rb][cb][r] + *q; } }
          __syncthreads();
#pragma unroll
          for (int i = 0; i < 8; ++i) { const int idx = F.tid + 512 * i, row = idx >> 7, col = idx & 127;
              const float v = ((PS[idx] + PS[4096 + idx]) + (PS[8192 + idx] + PS[12288 + idx])) + b1[col];
              H2[row * 136 + col] = (bf16)f2bf(gelu_tanh_safe(v)); } }
        __syncthreads();
        { const int rb = w >> 2, db = w & 3;
          pg8::f32x4 o = (pg8::f32x4){0.f, 0.f, 0.f, 0.f};
#pragma unroll
          for (int ks = 0; ks < 4; ++ks) {
              const bf16x8 a = *(const LAS bf16x8*)(H2 + (16 * rb + l15) * 136 + 32 * ks + 8 * lq);
              const bf16x8 b = *(const GAS bf16x8*)(W2T + (size_t)(16 * db + l15) * 128 + 32 * ks + 8 * lq);
              o = __builtin_amdgcn_mfma_f32_16x16x32_bf16(a, b, o, 0, 0, 0); }
#pragma unroll
          for (int r = 0; r < 4; ++r) OUTS[(16 * rb + 4 * lq + r) * 65 + 16 * db + l15] = o[r]; }
        __syncthreads();
        { const int n = F.tid >> 4, d4 = (F.tid & 15) * 4, ng = n0 + n;
          float v[4]; float ss = 0.f;
#pragma unroll
          for (int i = 0; i < 4; ++i) { v[i] = OUTS[n * 65 + d4 + i]; ss += v[i] * v[i]; }
          ss += dppf<DPP_XOR1>(ss); ss += dppf<DPP_XOR2>(ss); ss += dppf<DPP_HMIR>(ss); ss += dppf<DPP_ROR8>(ss);
          const bool pad = (ng >= NCMP);
          if (kv == 0) { const float rs = rsqrtf(ss * (1.f / 64.f) + EPS);
              v2u o; o.x = pad ? 0u : pk2(v[0] * rs * kng[d4], v[1] * rs * kng[d4 + 1]); o.y = pad ? 0u : pk2(v[2] * rs * kng[d4 + 2], v[3] * rs * kng[d4 + 3]);
              *(GAS v2u*)((bf16*)(F.ws + WS_KC) + ((size_t)bg * 256 + ng) * 64 + d4) = o; }
          else { bf16* vt = (bf16*)(F.ws + WS_VCT) + (size_t)bg * 64 * 256 + ng;
#pragma unroll
              for (int i = 0; i < 4; ++i) vt[(size_t)(d4 + i) * 256] = pad ? (bf16)0 : (bf16)f2bf(v[i]); } }
        __syncthreads();
    }
}
__device__ __forceinline__ void vtranspose_phase(Frame& F) {
    LAS bf16* T = (LAS bf16*)(F.lds + F.wave * 9216);
    const int gw = F.bid * NWAVES + F.wave, NGW = F.G * NWAVES, lane = F.lane;
    for (int job = gw; job < 2 * NBG * 64; job += NGW) {
        const int s = job & 63, bg = (job >> 6) & 15, which = job >> 10;
        const bf16* X = (const bf16*)(F.ws + (which ? WS_VW : WS_VS)) + ((size_t)bg * SEQ + 64 * s) * 64;
        bf16* XT = (bf16*)(F.ws + (which ? WS_VWT : WS_VST)) + (size_t)bg * 64 * SEQ + 64 * s;
#pragma unroll
        for (int i = 0; i < 8; ++i) { const int tok = (lane >> 3) + 8 * i, ch = lane & 7;
            const v4u x = *(const GAS v4u*)(X + (size_t)tok * 64 + 8 * ch);
            const unsigned ww[4] = {x.x, x.y, x.z, x.w};
#pragma unroll
            for (int e = 0; e < 4; ++e) { T[(8 * ch + 2 * e) * 72 + tok] = (bf16)(ww[e] & 0xffffu); T[(8 * ch + 2 * e + 1) * 72 + tok] = (bf16)(ww[e] >> 16); } }
        LDS_WAIT(); asm volatile("" ::: "memory");
#pragma unroll
        for (int i = 0; i < 8; ++i) { const int dim = (lane >> 3) + 8 * i, ch = lane & 7;
            const v4u y = *(const LAS v4u*)(T + dim * 72 + 8 * ch);
            *(GAS v4u*)(XT + (size_t)dim * SEQ + 8 * ch) = y; }
        LDS_WAIT(); asm volatile("" ::: "memory");
    }
}

constexpr int AT_KBUF = 64 * 128;
constexpr int AT_NBUF = 2;
constexpr int AT_OFF_K = 0, AT_OFF_V = AT_NBUF * AT_KBUF;
constexpr int AT_OFF_IMP1 = 2 * AT_NBUF * AT_KBUF, AT_OFF_IMP2 = AT_OFF_IMP1 + 64 * 65 * 4, AT_OFF_SEL = AT_OFF_IMP2 + 64 * 65 * 4;
constexpr int AT_OFF_LUT = AT_OFF_SEL + 512, AT_OFF_LROW = AT_OFF_LUT + 4 * 128 * 4;
constexpr int AT_OFF_TD = AT_OFF_LROW + 8 * 32 * 4;
constexpr int AT_OFF_OUT = AT_OFF_TD + 96 * 32;
constexpr int AT_OFF_GATL = AT_OFF_OUT + 256 * 144;
constexpr int AT_OFF_TS = AT_OFF_GATL + 64 * 12 * 4;
constexpr int AT_TS_ROW = 65 * 16;
constexpr int AT_LDS_END = AT_OFF_TS + 16 * AT_TS_ROW;
static_assert(AT_LDS_END <= RING_BYTES, "attention LDS");

struct AtTile { const bf16* k; const bf16* vt; int vstride; };
enum { TM_CMP1 = 0, TM_CMP2, TM_SELN, TM_SELF, TM_WINN, TM_WINF, TM_WINE, TM_CMP1F, TM_CMP2F };
__device__ __forceinline__ float fexp2(float x) { return __builtin_amdgcn_exp2f(x); }
template <int TM, int VAR, int RB = 3>
__device__ __forceinline__ void at_tile(const LAS unsigned char* kb_, const LAS unsigned char* vb_, const LAS float* LUTJ, LAS float* IMP1, LAS float* IMP2,
                                        const bf16x8 (&qf)[2][2], pg8::f32x4 (&oacc)[2][4], pg8::f32x4 (&lacc)[2], const LAS float* LINV,
                                        const int (&tok_r_in)[2], const unsigned (&selb)[2], float cfar, int relbase, int idx, int l15_in, int lq_in, const LAS unsigned char* tsw, const LAS unsigned char* tsn) {
    constexpr bool FAR = (TM == TM_SELF || TM == TM_WINF || TM == TM_WINE || TM == TM_CMP1F || TM == TM_CMP2F);
    constexpr bool C1 = (TM == TM_CMP1 || TM == TM_CMP1F), C2 = (TM == TM_CMP2 || TM == TM_CMP2F);
    int l15 = l15_in, lq = lq_in; asm volatile("" : "+v"(l15), "+v"(lq));
    int tok_r[2] = {tok_r_in[0], tok_r_in[1]}; asm volatile("" : "+v"(tok_r[0]), "+v"(tok_r[1]));
    v4u pfr[2][2];
    const LAS unsigned char* tsp[2] = {tsw, tsw};
    if (TM == TM_SELN || TM == TM_WINN) {
#pragma unroll
        for (int rb = 0; rb < 2; ++rb) { const LAS unsigned char* pa = tsw + l15 * AT_TS_ROW + 16 * (2 * lq - rb) - 4 * relbase;
            const LAS unsigned char* pn = tsn + l15 * AT_TS_ROW;
            tsp[rb] = (TM == TM_SELN && !selb[rb]) ? pn : pa; } }
    auto kld = [&](int cb, bf16x8 (&kf)[2], pg8::f32x4 (&cq)[2]) __attribute__((always_inline)) {
        if (TM == TM_SELN || TM == TM_WINN) {
#pragma unroll
            for (int rb = 0; rb < 2; ++rb) cq[rb] = *(const LAS pg8::f32x4*)(tsp[rb] + 16 * (8 * (cb >> 1) + (cb & 1))); }
        if (!(VAR & 64)) {
        const int krow = 8 * (l15 >> 2) + (l15 & 3) + 32 * (cb >> 1) + 4 * (cb & 1), kf_ = ((l15 >> 2) << 1) | ((l15 >> 1) & 1);
#pragma unroll
        for (int ks = 0; ks < 2; ++ks) kf[ks] = *(const LAS bf16x8*)(kb_ + krow * 128 + 16 * ((4 * ks + lq) ^ kf_)); }
    };
    auto qkm = [&](int cb, const bf16x8 (&kf)[2], const pg8::f32x4 (&cq)[2], pg8::f32x4 (&st)[2]) __attribute__((always_inline)) {
        st[0] = FAR ? (pg8::f32x4){cfar, cfar, cfar, cfar} : (pg8::f32x4){0.f, 0.f, 0.f, 0.f}; st[1] = st[0];
        if (TM == TM_SELN || TM == TM_WINN) { st[0] = cq[0]; st[1] = cq[1]; }
        if (TM == TM_SELF) {
#pragma unroll
            for (int rb = 0; rb < 2; ++rb) { const float ci = selb[rb] ? cfar : -1.0e30f; st[rb] = (pg8::f32x4){ci, ci, ci, ci}; } }
        if (!(VAR & 64)) {
#pragma unroll
        for (int ks = 0; ks < 2; ++ks) {
#pragma unroll
            for (int rb = 0; rb < 2; ++rb) if (RB & (1 << rb)) st[rb] = __builtin_amdgcn_mfma_f32_16x16x32_bf16(kf[ks], qf[rb][ks], st[rb], 0, 0, 0); } }
    };
    float linv_[2] = {0.f, 0.f};
    if (C2) { linv_[0] = LINV[l15]; linv_[1] = LINV[16 + l15]; }
    auto prob = [&](int cb, const pg8::f32x4 (&st)[2]) __attribute__((always_inline)) {
#pragma unroll
        for (int rb = 0; rb < 2; ++rb) if (RB & (1 << rb)) {
            const int tokc = tok_r[rb];
            float p[4];
#pragma unroll
            for (int r = 0; r < 4; ++r) {
                const int kl = 32 * (cb >> 1) + 8 * lq + 4 * (cb & 1) + r;
                if (VAR & 16) { p[r] = st[rb][r]; }
                else if (TM == TM_SELF) { p[r] = fexp2(st[rb][r]); }
                else if (TM == TM_WINF || TM == TM_SELN || TM == TM_WINN || TM == TM_CMP1F || TM == TM_CMP2F) { p[r] = fexp2(st[rb][r]); }
                else if (TM == TM_WINE) { const float e = fexp2(st[rb][r]); p[r] = (kl > tokc) ? e : 0.f; }
                else {
                    const int rel = (TM == TM_CMP1 || TM == TM_CMP2) ? (relbase + tokc - 16 * kl) : (relbase + tokc - kl);
                    const bool valid = rel >= 0;
                    const int ri = rel < 0 ? 0 : (rel > 127 ? 127 : rel);
                    const float e = fexp2(st[rb][r] + LUTJ[ri]);
                    p[r] = valid ? e : 0.f; }
            }
            if (C1) { lacc[rb][0] += (p[0] + p[1]) + (p[2] + p[3]); }
            else {
                if (C2) {
#pragma unroll
                    for (int r = 0; r < 4; ++r) p[r] *= linv_[rb];
                    float h0 = p[0], h1 = p[1], h2 = p[2], h3 = p[3];
                    h0 += dppf<DPP_XOR1>(h0); h1 += dppf<DPP_XOR1>(h1); h2 += dppf<DPP_XOR1>(h2); h3 += dppf<DPP_XOR1>(h3);
                    h0 += dppf<DPP_XOR2>(h0); h1 += dppf<DPP_XOR2>(h1); h2 += dppf<DPP_XOR2>(h2); h3 += dppf<DPP_XOR2>(h3);
                    if ((l15 & 3) == 0) { const int sp = 16 * idx + 8 * (cb >> 1) + 2 * lq + (cb & 1);
                        IMP1[tokc * 65 + sp] = (h0 + h1) + (h2 + 0.5f * h3);
                        if (sp + 1 < 64) IMP2[tokc * 65 + sp + 1] = 0.5f * h3; }
                }
                const unsigned lo = pkh(p[0], p[1]), hi = pkh(p[2], p[3]);
                if (cb & 1) { pfr[rb][cb >> 1].z = lo; pfr[rb][cb >> 1].w = hi; } else { pfr[rb][cb >> 1].x = lo; pfr[rb][cb >> 1].y = hi; } }
        }
    };
    auto vld = [&](int ks, v4u (&vv)[4]) __attribute__((always_inline)) {
        if (!C1 && !(VAR & 8)) {
#pragma unroll
            for (int db = 0; db < 4; ++db) vv[db] = *(const LAS v4u*)(vb_ + (16 * db + l15) * 128 + 16 * ((4 * ks + lq) ^ (l15 >> 1))); }
    };
    auto pvm = [&](int ks, const v4u (&vv)[4]) __attribute__((always_inline)) {
        if (!C1 && !(VAR & 8)) {
#pragma unroll
            for (int db = 0; db < 4; ++db) {
#pragma unroll
                for (int rb = 0; rb < 2; ++rb) if (RB & (1 << rb)) oacc[rb][db] = __builtin_amdgcn_mfma_f32_16x16x32_bf16(__builtin_bit_cast(bf16x8, pfr[rb][ks]), __builtin_bit_cast(bf16x8, vv[db]), oacc[rb][db], 0, 0, 0); }
            if (!C2) { const v4u ones = (v4u){0x3F803F80u, 0x3F803F80u, 0x3F803F80u, 0x3F803F80u};
#pragma unroll
                for (int rb = 0; rb < 2; ++rb) if (RB & (1 << rb)) lacc[rb] = __builtin_amdgcn_mfma_f32_16x16x32_bf16(__builtin_bit_cast(bf16x8, pfr[rb][ks]), __builtin_bit_cast(bf16x8, ones), lacc[rb], 0, 0, 0); }
        }
    };
    pg8::f32x4 sA[2], sB[2], cA[2], cB[2]; bf16x8 kA[2], kB[2]; v4u vA[4], vB[4];
#define AT_SB __builtin_amdgcn_sched_barrier(0)
    kld(0, kA, cA); kld(1, kB, cB); AT_SB;
    qkm(0, kA, cA, sA); kld(2, kA, cA); AT_SB;
    qkm(1, kB, cB, sB); kld(3, kB, cB); prob(0, sA); AT_SB;
    qkm(2, kA, cA, sA); vld(0, vA); prob(1, sB); AT_SB;
    qkm(3, kB, cB, sB); pvm(0, vA); vld(1, vB); prob(2, sA); AT_SB;
    prob(3, sB); AT_SB;
    pvm(1, vB);
#undef AT_SB
}

template <int VAR> __device__ __forceinline__ void attention_phase(Frame& F, const Args& args) {
    unsigned char* ws = F.ws;
    const int lane = F.lane, w = F.wave, l15 = lane & 15, lq = lane >> 4, tid = F.tid;
    LAS unsigned char* L = F.lds;
    LAS float* IMP1 = (LAS float*)(L + AT_OFF_IMP1); LAS float* IMP2 = (LAS float*)(L + AT_OFF_IMP2);
    LAS unsigned long long* SELM = (LAS unsigned long long*)(L + AT_OFF_SEL); LAS float* LUT = (LAS float*)(L + AT_OFF_LUT); LAS float* LROW = (LAS float*)(L + AT_OFF_LROW) + w * 32;
    LAS int* TD = (LAS int*)(L + AT_OFF_TD); LAS bf16* OUTL = (LAS bf16*)(L + AT_OFF_OUT) + (32 * w) * 72; LAS float* GATL = (LAS float*)(L + AT_OFF_GATL);
    const bf16* Qg = (const bf16*)(ws + WS_Q); const float* GATE = (const float*)(ws + WS_GATE); bf16* YA = (bf16*)(ws + WS_PL) + 512;
    const int jq = l15 & 3;
    const LAS float* LUTJ = LUT + jq * 128;
    const int nrounds = (F.G == 256) ? 4 : (1024 + F.G - 1) / F.G;
    for (int round = 0; round < nrounds; ++round) {
        const int ui = (F.G == 256) ? ((round & 1) ? ((round >> 1) * 512 + 511 - F.bid) : ((round >> 1) * 512 + F.bid)) : (round * F.G + F.bid);
        if (ui >= 1024) break;
        const int c = 63 - (ui >> 4), bg = ui & 15, b = bg >> 1, g = bg & 1;
        const int m0 = b * SEQ + 64 * c;
        __syncthreads();
        { const float M0 = ((const float*)(ws + WS_BIASL))[8 * 128];
          for (int i = tid; i < 512; i += NTHREADS) LUT[i] = (((const float*)(ws + WS_BIASL))[(4 * g + (i >> 7)) * 128 + (i & 127)] - M0) * 1.4426950408889634f; }
        for (int i = tid; i < 64 * 65; i += NTHREADS) { IMP1[i] = 0.f; IMP2[i] = 0.f; }
        { const float M0 = ((const float*)(ws + WS_BIASL))[8 * 128]; const float* BL = (const float*)(ws + WS_BIASL) + (size_t)(4 * g) * 128;
          for (int i = tid; i < 16 * 63 * 4; i += NTHREADS) { const int r = i & 3, yi = (i >> 2) % 63, row = i / 252, rel = 4 * (47 - yi) + (row >> 2) - r;
              ((LAS float*)(L + AT_OFF_TS + row * AT_TS_ROW))[4 * yi + r] = rel < 0 ? -1.0e30f : (BL[(row & 3) * 128 + (rel > 127 ? 127 : rel)] - M0) * 1.4426950408889634f; } }
        for (int i = tid; i < 64 * 12; i += NTHREADS) GATL[i] = GATE[(size_t)(m0 + i / 12) * 24 + g * 12 + (i % 12)];
        bf16x8 qf[2][2];
#pragma unroll
        for (int rb = 0; rb < 2; ++rb)
#pragma unroll
            for (int ks = 0; ks < 2; ++ks) qf[rb][ks] = *(const GAS bf16x8*)(Qg + (size_t)(m0 + 8 * w + 4 * rb + (l15 >> 2)) * 512 + g * 256 + jq * 64 + 32 * ks + 8 * lq);
        asm volatile("" :: "v"(qf[0][0]), "v"(qf[0][1]), "v"(qf[1][0]), "v"(qf[1][1]));
        const int ncmp = 4 * c + 3, n1 = (ncmp + 63) >> 6, nsel = c + 1, w0 = c >= 8 ? c - 8 : 0, nwin = c - w0 + 1;
        const int ntiles = 2 * n1 + nsel + nwin;
        if (tid < ntiles) { const int i = tid;
            auto kindof = [&](int t, int& kind, int& idx) { if (t < n1) { kind = 0; idx = t; } else if (t < 2 * n1) { kind = 1; idx = t - n1; } else if (t < 2 * n1 + nsel) { kind = 2; idx = t - 2 * n1; } else { kind = 3; idx = w0 + (t - 2 * n1 - nsel); } };
            int kind, idx, kn, in_; kindof(i, kind, idx); kindof(i + 1 < ntiles ? i + 1 : i, kn, in_);
            unsigned ko, vo;
            if (kn < 2) { ko = (unsigned)(WS_KC + ((size_t)bg * 256 * 64 + (size_t)in_ * 4096) * 2); vo = (unsigned)(WS_VCT + ((size_t)bg * 64 * 256 + 64 * in_) * 2); }
            else if (kn == 2) { ko = (unsigned)(WS_KS + ((size_t)bg * SEQ * 64 + (size_t)in_ * 4096) * 2); vo = (unsigned)(WS_VST + ((size_t)bg * 64 * SEQ + 64 * in_) * 2); }
            else { ko = (unsigned)(WS_KW + ((size_t)bg * SEQ * 64 + (size_t)in_ * 4096) * 2); vo = (unsigned)(WS_VWT + ((size_t)bg * 64 * SEQ + 64 * in_) * 2); }
            const int dd = c - idx;
            int mode, relbase;
            if (kind == 0) { relbase = 64 * c - 31 - 1024 * idx; mode = relbase >= 1135 ? TM_CMP1F : TM_CMP1; } else if (kind == 1) { relbase = 64 * c - 31 - 1024 * idx; mode = relbase >= 1135 ? TM_CMP2F : TM_CMP2; }
            else if (kind == 2) { mode = dd <= 2 ? TM_SELN : TM_SELF; relbase = 64 * dd; } else { mode = dd <= 2 ? TM_WINN : (dd == 8 ? TM_WINE : TM_WINF); relbase = 64 * dd; }
            const int endf = ((kind == 1 && idx == n1 - 1) || (kind == 2 && idx == nsel - 1) || (kind == 3 && idx == c)) ? kind : 0;
            v4i e; e.x = mode | (idx << 8) | (endf << 16) | ((kind == 2 && idx == 0) ? (1 << 24) : 0) | (kn >= 2 ? (1 << 25) : 0); e.y = relbase; e.z = (int)ko; e.w = (int)vo;
            *(LAS v4i*)(TD + 4 * i) = e; }
        const int drow = 8 * w + (lane >> 3), dsrck = 16 * ((lane & 7) ^ (((w & 3) << 1) | ((lane >> 4) & 1))), dsrcv = 16 * ((lane & 7) ^ ((4 * (w & 1)) | (lane >> 4)));
#define AT_DMA(tile_, ko_, vo_, vs_) do { const int nb_ = (tile_) % AT_NBUF; \
        __builtin_amdgcn_global_load_lds((const GAS unsigned*)(ws + (size_t)((ko_) + drow * 128 + dsrck)), (LAS unsigned*)(L + AT_OFF_K + nb_ * AT_KBUF + w * 1024), 16, 0, 0); \
        __builtin_amdgcn_global_load_lds((const GAS unsigned*)(ws + (size_t)((vo_) + drow * (vs_) + dsrcv)), (LAS unsigned*)(L + AT_OFF_V + nb_ * AT_KBUF + w * 1024), 16, 0, 0); } while (0)
        __syncthreads();
        if (!(VAR & 2)) { AT_DMA(0, (unsigned)(WS_KC + (size_t)bg * 256 * 64 * 2), (unsigned)(WS_VCT + (size_t)bg * 64 * 256 * 2), 512u); }
        int d0, d1, d2, d3;
        { const v4i e = *(const LAS v4i*)TD; d0 = __builtin_amdgcn_readfirstlane(e.x); d1 = __builtin_amdgcn_readfirstlane(e.y); d2 = __builtin_amdgcn_readfirstlane(e.z); d3 = __builtin_amdgcn_readfirstlane(e.w); }
        pg8::f32x4 oacc[2][4];
        pg8::f32x4 lacc[2] = {(pg8::f32x4){0.f, 0.f, 0.f, 0.f}, (pg8::f32x4){0.f, 0.f, 0.f, 0.f}};
#pragma unroll
        for (int rb = 0; rb < 2; ++rb)
#pragma unroll
            for (int db = 0; db < 4; ++db) oacc[rb][db] = (pg8::f32x4){0.f, 0.f, 0.f, 0.f};
        const int tok_r[2] = {8 * w + (l15 >> 2), 8 * w + 4 + (l15 >> 2)};
        const LAS unsigned char* tsw = L + AT_OFF_TS + 16 * (47 - 2 * w); const LAS unsigned char* tsn = L + AT_OFF_TS + 16 * 48;
        for (int it = 0; it < ((VAR & 32) ? 0 : ntiles); ++it) {
            if (!(VAR & 512)) { asm volatile("s_waitcnt vmcnt(0)" ::: "memory");
            asm volatile("s_waitcnt lgkmcnt(0)" ::: "memory"); __builtin_amdgcn_s_barrier(); asm volatile("" ::: "memory"); }
            if (!(VAR & 2) && it + 1 < ntiles) AT_DMA(it + 1, (unsigned)d2, (unsigned)d3, ((d0 >> 25) & 1) ? 2u * SEQ : 512u);
            v4i tdn;
            { const LAS int* tn_ = TD + 4 * (it + 1); asm volatile("ds_read_b128 %0, %1" : "=v"(tdn) : "v"(tn_) : "memory"); }
            {
            const int mode = d0 & 255, idx = (d0 >> 8) & 255, relbase = d1, endf = (d0 >> 16) & 3, selfirst = (d0 >> 24) & 1;
            const int buf = it % AT_NBUF;
            if (selfirst) {
                { const int tok = 8 * w + (lane >> 3), s0 = 8 * (lane & 7);
                  unsigned key[8]; int rank[8];
#pragma unroll
                  for (int q = 0; q < 8; ++q) { const int sB = s0 + q; const bool vis = sB <= c, forced = (sB == 0) || (sB == c) || (sB == c - 1);
                      const float sc = vis ? (IMP1[tok * 65 + sB] + IMP2[tok * 65 + sB] + (forced ? 1000.f : 0.f)) : -1.f;
                      const unsigned u = __builtin_bit_cast(unsigned, sc); const unsigned fk = (u >> 31) ? ~u : (u | 0x80000000u);
                      key[q] = (fk & ~63u) | (unsigned)(63 - sB); rank[q] = 0; }
                  LAS unsigned* KEYS = (LAS unsigned*)IMP1;
#pragma unroll
                  for (int q = 0; q < 8; ++q) KEYS[tok * 65 + s0 + q] = key[q];
                  if (c >= 16 && !(VAR & 128)) {
#pragma unroll 8
                      for (int s2 = 0; s2 < 64; ++s2) { const unsigned k2 = KEYS[tok * 65 + s2];
#pragma unroll
                          for (int q = 0; q < 8; ++q) rank[q] += (k2 > key[q]) ? 1 : 0; } }
                  unsigned byte = 0u;
#pragma unroll
                  for (int q = 0; q < 8; ++q) byte |= ((rank[q] < 16 && (s0 + q) <= c) ? 1u : 0u) << q;
                  ((LAS unsigned char*)SELM)[tok * 8 + (lane & 7)] = (unsigned char)byte; }
            }
            const LAS unsigned char* kb_ = L + AT_OFF_K + buf * AT_KBUF; const LAS unsigned char* vb_ = L + AT_OFF_V + buf * AT_KBUF;
            const float cfar = LUTJ[127];
            unsigned selb[2] = {1u, 1u};
#define AT_CALL(TMX) at_tile<TMX, VAR>(kb_, vb_, LUTJ, IMP1, IMP2, qf, oacc, lacc, LROW, tok_r, selb, cfar, relbase, idx, l15, lq, tsw, tsn)
            if (mode == TM_SELF || mode == TM_SELN) { selb[0] = (unsigned)(SELM[tok_r[0]] >> idx) & 1u; selb[1] = (unsigned)(SELM[tok_r[1]] >> idx) & 1u; }
            if (mode == TM_SELF) {
                const bool a0 = __ballot(selb[0] != 0u) != 0ull, a1 = __ballot(selb[1] != 0u) != 0ull;
                if (a0 && a1) AT_CALL(TM_SELF);
                else if (a0) at_tile<TM_SELF, VAR, 1>(kb_, vb_, LUTJ, IMP1, IMP2, qf, oacc, lacc, LROW, tok_r, selb, cfar, relbase, idx, l15, lq, tsw, tsn);
                else if (a1) at_tile<TM_SELF, VAR, 2>(kb_, vb_, LUTJ, IMP1, IMP2, qf, oacc, lacc, LROW, tok_r, selb, cfar, relbase, idx, l15, lq, tsw, tsn); }
            else if (mode == TM_WINF) AT_CALL(TM_WINF);
            else if (mode == TM_SELN) AT_CALL(TM_SELN);
            else if (mode == TM_WINN) AT_CALL(TM_WINN);
            else if (mode == TM_WINE) AT_CALL(TM_WINE);
            else if (mode == TM_CMP2) AT_CALL(TM_CMP2);
            else if (mode == TM_CMP2F) AT_CALL(TM_CMP2F);
            else if (mode == TM_CMP1F) AT_CALL(TM_CMP1F);
            else { AT_CALL(TM_CMP1);
                if (idx == n1 - 1) {
#pragma unroll
                    for (int rb = 0; rb < 2; ++rb) { const float s = sum_xor32(sum_xor16(lacc[rb][0])); if (lq == 0) LROW[16 * rb + l15] = s > 0.f ? 1.0f / s : 0.f; lacc[rb] = (pg8::f32x4){0.f, 0.f, 0.f, 0.f}; } } }
#undef AT_CALL
            {
                if (endf && !(VAR & 256)) {
                    const int br = endf - 1;
#pragma unroll
                    for (int rb = 0; rb < 2; ++rb)
#pragma unroll
                        for (int r = 0; r < 4; ++r) { const int qrow = 16 * rb + 4 * lq + r;
                            const float ls_ = lacc[rb][r]; lacc[rb][r] = 0.f;
                            const float gt = GATL[(8 * w + 4 * rb + lq) * 12 + r * 3 + br] * (endf == 1 ? 1.0f : (ls_ > 0.f ? 1.0f / ls_ : 0.f));
#pragma unroll
                            for (int db = 0; db < 4; ++db) { float v = gt * oacc[rb][db][r]; oacc[rb][db][r] = 0.f;
                                LAS bf16* po = OUTL + qrow * 72 + 16 * db + l15;
                                if (br > 0) v += __builtin_bit_cast(float, (unsigned)(*po) << 16);
                                *po = (bf16)f2bf(v); } }
                    if (br == 2 && !(VAR & 1)) {
                        LDS_WAIT(); asm volatile("" ::: "memory");
#pragma unroll
                        for (int i = 0; i < 4; ++i) { const int ch = i * 64 + lane, row = ch >> 3, c16 = ch & 7;
                            const v4u o = *(const LAS v4u*)((const LAS unsigned char*)OUTL + row * 144 + 16 * c16);
                            *(GAS v4u*)(YA + (size_t)(m0 + 8 * w + (row >> 2)) * 1024 + g * 256 + (row & 3) * 64 + 8 * c16) = o; }
                    }
                }
            }
            }
            asm volatile("s_waitcnt lgkmcnt(0)" : "+v"(tdn) :: "memory");
            d0 = __builtin_amdgcn_readfirstlane(tdn.x); d1 = __builtin_amdgcn_readfirstlane(tdn.y); d2 = __builtin_amdgcn_readfirstlane(tdn.z); d3 = __builtin_amdgcn_readfirstlane(tdn.w);
        }
#undef AT_DMA
    }
}

constexpr int N_PHASES = 13;
#ifndef MK_ONE_LAUNCH
#define MK_ONE_LAUNCH 1
#endif
#ifndef REP_P0
#define REP_P0 1
#endif
#ifndef REP_P1
#define REP_P1 1
#endif
#ifndef REP_P2
#define REP_P2 1
#endif
#ifndef REP_P3
#define REP_P3 1
#endif
#ifndef REP_P5
#define REP_P5 1
#endif
#ifndef REP_P6
#define REP_P6 1
#endif
#ifndef REP_P8
#define REP_P8 1
#endif
#ifndef REP_P7
#define REP_P7 1
#endif
#ifndef REP_P11
#define REP_P11 1
#endif
#ifndef REP_P4
#define REP_P4 1
#endif
#ifndef REP_P9
#define REP_P9 1
#endif
#ifndef REP_P10
#define REP_P10 1
#endif
#ifndef MK_BUILD
#define MK_BUILD 0
#endif

#ifndef STAG_P2
#define STAG_P2 0
#endif
__device__ __forceinline__ void phase_stagger(const Frame& F, int step_ns) {
    const int grp = (F.bid >> 3) & 7;
    if (step_ns > 0 && grp > 0) { const unsigned long long t0 = wall_clock64(), dt = (unsigned long long)(grp * step_ns) / 10ull;
        while (wall_clock64() - t0 < dt) __builtin_amdgcn_s_sleep(8); }
}
struct EpiNull {
    static constexpr bool PERM = true, AFTER_DRAIN = false, MID = false;
    __device__ __forceinline__ void operator()(const pg8::f32x4 (&acc)[2][2][4][2], const pg8::Unit& u, int wr, int wc, int fr, int fq) const {
#pragma unroll
        for (int ai = 0; ai < 2; ++ai)
#pragma unroll
            for (int bj = 0; bj < 2; ++bj)
#pragma unroll
                for (int m = 0; m < 4; ++m) { asm volatile("" :: "v"(acc[ai][bj][m][0]), "v"(acc[ai][bj][m][1])); }
    }
};
__global__ void __launch_bounds__(NTHREADS, 2) fwd_kernel(Args args) {
    extern __shared__ __attribute__((aligned(16))) unsigned char lds[];
    Frame F;
    F.lds = (LAS unsigned char*)lds;
    F.MISC = (volatile LAS unsigned*)(F.lds + MISC_OFF);
    F.tid = threadIdx.x; F.lane = F.tid & 63; F.wave = __builtin_amdgcn_readfirstlane(F.tid >> 6);
    F.G = gridDim.x; F.bid = blockIdx.x; F.ws = args.ws;
    F.ctl = (gu32*)(args.ws + WS_CTL);
    for (int u = F.tid; u < (LDS_BYTES - LDSCTL_OFF) / 4; u += NTHREADS) ((LAS unsigned*)(F.lds + LDSCTL_OFF))[u] = 0u;
    __syncthreads();
    XcdBarrier bar; bar.bar = (unsigned*)(F.ctl + CW_BAR); bar.x = 0; bar.st = nullptr;
    if (MK_ONE_LAUNCH) bar = xcd_barrier_post((unsigned*)(F.ctl + CW_BAR), F.MISC + 8);
    const int lo = args.ph_lo, hi = args.ph_hi;
#define IN(k) (lo <= (k) && (k) < hi)
#define SEAM(k) do { if (IN(k) && IN((k) + 1)) xcd_barrier(bar); } while (0)
    unsigned char* ws = args.ws;
    const float* ada = (const float*)(ws + WS_ADA);

    if (IN(0)) { for (int rep = 0; rep < REP_P0; ++rep) { p0_prologue(F, args, rep == REP_P0 - 1); __syncthreads(); } } SEAM(0);
    if (IN(1)) { for (int rep = 0; rep < REP_P1; ++rep) modnorm_rows<false>(F, args.in[I_X], args.in[I_N1G], ada, 0, (bf16*)(ws + WS_H)); } SEAM(1);
    if (IN(2)) { {
        phase_stagger(F, STAG_P2);
        pg8::Gemm g{(const bf16*)(ws + WS_H), (const bf16*)(ws + WS_WIN_T), M, NIN, D, D, D}; pg8::StaticOrder S; S.init(M, NIN, F.G, F.bid);
        if (F.tid == 0) F.MISC[40] = 0xffffffffu; __syncthreads();
        EpiIn E{ws, args.in[I_QNG], args.in[I_KNG], F.MISC + 40};
#if defined(PROBE_P2) && PROBE_P2 == 1
        { EpiNull EN; pg8::gemm_phase<EpiNull, pg8::StaticOrder, true, true>(F.lds + RING_OFF, g, S, EN); __syncthreads(); }
#elif defined(PROBE_P2) && PROBE_P2 == 2
        { if (F.tid == 0) F.MISC[40] = 0u; __syncthreads(); pg8::gemm_phase<EpiIn, pg8::StaticOrder, true, true>(F.lds + RING_OFF, g, S, E); __syncthreads(); if (F.tid == 0) F.MISC[40] = 0xffffffffu; __syncthreads(); }
#endif
        pg8::gemm_phase<EpiIn, pg8::StaticOrder, true, true>(F.lds + RING_OFF, g, S, E);
#if REP_P2 > 1
        __syncthreads(); pg8::gemm_phase<EpiIn, pg8::StaticOrder, true, true>(F.lds + RING_OFF, g, S, E);
#endif
        }
    } SEAM(2);
#ifndef PROBE_P3
#define PROBE_P3 0
#endif
    if (IN(3)) { for (int rep = 0; rep < REP_P3; ++rep) { __syncthreads(); pool_phase(F); if (PROBE_P3 == 1) { __syncthreads(); pool_phase(F); }
        __syncthreads(); compress_phase(F, args.in[I_KNG]); if (PROBE_P3 == 2) { __syncthreads(); compress_phase(F, args.in[I_KNG]); }
        __syncthreads(); vtranspose_phase(F); if (PROBE_P3 == 3) { __syncthreads(); vtranspose_phase(F); } } } SEAM(3);
    if (IN(4)) {
#ifdef PROBE_P4
        attention_phase<PROBE_P4>(F, args); __syncthreads();
#endif
        for (int rep = 0; rep < REP_P4; ++rep) { attention_phase<0>(F, args); __syncthreads(); } } SEAM(4);
    if (IN(5)) { {
        pg8::Gemm g{(const bf16*)(ws + WS_PL), (const bf16*)(ws + WS_WEFF_T), M, D, 2 * POOLW, 2 * POOLW, 2 * POOLW}; pg8::StaticOrder S; S.init(M, D, F.G, F.bid);
        EpiMix2 E{(bf16*)(ws + WS_MIX), (const bf16*)(ws + WS_GM)};
        pg8::gemm_phase<EpiMix2, pg8::StaticOrder, true, true>(F.lds + RING_OFF, g, S, E);
#if REP_P5 > 1
        __syncthreads(); pg8::gemm_phase<EpiMix2, pg8::StaticOrder, true, true>(F.lds + RING_OFF, g, S, E);
#endif
        }
    } SEAM(5);
    if (IN(6)) { {
        pg8::Gemm g{(const bf16*)(ws + WS_MIX), (const bf16*)(ws + WS_WOUT_T), M, D, D, D, D}; pg8::StaticOrder S; S.init(M, D, F.G, F.bid);
        EpiRes E{args.in[I_X], (bf16*)(ws + WS_X1), ada, 2};
        pg8::gemm_phase<EpiRes, pg8::StaticOrder, true, true>(F.lds + RING_OFF, g, S, E);
#if REP_P6 > 1
        __syncthreads(); pg8::gemm_phase<EpiRes, pg8::StaticOrder, true, true>(F.lds + RING_OFF, g, S, E);
#endif
        }
    } SEAM(6);
    if (IN(7)) { for (int rep = 0; rep < REP_P7; ++rep) modnorm_rows<true>(F, ws + WS_X1, args.in[I_N2G], ada, 3, (bf16*)(ws + WS_H)); } SEAM(7);
    if (IN(8)) { {
        pg8::Gemm g{(const bf16*)(ws + WS_H), (const bf16*)(ws + WS_WQ_T), M, PQW, D, D, D}; pg8::StaticOrder S; S.init(M, PQW, F.G, F.bid);
        EpiStoreBf16 E{(bf16*)(ws + WS_QV), PQW};
        pg8::gemm_phase<EpiStoreBf16, pg8::StaticOrder, true, true>(F.lds + RING_OFF, g, S, E);
#if REP_P8 > 1
        __syncthreads(); pg8::gemm_phase<EpiStoreBf16, pg8::StaticOrder, true, true>(F.lds + RING_OFF, g, S, E);
#endif
        }
    } SEAM(8);
    if (IN(9)) { for (int rep = 0; rep < REP_P9; ++rep) peer_select_phase(F); } SEAM(9);
#ifdef PROBE_XCD
    if (IN(10)) { if (F.tid == 0) __hip_atomic_store((unsigned*)(F.ctl + 2048 + F.bid), 100u + xb_xcc_id(), RLX_AGENT); }
#endif
    if (IN(10)) {
#ifdef PROBE_DOT
        peer_dot_phase<PROBE_DOT>(F); __syncthreads();
#endif
#ifdef PROBE_LOADRATE
        peer_loadrate_probe<PROBE_LOADRATE>(F); __syncthreads();
#endif
        peer_dot_phase<0>(F); } SEAM(10);
    if (IN(11)) { for (int rep = 0; rep < REP_P11; ++rep) peer_coef_phase(F); } SEAM(11);
#ifdef PROBE_XCD
    if (IN(12) && F.bid == 0 && F.tid == 0) { bool ok = true; for (int i = 0; i < F.G; ++i) { const unsigned a = __hip_atomic_load((unsigned*)(F.ctl + 2048 + i), RLX_AGENT), b0 = __hip_atomic_load((unsigned*)(F.ctl + 2048 + (i & 7)), RLX_AGENT); if (a != b0 || a < 100u) ok = false; }
        for (int i = 0; i < 8; ++i) for (int q = 0; q < i; ++q) if (__hip_atomic_load((unsigned*)(F.ctl + 2048 + i), RLX_AGENT) == __hip_atomic_load((unsigned*)(F.ctl + 2048 + q), RLX_AGENT)) ok = false;
        if (!ok) args.out[12345] = 1.0e9f; }
    __syncthreads();
#endif
    if (IN(12)) {
#if defined(CHECK_OUT_MFMA)
        peer_out_mfma_phase<1>(F, ada, args.out); __syncthreads(); VM_WAIT(); __syncthreads(); peer_out_phase<false, true>(F, ada, args.out);
#elif defined(OUT_VALU)
        for (int rep = 1; rep < REP_P10; ++rep) peer_out_phase<true>(F, ada, args.out); peer_out_phase<false>(F, ada, args.out);
#else
#ifdef PROBE_OUT
        peer_out_mfma_phase<1>(F, ada, args.out); __syncthreads();
#endif
        peer_out_mfma_phase<0>(F, ada, args.out);
#endif
    }
#undef IN
#undef SEAM
}

extern "C" void kernel_launch(void* const* d_in, const int* in_sizes, int n_in, void* d_out, int out_size, void* d_ws, size_t ws_size, hipStream_t stream) {
    static int grid = 0;
    if (grid == 0) {
        if (n_in != N_IN || in_sizes[0] != M * D || out_size != M * D || ws_size < WS_END) {
            fprintf(stderr, "kernel_launch: unexpected shapes: n_in %d in0 %d out %d ws %zu (need %zu)\n", n_in, n_in > 0 ? in_sizes[0] : -1, out_size, ws_size, (size_t)WS_END); grid = -1; return; }
        int dev = 0, cus = 0, per_cu = 0;
        if (hipGetDevice(&dev) != hipSuccess || hipDeviceGetAttribute(&cus, hipDeviceAttributeMultiprocessorCount, dev) != hipSuccess) { grid = -1; return; }
        if (hipFuncSetAttribute((const void*)fwd_kernel, hipFuncAttributeMaxDynamicSharedMemorySize, LDS_BYTES) != hipSuccess) { fprintf(stderr, "kernel_launch: hipFuncSetAttribute failed\n"); grid = -1; return; }
        if (hipOccupancyMaxActiveBlocksPerMultiprocessor(&per_cu, (const void*)fwd_kernel, NTHREADS, LDS_BYTES) != hipSuccess || per_cu < 1)
            fprintf(stderr, "kernel_launch: occupancy query reports %d workgroups per CU\n", per_cu);
        (void)hipGetLastError();
        grid = cus;
    }
    if (grid < 0) return;
    if (hipMemsetAsync((char*)d_ws + WS_CTL, 0, CTL_ZERO_BYTES, stream) != hipSuccess) return;
    Args a{};
    for (int i = 0; i < N_IN; ++i) a.in[i] = (const float*)d_in[i];
    a.out = (float*)d_out; a.ws = (unsigned char*)d_ws;
    if (MK_ONE_LAUNCH) {
        a.ph_lo = 0; a.ph_hi = N_PHASES; a.li = 0;
        hipLaunchKernelGGL(fwd_kernel, dim3(grid), dim3(NTHREADS), LDS_BYTES, stream, a);
    } else {
        for (int p = 0; p < N_PHASES; ++p) {
            a.ph_lo = p; a.ph_hi = p + 1; a.li = p;
            hipLaunchKernelGGL(fwd_kernel, dim3(grid), dim3(NTHREADS), LDS_BYTES, stream, a);
        }
    }
}
```

```cpp
#include <hip/hip_runtime.h>
#include <cstdio>
#include <cstdint>
namespace pg8 {
#define PG8_LAS __attribute__((address_space(3)))
typedef unsigned short bf16_t;
typedef short bf16x8 __attribute__((ext_vector_type(8)));
typedef float f32x4 __attribute__((ext_vector_type(4)));
typedef unsigned u32x4 __attribute__((ext_vector_type(4)));
constexpr int BM = 256, BK = 64, HALF = 128, HTB = HALF * BK * 2  , STAGE_BYTES = 8 * HTB, NXCD = 8, WGM = 8;

__host__ __device__ __forceinline__ int lds_byte(int r, int c) { const int st = (r >> 4) * 2 + (c >> 5), rr = r & 15, cc = c & 31, ob = rr * 64 + cc * 2; return st * 1024 + (ob ^ (((ob >> 9) & 1) << 5)); }
__host__ __device__ __forceinline__ void stage_rc(int b, int& R, int& C) { const int st = b / 1024, sb = b % 1024, swz = sb ^ (((sb >> 9) & 1) << 5); R = (st >> 1) * 16 + swz / 64; C = (st & 1) * 32 + (swz % 64) / 2; }
__host__ __device__ __forceinline__ int perm32(int rho) { const int n = rho >> 4, i = rho & 15; return 8 * (i >> 2) + 4 * n + (i & 3); }

struct Unit { int pm, pn; };
struct Gemm { const bf16_t* A; const bf16_t* Bt; int M, N, K, lda, ldb; };

struct StaticOrder {
    int nM, nN, nwg, G, c;
    __host__ __device__ void init(int M, int N, int G_, int c_) { nM = M / BM; nN = N / BM; nwg = nM * nN; G = G_; c = c_; }
    __host__ __device__ bool next(int i, Unit& u) const {
        const long L = (long)i * G + c; if (L >= nwg) return false;
        int wgid = (int)L; { const int q = nwg / NXCD, r = nwg % NXCD, xcd = wgid % NXCD, off = wgid / NXCD; wgid = (xcd < r ? xcd * (q + 1) : r * (q + 1) + (xcd - r) * q) + off; }
        const int nig = WGM * nN, gid = wgid / nig, fm = gid * WGM, gsz = (nM - fm) < WGM ? (nM - fm) : WGM;
        u.pm = fm + ((wgid % nig) % gsz); u.pn = (wgid % nig) / gsz; return true;
    }
    __device__ __forceinline__ void a_ready(const Unit&) const {}
    __device__ __forceinline__ void done(const Unit&) const {}
};

__device__ __forceinline__ unsigned cvt_pk_bf16(float lo, float hi) { unsigned r; asm volatile("v_cvt_pk_bf16_f32 %0, %1, %2" : "=v"(r) : "v"(lo), "v"(hi)); return r; }
template <class Epi, class Sched, bool ALIGN_EPI = false, bool SP2 = false>
__device__ __forceinline__ void gemm_phase(PG8_LAS unsigned char* lds, const Gemm g, const Sched& S, const Epi& E) {
    const int tid = threadIdx.x, wid = __builtin_amdgcn_readfirstlane(tid >> 6), lane = tid & 63, wr = wid >> 2, wc = wid & 3, fr = lane & 15, fq = lane >> 4;
    const int K = g.K, nt = K / BK;
    unsigned voffA[2], voffB[2];
#pragma unroll
    for (int i = 0; i < 2; ++i) { int R, C; stage_rc(tid * 16 + i * 8192, R, C); const int Rb = Epi::PERM ? ((R & ~31) + perm32(R & 31)) : R;
        voffA[i] = (unsigned)(R * g.lda + C) * 2u; voffB[i] = (unsigned)(Rb * g.ldb + C) * 2u; }
    const size_t kstep = (size_t)(BK * 2);
    const size_t hstepA = (size_t)HALF * g.lda * 2, hstepB = (size_t)HALF * g.ldb * 2;
    const size_t tstepA = 2 * hstepA, tstepB = 2 * hstepB;
    const unsigned ldsw = (unsigned)wid * 1024u;
    const int aoff = lds_byte(wr * 64 + fr, fq * 8), boff = lds_byte(wc * 32 + fr, fq * 8);
#define PG8_SA(b, h) (((b) * 2 + (h)) * HTB)
#define PG8_SB(b, h) ((4 + (b) * 2 + (h)) * HTB)
#define PG8_STAGE(bufoff, gbase, voff) do { _Pragma("unroll") for (int _i = 0; _i < 2; ++_i) \
        __builtin_amdgcn_global_load_lds((const unsigned*)((const char*)(gbase) + (voff)[_i]), (PG8_LAS unsigned*)(lds + (bufoff) + ldsw + _i * 8192), 16, 0, 0); } while (0)
#define PG8_LDA(dst, b, h) do { _Pragma("unroll") for (int m = 0; m < 4; ++m) _Pragma("unroll") for (int k = 0; k < 2; ++k) dst[m][k] = *(const PG8_LAS bf16x8*)(lds + PG8_SA(b, h) + aoff + m * 2048 + k * 1024); } while (0)
#define PG8_LDB(dst, b, h) do { _Pragma("unroll") for (int n = 0; n < 2; ++n) _Pragma("unroll") for (int k = 0; k < 2; ++k) dst[n][k] = *(const PG8_LAS bf16x8*)(lds + PG8_SB(b, h) + boff + n * 2048 + k * 1024); } while (0)
#define PG8_MMA(ai, bj, At, Bt) do { __builtin_amdgcn_s_setprio(1); _Pragma("unroll") for (int m = 0; m < 4; ++m) _Pragma("unroll") for (int n = 0; n < 2; ++n) _Pragma("unroll") for (int k = 0; k < 2; ++k) \
        acc[ai][bj][m][n] = __builtin_amdgcn_mfma_f32_16x16x32_bf16(Bt[n][k], At[m][k], acc[ai][bj][m][n], 0, 0, 0); __builtin_amdgcn_s_setprio(0); } while (0)
#define PG8_WAIT_V(n) asm volatile("s_waitcnt vmcnt(" #n ")" ::: "memory")
#define PG8_WAIT_L(n) asm volatile("s_waitcnt lgkmcnt(" #n ")" ::: "memory")
#define PG8_BAR __builtin_amdgcn_s_barrier()
#define PG8_SCHED __builtin_amdgcn_sched_barrier(0)
    Unit cur, nxt; int ui = 0;
    if (!S.next(0, cur)) return;
    f32x4 acc[2][2][4][2];
#pragma unroll
    for (int a = 0; a < 2; ++a)
#pragma unroll
        for (int b = 0; b < 2; ++b)
#pragma unroll
            for (int m = 0; m < 4; ++m)
#pragma unroll
                for (int n = 0; n < 2; ++n) acc[a][b][m][n] = (f32x4){0.f, 0.f, 0.f, 0.f};
    bf16x8 At[4][2], B0[2][2], B1[2][2];
    const char* cA = (const char*)g.A + (size_t)cur.pm * tstepA; const char* cB = (const char*)g.Bt + (size_t)cur.pn * tstepB;
    S.a_ready(cur);
    if constexpr (SP2) {
        PG8_STAGE(PG8_SB(0, 0), cB, voffB); PG8_STAGE(PG8_SB(0, 1), cB + hstepB, voffB); PG8_STAGE(PG8_SA(0, 0), cA, voffA); PG8_STAGE(PG8_SA(0, 1), cA + hstepA, voffA);
        if (wr == 1) PG8_BAR;
        PG8_WAIT_V(2); PG8_BAR;
        PG8_STAGE(PG8_SB(1, 0), cB + kstep, voffB); PG8_STAGE(PG8_SA(1, 0), cA + kstep, voffA); PG8_STAGE(PG8_SB(1, 1), cB + hstepB + kstep, voffB);
        PG8_WAIT_V(6); PG8_BAR;
    } else {
        PG8_STAGE(PG8_SB(0, 0), cB, voffB); PG8_STAGE(PG8_SA(0, 0), cA, voffA); PG8_STAGE(PG8_SB(0, 1), cB + hstepB, voffB); PG8_STAGE(PG8_SA(0, 1), cA + hstepA, voffA);
        if (wr == 1) PG8_BAR;
        PG8_WAIT_V(4); PG8_BAR;
        PG8_STAGE(PG8_SB(1, 0), cB + kstep, voffB); PG8_STAGE(PG8_SA(1, 0), cA + kstep, voffA); PG8_STAGE(PG8_SB(1, 1), cB + hstepB + kstep, voffB);
        PG8_WAIT_V(6); PG8_BAR;
    }
    for (;;) {
        const bool has_next = S.next(ui + 1, nxt);
        const char* nA = has_next ? (const char*)g.A + (size_t)nxt.pm * tstepA : cA; const char* nB = has_next ? (const char*)g.Bt + (size_t)nxt.pn * tstepB : cB;
        for (int t = 0; t < nt; t += 2) {
            if constexpr (Epi::MID) { if (t == nt / 2) E.mid(acc, cur, wr, wc, fr, fq); }
            const bool last = (t == nt - 2);
            const char* a1 = cA + (size_t)(t + 1) * kstep;
            const char* a2 = last ? nA : cA + (size_t)(t + 2) * kstep; const char* b2 = last ? nB : cB + (size_t)(t + 2) * kstep;
            const char* a3 = a2 + kstep; const char* b3 = b2 + kstep;
            if (last && has_next) S.a_ready(nxt);
            if constexpr (SP2) {
            PG8_LDB(B0, 0, 0); PG8_LDB(B1, 0, 1); PG8_SCHED; PG8_LDA(At, 0, 0); PG8_STAGE(PG8_SA(1, 1), a1 + hstepA, voffA);
            PG8_WAIT_V(8); PG8_WAIT_L(0); PG8_BAR; PG8_MMA(0, 0, At, B0); PG8_MMA(0, 1, At, B1); PG8_BAR; PG8_SCHED;
            PG8_LDA(At, 0, 1); PG8_STAGE(PG8_SB(0, 0), b2, voffB); PG8_STAGE(PG8_SB(0, 1), b2 + hstepB, voffB); PG8_STAGE(PG8_SA(0, 0), a2, voffA);
            PG8_WAIT_V(8); PG8_WAIT_L(0); PG8_BAR; PG8_MMA(1, 0, At, B0); PG8_MMA(1, 1, At, B1); PG8_BAR; PG8_SCHED;
            PG8_LDB(B0, 1, 0); PG8_LDB(B1, 1, 1); PG8_SCHED; PG8_LDA(At, 1, 0); PG8_STAGE(PG8_SA(0, 1), a2 + hstepA, voffA);
            PG8_WAIT_V(8); PG8_WAIT_L(0); PG8_BAR; PG8_MMA(0, 0, At, B0); PG8_MMA(0, 1, At, B1); PG8_BAR; PG8_SCHED;
            PG8_LDA(At, 1, 1); PG8_STAGE(PG8_SB(1, 0), b3, voffB); PG8_STAGE(PG8_SB(1, 1), b3 + hstepB, voffB); PG8_STAGE(PG8_SA(1, 0), a3, voffA);
            PG8_WAIT_V(8); PG8_WAIT_L(0); PG8_BAR; PG8_MMA(1, 0, At, B0); PG8_MMA(1, 1, At, B1); PG8_BAR; PG8_SCHED;
            } else {
            PG8_LDB(B0, 0, 0); PG8_SCHED; PG8_LDA(At, 0, 0); PG8_STAGE(PG8_SA(1, 1), a1 + hstepA, voffA);
            PG8_WAIT_L(8); PG8_BAR; PG8_WAIT_L(0); PG8_MMA(0, 0, At, B0); PG8_BAR; PG8_SCHED;
            PG8_LDB(B1, 0, 1); PG8_STAGE(PG8_SB(0, 0), b2, voffB);
            PG8_BAR; PG8_WAIT_L(0); PG8_MMA(0, 1, At, B1); PG8_BAR;
            PG8_LDA(At, 0, 1); PG8_STAGE(PG8_SA(0, 0), a2, voffA);
            PG8_BAR; PG8_WAIT_L(0); PG8_MMA(1, 0, At, B0); PG8_BAR; PG8_SCHED;
            PG8_STAGE(PG8_SB(0, 1), b2 + hstepB, voffB);
            PG8_WAIT_V(6); PG8_BAR; PG8_MMA(1, 1, At, B1); PG8_BAR;
            PG8_LDB(B0, 1, 0); PG8_SCHED; PG8_LDA(At, 1, 0); PG8_STAGE(PG8_SA(0, 1), a2 + hstepA, voffA);
            PG8_WAIT_L(8); PG8_BAR; PG8_WAIT_L(0); PG8_MMA(0, 0, At, B0); PG8_BAR; PG8_SCHED;
            PG8_LDB(B1, 1, 1); PG8_STAGE(PG8_SB(1, 0), b3, voffB);
            PG8_BAR; PG8_WAIT_L(0); PG8_MMA(0, 1, At, B1); PG8_BAR;
            PG8_LDA(At, 1, 1); PG8_STAGE(PG8_SA(1, 0), a3, voffA);
            PG8_BAR; PG8_WAIT_L(0); PG8_MMA(1, 0, At, B0); PG8_BAR; PG8_SCHED;
            PG8_STAGE(PG8_SB(1, 1), b3 + hstepB, voffB);
            PG8_WAIT_V(6); PG8_BAR; PG8_MMA(1, 1, At, B1); PG8_BAR;
            }
        }
        if constexpr (ALIGN_EPI) { if (wr == 0) PG8_BAR; }
        if constexpr (!Epi::AFTER_DRAIN) { E(acc, cur, wr, wc, fr, fq); S.done(cur); }
        if (!has_next) break;
#pragma unroll
        for (int a = 0; a < 2; ++a)
#pragma unroll
            for (int b = 0; b < 2; ++b)
#pragma unroll
                for (int m = 0; m < 4; ++m)
#pragma unroll
                    for (int n = 0; n < 2; ++n) acc[a][b][m][n] = (f32x4){0.f, 0.f, 0.f, 0.f};
        cur = nxt; cA = nA; cB = nB; ++ui;
        if constexpr (ALIGN_EPI) { if (wr == 1) PG8_BAR; }
    }
    PG8_WAIT_V(0);
    if constexpr (!ALIGN_EPI) { if (wr == 0) PG8_BAR; }
    PG8_BAR;
    if constexpr (Epi::AFTER_DRAIN) { E.fused(acc, cur, wr, wc, fr, fq, lds, wid, lane); S.done(cur); }
#undef PG8_SA
#undef PG8_SB
#undef PG8_STAGE
#undef PG8_LDA
#undef PG8_LDB
#undef PG8_MMA
#undef PG8_WAIT_V
#undef PG8_WAIT_L
#undef PG8_BAR
#undef PG8_SCHED
}
}

constexpr int NWAVES = 8, NTHREADS = NWAVES * 64;
constexpr int BATCH = 8, SEQ = 4096, D = 1024, M = BATCH * SEQ;
constexpr int POOLW = 512, QW = 512, NG = 2, HD = 64, NBG = BATCH * NG;
constexpr int IN_COLS = 3864, NIN = 4096;
constexpr int NCMP = 255, NCMP_PAD = 256, NSEL = 64;
constexpr int PH = 8, PK = 128, PTOP = 16, PQD = 256, PQW = PH * PQD;
constexpr int NEXP = PK * PK;
constexpr float EPS = 1e-6f;
enum { I_X = 0, I_C, I_RELB, I_ADAW, I_ADAB, I_N1G, I_N2G, I_WIN, I_POOLW, I_POOLS, I_CPEK, I_CW1K, I_CW2K, I_CPEV, I_CW1V, I_CW2V, I_QNG, I_KNG, I_WBP, I_WBA, I_WOUT, I_PWQ, I_PSK, I_PU, I_PV, N_IN };

constexpr size_t MiB = 1u << 20, KiB = 1u << 10;
constexpr size_t WS_CTL = 0, CTL_ZERO_BYTES = 1 * MiB;
constexpr size_t WS_ADA = 1 * MiB;
constexpr size_t WS_CB1K = 64 * KiB;
constexpr size_t WS_CB1V = WS_CB1K + 1 * KiB;
constexpr size_t WS_BIASL = WS_ADA + 256 * KiB;
constexpr size_t WS_WIN_T = 2 * MiB;
constexpr size_t WS_WEFF_T = 10 * MiB;
constexpr size_t WS_WBA_T = 11 * MiB;
constexpr size_t WS_WOUT_T = 12 * MiB;
constexpr size_t WS_WQ_T = 14 * MiB;
constexpr size_t WS_SUBK = 18 * MiB;
constexpr size_t WS_CW1K_T = 18 * MiB + 512 * KiB;
constexpr size_t WS_CW1V_T = 19 * MiB;
constexpr size_t WS_CW2K_T = 19 * MiB + 512 * KiB;
constexpr size_t WS_CW2V_T = WS_CW2K_T + 64 * KiB;
constexpr size_t WS_KC = 20 * MiB;
constexpr size_t WS_VCT = 20 * MiB + 512 * KiB;
constexpr size_t WS_GATE = 21 * MiB;
constexpr size_t WS_UB = 24 * MiB;
constexpr size_t WS_VB = 56 * MiB;
constexpr size_t WS_SCLU = WS_UB + 16 * MiB, WS_SCLV = WS_SCLU + 64 * KiB;
constexpr size_t WS_H = 88 * MiB;
constexpr size_t WS_ZP = 152 * MiB;
constexpr size_t WS_Q = 184 * MiB;
constexpr size_t WS_KCR = 216 * MiB;
constexpr size_t WS_VCR = 225 * MiB;
constexpr size_t WS_KS = 234 * MiB, WS_VS = 242 * MiB, WS_KW = 250 * MiB, WS_VW = 258 * MiB;
constexpr size_t WS_VST = 266 * MiB, WS_VWT = 274 * MiB;
constexpr size_t WS_PL = 282 * MiB;
constexpr size_t WS_YA = 314 * MiB;
constexpr size_t WS_GM = 346 * MiB;
constexpr size_t WS_MIX = WS_ZP;
constexpr size_t WS_QV = WS_GM;
constexpr size_t WS_EID = WS_PL;
constexpr size_t WS_GW = WS_PL + 16 * MiB;
constexpr size_t WS_PART = WS_GM;
constexpr size_t WS_CF = WS_YA;
constexpr size_t WS_CFS = WS_YA + 8 * MiB;
constexpr size_t WS_H8 = WS_ZP;
constexpr size_t WS_HS = WS_ZP + 32 * MiB;
constexpr size_t WS_X1 = WS_KCR;
constexpr size_t WS_END = 474 * MiB;
constexpr int CW_TMO = 0, CW_CODE = 1, CW_BAR = 4096;

constexpr int RING_OFF = 0, RING_BYTES = 131072;
constexpr int LDSCTL_OFF = RING_BYTES, MISC_OFF = LDSCTL_OFF + 320;
constexpr int LDS_BYTES = 147456;

#define GAS __attribute__((address_space(1)))
#define LAS __attribute__((address_space(3)))
typedef unsigned short bf16;
typedef unsigned v4u __attribute__((ext_vector_type(4)));
typedef unsigned v2u __attribute__((ext_vector_type(2)));
typedef int v2i __attribute__((ext_vector_type(2)));
typedef float f32x4 __attribute__((ext_vector_type(4)));
typedef short bf16x8 __attribute__((ext_vector_type(8)));
typedef GAS unsigned gu32;
#define RLX_AGENT __ATOMIC_RELAXED, __HIP_MEMORY_SCOPE_AGENT
#define LDS_WAIT() asm volatile("s_waitcnt lgkmcnt(0)" ::: "memory")
#define VM_WAIT() asm volatile("s_waitcnt vmcnt(0)" ::: "memory")
__device__ __forceinline__ unsigned f2bf(float f) { unsigned u = __builtin_bit_cast(unsigned, f); return (u + 0x7fffu + ((u >> 16) & 1u)) >> 16; }
__device__ __forceinline__ unsigned pk2(float lo, float hi) { return f2bf(lo) | (f2bf(hi) << 16); }
__device__ __forceinline__ float bflo(unsigned w) { return __builtin_bit_cast(float, w << 16); }
__device__ __forceinline__ float bfhi(unsigned w) { return __builtin_bit_cast(float, w & 0xffff0000u); }
__device__ __forceinline__ float sigmoidf_(float v) { return __builtin_amdgcn_rcpf(1.0f + __builtin_amdgcn_exp2f(v * -1.4426950408889634f)); }
typedef __bf16 bf16x2_hw __attribute__((ext_vector_type(2)));
typedef float f32x2_hw __attribute__((ext_vector_type(2)));
__device__ __forceinline__ unsigned pkh(float lo, float hi) { return __builtin_bit_cast(unsigned, __builtin_convertvector((f32x2_hw){lo, hi}, bf16x2_hw)); }
__device__ __forceinline__ float gelu_tanh_safe(float v) { const float u = 0.7978845608028654f * (v + 0.044715f * v * v * v); return 0.5f * v * (1.0f + tanhf(u)); }
template <int CTRL> __device__ __forceinline__ float dppf(float v) { return __builtin_bit_cast(float, __builtin_amdgcn_update_dpp(0, __builtin_bit_cast(int, v), CTRL, 0xF, 0xF, true)); }
template <int CTRL> __device__ __forceinline__ int dppi(int v) { return __builtin_amdgcn_update_dpp(0, v, CTRL, 0xF, 0xF, true); }
#define DPP_XOR1 0xB1
#define DPP_XOR2 0x4E
#define DPP_HMIR 0x141
#define DPP_ROR8 0x128
__device__ __forceinline__ void swap16_(float& a, float& b) { asm volatile("v_nop\n\tv_nop\n\tv_permlane16_swap_b32 %0, %1" : "+v"(a), "+v"(b)); }
__device__ __forceinline__ void swap32_(float& a, float& b) { asm volatile("v_nop\n\tv_nop\n\tv_permlane32_swap_b32 %0, %1" : "+v"(a), "+v"(b)); }
__device__ __forceinline__ float sum_xor16(float v) { float a = v, b = v; swap16_(a, b); return a + b; }
__device__ __forceinline__ float sum_xor32(float v) { float a = v, b = v; swap32_(a, b); return a + b; }
__device__ __forceinline__ float max_xor16(float v) { float a = v, b = v; swap16_(a, b); return fmaxf(a, b); }
__device__ __forceinline__ float max_xor32(float v) { float a = v, b = v; swap32_(a, b); return fmaxf(a, b); }
__device__ __forceinline__ float wave_sum(float v) {
    v += dppf<DPP_XOR1>(v); v += dppf<DPP_XOR2>(v); v += dppf<DPP_HMIR>(v); v += dppf<DPP_ROR8>(v);
    return sum_xor32(sum_xor16(v));
}
__device__ __forceinline__ float wave_max(float v) {
    v = fmaxf(v, dppf<DPP_XOR1>(v)); v = fmaxf(v, dppf<DPP_XOR2>(v)); v = fmaxf(v, dppf<DPP_HMIR>(v)); v = fmaxf(v, dppf<DPP_ROR8>(v));
    return max_xor32(max_xor16(v));
}

#define XB_TMO      128
#define XB_XCNT(j)  (256  + 64 * (j))
#define XB_XSUB(j)  (1280 + 64 * (j))
#define XB_XGEN(j)  (2304 + 64 * (j))
#define XB_TOP      3328
#define XB_TOPGEN   3392
#define XCD_BAR_WORDS 3456
#define XB_SPIN_CAP (1u << 18)
__device__ __forceinline__ unsigned xb_ld(unsigned* p)              { return __hip_atomic_load(p, __ATOMIC_RELAXED, __HIP_MEMORY_SCOPE_AGENT); }
__device__ __forceinline__ unsigned xb_add(unsigned* p, unsigned v) { return __hip_atomic_fetch_add(p, v, __ATOMIC_RELAXED, __HIP_MEMORY_SCOPE_AGENT); }
__device__ __forceinline__ unsigned xb_xcc_id() { return (unsigned)__builtin_amdgcn_s_getreg((3 << 11) | 20) & 0xFu; }
#define XB_SPIN(cond, bar) do { unsigned _sp = 0; while (cond) { __builtin_amdgcn_s_sleep(1); \
    if ((++_sp & 255u) == 0u) { if (xb_ld(&(bar)[XB_TMO])) break; if (_sp > XB_SPIN_CAP) { atomicAdd(&(bar)[XB_TMO], 1u); break; } } } } while (0)
struct XcdBarrier { unsigned* bar; unsigned x; volatile LAS unsigned* st; };
__device__ __forceinline__ XcdBarrier xcd_barrier_post(unsigned* bar, volatile LAS unsigned* st) {
    XcdBarrier b; b.bar = bar; b.x = xb_xcc_id(); b.st = st;
    if (threadIdx.x == 0) (void)xb_add(&bar[XB_XCNT(b.x)], 1u);
    return b;
}
__device__ __forceinline__ void xcd_barrier_complete(unsigned* bar, unsigned x, unsigned& nloc, unsigned& nx) {
    const unsigned G = gridDim.x * gridDim.y * gridDim.z;
    unsigned sum, cnt, mine, sp = 0u;
    for (;;) {
        sum = 0u; cnt = 0u; mine = 0u;
#pragma unroll
        for (unsigned j = 0; j < 16; ++j) { const unsigned c = xb_ld(&bar[XB_XCNT(j)]); sum += c; cnt += (c > 0u) ? 1u : 0u; mine = (j == x) ? c : mine; }
        if (sum == G) break;
        __builtin_amdgcn_s_sleep(1);
        if ((++sp & 255u) == 0u) { if (xb_ld(&bar[XB_TMO])) break; if (sp > XB_SPIN_CAP) { atomicAdd(&bar[XB_TMO], 1u); break; } }
    }
    nloc = mine > 0u ? mine : 1u; nx = cnt > 0u ? cnt : 1u;
}
__device__ __forceinline__ void xcd_barrier(const XcdBarrier& b) {
    asm volatile("s_waitcnt vmcnt(0)" ::: "memory");
    __syncthreads();
    if (threadIdx.x == 0) {
        unsigned* bar = b.bar;
        __builtin_amdgcn_s_waitcnt(0);
        unsigned nloc = b.st[0], nx = b.st[1];
        if (nloc == 0u) { xcd_barrier_complete(bar, b.x, nloc, nx); b.st[0] = nloc; b.st[1] = nx; }
        const unsigned old = xb_add(&bar[XB_XSUB(b.x)], 1u);
        const unsigned gen = old / nloc;
        if (old + 1u == (gen + 1u) * nloc) {
            __builtin_amdgcn_fence(__ATOMIC_RELEASE, "agent");
            asm volatile("s_waitcnt vmcnt(0)" ::: "memory");
            const unsigned og = xb_add(&bar[XB_TOP], 1u);
            const unsigned tg = og / nx;
            if (og + 1u == (tg + 1u) * nx) xb_add(&bar[XB_TOPGEN], 1u);
            else XB_SPIN(xb_ld(&bar[XB_TOPGEN]) == tg, bar);
            __builtin_amdgcn_fence(__ATOMIC_ACQUIRE, "agent");
            xb_add(&bar[XB_XGEN(b.x)], 1u);
            asm volatile("s_waitcnt vmcnt(0)" ::: "memory");
        } else {
            XB_SPIN(xb_ld(&bar[XB_XGEN(b.x)]) == gen, bar);
            __builtin_amdgcn_fence(__ATOMIC_ACQUIRE, "agent");
            asm volatile("s_waitcnt vmcnt(0)" ::: "memory");
        }
    }
    __syncthreads();
}

struct Args { const float* in[N_IN]; float* out; unsigned char* ws; int ph_lo, ph_hi, li, pad; };
struct Frame {
    LAS unsigned char* lds;
    volatile LAS unsigned* MISC;
    gu32* ctl;
    int tid, lane, wave, G, bid;
    unsigned char* ws;
};

template <bool I8> __device__ __forceinline__ void cvt_row_store(const f32x4 (&v)[4], int row, unsigned char* dst, float* inv_scale, int lane) {
    float m = 0.f;
#pragma unroll
    for (int j = 0; j < 4; ++j) m = fmaxf(m, fmaxf(fmaxf(fabsf(v[j].x), fabsf(v[j].y)), fmaxf(fabsf(v[j].z), fabsf(v[j].w))));
    m = wave_max(m);
    unsigned ww[4]; float isc;
    if (I8) { const float sc = m > 0.f ? 127.0f / m : 0.f; isc = m * (1.0f / 127.0f);
#pragma unroll
        for (int j = 0; j < 4; ++j) { const int q0 = (int)rintf(v[j].x * sc), q1 = (int)rintf(v[j].y * sc), q2 = (int)rintf(v[j].z * sc), q3 = (int)rintf(v[j].w * sc);
            ww[j] = ((unsigned)q0 & 0xffu) | (((unsigned)q1 & 0xffu) << 8) | (((unsigned)q2 & 0xffu) << 16) | (((unsigned)q3 & 0xffu) << 24); } }
    else { const unsigned E = (__builtin_bit_cast(unsigned, m) >> 23) & 0xffu; float sc = 1.f; isc = 1.f;
        if (E >= 8u && E <= 250u) { sc = __builtin_bit_cast(float, (261u - E) << 23); isc = __builtin_bit_cast(float, (E - 7u) << 23); }
#pragma unroll
        for (int j = 0; j < 4; ++j) { int t = __builtin_amdgcn_cvt_pk_fp8_f32(v[j].x * sc, v[j].y * sc, 0, false); t = __builtin_amdgcn_cvt_pk_fp8_f32(v[j].z * sc, v[j].w * sc, t, true); ww[j] = (unsigned)t; } }
    *(GAS v4u*)(dst + (size_t)(lane >> 3) * NEXP * 128 + (size_t)row * 128 + 16 * (lane & 7)) = (v4u){ww[0], ww[1], ww[2], ww[3]};
    if (lane == 0) inv_scale[row] = isc;
}
template <bool I8> __device__ __forceinline__ void cvt_rows_8bit(const float* src, unsigned char* dst, float* inv_scale, int gw, int NGW, int lane) {
    for (int row = gw; row < NEXP; row += 2 * NGW) {
        const int row1 = row + NGW; const bool has1 = row1 < NEXP;
        f32x4 v0[4], v1[4];
#pragma unroll
        for (int j = 0; j < 4; ++j) v0[j] = *(const GAS f32x4*)(src + (size_t)row * D + 16 * lane + 4 * j);
#pragma unroll
        for (int j = 0; j < 4; ++j) v1[j] = has1 ? *(const GAS f32x4*)(src + (size_t)row1 * D + 16 * lane + 4 * j) : (f32x4){0.f, 0.f, 0.f, 0.f};
        cvt_row_store<I8>(v0, row, dst, inv_scale, lane);
        if (has1) cvt_row_store<I8>(v1, row1, dst, inv_scale, lane);
    }
}
__device__ __forceinline__ void p0_transpose_item(const float* W, int ldw, int src_col0, int valid, int K, bf16* WT, int dst_row0, int k0, LAS float* scr, int lane, int ldt = -1) {
    if (ldt < 0) ldt = K;
    const int n_ = lane & 31;
#pragma unroll 8
    for (int i = 0; i < 32; ++i) { const int kk = 2 * i + (lane >> 5); scr[kk * 33 + n_] = (n_ < valid) ? W[(size_t)(k0 + kk) * ldw + src_col0 + n_] : 0.f; }
    LDS_WAIT(); asm volatile("" ::: "memory");
    const int c = lane & 7;
#pragma unroll
    for (int j = 0; j < 4; ++j) { const int n = (lane >> 3) + 8 * j; const LAS float* s = scr + (8 * c) * 33 + n;
        v4u o; o.x = pk2(s[0 * 33], s[1 * 33]); o.y = pk2(s[2 * 33], s[3 * 33]); o.z = pk2(s[4 * 33], s[5 * 33]); o.w = pk2(s[6 * 33], s[7 * 33]);
        *(GAS v4u*)(WT + (size_t)(dst_row0 + n) * ldt + k0 + 8 * c) = o; }
    LDS_WAIT(); asm volatile("" ::: "memory");
}
__device__ __forceinline__ bool p0_mat(int& r, const float* W, int K, int N, bf16* WT, LAS float* scr, int lane, int ldt = -1) {
    const int ng = N / 32, items = ng * (K / 64);
    if (r < items) { const int kb = r / ng, nb = r % ng; p0_transpose_item(W, N, 32 * nb, 32, K, WT, 32 * nb, 64 * kb, scr, lane, ldt); return true; }
    r -= items; return false;
}
__device__ __forceinline__ void cvt_f32_bf16_stream(const float* src, bf16* dst, size_t n8, size_t gtid, size_t gthreads) {
    for (size_t i = gtid; i < n8; i += gthreads) {
        const f32x4 a = *(const GAS f32x4*)(src + 8 * i), b = *(const GAS f32x4*)(src + 8 * i + 4);
        v4u o; o.x = pk2(a.x, a.y); o.y = pk2(a.z, a.w); o.z = pk2(b.x, b.y); o.w = pk2(b.z, b.w);
        *(GAS v4u*)(dst + 8 * i) = o; }
}

__device__ __forceinline__ void p0_prologue(Frame& F, const Args& args, bool do_bias = true) {
    unsigned char* ws = F.ws;
    const int gw = F.bid * NWAVES + F.wave, NGW = F.G * NWAVES;
    const size_t gtid = (size_t)F.bid * NTHREADS + F.tid, gthreads = (size_t)F.G * NTHREADS;
    {
        LAS float* sl = (LAS float*)(F.lds);
        LAS float* red = (LAS float*)(F.lds + 32768);
        const float* c = args.in[I_C];
        { f32x4 cv[4];
#pragma unroll
          for (int q = 0; q < 4; ++q) cv[q] = *(const GAS f32x4*)(c + 4 * (F.tid + NTHREADS * q));
#pragma unroll
          for (int q = 0; q < 4; ++q) { f32x4 o; o.x = cv[q].x / (1.0f + __expf(-cv[q].x)); o.y = cv[q].y / (1.0f + __expf(-cv[q].y)); o.z = cv[q].z / (1.0f + __expf(-cv[q].z)); o.w = cv[q].w / (1.0f + __expf(-cv[q].w));
              *(LAS f32x4*)(sl + 4 * (F.tid + NTHREADS * q)) = o; } }
        __syncthreads();
        for (int cb = F.bid; cb < 6 * D / 24; cb += F.G) {
            const int j0 = cb * 24;
            if (F.tid < 510) {
                const int kk = F.tid / 6, c4 = F.tid % 6;
                const float* w = args.in[I_ADAW] + j0 + 4 * c4;
                f32x4 wv[13];
#pragma unroll
                for (int m = 0; m < 13; ++m) { const int k = kk + 85 * m; wv[m] = (k < D) ? *(const GAS f32x4*)(w + (size_t)k * (6 * D)) : (f32x4){0.f, 0.f, 0.f, 0.f}; }
                f32x4 a[BATCH];
#pragma unroll
                for (int b = 0; b < BATCH; ++b) a[b] = (f32x4){0.f, 0.f, 0.f, 0.f};
#pragma unroll
                for (int m = 0; m < 13; ++m) { const int k = kk + 85 * m; const int kc = k < D ? k : 0;
#pragma unroll
                    for (int b = 0; b < BATCH; ++b) a[b] = a[b] + wv[m] * sl[b * D + kc]; }
#pragma unroll
                for (int b = 0; b < BATCH; ++b) { LAS float* rp = red + (kk * 24 + 4 * c4) * BATCH + b; rp[0] = a[b].x; rp[BATCH] = a[b].y; rp[2 * BATCH] = a[b].z; rp[3 * BATCH] = a[b].w; }
            }
            __syncthreads();
            if (F.tid < 24 * BATCH) { const int jj = F.tid / BATCH, b = F.tid % BATCH; float s = 0.f;
#pragma unroll 5
                for (int kk = 0; kk < 85; ++kk) s += red[(kk * 24 + jj) * BATCH + b];
                ((float*)(ws + WS_ADA))[b * (6 * D) + j0 + jj] = s + args.in[I_ADAB][j0 + jj]; }
            __syncthreads();
        }
    }
    if (F.bid >= 8 && F.bid < 40 && do_bias) {
        const int bb = F.bid - 8, kv = bb & 1, ch = bb >> 1;
        const float* pe = args.in[kv == 0 ? I_CPEK : I_CPEV]; const float* w1 = args.in[kv == 0 ? I_CW1K : I_CW1V];
        LAS float* red = (LAS float*)(F.lds);
        const int j = F.tid & 127, ic = F.tid >> 7; float s = 0.f;
        const int i0 = ch * 128 + ic * 32;
#pragma unroll 8
        for (int i = i0; i < i0 + 32; ++i) s += pe[i] * w1[(size_t)i * 128 + j];
        red[ic * 128 + j] = s; __syncthreads();
        if (F.tid < 128) atomicAdd((float*)(ws + (kv == 0 ? WS_CB1K : WS_CB1V)) + F.tid, (red[F.tid] + red[128 + F.tid]) + (red[256 + F.tid] + red[384 + F.tid]));
        __syncthreads();
    } else if (F.bid == 2) {
        for (int i = F.tid; i < 8 * 128; i += NTHREADS) { const int h = i >> 7, rel = i & 127;
            int bk = rel;
            if (rel >= 16) bk = 16 + (rel >= 19) + (rel >= 21) + (rel >= 24) + (rel >= 27) + (rel >= 31) + (rel >= 35) + (rel >= 40) + (rel >= 46) + (rel >= 52) + (rel >= 59) + (rel >= 67) + (rel >= 77) + (rel >= 87) + (rel >= 99) + (rel >= 113);
            ((float*)(ws + WS_BIASL))[i] = args.in[I_RELB][bk * 8 + h]; }
        if (F.tid < 64) {
            float mq = fabsf(args.in[I_QNG][F.tid]), mk = fmaxf(fmaxf(fabsf(args.in[I_KNG][F.tid]), fabsf(args.in[I_KNG][64 + F.tid])), fabsf(args.in[I_KNG][128 + F.tid]));
            float mb = fmaxf(fmaxf(fabsf(args.in[I_RELB][F.tid]), fabsf(args.in[I_RELB][64 + F.tid])), fmaxf(fabsf(args.in[I_RELB][128 + F.tid]), fabsf(args.in[I_RELB][192 + F.tid])));
            mq = wave_max(mq); mk = wave_max(mk); mb = wave_max(mb);
            if (F.tid == 0) ((float*)(ws + WS_BIASL))[8 * 128] = 8.0f * mq * mk + mb; }
    }
    {
        const float* pw = args.in[I_POOLW]; const float* ps = args.in[I_POOLS]; const float* wbp = args.in[I_WBP];
        bf16* weff = (bf16*)(ws + WS_WEFF_T);
        LAS float* PWl = (LAS float*)(F.lds);
        LAS float* WBl = (LAS float*)(F.lds + 128 * 129 * 4);
        __syncthreads();
        for (int bb = F.bid; bb < 256; bb += F.G) {
            const int g = bb >> 6, d0 = (bb & 63) * 16;
            { f32x4 t[8];
#pragma unroll
              for (int q = 0; q < 8; ++q) t[q] = *(const GAS f32x4*)(pw + (size_t)g * 16384 + 4 * (F.tid + NTHREADS * q));
#pragma unroll
              for (int q = 0; q < 8; ++q) { const int i = 4 * (F.tid + NTHREADS * q); LAS float* d = PWl + (i >> 7) * 129 + (i & 127); d[0] = t[q].x; d[1] = t[q].y; d[2] = t[q].z; d[3] = t[q].w; }
              const int cc = F.tid >> 2, d4 = (F.tid & 3) * 4;
              const f32x4 wv = *(const GAS f32x4*)(wbp + (size_t)(g * 128 + cc) * D + d0 + d4); const float pv = ps[g * 128 + cc];
              LAS float* d = WBl + cc * 17 + d4; d[0] = wv.x * pv; d[1] = wv.y * pv; d[2] = wv.z * pv; d[3] = wv.w * pv; }
            __syncthreads();
            const int c = F.tid & 127, q = F.tid >> 7;
            float acc4[4] = {0.f, 0.f, 0.f, 0.f};
#pragma unroll 4
            for (int cc = 0; cc < 128; ++cc) { const float a = PWl[c * 129 + cc];
#pragma unroll
                for (int e = 0; e < 4; ++e) acc4[e] += a * WBl[cc * 17 + 4 * q + e]; }
#pragma unroll
            for (int e = 0; e < 4; ++e) weff[(size_t)(d0 + 4 * q + e) * 1024 + g * 128 + c] = (bf16)f2bf(acc4[e]);
            __syncthreads();
        }
    }
    {
        const float* wq = args.in[I_PWQ]; const float* sk = args.in[I_PSK]; bf16* wf = (bf16*)(ws + WS_WQ_T);
        const int l15 = F.lane & 15, lq = F.lane >> 4;
        for (int bb = F.bid; bb < 256; bb += F.G) {
            const int hp = bb >> 4, kg = bb & 15;
            bf16x8 bfr[4];
#pragma unroll
            for (int ks = 0; ks < 4; ++ks) { const float* sp = sk + ((size_t)hp * 128 + 16 * F.wave + l15) * 128 + 32 * ks + 8 * lq;
                const f32x4 s0 = *(const GAS f32x4*)sp, s1 = *(const GAS f32x4*)(sp + 4);
                bfr[ks] = __builtin_bit_cast(bf16x8, (v4u){pkh(s0.x, s0.y), pkh(s0.z, s0.w), pkh(s1.x, s1.y), pkh(s1.z, s1.w)}); }
#pragma unroll
            for (int cb = 0; cb < 4; ++cb) {
                pg8::f32x4 acc = (pg8::f32x4){0.f, 0.f, 0.f, 0.f};
#pragma unroll
                for (int ks = 0; ks < 4; ++ks) { const float* ap = wq + (size_t)(64 * kg + 16 * cb + l15) * PQW + hp * 128 + 32 * ks + 8 * lq;
                    const f32x4 a0 = *(const GAS f32x4*)ap, a1 = *(const GAS f32x4*)(ap + 4);
                    const bf16x8 af = __builtin_bit_cast(bf16x8, (v4u){pkh(a0.x, a0.y), pkh(a0.z, a0.w), pkh(a1.x, a1.y), pkh(a1.z, a1.w)});
                    acc = __builtin_amdgcn_mfma_f32_16x16x32_bf16(af, bfr[ks], acc, 0, 0, 0); }
                v2u o; o.x = pkh(acc[0], acc[1]); o.y = pkh(acc[2], acc[3]);
                *(GAS v2u*)(wf + (size_t)(hp * 128 + 16 * F.wave + l15) * D + 64 * kg + 16 * cb + 4 * lq) = o; }
        }
    }
}
template <int SEG> __device__ __forceinline__ void p0_stream_seg(Frame& F, const Args& args) {
    unsigned char* ws = F.ws;
    const int gw = F.bid * NWAVES + F.wave, NGW = F.G * NWAVES;
    if (SEG == 0) {
        {
            LAS float* scr = (LAS float*)(F.lds + F.wave * 16384);
            constexpr int I_WINT = (NIN / 32) * (D / 64);
            constexpr int NITEMS = I_WINT + (1024 / 32) * (512 / 64) + (1024 / 32) * (1024 / 64) + 2 * (128 / 32) * (2048 / 64) + 2 * (64 / 32) * (128 / 64);
            for (int it = gw; it < NITEMS; it += NGW) {
                int r = it;
                if (r < I_WINT) {
                    const int grp = r % (NIN / 32), kb = r / (NIN / 32);
                    const int tile = grp >> 3, ct0 = (grp & 7) * 32;
                    const int L0 = 64 * ((ct0 >> 5) & 3) + 32 * (ct0 >> 7);
                    int src0, valid = 32;
                    if (tile < 7) src0 = 256 * tile + L0; else if (tile < 15) src0 = 1816 + 256 * (tile - 7) + L0; else { src0 = 1792 + L0; valid = (L0 == 0) ? 24 : 0; }
                    if (valid == 0) src0 = 0;
                    p0_transpose_item(args.in[I_WIN], IN_COLS, src0, valid, D, (bf16*)(ws + WS_WIN_T), 32 * grp, 64 * kb, scr, F.lane);
                    continue; }
                r -= I_WINT;
                if (p0_mat(r, args.in[I_WBA], 512, 1024, (bf16*)(ws + WS_WEFF_T) + 512, scr, F.lane, 1024)) continue;
                if (p0_mat(r, args.in[I_WOUT], 1024, 1024, (bf16*)(ws + WS_WOUT_T), scr, F.lane)) continue;
                if (p0_mat(r, args.in[I_CW1K], 2048, 128, (bf16*)(ws + WS_CW1K_T), scr, F.lane)) continue;
                if (p0_mat(r, args.in[I_CW1V], 2048, 128, (bf16*)(ws + WS_CW1V_T), scr, F.lane)) continue;
                if (p0_mat(r, args.in[I_CW2K], 128, 64, (bf16*)(ws + WS_CW2K_T), scr, F.lane)) continue;
                p0_mat(r, args.in[I_CW2V], 128, 64, (bf16*)(ws + WS_CW2V_T), scr, F.lane);
            }
        }
    }
    if (SEG == 1) cvt_rows_8bit<true>(args.in[I_PU], ws + WS_UB, (float*)(ws + WS_SCLU), gw, NGW, F.lane);
    if (SEG == 2) cvt_rows_8bit<false>(args.in[I_PV], ws + WS_VB, (float*)(ws + WS_SCLV), gw, NGW, F.lane);
}

template <bool Q8> __device__ __forceinline__ void modnorm_rows(Frame& F, const void* xin, const float* g, const float* ada, int shift_idx, bf16* out) {
    const int gw = F.bid * NWAVES + F.wave, NGW = F.G * NWAVES;
    for (int m = gw; m < M; m += NGW) {
        const int b = m >> 12;
        const GAS f32x4* gr = (const GAS f32x4*)g + F.lane;
        const GAS f32x4* sh = (const GAS f32x4*)(ada + (size_t)b * 6 * D + shift_idx * D) + F.lane;
        const GAS f32x4* sc = (const GAS f32x4*)(ada + (size_t)b * 6 * D + (shift_idx + 1) * D) + F.lane;
        f32x4 v[4]; float s = 0.f;
#pragma unroll
        for (int j = 0; j < 4; ++j) {
            if (Q8) { const v2u xb = ((const GAS v2u*)((const bf16*)xin + (size_t)m * D))[F.lane + 64 * j]; v[j] = (f32x4){bflo(xb.x), bfhi(xb.x), bflo(xb.y), bfhi(xb.y)}; }
            else v[j] = ((const GAS f32x4*)((const float*)xin + (size_t)m * D))[F.lane + 64 * j];
            s += (v[j].x * v[j].x + v[j].y * v[j].y) + (v[j].z * v[j].z + v[j].w * v[j].w); }
        const float rstd = rsqrtf(wave_sum(s) * (1.f / D) + EPS);
        GAS v2u* o8 = (GAS v2u*)(out + (size_t)m * D) + F.lane;
        float mx = 0.f;
#pragma unroll
        for (int j = 0; j < 4; ++j) { const f32x4 gg = gr[64 * j], ss = sh[64 * j], cc = sc[64 * j];
            const f32x4 y = (v[j] * rstd) * gg * (cc + 1.0f) + ss; v[j] = y;
            mx = fmaxf(mx, fmaxf(fmaxf(fabsf(y.x), fabsf(y.y)), fmaxf(fabsf(y.z), fabsf(y.w))));
            v2u o; o.x = pk2(y.x, y.y); o.y = pk2(y.z, y.w); o8[64 * j] = o; }
        if (Q8) {
            mx = wave_max(mx);
            const float qs = mx > 0.f ? 127.0f / mx : 0.f;
            GAS unsigned* h8 = (GAS unsigned*)(F.ws + WS_H8 + (size_t)m * D) + F.lane;
#pragma unroll
            for (int j = 0; j < 4; ++j) { const int q0 = (int)rintf(v[j].x * qs), q1 = (int)rintf(v[j].y * qs), q2 = (int)rintf(v[j].z * qs), q3 = (int)rintf(v[j].w * qs);
                h8[64 * j] = ((unsigned)q0 & 0xffu) | (((unsigned)q1 & 0xffu) << 8) | (((unsigned)q2 & 0xffu) << 16) | (((unsigned)q3 & 0xffu) << 24); }
            if (F.lane == 0) ((float*)(F.ws + WS_HS))[m] = mx * (1.0f / 127.0f);
        }
    }
}

struct EpiIn {
    static constexpr bool PERM = true, AFTER_DRAIN = false, MID = false;
    unsigned char* ws; const float* qg; const float* kg; const volatile LAS unsigned* rmp;
    __device__ __forceinline__ void operator()(const pg8::f32x4 (&acc)[2][2][4][2], const pg8::Unit& u, int wr, int wc, int fr, int fq) const {
        const int pn = u.pn, rmask = __builtin_amdgcn_readfirstlane((int)*rmp);
#pragma unroll
        for (int ai = 0; ai < 2; ++ai)
#pragma unroll
            for (int m = 0; m < 4; ++m) {
                const int row = (u.pm & rmask) * 256 + ai * 128 + wr * 64 + m * 16 + fr;
                float v[2][8];
#pragma unroll
                for (int bj = 0; bj < 2; ++bj)
#pragma unroll
                    for (int n = 0; n < 2; ++n)
#pragma unroll
                        for (int i = 0; i < 4; ++i) v[bj][4 * n + i] = acc[ai][bj][m][n][i];
                bf16* dst = nullptr; bool norm = false; const float* gain = nullptr; float mul = 1.f; bool sig = false;
                if (pn < 2) { dst = (bf16*)(ws + WS_ZP) + (size_t)row * 512 + 256 * pn + 64 * wc; }
                else if (pn < 4) { dst = (bf16*)(ws + WS_Q) + (size_t)row * 512 + 256 * (pn - 2) + 64 * wc; norm = true; gain = qg; mul = 0.125f * 1.4426950408889634f; }
                else if (pn < 7) { const int kind = pn - 4, isv = wc >> 1, g = wc & 1, b = row >> 12, t = row & 4095;
                    const size_t base = ((size_t)(b * 2 + g) * SEQ + t) * 64;
                    const size_t off = kind == 0 ? (isv ? WS_VCR : WS_KCR) : kind == 1 ? (isv ? WS_VS : WS_KS) : (isv ? WS_VW : WS_KW);
                    dst = (bf16*)(ws + off) + base; if (!isv && kind > 0) { norm = true; gain = kg + kind * 64; } }
                else if (pn < 15) { dst = (bf16*)(ws + WS_GM) + (size_t)row * 2048 + 256 * (pn - 7) + 64 * wc; sig = true; }
                else {
                    if (wc == 0 && fq < 3) { float* gp = (float*)(ws + WS_GATE) + (size_t)row * 24 + 8 * fq;
                        *(GAS f32x4*)gp = (f32x4){sigmoidf_(v[0][0]), sigmoidf_(v[0][1]), sigmoidf_(v[0][2]), sigmoidf_(v[0][3])};
                        *(GAS f32x4*)(gp + 4) = (f32x4){sigmoidf_(v[0][4]), sigmoidf_(v[0][5]), sigmoidf_(v[0][6]), sigmoidf_(v[0][7])}; }
                    continue; }
                if (norm) { float ss = 0.f;
#pragma unroll
                    for (int bj = 0; bj < 2; ++bj)
#pragma unroll
                        for (int e = 0; e < 8; ++e) ss += v[bj][e] * v[bj][e];
                    ss = sum_xor32(sum_xor16(ss));
                    const float rs = rsqrtf(ss * (1.f / 64.f) + EPS) * mul;
#pragma unroll
                    for (int bj = 0; bj < 2; ++bj)
#pragma unroll
                        for (int e = 0; e < 8; ++e) v[bj][e] = v[bj][e] * rs * gain[32 * bj + 8 * fq + e]; }
                if (sig) {
#pragma unroll
                    for (int bj = 0; bj < 2; ++bj)
#pragma unroll
                        for (int e = 0; e < 8; ++e) v[bj][e] = sigmoidf_(v[bj][e]); }
#pragma unroll
                for (int bj = 0; bj < 2; ++bj) { v4u o; o.x = pkh(v[bj][0], v[bj][1]); o.y = pkh(v[bj][2], v[bj][3]); o.z = pkh(v[bj][4], v[bj][5]); o.w = pkh(v[bj][6], v[bj][7]);
                    *(GAS v4u*)(dst + 32 * bj + 8 * fq) = o; }
            }
    }
};
template <bool ADD> struct EpiMix {
    static constexpr bool PERM = true, AFTER_DRAIN = false, MID = false;
    bf16* MIX; const bf16* GM; int gmoff;
    __device__ __forceinline__ void operator()(const pg8::f32x4 (&acc)[2][2][4][2], const pg8::Unit& u, int wr, int wc, int fr, int fq) const {
#pragma unroll
        for (int ai = 0; ai < 2; ++ai)
#pragma unroll
            for (int m = 0; m < 4; ++m) {
                const int row = u.pm * 256 + ai * 128 + wr * 64 + m * 16 + fr;
#pragma unroll
                for (int bj = 0; bj < 2; ++bj) {
                    const int col = u.pn * 256 + bj * 128 + wc * 32 + 8 * fq;
                    const v4u gmv = *(const GAS v4u*)(GM + (size_t)row * 2048 + gmoff + col);
                    float r[8];
                    r[0] = acc[ai][bj][m][0][0] * bflo(gmv.x); r[1] = acc[ai][bj][m][0][1] * bfhi(gmv.x); r[2] = acc[ai][bj][m][0][2] * bflo(gmv.y); r[3] = acc[ai][bj][m][0][3] * bfhi(gmv.y);
                    r[4] = acc[ai][bj][m][1][0] * bflo(gmv.z); r[5] = acc[ai][bj][m][1][1] * bfhi(gmv.z); r[6] = acc[ai][bj][m][1][2] * bflo(gmv.w); r[7] = acc[ai][bj][m][1][3] * bfhi(gmv.w);
                    GAS v4u* dp = (GAS v4u*)(MIX + (size_t)row * 1024 + col);
                    if (ADD) { const v4u old = *dp; r[0] += bflo(old.x); r[1] += bfhi(old.x); r[2] += bflo(old.y); r[3] += bfhi(old.y); r[4] += bflo(old.z); r[5] += bfhi(old.z); r[6] += bflo(old.w); r[7] += bfhi(old.w); }
                    v4u o; o.x = pkh(r[0], r[1]); o.y = pkh(r[2], r[3]); o.z = pkh(r[4], r[5]); o.w = pkh(r[6], r[7]); *dp = o; }
            }
    }
};
struct EpiMix2 {
    static constexpr bool PERM = true, AFTER_DRAIN = false, MID = true;
    bf16* MIX; const bf16* GM;
    __device__ __forceinline__ void mid(pg8::f32x4 (&acc)[2][2][4][2], const pg8::Unit& u, int wr, int wc, int fr, int fq) const {
#pragma unroll
        for (int ai = 0; ai < 2; ++ai)
#pragma unroll
            for (int m = 0; m < 4; ++m) {
                const int row = u.pm * 256 + ai * 128 + wr * 64 + m * 16 + fr;
#pragma unroll
                for (int bj = 0; bj < 2; ++bj) {
                    const int col = u.pn * 256 + bj * 128 + wc * 32 + 8 * fq;
                    const v4u g1 = *(const GAS v4u*)(GM + (size_t)row * 2048 + col), g2 = *(const GAS v4u*)(GM + (size_t)row * 2048 + 1024 + col);
                    const unsigned w1[4] = {g1.x, g1.y, g1.z, g1.w}, w2[4] = {g2.x, g2.y, g2.z, g2.w};
#pragma unroll
                    for (int n = 0; n < 2; ++n)
#pragma unroll
                        for (int i = 0; i < 4; ++i) { const unsigned a = w1[2 * n + (i >> 1)], b = w2[2 * n + (i >> 1)];
                            const float ga = (i & 1) ? bfhi(a) : bflo(a), gb = fmaxf((i & 1) ? bfhi(b) : bflo(b), 9.5367431640625e-07f);
                            acc[ai][bj][m][n][i] *= ga * __builtin_amdgcn_rcpf(gb); } }
            }
    }
    __device__ __forceinline__ void operator()(const pg8::f32x4 (&acc)[2][2][4][2], const pg8::Unit& u, int wr, int wc, int fr, int fq) const {
#pragma unroll
        for (int ai = 0; ai < 2; ++ai)
#pragma unroll
            for (int m = 0; m < 4; ++m) {
                const int row = u.pm * 256 + ai * 128 + wr * 64 + m * 16 + fr;
#pragma unroll
                for (int bj = 0; bj < 2; ++bj) {
                    const int col = u.pn * 256 + bj * 128 + wc * 32 + 8 * fq;
                    const v4u g2 = *(const GAS v4u*)(GM + (size_t)row * 2048 + 1024 + col);
                    const unsigned w2[4] = {g2.x, g2.y, g2.z, g2.w};
                    float r[8];
#pragma unroll
                    for (int n = 0; n < 2; ++n)
#pragma unroll
                        for (int i = 0; i < 4; ++i) { const unsigned b = w2[2 * n + (i >> 1)];
                            r[4 * n + i] = acc[ai][bj][m][n][i] * fmaxf((i & 1) ? bfhi(b) : bflo(b), 9.5367431640625e-07f); }
                    v4u o; o.x = pkh(r[0], r[1]); o.y = pkh(r[2], r[3]); o.z = pkh(r[4], r[5]); o.w = pkh(r[6], r[7]);
                    *(GAS v4u*)(MIX + (size_t)row * 1024 + col) = o; }
            }
    }
};
struct EpiRes {
    static constexpr bool PERM = true, AFTER_DRAIN = false, MID = false;
    const float* x; bf16* x1; const float* ada; int gate_idx;
    __device__ __forceinline__ void operator()(const pg8::f32x4 (&acc)[2][2][4][2], const pg8::Unit& u, int wr, int wc, int fr, int fq) const {
#pragma unroll
        for (int ai = 0; ai < 2; ++ai)
#pragma unroll
            for (int m = 0; m < 4; ++m) {
                const int row = u.pm * 256 + ai * 128 + wr * 64 + m * 16 + fr, b = row >> 12;
#pragma unroll
                for (int bj = 0; bj < 2; ++bj) {
                    const int col = u.pn * 256 + bj * 128 + wc * 32 + 8 * fq;
                    const float* gp = ada + (size_t)b * 6 * D + gate_idx * D + col; const float* xp = x + (size_t)row * D + col;
                    const f32x4 g0 = *(const GAS f32x4*)gp, g1 = *(const GAS f32x4*)(gp + 4), x0 = *(const GAS f32x4*)xp, x1v = *(const GAS f32x4*)(xp + 4);
                    const f32x4 r0 = x0 + g0 * acc[ai][bj][m][0], r1 = x1v + g1 * acc[ai][bj][m][1];
                    v4u o; o.x = pkh(r0.x, r0.y); o.y = pkh(r0.z, r0.w); o.z = pkh(r1.x, r1.y); o.w = pkh(r1.z, r1.w);
                    *(GAS v4u*)(x1 + (size_t)row * D + col) = o; }
            }
    }
};

template <int W> __device__ __forceinline__ void pool_load(const bf16* zp, int row, int t, int col, v4u (&z)[W]) {
#pragma unroll
    for (int j = 0; j < W; ++j) z[j] = (j <= t) ? *(const GAS v4u*)(zp + (size_t)(row - j) * 512 + col) : (v4u){0u, 0u, 0u, 0u};
}
template <int W> __device__ __forceinline__ v4u pool_reduce(const v4u (&z)[W], int t) {
    float s[8], self[8];
#pragma unroll
    for (int e = 0; e < 8; ++e) { s[e] = 0.f; self[e] = 0.f; }
#pragma unroll
    for (int j = 0; j < W; ++j) { const float f[8] = {bflo(z[j].x), bfhi(z[j].x), bflo(z[j].y), bfhi(z[j].y), bflo(z[j].z), bfhi(z[j].z), bflo(z[j].w), bfhi(z[j].w)};
#pragma unroll
        for (int e = 0; e < 8; ++e) { s[e] += f[e]; if (j == 0) self[e] = f[e]; } }
    const float inv = 1.0f / (float)((t + 1 < W) ? (t + 1) : W);
    v4u o; o.x = pk2(s[0] * inv - self[0], s[1] * inv - self[1]); o.y = pk2(s[2] * inv - self[2], s[3] * inv - self[3]);
    o.z = pk2(s[4] * inv - self[4], s[5] * inv - self[5]); o.w = pk2(s[6] * inv - self[6], s[7] * inv - self[7]);
    return o;
}
__device__ __forceinline__ void pool_phase(Frame& F) {
    const bf16* zp = (const bf16*)(F.ws + WS_ZP); bf16* pl = (bf16*)(F.ws + WS_PL);
    const int gw = F.bid * NWAVES + F.wave, NGW = F.G * NWAVES;
    for (int r4 = gw; r4 < M / 4; r4 += NGW) {
        const int row = 4 * r4 + (F.lane >> 4), t = row & 4095, c0 = 8 * (F.lane & 15);
        v4u z2[2], z4[4], z8[8], z16[16];
        pool_load<2>(zp, row, t, c0, z2); pool_load<4>(zp, row, t, 128 + c0, z4); pool_load<8>(zp, row, t, 256 + c0, z8); pool_load<16>(zp, row, t, 384 + c0, z16);
        const v4u o2 = pool_reduce<2>(z2, t), o4 = pool_reduce<4>(z4, t), o8 = pool_reduce<8>(z8, t), o16 = pool_reduce<16>(z16, t);
        GAS v4u* dst = (GAS v4u*)(pl + (size_t)row * 1024 + c0);
        dst[0] = o2; dst[16] = o4; dst[32] = o8; dst[48] = o16;
    }
}

typedef int v4i __attribute__((ext_vector_type(4)));
__device__ __forceinline__ unsigned pkf16(float a, float b) { return __builtin_bit_cast(unsigned, __builtin_amdgcn_cvt_pkrtz(a, b)); }
__device__ __forceinline__ float f16lo(unsigned w) { return (float)__builtin_bit_cast(_Float16, (unsigned short)(w & 0xffffu)); }
__device__ __forceinline__ float f16hi(unsigned w) { return (float)__builtin_bit_cast(_Float16, (unsigned short)(w >> 16)); }
struct EpiStoreBf16 {
    static constexpr bool PERM = true, AFTER_DRAIN = false, MID = false;
    bf16* O; int ldc;
    __device__ __forceinline__ void operator()(const pg8::f32x4 (&acc)[2][2][4][2], const pg8::Unit& u, int wr, int wc, int fr, int fq) const {
#pragma unroll
        for (int ai = 0; ai < 2; ++ai)
#pragma unroll
            for (int m = 0; m < 4; ++m) {
                const int row = u.pm * 256 + ai * 128 + wr * 64 + m * 16 + fr;
#pragma unroll
                for (int bj = 0; bj < 2; ++bj) {
                    const int col = u.pn * 256 + bj * 128 + wc * 32 + 8 * fq;
                    v4u o; o.x = pkf16(acc[ai][bj][m][0][0], acc[ai][bj][m][0][1]); o.y = pkf16(acc[ai][bj][m][0][2], acc[ai][bj][m][0][3]);
                    o.z = pkf16(acc[ai][bj][m][1][0], acc[ai][bj][m][1][1]); o.w = pkf16(acc[ai][bj][m][1][2], acc[ai][bj][m][1][3]);
                    *(GAS v4u*)(O + (size_t)row * ldc + col) = o; }
            }
    }
};

__device__ __forceinline__ unsigned fkey(float f) { const unsigned u = __builtin_bit_cast(unsigned, f); return (u >> 31) ? ~u : (u | 0x80000000u); }
__device__ __forceinline__ float funkey(unsigned k) { const unsigned u = (k >> 31) ? (k & 0x7fffffffu) : ~k; return __builtin_bit_cast(float, u); }
__device__ __forceinline__ unsigned umax_(unsigned a, unsigned b) { return a > b ? a : b; }
__device__ __forceinline__ unsigned umin_(unsigned a, unsigned b) { return a > b ? b : a; }
#define TOP16_INSERT(L, xin) do { unsigned _x = (xin); _Pragma("unroll") for (int _i = 0; _i < 16; ++_i) { const unsigned _h = umax_(L[_i], _x); _x = umin_(L[_i], _x); L[_i] = _h; } } while (0)
template <int MASK> __device__ __forceinline__ void top16_merge(unsigned (&L)[16]) {
    unsigned o[16];
#pragma unroll
    for (int i = 0; i < 16; ++i) o[i] = (unsigned)dppi<MASK == 1 ? DPP_XOR1 : DPP_XOR2>((int)L[i]);
#pragma unroll
    for (int i = 0; i < 16; ++i) L[i] = umax_(L[i], o[15 - i]);
#pragma unroll
    for (int d = 8; d >= 1; d >>= 1)
#pragma unroll
        for (int i = 0; i < 16; ++i) if ((i & d) == 0) { const unsigned hi = umax_(L[i], L[i + d]), lo = umin_(L[i], L[i + d]); L[i] = hi; L[i + d] = lo; }
}
#define CE_DESC(a_, b_) do { const unsigned _h = umax_(a_, b_), _l = umin_(a_, b_); a_ = _h; b_ = _l; } while (0)
template <int OFF> __device__ __forceinline__ void bitonic_sort16_desc(unsigned (&v)[32]) {
#pragma unroll
    for (int k = 2; k <= 16; k <<= 1)
#pragma unroll
        for (int j = k >> 1; j > 0; j >>= 1)
#pragma unroll
            for (int i = 0; i < 16; ++i) { const int l = i ^ j; if (l > i) { if ((i & k) == 0) CE_DESC(v[OFF + i], v[OFF + l]); else CE_DESC(v[OFF + l], v[OFF + i]); } }
}
__device__ __forceinline__ void bitonic_merge16_desc(unsigned (&L)[16]) {
#pragma unroll
    for (int d = 8; d >= 1; d >>= 1)
#pragma unroll
        for (int i = 0; i < 16; ++i) if ((i & d) == 0) CE_DESC(L[i], L[i + d]);
}
constexpr int SST = 132;
constexpr int P9_LIST_OFF = 2 * 64 * SST * 4;
__device__ __forceinline__ void peer_select_phase(Frame& F) {
    const unsigned short* S16 = (const unsigned short*)(F.ws + WS_QV);
    int* EID = (int*)(F.ws + WS_EID); float* GW = (float*)(F.ws + WS_GW);
    LAS unsigned* LIST = (LAS unsigned*)(F.lds + P9_LIST_OFF);
    const int lane = F.lane, w = F.wave;
    constexpr int NU = (M / 64) * PH;
    const int row = F.tid >> 2, sub = F.tid & 3, p1 = row >> 6, tk1 = row & 63;
    v4u sn[4], sm[4];
#define P9_LOAD(dst_, u_) do { const int _tt = (u_) >> 3, _h = (u_) & 7; const unsigned short* sp_ = S16 + (size_t)(_tt * 64 + tk1) * PQW + _h * 256 + p1 * 128 + 32 * sub; \
        _Pragma("unroll") for (int q = 0; q < 4; ++q) dst_[q] = *(const GAS v4u*)(sp_ + 8 * q); } while (0)
#define P9_STAGE1(sc_, list_, unext_) do { \
            unsigned kv[32]; \
            _Pragma("unroll") for (int q = 0; q < 4; ++q) { const unsigned ww[4] = {sc_[q].x, sc_[q].y, sc_[q].z, sc_[q].w}; \
                _Pragma("unroll") for (int e = 0; e < 4; ++e) { kv[8 * q + 2 * e] = (fkey(f16lo(ww[e])) & ~127u) | (unsigned)(32 * sub + 8 * q + 2 * e); \
                    kv[8 * q + 2 * e + 1] = (fkey(f16hi(ww[e])) & ~127u) | (unsigned)(32 * sub + 8 * q + 2 * e + 1); } } \
            if ((unext_) < NU) P9_LOAD(sc_, (unext_)); \
            bitonic_sort16_desc<0>(kv); bitonic_sort16_desc<16>(kv); \
            unsigned L[16]; \
            _Pragma("unroll") for (int i = 0; i < 16; ++i) L[i] = umax_(kv[i], kv[31 - i]); \
            bitonic_merge16_desc(L); \
            top16_merge<1>(L); top16_merge<2>(L); \
            if (sub == 0) { _Pragma("unroll") for (int i = 0; i < 4; ++i) *(LAS v4u*)((list_) + row * 16 + 4 * i) = (v4u){L[4 * i], L[4 * i + 1], L[4 * i + 2], L[4 * i + 3]}; } } while (0)
    if (F.bid < NU) P9_LOAD(sn, F.bid);
    if (F.bid + F.G < NU) P9_LOAD(sm, F.bid + F.G);
    for (int u = F.bid; u < NU; u += 2 * F.G) {
        const int u1 = u + F.G;
        P9_STAGE1(sn, LIST, u + 2 * F.G);
        if (u1 < NU) P9_STAGE1(sm, LIST + 2048, u1 + 2 * F.G);
        __syncthreads();
        const int half = F.tid >> 8, uu = half ? u1 : u;
        if (uu < NU) {
            const int tt = uu >> 3, h = uu & 7, tok0 = tt * 64;
            LAS unsigned* LIST = (LAS unsigned*)(F.lds + P9_LIST_OFF) + half * 2048;
            const int tok = (F.tid & 255) >> 2, sub = F.tid & 3;
            float va[16], vb[16];
#pragma unroll
            for (int i = 0; i < 4; ++i) { const v4u x = *(const LAS v4u*)(LIST + tok * 16 + 4 * i), y = *(const LAS v4u*)(LIST + (64 + tok) * 16 + 4 * i);
                va[4 * i] = funkey(x.x & ~127u); va[4 * i + 1] = funkey(x.y & ~127u); va[4 * i + 2] = funkey(x.z & ~127u); va[4 * i + 3] = funkey(x.w & ~127u);
                vb[4 * i] = funkey(y.x & ~127u); vb[4 * i + 1] = funkey(y.y & ~127u); vb[4 * i + 2] = funkey(y.z & ~127u); vb[4 * i + 3] = funkey(y.w & ~127u); }
            unsigned cand[32];
#pragma unroll
            for (int i = 0; i < 32; ++i) cand[i] = 0u;
            {
                constexpr int NC = 50;
                constexpr unsigned char CI[52] = {0,0,0,0,0,0,0,0,0,0,0,0,0,0,0,0, 1,1,1,1,1,1,1,1, 2,2,2,2,2, 3,3,3,3, 4,4,4, 5,5, 6,6, 7,7, 8,9,10,11,12,13,14,15, 0,0};
                constexpr unsigned char CJ[52] = {0,1,2,3,4,5,6,7,8,9,10,11,12,13,14,15, 0,1,2,3,4,5,6,7, 0,1,2,3,4, 0,1,2,3, 0,1,2, 0,1, 0,1, 0,1, 0,0,0,0,0,0,0,0, 0,0};
#pragma unroll
                for (int g4 = 0; g4 < 13; ++g4) {
                    float sa = 0.f, sb = 0.f; unsigned id = 0u; bool ok = false;
#pragma unroll
                    for (int q = 0; q < 4; ++q) { const int n = 4 * g4 + q; if (n < NC) { const bool me = (sub == q); sa = me ? va[CI[n]] : sa; sb = me ? vb[CJ[n]] : sb; id = me ? (unsigned)(CI[n] * 16 + CJ[n]) : id; ok = ok || me; } }
                    cand[g4] = ok ? ((fkey(sa + sb) & ~255u) | id) : 0u;
                }
            }
            bitonic_sort16_desc<0>(cand);
            unsigned L[16];
#pragma unroll
            for (int i = 0; i < 16; ++i) L[i] = cand[i];
            top16_merge<1>(L); top16_merge<2>(L);
            const float mx = funkey(L[0] & ~255u);
            float e[16], sum = 0.f;
#pragma unroll
            for (int k = 0; k < 16; ++k) { e[k] = __expf(funkey(L[k] & ~255u) - mx); sum += e[k]; }
            const float inv = 1.0f / sum;
            const size_t ob = (size_t)(tok0 + tok) * 128;
#pragma unroll
            for (int k4 = 0; k4 < 4; ++k4) if (sub == k4) {
#pragma unroll
                for (int q = 0; q < 4; ++q) { const unsigned cid = L[4 * k4 + q] & 255u;
                    const unsigned ia = LIST[tok * 16 + (cid >> 4)] & 127u, ib = LIST[(64 + tok) * 16 + (cid & 15u)] & 127u;
                    const int slot = h * 16 + 4 * k4 + q;
                    EID[ob + slot] = (int)(ia * 128u + ib); GW[ob + slot] = e[4 * k4 + q] * inv; }
            }
        }
        __syncthreads();
    }
#undef P9_LOAD
#undef P9_STAGE1
}

__device__ __forceinline__ void unpack8(const v4u w, float (&f)[8]) { f[0] = bflo(w.x); f[1] = bfhi(w.x); f[2] = bflo(w.y); f[3] = bfhi(w.y); f[4] = bflo(w.z); f[5] = bfhi(w.z); f[6] = bflo(w.w); f[7] = bfhi(w.w); }
typedef float f32x2 __attribute__((ext_vector_type(2)));
__device__ __forceinline__ void unpack16_fp8(const v4u w, float (&f)[16]) {
    const unsigned ww[4] = {w.x, w.y, w.z, w.w};
#pragma unroll
    for (int d = 0; d < 4; ++d) { const f32x2 a = __builtin_amdgcn_cvt_pk_f32_fp8((int)ww[d], false), b = __builtin_amdgcn_cvt_pk_f32_fp8((int)ww[d], true);
        f[4 * d] = a.x; f[4 * d + 1] = a.y; f[4 * d + 2] = b.x; f[4 * d + 3] = b.y; }
}
template <int PV_> __device__ __forceinline__ void peer_dot_phase(Frame& F) {
    const unsigned char* H8 = F.ws + WS_H8; const int* EID = (const int*)(F.ws + WS_EID); float* PART = (float*)(F.ws + WS_PART);
    const int lane = F.lane, g = lane >> 3, j = lane & 7, x = F.bid & 7;
    const int nbx = (F.G - x + 7) >> 3, NW = nbx * NWAVES, gwv = (F.bid >> 3) * NWAVES + F.wave;
    const unsigned char* US = F.ws + WS_UB + (size_t)x * NEXP * 128; const unsigned j16 = 16u * (unsigned)j;
    int token = gwv;
    if (token >= M) return;
    const int lasttok = gwv + ((M - 1 - gwv) / NW) * NW;
    v4i eA[4], eB[4]; v4i hA, hB;
#define PD_CL(t_) ((t_) < M ? (t_) : lasttok)
#define PD_LOAD_E(e_, tok_) do { _Pragma("unroll") for (int q = 0; q < 4; ++q) e_[q] = *(const GAS v4i*)(EID + (size_t)(tok_) * 128 + 16 * g + 4 * q); } while (0)
#define PD_ISSUE4(buf_, e_, b0_) do { buf_[b0_] = *(const GAS v4i*)(US + ((unsigned)e_.x * 128u + j16)); buf_[b0_ + 1] = *(const GAS v4i*)(US + ((unsigned)e_.y * 128u + j16)); \
        buf_[b0_ + 2] = *(const GAS v4i*)(US + ((unsigned)e_.z * 128u + j16)); buf_[b0_ + 3] = *(const GAS v4i*)(US + ((unsigned)e_.w * 128u + j16)); } while (0)
#define PD_DOT1(w_, hc_, dst_) do { int t = __builtin_amdgcn_sdot4(w_.x, hc_.x, 0, false); t = __builtin_amdgcn_sdot4(w_.y, hc_.y, t, false); t = __builtin_amdgcn_sdot4(w_.z, hc_.z, t, false); t = __builtin_amdgcn_sdot4(w_.w, hc_.w, t, false); \
        t += dppi<DPP_XOR1>(t); t += dppi<DPP_XOR2>(t); t += dppi<DPP_HMIR>(t); dst_ = (float)t; } while (0)
#define PD_BODY(eC, eN, hC, hN, tok_) do { const int tk_ = PD_CL(tok_); \
        PD_ISSUE4(bB, eC[2], 0); PD_ISSUE4(bB, eC[3], 4); \
        PD_LOAD_E(eC, PD_CL(tk_ + 2 * NW)); \
        hN = *(const GAS v4i*)(H8 + (size_t)PD_CL(tk_ + NW) * D + 128 * x + j16); \
        float s[16]; \
        _Pragma("unroll") for (int i = 0; i < 8; ++i) PD_DOT1(bA[i], hC, s[i]); \
        PD_ISSUE4(bA, eN[0], 0); PD_ISSUE4(bA, eN[1], 4); \
        _Pragma("unroll") for (int i = 0; i < 8; ++i) PD_DOT1(bB[i], hC, s[8 + i]); \
        { float* pp = PART + ((size_t)x * M + tk_) * 128 + g * 16;       \
          _Pragma("unroll") for (int i4 = 0; i4 < 4; ++i4) *(GAS f32x4*)(pp + 4 * i4) = (f32x4){s[4 * i4], s[4 * i4 + 1], s[4 * i4 + 2], s[4 * i4 + 3]}; } } while (0)
    PD_LOAD_E(eA, token); hA = *(const GAS v4i*)(H8 + (size_t)token * D + 128 * x + j16);
    PD_LOAD_E(eB, PD_CL(token + NW));
    v4i bA[8], bB[8];
    PD_ISSUE4(bA, eA[0], 0); PD_ISSUE4(bA, eA[1], 4);
    __builtin_amdgcn_s_waitcnt(0x0F70);
    for (; token < M; token += 2 * NW) {
        PD_BODY(eA, eB, hA, hB, token);
        PD_BODY(eB, eA, hB, hA, token + NW);
    }
#undef PD_BODY
#undef PD_CL
#undef PD_LOAD_E
#undef PD_ISSUE4
#undef PD_DOT1
}
template <int NTOK> __device__ __forceinline__ void peer_loadrate_probe(Frame& F) {
    const int* EID = (const int*)(F.ws + WS_EID);
    const int lane = F.lane, g = lane >> 3, j = lane & 7, x = F.bid & 7;
    const int nbx = (F.G - x + 7) >> 3, NW = nbx * NWAVES, gwv = (F.bid >> 3) * NWAVES + F.wave;
    const unsigned char* US = F.ws + WS_UB + (size_t)x * NEXP * 128; const unsigned j16 = 16u * (unsigned)j;
    unsigned acc = 0u;
    for (int token = gwv; token + (NTOK - 1) * NW < M; token += NTOK * NW) {
        v4i e4[NTOK][4];
#pragma unroll
        for (int t = 0; t < NTOK; ++t)
#pragma unroll
            for (int q = 0; q < 4; ++q) e4[t][q] = *(const GAS v4i*)(EID + (size_t)(token + t * NW) * 128 + 16 * g + 4 * q);
        v4i b[NTOK][16];
#pragma unroll
        for (int t = 0; t < NTOK; ++t)
#pragma unroll
            for (int q = 0; q < 4; ++q) { b[t][4 * q] = *(const GAS v4i*)(US + ((unsigned)e4[t][q].x * 128u + j16)); b[t][4 * q + 1] = *(const GAS v4i*)(US + ((unsigned)e4[t][q].y * 128u + j16));
                b[t][4 * q + 2] = *(const GAS v4i*)(US + ((unsigned)e4[t][q].z * 128u + j16)); b[t][4 * q + 3] = *(const GAS v4i*)(US + ((unsigned)e4[t][q].w * 128u + j16)); }
#pragma unroll
        for (int t = 0; t < NTOK; ++t)
#pragma unroll
            for (int i = 0; i < 16; ++i) acc ^= (unsigned)(b[t][i].x ^ b[t][i].y ^ b[t][i].z ^ b[t][i].w);
    }
    asm volatile("" :: "v"(acc));
}
__device__ __forceinline__ void peer_coef_phase(Frame& F) {
    const float* PART = (const float*)(F.ws + WS_PART); const int* EID = (const int*)(F.ws + WS_EID); const float* GW = (const float*)(F.ws + WS_GW);
    const float* SCU = (const float*)(F.ws + WS_SCLU); const float* SCV = (const float*)(F.ws + WS_SCLV); const float* HS = (const float*)(F.ws + WS_HS);
    unsigned* CF8 = (unsigned*)(F.ws + WS_CF); float* CFS = (float*)(F.ws + WS_CFS);
    const size_t gtid = (size_t)F.bid * NTHREADS + F.tid, gthreads = (size_t)F.G * NTHREADS, n4 = (size_t)M * 128 / 4;
    for (size_t i4 = gtid; i4 < n4; i4 += gthreads) {
        f32x4 d = *(const GAS f32x4*)(PART + 4 * i4);
#pragma unroll
        for (int xx = 1; xx < 8; ++xx) d = d + *(const GAS f32x4*)(PART + (size_t)xx * M * 128 + 4 * i4);
        const v4i e = *(const GAS v4i*)(EID + 4 * i4); const f32x4 gw = *(const GAS f32x4*)(GW + 4 * i4);
        const float hs = HS[i4 >> 5];
        f32x4 r; r.x = gw.x * SCV[e.x] * gelu_tanh_safe(d.x * (SCU[e.x] * hs)); r.y = gw.y * SCV[e.y] * gelu_tanh_safe(d.y * (SCU[e.y] * hs));
        r.z = gw.z * SCV[e.z] * gelu_tanh_safe(d.z * (SCU[e.z] * hs)); r.w = gw.w * SCV[e.w] * gelu_tanh_safe(d.w * (SCU[e.w] * hs));
        float m = fmaxf(fmaxf(fabsf(r.x), fabsf(r.y)), fmaxf(fabsf(r.z), fabsf(r.w)));
        m = fmaxf(m, dppf<DPP_XOR1>(m)); m = fmaxf(m, dppf<DPP_XOR2>(m)); m = fmaxf(m, dppf<DPP_HMIR>(m)); m = fmaxf(m, dppf<DPP_ROR8>(m)); m = max_xor16(m);
        const unsigned E = (__builtin_bit_cast(unsigned, m) >> 23) & 0xffu; float sc = 1.f, isc = 1.f;
        if (E >= 8u && E <= 250u) { sc = __builtin_bit_cast(float, (261u - E) << 23); isc = __builtin_bit_cast(float, (E - 7u) << 23); }
        int t = __builtin_amdgcn_cvt_pk_fp8_f32(r.x * sc, r.y * sc, 0, false); t = __builtin_amdgcn_cvt_pk_fp8_f32(r.z * sc, r.w * sc, t, true);
        CF8[i4] = (unsigned)t;
        if ((F.lane & 31) == 0) CFS[i4 >> 5] = isc; }
}
template <bool DRY, bool CHECK = false> __device__ __forceinline__ void peer_out_phase(Frame& F, const float* ada, float* out) {
    const int* EID = (const int*)(F.ws + WS_EID); const unsigned char* CF8 = (const unsigned char*)(F.ws + WS_CF); const float* CFS = (const float*)(F.ws + WS_CFS);
    const int lane = F.lane, g = lane >> 3, j = lane & 7, x = F.bid & 7;
    const int nbx = (F.G - x + 7) >> 3, NW = nbx * NWAVES, gwv = (F.bid >> 3) * NWAVES + F.wave;
    const unsigned char* VS = F.ws + WS_VB + (size_t)x * NEXP * 128; const unsigned j16 = 16u * (unsigned)j;
    if (gwv >= M) return;
    const int ntok = (M - 1 - gwv) / NW + 1;
#define PO_ISSUE4(buf_, e_, b0_) do { buf_[b0_] = *(const GAS v4u*)(VS + ((unsigned)e_.x * 128u + j16)); buf_[b0_ + 1] = *(const GAS v4u*)(VS + ((unsigned)e_.y * 128u + j16)); \
        buf_[b0_ + 2] = *(const GAS v4u*)(VS + ((unsigned)e_.z * 128u + j16)); buf_[b0_ + 3] = *(const GAS v4u*)(VS + ((unsigned)e_.w * 128u + j16)); } while (0)
#define PO_ROW(w_, c_) do { float f[16]; unpack16_fp8(w_, f); _Pragma("unroll") for (int k = 0; k < 16; ++k) o[k] += (c_) * f[k]; } while (0)
#define PO_ACC4(buf_, c4_, b0_) do { PO_ROW(buf_[b0_], c4_.x); PO_ROW(buf_[b0_ + 1], c4_.y); PO_ROW(buf_[b0_ + 2], c4_.z); PO_ROW(buf_[b0_ + 3], c4_.w); } while (0)
    v4i e4[4]; f32x4 c4[4]; v4u bA[8], bB[8];
#define PO_LOADC(tok_) do { const float cs_ = CFS[tok_]; _Pragma("unroll") for (int q = 0; q < 4; ++q) { const unsigned w_ = *(const GAS unsigned*)(CF8 + (size_t)(tok_) * 128 + g * 16 + 4 * q); \
        const f32x2 lo_ = __builtin_amdgcn_cvt_pk_f32_fp8((int)w_, false), hi_ = __builtin_amdgcn_cvt_pk_f32_fp8((int)w_, true); c4[q] = (f32x4){lo_.x * cs_, lo_.y * cs_, hi_.x * cs_, hi_.y * cs_}; } } while (0)
#pragma unroll
    for (int q = 0; q < 4; ++q) e4[q] = *(const GAS v4i*)(EID + (size_t)gwv * 128 + g * 16 + 4 * q);
    PO_LOADC(gwv);
    PO_ISSUE4(bA, e4[0], 0); PO_ISSUE4(bA, e4[1], 4);
    for (int it = 0; it < ntok; ++it) {
        const int token = gwv + it * NW, tn = gwv + (it + 1 < ntok ? it + 1 : it) * NW;
        PO_ISSUE4(bB, e4[2], 0); PO_ISSUE4(bB, e4[3], 4);
#pragma unroll
        for (int q = 0; q < 4; ++q) e4[q] = *(const GAS v4i*)(EID + (size_t)tn * 128 + g * 16 + 4 * q);
        float o[16];
#pragma unroll
        for (int k = 0; k < 16; ++k) o[k] = 0.f;
        PO_ACC4(bA, c4[0], 0); PO_ACC4(bA, c4[1], 4);
        PO_ISSUE4(bA, e4[0], 0); PO_ISSUE4(bA, e4[1], 4);
        PO_ACC4(bB, c4[2], 0); PO_ACC4(bB, c4[3], 4);
        PO_LOADC(tn);
#pragma unroll
        for (int k = 0; k < 16; ++k) { float t = o[k]; t += dppf<DPP_ROR8>(t); o[k] = sum_xor32(sum_xor16(t)); }
        if (g == 0) { const int b = token >> 12;
            const float* gt = ada + (size_t)b * 6 * D + 5 * D + 128 * x + 16 * j;
            float* xo = out + (size_t)token * D + 128 * x + 16 * j;
#pragma unroll
            for (int q = 0; q < 4; ++q) { const f32x4 xv = *(const GAS f32x4*)(xo + 4 * q), gv = *(const GAS f32x4*)(gt + 4 * q);
                f32x4 res = xv + gv * (f32x4){o[4 * q], o[4 * q + 1], o[4 * q + 2], o[4 * q + 3]};
                if (CHECK) { const f32x4 mf = *(const GAS f32x4*)((const float*)(F.ws + WS_PART) + (size_t)token * D + 128 * x + 16 * j + 4 * q);
                    const float rr[4] = {o[4 * q], o[4 * q + 1], o[4 * q + 2], o[4 * q + 3]}, mm[4] = {mf.x, mf.y, mf.z, mf.w}; bool bad = false;
#pragma unroll
                    for (int z = 0; z < 4; ++z) bad = bad || !(fabsf(rr[z] - mm[z]) <= 0.01f * fabsf(rr[z]) + 1.0e-3f);
                    if (bad) res.x = 1.0e9f; }
                if (DRY) { asm volatile("" :: "v"(res.x), "v"(res.y), "v"(res.z), "v"(res.w)); } else *(GAS f32x4*)(xo + 4 * q) = res; } }
    }
#undef PO_LOADC
#undef PO_ISSUE4
#undef PO_ROW
#undef PO_ACC4
}

constexpr int PO_TILE = 64 * 144;
template <int MODE> __device__ __forceinline__ void peer_out_mfma_phase(Frame& F, const float* ada, float* out) {
    const int* EID = (const int*)(F.ws + WS_EID); const unsigned char* CF8 = (const unsigned char*)(F.ws + WS_CF); const float* CFS = (const float*)(F.ws + WS_CFS);
    const int lane = F.lane, g = lane >> 3, j = lane & 7, l15 = lane & 15, lq = lane >> 4, x = F.bid & 7;
    const int nbx = (F.G - x + 7) >> 3, NW = nbx * NWAVES, gwv = (F.bid >> 3) * NWAVES + F.wave;
    const unsigned char* VS = F.ws + WS_VB + (size_t)x * NEXP * 128; const unsigned j16 = 16u * (unsigned)j;
    LAS unsigned char* TL = F.lds + F.wave * PO_TILE;
    if (gwv >= M) return;
    const int nst = 2 * ((M - 1 - gwv) / NW + 1);
    const int trow = l15 >> 1, tcol = 8 * (l15 & 1);
#define PM_IDS(e_, a_, tok_) do { const size_t base = (size_t)(tok_) * 128; \
        _Pragma("unroll") for (int m = 0; m < 16; ++m) e_[m] = EID[base + 8 * m + g]; \
        _Pragma("unroll") for (int q = 0; q < 4; ++q) a_[q] = *(const GAS long*)(CF8 + base + 32 * q + 8 * lq); } while (0)
#define PM_GATHER(vv_, e_, h_) do { _Pragma("unroll") for (int m = 0; m < 8; ++m) vv_[m] = *(const GAS v4u*)(VS + ((unsigned)e_[8 * (h_) + m] * 128u + j16)); } while (0)
#define PM_HALF(vv_, aq0_, aq1_) do { _Pragma("unroll") for (int m = 0; m < 8; ++m) *(LAS v4u*)(TL + (8 * m + g) * 144 + 16 * j) = vv_[m]; } while (0)
#define PM_MMA(aq0_, aq1_) do { LDS_WAIT(); asm volatile("" ::: "memory"); \
        _Pragma("unroll") for (int ks = 0; ks < 2; ++ks) _Pragma("unroll") for (int cb = 0; cb < 8; ++cb) { \
            const v2i bb = __builtin_amdgcn_ds_read_tr8_b64_v2i32((LAS v2i*)(TL + (32 * ks + 8 * lq + trow) * 144 + 16 * cb + tcol)); \
            acc[cb] = __builtin_amdgcn_mfma_f32_16x16x32_fp8_fp8(ks ? (aq1_) : (aq0_), __builtin_bit_cast(long, bb), acc[cb], 0, 0, 0); } \
        LDS_WAIT(); asm volatile("" ::: "memory"); } while (0)
    const int ntok = nst >> 1;
    int e1[16], e2[16]; long a0[4], a1[4], a2[4]; v4u vvA[8], vvB[8];
    PM_IDS(e1, a0, gwv);
    PM_GATHER(vvA, e1, 0); PM_GATHER(vvB, e1, 1);
    { const int t1 = ntok > 1 ? 1 : 0; PM_IDS(e1, a1, gwv + t1 * NW); }
    f32x4 acc[8];
    for (int it = 0; it < ntok; ++it) {
        const int token = gwv + it * NW;
        { const int t2 = it + 2 < ntok ? it + 2 : ntok - 1; PM_IDS(e2, a2, gwv + t2 * NW); }
#pragma unroll
        for (int cb = 0; cb < 8; ++cb) acc[cb] = (f32x4){0.f, 0.f, 0.f, 0.f};
        float xv[8], gv[8]; float cs;
        { const int b = token >> 12; const float* gt = ada + (size_t)b * 6 * D + 5 * D + 128 * x + l15; const bf16* xi = (const bf16*)(F.ws + WS_X1) + (size_t)token * D + 128 * x + l15;
          cs = CFS[token];
#pragma unroll
          for (int cb = 0; cb < 8; ++cb) { xv[cb] = bflo((unsigned)xi[16 * cb]); gv[cb] = gt[16 * cb]; } }
        PM_HALF(vvA, 0, 0); PM_GATHER(vvA, e1, 0); PM_MMA(a0[0], a0[1]);
        PM_HALF(vvB, 0, 0); PM_GATHER(vvB, e1, 1); PM_MMA(a0[2], a0[3]);
        if (lq == 0) {
            if (MODE == 1) { float* oc = (float*)(F.ws + WS_PART) + (size_t)token * D + 128 * x + l15;
#pragma unroll
                for (int cb = 0; cb < 8; ++cb) oc[16 * cb] = acc[cb][0] * cs; }
            else { float* xo = out + (size_t)token * D + 128 * x + l15;
#pragma unroll
                for (int cb = 0; cb < 8; ++cb) xo[16 * cb] = xv[cb] + gv[cb] * (acc[cb][0] * cs); }
        }
#pragma unroll
        for (int m = 0; m < 16; ++m) e1[m] = e2[m];
#pragma unroll
        for (int q = 0; q < 4; ++q) { a0[q] = a1[q]; a1[q] = a2[q]; }
    }
#undef PM_HALF
#undef PM_MMA
#undef PM_IDS
#undef PM_GATHER
}

__device__ __forceinline__ void compress_phase(Frame& F, const float* kng) {
    LAS bf16* H2 = (LAS bf16*)(F.lds);
    LAS float* OUTS = (LAS float*)(F.lds + 16384);
    const int lane = F.lane, w = F.wave, l15 = lane & 15, lq = lane >> 4;
    for (int u = F.bid; u < NBG * 2 * 8; u += F.G) {
        const int ns = u & 7, kv = (u >> 3) & 1, bg = u >> 4, n0 = ns * 32;
        const bf16* A = (const bf16*)(F.ws + (kv ? WS_VCR : WS_KCR)) + (size_t)bg * SEQ * 64;
        const bf16* W1T = (const bf16*)(F.ws + (kv ? WS_CW1V_T : WS_CW1K_T));
        const bf16* W2T = (const bf16*)(F.ws + (kv ? WS_CW2V_T : WS_CW2K_T));
        const float* b1 = (const float*)(F.ws + (kv ? WS_CB1V : WS_CB1K));
        pg8::f32x4 acc[2][8];
#pragma unroll
        for (int rb = 0; rb < 2; ++rb)
#pragma unroll
            for (int cb = 0; cb < 8; ++cb) acc[rb][cb] = (pg8::f32x4){0.f, 0.f, 0.f, 0.f};
        const bf16* ap = A + (size_t)(n0 + l15) * 1024 + 256 * w + 8 * lq;
        const bf16* bp = W1T + (size_t)l15 * 2048 + 256 * w + 8 * lq;
#pragma unroll
        for (int ks = 0; ks < 8; ++ks) {
            const bf16x8 a0 = *(const GAS bf16x8*)(ap + 32 * ks), a1 = *(const GAS bf16x8*)(ap + 16 * 1024 + 32 * ks);
#pragma unroll
            for (int cb = 0; cb < 8; ++cb) { const bf16x8 b = *(const GAS bf16x8*)(bp + (size_t)(16 * cb) * 2048 + 32 * ks);
                acc[0][cb] = __builtin_amdgcn_mfma_f32_16x16x32_bf16(a0, b, acc[0][cb], 0, 0, 0);
                acc[1][cb] = __builtin_amdgcn_mfma_f32_16x16x32_bf16(a1, b, acc[1][cb], 0, 0, 0); }
        }
        { LAS float* PS = (LAS float*)(F.lds + 32768);
          LAS float* mine = PS + (w & 3) * 4096 + (4 * lq) * 128 + l15;
          if (w >= 4) {
#pragma unroll
              for (int rb = 0; rb < 2; ++rb)
#pragma unroll
                  for (int cb = 0; cb < 8; ++cb)
#pragma unroll
                      for (int r = 0; r < 4; ++r) mine[(16 * rb + r) * 128 + 16 * cb] = acc[rb][cb][r]; }
          __syncthreads();
          if (w < 4) {
#pragma unroll
              for (int rb = 0; rb < 2; ++rb)
#pragma unroll
                  for (int cb = 0; cb < 8; ++cb)
#pragma unroll
                      for (int r = 0; r < 4; ++r) { LAS float* q = mine + (16 * rb + r) * 128 + 16 * cb; *q = acc[rb][cb][r] + *q; } }
          __syncthreads();
#pragma unroll
          for (int i = 0; i < 8; ++i) { const int idx = F.tid + 512 * i, row = idx >> 7, col = idx & 127;
              const float v = ((PS[idx] + PS[4096 + idx]) + (PS[8192 + idx] + PS[12288 + idx])) + b1[col];
              H2[row * 136 + col] = (bf16)f2bf(gelu_tanh_safe(v)); } }
        __syncthreads();
        { const int rb = w >> 2, db = w & 3;
          pg8::f32x4 o = (pg8::f32x4){0.f, 0.f, 0.f, 0.f};
#pragma unroll
          for (int ks = 0; ks < 4; ++ks) {
              const bf16x8 a = *(const LAS bf16x8*)(H2 + (16 * rb + l15) * 136 + 32 * ks + 8 * lq);
              const bf16x8 b = *(const GAS bf16x8*)(W2T + (size_t)(16 * db + l15) * 128 + 32 * ks + 8 * lq);
              o = __builtin_amdgcn_mfma_f32_16x16x32_bf16(a, b, o, 0, 0, 0); }
#pragma unroll
          for (int r = 0; r < 4; ++r) OUTS[(16 * rb + 4 * lq + r) * 65 + 16 * db + l15] = o[r]; }
        __syncthreads();
        { const int n = F.tid >> 4, d4 = (F.tid & 15) * 4, ng = n0 + n;
          float v[4]; float ss = 0.f;
#pragma unroll
          for (int i = 0; i < 4; ++i) { v[i] = OUTS[n * 65 + d4 + i]; ss += v[i] * v[i]; }
          ss += dppf<DPP_XOR1>(ss); ss += dppf<DPP_XOR2>(ss); ss += dppf<DPP_HMIR>(ss); ss += dppf<DPP_ROR8>(ss);
          const bool pad = (ng >= NCMP);
          if (kv == 0) { const float rs = rsqrtf(ss * (1.f / 64.f) + EPS);
              v2u o; o.x = pad ? 0u : pk2(v[0] * rs * kng[d4], v[1] * rs * kng[d4 + 1]); o.y = pad ? 0u : pk2(v[2] * rs * kng[d4 + 2], v[3] * rs * kng[d4 + 3]);
              *(GAS v2u*)((bf16*)(F.ws + WS_KC) + ((size_t)bg * 256 + ng) * 64 + d4) = o; }
          else { bf16* vt = (bf16*)(F.ws + WS_VCT) + (size_t)bg * 64 * 256 + ng;
#pragma unroll
              for (int i = 0; i < 4; ++i) vt[(size_t)(d4 + i) * 256] = pad ? (bf16)0 : (bf16)f2bf(v[i]); } }
        __syncthreads();
    }
}
__device__ __forceinline__ void vtranspose_phase(Frame& F) {
    LAS bf16* T = (LAS bf16*)(F.lds + F.wave * 9216);
    const int gw = F.bid * NWAVES + F.wave, NGW = F.G * NWAVES, lane = F.lane;
    for (int job = gw; job < 2 * NBG * 64; job += NGW) {
        const int s = job & 63, bg = (job >> 6) & 15, which = job >> 10;
        const bf16* X = (const bf16*)(F.ws + (which ? WS_VW : WS_VS)) + ((size_t)bg * SEQ + 64 * s) * 64;
        bf16* XT = (bf16*)(F.ws + (which ? WS_VWT : WS_VST)) + (size_t)bg * 64 * SEQ + 64 * s;
#pragma unroll
        for (int i = 0; i < 8; ++i) { const int tok = (lane >> 3) + 8 * i, ch = lane & 7;
            const v4u x = *(const GAS v4u*)(X + (size_t)tok * 64 + 8 * ch);
            const unsigned ww[4] = {x.x, x.y, x.z, x.w};
#pragma unroll
            for (int e = 0; e < 4; ++e) { T[(8 * ch + 2 * e) * 72 + tok] = (bf16)(ww[e] & 0xffffu); T[(8 * ch + 2 * e + 1) * 72 + tok] = (bf16)(ww[e] >> 16); } }
        LDS_WAIT(); asm volatile("" ::: "memory");
#pragma unroll
        for (int i = 0; i < 8; ++i) { const int dim = (lane >> 3) + 8 * i, ch = lane & 7;
            const v4u y = *(const LAS v4u*)(T + dim * 72 + 8 * ch);
            *(GAS v4u*)(XT + (size_t)dim * SEQ + 8 * ch) = y; }
        LDS_WAIT(); asm volatile("" ::: "memory");
    }
}

constexpr int AT_KBUF = 64 * 128;
constexpr int AT_NBUF = 2;
constexpr int AT_OFF_K = 0, AT_OFF_V = AT_NBUF * AT_KBUF;
constexpr int AT_OFF_IMP1 = 2 * AT_NBUF * AT_KBUF, AT_OFF_IMP2 = AT_OFF_IMP1 + 64 * 65 * 4, AT_OFF_SEL = AT_OFF_IMP2 + 64 * 65 * 4;
constexpr int AT_OFF_LUT = AT_OFF_SEL + 512, AT_OFF_LROW = AT_OFF_LUT + 4 * 128 * 4;
constexpr int AT_OFF_TD = AT_OFF_LROW + 8 * 32 * 4;
constexpr int AT_OFF_OUT = AT_OFF_TD + 96 * 32;
constexpr int AT_OFF_GATL = AT_OFF_OUT + 256 * 144;
constexpr int AT_OFF_TS = AT_OFF_GATL + 64 * 12 * 4;
constexpr int AT_TS_ROW = 65 * 16;
constexpr int AT_LDS_END = AT_OFF_TS + 16 * AT_TS_ROW;
static_assert(AT_LDS_END <= RING_BYTES, "attention LDS");

struct AtTile { const bf16* k; const bf16* vt; int vstride; };
enum { TM_CMP1 = 0, TM_CMP2, TM_SELN, TM_SELF, TM_WINN, TM_WINF, TM_WINE, TM_CMP1F, TM_CMP2F };
__device__ __forceinline__ float fexp2(float x) { return __builtin_amdgcn_exp2f(x); }
template <int TM, int VAR, int RB = 3>
__device__ __forceinline__ void at_tile(const LAS unsigned char* kb_, const LAS unsigned char* vb_, const LAS float* LUTJ, LAS float* IMP1, LAS float* IMP2,
                                        const bf16x8 (&qf)[2][2], pg8::f32x4 (&oacc)[2][4], pg8::f32x4 (&lacc)[2], const LAS float* LINV,
                                        const int (&tok_r_in)[2], const unsigned (&selb)[2], float cfar, int relbase, int idx, int l15_in, int lq_in, const LAS unsigned char* tsw, const LAS unsigned char* tsn) {
    constexpr bool FAR = (TM == TM_SELF || TM == TM_WINF || TM == TM_WINE || TM == TM_CMP1F || TM == TM_CMP2F);
    constexpr bool C1 = (TM == TM_CMP1 || TM == TM_CMP1F), C2 = (TM == TM_CMP2 || TM == TM_CMP2F);
    int l15 = l15_in, lq = lq_in; asm volatile("" : "+v"(l15), "+v"(lq));
    int tok_r[2] = {tok_r_in[0], tok_r_in[1]}; asm volatile("" : "+v"(tok_r[0]), "+v"(tok_r[1]));
    v4u pfr[2][2];
    const LAS unsigned char* tsp[2] = {tsw, tsw};
    if (TM == TM_SELN || TM == TM_WINN) {
#pragma unroll
        for (int rb = 0; rb < 2; ++rb) { const LAS unsigned char* pa = tsw + l15 * AT_TS_ROW + 16 * (2 * lq - rb) - 4 * relbase;
            const LAS unsigned char* pn = tsn + l15 * AT_TS_ROW;
            tsp[rb] = (TM == TM_SELN && !selb[rb]) ? pn : pa; } }
    auto kld = [&](int cb, bf16x8 (&kf)[2], pg8::f32x4 (&cq)[2]) __attribute__((always_inline)) {
        if (TM == TM_SELN || TM == TM_WINN) {
#pragma unroll
            for (int rb = 0; rb < 2; ++rb) cq[rb] = *(const LAS pg8::f32x4*)(tsp[rb] + 16 * (8 * (cb >> 1) + (cb & 1))); }
        if (!(VAR & 64)) {
        const int krow = 8 * (l15 >> 2) + (l15 & 3) + 32 * (cb >> 1) + 4 * (cb & 1), kf_ = ((l15 >> 2) << 1) | ((l15 >> 1) & 1);
#pragma unroll
        for (int ks = 0; ks < 2; ++ks) kf[ks] = (VAR & 1024) ? *(const LAS bf16x8*)(kb_ + (l15 + 16 * lq) * 16 + 1024 * ks + 2048 * cb) : *(const LAS bf16x8*)(kb_ + krow * 128 + 16 * ((4 * ks + lq) ^ kf_)); }
    };
    auto qkm = [&](int cb, const bf16x8 (&kf)[2], const pg8::f32x4 (&cq)[2], pg8::f32x4 (&st)[2]) __attribute__((always_inline)) {
        st[0] = FAR ? (pg8::f32x4){cfar, cfar, cfar, cfar} : (pg8::f32x4){0.f, 0.f, 0.f, 0.f}; st[1] = st[0];
        if (TM == TM_SELN || TM == TM_WINN) { st[0] = cq[0]; st[1] = cq[1]; }
        if (TM == TM_SELF) {
#pragma unroll
            for (int rb = 0; rb < 2; ++rb) { const float ci = selb[rb] ? cfar : -1.0e30f; st[rb] = (pg8::f32x4){ci, ci, ci, ci}; } }
        if (!(VAR & 64)) {
#pragma unroll
        for (int ks = 0; ks < 2; ++ks) {
#pragma unroll
            for (int rb = 0; rb < 2; ++rb) if (RB & (1 << rb)) st[rb] = __builtin_amdgcn_mfma_f32_16x16x32_bf16(kf[ks], qf[rb][ks], st[rb], 0, 0, 0); } }
    };
    float linv_[2] = {0.f, 0.f};
    if (C2) { linv_[0] = LINV[l15]; linv_[1] = LINV[16 + l15]; }
    auto prob = [&](int cb, const pg8::f32x4 (&st)[2]) __attribute__((always_inline)) {
#pragma unroll
        for (int rb = 0; rb < 2; ++rb) if (RB & (1 << rb)) {
            const int tokc = tok_r[rb];
            float p[4];
#pragma unroll
            for (int r = 0; r < 4; ++r) {
                const int kl = 32 * (cb >> 1) + 8 * lq + 4 * (cb & 1) + r;
                if (VAR & 16) { p[r] = st[rb][r]; }
                else if (TM == TM_SELF) { p[r] = fexp2(st[rb][r]); }
                else if (TM == TM_WINF || TM == TM_SELN || TM == TM_WINN || TM == TM_CMP1F || TM == TM_CMP2F) { p[r] = fexp2(st[rb][r]); }
                else if (TM == TM_WINE) { const float e = fexp2(st[rb][r]); p[r] = (kl > tokc) ? e : 0.f; }
                else {
                    const int rel = (TM == TM_CMP1 || TM == TM_CMP2) ? (relbase + tokc - 16 * kl) : (relbase + tokc - kl);
                    const bool valid = rel >= 0;
                    const int ri = rel < 0 ? 0 : (rel > 127 ? 127 : rel);
                    const float e = fexp2(st[rb][r] + LUTJ[ri]);
                    p[r] = valid ? e : 0.f; }
            }
            if (C1) { lacc[rb][0] += (p[0] + p[1]) + (p[2] + p[3]); }
            else {
                if (C2) {
#pragma unroll
                    for (int r = 0; r < 4; ++r) p[r] *= linv_[rb];
                    float h0 = p[0], h1 = p[1], h2 = p[2], h3 = p[3];
                    h0 += dppf<DPP_XOR1>(h0); h1 += dppf<DPP_XOR1>(h1); h2 += dppf<DPP_XOR1>(h2); h3 += dppf<DPP_XOR1>(h3);
                    h0 += dppf<DPP_XOR2>(h0); h1 += dppf<DPP_XOR2>(h1); h2 += dppf<DPP_XOR2>(h2); h3 += dppf<DPP_XOR2>(h3);
                    if ((l15 & 3) == 0) { const int sp = 16 * idx + 8 * (cb >> 1) + 2 * lq + (cb & 1);
                        IMP1[tokc * 65 + sp] = (h0 + h1) + (h2 + 0.5f * h3);
                        if (sp + 1 < 64) IMP2[tokc * 65 + sp + 1] = 0.5f * h3; }
                }
                const unsigned lo = pkh(p[0], p[1]), hi = pkh(p[2], p[3]);
                if (cb & 1) { pfr[rb][cb >> 1].z = lo; pfr[rb][cb >> 1].w = hi; } else { pfr[rb][cb >> 1].x = lo; pfr[rb][cb >> 1].y = hi; } }
        }
    };
    auto vld = [&](int ks, v4u (&vv)[4]) __attribute__((always_inline)) {
        if (!C1 && !(VAR & 8)) {
#pragma unroll
            for (int db = 0; db < 4; ++db) vv[db] = (VAR & 1024) ? *(const LAS v4u*)(vb_ + (l15 + 16 * lq) * 16 + 1024 * ks + 2048 * db) : *(const LAS v4u*)(vb_ + (16 * db + l15) * 128 + 16 * ((4 * ks + lq) ^ (l15 >> 1))); }
    };
    auto pvm = [&](int ks, const v4u (&vv)[4]) __attribute__((always_inline)) {
        if (!C1 && !(VAR & 8)) {
#pragma unroll
            for (int db = 0; db < 4; ++db) {
#pragma unroll
                for (int rb = 0; rb < 2; ++rb) if (RB & (1 << rb)) oacc[rb][db] = __builtin_amdgcn_mfma_f32_16x16x32_bf16(__builtin_bit_cast(bf16x8, pfr[rb][ks]), __builtin_bit_cast(bf16x8, vv[db]), oacc[rb][db], 0, 0, 0); }
            if (!C2) { const v4u ones = (v4u){0x3F803F80u, 0x3F803F80u, 0x3F803F80u, 0x3F803F80u};
#pragma unroll
                for (int rb = 0; rb < 2; ++rb) if (RB & (1 << rb)) lacc[rb] = __builtin_amdgcn_mfma_f32_16x16x32_bf16(__builtin_bit_cast(bf16x8, pfr[rb][ks]), __builtin_bit_cast(bf16x8, ones), lacc[rb], 0, 0, 0); }
        }
    };
    pg8::f32x4 sA[2], sB[2], cA[2], cB[2]; bf16x8 kA[2], kB[2]; v4u vA[4], vB[4];
#define AT_SB __builtin_amdgcn_sched_barrier(0)
    kld(0, kA, cA); kld(1, kB, cB); AT_SB;
    qkm(0, kA, cA, sA); kld(2, kA, cA); AT_SB;
    qkm(1, kB, cB, sB); kld(3, kB, cB); prob(0, sA); AT_SB;
    qkm(2, kA, cA, sA); vld(0, vA); prob(1, sB); AT_SB;
    qkm(3, kB, cB, sB); pvm(0, vA); vld(1, vB); prob(2, sA); AT_SB;
    prob(3, sB); AT_SB;
    pvm(1, vB);
#undef AT_SB
}

template <int VAR> __device__ __forceinline__ void attention_phase(Frame& F, const Args& args) {
    unsigned char* ws = F.ws;
    const int lane = F.lane, w = F.wave, l15 = lane & 15, lq = lane >> 4, tid = F.tid;
    LAS unsigned char* L = F.lds;
    LAS float* IMP1 = (LAS float*)(L + AT_OFF_IMP1); LAS float* IMP2 = (LAS float*)(L + AT_OFF_IMP2);
    LAS unsigned long long* SELM = (LAS unsigned long long*)(L + AT_OFF_SEL); LAS float* LUT = (LAS float*)(L + AT_OFF_LUT); LAS float* LROW = (LAS float*)(L + AT_OFF_LROW) + w * 32;
    LAS int* TD = (LAS int*)(L + AT_OFF_TD); LAS bf16* OUTL = (LAS bf16*)(L + AT_OFF_OUT) + (32 * w) * 72; LAS float* GATL = (LAS float*)(L + AT_OFF_GATL);
    const bf16* Qg = (const bf16*)(ws + WS_Q); const float* GATE = (const float*)(ws + WS_GATE); bf16* YA = (bf16*)(ws + WS_PL) + 512;
    const int jq = l15 & 3;
    const LAS float* LUTJ = LUT + jq * 128;
    const int nrounds = (F.G == 256) ? 4 : (1024 + F.G - 1) / F.G;
    for (int round = 0; round < nrounds; ++round) {
        const int ui = (F.G == 256) ? ((round & 1) ? ((round >> 1) * 512 + 511 - F.bid) : ((round >> 1) * 512 + F.bid)) : (round * F.G + F.bid);
        if (ui >= 1024) break;
        const int c = 63 - (ui >> 4), bg = ui & 15, b = bg >> 1, g = bg & 1;
        const int m0 = b * SEQ + 64 * c;
        __syncthreads();
        { const float M0 = ((const float*)(ws + WS_BIASL))[8 * 128];
          for (int i = tid; i < 512; i += NTHREADS) LUT[i] = (((const float*)(ws + WS_BIASL))[(4 * g + (i >> 7)) * 128 + (i & 127)] - M0) * 1.4426950408889634f; }
        for (int i = tid; i < 64 * 65; i += NTHREADS) { IMP1[i] = 0.f; IMP2[i] = 0.f; }
        { const float M0 = ((const float*)(ws + WS_BIASL))[8 * 128]; const float* BL = (const float*)(ws + WS_BIASL) + (size_t)(4 * g) * 128;
          for (int i = tid; i < 16 * 63 * 4; i += NTHREADS) { const int r = i & 3, yi = (i >> 2) % 63, row = i / 252, rel = 4 * (47 - yi) + (row >> 2) - r;
              ((LAS float*)(L + AT_OFF_TS + row * AT_TS_ROW))[4 * yi + r] = rel < 0 ? -1.0e30f : (BL[(row & 3) * 128 + (rel > 127 ? 127 : rel)] - M0) * 1.4426950408889634f; } }
        for (int i = tid; i < 64 * 12; i += NTHREADS) GATL[i] = GATE[(size_t)(m0 + i / 12) * 24 + g * 12 + (i % 12)];
        bf16x8 qf[2][2];
#pragma unroll
        for (int rb = 0; rb < 2; ++rb)
#pragma unroll
            for (int ks = 0; ks < 2; ++ks) qf[rb][ks] = *(const GAS bf16x8*)(Qg + (size_t)(m0 + 8 * w + 4 * rb + (l15 >> 2)) * 512 + g * 256 + jq * 64 + 32 * ks + 8 * lq);
        asm volatile("" :: "v"(qf[0][0]), "v"(qf[0][1]), "v"(qf[1][0]), "v"(qf[1][1]));
        const int ncmp = 4 * c + 3, n1 = (ncmp + 63) >> 6, nsel = c + 1, w0 = c >= 8 ? c - 8 : 0, nwin = c - w0 + 1;
        const int ntiles = 2 * n1 + nsel + nwin;
        if (tid < ntiles) { const int i = tid;
            auto kindof = [&](int t, int& kind, int& idx) { if (t < n1) { kind = 0; idx = t; } else if (t < 2 * n1) { kind = 1; idx = t - n1; } else if (t < 2 * n1 + nsel) { kind = 2; idx = t - 2 * n1; } else { kind = 3; idx = w0 + (t - 2 * n1 - nsel); } };
            int kind, idx, kn, in_; kindof(i, kind, idx); kindof(i + 1 < ntiles ? i + 1 : i, kn, in_);
            unsigned ko, vo;
            if (kn < 2) { ko = (unsigned)(WS_KC + ((size_t)bg * 256 * 64 + (size_t)in_ * 4096) * 2); vo = (unsigned)(WS_VCT + ((size_t)bg * 64 * 256 + 64 * in_) * 2); }
            else if (kn == 2) { ko = (unsigned)(WS_KS + ((size_t)bg * SEQ * 64 + (size_t)in_ * 4096) * 2); vo = (unsigned)(WS_VST + ((size_t)bg * 64 * SEQ + 64 * in_) * 2); }
            else { ko = (unsigned)(WS_KW + ((size_t)bg * SEQ * 64 + (size_t)in_ * 4096) * 2); vo = (unsigned)(WS_VWT + ((size_t)bg * 64 * SEQ + 64 * in_) * 2); }
            const int dd = c - idx;
            int mode, relbase;
            if (kind == 0) { relbase = 64 * c - 31 - 1024 * idx; mode = relbase >= 1135 ? TM_CMP1F : TM_CMP1; } else if (kind == 1) { relbase = 64 * c - 31 - 1024 * idx; mode = relbase >= 1135 ? TM_CMP2F : TM_CMP2; }
            else if (kind == 2) { mode = dd <= 2 ? TM_SELN : TM_SELF; relbase = 64 * dd; } else { mode = dd <= 2 ? TM_WINN : (dd == 8 ? TM_WINE : TM_WINF); relbase = 64 * dd; }
            const int endf = ((kind == 1 && idx == n1 - 1) || (kind == 2 && idx == nsel - 1) || (kind == 3 && idx == c)) ? kind : 0;
            v4i e; e.x = mode | (idx << 8) | (endf << 16) | ((kind == 2 && idx == 0) ? (1 << 24) : 0) | (kn >= 2 ? (1 << 25) : 0); e.y = relbase; e.z = (int)ko; e.w = (int)vo;
            *(LAS v4i*)(TD + 4 * i) = e; }
        const int drow = 8 * w + (lane >> 3), dsrck = 16 * ((lane & 7) ^ (((w & 3) << 1) | ((lane >> 4) & 1))), dsrcv = 16 * ((lane & 7) ^ ((4 * (w & 1)) | (lane >> 4)));
#define AT_DMA(tile_, ko_, vo_, vs_) do { const int nb_ = (tile_) % AT_NBUF; \
        __builtin_amdgcn_global_load_lds((const GAS unsigned*)(ws + (size_t)((ko_) + drow * 128 + dsrck)), (LAS unsigned*)(L + AT_OFF_K + nb_ * AT_KBUF + w * 1024), 16, 0, 0); \
        __builtin_amdgcn_global_load_lds((const GAS unsigned*)(ws + (size_t)((vo_) + drow * (vs_) + dsrcv)), (LAS unsigned*)(L + AT_OFF_V + nb_ * AT_KBUF + w * 1024), 16, 0, 0); } while (0)
        __syncthreads();
        if (!(VAR & 2)) { AT_DMA(0, (unsigned)(WS_KC + (size_t)bg * 256 * 64 * 2), (unsigned)(WS_VCT + (size_t)bg * 64 * 256 * 2), 512u); }
        int d0, d1, d2, d3;
        { const v4i e = *(const LAS v4i*)TD; d0 = __builtin_amdgcn_readfirstlane(e.x); d1 = __builtin_amdgcn_readfirstlane(e.y); d2 = __builtin_amdgcn_readfirstlane(e.z); d3 = __builtin_amdgcn_readfirstlane(e.w); }
        pg8::f32x4 oacc[2][4];
        pg8::f32x4 lacc[2] = {(pg8::f32x4){0.f, 0.f, 0.f, 0.f}, (pg8::f32x4){0.f, 0.f, 0.f, 0.f}};
#pragma unroll
        for (int rb = 0; rb < 2; ++rb)
#pragma unroll
            for (int db = 0; db < 4; ++db) oacc[rb][db] = (pg8::f32x4){0.f, 0.f, 0.f, 0.f};
        const int tok_r[2] = {8 * w + (l15 >> 2), 8 * w + 4 + (l15 >> 2)};
        const LAS unsigned char* tsw = L + AT_OFF_TS + 16 * (47 - 2 * w); const LAS unsigned char* tsn = L + AT_OFF_TS + 16 * 48;
        for (int it = 0; it < ((VAR & 32) ? 0 : ntiles); ++it) {
            if (!(VAR & 512)) { asm volatile("s_waitcnt vmcnt(0)" ::: "memory");
            asm volatile("s_waitcnt lgkmcnt(0)" ::: "memory"); __builtin_amdgcn_s_barrier(); asm volatile("" ::: "memory"); }
            if (!(VAR & 2) && it + 1 < ntiles) AT_DMA(it + 1, (unsigned)d2, (unsigned)d3, ((d0 >> 25) & 1) ? 2u * SEQ : 512u);
            v4i tdn;
            { const LAS int* tn_ = TD + 4 * (it + 1); asm volatile("ds_read_b128 %0, %1" : "=v"(tdn) : "v"(tn_) : "memory"); }
            {
            const int mode = d0 & 255, idx = (d0 >> 8) & 255, relbase = d1, endf = (d0 >> 16) & 3, selfirst = (d0 >> 24) & 1;
            const int buf = it % AT_NBUF;
            if (selfirst) {
                { const int tok = 8 * w + (lane >> 3), s0 = 8 * (lane & 7);
                  unsigned key[8]; int rank[8];
#pragma unroll
                  for (int q = 0; q < 8; ++q) { const int sB = s0 + q; const bool vis = sB <= c, forced = (sB == 0) || (sB == c) || (sB == c - 1);
                      const float sc = vis ? (IMP1[tok * 65 + sB] + IMP2[tok * 65 + sB] + (forced ? 1000.f : 0.f)) : -1.f;
                      const unsigned u = __builtin_bit_cast(unsigned, sc); const unsigned fk = (u >> 31) ? ~u : (u | 0x80000000u);
                      key[q] = (fk & ~63u) | (unsigned)(63 - sB); rank[q] = 0; }
                  LAS unsigned* KEYS = (LAS unsigned*)IMP1;
#pragma unroll
                  for (int q = 0; q < 8; ++q) KEYS[tok * 65 + s0 + q] = key[q];
                  if (c >= 16 && !(VAR & 128)) {
#pragma unroll 8
                      for (int s2 = 0; s2 < 64; ++s2) { const unsigned k2 = KEYS[tok * 65 + s2];
#pragma unroll
                          for (int q = 0; q < 8; ++q) rank[q] += (k2 > key[q]) ? 1 : 0; } }
                  unsigned byte = 0u;
#pragma unroll
                  for (int q = 0; q < 8; ++q) byte |= ((rank[q] < 16 && (s0 + q) <= c) ? 1u : 0u) << q;
                  ((LAS unsigned char*)SELM)[tok * 8 + (lane & 7)] = (unsigned char)byte; }
            }
            const LAS unsigned char* kb_ = L + AT_OFF_K + buf * AT_KBUF; const LAS unsigned char* vb_ = L + AT_OFF_V + buf * AT_KBUF;
            const float cfar = LUTJ[127];
            unsigned selb[2] = {1u, 1u};
#define AT_CALL(TMX) at_tile<TMX, VAR>(kb_, vb_, LUTJ, IMP1, IMP2, qf, oacc, lacc, LROW, tok_r, selb, cfar, relbase, idx, l15, lq, tsw, tsn)
            if (mode == TM_SELF || mode == TM_SELN) { selb[0] = (unsigned)(SELM[tok_r[0]] >> idx) & 1u; selb[1] = (unsigned)(SELM[tok_r[1]] >> idx) & 1u; }
            if (mode == TM_SELF) {
                const bool a0 = __ballot(selb[0] != 0u) != 0ull, a1 = __ballot(selb[1] != 0u) != 0ull;
                if (a0 && a1) AT_CALL(TM_SELF);
                else if (a0) at_tile<TM_SELF, VAR, 1>(kb_, vb_, LUTJ, IMP1, IMP2, qf, oacc, lacc, LROW, tok_r, selb, cfar, relbase, idx, l15, lq, tsw, tsn);
                else if (a1) at_tile<TM_SELF, VAR, 2>(kb_, vb_, LUTJ, IMP1, IMP2, qf, oacc, lacc, LROW, tok_r, selb, cfar, relbase, idx, l15, lq, tsw, tsn); }
            else if (mode == TM_WINF) AT_CALL(TM_WINF);
            else if (mode == TM_SELN) AT_CALL(TM_SELN);
            else if (mode == TM_WINN) AT_CALL(TM_WINN);
            else if (mode == TM_WINE) AT_CALL(TM_WINE);
            else if (mode == TM_CMP2) AT_CALL(TM_CMP2);
            else if (mode == TM_CMP2F) AT_CALL(TM_CMP2F);
            else if (mode == TM_CMP1F) AT_CALL(TM_CMP1F);
            else { AT_CALL(TM_CMP1);
                if (idx == n1 - 1) {
#pragma unroll
                    for (int rb = 0; rb < 2; ++rb) { const float s = sum_xor32(sum_xor16(lacc[rb][0])); if (lq == 0) LROW[16 * rb + l15] = s > 0.f ? 1.0f / s : 0.f; lacc[rb] = (pg8::f32x4){0.f, 0.f, 0.f, 0.f}; } } }
#undef AT_CALL
            {
                if (endf && !(VAR & 256)) {
                    const int br = endf - 1;
#pragma unroll
                    for (int rb = 0; rb < 2; ++rb)
#pragma unroll
                        for (int r = 0; r < 4; ++r) { const int qrow = 16 * rb + 4 * lq + r;
                            const float ls_ = lacc[rb][r]; lacc[rb][r] = 0.f;
                            const float gt = GATL[(8 * w + 4 * rb + lq) * 12 + r * 3 + br] * (endf == 1 ? 1.0f : (ls_ > 0.f ? 1.0f / ls_ : 0.f));
#pragma unroll
                            for (int db = 0; db < 4; ++db) { float v = gt * oacc[rb][db][r]; oacc[rb][db][r] = 0.f;
                                LAS bf16* po = OUTL + qrow * 72 + 16 * db + l15;
                                if (br > 0) v += __builtin_bit_cast(float, (unsigned)(*po) << 16);
                                *po = (bf16)f2bf(v); } }
                    if (br == 2 && !(VAR & 1)) {
                        LDS_WAIT(); asm volatile("" ::: "memory");
#pragma unroll
                        for (int i = 0; i < 4; ++i) { const int ch = i * 64 + lane, row = ch >> 3, c16 = ch & 7;
                            const v4u o = *(const LAS v4u*)((const LAS unsigned char*)OUTL + row * 144 + 16 * c16);
                            *(GAS v4u*)(YA + (size_t)(m0 + 8 * w + (row >> 2)) * 1024 + g * 256 + (row & 3) * 64 + 8 * c16) = o; }
                    }
                }
            }
            }
            asm volatile("s_waitcnt lgkmcnt(0)" : "+v"(tdn) :: "memory");
            d0 = __builtin_amdgcn_readfirstlane(tdn.x); d1 = __builtin_amdgcn_readfirstlane(tdn.y); d2 = __builtin_amdgcn_readfirstlane(tdn.z); d3 = __builtin_amdgcn_readfirstlane(tdn.w);
        }
#undef AT_DMA
    }
}

constexpr int N_PHASES = 13;
#ifndef MK_ONE_LAUNCH
#define MK_ONE_LAUNCH 1
#endif
#ifndef REP_P0
#define REP_P0 1
#endif
#ifndef REP_P1
#define REP_P1 1
#endif
#ifndef REP_P2
#define REP_P2 1
#endif
#ifndef REP_P3
#define REP_P3 1
#endif
#ifndef REP_P5
#define REP_P5 1
#endif
#ifndef REP_P6
#define REP_P6 1
#endif
#ifndef REP_P8
#define REP_P8 1
#endif
#ifndef REP_P7
#define REP_P7 1
#endif
#ifndef REP_P11
#define REP_P11 1
#endif
#ifndef REP_P4
#define REP_P4 1
#endif
#ifndef REP_P9
#define REP_P9 1
#endif
#ifndef REP_P10
#define REP_P10 1
#endif
#ifndef MK_BUILD
#define MK_BUILD 0
#endif

#ifndef STAG_P2
#define STAG_P2 0
#endif
__device__ __forceinline__ void phase_stagger(const Frame& F, int step_ns) {
    const int grp = (F.bid >> 3) & 7;
    if (step_ns > 0 && grp > 0) { const unsigned long long t0 = wall_clock64(), dt = (unsigned long long)(grp * step_ns) / 10ull;
        while (wall_clock64() - t0 < dt) __builtin_amdgcn_s_sleep(8); }
}
struct EpiNull {
    static constexpr bool PERM = true, AFTER_DRAIN = false, MID = false;
    __device__ __forceinline__ void operator()(const pg8::f32x4 (&acc)[2][2][4][2], const pg8::Unit& u, int wr, int wc, int fr, int fq) const {
#pragma unroll
        for (int ai = 0; ai < 2; ++ai)
#pragma unroll
            for (int bj = 0; bj < 2; ++bj)
#pragma unroll
                for (int m = 0; m < 4; ++m) { asm volatile("" :: "v"(acc[ai][bj][m][0]), "v"(acc[ai][bj][m][1])); }
    }
};
__global__ void __launch_bounds__(NTHREADS, 2) fwd_kernel(Args args) {
    extern __shared__ __attribute__((aligned(16))) unsigned char lds[];
    Frame F;
    F.lds = (LAS unsigned char*)lds;
    F.MISC = (volatile LAS unsigned*)(F.lds + MISC_OFF);
    F.tid = threadIdx.x; F.lane = F.tid & 63; F.wave = __builtin_amdgcn_readfirstlane(F.tid >> 6);
    F.G = gridDim.x; F.bid = blockIdx.x; F.ws = args.ws;
    F.ctl = (gu32*)(args.ws + WS_CTL);
    for (int u = F.tid; u < (LDS_BYTES - LDSCTL_OFF) / 4; u += NTHREADS) ((LAS unsigned*)(F.lds + LDSCTL_OFF))[u] = 0u;
    __syncthreads();
    XcdBarrier bar; bar.bar = (unsigned*)(F.ctl + CW_BAR); bar.x = 0; bar.st = nullptr;
    if (MK_ONE_LAUNCH) bar = xcd_barrier_post((unsigned*)(F.ctl + CW_BAR), F.MISC + 8);
    const int lo = args.ph_lo, hi = args.ph_hi;
#define IN(k) (lo <= (k) && (k) < hi)
#define SEAM(k) do { if (IN(k) && IN((k) + 1)) xcd_barrier(bar); } while (0)
    unsigned char* ws = args.ws;
    const float* ada = (const float*)(ws + WS_ADA);

    if (IN(0)) { for (int rep = 0; rep < REP_P0; ++rep) { p0_prologue(F, args, rep == REP_P0 - 1); __syncthreads(); } } SEAM(0);
    if (IN(1)) { for (int rep = 0; rep < REP_P1; ++rep) {
        const int r0 = F.wave & 3;
        for (int k = 0; k < 4; ++k) { const int seg = (r0 + k) & 3;
            if (seg == 0) p0_stream_seg<0>(F, args); else if (seg == 1) p0_stream_seg<1>(F, args); else if (seg == 2) p0_stream_seg<2>(F, args);
            else modnorm_rows<false>(F, args.in[I_X], args.in[I_N1G], ada, 0, (bf16*)(ws + WS_H)); } } } SEAM(1);
    if (IN(2)) { {
        phase_stagger(F, STAG_P2);
        pg8::Gemm g{(const bf16*)(ws + WS_H), (const bf16*)(ws + WS_WIN_T), M, NIN, D, D, D}; pg8::StaticOrder S; S.init(M, NIN, F.G, F.bid);
        if (F.tid == 0) F.MISC[40] = 0xffffffffu; __syncthreads();
        EpiIn E{ws, args.in[I_QNG], args.in[I_KNG], F.MISC + 40};
#if defined(PROBE_P2) && PROBE_P2 == 1
        { EpiNull EN; pg8::gemm_phase<EpiNull, pg8::StaticOrder, true, true>(F.lds + RING_OFF, g, S, EN); __syncthreads(); }
#elif defined(PROBE_P2) && PROBE_P2 == 2
        { if (F.tid == 0) F.MISC[40] = 0u; __syncthreads(); pg8::gemm_phase<EpiIn, pg8::StaticOrder, true, true>(F.lds + RING_OFF, g, S, E); __syncthreads(); if (F.tid == 0) F.MISC[40] = 0xffffffffu; __syncthreads(); }
#endif
        pg8::gemm_phase<EpiIn, pg8::StaticOrder, true, true>(F.lds + RING_OFF, g, S, E);
#if REP_P2 > 1
        __syncthreads(); pg8::gemm_phase<EpiIn, pg8::StaticOrder, true, true>(F.lds + RING_OFF, g, S, E);
#endif
        }
    } SEAM(2);
#ifndef PROBE_P3
#define PROBE_P3 0
#endif
    if (IN(3)) { for (int rep = 0; rep < REP_P3; ++rep) { __syncthreads(); pool_phase(F); if (PROBE_P3 == 1) { __syncthreads(); pool_phase(F); }
        __syncthreads(); compress_phase(F, args.in[I_KNG]); if (PROBE_P3 == 2) { __syncthreads(); compress_phase(F, args.in[I_KNG]); }
        __syncthreads(); vtranspose_phase(F); if (PROBE_P3 == 3) { __syncthreads(); vtranspose_phase(F); } } } SEAM(3);
    if (IN(4)) {
#ifdef PROBE_P4
        attention_phase<PROBE_P4>(F, args); __syncthreads();
#endif
        for (int rep = 0; rep < REP_P4; ++rep) { attention_phase<0>(F, args); __syncthreads(); } } SEAM(4);
    if (IN(5)) { {
        pg8::Gemm g{(const bf16*)(ws + WS_PL), (const bf16*)(ws + WS_WEFF_T), M, D, 2 * POOLW, 2 * POOLW, 2 * POOLW}; pg8::StaticOrder S; S.init(M, D, F.G, F.bid);
        EpiMix2 E{(bf16*)(ws + WS_MIX), (const bf16*)(ws + WS_GM)};
        pg8::gemm_phase<EpiMix2, pg8::StaticOrder, true, true>(F.lds + RING_OFF, g, S, E);
#if REP_P5 > 1
        __syncthreads(); pg8::gemm_phase<EpiMix2, pg8::StaticOrder, true, true>(F.lds + RING_OFF, g, S, E);
#endif
        }
    } SEAM(5);
    if (IN(6)) { {
        pg8::Gemm g{(const bf16*)(ws + WS_MIX), (const bf16*)(ws + WS_WOUT_T), M, D, D, D, D}; pg8::StaticOrder S; S.init(M, D, F.G, F.bid);
        EpiRes E{args.in[I_X], (bf16*)(ws + WS_X1), ada, 2};
        pg8::gemm_phase<EpiRes, pg8::StaticOrder, true, true>(F.lds + RING_OFF, g, S, E);
#if REP_P6 > 1
        __syncthreads(); pg8::gemm_phase<EpiRes, pg8::StaticOrder, true, true>(F.lds + RING_OFF, g, S, E);
#endif
        }
    } SEAM(6);
    if (IN(7)) { for (int rep = 0; rep < REP_P7; ++rep) modnorm_rows<true>(F, ws + WS_X1, args.in[I_N2G], ada, 3, (bf16*)(ws + WS_H)); } SEAM(7);
    if (IN(8)) { {
        pg8::Gemm g{(const bf16*)(ws + WS_H), (const bf16*)(ws + WS_WQ_T), M, PQW, D, D, D}; pg8::StaticOrder S; S.init(M, PQW, F.G, F.bid);
        EpiStoreBf16 E{(bf16*)(ws + WS_QV), PQW};
        pg8::gemm_phase<EpiStoreBf16, pg8::StaticOrder, true, true>(F.lds + RING_OFF, g, S, E);
#if REP_P8 > 1
        __syncthreads(); pg8::gemm_phase<EpiStoreBf16, pg8::StaticOrder, true, true>(F.lds + RING_OFF, g, S, E);
#endif
        }
    } SEAM(8);
    if (IN(9)) { for (int rep = 0; rep < REP_P9; ++rep) peer_select_phase(F); } SEAM(9);
#ifdef PROBE_XCD
    if (IN(10)) { if (F.tid == 0) __hip_atomic_store((unsigned*)(F.ctl + 2048 + F.bid), 100u + xb_xcc_id(), RLX_AGENT); }
#endif
    if (IN(10)) {
#ifdef PROBE_DOT
        peer_dot_phase<PROBE_DOT>(F); __syncthreads();
#endif
#ifdef PROBE_LOADRATE
        peer_loadrate_probe<PROBE_LOADRATE>(F); __syncthreads();
#endif
        peer_dot_phase<0>(F); } SEAM(10);
    if (IN(11)) { for (int rep = 0; rep < REP_P11; ++rep) peer_coef_phase(F); } SEAM(11);
#ifdef PROBE_XCD
    if (IN(12) && F.bid == 0 && F.tid == 0) { bool ok = true; for (int i = 0; i < F.G; ++i) { const unsigned a = __hip_atomic_load((unsigned*)(F.ctl + 2048 + i), RLX_AGENT), b0 = __hip_atomic_load((unsigned*)(F.ctl + 2048 + (i & 7)), RLX_AGENT); if (a != b0 || a < 100u) ok = false; }
        for (int i = 0; i < 8; ++i) for (int q = 0; q < i; ++q) if (__hip_atomic_load((unsigned*)(F.ctl + 2048 + i), RLX_AGENT) == __hip_atomic_load((unsigned*)(F.ctl + 2048 + q), RLX_AGENT)) ok = false;
        if (!ok) args.out[12345] = 1.0e9f; }
    __syncthreads();
#endif
    if (IN(12)) {
#if defined(CHECK_OUT_MFMA)
        peer_out_mfma_phase<1>(F, ada, args.out); __syncthreads(); VM_WAIT(); __syncthreads(); peer_out_phase<false, true>(F, ada, args.out);
#elif defined(OUT_VALU)
        for (int rep = 1; rep < REP_P10; ++rep) peer_out_phase<true>(F, ada, args.out); peer_out_phase<false>(F, ada, args.out);
#else
#ifdef PROBE_OUT
        peer_out_mfma_phase<1>(F, ada, args.out); __syncthreads();
#endif
        peer_out_mfma_phase<0>(F, ada, args.out);
#endif
    }
#undef IN
#undef SEAM
}

extern "C" void kernel_launch(void* const* d_in, const int* in_sizes, int n_in, void* d_out, int out_size, void* d_ws, size_t ws_size, hipStream_t stream) {
    static int grid = 0;
    if (grid == 0) {
        if (n_in != N_IN || in_sizes[0] != M * D || out_size != M * D || ws_size < WS_END) {
            fprintf(stderr, "kernel_launch: unexpected shapes: n_in %d in0 %d out %d ws %zu (need %zu)\n", n_in, n_in > 0 ? in_sizes[0] : -1, out_size, ws_size, (size_t)WS_END); grid = -1; return; }
        int dev = 0, cus = 0, per_cu = 0;
        if (hipGetDevice(&dev) != hipSuccess || hipDeviceGetAttribute(&cus, hipDeviceAttributeMultiprocessorCount, dev) != hipSuccess) { grid = -1; return; }
        if (hipFuncSetAttribute((const void*)fwd_kernel, hipFuncAttributeMaxDynamicSharedMemorySize, LDS_BYTES) != hipSuccess) { fprintf(stderr, "kernel_launch: hipFuncSetAttribute failed\n"); grid = -1; return; }
        if (hipOccupancyMaxActiveBlocksPerMultiprocessor(&per_cu, (const void*)fwd_kernel, NTHREADS, LDS_BYTES) != hipSuccess || per_cu < 1)
            fprintf(stderr, "kernel_launch: occupancy query reports %d workgroups per CU\n", per_cu);
        (void)hipGetLastError();
        grid = cus;
    }
    if (grid < 0) return;
    if (hipMemsetAsync((char*)d_ws + WS_CTL, 0, CTL_ZERO_BYTES, stream) != hipSuccess) return;
    Args a{};
    for (int i = 0; i < N_IN; ++i) a.in[i] = (const float*)d_in[i];
    a.out = (float*)d_out; a.ws = (unsigned char*)d_ws;
    if (MK_ONE_LAUNCH) {
        a.ph_lo = 0; a.ph_hi = N_PHASES; a.li = 0;
        hipLaunchKernelGGL(fwd_kernel, dim3(grid), dim3(NTHREADS), LDS_BYTES, stream, a);
    } else {
        for (int p = 0; p < N_PHASES; ++p) {
            a.ph_lo = p; a.ph_hi = p + 1; a.li = p;
            hipLaunchKernelGGL(fwd_kernel, dim3(grid), dim3(NTHREADS), LDS_BYTES, stream, a);
        }
    }
}
```

```cpp
#include <hip/hip_runtime.h>
#include <cstdio>
#include <cstdint>
namespace pg8 {
#define PG8_LAS __attribute__((address_space(3)))
typedef unsigned short bf16_t;
typedef short bf16x8 __attribute__((ext_vector_type(8)));
typedef float f32x4 __attribute__((ext_vector_type(4)));
typedef unsigned u32x4 __attribute__((ext_vector_type(4)));
constexpr int BM = 256, BK = 64, HALF = 128, HTB = HALF * BK * 2  , STAGE_BYTES = 8 * HTB, NXCD = 8, WGM = 8;

__host__ __device__ __forceinline__ int lds_byte(int r, int c) { const int st = (r >> 4) * 2 + (c >> 5), rr = r & 15, cc = c & 31, ob = rr * 64 + cc * 2; return st * 1024 + (ob ^ (((ob >> 9) & 1) << 5)); }
__host__ __device__ __forceinline__ void stage_rc(int b, int& R, int& C) { const int st = b / 1024, sb = b % 1024, swz = sb ^ (((sb >> 9) & 1) << 5); R = (st >> 1) * 16 + swz / 64; C = (st & 1) * 32 + (swz % 64) / 2; }
__host__ __device__ __forceinline__ int perm32(int rho) { const int n = rho >> 4, i = rho & 15; return 8 * (i >> 2) + 4 * n + (i & 3); }

struct Unit { int pm, pn; };
struct Gemm { const bf16_t* A; const bf16_t* Bt; int M, N, K, lda, ldb; };

struct StaticOrder {
    int nM, nN, nwg, G, c;
    __host__ __device__ void init(int M, int N, int G_, int c_) { nM = M / BM; nN = N / BM; nwg = nM * nN; G = G_; c = c_; }
    __host__ __device__ bool next(int i, Unit& u) const {
        const long L = (long)i * G + c; if (L >= nwg) return false;
        int wgid = (int)L; { const int q = nwg / NXCD, r = nwg % NXCD, xcd = wgid % NXCD, off = wgid / NXCD; wgid = (xcd < r ? xcd * (q + 1) : r * (q + 1) + (xcd - r) * q) + off; }
        const int nig = WGM * nN, gid = wgid / nig, fm = gid * WGM, gsz = (nM - fm) < WGM ? (nM - fm) : WGM;
        u.pm = fm + ((wgid % nig) % gsz); u.pn = (wgid % nig) / gsz; return true;
    }
    __device__ __forceinline__ void a_ready(const Unit&) const {}
    __device__ __forceinline__ void done(const Unit&) const {}
};

__device__ __forceinline__ unsigned cvt_pk_bf16(float lo, float hi) { unsigned r; asm volatile("v_cvt_pk_bf16_f32 %0, %1, %2" : "=v"(r) : "v"(lo), "v"(hi)); return r; }
template <class Epi, class Sched, bool ALIGN_EPI = false, bool SP2 = false>
__device__ __forceinline__ void gemm_phase(PG8_LAS unsigned char* lds, const Gemm g, const Sched& S, const Epi& E) {
    const int tid = threadIdx.x, wid = __builtin_amdgcn_readfirstlane(tid >> 6), lane = tid & 63, wr = wid >> 2, wc = wid & 3, fr = lane & 15, fq = lane >> 4;
    const int K = g.K, nt = K / BK;
    unsigned voffA[2], voffB[2];
#pragma unroll
    for (int i = 0; i < 2; ++i) { int R, C; stage_rc(tid * 16 + i * 8192, R, C); const int Rb = Epi::PERM ? ((R & ~31) + perm32(R & 31)) : R;
        voffA[i] = (unsigned)(R * g.lda + C) * 2u; voffB[i] = (unsigned)(Rb * g.ldb + C) * 2u; }
    const size_t kstep = (size_t)(BK * 2);
    const size_t hstepA = (size_t)HALF * g.lda * 2, hstepB = (size_t)HALF * g.ldb * 2;
    const size_t tstepA = 2 * hstepA, tstepB = 2 * hstepB;
    const unsigned ldsw = (unsigned)wid * 1024u;
    const int aoff = lds_byte(wr * 64 + fr, fq * 8), boff = lds_byte(wc * 32 + fr, fq * 8);
#define PG8_SA(b, h) (((b) * 2 + (h)) * HTB)
#define PG8_SB(b, h) ((4 + (b) * 2 + (h)) * HTB)
#define PG8_STAGE(bufoff, gbase, voff) do { _Pragma("unroll") for (int _i = 0; _i < 2; ++_i) \
        __builtin_amdgcn_global_load_lds((const unsigned*)((const char*)(gbase) + (voff)[_i]), (PG8_LAS unsigned*)(lds + (bufoff) + ldsw + _i * 8192), 16, 0, 0); } while (0)
#define PG8_LDA(dst, b, h) do { _Pragma("unroll") for (int m = 0; m < 4; ++m) _Pragma("unroll") for (int k = 0; k < 2; ++k) dst[m][k] = *(const PG8_LAS bf16x8*)(lds + PG8_SA(b, h) + aoff + m * 2048 + k * 1024); } while (0)
#define PG8_LDB(dst, b, h) do { _Pragma("unroll") for (int n = 0; n < 2; ++n) _Pragma("unroll") for (int k = 0; k < 2; ++k) dst[n][k] = *(const PG8_LAS bf16x8*)(lds + PG8_SB(b, h) + boff + n * 2048 + k * 1024); } while (0)
#define PG8_MMA(ai, bj, At, Bt) do { __builtin_amdgcn_s_setprio(1); _Pragma("unroll") for (int m = 0; m < 4; ++m) _Pragma("unroll") for (int n = 0; n < 2; ++n) _Pragma("unroll") for (int k = 0; k < 2; ++k) \
        acc[ai][bj][m][n] = __builtin_amdgcn_mfma_f32_16x16x32_bf16(Bt[n][k], At[m][k], acc[ai][bj][m][n], 0, 0, 0); __builtin_amdgcn_s_setprio(0); } while (0)
#define PG8_WAIT_V(n) asm volatile("s_waitcnt vmcnt(" #n ")" ::: "memory")
#define PG8_WAIT_L(n) asm volatile("s_waitcnt lgkmcnt(" #n ")" ::: "memory")
#define PG8_BAR __builtin_amdgcn_s_barrier()
#define PG8_SCHED __builtin_amdgcn_sched_barrier(0)
    Unit cur, nxt; int ui = 0;
    if (!S.next(0, cur)) return;
    f32x4 acc[2][2][4][2];
#pragma unroll
    for (int a = 0; a < 2; ++a)
#pragma unroll
        for (int b = 0; b < 2; ++b)
#pragma unroll
            for (int m = 0; m < 4; ++m)
#pragma unroll
                for (int n = 0; n < 2; ++n) acc[a][b][m][n] = (f32x4){0.f, 0.f, 0.f, 0.f};
    bf16x8 At[4][2], B0[2][2], B1[2][2];
    const char* cA = (const char*)g.A + (size_t)cur.pm * tstepA; const char* cB = (const char*)g.Bt + (size_t)cur.pn * tstepB;
    S.a_ready(cur);
    if constexpr (SP2) {
        PG8_STAGE(PG8_SB(0, 0), cB, voffB); PG8_STAGE(PG8_SB(0, 1), cB + hstepB, voffB); PG8_STAGE(PG8_SA(0, 0), cA, voffA); PG8_STAGE(PG8_SA(0, 1), cA + hstepA, voffA);
        if (wr == 1) PG8_BAR;
        PG8_WAIT_V(2); PG8_BAR;
        PG8_STAGE(PG8_SB(1, 0), cB + kstep, voffB); PG8_STAGE(PG8_SA(1, 0), cA + kstep, voffA); PG8_STAGE(PG8_SB(1, 1), cB + hstepB + kstep, voffB);
        PG8_WAIT_V(6); PG8_BAR;
    } else {
        PG8_STAGE(PG8_SB(0, 0), cB, voffB); PG8_STAGE(PG8_SA(0, 0), cA, voffA); PG8_STAGE(PG8_SB(0, 1), cB + hstepB, voffB); PG8_STAGE(PG8_SA(0, 1), cA + hstepA, voffA);
        if (wr == 1) PG8_BAR;
        PG8_WAIT_V(4); PG8_BAR;
        PG8_STAGE(PG8_SB(1, 0), cB + kstep, voffB); PG8_STAGE(PG8_SA(1, 0), cA + kstep, voffA); PG8_STAGE(PG8_SB(1, 1), cB + hstepB + kstep, voffB);
        PG8_WAIT_V(6); PG8_BAR;
    }
    for (;;) {
        const bool has_next = S.next(ui + 1, nxt);
        const char* nA = has_next ? (const char*)g.A + (size_t)nxt.pm * tstepA : cA; const char* nB = has_next ? (const char*)g.Bt + (size_t)nxt.pn * tstepB : cB;
        for (int t = 0; t < nt; t += 2) {
            if constexpr (Epi::MID) { if (t == nt / 2) E.mid(acc, cur, wr, wc, fr, fq); }
            const bool last = (t == nt - 2);
            const char* a1 = cA + (size_t)(t + 1) * kstep;
            const char* a2 = last ? nA : cA + (size_t)(t + 2) * kstep; const char* b2 = last ? nB : cB + (size_t)(t + 2) * kstep;
            const char* a3 = a2 + kstep; const char* b3 = b2 + kstep;
            if (last && has_next) S.a_ready(nxt);
            if constexpr (SP2) {
            PG8_LDB(B0, 0, 0); PG8_LDB(B1, 0, 1); PG8_SCHED; PG8_LDA(At, 0, 0); PG8_STAGE(PG8_SA(1, 1), a1 + hstepA, voffA);
            PG8_WAIT_V(8); PG8_WAIT_L(0); PG8_BAR; PG8_MMA(0, 0, At, B0); PG8_MMA(0, 1, At, B1); PG8_BAR; PG8_SCHED;
            PG8_LDA(At, 0, 1); PG8_STAGE(PG8_SB(0, 0), b2, voffB); PG8_STAGE(PG8_SB(0, 1), b2 + hstepB, voffB); PG8_STAGE(PG8_SA(0, 0), a2, voffA);
            PG8_WAIT_V(8); PG8_WAIT_L(0); PG8_BAR; PG8_MMA(1, 0, At, B0); PG8_MMA(1, 1, At, B1); PG8_BAR; PG8_SCHED;
            PG8_LDB(B0, 1, 0); PG8_LDB(B1, 1, 1); PG8_SCHED; PG8_LDA(At, 1, 0); PG8_STAGE(PG8_SA(0, 1), a2 + hstepA, voffA);
            PG8_WAIT_V(8); PG8_WAIT_L(0); PG8_BAR; PG8_MMA(0, 0, At, B0); PG8_MMA(0, 1, At, B1); PG8_BAR; PG8_SCHED;
            PG8_LDA(At, 1, 1); PG8_STAGE(PG8_SB(1, 0), b3, voffB); PG8_STAGE(PG8_SB(1, 1), b3 + hstepB, voffB); PG8_STAGE(PG8_SA(1, 0), a3, voffA);
            PG8_WAIT_V(8); PG8_WAIT_L(0); PG8_BAR; PG8_MMA(1, 0, At, B0); PG8_MMA(1, 1, At, B1); PG8_BAR; PG8_SCHED;
            } else {
            PG8_LDB(B0, 0, 0); PG8_SCHED; PG8_LDA(At, 0, 0); PG8_STAGE(PG8_SA(1, 1), a1 + hstepA, voffA);
            PG8_WAIT_L(8); PG8_BAR; PG8_WAIT_L(0); PG8_MMA(0, 0, At, B0); PG8_BAR; PG8_SCHED;
            PG8_LDB(B1, 0, 1); PG8_STAGE(PG8_SB(0, 0), b2, voffB);
            PG8_BAR; PG8_WAIT_L(0); PG8_MMA(0, 1, At, B1); PG8_BAR;
            PG8_LDA(At, 0, 1); PG8_STAGE(PG8_SA(0, 0), a2, voffA);
            PG8_BAR; PG8_WAIT_L(0); PG8_MMA(1, 0, At, B0); PG8_BAR; PG8_SCHED;
            PG8_STAGE(PG8_SB(0, 1), b2 + hstepB, voffB);
            PG8_WAIT_V(6); PG8_BAR; PG8_MMA(1, 1, At, B1); PG8_BAR;
            PG8_LDB(B0, 1, 0); PG8_SCHED; PG8_LDA(At, 1, 0); PG8_STAGE(PG8_SA(0, 1), a2 + hstepA, voffA);
            PG8_WAIT_L(8); PG8_BAR; PG8_WAIT_L(0); PG8_MMA(0, 0, At, B0); PG8_BAR; PG8_SCHED;
            PG8_LDB(B1, 1, 1); PG8_STAGE(PG8_SB(1, 0), b3, voffB);
            PG8_BAR; PG8_WAIT_L(0); PG8_MMA(0, 1, At, B1); PG8_BAR;
            PG8_LDA(At, 1, 1); PG8_STAGE(PG8_SA(1, 0), a3, voffA);
            PG8_BAR; PG8_WAIT_L(0); PG8_MMA(1, 0, At, B0); PG8_BAR; PG8_SCHED;
            PG8_STAGE(PG8_SB(1, 1), b3 + hstepB, voffB);
            PG8_WAIT_V(6); PG8_BAR; PG8_MMA(1, 1, At, B1); PG8_BAR;
            }
        }
        if constexpr (ALIGN_EPI) { if (wr == 0) PG8_BAR; }
        if constexpr (!Epi::AFTER_DRAIN) { E(acc, cur, wr, wc, fr, fq); S.done(cur); }
        if (!has_next) break;
#pragma unroll
        for (int a = 0; a < 2; ++a)
#pragma unroll
            for (int b = 0; b < 2; ++b)
#pragma unroll
                for (int m = 0; m < 4; ++m)
#pragma unroll
                    for (int n = 0; n < 2; ++n) acc[a][b][m][n] = (f32x4){0.f, 0.f, 0.f, 0.f};
        cur = nxt; cA = nA; cB = nB; ++ui;
        if constexpr (ALIGN_EPI) { if (wr == 1) PG8_BAR; }
    }
    PG8_WAIT_V(0);
    if constexpr (!ALIGN_EPI) { if (wr == 0) PG8_BAR; }
    PG8_BAR;
    if constexpr (Epi::AFTER_DRAIN) { E.fused(acc, cur, wr, wc, fr, fq, lds, wid, lane); S.done(cur); }
#undef PG8_SA
#undef PG8_SB
#undef PG8_STAGE
#undef PG8_LDA
#undef PG8_LDB
#undef PG8_MMA
#undef PG8_WAIT_V
#undef PG8_WAIT_L
#undef PG8_BAR
#undef PG8_SCHED
}
}

constexpr int NWAVES = 8, NTHREADS = NWAVES * 64;
constexpr int BATCH = 8, SEQ = 4096, D = 1024, M = BATCH * SEQ;
constexpr int POOLW = 512, QW = 512, NG = 2, HD = 64, NBG = BATCH * NG;
constexpr int IN_COLS = 3864, NIN = 4096;
constexpr int NCMP = 255, NCMP_PAD = 256, NSEL = 64;
constexpr int PH = 8, PK = 128, PTOP = 16, PQD = 256, PQW = PH * PQD;
constexpr int NEXP = PK * PK;
constexpr float EPS = 1e-6f;
enum { I_X = 0, I_C, I_RELB, I_ADAW, I_ADAB, I_N1G, I_N2G, I_WIN, I_POOLW, I_POOLS, I_CPEK, I_CW1K, I_CW2K, I_CPEV, I_CW1V, I_CW2V, I_QNG, I_KNG, I_WBP, I_WBA, I_WOUT, I_PWQ, I_PSK, I_PU, I_PV, N_IN };

constexpr size_t MiB = 1u << 20, KiB = 1u << 10;
constexpr size_t WS_CTL = 0, CTL_ZERO_BYTES = 1 * MiB;
constexpr size_t WS_ADA = 1 * MiB;
constexpr size_t WS_CB1K = 64 * KiB;
constexpr size_t WS_CB1V = WS_CB1K + 1 * KiB;
constexpr size_t WS_BIASL = WS_ADA + 256 * KiB;
constexpr size_t WS_WIN_T = 2 * MiB;
constexpr size_t WS_WEFF_T = 10 * MiB;
constexpr size_t WS_WBA_T = 11 * MiB;
constexpr size_t WS_WOUT_T = 12 * MiB;
constexpr size_t WS_WQ_T = 14 * MiB;
constexpr size_t WS_SUBK = 18 * MiB;
constexpr size_t WS_CW1K_T = 18 * MiB + 512 * KiB;
constexpr size_t WS_CW1V_T = 19 * MiB;
constexpr size_t WS_CW2K_T = 19 * MiB + 512 * KiB;
constexpr size_t WS_CW2V_T = WS_CW2K_T + 64 * KiB;
constexpr size_t WS_KC = 20 * MiB;
constexpr size_t WS_VCT = 20 * MiB + 512 * KiB;
constexpr size_t WS_GATE = 21 * MiB;
constexpr size_t WS_UB = 24 * MiB;
constexpr size_t WS_VB = 56 * MiB;
constexpr size_t WS_SCLU = WS_UB + 16 * MiB, WS_SCLV = WS_SCLU + 64 * KiB;
constexpr size_t WS_H = 88 * MiB;
constexpr size_t WS_ZP = 152 * MiB;
constexpr size_t WS_Q = 184 * MiB;
constexpr size_t WS_KCR = 216 * MiB;
constexpr size_t WS_VCR = 225 * MiB;
constexpr size_t WS_KS = 234 * MiB, WS_VS = 242 * MiB, WS_KW = 250 * MiB, WS_VW = 258 * MiB;
constexpr size_t WS_VST = 266 * MiB, WS_VWT = 274 * MiB;
constexpr size_t WS_PL = 282 * MiB;
constexpr size_t WS_YA = 314 * MiB;
constexpr size_t WS_GM = 346 * MiB;
constexpr size_t WS_MIX = WS_ZP;
constexpr size_t WS_QV = WS_GM;
constexpr size_t WS_EID = WS_PL;
constexpr size_t WS_GW = WS_PL + 16 * MiB;
constexpr size_t WS_PART = WS_GM;
constexpr size_t WS_CF = WS_YA;
constexpr size_t WS_CFS = WS_YA + 8 * MiB;
constexpr size_t WS_H8 = WS_ZP;
constexpr size_t WS_HS = WS_ZP + 32 * MiB;
constexpr size_t WS_X1 = WS_KCR;
constexpr size_t WS_END = 474 * MiB;
constexpr int CW_TMO = 0, CW_CODE = 1, CW_BAR = 4096;

constexpr int RING_OFF = 0, RING_BYTES = 131072;
constexpr int LDSCTL_OFF = RING_BYTES, MISC_OFF = LDSCTL_OFF + 320;
constexpr int LDS_BYTES = 147456;

#define GAS __attribute__((address_space(1)))
#define LAS __attribute__((address_space(3)))
typedef unsigned short bf16;
typedef unsigned v4u __attribute__((ext_vector_type(4)));
typedef unsigned v2u __attribute__((ext_vector_type(2)));
typedef int v2i __attribute__((ext_vector_type(2)));
typedef float f32x4 __attribute__((ext_vector_type(4)));
typedef short bf16x8 __attribute__((ext_vector_type(8)));
typedef GAS unsigned gu32;
#define RLX_AGENT __ATOMIC_RELAXED, __HIP_MEMORY_SCOPE_AGENT
#define LDS_WAIT() asm volatile("s_waitcnt lgkmcnt(0)" ::: "memory")
#define VM_WAIT() asm volatile("s_waitcnt vmcnt(0)" ::: "memory")
__device__ __forceinline__ unsigned f2bf(float f) { unsigned u = __builtin_bit_cast(unsigned, f); return (u + 0x7fffu + ((u >> 16) & 1u)) >> 16; }
__device__ __forceinline__ unsigned pk2(float lo, float hi) { return f2bf(lo) | (f2bf(hi) << 16); }
__device__ __forceinline__ float bflo(unsigned w) { return __builtin_bit_cast(float, w << 16); }
__device__ __forceinline__ float bfhi(unsigned w) { return __builtin_bit_cast(float, w & 0xffff0000u); }
__device__ __forceinline__ float sigmoidf_(float v) { return __builtin_amdgcn_rcpf(1.0f + __builtin_amdgcn_exp2f(v * -1.4426950408889634f)); }
typedef __bf16 bf16x2_hw __attribute__((ext_vector_type(2)));
typedef float f32x2_hw __attribute__((ext_vector_type(2)));
__device__ __forceinline__ unsigned pkh(float lo, float hi) { return __builtin_bit_cast(unsigned, __builtin_convertvector((f32x2_hw){lo, hi}, bf16x2_hw)); }
__device__ __forceinline__ float gelu_tanh_safe(float v) { const float u = 0.7978845608028654f * (v + 0.044715f * v * v * v); return 0.5f * v * (1.0f + tanhf(u)); }
template <int CTRL> __device__ __forceinline__ float dppf(float v) { return __builtin_bit_cast(float, __builtin_amdgcn_update_dpp(0, __builtin_bit_cast(int, v), CTRL, 0xF, 0xF, true)); }
template <int CTRL> __device__ __forceinline__ int dppi(int v) { return __builtin_amdgcn_update_dpp(0, v, CTRL, 0xF, 0xF, true); }
#define DPP_XOR1 0xB1
#define DPP_XOR2 0x4E
#define DPP_HMIR 0x141
#define DPP_ROR8 0x128
__device__ __forceinline__ void swap16_(float& a, float& b) { asm volatile("v_nop\n\tv_nop\n\tv_permlane16_swap_b32 %0, %1" : "+v"(a), "+v"(b)); }
__device__ __forceinline__ void swap32_(float& a, float& b) { asm volatile("v_nop\n\tv_nop\n\tv_permlane32_swap_b32 %0, %1" : "+v"(a), "+v"(b)); }
__device__ __forceinline__ float sum_xor16(float v) { float a = v, b = v; swap16_(a, b); return a + b; }
__device__ __forceinline__ float sum_xor32(float v) { float a = v, b = v; swap32_(a, b); return a + b; }
__device__ __forceinline__ float max_xor16(float v) { float a = v, b = v; swap16_(a, b); return fmaxf(a, b); }
__device__ __forceinline__ float max_xor32(float v) { float a = v, b = v; swap32_(a, b); return fmaxf(a, b); }
__device__ __forceinline__ float wave_sum(float v) {
    v += dppf<DPP_XOR1>(v); v += dppf<DPP_XOR2>(v); v += dppf<DPP_HMIR>(v); v += dppf<DPP_ROR8>(v);
    return sum_xor32(sum_xor16(v));
}
__device__ __forceinline__ float wave_max(float v) {
    v = fmaxf(v, dppf<DPP_XOR1>(v)); v = fmaxf(v, dppf<DPP_XOR2>(v)); v = fmaxf(v, dppf<DPP_HMIR>(v)); v = fmaxf(v, dppf<DPP_ROR8>(v));
    return max_xor32(max_xor16(v));
}

#define XB_TMO      128
#define XB_XCNT(j)  (256  + 64 * (j))
#define XB_XSUB(j)  (1280 + 64 * (j))
#define XB_XGEN(j)  (2304 + 64 * (j))
#define XB_TOP      3328
#define XB_TOPGEN   3392
#define XCD_BAR_WORDS 3456
#define XB_SPIN_CAP (1u << 18)
__device__ __forceinline__ unsigned xb_ld(unsigned* p)              { return __hip_atomic_load(p, __ATOMIC_RELAXED, __HIP_MEMORY_SCOPE_AGENT); }
__device__ __forceinline__ unsigned xb_add(unsigned* p, unsigned v) { return __hip_atomic_fetch_add(p, v, __ATOMIC_RELAXED, __HIP_MEMORY_SCOPE_AGENT); }
__device__ __forceinline__ unsigned xb_xcc_id() { return (unsigned)__builtin_amdgcn_s_getreg((3 << 11) | 20) & 0xFu; }
#define XB_SPIN(cond, bar) do { unsigned _sp = 0; while (cond) { __builtin_amdgcn_s_sleep(1); \
    if ((++_sp & 255u) == 0u) { if (xb_ld(&(bar)[XB_TMO])) break; if (_sp > XB_SPIN_CAP) { atomicAdd(&(bar)[XB_TMO], 1u); break; } } } } while (0)
struct XcdBarrier { unsigned* bar; unsigned x; volatile LAS unsigned* st; };
__device__ __forceinline__ XcdBarrier xcd_barrier_post(unsigned* bar, volatile LAS unsigned* st) {
    XcdBarrier b; b.bar = bar; b.x = xb_xcc_id(); b.st = st;
    if (threadIdx.x == 0) (void)xb_add(&bar[XB_XCNT(b.x)], 1u);
    return b;
}
__device__ __forceinline__ void xcd_barrier_complete(unsigned* bar, unsigned x, unsigned& nloc, unsigned& nx) {
    const unsigned G = gridDim.x * gridDim.y * gridDim.z;
    unsigned sum, cnt, mine, sp = 0u;
    for (;;) {
        sum = 0u; cnt = 0u; mine = 0u;
#pragma unroll
        for (unsigned j = 0; j < 16; ++j) { const unsigned c = xb_ld(&bar[XB_XCNT(j)]); sum += c; cnt += (c > 0u) ? 1u : 0u; mine = (j == x) ? c : mine; }
        if (sum == G) break;
        __builtin_amdgcn_s_sleep(1);
        if ((++sp & 255u) == 0u) { if (xb_ld(&bar[XB_TMO])) break; if (sp > XB_SPIN_CAP) { atomicAdd(&bar[XB_TMO], 1u); break; } }
    }
    nloc = mine > 0u ? mine : 1u; nx = cnt > 0u ? cnt : 1u;
}
__device__ __forceinline__ void xcd_barrier(const XcdBarrier& b) {
    asm volatile("s_waitcnt vmcnt(0)" ::: "memory");
    __syncthreads();
    if (threadIdx.x == 0) {
        unsigned* bar = b.bar;
        __builtin_amdgcn_s_waitcnt(0);
        unsigned nloc = b.st[0], nx = b.st[1];
        if (nloc == 0u) { xcd_barrier_complete(bar, b.x, nloc, nx); b.st[0] = nloc; b.st[1] = nx; }
        const unsigned old = xb_add(&bar[XB_XSUB(b.x)], 1u);
        const unsigned gen = old / nloc;
        if (old + 1u == (gen + 1u) * nloc) {
            __builtin_amdgcn_fence(__ATOMIC_RELEASE, "agent");
            asm volatile("s_waitcnt vmcnt(0)" ::: "memory");
            const unsigned og = xb_add(&bar[XB_TOP], 1u);
            const unsigned tg = og / nx;
            if (og + 1u == (tg + 1u) * nx) xb_add(&bar[XB_TOPGEN], 1u);
            else XB_SPIN(xb_ld(&bar[XB_TOPGEN]) == tg, bar);
            __builtin_amdgcn_fence(__ATOMIC_ACQUIRE, "agent");
            xb_add(&bar[XB_XGEN(b.x)], 1u);
            asm volatile("s_waitcnt vmcnt(0)" ::: "memory");
        } else {
            XB_SPIN(xb_ld(&bar[XB_XGEN(b.x)]) == gen, bar);
            __builtin_amdgcn_fence(__ATOMIC_ACQUIRE, "agent");
            asm volatile("s_waitcnt vmcnt(0)" ::: "memory");
        }
    }
    __syncthreads();
}

struct Args { const float* in[N_IN]; float* out; unsigned char* ws; int ph_lo, ph_hi, li, pad; };
struct Frame {
    LAS unsigned char* lds;
    volatile LAS unsigned* MISC;
    gu32* ctl;
    int tid, lane, wave, G, bid;
    unsigned char* ws;
};

template <bool I8> __device__ __forceinline__ void cvt_row_store(const f32x4 (&v)[4], int row, unsigned char* dst, float* inv_scale, int lane) {
    float m = 0.f;
#pragma unroll
    for (int j = 0; j < 4; ++j) m = fmaxf(m, fmaxf(fmaxf(fabsf(v[j].x), fabsf(v[j].y)), fmaxf(fabsf(v[j].z), fabsf(v[j].w))));
    m = wave_max(m);
    unsigned ww[4]; float isc;
    if (I8) { const float sc = m > 0.f ? 127.0f / m : 0.f; isc = m * (1.0f / 127.0f);
#pragma unroll
        for (int j = 0; j < 4; ++j) { const int q0 = (int)rintf(v[j].x * sc), q1 = (int)rintf(v[j].y * sc), q2 = (int)rintf(v[j].z * sc), q3 = (int)rintf(v[j].w * sc);
            ww[j] = ((unsigned)q0 & 0xffu) | (((unsigned)q1 & 0xffu) << 8) | (((unsigned)q2 & 0xffu) << 16) | (((unsigned)q3 & 0xffu) << 24); } }
    else { const unsigned E = (__builtin_bit_cast(unsigned, m) >> 23) & 0xffu; float sc = 1.f; isc = 1.f;
        if (E >= 8u && E <= 250u) { sc = __builtin_bit_cast(float, (261u - E) << 23); isc = __builtin_bit_cast(float, (E - 7u) << 23); }
#pragma unroll
        for (int j = 0; j < 4; ++j) { int t = __builtin_amdgcn_cvt_pk_fp8_f32(v[j].x * sc, v[j].y * sc, 0, false); t = __builtin_amdgcn_cvt_pk_fp8_f32(v[j].z * sc, v[j].w * sc, t, true); ww[j] = (unsigned)t; } }
    *(GAS v4u*)(dst + (size_t)(lane >> 3) * NEXP * 128 + (size_t)row * 128 + 16 * (lane & 7)) = (v4u){ww[0], ww[1], ww[2], ww[3]};
    if (lane == 0) inv_scale[row] = isc;
}
template <bool I8> __device__ __forceinline__ void cvt_rows_8bit(const float* src, unsigned char* dst, float* inv_scale, int gw, int NGW, int lane) {
    for (int row = gw; row < NEXP; row += 2 * NGW) {
        const int row1 = row + NGW; const bool has1 = row1 < NEXP;
        f32x4 v0[4], v1[4];
#pragma unroll
        for (int j = 0; j < 4; ++j) v0[j] = *(const GAS f32x4*)(src + (size_t)row * D + 16 * lane + 4 * j);
#pragma unroll
        for (int j = 0; j < 4; ++j) v1[j] = has1 ? *(const GAS f32x4*)(src + (size_t)row1 * D + 16 * lane + 4 * j) : (f32x4){0.f, 0.f, 0.f, 0.f};
        cvt_row_store<I8>(v0, row, dst, inv_scale, lane);
        if (has1) cvt_row_store<I8>(v1, row1, dst, inv_scale, lane);
    }
}
__device__ __forceinline__ void p0_transpose_item(const float* W, int ldw, int src_col0, int valid, int K, bf16* WT, int dst_row0, int k0, LAS float* scr, int lane, int ldt = -1) {
    if (ldt < 0) ldt = K;
    const int n_ = lane & 31;
#pragma unroll 8
    for (int i = 0; i < 32; ++i) { const int kk = 2 * i + (lane >> 5); scr[kk * 33 + n_] = (n_ < valid) ? W[(size_t)(k0 + kk) * ldw + src_col0 + n_] : 0.f; }
    LDS_WAIT(); asm volatile("" ::: "memory");
    const int c = lane & 7;
#pragma unroll
    for (int j = 0; j < 4; ++j) { const int n = (lane >> 3) + 8 * j; const LAS float* s = scr + (8 * c) * 33 + n;
        v4u o; o.x = pk2(s[0 * 33], s[1 * 33]); o.y = pk2(s[2 * 33], s[3 * 33]); o.z = pk2(s[4 * 33], s[5 * 33]); o.w = pk2(s[6 * 33], s[7 * 33]);
        *(GAS v4u*)(WT + (size_t)(dst_row0 + n) * ldt + k0 + 8 * c) = o; }
    LDS_WAIT(); asm volatile("" ::: "memory");
}
__device__ __forceinline__ bool p0_mat(int& r, const float* W, int K, int N, bf16* WT, LAS float* scr, int lane, int ldt = -1) {
    const int ng = N / 32, items = ng * (K / 64);
    if (r < items) { const int kb = r / ng, nb = r % ng; p0_transpose_item(W, N, 32 * nb, 32, K, WT, 32 * nb, 64 * kb, scr, lane, ldt); return true; }
    r -= items; return false;
}
__device__ __forceinline__ void cvt_f32_bf16_stream(const float* src, bf16* dst, size_t n8, size_t gtid, size_t gthreads) {
    for (size_t i = gtid; i < n8; i += gthreads) {
        const f32x4 a = *(const GAS f32x4*)(src + 8 * i), b = *(const GAS f32x4*)(src + 8 * i + 4);
        v4u o; o.x = pk2(a.x, a.y); o.y = pk2(a.z, a.w); o.z = pk2(b.x, b.y); o.w = pk2(b.z, b.w);
        *(GAS v4u*)(dst + 8 * i) = o; }
}

__device__ __forceinline__ void p0_prologue(Frame& F, const Args& args, bool do_bias = true) {
    unsigned char* ws = F.ws;
    const int gw = F.bid * NWAVES + F.wave, NGW = F.G * NWAVES;
    const size_t gtid = (size_t)F.bid * NTHREADS + F.tid, gthreads = (size_t)F.G * NTHREADS;
    {
        LAS float* sl = (LAS float*)(F.lds);
        LAS float* red = (LAS float*)(F.lds + 32768);
        const float* c = args.in[I_C];
        { f32x4 cv[4];
#pragma unroll
          for (int q = 0; q < 4; ++q) cv[q] = *(const GAS f32x4*)(c + 4 * (F.tid + NTHREADS * q));
#pragma unroll
          for (int q = 0; q < 4; ++q) { f32x4 o; o.x = cv[q].x / (1.0f + __expf(-cv[q].x)); o.y = cv[q].y / (1.0f + __expf(-cv[q].y)); o.z = cv[q].z / (1.0f + __expf(-cv[q].z)); o.w = cv[q].w / (1.0f + __expf(-cv[q].w));
              *(LAS f32x4*)(sl + 4 * (F.tid + NTHREADS * q)) = o; } }
        __syncthreads();
        for (int cb = F.bid; cb < 6 * D / 24; cb += F.G) {
            const int j0 = cb * 24;
            if (F.tid < 510) {
                const int kk = F.tid / 6, c4 = F.tid % 6;
                const float* w = args.in[I_ADAW] + j0 + 4 * c4;
                f32x4 wv[13];
#pragma unroll
                for (int m = 0; m < 13; ++m) { const int k = kk + 85 * m; wv[m] = (k < D) ? *(const GAS f32x4*)(w + (size_t)k * (6 * D)) : (f32x4){0.f, 0.f, 0.f, 0.f}; }
                f32x4 a[BATCH];
#pragma unroll
                for (int b = 0; b < BATCH; ++b) a[b] = (f32x4){0.f, 0.f, 0.f, 0.f};
#pragma unroll
                for (int m = 0; m < 13; ++m) { const int k = kk + 85 * m; const int kc = k < D ? k : 0;
#pragma unroll
                    for (int b = 0; b < BATCH; ++b) a[b] = a[b] + wv[m] * sl[b * D + kc]; }
#pragma unroll
                for (int b = 0; b < BATCH; ++b) { LAS float* rp = red + (kk * 24 + 4 * c4) * BATCH + b; rp[0] = a[b].x; rp[BATCH] = a[b].y; rp[2 * BATCH] = a[b].z; rp[3 * BATCH] = a[b].w; }
            }
            __syncthreads();
            if (F.tid < 24 * BATCH) { const int jj = F.tid / BATCH, b = F.tid % BATCH; float s = 0.f;
#pragma unroll 5
                for (int kk = 0; kk < 85; ++kk) s += red[(kk * 24 + jj) * BATCH + b];
                ((float*)(ws + WS_ADA))[b * (6 * D) + j0 + jj] = s + args.in[I_ADAB][j0 + jj]; }
            __syncthreads();
        }
    }
    if (F.bid >= 8 && F.bid < 40 && do_bias) {
        const int bb = F.bid - 8, kv = bb & 1, ch = bb >> 1;
        const float* pe = args.in[kv == 0 ? I_CPEK : I_CPEV]; const float* w1 = args.in[kv == 0 ? I_CW1K : I_CW1V];
        LAS float* red = (LAS float*)(F.lds);
        const int j = F.tid & 127, ic = F.tid >> 7; float s = 0.f;
        const int i0 = ch * 128 + ic * 32;
#pragma unroll 8
        for (int i = i0; i < i0 + 32; ++i) s += pe[i] * w1[(size_t)i * 128 + j];
        red[ic * 128 + j] = s; __syncthreads();
        if (F.tid < 128) atomicAdd((float*)(ws + (kv == 0 ? WS_CB1K : WS_CB1V)) + F.tid, (red[F.tid] + red[128 + F.tid]) + (red[256 + F.tid] + red[384 + F.tid]));
        __syncthreads();
    } else if (F.bid == 2) {
        for (int i = F.tid; i < 8 * 128; i += NTHREADS) { const int h = i >> 7, rel = i & 127;
            int bk = rel;
            if (rel >= 16) bk = 16 + (rel >= 19) + (rel >= 21) + (rel >= 24) + (rel >= 27) + (rel >= 31) + (rel >= 35) + (rel >= 40) + (rel >= 46) + (rel >= 52) + (rel >= 59) + (rel >= 67) + (rel >= 77) + (rel >= 87) + (rel >= 99) + (rel >= 113);
            ((float*)(ws + WS_BIASL))[i] = args.in[I_RELB][bk * 8 + h]; }
        if (F.tid < 64) {
            float mq = fabsf(args.in[I_QNG][F.tid]), mk = fmaxf(fmaxf(fabsf(args.in[I_KNG][F.tid]), fabsf(args.in[I_KNG][64 + F.tid])), fabsf(args.in[I_KNG][128 + F.tid]));
            float mb = fmaxf(fmaxf(fabsf(args.in[I_RELB][F.tid]), fabsf(args.in[I_RELB][64 + F.tid])), fmaxf(fabsf(args.in[I_RELB][128 + F.tid]), fabsf(args.in[I_RELB][192 + F.tid])));
            mq = wave_max(mq); mk = wave_max(mk); mb = wave_max(mb);
            if (F.tid == 0) ((float*)(ws + WS_BIASL))[8 * 128] = 8.0f * mq * mk + mb; }
    }
    {
        const float* pw = args.in[I_POOLW]; const float* ps = args.in[I_POOLS]; const float* wbp = args.in[I_WBP];
        bf16* weff = (bf16*)(ws + WS_WEFF_T);
        LAS float* PWl = (LAS float*)(F.lds);
        LAS float* WBl = (LAS float*)(F.lds + 128 * 129 * 4);
        __syncthreads();
        for (int bb = F.bid; bb < 256; bb += F.G) {
            const int g = bb >> 6, d0 = (bb & 63) * 16;
            { f32x4 t[8];
#pragma unroll
              for (int q = 0; q < 8; ++q) t[q] = *(const GAS f32x4*)(pw + (size_t)g * 16384 + 4 * (F.tid + NTHREADS * q));
#pragma unroll
              for (int q = 0; q < 8; ++q) { const int i = 4 * (F.tid + NTHREADS * q); LAS float* d = PWl + (i >> 7) * 129 + (i & 127); d[0] = t[q].x; d[1] = t[q].y; d[2] = t[q].z; d[3] = t[q].w; }
              const int cc = F.tid >> 2, d4 = (F.tid & 3) * 4;
              const f32x4 wv = *(const GAS f32x4*)(wbp + (size_t)(g * 128 + cc) * D + d0 + d4); const float pv = ps[g * 128 + cc];
              LAS float* d = WBl + cc * 17 + d4; d[0] = wv.x * pv; d[1] = wv.y * pv; d[2] = wv.z * pv; d[3] = wv.w * pv; }
            __syncthreads();
            const int c = F.tid & 127, q = F.tid >> 7;
            float acc4[4] = {0.f, 0.f, 0.f, 0.f};
#pragma unroll 4
            for (int cc = 0; cc < 128; ++cc) { const float a = PWl[c * 129 + cc];
#pragma unroll
                for (int e = 0; e < 4; ++e) acc4[e] += a * WBl[cc * 17 + 4 * q + e]; }
#pragma unroll
            for (int e = 0; e < 4; ++e) weff[(size_t)(d0 + 4 * q + e) * 1024 + g * 128 + c] = (bf16)f2bf(acc4[e]);
            __syncthreads();
        }
    }
    {
        const float* wq = args.in[I_PWQ]; const float* sk = args.in[I_PSK]; bf16* wf = (bf16*)(ws + WS_WQ_T);
        const int l15 = F.lane & 15, lq = F.lane >> 4;
        for (int bb = F.bid; bb < 256; bb += F.G) {
            const int hp = bb >> 4, kg = bb & 15;
            bf16x8 bfr[4];
#pragma unroll
            for (int ks = 0; ks < 4; ++ks) { const float* sp = sk + ((size_t)hp * 128 + 16 * F.wave + l15) * 128 + 32 * ks + 8 * lq;
                const f32x4 s0 = *(const GAS f32x4*)sp, s1 = *(const GAS f32x4*)(sp + 4);
                bfr[ks] = __builtin_bit_cast(bf16x8, (v4u){pkh(s0.x, s0.y), pkh(s0.z, s0.w), pkh(s1.x, s1.y), pkh(s1.z, s1.w)}); }
#pragma unroll
            for (int cb = 0; cb < 4; ++cb) {
                pg8::f32x4 acc = (pg8::f32x4){0.f, 0.f, 0.f, 0.f};
#pragma unroll
                for (int ks = 0; ks < 4; ++ks) { const float* ap = wq + (size_t)(64 * kg + 16 * cb + l15) * PQW + hp * 128 + 32 * ks + 8 * lq;
                    const f32x4 a0 = *(const GAS f32x4*)ap, a1 = *(const GAS f32x4*)(ap + 4);
                    const bf16x8 af = __builtin_bit_cast(bf16x8, (v4u){pkh(a0.x, a0.y), pkh(a0.z, a0.w), pkh(a1.x, a1.y), pkh(a1.z, a1.w)});
                    acc = __builtin_amdgcn_mfma_f32_16x16x32_bf16(af, bfr[ks], acc, 0, 0, 0); }
                v2u o; o.x = pkh(acc[0], acc[1]); o.y = pkh(acc[2], acc[3]);
                *(GAS v2u*)(wf + (size_t)(hp * 128 + 16 * F.wave + l15) * D + 64 * kg + 16 * cb + 4 * lq) = o; }
        }
    }
}
template <int SEG> __device__ __forceinline__ void p0_stream_seg(Frame& F, const Args& args) {
    unsigned char* ws = F.ws;
    const int gw = F.bid * NWAVES + F.wave, NGW = F.G * NWAVES;
    if (SEG == 0) {
        {
            LAS float* scr = (LAS float*)(F.lds + F.wave * 16384);
            constexpr int I_WINT = (NIN / 32) * (D / 64);
            constexpr int NITEMS = I_WINT + (1024 / 32) * (512 / 64) + (1024 / 32) * (1024 / 64) + 2 * (128 / 32) * (2048 / 64) + 2 * (64 / 32) * (128 / 64);
            for (int it = gw; it < NITEMS; it += NGW) {
                int r = it;
                if (r < I_WINT) {
                    const int grp = r % (NIN / 32), kb = r / (NIN / 32);
                    const int tile = grp >> 3, ct0 = (grp & 7) * 32;
                    const int L0 = 64 * ((ct0 >> 5) & 3) + 32 * (ct0 >> 7);
                    int src0, valid = 32;
                    if (tile < 7) src0 = 256 * tile + L0; else if (tile < 15) src0 = 1816 + 256 * (tile - 7) + L0; else { src0 = 1792 + L0; valid = (L0 == 0) ? 24 : 0; }
                    if (valid == 0) src0 = 0;
                    p0_transpose_item(args.in[I_WIN], IN_COLS, src0, valid, D, (bf16*)(ws + WS_WIN_T), 32 * grp, 64 * kb, scr, F.lane);
                    continue; }
                r -= I_WINT;
                if (p0_mat(r, args.in[I_WBA], 512, 1024, (bf16*)(ws + WS_WEFF_T) + 512, scr, F.lane, 1024)) continue;
                if (p0_mat(r, args.in[I_WOUT], 1024, 1024, (bf16*)(ws + WS_WOUT_T), scr, F.lane)) continue;
                if (p0_mat(r, args.in[I_CW1K], 2048, 128, (bf16*)(ws + WS_CW1K_T), scr, F.lane)) continue;
                if (p0_mat(r, args.in[I_CW1V], 2048, 128, (bf16*)(ws + WS_CW1V_T), scr, F.lane)) continue;
                if (p0_mat(r, args.in[I_CW2K], 128, 64, (bf16*)(ws + WS_CW2K_T), scr, F.lane)) continue;
                p0_mat(r, args.in[I_CW2V], 128, 64, (bf16*)(ws + WS_CW2V_T), scr, F.lane);
            }
        }
    }
    if (SEG == 1) cvt_rows_8bit<true>(args.in[I_PU], ws + WS_UB, (float*)(ws + WS_SCLU), gw, NGW, F.lane);
    if (SEG == 2) cvt_rows_8bit<false>(args.in[I_PV], ws + WS_VB, (float*)(ws + WS_SCLV), gw, NGW, F.lane);
}

template <bool Q8> __device__ __forceinline__ void modnorm_rows(Frame& F, const void* xin, const float* g, const float* ada, int shift_idx, bf16* out) {
    const int gw = F.bid * NWAVES + F.wave, NGW = F.G * NWAVES;
    for (int m = gw; m < M; m += NGW) {
        const int b = m >> 12;
        const GAS f32x4* gr = (const GAS f32x4*)g + F.lane;
        const GAS f32x4* sh = (const GAS f32x4*)(ada + (size_t)b * 6 * D + shift_idx * D) + F.lane;
        const GAS f32x4* sc = (const GAS f32x4*)(ada + (size_t)b * 6 * D + (shift_idx + 1) * D) + F.lane;
        f32x4 v[4]; float s = 0.f;
#pragma unroll
        for (int j = 0; j < 4; ++j) {
            if (Q8) { const v2u xb = ((const GAS v2u*)((const bf16*)xin + (size_t)m * D))[F.lane + 64 * j]; v[j] = (f32x4){bflo(xb.x), bfhi(xb.x), bflo(xb.y), bfhi(xb.y)}; }
            else v[j] = ((const GAS f32x4*)((const float*)xin + (size_t)m * D))[F.lane + 64 * j];
            s += (v[j].x * v[j].x + v[j].y * v[j].y) + (v[j].z * v[j].z + v[j].w * v[j].w); }
        const float rstd = rsqrtf(wave_sum(s) * (1.f / D) + EPS);
        GAS v2u* o8 = (GAS v2u*)(out + (size_t)m * D) + F.lane;
        float mx = 0.f;
#pragma unroll
        for (int j = 0; j < 4; ++j) { const f32x4 gg = gr[64 * j], ss = sh[64 * j], cc = sc[64 * j];
            const f32x4 y = (v[j] * rstd) * gg * (cc + 1.0f) + ss; v[j] = y;
            mx = fmaxf(mx, fmaxf(fmaxf(fabsf(y.x), fabsf(y.y)), fmaxf(fabsf(y.z), fabsf(y.w))));
            v2u o; o.x = pk2(y.x, y.y); o.y = pk2(y.z, y.w); o8[64 * j] = o; }
        if (Q8) {
            mx = wave_max(mx);
            const float qs = mx > 0.f ? 127.0f / mx : 0.f;
            GAS unsigned* h8 = (GAS unsigned*)(F.ws + WS_H8 + (size_t)m * D) + F.lane;
#pragma unroll
            for (int j = 0; j < 4; ++j) { const int q0 = (int)rintf(v[j].x * qs), q1 = (int)rintf(v[j].y * qs), q2 = (int)rintf(v[j].z * qs), q3 = (int)rintf(v[j].w * qs);
                h8[64 * j] = ((unsigned)q0 & 0xffu) | (((unsigned)q1 & 0xffu) << 8) | (((unsigned)q2 & 0xffu) << 16) | (((unsigned)q3 & 0xffu) << 24); }
            if (F.lane == 0) ((float*)(F.ws + WS_HS))[m] = mx * (1.0f / 127.0f);
        }
    }
}

struct EpiIn {
    static constexpr bool PERM = true, AFTER_DRAIN = false, MID = false;
    unsigned char* ws; const float* qg; const float* kg; const volatile LAS unsigned* rmp;
    __device__ __forceinline__ void operator()(const pg8::f32x4 (&acc)[2][2][4][2], const pg8::Unit& u, int wr, int wc, int fr, int fq) const {
        const int pn = u.pn, rmask = __builtin_amdgcn_readfirstlane((int)*rmp);
#pragma unroll
        for (int ai = 0; ai < 2; ++ai)
#pragma unroll
            for (int m = 0; m < 4; ++m) {
                const int row = (u.pm & rmask) * 256 + ai * 128 + wr * 64 + m * 16 + fr;
                float v[2][8];
#pragma unroll
                for (int bj = 0; bj < 2; ++bj)
#pragma unroll
                    for (int n = 0; n < 2; ++n)
#pragma unroll
                        for (int i = 0; i < 4; ++i) v[bj][4 * n + i] = acc[ai][bj][m][n][i];
                bf16* dst = nullptr; bool norm = false; const float* gain = nullptr; float mul = 1.f; bool sig = false;
                if (pn < 2) { dst = (bf16*)(ws + WS_ZP) + (size_t)row * 512 + 256 * pn + 64 * wc; }
                else if (pn < 4) { dst = (bf16*)(ws + WS_Q) + (size_t)row * 512 + 256 * (pn - 2) + 64 * wc; norm = true; gain = qg; mul = 0.125f * 1.4426950408889634f; }
                else if (pn < 7) { const int kind = pn - 4, isv = wc >> 1, g = wc & 1, b = row >> 12, t = row & 4095;
                    const size_t base = ((size_t)(b * 2 + g) * SEQ + t) * 64;
                    const size_t off = kind == 0 ? (isv ? WS_VCR : WS_KCR) : kind == 1 ? (isv ? WS_VS : WS_KS) : (isv ? WS_VW : WS_KW);
                    dst = (bf16*)(ws + off) + base; if (!isv && kind > 0) { norm = true; gain = kg + kind * 64; } }
                else if (pn < 15) { dst = (bf16*)(ws + WS_GM) + (size_t)row * 2048 + 256 * (pn - 7) + 64 * wc; sig = true; }
                else {
                    if (wc == 0 && fq < 3) { float* gp = (float*)(ws + WS_GATE) + (size_t)row * 24 + 8 * fq;
                        *(GAS f32x4*)gp = (f32x4){sigmoidf_(v[0][0]), sigmoidf_(v[0][1]), sigmoidf_(v[0][2]), sigmoidf_(v[0][3])};
                        *(GAS f32x4*)(gp + 4) = (f32x4){sigmoidf_(v[0][4]), sigmoidf_(v[0][5]), sigmoidf_(v[0][6]), sigmoidf_(v[0][7])}; }
                    continue; }
                if (norm) { float ss = 0.f;
#pragma unroll
                    for (int bj = 0; bj < 2; ++bj)
#pragma unroll
                        for (int e = 0; e < 8; ++e) ss += v[bj][e] * v[bj][e];
                    ss = sum_xor32(sum_xor16(ss));
                    const float rs = rsqrtf(ss * (1.f / 64.f) + EPS) * mul;
#pragma unroll
                    for (int bj = 0; bj < 2; ++bj)
#pragma unroll
                        for (int e = 0; e < 8; ++e) v[bj][e] = v[bj][e] * rs * gain[32 * bj + 8 * fq + e]; }
                if (sig) {
#pragma unroll
                    for (int bj = 0; bj < 2; ++bj)
#pragma unroll
                        for (int e = 0; e < 8; ++e) v[bj][e] = sigmoidf_(v[bj][e]); }
#pragma unroll
                for (int bj = 0; bj < 2; ++bj) { v4u o; o.x = pkh(v[bj][0], v[bj][1]); o.y = pkh(v[bj][2], v[bj][3]); o.z = pkh(v[bj][4], v[bj][5]); o.w = pkh(v[bj][6], v[bj][7]);
                    *(GAS v4u*)(dst + 32 * bj + 8 * fq) = o; }
            }
    }
};
template <bool ADD> struct EpiMix {
    static constexpr bool PERM = true, AFTER_DRAIN = false, MID = false;
    bf16* MIX; const bf16* GM; int gmoff;
    __device__ __forceinline__ void operator()(const pg8::f32x4 (&acc)[2][2][4][2], const pg8::Unit& u, int wr, int wc, int fr, int fq) const {
#pragma unroll
        for (int ai = 0; ai < 2; ++ai)
#pragma unroll
            for (int m = 0; m < 4; ++m) {
                const int row = u.pm * 256 + ai * 128 + wr * 64 + m * 16 + fr;
#pragma unroll
                for (int bj = 0; bj < 2; ++bj) {
                    const int col = u.pn * 256 + bj * 128 + wc * 32 + 8 * fq;
                    const v4u gmv = *(const GAS v4u*)(GM + (size_t)row * 2048 + gmoff + col);
                    float r[8];
                    r[0] = acc[ai][bj][m][0][0] * bflo(gmv.x); r[1] = acc[ai][bj][m][0][1] * bfhi(gmv.x); r[2] = acc[ai][bj][m][0][2] * bflo(gmv.y); r[3] = acc[ai][bj][m][0][3] * bfhi(gmv.y);
                    r[4] = acc[ai][bj][m][1][0] * bflo(gmv.z); r[5] = acc[ai][bj][m][1][1] * bfhi(gmv.z); r[6] = acc[ai][bj][m][1][2] * bflo(gmv.w); r[7] = acc[ai][bj][m][1][3] * bfhi(gmv.w);
                    GAS v4u* dp = (GAS v4u*)(MIX + (size_t)row * 1024 + col);
                    if (ADD) { const v4u old = *dp; r[0] += bflo(old.x); r[1] += bfhi(old.x); r[2] += bflo(old.y); r[3] += bfhi(old.y); r[4] += bflo(old.z); r[5] += bfhi(old.z); r[6] += bflo(old.w); r[7] += bfhi(old.w); }
                    v4u o; o.x = pkh(r[0], r[1]); o.y = pkh(r[2], r[3]); o.z = pkh(r[4], r[5]); o.w = pkh(r[6], r[7]); *dp = o; }
            }
    }
};
struct EpiMix2 {
    static constexpr bool PERM = true, AFTER_DRAIN = false, MID = true;
    bf16* MIX; const bf16* GM;
    __device__ __forceinline__ void mid(pg8::f32x4 (&acc)[2][2][4][2], const pg8::Unit& u, int wr, int wc, int fr, int fq) const {
#pragma unroll
        for (int ai = 0; ai < 2; ++ai)
#pragma unroll
            for (int m = 0; m < 4; ++m) {
                const int row = u.pm * 256 + ai * 128 + wr * 64 + m * 16 + fr;
#pragma unroll
                for (int bj = 0; bj < 2; ++bj) {
                    const int col = u.pn * 256 + bj * 128 + wc * 32 + 8 * fq;
                    const v4u g1 = *(const GAS v4u*)(GM + (size_t)row * 2048 + col), g2 = *(const GAS v4u*)(GM + (size_t)row * 2048 + 1024 + col);
                    const unsigned w1[4] = {g1.x, g1.y, g1.z, g1.w}, w2[4] = {g2.x, g2.y, g2.z, g2.w};
#pragma unroll
                    for (int n = 0; n < 2; ++n)
#pragma unroll
                        for (int i = 0; i < 4; ++i) { const unsigned a = w1[2 * n + (i >> 1)], b = w2[2 * n + (i >> 1)];
                            const float ga = (i & 1) ? bfhi(a) : bflo(a), gb = fmaxf((i & 1) ? bfhi(b) : bflo(b), 9.5367431640625e-07f);
                            acc[ai][bj][m][n][i] *= ga * __builtin_amdgcn_rcpf(gb); } }
            }
    }
    __device__ __forceinline__ void operator()(const pg8::f32x4 (&acc)[2][2][4][2], const pg8::Unit& u, int wr, int wc, int fr, int fq) const {
#pragma unroll
        for (int ai = 0; ai < 2; ++ai)
#pragma unroll
            for (int m = 0; m < 4; ++m) {
                const int row = u.pm * 256 + ai * 128 + wr * 64 + m * 16 + fr;
#pragma unroll
                for (int bj = 0; bj < 2; ++bj) {
                    const int col = u.pn * 256 + bj * 128 + wc * 32 + 8 * fq;
                    const v4u g2 = *(const GAS v4u*)(GM + (size_t)row * 2048 + 1024 + col);
                    const unsigned w2[4] = {g2.x, g2.y, g2.z, g2.w};
                    float r[8];
#pragma unroll
                    for (int n = 0; n < 2; ++n)
#pragma unroll
                        for (int i = 0; i < 4; ++i) { const unsigned b = w2[2 * n + (i >> 1)];
                            r[4 * n + i] = acc[ai][bj][m][n][i] * fmaxf((i & 1) ? bfhi(b) : bflo(b), 9.5367431640625e-07f); }
                    v4u o; o.x = pkh(r[0], r[1]); o.y = pkh(r[2], r[3]); o.z = pkh(r[4], r[5]); o.w = pkh(r[6], r[7]);
                    *(GAS v4u*)(MIX + (size_t)row * 1024 + col) = o; }
            }
    }
};
struct EpiRes {
    static constexpr bool PERM = true, AFTER_DRAIN = false, MID = false;
    const float* x; bf16* x1; const float* ada; int gate_idx;
    __device__ __forceinline__ void operator()(const pg8::f32x4 (&acc)[2][2][4][2], const pg8::Unit& u, int wr, int wc, int fr, int fq) const {
#pragma unroll
        for (int ai = 0; ai < 2; ++ai)
#pragma unroll
            for (int m = 0; m < 4; ++m) {
                const int row = u.pm * 256 + ai * 128 + wr * 64 + m * 16 + fr, b = row >> 12;
#pragma unroll
                for (int bj = 0; bj < 2; ++bj) {
                    const int col = u.pn * 256 + bj * 128 + wc * 32 + 8 * fq;
                    const float* gp = ada + (size_t)b * 6 * D + gate_idx * D + col; const float* xp = x + (size_t)row * D + col;
                    const f32x4 g0 = *(const GAS f32x4*)gp, g1 = *(const GAS f32x4*)(gp + 4), x0 = *(const GAS f32x4*)xp, x1v = *(const GAS f32x4*)(xp + 4);
                    const f32x4 r0 = x0 + g0 * acc[ai][bj][m][0], r1 = x1v + g1 * acc[ai][bj][m][1];
                    v4u o; o.x = pkh(r0.x, r0.y); o.y = pkh(r0.z, r0.w); o.z = pkh(r1.x, r1.y); o.w = pkh(r1.z, r1.w);
                    *(GAS v4u*)(x1 + (size_t)row * D + col) = o; }
            }
    }
};

template <int W> __device__ __forceinline__ void pool_load(const bf16* zp, int row, int t, int col, v4u (&z)[W]) {
#pragma unroll
    for (int j = 0; j < W; ++j) z[j] = (j <= t) ? *(const GAS v4u*)(zp + (size_t)(row - j) * 512 + col) : (v4u){0u, 0u, 0u, 0u};
}
template <int W> __device__ __forceinline__ v4u pool_reduce(const v4u (&z)[W], int t) {
    float s[8], self[8];
#pragma unroll
    for (int e = 0; e < 8; ++e) { s[e] = 0.f; self[e] = 0.f; }
#pragma unroll
    for (int j = 0; j < W; ++j) { const float f[8] = {bflo(z[j].x), bfhi(z[j].x), bflo(z[j].y), bfhi(z[j].y), bflo(z[j].z), bfhi(z[j].z), bflo(z[j].w), bfhi(z[j].w)};
#pragma unroll
        for (int e = 0; e < 8; ++e) { s[e] += f[e]; if (j == 0) self[e] = f[e]; } }
    const float inv = 1.0f / (float)((t + 1 < W) ? (t + 1) : W);
    v4u o; o.x = pk2(s[0] * inv - self[0], s[1] * inv - self[1]); o.y = pk2(s[2] * inv - self[2], s[3] * inv - self[3]);
    o.z = pk2(s[4] * inv - self[4], s[5] * inv - self[5]); o.w = pk2(s[6] * inv - self[6], s[7] * inv - self[7]);
    return o;
}
__device__ __forceinline__ void pool_phase(Frame& F) {
    const bf16* zp = (const bf16*)(F.ws + WS_ZP); bf16* pl = (bf16*)(F.ws + WS_PL);
    const int gw = F.bid * NWAVES + F.wave, NGW = F.G * NWAVES;
    for (int r4 = gw; r4 < M / 4; r4 += NGW) {
        const int row = 4 * r4 + (F.lane >> 4), t = row & 4095, c0 = 8 * (F.lane & 15);
        v4u z2[2], z4[4], z8[8], z16[16];
        pool_load<2>(zp, row, t, c0, z2); pool_load<4>(zp, row, t, 128 + c0, z4); pool_load<8>(zp, row, t, 256 + c0, z8); pool_load<16>(zp, row, t, 384 + c0, z16);
        const v4u o2 = pool_reduce<2>(z2, t), o4 = pool_reduce<4>(z4, t), o8 = pool_reduce<8>(z8, t), o16 = pool_reduce<16>(z16, t);
        GAS v4u* dst = (GAS v4u*)(pl + (size_t)row * 1024 + c0);
        dst[0] = o2; dst[16] = o4; dst[32] = o8; dst[48] = o16;
    }
}

typedef int v4i __attribute__((ext_vector_type(4)));
__device__ __forceinline__ unsigned pkf16(float a, float b) { return __builtin_bit_cast(unsigned, __builtin_amdgcn_cvt_pkrtz(a, b)); }
__device__ __forceinline__ float f16lo(unsigned w) { return (float)__builtin_bit_cast(_Float16, (unsigned short)(w & 0xffffu)); }
__device__ __forceinline__ float f16hi(unsigned w) { return (float)__builtin_bit_cast(_Float16, (unsigned short)(w >> 16)); }
struct EpiStoreBf16 {
    static constexpr bool PERM = true, AFTER_DRAIN = false, MID = false;
    bf16* O; int ldc;
    __device__ __forceinline__ void operator()(const pg8::f32x4 (&acc)[2][2][4][2], const pg8::Unit& u, int wr, int wc, int fr, int fq) const {
#pragma unroll
        for (int ai = 0; ai < 2; ++ai)
#pragma unroll
            for (int m = 0; m < 4; ++m) {
                const int row = u.pm * 256 + ai * 128 + wr * 64 + m * 16 + fr;
#pragma unroll
                for (int bj = 0; bj < 2; ++bj) {
                    const int col = u.pn * 256 + bj * 128 + wc * 32 + 8 * fq;
                    v4u o; o.x = pkf16(acc[ai][bj][m][0][0], acc[ai][bj][m][0][1]); o.y = pkf16(acc[ai][bj][m][0][2], acc[ai][bj][m][0][3]);
                    o.z = pkf16(acc[ai][bj][m][1][0], acc[ai][bj][m][1][1]); o.w = pkf16(acc[ai][bj][m][1][2], acc[ai][bj][m][1][3]);
                    *(GAS v4u*)(O + (size_t)row * ldc + col) = o; }
            }
    }
};

__device__ __forceinline__ unsigned fkey(float f) { const unsigned u = __builtin_bit_cast(unsigned, f); return (u >> 31) ? ~u : (u | 0x80000000u); }
__device__ __forceinline__ float funkey(unsigned k) { const unsigned u = (k >> 31) ? (k & 0x7fffffffu) : ~k; return __builtin_bit_cast(float, u); }
__device__ __forceinline__ unsigned umax_(unsigned a, unsigned b) { return a > b ? a : b; }
__device__ __forceinline__ unsigned umin_(unsigned a, unsigned b) { return a > b ? b : a; }
#define TOP16_INSERT(L, xin) do { unsigned _x = (xin); _Pragma("unroll") for (int _i = 0; _i < 16; ++_i) { const unsigned _h = umax_(L[_i], _x); _x = umin_(L[_i], _x); L[_i] = _h; } } while (0)
template <int MASK> __device__ __forceinline__ void top16_merge(unsigned (&L)[16]) {
    unsigned o[16];
#pragma unroll
    for (int i = 0; i < 16; ++i) o[i] = (unsigned)dppi<MASK == 1 ? DPP_XOR1 : DPP_XOR2>((int)L[i]);
#pragma unroll
    for (int i = 0; i < 16; ++i) L[i] = umax_(L[i], o[15 - i]);
#pragma unroll
    for (int d = 8; d >= 1; d >>= 1)
#pragma unroll
        for (int i = 0; i < 16; ++i) if ((i & d) == 0) { const unsigned hi = umax_(L[i], L[i + d]), lo = umin_(L[i], L[i + d]); L[i] = hi; L[i + d] = lo; }
}
#define CE_DESC(a_, b_) do { const unsigned _h = umax_(a_, b_), _l = umin_(a_, b_); a_ = _h; b_ = _l; } while (0)
template <int OFF> __device__ __forceinline__ void bitonic_sort16_desc(unsigned (&v)[32]) {
#pragma unroll
    for (int k = 2; k <= 16; k <<= 1)
#pragma unroll
        for (int j = k >> 1; j > 0; j >>= 1)
#pragma unroll
            for (int i = 0; i < 16; ++i) { const int l = i ^ j; if (l > i) { if ((i & k) == 0) CE_DESC(v[OFF + i], v[OFF + l]); else CE_DESC(v[OFF + l], v[OFF + i]); } }
}
__device__ __forceinline__ void bitonic_merge16_desc(unsigned (&L)[16]) {
#pragma unroll
    for (int d = 8; d >= 1; d >>= 1)
#pragma unroll
        for (int i = 0; i < 16; ++i) if ((i & d) == 0) CE_DESC(L[i], L[i + d]);
}
constexpr int SST = 132;
constexpr int P9_LIST_OFF = 2 * 64 * SST * 4;
__device__ __forceinline__ void peer_select_phase(Frame& F) {
    const unsigned short* S16 = (const unsigned short*)(F.ws + WS_QV);
    int* EID = (int*)(F.ws + WS_EID); float* GW = (float*)(F.ws + WS_GW);
    LAS unsigned* LIST = (LAS unsigned*)(F.lds + P9_LIST_OFF);
    const int lane = F.lane, w = F.wave;
    constexpr int NU = (M / 64) * PH;
    const int row = F.tid >> 2, sub = F.tid & 3, p1 = row >> 6, tk1 = row & 63;
    v4u sn[4], sm[4];
#define P9_LOAD(dst_, u_) do { const int _tt = (u_) >> 3, _h = (u_) & 7; const unsigned short* sp_ = S16 + (size_t)(_tt * 64 + tk1) * PQW + _h * 256 + p1 * 128 + 32 * sub; \
        _Pragma("unroll") for (int q = 0; q < 4; ++q) dst_[q] = *(const GAS v4u*)(sp_ + 8 * q); } while (0)
#define P9_STAGE1(sc_, list_, unext_) do { \
            unsigned kv[32]; \
            _Pragma("unroll") for (int q = 0; q < 4; ++q) { const unsigned ww[4] = {sc_[q].x, sc_[q].y, sc_[q].z, sc_[q].w}; \
                _Pragma("unroll") for (int e = 0; e < 4; ++e) { kv[8 * q + 2 * e] = (fkey(f16lo(ww[e])) & ~127u) | (unsigned)(32 * sub + 8 * q + 2 * e); \
                    kv[8 * q + 2 * e + 1] = (fkey(f16hi(ww[e])) & ~127u) | (unsigned)(32 * sub + 8 * q + 2 * e + 1); } } \
            if ((unext_) < NU) P9_LOAD(sc_, (unext_)); \
            bitonic_sort16_desc<0>(kv); bitonic_sort16_desc<16>(kv); \
            unsigned L[16]; \
            _Pragma("unroll") for (int i = 0; i < 16; ++i) L[i] = umax_(kv[i], kv[31 - i]); \
            bitonic_merge16_desc(L); \
            top16_merge<1>(L); top16_merge<2>(L); \
            if (sub == 0) { _Pragma("unroll") for (int i = 0; i < 4; ++i) *(LAS v4u*)((list_) + row * 16 + 4 * i) = (v4u){L[4 * i], L[4 * i + 1], L[4 * i + 2], L[4 * i + 3]}; } } while (0)
    if (F.bid < NU) P9_LOAD(sn, F.bid);
    if (F.bid + F.G < NU) P9_LOAD(sm, F.bid + F.G);
    for (int u = F.bid; u < NU; u += 2 * F.G) {
        const int u1 = u + F.G;
        P9_STAGE1(sn, LIST, u + 2 * F.G);
        if (u1 < NU) P9_STAGE1(sm, LIST + 2048, u1 + 2 * F.G);
        __syncthreads();
        const int half = F.tid >> 8, uu = half ? u1 : u;
        if (uu < NU) {
            const int tt = uu >> 3, h = uu & 7, tok0 = tt * 64;
            LAS unsigned* LIST = (LAS unsigned*)(F.lds + P9_LIST_OFF) + half * 2048;
            const int tok = (F.tid & 255) >> 2, sub = F.tid & 3;
            float va[16], vb[16];
#pragma unroll
            for (int i = 0; i < 4; ++i) { const v4u x = *(const LAS v4u*)(LIST + tok * 16 + 4 * i), y = *(const LAS v4u*)(LIST + (64 + tok) * 16 + 4 * i);
                va[4 * i] = funkey(x.x & ~127u); va[4 * i + 1] = funkey(x.y & ~127u); va[4 * i + 2] = funkey(x.z & ~127u); va[4 * i + 3] = funkey(x.w & ~127u);
                vb[4 * i] = funkey(y.x & ~127u); vb[4 * i + 1] = funkey(y.y & ~127u); vb[4 * i + 2] = funkey(y.z & ~127u); vb[4 * i + 3] = funkey(y.w & ~127u); }
            unsigned cand[32];
#pragma unroll
            for (int i = 0; i < 32; ++i) cand[i] = 0u;
            {
                constexpr int NC = 50;
                constexpr unsigned char CI[52] = {0,0,0,0,0,0,0,0,0,0,0,0,0,0,0,0, 1,1,1,1,1,1,1,1, 2,2,2,2,2, 3,3,3,3, 4,4,4, 5,5, 6,6, 7,7, 8,9,10,11,12,13,14,15, 0,0};
                constexpr unsigned char CJ[52] = {0,1,2,3,4,5,6,7,8,9,10,11,12,13,14,15, 0,1,2,3,4,5,6,7, 0,1,2,3,4, 0,1,2,3, 0,1,2, 0,1, 0,1, 0,1, 0,0,0,0,0,0,0,0, 0,0};
#pragma unroll
                for (int g4 = 0; g4 < 13; ++g4) {
                    float sa = 0.f, sb = 0.f; unsigned id = 0u; bool ok = false;
#pragma unroll
                    for (int q = 0; q < 4; ++q) { const int n = 4 * g4 + q; if (n < NC) { const bool me = (sub == q); sa = me ? va[CI[n]] : sa; sb = me ? vb[CJ[n]] : sb; id = me ? (unsigned)(CI[n] * 16 + CJ[n]) : id; ok = ok || me; } }
                    cand[g4] = ok ? ((fkey(sa + sb) & ~255u) | id) : 0u;
                }
            }
            bitonic_sort16_desc<0>(cand);
            unsigned L[16];
#pragma unroll
            for (int i = 0; i < 16; ++i) L[i] = cand[i];
            top16_merge<1>(L); top16_merge<2>(L);
            const float mx = funkey(L[0] & ~255u);
            float e[16], sum = 0.f;
#pragma unroll
            for (int k = 0; k < 16; ++k) { e[k] = __expf(funkey(L[k] & ~255u) - mx); sum += e[k]; }
            const float inv = 1.0f / sum;
            const size_t ob = (size_t)(tok0 + tok) * 128;
#pragma unroll
            for (int k4 = 0; k4 < 4; ++k4) if (sub == k4) {
#pragma unroll
                for (int q = 0; q < 4; ++q) { const unsigned cid = L[4 * k4 + q] & 255u;
                    const unsigned ia = LIST[tok * 16 + (cid >> 4)] & 127u, ib = LIST[(64 + tok) * 16 + (cid & 15u)] & 127u;
                    const int slot = h * 16 + 4 * k4 + q;
                    EID[ob + slot] = (int)(ia * 128u + ib); GW[ob + slot] = e[4 * k4 + q] * inv; }
            }
        }
        __syncthreads();
    }
#undef P9_LOAD
#undef P9_STAGE1
}

__device__ __forceinline__ void unpack8(const v4u w, float (&f)[8]) { f[0] = bflo(w.x); f[1] = bfhi(w.x); f[2] = bflo(w.y); f[3] = bfhi(w.y); f[4] = bflo(w.z); f[5] = bfhi(w.z); f[6] = bflo(w.w); f[7] = bfhi(w.w); }
typedef float f32x2 __attribute__((ext_vector_type(2)));
__device__ __forceinline__ void unpack16_fp8(const v4u w, float (&f)[16]) {
    const unsigned ww[4] = {w.x, w.y, w.z, w.w};
#pragma unroll
    for (int d = 0; d < 4; ++d) { const f32x2 a = __builtin_amdgcn_cvt_pk_f32_fp8((int)ww[d], false), b = __builtin_amdgcn_cvt_pk_f32_fp8((int)ww[d], true);
        f[4 * d] = a.x; f[4 * d + 1] = a.y; f[4 * d + 2] = b.x; f[4 * d + 3] = b.y; }
}
template <int PV_> __device__ __forceinline__ void peer_dot_phase(Frame& F) {
    const unsigned char* H8 = F.ws + WS_H8; const int* EID = (const int*)(F.ws + WS_EID); unsigned short* PART = (unsigned short*)(F.ws + WS_PART);
    const int lane = F.lane, g = lane >> 3, j = lane & 7, x = F.bid & 7;
    const int nbx = (F.G - x + 7) >> 3, NW = nbx * NWAVES, gwv = (F.bid >> 3) * NWAVES + F.wave;
    const unsigned char* US = F.ws + WS_UB + (size_t)x * NEXP * 128; const unsigned j16 = 16u * (unsigned)j;
    int token = gwv;
    if (token >= M) return;
    const int lasttok = gwv + ((M - 1 - gwv) / NW) * NW;
    v4i eA[4], eB[4]; v4i hA, hB;
#define PD_CL(t_) ((t_) < M ? (t_) : lasttok)
#define PD_LOAD_E(e_, tok_) do { _Pragma("unroll") for (int q = 0; q < 4; ++q) e_[q] = *(const GAS v4i*)(EID + (size_t)(tok_) * 128 + 16 * g + 4 * q); } while (0)
#define PD_ISSUE4(buf_, e_, b0_) do { buf_[b0_] = *(const GAS v4i*)(US + ((unsigned)e_.x * 128u + j16)); buf_[b0_ + 1] = *(const GAS v4i*)(US + ((unsigned)e_.y * 128u + j16)); \
        buf_[b0_ + 2] = *(const GAS v4i*)(US + ((unsigned)e_.z * 128u + j16)); buf_[b0_ + 3] = *(const GAS v4i*)(US + ((unsigned)e_.w * 128u + j16)); } while (0)
#define PD_DOT1(w_, hc_, dst_) do { int t = __builtin_amdgcn_sdot4(w_.x, hc_.x, 0, false); t = __builtin_amdgcn_sdot4(w_.y, hc_.y, t, false); t = __builtin_amdgcn_sdot4(w_.z, hc_.z, t, false); t = __builtin_amdgcn_sdot4(w_.w, hc_.w, t, false); \
        t += dppi<DPP_XOR1>(t); t += dppi<DPP_XOR2>(t); t += dppi<DPP_HMIR>(t); dst_ = (float)t; } while (0)
#define PD_BODY(eC, eN, hC, hN, tok_) do { const int tk_ = PD_CL(tok_); \
        PD_ISSUE4(bB, eC[2], 0); PD_ISSUE4(bB, eC[3], 4); \
        PD_LOAD_E(eC, PD_CL(tk_ + 2 * NW)); \
        hN = *(const GAS v4i*)(H8 + (size_t)PD_CL(tk_ + NW) * D + 128 * x + j16); \
        float s[16]; \
        _Pragma("unroll") for (int i = 0; i < 8; ++i) PD_DOT1(bA[i], hC, s[i]); \
        PD_ISSUE4(bA, eN[0], 0); PD_ISSUE4(bA, eN[1], 4); \
        _Pragma("unroll") for (int i = 0; i < 8; ++i) PD_DOT1(bB[i], hC, s[8 + i]); \
        { unsigned short* pp = PART + ((size_t)x * M + tk_) * 128 + g * 16;       \
          _Pragma("unroll") for (int i8 = 0; i8 < 2; ++i8) *(GAS v4u*)(pp + 8 * i8) = (v4u){pkf16(s[8 * i8] * 0.015625f, s[8 * i8 + 1] * 0.015625f), pkf16(s[8 * i8 + 2] * 0.015625f, s[8 * i8 + 3] * 0.015625f), \
              pkf16(s[8 * i8 + 4] * 0.015625f, s[8 * i8 + 5] * 0.015625f), pkf16(s[8 * i8 + 6] * 0.015625f, s[8 * i8 + 7] * 0.015625f)}; } } while (0)
    PD_LOAD_E(eA, token); hA = *(const GAS v4i*)(H8 + (size_t)token * D + 128 * x + j16);
    PD_LOAD_E(eB, PD_CL(token + NW));
    v4i bA[8], bB[8];
    PD_ISSUE4(bA, eA[0], 0); PD_ISSUE4(bA, eA[1], 4);
    __builtin_amdgcn_s_waitcnt(0x0F70);
    for (; token < M; token += 2 * NW) {
        PD_BODY(eA, eB, hA, hB, token);
        PD_BODY(eB, eA, hB, hA, token + NW);
    }
#undef PD_BODY
#undef PD_CL
#undef PD_LOAD_E
#undef PD_ISSUE4
#undef PD_DOT1
}
template <int NTOK> __device__ __forceinline__ void peer_loadrate_probe(Frame& F) {
    const int* EID = (const int*)(F.ws + WS_EID);
    const int lane = F.lane, g = lane >> 3, j = lane & 7, x = F.bid & 7;
    const int nbx = (F.G - x + 7) >> 3, NW = nbx * NWAVES, gwv = (F.bid >> 3) * NWAVES + F.wave;
    const unsigned char* US = F.ws + WS_UB + (size_t)x * NEXP * 128; const unsigned j16 = 16u * (unsigned)j;
    unsigned acc = 0u;
    for (int token = gwv; token + (NTOK - 1) * NW < M; token += NTOK * NW) {
        v4i e4[NTOK][4];
#pragma unroll
        for (int t = 0; t < NTOK; ++t)
#pragma unroll
            for (int q = 0; q < 4; ++q) e4[t][q] = *(const GAS v4i*)(EID + (size_t)(token + t * NW) * 128 + 16 * g + 4 * q);
        v4i b[NTOK][16];
#pragma unroll
        for (int t = 0; t < NTOK; ++t)
#pragma unroll
            for (int q = 0; q < 4; ++q) { b[t][4 * q] = *(const GAS v4i*)(US + ((unsigned)e4[t][q].x * 128u + j16)); b[t][4 * q + 1] = *(const GAS v4i*)(US + ((unsigned)e4[t][q].y * 128u + j16));
                b[t][4 * q + 2] = *(const GAS v4i*)(US + ((unsigned)e4[t][q].z * 128u + j16)); b[t][4 * q + 3] = *(const GAS v4i*)(US + ((unsigned)e4[t][q].w * 128u + j16)); }
#pragma unroll
        for (int t = 0; t < NTOK; ++t)
#pragma unroll
            for (int i = 0; i < 16; ++i) acc ^= (unsigned)(b[t][i].x ^ b[t][i].y ^ b[t][i].z ^ b[t][i].w);
    }
    asm volatile("" :: "v"(acc));
}
__device__ __forceinline__ void peer_coef_phase(Frame& F) {
    const unsigned short* PART = (const unsigned short*)(F.ws + WS_PART); const int* EID = (const int*)(F.ws + WS_EID); const float* GW = (const float*)(F.ws + WS_GW);
    const float* SCU = (const float*)(F.ws + WS_SCLU); const float* SCV = (const float*)(F.ws + WS_SCLV); const float* HS = (const float*)(F.ws + WS_HS);
    unsigned* CF8 = (unsigned*)(F.ws + WS_CF); float* CFS = (float*)(F.ws + WS_CFS);
    const size_t gtid = (size_t)F.bid * NTHREADS + F.tid, gthreads = (size_t)F.G * NTHREADS, n4 = (size_t)M * 128 / 4;
    for (size_t i4 = gtid; i4 < n4; i4 += gthreads) {
        v2u pw[8];
#pragma unroll
        for (int xx = 0; xx < 8; ++xx) pw[xx] = *(const GAS v2u*)(PART + (size_t)xx * M * 128 + 4 * i4);
        f32x4 d = (f32x4){0.f, 0.f, 0.f, 0.f};
#pragma unroll
        for (int xx = 0; xx < 8; ++xx) d = d + (f32x4){f16lo(pw[xx].x), f16hi(pw[xx].x), f16lo(pw[xx].y), f16hi(pw[xx].y)};
        d = d * 64.0f;
        const v4i e = *(const GAS v4i*)(EID + 4 * i4); const f32x4 gw = *(const GAS f32x4*)(GW + 4 * i4);
        const float hs = HS[i4 >> 5];
        f32x4 r; r.x = gw.x * SCV[e.x] * gelu_tanh_safe(d.x * (SCU[e.x] * hs)); r.y = gw.y * SCV[e.y] * gelu_tanh_safe(d.y * (SCU[e.y] * hs));
        r.z = gw.z * SCV[e.z] * gelu_tanh_safe(d.z * (SCU[e.z] * hs)); r.w = gw.w * SCV[e.w] * gelu_tanh_safe(d.w * (SCU[e.w] * hs));
        float m = fmaxf(fmaxf(fabsf(r.x), fabsf(r.y)), fmaxf(fabsf(r.z), fabsf(r.w)));
        m = fmaxf(m, dppf<DPP_XOR1>(m)); m = fmaxf(m, dppf<DPP_XOR2>(m)); m = fmaxf(m, dppf<DPP_HMIR>(m)); m = fmaxf(m, dppf<DPP_ROR8>(m)); m = max_xor16(m);
        const unsigned E = (__builtin_bit_cast(unsigned, m) >> 23) & 0xffu; float sc = 1.f, isc = 1.f;
        if (E >= 8u && E <= 250u) { sc = __builtin_bit_cast(float, (261u - E) << 23); isc = __builtin_bit_cast(float, (E - 7u) << 23); }
        int t = __builtin_amdgcn_cvt_pk_fp8_f32(r.x * sc, r.y * sc, 0, false); t = __builtin_amdgcn_cvt_pk_fp8_f32(r.z * sc, r.w * sc, t, true);
        CF8[i4] = (unsigned)t;
        if ((F.lane & 31) == 0) CFS[i4 >> 5] = isc; }
}
template <bool DRY, bool CHECK = false> __device__ __forceinline__ void peer_out_phase(Frame& F, const float* ada, float* out) {
    const int* EID = (const int*)(F.ws + WS_EID); const unsigned char* CF8 = (const unsigned char*)(F.ws + WS_CF); const float* CFS = (const float*)(F.ws + WS_CFS);
    const int lane = F.lane, g = lane >> 3, j = lane & 7, x = F.bid & 7;
    const int nbx = (F.G - x + 7) >> 3, NW = nbx * NWAVES, gwv = (F.bid >> 3) * NWAVES + F.wave;
    const unsigned char* VS = F.ws + WS_VB + (size_t)x * NEXP * 128; const unsigned j16 = 16u * (unsigned)j;
    if (gwv >= M) return;
    const int ntok = (M - 1 - gwv) / NW + 1;
#define PO_ISSUE4(buf_, e_, b0_) do { buf_[b0_] = *(const GAS v4u*)(VS + ((unsigned)e_.x * 128u + j16)); buf_[b0_ + 1] = *(const GAS v4u*)(VS + ((unsigned)e_.y * 128u + j16)); \
        buf_[b0_ + 2] = *(const GAS v4u*)(VS + ((unsigned)e_.z * 128u + j16)); buf_[b0_ + 3] = *(const GAS v4u*)(VS + ((unsigned)e_.w * 128u + j16)); } while (0)
#define PO_ROW(w_, c_) do { float f[16]; unpack16_fp8(w_, f); _Pragma("unroll") for (int k = 0; k < 16; ++k) o[k] += (c_) * f[k]; } while (0)
#define PO_ACC4(buf_, c4_, b0_) do { PO_ROW(buf_[b0_], c4_.x); PO_ROW(buf_[b0_ + 1], c4_.y); PO_ROW(buf_[b0_ + 2], c4_.z); PO_ROW(buf_[b0_ + 3], c4_.w); } while (0)
    v4i e4[4]; f32x4 c4[4]; v4u bA[8], bB[8];
#define PO_LOADC(tok_) do { const float cs_ = CFS[tok_]; _Pragma("unroll") for (int q = 0; q < 4; ++q) { const unsigned w_ = *(const GAS unsigned*)(CF8 + (size_t)(tok_) * 128 + g * 16 + 4 * q); \
        const f32x2 lo_ = __builtin_amdgcn_cvt_pk_f32_fp8((int)w_, false), hi_ = __builtin_amdgcn_cvt_pk_f32_fp8((int)w_, true); c4[q] = (f32x4){lo_.x * cs_, lo_.y * cs_, hi_.x * cs_, hi_.y * cs_}; } } while (0)
#pragma unroll
    for (int q = 0; q < 4; ++q) e4[q] = *(const GAS v4i*)(EID + (size_t)gwv * 128 + g * 16 + 4 * q);
    PO_LOADC(gwv);
    PO_ISSUE4(bA, e4[0], 0); PO_ISSUE4(bA, e4[1], 4);
    for (int it = 0; it < ntok; ++it) {
        const int token = gwv + it * NW, tn = gwv + (it + 1 < ntok ? it + 1 : it) * NW;
        PO_ISSUE4(bB, e4[2], 0); PO_ISSUE4(bB, e4[3], 4);
#pragma unroll
        for (int q = 0; q < 4; ++q) e4[q] = *(const GAS v4i*)(EID + (size_t)tn * 128 + g * 16 + 4 * q);
        float o[16];
#pragma unroll
        for (int k = 0; k < 16; ++k) o[k] = 0.f;
        PO_ACC4(bA, c4[0], 0); PO_ACC4(bA, c4[1], 4);
        PO_ISSUE4(bA, e4[0], 0); PO_ISSUE4(bA, e4[1], 4);
        PO_ACC4(bB, c4[2], 0); PO_ACC4(bB, c4[3], 4);
        PO_LOADC(tn);
#pragma unroll
        for (int k = 0; k < 16; ++k) { float t = o[k]; t += dppf<DPP_ROR8>(t); o[k] = sum_xor32(sum_xor16(t)); }
        if (g == 0) { const int b = token >> 12;
            const float* gt = ada + (size_t)b * 6 * D + 5 * D + 128 * x + 16 * j;
            float* xo = out + (size_t)token * D + 128 * x + 16 * j;
#pragma unroll
            for (int q = 0; q < 4; ++q) { const f32x4 xv = *(const GAS f32x4*)(xo + 4 * q), gv = *(const GAS f32x4*)(gt + 4 * q);
                f32x4 res = xv + gv * (f32x4){o[4 * q], o[4 * q + 1], o[4 * q + 2], o[4 * q + 3]};
                if (CHECK) { const f32x4 mf = *(const GAS f32x4*)((const float*)(F.ws + WS_PART) + (size_t)token * D + 128 * x + 16 * j + 4 * q);
                    const float rr[4] = {o[4 * q], o[4 * q + 1], o[4 * q + 2], o[4 * q + 3]}, mm[4] = {mf.x, mf.y, mf.z, mf.w}; bool bad = false;
#pragma unroll
                    for (int z = 0; z < 4; ++z) bad = bad || !(fabsf(rr[z] - mm[z]) <= 0.01f * fabsf(rr[z]) + 1.0e-3f);
                    if (bad) res.x = 1.0e9f; }
                if (DRY) { asm volatile("" :: "v"(res.x), "v"(res.y), "v"(res.z), "v"(res.w)); } else *(GAS f32x4*)(xo + 4 * q) = res; } }
    }
#undef PO_LOADC
#undef PO_ISSUE4
#undef PO_ROW
#undef PO_ACC4
}

constexpr int PO_TILE = 64 * 144;
template <int MODE> __device__ __forceinline__ void peer_out_mfma_phase(Frame& F, const float* ada, float* out) {
    const int* EID = (const int*)(F.ws + WS_EID); const unsigned char* CF8 = (const unsigned char*)(F.ws + WS_CF); const float* CFS = (const float*)(F.ws + WS_CFS);
    const int lane = F.lane, g = lane >> 3, j = lane & 7, l15 = lane & 15, lq = lane >> 4, x = F.bid & 7;
    const int nbx = (F.G - x + 7) >> 3, NW = nbx * NWAVES, gwv = (F.bid >> 3) * NWAVES + F.wave;
    const unsigned char* VS = F.ws + WS_VB + (size_t)x * NEXP * 128; const unsigned j16 = 16u * (unsigned)j;
    LAS unsigned char* TL = F.lds + F.wave * PO_TILE;
    if (gwv >= M) return;
    const int nst = 2 * ((M - 1 - gwv) / NW + 1);
    const int trow = l15 >> 1, tcol = 8 * (l15 & 1);
#define PM_IDS(e_, a_, tok_) do { const size_t base = (size_t)(tok_) * 128; \
        _Pragma("unroll") for (int m = 0; m < 16; ++m) e_[m] = EID[base + 8 * m + g]; \
        _Pragma("unroll") for (int q = 0; q < 4; ++q) a_[q] = *(const GAS long*)(CF8 + base + 32 * q + 8 * lq); } while (0)
#define PM_GATHER(vv_, e_, h_) do { _Pragma("unroll") for (int m = 0; m < 8; ++m) vv_[m] = *(const GAS v4u*)(VS + ((unsigned)e_[8 * (h_) + m] * 128u + j16)); } while (0)
#define PM_HALF(vv_, aq0_, aq1_) do { _Pragma("unroll") for (int m = 0; m < 8; ++m) *(LAS v4u*)(TL + (8 * m + g) * 144 + 16 * j) = vv_[m]; } while (0)
#define PM_MMA(aq0_, aq1_) do { LDS_WAIT(); asm volatile("" ::: "memory"); \
        _Pragma("unroll") for (int ks = 0; ks < 2; ++ks) _Pragma("unroll") for (int cb = 0; cb < 8; ++cb) { \
            const v2i bb = __builtin_amdgcn_ds_read_tr8_b64_v2i32((LAS v2i*)(TL + (32 * ks + 8 * lq + trow) * 144 + 16 * cb + tcol)); \
            acc[cb] = __builtin_amdgcn_mfma_f32_16x16x32_fp8_fp8(ks ? (aq1_) : (aq0_), __builtin_bit_cast(long, bb), acc[cb], 0, 0, 0); } \
        LDS_WAIT(); asm volatile("" ::: "memory"); } while (0)
    const int ntok = nst >> 1;
    int e1[16], e2[16]; long a0[4], a1[4], a2[4]; v4u vvA[8], vvB[8];
    PM_IDS(e1, a0, gwv);
    PM_GATHER(vvA, e1, 0); PM_GATHER(vvB, e1, 1);
    { const int t1 = ntok > 1 ? 1 : 0; PM_IDS(e1, a1, gwv + t1 * NW); }
    f32x4 acc[8];
    for (int it = 0; it < ntok; ++it) {
        const int token = gwv + it * NW;
        { const int t2 = it + 2 < ntok ? it + 2 : ntok - 1; PM_IDS(e2, a2, gwv + t2 * NW); }
#pragma unroll
        for (int cb = 0; cb < 8; ++cb) acc[cb] = (f32x4){0.f, 0.f, 0.f, 0.f};
        float xv[8], gv[8]; float cs;
        { const int b = token >> 12; const float* gt = ada + (size_t)b * 6 * D + 5 * D + 128 * x + l15; const bf16* xi = (const bf16*)(F.ws + WS_X1) + (size_t)token * D + 128 * x + l15;
          cs = CFS[token];
#pragma unroll
          for (int cb = 0; cb < 8; ++cb) { xv[cb] = bflo((unsigned)xi[16 * cb]); gv[cb] = gt[16 * cb]; } }
        PM_HALF(vvA, 0, 0); PM_GATHER(vvA, e1, 0); PM_MMA(a0[0], a0[1]);
        PM_HALF(vvB, 0, 0); PM_GATHER(vvB, e1, 1); PM_MMA(a0[2], a0[3]);
        if (lq == 0) {
            if (MODE == 1) { float* oc = (float*)(F.ws + WS_PART) + (size_t)token * D + 128 * x + l15;
#pragma unroll
                for (int cb = 0; cb < 8; ++cb) oc[16 * cb] = acc[cb][0] * cs; }
            else { float* xo = out + (size_t)token * D + 128 * x + l15;
#pragma unroll
                for (int cb = 0; cb < 8; ++cb) xo[16 * cb] = xv[cb] + gv[cb] * (acc[cb][0] * cs); }
        }
#pragma unroll
        for (int m = 0; m < 16; ++m) e1[m] = e2[m];
#pragma unroll
        for (int q = 0; q < 4; ++q) { a0[q] = a1[q]; a1[q] = a2[q]; }
    }
#undef PM_HALF
#undef PM_MMA
#undef PM_IDS
#undef PM_GATHER
}

__device__ __forceinline__ void compress_phase(Frame& F, const float* kng) {
    LAS bf16* H2 = (LAS bf16*)(F.lds);
    LAS float* OUTS = (LAS float*)(F.lds + 16384);
    const int lane = F.lane, w = F.wave, l15 = lane & 15, lq = lane >> 4;
    for (int u = F.bid; u < NBG * 2 * 8; u += F.G) {
        const int ns = u & 7, kv = (u >> 3) & 1, bg = u >> 4, n0 = ns * 32;
        const bf16* A = (const bf16*)(F.ws + (kv ? WS_VCR : WS_KCR)) + (size_t)bg * SEQ * 64;
        const bf16* W1T = (const bf16*)(F.ws + (kv ? WS_CW1V_T : WS_CW1K_T));
        const bf16* W2T = (const bf16*)(F.ws + (kv ? WS_CW2V_T : WS_CW2K_T));
        const float* b1 = (const float*)(F.ws + (kv ? WS_CB1V : WS_CB1K));
        pg8::f32x4 acc[2][8];
#pragma unroll
        for (int rb = 0; rb < 2; ++rb)
#pragma unroll
            for (int cb = 0; cb < 8; ++cb) acc[rb][cb] = (pg8::f32x4){0.f, 0.f, 0.f, 0.f};
        const bf16* ap = A + (size_t)(n0 + l15) * 1024 + 256 * w + 8 * lq;
        const bf16* bp = W1T + (size_t)l15 * 2048 + 256 * w + 8 * lq;
#pragma unroll
        for (int ks = 0; ks < 8; ++ks) {
            const bf16x8 a0 = *(const GAS bf16x8*)(ap + 32 * ks), a1 = *(const GAS bf16x8*)(ap + 16 * 1024 + 32 * ks);
#pragma unroll
            for (int cb = 0; cb < 8; ++cb) { const bf16x8 b = *(const GAS bf16x8*)(bp + (size_t)(16 * cb) * 2048 + 32 * ks);
                acc[0][cb] = __builtin_amdgcn_mfma_f32_16x16x32_bf16(a0, b, acc[0][cb], 0, 0, 0);
                acc[1][cb] = __builtin_amdgcn_mfma_f32_16x16x32_bf16(a1, b, acc[1][cb], 0, 0, 0); }
        }
        { LAS float* PS = (LAS float*)(F.lds + 32768);
          LAS float* mine = PS + (w & 3) * 4096 + (4 * lq) * 128 + l15;
          if (w >= 4) {
#pragma unroll
              for (int rb = 0; rb < 2; ++rb)
#pragma unroll
                  for (int cb = 0; cb < 8; ++cb)
#pragma unroll
                      for (int r = 0; r < 4; ++r) mine[(16 * rb + r) * 128 + 16 * cb] = acc[rb][cb][r]; }
          __syncthreads();
          if (w < 4) {
#pragma unroll
              for (int rb = 0; rb < 2; ++rb)
#pragma unroll
                  for (int cb = 0; cb < 8; ++cb)
#pragma unroll
                      for (int r = 0; r < 4; ++r) { LAS float* q = mine + (16 * rb + r) * 128 + 16 * cb; *q = acc[rb][cb][r] + *q; } }
          __syncthreads();
#pragma unroll
          for (int i = 0; i < 8; ++i) { const int idx = F.tid + 512 * i, row = idx >> 7, col = idx & 127;
              const float v = ((PS[idx] + PS[4096 + idx]) + (PS[8192 + idx] + PS[12288 + idx])) + b1[col];
              H2[row * 136 + col] = (bf16)f2bf(gelu_tanh_safe(v)); } }
        __syncthreads();
        { const int rb = w >> 2, db = w & 3;
          pg8::f32x4 o = (pg8::f32x4){0.f, 0.f, 0.f, 0.f};
#pragma unroll
          for (int ks = 0; ks < 4; ++ks) {
              const bf16x8 a = *(const LAS bf16x8*)(H2 + (16 * rb + l15) * 136 + 32 * ks + 8 * lq);
              const bf16x8 b = *(const GAS bf16x8*)(W2T + (size_t)(16 * db + l15) * 128 + 32 * ks + 8 * lq);
              o = __builtin_amdgcn_mfma_f32_16x16x32_bf16(a, b, o, 0, 0, 0); }
#pragma unroll
          for (int r = 0; r < 4; ++r) OUTS[(16 * rb + 4 * lq + r) * 65 + 16 * db + l15] = o[r]; }
        __syncthreads();
        { const int n = F.tid >> 4, d4 = (F.tid & 15) * 4, ng = n0 + n;
          float v[4]; float ss = 0.f;
#pragma unroll
          for (int i = 0; i < 4; ++i) { v[i] = OUTS[n * 65 + d4 + i]; ss += v[i] * v[i]; }
          ss += dppf<DPP_XOR1>(ss); ss += dppf<DPP_XOR2>(ss); ss += dppf<DPP_HMIR>(ss); ss += dppf<DPP_ROR8>(ss);
          const bool pad = (ng >= NCMP);
          if (kv == 0) { const float rs = rsqrtf(ss * (1.f / 64.f) + EPS);
              v2u o; o.x = pad ? 0u : pk2(v[0] * rs * kng[d4], v[1] * rs * kng[d4 + 1]); o.y = pad ? 0u : pk2(v[2] * rs * kng[d4 + 2], v[3] * rs * kng[d4 + 3]);
              *(GAS v2u*)((bf16*)(F.ws + WS_KC) + ((size_t)bg * 256 + ng) * 64 + d4) = o; }
          else { bf16* vt = (bf16*)(F.ws + WS_VCT) + (size_t)bg * 64 * 256 + ng;
#pragma unroll
              for (int i = 0; i < 4; ++i) vt[(size_t)(d4 + i) * 256] = pad ? (bf16)0 : (bf16)f2bf(v[i]); } }
        __syncthreads();
    }
}
__device__ __forceinline__ void vtranspose_phase(Frame& F) {
    LAS bf16* T = (LAS bf16*)(F.lds + F.wave * 9216);
    const int gw = F.bid * NWAVES + F.wave, NGW = F.G * NWAVES, lane = F.lane;
    for (int job = gw; job < 2 * NBG * 64; job += NGW) {
        const int s = job & 63, bg = (job >> 6) & 15, which = job >> 10;
        const bf16* X = (const bf16*)(F.ws + (which ? WS_VW : WS_VS)) + ((size_t)bg * SEQ + 64 * s) * 64;
        bf16* XT = (bf16*)(F.ws + (which ? WS_VWT : WS_VST)) + (size_t)bg * 64 * SEQ + 64 * s;
#pragma unroll
        for (int i = 0; i < 8; ++i) { const int tok = (lane >> 3) + 8 * i, ch = lane & 7;
            const v4u x = *(const GAS v4u*)(X + (size_t)tok * 64 + 8 * ch);
            const unsigned ww[4] = {x.x, x.y, x.z, x.w};
#pragma unroll
            for (int e = 0; e < 4; ++e) { T[(8 * ch + 2 * e) * 72 + tok] = (bf16)(ww[e] & 0xffffu); T[(8 * ch + 2 * e + 1) * 72 + tok] = (bf16)(ww[e] >> 16); } }
        LDS_WAIT(); asm volatile("" ::: "memory");
#pragma unroll
        for (int i = 0; i < 8; ++i) { const int dim = (lane >> 3) + 8 * i, ch = lane & 7;
            const v4u y = *(const LAS v4u*)(T + dim * 72 + 8 * ch);
            *(GAS v4u*)(XT + (size_t)dim * SEQ + 8 * ch) = y; }
        LDS_WAIT(); asm volatile("" ::: "memory");
    }
}

constexpr int AT_KBUF = 64 * 128;
constexpr int AT_NBUF = 2;
constexpr int AT_OFF_K = 0, AT_OFF_V = AT_NBUF * AT_KBUF;
constexpr int AT_OFF_IMP1 = 2 * AT_NBUF * AT_KBUF, AT_OFF_IMP2 = AT_OFF_IMP1 + 64 * 65 * 4, AT_OFF_SEL = AT_OFF_IMP2 + 64 * 65 * 4;
constexpr int AT_OFF_LUT = AT_OFF_SEL + 512, AT_OFF_LROW = AT_OFF_LUT + 4 * 128 * 4;
constexpr int AT_OFF_TD = AT_OFF_LROW + 8 * 32 * 4;
constexpr int AT_OFF_OUT = AT_OFF_TD + 96 * 32;
constexpr int AT_OFF_GATL = AT_OFF_OUT + 256 * 144;
constexpr int AT_OFF_TS = AT_OFF_GATL + 64 * 12 * 4;
constexpr int AT_TS_ROW = 65 * 16;
constexpr int AT_LDS_END = AT_OFF_TS + 16 * AT_TS_ROW;
static_assert(AT_LDS_END <= RING_BYTES, "attention LDS");

struct AtTile { const bf16* k; const bf16* vt; int vstride; };
enum { TM_CMP1 = 0, TM_CMP2, TM_SELN, TM_SELF, TM_WINN, TM_WINF, TM_WINE, TM_CMP1F, TM_CMP2F };
__device__ __forceinline__ float fexp2(float x) { return __builtin_amdgcn_exp2f(x); }
template <int TM, int VAR, int RB = 3>
__device__ __forceinline__ void at_tile(const LAS unsigned char* kb_, const LAS unsigned char* vb_, const LAS float* LUTJ, LAS float* IMP1, LAS float* IMP2,
                                        const bf16x8 (&qf)[2][2], pg8::f32x4 (&oacc)[2][4], pg8::f32x4 (&lacc)[2], const LAS float* LINV,
                                        const int (&tok_r_in)[2], const unsigned (&selb)[2], float cfar, int relbase, int idx, int l15_in, int lq_in, const LAS unsigned char* tsw, const LAS unsigned char* tsn) {
    constexpr bool FAR = (TM == TM_SELF || TM == TM_WINF || TM == TM_WINE || TM == TM_CMP1F || TM == TM_CMP2F);
    constexpr bool C1 = (TM == TM_CMP1 || TM == TM_CMP1F), C2 = (TM == TM_CMP2 || TM == TM_CMP2F);
    int l15 = l15_in, lq = lq_in; asm volatile("" : "+v"(l15), "+v"(lq));
    int tok_r[2] = {tok_r_in[0], tok_r_in[1]}; asm volatile("" : "+v"(tok_r[0]), "+v"(tok_r[1]));
    v4u pfr[2][2];
    const LAS unsigned char* tsp[2] = {tsw, tsw};
    if (TM == TM_SELN || TM == TM_WINN) {
#pragma unroll
        for (int rb = 0; rb < 2; ++rb) { const LAS unsigned char* pa = tsw + l15 * AT_TS_ROW + 16 * (2 * lq - rb) - 4 * relbase;
            const LAS unsigned char* pn = tsn + l15 * AT_TS_ROW;
            tsp[rb] = (TM == TM_SELN && !selb[rb]) ? pn : pa; } }
    auto kld = [&](int cb, bf16x8 (&kf)[2], pg8::f32x4 (&cq)[2]) __attribute__((always_inline)) {
        if (TM == TM_SELN || TM == TM_WINN) {
#pragma unroll
            for (int rb = 0; rb < 2; ++rb) cq[rb] = *(const LAS pg8::f32x4*)(tsp[rb] + 16 * (8 * (cb >> 1) + (cb & 1))); }
        if (!(VAR & 64)) {
        const int krow = 8 * (l15 >> 2) + (l15 & 3) + 32 * (cb >> 1) + 4 * (cb & 1), kf_ = ((l15 >> 2) << 1) | ((l15 >> 1) & 1);
#pragma unroll
        for (int ks = 0; ks < 2; ++ks) kf[ks] = (VAR & 1024) ? *(const LAS bf16x8*)(kb_ + (l15 + 16 * lq) * 16 + 1024 * ks + 2048 * cb) : *(const LAS bf16x8*)(kb_ + krow * 128 + 16 * ((4 * ks + lq) ^ kf_)); }
    };
    auto qkm = [&](int cb, const bf16x8 (&kf)[2], const pg8::f32x4 (&cq)[2], pg8::f32x4 (&st)[2]) __attribute__((always_inline)) {
        st[0] = FAR ? (pg8::f32x4){cfar, cfar, cfar, cfar} : (pg8::f32x4){0.f, 0.f, 0.f, 0.f}; st[1] = st[0];
        if (TM == TM_SELN || TM == TM_WINN) { st[0] = cq[0]; st[1] = cq[1]; }
        if (TM == TM_SELF) {
#pragma unroll
            for (int rb = 0; rb < 2; ++rb) { const float ci = selb[rb] ? cfar : -1.0e30f; st[rb] = (pg8::f32x4){ci, ci, ci, ci}; } }
        if (!(VAR & 64)) {
#pragma unroll
        for (int ks = 0; ks < 2; ++ks) {
#pragma unroll
            for (int rb = 0; rb < 2; ++rb) if (RB & (1 << rb)) st[rb] = __builtin_amdgcn_mfma_f32_16x16x32_bf16(kf[ks], qf[rb][ks], st[rb], 0, 0, 0); } }
    };
    float linv_[2] = {0.f, 0.f};
    if (C2) { linv_[0] = LINV[l15]; linv_[1] = LINV[16 + l15]; }
    auto prob = [&](int cb, const pg8::f32x4 (&st)[2]) __attribute__((always_inline)) {
#pragma unroll
        for (int rb = 0; rb < 2; ++rb) if (RB & (1 << rb)) {
            const int tokc = tok_r[rb];
            float p[4];
#pragma unroll
            for (int r = 0; r < 4; ++r) {
                const int kl = 32 * (cb >> 1) + 8 * lq + 4 * (cb & 1) + r;
                if (VAR & 16) { p[r] = st[rb][r]; }
                else if (TM == TM_SELF) { p[r] = fexp2(st[rb][r]); }
                else if (TM == TM_WINF || TM == TM_SELN || TM == TM_WINN || TM == TM_CMP1F || TM == TM_CMP2F) { p[r] = fexp2(st[rb][r]); }
                else if (TM == TM_WINE) { const float e = fexp2(st[rb][r]); p[r] = (kl > tokc) ? e : 0.f; }
                else {
                    const int rel = (TM == TM_CMP1 || TM == TM_CMP2) ? (relbase + tokc - 16 * kl) : (relbase + tokc - kl);
                    const bool valid = rel >= 0;
                    const int ri = rel < 0 ? 0 : (rel > 127 ? 127 : rel);
                    const float e = fexp2(st[rb][r] + LUTJ[ri]);
                    p[r] = valid ? e : 0.f; }
            }
            if (C1) { lacc[rb][0] += (p[0] + p[1]) + (p[2] + p[3]); }
            else {
                if (C2) {
#pragma unroll
                    for (int r = 0; r < 4; ++r) p[r] *= linv_[rb];
                    float h0 = p[0], h1 = p[1], h2 = p[2], h3 = p[3];
                    h0 += dppf<DPP_XOR1>(h0); h1 += dppf<DPP_XOR1>(h1); h2 += dppf<DPP_XOR1>(h2); h3 += dppf<DPP_XOR1>(h3);
                    h0 += dppf<DPP_XOR2>(h0); h1 += dppf<DPP_XOR2>(h1); h2 += dppf<DPP_XOR2>(h2); h3 += dppf<DPP_XOR2>(h3);
                    if ((l15 & 3) == 0) { const int sp = 16 * idx + 8 * (cb >> 1) + 2 * lq + (cb & 1);
                        IMP1[tokc * 65 + sp] = (h0 + h1) + (h2 + 0.5f * h3);
                        if (sp + 1 < 64) IMP2[tokc * 65 + sp + 1] = 0.5f * h3; }
                }
                const unsigned lo = pkh(p[0], p[1]), hi = pkh(p[2], p[3]);
                if (cb & 1) { pfr[rb][cb >> 1].z = lo; pfr[rb][cb >> 1].w = hi; } else { pfr[rb][cb >> 1].x = lo; pfr[rb][cb >> 1].y = hi; } }
        }
    };
    auto vld = [&](int ks, v4u (&vv)[4]) __attribute__((always_inline)) {
        if (!C1 && !(VAR & 8)) {
#pragma unroll
            for (int db = 0; db < 4; ++db) vv[db] = (VAR & 1024) ? *(const LAS v4u*)(vb_ + (l15 + 16 * lq) * 16 + 1024 * ks + 2048 * db) : *(const LAS v4u*)(vb_ + (16 * db + l15) * 128 + 16 * ((4 * ks + lq) ^ (l15 >> 1))); }
    };
    auto pvm = [&](int ks, const v4u (&vv)[4]) __attribute__((always_inline)) {
        if (!C1 && !(VAR & 8)) {
#pragma unroll
            for (int db = 0; db < 4; ++db) {
#pragma unroll
                for (int rb = 0; rb < 2; ++rb) if (RB & (1 << rb)) oacc[rb][db] = __builtin_amdgcn_mfma_f32_16x16x32_bf16(__builtin_bit_cast(bf16x8, pfr[rb][ks]), __builtin_bit_cast(bf16x8, vv[db]), oacc[rb][db], 0, 0, 0); }
            if (!C2) { const v4u ones = (v4u){0x3F803F80u, 0x3F803F80u, 0x3F803F80u, 0x3F803F80u};
#pragma unroll
                for (int rb = 0; rb < 2; ++rb) if (RB & (1 << rb)) lacc[rb] = __builtin_amdgcn_mfma_f32_16x16x32_bf16(__builtin_bit_cast(bf16x8, pfr[rb][ks]), __builtin_bit_cast(bf16x8, ones), lacc[rb], 0, 0, 0); }
        }
    };
    pg8::f32x4 sA[2], sB[2], cA[2], cB[2]; bf16x8 kA[2], kB[2]; v4u vA[4], vB[4];
#define AT_SB __builtin_amdgcn_sched_barrier(0)
    kld(0, kA, cA); kld(1, kB, cB); AT_SB;
    qkm(0, kA, cA, sA); kld(2, kA, cA); AT_SB;
    qkm(1, kB, cB, sB); kld(3, kB, cB); prob(0, sA); AT_SB;
    qkm(2, kA, cA, sA); vld(0, vA); prob(1, sB); AT_SB;
    qkm(3, kB, cB, sB); pvm(0, vA); vld(1, vB); prob(2, sA); AT_SB;
    prob(3, sB); AT_SB;
    pvm(1, vB);
#undef AT_SB
}

template <int VAR> __device__ __forceinline__ void attention_phase(Frame& F, const Args& args) {
    unsigned char* ws = F.ws;
    const int lane = F.lane, w = F.wave, l15 = lane & 15, lq = lane >> 4, tid = F.tid;
    LAS unsigned char* L = F.lds;
    LAS float* IMP1 = (LAS float*)(L + AT_OFF_IMP1); LAS float* IMP2 = (LAS float*)(L + AT_OFF_IMP2);
    LAS unsigned long long* SELM = (LAS unsigned long long*)(L + AT_OFF_SEL); LAS float* LUT = (LAS float*)(L + AT_OFF_LUT); LAS float* LROW = (LAS float*)(L + AT_OFF_LROW) + w * 32;
    LAS int* TD = (LAS int*)(L + AT_OFF_TD); LAS bf16* OUTL = (LAS bf16*)(L + AT_OFF_OUT) + (32 * w) * 72; LAS float* GATL = (LAS float*)(L + AT_OFF_GATL);
    const bf16* Qg = (const bf16*)(ws + WS_Q); const float* GATE = (const float*)(ws + WS_GATE); bf16* YA = (bf16*)(ws + WS_PL) + 512;
    const int jq = l15 & 3;
    const LAS float* LUTJ = LUT + jq * 128;
    const int nrounds = (F.G == 256) ? 4 : (1024 + F.G - 1) / F.G;
    for (int round = 0; round < nrounds; ++round) {
        const int ui = (F.G == 256) ? ((round & 1) ? ((round >> 1) * 512 + 511 - F.bid) : ((round >> 1) * 512 + F.bid)) : (round * F.G + F.bid);
        if (ui >= 1024) break;
        const int c = 63 - (ui >> 4), bg = ui & 15, b = bg >> 1, g = bg & 1;
        const int m0 = b * SEQ + 64 * c;
        __syncthreads();
        { const float M0 = ((const float*)(ws + WS_BIASL))[8 * 128];
          for (int i = tid; i < 512; i += NTHREADS) LUT[i] = (((const float*)(ws + WS_BIASL))[(4 * g + (i >> 7)) * 128 + (i & 127)] - M0) * 1.4426950408889634f; }
        for (int i = tid; i < 64 * 65; i += NTHREADS) { IMP1[i] = 0.f; IMP2[i] = 0.f; }
        { const float M0 = ((const float*)(ws + WS_BIASL))[8 * 128]; const float* BL = (const float*)(ws + WS_BIASL) + (size_t)(4 * g) * 128;
          for (int i = tid; i < 16 * 63 * 4; i += NTHREADS) { const int r = i & 3, yi = (i >> 2) % 63, row = i / 252, rel = 4 * (47 - yi) + (row >> 2) - r;
              ((LAS float*)(L + AT_OFF_TS + row * AT_TS_ROW))[4 * yi + r] = rel < 0 ? -1.0e30f : (BL[(row & 3) * 128 + (rel > 127 ? 127 : rel)] - M0) * 1.4426950408889634f; } }
        for (int i = tid; i < 64 * 12; i += NTHREADS) GATL[i] = GATE[(size_t)(m0 + i / 12) * 24 + g * 12 + (i % 12)];
        bf16x8 qf[2][2];
#pragma unroll
        for (int rb = 0; rb < 2; ++rb)
#pragma unroll
            for (int ks = 0; ks < 2; ++ks) qf[rb][ks] = *(const GAS bf16x8*)(Qg + (size_t)(m0 + 8 * w + 4 * rb + (l15 >> 2)) * 512 + g * 256 + jq * 64 + 32 * ks + 8 * lq);
        asm volatile("" :: "v"(qf[0][0]), "v"(qf[0][1]), "v"(qf[1][0]), "v"(qf[1][1]));
        const int ncmp = 4 * c + 3, n1 = (ncmp + 63) >> 6, nsel = c + 1, w0 = c >= 8 ? c - 8 : 0, nwin = c - w0 + 1;
        const int ntiles = 2 * n1 + nsel + nwin;
        if (tid < ntiles) { const int i = tid;
            auto kindof = [&](int t, int& kind, int& idx) { if (t < n1) { kind = 0; idx = t; } else if (t < 2 * n1) { kind = 1; idx = t - n1; } else if (t < 2 * n1 + nsel) { kind = 2; idx = t - 2 * n1; } else { kind = 3; idx = w0 + (t - 2 * n1 - nsel); } };
            int kind, idx, kn, in_; kindof(i, kind, idx); kindof(i + 1 < ntiles ? i + 1 : i, kn, in_);
            unsigned ko, vo;
            if (kn < 2) { ko = (unsigned)(WS_KC + ((size_t)bg * 256 * 64 + (size_t)in_ * 4096) * 2); vo = (unsigned)(WS_VCT + ((size_t)bg * 64 * 256 + 64 * in_) * 2); }
            else if (kn == 2) { ko = (unsigned)(WS_KS + ((size_t)bg * SEQ * 64 + (size_t)in_ * 4096) * 2); vo = (unsigned)(WS_VST + ((size_t)bg * 64 * SEQ + 64 * in_) * 2); }
            else { ko = (unsigned)(WS_KW + ((size_t)bg * SEQ * 64 + (size_t)in_ * 4096) * 2); vo = (unsigned)(WS_VWT + ((size_t)bg * 64 * SEQ + 64 * in_) * 2); }
            const int dd = c - idx;
            int mode, relbase;
            if (kind == 0) { relbase = 64 * c - 31 - 1024 * idx; mode = relbase >= 1135 ? TM_CMP1F : TM_CMP1; } else if (kind == 1) { relbase = 64 * c - 31 - 1024 * idx; mode = relbase >= 1135 ? TM_CMP2F : TM_CMP2; }
            else if (kind == 2) { mode = dd <= 2 ? TM_SELN : TM_SELF; relbase = 64 * dd; } else { mode = dd <= 2 ? TM_WINN : (dd == 8 ? TM_WINE : TM_WINF); relbase = 64 * dd; }
            const int endf = ((kind == 1 && idx == n1 - 1) || (kind == 2 && idx == nsel - 1) || (kind == 3 && idx == c)) ? kind : 0;
            v4i e; e.x = mode | (idx << 8) | (endf << 16) | ((kind == 2 && idx == 0) ? (1 << 24) : 0) | (kn >= 2 ? (1 << 25) : 0); e.y = relbase; e.z = (int)ko; e.w = (int)vo;
            *(LAS v4i*)(TD + 4 * i) = e; }
        const int drow = 8 * w + (lane >> 3), dsrck = 16 * ((lane & 7) ^ (((w & 3) << 1) | ((lane >> 4) & 1))), dsrcv = 16 * ((lane & 7) ^ ((4 * (w & 1)) | (lane >> 4)));
#define AT_DMA(tile_, ko_, vo_, vs_) do { const int nb_ = (tile_) % AT_NBUF; \
        __builtin_amdgcn_global_load_lds((const GAS unsigned*)(ws + (size_t)((ko_) + drow * 128 + dsrck)), (LAS unsigned*)(L + AT_OFF_K + nb_ * AT_KBUF + w * 1024), 16, 0, 0); \
        __builtin_amdgcn_global_load_lds((const GAS unsigned*)(ws + (size_t)((vo_) + drow * (vs_) + dsrcv)), (LAS unsigned*)(L + AT_OFF_V + nb_ * AT_KBUF + w * 1024), 16, 0, 0); } while (0)
        __syncthreads();
        if (!(VAR & 2)) { AT_DMA(0, (unsigned)(WS_KC + (size_t)bg * 256 * 64 * 2), (unsigned)(WS_VCT + (size_t)bg * 64 * 256 * 2), 512u); }
        int d0, d1, d2, d3;
        { const v4i e = *(const LAS v4i*)TD; d0 = __builtin_amdgcn_readfirstlane(e.x); d1 = __builtin_amdgcn_readfirstlane(e.y); d2 = __builtin_amdgcn_readfirstlane(e.z); d3 = __builtin_amdgcn_readfirstlane(e.w); }
        pg8::f32x4 oacc[2][4];
        pg8::f32x4 lacc[2] = {(pg8::f32x4){0.f, 0.f, 0.f, 0.f}, (pg8::f32x4){0.f, 0.f, 0.f, 0.f}};
#pragma unroll
        for (int rb = 0; rb < 2; ++rb)
#pragma unroll
            for (int db = 0; db < 4; ++db) oacc[rb][db] = (pg8::f32x4){0.f, 0.f, 0.f, 0.f};
        const int tok_r[2] = {8 * w + (l15 >> 2), 8 * w + 4 + (l15 >> 2)};
        const LAS unsigned char* tsw = L + AT_OFF_TS + 16 * (47 - 2 * w); const LAS unsigned char* tsn = L + AT_OFF_TS + 16 * 48;
        for (int it = 0; it < ((VAR & 32) ? 0 : ntiles); ++it) {
            if (!(VAR & 512)) { asm volatile("s_waitcnt vmcnt(0)" ::: "memory");
            asm volatile("s_waitcnt lgkmcnt(0)" ::: "memory"); __builtin_amdgcn_s_barrier(); asm volatile("" ::: "memory"); }
            if (!(VAR & 2) && it + 1 < ntiles) AT_DMA(it + 1, (unsigned)d2, (unsigned)d3, ((d0 >> 25) & 1) ? 2u * SEQ : 512u);
            v4i tdn;
            { const LAS int* tn_ = TD + 4 * (it + 1); asm volatile("ds_read_b128 %0, %1" : "=v"(tdn) : "v"(tn_) : "memory"); }
            {
            const int mode = d0 & 255, idx = (d0 >> 8) & 255, relbase = d1, endf = (d0 >> 16) & 3, selfirst = (d0 >> 24) & 1;
            const int buf = it % AT_NBUF;
            if (selfirst) {
                { const int tok = 8 * w + (lane >> 3), s0 = 8 * (lane & 7);
                  unsigned key[8]; int rank[8];
#pragma unroll
                  for (int q = 0; q < 8; ++q) { const int sB = s0 + q; const bool vis = sB <= c, forced = (sB == 0) || (sB == c) || (sB == c - 1);
                      const float sc = vis ? (IMP1[tok * 65 + sB] + IMP2[tok * 65 + sB] + (forced ? 1000.f : 0.f)) : -1.f;
                      const unsigned u = __builtin_bit_cast(unsigned, sc); const unsigned fk = (u >> 31) ? ~u : (u | 0x80000000u);
                      key[q] = (fk & ~63u) | (unsigned)(63 - sB); rank[q] = 0; }
                  LAS unsigned* KEYS = (LAS unsigned*)IMP1;
#pragma unroll
                  for (int q = 0; q < 8; ++q) KEYS[tok * 65 + s0 + q] = key[q];
                  if (c >= 16 && !(VAR & 128)) {
#pragma unroll 8
                      for (int s2 = 0; s2 < 64; ++s2) { const unsigned k2 = KEYS[tok * 65 + s2];
#pragma unroll
                          for (int q = 0; q < 8; ++q) rank[q] += (k2 > key[q]) ? 1 : 0; } }
                  unsigned byte = 0u;
#pragma unroll
                  for (int q = 0; q < 8; ++q) byte |= ((rank[q] < 16 && (s0 + q) <= c) ? 1u : 0u) << q;
                  ((LAS unsigned char*)SELM)[tok * 8 + (lane & 7)] = (unsigned char)byte; }
            }
            const LAS unsigned char* kb_ = L + AT_OFF_K + buf * AT_KBUF; const LAS unsigned char* vb_ = L + AT_OFF_V + buf * AT_KBUF;
            const float cfar = LUTJ[127];
            unsigned selb[2] = {1u, 1u};
#define AT_CALL(TMX) at_tile<TMX, VAR>(kb_, vb_, LUTJ, IMP1, IMP2, qf, oacc, lacc, LROW, tok_r, selb, cfar, relbase, idx, l15, lq, tsw, tsn)
            if (mode == TM_SELF || mode == TM_SELN) { selb[0] = (unsigned)(SELM[tok_r[0]] >> idx) & 1u; selb[1] = (unsigned)(SELM[tok_r[1]] >> idx) & 1u; }
            if (mode == TM_SELF) {
                const bool a0 = __ballot(selb[0] != 0u) != 0ull, a1 = __ballot(selb[1] != 0u) != 0ull;
                if (a0 && a1) AT_CALL(TM_SELF);
                else if (a0) at_tile<TM_SELF, VAR, 1>(kb_, vb_, LUTJ, IMP1, IMP2, qf, oacc, lacc, LROW, tok_r, selb, cfar, relbase, idx, l15, lq, tsw, tsn);
                else if (a1) at_tile<TM_SELF, VAR, 2>(kb_, vb_, LUTJ, IMP1, IMP2, qf, oacc, lacc, LROW, tok_r, selb, cfar, relbase, idx, l15, lq, tsw, tsn); }
            else if (mode == TM_WINF) AT_CALL(TM_WINF);
            else if (mode == TM_SELN) AT_CALL(TM_SELN);
            else if (mode == TM_WINN) AT_CALL(TM_WINN);
            else if (mode == TM_WINE) AT_CALL(TM_WINE);
            else if (mode == TM_CMP2) AT_CALL(TM_CMP2);
            else if (mode == TM_CMP2F) AT_CALL(TM_CMP2F);
            else if (mode == TM_CMP1F) AT_CALL(TM_CMP1F);
            else { AT_CALL(TM_CMP1);
                if (idx == n1 - 1) {
#pragma unroll
                    for (int rb = 0; rb < 2; ++rb) { const float s = sum_xor32(sum_xor16(lacc[rb][0])); if (lq == 0) LROW[16 * rb + l15] = s > 0.f ? 1.0f / s : 0.f; lacc[rb] = (pg8::f32x4){0.f, 0.f, 0.f, 0.f}; } } }
#undef AT_CALL
            {
                if (endf && !(VAR & 256)) {
                    const int br = endf - 1;
#pragma unroll
                    for (int rb = 0; rb < 2; ++rb)
#pragma unroll
                        for (int r = 0; r < 4; ++r) { const int qrow = 16 * rb + 4 * lq + r;
                            const float ls_ = lacc[rb][r]; lacc[rb][r] = 0.f;
                            const float gt = GATL[(8 * w + 4 * rb + lq) * 12 + r * 3 + br] * (endf == 1 ? 1.0f : (ls_ > 0.f ? 1.0f / ls_ : 0.f));
#pragma unroll
                            for (int db = 0; db < 4; ++db) { float v = gt * oacc[rb][db][r]; oacc[rb][db][r] = 0.f;
                                LAS bf16* po = OUTL + qrow * 72 + 16 * db + l15;
                                if (br > 0) v += __builtin_bit_cast(float, (unsigned)(*po) << 16);
                                *po = (bf16)f2bf(v); } }
                    if (br == 2 && !(VAR & 1)) {
                        LDS_WAIT(); asm volatile("" ::: "memory");
#pragma unroll
                        for (int i = 0; i < 4; ++i) { const int ch = i * 64 + lane, row = ch >> 3, c16 = ch & 7;
                            const v4u o = *(const LAS v4u*)((const LAS unsigned char*)OUTL + row * 144 + 16 * c16);
                            *(GAS v4u*)(YA + (size_t)(m0 + 8 * w + (row >> 2)) * 1024 + g * 256 + (row & 3) * 64 + 8 * c16) = o; }
                    }
                }
            }
            }
            asm volatile("s_waitcnt lgkmcnt(0)" : "+v"(tdn) :: "memory");
            d0 = __builtin_amdgcn_readfirstlane(tdn.x); d1 = __builtin_amdgcn_readfirstlane(tdn.y); d2 = __builtin_amdgcn_readfirstlane(tdn.z); d3 = __builtin_amdgcn_readfirstlane(tdn.w);
        }
#undef AT_DMA
    }
}

constexpr int N_PHASES = 13;
#ifndef MK_ONE_LAUNCH
#define MK_ONE_LAUNCH 1
#endif
#ifndef REP_P0
#define REP_P0 1
#endif
#ifndef REP_P1
#define REP_P1 1
#endif
#ifndef REP_P2
#define REP_P2 1
#endif
#ifndef REP_P3
#define REP_P3 1
#endif
#ifndef REP_P5
#define REP_P5 1
#endif
#ifndef REP_P6
#define REP_P6 1
#endif
#ifndef REP_P8
#define REP_P8 1
#endif
#ifndef REP_P7
#define REP_P7 1
#endif
#ifndef REP_P11
#define REP_P11 1
#endif
#ifndef REP_P4
#define REP_P4 1
#endif
#ifndef REP_P9
#define REP_P9 1
#endif
#ifndef REP_P10
#define REP_P10 1
#endif
#ifndef MK_BUILD
#define MK_BUILD 0
#endif

#ifndef STAG_P2
#define STAG_P2 0
#endif
__device__ __forceinline__ void phase_stagger(const Frame& F, int step_ns) {
    const int grp = (F.bid >> 3) & 7;
    if (step_ns > 0 && grp > 0) { const unsigned long long t0 = wall_clock64(), dt = (unsigned long long)(grp * step_ns) / 10ull;
        while (wall_clock64() - t0 < dt) __builtin_amdgcn_s_sleep(8); }
}
struct EpiNull {
    static constexpr bool PERM = true, AFTER_DRAIN = false, MID = false;
    __device__ __forceinline__ void operator()(const pg8::f32x4 (&acc)[2][2][4][2], const pg8::Unit& u, int wr, int wc, int fr, int fq) const {
#pragma unroll
        for (int ai = 0; ai < 2; ++ai)
#pragma unroll
            for (int bj = 0; bj < 2; ++bj)
#pragma unroll
                for (int m = 0; m < 4; ++m) { asm volatile("" :: "v"(acc[ai][bj][m][0]), "v"(acc[ai][bj][m][1])); }
    }
};
__global__ void __launch_bounds__(NTHREADS, 2) fwd_kernel(Args args) {
    extern __shared__ __attribute__((aligned(16))) unsigned char lds[];
    Frame F;
    F.lds = (LAS unsigned char*)lds;
    F.MISC = (volatile LAS unsigned*)(F.lds + MISC_OFF);
    F.tid = threadIdx.x; F.lane = F.tid & 63; F.wave = __builtin_amdgcn_readfirstlane(F.tid >> 6);
    F.G = gridDim.x; F.bid = blockIdx.x; F.ws = args.ws;
    F.ctl = (gu32*)(args.ws + WS_CTL);
    for (int u = F.tid; u < (LDS_BYTES - LDSCTL_OFF) / 4; u += NTHREADS) ((LAS unsigned*)(F.lds + LDSCTL_OFF))[u] = 0u;
    __syncthreads();
    XcdBarrier bar; bar.bar = (unsigned*)(F.ctl + CW_BAR); bar.x = 0; bar.st = nullptr;
    if (MK_ONE_LAUNCH) bar = xcd_barrier_post((unsigned*)(F.ctl + CW_BAR), F.MISC + 8);
    const int lo = args.ph_lo, hi = args.ph_hi;
#define IN(k) (lo <= (k) && (k) < hi)
#define SEAM(k) do { if (IN(k) && IN((k) + 1)) xcd_barrier(bar); } while (0)
    unsigned char* ws = args.ws;
    const float* ada = (const float*)(ws + WS_ADA);

    if (IN(0)) { for (int rep = 0; rep < REP_P0; ++rep) { p0_prologue(F, args, rep == REP_P0 - 1); __syncthreads(); } } SEAM(0);
    if (IN(1)) { for (int rep = 0; rep < REP_P1; ++rep) {
        const int r0 = F.wave & 3;
        for (int k = 0; k < 4; ++k) { const int seg = (r0 + k) & 3;
            if (seg == 0) p0_stream_seg<0>(F, args); else if (seg == 1) p0_stream_seg<1>(F, args); else if (seg == 2) p0_stream_seg<2>(F, args);
            else modnorm_rows<false>(F, args.in[I_X], args.in[I_N1G], ada, 0, (bf16*)(ws + WS_H)); } } } SEAM(1);
    if (IN(2)) { {
        phase_stagger(F, STAG_P2);
        pg8::Gemm g{(const bf16*)(ws + WS_H), (const bf16*)(ws + WS_WIN_T), M, NIN, D, D, D}; pg8::StaticOrder S; S.init(M, NIN, F.G, F.bid);
        if (F.tid == 0) F.MISC[40] = 0xffffffffu; __syncthreads();
        EpiIn E{ws, args.in[I_QNG], args.in[I_KNG], F.MISC + 40};
#if defined(PROBE_P2) && PROBE_P2 == 1
        { EpiNull EN; pg8::gemm_phase<EpiNull, pg8::StaticOrder, true, true>(F.lds + RING_OFF, g, S, EN); __syncthreads(); }
#elif defined(PROBE_P2) && PROBE_P2 == 2
        { if (F.tid == 0) F.MISC[40] = 0u; __syncthreads(); pg8::gemm_phase<EpiIn, pg8::StaticOrder, true, true>(F.lds + RING_OFF, g, S, E); __syncthreads(); if (F.tid == 0) F.MISC[40] = 0xffffffffu; __syncthreads(); }
#endif
        pg8::gemm_phase<EpiIn, pg8::StaticOrder, true, true>(F.lds + RING_OFF, g, S, E);
#if REP_P2 > 1
        __syncthreads(); pg8::gemm_phase<EpiIn, pg8::StaticOrder, true, true>(F.lds + RING_OFF, g, S, E);
#endif
        }
    } SEAM(2);
#ifndef PROBE_P3
#define PROBE_P3 0
#endif
    if (IN(3)) { for (int rep = 0; rep < REP_P3; ++rep) { __syncthreads(); pool_phase(F); if (PROBE_P3 == 1) { __syncthreads(); pool_phase(F); }
        __syncthreads(); compress_phase(F, args.in[I_KNG]); if (PROBE_P3 == 2) { __syncthreads(); compress_phase(F, args.in[I_KNG]); }
        __syncthreads(); vtranspose_phase(F); if (PROBE_P3 == 3) { __syncthreads(); vtranspose_phase(F); } } } SEAM(3);
    if (IN(4)) {
#ifdef PROBE_P4
        attention_phase<PROBE_P4>(F, args); __syncthreads();
#endif
        for (int rep = 0; rep < REP_P4; ++rep) { attention_phase<0>(F, args); __syncthreads(); } } SEAM(4);
    if (IN(5)) { {
        pg8::Gemm g{(const bf16*)(ws + WS_PL), (const bf16*)(ws + WS_WEFF_T), M, D, 2 * POOLW, 2 * POOLW, 2 * POOLW}; pg8::StaticOrder S; S.init(M, D, F.G, F.bid);
        EpiMix2 E{(bf16*)(ws + WS_MIX), (const bf16*)(ws + WS_GM)};
        pg8::gemm_phase<EpiMix2, pg8::StaticOrder, true, true>(F.lds + RING_OFF, g, S, E);
#if REP_P5 > 1
        __syncthreads(); pg8::gemm_phase<EpiMix2, pg8::StaticOrder, true, true>(F.lds + RING_OFF, g, S, E);
#endif
        }
    } SEAM(5);
    if (IN(6)) { {
        pg8::Gemm g{(const bf16*)(ws + WS_MIX), (const bf16*)(ws + WS_WOUT_T), M, D, D, D, D}; pg8::StaticOrder S; S.init(M, D, F.G, F.bid);
        EpiRes E{args.in[I_X], (bf16*)(ws + WS_X1), ada, 2};
        pg8::gemm_phase<EpiRes, pg8::StaticOrder, true, true>(F.lds + RING_OFF, g, S, E);
#if REP_P6 > 1
        __syncthreads(); pg8::gemm_phase<EpiRes, pg8::StaticOrder, true, true>(F.lds + RING_OFF, g, S, E);
#endif
        }
    } SEAM(6);
    if (IN(7)) { for (int rep = 0; rep < REP_P7; ++rep) modnorm_rows<true>(F, ws + WS_X1, args.in[I_N2G], ada, 3, (bf16*)(ws + WS_H)); } SEAM(7);
    if (IN(8)) { {
        pg8::Gemm g{(const bf16*)(ws + WS_H), (const bf16*)(ws + WS_WQ_T), M, PQW, D, D, D}; pg8::StaticOrder S; S.init(M, PQW, F.G, F.bid);
        EpiStoreBf16 E{(bf16*)(ws + WS_QV), PQW};
        pg8::gemm_phase<EpiStoreBf16, pg8::StaticOrder, true, true>(F.lds + RING_OFF, g, S, E);
#if REP_P8 > 1
        __syncthreads(); pg8::gemm_phase<EpiStoreBf16, pg8::StaticOrder, true, true>(F.lds + RING_OFF, g, S, E);
#endif
        }
    } SEAM(8);
    if (IN(9)) { for (int rep = 0; rep < REP_P9; ++rep) peer_select_phase(F); } SEAM(9);
#ifdef PROBE_XCD
    if (IN(10)) { if (F.tid == 0) __hip_atomic_store((unsigned*)(F.ctl + 2048 + F.bid), 100u + xb_xcc_id(), RLX_AGENT); }
#endif
    if (IN(10)) {
#ifdef PROBE_DOT
        peer_dot_phase<PROBE_DOT>(F); __syncthreads();
#endif
#ifdef PROBE_LOADRATE
        peer_loadrate_probe<PROBE_LOADRATE>(F); __syncthreads();
#endif
        peer_dot_phase<0>(F); } SEAM(10);
    if (IN(11)) { for (int rep = 0; rep < REP_P11; ++rep) peer_coef_phase(F); } SEAM(11);
#ifdef PROBE_XCD
    if (IN(12) && F.bid == 0 && F.tid == 0) { bool ok = true; for (int i = 0; i < F.G; ++i) { const unsigned a = __hip_atomic_load((unsigned*)(F.ctl + 2048 + i), RLX_AGENT), b0 = __hip_atomic_load((unsigned*)(F.ctl + 2048 + (i & 7)), RLX_AGENT); if (a != b0 || a < 100u) ok = false; }
        for (int i = 0; i < 8; ++i) for (int q = 0; q < i; ++q) if (__hip_atomic_load((unsigned*)(F.ctl + 2048 + i), RLX_AGENT) == __hip_atomic_load((unsigned*)(F.ctl + 2048 + q), RLX_AGENT)) ok = false;
        if (!ok) args.out[12345] = 1.0e9f; }
    __syncthreads();
#endif
    if (IN(12)) {
#if defined(CHECK_OUT_MFMA)
        peer_out_mfma_phase<1>(F, ada, args.out); __syncthreads(); VM_WAIT(); __syncthreads(); peer_out_phase<false, true>(F, ada, args.out);
#elif defined(OUT_VALU)
        for (int rep = 1; rep < REP_P10; ++rep) peer_out_phase<true>(F, ada, args.out); peer_out_phase<false>(F, ada, args.out);
#else
#ifdef PROBE_OUT
        peer_out_mfma_phase<1>(F, ada, args.out); __syncthreads();
#endif
        peer_out_mfma_phase<0>(F, ada, args.out);
#endif
    }
#undef IN
#undef SEAM
}

extern "C" void kernel_launch(void* const* d_in, const int* in_sizes, int n_in, void* d_out, int out_size, void* d_ws, size_t ws_size, hipStream_t stream) {
    static int grid = 0;
    if (grid == 0) {
        if (n_in != N_IN || in_sizes[0] != M * D || out_size != M * D || ws_size < WS_END) {
            fprintf(stderr, "kernel_launch: unexpected shapes: n_in %d in0 %d out %d ws %zu (need %zu)\n", n_in, n_in > 0 ? in_sizes[0] : -1, out_size, ws_size, (size_t)WS_END); grid = -1; return; }
        int dev = 0, cus = 0, per_cu = 0;
        if (hipGetDevice(&dev) != hipSuccess || hipDeviceGetAttribute(&cus, hipDeviceAttributeMultiprocessorCount, dev) != hipSuccess) { grid = -1; return; }
        if (hipFuncSetAttribute((const void*)fwd_kernel, hipFuncAttributeMaxDynamicSharedMemorySize, LDS_BYTES) != hipSuccess) { fprintf(stderr, "kernel_launch: hipFuncSetAttribute failed\n"); grid = -1; return; }
        if (hipOccupancyMaxActiveBlocksPerMultiprocessor(&per_cu, (const void*)fwd_kernel, NTHREADS, LDS_BYTES) != hipSuccess || per_cu < 1)
            fprintf(stderr, "kernel_launch: occupancy query reports %d workgroups per CU\n", per_cu);
        (void)hipGetLastError();
        grid = cus;
    }
    if (grid < 0) return;
    if (hipMemsetAsync((char*)d_ws + WS_CTL, 0, CTL_ZERO_BYTES, stream) != hipSuccess) return;
    Args a{};
    for (int i = 0; i < N_IN; ++i) a.in[i] = (const float*)d_in[i];
    a.out = (float*)d_out; a.ws = (unsigned char*)d_ws;
    if (MK_ONE_LAUNCH) {
        a.ph_lo = 0; a.ph_hi = N_PHASES; a.li = 0;
        hipLaunchKernelGGL(fwd_kernel, dim3(grid), dim3(NTHREADS), LDS_BYTES, stream, a);
    } else {
        for (int p = 0; p < N_PHASES; ++p) {
            a.ph_lo = p; a.ph_hi = p + 1; a.li = p;
            hipLaunchKernelGGL(fwd_kernel, dim3(grid), dim3(NTHREADS), LDS_BYTES, stream, a);
        }
    }
}
```

```cpp
#include <hip/hip_runtime.h>
#include <cstdio>
#include <cstdint>
namespace pg8 {
#define PG8_LAS __attribute__((address_space(3)))
typedef unsigned short bf16_t;
typedef short bf16x8 __attribute__((ext_vector_type(8)));
typedef float f32x4 __attribute__((ext_vector_type(4)));
typedef unsigned u32x4 __attribute__((ext_vector_type(4)));
constexpr int BM = 256, BK = 64, HALF = 128, HTB = HALF * BK * 2  , STAGE_BYTES = 8 * HTB, NXCD = 8, WGM = 4;

__host__ __device__ __forceinline__ int lds_byte(int r, int c) { const int st = (r >> 4) * 2 + (c >> 5), rr = r & 15, cc = c & 31, ob = rr * 64 + cc * 2; return st * 1024 + (ob ^ (((ob >> 9) & 1) << 5)); }
__host__ __device__ __forceinline__ void stage_rc(int b, int& R, int& C) { const int st = b / 1024, sb = b % 1024, swz = sb ^ (((sb >> 9) & 1) << 5); R = (st >> 1) * 16 + swz / 64; C = (st & 1) * 32 + (swz % 64) / 2; }
__host__ __device__ __forceinline__ int perm32(int rho) { const int n = rho >> 4, i = rho & 15; return 8 * (i >> 2) + 4 * n + (i & 3); }

struct Unit { int pm, pn; };
struct Gemm { const bf16_t* A; const bf16_t* Bt; int M, N, K, lda, ldb; };

struct StaticOrder {
    int nM, nN, nwg, G, c, wgm;
    __host__ __device__ void init(int M, int N, int G_, int c_, int wgm_ = WGM) { nM = M / BM; nN = N / BM; nwg = nM * nN; G = G_; c = c_; wgm = wgm_; }
    __host__ __device__ bool next(int i, Unit& u) const {
        const long L = (long)i * G + c; if (L >= nwg) return false;
        int wgid = (int)L; { const int q = nwg / NXCD, r = nwg % NXCD, xcd = wgid % NXCD, off = wgid / NXCD; wgid = (xcd < r ? xcd * (q + 1) : r * (q + 1) + (xcd - r) * q) + off; }
        const int nig = wgm * nN, gid = wgid / nig, fm = gid * wgm, gsz = (nM - fm) < wgm ? (nM - fm) : wgm;
        u.pm = fm + ((wgid % nig) % gsz); u.pn = (wgid % nig) / gsz; return true;
    }
    __device__ __forceinline__ void a_ready(const Unit&) const {}
    __device__ __forceinline__ void done(const Unit&) const {}
};

__device__ __forceinline__ unsigned cvt_pk_bf16(float lo, float hi) { unsigned r; asm volatile("v_cvt_pk_bf16_f32 %0, %1, %2" : "=v"(r) : "v"(lo), "v"(hi)); return r; }
template <class Epi, class Sched, bool ALIGN_EPI = false, bool SP2 = false>
__device__ __forceinline__ void gemm_phase(PG8_LAS unsigned char* lds, const Gemm g, const Sched& S, const Epi& E) {
    const int tid = threadIdx.x, wid = __builtin_amdgcn_readfirstlane(tid >> 6), lane = tid & 63, wr = wid >> 2, wc = wid & 3, fr = lane & 15, fq = lane >> 4;
    const int K = g.K, nt = K / BK;
    unsigned voffA[2], voffB[2];
#pragma unroll
    for (int i = 0; i < 2; ++i) { int R, C; stage_rc(tid * 16 + i * 8192, R, C); const int Rb = Epi::PERM ? ((R & ~31) + perm32(R & 31)) : R;
        voffA[i] = (unsigned)(R * g.lda + C) * 2u; voffB[i] = (unsigned)(Rb * g.ldb + C) * 2u; }
    const size_t kstep = (size_t)(BK * 2);
    const size_t hstepA = (size_t)HALF * g.lda * 2, hstepB = (size_t)HALF * g.ldb * 2;
    const size_t tstepA = 2 * hstepA, tstepB = 2 * hstepB;
    const unsigned ldsw = (unsigned)wid * 1024u;
    const int aoff = lds_byte(wr * 64 + fr, fq * 8), boff = lds_byte(wc * 32 + fr, fq * 8);
#define PG8_SA(b, h) (((b) * 2 + (h)) * HTB)
#define PG8_SB(b, h) ((4 + (b) * 2 + (h)) * HTB)
#define PG8_STAGE(bufoff, gbase, voff) do { _Pragma("unroll") for (int _i = 0; _i < 2; ++_i) \
        __builtin_amdgcn_global_load_lds((const unsigned*)((const char*)(gbase) + (voff)[_i]), (PG8_LAS unsigned*)(lds + (bufoff) + ldsw + _i * 8192), 16, 0, 0); } while (0)
#define PG8_LDA(dst, b, h) do { _Pragma("unroll") for (int m = 0; m < 4; ++m) _Pragma("unroll") for (int k = 0; k < 2; ++k) dst[m][k] = *(const PG8_LAS bf16x8*)(lds + PG8_SA(b, h) + aoff + m * 2048 + k * 1024); } while (0)
#define PG8_LDB(dst, b, h) do { _Pragma("unroll") for (int n = 0; n < 2; ++n) _Pragma("unroll") for (int k = 0; k < 2; ++k) dst[n][k] = *(const PG8_LAS bf16x8*)(lds + PG8_SB(b, h) + boff + n * 2048 + k * 1024); } while (0)
#define PG8_MMA(ai, bj, At, Bt) do { __builtin_amdgcn_s_setprio(1); _Pragma("unroll") for (int m = 0; m < 4; ++m) _Pragma("unroll") for (int n = 0; n < 2; ++n) _Pragma("unroll") for (int k = 0; k < 2; ++k) \
        acc[ai][bj][m][n] = __builtin_amdgcn_mfma_f32_16x16x32_bf16(Bt[n][k], At[m][k], acc[ai][bj][m][n], 0, 0, 0); __builtin_amdgcn_s_setprio(0); } while (0)
#define PG8_WAIT_V(n) asm volatile("s_waitcnt vmcnt(" #n ")" ::: "memory")
#define PG8_WAIT_L(n) asm volatile("s_waitcnt lgkmcnt(" #n ")" ::: "memory")
#define PG8_BAR __builtin_amdgcn_s_barrier()
#define PG8_SCHED __builtin_amdgcn_sched_barrier(0)
    Unit cur, nxt; int ui = 0;
    if (!S.next(0, cur)) return;
    f32x4 acc[2][2][4][2];
#pragma unroll
    for (int a = 0; a < 2; ++a)
#pragma unroll
        for (int b = 0; b < 2; ++b)
#pragma unroll
            for (int m = 0; m < 4; ++m)
#pragma unroll
                for (int n = 0; n < 2; ++n) acc[a][b][m][n] = (f32x4){0.f, 0.f, 0.f, 0.f};
    bf16x8 At[4][2], B0[2][2], B1[2][2];
    const char* cA = (const char*)g.A + (size_t)cur.pm * tstepA; const char* cB = (const char*)g.Bt + (size_t)cur.pn * tstepB;
    S.a_ready(cur);
    if constexpr (SP2) {
        PG8_STAGE(PG8_SB(0, 0), cB, voffB); PG8_STAGE(PG8_SB(0, 1), cB + hstepB, voffB); PG8_STAGE(PG8_SA(0, 0), cA, voffA); PG8_STAGE(PG8_SA(0, 1), cA + hstepA, voffA);
        if (wr == 1) PG8_BAR;
        PG8_WAIT_V(2); PG8_BAR;
        PG8_STAGE(PG8_SB(1, 0), cB + kstep, voffB); PG8_STAGE(PG8_SA(1, 0), cA + kstep, voffA); PG8_STAGE(PG8_SB(1, 1), cB + hstepB + kstep, voffB);
        PG8_WAIT_V(6); PG8_BAR;
    } else {
        PG8_STAGE(PG8_SB(0, 0), cB, voffB); PG8_STAGE(PG8_SA(0, 0), cA, voffA); PG8_STAGE(PG8_SB(0, 1), cB + hstepB, voffB); PG8_STAGE(PG8_SA(0, 1), cA + hstepA, voffA);
        if (wr == 1) PG8_BAR;
        PG8_WAIT_V(4); PG8_BAR;
        PG8_STAGE(PG8_SB(1, 0), cB + kstep, voffB); PG8_STAGE(PG8_SA(1, 0), cA + kstep, voffA); PG8_STAGE(PG8_SB(1, 1), cB + hstepB + kstep, voffB);
        PG8_WAIT_V(6); PG8_BAR;
    }
    for (;;) {
        const bool has_next = S.next(ui + 1, nxt);
        const char* nA = has_next ? (const char*)g.A + (size_t)nxt.pm * tstepA : cA; const char* nB = has_next ? (const char*)g.Bt + (size_t)nxt.pn * tstepB : cB;
        for (int t = 0; t < nt; t += 2) {
            if constexpr (Epi::MID) { if (t == nt / 2) E.mid(acc, cur, wr, wc, fr, fq); }
            const bool last = (t == nt - 2);
            const char* a1 = cA + (size_t)(t + 1) * kstep;
            const char* a2 = last ? nA : cA + (size_t)(t + 2) * kstep; const char* b2 = last ? nB : cB + (size_t)(t + 2) * kstep;
            const char* a3 = a2 + kstep; const char* b3 = b2 + kstep;
            if (last && has_next) S.a_ready(nxt);
            if constexpr (SP2) {
            PG8_LDB(B0, 0, 0); PG8_LDB(B1, 0, 1); PG8_SCHED; PG8_LDA(At, 0, 0); PG8_STAGE(PG8_SA(1, 1), a1 + hstepA, voffA);
            PG8_WAIT_V(8); PG8_WAIT_L(0); PG8_BAR; PG8_MMA(0, 0, At, B0); PG8_MMA(0, 1, At, B1); PG8_BAR; PG8_SCHED;
            PG8_LDA(At, 0, 1); PG8_STAGE(PG8_SB(0, 0), b2, voffB); PG8_STAGE(PG8_SB(0, 1), b2 + hstepB, voffB); PG8_STAGE(PG8_SA(0, 0), a2, voffA);
            PG8_WAIT_V(8); PG8_WAIT_L(0); PG8_BAR; PG8_MMA(1, 0, At, B0); PG8_MMA(1, 1, At, B1); PG8_BAR; PG8_SCHED;
            PG8_LDB(B0, 1, 0); PG8_LDB(B1, 1, 1); PG8_SCHED; PG8_LDA(At, 1, 0); PG8_STAGE(PG8_SA(0, 1), a2 + hstepA, voffA);
            PG8_WAIT_V(8); PG8_WAIT_L(0); PG8_BAR; PG8_MMA(0, 0, At, B0); PG8_MMA(0, 1, At, B1); PG8_BAR; PG8_SCHED;
            PG8_LDA(At, 1, 1); PG8_STAGE(PG8_SB(1, 0), b3, voffB); PG8_STAGE(PG8_SB(1, 1), b3 + hstepB, voffB); PG8_STAGE(PG8_SA(1, 0), a3, voffA);
            PG8_WAIT_V(8); PG8_WAIT_L(0); PG8_BAR; PG8_MMA(1, 0, At, B0); PG8_MMA(1, 1, At, B1); PG8_BAR; PG8_SCHED;
            } else {
            PG8_LDB(B0, 0, 0); PG8_SCHED; PG8_LDA(At, 0, 0); PG8_STAGE(PG8_SA(1, 1), a1 + hstepA, voffA);
            PG8_WAIT_L(8); PG8_BAR; PG8_WAIT_L(0); PG8_MMA(0, 0, At, B0); PG8_BAR; PG8_SCHED;
            PG8_LDB(B1, 0, 1); PG8_STAGE(PG8_SB(0, 0), b2, voffB);
            PG8_BAR; PG8_WAIT_L(0); PG8_MMA(0, 1, At, B1); PG8_BAR;
            PG8_LDA(At, 0, 1); PG8_STAGE(PG8_SA(0, 0), a2, voffA);
            PG8_BAR; PG8_WAIT_L(0); PG8_MMA(1, 0, At, B0); PG8_BAR; PG8_SCHED;
            PG8_STAGE(PG8_SB(0, 1), b2 + hstepB, voffB);
            PG8_WAIT_V(6); PG8_BAR; PG8_MMA(1, 1, At, B1); PG8_BAR;
            PG8_LDB(B0, 1, 0); PG8_SCHED; PG8_LDA(At, 1, 0); PG8_STAGE(PG8_SA(0, 1), a2 + hstepA, voffA);
            PG8_WAIT_L(8); PG8_BAR; PG8_WAIT_L(0); PG8_MMA(0, 0, At, B0); PG8_BAR; PG8_SCHED;
            PG8_LDB(B1, 1, 1); PG8_STAGE(PG8_SB(1, 0), b3, voffB);
            PG8_BAR; PG8_WAIT_L(0); PG8_MMA(0, 1, At, B1); PG8_BAR;
            PG8_LDA(At, 1, 1); PG8_STAGE(PG8_SA(1, 0), a3, voffA);
            PG8_BAR; PG8_WAIT_L(0); PG8_MMA(1, 0, At, B0); PG8_BAR; PG8_SCHED;
            PG8_STAGE(PG8_SB(1, 1), b3 + hstepB, voffB);
            PG8_WAIT_V(6); PG8_BAR; PG8_MMA(1, 1, At, B1); PG8_BAR;
            }
        }
        if constexpr (ALIGN_EPI) { if (wr == 0) PG8_BAR; }
        if constexpr (!Epi::AFTER_DRAIN) { E(acc, cur, wr, wc, fr, fq); S.done(cur); }
        if (!has_next) break;
#pragma unroll
        for (int a = 0; a < 2; ++a)
#pragma unroll
            for (int b = 0; b < 2; ++b)
#pragma unroll
                for (int m = 0; m < 4; ++m)
#pragma unroll
                    for (int n = 0; n < 2; ++n) acc[a][b][m][n] = (f32x4){0.f, 0.f, 0.f, 0.f};
        cur = nxt; cA = nA; cB = nB; ++ui;
        if constexpr (ALIGN_EPI) { if (wr == 1) PG8_BAR; }
    }
    PG8_WAIT_V(0);
    if constexpr (!ALIGN_EPI) { if (wr == 0) PG8_BAR; }
    PG8_BAR;
    if constexpr (Epi::AFTER_DRAIN) { E.fused(acc, cur, wr, wc, fr, fq, lds, wid, lane); S.done(cur); }
#undef PG8_SA
#undef PG8_SB
#undef PG8_STAGE
#undef PG8_LDA
#undef PG8_LDB
#undef PG8_MMA
#undef PG8_WAIT_V
#undef PG8_WAIT_L
#undef PG8_BAR
#undef PG8_SCHED
}
}

constexpr int NWAVES = 8, NTHREADS = NWAVES * 64;
constexpr int BATCH = 8, SEQ = 4096, D = 1024, M = BATCH * SEQ;
constexpr int POOLW = 512, QW = 512, NG = 2, HD = 64, NBG = BATCH * NG;
constexpr int IN_COLS = 3864, NIN = 4096;
constexpr int NCMP = 255, NCMP_PAD = 256, NSEL = 64;
constexpr int PH = 8, PK = 128, PTOP = 16, PQD = 256, PQW = PH * PQD;
constexpr int NEXP = PK * PK;
constexpr float EPS = 1e-6f;
enum { I_X = 0, I_C, I_RELB, I_ADAW, I_ADAB, I_N1G, I_N2G, I_WIN, I_POOLW, I_POOLS, I_CPEK, I_CW1K, I_CW2K, I_CPEV, I_CW1V, I_CW2V, I_QNG, I_KNG, I_WBP, I_WBA, I_WOUT, I_PWQ, I_PSK, I_PU, I_PV, N_IN };

constexpr size_t MiB = 1u << 20, KiB = 1u << 10;
constexpr size_t WS_CTL = 0, CTL_ZERO_BYTES = 128 * KiB;
constexpr size_t WS_ADA = 1 * MiB;
constexpr size_t WS_CB1K = 64 * KiB;
constexpr size_t WS_CB1V = WS_CB1K + 1 * KiB;
constexpr size_t WS_ATAB = WS_ADA + 320 * KiB;
constexpr size_t AT_TABG = 512 * 4 + 16 * 65 * 16 + 4 * 177 * 16;
constexpr size_t WS_BIASL = WS_ADA + 256 * KiB;
constexpr size_t WS_WIN_T = 2 * MiB;
constexpr size_t WS_WEFF_T = 10 * MiB;
constexpr size_t WS_WBA_T = 11 * MiB;
constexpr size_t WS_WOUT_T = 12 * MiB;
constexpr size_t WS_WQ_T = 14 * MiB;
constexpr size_t WS_SUBK = 18 * MiB;
constexpr size_t WS_CW1K_T = 18 * MiB + 512 * KiB;
constexpr size_t WS_CW1V_T = 19 * MiB;
constexpr size_t WS_CW2K_T = 19 * MiB + 512 * KiB;
constexpr size_t WS_CW2V_T = WS_CW2K_T + 64 * KiB;
constexpr size_t WS_KC = 20 * MiB;
constexpr size_t WS_VCT = 20 * MiB + 512 * KiB;
constexpr size_t WS_GATE = 21 * MiB;
constexpr size_t WS_UB = 24 * MiB;
constexpr size_t WS_VB = 56 * MiB;
constexpr size_t WS_SCLU = WS_UB + 16 * MiB, WS_SCLV = WS_SCLU + 64 * KiB;
constexpr size_t WS_H = 88 * MiB;
constexpr size_t WS_ZP = 152 * MiB;
constexpr size_t WS_Q = 184 * MiB;
constexpr size_t WS_KCR = 216 * MiB;
constexpr size_t WS_VCR = 225 * MiB;
constexpr size_t WS_KS = 234 * MiB, WS_VS = 242 * MiB, WS_KW = 250 * MiB, WS_VW = 258 * MiB;
constexpr size_t WS_VST = 266 * MiB, WS_VWT = 274 * MiB;
constexpr size_t WS_PL = 282 * MiB;
constexpr size_t WS_YA = 314 * MiB;
constexpr size_t WS_GM = 346 * MiB;
constexpr size_t WS_MIX = WS_ZP;
constexpr size_t WS_QV = WS_GM;
constexpr size_t WS_EID = WS_PL;
constexpr size_t WS_GW = WS_PL + 16 * MiB;
constexpr size_t WS_PART = WS_GM;
constexpr size_t WS_CF = WS_YA;
constexpr size_t WS_CFS = WS_YA + 8 * MiB;
constexpr size_t WS_H8 = WS_ZP;
constexpr size_t WS_HS = WS_ZP + 32 * MiB;
constexpr size_t WS_X1 = WS_KCR;
constexpr size_t WS_END = 474 * MiB;
constexpr int CW_TMO = 0, CW_CODE = 1, CW_BAR = 4096;

constexpr int RING_OFF = 0, RING_BYTES = 147456;
constexpr int LDSCTL_OFF = RING_BYTES, MISC_OFF = LDSCTL_OFF + 320;
constexpr int LDS_BYTES = 163840;

#define GAS __attribute__((address_space(1)))
#define LAS __attribute__((address_space(3)))
typedef unsigned short bf16;
typedef unsigned v4u __attribute__((ext_vector_type(4)));
typedef unsigned v2u __attribute__((ext_vector_type(2)));
typedef int v2i __attribute__((ext_vector_type(2)));
typedef float f32x4 __attribute__((ext_vector_type(4)));
typedef short bf16x8 __attribute__((ext_vector_type(8)));
typedef GAS unsigned gu32;
#define RLX_AGENT __ATOMIC_RELAXED, __HIP_MEMORY_SCOPE_AGENT
#define LDS_WAIT() asm volatile("s_waitcnt lgkmcnt(0)" ::: "memory")
#define VM_WAIT() asm volatile("s_waitcnt vmcnt(0)" ::: "memory")
__device__ __forceinline__ unsigned f2bf(float f) { unsigned u = __builtin_bit_cast(unsigned, f); return (u + 0x7fffu + ((u >> 16) & 1u)) >> 16; }
__device__ __forceinline__ unsigned pk2(float lo, float hi) { return f2bf(lo) | (f2bf(hi) << 16); }
__device__ __forceinline__ float bflo(unsigned w) { return __builtin_bit_cast(float, w << 16); }
__device__ __forceinline__ float bfhi(unsigned w) { return __builtin_bit_cast(float, w & 0xffff0000u); }
__device__ __forceinline__ float sigmoidf_(float v) { return __builtin_amdgcn_rcpf(1.0f + __builtin_amdgcn_exp2f(v * -1.4426950408889634f)); }
typedef __bf16 bf16x2_hw __attribute__((ext_vector_type(2)));
typedef float f32x2_hw __attribute__((ext_vector_type(2)));
__device__ __forceinline__ unsigned pkh(float lo, float hi) { return __builtin_bit_cast(unsigned, __builtin_convertvector((f32x2_hw){lo, hi}, bf16x2_hw)); }
__device__ __forceinline__ float gelu_tanh_safe(float v) { const float u = 0.7978845608028654f * (v + 0.044715f * v * v * v); return 0.5f * v * (1.0f + tanhf(u)); }
template <int CTRL> __device__ __forceinline__ float dppf(float v) { return __builtin_bit_cast(float, __builtin_amdgcn_update_dpp(0, __builtin_bit_cast(int, v), CTRL, 0xF, 0xF, true)); }
template <int CTRL> __device__ __forceinline__ int dppi(int v) { return __builtin_amdgcn_update_dpp(0, v, CTRL, 0xF, 0xF, true); }
#define DPP_XOR1 0xB1
#define DPP_XOR2 0x4E
#define DPP_HMIR 0x141
#define DPP_ROR8 0x128
__device__ __forceinline__ void swap16_(float& a, float& b) { asm volatile("v_nop\n\tv_nop\n\tv_permlane16_swap_b32 %0, %1" : "+v"(a), "+v"(b)); }
__device__ __forceinline__ void swap32_(float& a, float& b) { asm volatile("v_nop\n\tv_nop\n\tv_permlane32_swap_b32 %0, %1" : "+v"(a), "+v"(b)); }
__device__ __forceinline__ float sum_xor16(float v) { float a = v, b = v; swap16_(a, b); return a + b; }
__device__ __forceinline__ float sum_xor32(float v) { float a = v, b = v; swap32_(a, b); return a + b; }
__device__ __forceinline__ float max_xor16(float v) { float a = v, b = v; swap16_(a, b); return fmaxf(a, b); }
__device__ __forceinline__ float max_xor32(float v) { float a = v, b = v; swap32_(a, b); return fmaxf(a, b); }
__device__ __forceinline__ float wave_sum(float v) {
    v += dppf<DPP_XOR1>(v); v += dppf<DPP_XOR2>(v); v += dppf<DPP_HMIR>(v); v += dppf<DPP_ROR8>(v);
    return sum_xor32(sum_xor16(v));
}
__device__ __forceinline__ float wave_max(float v) {
    v = fmaxf(v, dppf<DPP_XOR1>(v)); v = fmaxf(v, dppf<DPP_XOR2>(v)); v = fmaxf(v, dppf<DPP_HMIR>(v)); v = fmaxf(v, dppf<DPP_ROR8>(v));
    return max_xor32(max_xor16(v));
}

#define XB_TMO      128
#define XB_XCNT(j)  (256  + 64 * (j))
#define XB_XSUB(j)  (1280 + 64 * (j))
#define XB_XGEN(j)  (2304 + 64 * (j))
#define XB_TOP      3328
#define XB_TOPGEN   3392
#define XCD_BAR_WORDS 3456
#define XB_SPIN_CAP (1u << 18)
__device__ __forceinline__ unsigned xb_ld(unsigned* p)              { return __hip_atomic_load(p, __ATOMIC_RELAXED, __HIP_MEMORY_SCOPE_AGENT); }
__device__ __forceinline__ unsigned xb_add(unsigned* p, unsigned v) { return __hip_atomic_fetch_add(p, v, __ATOMIC_RELAXED, __HIP_MEMORY_SCOPE_AGENT); }
__device__ __forceinline__ unsigned xb_xcc_id() { return (unsigned)__builtin_amdgcn_s_getreg((3 << 11) | 20) & 0xFu; }
#define XB_SPIN(cond, bar) do { unsigned _sp = 0; while (cond) { __builtin_amdgcn_s_sleep(1); \
    if ((++_sp & 255u) == 0u) { if (xb_ld(&(bar)[XB_TMO])) break; if (_sp > XB_SPIN_CAP) { atomicAdd(&(bar)[XB_TMO], 1u); break; } } } } while (0)
struct XcdBarrier { unsigned* bar; unsigned x; volatile LAS unsigned* st; };
__device__ __forceinline__ XcdBarrier xcd_barrier_post(unsigned* bar, volatile LAS unsigned* st) {
    XcdBarrier b; b.bar = bar; b.x = xb_xcc_id(); b.st = st;
    if (threadIdx.x == 0) (void)xb_add(&bar[XB_XCNT(b.x)], 1u);
    return b;
}
__device__ __forceinline__ void xcd_barrier_complete(unsigned* bar, unsigned x, unsigned& nloc, unsigned& nx) {
    const unsigned G = gridDim.x * gridDim.y * gridDim.z;
    unsigned sum, cnt, mine, sp = 0u;
    for (;;) {
        sum = 0u; cnt = 0u; mine = 0u;
#pragma unroll
        for (unsigned j = 0; j < 16; ++j) { const unsigned c = xb_ld(&bar[XB_XCNT(j)]); sum += c; cnt += (c > 0u) ? 1u : 0u; mine = (j == x) ? c : mine; }
        if (sum == G) break;
        __builtin_amdgcn_s_sleep(1);
        if ((++sp & 255u) == 0u) { if (xb_ld(&bar[XB_TMO])) break; if (sp > XB_SPIN_CAP) { atomicAdd(&bar[XB_TMO], 1u); break; } }
    }
    nloc = mine > 0u ? mine : 1u; nx = cnt > 0u ? cnt : 1u;
}
__device__ __forceinline__ void xcd_barrier(const XcdBarrier& b) {
    asm volatile("s_waitcnt vmcnt(0)" ::: "memory");
    __syncthreads();
    if (threadIdx.x == 0) {
        unsigned* bar = b.bar;
        __builtin_amdgcn_s_waitcnt(0);
        unsigned nloc = b.st[0], nx = b.st[1];
        if (nloc == 0u) { xcd_barrier_complete(bar, b.x, nloc, nx); b.st[0] = nloc; b.st[1] = nx; }
        const unsigned old = xb_add(&bar[XB_XSUB(b.x)], 1u);
        const unsigned gen = old / nloc;
        if (old + 1u == (gen + 1u) * nloc) {
            __builtin_amdgcn_fence(__ATOMIC_RELEASE, "agent");
            asm volatile("s_waitcnt vmcnt(0)" ::: "memory");
            const unsigned og = xb_add(&bar[XB_TOP], 1u);
            const unsigned tg = og / nx;
            if (og + 1u == (tg + 1u) * nx) xb_add(&bar[XB_TOPGEN], 1u);
            else XB_SPIN(xb_ld(&bar[XB_TOPGEN]) == tg, bar);
            __builtin_amdgcn_fence(__ATOMIC_ACQUIRE, "agent");
            xb_add(&bar[XB_XGEN(b.x)], 1u);
            asm volatile("s_waitcnt vmcnt(0)" ::: "memory");
        } else {
            XB_SPIN(xb_ld(&bar[XB_XGEN(b.x)]) == gen, bar);
            __builtin_amdgcn_fence(__ATOMIC_ACQUIRE, "agent");
            asm volatile("s_waitcnt vmcnt(0)" ::: "memory");
        }
    }
    __syncthreads();
}

struct Args { const float* in[N_IN]; float* out; unsigned char* ws; int ph_lo, ph_hi, li, pad; };
struct Frame {
    LAS unsigned char* lds;
    volatile LAS unsigned* MISC;
    gu32* ctl;
    int tid, lane, wave, G, bid;
    unsigned char* ws;
};

template <bool I8> __device__ __forceinline__ void cvt_row_store(const f32x4 (&v)[4], int row, unsigned char* dst, float* inv_scale, int lane) {
    float m = 0.f;
#pragma unroll
    for (int j = 0; j < 4; ++j) m = fmaxf(m, fmaxf(fmaxf(fabsf(v[j].x), fabsf(v[j].y)), fmaxf(fabsf(v[j].z), fabsf(v[j].w))));
    m = wave_max(m);
    unsigned ww[4]; float isc;
    if (I8) { const float sc = m > 0.f ? 127.0f / m : 0.f; isc = m * (1.0f / 127.0f);
#pragma unroll
        for (int j = 0; j < 4; ++j) { const int q0 = (int)rintf(v[j].x * sc), q1 = (int)rintf(v[j].y * sc), q2 = (int)rintf(v[j].z * sc), q3 = (int)rintf(v[j].w * sc);
            ww[j] = ((unsigned)q0 & 0xffu) | (((unsigned)q1 & 0xffu) << 8) | (((unsigned)q2 & 0xffu) << 16) | (((unsigned)q3 & 0xffu) << 24); } }
    else { const unsigned E = (__builtin_bit_cast(unsigned, m) >> 23) & 0xffu; float sc = 1.f; isc = 1.f;
        if (E >= 8u && E <= 250u) { sc = __builtin_bit_cast(float, (261u - E) << 23); isc = __builtin_bit_cast(float, (E - 7u) << 23); }
#pragma unroll
        for (int j = 0; j < 4; ++j) { int t = __builtin_amdgcn_cvt_pk_fp8_f32(v[j].x * sc, v[j].y * sc, 0, false); t = __builtin_amdgcn_cvt_pk_fp8_f32(v[j].z * sc, v[j].w * sc, t, true); ww[j] = (unsigned)t; } }
    *(GAS v4u*)(dst + (size_t)(lane >> 3) * NEXP * 128 + (size_t)row * 128 + 16 * (lane & 7)) = (v4u){ww[0], ww[1], ww[2], ww[3]};
    if (lane == 0) inv_scale[row] = isc;
}
template <bool I8> __device__ __forceinline__ void cvt_rows_8bit(const float* src, unsigned char* dst, float* inv_scale, int gw, int NGW, int lane) {
    for (int row = gw; row < NEXP; row += 2 * NGW) {
        const int row1 = row + NGW; const bool has1 = row1 < NEXP;
        f32x4 v0[4], v1[4];
#pragma unroll
        for (int j = 0; j < 4; ++j) v0[j] = *(const GAS f32x4*)(src + (size_t)row * D + 16 * lane + 4 * j);
#pragma unroll
        for (int j = 0; j < 4; ++j) v1[j] = has1 ? *(const GAS f32x4*)(src + (size_t)row1 * D + 16 * lane + 4 * j) : (f32x4){0.f, 0.f, 0.f, 0.f};
        cvt_row_store<I8>(v0, row, dst, inv_scale, lane);
        if (has1) cvt_row_store<I8>(v1, row1, dst, inv_scale, lane);
    }
}
__device__ __forceinline__ void p0_transpose_item(const float* W, int ldw, int src_col0, int valid, int K, bf16* WT, int dst_row0, int k0, LAS float* scr, int lane, int ldt = -1) {
    if (ldt < 0) ldt = K;
    const int n_ = lane & 31;
#pragma unroll 8
    for (int i = 0; i < 32; ++i) { const int kk = 2 * i + (lane >> 5); scr[kk * 33 + n_] = (n_ < valid) ? W[(size_t)(k0 + kk) * ldw + src_col0 + n_] : 0.f; }
    LDS_WAIT(); asm volatile("" ::: "memory");
    const int c = lane & 7;
#pragma unroll
    for (int j = 0; j < 4; ++j) { const int n = (lane >> 3) + 8 * j; const LAS float* s = scr + (8 * c) * 33 + n;
        v4u o; o.x = pk2(s[0 * 33], s[1 * 33]); o.y = pk2(s[2 * 33], s[3 * 33]); o.z = pk2(s[4 * 33], s[5 * 33]); o.w = pk2(s[6 * 33], s[7 * 33]);
        *(GAS v4u*)(WT + (size_t)(dst_row0 + n) * ldt + k0 + 8 * c) = o; }
    LDS_WAIT(); asm volatile("" ::: "memory");
}
__device__ __forceinline__ bool p0_mat(int& r, const float* W, int K, int N, bf16* WT, LAS float* scr, int lane, int ldt = -1) {
    const int ng = N / 32, items = ng * (K / 64);
    if (r < items) { const int kb = r / ng, nb = r % ng; p0_transpose_item(W, N, 32 * nb, 32, K, WT, 32 * nb, 64 * kb, scr, lane, ldt); return true; }
    r -= items; return false;
}
__device__ __forceinline__ void cvt_f32_bf16_stream(const float* src, bf16* dst, size_t n8, size_t gtid, size_t gthreads) {
    for (size_t i = gtid; i < n8; i += gthreads) {
        const f32x4 a = *(const GAS f32x4*)(src + 8 * i), b = *(const GAS f32x4*)(src + 8 * i + 4);
        v4u o; o.x = pk2(a.x, a.y); o.y = pk2(a.z, a.w); o.z = pk2(b.x, b.y); o.w = pk2(b.z, b.w);
        *(GAS v4u*)(dst + 8 * i) = o; }
}

__device__ __forceinline__ void p0_prologue(Frame& F, const Args& args, bool do_bias = true) {
    unsigned char* ws = F.ws;
    const int gw = F.bid * NWAVES + F.wave, NGW = F.G * NWAVES;
    const size_t gtid = (size_t)F.bid * NTHREADS + F.tid, gthreads = (size_t)F.G * NTHREADS;
    {
        LAS float* sl = (LAS float*)(F.lds);
        LAS float* red = (LAS float*)(F.lds + 32768);
        const float* c = args.in[I_C];
        { f32x4 cv[4];
#pragma unroll
          for (int q = 0; q < 4; ++q) cv[q] = *(const GAS f32x4*)(c + 4 * (F.tid + NTHREADS * q));
#pragma unroll
          for (int q = 0; q < 4; ++q) { f32x4 o; o.x = cv[q].x / (1.0f + __expf(-cv[q].x)); o.y = cv[q].y / (1.0f + __expf(-cv[q].y)); o.z = cv[q].z / (1.0f + __expf(-cv[q].z)); o.w = cv[q].w / (1.0f + __expf(-cv[q].w));
              *(LAS f32x4*)(sl + 4 * (F.tid + NTHREADS * q)) = o; } }
        __syncthreads();
        for (int cb = F.bid; cb < 6 * D / 24; cb += F.G) {
            const int j0 = cb * 24;
            if (F.tid < 510) {
                const int kk = F.tid / 6, c4 = F.tid % 6;
                const float* w = args.in[I_ADAW] + j0 + 4 * c4;
                f32x4 wv[13];
#pragma unroll
                for (int m = 0; m < 13; ++m) { const int k = kk + 85 * m; wv[m] = (k < D) ? *(const GAS f32x4*)(w + (size_t)k * (6 * D)) : (f32x4){0.f, 0.f, 0.f, 0.f}; }
                f32x4 a[BATCH];
#pragma unroll
                for (int b = 0; b < BATCH; ++b) a[b] = (f32x4){0.f, 0.f, 0.f, 0.f};
#pragma unroll
                for (int m = 0; m < 13; ++m) { const int k = kk + 85 * m; const int kc = k < D ? k : 0;
#pragma unroll
                    for (int b = 0; b < BATCH; ++b) a[b] = a[b] + wv[m] * sl[b * D + kc]; }
#pragma unroll
                for (int b = 0; b < BATCH; ++b) { LAS float* rp = red + (kk * 24 + 4 * c4) * BATCH + b; rp[0] = a[b].x; rp[BATCH] = a[b].y; rp[2 * BATCH] = a[b].z; rp[3 * BATCH] = a[b].w; }
            }
            __syncthreads();
            if (F.tid < 24 * BATCH) { const int jj = F.tid / BATCH, b = F.tid % BATCH; float s = 0.f;
#pragma unroll 5
                for (int kk = 0; kk < 85; ++kk) s += red[(kk * 24 + jj) * BATCH + b];
                ((float*)(ws + WS_ADA))[b * (6 * D) + j0 + jj] = s + args.in[I_ADAB][j0 + jj]; }
            __syncthreads();
        }
    }
    if (F.bid >= 8 && F.bid < 40 && do_bias) {
        const int bb = F.bid - 8, kv = bb & 1, ch = bb >> 1;
        const float* pe = args.in[kv == 0 ? I_CPEK : I_CPEV]; const float* w1 = args.in[kv == 0 ? I_CW1K : I_CW1V];
        LAS float* red = (LAS float*)(F.lds);
        const int j = F.tid & 127, ic = F.tid >> 7; float s = 0.f;
        const int i0 = ch * 128 + ic * 32;
#pragma unroll 8
        for (int i = i0; i < i0 + 32; ++i) s += pe[i] * w1[(size_t)i * 128 + j];
        red[ic * 128 + j] = s; __syncthreads();
        if (F.tid < 128) atomicAdd((float*)(ws + (kv == 0 ? WS_CB1K : WS_CB1V)) + F.tid, (red[F.tid] + red[128 + F.tid]) + (red[256 + F.tid] + red[384 + F.tid]));
        __syncthreads();
    } else if (F.bid == 2) {
        auto t5bias = [&](int h, int rel) -> float {
            int bk = rel;
            if (rel >= 16) bk = 16 + (rel >= 19) + (rel >= 21) + (rel >= 24) + (rel >= 27) + (rel >= 31) + (rel >= 35) + (rel >= 40) + (rel >= 46) + (rel >= 52) + (rel >= 59) + (rel >= 67) + (rel >= 77) + (rel >= 87) + (rel >= 99) + (rel >= 113);
            return args.in[I_RELB][bk * 8 + h]; };
        for (int i = F.tid; i < 8 * 128; i += NTHREADS) ((float*)(ws + WS_BIASL))[i] = t5bias(i >> 7, i & 127);
        LAS float* m0s = (LAS float*)(F.lds);
        if (F.tid < 64) {
            float mq = fabsf(args.in[I_QNG][F.tid]), mk = fmaxf(fmaxf(fabsf(args.in[I_KNG][F.tid]), fabsf(args.in[I_KNG][64 + F.tid])), fabsf(args.in[I_KNG][128 + F.tid]));
            float mb = fmaxf(fmaxf(fabsf(args.in[I_RELB][F.tid]), fabsf(args.in[I_RELB][64 + F.tid])), fmaxf(fabsf(args.in[I_RELB][128 + F.tid]), fabsf(args.in[I_RELB][192 + F.tid])));
            mq = wave_max(mq); mk = wave_max(mk); mb = wave_max(mb);
            if (F.tid == 0) { ((float*)(ws + WS_BIASL))[8 * 128] = 8.0f * mq * mk + mb; m0s[0] = 8.0f * mq * mk + mb; } }
        __syncthreads();
        { const float M0 = m0s[0];
          constexpr int NE = 512 + 16 * 65 * 4 + 4 * 177 * 4;
          for (int i = F.tid; i < 2 * NE; i += NTHREADS) { const int g = i / NE, e = i % NE; float v;
              if (e < 512) v = (t5bias(4 * g + (e >> 7), e & 127) - M0) * 1.4426950408889634f;
              else if (e >= 512 + 16 * 65 * 4) { const int q = e - (512 + 16 * 65 * 4), r = q & 3, zi = (q >> 2) % 177, hd = q / (4 * 177), rel = zi - 1 - 16 * r;
                  v = rel < 0 ? -1.0e30f : (t5bias(4 * g + hd, rel > 127 ? 127 : rel) - M0) * 1.4426950408889634f; }
              else { const int q = e - 512, row = q / 260, yq = q % 260, yi = yq >> 2, r = yq & 3, rel = 4 * (47 - yi) + (row >> 2) - r;
                  v = (yi >= 63) ? 0.f : (rel < 0 ? -1.0e30f : (t5bias(4 * g + (row & 3), rel > 127 ? 127 : rel) - M0) * 1.4426950408889634f); }
              ((float*)(ws + WS_ATAB + (size_t)g * AT_TABG))[e] = v; } }
        __syncthreads();
    }
}
template <int SEG> __device__ __forceinline__ void p0_stream_seg(Frame& F, const Args& args) {
    unsigned char* ws = F.ws;
    const int gw = F.bid * NWAVES + F.wave, NGW = F.G * NWAVES;
    if (SEG == 0) {
        {
            LAS float* scr = (LAS float*)(F.lds + F.wave * 16384);
            constexpr int I_WINT = (NIN / 32) * (D / 64);
            constexpr int NITEMS = I_WINT + (1024 / 32) * (512 / 64) + (1024 / 32) * (1024 / 64) + 2 * (128 / 32) * (2048 / 64) + 2 * (64 / 32) * (128 / 64);
            for (int it = gw; it < NITEMS; it += NGW) {
                int r = it;
                if (r < I_WINT) {
                    const int grp = r % (NIN / 32), kb = r / (NIN / 32);
                    const int tile = grp >> 3, ct0 = (grp & 7) * 32;
                    const int L0 = 64 * ((ct0 >> 5) & 3) + 32 * (ct0 >> 7);
                    int src0, valid = 32;
                    if (tile < 7) src0 = 256 * tile + L0; else if (tile < 15) src0 = 1816 + 256 * (tile - 7) + L0; else { src0 = 1792 + L0; valid = (L0 == 0) ? 24 : 0; }
                    if (valid == 0) src0 = 0;
                    p0_transpose_item(args.in[I_WIN], IN_COLS, src0, valid, D, (bf16*)(ws + WS_WIN_T), 32 * grp, 64 * kb, scr, F.lane);
                    continue; }
                r -= I_WINT;
                if (p0_mat(r, args.in[I_WBA], 512, 1024, (bf16*)(ws + WS_WEFF_T) + 512, scr, F.lane, 1024)) continue;
                if (p0_mat(r, args.in[I_WOUT], 1024, 1024, (bf16*)(ws + WS_WOUT_T), scr, F.lane)) continue;
                if (p0_mat(r, args.in[I_CW1K], 2048, 128, (bf16*)(ws + WS_CW1K_T), scr, F.lane)) continue;
                if (p0_mat(r, args.in[I_CW1V], 2048, 128, (bf16*)(ws + WS_CW1V_T), scr, F.lane)) continue;
                if (p0_mat(r, args.in[I_CW2K], 128, 64, (bf16*)(ws + WS_CW2K_T), scr, F.lane)) continue;
                p0_mat(r, args.in[I_CW2V], 128, 64, (bf16*)(ws + WS_CW2V_T), scr, F.lane);
            }
        }
    }
    if (SEG == 0) {
        {
            const float* wq = args.in[I_PWQ]; const float* sk = args.in[I_PSK]; bf16* wf = (bf16*)(ws + WS_WQ_T);
            const int l15 = F.lane & 15, lq = F.lane >> 4;
            for (int bb = F.bid; bb < 256; bb += F.G) {
                const int hp = bb >> 4, kg = bb & 15;
                bf16x8 bfr[4];
    #pragma unroll
                for (int ks = 0; ks < 4; ++ks) { const float* sp = sk + ((size_t)hp * 128 + 16 * F.wave + l15) * 128 + 32 * ks + 8 * lq;
                    const f32x4 s0 = *(const GAS f32x4*)sp, s1 = *(const GAS f32x4*)(sp + 4);
                    bfr[ks] = __builtin_bit_cast(bf16x8, (v4u){pkh(s0.x, s0.y), pkh(s0.z, s0.w), pkh(s1.x, s1.y), pkh(s1.z, s1.w)}); }
    #pragma unroll
                for (int cb = 0; cb < 4; ++cb) {
                    pg8::f32x4 acc = (pg8::f32x4){0.f, 0.f, 0.f, 0.f};
    #pragma unroll
                    for (int ks = 0; ks < 4; ++ks) { const float* ap = wq + (size_t)(64 * kg + 16 * cb + l15) * PQW + hp * 128 + 32 * ks + 8 * lq;
                        const f32x4 a0 = *(const GAS f32x4*)ap, a1 = *(const GAS f32x4*)(ap + 4);
                        const bf16x8 af = __builtin_bit_cast(bf16x8, (v4u){pkh(a0.x, a0.y), pkh(a0.z, a0.w), pkh(a1.x, a1.y), pkh(a1.z, a1.w)});
                        acc = __builtin_amdgcn_mfma_f32_16x16x32_bf16(af, bfr[ks], acc, 0, 0, 0); }
                    v2u o; o.x = pkh(acc[0], acc[1]); o.y = pkh(acc[2], acc[3]);
                    *(GAS v2u*)(wf + (size_t)(hp * 128 + 16 * F.wave + l15) * D + 64 * kg + 16 * cb + 4 * lq) = o; }
            }
        }
    }
    if (SEG == 0) {
        const float* pw = args.in[I_POOLW]; const float* ps = args.in[I_POOLS]; const float* wbp = args.in[I_WBP];
        bf16* weff = (bf16*)(ws + WS_WEFF_T);
        const int l15 = F.lane & 15, lq = F.lane >> 4;
        for (int bb = F.bid; bb < 256; bb += F.G) {
            const int g = bb >> 6, d0 = (bb & 63) * 16;
            bf16x8 bfr[4];
#pragma unroll
            for (int ks = 0; ks < 4; ++ks) { const int c0 = g * 128 + 32 * ks + 8 * lq;
                const f32x4 p0 = *(const GAS f32x4*)(ps + c0), p1 = *(const GAS f32x4*)(ps + c0 + 4);
                float wv[8];
#pragma unroll
                for (int i = 0; i < 8; ++i) wv[i] = wbp[(size_t)(c0 + i) * D + d0 + l15];
                bfr[ks] = __builtin_bit_cast(bf16x8, (v4u){pkh(wv[0] * p0.x, wv[1] * p0.y), pkh(wv[2] * p0.z, wv[3] * p0.w), pkh(wv[4] * p1.x, wv[5] * p1.y), pkh(wv[6] * p1.z, wv[7] * p1.w)}); }
            { const int cb = F.wave;
                pg8::f32x4 acc = (pg8::f32x4){0.f, 0.f, 0.f, 0.f};
#pragma unroll
                for (int ks = 0; ks < 4; ++ks) { const float* ap = pw + (size_t)g * 16384 + (size_t)(16 * cb + l15) * 128 + 32 * ks + 8 * lq;
                    const f32x4 a0 = *(const GAS f32x4*)ap, a1 = *(const GAS f32x4*)(ap + 4);
                    const bf16x8 af = __builtin_bit_cast(bf16x8, (v4u){pkh(a0.x, a0.y), pkh(a0.z, a0.w), pkh(a1.x, a1.y), pkh(a1.z, a1.w)});
                    acc = __builtin_amdgcn_mfma_f32_16x16x32_bf16(af, bfr[ks], acc, 0, 0, 0); }
                v2u o; o.x = pkh(acc[0], acc[1]); o.y = pkh(acc[2], acc[3]);
                *(GAS v2u*)(weff + (size_t)(d0 + l15) * 1024 + g * 128 + 16 * cb + 4 * lq) = o; }
        }
    }
    if (SEG == 1) cvt_rows_8bit<true>(args.in[I_PU], ws + WS_UB, (float*)(ws + WS_SCLU), gw, NGW, F.lane);
    if (SEG == 2) cvt_rows_8bit<false>(args.in[I_PV], ws + WS_VB, (float*)(ws + WS_SCLV), gw, NGW, F.lane);
}

template <bool Q8> __device__ __forceinline__ void modnorm_rows(Frame& F, const void* xin, const float* g, const float* ada, int shift_idx, bf16* out) {
    const int gw = F.bid * NWAVES + F.wave, NGW = F.G * NWAVES;
    const int b = gw & (BATCH - 1), rw = gw >> 3, nrw = (NGW + BATCH - 1) >> 3;
    f32x4 gg[4], ss[4], cc[4];
#pragma unroll
    for (int j = 0; j < 4; ++j) { gg[j] = ((const GAS f32x4*)g)[F.lane + 64 * j]; ss[j] = ((const GAS f32x4*)(ada + (size_t)b * 6 * D + shift_idx * D))[F.lane + 64 * j];
        const f32x4 c1 = ((const GAS f32x4*)(ada + (size_t)b * 6 * D + (shift_idx + 1) * D))[F.lane + 64 * j]; cc[j] = gg[j] * (c1 + 1.0f); }
    typedef typename std::conditional<Q8, v2u, f32x4>::type XT;
#define MN_LOAD(dst_, r_) do { const int rr_ = (r_) < SEQ ? (r_) : rw; const size_t m_ = (size_t)b * SEQ + rr_; \
        _Pragma("unroll") for (int j = 0; j < 4; ++j) dst_[j] = ((const GAS XT*)((const typename std::conditional<Q8, bf16, float>::type*)xin + m_ * D))[F.lane + 64 * j]; } while (0)
#define MN_ROW(xr_, r_) do { const int m = b * SEQ + (r_); \
        f32x4 v[4]; float s = 0.f; \
        _Pragma("unroll") for (int j = 0; j < 4; ++j) { \
            if constexpr (Q8) { const v2u xb = __builtin_bit_cast(v2u, xr_[j]); v[j] = (f32x4){bflo(xb.x), bfhi(xb.x), bflo(xb.y), bfhi(xb.y)}; } \
            else v[j] = __builtin_bit_cast(f32x4, xr_[j]); \
            s += (v[j].x * v[j].x + v[j].y * v[j].y) + (v[j].z * v[j].z + v[j].w * v[j].w); } \
        const float rstd = rsqrtf(wave_sum(s) * (1.f / D) + EPS); \
        GAS v2u* o8 = (GAS v2u*)(out + (size_t)m * D) + F.lane; \
        float mx = 0.f; \
        _Pragma("unroll") for (int j = 0; j < 4; ++j) { const f32x4 y = (v[j] * rstd) * cc[j] + ss[j]; v[j] = y; \
            mx = fmaxf(mx, fmaxf(fmaxf(fabsf(y.x), fabsf(y.y)), fmaxf(fabsf(y.z), fabsf(y.w)))); \
            v2u o; o.x = pk2(y.x, y.y); o.y = pk2(y.z, y.w); o8[64 * j] = o; } \
        if constexpr (Q8) {     \
            mx = wave_max(mx); \
            const float qs = mx > 0.f ? 127.0f / mx : 0.f; \
            GAS unsigned* h8 = (GAS unsigned*)(F.ws + WS_H8 + (size_t)m * D) + F.lane; \
            _Pragma("unroll") for (int j = 0; j < 4; ++j) { const int q0 = (int)rintf(v[j].x * qs), q1 = (int)rintf(v[j].y * qs), q2 = (int)rintf(v[j].z * qs), q3 = (int)rintf(v[j].w * qs); \
                h8[64 * j] = ((unsigned)q0 & 0xffu) | (((unsigned)q1 & 0xffu) << 8) | (((unsigned)q2 & 0xffu) << 16) | (((unsigned)q3 & 0xffu) << 24); } \
            if (F.lane == 0) ((float*)(F.ws + WS_HS))[m] = mx * (1.0f / 127.0f); } } while (0)
    XT xa[4], xb2[4];
    if (rw < SEQ) MN_LOAD(xa, rw);
    for (int r = rw; r < SEQ; r += 2 * nrw) {
        MN_LOAD(xb2, r + nrw);
        MN_ROW(xa, r);
        MN_LOAD(xa, r + 2 * nrw);
        if (r + nrw < SEQ) MN_ROW(xb2, r + nrw);
    }
#undef MN_LOAD
#undef MN_ROW
}

struct EpiIn {
    static constexpr bool PERM = true, AFTER_DRAIN = false, MID = false;
    unsigned char* ws; const float* qg; const float* kg; const volatile LAS unsigned* rmp;
    __device__ __forceinline__ void operator()(const pg8::f32x4 (&acc)[2][2][4][2], const pg8::Unit& u, int wr, int wc, int fr, int fq) const {
        const int pn = u.pn, rmask = __builtin_amdgcn_readfirstlane((int)*rmp);
#pragma unroll
        for (int ai = 0; ai < 2; ++ai)
#pragma unroll
            for (int m = 0; m < 4; ++m) {
                const int row = (u.pm & rmask) * 256 + ai * 128 + wr * 64 + m * 16 + fr;
                float v[2][8];
#pragma unroll
                for (int bj = 0; bj < 2; ++bj)
#pragma unroll
                    for (int n = 0; n < 2; ++n)
#pragma unroll
                        for (int i = 0; i < 4; ++i) v[bj][4 * n + i] = acc[ai][bj][m][n][i];
                bf16* dst = nullptr; bool norm = false; const float* gain = nullptr; float mul = 1.f; bool sig = false;
                if (pn < 2) { dst = (bf16*)(ws + WS_ZP) + (size_t)row * 512 + 256 * pn + 64 * wc; }
                else if (pn < 4) { dst = (bf16*)(ws + WS_Q) + (size_t)row * 512 + 256 * (pn - 2) + 64 * wc; norm = true; gain = qg; mul = 0.125f * 1.4426950408889634f; }
                else if (pn < 7) { const int kind = pn - 4, isv = wc >> 1, g = wc & 1, b = row >> 12, t = row & 4095;
                    const size_t base = ((size_t)(b * 2 + g) * SEQ + t) * 64;
                    const size_t off = kind == 0 ? (isv ? WS_VCR : WS_KCR) : kind == 1 ? (isv ? WS_VS : WS_KS) : (isv ? WS_VW : WS_KW);
                    dst = (bf16*)(ws + off) + base; if (!isv && kind > 0) { norm = true; gain = kg + kind * 64; } }
                else if (pn < 15) { dst = (bf16*)(ws + WS_GM) + (size_t)row * 2048 + 256 * (pn - 7) + 64 * wc; sig = true; }
                else {
                    if (wc == 0 && fq < 3) { float* gp = (float*)(ws + WS_GATE) + (size_t)row * 24 + 8 * fq;
                        *(GAS f32x4*)gp = (f32x4){sigmoidf_(v[0][0]), sigmoidf_(v[0][1]), sigmoidf_(v[0][2]), sigmoidf_(v[0][3])};
                        *(GAS f32x4*)(gp + 4) = (f32x4){sigmoidf_(v[0][4]), sigmoidf_(v[0][5]), sigmoidf_(v[0][6]), sigmoidf_(v[0][7])}; }
                    continue; }
                if (norm) { float ss = 0.f;
#pragma unroll
                    for (int bj = 0; bj < 2; ++bj)
#pragma unroll
                        for (int e = 0; e < 8; ++e) ss += v[bj][e] * v[bj][e];
                    ss = sum_xor32(sum_xor16(ss));
                    const float rs = rsqrtf(ss * (1.f / 64.f) + EPS) * mul;
#pragma unroll
                    for (int bj = 0; bj < 2; ++bj)
#pragma unroll
                        for (int e = 0; e < 8; ++e) v[bj][e] = v[bj][e] * rs * gain[32 * bj + 8 * fq + e]; }
                if (sig) {
#pragma unroll
                    for (int bj = 0; bj < 2; ++bj)
#pragma unroll
                        for (int e = 0; e < 8; ++e) v[bj][e] = sigmoidf_(v[bj][e]); }
#pragma unroll
                for (int bj = 0; bj < 2; ++bj) { v4u o; o.x = pkh(v[bj][0], v[bj][1]); o.y = pkh(v[bj][2], v[bj][3]); o.z = pkh(v[bj][4], v[bj][5]); o.w = pkh(v[bj][6], v[bj][7]);
                    *(GAS v4u*)(dst + 32 * bj + 8 * fq) = o; }
            }
    }
};
template <bool ADD> struct EpiMix {
    static constexpr bool PERM = true, AFTER_DRAIN = false, MID = false;
    bf16* MIX; const bf16* GM; int gmoff;
    __device__ __forceinline__ void operator()(const pg8::f32x4 (&acc)[2][2][4][2], const pg8::Unit& u, int wr, int wc, int fr, int fq) const {
#pragma unroll
        for (int ai = 0; ai < 2; ++ai)
#pragma unroll
            for (int m = 0; m < 4; ++m) {
                const int row = u.pm * 256 + ai * 128 + wr * 64 + m * 16 + fr;
#pragma unroll
                for (int bj = 0; bj < 2; ++bj) {
                    const int col = u.pn * 256 + bj * 128 + wc * 32 + 8 * fq;
                    const v4u gmv = *(const GAS v4u*)(GM + (size_t)row * 2048 + gmoff + col);
                    float r[8];
                    r[0] = acc[ai][bj][m][0][0] * bflo(gmv.x); r[1] = acc[ai][bj][m][0][1] * bfhi(gmv.x); r[2] = acc[ai][bj][m][0][2] * bflo(gmv.y); r[3] = acc[ai][bj][m][0][3] * bfhi(gmv.y);
                    r[4] = acc[ai][bj][m][1][0] * bflo(gmv.z); r[5] = acc[ai][bj][m][1][1] * bfhi(gmv.z); r[6] = acc[ai][bj][m][1][2] * bflo(gmv.w); r[7] = acc[ai][bj][m][1][3] * bfhi(gmv.w);
                    GAS v4u* dp = (GAS v4u*)(MIX + (size_t)row * 1024 + col);
                    if (ADD) { const v4u old = *dp; r[0] += bflo(old.x); r[1] += bfhi(old.x); r[2] += bflo(old.y); r[3] += bfhi(old.y); r[4] += bflo(old.z); r[5] += bfhi(old.z); r[6] += bflo(old.w); r[7] += bfhi(old.w); }
                    v4u o; o.x = pkh(r[0], r[1]); o.y = pkh(r[2], r[3]); o.z = pkh(r[4], r[5]); o.w = pkh(r[6], r[7]); *dp = o; }
            }
    }
};
struct EpiMix2 {
    static constexpr bool PERM = true, AFTER_DRAIN = false, MID = true;
    bf16* MIX; const bf16* GM;
    __device__ __forceinline__ void mid(pg8::f32x4 (&acc)[2][2][4][2], const pg8::Unit& u, int wr, int wc, int fr, int fq) const {
#pragma unroll
        for (int ai = 0; ai < 2; ++ai)
#pragma unroll
            for (int m = 0; m < 4; ++m) {
                const int row = u.pm * 256 + ai * 128 + wr * 64 + m * 16 + fr;
#pragma unroll
                for (int bj = 0; bj < 2; ++bj) {
                    const int col = u.pn * 256 + bj * 128 + wc * 32 + 8 * fq;
                    const v4u g1 = *(const GAS v4u*)(GM + (size_t)row * 2048 + col), g2 = *(const GAS v4u*)(GM + (size_t)row * 2048 + 1024 + col);
                    const unsigned w1[4] = {g1.x, g1.y, g1.z, g1.w}, w2[4] = {g2.x, g2.y, g2.z, g2.w};
#pragma unroll
                    for (int n = 0; n < 2; ++n)
#pragma unroll
                        for (int i = 0; i < 4; ++i) { const unsigned a = w1[2 * n + (i >> 1)], b = w2[2 * n + (i >> 1)];
                            const float ga = (i & 1) ? bfhi(a) : bflo(a), gb = fmaxf((i & 1) ? bfhi(b) : bflo(b), 9.5367431640625e-07f);
                            acc[ai][bj][m][n][i] *= ga * __builtin_amdgcn_rcpf(gb); } }
            }
    }
    __device__ __forceinline__ void operator()(const pg8::f32x4 (&acc)[2][2][4][2], const pg8::Unit& u, int wr, int wc, int fr, int fq) const {
#pragma unroll
        for (int ai = 0; ai < 2; ++ai)
#pragma unroll
            for (int m = 0; m < 4; ++m) {
                const int row = u.pm * 256 + ai * 128 + wr * 64 + m * 16 + fr;
#pragma unroll
                for (int bj = 0; bj < 2; ++bj) {
                    const int col = u.pn * 256 + bj * 128 + wc * 32 + 8 * fq;
                    const v4u g2 = *(const GAS v4u*)(GM + (size_t)row * 2048 + 1024 + col);
                    const unsigned w2[4] = {g2.x, g2.y, g2.z, g2.w};
                    float r[8];
#pragma unroll
                    for (int n = 0; n < 2; ++n)
#pragma unroll
                        for (int i = 0; i < 4; ++i) { const unsigned b = w2[2 * n + (i >> 1)];
                            r[4 * n + i] = acc[ai][bj][m][n][i] * fmaxf((i & 1) ? bfhi(b) : bflo(b), 9.5367431640625e-07f); }
                    v4u o; o.x = pkh(r[0], r[1]); o.y = pkh(r[2], r[3]); o.z = pkh(r[4], r[5]); o.w = pkh(r[6], r[7]);
                    *(GAS v4u*)(MIX + (size_t)row * 1024 + col) = o; }
            }
    }
};
struct EpiRes {
    static constexpr bool PERM = true, AFTER_DRAIN = false, MID = false;
    const float* x; bf16* x1; const float* ada; int gate_idx;
    __device__ __forceinline__ void operator()(const pg8::f32x4 (&acc)[2][2][4][2], const pg8::Unit& u, int wr, int wc, int fr, int fq) const {
#pragma unroll
        for (int ai = 0; ai < 2; ++ai)
#pragma unroll
            for (int m = 0; m < 4; ++m) {
                const int row = u.pm * 256 + ai * 128 + wr * 64 + m * 16 + fr, b = row >> 12;
#pragma unroll
                for (int bj = 0; bj < 2; ++bj) {
                    const int col = u.pn * 256 + bj * 128 + wc * 32 + 8 * fq;
                    const float* gp = ada + (size_t)b * 6 * D + gate_idx * D + col; const float* xp = x + (size_t)row * D + col;
                    const f32x4 g0 = *(const GAS f32x4*)gp, g1 = *(const GAS f32x4*)(gp + 4), x0 = *(const GAS f32x4*)xp, x1v = *(const GAS f32x4*)(xp + 4);
                    const f32x4 r0 = x0 + g0 * acc[ai][bj][m][0], r1 = x1v + g1 * acc[ai][bj][m][1];
                    v4u o; o.x = pkh(r0.x, r0.y); o.y = pkh(r0.z, r0.w); o.z = pkh(r1.x, r1.y); o.w = pkh(r1.z, r1.w);
                    *(GAS v4u*)(x1 + (size_t)row * D + col) = o; }
            }
    }
};

template <int W> __device__ __forceinline__ void pool_load(const bf16* zp, int row, int t, int col, v4u (&z)[W]) {
#pragma unroll
    for (int j = 0; j < W; ++j) z[j] = (j <= t) ? *(const GAS v4u*)(zp + (size_t)(row - j) * 512 + col) : (v4u){0u, 0u, 0u, 0u};
}
template <int W> __device__ __forceinline__ v4u pool_reduce(const v4u (&z)[W], int t) {
    float s[8], self[8];
#pragma unroll
    for (int e = 0; e < 8; ++e) { s[e] = 0.f; self[e] = 0.f; }
#pragma unroll
    for (int j = 0; j < W; ++j) { const float f[8] = {bflo(z[j].x), bfhi(z[j].x), bflo(z[j].y), bfhi(z[j].y), bflo(z[j].z), bfhi(z[j].z), bflo(z[j].w), bfhi(z[j].w)};
#pragma unroll
        for (int e = 0; e < 8; ++e) { s[e] += f[e]; if (j == 0) self[e] = f[e]; } }
    const float inv = 1.0f / (float)((t + 1 < W) ? (t + 1) : W);
    v4u o; o.x = pk2(s[0] * inv - self[0], s[1] * inv - self[1]); o.y = pk2(s[2] * inv - self[2], s[3] * inv - self[3]);
    o.z = pk2(s[4] * inv - self[4], s[5] * inv - self[5]); o.w = pk2(s[6] * inv - self[6], s[7] * inv - self[7]);
    return o;
}
__device__ __forceinline__ void pool_phase(Frame& F) {
    const bf16* zp = (const bf16*)(F.ws + WS_ZP); bf16* pl = (bf16*)(F.ws + WS_PL);
    const int gw = F.bid * NWAVES + F.wave, NGW = F.G * NWAVES;
    v4u z2[2], z4[4], z8[8], z16[16];
    const int c0 = 8 * (F.lane & 15);
    if (gw < M / 4) { const int row = 4 * gw + (F.lane >> 4), t = row & 4095;
        pool_load<2>(zp, row, t, c0, z2); pool_load<4>(zp, row, t, 128 + c0, z4); pool_load<8>(zp, row, t, 256 + c0, z8); }
    for (int r4 = gw; r4 < M / 4; r4 += NGW) {
        const int row = 4 * r4 + (F.lane >> 4), t = row & 4095;
        pool_load<16>(zp, row, t, 384 + c0, z16);
        const v4u o2 = pool_reduce<2>(z2, t), o4 = pool_reduce<4>(z4, t), o8 = pool_reduce<8>(z8, t);
        if (r4 + NGW < M / 4) { const int rown = 4 * (r4 + NGW) + (F.lane >> 4), tn = rown & 4095;
            pool_load<2>(zp, rown, tn, c0, z2); pool_load<4>(zp, rown, tn, 128 + c0, z4); pool_load<8>(zp, rown, tn, 256 + c0, z8); }
        const v4u o16 = pool_reduce<16>(z16, t);
        GAS v4u* dst = (GAS v4u*)(pl + (size_t)row * 1024 + c0);
        dst[0] = o2; dst[16] = o4; dst[32] = o8; dst[48] = o16;
    }
}

typedef int v4i __attribute__((ext_vector_type(4)));
__device__ __forceinline__ unsigned pkf16(float a, float b) { return __builtin_bit_cast(unsigned, __builtin_amdgcn_cvt_pkrtz(a, b)); }
__device__ __forceinline__ float f16lo(unsigned w) { return (float)__builtin_bit_cast(_Float16, (unsigned short)(w & 0xffffu)); }
__device__ __forceinline__ float f16hi(unsigned w) { return (float)__builtin_bit_cast(_Float16, (unsigned short)(w >> 16)); }
struct EpiStoreBf16 {
    static constexpr bool PERM = true, AFTER_DRAIN = false, MID = false;
    bf16* O; int ldc;
    __device__ __forceinline__ void operator()(const pg8::f32x4 (&acc)[2][2][4][2], const pg8::Unit& u, int wr, int wc, int fr, int fq) const {
#pragma unroll
        for (int ai = 0; ai < 2; ++ai)
#pragma unroll
            for (int m = 0; m < 4; ++m) {
                const int row = u.pm * 256 + ai * 128 + wr * 64 + m * 16 + fr;
#pragma unroll
                for (int bj = 0; bj < 2; ++bj) {
                    const int col = u.pn * 256 + bj * 128 + wc * 32 + 8 * fq;
                    v4u o; o.x = pkf16(acc[ai][bj][m][0][0], acc[ai][bj][m][0][1]); o.y = pkf16(acc[ai][bj][m][0][2], acc[ai][bj][m][0][3]);
                    o.z = pkf16(acc[ai][bj][m][1][0], acc[ai][bj][m][1][1]); o.w = pkf16(acc[ai][bj][m][1][2], acc[ai][bj][m][1][3]);
                    *(GAS v4u*)(O + (size_t)row * ldc + col) = o; }
            }
    }
};

__device__ __forceinline__ unsigned fkey(float f) { const unsigned u = __builtin_bit_cast(unsigned, f); return (u >> 31) ? ~u : (u | 0x80000000u); }
__device__ __forceinline__ float funkey(unsigned k) { const unsigned u = (k >> 31) ? (k & 0x7fffffffu) : ~k; return __builtin_bit_cast(float, u); }
__device__ __forceinline__ unsigned umax_(unsigned a, unsigned b) { return a > b ? a : b; }
__device__ __forceinline__ unsigned umin_(unsigned a, unsigned b) { return a > b ? b : a; }
#define TOP16_INSERT(L, xin) do { unsigned _x = (xin); _Pragma("unroll") for (int _i = 0; _i < 16; ++_i) { const unsigned _h = umax_(L[_i], _x); _x = umin_(L[_i], _x); L[_i] = _h; } } while (0)
template <int MASK> __device__ __forceinline__ void top16_merge(unsigned (&L)[16]) {
    unsigned o[16];
#pragma unroll
    for (int i = 0; i < 16; ++i) o[i] = (unsigned)dppi<MASK == 1 ? DPP_XOR1 : DPP_XOR2>((int)L[i]);
#pragma unroll
    for (int i = 0; i < 16; ++i) L[i] = umax_(L[i], o[15 - i]);
#pragma unroll
    for (int d = 8; d >= 1; d >>= 1)
#pragma unroll
        for (int i = 0; i < 16; ++i) if ((i & d) == 0) { const unsigned hi = umax_(L[i], L[i + d]), lo = umin_(L[i], L[i + d]); L[i] = hi; L[i + d] = lo; }
}
#define CE_DESC(a_, b_) do { const unsigned _h = umax_(a_, b_), _l = umin_(a_, b_); a_ = _h; b_ = _l; } while (0)
template <int OFF> __device__ __forceinline__ void bitonic_sort16_desc(unsigned (&v)[32]) {
#pragma unroll
    for (int k = 2; k <= 16; k <<= 1)
#pragma unroll
        for (int j = k >> 1; j > 0; j >>= 1)
#pragma unroll
            for (int i = 0; i < 16; ++i) { const int l = i ^ j; if (l > i) { if ((i & k) == 0) CE_DESC(v[OFF + i], v[OFF + l]); else CE_DESC(v[OFF + l], v[OFF + i]); } }
}
__device__ __forceinline__ void bitonic_merge16_desc(unsigned (&L)[16]) {
#pragma unroll
    for (int d = 8; d >= 1; d >>= 1)
#pragma unroll
        for (int i = 0; i < 16; ++i) if ((i & d) == 0) CE_DESC(L[i], L[i + d]);
}
constexpr int SST = 132;
constexpr int P9_LIST_OFF = 2 * 64 * SST * 4;
__device__ __forceinline__ void peer_select_phase(Frame& F) {
    const unsigned short* S16 = (const unsigned short*)(F.ws + WS_QV);
    unsigned short* EID = (unsigned short*)(F.ws + WS_EID); float* GW = (float*)(F.ws + WS_GW);
    LAS unsigned* LIST = (LAS unsigned*)(F.lds + P9_LIST_OFF);
    const int lane = F.lane, w = F.wave;
    constexpr int NU = (M / 64) * PH;
    const int row = F.tid >> 2, sub = F.tid & 3, p1 = row >> 6, tk1 = row & 63;
    v4u sn[4], sm[4];
#define P9_LOAD(dst_, u_) do { const int _tt = (u_) >> 3, _h = (u_) & 7; const unsigned short* sp_ = S16 + (size_t)(_tt * 64 + tk1) * PQW + _h * 256 + p1 * 128 + 32 * sub; \
        _Pragma("unroll") for (int q = 0; q < 4; ++q) dst_[q] = *(const GAS v4u*)(sp_ + 8 * q); } while (0)
#define P9_STAGE1(sc_, list_, unext_) do { \
            unsigned kv[32]; \
            _Pragma("unroll") for (int q = 0; q < 4; ++q) { const unsigned ww[4] = {sc_[q].x, sc_[q].y, sc_[q].z, sc_[q].w}; \
                _Pragma("unroll") for (int e = 0; e < 4; ++e) { kv[8 * q + 2 * e] = (fkey(f16lo(ww[e])) & ~127u) | (unsigned)(32 * sub + 8 * q + 2 * e); \
                    kv[8 * q + 2 * e + 1] = (fkey(f16hi(ww[e])) & ~127u) | (unsigned)(32 * sub + 8 * q + 2 * e + 1); } } \
            if ((unext_) < NU) P9_LOAD(sc_, (unext_)); \
            bitonic_sort16_desc<0>(kv); bitonic_sort16_desc<16>(kv); \
            unsigned L[16]; \
            _Pragma("unroll") for (int i = 0; i < 16; ++i) L[i] = umax_(kv[i], kv[31 - i]); \
            bitonic_merge16_desc(L); \
            top16_merge<1>(L); top16_merge<2>(L); \
            if (sub == 0) { _Pragma("unroll") for (int i = 0; i < 4; ++i) *(LAS v4u*)((list_) + row * 16 + 4 * i) = (v4u){L[4 * i], L[4 * i + 1], L[4 * i + 2], L[4 * i + 3]}; } } while (0)
    if (F.bid < NU) P9_LOAD(sn, F.bid);
    if (F.bid + F.G < NU) P9_LOAD(sm, F.bid + F.G);
    for (int u = F.bid; u < NU; u += 2 * F.G) {
        const int u1 = u + F.G;
        P9_STAGE1(sn, LIST, u + 2 * F.G);
        if (u1 < NU) P9_STAGE1(sm, LIST + 2048, u1 + 2 * F.G);
        __syncthreads();
        const int half = F.tid >> 8, uu = half ? u1 : u;
        if (uu < NU) {
            const int tt = uu >> 3, h = uu & 7, tok0 = tt * 64;
            LAS unsigned* LIST = (LAS unsigned*)(F.lds + P9_LIST_OFF) + half * 2048;
            const int tok = (F.tid & 255) >> 2, sub = F.tid & 3;
            float va[16], vb[16];
#pragma unroll
            for (int i = 0; i < 4; ++i) { const v4u x = *(const LAS v4u*)(LIST + tok * 16 + 4 * i), y = *(const LAS v4u*)(LIST + (64 + tok) * 16 + 4 * i);
                va[4 * i] = funkey(x.x & ~127u); va[4 * i + 1] = funkey(x.y & ~127u); va[4 * i + 2] = funkey(x.z & ~127u); va[4 * i + 3] = funkey(x.w & ~127u);
                vb[4 * i] = funkey(y.x & ~127u); vb[4 * i + 1] = funkey(y.y & ~127u); vb[4 * i + 2] = funkey(y.z & ~127u); vb[4 * i + 3] = funkey(y.w & ~127u); }
            unsigned cand[32];
#pragma unroll
            for (int i = 0; i < 32; ++i) cand[i] = 0u;
            {
                constexpr int NC = 50;
                constexpr unsigned char CI[52] = {0,0,0,0,0,0,0,0,0,0,0,0,0,0,0,0, 1,1,1,1,1,1,1,1, 2,2,2,2,2, 3,3,3,3, 4,4,4, 5,5, 6,6, 7,7, 8,9,10,11,12,13,14,15, 0,0};
                constexpr unsigned char CJ[52] = {0,1,2,3,4,5,6,7,8,9,10,11,12,13,14,15, 0,1,2,3,4,5,6,7, 0,1,2,3,4, 0,1,2,3, 0,1,2, 0,1, 0,1, 0,1, 0,0,0,0,0,0,0,0, 0,0};
#pragma unroll
                for (int g4 = 0; g4 < 13; ++g4) {
                    float sa = 0.f, sb = 0.f; unsigned id = 0u; bool ok = false;
#pragma unroll
                    for (int q = 0; q < 4; ++q) { const int n = 4 * g4 + q; if (n < NC) { const bool me = (sub == q); sa = me ? va[CI[n]] : sa; sb = me ? vb[CJ[n]] : sb; id = me ? (unsigned)(CI[n] * 16 + CJ[n]) : id; ok = ok || me; } }
                    cand[g4] = ok ? ((fkey(sa + sb) & ~255u) | id) : 0u;
                }
            }
            bitonic_sort16_desc<0>(cand);
            unsigned L[16];
#pragma unroll
            for (int i = 0; i < 16; ++i) L[i] = cand[i];
            top16_merge<1>(L); top16_merge<2>(L);
            const float mx = funkey(L[0] & ~255u);
            float e[16], sum = 0.f;
#pragma unroll
            for (int k = 0; k < 16; ++k) { e[k] = __expf(funkey(L[k] & ~255u) - mx); sum += e[k]; }
            const float inv = 1.0f / sum;
            const size_t ob = (size_t)(tok0 + tok) * 128;
            unsigned myL[4]; float myE[4];
#pragma unroll
            for (int q = 0; q < 4; ++q) { myL[q] = L[q]; myE[q] = e[q];
#pragma unroll
                for (int k4 = 1; k4 < 4; ++k4) { const bool me = (sub == k4); myL[q] = me ? L[4 * k4 + q] : myL[q]; myE[q] = me ? e[4 * k4 + q] : myE[q]; } }
            unsigned idw[2] = {0u, 0u};
#pragma unroll
            for (int q = 0; q < 4; ++q) { const unsigned cid = myL[q] & 255u;
                const unsigned ia = LIST[tok * 16 + (cid >> 4)] & 127u, ib = LIST[(64 + tok) * 16 + (cid & 15u)] & 127u;
                idw[q >> 1] |= (ia * 128u + ib) << (16 * (q & 1)); }
            *(GAS pg8::f32x4*)(GW + ob + h * 16 + 4 * sub) = (pg8::f32x4){myE[0] * inv, myE[1] * inv, myE[2] * inv, myE[3] * inv};
            *(GAS v2u*)(EID + ob + h * 16 + 4 * sub) = (v2u){idw[0], idw[1]};
        }
        __syncthreads();
    }
#undef P9_LOAD
#undef P9_STAGE1
}

__device__ __forceinline__ void unpack8(const v4u w, float (&f)[8]) { f[0] = bflo(w.x); f[1] = bfhi(w.x); f[2] = bflo(w.y); f[3] = bfhi(w.y); f[4] = bflo(w.z); f[5] = bfhi(w.z); f[6] = bflo(w.w); f[7] = bfhi(w.w); }
typedef float f32x2 __attribute__((ext_vector_type(2)));
__device__ __forceinline__ void unpack16_fp8(const v4u w, float (&f)[16]) {
    const unsigned ww[4] = {w.x, w.y, w.z, w.w};
#pragma unroll
    for (int d = 0; d < 4; ++d) { const f32x2 a = __builtin_amdgcn_cvt_pk_f32_fp8((int)ww[d], false), b = __builtin_amdgcn_cvt_pk_f32_fp8((int)ww[d], true);
        f[4 * d] = a.x; f[4 * d + 1] = a.y; f[4 * d + 2] = b.x; f[4 * d + 3] = b.y; }
}
template <int PV_> __device__ __forceinline__ void peer_dot_phase(Frame& F) {
    const unsigned char* H8 = F.ws + WS_H8; const unsigned short* EID = (const unsigned short*)(F.ws + WS_EID); unsigned short* PART = (unsigned short*)(F.ws + WS_PART);
    const int lane = F.lane, g = lane >> 3, j = lane & 7, x = F.bid & 7;
    const int nbx = (F.G - x + 7) >> 3, NW = nbx * NWAVES, gwv = (F.bid >> 3) * NWAVES + F.wave;
    const unsigned char* US = F.ws + WS_UB + (size_t)x * NEXP * 128; const unsigned j16 = 16u * (unsigned)j;
    int token = gwv;
    if (token >= M) return;
    const int lasttok = gwv + ((M - 1 - gwv) / NW) * NW;
    unsigned eA, eB; v4i hA, hB;
    const int pg = g & 1;
#define PD_CL(t_) ((t_) < M ? (t_) : lasttok)
#define PD_LOAD_E(e_, tok_) do { e_ = *(const GAS unsigned*)(EID + (size_t)(tok_) * 128 + 16 * g + 2 * j); } while (0)
#define PD_BC(e_, k_) (pg ? (unsigned)dppi<0x158 + (k_)>((int)(e_)) : (unsigned)dppi<0x150 + (k_)>((int)(e_)))
#define PD_ISSUE4(buf_, w0_, w1_, b0_) do { buf_[b0_] = *(const GAS v4i*)(US + (((w0_) & 0xffffu) * 128u + j16)); buf_[b0_ + 1] = *(const GAS v4i*)(US + (((w0_) >> 16) * 128u + j16)); \
        buf_[b0_ + 2] = *(const GAS v4i*)(US + (((w1_) & 0xffffu) * 128u + j16)); buf_[b0_ + 3] = *(const GAS v4i*)(US + (((w1_) >> 16) * 128u + j16)); } while (0)
#define PD_DOT1(w_, hc_, dst_) do { int t = __builtin_amdgcn_sdot4(w_.x, hc_.x, 0, false); t = __builtin_amdgcn_sdot4(w_.y, hc_.y, t, false); t = __builtin_amdgcn_sdot4(w_.z, hc_.z, t, false); t = __builtin_amdgcn_sdot4(w_.w, hc_.w, t, false); \
        t += dppi<DPP_XOR1>(t); t += dppi<DPP_XOR2>(t); t += dppi<DPP_HMIR>(t); dst_ = (float)t; } while (0)
#define PD_BODY(eC, eN, hC, hN, tok_) do { const int tk_ = PD_CL(tok_); \
        { const unsigned w4_ = PD_BC(eC, 4), w5_ = PD_BC(eC, 5), w6_ = PD_BC(eC, 6), w7_ = PD_BC(eC, 7); PD_ISSUE4(bB, w4_, w5_, 0); PD_ISSUE4(bB, w6_, w7_, 4); } \
        PD_LOAD_E(eC, PD_CL(tk_ + 2 * NW)); \
        hN = *(const GAS v4i*)(H8 + (size_t)PD_CL(tk_ + NW) * D + 128 * x + j16); \
        float s[16]; \
        _Pragma("unroll") for (int i = 0; i < 8; ++i) PD_DOT1(bA[i], hC, s[i]); \
        { const unsigned w0_ = PD_BC(eN, 0), w1_ = PD_BC(eN, 1), w2_ = PD_BC(eN, 2), w3_ = PD_BC(eN, 3); PD_ISSUE4(bA, w0_, w1_, 0); PD_ISSUE4(bA, w2_, w3_, 4); } \
        _Pragma("unroll") for (int i = 0; i < 8; ++i) PD_DOT1(bB[i], hC, s[8 + i]); \
        { unsigned pk_[8];       \
          _Pragma("unroll") for (int i = 0; i < 8; ++i) pk_[i] = pkf16(s[2 * i] * 0.015625f, s[2 * i + 1] * 0.015625f); \
          const unsigned q0_ = (j & 1) ? pk_[1] : pk_[0], q1_ = (j & 1) ? pk_[3] : pk_[2], q2_ = (j & 1) ? pk_[5] : pk_[4], q3_ = (j & 1) ? pk_[7] : pk_[6]; \
          const unsigned h0_ = (j & 2) ? q1_ : q0_, h1_ = (j & 2) ? q3_ : q2_; \
          *(GAS unsigned*)(PART + ((size_t)x * M + tk_) * 128 + g * 16 + 2 * j) = (j & 4) ? h1_ : h0_; } } while (0)
    PD_LOAD_E(eA, token); hA = *(const GAS v4i*)(H8 + (size_t)token * D + 128 * x + j16);
    PD_LOAD_E(eB, PD_CL(token + NW));
    v4i bA[8], bB[8];
    { const unsigned w0_ = PD_BC(eA, 0), w1_ = PD_BC(eA, 1), w2_ = PD_BC(eA, 2), w3_ = PD_BC(eA, 3); PD_ISSUE4(bA, w0_, w1_, 0); PD_ISSUE4(bA, w2_, w3_, 4); }
    __builtin_amdgcn_s_waitcnt(0x0F70);
    for (; token < M; token += 2 * NW) {
        PD_BODY(eA, eB, hA, hB, token);
        PD_BODY(eB, eA, hB, hA, token + NW);
    }
#undef PD_BODY
#undef PD_CL
#undef PD_LOAD_E
#undef PD_BC
#undef PD_ISSUE4
#undef PD_DOT1
}
template <int NTOK> __device__ __forceinline__ void peer_loadrate_probe(Frame& F) {
    const int* EID = (const int*)(F.ws + WS_EID);
    const int lane = F.lane, g = lane >> 3, j = lane & 7, x = F.bid & 7;
    const int nbx = (F.G - x + 7) >> 3, NW = nbx * NWAVES, gwv = (F.bid >> 3) * NWAVES + F.wave;
    const unsigned char* US = F.ws + WS_UB + (size_t)x * NEXP * 128; const unsigned j16 = 16u * (unsigned)j;
    unsigned acc = 0u;
    for (int token = gwv; token + (NTOK - 1) * NW < M; token += NTOK * NW) {
        v4i e4[NTOK][4];
#pragma unroll
        for (int t = 0; t < NTOK; ++t)
#pragma unroll
            for (int q = 0; q < 4; ++q) e4[t][q] = *(const GAS v4i*)(EID + (size_t)(token + t * NW) * 128 + 16 * g + 4 * q);
        v4i b[NTOK][16];
#pragma unroll
        for (int t = 0; t < NTOK; ++t)
#pragma unroll
            for (int q = 0; q < 4; ++q) { b[t][4 * q] = *(const GAS v4i*)(US + ((unsigned)e4[t][q].x * 128u + j16)); b[t][4 * q + 1] = *(const GAS v4i*)(US + ((unsigned)e4[t][q].y * 128u + j16));
                b[t][4 * q + 2] = *(const GAS v4i*)(US + ((unsigned)e4[t][q].z * 128u + j16)); b[t][4 * q + 3] = *(const GAS v4i*)(US + ((unsigned)e4[t][q].w * 128u + j16)); }
#pragma unroll
        for (int t = 0; t < NTOK; ++t)
#pragma unroll
            for (int i = 0; i < 16; ++i) acc ^= (unsigned)(b[t][i].x ^ b[t][i].y ^ b[t][i].z ^ b[t][i].w);
    }
    asm volatile("" :: "v"(acc));
}
__device__ __forceinline__ void peer_coef_phase(Frame& F) {
    const unsigned short* PART = (const unsigned short*)(F.ws + WS_PART); const unsigned short* EID = (const unsigned short*)(F.ws + WS_EID); const float* GW = (const float*)(F.ws + WS_GW);
    const float* SCU = (const float*)(F.ws + WS_SCLU); const float* SCV = (const float*)(F.ws + WS_SCLV); const float* HS = (const float*)(F.ws + WS_HS);
    unsigned* CF8 = (unsigned*)(F.ws + WS_CF); float* CFS = (float*)(F.ws + WS_CFS);
    const size_t gtid = (size_t)F.bid * NTHREADS + F.tid, gthreads = (size_t)F.G * NTHREADS, n4 = (size_t)M * 128 / 4;
    v2u pw[8]; v2u ewn; f32x4 gwn; float hsn;
#define P11_LOAD(i_) do { _Pragma("unroll") for (int xx = 0; xx < 8; ++xx) pw[xx] = *(const GAS v2u*)(PART + (size_t)xx * M * 128 + 4 * (i_)); \
        ewn = *(const GAS v2u*)(EID + 4 * (i_)); gwn = *(const GAS f32x4*)(GW + 4 * (i_)); hsn = HS[(i_) >> 5]; } while (0)
    if (gtid < n4) P11_LOAD(gtid);
    for (size_t i4 = gtid; i4 < n4; i4 += gthreads) {
        f32x4 d = (f32x4){0.f, 0.f, 0.f, 0.f};
#pragma unroll
        for (int xx = 0; xx < 8; ++xx) d = d + (f32x4){f16lo(pw[xx].x), f16hi(pw[xx].x), f16lo(pw[xx].y), f16hi(pw[xx].y)};
        d = d * 64.0f;
        const v2u ew = ewn; const v4i e = (v4i){(int)(ew.x & 0xffffu), (int)(ew.x >> 16), (int)(ew.y & 0xffffu), (int)(ew.y >> 16)}; const f32x4 gw = gwn;
        const float hs = hsn;
        const float su0 = SCU[e.x], su1 = SCU[e.y], su2 = SCU[e.z], su3 = SCU[e.w], sv0 = SCV[e.x], sv1 = SCV[e.y], sv2 = SCV[e.z], sv3 = SCV[e.w];
        if (i4 + gthreads < n4) P11_LOAD(i4 + gthreads);
        f32x4 r; r.x = gw.x * sv0 * gelu_tanh_safe(d.x * (su0 * hs)); r.y = gw.y * sv1 * gelu_tanh_safe(d.y * (su1 * hs));
        r.z = gw.z * sv2 * gelu_tanh_safe(d.z * (su2 * hs)); r.w = gw.w * sv3 * gelu_tanh_safe(d.w * (su3 * hs));
        float m = fmaxf(fmaxf(fabsf(r.x), fabsf(r.y)), fmaxf(fabsf(r.z), fabsf(r.w)));
        m = fmaxf(m, dppf<DPP_XOR1>(m)); m = fmaxf(m, dppf<DPP_XOR2>(m)); m = fmaxf(m, dppf<DPP_HMIR>(m)); m = fmaxf(m, dppf<DPP_ROR8>(m)); m = max_xor16(m);
        const unsigned E = (__builtin_bit_cast(unsigned, m) >> 23) & 0xffu; float sc = 1.f, isc = 1.f;
        if (E >= 8u && E <= 250u) { sc = __builtin_bit_cast(float, (261u - E) << 23); isc = __builtin_bit_cast(float, (E - 7u) << 23); }
        int t = __builtin_amdgcn_cvt_pk_fp8_f32(r.x * sc, r.y * sc, 0, false); t = __builtin_amdgcn_cvt_pk_fp8_f32(r.z * sc, r.w * sc, t, true);
        CF8[i4] = (unsigned)t;
        if ((F.lane & 31) == 0) CFS[i4 >> 5] = isc; }
#undef P11_LOAD
}
template <bool DRY, bool CHECK = false> __device__ __forceinline__ void peer_out_phase(Frame& F, const float* ada, float* out) {
    const int* EID = (const int*)(F.ws + WS_EID); const unsigned char* CF8 = (const unsigned char*)(F.ws + WS_CF); const float* CFS = (const float*)(F.ws + WS_CFS);
    const int lane = F.lane, g = lane >> 3, j = lane & 7, x = F.bid & 7;
    const int nbx = (F.G - x + 7) >> 3, NW = nbx * NWAVES, gwv = (F.bid >> 3) * NWAVES + F.wave;
    const unsigned char* VS = F.ws + WS_VB + (size_t)x * NEXP * 128; const unsigned j16 = 16u * (unsigned)j;
    if (gwv >= M) return;
    const int ntok = (M - 1 - gwv) / NW + 1;
#define PO_ISSUE4(buf_, e_, b0_) do { buf_[b0_] = *(const GAS v4u*)(VS + ((unsigned)e_.x * 128u + j16)); buf_[b0_ + 1] = *(const GAS v4u*)(VS + ((unsigned)e_.y * 128u + j16)); \
        buf_[b0_ + 2] = *(const GAS v4u*)(VS + ((unsigned)e_.z * 128u + j16)); buf_[b0_ + 3] = *(const GAS v4u*)(VS + ((unsigned)e_.w * 128u + j16)); } while (0)
#define PO_ROW(w_, c_) do { float f[16]; unpack16_fp8(w_, f); _Pragma("unroll") for (int k = 0; k < 16; ++k) o[k] += (c_) * f[k]; } while (0)
#define PO_ACC4(buf_, c4_, b0_) do { PO_ROW(buf_[b0_], c4_.x); PO_ROW(buf_[b0_ + 1], c4_.y); PO_ROW(buf_[b0_ + 2], c4_.z); PO_ROW(buf_[b0_ + 3], c4_.w); } while (0)
    v4i e4[4]; f32x4 c4[4]; v4u bA[8], bB[8];
#define PO_LOADC(tok_) do { const float cs_ = CFS[tok_]; _Pragma("unroll") for (int q = 0; q < 4; ++q) { const unsigned w_ = *(const GAS unsigned*)(CF8 + (size_t)(tok_) * 128 + g * 16 + 4 * q); \
        const f32x2 lo_ = __builtin_amdgcn_cvt_pk_f32_fp8((int)w_, false), hi_ = __builtin_amdgcn_cvt_pk_f32_fp8((int)w_, true); c4[q] = (f32x4){lo_.x * cs_, lo_.y * cs_, hi_.x * cs_, hi_.y * cs_}; } } while (0)
#pragma unroll
    for (int q = 0; q < 4; ++q) e4[q] = *(const GAS v4i*)(EID + (size_t)gwv * 128 + g * 16 + 4 * q);
    PO_LOADC(gwv);
    PO_ISSUE4(bA, e4[0], 0); PO_ISSUE4(bA, e4[1], 4);
    for (int it = 0; it < ntok; ++it) {
        const int token = gwv + it * NW, tn = gwv + (it + 1 < ntok ? it + 1 : it) * NW;
        PO_ISSUE4(bB, e4[2], 0); PO_ISSUE4(bB, e4[3], 4);
#pragma unroll
        for (int q = 0; q < 4; ++q) e4[q] = *(const GAS v4i*)(EID + (size_t)tn * 128 + g * 16 + 4 * q);
        float o[16];
#pragma unroll
        for (int k = 0; k < 16; ++k) o[k] = 0.f;
        PO_ACC4(bA, c4[0], 0); PO_ACC4(bA, c4[1], 4);
        PO_ISSUE4(bA, e4[0], 0); PO_ISSUE4(bA, e4[1], 4);
        PO_ACC4(bB, c4[2], 0); PO_ACC4(bB, c4[3], 4);
        PO_LOADC(tn);
#pragma unroll
        for (int k = 0; k < 16; ++k) { float t = o[k]; t += dppf<DPP_ROR8>(t); o[k] = sum_xor32(sum_xor16(t)); }
        if (g == 0) { const int b = token >> 12;
            const float* gt = ada + (size_t)b * 6 * D + 5 * D + 128 * x + 16 * j;
            float* xo = out + (size_t)token * D + 128 * x + 16 * j;
#pragma unroll
            for (int q = 0; q < 4; ++q) { const f32x4 xv = *(const GAS f32x4*)(xo + 4 * q), gv = *(const GAS f32x4*)(gt + 4 * q);
                f32x4 res = xv + gv * (f32x4){o[4 * q], o[4 * q + 1], o[4 * q + 2], o[4 * q + 3]};
                if (CHECK) { const f32x4 mf = *(const GAS f32x4*)((const float*)(F.ws + WS_PART) + (size_t)token * D + 128 * x + 16 * j + 4 * q);
                    const float rr[4] = {o[4 * q], o[4 * q + 1], o[4 * q + 2], o[4 * q + 3]}, mm[4] = {mf.x, mf.y, mf.z, mf.w}; bool bad = false;
#pragma unroll
                    for (int z = 0; z < 4; ++z) bad = bad || !(fabsf(rr[z] - mm[z]) <= 0.01f * fabsf(rr[z]) + 1.0e-3f);
                    if (bad) res.x = 1.0e9f; }
                if (DRY) { asm volatile("" :: "v"(res.x), "v"(res.y), "v"(res.z), "v"(res.w)); } else *(GAS f32x4*)(xo + 4 * q) = res; } }
    }
#undef PO_LOADC
#undef PO_ISSUE4
#undef PO_ROW
#undef PO_ACC4
}

constexpr int PO_TILE = 64 * 144;
template <int MODE> __device__ __forceinline__ void peer_out_mfma_phase(Frame& F, const float* ada, float* out) {
    const unsigned short* EID = (const unsigned short*)(F.ws + WS_EID); const unsigned char* CF8 = (const unsigned char*)(F.ws + WS_CF); const float* CFS = (const float*)(F.ws + WS_CFS);
    const int lane = F.lane, g = lane >> 3, j = lane & 7, l15 = lane & 15, lq = lane >> 4, x = F.bid & 7;
    const int nbx = (F.G - x + 7) >> 3, NW = nbx * NWAVES, gwv = (F.bid >> 3) * NWAVES + F.wave;
    const unsigned char* VS = F.ws + WS_VB + (size_t)x * NEXP * 128; const unsigned j16 = 16u * (unsigned)j;
    LAS unsigned char* TL = F.lds + F.wave * PO_TILE;
    if (gwv >= M) return;
    const int nst = 2 * ((M - 1 - gwv) / NW + 1);
    const int trow = l15 >> 1, tcol = 8 * (l15 & 1);
#define PM_IDS(e_, a_, tok_) do { const size_t base = (size_t)(tok_) * 128; \
        e_ = *(const GAS unsigned*)(EID + base + 64 * (j >> 2) + 8 * g + 2 * (j & 3)); \
        a_ = *(const GAS unsigned*)(CF8 + base + 32 * ((l15 & 7) >> 1) + 8 * lq + 4 * (l15 & 1)); } while (0)
#define PM_BCG(e_, k_) (pg ? (unsigned)dppi<0x158 + (k_)>((int)(e_)) : (unsigned)dppi<0x150 + (k_)>((int)(e_)))
#define PM_BCR(a_, k_) ((unsigned)dppi<0x150 + (k_)>((int)(a_)))
#define PM_AQ(a_, q_) ((long)(((unsigned long long)PM_BCR(a_, 2 * (q_) + 1) << 32) | (unsigned long long)PM_BCR(a_, 2 * (q_))))
#define PM_GATHER(vv_, e_, h_) do { const unsigned ew_[4] = {PM_BCG(e_, 4 * (h_)), PM_BCG(e_, 4 * (h_) + 1), PM_BCG(e_, 4 * (h_) + 2), PM_BCG(e_, 4 * (h_) + 3)}; \
        _Pragma("unroll") for (int m = 0; m < 8; ++m) vv_[m] = *(const GAS v4u*)(VS + (((ew_[m >> 1] >> (16 * (m & 1))) & 0xffffu) * 128u + j16)); } while (0)
#define PM_HALF(vv_, aq0_, aq1_) do { _Pragma("unroll") for (int m = 0; m < 8; ++m) *(LAS v4u*)(TL + (8 * g + m) * 144 + 16 * j) = vv_[m]; } while (0)
#define PM_MMA(aq0_, aq1_) do { LDS_WAIT(); asm volatile("" ::: "memory"); \
        _Pragma("unroll") for (int ks = 0; ks < 2; ++ks) _Pragma("unroll") for (int cb = 0; cb < 8; ++cb) { \
            const v2i bb = __builtin_amdgcn_ds_read_tr8_b64_v2i32((LAS v2i*)(TL + (32 * ks + 8 * lq + trow) * 144 + 16 * cb + tcol)); \
            acc[cb] = __builtin_amdgcn_mfma_f32_16x16x32_fp8_fp8(ks ? (aq1_) : (aq0_), __builtin_bit_cast(long, bb), acc[cb], 0, 0, 0); } \
        LDS_WAIT(); asm volatile("" ::: "memory"); } while (0)
    const int ntok = nst >> 1;
    unsigned e1, e2, a0, a1, a2; v4u vvA[8], vvB[8]; const int pg = g & 1;
    PM_IDS(e1, a0, gwv);
    PM_GATHER(vvA, e1, 0); PM_GATHER(vvB, e1, 1);
    { const int t1 = ntok > 1 ? 1 : 0; PM_IDS(e1, a1, gwv + t1 * NW); }
    f32x4 acc[8];
    for (int it = 0; it < ntok; ++it) {
        const int token = gwv + it * NW;
        { const int t2 = it + 2 < ntok ? it + 2 : ntok - 1; PM_IDS(e2, a2, gwv + t2 * NW); }
#pragma unroll
        for (int cb = 0; cb < 8; ++cb) acc[cb] = (f32x4){0.f, 0.f, 0.f, 0.f};
        float xv[2], gv[2]; float cs;
        { const int b = token >> 12; const float* gt = ada + (size_t)b * 6 * D + 5 * D + 128 * x + 32 * lq + l15; const bf16* xi = (const bf16*)(F.ws + WS_X1) + (size_t)token * D + 128 * x + 32 * lq + l15;
          cs = CFS[token];
#pragma unroll
          for (int k = 0; k < 2; ++k) { xv[k] = bflo((unsigned)xi[16 * k]); gv[k] = gt[16 * k]; } }
        { const long q0_ = PM_AQ(a0, 0), q1_ = PM_AQ(a0, 1), q2_ = PM_AQ(a0, 2), q3_ = PM_AQ(a0, 3);
        PM_HALF(vvA, 0, 0); PM_GATHER(vvA, e1, 0); PM_MMA(q0_, q1_);
        PM_HALF(vvB, 0, 0); PM_GATHER(vvB, e1, 1); PM_MMA(q2_, q3_); }
        {
            float sv[2];
#pragma unroll
            for (int k = 0; k < 2; ++k) sv[k] = lq == 0 ? acc[k][0] : (lq == 1 ? acc[2 + k][0] : (lq == 2 ? acc[4 + k][0] : acc[6 + k][0]));
            if (MODE == 1) { float* oc = (float*)(F.ws + WS_PART) + (size_t)token * D + 128 * x + 32 * lq + l15; oc[0] = sv[0] * cs; oc[16] = sv[1] * cs; }
            else { float* xo = out + (size_t)token * D + 128 * x + 32 * lq + l15;
                xo[0] = xv[0] + gv[0] * (sv[0] * cs); xo[16] = xv[1] + gv[1] * (sv[1] * cs); }
        }
        e1 = e2; a0 = a1; a1 = a2;
    }
#undef PM_HALF
#undef PM_MMA
#undef PM_IDS
#undef PM_BCG
#undef PM_BCR
#undef PM_AQ
#undef PM_GATHER
}

__device__ __forceinline__ void compress_phase(Frame& F, const float* kng) {
    LAS bf16* H2 = (LAS bf16*)(F.lds);
    LAS float* OUTS = (LAS float*)(F.lds + 16384);
    const int lane = F.lane, w = F.wave, l15 = lane & 15, lq = lane >> 4;
    for (int u = F.bid; u < NBG * 2 * 8; u += F.G) {
        const int ns = u & 7, kv = (u >> 3) & 1, bg = u >> 4, n0 = ns * 32;
        const bf16* A = (const bf16*)(F.ws + (kv ? WS_VCR : WS_KCR)) + (size_t)bg * SEQ * 64;
        const bf16* W1T = (const bf16*)(F.ws + (kv ? WS_CW1V_T : WS_CW1K_T));
        const bf16* W2T = (const bf16*)(F.ws + (kv ? WS_CW2V_T : WS_CW2K_T));
        const float* b1 = (const float*)(F.ws + (kv ? WS_CB1V : WS_CB1K));
        pg8::f32x4 acc[2][8];
#pragma unroll
        for (int rb = 0; rb < 2; ++rb)
#pragma unroll
            for (int cb = 0; cb < 8; ++cb) acc[rb][cb] = (pg8::f32x4){0.f, 0.f, 0.f, 0.f};
        const bf16* ap = A + (size_t)(n0 + l15) * 1024 + 256 * w + 8 * lq;
        const bf16* bp = W1T + (size_t)l15 * 2048 + 256 * w + 8 * lq;
        bf16x8 w2f[4];
#pragma unroll
        for (int ks = 0; ks < 4; ++ks) w2f[ks] = *(const GAS bf16x8*)(W2T + (size_t)(16 * (w & 3) + l15) * 128 + 32 * ks + 8 * lq);
        const float b1v = b1[F.tid & 127]; float knv[4];
#pragma unroll
        for (int i = 0; i < 4; ++i) knv[i] = kng[(F.tid & 15) * 4 + i];
#pragma unroll
        for (int ks = 0; ks < 8; ++ks) {
            const bf16x8 a0 = *(const GAS bf16x8*)(ap + 32 * ks), a1 = *(const GAS bf16x8*)(ap + 16 * 1024 + 32 * ks);
#pragma unroll
            for (int cb = 0; cb < 8; ++cb) { const bf16x8 b = *(const GAS bf16x8*)(bp + (size_t)(16 * cb) * 2048 + 32 * ks);
                acc[0][cb] = __builtin_amdgcn_mfma_f32_16x16x32_bf16(a0, b, acc[0][cb], 0, 0, 0);
                acc[1][cb] = __builtin_amdgcn_mfma_f32_16x16x32_bf16(a1, b, acc[1][cb], 0, 0, 0); }
        }
        { LAS float* PS = (LAS float*)(F.lds + 32768);
          LAS float* mine = PS + (w & 3) * 4096 + (4 * lq) * 128 + l15;
          if (w >= 4) {
#pragma unroll
              for (int rb = 0; rb < 2; ++rb)
#pragma unroll
                  for (int cb = 0; cb < 8; ++cb)
#pragma unroll
                      for (int r = 0; r < 4; ++r) mine[(16 * rb + r) * 128 + 16 * cb] = acc[rb][cb][r]; }
          __syncthreads();
          if (w < 4) {
#pragma unroll
              for (int rb = 0; rb < 2; ++rb)
#pragma unroll
                  for (int cb = 0; cb < 8; ++cb)
#pragma unroll
                      for (int r = 0; r < 4; ++r) { LAS float* q = mine + (16 * rb + r) * 128 + 16 * cb; *q = acc[rb][cb][r] + *q; } }
          __syncthreads();
#pragma unroll
          for (int i = 0; i < 8; ++i) { const int idx = F.tid + 512 * i, row = idx >> 7, col = idx & 127;
              const float v = ((PS[idx] + PS[4096 + idx]) + (PS[8192 + idx] + PS[12288 + idx])) + b1v;
              H2[row * 136 + col] = (bf16)f2bf(gelu_tanh_safe(v)); } }
        __syncthreads();
        { const int rb = w >> 2, db = w & 3;
          pg8::f32x4 o = (pg8::f32x4){0.f, 0.f, 0.f, 0.f};
#pragma unroll
          for (int ks = 0; ks < 4; ++ks) {
              const bf16x8 a = *(const LAS bf16x8*)(H2 + (16 * rb + l15) * 136 + 32 * ks + 8 * lq);
              o = __builtin_amdgcn_mfma_f32_16x16x32_bf16(a, w2f[ks], o, 0, 0, 0); }
#pragma unroll
          for (int r = 0; r < 4; ++r) OUTS[(16 * rb + 4 * lq + r) * 65 + 16 * db + l15] = o[r]; }
        __syncthreads();
        { const int n = F.tid >> 4, d4 = (F.tid & 15) * 4, ng = n0 + n;
          float v[4]; float ss = 0.f;
#pragma unroll
          for (int i = 0; i < 4; ++i) { v[i] = OUTS[n * 65 + d4 + i]; ss += v[i] * v[i]; }
          ss += dppf<DPP_XOR1>(ss); ss += dppf<DPP_XOR2>(ss); ss += dppf<DPP_HMIR>(ss); ss += dppf<DPP_ROR8>(ss);
          const bool pad = (ng >= NCMP);
          if (kv == 0) { const float rs = rsqrtf(ss * (1.f / 64.f) + EPS);
              v2u o; o.x = pad ? 0u : pk2(v[0] * rs * knv[0], v[1] * rs * knv[1]); o.y = pad ? 0u : pk2(v[2] * rs * knv[2], v[3] * rs * knv[3]);
              *(GAS v2u*)((bf16*)(F.ws + WS_KC) + ((size_t)bg * 256 + ng) * 64 + d4) = o; }
          else { bf16* vt = (bf16*)(F.ws + WS_VCT) + (size_t)bg * 64 * 256 + ng;
#pragma unroll
              for (int i = 0; i < 4; ++i) vt[(size_t)(d4 + i) * 256] = pad ? (bf16)0 : (bf16)f2bf(v[i]); } }
        __syncthreads();
    }
}
__device__ __forceinline__ void vtranspose_phase(Frame& F) {
    LAS bf16* T = (LAS bf16*)(F.lds + F.wave * 9216);
    const int gw = F.bid * NWAVES + F.wave, NGW = F.G * NWAVES, lane = F.lane;
    for (int job = gw; job < 2 * NBG * 64; job += NGW) {
        const int s = job & 63, bg = (job >> 6) & 15, which = job >> 10;
        const bf16* X = (const bf16*)(F.ws + (which ? WS_VW : WS_VS)) + ((size_t)bg * SEQ + 64 * s) * 64;
        bf16* XT = (bf16*)(F.ws + (which ? WS_VWT : WS_VST)) + (size_t)bg * 64 * SEQ + 64 * s;
#pragma unroll
        for (int i = 0; i < 8; ++i) { const int tok = (lane >> 3) + 8 * i, ch = lane & 7;
            const v4u x = *(const GAS v4u*)(X + (size_t)tok * 64 + 8 * ch);
            const unsigned ww[4] = {x.x, x.y, x.z, x.w};
#pragma unroll
            for (int e = 0; e < 4; ++e) { T[(8 * ch + 2 * e) * 72 + tok] = (bf16)(ww[e] & 0xffffu); T[(8 * ch + 2 * e + 1) * 72 + tok] = (bf16)(ww[e] >> 16); } }
        LDS_WAIT(); asm volatile("" ::: "memory");
#pragma unroll
        for (int i = 0; i < 8; ++i) { const int dim = (lane >> 3) + 8 * i, ch = lane & 7;
            const v4u y = *(const LAS v4u*)(T + dim * 72 + 8 * ch);
            *(GAS v4u*)(XT + (size_t)dim * SEQ + 8 * ch) = y; }
        LDS_WAIT(); asm volatile("" ::: "memory");
    }
}

constexpr int AT_KBUF = 64 * 128;
constexpr int AT_NBUF = 2;
constexpr int AT_OFF_K = 0, AT_OFF_V = AT_NBUF * AT_KBUF;
constexpr int AT_OFF_IMP1 = 2 * AT_NBUF * AT_KBUF, AT_OFF_IMP2 = AT_OFF_IMP1 + 64 * 65 * 4, AT_OFF_SEL = AT_OFF_IMP2 + 64 * 65 * 4;
constexpr int AT_OFF_LUT = AT_OFF_SEL + 512, AT_OFF_LROW = AT_OFF_LUT + 4 * 128 * 4;
constexpr int AT_OFF_TD = AT_OFF_LROW + 8 * 32 * 4;
constexpr int AT_OFF_OUT = AT_OFF_TD + 96 * 32;
constexpr int AT_OFF_GATL = AT_OFF_OUT + 256 * 144;
constexpr int AT_OFF_TS = AT_OFF_GATL + 64 * 12 * 4;
constexpr int AT_TS_ROW = 65 * 16;
constexpr int AT_OFF_TC = AT_OFF_TS + 16 * AT_TS_ROW;
constexpr int AT_TC_N = 177;
constexpr int AT_LDS_END = AT_OFF_TC + 4 * AT_TC_N * 16;
static_assert(AT_LDS_END <= RING_BYTES, "attention LDS");

struct AtTile { const bf16* k; const bf16* vt; int vstride; };
enum { TM_CMP1 = 0, TM_CMP2, TM_SELN, TM_SELF, TM_WINN, TM_WINF, TM_WINE, TM_CMP1F, TM_CMP2F };
__device__ __forceinline__ float fexp2(float x) { return __builtin_amdgcn_exp2f(x); }
template <int TM, int VAR, int RB = 3>
__device__ __forceinline__ void at_tile(const LAS unsigned char* kb_, const LAS unsigned char* vb_, const LAS float* LUTJ, LAS float* IMP1, LAS float* IMP2,
                                        const bf16x8 (&qf)[2][2], pg8::f32x4 (&oacc)[2][4], pg8::f32x4 (&lacc)[2], const LAS float* LINV,
                                        const int (&tok_r_in)[2], const unsigned (&selb)[2], float cfar, int relbase, int idx, int l15_in, int lq_in, const LAS unsigned char* tsw, const LAS unsigned char* tsn, int ko0, int vo0, const LAS unsigned char* tcb) {
    constexpr bool FAR = (TM == TM_SELF || TM == TM_WINF || TM == TM_WINE || TM == TM_CMP1F || TM == TM_CMP2F);
    constexpr bool C1 = (TM == TM_CMP1 || TM == TM_CMP1F), C2 = (TM == TM_CMP2 || TM == TM_CMP2F);
    int l15 = l15_in, lq = lq_in; asm volatile("" : "+v"(l15), "+v"(lq));
    int tok_r[2] = {tok_r_in[0], tok_r_in[1]}; asm volatile("" : "+v"(tok_r[0]), "+v"(tok_r[1]));
    v4u pfr[2][2];
    const LAS unsigned char* tsp[2] = {tsw, tsw};
    if (TM == TM_SELN || TM == TM_WINN) {
#pragma unroll
        for (int rb = 0; rb < 2; ++rb) { const LAS unsigned char* pa = tsw + l15 * AT_TS_ROW + 16 * (2 * lq - rb) - 4 * relbase;
            const LAS unsigned char* pn = tsn + l15 * AT_TS_ROW;
            tsp[rb] = (TM == TM_SELN && !selb[rb]) ? pn : pa; } }
    auto kld = [&](int cb, bf16x8 (&kf)[2], pg8::f32x4 (&cq)[2]) __attribute__((always_inline)) {
        if (TM == TM_SELN || TM == TM_WINN) {
#pragma unroll
            for (int rb = 0; rb < 2; ++rb) cq[rb] = *(const LAS pg8::f32x4*)(tsp[rb] + 16 * (8 * (cb >> 1) + (cb & 1))); }
        if (TM == TM_CMP1 || TM == TM_CMP2) {
#pragma unroll
            for (int rb = 0; rb < 2; ++rb) { const int rel0 = relbase + tok_r[rb] - 16 * (32 * (cb >> 1) + 8 * lq + 4 * (cb & 1));
                const int zi = (rel0 < -1 ? -1 : (rel0 > 175 ? 175 : rel0)) + 1;
                cq[rb] = *(const LAS pg8::f32x4*)(tcb + ((l15 & 3) * AT_TC_N + zi) * 16); } }
        if (!(VAR & 64)) {
#pragma unroll
        for (int ks = 0; ks < 2; ++ks) kf[ks] = *(const LAS bf16x8*)(kb_ + ((ko0 ^ (64 * ks)) + (32 * (cb >> 1) + 4 * (cb & 1)) * 128)); }
    };
    auto qkm = [&](int cb, const bf16x8 (&kf)[2], const pg8::f32x4 (&cq)[2], pg8::f32x4 (&st)[2]) __attribute__((always_inline)) {
        st[0] = FAR ? (pg8::f32x4){cfar, cfar, cfar, cfar} : (pg8::f32x4){0.f, 0.f, 0.f, 0.f}; st[1] = st[0];
        if (TM == TM_SELN || TM == TM_WINN || TM == TM_CMP1 || TM == TM_CMP2) { st[0] = cq[0]; st[1] = cq[1]; }
        if (TM == TM_SELF) {
#pragma unroll
            for (int rb = 0; rb < 2; ++rb) { const float ci = selb[rb] ? cfar : -1.0e30f; st[rb] = (pg8::f32x4){ci, ci, ci, ci}; } }
        if (!(VAR & 64)) {
        __builtin_amdgcn_s_setprio(1);
#pragma unroll
        for (int ks = 0; ks < 2; ++ks) {
#pragma unroll
            for (int rb = 0; rb < 2; ++rb) if (RB & (1 << rb)) st[rb] = __builtin_amdgcn_mfma_f32_16x16x32_bf16(kf[ks], qf[rb][ks], st[rb], 0, 0, 0); }
        __builtin_amdgcn_s_setprio(0); }
    };
    float linv_[2] = {0.f, 0.f};
    if (C2) { linv_[0] = LINV[l15]; linv_[1] = LINV[16 + l15]; }
    auto prob = [&](int cb, const pg8::f32x4 (&st)[2]) __attribute__((always_inline)) {
#pragma unroll
        for (int rb = 0; rb < 2; ++rb) if (RB & (1 << rb)) {
            const int tokc = tok_r[rb];
            float p[4];
#pragma unroll
            for (int r = 0; r < 4; ++r) {
                const int kl = 32 * (cb >> 1) + 8 * lq + 4 * (cb & 1) + r;
                if (VAR & 16) { p[r] = st[rb][r]; }
                else if (TM == TM_SELF) { p[r] = fexp2(st[rb][r]); }
                else if (TM == TM_WINF || TM == TM_SELN || TM == TM_WINN || TM == TM_CMP1F || TM == TM_CMP2F) { p[r] = fexp2(st[rb][r]); }
                else if (TM == TM_WINE) { const float e = fexp2(st[rb][r]); p[r] = (kl > tokc) ? e : 0.f; }
                else { p[r] = fexp2(st[rb][r]); }
            }
            if (C1) { lacc[rb][0] += (p[0] + p[1]) + (p[2] + p[3]); }
            else {
                if (C2) {
#pragma unroll
                    for (int r = 0; r < 4; ++r) p[r] *= linv_[rb];
                    float h0 = p[0], h1 = p[1], h2 = p[2], h3 = p[3];
                    h0 += dppf<DPP_XOR1>(h0); h1 += dppf<DPP_XOR1>(h1); h2 += dppf<DPP_XOR1>(h2); h3 += dppf<DPP_XOR1>(h3);
                    h0 += dppf<DPP_XOR2>(h0); h1 += dppf<DPP_XOR2>(h1); h2 += dppf<DPP_XOR2>(h2); h3 += dppf<DPP_XOR2>(h3);
                    if ((l15 & 3) == 0) { const int sp = 16 * idx + 8 * (cb >> 1) + 2 * lq + (cb & 1);
                        IMP1[tokc * 65 + sp] = (h0 + h1) + (h2 + 0.5f * h3);
                        if (sp + 1 < 64) IMP2[tokc * 65 + sp + 1] = 0.5f * h3; }
                }
                const unsigned lo = pkh(p[0], p[1]), hi = pkh(p[2], p[3]);
                if (cb & 1) { pfr[rb][cb >> 1].z = lo; pfr[rb][cb >> 1].w = hi; } else { pfr[rb][cb >> 1].x = lo; pfr[rb][cb >> 1].y = hi; } }
        }
    };
    auto vld = [&](int ks, v4u (&vv)[4]) __attribute__((always_inline)) {
        if (!C1 && !(VAR & 8)) {
#pragma unroll
            for (int db = 0; db < 4; ++db) vv[db] = *(const LAS v4u*)(vb_ + ((vo0 ^ (64 * ks)) + 2048 * db)); }
    };
    auto pvm = [&](int ks, const v4u (&vv)[4]) __attribute__((always_inline)) {
        if (!C1 && !(VAR & 8)) {
            __builtin_amdgcn_s_setprio(1);
#pragma unroll
            for (int db = 0; db < 4; ++db) {
#pragma unroll
                for (int rb = 0; rb < 2; ++rb) if (RB & (1 << rb)) oacc[rb][db] = __builtin_amdgcn_mfma_f32_16x16x32_bf16(__builtin_bit_cast(bf16x8, pfr[rb][ks]), __builtin_bit_cast(bf16x8, vv[db]), oacc[rb][db], 0, 0, 0); }
            if (!C2) { const v4u ones = (v4u){0x3F803F80u, 0x3F803F80u, 0x3F803F80u, 0x3F803F80u};
#pragma unroll
                for (int rb = 0; rb < 2; ++rb) if (RB & (1 << rb)) lacc[rb] = __builtin_amdgcn_mfma_f32_16x16x32_bf16(__builtin_bit_cast(bf16x8, pfr[rb][ks]), __builtin_bit_cast(bf16x8, ones), lacc[rb], 0, 0, 0); }
            __builtin_amdgcn_s_setprio(0);
        }
    };
    pg8::f32x4 sA[2], sB[2], cA[2], cB[2]; bf16x8 kA[2], kB[2]; v4u vA[4], vB[4];
#define AT_SB __builtin_amdgcn_sched_barrier(0)
    kld(0, kA, cA); kld(1, kB, cB); AT_SB;
    qkm(0, kA, cA, sA); kld(2, kA, cA); AT_SB;
    qkm(1, kB, cB, sB); kld(3, kB, cB); prob(0, sA); AT_SB;
    qkm(2, kA, cA, sA); vld(0, vA); prob(1, sB); AT_SB;
    qkm(3, kB, cB, sB); pvm(0, vA); vld(1, vB); prob(2, sA); AT_SB;
    prob(3, sB); AT_SB;
    pvm(1, vB);
#undef AT_SB
}

template <int VAR> __device__ __forceinline__ void attention_phase(Frame& F, const Args& args) {
    unsigned char* ws = F.ws;
    const int lane = F.lane, w = F.wave, l15 = lane & 15, lq = lane >> 4, tid = F.tid;
    LAS unsigned char* L = F.lds;
    LAS float* IMP1 = (LAS float*)(L + AT_OFF_IMP1); LAS float* IMP2 = (LAS float*)(L + AT_OFF_IMP2); const LAS unsigned char* tcb = L + AT_OFF_TC;
    LAS unsigned long long* SELM = (LAS unsigned long long*)(L + AT_OFF_SEL); LAS float* LUT = (LAS float*)(L + AT_OFF_LUT); LAS float* LROW = (LAS float*)(L + AT_OFF_LROW) + w * 32;
    LAS int* TD = (LAS int*)(L + AT_OFF_TD); LAS bf16* OUTL = (LAS bf16*)(L + AT_OFF_OUT) + (32 * w) * 72; LAS float* GATL = (LAS float*)(L + AT_OFF_GATL);
    const bf16* Qg = (const bf16*)(ws + WS_Q); const float* GATE = (const float*)(ws + WS_GATE); bf16* YA = (bf16*)(ws + WS_PL) + 512;
    const int jq = l15 & 3;
    const LAS float* LUTJ = LUT + jq * 128;
    const int nrounds = (F.G == 256) ? 4 : (1024 + F.G - 1) / F.G;
    int gtab = -1;
    for (int round = 0; round < nrounds; ++round) {
        const int ui = (F.G == 256) ? ((round & 1) ? ((round >> 1) * 512 + 511 - F.bid) : ((round >> 1) * 512 + F.bid)) : (round * F.G + F.bid);
        if (ui >= 1024) break;
        const int c = 63 - (ui >> 4), bg = (ui & 15) ^ ((F.G == 256) ? (round & 1) : 0), b = bg >> 1, g = bg & 1;
        const int m0 = b * SEQ + 64 * c;
        bf16x8 qf[2][2];
#pragma unroll
        for (int rb = 0; rb < 2; ++rb)
#pragma unroll
            for (int ks = 0; ks < 2; ++ks) qf[rb][ks] = *(const GAS bf16x8*)(Qg + (size_t)(m0 + 8 * w + 4 * rb + (l15 >> 2)) * 512 + g * 256 + jq * 64 + 32 * ks + 8 * lq);
        const float gv0 = GATE[(size_t)(m0 + tid / 12) * 24 + g * 12 + (tid % 12)]; float gv1 = 0.f;
        if (tid < 256) gv1 = GATE[(size_t)(m0 + (tid + 512) / 12) * 24 + g * 12 + ((tid + 512) % 12)];
        __syncthreads();
        if (g != gtab) { const GAS v4u* src = (const GAS v4u*)(ws + WS_ATAB + (size_t)g * AT_TABG); gtab = g;
          for (int i = tid; i < 128 + 16 * 65 + 4 * AT_TC_N; i += NTHREADS) { const v4u t = src[i]; if (i < 128) ((LAS v4u*)LUT)[i] = t; else ((LAS v4u*)(L + AT_OFF_TS))[i - 128] = t; } }
        for (int i = tid; i < 64 * 65; i += NTHREADS) { IMP1[i] = 0.f; IMP2[i] = 0.f; }
        GATL[tid] = gv0; if (tid < 256) GATL[tid + 512] = gv1;
        asm volatile("" :: "v"(qf[0][0]), "v"(qf[0][1]), "v"(qf[1][0]), "v"(qf[1][1]));
        const int ncmp = 4 * c + 3, n1 = (ncmp + 63) >> 6, nsel = c + 1, w0 = c >= 8 ? c - 8 : 0, nwin = c - w0 + 1;
        const int ntiles = 2 * n1 + nsel + nwin;
        if (tid < ntiles) { const int i = tid;
            auto kindof = [&](int t, int& kind, int& idx) { if (t < n1) { kind = 0; idx = t; } else if (t < 2 * n1) { kind = 1; idx = t - n1; } else if (t < 2 * n1 + nsel) { kind = 2; idx = t - 2 * n1; } else { kind = 3; idx = w0 + (t - 2 * n1 - nsel); } };
            int kind, idx, kn, in_; kindof(i, kind, idx); kindof(i + 1 < ntiles ? i + 1 : i, kn, in_);
            unsigned ko, vo;
            if (kn < 2) { ko = (unsigned)(WS_KC + ((size_t)bg * 256 * 64 + (size_t)in_ * 4096) * 2); vo = (unsigned)(WS_VCT + ((size_t)bg * 64 * 256 + 64 * in_) * 2); }
            else if (kn == 2) { ko = (unsigned)(WS_KS + ((size_t)bg * SEQ * 64 + (size_t)in_ * 4096) * 2); vo = (unsigned)(WS_VST + ((size_t)bg * 64 * SEQ + 64 * in_) * 2); }
            else { ko = (unsigned)(WS_KW + ((size_t)bg * SEQ * 64 + (size_t)in_ * 4096) * 2); vo = (unsigned)(WS_VWT + ((size_t)bg * 64 * SEQ + 64 * in_) * 2); }
            const int dd = c - idx;
            int mode, relbase;
            if (kind == 0) { relbase = 64 * c - 31 - 1024 * idx; mode = relbase >= 1135 ? TM_CMP1F : TM_CMP1; } else if (kind == 1) { relbase = 64 * c - 31 - 1024 * idx; mode = relbase >= 1135 ? TM_CMP2F : TM_CMP2; }
            else if (kind == 2) { mode = dd <= 2 ? TM_SELN : TM_SELF; relbase = 64 * dd; } else { mode = dd <= 2 ? TM_WINN : (dd == 8 ? TM_WINE : TM_WINF); relbase = 64 * dd; }
            const int endf = ((kind == 1 && idx == n1 - 1) || (kind == 2 && idx == nsel - 1) || (kind == 3 && idx == c)) ? kind : 0;
            v4i e; e.x = mode | (idx << 8) | (endf << 16) | ((kind == 2 && idx == 0) ? (1 << 24) : 0) | (kn >= 2 ? (1 << 25) : 0); e.y = relbase; e.z = (int)ko; e.w = (int)vo;
            *(LAS v4i*)(TD + 4 * i) = e; }
        const int drow = 8 * w + (lane >> 3), dsrck = 16 * ((lane & 7) ^ (((w & 3) << 1) | ((lane >> 4) & 1))), dsrcv = 16 * ((lane & 7) ^ ((4 * (w & 1)) | (lane >> 4)));
#define AT_DMA(tile_, ko_, vo_, vs_) do { const int nb_ = (tile_) % AT_NBUF; \
        __builtin_amdgcn_global_load_lds((const GAS unsigned*)(ws + (size_t)((ko_) + drow * 128 + dsrck)), (LAS unsigned*)(L + AT_OFF_K + nb_ * AT_KBUF + w * 1024), 16, 0, 0); \
        __builtin_amdgcn_global_load_lds((const GAS unsigned*)(ws + (size_t)((vo_) + drow * (vs_) + dsrcv)), (LAS unsigned*)(L + AT_OFF_V + nb_ * AT_KBUF + w * 1024), 16, 0, 0); } while (0)
        __syncthreads();
        if (!(VAR & 2)) { AT_DMA(0, (unsigned)(WS_KC + (size_t)bg * 256 * 64 * 2), (unsigned)(WS_VCT + (size_t)bg * 64 * 256 * 2), 512u); }
        float cfar = LUTJ[127]; asm volatile("" : "+v"(cfar));
        unsigned long long selm0 = ~0ull, selm1 = ~0ull;
        int d0, d1, d2, d3;
        { const v4i e = *(const LAS v4i*)TD; d0 = __builtin_amdgcn_readfirstlane(e.x); d1 = __builtin_amdgcn_readfirstlane(e.y); d2 = __builtin_amdgcn_readfirstlane(e.z); d3 = __builtin_amdgcn_readfirstlane(e.w); }
        pg8::f32x4 oacc[2][4];
        pg8::f32x4 lacc[2] = {(pg8::f32x4){0.f, 0.f, 0.f, 0.f}, (pg8::f32x4){0.f, 0.f, 0.f, 0.f}};
#pragma unroll
        for (int rb = 0; rb < 2; ++rb)
#pragma unroll
            for (int db = 0; db < 4; ++db) oacc[rb][db] = (pg8::f32x4){0.f, 0.f, 0.f, 0.f};
        const int tok_r[2] = {8 * w + (l15 >> 2), 8 * w + 4 + (l15 >> 2)};
        const LAS unsigned char* tsw = L + AT_OFF_TS + 16 * (47 - 2 * w); const LAS unsigned char* tsn = L + AT_OFF_TS + 16 * 48;
        int ko0 = (8 * (l15 >> 2) + (l15 & 3)) * 128 + 16 * (lq ^ (((l15 >> 2) << 1) | ((l15 >> 1) & 1))), vo0 = l15 * 128 + 16 * (lq ^ (l15 >> 1)); asm volatile("" : "+v"(ko0), "+v"(vo0));
        for (int it = 0; it < ((VAR & 32) ? 0 : ntiles); ++it) {
            if (!(VAR & 512)) { asm volatile("s_waitcnt vmcnt(0)" ::: "memory");
            asm volatile("s_waitcnt lgkmcnt(0)" ::: "memory"); __builtin_amdgcn_s_barrier(); asm volatile("" ::: "memory"); }
            if (!(VAR & 2) && it + 1 < ntiles) AT_DMA(it + 1, (unsigned)d2, (unsigned)d3, ((d0 >> 25) & 1) ? 2u * SEQ : 512u);
            v4i tdn;
            { const LAS int* tn_ = TD + 4 * (it + 1); asm volatile("ds_read_b128 %0, %1" : "=v"(tdn) : "v"(tn_) : "memory"); }
            {
            const int mode = d0 & 255, idx = (d0 >> 8) & 255, relbase = d1, endf = (d0 >> 16) & 3, selfirst = (d0 >> 24) & 1;
            const int buf = it % AT_NBUF;
            if (selfirst) {
                { const int tok = 8 * w + (lane >> 3), s0 = 8 * (lane & 7);
                  unsigned key[8];
#pragma unroll
                  for (int q = 0; q < 8; ++q) { const int sB = s0 + q; const bool vis = sB <= c, forced = (sB == 0) || (sB == c) || (sB == c - 1);
                      const float raw = IMP1[tok * 65 + sB] + IMP2[tok * 65 + sB];
                      const float sc = vis ? (raw + (forced ? 1000.f : 0.f)) : -1.f;
                      const unsigned u = __builtin_bit_cast(unsigned, sc); const unsigned fk = (u >> 31) ? ~u : (u | 0x80000000u);
                      key[q] = (fk & ~63u) | (unsigned)(63 - sB); }
                  unsigned byte = 0u;
                  if (c >= 16 && !(VAR & 128)) {
#pragma unroll 4
                      for (int rnd = 0; rnd < 16; ++rnd) {
                          unsigned m = umax_(umax_(umax_(key[0], key[1]), umax_(key[2], key[3])), umax_(umax_(key[4], key[5]), umax_(key[6], key[7])));
                          m = umax_(m, (unsigned)dppi<DPP_XOR1>((int)m)); m = umax_(m, (unsigned)dppi<DPP_XOR2>((int)m)); m = umax_(m, (unsigned)dppi<DPP_HMIR>((int)m));
#pragma unroll
                          for (int q = 0; q < 8; ++q) key[q] = (key[q] == m) ? 0u : key[q]; }
#pragma unroll
                      for (int q = 0; q < 8; ++q) byte |= ((key[q] == 0u) ? 1u : 0u) << q;
                  } else {
#pragma unroll
                      for (int q = 0; q < 8; ++q) byte |= (((s0 + q) <= c) ? 1u : 0u) << q; }
                  ((LAS unsigned char*)SELM)[tok * 8 + (lane & 7)] = (unsigned char)byte; }
                selm0 = SELM[tok_r[0]]; selm1 = SELM[tok_r[1]];
            }
            const LAS unsigned char* kb_ = L + AT_OFF_K + buf * AT_KBUF; const LAS unsigned char* vb_ = L + AT_OFF_V + buf * AT_KBUF;
            unsigned selb[2] = {1u, 1u};
#define AT_CALL(TMX) at_tile<TMX, VAR>(kb_, vb_, LUTJ, IMP1, IMP2, qf, oacc, lacc, LROW, tok_r, selb, cfar, relbase, idx, l15, lq, tsw, tsn, ko0, vo0, tcb)
            if (mode == TM_SELF || mode == TM_SELN) { selb[0] = (unsigned)(selm0 >> idx) & 1u; selb[1] = (unsigned)(selm1 >> idx) & 1u; }
            if (mode == TM_SELF) {
                const bool a0 = __ballot(selb[0] != 0u) != 0ull, a1 = __ballot(selb[1] != 0u) != 0ull;
                if (a0 && a1) AT_CALL(TM_SELF);
                else if (a0) at_tile<TM_SELF, VAR, 1>(kb_, vb_, LUTJ, IMP1, IMP2, qf, oacc, lacc, LROW, tok_r, selb, cfar, relbase, idx, l15, lq, tsw, tsn, ko0, vo0, tcb);
                else if (a1) at_tile<TM_SELF, VAR, 2>(kb_, vb_, LUTJ, IMP1, IMP2, qf, oacc, lacc, LROW, tok_r, selb, cfar, relbase, idx, l15, lq, tsw, tsn, ko0, vo0, tcb); }
            else if (mode == TM_WINF) AT_CALL(TM_WINF);
            else if (mode == TM_SELN) AT_CALL(TM_SELN);
            else if (mode == TM_WINN) AT_CALL(TM_WINN);
            else if (mode == TM_WINE) AT_CALL(TM_WINE);
            else if (mode == TM_CMP2) AT_CALL(TM_CMP2);
            else if (mode == TM_CMP2F) AT_CALL(TM_CMP2F);
            else if (mode == TM_CMP1F) AT_CALL(TM_CMP1F);
            else { AT_CALL(TM_CMP1);
                if (idx == n1 - 1) {
#pragma unroll
                    for (int rb = 0; rb < 2; ++rb) { const float s = sum_xor32(sum_xor16(lacc[rb][0])); if (lq == 0) LROW[16 * rb + l15] = s > 0.f ? 1.0f / s : 0.f; lacc[rb] = (pg8::f32x4){0.f, 0.f, 0.f, 0.f}; } } }
#undef AT_CALL
            {
                if (endf && !(VAR & 256)) {
                    const int br = endf - 1;
#pragma unroll
                    for (int rb = 0; rb < 2; ++rb)
#pragma unroll
                        for (int r = 0; r < 4; ++r) { const int qrow = 16 * rb + 4 * lq + r;
                            const float ls_ = lacc[rb][r]; lacc[rb][r] = 0.f;
                            const float gt = GATL[(8 * w + 4 * rb + lq) * 12 + r * 3 + br] * (endf == 1 ? 1.0f : (ls_ > 0.f ? 1.0f / ls_ : 0.f));
#pragma unroll
                            for (int db = 0; db < 4; ++db) { float v = gt * oacc[rb][db][r]; oacc[rb][db][r] = 0.f;
                                LAS bf16* po = OUTL + qrow * 72 + 16 * db + l15;
                                if (br > 0) v += __builtin_bit_cast(float, (unsigned)(*po) << 16);
                                *po = (bf16)f2bf(v); } }
                    if (br == 2 && !(VAR & 1)) {
                        LDS_WAIT(); asm volatile("" ::: "memory");
#pragma unroll
                        for (int i = 0; i < 4; ++i) { const int ch = i * 64 + lane, row = ch >> 3, c16 = ch & 7;
                            const v4u o = *(const LAS v4u*)((const LAS unsigned char*)OUTL + row * 144 + 16 * c16);
                            *(GAS v4u*)(YA + (size_t)(m0 + 8 * w + (row >> 2)) * 1024 + g * 256 + (row & 3) * 64 + 8 * c16) = o; }
                    }
                }
            }
            }
            asm volatile("s_waitcnt lgkmcnt(0)" : "+v"(tdn) :: "memory");
            d0 = __builtin_amdgcn_readfirstlane(tdn.x); d1 = __builtin_amdgcn_readfirstlane(tdn.y); d2 = __builtin_amdgcn_readfirstlane(tdn.z); d3 = __builtin_amdgcn_readfirstlane(tdn.w);
        }
#undef AT_DMA
    }
}

constexpr int N_PHASES = 13;
#ifndef WGM_P2
#define WGM_P2 4
#endif
#ifndef WGM_P5
#define WGM_P5 4
#endif
#ifndef WGM_P6
#define WGM_P6 4
#endif
#ifndef WGM_P8
#define WGM_P8 4
#endif
#ifndef MK_ONE_LAUNCH
#define MK_ONE_LAUNCH 1
#endif
#ifndef REP_P0
#define REP_P0 1
#endif
#ifndef REP_P1
#define REP_P1 1
#endif
#ifndef REP_P2
#define REP_P2 1
#endif
#ifndef REP_P3
#define REP_P3 1
#endif
#ifndef REP_P5
#define REP_P5 1
#endif
#ifndef REP_P6
#define REP_P6 1
#endif
#ifndef REP_P8
#define REP_P8 1
#endif
#ifndef REP_P7
#define REP_P7 1
#endif
#ifndef REP_P11
#define REP_P11 1
#endif
#ifndef REP_P4
#define REP_P4 1
#endif
#ifndef REP_P9
#define REP_P9 1
#endif
#ifndef REP_P10
#define REP_P10 1
#endif
#ifndef MK_BUILD
#define MK_BUILD 0
#endif

#ifndef STAG_P2
#define STAG_P2 0
#endif
__device__ __forceinline__ void phase_stagger(const Frame& F, int step_ns) {
    const int grp = (F.bid >> 3) & 7;
    if (step_ns > 0 && grp > 0) { const unsigned long long t0 = wall_clock64(), dt = (unsigned long long)(grp * step_ns) / 10ull;
        while (wall_clock64() - t0 < dt) __builtin_amdgcn_s_sleep(8); }
}
struct EpiNull {
    static constexpr bool PERM = true, AFTER_DRAIN = false, MID = false;
    __device__ __forceinline__ void operator()(const pg8::f32x4 (&acc)[2][2][4][2], const pg8::Unit& u, int wr, int wc, int fr, int fq) const {
#pragma unroll
        for (int ai = 0; ai < 2; ++ai)
#pragma unroll
            for (int bj = 0; bj < 2; ++bj)
#pragma unroll
                for (int m = 0; m < 4; ++m) { asm volatile("" :: "v"(acc[ai][bj][m][0]), "v"(acc[ai][bj][m][1])); }
    }
};
__global__ void __launch_bounds__(NTHREADS, 2) fwd_kernel(Args args) {
    extern __shared__ __attribute__((aligned(16))) unsigned char lds[];
    Frame F;
    F.lds = (LAS unsigned char*)lds;
    F.MISC = (volatile LAS unsigned*)(F.lds + MISC_OFF);
    F.tid = threadIdx.x; F.lane = F.tid & 63; F.wave = __builtin_amdgcn_readfirstlane(F.tid >> 6);
    F.G = gridDim.x; F.bid = blockIdx.x; F.ws = args.ws;
    F.ctl = (gu32*)(args.ws + WS_CTL);
    for (int u = F.tid; u < (LDS_BYTES - LDSCTL_OFF) / 4; u += NTHREADS) ((LAS unsigned*)(F.lds + LDSCTL_OFF))[u] = 0u;
    __syncthreads();
    XcdBarrier bar; bar.bar = (unsigned*)(F.ctl + CW_BAR); bar.x = 0; bar.st = nullptr;
    if (MK_ONE_LAUNCH) bar = xcd_barrier_post((unsigned*)(F.ctl + CW_BAR), F.MISC + 8);
    const int lo = args.ph_lo, hi = args.ph_hi;
#define IN(k) (lo <= (k) && (k) < hi)
#define SEAM(k) do { if (IN(k) && IN((k) + 1)) xcd_barrier(bar); } while (0)
    unsigned char* ws = args.ws;
    const float* ada = (const float*)(ws + WS_ADA);

    if (IN(0)) { for (int rep = 0; rep < REP_P0; ++rep) { p0_prologue(F, args, rep == REP_P0 - 1); __syncthreads(); } } SEAM(0);
    if (IN(1)) { for (int rep = 0; rep < REP_P1; ++rep) {
        const int r0 = F.wave & 3;
        for (int k = 0; k < 4; ++k) { const int seg = (r0 + k) & 3;
            if (seg == 0) p0_stream_seg<0>(F, args); else if (seg == 1) p0_stream_seg<1>(F, args); else if (seg == 2) p0_stream_seg<2>(F, args);
            else modnorm_rows<false>(F, args.in[I_X], args.in[I_N1G], ada, 0, (bf16*)(ws + WS_H)); } } } SEAM(1);
    if (IN(2)) { {
        phase_stagger(F, STAG_P2);
        pg8::Gemm g{(const bf16*)(ws + WS_H), (const bf16*)(ws + WS_WIN_T), M, NIN, D, D, D}; pg8::StaticOrder S; S.init(M, NIN, F.G, F.bid, WGM_P2);
        if (F.tid == 0) F.MISC[40] = 0xffffffffu; __syncthreads();
        EpiIn E{ws, args.in[I_QNG], args.in[I_KNG], F.MISC + 40};
#if defined(PROBE_P2) && PROBE_P2 == 1
        { EpiNull EN; pg8::gemm_phase<EpiNull, pg8::StaticOrder, true, true>(F.lds + RING_OFF, g, S, EN); __syncthreads(); }
#elif defined(PROBE_P2) && PROBE_P2 == 2
        { if (F.tid == 0) F.MISC[40] = 0u; __syncthreads(); pg8::gemm_phase<EpiIn, pg8::StaticOrder, true, true>(F.lds + RING_OFF, g, S, E); __syncthreads(); if (F.tid == 0) F.MISC[40] = 0xffffffffu; __syncthreads(); }
#endif
        pg8::gemm_phase<EpiIn, pg8::StaticOrder, true, true>(F.lds + RING_OFF, g, S, E);
#if REP_P2 > 1
        __syncthreads(); pg8::gemm_phase<EpiIn, pg8::StaticOrder, true, true>(F.lds + RING_OFF, g, S, E);
#endif
        }
    } SEAM(2);
#ifndef PROBE_P3
#define PROBE_P3 0
#endif
    if (IN(3)) { for (int rep = 0; rep < REP_P3; ++rep) { __syncthreads(); pool_phase(F); if (PROBE_P3 == 1) { __syncthreads(); pool_phase(F); }
        __syncthreads(); compress_phase(F, args.in[I_KNG]); if (PROBE_P3 == 2) { __syncthreads(); compress_phase(F, args.in[I_KNG]); }
        __syncthreads(); vtranspose_phase(F); if (PROBE_P3 == 3) { __syncthreads(); vtranspose_phase(F); } } } SEAM(3);
    if (IN(4)) {
#ifdef PROBE_P4
        attention_phase<PROBE_P4>(F, args); __syncthreads();
#endif
        for (int rep = 0; rep < REP_P4; ++rep) { attention_phase<0>(F, args); __syncthreads(); } } SEAM(4);
    if (IN(5)) { {
        pg8::Gemm g{(const bf16*)(ws + WS_PL), (const bf16*)(ws + WS_WEFF_T), M, D, 2 * POOLW, 2 * POOLW, 2 * POOLW}; pg8::StaticOrder S; S.init(M, D, F.G, F.bid, WGM_P5);
        EpiMix2 E{(bf16*)(ws + WS_MIX), (const bf16*)(ws + WS_GM)};
        pg8::gemm_phase<EpiMix2, pg8::StaticOrder, true, true>(F.lds + RING_OFF, g, S, E);
#if REP_P5 > 1
        __syncthreads(); pg8::gemm_phase<EpiMix2, pg8::StaticOrder, true, true>(F.lds + RING_OFF, g, S, E);
#endif
        }
    } SEAM(5);
    if (IN(6)) { {
        pg8::Gemm g{(const bf16*)(ws + WS_MIX), (const bf16*)(ws + WS_WOUT_T), M, D, D, D, D}; pg8::StaticOrder S; S.init(M, D, F.G, F.bid, WGM_P6);
        EpiRes E{args.in[I_X], (bf16*)(ws + WS_X1), ada, 2};
        pg8::gemm_phase<EpiRes, pg8::StaticOrder, true, true>(F.lds + RING_OFF, g, S, E);
#if REP_P6 > 1
        __syncthreads(); pg8::gemm_phase<EpiRes, pg8::StaticOrder, true, true>(F.lds + RING_OFF, g, S, E);
#endif
        }
    } SEAM(6);
    if (IN(7)) { for (int rep = 0; rep < REP_P7; ++rep) modnorm_rows<true>(F, ws + WS_X1, args.in[I_N2G], ada, 3, (bf16*)(ws + WS_H)); } SEAM(7);
    if (IN(8)) { {
        pg8::Gemm g{(const bf16*)(ws + WS_H), (const bf16*)(ws + WS_WQ_T), M, PQW, D, D, D}; pg8::StaticOrder S; S.init(M, PQW, F.G, F.bid, WGM_P8);
        EpiStoreBf16 E{(bf16*)(ws + WS_QV), PQW};
        pg8::gemm_phase<EpiStoreBf16, pg8::StaticOrder, true, true>(F.lds + RING_OFF, g, S, E);
#if REP_P8 > 1
        __syncthreads(); pg8::gemm_phase<EpiStoreBf16, pg8::StaticOrder, true, true>(F.lds + RING_OFF, g, S, E);
#endif
        }
    } SEAM(8);
    if (IN(9)) { for (int rep = 0; rep < REP_P9; ++rep) peer_select_phase(F); } SEAM(9);
#ifdef PROBE_XCD
    if (IN(10)) { if (F.tid == 0) __hip_atomic_store((unsigned*)(F.ctl + 2048 + F.bid), 100u + xb_xcc_id(), RLX_AGENT); }
#endif
    if (IN(10)) {
#ifdef PROBE_DOT
        peer_dot_phase<PROBE_DOT>(F); __syncthreads();
#endif
#ifdef PROBE_LOADRATE
        peer_loadrate_probe<PROBE_LOADRATE>(F); __syncthreads();
#endif
        peer_dot_phase<0>(F); } SEAM(10);
    if (IN(11)) { for (int rep = 0; rep < REP_P11; ++rep) peer_coef_phase(F); } SEAM(11);
#ifdef PROBE_XCD
    if (IN(12) && F.bid == 0 && F.tid == 0) { bool ok = true; for (int i = 0; i < F.G; ++i) { const unsigned a = __hip_atomic_load((unsigned*)(F.ctl + 2048 + i), RLX_AGENT), b0 = __hip_atomic_load((unsigned*)(F.ctl + 2048 + (i & 7)), RLX_AGENT); if (a != b0 || a < 100u) ok = false; }
        for (int i = 0; i < 8; ++i) for (int q = 0; q < i; ++q) if (__hip_atomic_load((unsigned*)(F.ctl + 2048 + i), RLX_AGENT) == __hip_atomic_load((unsigned*)(F.ctl + 2048 + q), RLX_AGENT)) ok = false;
        if (!ok) args.out[12345] = 1.0e9f; }
    __syncthreads();
#endif
    if (IN(12)) {
#if defined(CHECK_OUT_MFMA)
        peer_out_mfma_phase<1>(F, ada, args.out); __syncthreads(); VM_WAIT(); __syncthreads(); peer_out_phase<false, true>(F, ada, args.out);
#elif defined(OUT_VALU)
        for (int rep = 1; rep < REP_P10; ++rep) peer_out_phase<true>(F, ada, args.out); peer_out_phase<false>(F, ada, args.out);
#else
#ifdef PROBE_OUT
        peer_out_mfma_phase<1>(F, ada, args.out); __syncthreads();
#endif
        peer_out_mfma_phase<0>(F, ada, args.out);
#endif
    }
#undef IN
#undef SEAM
}

#ifdef MK_PROBE_LDS
__global__ void __launch_bounds__(NTHREADS, 2) lds_probe_kernel(unsigned* outp) {
    extern __shared__ __attribute__((aligned(16))) unsigned char lds[];
    LAS unsigned char* L = (LAS unsigned char*)lds;
    const int lane = threadIdx.x & 63, l15 = lane & 15, lq = lane >> 4;
    for (int i = threadIdx.x; i < 16384 / 4; i += NTHREADS) ((LAS unsigned*)L)[i] = i;
    __syncthreads();
    int a0, a1;
#if MK_PROBE_LDS == 0
    a0 = lane * 16; a1 = lane * 16 + 1024;
#elif MK_PROBE_LDS == 1
    { const int ko0 = (8 * (l15 >> 2) + (l15 & 3)) * 128 + 16 * (lq ^ (((l15 >> 2) << 1) | ((l15 >> 1) & 1))); a0 = ko0; a1 = ko0 ^ 64; }
#else
    { const int vo0 = l15 * 128 + 16 * (lq ^ (l15 >> 1)); a0 = vo0; a1 = vo0 ^ 64; }
#endif
    asm volatile("" : "+v"(a0), "+v"(a1));
    v4u acc = (v4u){0u, 0u, 0u, 0u};
    for (int it = 0; it < 2048; ++it) {
#pragma unroll
        for (int q = 0; q < 4; ++q) { const v4u x = *(const LAS v4u*)(L + a0 + 2048 * q), y = *(const LAS v4u*)(L + a1 + 2048 * q); acc.x ^= x.x ^ y.x; acc.y ^= x.y ^ y.y; acc.z ^= x.z ^ y.z; acc.w ^= x.w ^ y.w; }
        asm volatile("" : "+v"(a0), "+v"(a1)); }
    if ((acc.x ^ acc.y ^ acc.z ^ acc.w) == 0x12345u) outp[threadIdx.x] = 1u;
}
#endif
#ifdef MK_PROBE_ATT
__global__ void __launch_bounds__(NTHREADS, 2) attn_probe_kernel(unsigned* outp, int nactive) {
    extern __shared__ __attribute__((aligned(16))) unsigned char lds[];
    LAS unsigned char* L = (LAS unsigned char*)lds;
    const int lane = threadIdx.x & 63, w = __builtin_amdgcn_readfirstlane(threadIdx.x >> 6), l15 = lane & 15, lq = lane >> 4;
    for (int i = threadIdx.x; i < 65536 / 4; i += NTHREADS) ((LAS unsigned*)L)[i] = 0x3c003c00u ^ (unsigned)(i * 2654435761u & 0x00ff00ffu);
    __syncthreads();
    if (w >= nactive) return;
    LAS float* IMP1 = (LAS float*)(L + 40000); LAS float* LROW = (LAS float*)(L + 60000) + w * 32; const LAS float* LUTJ = (const LAS float*)(L + 58000);
    bf16x8 qf[2][2];
#pragma unroll
    for (int rb = 0; rb < 2; ++rb)
#pragma unroll
        for (int ks = 0; ks < 2; ++ks) qf[rb][ks] = *(const LAS bf16x8*)(L + 32768 + (lane * 4 + rb * 2 + ks) * 16);
    pg8::f32x4 oacc[2][4]; pg8::f32x4 lacc[2] = {(pg8::f32x4){0.f, 0.f, 0.f, 0.f}, (pg8::f32x4){0.f, 0.f, 0.f, 0.f}};
#pragma unroll
    for (int rb = 0; rb < 2; ++rb)
#pragma unroll
        for (int db = 0; db < 4; ++db) oacc[rb][db] = (pg8::f32x4){0.f, 0.f, 0.f, 0.f};
    const int tok_r[2] = {8 * w + (l15 >> 2), 8 * w + 4 + (l15 >> 2)};
    unsigned selb[2] = {1u, 1u};
    int ko0 = (8 * (l15 >> 2) + (l15 & 3)) * 128 + 16 * (lq ^ (((l15 >> 2) << 1) | ((l15 >> 1) & 1))), vo0 = l15 * 128 + 16 * (lq ^ (l15 >> 1)); asm volatile("" : "+v"(ko0), "+v"(vo0));
    for (int it = 0; it < MK_PROBE_ATT_NT; ++it) {
        const LAS unsigned char* kb_ = L + (it & 1) * 8192; const LAS unsigned char* vb_ = L + 16384 + (it & 1) * 8192;
        at_tile<TM_WINF, 0>(kb_, vb_, LUTJ, IMP1, IMP1, qf, oacc, lacc, LROW, tok_r, selb, -3.0f, 0, 0, l15, lq, L + 50000, L + 50000, ko0, vo0);
    }
    float s = 0.f;
#pragma unroll
    for (int rb = 0; rb < 2; ++rb) { s += lacc[rb][0];
#pragma unroll
        for (int db = 0; db < 4; ++db) s += oacc[rb][db][0] + oacc[rb][db][3]; }
    if (s == 12345.678f) outp[threadIdx.x] = 1u;
}
#endif
#ifdef MK_PROBE_ATTV
__global__ void __launch_bounds__(NTHREADS, 2) att_only_kernel(Args args) {
    extern __shared__ __attribute__((aligned(16))) unsigned char lds[];
    Frame F;
    F.lds = (LAS unsigned char*)lds;
    F.MISC = (volatile LAS unsigned*)(F.lds + MISC_OFF);
    F.tid = threadIdx.x; F.lane = F.tid & 63; F.wave = __builtin_amdgcn_readfirstlane(F.tid >> 6);
    F.G = gridDim.x; F.bid = blockIdx.x; F.ws = args.ws;
    F.ctl = (gu32*)(args.ws + WS_CTL);
    attention_phase<MK_PROBE_ATTV>(F, args);
}
#endif
extern "C" void kernel_launch(void* const* d_in, const int* in_sizes, int n_in, void* d_out, int out_size, void* d_ws, size_t ws_size, hipStream_t stream) {
    static int grid = 0;
    if (grid == 0) {
        if (n_in != N_IN || in_sizes[0] != M * D || out_size != M * D || ws_size < WS_END) {
            fprintf(stderr, "kernel_launch: unexpected shapes: n_in %d in0 %d out %d ws %zu (need %zu)\n", n_in, n_in > 0 ? in_sizes[0] : -1, out_size, ws_size, (size_t)WS_END); grid = -1; return; }
        int dev = 0, cus = 0, per_cu = 0;
        if (hipGetDevice(&dev) != hipSuccess || hipDeviceGetAttribute(&cus, hipDeviceAttributeMultiprocessorCount, dev) != hipSuccess) { grid = -1; return; }
        if (hipFuncSetAttribute((const void*)fwd_kernel, hipFuncAttributeMaxDynamicSharedMemorySize, LDS_BYTES) != hipSuccess) { fprintf(stderr, "kernel_launch: hipFuncSetAttribute failed\n"); grid = -1; return; }
        if (hipOccupancyMaxActiveBlocksPerMultiprocessor(&per_cu, (const void*)fwd_kernel, NTHREADS, LDS_BYTES) != hipSuccess || per_cu < 1)
            fprintf(stderr, "kernel_launch: occupancy query reports %d workgroups per CU\n", per_cu);
        (void)hipGetLastError();
        grid = cus;
    }
    if (grid < 0) return;
    if (hipMemsetAsync((char*)d_ws + WS_CTL, 0, CTL_ZERO_BYTES, stream) != hipSuccess) return;
#ifdef MK_PROBE_ATT
    (void)hipFuncSetAttribute((const void*)attn_probe_kernel, hipFuncAttributeMaxDynamicSharedMemorySize, 65536);
    hipLaunchKernelGGL(attn_probe_kernel, dim3(grid), dim3(NTHREADS), 65536, stream, (unsigned*)((char*)d_ws + WS_H), MK_PROBE_ATT);
#endif
#ifdef MK_PROBE_LDS
    hipLaunchKernelGGL(lds_probe_kernel, dim3(grid), dim3(NTHREADS), 16384, stream, (unsigned*)((char*)d_ws + WS_H));
#endif
    Args a{};
    for (int i = 0; i < N_IN; ++i) a.in[i] = (const float*)d_in[i];
    a.out = (float*)d_out; a.ws = (unsigned char*)d_ws;
    if (MK_ONE_LAUNCH) {
        a.ph_lo = 0; a.ph_hi = N_PHASES; a.li = 0;
        hipLaunchKernelGGL(fwd_kernel, dim3(grid), dim3(NTHREADS), LDS_BYTES, stream, a);
    } else {
        for (int p = 0; p < N_PHASES; ++p) {
            a.ph_lo = p; a.ph_hi = p + 1; a.li = p;
            hipLaunchKernelGGL(fwd_kernel, dim3(grid), dim3(NTHREADS), LDS_BYTES, stream, a);
        }
    }
#ifdef MK_PROBE_ATTV
    (void)hipFuncSetAttribute((const void*)att_only_kernel, hipFuncAttributeMaxDynamicSharedMemorySize, LDS_BYTES);
    hipLaunchKernelGGL(att_only_kernel, dim3(grid), dim3(NTHREADS), LDS_BYTES, stream, a);
#endif
}
```
